# Optimizing an MI355X kernel written in HIP

```python
import jax, jax.numpy as jnp
from jax import lax
import numpy as np

D_MODEL = 2048
BATCH = 4
SEQ = 8192
DEPTH = 2

MLA_HEADS = 8
MLA_NOPE = 128
MLA_ROPE = 64
MLA_V = 128
MLA_Q_LORA = D_MODEL // 4
MLA_KV_LORA = D_MODEL // 8
ROPE_THETA = 10000.0
Q_BLOCK = 128
DIL_HEADS = 8
DIL_HEAD_DIM = 128
DIL_WINDOWS = (128, 512, 2048)
DIL_RATES = (1, 4, 16)
DIL_WIDTH = DIL_HEADS * DIL_HEAD_DIM
MLA_WIDTH = MLA_HEADS * MLA_V
MIX_WIDTH = MLA_WIDTH + DIL_WIDTH
IN_COLS = MLA_Q_LORA + MLA_KV_LORA + MLA_ROPE + 3 * DIL_WIDTH
N_EXPERTS = 16
N_GROUPS = 4
TOP_K = 2
D_EXPERT = D_MODEL // 2
EXPERT_BLOCK = 256
N_ADA = 6
EPS = 1e-6
F32 = jnp.float32

kernel_name = "hybrid_mla_dilated_alibi_grouped_moe"


def rms_norm(x, g):
    xf = x.astype(F32)
    y = xf * lax.rsqrt(jnp.mean(xf * xf, axis=-1, keepdims=True) + EPS)
    return (y * g.astype(F32)).astype(x.dtype)


def rope(x, pos):
    r = x.shape[-1]
    half = r // 2
    inv = ROPE_THETA ** (-jnp.arange(half, dtype=F32) * 2.0 / r)
    ang = pos.astype(F32)[:, None] * inv[None, :]
    cos = jnp.cos(ang)[None, :, None, :]
    sin = jnp.sin(ang)[None, :, None, :]
    x1 = x[..., :half].astype(F32)
    x2 = x[..., half:].astype(F32)
    return jnp.concatenate([x1 * cos - x2 * sin, x2 * cos + x1 * sin], axis=-1).astype(x.dtype)


def alibi_slopes(n):
    return jnp.asarray([2.0 ** (-8.0 * (i + 1) / n) for i in range(n)], dtype=F32)


def causal_block_attention(q, k, v, scale):
    b, s, h, e = q.shape
    nq = s // Q_BLOCK
    qb = q.reshape(b, nq, Q_BLOCK, h, e).transpose(1, 0, 2, 3, 4)
    kpos = jnp.arange(s)

    def one_block(args):
        qblk, i = args
        sc = jnp.einsum('bqhe,bkhe->bhqk', qblk, k, preferred_element_type=F32) * scale
        qpos = i * Q_BLOCK + jnp.arange(Q_BLOCK)
        sc = jnp.where(kpos[None, :] <= qpos[:, None], sc, -jnp.inf)
        p = jax.nn.softmax(sc, axis=-1)
        return jnp.einsum('bhqk,bkhe->bqhe', p.astype(v.dtype), v)

    o = lax.map(one_block, (qb, jnp.arange(nq)))
    return o.transpose(1, 0, 2, 3, 4).reshape(b, s, h, v.shape[-1])


def dilated_branch(q, k, v, window, rate, slopes):
    b, s, h, e = q.shape
    band = window // rate
    n_sub = s // rate
    nb = -(-n_sub // band)
    n_pad = nb * band
    scale = e ** -0.5

    def by_stride(t):
        t = t.reshape(b, n_sub, rate, h, e)
        return jnp.pad(t, ((0, 0), (0, n_pad - n_sub), (0, 0), (0, 0), (0, 0)))

    def windows(t):
        t = jnp.pad(by_stride(t), ((0, 0), (band, 0), (0, 0), (0, 0), (0, 0)))
        t = t.reshape(b, nb + 1, band, rate, h, e)
        return jnp.concatenate([t[:, :-1], t[:, 1:]], axis=2)

    qs = by_stride(q).reshape(b, nb, band, rate, h, e)
    kw = windows(k)
    vw = windows(v)
    sc = jnp.einsum('bnqrhe,bnkrhe->bnrhqk', qs, kw, preferred_element_type=F32) * scale
    qi = jnp.arange(band)[:, None]
    kj = jnp.arange(2 * band)[None, :]
    delta = qi + band - kj
    blk = jnp.arange(nb)[:, None, None]
    valid = (delta >= 0) & (delta <= band) & (blk * band + kj - band >= 0)
    bias = -slopes[:, None, None] * (rate * delta).astype(F32)[None]
    sc = jnp.where(valid[None, :, None, None], sc + bias[None, None, None], -jnp.inf)
    lse = jax.nn.logsumexp(sc, axis=-1)
    p = jnp.exp(sc - lse[..., None])
    o = jnp.einsum('bnrhqk,bnkrhe->bnqrhe', p.astype(v.dtype), vw)
    o = o.reshape(b, n_pad, rate, h, e)[:, :n_sub].reshape(b, s, h, e)
    lse = lse.transpose(0, 1, 4, 2, 3).reshape(b, n_pad, rate, h)[:, :n_sub].reshape(b, s, h)
    return o, lse


def hybrid_mixer(h, w_in, q_norm_g, kv_norm_g, w_uq, w_ukv, out_norm_a_g, out_norm_b_g, w_out):
    b, s, _ = h.shape
    proj = h @ w_in
    o1 = MLA_Q_LORA
    o2 = o1 + MLA_KV_LORA
    o3 = o2 + MLA_ROPE
    o4 = o3 + DIL_WIDTH
    o5 = o4 + DIL_WIDTH
    c_q, c_kv, k_rope, q_b, k_b, v_b = jnp.split(proj, [o1, o2, o3, o4, o5], axis=-1)
    pos = jnp.arange(s)

    q_a = (rms_norm(c_q, q_norm_g) @ w_uq).reshape(b, s, MLA_HEADS, MLA_NOPE + MLA_ROPE)
    kv_a = (rms_norm(c_kv, kv_norm_g) @ w_ukv).reshape(b, s, MLA_HEADS, MLA_NOPE + MLA_V)
    q_a = jnp.concatenate([q_a[..., :MLA_NOPE], rope(q_a[..., MLA_NOPE:], pos)], axis=-1)
    k_r = rope(k_rope[:, :, None, :], pos)
    k_a = jnp.concatenate([kv_a[..., :MLA_NOPE], jnp.broadcast_to(k_r, (b, s, MLA_HEADS, MLA_ROPE))], axis=-1)
    v_a = kv_a[..., MLA_NOPE:]
    o_a = causal_block_attention(q_a, k_a, v_a, (MLA_NOPE + MLA_ROPE) ** -0.5).reshape(b, s, MLA_WIDTH)

    qd = q_b.reshape(b, s, DIL_HEADS, DIL_HEAD_DIM)
    kd = k_b.reshape(b, s, DIL_HEADS, DIL_HEAD_DIM)
    vd = v_b.reshape(b, s, DIL_HEADS, DIL_HEAD_DIM)
    slopes = alibi_slopes(DIL_HEADS)
    outs = []
    lses = []
    for window, rate in zip(DIL_WINDOWS, DIL_RATES):
        o_i, l_i = dilated_branch(qd, kd, vd, window, rate, slopes)
        outs.append(o_i)
        lses.append(l_i)
    alpha = jax.nn.softmax(jnp.stack(lses, axis=0), axis=0)
    o_b = jnp.einsum('nbsh,nbshe->bshe', alpha.astype(vd.dtype), jnp.stack(outs, axis=0)).reshape(b, s, DIL_WIDTH)

    y = jnp.concatenate([rms_norm(o_a, out_norm_a_g), rms_norm(o_b, out_norm_b_g)], axis=-1)
    return y @ w_out


def route(hf, router_w, router_b):
    t = hf.shape[0]
    scores = jax.nn.sigmoid((hf @ router_w).astype(F32))
    biased = scores + router_b.astype(F32)
    grouped = biased.reshape(t, N_GROUPS, N_EXPERTS // N_GROUPS)
    group_score = lax.top_k(grouped, 2)[0].sum(-1)
    g_sel = jnp.argmax(group_score, axis=-1)
    in_group = (jnp.arange(N_EXPERTS) // (N_EXPERTS // N_GROUPS))[None, :] == g_sel[:, None]
    _, idx = lax.top_k(jnp.where(in_group, biased, -jnp.inf), TOP_K)
    w = jnp.take_along_axis(scores, idx, axis=-1)
    w = w / jnp.sum(w, axis=-1, keepdims=True)
    return idx, w


def moe(h, router_w, router_b, w_gate, w_up, w_down):
    b, s, d = h.shape
    t = b * s
    hf = h.reshape(t, d)
    idx, wts = route(hf, router_w, router_b)
    n_assign = t * TOP_K
    flat_e = idx.reshape(-1)
    flat_tok = jnp.arange(n_assign, dtype=jnp.int32) // TOP_K
    flat_w = wts.reshape(-1)
    order = jnp.argsort(flat_e)
    e_sorted = flat_e[order]
    counts = jnp.bincount(flat_e, length=N_EXPERTS)
    padded = (counts + EXPERT_BLOCK - 1) // EXPERT_BLOCK * EXPERT_BLOCK
    pad_end = jnp.cumsum(padded)
    pad_start = pad_end - padded
    start = jnp.cumsum(counts) - counts
    dest = pad_start[e_sorted] + (jnp.arange(n_assign) - start[e_sorted])
    n_rows = n_assign + N_EXPERTS * EXPERT_BLOCK
    n_blocks = n_rows // EXPERT_BLOCK
    row_tok = jnp.full((n_rows,), t, dtype=jnp.int32).at[dest].set(flat_tok[order])
    row_w = jnp.zeros((n_rows,), h.dtype).at[dest].set(flat_w[order].astype(h.dtype))
    blk_e = jnp.minimum(jnp.searchsorted(pad_end, jnp.arange(n_blocks) * EXPERT_BLOCK, side='right'), N_EXPERTS - 1)
    h_pad = jnp.concatenate([hf, jnp.zeros((1, d), hf.dtype)], axis=0)

    def expert_block(args):
        tok, wt, e = args
        xb = h_pad[tok]
        a = xb @ w_gate[e]
        u = xb @ w_up[e]
        return ((jax.nn.silu(a) * u) @ w_down[e]) * wt[:, None]

    y = lax.map(expert_block, (row_tok.reshape(n_blocks, EXPERT_BLOCK), row_w.reshape(n_blocks, EXPERT_BLOCK), blk_e))
    out = jnp.zeros((t + 1, d), h.dtype).at[row_tok].add(y.reshape(n_rows, d))[:t]
    return out.reshape(b, s, d)


def setup_inputs(seed: int = 0) -> dict:
    key = jax.random.key(seed)
    ks = jax.random.split(key, 20)
    nrm = jax.random.normal
    L = DEPTH
    return {
        "x": nrm(ks[0], (BATCH, SEQ, D_MODEL), F32),
        "c": nrm(ks[1], (BATCH, D_MODEL), F32),
        "ada_w": nrm(ks[2], (L, D_MODEL, N_ADA * D_MODEL), F32) * (0.5 * D_MODEL ** -0.5),
        "ada_b": nrm(ks[3], (L, N_ADA * D_MODEL), F32) * 0.02,
        "norm1_g": 1.0 + 0.05 * nrm(ks[4], (L, D_MODEL), F32),
        "norm2_g": 1.0 + 0.05 * nrm(ks[5], (L, D_MODEL), F32),
        "w_in": nrm(ks[6], (L, D_MODEL, IN_COLS), F32) * D_MODEL ** -0.5,
        "q_norm_g": 1.0 + 0.05 * nrm(ks[7], (L, MLA_Q_LORA), F32),
        "kv_norm_g": 1.0 + 0.05 * nrm(ks[8], (L, MLA_KV_LORA), F32),
        "w_uq": nrm(ks[9], (L, MLA_Q_LORA, MLA_HEADS * (MLA_NOPE + MLA_ROPE)), F32) * MLA_Q_LORA ** -0.5,
        "w_ukv": nrm(ks[10], (L, MLA_KV_LORA, MLA_HEADS * (MLA_NOPE + MLA_V)), F32) * MLA_KV_LORA ** -0.5,
        "out_norm_a_g": 1.0 + 0.05 * nrm(ks[11], (L, MLA_WIDTH), F32),
        "out_norm_b_g": 1.0 + 0.05 * nrm(ks[12], (L, DIL_WIDTH), F32),
        "w_out": nrm(ks[13], (L, MIX_WIDTH, D_MODEL), F32) * MIX_WIDTH ** -0.5,
        "router_w": nrm(ks[14], (D_MODEL, N_EXPERTS), F32) * D_MODEL ** -0.5,
        "router_b": nrm(ks[15], (N_EXPERTS,), F32) * 0.01,
        "exp_gate": nrm(ks[16], (L, N_EXPERTS, D_MODEL, D_EXPERT), F32) * D_MODEL ** -0.5,
        "exp_up": nrm(ks[17], (L, N_EXPERTS, D_MODEL, D_EXPERT), F32) * D_MODEL ** -0.5,
        "exp_down": nrm(ks[18], (L, N_EXPERTS, D_EXPERT, D_MODEL), F32) * D_EXPERT ** -0.5,
        "final_g": 1.0 + 0.05 * nrm(ks[19], (D_MODEL,), F32),
    }


def reference(x, c, ada_w, ada_b, norm1_g, norm2_g, w_in, q_norm_g, kv_norm_g, w_uq, w_ukv,
              out_norm_a_g, out_norm_b_g, w_out, router_w, router_b, exp_gate, exp_up, exp_down, final_g):
    c_act = jax.nn.silu(c)
    for l in range(DEPTH):
        mod = (c_act @ ada_w[l] + ada_b[l])[:, None, :]
        sh1, sc1, g1, sh2, sc2, g2 = jnp.split(mod, N_ADA, axis=-1)
        h = rms_norm(x, norm1_g[l]) * (1.0 + sc1) + sh1
        x = x + g1 * hybrid_mixer(h, w_in[l], q_norm_g[l], kv_norm_g[l], w_uq[l], w_ukv[l],
                                  out_norm_a_g[l], out_norm_b_g[l], w_out[l])
        h = rms_norm(x, norm2_g[l]) * (1.0 + sc2) + sh2
        x = x + g2 * moe(h, router_w, router_b, exp_gate[l], exp_up[l], exp_down[l])
    return rms_norm(x, final_g)
```

```cpp
#define MK_PER_PHASE 0
#define XRES_BF16 1
#define ATT_QROPE 1
#include <hip/hip_runtime.h>
#include <cstdio>
#include <cstdint>
#include <cstring>
#include <cmath>
namespace pg8 {
#define PG8_LAS __attribute__((address_space(3)))
typedef unsigned short bf16_t;
typedef short bf16x8 __attribute__((ext_vector_type(8)));
typedef float f32x4 __attribute__((ext_vector_type(4)));
typedef float f32x2 __attribute__((ext_vector_type(2)));
typedef unsigned u32x4 __attribute__((ext_vector_type(4)));
typedef int v4i_t __attribute__((ext_vector_type(4)));
typedef int v8i_t __attribute__((ext_vector_type(8)));
constexpr int BM = 256, BK = 64, HALF = 128, HTB = HALF * BK * 2  , STAGE_BYTES = 8 * HTB, NXCD = 8, WGM = 8;

__host__ __device__ __forceinline__ int lds_byte(int r, int c) { const int st = (r >> 4) * 2 + (c >> 5), rr = r & 15, cc = c & 31, ob = rr * 64 + cc * 2; return st * 1024 + (ob ^ (((ob >> 9) & 1) << 5)); }
__host__ __device__ __forceinline__ void stage_rc(int b, int& R, int& C) { const int st = b / 1024, sb = b % 1024, swz = sb ^ (((sb >> 9) & 1) << 5); R = (st >> 1) * 16 + swz / 64; C = (st & 1) * 32 + (swz % 64) / 2; }
__host__ __device__ __forceinline__ int perm32(int rho) { const int n = rho >> 4, i = rho & 15; return 8 * (i >> 2) + 4 * n + (i & 3); }

struct Unit { int pm, pn, pb, e, lt; };
struct Gemm { const void* A; const void* Bt; int Kb; };

__device__ __forceinline__ bool order_tile(int i, int G, int c, int nM, int nN, int& pm, int& pn) {
    const int nwg = nM * nN; const long L = (long)i * G + c; if (L >= nwg) return false;
    int wgid = (int)L; { const int q = nwg / NXCD, r = nwg % NXCD, xcd = wgid % NXCD, off = wgid / NXCD; wgid = (xcd < r ? xcd * (q + 1) : r * (q + 1) + (xcd - r) * q) + off; }
    const int nig = WGM * nN, gid = wgid / nig, fm = gid * WGM, gsz = (nM - fm) < WGM ? (nM - fm) : WGM;
    pm = fm + ((wgid % nig) % gsz); pn = (wgid % nig) / gsz; return true;
}
struct StaticOrder {
    int nM, nN, G, c;
    __device__ __forceinline__ void init(int M, int N, int G_, int c_) { nM = M / BM; nN = N / BM; G = G_; c = c_; }
    __device__ __forceinline__ bool next(int i, Unit& u) const { int pm, pn; if (!order_tile(i, G, c, nM, nN, pm, pn)) return false; u.pm = pm; u.pn = pn; u.pb = pn; u.e = 0; u.lt = 0; return true; }
};
struct MoeOrder {
    int nM, nN, G, c; const PG8_LAS int* ts;
    __device__ __forceinline__ bool next(int i, Unit& u) const {
        int pm, pn; if (i >= 10 || !order_tile(i, G, c, nM, nN, pm, pn)) return false;
        int e = 0;
#pragma unroll
        for (int j = 1; j < 16; ++j) e += (__builtin_amdgcn_readfirstlane(ts[j]) <= pm) ? 1 : 0;
        e = __builtin_amdgcn_readfirstlane(e); u.pm = pm; u.pn = pn; u.e = e; u.lt = pm - __builtin_amdgcn_readfirstlane(ts[e]); u.pb = e * nN + pn; return true;
    }
};
struct ALinear { __device__ __forceinline__ unsigned off(const Unit& u, int slot, int r, int Kb) const { return (unsigned)(u.pm * BM + r) * (unsigned)Kb; } };
struct APitch  { unsigned pitchB; __device__ __forceinline__ unsigned off(const Unit& u, int slot, int r, int K) const { return (unsigned)(u.pm * BM + r) * pitchB; } };
struct ATable  { const PG8_LAS unsigned* tab; __device__ __forceinline__ unsigned off(const Unit& u, int slot, int r, int K) const { return tab[slot * BM + r]; } };

typedef __bf16 bf16x2_t __attribute__((ext_vector_type(2)));
__device__ __forceinline__ unsigned cvt_pk_bf16(float lo, float hi) { const f32x2 v = {lo, hi}; return __builtin_bit_cast(unsigned, __builtin_convertvector(v, bf16x2_t)); }

typedef f32x4 Acc[2][2][4][2];

typedef __amdgpu_buffer_rsrc_t rsrc_t;
#define PG8_RSRC(p) __builtin_amdgcn_make_buffer_rsrc((void*)(p), 0, 0x7fffffff, 0x00020000)
__device__ __forceinline__ void st16(rsrc_t r, int vo, int so, u32x4 v) { __builtin_amdgcn_raw_buffer_store_b128(v, r, vo, so, 0); }
__device__ __forceinline__ f32x4 ld16f(rsrc_t r, int vo, int so) { return __builtin_bit_cast(f32x4, __builtin_amdgcn_raw_buffer_load_b128(r, vo, so, 0)); }
__device__ __forceinline__ float ld4f(rsrc_t r, int vo, int so) { return __uint_as_float(__builtin_amdgcn_raw_buffer_load_b32(r, vo, so, 0)); }
__device__ __forceinline__ u32x4 pack8(const f32x4 v0, const f32x4 v1) { u32x4 w; w.x = cvt_pk_bf16(v0[0], v0[1]); w.y = cvt_pk_bf16(v0[2], v0[3]); w.z = cvt_pk_bf16(v1[0], v1[1]); w.w = cvt_pk_bf16(v1[2], v1[3]); return w; }
struct EpiPlain {
    static constexpr bool PERM = true;
    bf16_t* O; int ldc;
    __device__ __forceinline__ void operator()(const Acc& acc, const Unit& u, int wr, int wc, int fr, int fq) const {
        const rsrc_t ro = PG8_RSRC(O); const int vo = (fr * ldc + wc * 32 + 8 * fq) * 2;
#pragma unroll
        for (int ai = 0; ai < 2; ++ai)
#pragma unroll
            for (int m = 0; m < 4; ++m) { const int so = ((u.pm * BM + wr * 64 + ai * HALF + m * 16) * ldc + u.pn * BM) * 2;
#pragma unroll
                for (int bj = 0; bj < 2; ++bj) st16(ro, vo, so + bj * HALF * 2, pack8(acc[ai][bj][m][0], acc[ai][bj][m][1])); }
    }
};
struct EpiQup {
    static constexpr bool PERM = true;
    bf16_t* O; const float* rstd;
    __device__ __forceinline__ void operator()(const Acc& acc, const Unit& u, int wr, int wc, int fr, int fq) const {
        const rsrc_t ro = PG8_RSRC(O), rr = PG8_RSRC(rstd);
        const int vo = (fr * 1536 + wc * 32 + 8 * fq) * 2;
        float rs[2][4];
#pragma unroll
        for (int ai = 0; ai < 2; ++ai)
#pragma unroll
            for (int m = 0; m < 4; ++m) rs[ai][m] = ld4f(rr, fr * 4, (u.pm * BM + wr * 64 + ai * HALF + m * 16) * 4);
#pragma unroll
        for (int ai = 0; ai < 2; ++ai)
#pragma unroll
            for (int m = 0; m < 4; ++m) { const int rowu = u.pm * BM + wr * 64 + ai * HALF + m * 16; const float r1 = rs[ai][m];
                const int so = (rowu * 1536 + u.pn * BM) * 2;
                st16(ro, vo, so, pack8(acc[ai][0][m][0] * r1, acc[ai][0][m][1] * r1));
                st16(ro, vo, so + HALF * 2, pack8(acc[ai][1][m][0] * r1, acc[ai][1][m][1] * r1)); }
    }
};
struct EpiKVup {
    static constexpr bool PERM = true;
    bf16_t* KF; bf16_t* VB; const float* rstd;
    __device__ __forceinline__ void operator()(const Acc& acc, const Unit& u, int wr, int wc, int fr, int fq) const {
        const rsrc_t rk = PG8_RSRC(KF), rv = PG8_RSRC(VB), rr = PG8_RSRC(rstd);
        const int c0 = wc * 32 + 8 * fq, vok = (fr * 1536 + c0) * 2, vov = (fr * 1024 + c0) * 2;
        float rs[2][4];
#pragma unroll
        for (int ai = 0; ai < 2; ++ai)
#pragma unroll
            for (int m = 0; m < 4; ++m) rs[ai][m] = ld4f(rr, fr * 4, (u.pm * BM + wr * 64 + ai * HALF + m * 16) * 4);
#pragma unroll
        for (int ai = 0; ai < 2; ++ai)
#pragma unroll
            for (int m = 0; m < 4; ++m) { const int rowu = u.pm * BM + wr * 64 + ai * HALF + m * 16; const float r1 = rs[ai][m];
                st16(rk, vok, (rowu * 1536 + u.pn * 192) * 2, pack8(acc[ai][0][m][0] * r1, acc[ai][0][m][1] * r1));
                st16(rv, vov, (rowu * 1024 + u.pn * 128) * 2, pack8(acc[ai][1][m][0] * r1, acc[ai][1][m][1] * r1)); }
    }
};
struct EpiResid {
    static constexpr bool PERM = false;
    const float* base; float* out; const float* gate; int ldc; int gld; float ascale;
    __device__ __forceinline__ void operator()(const Acc& acc, const Unit& u, int wr, int wc, int fr, int fq) const {
        const rsrc_t rb = PG8_RSRC(base), ro = PG8_RSRC(out), rg = PG8_RSRC(gate);
        const int cl = (wc * 32 + 4 * fq) * 4, vo = fr * ldc * 4 + cl;
        f32x4 gv[2][2];
#pragma unroll
        for (int bj = 0; bj < 2; ++bj)
#pragma unroll
            for (int n = 0; n < 2; ++n) gv[bj][n] = ld16f(rg, cl, (((u.pm * BM) >> 13) * gld + u.pn * BM + bj * HALF + n * 16) * 4) * ascale;
#pragma unroll
        for (int ai = 0; ai < 2; ++ai) {
            f32x4 bs[4][2][2];
#pragma unroll
            for (int m = 0; m < 4; ++m) { const int so = ((u.pm * BM + ai * HALF + wr * 64 + m * 16) * ldc + u.pn * BM) * 4;
#pragma unroll
                for (int bj = 0; bj < 2; ++bj)
#pragma unroll
                    for (int n = 0; n < 2; ++n) bs[m][bj][n] = ld16f(rb, vo, so + (bj * HALF + n * 16) * 4); }
#pragma unroll
            for (int m = 0; m < 4; ++m) { const int so = ((u.pm * BM + ai * HALF + wr * 64 + m * 16) * ldc + u.pn * BM) * 4;
#pragma unroll
                for (int bj = 0; bj < 2; ++bj)
#pragma unroll
                    for (int n = 0; n < 2; ++n) st16(ro, vo, so + (bj * HALF + n * 16) * 4, __builtin_bit_cast(u32x4, bs[m][bj][n] + gv[bj][n] * acc[ai][bj][m][n])); }
            asm volatile("s_waitcnt vmcnt(0)" ::: "memory");
        }
    }
};
struct EpiResidB {
    static constexpr bool PERM = true;
    const void* base; bf16_t* out; const float* gate; int gld; float ascale; int BASE_F32;
    __device__ __forceinline__ void operator()(const Acc& acc, const Unit& u, int wr, int wc, int fr, int fq) const {
        const rsrc_t rb = PG8_RSRC(base), ro = PG8_RSRC(out), rg = PG8_RSRC(gate);
        const int c0 = wc * 32 + 8 * fq;
        f32x4 gv[2][2];
#pragma unroll
        for (int bj = 0; bj < 2; ++bj)
#pragma unroll
            for (int n = 0; n < 2; ++n) gv[bj][n] = ld16f(rg, (c0 + 4 * n) * 4, (((u.pm * BM) >> 13) * gld + u.pn * BM + bj * HALF) * 4) * ascale;
#pragma unroll
        for (int ai = 0; ai < 2; ++ai) {
            f32x4 bs[4][2][2];
#pragma unroll
            for (int m = 0; m < 4; ++m) { const int rowu = u.pm * BM + ai * HALF + wr * 64 + m * 16;
#pragma unroll
                for (int bj = 0; bj < 2; ++bj) {
                    if (BASE_F32) { const int so = (rowu * 2048 + u.pn * BM + bj * HALF) * 4, vo = (fr * 2048 + c0) * 4;
                        bs[m][bj][0] = ld16f(rb, vo, so); bs[m][bj][1] = ld16f(rb, vo + 16, so); }
                    else { const int so = (rowu * 2048 + u.pn * BM + bj * HALF) * 2, vo = (fr * 2048 + c0) * 2;
                        const u32x4 w = __builtin_bit_cast(u32x4, __builtin_amdgcn_raw_buffer_load_b128(rb, vo, so, 0));
                        bs[m][bj][0] = (f32x4){__uint_as_float(w.x << 16), __uint_as_float(w.x & 0xffff0000u), __uint_as_float(w.y << 16), __uint_as_float(w.y & 0xffff0000u)};
                        bs[m][bj][1] = (f32x4){__uint_as_float(w.z << 16), __uint_as_float(w.z & 0xffff0000u), __uint_as_float(w.w << 16), __uint_as_float(w.w & 0xffff0000u)}; } } }
#pragma unroll
            for (int m = 0; m < 4; ++m) { const int rowu = u.pm * BM + ai * HALF + wr * 64 + m * 16;
#pragma unroll
                for (int bj = 0; bj < 2; ++bj) st16(ro, (fr * 2048 + c0) * 2, (rowu * 2048 + u.pn * BM + bj * HALF) * 2,
                                                    pack8(bs[m][bj][0] + gv[bj][0] * acc[ai][bj][m][0], bs[m][bj][1] + gv[bj][1] * acc[ai][bj][m][1])); }
            asm volatile("s_waitcnt vmcnt(0)" ::: "memory");
        }
    }
};
struct EpiSwiglu {
    static constexpr bool PERM = true;
    unsigned char* O; int ldc;
    __device__ __forceinline__ void operator()(const Acc& acc, const Unit& u, int wr, int wc, int fr, int fq) const {
        const rsrc_t ro = PG8_RSRC(O); const int vo = fr * ldc + wc * 32 + 8 * fq;
#pragma unroll
        for (int ai = 0; ai < 2; ++ai)
#pragma unroll
            for (int m = 0; m < 4; ++m) { const int so = (u.pm * BM + wr * 64 + ai * HALF + m * 16) * ldc + u.pn * HALF; float r[8];
#pragma unroll
                for (int n = 0; n < 2; ++n)
#pragma unroll
                    for (int k = 0; k < 4; ++k) { const float g = acc[ai][0][m][n][k] * (1.0f / 256.0f), up = acc[ai][1][m][n][k] * (1.0f / 256.0f);
                        r[n * 4 + k] = g * __builtin_amdgcn_rcpf(1.0f + __builtin_amdgcn_exp2f(-1.4426950408889634f * g)) * up; }
                int w0 = 0, w1 = 0;
                w0 = __builtin_amdgcn_cvt_pk_fp8_f32(r[0], r[1], w0, false); w0 = __builtin_amdgcn_cvt_pk_fp8_f32(r[2], r[3], w0, true);
                w1 = __builtin_amdgcn_cvt_pk_fp8_f32(r[4], r[5], w1, false); w1 = __builtin_amdgcn_cvt_pk_fp8_f32(r[6], r[7], w1, true);
                typedef unsigned u32x2_t __attribute__((ext_vector_type(2)));
                __builtin_amdgcn_raw_buffer_store_b64((u32x2_t){(unsigned)w0, (unsigned)w1}, ro, vo, so, 0); }
    }
};
struct EpiMoeDown {
    static constexpr bool PERM = true;
    bf16_t* Y; const int* rowidx; const float* aw; const unsigned* cnt;
    __device__ __forceinline__ void operator()(const Acc& acc, const Unit& u, int wr, int wc, int fr, int fq) const {
        const rsrc_t ry = PG8_RSRC(Y), ri = PG8_RSRC(rowidx), ra = PG8_RSRC(aw);
        const int nvalid = (int)cnt[u.e] - u.lt * BM; const int cb = (u.pn * BM + wc * 32 + 8 * fq) * 2;
        int idx[2][4]; float w8[2][4];
#pragma unroll
        for (int ai = 0; ai < 2; ++ai)
#pragma unroll
            for (int m = 0; m < 4; ++m) { const int ru = ai * HALF + wr * 64 + m * 16; idx[ai][m] = -1; w8[ai][m] = 0.f;
                if (ru + fr < nvalid) { idx[ai][m] = (int)__builtin_amdgcn_raw_buffer_load_b32(ri, fr * 4, (u.e * 32768 + u.lt * BM + ru) * 4, 0); w8[ai][m] = ld4f(ra, idx[ai][m] * 4, 0); } }
#pragma unroll
        for (int ai = 0; ai < 2; ++ai)
#pragma unroll
            for (int m = 0; m < 4; ++m) if (idx[ai][m] >= 0) { const int vo = idx[ai][m] * 4096 + cb; const float w1 = w8[ai][m] * (1.0f / 256.0f);
#pragma unroll
                for (int bj = 0; bj < 2; ++bj) st16(ry, vo, bj * HALF * 2, pack8(acc[ai][bj][m][0] * w1, acc[ai][bj][m][1] * w1)); }
    }
};

template <class Epi, class Sched, class AOff, bool FP8 = false>
__device__ __forceinline__ void gemm_phase(PG8_LAS unsigned char* lds, const Gemm g, const Sched& S, const AOff& AO, const Epi& E, int tid_in) {
    int tid = tid_in; asm volatile("" : "+v"(tid));
    const int wid = __builtin_amdgcn_readfirstlane(tid >> 6), lane = tid & 63, wr = wid >> 2, wc = wid & 3, fr = lane & 15, fq = lane >> 4;
    int K = g.Kb; asm volatile("" : "+s"(K));
    const int nt = K / (BK * 2);
    int Ra[2], Ca[2]; unsigned voffB[2];
#pragma unroll
    for (int i = 0; i < 2; ++i) { int R, C; stage_rc(tid * 16 + i * 8192, R, C); const int Rb = Epi::PERM ? ((R & ~31) + perm32(R & 31)) : R;
        Ra[i] = R; Ca[i] = C * 2; voffB[i] = (unsigned)(Rb * K + C * 2); }
    const size_t kstep = (size_t)(BK * 2);
    const size_t hstep = (size_t)HALF * K;
    const size_t tstep = 2 * hstep;
    const unsigned ldsw = (unsigned)wid * 1024u;
    const unsigned lds0 = (unsigned)(uintptr_t)lds;
    const int aoff = lds_byte(wr * 64 + fr, fq * 8), boff = lds_byte(wc * 32 + fr, fq * 8);
#define PG8_SA(b, h) (((b) * 2 + (h)) * HTB)
#define PG8_SB(b, h) ((4 + (b) * 2 + (h)) * HTB)
#define PG8_STAGE(bufoff, gbase, voff) do { _Pragma("unroll") for (int _i = 0; _i < 2; ++_i) { unsigned keep_; \
        asm volatile("s_mov_b32 %0, m0\n\ts_mov_b32 m0, %2\n\ts_nop 0\n\tglobal_load_lds_dwordx4 %1, %3\n\ts_mov_b32 m0, %0" : "=&s"(keep_) \
            : "v"((voff)[_i]), "s"((unsigned)__builtin_amdgcn_readfirstlane((int)(lds0 + (bufoff) + ldsw + _i * 8192))), "s"((const void*)(gbase)) : "memory"); } } while (0)
#define PG8_LD8(addr) __builtin_shufflevector(*(const PG8_LAS v4i_t*)(addr), *(const PG8_LAS v4i_t*)((addr) + 1024), 0, 1, 2, 3, 4, 5, 6, 7)
#define PG8_LDA(dst, b, h) do { _Pragma("unroll") for (int m = 0; m < 4; ++m) dst[m] = PG8_LD8(lds + PG8_SA(b, h) + aoff + m * 2048); } while (0)
#define PG8_LDB(dst, b, h) do { _Pragma("unroll") for (int n = 0; n < 2; ++n) dst[n] = PG8_LD8(lds + PG8_SB(b, h) + boff + n * 2048); } while (0)
#define PG8_HALF(x, k) __builtin_bit_cast(bf16x8, __builtin_shufflevector(x, x, 4 * (k), 4 * (k) + 1, 4 * (k) + 2, 4 * (k) + 3))
#define PG8_MMA(ai, bj, At, Bt) do { __builtin_amdgcn_s_setprio(1); _Pragma("unroll") for (int m = 0; m < 4; ++m) _Pragma("unroll") for (int n = 0; n < 2; ++n) { \
        if constexpr (FP8) asm volatile("v_mfma_scale_f32_16x16x128_f8f6f4 %0, %1, %2, %0, %3, %3 op_sel_hi:[0,0,0]" : "+v"(acc[ai][bj][m][n]) : "v"(Bt[n]), "v"(At[m]), "v"(sc1_));   \
        else { acc[ai][bj][m][n] = __builtin_amdgcn_mfma_f32_16x16x32_bf16(PG8_HALF(Bt[n], 0), PG8_HALF(At[m], 0), acc[ai][bj][m][n], 0, 0, 0); \
               acc[ai][bj][m][n] = __builtin_amdgcn_mfma_f32_16x16x32_bf16(PG8_HALF(Bt[n], 1), PG8_HALF(At[m], 1), acc[ai][bj][m][n], 0, 0, 0); } } \
        __builtin_amdgcn_s_setprio(0); } while (0)
#define PG8_WAIT_V(n) asm volatile("s_waitcnt vmcnt(" #n ")" ::: "memory")
#define PG8_WAIT_L(n) asm volatile("s_waitcnt lgkmcnt(" #n ")" ::: "memory")
#define PG8_BAR __builtin_amdgcn_s_barrier()
#define PG8_SCHED __builtin_amdgcn_sched_barrier(0)
#define PG8_AOFF(dst, u, slot) do { _Pragma("unroll") for (int _h = 0; _h < 2; ++_h) _Pragma("unroll") for (int _i = 0; _i < 2; ++_i) dst[_h][_i] = AO.off(u, slot, _h * HALF + Ra[_i], K) + (unsigned)Ca[_i]; } while (0)
    Unit cur, nxt; int ui = 0;
    if (!S.next(0, cur)) return;
    Acc acc;
#pragma unroll
    for (int a = 0; a < 2; ++a)
#pragma unroll
        for (int b = 0; b < 2; ++b)
#pragma unroll
            for (int m = 0; m < 4; ++m)
#pragma unroll
                for (int n = 0; n < 2; ++n) acc[a][b][m][n] = (f32x4){0.f, 0.f, 0.f, 0.f};
    v8i_t At[4], B0[2], B1[2];
    int sc1_ = 0x7F7F7F7F; asm volatile("" : "+v"(sc1_));
    unsigned aoC[2][2];
    PG8_AOFF(aoC, cur, 0);
    const char* gA = (const char*)g.A; const char* gB = (const char*)g.Bt;
    asm volatile("" : "+s"(gA), "+s"(gB));
    const char* cB = gB + (size_t)cur.pb * tstep;
    PG8_STAGE(PG8_SB(0, 0), cB, voffB); PG8_STAGE(PG8_SB(0, 1), cB + hstep, voffB); PG8_STAGE(PG8_SA(0, 0), gA, aoC[0]); PG8_STAGE(PG8_SA(0, 1), gA, aoC[1]);
    if (wr == 1) PG8_BAR;
    PG8_WAIT_V(2); PG8_BAR;
    PG8_STAGE(PG8_SB(1, 0), cB + kstep, voffB); PG8_STAGE(PG8_SA(1, 0), gA + kstep, aoC[0]); PG8_STAGE(PG8_SB(1, 1), cB + hstep + kstep, voffB);
    PG8_WAIT_V(6); PG8_BAR;
    for (;;) {
        const bool has_next = S.next(ui + 1, nxt);
        const char* nB = has_next ? gB + (size_t)nxt.pb * tstep : cB;
        for (int t = 0; t < nt; t += 2) {
            const bool last = (t == nt - 2);
            const char* a1 = gA + (size_t)(t + 1) * kstep;
            const char* a2 = last ? gA : gA + (size_t)(t + 2) * kstep; const char* b2 = last ? nB : cB + (size_t)(t + 2) * kstep;
            const char* a3 = a2 + kstep; const char* b3 = b2 + kstep;
            unsigned ao2[2][2];
            if (last && has_next) { PG8_AOFF(ao2, nxt, ui + 1); }
            else {
#pragma unroll
                for (int _h = 0; _h < 2; ++_h)
#pragma unroll
                    for (int _i = 0; _i < 2; ++_i) ao2[_h][_i] = aoC[_h][_i]; }
            PG8_LDB(B0, 0, 0); PG8_LDB(B1, 0, 1); PG8_SCHED; PG8_LDA(At, 0, 0); PG8_STAGE(PG8_SA(1, 1), a1, aoC[1]);
            PG8_WAIT_V(8); PG8_WAIT_L(0); PG8_BAR; PG8_MMA(0, 0, At, B0); PG8_MMA(0, 1, At, B1); PG8_BAR; PG8_SCHED;
            PG8_LDA(At, 0, 1); PG8_STAGE(PG8_SB(0, 0), b2, voffB); PG8_STAGE(PG8_SB(0, 1), b2 + hstep, voffB); PG8_STAGE(PG8_SA(0, 0), a2, ao2[0]);
            PG8_WAIT_V(8); PG8_WAIT_L(0); PG8_BAR; PG8_MMA(1, 0, At, B0); PG8_MMA(1, 1, At, B1); PG8_BAR; PG8_SCHED;
            PG8_LDB(B0, 1, 0); PG8_LDB(B1, 1, 1); PG8_SCHED; PG8_LDA(At, 1, 0); PG8_STAGE(PG8_SA(0, 1), a2, ao2[1]);
            PG8_WAIT_V(8); PG8_WAIT_L(0); PG8_BAR; PG8_MMA(0, 0, At, B0); PG8_MMA(0, 1, At, B1); PG8_BAR; PG8_SCHED;
            PG8_LDA(At, 1, 1); PG8_STAGE(PG8_SB(1, 0), b3, voffB); PG8_STAGE(PG8_SB(1, 1), b3 + hstep, voffB); PG8_STAGE(PG8_SA(1, 0), a3, ao2[0]);
            PG8_WAIT_V(8); PG8_WAIT_L(0); PG8_BAR; PG8_MMA(1, 0, At, B0); PG8_MMA(1, 1, At, B1); PG8_BAR; PG8_SCHED;
        }
        if (wr == 0) PG8_BAR;
        E(acc, cur, wr, wc, fr, fq);
        if (!has_next) break;
#pragma unroll
        for (int a = 0; a < 2; ++a)
#pragma unroll
            for (int b = 0; b < 2; ++b)
#pragma unroll
                for (int m = 0; m < 4; ++m)
#pragma unroll
                    for (int n = 0; n < 2; ++n) acc[a][b][m][n] = (f32x4){0.f, 0.f, 0.f, 0.f};
        cur = nxt; cB = nB; ++ui;
        PG8_AOFF(aoC, cur, ui);
        if (wr == 1) PG8_BAR;
    }
    PG8_WAIT_V(0);
    PG8_BAR;
#undef PG8_SA
#undef PG8_SB
#undef PG8_STAGE
#undef PG8_LDA
#undef PG8_LDB
#undef PG8_MMA
#undef PG8_LD8
#undef PG8_HALF
#undef PG8_WAIT_V
#undef PG8_WAIT_L
#undef PG8_BAR
#undef PG8_SCHED
#undef PG8_AOFF
}
}
namespace att {
typedef unsigned short bf16;
typedef short bf16x8 __attribute__((ext_vector_type(8)));
typedef short s16x4 __attribute__((ext_vector_type(4)));
typedef float f32x16 __attribute__((ext_vector_type(16)));
typedef float f32x4 __attribute__((ext_vector_type(4)));
typedef unsigned u32x4 __attribute__((ext_vector_type(4)));
constexpr int NW = 8, QBLK = 32, KVBLK = 64, QB = NW * QBLK, DV = 128;
constexpr float THR = 8.f;
constexpr int SHM_V = KVBLK * DV * 2;
template <int DQK> struct Cfg { static constexpr int NKC = DQK / 8, KCH = NKC / 8, KPITCH = DQK * 2, SHM_K = KVBLK * KPITCH, NQF = DQK / 16, LDS_BYTES = 2 * SHM_V + 2 * SHM_K + NW * 64 * 4; };
#define SBAR() __builtin_amdgcn_sched_barrier(0)
__device__ __forceinline__ int v_st(int k, int c) { const int kk = (k & ~0xC) | ((k & 4) << 1) | ((k & 8) >> 1); return ((kk >> 3) * 4 + (c >> 5)) * 512 + ((kk & 7) * 32 + (c & 31)) * 2; }
__device__ __forceinline__ int v_rd_base(int lane) { return ((lane & 3) << 3) | (((lane >> 2) & 3) << 6) | (((lane >> 4) & 1) << 5) | (((lane >> 5) & 1) << 8); }
constexpr int v_rd_off(int d0, int ks, int half) { return d0 * 512 + ks * 4096 + half * 2048; }
__device__ __forceinline__ int crow(int r, int hi) { return (r & 3) + 8 * (r >> 2) + 4 * hi; }
__device__ __forceinline__ unsigned cvtpk(float lo, float hi) { return pg8::cvt_pk_bf16(lo, hi); }
__device__ __forceinline__ bf16x8 load8(const bf16* p) { return *reinterpret_cast<const bf16x8*>(p); }
__device__ __forceinline__ void mask_tile(f32x16& p0, f32x16& p1, int dq, unsigned W) {
    const float NEG = -__builtin_inff();
#pragma unroll
    for (int r = 0; r < 16; ++r) { const int c = (r & 3) + 8 * (r >> 2);
        if ((unsigned)(dq - c) >= W) p0[r] = NEG;
        if ((unsigned)(dq - c - 32) >= W) p1[r] = NEG; }
}
__device__ __forceinline__ void partialSM(f32x16& p0, f32x16& p1, float& m_reg, float& mn, float& alpha, float scale) {
    float pmax = p0[0];
#pragma unroll
    for (int r = 1; r < 16; ++r) pmax = fmaxf(pmax, p0[r]);
#pragma unroll
    for (int r = 0; r < 16; ++r) pmax = fmaxf(pmax, p1[r]);
    { auto rr = __builtin_amdgcn_permlane32_swap(__float_as_uint(pmax), __float_as_uint(pmax), false, false);
      pmax = fmaxf(__uint_as_float(rr[0]), __uint_as_float(rr[1])); }
    const float C2 = 1.4426950408889634f * scale;
    if (__builtin_expect(__all((pmax - m_reg) * scale <= THR), 1)) { mn = m_reg; alpha = 1.f; }
    else { mn = fmaxf(m_reg, pmax); alpha = __builtin_amdgcn_exp2f((m_reg - mn) * C2); m_reg = mn; }
    const float mnL = -mn * C2;
#pragma unroll
    for (int r = 0; r < 16; ++r) p0[r] = fmaf(p0[r], C2, mnL);
#pragma unroll
    for (int r = 0; r < 16; ++r) p1[r] = fmaf(p1[r], C2, mnL);
#pragma unroll
    for (int r = 0; r < 16; ++r) p0[r] = __builtin_amdgcn_exp2f(p0[r]);
}
__device__ __forceinline__ void finishSM(f32x16& p0, f32x16& p1, float alpha, float& l_reg, bf16x8& pa0, bf16x8& pa1, bf16x8& pa2, bf16x8& pa3) {
#pragma unroll
    for (int r = 0; r < 16; ++r) p1[r] = __builtin_amdgcn_exp2f(p1[r]);
    float ps = 0;
#pragma unroll
    for (int r = 0; r < 16; ++r) ps += p0[r];
#pragma unroll
    for (int r = 0; r < 16; ++r) ps += p1[r];
    { auto rr = __builtin_amdgcn_permlane32_swap(__float_as_uint(ps), __float_as_uint(ps), false, false);
      ps = __uint_as_float(rr[0]) + __uint_as_float(rr[1]); }
    l_reg = l_reg * alpha + ps;
#define PK4(P, B_, OUT) do { unsigned a0 = cvtpk(P[B_+0], P[B_+1]), a1 = cvtpk(P[B_+2], P[B_+3]);                          \
        unsigned b0 = cvtpk(P[B_+4], P[B_+5]), b1 = cvtpk(P[B_+6], P[B_+7]);                                             \
        auto r0 = __builtin_amdgcn_permlane32_swap(a0, b0, false, false); auto r1 = __builtin_amdgcn_permlane32_swap(a1, b1, false, false); \
        u32x4 w = {r0[0], r1[0], r0[1], r1[1]}; OUT = *reinterpret_cast<bf16x8*>(&w); } while (0)
    PK4(p0, 0, pa0); PK4(p0, 8, pa1); PK4(p1, 0, pa2); PK4(p1, 8, pa3);
#undef PK4
}
template <int KB, bool SK, int DQK, bool DIL>
__device__ __forceinline__ void qkt(f32x16& p0, f32x16& p1, const char* K_lds, int r32, int hi, const bf16x8* qr, bool act, float beta, int dq) {
    typedef Cfg<DQK> C;
    if (SK && !act) { const float NEG = -__builtin_inff();
#pragma unroll
        for (int r = 0; r < 16; ++r) { p0[r] = NEG; p1[r] = NEG; } return; }
    if constexpr (DIL) { const float b0 = -beta * (float)dq;
#pragma unroll
        for (int r = 0; r < 16; ++r) { const int c = (r & 3) + 8 * (r >> 2); p0[r] = fmaf(beta, (float)c, b0); p1[r] = fmaf(beta, (float)(c + 32), b0); } }
    else { p0 = f32x16{}; p1 = f32x16{}; }
    const char* kb[4];
#pragma unroll
    for (int dd = 0; dd < 4; ++dd) { const int colB = (dd * 16 + hi * 8) * 2; kb[dd] = K_lds + KB * C::SHM_K + r32 * C::KPITCH + (colB ^ ((r32 & 7) << 4)); }
#pragma unroll
    for (int d0 = 0; d0 < C::NQF; ++d0) { const char* a = kb[d0 & 3] + (d0 >> 2) * 128;
        bf16x8 b0 = *reinterpret_cast<const bf16x8*>(a);
        bf16x8 b1 = *reinterpret_cast<const bf16x8*>(a + 32 * C::KPITCH);
        p0 = __builtin_amdgcn_mfma_f32_32x32x16_bf16(b0, qr[d0], p0, 0, 0, 0);
        p1 = __builtin_amdgcn_mfma_f32_32x32x16_bf16(b1, qr[d0], p1, 0, 0, 0);
#ifndef ATT_NO_QKT_SBAR
        if ((d0 & 3) == 3) SBAR();
#endif
    }
}
template <int VB, bool SK>
__device__ __forceinline__ void pv_tile(f32x16* o, int vb0, bf16x8 pa0, bf16x8 pa1, bf16x8 pa2, bf16x8 pa3, bool act) {
    if (SK && !act) return;
#define TRRD(dst, off) asm volatile("ds_read_b64_tr_b16 %0, %1 offset:%2" : "=&v"(dst) : "v"(vb0), "i"(off) : "memory")
#define PV_D0(d0) do { s16x4 l0, l1, l2, l3, h0, h1, h2, h3; constexpr int b_ = VB * SHM_V + v_rd_off(d0, 0, 0); \
        TRRD(l0, b_); TRRD(h0, b_ + 2048); TRRD(l1, b_ + 4096); TRRD(h1, b_ + 6144); TRRD(l2, b_ + 8192); TRRD(h2, b_ + 10240); TRRD(l3, b_ + 12288); TRRD(h3, b_ + 14336); \
        asm volatile("s_waitcnt lgkmcnt(0)" ::: "memory"); SBAR();   \
        o[d0] = __builtin_amdgcn_mfma_f32_32x32x16_bf16(pa0, (bf16x8){l0[0], l0[1], l0[2], l0[3], h0[0], h0[1], h0[2], h0[3]}, o[d0], 0, 0, 0);   \
        o[d0] = __builtin_amdgcn_mfma_f32_32x32x16_bf16(pa1, (bf16x8){l1[0], l1[1], l1[2], l1[3], h1[0], h1[1], h1[2], h1[3]}, o[d0], 0, 0, 0);   \
        o[d0] = __builtin_amdgcn_mfma_f32_32x32x16_bf16(pa2, (bf16x8){l2[0], l2[1], l2[2], l2[3], h2[0], h2[1], h2[2], h2[3]}, o[d0], 0, 0, 0);   \
        o[d0] = __builtin_amdgcn_mfma_f32_32x32x16_bf16(pa3, (bf16x8){l3[0], l3[1], l3[2], l3[3], h3[0], h3[1], h3[2], h3[3]}, o[d0], 0, 0, 0); } while (0)
    PV_D0(0); PV_D0(1); PV_D0(2); PV_D0(3);
#undef PV_D0
#undef TRRD
}

struct Blk { unsigned qo, ko, vo, oo, lo; int P0, rate; float beta; };
constexpr int PVAR = 0;
#define QS_(B) (DIL ? ((PVAR & 4) ? 128 : (B).rate * 4096) : 1536)
#define KS_(B) (DIL ? ((PVAR & 2) ? 128 : (B).rate * 4096) : 1536)
#define VS_(B) (DIL ? ((PVAR & 2) ? 128 : (B).rate * 4096) : 1024)
#define OS_(B) (DIL ? (B).rate * 1024 : 1024)
#define LS_(B) ((B).rate * 8)
#define SKV_(B) (DIL ? 8192 / (B).rate : 8192)
#define W_(B) (DIL ? 129 : (1 << 30))
#define SCALE_ (DIL ? 0.08838834764831845f : 0.07216878364870322f)
template <int DQK> struct Seam { bf16x8 qr[Cfg<DQK>::NQF]; bf16x8 st_v0, st_v1; bf16x8 st_k[Cfg<DQK>::KCH]; unsigned p_oo = 0; int p_rb = 0, p_so0 = 0, p_on = 0; float cv[4], cw[4]; int cv_j = 0, cv_q = 0, cl_j = 0, cl_q = 0; f32x4 rt[8]; };
__device__ __forceinline__ int swa_jlo(int P0, int W) { const int lowk = P0 - W + 1; return lowk > 0 ? lowk / KVBLK : 0; }

#define VMW() asm volatile("s_waitcnt vmcnt(0)" ::: "memory")
#define VMWN(n) asm volatile("s_waitcnt vmcnt(%0)" :: "i"(n) : "memory")
#define A_RSRC(p) __builtin_amdgcn_make_buffer_rsrc((void*)(p), 0, 0x7fffffff, 0x00020000)
#define A_BLD(rs, vo, so) __builtin_bit_cast(bf16x8, __builtin_amdgcn_raw_buffer_load_b128((rs), (int)(vo), (int)(so), 0))
#ifdef ATT_SLOAD_RECOMP
#define A_SLOAD(B_, k0) do { const __amdgpu_buffer_rsrc_t rv_ = A_RSRC(wsb + (B_).vo), rk_ = A_RSRC(wsb + (B_).ko); const int sov_ = (k0) * VS_(B_) * 2, sok_ = (k0) * KS_(B_) * 2; \
        int t_ = tid; asm volatile("" : "+v"(t_)); const int sr_ = t_ >> 4, sc_ = (t_ & 15) * 8; \
        S.st_v0 = A_BLD(rv_, (sr_ * VS_(B_) + sc_) * 2, sov_); S.st_v1 = A_BLD(rv_, ((32 + sr_) * VS_(B_) + sc_) * 2, sov_); \
        _Pragma("unroll") for (int j_ = 0; j_ < C::KCH; ++j_) { const int q_ = t_ + 512 * j_; S.st_k[j_] = A_BLD(rk_, ((q_ / C::NKC) * KS_(B_) + (q_ % C::NKC) * 8) * 2, sok_); } } while (0)
#else
#define A_SLOAD(B_, k0) do { const __amdgpu_buffer_rsrc_t rv_ = A_RSRC(wsb + (B_).vo), rk_ = A_RSRC(wsb + (B_).ko); const int sov_ = (k0) * VS_(B_) * 2, sok_ = (k0) * KS_(B_) * 2; \
        S.st_v0 = A_BLD(rv_, (sr * VS_(B_) + sc) * 2, sov_); S.st_v1 = A_BLD(rv_, ((32 + sr) * VS_(B_) + sc) * 2, sov_); \
        _Pragma("unroll") for (int j_ = 0; j_ < C::KCH; ++j_) S.st_k[j_] = A_BLD(rk_, (krow[j_] * KS_(B_) + kcol[j_]) * 2, sok_); } while (0)
#endif
#define A_QLOAD(B_) do { const __amdgpu_buffer_rsrc_t rq_ = A_RSRC(wsb + (B_).qo); const int soq_ = ((B_).P0 + wid * QBLK) * QS_(B_) * 2; const int qo_ = r32 * QS_(B_) * 2 + hi * 16; \
        _Pragma("unroll") for (int d0 = 0; d0 < C::NQF; ++d0) S.qr[d0] = A_BLD(rq_, qo_ + d0 * 32, soq_); } while (0)
#define A_SWRITE_K(bf) do { _Pragma("unroll") for (int j_ = 0; j_ < C::KCH; ++j_) *(bf16x8*)(K_lds + (bf) * C::SHM_K + kws[j_]) = S.st_k[j_]; } while (0)
#define A_SWRITE_V(bf) do { *(bf16x8*)(V_lds + (bf) * SHM_V + vst0) = S.st_v0; *(bf16x8*)(V_lds + (bf) * SHM_V + vst1) = S.st_v1; } while (0)
#define A_STAGE_IDX() const int sr = tid >> 4, sc = (tid & 15) * 8; int krow[C::KCH], kcol[C::KCH], kws[C::KCH]; \
        _Pragma("unroll") for (int j_ = 0; j_ < C::KCH; ++j_) { const int q_ = tid + 512 * j_; krow[j_] = q_ / C::NKC; kcol[j_] = (q_ % C::NKC) * 8; kws[j_] = krow[j_] * C::KPITCH + ((kcol[j_] * 2) ^ ((krow[j_] & 7) << 4)); }

__device__ __forceinline__ void store_o_staged(const f32x16* o, const float* rli, char* stg, __amdgpu_buffer_rsrc_t ro_, int rowbytes, int so0_, int lane) {
    const int r32 = lane & 31, hi = lane >> 5, odd = lane & 1, g = odd | (hi << 1);
    char* wb = stg + (odd + 4 * hi) * 256 + (r32 >> 1) * 4;
    char* wa[4];
#pragma unroll
    for (int d0 = 0; d0 < 4; ++d0) wa[d0] = wb + ((d0 ^ g) << 6);
    const int lr = lane >> 4, ch = lane & 15, sp = ch >> 2, gl = lr & 1;
    const char* rb_e = stg + lr * 256 + ((sp ^ gl) << 6) + (lane & 3) * 16;
    const char* rb_o = stg + lr * 256 + ((sp ^ (gl | 2)) << 6) + (lane & 3) * 16;
    const int voff = lr * rowbytes + ch * 16;
#pragma unroll
    for (int h = 0; h < 2; ++h) {
#pragma unroll
        for (int rp = 0; rp < 4; ++rp) { const int r = 8 * h + 2 * rp, Rl = (r & 3) + 8 * ((r >> 2) & 1);
#pragma unroll
            for (int d0 = 0; d0 < 4; ++d0) { const float v0 = o[d0][r] * rli[r], v1 = o[d0][r + 1] * rli[r + 1];
                const float send = odd ? v0 : v1;
                const float recv = __int_as_float(__builtin_amdgcn_update_dpp(0, __float_as_int(send), 0xB1, 0xF, 0xF, true));
                *reinterpret_cast<unsigned*>(wa[d0] + Rl * 256) = cvtpk(odd ? recv : v0, odd ? v1 : recv); } }
        u32x4 d_[4];
#pragma unroll
        for (int i = 0; i < 4; ++i) d_[i] = *reinterpret_cast<const u32x4*>(((i & 1) ? rb_o : rb_e) + i * 1024);
#pragma unroll
        for (int i = 0; i < 4; ++i) __builtin_amdgcn_raw_buffer_store_b128(d_[i], ro_, voff + so0_ + (16 * h + 4 * i) * rowbytes, 0, 0);
    }
}
constexpr int DEFER_STG = 65536, DEFER_WS = 131072 + 512;
__device__ __forceinline__ void stage_write(const f32x16* o, const float* rli, char* stg, int lane) {
    const int r32 = lane & 31, hi = lane >> 5, odd = lane & 1, g = odd | (hi << 1);
    char* wb = stg + (odd + 4 * hi) * 256 + (r32 >> 1) * 4;
    char* wa[4];
#pragma unroll
    for (int d0 = 0; d0 < 4; ++d0) wa[d0] = wb + ((d0 ^ g) << 6);
#pragma unroll
    for (int h = 0; h < 2; ++h)
#pragma unroll
        for (int rp = 0; rp < 4; ++rp) { const int r = 8 * h + 2 * rp, Rl = (r & 3) + 8 * ((r >> 2) & 1);
#pragma unroll
            for (int d0 = 0; d0 < 4; ++d0) { const float v0 = o[d0][r] * rli[r], v1 = o[d0][r + 1] * rli[r + 1];
                const float send = odd ? v0 : v1;
                const float recv = __int_as_float(__builtin_amdgcn_update_dpp(0, __float_as_int(send), 0xB1, 0xF, 0xF, true));
                *reinterpret_cast<unsigned*>(wa[d0] + h * 4096 + Rl * 256) = cvtpk(odd ? recv : v0, odd ? v1 : recv); } }
}
__device__ __forceinline__ void flush_piece(const char* stg, int p, const char* obase, int rowbytes, int so0, int lane) {
    const int lr = lane >> 4, ch = lane & 15, sp = ch >> 2, g = (lr & 1) | ((p & 1) << 1);
    const u32x4 d = *reinterpret_cast<const u32x4*>(stg + p * 1024 + lr * 256 + ((sp ^ g) << 6) + (lane & 3) * 16);
    __builtin_amdgcn_raw_buffer_store_b128(d, A_RSRC(obase), lr * rowbytes + ch * 16 + so0 + 4 * p * rowbytes, 0, 0);
}
struct ConvCtx { const float* eg; const float* eu; const float* ed; unsigned char* w13; unsigned char* w2; int gw; };
constexpr int CONV_SCR = 86016, CONV_NJ = 48;
#ifndef CONV_AUX
#define CONV_AUX 2
#endif
struct ConvItem { const float* src; unsigned char* dst; int ldw, kd; };
__device__ __forceinline__ ConvItem conv_decode(const ConvCtx& X, int j) {
    const int q = X.gw + 2048 * j, e = q / 6144, r = q - e * 6144, m = r >> 11, r2 = r & 2047;
    ConvItem I;
    if (m < 2) { const int kb = r2 >> 6, nb = r2 & 63, n0 = nb * 16; I.ldw = 1024; I.kd = 2048;
        I.src = (m == 0 ? X.eg : X.eu) + (size_t)e * (2048 * 1024) + (size_t)kb * (64 * 1024) + n0;
        I.dst = X.w13 + (size_t)e * (2048 * 2048) + (size_t)((n0 >> 7) * 256 + (m == 1 ? 128 : 0) + (n0 & 127)) * 2048 + kb * 64; }
    else { const int kb = r2 >> 7, nb = r2 & 127; I.ldw = 2048; I.kd = 1024;
        I.src = X.ed + (size_t)e * (1024 * 2048) + (size_t)kb * (64 * 2048) + nb * 16;
        I.dst = X.w2 + (size_t)e * (2048 * 1024) + (size_t)(nb * 16) * 1024 + kb * 64; }
    return I;
}
__device__ __forceinline__ void conv_load(const ConvCtx& X, int j, int qd, float* cv, int lane) {
    const ConvItem I = conv_decode(X, j); const __amdgpu_buffer_rsrc_t rs = A_RSRC(I.src);
#pragma unroll
    for (int i = 0; i < 4; ++i) { const int k = 4 * (4 * qd + i) + (lane >> 4);
        cv[i] = __uint_as_float(__builtin_amdgcn_raw_buffer_load_b32(rs, (k * I.ldw + (lane & 15)) * 4, 0, CONV_AUX)); }
}
__device__ __forceinline__ void conv_put(const ConvCtx& X, int j, int qd, const float* cv, char* scr, int lane) {
    float* s = reinterpret_cast<float*>(scr);
#pragma unroll
    for (int i = 0; i < 4; ++i) { const int k = 4 * (4 * qd + i) + (lane >> 4); s[k * 17 + (lane & 15)] = cv[i] * 256.0f; }
    if (qd == 3) {
        const ConvItem I = conv_decode(X, j); const int n = lane & 15, kq = lane >> 4; const float* c = s + (16 * kq) * 17 + n;
        u32x4 w;
        { int w0 = 0, w1 = 0, w2 = 0, w3 = 0;
          w0 = __builtin_amdgcn_cvt_pk_fp8_f32(c[0 * 17], c[1 * 17], w0, false); w0 = __builtin_amdgcn_cvt_pk_fp8_f32(c[2 * 17], c[3 * 17], w0, true);
          w1 = __builtin_amdgcn_cvt_pk_fp8_f32(c[4 * 17], c[5 * 17], w1, false); w1 = __builtin_amdgcn_cvt_pk_fp8_f32(c[6 * 17], c[7 * 17], w1, true);
          w2 = __builtin_amdgcn_cvt_pk_fp8_f32(c[8 * 17], c[9 * 17], w2, false); w2 = __builtin_amdgcn_cvt_pk_fp8_f32(c[10 * 17], c[11 * 17], w2, true);
          w3 = __builtin_amdgcn_cvt_pk_fp8_f32(c[12 * 17], c[13 * 17], w3, false); w3 = __builtin_amdgcn_cvt_pk_fp8_f32(c[14 * 17], c[15 * 17], w3, true);
          w = (u32x4){(unsigned)w0, (unsigned)w1, (unsigned)w2, (unsigned)w3}; }
        __builtin_amdgcn_raw_buffer_store_b128(w, A_RSRC(I.dst), n * I.kd + 16 * kq, 0, CONV_AUX);
    }
}
constexpr unsigned ROPE_OFF = 2u << 20;
#define A_RTLOAD(B_) do { const __amdgpu_buffer_rsrc_t rr_ = A_RSRC(wsb + ROPE_OFF); const int vo_ = ((B_).P0 + wid * QBLK + r32) * 256 + hi * 32; \
        _Pragma("unroll") for (int d_ = 0; d_ < 4; ++d_) { S.rt[2 * d_] = __builtin_bit_cast(f32x4, __builtin_amdgcn_raw_buffer_load_b128(rr_, vo_ + d_ * 64, 0, 0)); \
                                                            S.rt[2 * d_ + 1] = __builtin_bit_cast(f32x4, __builtin_amdgcn_raw_buffer_load_b128(rr_, vo_ + d_ * 64 + 16, 0, 0)); } } while (0)
__device__ __forceinline__ unsigned rope_pair(unsigned w, float c, float s) { const float x1 = __uint_as_float(w << 16), x2 = __uint_as_float(w & 0xffff0000u); return cvtpk(x1 * c - x2 * s, x2 * c + x1 * s); }
#define A_ROTATE() do { _Pragma("unroll") for (int d_ = 0; d_ < 4; ++d_) { u32x4 w_ = __builtin_bit_cast(u32x4, S.qr[8 + d_]); const f32x4 c01_ = S.rt[2 * d_], c23_ = S.rt[2 * d_ + 1]; \
        w_.x = rope_pair(w_.x, c01_[0], c01_[1]); w_.y = rope_pair(w_.y, c01_[2], c01_[3]); w_.z = rope_pair(w_.z, c23_[0], c23_[1]); w_.w = rope_pair(w_.w, c23_[2], c23_[3]); \
        S.qr[8 + d_] = __builtin_bit_cast(bf16x8, w_); } } while (0)
template <int DQK, bool DIL, int PVAR = 0, bool ROPE = false>
__device__ __forceinline__ void att_prime(const Blk& cur, const char* wsb, char* lds, Seam<DQK>& S, int tid_in) {
    typedef Cfg<DQK> C;
    int tid = tid_in; asm volatile("" : "+v"(tid));
    const int wid = __builtin_amdgcn_readfirstlane(tid >> 6), lane = tid & 63, r32 = lane & 31, hi = lane >> 5;
    A_STAGE_IDX(); char* K_lds = lds + 2 * SHM_V;
    const int kb0 = swa_jlo(cur.P0, W_(cur)) * KVBLK;
    A_QLOAD(cur);
    if constexpr (ROPE) A_RTLOAD(cur);
    A_SLOAD(cur, kb0); VMW(); A_SWRITE_K(0);
    __syncthreads();
}
template <int DQK, bool DIL, bool SK, int PVAR = 0, bool CONV = false, bool ROPE = false>
__device__ __forceinline__ void att_block(const Blk& cur, const Blk& nxt, const char* wsb, char* lds, Seam<DQK>& S, int tid_in, const ConvCtx* X = nullptr) {
    typedef Cfg<DQK> C;
    int tid = tid_in; asm volatile("" : "+v"(tid));
    const int wid = __builtin_amdgcn_readfirstlane(tid >> 6), lane = tid & 63, r32 = lane & 31, hi = lane >> 5;
    const int W = W_(cur); const float scale = SCALE_, beta = cur.beta;
    int j_lo = swa_jlo(cur.P0, W);
    int j_hi = (cur.P0 + QB - 1) / KVBLK + 1; if (j_hi > SKV_(cur) / KVBLK) j_hi = SKV_(cur) / KVBLK;
    if (PVAR & 8) j_lo = j_hi - 2;
    const int NT = j_hi - j_lo;
    const int kbn = swa_jlo(nxt.P0, W_(nxt)) * KVBLK;
    const int qlo = cur.P0 + wid * QBLK, qm = qlo + r32 - 4 * hi;
    char* V_lds = lds; char* K_lds = lds + 2 * SHM_V;
#ifdef ATT_DEFER
    constexpr bool DEFER = DIL;
#else
    constexpr bool DEFER = false;
#endif
    float* ws = (float*)(lds + (DEFER ? DEFER_WS : 2 * SHM_V + 2 * C::SHM_K)) + wid * 64; float* li_l = ws, * al_l = ws + 32;
    char* stg = lds + DEFER_STG + wid * 8192;
    float m_reg = -1e30f, l_reg = 0; f32x16 o[4] = {};
    A_STAGE_IDX();
    const int vst0 = v_st(sr, sc), vst1 = v_st(32 + sr, sc);
    const int vb0 = (int)(uintptr_t)V_lds + v_rd_base(lane);
#define RESC(a) do { if (__any((a) < 1.f)) { if (hi == 0) al_l[r32] = (a); asm volatile("s_waitcnt lgkmcnt(0)" ::: "memory");              \
                     _Pragma("unroll") for (int d_ = 0; d_ < 4; ++d_) _Pragma("unroll") for (int r = 0; r < 16; ++r) o[d_][r] *= al_l[crow(r, hi)]; } } while (0)
#define KBASE(t) ((j_lo + (t)) * KVBLK)
#define ACT(t) (KBASE(t) <= qlo + QBLK - 1 && KBASE(t) + KVBLK - 1 >= qlo - W + 1)
#define MASKT(P0_, P1_, t) do { const int kb_ = KBASE(t); if ((!SK || ACT(t)) && (kb_ + KVBLK - 1 > qlo || kb_ <= qlo + QBLK - 1 - W)) mask_tile(P0_, P1_, qm - kb_, (unsigned)W); } while (0)
    A_SWRITE_V(0);
    __syncthreads();
    if constexpr (ROPE) { VMW(); A_ROTATE(); }
#define STEP(t, BUF) do { const bool more_ = (t) + 1 < NT;                                                                        \
        if (more_) { A_SLOAD(cur, KBASE((t) + 1)); } else { A_SLOAD(nxt, kbn); }                                                   \
        const bool cpend_ = CONV && (S.cv_j != S.cl_j || S.cv_q != S.cl_q); const bool cld_ = CONV && more_ && S.cl_j < CONV_NJ;        \
        if (cld_) { conv_load(*X, S.cl_j, S.cl_q, BUF ? S.cw : S.cv, lane); if (++S.cl_q == 4) { S.cl_q = 0; ++S.cl_j; } }               \
        if (DEFER && S.p_on && (t) < 4) { flush_piece(stg, 2 * (t), wsb + S.p_oo, S.p_rb, S.p_so0, lane); flush_piece(stg, 2 * (t) + 1, wsb + S.p_oo, S.p_rb, S.p_so0, lane); } \
        SBAR(); f32x16 p0, p1; float mn_, al_; bf16x8 pa0, pa1, pa2, pa3;                                                            \
        qkt<BUF, SK, DQK, DIL>(p0, p1, K_lds, r32, hi, S.qr, ACT(t), beta, qm - KBASE(t)); SBAR();                                  \
        if (!more_) { A_QLOAD(nxt); SBAR(); } \
        MASKT(p0, p1, t); partialSM(p0, p1, m_reg, mn_, al_, scale); finishSM(p0, p1, al_, l_reg, pa0, pa1, pa2, pa3); RESC(al_); SBAR(); \
        pv_tile<BUF, SK>(o, vb0, pa0, pa1, pa2, pa3, ACT(t));                                                                      \
        if (more_) { if (cld_) VMWN(4); else VMW();            \
            A_SWRITE_V(1 - BUF); A_SWRITE_K(1 - BUF);                                                                              \
            if (cpend_) { conv_put(*X, S.cv_j, S.cv_q, BUF ? S.cv : S.cw, lds + CONV_SCR + wid * 4352, lane); if (++S.cv_q == 4) { S.cv_q = 0; ++S.cv_j; } } } \
        __syncthreads(); } while (0)
    int t = 0;
    for (; t + 1 < NT; t += 2) { STEP(t, 0); STEP(t + 1, 1); }
    if (t < NT) { STEP(t, 0); }
    VMWN(C::NQF); A_SWRITE_K(0); SBAR();
    if (CONV && (S.cv_j != S.cl_j || S.cv_q != S.cl_q)) { conv_put(*X, S.cv_j, S.cv_q, S.cv, lds + CONV_SCR + wid * 4352, lane); if (++S.cv_q == 4) { S.cv_q = 0; ++S.cv_j; } }
    if (hi == 0) li_l[r32] = l_reg; asm volatile("s_waitcnt lgkmcnt(0)" ::: "memory");
    if constexpr (DIL) { if (hi == 0) __builtin_amdgcn_raw_buffer_store_b32(__float_as_uint(m_reg * scale + __logf(l_reg)), A_RSRC(wsb + cur.lo), r32 * LS_(cur) * 4, (cur.P0 + wid * QBLK) * LS_(cur) * 4, 0); }
    float rli[16];
#pragma unroll
    for (int r = 0; r < 16; ++r) rli[r] = __builtin_amdgcn_rcpf(li_l[crow(r, hi)]);
    if constexpr (DEFER) { stage_write(o, rli, stg, lane); S.p_oo = cur.oo; S.p_rb = OS_(cur) * 2; S.p_so0 = (cur.P0 + wid * QBLK) * OS_(cur) * 2; S.p_on = 1; }
    else {
#ifdef ATT_T21
    store_o_staged(o, rli, wid < 4 ? lds + SHM_V + wid * 4096 : lds + 2 * SHM_V + C::SHM_K + (wid - 4) * 4096, A_RSRC(wsb + cur.oo), OS_(cur) * 2, (cur.P0 + wid * QBLK) * OS_(cur) * 2, lane);
#else
    const int os_ = (PVAR & 1) ? 0 : OS_(cur);
    const __amdgpu_buffer_rsrc_t ro_ = A_RSRC(wsb + cur.oo); const int oo_ = (4 * hi * os_ + r32) * 2, so0_ = (cur.P0 + wid * QBLK) * os_ * 2;
#pragma unroll
    for (int r = 0; r < 16; ++r) { const int sor_ = so0_ + ((r & 3) + 8 * (r >> 2)) * os_ * 2;
#pragma unroll
        for (int d0 = 0; d0 < 4; ++d0) { const float v = o[d0][r] * rli[r];
            const float vn = __int_as_float(__builtin_amdgcn_update_dpp(0, __float_as_int(v), 0xB1, 0xF, 0xF, true));
            if ((r32 & 1) == 0) __builtin_amdgcn_raw_buffer_store_b32(cvtpk(v, vn), ro_, oo_ + d0 * 64, sor_, 0); } }
#endif
    }
    if constexpr (ROPE) A_RTLOAD(nxt);
#undef RESC
#undef KBASE
#undef ACT
#undef MASKT
#undef STEP
}

template <int DQK> struct SeamD { bf16x8 qr[Cfg<DQK>::NQF]; };
#define A_GLDS(voff, sbase, ldsdst) do { unsigned keep_; asm volatile("s_mov_b32 %0, m0\n\ts_mov_b32 m0, %2\n\ts_nop 0\n\tglobal_load_lds_dwordx4 %1, %3\n\ts_mov_b32 m0, %0" \
        : "=&s"(keep_) : "v"(voff), "s"((unsigned)__builtin_amdgcn_readfirstlane((int)(ldsdst))), "s"((const void*)(sbase)) : "memory"); } while (0)
#define A_DMA_IDX() int krow_[C::KCH], kcb_[C::KCH], vrow_[2], vcb_[2]; \
        _Pragma("unroll") for (int j_ = 0; j_ < C::KCH; ++j_) { const int p_ = (j_ * 8 + wid) * 1024 + lane * 16, row_ = p_ / C::KPITCH, pc_ = (p_ % C::KPITCH) / 16, lc_ = (pc_ & ~7) | ((pc_ & 7) ^ (row_ & 7)); \
            krow_[j_] = row_; kcb_[j_] = lc_ * 16; } \
        _Pragma("unroll") for (int j_ = 0; j_ < 2; ++j_) { const int p_ = (j_ * 8 + wid) * 1024 + lane * 16, s_ = p_ / 512, w_ = p_ % 512, kk_ = (s_ >> 2) * 8 + (w_ >> 6), col_ = (s_ & 3) * 32 + ((w_ & 63) >> 1); \
            vrow_[j_] = (kk_ & ~0xC) | ((kk_ & 4) << 1) | ((kk_ & 8) >> 1); vcb_[j_] = col_ * 2; }
#define A_DMA(B_, k0, sl_) do { const char* kb_ = wsb + (B_).ko + (size_t)(k0) * (size_t)(KS_(B_) * 2); const char* vb_ = wsb + (B_).vo + (size_t)(k0) * (size_t)(VS_(B_) * 2); \
        _Pragma("unroll") for (int j_ = 0; j_ < C::KCH; ++j_) A_GLDS((unsigned)(krow_[j_] * KS_(B_) * 2 + kcb_[j_]), kb_, lds0 + NS * SHM_V + (sl_) * C::SHM_K + (j_ * 8 + wid) * 1024); \
        _Pragma("unroll") for (int j_ = 0; j_ < 2; ++j_) A_GLDS((unsigned)(vrow_[j_] * VS_(B_) * 2 + vcb_[j_]), vb_, lds0 + (sl_) * SHM_V + (j_ * 8 + wid) * 1024); } while (0)
template <int DQK, bool DIL, int NS>
__device__ __forceinline__ void att_prime_dma(const Blk& cur, const char* wsb, char* lds, SeamD<DQK>& S, int tid_in) {
    typedef Cfg<DQK> C;
    int tid = tid_in; asm volatile("" : "+v"(tid));
    const int wid = __builtin_amdgcn_readfirstlane(tid >> 6), lane = tid & 63, r32 = lane & 31, hi = lane >> 5;
    const unsigned lds0 = (unsigned)(uintptr_t)lds;
    A_DMA_IDX();
    const int kb0 = swa_jlo(cur.P0, W_(cur)) * KVBLK;
    A_QLOAD(cur);
#pragma unroll
    for (int i_ = 0; i_ < NS - 1; ++i_) A_DMA(cur, kb0 + i_ * KVBLK, i_);
}
template <int DQK, bool DIL, bool SK, int NS>
__device__ __forceinline__ void att_block_dma(const Blk& cur, const Blk& nxt, const char* wsb, char* lds, char* wsl, SeamD<DQK>& S, int tid_in) {
    typedef Cfg<DQK> C;
    int tid = tid_in; asm volatile("" : "+v"(tid));
    const int wid = __builtin_amdgcn_readfirstlane(tid >> 6), lane = tid & 63, r32 = lane & 31, hi = lane >> 5;
    const int W = W_(cur); const float scale = SCALE_, beta = cur.beta;
    const int j_lo = swa_jlo(cur.P0, W);
    int j_hi = (cur.P0 + QB - 1) / KVBLK + 1; if (j_hi > SKV_(cur) / KVBLK) j_hi = SKV_(cur) / KVBLK;
    const int NT = j_hi - j_lo;
    const int kbn = swa_jlo(nxt.P0, W_(nxt)) * KVBLK;
    const int qlo = cur.P0 + wid * QBLK, qm = qlo + r32 - 4 * hi;
    const unsigned lds0 = (unsigned)(uintptr_t)lds;
    const char* K_lds = lds + NS * SHM_V;
    float* ws = (float*)wsl + wid * 64; float* li_l = ws, * al_l = ws + 32;
    float m_reg = -1e30f, l_reg = 0; f32x16 o[4] = {};
    A_DMA_IDX();
    const int vb0 = (int)lds0 + v_rd_base(lane);
    constexpr int NDMA = C::KCH + 2;
#define RESC(a) do { if (__any((a) < 1.f)) { if (hi == 0) al_l[r32] = (a); asm volatile("s_waitcnt lgkmcnt(0)" ::: "memory");              \
                     _Pragma("unroll") for (int d_ = 0; d_ < 4; ++d_) _Pragma("unroll") for (int r = 0; r < 16; ++r) o[d_][r] *= al_l[crow(r, hi)]; } } while (0)
#define KBASE(t) ((j_lo + (t)) * KVBLK)
#define ACT(t) (KBASE(t) <= qlo + QBLK - 1 && KBASE(t) + KVBLK - 1 >= qlo - W + 1)
#define MASKT(P0_, P1_, t) do { const int kb_ = KBASE(t); if ((!SK || ACT(t)) && (kb_ + KVBLK - 1 > qlo || kb_ <= qlo + QBLK - 1 - W)) mask_tile(P0_, P1_, qm - kb_, (unsigned)W); } while (0)
    VMW();
#pragma unroll
    for (int d0 = 0; d0 < C::NQF; ++d0) asm volatile("" : "+v"(S.qr[d0]));
    asm volatile("s_waitcnt lgkmcnt(0)" ::: "memory"); __builtin_amdgcn_s_barrier(); asm volatile("" ::: "memory");
    int sl = 0, sl2 = NS - 1;
#pragma unroll 1
    for (int t = 0; t < NT; ++t) {
        const bool pre = t + NS - 1 < NT;
        if (pre) A_DMA(cur, KBASE(t + NS - 1), sl2);
        SBAR(); f32x16 p0, p1; float mn_, al_; bf16x8 pa0, pa1, pa2, pa3;
        qkt<0, SK, DQK, DIL>(p0, p1, K_lds + sl * C::SHM_K, r32, hi, S.qr, ACT(t), beta, qm - KBASE(t)); SBAR();
        MASKT(p0, p1, t); partialSM(p0, p1, m_reg, mn_, al_, scale); finishSM(p0, p1, al_, l_reg, pa0, pa1, pa2, pa3); RESC(al_); SBAR();
        pv_tile<0, SK>(o, vb0 + sl * SHM_V, pa0, pa1, pa2, pa3, ACT(t));
        if (t + 1 < NT) { int infl = NT - 2 - t; if (infl > NS - 2) infl = NS - 2;
                          if (infl <= 0) VMW(); else if (infl == 1) VMWN(NDMA); else VMWN(2 * NDMA);
                          asm volatile("s_waitcnt lgkmcnt(0)" ::: "memory"); __builtin_amdgcn_s_barrier(); asm volatile("" ::: "memory"); }
        sl = sl == NS - 1 ? 0 : sl + 1; sl2 = sl2 == NS - 1 ? 0 : sl2 + 1;
    }
    asm volatile("s_waitcnt lgkmcnt(0)" ::: "memory"); __builtin_amdgcn_s_barrier(); asm volatile("" ::: "memory");
    A_QLOAD(nxt);
#pragma unroll
    for (int i_ = 0; i_ < NS - 1; ++i_) A_DMA(nxt, kbn + i_ * KVBLK, i_);
    if (hi == 0) li_l[r32] = l_reg; asm volatile("s_waitcnt lgkmcnt(0)" ::: "memory");
    if constexpr (DIL) { if (hi == 0) __builtin_amdgcn_raw_buffer_store_b32(__float_as_uint(m_reg * scale + __logf(l_reg)), A_RSRC(wsb + cur.lo), r32 * LS_(cur) * 4, (cur.P0 + wid * QBLK) * LS_(cur) * 4, 0); }
    float rli[16];
#pragma unroll
    for (int r = 0; r < 16; ++r) rli[r] = __builtin_amdgcn_rcpf(li_l[crow(r, hi)]);
    const __amdgpu_buffer_rsrc_t ro_ = A_RSRC(wsb + cur.oo); const int oo_ = (4 * hi * OS_(cur) + r32) * 2, so0_ = (cur.P0 + wid * QBLK) * OS_(cur) * 2;
#pragma unroll
    for (int r = 0; r < 16; ++r) { const int sor_ = so0_ + ((r & 3) + 8 * (r >> 2)) * OS_(cur) * 2;
#pragma unroll
        for (int d0 = 0; d0 < 4; ++d0) { const float v = o[d0][r] * rli[r];
            const float vn = __int_as_float(__builtin_amdgcn_update_dpp(0, __float_as_int(v), 0xB1, 0xF, 0xF, true));
            if ((r32 & 1) == 0) __builtin_amdgcn_raw_buffer_store_b32(cvtpk(v, vn), ro_, oo_ + d0 * 64, sor_, 0); } }
#undef RESC
#undef KBASE
#undef ACT
#undef MASKT
}

template <bool SK, int DQK, bool DIL>
__device__ __forceinline__ void qkt_fin(f32x16& p0, f32x16& p1, const char* K_lds, int r32, int hi, const bf16x8* qr, bool act, float beta, int dq,
                                        f32x16& y0, f32x16& y1, float alpha, float& l_reg, bf16x8& pa0, bf16x8& pa1, bf16x8& pa2, bf16x8& pa3) {
    typedef Cfg<DQK> C;
    const bool run = !(SK && !act);
    if (!run) { const float NEG = -__builtin_inff();
#pragma unroll
        for (int r = 0; r < 16; ++r) { p0[r] = NEG; p1[r] = NEG; } }
    else if constexpr (DIL) { const float b0 = -beta * (float)dq;
#pragma unroll
        for (int r = 0; r < 16; ++r) { const int c = (r & 3) + 8 * (r >> 2); p0[r] = fmaf(beta, (float)c, b0); p1[r] = fmaf(beta, (float)(c + 32), b0); } }
    else { p0 = f32x16{}; p1 = f32x16{}; }
    const char* kb[4];
#pragma unroll
    for (int dd = 0; dd < 4; ++dd) { const int colB = (dd * 16 + hi * 8) * 2; kb[dd] = K_lds + r32 * C::KPITCH + (colB ^ ((r32 & 7) << 4)); }
#define QK_CHUNK(c_) do { if (run) { _Pragma("unroll") for (int d0 = 4 * (c_); d0 < 4 * (c_) + 4 && d0 < C::NQF; ++d0) { const char* a = kb[d0 & 3] + (d0 >> 2) * 128; \
            bf16x8 b0 = *reinterpret_cast<const bf16x8*>(a); bf16x8 b1 = *reinterpret_cast<const bf16x8*>(a + 32 * C::KPITCH);                                  \
            p0 = __builtin_amdgcn_mfma_f32_32x32x16_bf16(b0, qr[d0], p0, 0, 0, 0); p1 = __builtin_amdgcn_mfma_f32_32x32x16_bf16(b1, qr[d0], p1, 0, 0, 0); } } } while (0)
#define PK4(P, B_, OUT) do { unsigned a0 = cvtpk(P[B_+0], P[B_+1]), a1 = cvtpk(P[B_+2], P[B_+3]);                          \
        unsigned b0 = cvtpk(P[B_+4], P[B_+5]), b1 = cvtpk(P[B_+6], P[B_+7]);                                             \
        auto r0 = __builtin_amdgcn_permlane32_swap(a0, b0, false, false); auto r1 = __builtin_amdgcn_permlane32_swap(a1, b1, false, false); \
        u32x4 w = {r0[0], r1[0], r0[1], r1[1]}; OUT = *reinterpret_cast<bf16x8*>(&w); } while (0)
    QK_CHUNK(0);
#pragma unroll
    for (int r = 0; r < 16; ++r) y1[r] = __builtin_amdgcn_exp2f(y1[r]);
    float ps = 0;
#pragma unroll
    for (int r = 0; r < 16; ++r) ps += y0[r];
#pragma unroll
    for (int r = 0; r < 16; ++r) ps += y1[r];
    SBAR();
    QK_CHUNK(1);
    { auto rr = __builtin_amdgcn_permlane32_swap(__float_as_uint(ps), __float_as_uint(ps), false, false);
      ps = __uint_as_float(rr[0]) + __uint_as_float(rr[1]); }
    l_reg = l_reg * alpha + ps;
    PK4(y0, 0, pa0); PK4(y0, 8, pa1);
    if constexpr (C::NQF > 8) { SBAR(); QK_CHUNK(2); }
    PK4(y1, 0, pa2); PK4(y1, 8, pa3);
#undef PK4
#undef QK_CHUNK
}
#ifndef ATT_SKEW_SEL
#define ATT_SKEW_SEL 0
#endif
#if ATT_SKEW_SEL == 0
#define ATT_SKEW_A (wid < 4)
#elif ATT_SKEW_SEL == 1
#define ATT_SKEW_A ((wid & 1) == 0)
#elif ATT_SKEW_SEL == 2
#define ATT_SKEW_A true
#else
#define ATT_SKEW_A false
#endif
#define A_DMA_K(B_, k0, sl_) do { const char* kb_ = wsb + (B_).ko + (size_t)(k0) * (size_t)(KS_(B_) * 2); int ln_ = lane; asm volatile("" : "+v"(ln_)); \
        _Pragma("unroll") for (int j_ = 0; j_ < C::KCH; ++j_) { const int p_ = (j_ * 8 + wid) * 1024 + ln_ * 16, row_ = p_ / C::KPITCH, pc_ = (p_ % C::KPITCH) / 16, lc_ = (pc_ & ~7) | ((pc_ & 7) ^ (row_ & 7)); \
            A_GLDS((unsigned)(row_ * KS_(B_) * 2 + lc_ * 16), kb_, lds0 + 3 * SHM_V + (sl_) * C::SHM_K + (j_ * 8 + wid) * 1024); } } while (0)
#define A_DMA_V(B_, k0, sl_) do { const char* vb_ = wsb + (B_).vo + (size_t)(k0) * (size_t)(VS_(B_) * 2); int ln_ = lane; asm volatile("" : "+v"(ln_)); \
        _Pragma("unroll") for (int j_ = 0; j_ < 2; ++j_) { const int p_ = (j_ * 8 + wid) * 1024 + ln_ * 16, s_ = p_ / 512, w_ = p_ % 512, kk_ = (s_ >> 2) * 8 + (w_ >> 6), col_ = (s_ & 3) * 32 + ((w_ & 63) >> 1); \
            const int vr_ = (kk_ & ~0xC) | ((kk_ & 4) << 1) | ((kk_ & 8) >> 1); \
            A_GLDS((unsigned)(vr_ * VS_(B_) * 2 + col_ * 2), vb_, lds0 + (sl_) * SHM_V + (j_ * 8 + wid) * 1024); } } while (0)
#define A_RAWBAR() do { asm volatile("s_waitcnt lgkmcnt(0)" ::: "memory"); __builtin_amdgcn_s_barrier(); asm volatile("" ::: "memory"); } while (0)
template <int DQK, bool DIL>
__device__ __forceinline__ void att_prime_dma2(const Blk& cur, const char* wsb, char* lds, SeamD<DQK>& S, int tid_in) {
    typedef Cfg<DQK> C; constexpr int NS = 3;
    int tid = tid_in; asm volatile("" : "+v"(tid));
    const int wid = __builtin_amdgcn_readfirstlane(tid >> 6), lane = tid & 63, r32 = lane & 31, hi = lane >> 5;
    const unsigned lds0 = (unsigned)(uintptr_t)lds;
    const int kb0 = swa_jlo(cur.P0, W_(cur)) * KVBLK;
    A_QLOAD(cur);
    A_DMA_K(cur, kb0, 0); A_DMA_V(cur, kb0, 0); A_DMA_K(cur, kb0 + KVBLK, 1);
}
template <int DQK, bool DIL, bool SK, int ORD>
__device__ __forceinline__ void att_block_dma2(const Blk& cur, const Blk& nxt, const char* wsb, char* lds, SeamD<DQK>& S, int tid_in) {
    typedef Cfg<DQK> C; constexpr int NS = 3;
    int tid = tid_in; asm volatile("" : "+v"(tid));
    const int wid = __builtin_amdgcn_readfirstlane(tid >> 6), lane = tid & 63, r32 = lane & 31, hi = lane >> 5;
    const int W = W_(cur); const float scale = SCALE_, beta = cur.beta;
    const int j_lo = swa_jlo(cur.P0, W);
    int j_hi = (cur.P0 + QB - 1) / KVBLK + 1; if (j_hi > SKV_(cur) / KVBLK) j_hi = SKV_(cur) / KVBLK;
    const int NT = j_hi - j_lo;
    const int kbn = swa_jlo(nxt.P0, W_(nxt)) * KVBLK;
    const int qlo = cur.P0 + wid * QBLK, qm = qlo + r32 - 4 * hi;
    const unsigned lds0 = (unsigned)(uintptr_t)lds;
    const char* K_lds = lds + 3 * SHM_V;
    float* ws = (float*)(lds + 3 * SHM_V + 3 * C::SHM_K) + wid * 64; float* li_l = ws, * al_l = ws + 32;
    float m_reg = -1e30f, l_reg = 0; f32x16 o[4] = {};
    const int vb0 = (int)lds0 + v_rd_base(lane);
#define RESC(a) do { if (__any((a) < 1.f)) { if (hi == 0) al_l[r32] = (a); asm volatile("s_waitcnt lgkmcnt(0)" ::: "memory");              \
                     _Pragma("unroll") for (int d_ = 0; d_ < 4; ++d_) _Pragma("unroll") for (int r = 0; r < 16; ++r) o[d_][r] *= al_l[crow(r, hi)]; } } while (0)
#define KBASE(t) ((j_lo + (t)) * KVBLK)
#define ACT(t) (KBASE(t) <= qlo + QBLK - 1 && KBASE(t) + KVBLK - 1 >= qlo - W + 1)
#define MASKT(P0_, P1_, t) do { const int kb_ = KBASE(t); if ((!SK || ACT(t)) && (kb_ + KVBLK - 1 > qlo || kb_ <= qlo + QBLK - 1 - W)) mask_tile(P0_, P1_, qm - kb_, (unsigned)W); } while (0)
#define ISSUE(t, n_) do { n_ = 0; if ((t) + 2 < NT) { int slotk_ = sl + 2; if (slotk_ >= 3) slotk_ -= 3; A_DMA_K(cur, KBASE((t) + 2), slotk_); n_ += C::KCH; } \
                          if ((t) + 1 < NT) { int slotv_ = sl + 1; if (slotv_ >= 3) slotv_ -= 3; A_DMA_V(cur, KBASE((t) + 1), slotv_); n_ += 2; } } while (0)
#define CLOSE(n_) do { if ((n_) == C::KCH + 2) VMWN(C::KCH + 2); else if ((n_) == 2) VMWN(2); else VMW(); A_RAWBAR(); } while (0)
    VMW();
#pragma unroll
    for (int d0 = 0; d0 < C::NQF; ++d0) asm volatile("" : "+v"(S.qr[d0]));
    A_RAWBAR();
    int sl = 0, slp = 2, nis;
    f32x16 pA0, pA1, pB0, pB1; float mnA, mnB, alA, alB; bf16x8 pa0, pa1, pa2, pa3;
    ISSUE(0, nis); SBAR();
    qkt<0, SK, DQK, DIL>(pA0, pA1, K_lds + sl * C::SHM_K, r32, hi, S.qr, ACT(0), beta, qm - KBASE(0)); SBAR();
    MASKT(pA0, pA1, 0); partialSM(pA0, pA1, m_reg, mnA, alA, scale);
    CLOSE(nis); slp = sl; sl = sl == 2 ? 0 : sl + 1;
#define STEPP(PX0, PX1, mnX, alX, PY0, PY1, alY, t) do { ISSUE(t, nis); SBAR();                                               \
        if constexpr (ORD == 0) {                                                                                               \
            qkt<0, SK, DQK, DIL>(PX0, PX1, K_lds + sl * C::SHM_K, r32, hi, S.qr, ACT(t), beta, qm - KBASE(t)); SBAR();           \
            finishSM(PY0, PY1, alY, l_reg, pa0, pa1, pa2, pa3); SBAR();                                                         \
            pv_tile<0, SK>(o, vb0 + slp * SHM_V, pa0, pa1, pa2, pa3, ACT((t) - 1)); SBAR();                                     \
        } else {                                                                                                                \
            finishSM(PY0, PY1, alY, l_reg, pa0, pa1, pa2, pa3); SBAR();                                                         \
            pv_tile<0, SK>(o, vb0 + slp * SHM_V, pa0, pa1, pa2, pa3, ACT((t) - 1)); SBAR();                                     \
            qkt<0, SK, DQK, DIL>(PX0, PX1, K_lds + sl * C::SHM_K, r32, hi, S.qr, ACT(t), beta, qm - KBASE(t)); SBAR();           \
        }                                                                                                                       \
        MASKT(PX0, PX1, (t)); partialSM(PX0, PX1, m_reg, mnX, alX, scale);                                                     \
        RESC(alX); CLOSE(nis); slp = sl; sl = sl == 2 ? 0 : sl + 1; } while (0)
    int t = 1;
#pragma unroll 1
    for (; t + 2 < NT; t += 2) {
        STEPP(pB0, pB1, mnB, alB, pA0, pA1, alA, t);
        STEPP(pA0, pA1, mnA, alA, pB0, pB1, alB, t + 1);
    }
    STEPP(pB0, pB1, mnB, alB, pA0, pA1, alA, t);
    finishSM(pB0, pB1, alB, l_reg, pa0, pa1, pa2, pa3); SBAR();
    pv_tile<0, SK>(o, vb0 + slp * SHM_V, pa0, pa1, pa2, pa3, ACT(NT - 1));
    A_RAWBAR();
    A_QLOAD(nxt);
    A_DMA_K(nxt, kbn, 0); A_DMA_V(nxt, kbn, 0); A_DMA_K(nxt, kbn + KVBLK, 1);
    if (hi == 0) li_l[r32] = l_reg; asm volatile("s_waitcnt lgkmcnt(0)" ::: "memory");
    if constexpr (DIL) { if (hi == 0) __builtin_amdgcn_raw_buffer_store_b32(__float_as_uint(m_reg * scale + __logf(l_reg)), A_RSRC(wsb + cur.lo), r32 * LS_(cur) * 4, (cur.P0 + wid * QBLK) * LS_(cur) * 4, 0); }
    float rli[16];
#pragma unroll
    for (int r = 0; r < 16; ++r) rli[r] = __builtin_amdgcn_rcpf(li_l[crow(r, hi)]);
    const __amdgpu_buffer_rsrc_t ro_ = A_RSRC(wsb + cur.oo); const int oo_ = (4 * hi * OS_(cur) + r32) * 2, so0_ = (cur.P0 + wid * QBLK) * OS_(cur) * 2;
#pragma unroll
    for (int r = 0; r < 16; ++r) { const int sor_ = so0_ + ((r & 3) + 8 * (r >> 2)) * OS_(cur) * 2;
#pragma unroll
        for (int d0 = 0; d0 < 4; ++d0) { const float v = o[d0][r] * rli[r];
            const float vn = __int_as_float(__builtin_amdgcn_update_dpp(0, __float_as_int(v), 0xB1, 0xF, 0xF, true));
            if ((r32 & 1) == 0) __builtin_amdgcn_raw_buffer_store_b32(cvtpk(v, vn), ro_, oo_ + d0 * 64, sor_, 0); } }
#undef RESC
#undef KBASE
#undef ACT
#undef MASKT
#undef ISSUE
#undef CLOSE
#undef STEPP
}
#undef A_DMA_K
#undef A_DMA_V
#undef A_RAWBAR
#undef A_GLDS
#undef A_DMA_IDX
#undef A_DMA
#undef VMW
#undef VMWN
#undef A_SLOAD
#undef A_RSRC
#undef A_BLD
#undef A_QLOAD
#undef A_SWRITE_K
#undef A_SWRITE_V
#undef A_STAGE_IDX
#undef SBAR
#undef QS_
#undef KS_
#undef VS_
#undef OS_
#undef LS_
#undef SKV_
#undef W_
#undef SCALE_
}
constexpr int NWAVES = 8;
constexpr int T = 32768, DM = 2048, SEQ = 8192, NB = 4, DEPTH = 2;
constexpr int IN_COLS = 3904, PROJ_LD = 4096, NEXP = 16, DEXP = 1024;
constexpr int C_QB = 0, C_KB = 1024, C_VB = 2048, C_CQ = 3072, C_CKV = 3584, C_KR = 3840;
constexpr float EPS = 1e-6f;
constexpr size_t MiB = 1u << 20;
constexpr size_t WS_CTL = 0, CTL_ZERO_BYTES = 1 * MiB;
constexpr size_t WS_MOD = 1 * MiB;
constexpr size_t WS_ROPE = 2 * MiB;
constexpr size_t WS_RSTDQ = 4 * MiB, WS_RSTDKV = 4 * MiB + 256 * 1024, WS_AW = 4 * MiB + 512 * 1024;
constexpr size_t WS_ROWIDX = 5 * MiB;
constexpr size_t WS_LSE = 8 * MiB;
constexpr size_t WS_WIN = 16 * MiB;
constexpr size_t WS_WUQ = 48 * MiB;
constexpr size_t WS_WUKV = 51 * MiB;
constexpr size_t WS_WOUT = 53 * MiB;
constexpr size_t WS_W13 = 72 * MiB;
constexpr size_t WS_W2 = 200 * MiB;
constexpr size_t WS_H = 264 * MiB;
constexpr size_t WS_PROJ = 392 * MiB;
constexpr size_t WS_QA = 648 * MiB;
constexpr size_t WS_KF = 744 * MiB;
constexpr size_t WS_VB = 840 * MiB;
constexpr size_t WS_OA = 904 * MiB;
constexpr size_t WS_OB = 968 * MiB;
constexpr size_t WS_XB = 1160 * MiB;
constexpr size_t WS_END = 1288 * MiB;
constexpr size_t WS_HMID = WS_PROJ;
constexpr size_t WS_Y = WS_QA;
constexpr int CW_TMO = 0;
constexpr int CW_CNT = 64;
constexpr int CW_BAR = 4096;
constexpr int RING_BYTES = 131072;
constexpr int L_MISC = RING_BYTES, L_TS = RING_BYTES + 256, L_CNT = RING_BYTES + 384, L_TOK = RING_BYTES + 512, L_ATAB = RING_BYTES + 2560;
constexpr int MAXU = 10;
constexpr int LDS_BYTES = 147456;
static_assert(L_ATAB + MAXU * 1024 <= LDS_BYTES, "LDS map");

#define GAS __attribute__((address_space(1)))
#define LAS __attribute__((address_space(3)))
typedef unsigned short bf16;
typedef unsigned v4u __attribute__((ext_vector_type(4)));
typedef unsigned v2u __attribute__((ext_vector_type(2)));
typedef float f32x4 __attribute__((ext_vector_type(4)));
typedef float f32x2 __attribute__((ext_vector_type(2)));
#define LDS_WAIT() asm volatile("s_waitcnt lgkmcnt(0)" ::: "memory")
#define VM_WAIT() asm volatile("s_waitcnt vmcnt(0)" ::: "memory")
__device__ __forceinline__ unsigned pk2(float lo, float hi) { return pg8::cvt_pk_bf16(lo, hi); }
__device__ __forceinline__ float bf_lo(unsigned w) { return __uint_as_float(w << 16); }
__device__ __forceinline__ float bf_hi(unsigned w) { return __uint_as_float(w & 0xffff0000u); }


typedef __amdgpu_buffer_rsrc_t rsrc_t;
#define RSRC(p) __builtin_amdgcn_make_buffer_rsrc((void*)(p), 0, 0x7fffffff, 0x00020000)
__device__ __forceinline__ f32x4 bld4f(rsrc_t r, int vo, int so) { return __builtin_bit_cast(f32x4, __builtin_amdgcn_raw_buffer_load_b128(r, vo, so, 0)); }
__device__ __forceinline__ v4u bld4u(rsrc_t r, int vo, int so) { return __builtin_bit_cast(v4u, __builtin_amdgcn_raw_buffer_load_b128(r, vo, so, 0)); }
__device__ __forceinline__ v2u bld2u(rsrc_t r, int vo, int so) { return __builtin_bit_cast(v2u, __builtin_amdgcn_raw_buffer_load_b64(r, vo, so, 0)); }
__device__ __forceinline__ void bst2u(rsrc_t r, int vo, int so, v2u v) { __builtin_amdgcn_raw_buffer_store_b64(v, r, vo, so, 0); }
__device__ __forceinline__ void bst4u(rsrc_t r, int vo, int so, v4u v) { __builtin_amdgcn_raw_buffer_store_b128(v, r, vo, so, 0); }
__device__ __forceinline__ void bst4f(rsrc_t r, int vo, int so, f32x4 v) { __builtin_amdgcn_raw_buffer_store_b128(__builtin_bit_cast(v4u, v), r, vo, so, 0); }

#define XB_TMO      128
#define XB_XCNT(j)  (256  + 64 * (j))
#define XB_XSUB(j)  (1280 + 64 * (j))
#define XB_XGEN(j)  (2304 + 64 * (j))
#define XB_TOP      3328
#define XB_TOPGEN   3392
#define XCD_BAR_WORDS 3456
#define XB_SPIN_CAP (1u << 18)
__device__ __forceinline__ unsigned xb_ld(unsigned* p)              { return __hip_atomic_load(p, __ATOMIC_RELAXED, __HIP_MEMORY_SCOPE_AGENT); }
__device__ __forceinline__ unsigned xb_add(unsigned* p, unsigned v) { return __hip_atomic_fetch_add(p, v, __ATOMIC_RELAXED, __HIP_MEMORY_SCOPE_AGENT); }
__device__ __forceinline__ unsigned xb_xcc_id() { return (unsigned)__builtin_amdgcn_s_getreg((3 << 11) | 20) & 0xFu; }
#define XB_SPIN(cond, bar) do { unsigned _sp = 0; while (cond) { __builtin_amdgcn_s_sleep(1); \
    if ((++_sp & 255u) == 0u) { if (xb_ld(&(bar)[XB_TMO])) break; if (_sp > XB_SPIN_CAP) { atomicAdd(&(bar)[XB_TMO], 1u); break; } } } } while (0)
struct XcdBarrier { unsigned* bar; unsigned x; volatile LAS unsigned* st; };
__device__ __forceinline__ XcdBarrier xcd_barrier_post(unsigned* bar, volatile LAS unsigned* st, int tid) {
    XcdBarrier b; b.bar = bar; b.x = xb_xcc_id(); b.st = st;
    if (tid == 0) (void)xb_add(&bar[XB_XCNT(b.x)], 1u);
    return b;
}
__device__ __forceinline__ void xcd_barrier_complete(unsigned* bar, unsigned x, unsigned& nloc, unsigned& nx) {
    const unsigned G = gridDim.x * gridDim.y * gridDim.z;
    unsigned sum, cnt, mine, sp = 0u;
    for (;;) {
        sum = 0u; cnt = 0u; mine = 0u;
#pragma unroll
        for (unsigned j = 0; j < 16; ++j) { const unsigned c = xb_ld(&bar[XB_XCNT(j)]); sum += c; cnt += (c > 0u) ? 1u : 0u; mine = (j == x) ? c : mine; }
        if (sum == G) break;
        __builtin_amdgcn_s_sleep(1);
        if ((++sp & 255u) == 0u) { if (xb_ld(&bar[XB_TMO])) break; if (sp > XB_SPIN_CAP) { atomicAdd(&bar[XB_TMO], 1u); break; } }
    }
    nloc = mine > 0u ? mine : 1u; nx = cnt > 0u ? cnt : 1u;
}
__device__ __forceinline__ void xcd_barrier(const XcdBarrier& b, int tid) {
    asm volatile("s_waitcnt vmcnt(0)" ::: "memory");
    __syncthreads();
    if (tid == 0) {
        unsigned* bar = b.bar; asm volatile("" : "+s"(bar));
        __builtin_amdgcn_s_waitcnt(0);
        unsigned nloc = b.st[0], nx = b.st[1];
        if (nloc == 0u) { xcd_barrier_complete(bar, b.x, nloc, nx); b.st[0] = nloc; b.st[1] = nx; }
        const unsigned old = xb_add(&bar[XB_XSUB(b.x)], 1u);
        const unsigned gen = old / nloc;
        if (old + 1u == (gen + 1u) * nloc) {
            __builtin_amdgcn_fence(__ATOMIC_RELEASE, "agent");
            asm volatile("s_waitcnt vmcnt(0)" ::: "memory");
            const unsigned og = xb_add(&bar[XB_TOP], 1u);
            const unsigned tg = og / nx;
            if (og + 1u == (tg + 1u) * nx) xb_add(&bar[XB_TOPGEN], 1u);
            else XB_SPIN(xb_ld(&bar[XB_TOPGEN]) == tg, bar);
            __builtin_amdgcn_fence(__ATOMIC_ACQUIRE, "agent");
            xb_add(&bar[XB_XGEN(b.x)], 1u);
            asm volatile("s_waitcnt vmcnt(0)" ::: "memory");
        } else {
            XB_SPIN(xb_ld(&bar[XB_XGEN(b.x)]) == gen, bar);
            __builtin_amdgcn_fence(__ATOMIC_ACQUIRE, "agent");
            asm volatile("s_waitcnt vmcnt(0)" ::: "memory");
        }
    }
    __syncthreads();
}

struct Args {
    const float* in[20]; float* out; unsigned char* ws;
    float invf[32];
    int ph_lo, ph_hi, li, pad;
};
enum { I_X = 0, I_C, I_ADAW, I_ADAB, I_N1G, I_N2G, I_WIN, I_QNG, I_KVNG, I_WUQ, I_WUKV, I_ONA, I_ONB, I_WOUT, I_RW, I_RB, I_EG, I_EU, I_ED, I_FG };

struct Frame {
    LAS unsigned char* lds; unsigned char* ldsg;
    unsigned* ctl; unsigned char* ws;
    int tid, lane, wave, vcu, G;
};
__device__ __forceinline__ int lane_id() { int l; asm volatile("v_mbcnt_lo_u32_b32 %0, -1, 0\n\tv_mbcnt_hi_u32_b32 %0, -1, %0" : "=v"(l)); return l; }
#define DPP_ADD(v, ctrl) v += __int_as_float(__builtin_amdgcn_update_dpp(0, __float_as_int(v), ctrl, 0xF, 0xF, true))
__device__ __forceinline__ float wave_sum(float v) {
    DPP_ADD(v, 0xB1); DPP_ADD(v, 0x4E); DPP_ADD(v, 0x141); DPP_ADD(v, 0x140);
    v += __int_as_float(__builtin_amdgcn_ds_swizzle(__float_as_int(v), 0x401F));
    auto rr = __builtin_amdgcn_permlane32_swap(__float_as_uint(v), __float_as_uint(v), false, false);
    return __uint_as_float(rr[0]) + __uint_as_float(rr[1]);
}
__device__ __forceinline__ int il64(int j) { return j < 32 ? 2 * j : 2 * (j - 32) + 1; }
template <int MODE> __device__ __forceinline__ int dest_row(int n) {
    if constexpr (MODE == 0) return n;
    else if constexpr (MODE == 1) {
        if (n < 512) return C_CQ + n; if (n < 768) return C_CKV + (n - 512); if (n < 832) return C_KR + il64(n - 768);
        if (n < 1856) return C_QB + (n - 832); if (n < 2880) return C_KB + (n - 1856); return C_VB + (n - 2880); }
    else if constexpr (MODE == 2) { const int h = n / 192, j = n % 192; return j < 128 ? n : h * 192 + 128 + il64(j - 128); }
    else if constexpr (MODE == 3) return (n >> 7) * 256 + (n & 127);
    else return (n >> 7) * 256 + 128 + (n & 127);
}
template <int MODE>
__device__ __forceinline__ void transpose_item(const float* W, int ldw, int K, int N, bf16* WT, const float* kscale, LAS float* scr, int item, int lane) {
    const int nblk = N / 32, kb = item / nblk, nb = item % nblk, k0 = 64 * kb, n0 = 32 * nb;
    float tv[32];
#pragma unroll
    for (int i = 0; i < 32; ++i) { const int kk = 2 * i + (lane >> 5); tv[i] = W[(size_t)(k0 + kk) * ldw + n0 + (lane & 31)]; }
#pragma unroll
    for (int i = 0; i < 32; ++i) { const int kk = 2 * i + (lane >> 5); float v = tv[i]; if (kscale) v *= kscale[k0 + kk]; scr[kk * 33 + (lane & 31)] = v; }
    LDS_WAIT(); asm volatile("" ::: "memory");
    const int c = lane & 7;
#pragma unroll
    for (int j = 0; j < 4; ++j) { const int n = (lane >> 3) + 8 * j; const LAS float* s = scr + (8 * c) * 33 + n;
        v4u o; o.x = pk2(s[0 * 33], s[1 * 33]); o.y = pk2(s[2 * 33], s[3 * 33]); o.z = pk2(s[4 * 33], s[5 * 33]); o.w = pk2(s[6 * 33], s[7 * 33]);
        *(v4u*)(WT + (size_t)dest_row<MODE>(n0 + n) * K + k0 + 8 * c) = o; }
    LDS_WAIT(); asm volatile("s_waitcnt vmcnt(0)" ::: "memory");
}

__device__ __forceinline__ unsigned pk4_fp8(float a, float b, float c, float d) { int w = 0; w = __builtin_amdgcn_cvt_pk_fp8_f32(a, b, w, false); w = __builtin_amdgcn_cvt_pk_fp8_f32(c, d, w, true); return (unsigned)w; }
template <int MODE>
__device__ __forceinline__ void transpose_item8(const float* W, int ldw, int K, int N, unsigned char* WT, LAS float* scr, int item, int lane) {
    const int nblk = N / 32, kb = item / nblk, nb = item % nblk, k0 = 64 * kb, n0 = 32 * nb;
    float tv[32];
#pragma unroll
    for (int i = 0; i < 32; ++i) { const int kk = 2 * i + (lane >> 5); tv[i] = W[(size_t)(k0 + kk) * ldw + n0 + (lane & 31)]; }
#pragma unroll
    for (int i = 0; i < 32; ++i) { const int kk = 2 * i + (lane >> 5); scr[kk * 33 + (lane & 31)] = tv[i] * 256.0f; }
    LDS_WAIT(); asm volatile("" ::: "memory");
    const int c = lane & 7;
#pragma unroll
    for (int j = 0; j < 4; ++j) { const int n = (lane >> 3) + 8 * j; const LAS float* s = scr + (8 * c) * 33 + n;
        v2u o; o.x = pk4_fp8(s[0 * 33], s[1 * 33], s[2 * 33], s[3 * 33]); o.y = pk4_fp8(s[4 * 33], s[5 * 33], s[6 * 33], s[7 * 33]);
        *(v2u*)(WT + (size_t)dest_row<MODE>(n0 + n) * K + k0 + 8 * c) = o; }
    LDS_WAIT(); asm volatile("s_waitcnt vmcnt(0)" ::: "memory");
}

__device__ __forceinline__ void phase_prologue(Frame& F, const Args& A) {
    {
        const float* cc = A.in[I_C]; float* mod = (float*)(F.ws + WS_MOD);
        LAS float* red = (LAS float*)F.lds;
        for (int id = F.vcu; id < 2 * 96; id += F.G) {
            const int l = id / 96, ch = id % 96, cg = F.tid & 31, kg = F.tid >> 5, col = ch * 128 + cg * 4;
            const float* w = A.in[I_ADAW] + (size_t)l * DM * 12288 + col;
            f32x4 acc[4] = {};
#pragma unroll 4
            for (int kk = 0; kk < 128; ++kk) { const int k = kg * 128 + kk; const f32x4 wv = *(const f32x4*)(w + (size_t)k * 12288);
#pragma unroll
                for (int b = 0; b < 4; ++b) { const float cv = cc[b * DM + k]; const float ca = cv / (1.0f + __expf(-cv)); acc[b] += wv * ca; } }
#pragma unroll
            for (int b = 0; b < 4; ++b) *(LAS f32x4*)(red + ((kg * 32 + cg) * 16 + b * 4)) = acc[b];
            __syncthreads();
            if (F.tid < 128) { const int cg2 = F.tid & 31, b = F.tid >> 5; f32x4 s = {0.f, 0.f, 0.f, 0.f};
#pragma unroll
                for (int g = 0; g < 16; ++g) s += *(LAS f32x4*)(red + ((g * 32 + cg2) * 16 + b * 4));
                const int c2 = ch * 128 + cg2 * 4; const f32x4 bv = *(const f32x4*)(A.in[I_ADAB] + (size_t)l * 12288 + c2);
                *(f32x4*)(mod + ((size_t)l * 4 + b) * 12288 + c2) = s + bv; }
            asm volatile("s_waitcnt vmcnt(0)" ::: "memory");
            __syncthreads();
        }
    }
    {
        LAS float* scr = (LAS float*)(F.lds + F.wave * 16384);
        const int gw = F.vcu * NWAVES + F.wave, NGW = F.G * NWAVES;
        constexpr int I_IN = (DM / 64) * (IN_COLS / 32), I_UQ = (512 / 64) * (1536 / 32), I_UKV = (256 / 64) * (2048 / 32), I_OUT = (DM / 64) * (DM / 32), I_L = I_IN + I_UQ + I_UKV + I_OUT;
        for (int it = gw; it < 2 * I_L; it += NGW) {
            const int l = it / I_L; int r = it % I_L;
            if (r < I_IN) { transpose_item<1>(A.in[I_WIN] + (size_t)l * DM * IN_COLS, IN_COLS, DM, IN_COLS, (bf16*)(F.ws + WS_WIN) + (size_t)l * 4096 * DM, nullptr, scr, r, F.lane); continue; } r -= I_IN;
            if (r < I_UQ) { transpose_item<2>(A.in[I_WUQ] + (size_t)l * 512 * 1536, 1536, 512, 1536, (bf16*)(F.ws + WS_WUQ) + (size_t)l * 1536 * 512, A.in[I_QNG] + l * 512, scr, r, F.lane); continue; } r -= I_UQ;
            if (r < I_UKV) { transpose_item<0>(A.in[I_WUKV] + (size_t)l * 256 * 2048, 2048, 256, 2048, (bf16*)(F.ws + WS_WUKV) + (size_t)l * 2048 * 256, A.in[I_KVNG] + l * 256, scr, r, F.lane); continue; } r -= I_UKV;
#ifdef G3_FP8
            transpose_item8<0>(A.in[I_WOUT] + (size_t)l * DM * DM, DM, DM, DM, F.ws + WS_WOUT + (size_t)l * DM * DM, scr, r, F.lane);
#else
            transpose_item<0>(A.in[I_WOUT] + (size_t)l * DM * DM, DM, DM, DM, (bf16*)(F.ws + WS_WOUT) + (size_t)l * DM * DM, nullptr, scr, r, F.lane);
#endif
        }
    }
    {
        const int gt = F.vcu * (NWAVES * 64) + F.tid, NGT = F.G * NWAVES * 64;
        float* rope = (float*)(F.ws + WS_ROPE);
        for (int e = gt; e < SEQ * 32; e += NGT) { const int pos = e >> 5, i = e & 31;
            const float ang = (float)pos * A.invf[i];
            const double rev = (double)ang * 0.15915494309189535; const float fr = (float)(rev - __builtin_floor(rev));
            *(f32x2*)(rope + (size_t)e * 2) = (f32x2){__builtin_amdgcn_cosf(fr), __builtin_amdgcn_sinf(fr)}; }
        for (int e = gt; e < 2 * 192 * (DM / 8); e += NGT) { const int l = e / (192 * (DM / 8)), r = e % (192 * (DM / 8));
            *(v4u*)((bf16*)(F.ws + WS_WIN) + ((size_t)l * 4096 + IN_COLS) * DM + (size_t)r * 8) = (v4u){0u, 0u, 0u, 0u}; }
    }
}

__device__ __forceinline__ void phase_norm1(Frame& F, const Args& A, int l) {
    const int gw = F.vcu * NWAVES + F.wave, NGW = F.G * NWAVES;
    const float* mod = (const float*)(F.ws + WS_MOD);
    bf16* H = (bf16*)(F.ws + WS_H); const bf16* Y = (const bf16*)(F.ws + WS_Y);
    for (int ch = gw; ch < T / 16; ch += NGW) {
        const int row0 = ch * 16, b = row0 >> 13;
        const float* ml = mod + ((size_t)l * 4 + b) * 12288;
        f32x4 gsc[8], sh[8], g2p[8];
#pragma unroll
        for (int j = 0; j < 8; ++j) { const int c = 4 * F.lane + 256 * j; const f32x4 g = *(const f32x4*)(A.in[I_N1G] + l * DM + c), sc = *(const f32x4*)(ml + 1 * DM + c);
            gsc[j] = g * (sc + 1.0f); sh[j] = *(const f32x4*)(ml + 0 * DM + c);
            if (l > 0) g2p[j] = *(const f32x4*)(mod + ((size_t)(l - 1) * 4 + b) * 12288 + 5 * DM + c); }
#pragma unroll 1
        for (int rr = 0; rr < 16; ++rr) {
            const int row = row0 + rr; f32x4 v[8]; float s = 0.f;
            if (l == 0) {
#pragma unroll
                for (int j = 0; j < 8; ++j) v[j] = *(const f32x4*)(A.in[I_X] + (size_t)row * DM + 4 * F.lane + 256 * j);
            } else {
#pragma unroll
                for (int j = 0; j < 8; ++j) { const int c = 4 * F.lane + 256 * j;
#ifdef XRES_BF16
                    bf16* XB = (bf16*)(F.ws + WS_XB); const v2u xw = *(const v2u*)(XB + (size_t)row * DM + c); const f32x4 xr = {bf_lo(xw.x), bf_hi(xw.x), bf_lo(xw.y), bf_hi(xw.y)};
#else
                    const f32x4 xr = *(const f32x4*)(A.out + (size_t)row * DM + c);
#endif
                    const v2u y0 = *(const v2u*)(Y + (size_t)(2 * row) * DM + c), y1 = *(const v2u*)(Y + (size_t)(2 * row + 1) * DM + c);
                    const f32x4 ys = {bf_lo(y0.x) + bf_lo(y1.x), bf_hi(y0.x) + bf_hi(y1.x), bf_lo(y0.y) + bf_lo(y1.y), bf_hi(y0.y) + bf_hi(y1.y)};
                    v[j] = xr + g2p[j] * ys;
#ifdef XRES_BF16
                    { const v2u ow = {pk2(v[j].x, v[j].y), pk2(v[j].z, v[j].w)}; *(v2u*)(XB + (size_t)row * DM + c) = ow;
                      v[j] = (f32x4){bf_lo(ow.x), bf_hi(ow.x), bf_lo(ow.y), bf_hi(ow.y)}; }
#else
                    *(f32x4*)(A.out + (size_t)row * DM + c) = v[j];
#endif
                }
            }
#pragma unroll
            for (int j = 0; j < 8; ++j) s += (v[j].x * v[j].x + v[j].y * v[j].y) + (v[j].z * v[j].z + v[j].w * v[j].w);
            const float rstd = __builtin_amdgcn_rsqf(wave_sum(s) * (1.f / DM) + EPS);
#pragma unroll
            for (int j = 0; j < 8; ++j) { const f32x4 o = v[j] * rstd * gsc[j] + sh[j];
                *(v2u*)(H + (size_t)row * DM + 4 * F.lane + 256 * j) = (v2u){pk2(o.x, o.y), pk2(o.z, o.w)}; }
        }
    }
#ifndef ATT_CONV
    {
        LAS float* scr = (LAS float*)(F.lds + F.wave * 16384);
        constexpr int I_G = (DM / 64) * (DEXP / 32), I_D = (DEXP / 64) * (DM / 32), I_E = 2 * I_G + I_D;
        for (int it = gw; it < NEXP * I_E; it += NGW) {
            const int e = it / I_E; int r = it % I_E; const size_t eo = ((size_t)l * NEXP + e) * DM * DEXP;
            if (r < I_G) { transpose_item8<3>(A.in[I_EG] + eo, DEXP, DM, DEXP, F.ws + WS_W13 + (size_t)e * 2048 * DM, scr, r, F.lane); continue; } r -= I_G;
            if (r < I_G) { transpose_item8<4>(A.in[I_EU] + eo, DEXP, DM, DEXP, F.ws + WS_W13 + (size_t)e * 2048 * DM, scr, r, F.lane); continue; } r -= I_G;
            transpose_item8<0>(A.in[I_ED] + eo, DM, DEXP, DM, F.ws + WS_W2 + (size_t)e * DM * DEXP, scr, r, F.lane);
        }
    }
#endif
}
__device__ __forceinline__ void phase_final(Frame& F, const Args& A, int probe) {
    const int gw = F.vcu * NWAVES + F.wave, NGW = F.G * NWAVES;
    const float* mod = (const float*)(F.ws + WS_MOD); const bf16* Y = (const bf16*)(F.ws + WS_Y);
    for (int ch = gw; ch < T / 16; ch += NGW) {
        const int row0 = ch * 16, b = row0 >> 13;
        f32x4 fg[8], g2p[8];
#pragma unroll
        for (int j = 0; j < 8; ++j) { const int c = 4 * F.lane + 256 * j; fg[j] = *(const f32x4*)(A.in[I_FG] + c); g2p[j] = *(const f32x4*)(mod + ((size_t)(probe == 3 ? 0 : DEPTH - 1) * 4 + b) * 12288 + 5 * DM + c); }
#pragma unroll 1
        for (int rr = 0; rr < 16; ++rr) {
            const int row = row0 + rr; f32x4 v[8]; float s = 0.f;
#pragma unroll
            for (int j = 0; j < 8; ++j) { const int c = 4 * F.lane + 256 * j;
#ifdef XRES_BF16
                const v2u xw = *(const v2u*)((const bf16*)(F.ws + WS_XB) + (size_t)row * DM + c); const f32x4 xr = {bf_lo(xw.x), bf_hi(xw.x), bf_lo(xw.y), bf_hi(xw.y)};
#else
                const f32x4 xr = *(const f32x4*)((probe == 2 ? A.in[I_X] : A.out) + (size_t)row * DM + c);
#endif
                const v2u y0 = *(const v2u*)(Y + (size_t)(2 * row) * DM + c), y1 = *(const v2u*)(Y + (size_t)(2 * row + 1) * DM + c);
                const f32x4 ys = {bf_lo(y0.x) + bf_lo(y1.x), bf_hi(y0.x) + bf_hi(y1.x), bf_lo(y0.y) + bf_lo(y1.y), bf_hi(y0.y) + bf_hi(y1.y)};
                v[j] = (probe == 1 || probe == 2) ? xr : xr + g2p[j] * ys; }
#pragma unroll
            for (int j = 0; j < 8; ++j) s += (v[j].x * v[j].x + v[j].y * v[j].y) + (v[j].z * v[j].z + v[j].w * v[j].w);
            const float rstd = __builtin_amdgcn_rsqf(wave_sum(s) * (1.f / DM) + EPS);
#pragma unroll
            for (int j = 0; j < 8; ++j) *(f32x4*)(A.out + (size_t)row * DM + 4 * F.lane + 256 * j) = v[j] * rstd * fg[j];
        }
    }
}
#ifndef PROBE_DUMP_SCALE
#define PROBE_DUMP_SCALE 1.0f
#endif
#ifndef PROBE_DUMP_W
#define PROBE_DUMP_W 2048
#endif
__device__ __forceinline__ void phase_dump(Frame& F, const Args& A, size_t off, int pitch) {
    const int gw = F.vcu * NWAVES + F.wave, NGW = F.G * NWAVES;
    for (int row = gw; row < T; row += NGW) { const bf16* src = (const bf16*)(F.ws + off) + (size_t)row * pitch;
#ifdef PROBE_DUMP_F32
        for (int j = 0; j < 8; ++j) { const int c = 4 * F.lane + 256 * j; const float* sf = (const float*)(F.ws + off) + (size_t)row * pitch + c;
#ifdef PROBE_DUMP_SRC_OUT
            sf = A.out + (size_t)row * DM + c;
#endif
            f32x4 o = {0.f, 0.f, 0.f, 0.f}; if (c < PROBE_DUMP_W) o = *(const f32x4*)sf * PROBE_DUMP_SCALE;
#ifdef PROBE_DUMP_LOWBITS
            { const v4u ub = __builtin_bit_cast(v4u, o); o = (f32x4){(float)(ub.x & 0xFFFu), (float)(ub.y & 0xFFFu), (float)(ub.z & 0xFFFu), (float)(ub.w & 0xFFFu)}; }
#endif
            *(f32x4*)(A.out + (size_t)row * DM + c) = o; }
        continue;
#endif
        for (int j = 0; j < 8; ++j) { const int c = 4 * F.lane + 256 * j; const v2u w = *(const v2u*)(src + c);
#ifdef PROBE_DUMP_LOWBITS
            *(f32x4*)(A.out + (size_t)row * DM + c) = c < PROBE_DUMP_W ? (f32x4){(float)(w.x & 0x7Fu), (float)((w.x >> 16) & 0x7Fu), (float)(w.y & 0x7Fu), (float)((w.y >> 16) & 0x7Fu)} : (f32x4){0.f, 0.f, 0.f, 0.f}; } }
#else
            *(f32x4*)(A.out + (size_t)row * DM + c) = c < PROBE_DUMP_W ? (f32x4){bf_lo(w.x), bf_hi(w.x), bf_lo(w.y), bf_hi(w.y)} : (f32x4){0.f, 0.f, 0.f, 0.f}; } }
#endif
}
__device__ __forceinline__ void phase_mla_prep(Frame& F, const Args& A) {
    const int gw = F.vcu * NWAVES + F.wave, NGW = F.G * NWAVES;
    const bf16* P = (const bf16*)(F.ws + WS_PROJ); bf16* KF = (bf16*)(F.ws + WS_KF);
    float* rq = (float*)(F.ws + WS_RSTDQ); float* rkv = (float*)(F.ws + WS_RSTDKV); const float* rope = (const float*)(F.ws + WS_ROPE);
    for (int ch = gw; ch < T / 16; ch += NGW) {
#pragma unroll 1
        for (int r4 = 0; r4 < 16; r4 += 4) {
            v4u q[4]; v2u kv[4]; unsigned kr[4]; f32x2 cs[4];
#pragma unroll
            for (int u = 0; u < 4; ++u) { const int row = ch * 16 + r4 + u; const bf16* pr = P + (size_t)row * PROJ_LD;
                q[u] = *(const v4u*)(pr + C_CQ + 8 * F.lane); kv[u] = *(const v2u*)(pr + C_CKV + 4 * F.lane);
                kr[u] = *(const unsigned*)(pr + C_KR + 2 * (F.lane & 31)); cs[u] = *(const f32x2*)(rope + ((size_t)(row & (SEQ - 1)) * 32 + (F.lane & 31)) * 2); }
#pragma unroll
            for (int u = 0; u < 4; ++u) { const int row = ch * 16 + r4 + u;
                float sq = 0.f, skv = 0.f;
#pragma unroll
                for (int i = 0; i < 4; ++i) { const float a = bf_lo(q[u][i]), b2 = bf_hi(q[u][i]); sq += a * a + b2 * b2; }
#pragma unroll
                for (int i = 0; i < 2; ++i) { const float a = bf_lo(kv[u][i]), b2 = bf_hi(kv[u][i]); skv += a * a + b2 * b2; }
                sq = wave_sum(sq); skv = wave_sum(skv);
                if (F.lane == 0) { rq[row] = __builtin_amdgcn_rsqf(sq * (1.f / 512.f) + EPS); rkv[row] = __builtin_amdgcn_rsqf(skv * (1.f / 256.f) + EPS); }
                if (F.lane < 32) { const float x1 = bf_lo(kr[u]), x2 = bf_hi(kr[u]);
                    const unsigned o = pk2(x1 * cs[u].x - x2 * cs[u].y, x2 * cs[u].x + x1 * cs[u].y);
#pragma unroll
                    for (int h = 0; h < 8; ++h) *(unsigned*)(KF + (size_t)row * 1536 + h * 192 + 128 + 2 * F.lane) = o; } }
        }
    }
}
__device__ __forceinline__ void phase_q_rope(Frame& F, const Args& A) {
    const int gw = F.vcu * NWAVES + F.wave, NGW = F.G * NWAVES;
    bf16* QA = (bf16*)(F.ws + WS_QA); const float* rope = (const float*)(F.ws + WS_ROPE);
    for (int ch = gw; ch < T / 16; ch += NGW) {
#pragma unroll 1
        for (int r4 = 0; r4 < 16; r4 += 4) {
            v4u w[4]; f32x4 c01[4], c23[4];
#pragma unroll
            for (int u = 0; u < 4; ++u) { const int row = ch * 16 + r4 + u;
                w[u] = *(const v4u*)(QA + (size_t)row * 1536 + (F.lane >> 3) * 192 + 128 + (F.lane & 7) * 8);
                const f32x4* cs = (const f32x4*)(rope + ((size_t)(row & (SEQ - 1)) * 32 + (F.lane & 7) * 4) * 2); c01[u] = cs[0]; c23[u] = cs[1]; }
#pragma unroll
            for (int u = 0; u < 4; ++u) { const int row = ch * 16 + r4 + u; v4u o;
                { const float x1 = bf_lo(w[u].x), x2 = bf_hi(w[u].x); o.x = pk2(x1 * c01[u][0] - x2 * c01[u][1], x2 * c01[u][0] + x1 * c01[u][1]); }
                { const float x1 = bf_lo(w[u].y), x2 = bf_hi(w[u].y); o.y = pk2(x1 * c01[u][2] - x2 * c01[u][3], x2 * c01[u][2] + x1 * c01[u][3]); }
                { const float x1 = bf_lo(w[u].z), x2 = bf_hi(w[u].z); o.z = pk2(x1 * c23[u][0] - x2 * c23[u][1], x2 * c23[u][0] + x1 * c23[u][1]); }
                { const float x1 = bf_lo(w[u].w), x2 = bf_hi(w[u].w); o.w = pk2(x1 * c23[u][2] - x2 * c23[u][3], x2 * c23[u][2] + x1 * c23[u][3]); }
                *(v4u*)(QA + (size_t)row * 1536 + (F.lane >> 3) * 192 + 128 + (F.lane & 7) * 8) = o; }
        }
    }
}
__device__ __forceinline__ void phase_out_norm(Frame& F, const Args& A, int l) {
    const int gw = F.vcu * NWAVES + F.wave, NGW = F.G * NWAVES;
    const bf16* OA = (const bf16*)(F.ws + WS_OA); const bf16* OB = (const bf16*)(F.ws + WS_OB); const float* LSE = (const float*)(F.ws + WS_LSE); bf16* Yn = (bf16*)(F.ws + WS_H);
    for (int ch = gw; ch < T / 16; ch += NGW) {
        float ga[2][8], gb[2][8];
#pragma unroll
        for (int hf = 0; hf < 2; ++hf)
#pragma unroll
            for (int i = 0; i < 8; ++i) { ga[hf][i] = A.in[I_ONA][l * 1024 + hf * 512 + 8 * F.lane + i]; gb[hf][i] = A.in[I_ONB][l * 1024 + hf * 512 + 8 * F.lane + i]; }
#pragma unroll 1
        for (int rr = 0; rr < 16; ++rr) {
            const int row = ch * 16 + rr;
            float va[2][8], vb[2][8]; float sa = 0.f, sb = 0.f;
#pragma unroll
            for (int hf = 0; hf < 2; ++hf) {
                const int c = hf * 512 + 8 * F.lane, hd = c >> 7;
                const v4u a = *(const v4u*)(OA + (size_t)row * 1024 + c);
#pragma unroll
                for (int i = 0; i < 4; ++i) { va[hf][2 * i] = bf_lo(a[i]); va[hf][2 * i + 1] = bf_hi(a[i]); }
                const float l0 = LSE[((size_t)0 * T + row) * 8 + hd], l1 = LSE[((size_t)1 * T + row) * 8 + hd], l2 = LSE[((size_t)2 * T + row) * 8 + hd];
                const float mx = fmaxf(l0, fmaxf(l1, l2)); const float e0 = __expf(l0 - mx), e1 = __expf(l1 - mx), e2 = __expf(l2 - mx); const float inv = 1.0f / (e0 + e1 + e2);
                const float al[3] = {e0 * inv, e1 * inv, e2 * inv};
#pragma unroll
                for (int i = 0; i < 8; ++i) vb[hf][i] = 0.f;
#pragma unroll
                for (int n = 0; n < 3; ++n) { const v4u o = *(const v4u*)(OB + ((size_t)n * T + row) * 1024 + c);
#pragma unroll
                    for (int i = 0; i < 4; ++i) { vb[hf][2 * i] += al[n] * bf_lo(o[i]); vb[hf][2 * i + 1] += al[n] * bf_hi(o[i]); } }
#pragma unroll
                for (int i = 0; i < 8; ++i) { sa += va[hf][i] * va[hf][i]; sb += vb[hf][i] * vb[hf][i]; }
            }
            const float ra = __builtin_amdgcn_rsqf(wave_sum(sa) * (1.f / 1024.f) + EPS), rb = __builtin_amdgcn_rsqf(wave_sum(sb) * (1.f / 1024.f) + EPS);
#pragma unroll
            for (int hf = 0; hf < 2; ++hf) { const int c = hf * 512 + 8 * F.lane; v4u wa, wb;
#pragma unroll
                for (int i = 0; i < 4; ++i) { wa[i] = pk2(va[hf][2 * i] * ra * ga[hf][2 * i], va[hf][2 * i + 1] * ra * ga[hf][2 * i + 1]); wb[i] = pk2(vb[hf][2 * i] * rb * gb[hf][2 * i], vb[hf][2 * i + 1] * rb * gb[hf][2 * i + 1]); }
#ifdef G3_FP8
                { unsigned char* Y8 = (unsigned char*)Yn; float ya[8], yb[8];
#pragma unroll
                  for (int i = 0; i < 8; ++i) { ya[i] = va[hf][i] * ra * ga[hf][i]; yb[i] = vb[hf][i] * rb * gb[hf][i]; }
                  *(v2u*)(Y8 + (size_t)row * DM + c) = (v2u){pk4_fp8(ya[0], ya[1], ya[2], ya[3]), pk4_fp8(ya[4], ya[5], ya[6], ya[7])};
                  *(v2u*)(Y8 + (size_t)row * DM + 1024 + c) = (v2u){pk4_fp8(yb[0], yb[1], yb[2], yb[3]), pk4_fp8(yb[4], yb[5], yb[6], yb[7])}; }
#else
                *(v4u*)(Yn + (size_t)row * DM + c) = wa; *(v4u*)(Yn + (size_t)row * DM + 1024 + c) = wb;
#endif
            }
        }
    }
}
#ifndef ROUTER_SRC
#define ROUTER_SRC A.out
#endif
__device__ __forceinline__ void phase_router(Frame& F, const Args& A, int l, int dummy = 0) {
    const float* mod = (const float*)(F.ws + WS_MOD);
    bf16* H = (bf16*)(F.ws + WS_H);
    LAS f32x4* rwl = (LAS f32x4*)F.lds;
    LAS int* lcnt = (LAS int*)(F.lds + L_CNT); LAS int* gbase = lcnt + 16; LAS int* tokinfo = (LAS int*)(F.lds + L_TOK);
    unsigned* gcnt = F.ctl + CW_CNT + (dummy ? 3 : l) * 16;
    int* rowidx = (int*)(F.ws + (dummy ? WS_OB : WS_ROWIDX)); float* aw = (float*)(F.ws + (dummy ? WS_OB + 4 * MiB : WS_AW));
    for (int q = F.tid; q < 8192; q += NWAVES * 64) { const int k = q >> 2, e4 = q & 3, ln = (k & 255) >> 2, j = k >> 8, i = k & 3;
        rwl[((j * 4 + i) * 4 + e4) * 64 + ln] = *(const f32x4*)(A.in[I_RW] + (size_t)k * 16 + e4 * 4); }
    float rb[16];
#pragma unroll
    for (int e = 0; e < 16; ++e) rb[e] = __uint_as_float(__builtin_amdgcn_readfirstlane(__float_as_uint(A.in[I_RB][e])));
    __syncthreads();
    for (int bi = F.vcu; bi < T / 128; bi += F.G) {
        { const int t0_ = F.wave * 64 + lane_id(); if (t0_ < 16) lcnt[t0_] = 0; }
        __syncthreads();
        const int row0 = bi * 128 + F.wave * 16, b = row0 >> 13;
        const rsrc_t rml = RSRC(mod + ((size_t)l * 4 + b) * 12288), rgn = RSRC(A.in[I_N2G] + l * DM), rx = RSRC(ROUTER_SRC), rh = RSRC(H);
#ifdef XRES_BF16
        const rsrc_t rxb = RSRC(F.ws + WS_XB);
#endif
        const int lo16 = F.lane * 16, lo8 = F.lane * 8;
        float cst[16];
        { f32x4 ca[4] = {};
#pragma unroll
          for (int j = 0; j < 8; ++j) { const f32x4 sh = bld4f(rml, lo16 + j * 1024, 3 * DM * 4);
#pragma unroll
            for (int i = 0; i < 4; ++i)
#pragma unroll
                for (int e4 = 0; e4 < 4; ++e4) ca[e4] += rwl[((j * 4 + i) * 4 + e4) * 64 + F.lane] * sh[i];
            asm volatile("" ::: "memory"); }
#pragma unroll
          for (int e = 0; e < 16; ++e) cst[e] = __uint_as_float(__builtin_amdgcn_readfirstlane(__float_as_uint(wave_sum(ca[e >> 2][e & 3])))); }
        f32x4 gsv[8];
#pragma unroll
        for (int j = 0; j < 8; ++j) gsv[j] = bld4f(rgn, lo16 + j * 1024, 0) * (bld4f(rml, lo16 + j * 1024, 4 * DM * 4) + 1.0f);
#pragma unroll 1
        for (int rp = 0; rp < 8; ++rp) {
            float ss[2] = {0.f, 0.f}; f32x4 acc[2][4] = {};
            const int so0 = (row0 + rp * 2) * (DM * 4);
#ifdef XRES_BF16
            v2u xraw[2][8];
#pragma unroll
            for (int q = 0; q < 2; ++q)
#pragma unroll
                for (int j = 0; j < 8; ++j) xraw[q][j] = bld2u(rxb, lo8 + j * 512, (row0 + rp * 2 + q) * (DM * 2));
#define XV(q, j) ((f32x4){bf_lo(xraw[q][j].x), bf_hi(xraw[q][j].x), bf_lo(xraw[q][j].y), bf_hi(xraw[q][j].y)})
#else
            f32x4 xv[2][8];
#pragma unroll
            for (int q = 0; q < 2; ++q)
#pragma unroll
                for (int j = 0; j < 8; ++j) xv[q][j] = bld4f(rx, lo16 + j * 1024, so0 + q * (DM * 4));
#define XV(q, j) xv[q][j]
#endif
#pragma unroll
            for (int j = 0; j < 8; ++j) {
                f32x4 a[2];
#pragma unroll
                for (int q = 0; q < 2; ++q) { const f32x4 x = XV(q, j); ss[q] += (x.x * x.x + x.y * x.y) + (x.z * x.z + x.w * x.w); a[q] = x * gsv[j]; }
#pragma unroll
                for (int i = 0; i < 4; ++i) {
#pragma unroll
                    for (int e4 = 0; e4 < 4; ++e4) { const f32x4 w = rwl[((j * 4 + i) * 4 + e4) * 64 + F.lane]; acc[0][e4] += w * a[0][i]; acc[1][e4] += w * a[1][i]; }
                    asm volatile("" : "+v"(acc[0][0]), "+v"(acc[0][1]), "+v"(acc[0][2]), "+v"(acc[0][3]), "+v"(acc[1][0]), "+v"(acc[1][1]), "+v"(acc[1][2]), "+v"(acc[1][3]) :: "memory"); } }
            float rstd[2];
#pragma unroll
            for (int q = 0; q < 2; ++q) rstd[q] = __builtin_amdgcn_rsqf(wave_sum(ss[q]) * (1.f / DM) + EPS);
            asm volatile("" ::: "memory");
            f32x4 shv[8];
#pragma unroll
            for (int j = 0; j < 8; ++j) shv[j] = bld4f(rml, lo16 + j * 1024, 3 * DM * 4);
#pragma unroll
            for (int j = 0; j < 8; ++j) {
#pragma unroll
                for (int q = 0; q < 2; ++q) { const f32x4 o = XV(q, j) * rstd[q] * gsv[j] + shv[j]; __builtin_amdgcn_raw_buffer_store_b32(pk4_fp8(o.x, o.y, o.z, o.w), rh, F.lane * 4 + j * 256, (row0 + rp * 2 + q) * DM, 0); } }
#undef XV
#pragma unroll
            for (int q = 0; q < 2; ++q) {
                float sc[16], bs[16];
#pragma unroll
                for (int e = 0; e < 16; ++e) { const float lg = wave_sum(acc[q][e >> 2][e & 3]) * rstd[q] + cst[e]; sc[e] = 1.0f / (1.0f + __expf(-lg)); bs[e] = sc[e] + rb[e]; }
                float gs4[4];
#pragma unroll
                for (int g = 0; g < 4; ++g) { const float a = bs[4 * g], b2 = bs[4 * g + 1], c = bs[4 * g + 2], d = bs[4 * g + 3];
                    const float h1 = fmaxf(a, b2), l1 = fminf(a, b2), h2 = fmaxf(c, d), l2 = fminf(c, d);
                    gs4[g] = fmaxf(h1, h2) + fmaxf(fminf(h1, h2), fmaxf(l1, l2)); }
                int gsel = 0; float gbest = gs4[0];
#pragma unroll
                for (int g = 1; g < 4; ++g) if (gs4[g] > gbest) { gbest = gs4[g]; gsel = g; }
                float bv[4], sv[4];
#pragma unroll
                for (int i = 0; i < 4; ++i) { bv[i] = gsel == 0 ? bs[i] : gsel == 1 ? bs[4 + i] : gsel == 2 ? bs[8 + i] : bs[12 + i]; sv[i] = gsel == 0 ? sc[i] : gsel == 1 ? sc[4 + i] : gsel == 2 ? sc[8 + i] : sc[12 + i]; }
                int i1 = 0; float b1 = bv[0], s1 = sv[0];
#pragma unroll
                for (int i = 1; i < 4; ++i) if (bv[i] > b1) { b1 = bv[i]; s1 = sv[i]; i1 = i; }
                int i2 = -1; float b2v = -__builtin_inff(), s2 = 0.f;
#pragma unroll
                for (int i = 0; i < 4; ++i) if (i != i1 && bv[i] > b2v) { b2v = bv[i]; s2 = sv[i]; i2 = i; }
                const float inv = 1.0f / (s1 + s2);
                if (F.lane == 0) {
                    const int r = F.wave * 16 + rp * 2 + q, e0 = gsel * 4 + i1, e1 = gsel * 4 + i2;
                    tokinfo[r * 4 + 0] = e0; tokinfo[r * 4 + 2] = e1;
                    const int row = row0 + rp * 2 + q; *(f32x2*)(aw + (size_t)row * 2) = (f32x2){s1 * inv, s2 * inv};
                }
            }
        }
        __syncthreads();
        const int tb_ = F.wave * 64 + lane_id();
        if (tb_ < 16) {
            int c = 0;
            for (int r = 0; r < 128; ++r) { if (tokinfo[r * 4 + 0] == tb_) tokinfo[r * 4 + 1] = c++; if (tokinfo[r * 4 + 2] == tb_) tokinfo[r * 4 + 3] = c++; }
            gbase[tb_] = (int)__hip_atomic_fetch_add(gcnt + tb_, (unsigned)c, __ATOMIC_RELAXED, __HIP_MEMORY_SCOPE_AGENT); }
        __syncthreads();
        if (tb_ < 128) { const int e0 = tokinfo[tb_ * 4], p0 = tokinfo[tb_ * 4 + 1], e1 = tokinfo[tb_ * 4 + 2], p1 = tokinfo[tb_ * 4 + 3]; const int row = bi * 128 + tb_;
            rowidx[(size_t)e0 * 32768 + gbase[e0] + p0] = 2 * row; rowidx[(size_t)e1 * 32768 + gbase[e1] + p1] = 2 * row + 1; }
        __syncthreads();
    }
}
__device__ __forceinline__ int moe_setup(Frame& F, int l) {
    LAS int* ts = (LAS int*)(F.lds + L_TS);
    if (F.tid == 0) { int s = 0; for (int e = 0; e < 16; ++e) { ts[e] = s; s += ((int)__hip_atomic_load(F.ctl + CW_CNT + l * 16 + e, __ATOMIC_RELAXED, __HIP_MEMORY_SCOPE_AGENT) + 255) >> 8; } ts[16] = s; }
    __syncthreads();
    return __builtin_amdgcn_readfirstlane(ts[16]);
}

__device__ __forceinline__ att::Blk mla_blk(int bh, int qb) {
    const int b = bh >> 3, h = bh & 7; att::Blk k;
    k.qo = (unsigned)(WS_QA + ((size_t)b * SEQ * 1536 + h * 192) * 2); k.ko = (unsigned)(WS_KF + ((size_t)b * SEQ * 1536 + h * 192) * 2);
    k.vo = (unsigned)(WS_VB + ((size_t)b * SEQ * 1024 + h * 128) * 2); k.oo = (unsigned)(WS_OA + ((size_t)b * SEQ * 1024 + h * 128) * 2); k.lo = 0;
    k.P0 = qb * 256; k.rate = 1; k.beta = 0.f;
    return k;
}
__device__ __forceinline__ att::Blk dil_blk(int bh, int br, int blk) {
    const int b = bh >> 3, h = bh & 7, rate = br == 0 ? 1 : br == 1 ? 4 : 16, nqb = 32 / rate, cls = blk / nqb, qb = blk % nqb; att::Blk k;
    const size_t tok0 = (size_t)b * SEQ + cls;
    const unsigned p = (unsigned)(WS_PROJ + (tok0 * PROJ_LD + h * 128) * 2);
    k.qo = p + C_QB * 2; k.ko = p + C_KB * 2; k.vo = p + C_VB * 2;
    k.oo = (unsigned)(WS_OB + (((size_t)br * T + tok0) * 1024 + h * 128) * 2);
    k.lo = (unsigned)(WS_LSE + (((size_t)br * T + tok0) * 8 + h) * 4);
    k.P0 = qb * 256; k.rate = rate;
    const float slope = __builtin_amdgcn_exp2f(-(float)(h + 1));
    k.beta = slope * (float)rate * 11.313708498984761f;
    return k;
}
__device__ __forceinline__ void mla_decode(int id, int& bh, int& qb0, int& qb1) {
    const int v = id & 255, i = id >> 8, x = v >> 5, c = v & 31, j = i * 32 + c; bh = 4 * x + (j >> 4); const int s = j & 15; qb0 = s; qb1 = 31 - s;
}
__device__ __forceinline__ void dil_decode(int id, int& bh, int& br, int& blk) {
    const int v = id & 255, i = id >> 8, x = v >> 5, c = v & 31, j = i * 32 + c; bh = 4 * x + j / 96; const int r = j % 96; br = r >> 5; blk = r & 31;
}
#ifndef ATT_DIL_NS
#define ATT_DIL_NS 4
#endif
#ifndef ATT_SKEW_SEL
#define ATT_SKEW_SEL 0
#endif
#if ATT_SKEW_SEL == 0
#define ATT_SKEW_PICK(w) ((w) < 4)
#elif ATT_SKEW_SEL == 1
#define ATT_SKEW_PICK(w) (((w) & 1) == 0)
#elif ATT_SKEW_SEL == 2
#define ATT_SKEW_PICK(w) true
#else
#define ATT_SKEW_PICK(w) false
#endif
#ifdef ATT_DMA
#define ATT_SEAM(d) att::SeamD<d>
#define ATT_DMA_ON ATT_DMA
#else
#define ATT_SEAM(d) att::Seam<d>
#define ATT_DMA_ON 0
#endif
#if ATT_DMA_ON == 2
template <int ORD>
__device__ __forceinline__ void mla_stream2(Frame& F, char* lds) {
    constexpr int NIT = 512;
    int id = F.vcu;
    if (id < NIT) {
        att::SeamD<192> S; int bh, q0, q1; mla_decode(id, bh, q0, q1); int pass = 0;
        att::Blk cur = mla_blk(bh, q0);
        att::att_prime_dma2<192, false>(cur, (const char*)F.ws, lds, S, F.tid);
        for (;;) {
            const bool more_pass = pass == 0, more_item = id + F.G < NIT, last = !more_pass && !more_item;
            att::Blk nxt = cur; int idn = id, passn = pass + 1;
            if (more_pass) nxt = mla_blk(bh, q1);
            else if (more_item) { idn = id + F.G; passn = 0; mla_decode(idn, bh, q0, q1); nxt = mla_blk(bh, q0); }
            att::att_block_dma2<192, false, false, ORD>(cur, nxt, (const char*)F.ws, lds, S, F.tid);
            if (last) break;
            cur = nxt; id = idn; pass = passn;
        }
    }
}
template <int ORD>
__device__ __forceinline__ void dil_stream2(Frame& F, char* lds) {
    constexpr int NIT = 3072;
    int id = F.vcu;
    if (id < NIT) {
        att::SeamD<128> S; int bh, br, blk; dil_decode(id, bh, br, blk);
        att::Blk cur = dil_blk(bh, br, blk);
        att::att_prime_dma2<128, true>(cur, (const char*)F.ws, lds, S, F.tid);
        for (;;) {
            const bool last = id + F.G >= NIT;
            att::Blk nxt = cur;
            if (!last) { dil_decode(id + F.G, bh, br, blk); nxt = dil_blk(bh, br, blk); }
            att::att_block_dma2<128, true, true, ORD>(cur, nxt, (const char*)F.ws, lds, S, F.tid);
            if (last) break;
            cur = nxt; id += F.G;
        }
    }
}
#endif
template <int PV>
__device__ __forceinline__ void dil_stream_reg(Frame& F, char* lds, int rep_) {
        constexpr int NIT = 3072;
        int id = F.vcu;
        if (id < NIT) {
#if ATT_DMA_ON == 1
            att::SeamD<128> S;
#else
            att::Seam<128> S;
#endif
            int bh, br, blk; dil_decode(id, bh, br, blk);
            att::Blk cur = dil_blk(bh, br, blk);
#if ATT_DMA_ON == 1
            att::att_prime_dma<128, true, ATT_DIL_NS>(cur, (const char*)F.ws, lds, S, F.tid);
#else
            att::att_prime<128, true, PV>(cur, (const char*)F.ws, lds, S, F.tid);
#endif
            for (;;) {
                const bool last = id + F.G >= NIT;
                att::Blk nxt = cur;
                if (!last) { dil_decode(id + F.G, bh, br, blk); nxt = dil_blk(bh, br, blk); }
#if ATT_DMA_ON == 1
                att::att_block_dma<128, true, true, ATT_DIL_NS>(cur, nxt, (const char*)F.ws, lds, lds + RING_BYTES + 512, S, F.tid);
#else
                att::att_block<128, true, true, PV>(cur, nxt, (const char*)F.ws, lds, S, F.tid);
#endif
                if (last) break;
                cur = nxt; id += F.G;
            }
#if defined(ATT_DEFER) && ATT_DMA_ON != 1
            if (S.p_on) { const int ln_ = F.tid & 63; const char* stg_ = lds + att::DEFER_STG + __builtin_amdgcn_readfirstlane(F.tid >> 6) * 8192;
#pragma unroll
                for (int p = 0; p < 8; ++p) att::flush_piece(stg_, p, (const char*)F.ws + S.p_oo, S.p_rb, S.p_so0, ln_); }
#endif
        }
}
static_assert(WS_ROPE == att::ROPE_OFF, "rope table offset");
__device__ __forceinline__ void phase_attention(Frame& F, char* lds, const Args& A, int l) {
#ifdef ATT_PRIO
    if (__builtin_amdgcn_readfirstlane(F.tid >> 6) >= 4) __builtin_amdgcn_s_setprio(1);
#endif
#ifndef NO_MLA
#ifndef PROBE_REP_MLA
#define PROBE_REP_MLA 1
#endif
    for (int rep_ = 0; rep_ < PROBE_REP_MLA; ++rep_) {
        if (rep_) __syncthreads();
#if ATT_DMA_ON == 2
        { const int wsel_ = __builtin_amdgcn_readfirstlane(F.tid >> 6);
          if (ATT_SKEW_PICK(wsel_)) mla_stream2<0>(F, lds); else mla_stream2<1>(F, lds); }
#else
        constexpr int NIT = 512;
        int id = F.vcu;
        if (id < NIT) {
            ATT_SEAM(192) S; int bh, q0, q1; mla_decode(id, bh, q0, q1); int pass = 0;
            att::Blk cur = mla_blk(bh, q0);
#ifdef ATT_CONV
            const size_t eo_ = (size_t)l * NEXP * DM * DEXP;
            const att::ConvCtx X = {A.in[I_EG] + eo_, A.in[I_EU] + eo_, A.in[I_ED] + eo_, F.ws + WS_W13, F.ws + WS_W2, F.vcu * 8 + __builtin_amdgcn_readfirstlane(F.tid >> 6)};
#endif
#if ATT_DMA_ON
            att::att_prime_dma<192, false, 3>(cur, (const char*)F.ws, lds, S, F.tid);
#else
#ifdef ATT_QROPE
            att::att_prime<192, false, 0, true>(cur, (const char*)F.ws, lds, S, F.tid);
#else
            att::att_prime<192, false>(cur, (const char*)F.ws, lds, S, F.tid);
#endif
#endif
            for (;;) {
                const bool more_pass = pass == 0, more_item = id + F.G < NIT, last = !more_pass && !more_item;
                att::Blk nxt = cur; int idn = id, passn = pass + 1;
                if (more_pass) nxt = mla_blk(bh, q1);
                else if (more_item) { idn = id + F.G; passn = 0; mla_decode(idn, bh, q0, q1); nxt = mla_blk(bh, q0); }
#if ATT_DMA_ON
                att::att_block_dma<192, false, false, 3>(cur, nxt, (const char*)F.ws, lds, lds + 3 * att::SHM_V + 3 * att::Cfg<192>::SHM_K, S, F.tid);
#else
#ifdef ATT_CONV
                att::att_block<192, false, false, 0, true>(cur, nxt, (const char*)F.ws, lds, S, F.tid, &X);
#elif defined(ATT_QROPE)
                att::att_block<192, false, false, 0, false, true>(cur, nxt, (const char*)F.ws, lds, S, F.tid);
#else
                att::att_block<192, false, false>(cur, nxt, (const char*)F.ws, lds, S, F.tid);
#endif
#endif
                if (last) break;
                cur = nxt; id = idn; pass = passn;
            }
#ifdef ATT_CONV
            { const int ln_ = lane_id(); char* scr_ = lds + att::CONV_SCR + __builtin_amdgcn_readfirstlane(F.tid >> 6) * 4352;
              while (S.cv_j < att::CONV_NJ) { att::conv_load(X, S.cv_j, S.cv_q, S.cv, ln_); asm volatile("s_waitcnt vmcnt(0)" ::: "memory");
                  att::conv_put(X, S.cv_j, S.cv_q, S.cv, scr_, ln_); if (++S.cv_q == 4) { S.cv_q = 0; ++S.cv_j; } S.cl_j = S.cv_j; S.cl_q = S.cv_q; } }
#endif
        }
#endif
    }
#endif
#ifndef NO_DIL
#ifndef PROBE_REP_DIL
#define PROBE_REP_DIL 1
#endif
#ifndef PROBE_DIL_VAR
#define PROBE_DIL_VAR 0
#endif
#if ATT_DMA_ON == 2 && !defined(ATT_DIL_DMA2)
    asm volatile("s_waitcnt vmcnt(0)" ::: "memory"); __syncthreads();
#endif
    for (int rep_ = 0; rep_ < PROBE_REP_DIL; ++rep_) {
        if (rep_) __syncthreads();
#if ATT_DMA_ON == 2 && defined(ATT_DIL_DMA2)
        { const int wsel_ = __builtin_amdgcn_readfirstlane(F.tid >> 6);
          if (ATT_SKEW_PICK(wsel_)) dil_stream2<0>(F, lds); else dil_stream2<1>(F, lds); }
#else
        if (rep_ + 1 < PROBE_REP_DIL) dil_stream_reg<PROBE_DIL_VAR>(F, lds, rep_); else dil_stream_reg<0>(F, lds, rep_);
#endif
    }
#endif
#ifdef ATT_PRIO
    __builtin_amdgcn_s_setprio(0);
#endif
}
#ifndef MK_PER_PHASE
#define MK_PER_PHASE 0
#endif
constexpr int NPH = 2 + 11 * DEPTH;
__global__ void __launch_bounds__(NWAVES * 64, 2) mk_fwd(Args args) {
    extern __shared__ __attribute__((aligned(16))) unsigned char lds[];
    Frame F;
    F.lds = (LAS unsigned char*)lds; F.ldsg = lds;
    F.wave = __builtin_amdgcn_readfirstlane((int)threadIdx.x >> 6); F.lane = lane_id(); F.tid = F.wave * 64 + F.lane;
    F.G = gridDim.x; { const int bx = blockIdx.x; F.vcu = (F.G % 8 == 0) ? (bx % 8) * (F.G / 8) + bx / 8 : bx; }
    F.ws = args.ws; F.ctl = (unsigned*)(args.ws + WS_CTL);
    for (int u = F.tid; u < (LDS_BYTES - RING_BYTES) / 4; u += NWAVES * 64) ((LAS unsigned*)(F.lds + RING_BYTES))[u] = 0u;
    __syncthreads();
    volatile LAS unsigned* MISC = (volatile LAS unsigned*)(F.lds + L_MISC);
    XcdBarrier bar; bar.bar = F.ctl + CW_BAR; bar.x = 0; bar.st = nullptr;
    if (!MK_PER_PHASE) bar = xcd_barrier_post(F.ctl + CW_BAR, MISC + 8, F.tid);
    const int lo = args.ph_lo, hi = args.ph_hi;
#ifndef PROBE_GRID1_PHASE
#define PROBE_GRID1_PHASE (-1)
#endif
#define PROBE_GRID1(p) ((p) == PROBE_GRID1_PHASE)
#ifndef PROBE_MODE
#define PROBE_MODE 1
#endif
#ifndef PROBE_REP_MASK
#define PROBE_REP_MASK 0
#endif
#define NREP(j) ((((PROBE_REP_MASK) >> (j)) & 1) ? 2 : 1)
#ifndef PROBE_XIN
#define PROBE_XIN 0
#endif
#ifndef PH_MASK
#define PH_MASK 0x1FFF
#endif
#define IN(k) (lo <= (k) && (k) < hi)
#define MSK(j) (((PH_MASK) >> (j)) & 1)
#define FRESH(Fp) Frame Fp = F; { int l_ = lane_id(); int z_ = 0; asm volatile("" : "+v"(l_), "+s"(z_)); Fp.lane = l_; Fp.wave = F.wave + z_; Fp.tid = Fp.wave * 64 + l_; Fp.vcu = F.vcu + z_; Fp.ws = F.ws + z_; Fp.ctl = (unsigned*)(Fp.ws + WS_CTL); }
#define SEAM(k) do { if (IN(k) && IN((k) + 1)) xcd_barrier(bar, F.wave * 64 + lane_id()); } while (0)

    if (MSK(11) && IN(0)) { FRESH(P); phase_prologue(P, args);
#ifdef PROBE_REPEAT_PROLOGUE
        __syncthreads(); phase_prologue(P, args);
#endif
    }
    SEAM(0);
    for (int l = 0; l < DEPTH; ++l) {
        const int pb = 1 + 11 * l;
        const float* mod = (const float*)(F.ws + WS_MOD);
        if (MSK(0) && IN(pb + 0)) { for (int rep_ = 0; rep_ < (l == 0 ? NREP(0) : 1); ++rep_) { if (rep_) __syncthreads(); FRESH(P); phase_norm1(P, args, l); } }
        SEAM(pb + 0);
        if (MSK(1) && IN(pb + 1)) { for (int rep_ = 0; rep_ < NREP(1); ++rep_) { if (rep_) __syncthreads(); FRESH(P);
            pg8::Gemm g{(const bf16*)(P.ws + WS_H), (const bf16*)(P.ws + WS_WIN) + (size_t)l * 4096 * DM, DM * 2};
            pg8::StaticOrder S; S.init(T, PROJ_LD, P.G, (int)blockIdx.x);
            pg8::EpiPlain E{(bf16*)(P.ws + WS_PROJ), PROJ_LD};
            pg8::gemm_phase<pg8::EpiPlain, pg8::StaticOrder, pg8::ALinear>(P.lds, g, S, pg8::ALinear{}, E, P.tid);
        } }
        SEAM(pb + 1);
#ifdef PROBE_EXTRA_BARRIERS
        if (IN(pb + 2)) for (int xb_ = 0; xb_ < PROBE_EXTRA_BARRIERS; ++xb_) xcd_barrier(bar, F.wave * 64 + lane_id());
#endif
        if (MSK(2) && IN(pb + 2)) { for (int rep_ = 0; rep_ < NREP(2); ++rep_) { if (rep_) __syncthreads(); FRESH(P); phase_mla_prep(P, args); } }
        SEAM(pb + 2);
        if (MSK(3) && IN(pb + 3)) { for (int rep_ = 0; rep_ < NREP(3); ++rep_) { if (rep_) __syncthreads(); FRESH(P);
#ifdef PROBE_SWAP_UP
            { pg8::Gemm g{(const bf16*)(P.ws + WS_PROJ) + C_CKV, (const bf16*)(P.ws + WS_WUKV) + (size_t)l * 2048 * 256, 256 * 2};
              pg8::StaticOrder S; S.init(T, 2048, P.G, (int)blockIdx.x);
              pg8::EpiKVup E{(bf16*)(P.ws + WS_KF), (bf16*)(P.ws + WS_VB), (const float*)(P.ws + WS_RSTDKV)};
              pg8::gemm_phase<pg8::EpiKVup, pg8::StaticOrder, pg8::APitch>(P.lds, g, S, pg8::APitch{PROJ_LD * 2}, E, P.tid); }
            { pg8::Gemm g{(const bf16*)(P.ws + WS_PROJ) + C_CQ, (const bf16*)(P.ws + WS_WUQ) + (size_t)l * 1536 * 512, 512 * 2};
              pg8::StaticOrder S; S.init(T, 1536, P.G, (int)blockIdx.x);
              pg8::EpiQup E{(bf16*)(P.ws + WS_QA), (const float*)(P.ws + WS_RSTDQ)};
#ifdef PROBE_QUP_PLAIN
              { pg8::EpiPlain E2{(bf16*)(P.ws + WS_QA), 1536}; pg8::gemm_phase<pg8::EpiPlain, pg8::StaticOrder, pg8::APitch>(P.lds, g, S, pg8::APitch{PROJ_LD * 2}, E2, P.tid); }
#else
              pg8::gemm_phase<pg8::EpiQup, pg8::StaticOrder, pg8::APitch>(P.lds, g, S, pg8::APitch{PROJ_LD * 2}, E, P.tid);
#endif
            }
#else
            { pg8::Gemm g{(const bf16*)(P.ws + WS_PROJ) + C_CQ, (const bf16*)(P.ws + WS_WUQ) + (size_t)l * 1536 * 512, 512 * 2};
              pg8::StaticOrder S; S.init(T, 1536, P.G, (int)blockIdx.x);
              pg8::EpiQup E{(bf16*)(P.ws + WS_QA), (const float*)(P.ws + WS_RSTDQ)};
#ifdef PROBE_QUP_PLAIN
              { pg8::EpiPlain E2{(bf16*)(P.ws + WS_QA), 1536}; pg8::gemm_phase<pg8::EpiPlain, pg8::StaticOrder, pg8::APitch>(P.lds, g, S, pg8::APitch{PROJ_LD * 2}, E2, P.tid); }
#else
              pg8::gemm_phase<pg8::EpiQup, pg8::StaticOrder, pg8::APitch>(P.lds, g, S, pg8::APitch{PROJ_LD * 2}, E, P.tid);
#endif
            }
            { pg8::Gemm g{(const bf16*)(P.ws + WS_PROJ) + C_CKV, (const bf16*)(P.ws + WS_WUKV) + (size_t)l * 2048 * 256, 256 * 2};
              pg8::StaticOrder S; S.init(T, 2048, P.G, (int)blockIdx.x);
              pg8::EpiKVup E{(bf16*)(P.ws + WS_KF), (bf16*)(P.ws + WS_VB), (const float*)(P.ws + WS_RSTDKV)};
              pg8::gemm_phase<pg8::EpiKVup, pg8::StaticOrder, pg8::APitch>(P.lds, g, S, pg8::APitch{PROJ_LD * 2}, E, P.tid); }
#endif
        } }
        SEAM(pb + 3);
#ifndef ATT_QROPE
        if (MSK(4) && IN(pb + 4)) { FRESH(P); phase_q_rope(P, args); }
        SEAM(pb + 4);
#endif
        if (MSK(5) && IN(pb + 5)) { FRESH(P); phase_attention(P, (char*)lds, args, l);
#ifdef PROBE_REPEAT_ATT
            __syncthreads(); phase_attention(P, (char*)lds, args, l);
#endif
        }
        SEAM(pb + 5);
        if (MSK(6) && IN(pb + 6)) { for (int rep_ = 0; rep_ < NREP(6); ++rep_) { if (rep_) __syncthreads(); FRESH(P); phase_out_norm(P, args, l); } }
        SEAM(pb + 6);
        if (MSK(7) && IN(pb + 7)) { FRESH(P);
#ifdef G3_FP8
            pg8::Gemm g{P.ws + WS_H, P.ws + WS_WOUT + (size_t)l * DM * DM, DM};
            pg8::StaticOrder S; S.init(T, DM, P.G, (int)blockIdx.x);
            pg8::EpiResid E{l == 0 ? args.in[I_X] : args.out, args.out, mod + (size_t)l * 4 * 12288 + 2 * DM, DM, 12288, 1.0f / 256.0f};
            pg8::gemm_phase<pg8::EpiResid, pg8::StaticOrder, pg8::ALinear, true>(P.lds, g, S, pg8::ALinear{}, E, P.tid);
#elif defined(XRES_BF16)
            pg8::Gemm g{(const bf16*)(P.ws + WS_H), (const bf16*)(P.ws + WS_WOUT) + (size_t)l * DM * DM, DM * 2};
            pg8::StaticOrder S; S.init(T, DM, P.G, (int)blockIdx.x);
            pg8::EpiResidB E{l == 0 ? (const void*)args.in[I_X] : (const void*)(P.ws + WS_XB), (bf16*)(P.ws + WS_XB), mod + (size_t)l * 4 * 12288 + 2 * DM, 12288, 1.0f, l == 0 ? 1 : 0};
            pg8::gemm_phase<pg8::EpiResidB, pg8::StaticOrder, pg8::ALinear>(P.lds, g, S, pg8::ALinear{}, E, P.tid);
#else
            pg8::Gemm g{(const bf16*)(P.ws + WS_H), (const bf16*)(P.ws + WS_WOUT) + (size_t)l * DM * DM, DM * 2};
            pg8::StaticOrder S; S.init(T, DM, P.G, (int)blockIdx.x);
            pg8::EpiResid E{l == 0 ? args.in[I_X] : args.out, args.out, mod + (size_t)l * 4 * 12288 + 2 * DM, DM, 12288, 1.0f};
            pg8::gemm_phase<pg8::EpiResid, pg8::StaticOrder, pg8::ALinear>(P.lds, g, S, pg8::ALinear{}, E, P.tid);
#endif
        }
        SEAM(pb + 7);
        if (MSK(8) && IN(pb + 8)) { FRESH(P); phase_router(P, args, l);
#ifdef PROBE_REPEAT_ROUTER
            __syncthreads(); phase_router(P, args, l, 1);
#endif
        }
        SEAM(pb + 8);
        if (MSK(9) && IN(pb + 9)) { for (int rep_ = 0; rep_ < NREP(9); ++rep_) { if (rep_) __syncthreads(); FRESH(P);
            const int NT = moe_setup(P, l);
            pg8::MoeOrder S{NT, 8, P.G, (int)blockIdx.x, (const LAS int*)(P.lds + L_TS)};
            LAS unsigned* atab = (LAS unsigned*)(P.lds + L_ATAB); const int* rowidx = (const int*)(P.ws + WS_ROWIDX);
#pragma unroll 1
            for (int slot = 0; slot < MAXU; ++slot) { pg8::Unit u; if (!S.next(slot, u)) break;
                if (P.tid < 256) { const int lr = u.lt * 256 + P.tid; const int ce = (int)P.ctl[CW_CNT + l * 16 + u.e];
                    int tok = lr < ce ? (rowidx[(size_t)u.e * 32768 + lr] >> 1) : 0;
#ifdef PROBE_LINEAR_ATAB
                    tok = (int)(((unsigned)(u.pm * 256 + P.tid) * 2654435761u) >> 17) & 32767;
#endif
 atab[slot * 256 + P.tid] = (unsigned)tok * (unsigned)DM; } }
            __syncthreads();
            pg8::Gemm g{P.ws + WS_H, P.ws + WS_W13, DM};
            pg8::EpiSwiglu E{P.ws + WS_HMID, DEXP};
            pg8::gemm_phase<pg8::EpiSwiglu, pg8::MoeOrder, pg8::ATable, true>(P.lds, g, S, pg8::ATable{atab}, E, P.tid);
        } }
        SEAM(pb + 9);
        if (MSK(10) && IN(pb + 10)) { for (int rep_ = 0; rep_ < NREP(10); ++rep_) { if (rep_) __syncthreads(); FRESH(P);
            const int NT = moe_setup(P, l);
            pg8::MoeOrder S{NT, 8, P.G, (int)blockIdx.x, (const LAS int*)(P.lds + L_TS)};
            pg8::Gemm g{P.ws + WS_HMID, P.ws + WS_W2, DEXP};
            pg8::EpiMoeDown E{(bf16*)(P.ws + WS_Y), (const int*)(P.ws + WS_ROWIDX), (const float*)(P.ws + WS_AW), P.ctl + CW_CNT + l * 16};
            pg8::gemm_phase<pg8::EpiMoeDown, pg8::MoeOrder, pg8::ALinear, true>(P.lds, g, S, pg8::ALinear{}, E, P.tid);
        } }
        SEAM(pb + 10);
    }
    #ifdef PROBE_DUMP_OFF
    if (MSK(12) && IN(NPH - 1)) { FRESH(P); phase_dump(P, args, (size_t)(PROBE_DUMP_OFF), PROBE_DUMP_PITCH); }
#else
    if (MSK(12) && IN(NPH - 1)) { FRESH(P); phase_final(P, args, args.li != 0 ? (PROBE_XIN ? 2 : PROBE_MODE) : 0);
#ifdef PROBE_EXACT
        { const int gw = P.vcu * NWAVES + P.wave, NGW = P.G * NWAVES; __syncthreads();
          for (int ch = gw; ch < T / 16; ch += NGW) for (int rr = 0; rr < 16; ++rr) for (int j = 0; j < 8; ++j) { float* p = args.out + (size_t)(ch * 16 + rr) * DM + 4 * P.lane + 256 * j; asm volatile("s_waitcnt vmcnt(0)" ::: "memory");
              const v4u ub = *(const v4u*)p; *(f32x4*)p = (f32x4){(float)(ub.x & 0xFFFu), (float)(ub.y & 0xFFFu), (float)(ub.z & 0xFFFu), (float)(ub.w & 0xFFFu)}; } }
#endif
    }
#endif
#undef IN
#undef SEAM
}

extern "C" void kernel_launch(void* const* d_in, const int* in_sizes, int n_in, void* d_out, int out_size, void* d_ws, size_t ws_size, hipStream_t stream) {
    static int grid = 0;
    if (grid == 0) {
        if (n_in != 20 || in_sizes[0] != T * DM || out_size != T * DM || ws_size < WS_END) {
            fprintf(stderr, "kernel_launch: unexpected problem (n_in %d, in0 %d, out %d, ws %zu < %zu)\n", n_in, n_in > 0 ? in_sizes[0] : -1, out_size, ws_size, (size_t)WS_END); grid = -1; return; }
        int dev = 0, cus = 0;
        if (hipGetDevice(&dev) != hipSuccess || hipDeviceGetAttribute(&cus, hipDeviceAttributeMultiprocessorCount, dev) != hipSuccess) { grid = -1; return; }
        if (hipFuncSetAttribute((const void*)mk_fwd, hipFuncAttributeMaxDynamicSharedMemorySize, LDS_BYTES) != hipSuccess) { fprintf(stderr, "kernel_launch: hipFuncSetAttribute failed\n"); grid = -1; return; }
        int per_cu = 0;
        if (hipOccupancyMaxActiveBlocksPerMultiprocessor(&per_cu, (const void*)mk_fwd, NWAVES * 64, LDS_BYTES) != hipSuccess || per_cu < 1) fprintf(stderr, "kernel_launch: occupancy query says %d blocks per CU\n", per_cu);
        (void)hipGetLastError();
        grid = cus;
        if (grid != 256) fprintf(stderr, "kernel_launch: %d CUs (built for 256)\n", grid);
    }
    if (grid < 0) return;
    if (hipMemsetAsync((char*)d_ws + WS_CTL, 0, CTL_ZERO_BYTES, stream) != hipSuccess) return;
    Args a; memset(&a, 0, sizeof(a));
    for (int i = 0; i < 20; ++i) a.in[i] = (const float*)d_in[i];
    a.out = (float*)d_out; a.ws = (unsigned char*)d_ws;
    for (int i = 0; i < 32; ++i) a.invf[i] = (float)pow(10000.0, -(double)i / 32.0);
#if MK_PER_PHASE
#ifndef PROBE_LAST
#define PROBE_LAST (NPH - 2)
#endif
    for (int p = 0; p < NPH; ++p) { if (p > PROBE_LAST && p != NPH - 1) continue;
#ifdef PROBE_ONLY_MASK
        if (p != NPH - 1 && !((PROBE_ONLY_MASK >> p) & 1)) continue;
#endif
 a.ph_lo = p; a.ph_hi = p + 1; a.li = (PROBE_LAST != NPH - 2) ? 1 : 0; hipLaunchKernelGGL(mk_fwd, dim3(PROBE_GRID1(p) ? 1 : grid), dim3(NWAVES * 64), LDS_BYTES, stream, a); }
#else
    a.ph_lo = 0; a.ph_hi = NPH; a.li = 0;
    hipLaunchKernelGGL(mk_fwd, dim3(grid), dim3(NWAVES * 64), LDS_BYTES, stream, a);
#endif
    const hipError_t le = hipPeekAtLastError();
    if (le != hipSuccess) fprintf(stderr, "kernel_launch: launch failed: %s\n", hipGetErrorName(le));
}
```

```cpp
#define MK_PER_PHASE 0
#define XRES_BF16 1
#define G3_FP8 1
#define ATT_QROPE 1
#define ST16_IMM 1
#include <hip/hip_runtime.h>
#include <cstdio>
#include <cstdint>
#include <cstring>
#include <cmath>
namespace pg8 {
#define PG8_LAS __attribute__((address_space(3)))
typedef unsigned short bf16_t;
typedef short bf16x8 __attribute__((ext_vector_type(8)));
typedef float f32x4 __attribute__((ext_vector_type(4)));
typedef float f32x2 __attribute__((ext_vector_type(2)));
typedef unsigned u32x4 __attribute__((ext_vector_type(4)));
typedef int v4i_t __attribute__((ext_vector_type(4)));
typedef int v8i_t __attribute__((ext_vector_type(8)));
constexpr int BM = 256, BK = 64, HALF = 128, HTB = HALF * BK * 2  , STAGE_BYTES = 8 * HTB, NXCD = 8, WGM = 8;

__host__ __device__ __forceinline__ int lds_byte(int r, int c) { const int st = (r >> 4) * 2 + (c >> 5), rr = r & 15, cc = c & 31, ob = rr * 64 + cc * 2; return st * 1024 + (ob ^ (((ob >> 9) & 1) << 5)); }
__host__ __device__ __forceinline__ void stage_rc(int b, int& R, int& C) { const int st = b / 1024, sb = b % 1024, swz = sb ^ (((sb >> 9) & 1) << 5); R = (st >> 1) * 16 + swz / 64; C = (st & 1) * 32 + (swz % 64) / 2; }
__host__ __device__ __forceinline__ int perm32(int rho) { const int n = rho >> 4, i = rho & 15; return 8 * (i >> 2) + 4 * n + (i & 3); }

struct Unit { int pm, pn, pb, e, lt; };
struct Gemm { const void* A; const void* Bt; int Kb; };

__device__ __forceinline__ bool order_tile(int i, int G, int c, int nM, int nN, int& pm, int& pn) {
    const int nwg = nM * nN; const long L = (long)i * G + c; if (L >= nwg) return false;
    int wgid = (int)L; { const int q = nwg / NXCD, r = nwg % NXCD, xcd = wgid % NXCD, off = wgid / NXCD; wgid = (xcd < r ? xcd * (q + 1) : r * (q + 1) + (xcd - r) * q) + off; }
    const int nig = WGM * nN, gid = wgid / nig, fm = gid * WGM, gsz = (nM - fm) < WGM ? (nM - fm) : WGM;
    pm = fm + ((wgid % nig) % gsz); pn = (wgid % nig) / gsz; return true;
}
struct StaticOrder {
    int nM, nN, G, c;
    __device__ __forceinline__ void init(int M, int N, int G_, int c_) { nM = M / BM; nN = N / BM; G = G_; c = c_; }
    __device__ __forceinline__ bool next(int i, Unit& u) const { int pm, pn; if (!order_tile(i, G, c, nM, nN, pm, pn)) return false; u.pm = pm; u.pn = pn; u.pb = pn; u.e = 0; u.lt = 0; return true; }
};
struct MoeOrder {
    int nM, nN, G, c; const PG8_LAS int* ts;
    __device__ __forceinline__ bool next(int i, Unit& u) const {
        int pm, pn; if (i >= 10 || !order_tile(i, G, c, nM, nN, pm, pn)) return false;
        int e = 0;
#pragma unroll
        for (int j = 1; j < 16; ++j) e += (__builtin_amdgcn_readfirstlane(ts[j]) <= pm) ? 1 : 0;
        e = __builtin_amdgcn_readfirstlane(e); u.pm = pm; u.pn = pn; u.e = e; u.lt = pm - __builtin_amdgcn_readfirstlane(ts[e]); u.pb = e * nN + pn; return true;
    }
};
struct ALinear { __device__ __forceinline__ unsigned off(const Unit& u, int slot, int r, int Kb) const { return (unsigned)(u.pm * BM + r) * (unsigned)Kb; } };
struct APitch  { unsigned pitchB; __device__ __forceinline__ unsigned off(const Unit& u, int slot, int r, int K) const { return (unsigned)(u.pm * BM + r) * pitchB; } };
struct ATable  { const PG8_LAS unsigned* tab; __device__ __forceinline__ unsigned off(const Unit& u, int slot, int r, int K) const { return tab[slot * BM + r]; } };

typedef __bf16 bf16x2_t __attribute__((ext_vector_type(2)));
__device__ __forceinline__ unsigned cvt_pk_bf16(float lo, float hi) { const f32x2 v = {lo, hi}; return __builtin_bit_cast(unsigned, __builtin_convertvector(v, bf16x2_t)); }

typedef f32x4 Acc[2][2][4][2];

typedef __amdgpu_buffer_rsrc_t rsrc_t;
#define PG8_RSRC(p) __builtin_amdgcn_make_buffer_rsrc((void*)(p), 0, 0x7fffffff, 0x00020000)
#ifdef ST16_IMM
__device__ __forceinline__ void st16(rsrc_t r, int vo, int so, u32x4 v) { __builtin_amdgcn_raw_buffer_store_b128(v, r, vo + so, 0, 0); }
#else
__device__ __forceinline__ void st16(rsrc_t r, int vo, int so, u32x4 v) { __builtin_amdgcn_raw_buffer_store_b128(v, r, vo, so, 0); }
#endif
__device__ __forceinline__ f32x4 ld16f(rsrc_t r, int vo, int so) { return __builtin_bit_cast(f32x4, __builtin_amdgcn_raw_buffer_load_b128(r, vo, so, 0)); }
__device__ __forceinline__ float ld4f(rsrc_t r, int vo, int so) { return __uint_as_float(__builtin_amdgcn_raw_buffer_load_b32(r, vo, so, 0)); }
__device__ __forceinline__ u32x4 pack8(const f32x4 v0, const f32x4 v1) { u32x4 w; w.x = cvt_pk_bf16(v0[0], v0[1]); w.y = cvt_pk_bf16(v0[2], v0[3]); w.z = cvt_pk_bf16(v1[0], v1[1]); w.w = cvt_pk_bf16(v1[2], v1[3]); return w; }
struct EpiPlain {
    static constexpr bool PERM = true;
    bf16_t* O; int ldc;
    __device__ __forceinline__ void operator()(const Acc& acc, const Unit& u, int wr, int wc, int fr, int fq) const {
        const rsrc_t ro = PG8_RSRC(O); const int vo = (fr * ldc + wc * 32 + 8 * fq) * 2;
#pragma unroll
        for (int ai = 0; ai < 2; ++ai)
#pragma unroll
            for (int m = 0; m < 4; ++m) { const int so = ((u.pm * BM + wr * 64 + ai * HALF + m * 16) * ldc + u.pn * BM) * 2;
#pragma unroll
                for (int bj = 0; bj < 2; ++bj) st16(ro, vo, so + bj * HALF * 2, pack8(acc[ai][bj][m][0], acc[ai][bj][m][1])); }
    }
};
struct EpiQup {
    static constexpr bool PERM = true;
    bf16_t* O; const float* rstd;
    __device__ __forceinline__ void operator()(const Acc& acc, const Unit& u, int wr, int wc, int fr, int fq) const {
        const rsrc_t ro = PG8_RSRC(O), rr = PG8_RSRC(rstd);
        const int vo = (fr * 1536 + wc * 32 + 8 * fq) * 2;
        float rs[2][4];
#pragma unroll
        for (int ai = 0; ai < 2; ++ai)
#pragma unroll
            for (int m = 0; m < 4; ++m) rs[ai][m] = ld4f(rr, fr * 4, (u.pm * BM + wr * 64 + ai * HALF + m * 16) * 4);
#pragma unroll
        for (int ai = 0; ai < 2; ++ai)
#pragma unroll
            for (int m = 0; m < 4; ++m) { const int rowu = u.pm * BM + wr * 64 + ai * HALF + m * 16; const float r1 = rs[ai][m];
                const int so = (rowu * 1536 + u.pn * BM) * 2;
                st16(ro, vo, so, pack8(acc[ai][0][m][0] * r1, acc[ai][0][m][1] * r1));
                st16(ro, vo, so + HALF * 2, pack8(acc[ai][1][m][0] * r1, acc[ai][1][m][1] * r1)); }
    }
};
struct EpiKVup {
    static constexpr bool PERM = true;
    bf16_t* KF; bf16_t* VB; const float* rstd;
    __device__ __forceinline__ void operator()(const Acc& acc, const Unit& u, int wr, int wc, int fr, int fq) const {
        const rsrc_t rk = PG8_RSRC(KF), rv = PG8_RSRC(VB), rr = PG8_RSRC(rstd);
        const int c0 = wc * 32 + 8 * fq, vok = (fr * 1536 + c0) * 2, vov = (fr * 1024 + c0) * 2;
        float rs[2][4];
#pragma unroll
        for (int ai = 0; ai < 2; ++ai)
#pragma unroll
            for (int m = 0; m < 4; ++m) rs[ai][m] = ld4f(rr, fr * 4, (u.pm * BM + wr * 64 + ai * HALF + m * 16) * 4);
#pragma unroll
        for (int ai = 0; ai < 2; ++ai)
#pragma unroll
            for (int m = 0; m < 4; ++m) { const int rowu = u.pm * BM + wr * 64 + ai * HALF + m * 16; const float r1 = rs[ai][m];
                st16(rk, vok, (rowu * 1536 + u.pn * 192) * 2, pack8(acc[ai][0][m][0] * r1, acc[ai][0][m][1] * r1));
                st16(rv, vov, (rowu * 1024 + u.pn * 128) * 2, pack8(acc[ai][1][m][0] * r1, acc[ai][1][m][1] * r1)); }
    }
};
struct EpiResid {
    static constexpr bool PERM = false;
    const float* base; float* out; const float* gate; int ldc; int gld; float ascale;
    __device__ __forceinline__ void operator()(const Acc& acc, const Unit& u, int wr, int wc, int fr, int fq) const {
        const rsrc_t rb = PG8_RSRC(base), ro = PG8_RSRC(out), rg = PG8_RSRC(gate);
        const int cl = (wc * 32 + 4 * fq) * 4, vo = fr * ldc * 4 + cl;
        f32x4 gv[2][2];
#pragma unroll
        for (int bj = 0; bj < 2; ++bj)
#pragma unroll
            for (int n = 0; n < 2; ++n) gv[bj][n] = ld16f(rg, cl, (((u.pm * BM) >> 13) * gld + u.pn * BM + bj * HALF + n * 16) * 4) * ascale;
#pragma unroll
        for (int ai = 0; ai < 2; ++ai) {
            f32x4 bs[4][2][2];
#pragma unroll
            for (int m = 0; m < 4; ++m) { const int so = ((u.pm * BM + ai * HALF + wr * 64 + m * 16) * ldc + u.pn * BM) * 4;
#pragma unroll
                for (int bj = 0; bj < 2; ++bj)
#pragma unroll
                    for (int n = 0; n < 2; ++n) bs[m][bj][n] = ld16f(rb, vo, so + (bj * HALF + n * 16) * 4); }
#pragma unroll
            for (int m = 0; m < 4; ++m) { const int so = ((u.pm * BM + ai * HALF + wr * 64 + m * 16) * ldc + u.pn * BM) * 4;
#pragma unroll
                for (int bj = 0; bj < 2; ++bj)
#pragma unroll
                    for (int n = 0; n < 2; ++n) st16(ro, vo, so + (bj * HALF + n * 16) * 4, __builtin_bit_cast(u32x4, bs[m][bj][n] + gv[bj][n] * acc[ai][bj][m][n])); }
            asm volatile("s_waitcnt vmcnt(0)" ::: "memory");
        }
    }
};
struct EpiResidB {
    static constexpr bool PERM = true;
    const void* base; bf16_t* out; const float* gate; int gld; float ascale; int BASE_F32;
    __device__ __forceinline__ void operator()(const Acc& acc, const Unit& u, int wr, int wc, int fr, int fq) const {
        const rsrc_t rb = PG8_RSRC(base), ro = PG8_RSRC(out), rg = PG8_RSRC(gate);
        const int c0 = wc * 32 + 8 * fq;
        f32x4 gv[2][2];
#pragma unroll
        for (int bj = 0; bj < 2; ++bj)
#pragma unroll
            for (int n = 0; n < 2; ++n) gv[bj][n] = ld16f(rg, (c0 + 4 * n) * 4, (((u.pm * BM) >> 13) * gld + u.pn * BM + bj * HALF) * 4) * ascale;
#pragma unroll
        for (int ai = 0; ai < 2; ++ai) {
            f32x4 bs[4][2][2];
#pragma unroll
            for (int m = 0; m < 4; ++m) { const int rowu = u.pm * BM + ai * HALF + wr * 64 + m * 16;
#pragma unroll
                for (int bj = 0; bj < 2; ++bj) {
                    if (BASE_F32) { const int so = (rowu * 2048 + u.pn * BM + bj * HALF) * 4, vo = (fr * 2048 + c0) * 4;
                        bs[m][bj][0] = ld16f(rb, vo, so); bs[m][bj][1] = ld16f(rb, vo + 16, so); }
                    else { const int so = (rowu * 2048 + u.pn * BM + bj * HALF) * 2, vo = (fr * 2048 + c0) * 2;
                        const u32x4 w = __builtin_bit_cast(u32x4, __builtin_amdgcn_raw_buffer_load_b128(rb, vo, so, 0));
                        bs[m][bj][0] = (f32x4){__uint_as_float(w.x << 16), __uint_as_float(w.x & 0xffff0000u), __uint_as_float(w.y << 16), __uint_as_float(w.y & 0xffff0000u)};
                        bs[m][bj][1] = (f32x4){__uint_as_float(w.z << 16), __uint_as_float(w.z & 0xffff0000u), __uint_as_float(w.w << 16), __uint_as_float(w.w & 0xffff0000u)}; } } }
#pragma unroll
            for (int m = 0; m < 4; ++m) { const int rowu = u.pm * BM + ai * HALF + wr * 64 + m * 16;
#pragma unroll
                for (int bj = 0; bj < 2; ++bj) st16(ro, (fr * 2048 + c0) * 2, (rowu * 2048 + u.pn * BM + bj * HALF) * 2,
                                                    pack8(bs[m][bj][0] + gv[bj][0] * acc[ai][bj][m][0], bs[m][bj][1] + gv[bj][1] * acc[ai][bj][m][1])); }
            asm volatile("s_waitcnt vmcnt(0)" ::: "memory");
        }
    }
};
struct EpiSwiglu {
    static constexpr bool PERM = true;
    unsigned char* O; int ldc;
    __device__ __forceinline__ void operator()(const Acc& acc, const Unit& u, int wr, int wc, int fr, int fq) const {
        const rsrc_t ro = PG8_RSRC(O); const int vo = fr * ldc + wc * 32 + 8 * fq;
#pragma unroll
        for (int ai = 0; ai < 2; ++ai)
#pragma unroll
            for (int m = 0; m < 4; ++m) { const int so = (u.pm * BM + wr * 64 + ai * HALF + m * 16) * ldc + u.pn * HALF; float r[8];
#pragma unroll
                for (int n = 0; n < 2; ++n)
#pragma unroll
                    for (int k = 0; k < 4; ++k) { const float g = acc[ai][0][m][n][k] * (1.0f / 256.0f), up = acc[ai][1][m][n][k] * (1.0f / 256.0f);
                        r[n * 4 + k] = g * __builtin_amdgcn_rcpf(1.0f + __builtin_amdgcn_exp2f(-1.4426950408889634f * g)) * up; }
                int w0 = 0, w1 = 0;
                w0 = __builtin_amdgcn_cvt_pk_fp8_f32(r[0], r[1], w0, false); w0 = __builtin_amdgcn_cvt_pk_fp8_f32(r[2], r[3], w0, true);
                w1 = __builtin_amdgcn_cvt_pk_fp8_f32(r[4], r[5], w1, false); w1 = __builtin_amdgcn_cvt_pk_fp8_f32(r[6], r[7], w1, true);
                typedef unsigned u32x2_t __attribute__((ext_vector_type(2)));
                __builtin_amdgcn_raw_buffer_store_b64((u32x2_t){(unsigned)w0, (unsigned)w1}, ro, vo, so, 0); }
    }
};
struct EpiMoeDown {
    static constexpr bool PERM = true;
    bf16_t* Y; const int* rowidx; const float* aw; const unsigned* cnt;
    __device__ __forceinline__ void operator()(const Acc& acc, const Unit& u, int wr, int wc, int fr, int fq) const {
        const rsrc_t ry = PG8_RSRC(Y), ri = PG8_RSRC(rowidx), ra = PG8_RSRC(aw);
        const int nvalid = (int)cnt[u.e] - u.lt * BM; const int cb = (u.pn * BM + wc * 32 + 8 * fq) * 2;
        int idx[2][4]; float w8[2][4];
#pragma unroll
        for (int ai = 0; ai < 2; ++ai)
#pragma unroll
            for (int m = 0; m < 4; ++m) { const int ru = ai * HALF + wr * 64 + m * 16; idx[ai][m] = -1; w8[ai][m] = 0.f;
                if (ru + fr < nvalid) { idx[ai][m] = (int)__builtin_amdgcn_raw_buffer_load_b32(ri, fr * 4, (u.e * 32768 + u.lt * BM + ru) * 4, 0); w8[ai][m] = ld4f(ra, idx[ai][m] * 4, 0); } }
#pragma unroll
        for (int ai = 0; ai < 2; ++ai)
#pragma unroll
            for (int m = 0; m < 4; ++m) if (idx[ai][m] >= 0) { const int vo = idx[ai][m] * 4096 + cb; const float w1 = w8[ai][m] * (1.0f / 256.0f);
#pragma unroll
                for (int bj = 0; bj < 2; ++bj) st16(ry, vo, bj * HALF * 2, pack8(acc[ai][bj][m][0] * w1, acc[ai][bj][m][1] * w1)); }
    }
};

template <class Epi, class Sched, class AOff, bool FP8 = false>
__device__ __forceinline__ void gemm_phase(PG8_LAS unsigned char* lds, const Gemm g, const Sched& S, const AOff& AO, const Epi& E, int tid_in) {
    int tid = tid_in; asm volatile("" : "+v"(tid));
    const int wid = __builtin_amdgcn_readfirstlane(tid >> 6), lane = tid & 63, wr = wid >> 2, wc = wid & 3, fr = lane & 15, fq = lane >> 4;
    int K = g.Kb; asm volatile("" : "+s"(K));
    const int nt = K / (BK * 2);
    int Ra[2], Ca[2]; unsigned voffB[2];
#pragma unroll
    for (int i = 0; i < 2; ++i) { int R, C; stage_rc(tid * 16 + i * 8192, R, C); const int Rb = Epi::PERM ? ((R & ~31) + perm32(R & 31)) : R;
        Ra[i] = R; Ca[i] = C * 2; voffB[i] = (unsigned)(Rb * K + C * 2); }
    const size_t kstep = (size_t)(BK * 2);
    const size_t hstep = (size_t)HALF * K;
    const size_t tstep = 2 * hstep;
    const unsigned ldsw = (unsigned)wid * 1024u;
    const unsigned lds0 = (unsigned)(uintptr_t)lds;
    const int aoff = lds_byte(wr * 64 + fr, fq * 8), boff = lds_byte(wc * 32 + fr, fq * 8);
#define PG8_SA(b, h) (((b) * 2 + (h)) * HTB)
#define PG8_SB(b, h) ((4 + (b) * 2 + (h)) * HTB)
#define PG8_STAGE(bufoff, gbase, voff) do { _Pragma("unroll") for (int _i = 0; _i < 2; ++_i) { unsigned keep_; \
        asm volatile("s_mov_b32 %0, m0\n\ts_mov_b32 m0, %2\n\ts_nop 0\n\tglobal_load_lds_dwordx4 %1, %3\n\ts_mov_b32 m0, %0" : "=&s"(keep_) \
            : "v"((voff)[_i]), "s"((unsigned)__builtin_amdgcn_readfirstlane((int)(lds0 + (bufoff) + ldsw + _i * 8192))), "s"((const void*)(gbase)) : "memory"); } } while (0)
#define PG8_LD8(addr) __builtin_shufflevector(*(const PG8_LAS v4i_t*)(addr), *(const PG8_LAS v4i_t*)((addr) + 1024), 0, 1, 2, 3, 4, 5, 6, 7)
#define PG8_LDA(dst, b, h) do { _Pragma("unroll") for (int m = 0; m < 4; ++m) dst[m] = PG8_LD8(lds + PG8_SA(b, h) + aoff + m * 2048); } while (0)
#define PG8_LDB(dst, b, h) do { _Pragma("unroll") for (int n = 0; n < 2; ++n) dst[n] = PG8_LD8(lds + PG8_SB(b, h) + boff + n * 2048); } while (0)
#define PG8_HALF(x, k) __builtin_bit_cast(bf16x8, __builtin_shufflevector(x, x, 4 * (k), 4 * (k) + 1, 4 * (k) + 2, 4 * (k) + 3))
#define PG8_MMA(ai, bj, At, Bt) do { __builtin_amdgcn_s_setprio(1); _Pragma("unroll") for (int m = 0; m < 4; ++m) _Pragma("unroll") for (int n = 0; n < 2; ++n) { \
        if constexpr (FP8) asm volatile("v_mfma_scale_f32_16x16x128_f8f6f4 %0, %1, %2, %0, %3, %3 op_sel_hi:[0,0,0]" : "+v"(acc[ai][bj][m][n]) : "v"(Bt[n]), "v"(At[m]), "v"(sc1_));   \
        else { acc[ai][bj][m][n] = __builtin_amdgcn_mfma_f32_16x16x32_bf16(PG8_HALF(Bt[n], 0), PG8_HALF(At[m], 0), acc[ai][bj][m][n], 0, 0, 0); \
               acc[ai][bj][m][n] = __builtin_amdgcn_mfma_f32_16x16x32_bf16(PG8_HALF(Bt[n], 1), PG8_HALF(At[m], 1), acc[ai][bj][m][n], 0, 0, 0); } } \
        __builtin_amdgcn_s_setprio(0); } while (0)
#define PG8_WAIT_V(n) asm volatile("s_waitcnt vmcnt(" #n ")" ::: "memory")
#define PG8_WAIT_L(n) asm volatile("s_waitcnt lgkmcnt(" #n ")" ::: "memory")
#define PG8_BAR __builtin_amdgcn_s_barrier()
#define PG8_SCHED __builtin_amdgcn_sched_barrier(0)
#define PG8_AOFF(dst, u, slot) do { _Pragma("unroll") for (int _h = 0; _h < 2; ++_h) _Pragma("unroll") for (int _i = 0; _i < 2; ++_i) dst[_h][_i] = AO.off(u, slot, _h * HALF + Ra[_i], K) + (unsigned)Ca[_i]; } while (0)
    Unit cur, nxt; int ui = 0;
    if (!S.next(0, cur)) return;
    Acc acc;
#pragma unroll
    for (int a = 0; a < 2; ++a)
#pragma unroll
        for (int b = 0; b < 2; ++b)
#pragma unroll
            for (int m = 0; m < 4; ++m)
#pragma unroll
                for (int n = 0; n < 2; ++n) acc[a][b][m][n] = (f32x4){0.f, 0.f, 0.f, 0.f};
    v8i_t At[4], B0[2], B1[2];
    int sc1_ = 0x7F7F7F7F; asm volatile("" : "+v"(sc1_));
    unsigned aoC[2][2];
    PG8_AOFF(aoC, cur, 0);
    const char* gA = (const char*)g.A; const char* gB = (const char*)g.Bt;
    asm volatile("" : "+s"(gA), "+s"(gB));
    const char* cB = gB + (size_t)cur.pb * tstep;
    PG8_STAGE(PG8_SB(0, 0), cB, voffB); PG8_STAGE(PG8_SB(0, 1), cB + hstep, voffB); PG8_STAGE(PG8_SA(0, 0), gA, aoC[0]); PG8_STAGE(PG8_SA(0, 1), gA, aoC[1]);
    if (wr == 1) PG8_BAR;
    PG8_WAIT_V(2); PG8_BAR;
    PG8_STAGE(PG8_SB(1, 0), cB + kstep, voffB); PG8_STAGE(PG8_SA(1, 0), gA + kstep, aoC[0]); PG8_STAGE(PG8_SB(1, 1), cB + hstep + kstep, voffB);
    PG8_WAIT_V(6); PG8_BAR;
    for (;;) {
        const bool has_next = S.next(ui + 1, nxt);
        const char* nB = has_next ? gB + (size_t)nxt.pb * tstep : cB;
        for (int t = 0; t < nt; t += 2) {
            const bool last = (t == nt - 2);
            const char* a1 = gA + (size_t)(t + 1) * kstep;
            const char* a2 = last ? gA : gA + (size_t)(t + 2) * kstep; const char* b2 = last ? nB : cB + (size_t)(t + 2) * kstep;
            const char* a3 = a2 + kstep; const char* b3 = b2 + kstep;
            unsigned ao2[2][2];
            if (last && has_next) { PG8_AOFF(ao2, nxt, ui + 1); }
            else {
#pragma unroll
                for (int _h = 0; _h < 2; ++_h)
#pragma unroll
                    for (int _i = 0; _i < 2; ++_i) ao2[_h][_i] = aoC[_h][_i]; }
            PG8_LDB(B0, 0, 0); PG8_LDB(B1, 0, 1); PG8_SCHED; PG8_LDA(At, 0, 0); PG8_STAGE(PG8_SA(1, 1), a1, aoC[1]);
            PG8_WAIT_V(8); PG8_WAIT_L(0); PG8_BAR; PG8_MMA(0, 0, At, B0); PG8_MMA(0, 1, At, B1); PG8_BAR; PG8_SCHED;
            PG8_LDA(At, 0, 1); PG8_STAGE(PG8_SB(0, 0), b2, voffB); PG8_STAGE(PG8_SB(0, 1), b2 + hstep, voffB); PG8_STAGE(PG8_SA(0, 0), a2, ao2[0]);
            PG8_WAIT_V(8); PG8_WAIT_L(0); PG8_BAR; PG8_MMA(1, 0, At, B0); PG8_MMA(1, 1, At, B1); PG8_BAR; PG8_SCHED;
            PG8_LDB(B0, 1, 0); PG8_LDB(B1, 1, 1); PG8_SCHED; PG8_LDA(At, 1, 0); PG8_STAGE(PG8_SA(0, 1), a2, ao2[1]);
            PG8_WAIT_V(8); PG8_WAIT_L(0); PG8_BAR; PG8_MMA(0, 0, At, B0); PG8_MMA(0, 1, At, B1); PG8_BAR; PG8_SCHED;
            PG8_LDA(At, 1, 1); PG8_STAGE(PG8_SB(1, 0), b3, voffB); PG8_STAGE(PG8_SB(1, 1), b3 + hstep, voffB); PG8_STAGE(PG8_SA(1, 0), a3, ao2[0]);
            PG8_WAIT_V(8); PG8_WAIT_L(0); PG8_BAR; PG8_MMA(1, 0, At, B0); PG8_MMA(1, 1, At, B1); PG8_BAR; PG8_SCHED;
        }
        if (wr == 0) PG8_BAR;
        E(acc, cur, wr, wc, fr, fq);
        if (!has_next) break;
#pragma unroll
        for (int a = 0; a < 2; ++a)
#pragma unroll
            for (int b = 0; b < 2; ++b)
#pragma unroll
                for (int m = 0; m < 4; ++m)
#pragma unroll
                    for (int n = 0; n < 2; ++n) acc[a][b][m][n] = (f32x4){0.f, 0.f, 0.f, 0.f};
        cur = nxt; cB = nB; ++ui;
        PG8_AOFF(aoC, cur, ui);
        if (wr == 1) PG8_BAR;
    }
    PG8_WAIT_V(0);
    PG8_BAR;
#undef PG8_SA
#undef PG8_SB
#undef PG8_STAGE
#undef PG8_LDA
#undef PG8_LDB
#undef PG8_MMA
#undef PG8_LD8
#undef PG8_HALF
#undef PG8_WAIT_V
#undef PG8_WAIT_L
#undef PG8_BAR
#undef PG8_SCHED
#undef PG8_AOFF
}
}
namespace att {
typedef unsigned short bf16;
typedef short bf16x8 __attribute__((ext_vector_type(8)));
typedef short s16x4 __attribute__((ext_vector_type(4)));
typedef float f32x16 __attribute__((ext_vector_type(16)));
typedef float f32x4 __attribute__((ext_vector_type(4)));
typedef unsigned u32x4 __attribute__((ext_vector_type(4)));
constexpr int NW = 8, QBLK = 32, KVBLK = 64, QB = NW * QBLK, DV = 128;
constexpr float THR = 8.f;
constexpr int SHM_V = KVBLK * DV * 2;
template <int DQK> struct Cfg { static constexpr int NKC = DQK / 8, KCH = NKC / 8, KPITCH = DQK * 2, SHM_K = KVBLK * KPITCH, NQF = DQK / 16, LDS_BYTES = 2 * SHM_V + 2 * SHM_K + NW * 64 * 4; };
#define SBAR() __builtin_amdgcn_sched_barrier(0)
__device__ __forceinline__ int v_st(int k, int c) { const int kk = (k & ~0xC) | ((k & 4) << 1) | ((k & 8) >> 1); return ((kk >> 3) * 4 + (c >> 5)) * 512 + ((kk & 7) * 32 + (c & 31)) * 2; }
__device__ __forceinline__ int v_rd_base(int lane) { return ((lane & 3) << 3) | (((lane >> 2) & 3) << 6) | (((lane >> 4) & 1) << 5) | (((lane >> 5) & 1) << 8); }
constexpr int v_rd_off(int d0, int ks, int half) { return d0 * 512 + ks * 4096 + half * 2048; }
__device__ __forceinline__ int crow(int r, int hi) { return (r & 3) + 8 * (r >> 2) + 4 * hi; }
__device__ __forceinline__ unsigned cvtpk(float lo, float hi) { return pg8::cvt_pk_bf16(lo, hi); }
__device__ __forceinline__ bf16x8 load8(const bf16* p) { return *reinterpret_cast<const bf16x8*>(p); }
__device__ __forceinline__ void mask_tile(f32x16& p0, f32x16& p1, int dq, unsigned W) {
    const float NEG = -__builtin_inff();
#pragma unroll
    for (int r = 0; r < 16; ++r) { const int c = (r & 3) + 8 * (r >> 2);
        if ((unsigned)(dq - c) >= W) p0[r] = NEG;
        if ((unsigned)(dq - c - 32) >= W) p1[r] = NEG; }
}
__device__ __forceinline__ void partialSM(f32x16& p0, f32x16& p1, float& m_reg, float& mn, float& alpha, float scale) {
    float pmax = p0[0];
#pragma unroll
    for (int r = 1; r < 16; ++r) pmax = fmaxf(pmax, p0[r]);
#pragma unroll
    for (int r = 0; r < 16; ++r) pmax = fmaxf(pmax, p1[r]);
    { auto rr = __builtin_amdgcn_permlane32_swap(__float_as_uint(pmax), __float_as_uint(pmax), false, false);
      pmax = fmaxf(__uint_as_float(rr[0]), __uint_as_float(rr[1])); }
    const float C2 = 1.4426950408889634f * scale;
    if (__builtin_expect(__all((pmax - m_reg) * scale <= THR), 1)) { mn = m_reg; alpha = 1.f; }
    else { mn = fmaxf(m_reg, pmax); alpha = __builtin_amdgcn_exp2f((m_reg - mn) * C2); m_reg = mn; }
    const float mnL = -mn * C2;
#pragma unroll
    for (int r = 0; r < 16; ++r) p0[r] = fmaf(p0[r], C2, mnL);
#pragma unroll
    for (int r = 0; r < 16; ++r) p1[r] = fmaf(p1[r], C2, mnL);
#pragma unroll
    for (int r = 0; r < 16; ++r) p0[r] = __builtin_amdgcn_exp2f(p0[r]);
}
__device__ __forceinline__ void finishSM(f32x16& p0, f32x16& p1, float alpha, float& l_reg, bf16x8& pa0, bf16x8& pa1, bf16x8& pa2, bf16x8& pa3) {
#pragma unroll
    for (int r = 0; r < 16; ++r) p1[r] = __builtin_amdgcn_exp2f(p1[r]);
    float ps = 0;
#pragma unroll
    for (int r = 0; r < 16; ++r) ps += p0[r];
#pragma unroll
    for (int r = 0; r < 16; ++r) ps += p1[r];
    { auto rr = __builtin_amdgcn_permlane32_swap(__float_as_uint(ps), __float_as_uint(ps), false, false);
      ps = __uint_as_float(rr[0]) + __uint_as_float(rr[1]); }
    l_reg = l_reg * alpha + ps;
#define PK4(P, B_, OUT) do { unsigned a0 = cvtpk(P[B_+0], P[B_+1]), a1 = cvtpk(P[B_+2], P[B_+3]);                          \
        unsigned b0 = cvtpk(P[B_+4], P[B_+5]), b1 = cvtpk(P[B_+6], P[B_+7]);                                             \
        auto r0 = __builtin_amdgcn_permlane32_swap(a0, b0, false, false); auto r1 = __builtin_amdgcn_permlane32_swap(a1, b1, false, false); \
        u32x4 w = {r0[0], r1[0], r0[1], r1[1]}; OUT = *reinterpret_cast<bf16x8*>(&w); } while (0)
    PK4(p0, 0, pa0); PK4(p0, 8, pa1); PK4(p1, 0, pa2); PK4(p1, 8, pa3);
#undef PK4
}
template <int KB, bool SK, int DQK, bool DIL>
__device__ __forceinline__ void qkt(f32x16& p0, f32x16& p1, const char* K_lds, int r32, int hi, const bf16x8* qr, bool act, float beta, int dq) {
    typedef Cfg<DQK> C;
    if (SK && !act) { const float NEG = -__builtin_inff();
#pragma unroll
        for (int r = 0; r < 16; ++r) { p0[r] = NEG; p1[r] = NEG; } return; }
    if constexpr (DIL) { const float b0 = -beta * (float)dq;
#pragma unroll
        for (int r = 0; r < 16; ++r) { const int c = (r & 3) + 8 * (r >> 2); p0[r] = fmaf(beta, (float)c, b0); p1[r] = fmaf(beta, (float)(c + 32), b0); } }
    else { p0 = f32x16{}; p1 = f32x16{}; }
    const char* kb[4];
#pragma unroll
    for (int dd = 0; dd < 4; ++dd) { const int colB = (dd * 16 + hi * 8) * 2; kb[dd] = K_lds + KB * C::SHM_K + r32 * C::KPITCH + (colB ^ ((r32 & 7) << 4)); }
#pragma unroll
    for (int d0 = 0; d0 < C::NQF; ++d0) { const char* a = kb[d0 & 3] + (d0 >> 2) * 128;
        bf16x8 b0 = *reinterpret_cast<const bf16x8*>(a);
        bf16x8 b1 = *reinterpret_cast<const bf16x8*>(a + 32 * C::KPITCH);
        p0 = __builtin_amdgcn_mfma_f32_32x32x16_bf16(b0, qr[d0], p0, 0, 0, 0);
        p1 = __builtin_amdgcn_mfma_f32_32x32x16_bf16(b1, qr[d0], p1, 0, 0, 0);
#ifndef ATT_NO_QKT_SBAR
        if ((d0 & 3) == 3) SBAR();
#endif
    }
}
template <int VB, bool SK>
__device__ __forceinline__ void pv_tile(f32x16* o, int vb0, bf16x8 pa0, bf16x8 pa1, bf16x8 pa2, bf16x8 pa3, bool act) {
    if (SK && !act) return;
#define TRRD(dst, off) asm volatile("ds_read_b64_tr_b16 %0, %1 offset:%2" : "=&v"(dst) : "v"(vb0), "i"(off) : "memory")
#define PV_D0(d0) do { s16x4 l0, l1, l2, l3, h0, h1, h2, h3; constexpr int b_ = VB * SHM_V + v_rd_off(d0, 0, 0); \
        TRRD(l0, b_); TRRD(h0, b_ + 2048); TRRD(l1, b_ + 4096); TRRD(h1, b_ + 6144); TRRD(l2, b_ + 8192); TRRD(h2, b_ + 10240); TRRD(l3, b_ + 12288); TRRD(h3, b_ + 14336); \
        asm volatile("s_waitcnt lgkmcnt(0)" ::: "memory"); SBAR();   \
        o[d0] = __builtin_amdgcn_mfma_f32_32x32x16_bf16(pa0, (bf16x8){l0[0], l0[1], l0[2], l0[3], h0[0], h0[1], h0[2], h0[3]}, o[d0], 0, 0, 0);   \
        o[d0] = __builtin_amdgcn_mfma_f32_32x32x16_bf16(pa1, (bf16x8){l1[0], l1[1], l1[2], l1[3], h1[0], h1[1], h1[2], h1[3]}, o[d0], 0, 0, 0);   \
        o[d0] = __builtin_amdgcn_mfma_f32_32x32x16_bf16(pa2, (bf16x8){l2[0], l2[1], l2[2], l2[3], h2[0], h2[1], h2[2], h2[3]}, o[d0], 0, 0, 0);   \
        o[d0] = __builtin_amdgcn_mfma_f32_32x32x16_bf16(pa3, (bf16x8){l3[0], l3[1], l3[2], l3[3], h3[0], h3[1], h3[2], h3[3]}, o[d0], 0, 0, 0); } while (0)
    PV_D0(0); PV_D0(1); PV_D0(2); PV_D0(3);
#undef PV_D0
#undef TRRD
}

struct Blk { unsigned qo, ko, vo, oo, lo; int P0, rate; float beta; };
constexpr int PVAR = 0;
#define QS_(B) (DIL ? ((PVAR & 4) ? 128 : (B).rate * 4096) : 1536)
#define KS_(B) (DIL ? ((PVAR & 2) ? 128 : (B).rate * 4096) : 1536)
#define VS_(B) (DIL ? ((PVAR & 2) ? 128 : (B).rate * 4096) : 1024)
#define OS_(B) (DIL ? (B).rate * 1024 : 1024)
#define LS_(B) ((B).rate * 8)
#define SKV_(B) (DIL ? 8192 / (B).rate : 8192)
#define W_(B) (DIL ? 129 : (1 << 30))
#define SCALE_ (DIL ? 0.08838834764831845f : 0.07216878364870322f)
template <int DQK> struct Seam { bf16x8 qr[Cfg<DQK>::NQF]; bf16x8 st_v0, st_v1; bf16x8 st_k[Cfg<DQK>::KCH]; unsigned p_oo = 0; int p_rb = 0, p_so0 = 0, p_on = 0; float cv[4], cw[4]; int cv_j = 0, cv_q = 0, cl_j = 0, cl_q = 0; f32x4 rt[8]; };
__device__ __forceinline__ int swa_jlo(int P0, int W) { const int lowk = P0 - W + 1; return lowk > 0 ? lowk / KVBLK : 0; }

#define VMW() asm volatile("s_waitcnt vmcnt(0)" ::: "memory")
#define VMWN(n) asm volatile("s_waitcnt vmcnt(%0)" :: "i"(n) : "memory")
#define A_RSRC(p) __builtin_amdgcn_make_buffer_rsrc((void*)(p), 0, 0x7fffffff, 0x00020000)
#define A_BLD(rs, vo, so) __builtin_bit_cast(bf16x8, __builtin_amdgcn_raw_buffer_load_b128((rs), (int)(vo), (int)(so), 0))
#ifdef ATT_SLOAD_RECOMP
#define A_SLOAD(B_, k0) do { const __amdgpu_buffer_rsrc_t rv_ = A_RSRC(wsb + (B_).vo), rk_ = A_RSRC(wsb + (B_).ko); const int sov_ = (k0) * VS_(B_) * 2, sok_ = (k0) * KS_(B_) * 2; \
        int t_ = tid; asm volatile("" : "+v"(t_)); const int sr_ = t_ >> 4, sc_ = (t_ & 15) * 8; \
        S.st_v0 = A_BLD(rv_, (sr_ * VS_(B_) + sc_) * 2, sov_); S.st_v1 = A_BLD(rv_, ((32 + sr_) * VS_(B_) + sc_) * 2, sov_); \
        _Pragma("unroll") for (int j_ = 0; j_ < C::KCH; ++j_) { const int q_ = t_ + 512 * j_; S.st_k[j_] = A_BLD(rk_, ((q_ / C::NKC) * KS_(B_) + (q_ % C::NKC) * 8) * 2, sok_); } } while (0)
#else
#define A_SLOAD(B_, k0) do { const __amdgpu_buffer_rsrc_t rv_ = A_RSRC(wsb + (B_).vo), rk_ = A_RSRC(wsb + (B_).ko); const int sov_ = (k0) * VS_(B_) * 2, sok_ = (k0) * KS_(B_) * 2; \
        S.st_v0 = A_BLD(rv_, (sr * VS_(B_) + sc) * 2, sov_); S.st_v1 = A_BLD(rv_, ((32 + sr) * VS_(B_) + sc) * 2, sov_); \
        _Pragma("unroll") for (int j_ = 0; j_ < C::KCH; ++j_) S.st_k[j_] = A_BLD(rk_, (krow[j_] * KS_(B_) + kcol[j_]) * 2, sok_); } while (0)
#endif
#define A_QLOAD(B_) do { const __amdgpu_buffer_rsrc_t rq_ = A_RSRC(wsb + (B_).qo); const int soq_ = ((B_).P0 + wid * QBLK) * QS_(B_) * 2; const int qo_ = r32 * QS_(B_) * 2 + hi * 16; \
        _Pragma("unroll") for (int d0 = 0; d0 < C::NQF; ++d0) S.qr[d0] = A_BLD(rq_, qo_ + d0 * 32, soq_); } while (0)
#define A_SWRITE_K(bf) do { _Pragma("unroll") for (int j_ = 0; j_ < C::KCH; ++j_) *(bf16x8*)(K_lds + (bf) * C::SHM_K + kws[j_]) = S.st_k[j_]; } while (0)
#define A_SWRITE_V(bf) do { *(bf16x8*)(V_lds + (bf) * SHM_V + vst0) = S.st_v0; *(bf16x8*)(V_lds + (bf) * SHM_V + vst1) = S.st_v1; } while (0)
#define A_STAGE_IDX() const int sr = tid >> 4, sc = (tid & 15) * 8; int krow[C::KCH], kcol[C::KCH], kws[C::KCH]; \
        _Pragma("unroll") for (int j_ = 0; j_ < C::KCH; ++j_) { const int q_ = tid + 512 * j_; krow[j_] = q_ / C::NKC; kcol[j_] = (q_ % C::NKC) * 8; kws[j_] = krow[j_] * C::KPITCH + ((kcol[j_] * 2) ^ ((krow[j_] & 7) << 4)); }

__device__ __forceinline__ void store_o_staged(const f32x16* o, const float* rli, char* stg, __amdgpu_buffer_rsrc_t ro_, int rowbytes, int so0_, int lane) {
    const int r32 = lane & 31, hi = lane >> 5, odd = lane & 1, g = odd | (hi << 1);
    char* wb = stg + (odd + 4 * hi) * 256 + (r32 >> 1) * 4;
    char* wa[4];
#pragma unroll
    for (int d0 = 0; d0 < 4; ++d0) wa[d0] = wb + ((d0 ^ g) << 6);
    const int lr = lane >> 4, ch = lane & 15, sp = ch >> 2, gl = lr & 1;
    const char* rb_e = stg + lr * 256 + ((sp ^ gl) << 6) + (lane & 3) * 16;
    const char* rb_o = stg + lr * 256 + ((sp ^ (gl | 2)) << 6) + (lane & 3) * 16;
    const int voff = lr * rowbytes + ch * 16;
#pragma unroll
    for (int h = 0; h < 2; ++h) {
#pragma unroll
        for (int rp = 0; rp < 4; ++rp) { const int r = 8 * h + 2 * rp, Rl = (r & 3) + 8 * ((r >> 2) & 1);
#pragma unroll
            for (int d0 = 0; d0 < 4; ++d0) { const float v0 = o[d0][r] * rli[r], v1 = o[d0][r + 1] * rli[r + 1];
                const float send = odd ? v0 : v1;
                const float recv = __int_as_float(__builtin_amdgcn_update_dpp(0, __float_as_int(send), 0xB1, 0xF, 0xF, true));
                *reinterpret_cast<unsigned*>(wa[d0] + Rl * 256) = cvtpk(odd ? recv : v0, odd ? v1 : recv); } }
        u32x4 d_[4];
#pragma unroll
        for (int i = 0; i < 4; ++i) d_[i] = *reinterpret_cast<const u32x4*>(((i & 1) ? rb_o : rb_e) + i * 1024);
#pragma unroll
        for (int i = 0; i < 4; ++i) __builtin_amdgcn_raw_buffer_store_b128(d_[i], ro_, voff + so0_ + (16 * h + 4 * i) * rowbytes, 0, 0);
    }
}
constexpr int DEFER_STG = 65536, DEFER_WS = 131072 + 512;
__device__ __forceinline__ void stage_write(const f32x16* o, const float* rli, char* stg, int lane) {
    const int r32 = lane & 31, hi = lane >> 5, odd = lane & 1, g = odd | (hi << 1);
    char* wb = stg + (odd + 4 * hi) * 256 + (r32 >> 1) * 4;
    char* wa[4];
#pragma unroll
    for (int d0 = 0; d0 < 4; ++d0) wa[d0] = wb + ((d0 ^ g) << 6);
#pragma unroll
    for (int h = 0; h < 2; ++h)
#pragma unroll
        for (int rp = 0; rp < 4; ++rp) { const int r = 8 * h + 2 * rp, Rl = (r & 3) + 8 * ((r >> 2) & 1);
#pragma unroll
            for (int d0 = 0; d0 < 4; ++d0) { const float v0 = o[d0][r] * rli[r], v1 = o[d0][r + 1] * rli[r + 1];
                const float send = odd ? v0 : v1;
                const float recv = __int_as_float(__builtin_amdgcn_update_dpp(0, __float_as_int(send), 0xB1, 0xF, 0xF, true));
                *reinterpret_cast<unsigned*>(wa[d0] + h * 4096 + Rl * 256) = cvtpk(odd ? recv : v0, odd ? v1 : recv); } }
}
__device__ __forceinline__ void flush_piece(const char* stg, int p, const char* obase, int rowbytes, int so0, int lane) {
    const int lr = lane >> 4, ch = lane & 15, sp = ch >> 2, g = (lr & 1) | ((p & 1) << 1);
    const u32x4 d = *reinterpret_cast<const u32x4*>(stg + p * 1024 + lr * 256 + ((sp ^ g) << 6) + (lane & 3) * 16);
    __builtin_amdgcn_raw_buffer_store_b128(d, A_RSRC(obase), lr * rowbytes + ch * 16 + so0 + 4 * p * rowbytes, 0, 0);
}
struct ConvCtx { const float* eg; const float* eu; const float* ed; unsigned char* w13; unsigned char* w2; int gw; };
constexpr int CONV_SCR = 86016, CONV_NJ = 48;
#ifndef CONV_AUX
#define CONV_AUX 2
#endif
struct ConvItem { const float* src; unsigned char* dst; int ldw, kd; };
__device__ __forceinline__ ConvItem conv_decode(const ConvCtx& X, int j) {
    const int q = X.gw + 2048 * j, e = q / 6144, r = q - e * 6144, m = r >> 11, r2 = r & 2047;
    ConvItem I;
    if (m < 2) { const int kb = r2 >> 6, nb = r2 & 63, n0 = nb * 16; I.ldw = 1024; I.kd = 2048;
        I.src = (m == 0 ? X.eg : X.eu) + (size_t)e * (2048 * 1024) + (size_t)kb * (64 * 1024) + n0;
        I.dst = X.w13 + (size_t)e * (2048 * 2048) + (size_t)((n0 >> 7) * 256 + (m == 1 ? 128 : 0) + (n0 & 127)) * 2048 + kb * 64; }
    else { const int kb = r2 >> 7, nb = r2 & 127; I.ldw = 2048; I.kd = 1024;
        I.src = X.ed + (size_t)e * (1024 * 2048) + (size_t)kb * (64 * 2048) + nb * 16;
        I.dst = X.w2 + (size_t)e * (2048 * 1024) + (size_t)(nb * 16) * 1024 + kb * 64; }
    return I;
}
__device__ __forceinline__ void conv_load(const ConvCtx& X, int j, int qd, float* cv, int lane) {
    const ConvItem I = conv_decode(X, j); const __amdgpu_buffer_rsrc_t rs = A_RSRC(I.src);
#pragma unroll
    for (int i = 0; i < 4; ++i) { const int k = 4 * (4 * qd + i) + (lane >> 4);
        cv[i] = __uint_as_float(__builtin_amdgcn_raw_buffer_load_b32(rs, (k * I.ldw + (lane & 15)) * 4, 0, CONV_AUX)); }
}
__device__ __forceinline__ void conv_put(const ConvCtx& X, int j, int qd, const float* cv, char* scr, int lane) {
    float* s = reinterpret_cast<float*>(scr);
#pragma unroll
    for (int i = 0; i < 4; ++i) { const int k = 4 * (4 * qd + i) + (lane >> 4); s[k * 17 + (lane & 15)] = cv[i] * 256.0f; }
    if (qd == 3) {
        const ConvItem I = conv_decode(X, j); const int n = lane & 15, kq = lane >> 4; const float* c = s + (16 * kq) * 17 + n;
        u32x4 w;
        { int w0 = 0, w1 = 0, w2 = 0, w3 = 0;
          w0 = __builtin_amdgcn_cvt_pk_fp8_f32(c[0 * 17], c[1 * 17], w0, false); w0 = __builtin_amdgcn_cvt_pk_fp8_f32(c[2 * 17], c[3 * 17], w0, true);
          w1 = __builtin_amdgcn_cvt_pk_fp8_f32(c[4 * 17], c[5 * 17], w1, false); w1 = __builtin_amdgcn_cvt_pk_fp8_f32(c[6 * 17], c[7 * 17], w1, true);
          w2 = __builtin_amdgcn_cvt_pk_fp8_f32(c[8 * 17], c[9 * 17], w2, false); w2 = __builtin_amdgcn_cvt_pk_fp8_f32(c[10 * 17], c[11 * 17], w2, true);
          w3 = __builtin_amdgcn_cvt_pk_fp8_f32(c[12 * 17], c[13 * 17], w3, false); w3 = __builtin_amdgcn_cvt_pk_fp8_f32(c[14 * 17], c[15 * 17], w3, true);
          w = (u32x4){(unsigned)w0, (unsigned)w1, (unsigned)w2, (unsigned)w3}; }
        __builtin_amdgcn_raw_buffer_store_b128(w, A_RSRC(I.dst), n * I.kd + 16 * kq, 0, CONV_AUX);
    }
}
constexpr unsigned ROPE_OFF = 2u << 20;
#define A_RTLOAD(B_) do { const __amdgpu_buffer_rsrc_t rr_ = A_RSRC(wsb + ROPE_OFF); const int vo_ = ((B_).P0 + wid * QBLK + r32) * 256 + hi * 32; \
        _Pragma("unroll") for (int d_ = 0; d_ < 4; ++d_) { S.rt[2 * d_] = __builtin_bit_cast(f32x4, __builtin_amdgcn_raw_buffer_load_b128(rr_, vo_ + d_ * 64, 0, 0)); \
                                                            S.rt[2 * d_ + 1] = __builtin_bit_cast(f32x4, __builtin_amdgcn_raw_buffer_load_b128(rr_, vo_ + d_ * 64 + 16, 0, 0)); } } while (0)
__device__ __forceinline__ unsigned rope_pair(unsigned w, float c, float s) { const float x1 = __uint_as_float(w << 16), x2 = __uint_as_float(w & 0xffff0000u); return cvtpk(x1 * c - x2 * s, x2 * c + x1 * s); }
#define A_ROTATE() do { _Pragma("unroll") for (int d_ = 0; d_ < 4; ++d_) { u32x4 w_ = __builtin_bit_cast(u32x4, S.qr[8 + d_]); const f32x4 c01_ = S.rt[2 * d_], c23_ = S.rt[2 * d_ + 1]; \
        w_.x = rope_pair(w_.x, c01_[0], c01_[1]); w_.y = rope_pair(w_.y, c01_[2], c01_[3]); w_.z = rope_pair(w_.z, c23_[0], c23_[1]); w_.w = rope_pair(w_.w, c23_[2], c23_[3]); \
        S.qr[8 + d_] = __builtin_bit_cast(bf16x8, w_); } } while (0)
template <int DQK, bool DIL, int PVAR = 0, bool ROPE = false>
__device__ __forceinline__ void att_prime(const Blk& cur, const char* wsb, char* lds, Seam<DQK>& S, int tid_in) {
    typedef Cfg<DQK> C;
    int tid = tid_in; asm volatile("" : "+v"(tid));
    const int wid = __builtin_amdgcn_readfirstlane(tid >> 6), lane = tid & 63, r32 = lane & 31, hi = lane >> 5;
    A_STAGE_IDX(); char* K_lds = lds + 2 * SHM_V;
    const int kb0 = swa_jlo(cur.P0, W_(cur)) * KVBLK;
    A_QLOAD(cur);
    if constexpr (ROPE) A_RTLOAD(cur);
    A_SLOAD(cur, kb0); VMW(); A_SWRITE_K(0);
    __syncthreads();
}
template <int DQK, bool DIL, bool SK, int PVAR = 0, bool CONV = false, bool ROPE = false>
__device__ __forceinline__ void att_block(const Blk& cur, const Blk& nxt, const char* wsb, char* lds, Seam<DQK>& S, int tid_in, const ConvCtx* X = nullptr) {
    typedef Cfg<DQK> C;
    int tid = tid_in; asm volatile("" : "+v"(tid));
    const int wid = __builtin_amdgcn_readfirstlane(tid >> 6), lane = tid & 63, r32 = lane & 31, hi = lane >> 5;
    const int W = W_(cur); const float scale = SCALE_, beta = cur.beta;
    int j_lo = swa_jlo(cur.P0, W);
    int j_hi = (cur.P0 + QB - 1) / KVBLK + 1; if (j_hi > SKV_(cur) / KVBLK) j_hi = SKV_(cur) / KVBLK;
    if (PVAR & 8) j_lo = j_hi - 2;
    const int NT = j_hi - j_lo;
    const int kbn = swa_jlo(nxt.P0, W_(nxt)) * KVBLK;
    const int qlo = cur.P0 + wid * QBLK, qm = qlo + r32 - 4 * hi;
    char* V_lds = lds; char* K_lds = lds + 2 * SHM_V;
#ifdef ATT_DEFER
    constexpr bool DEFER = DIL;
#else
    constexpr bool DEFER = false;
#endif
    float* ws = (float*)(lds + (DEFER ? DEFER_WS : 2 * SHM_V + 2 * C::SHM_K)) + wid * 64; float* li_l = ws, * al_l = ws + 32;
    char* stg = lds + DEFER_STG + wid * 8192;
    float m_reg = -1e30f, l_reg = 0; f32x16 o[4] = {};
    A_STAGE_IDX();
    const int vst0 = v_st(sr, sc), vst1 = v_st(32 + sr, sc);
    const int vb0 = (int)(uintptr_t)V_lds + v_rd_base(lane);
#define RESC(a) do { if (__any((a) < 1.f)) { if (hi == 0) al_l[r32] = (a); asm volatile("s_waitcnt lgkmcnt(0)" ::: "memory");              \
                     _Pragma("unroll") for (int d_ = 0; d_ < 4; ++d_) _Pragma("unroll") for (int r = 0; r < 16; ++r) o[d_][r] *= al_l[crow(r, hi)]; } } while (0)
#define KBASE(t) ((j_lo + (t)) * KVBLK)
#define ACT(t) (KBASE(t) <= qlo + QBLK - 1 && KBASE(t) + KVBLK - 1 >= qlo - W + 1)
#define MASKT(P0_, P1_, t) do { const int kb_ = KBASE(t); if ((!SK || ACT(t)) && (kb_ + KVBLK - 1 > qlo || kb_ <= qlo + QBLK - 1 - W)) mask_tile(P0_, P1_, qm - kb_, (unsigned)W); } while (0)
    A_SWRITE_V(0);
    __syncthreads();
    if constexpr (ROPE) { VMW(); A_ROTATE(); }
#define STEP(t, BUF) do { const bool more_ = (t) + 1 < NT;                                                                        \
        if (more_) { A_SLOAD(cur, KBASE((t) + 1)); } else { A_SLOAD(nxt, kbn); }                                                   \
        const bool cpend_ = CONV && (S.cv_j != S.cl_j || S.cv_q != S.cl_q); const bool cld_ = CONV && more_ && S.cl_j < CONV_NJ;        \
        if (cld_) { conv_load(*X, S.cl_j, S.cl_q, BUF ? S.cw : S.cv, lane); if (++S.cl_q == 4) { S.cl_q = 0; ++S.cl_j; } }               \
        if (DEFER && S.p_on && (t) < 4) { flush_piece(stg, 2 * (t), wsb + S.p_oo, S.p_rb, S.p_so0, lane); flush_piece(stg, 2 * (t) + 1, wsb + S.p_oo, S.p_rb, S.p_so0, lane); } \
        SBAR(); f32x16 p0, p1; float mn_, al_; bf16x8 pa0, pa1, pa2, pa3;                                                            \
        qkt<BUF, SK, DQK, DIL>(p0, p1, K_lds, r32, hi, S.qr, ACT(t), beta, qm - KBASE(t)); SBAR();                                  \
        if (!more_) { A_QLOAD(nxt); SBAR(); } \
        MASKT(p0, p1, t); partialSM(p0, p1, m_reg, mn_, al_, scale); finishSM(p0, p1, al_, l_reg, pa0, pa1, pa2, pa3); RESC(al_); SBAR(); \
        pv_tile<BUF, SK>(o, vb0, pa0, pa1, pa2, pa3, ACT(t));                                                                      \
        if (more_) { if (cld_) VMWN(4); else VMW();            \
            A_SWRITE_V(1 - BUF); A_SWRITE_K(1 - BUF);                                                                              \
            if (cpend_) { conv_put(*X, S.cv_j, S.cv_q, BUF ? S.cv : S.cw, lds + CONV_SCR + wid * 4352, lane); if (++S.cv_q == 4) { S.cv_q = 0; ++S.cv_j; } } } \
        __syncthreads(); } while (0)
    int t = 0;
    for (; t + 1 < NT; t += 2) { STEP(t, 0); STEP(t + 1, 1); }
    if (t < NT) { STEP(t, 0); }
    VMWN(C::NQF); A_SWRITE_K(0); SBAR();
    if (CONV && (S.cv_j != S.cl_j || S.cv_q != S.cl_q)) { conv_put(*X, S.cv_j, S.cv_q, S.cv, lds + CONV_SCR + wid * 4352, lane); if (++S.cv_q == 4) { S.cv_q = 0; ++S.cv_j; } }
    if (hi == 0) li_l[r32] = l_reg; asm volatile("s_waitcnt lgkmcnt(0)" ::: "memory");
    if constexpr (DIL) { if (hi == 0) __builtin_amdgcn_raw_buffer_store_b32(__float_as_uint(m_reg * scale + __logf(l_reg)), A_RSRC(wsb + cur.lo), r32 * LS_(cur) * 4, (cur.P0 + wid * QBLK) * LS_(cur) * 4, 0); }
    float rli[16];
#pragma unroll
    for (int r = 0; r < 16; ++r) rli[r] = __builtin_amdgcn_rcpf(li_l[crow(r, hi)]);
    if constexpr (DEFER) { stage_write(o, rli, stg, lane); S.p_oo = cur.oo; S.p_rb = OS_(cur) * 2; S.p_so0 = (cur.P0 + wid * QBLK) * OS_(cur) * 2; S.p_on = 1; }
    else {
#ifdef ATT_T21
    store_o_staged(o, rli, wid < 4 ? lds + SHM_V + wid * 4096 : lds + 2 * SHM_V + C::SHM_K + (wid - 4) * 4096, A_RSRC(wsb + cur.oo), OS_(cur) * 2, (cur.P0 + wid * QBLK) * OS_(cur) * 2, lane);
#else
    const int os_ = (PVAR & 1) ? 0 : OS_(cur);
    const __amdgpu_buffer_rsrc_t ro_ = A_RSRC(wsb + cur.oo); const int oo_ = (4 * hi * os_ + r32) * 2, so0_ = (cur.P0 + wid * QBLK) * os_ * 2;
#pragma unroll
    for (int r = 0; r < 16; ++r) { const int sor_ = so0_ + ((r & 3) + 8 * (r >> 2)) * os_ * 2;
#pragma unroll
        for (int d0 = 0; d0 < 4; ++d0) { const float v = o[d0][r] * rli[r];
            const float vn = __int_as_float(__builtin_amdgcn_update_dpp(0, __float_as_int(v), 0xB1, 0xF, 0xF, true));
            if ((r32 & 1) == 0) __builtin_amdgcn_raw_buffer_store_b32(cvtpk(v, vn), ro_, oo_ + d0 * 64, sor_, 0); } }
#endif
    }
    if constexpr (ROPE) A_RTLOAD(nxt);
#undef RESC
#undef KBASE
#undef ACT
#undef MASKT
#undef STEP
}

template <int DQK> struct SeamD { bf16x8 qr[Cfg<DQK>::NQF]; };
#define A_GLDS(voff, sbase, ldsdst) do { unsigned keep_; asm volatile("s_mov_b32 %0, m0\n\ts_mov_b32 m0, %2\n\ts_nop 0\n\tglobal_load_lds_dwordx4 %1, %3\n\ts_mov_b32 m0, %0" \
        : "=&s"(keep_) : "v"(voff), "s"((unsigned)__builtin_amdgcn_readfirstlane((int)(ldsdst))), "s"((const void*)(sbase)) : "memory"); } while (0)
#define A_DMA_IDX() int krow_[C::KCH], kcb_[C::KCH], vrow_[2], vcb_[2]; \
        _Pragma("unroll") for (int j_ = 0; j_ < C::KCH; ++j_) { const int p_ = (j_ * 8 + wid) * 1024 + lane * 16, row_ = p_ / C::KPITCH, pc_ = (p_ % C::KPITCH) / 16, lc_ = (pc_ & ~7) | ((pc_ & 7) ^ (row_ & 7)); \
            krow_[j_] = row_; kcb_[j_] = lc_ * 16; } \
        _Pragma("unroll") for (int j_ = 0; j_ < 2; ++j_) { const int p_ = (j_ * 8 + wid) * 1024 + lane * 16, s_ = p_ / 512, w_ = p_ % 512, kk_ = (s_ >> 2) * 8 + (w_ >> 6), col_ = (s_ & 3) * 32 + ((w_ & 63) >> 1); \
            vrow_[j_] = (kk_ & ~0xC) | ((kk_ & 4) << 1) | ((kk_ & 8) >> 1); vcb_[j_] = col_ * 2; }
#define A_DMA(B_, k0, sl_) do { const char* kb_ = wsb + (B_).ko + (size_t)(k0) * (size_t)(KS_(B_) * 2); const char* vb_ = wsb + (B_).vo + (size_t)(k0) * (size_t)(VS_(B_) * 2); \
        _Pragma("unroll") for (int j_ = 0; j_ < C::KCH; ++j_) A_GLDS((unsigned)(krow_[j_] * KS_(B_) * 2 + kcb_[j_]), kb_, lds0 + NS * SHM_V + (sl_) * C::SHM_K + (j_ * 8 + wid) * 1024); \
        _Pragma("unroll") for (int j_ = 0; j_ < 2; ++j_) A_GLDS((unsigned)(vrow_[j_] * VS_(B_) * 2 + vcb_[j_]), vb_, lds0 + (sl_) * SHM_V + (j_ * 8 + wid) * 1024); } while (0)
template <int DQK, bool DIL, int NS>
__device__ __forceinline__ void att_prime_dma(const Blk& cur, const char* wsb, char* lds, SeamD<DQK>& S, int tid_in) {
    typedef Cfg<DQK> C;
    int tid = tid_in; asm volatile("" : "+v"(tid));
    const int wid = __builtin_amdgcn_readfirstlane(tid >> 6), lane = tid & 63, r32 = lane & 31, hi = lane >> 5;
    const unsigned lds0 = (unsigned)(uintptr_t)lds;
    A_DMA_IDX();
    const int kb0 = swa_jlo(cur.P0, W_(cur)) * KVBLK;
    A_QLOAD(cur);
#pragma unroll
    for (int i_ = 0; i_ < NS - 1; ++i_) A_DMA(cur, kb0 + i_ * KVBLK, i_);
}
template <int DQK, bool DIL, bool SK, int NS>
__device__ __forceinline__ void att_block_dma(const Blk& cur, const Blk& nxt, const char* wsb, char* lds, char* wsl, SeamD<DQK>& S, int tid_in) {
    typedef Cfg<DQK> C;
    int tid = tid_in; asm volatile("" : "+v"(tid));
    const int wid = __builtin_amdgcn_readfirstlane(tid >> 6), lane = tid & 63, r32 = lane & 31, hi = lane >> 5;
    const int W = W_(cur); const float scale = SCALE_, beta = cur.beta;
    const int j_lo = swa_jlo(cur.P0, W);
    int j_hi = (cur.P0 + QB - 1) / KVBLK + 1; if (j_hi > SKV_(cur) / KVBLK) j_hi = SKV_(cur) / KVBLK;
    const int NT = j_hi - j_lo;
    const int kbn = swa_jlo(nxt.P0, W_(nxt)) * KVBLK;
    const int qlo = cur.P0 + wid * QBLK, qm = qlo + r32 - 4 * hi;
    const unsigned lds0 = (unsigned)(uintptr_t)lds;
    const char* K_lds = lds + NS * SHM_V;
    float* ws = (float*)wsl + wid * 64; float* li_l = ws, * al_l = ws + 32;
    float m_reg = -1e30f, l_reg = 0; f32x16 o[4] = {};
    A_DMA_IDX();
    const int vb0 = (int)lds0 + v_rd_base(lane);
    constexpr int NDMA = C::KCH + 2;
#define RESC(a) do { if (__any((a) < 1.f)) { if (hi == 0) al_l[r32] = (a); asm volatile("s_waitcnt lgkmcnt(0)" ::: "memory");              \
                     _Pragma("unroll") for (int d_ = 0; d_ < 4; ++d_) _Pragma("unroll") for (int r = 0; r < 16; ++r) o[d_][r] *= al_l[crow(r, hi)]; } } while (0)
#define KBASE(t) ((j_lo + (t)) * KVBLK)
#define ACT(t) (KBASE(t) <= qlo + QBLK - 1 && KBASE(t) + KVBLK - 1 >= qlo - W + 1)
#define MASKT(P0_, P1_, t) do { const int kb_ = KBASE(t); if ((!SK || ACT(t)) && (kb_ + KVBLK - 1 > qlo || kb_ <= qlo + QBLK - 1 - W)) mask_tile(P0_, P1_, qm - kb_, (unsigned)W); } while (0)
    VMW();
#pragma unroll
    for (int d0 = 0; d0 < C::NQF; ++d0) asm volatile("" : "+v"(S.qr[d0]));
    asm volatile("s_waitcnt lgkmcnt(0)" ::: "memory"); __builtin_amdgcn_s_barrier(); asm volatile("" ::: "memory");
    int sl = 0, sl2 = NS - 1;
#pragma unroll 1
    for (int t = 0; t < NT; ++t) {
        const bool pre = t + NS - 1 < NT;
        if (pre) A_DMA(cur, KBASE(t + NS - 1), sl2);
        SBAR(); f32x16 p0, p1; float mn_, al_; bf16x8 pa0, pa1, pa2, pa3;
        qkt<0, SK, DQK, DIL>(p0, p1, K_lds + sl * C::SHM_K, r32, hi, S.qr, ACT(t), beta, qm - KBASE(t)); SBAR();
        MASKT(p0, p1, t); partialSM(p0, p1, m_reg, mn_, al_, scale); finishSM(p0, p1, al_, l_reg, pa0, pa1, pa2, pa3); RESC(al_); SBAR();
        pv_tile<0, SK>(o, vb0 + sl * SHM_V, pa0, pa1, pa2, pa3, ACT(t));
        if (t + 1 < NT) { int infl = NT - 2 - t; if (infl > NS - 2) infl = NS - 2;
                          if (infl <= 0) VMW(); else if (infl == 1) VMWN(NDMA); else VMWN(2 * NDMA);
                          asm volatile("s_waitcnt lgkmcnt(0)" ::: "memory"); __builtin_amdgcn_s_barrier(); asm volatile("" ::: "memory"); }
        sl = sl == NS - 1 ? 0 : sl + 1; sl2 = sl2 == NS - 1 ? 0 : sl2 + 1;
    }
    asm volatile("s_waitcnt lgkmcnt(0)" ::: "memory"); __builtin_amdgcn_s_barrier(); asm volatile("" ::: "memory");
    A_QLOAD(nxt);
#pragma unroll
    for (int i_ = 0; i_ < NS - 1; ++i_) A_DMA(nxt, kbn + i_ * KVBLK, i_);
    if (hi == 0) li_l[r32] = l_reg; asm volatile("s_waitcnt lgkmcnt(0)" ::: "memory");
    if constexpr (DIL) { if (hi == 0) __builtin_amdgcn_raw_buffer_store_b32(__float_as_uint(m_reg * scale + __logf(l_reg)), A_RSRC(wsb + cur.lo), r32 * LS_(cur) * 4, (cur.P0 + wid * QBLK) * LS_(cur) * 4, 0); }
    float rli[16];
#pragma unroll
    for (int r = 0; r < 16; ++r) rli[r] = __builtin_amdgcn_rcpf(li_l[crow(r, hi)]);
    const __amdgpu_buffer_rsrc_t ro_ = A_RSRC(wsb + cur.oo); const int oo_ = (4 * hi * OS_(cur) + r32) * 2, so0_ = (cur.P0 + wid * QBLK) * OS_(cur) * 2;
#pragma unroll
    for (int r = 0; r < 16; ++r) { const int sor_ = so0_ + ((r & 3) + 8 * (r >> 2)) * OS_(cur) * 2;
#pragma unroll
        for (int d0 = 0; d0 < 4; ++d0) { const float v = o[d0][r] * rli[r];
            const float vn = __int_as_float(__builtin_amdgcn_update_dpp(0, __float_as_int(v), 0xB1, 0xF, 0xF, true));
            if ((r32 & 1) == 0) __builtin_amdgcn_raw_buffer_store_b32(cvtpk(v, vn), ro_, oo_ + d0 * 64, sor_, 0); } }
#undef RESC
#undef KBASE
#undef ACT
#undef MASKT
}

template <bool SK, int DQK, bool DIL>
__device__ __forceinline__ void qkt_fin(f32x16& p0, f32x16& p1, const char* K_lds, int r32, int hi, const bf16x8* qr, bool act, float beta, int dq,
                                        f32x16& y0, f32x16& y1, float alpha, float& l_reg, bf16x8& pa0, bf16x8& pa1, bf16x8& pa2, bf16x8& pa3) {
    typedef Cfg<DQK> C;
    const bool run = !(SK && !act);
    if (!run) { const float NEG = -__builtin_inff();
#pragma unroll
        for (int r = 0; r < 16; ++r) { p0[r] = NEG; p1[r] = NEG; } }
    else if constexpr (DIL) { const float b0 = -beta * (float)dq;
#pragma unroll
        for (int r = 0; r < 16; ++r) { const int c = (r & 3) + 8 * (r >> 2); p0[r] = fmaf(beta, (float)c, b0); p1[r] = fmaf(beta, (float)(c + 32), b0); } }
    else { p0 = f32x16{}; p1 = f32x16{}; }
    const char* kb[4];
#pragma unroll
    for (int dd = 0; dd < 4; ++dd) { const int colB = (dd * 16 + hi * 8) * 2; kb[dd] = K_lds + r32 * C::KPITCH + (colB ^ ((r32 & 7) << 4)); }
#define QK_CHUNK(c_) do { if (run) { _Pragma("unroll") for (int d0 = 4 * (c_); d0 < 4 * (c_) + 4 && d0 < C::NQF; ++d0) { const char* a = kb[d0 & 3] + (d0 >> 2) * 128; \
            bf16x8 b0 = *reinterpret_cast<const bf16x8*>(a); bf16x8 b1 = *reinterpret_cast<const bf16x8*>(a + 32 * C::KPITCH);                                  \
            p0 = __builtin_amdgcn_mfma_f32_32x32x16_bf16(b0, qr[d0], p0, 0, 0, 0); p1 = __builtin_amdgcn_mfma_f32_32x32x16_bf16(b1, qr[d0], p1, 0, 0, 0); } } } while (0)
#define PK4(P, B_, OUT) do { unsigned a0 = cvtpk(P[B_+0], P[B_+1]), a1 = cvtpk(P[B_+2], P[B_+3]);                          \
        unsigned b0 = cvtpk(P[B_+4], P[B_+5]), b1 = cvtpk(P[B_+6], P[B_+7]);                                             \
        auto r0 = __builtin_amdgcn_permlane32_swap(a0, b0, false, false); auto r1 = __builtin_amdgcn_permlane32_swap(a1, b1, false, false); \
        u32x4 w = {r0[0], r1[0], r0[1], r1[1]}; OUT = *reinterpret_cast<bf16x8*>(&w); } while (0)
    QK_CHUNK(0);
#pragma unroll
    for (int r = 0; r < 16; ++r) y1[r] = __builtin_amdgcn_exp2f(y1[r]);
    float ps = 0;
#pragma unroll
    for (int r = 0; r < 16; ++r) ps += y0[r];
#pragma unroll
    for (int r = 0; r < 16; ++r) ps += y1[r];
    SBAR();
    QK_CHUNK(1);
    { auto rr = __builtin_amdgcn_permlane32_swap(__float_as_uint(ps), __float_as_uint(ps), false, false);
      ps = __uint_as_float(rr[0]) + __uint_as_float(rr[1]); }
    l_reg = l_reg * alpha + ps;
    PK4(y0, 0, pa0); PK4(y0, 8, pa1);
    if constexpr (C::NQF > 8) { SBAR(); QK_CHUNK(2); }
    PK4(y1, 0, pa2); PK4(y1, 8, pa3);
#undef PK4
#undef QK_CHUNK
}
#ifndef ATT_SKEW_SEL
#define ATT_SKEW_SEL 0
#endif
#if ATT_SKEW_SEL == 0
#define ATT_SKEW_A (wid < 4)
#elif ATT_SKEW_SEL == 1
#define ATT_SKEW_A ((wid & 1) == 0)
#elif ATT_SKEW_SEL == 2
#define ATT_SKEW_A true
#else
#define ATT_SKEW_A false
#endif
#define A_DMA_K(B_, k0, sl_) do { const char* kb_ = wsb + (B_).ko + (size_t)(k0) * (size_t)(KS_(B_) * 2); int ln_ = lane; asm volatile("" : "+v"(ln_)); \
        _Pragma("unroll") for (int j_ = 0; j_ < C::KCH; ++j_) { const int p_ = (j_ * 8 + wid) * 1024 + ln_ * 16, row_ = p_ / C::KPITCH, pc_ = (p_ % C::KPITCH) / 16, lc_ = (pc_ & ~7) | ((pc_ & 7) ^ (row_ & 7)); \
            A_GLDS((unsigned)(row_ * KS_(B_) * 2 + lc_ * 16), kb_, lds0 + 3 * SHM_V + (sl_) * C::SHM_K + (j_ * 8 + wid) * 1024); } } while (0)
#define A_DMA_V(B_, k0, sl_) do { const char* vb_ = wsb + (B_).vo + (size_t)(k0) * (size_t)(VS_(B_) * 2); int ln_ = lane; asm volatile("" : "+v"(ln_)); \
        _Pragma("unroll") for (int j_ = 0; j_ < 2; ++j_) { const int p_ = (j_ * 8 + wid) * 1024 + ln_ * 16, s_ = p_ / 512, w_ = p_ % 512, kk_ = (s_ >> 2) * 8 + (w_ >> 6), col_ = (s_ & 3) * 32 + ((w_ & 63) >> 1); \
            const int vr_ = (kk_ & ~0xC) | ((kk_ & 4) << 1) | ((kk_ & 8) >> 1); \
            A_GLDS((unsigned)(vr_ * VS_(B_) * 2 + col_ * 2), vb_, lds0 + (sl_) * SHM_V + (j_ * 8 + wid) * 1024); } } while (0)
#define A_RAWBAR() do { asm volatile("s_waitcnt lgkmcnt(0)" ::: "memory"); __builtin_amdgcn_s_barrier(); asm volatile("" ::: "memory"); } while (0)
template <int DQK, bool DIL>
__device__ __forceinline__ void att_prime_dma2(const Blk& cur, const char* wsb, char* lds, SeamD<DQK>& S, int tid_in) {
    typedef Cfg<DQK> C; constexpr int NS = 3;
    int tid = tid_in; asm volatile("" : "+v"(tid));
    const int wid = __builtin_amdgcn_readfirstlane(tid >> 6), lane = tid & 63, r32 = lane & 31, hi = lane >> 5;
    const unsigned lds0 = (unsigned)(uintptr_t)lds;
    const int kb0 = swa_jlo(cur.P0, W_(cur)) * KVBLK;
    A_QLOAD(cur);
    A_DMA_K(cur, kb0, 0); A_DMA_V(cur, kb0, 0); A_DMA_K(cur, kb0 + KVBLK, 1);
}
template <int DQK, bool DIL, bool SK, int ORD>
__device__ __forceinline__ void att_block_dma2(const Blk& cur, const Blk& nxt, const char* wsb, char* lds, SeamD<DQK>& S, int tid_in) {
    typedef Cfg<DQK> C; constexpr int NS = 3;
    int tid = tid_in; asm volatile("" : "+v"(tid));
    const int wid = __builtin_amdgcn_readfirstlane(tid >> 6), lane = tid & 63, r32 = lane & 31, hi = lane >> 5;
    const int W = W_(cur); const float scale = SCALE_, beta = cur.beta;
    const int j_lo = swa_jlo(cur.P0, W);
    int j_hi = (cur.P0 + QB - 1) / KVBLK + 1; if (j_hi > SKV_(cur) / KVBLK) j_hi = SKV_(cur) / KVBLK;
    const int NT = j_hi - j_lo;
    const int kbn = swa_jlo(nxt.P0, W_(nxt)) * KVBLK;
    const int qlo = cur.P0 + wid * QBLK, qm = qlo + r32 - 4 * hi;
    const unsigned lds0 = (unsigned)(uintptr_t)lds;
    const char* K_lds = lds + 3 * SHM_V;
    float* ws = (float*)(lds + 3 * SHM_V + 3 * C::SHM_K) + wid * 64; float* li_l = ws, * al_l = ws + 32;
    float m_reg = -1e30f, l_reg = 0; f32x16 o[4] = {};
    const int vb0 = (int)lds0 + v_rd_base(lane);
#define RESC(a) do { if (__any((a) < 1.f)) { if (hi == 0) al_l[r32] = (a); asm volatile("s_waitcnt lgkmcnt(0)" ::: "memory");              \
                     _Pragma("unroll") for (int d_ = 0; d_ < 4; ++d_) _Pragma("unroll") for (int r = 0; r < 16; ++r) o[d_][r] *= al_l[crow(r, hi)]; } } while (0)
#define KBASE(t) ((j_lo + (t)) * KVBLK)
#define ACT(t) (KBASE(t) <= qlo + QBLK - 1 && KBASE(t) + KVBLK - 1 >= qlo - W + 1)
#define MASKT(P0_, P1_, t) do { const int kb_ = KBASE(t); if ((!SK || ACT(t)) && (kb_ + KVBLK - 1 > qlo || kb_ <= qlo + QBLK - 1 - W)) mask_tile(P0_, P1_, qm - kb_, (unsigned)W); } while (0)
#define ISSUE(t, n_) do { n_ = 0; if ((t) + 2 < NT) { int slotk_ = sl + 2; if (slotk_ >= 3) slotk_ -= 3; A_DMA_K(cur, KBASE((t) + 2), slotk_); n_ += C::KCH; } \
                          if ((t) + 1 < NT) { int slotv_ = sl + 1; if (slotv_ >= 3) slotv_ -= 3; A_DMA_V(cur, KBASE((t) + 1), slotv_); n_ += 2; } } while (0)
#define CLOSE(n_) do { if ((n_) == C::KCH + 2) VMWN(C::KCH + 2); else if ((n_) == 2) VMWN(2); else VMW(); A_RAWBAR(); } while (0)
    VMW();
#pragma unroll
    for (int d0 = 0; d0 < C::NQF; ++d0) asm volatile("" : "+v"(S.qr[d0]));
    A_RAWBAR();
    int sl = 0, slp = 2, nis;
    f32x16 pA0, pA1, pB0, pB1; float mnA, mnB, alA, alB; bf16x8 pa0, pa1, pa2, pa3;
    ISSUE(0, nis); SBAR();
    qkt<0, SK, DQK, DIL>(pA0, pA1, K_lds + sl * C::SHM_K, r32, hi, S.qr, ACT(0), beta, qm - KBASE(0)); SBAR();
    MASKT(pA0, pA1, 0); partialSM(pA0, pA1, m_reg, mnA, alA, scale);
    CLOSE(nis); slp = sl; sl = sl == 2 ? 0 : sl + 1;
#define STEPP(PX0, PX1, mnX, alX, PY0, PY1, alY, t) do { ISSUE(t, nis); SBAR();                                               \
        if constexpr (ORD == 0) {                                                                                               \
            qkt<0, SK, DQK, DIL>(PX0, PX1, K_lds + sl * C::SHM_K, r32, hi, S.qr, ACT(t), beta, qm - KBASE(t)); SBAR();           \
            finishSM(PY0, PY1, alY, l_reg, pa0, pa1, pa2, pa3); SBAR();                                                         \
            pv_tile<0, SK>(o, vb0 + slp * SHM_V, pa0, pa1, pa2, pa3, ACT((t) - 1)); SBAR();                                     \
        } else {                                                                                                                \
            finishSM(PY0, PY1, alY, l_reg, pa0, pa1, pa2, pa3); SBAR();                                                         \
            pv_tile<0, SK>(o, vb0 + slp * SHM_V, pa0, pa1, pa2, pa3, ACT((t) - 1)); SBAR();                                     \
            qkt<0, SK, DQK, DIL>(PX0, PX1, K_lds + sl * C::SHM_K, r32, hi, S.qr, ACT(t), beta, qm - KBASE(t)); SBAR();           \
        }                                                                                                                       \
        MASKT(PX0, PX1, (t)); partialSM(PX0, PX1, m_reg, mnX, alX, scale);                                                     \
        RESC(alX); CLOSE(nis); slp = sl; sl = sl == 2 ? 0 : sl + 1; } while (0)
    int t = 1;
#pragma unroll 1
    for (; t + 2 < NT; t += 2) {
        STEPP(pB0, pB1, mnB, alB, pA0, pA1, alA, t);
        STEPP(pA0, pA1, mnA, alA, pB0, pB1, alB, t + 1);
    }
    STEPP(pB0, pB1, mnB, alB, pA0, pA1, alA, t);
    finishSM(pB0, pB1, alB, l_reg, pa0, pa1, pa2, pa3); SBAR();
    pv_tile<0, SK>(o, vb0 + slp * SHM_V, pa0, pa1, pa2, pa3, ACT(NT - 1));
    A_RAWBAR();
    A_QLOAD(nxt);
    A_DMA_K(nxt, kbn, 0); A_DMA_V(nxt, kbn, 0); A_DMA_K(nxt, kbn + KVBLK, 1);
    if (hi == 0) li_l[r32] = l_reg; asm volatile("s_waitcnt lgkmcnt(0)" ::: "memory");
    if constexpr (DIL) { if (hi == 0) __builtin_amdgcn_raw_buffer_store_b32(__float_as_uint(m_reg * scale + __logf(l_reg)), A_RSRC(wsb + cur.lo), r32 * LS_(cur) * 4, (cur.P0 + wid * QBLK) * LS_(cur) * 4, 0); }
    float rli[16];
#pragma unroll
    for (int r = 0; r < 16; ++r) rli[r] = __builtin_amdgcn_rcpf(li_l[crow(r, hi)]);
    const __amdgpu_buffer_rsrc_t ro_ = A_RSRC(wsb + cur.oo); const int oo_ = (4 * hi * OS_(cur) + r32) * 2, so0_ = (cur.P0 + wid * QBLK) * OS_(cur) * 2;
#pragma unroll
    for (int r = 0; r < 16; ++r) { const int sor_ = so0_ + ((r & 3) + 8 * (r >> 2)) * OS_(cur) * 2;
#pragma unroll
        for (int d0 = 0; d0 < 4; ++d0) { const float v = o[d0][r] * rli[r];
            const float vn = __int_as_float(__builtin_amdgcn_update_dpp(0, __float_as_int(v), 0xB1, 0xF, 0xF, true));
            if ((r32 & 1) == 0) __builtin_amdgcn_raw_buffer_store_b32(cvtpk(v, vn), ro_, oo_ + d0 * 64, sor_, 0); } }
#undef RESC
#undef KBASE
#undef ACT
#undef MASKT
#undef ISSUE
#undef CLOSE
#undef STEPP
}
#undef A_DMA_K
#undef A_DMA_V
#undef A_RAWBAR
#undef A_GLDS
#undef A_DMA_IDX
#undef A_DMA
#undef VMW
#undef VMWN
#undef A_SLOAD
#undef A_RSRC
#undef A_BLD
#undef A_QLOAD
#undef A_SWRITE_K
#undef A_SWRITE_V
#undef A_STAGE_IDX
#undef SBAR
#undef QS_
#undef KS_
#undef VS_
#undef OS_
#undef LS_
#undef SKV_
#undef W_
#undef SCALE_
}
constexpr int NWAVES = 8;
constexpr int T = 32768, DM = 2048, SEQ = 8192, NB = 4, DEPTH = 2;
constexpr int IN_COLS = 3904, PROJ_LD = 4096, NEXP = 16, DEXP = 1024;
constexpr int C_QB = 0, C_KB = 1024, C_VB = 2048, C_CQ = 3072, C_CKV = 3584, C_KR = 3840;
constexpr float EPS = 1e-6f;
constexpr size_t MiB = 1u << 20;
constexpr size_t WS_CTL = 0, CTL_ZERO_BYTES = 1 * MiB;
constexpr size_t WS_MOD = 1 * MiB;
constexpr size_t WS_ROPE = 2 * MiB;
constexpr size_t WS_RSTDQ = 4 * MiB, WS_RSTDKV = 4 * MiB + 256 * 1024, WS_AW = 4 * MiB + 512 * 1024;
constexpr size_t WS_ROWIDX = 5 * MiB;
constexpr size_t WS_LSE = 8 * MiB;
constexpr size_t WS_WIN = 16 * MiB;
constexpr size_t WS_WUQ = 48 * MiB;
constexpr size_t WS_WUKV = 51 * MiB;
constexpr size_t WS_WOUT = 53 * MiB;
constexpr size_t WS_W13 = 72 * MiB;
constexpr size_t WS_W2 = 200 * MiB;
constexpr size_t WS_H = 264 * MiB;
constexpr size_t WS_PROJ = 392 * MiB;
constexpr size_t WS_QA = 648 * MiB;
constexpr size_t WS_KF = 744 * MiB;
constexpr size_t WS_VB = 840 * MiB;
constexpr size_t WS_OA = 904 * MiB;
constexpr size_t WS_OB = 968 * MiB;
constexpr size_t WS_XB = 1160 * MiB;
constexpr size_t WS_END = 1288 * MiB;
constexpr size_t WS_HMID = WS_PROJ;
constexpr size_t WS_Y = WS_QA;
constexpr int CW_TMO = 0;
constexpr int CW_CNT = 64;
constexpr int CW_BAR = 4096;
constexpr int RING_BYTES = 131072;
constexpr int L_MISC = RING_BYTES, L_TS = RING_BYTES + 256, L_CNT = RING_BYTES + 384, L_TOK = RING_BYTES + 512, L_ATAB = RING_BYTES + 2560;
constexpr int MAXU = 10;
constexpr int LDS_BYTES = 147456;
static_assert(L_ATAB + MAXU * 1024 <= LDS_BYTES, "LDS map");

#define GAS __attribute__((address_space(1)))
#define LAS __attribute__((address_space(3)))
typedef unsigned short bf16;
typedef unsigned v4u __attribute__((ext_vector_type(4)));
typedef unsigned v2u __attribute__((ext_vector_type(2)));
typedef float f32x4 __attribute__((ext_vector_type(4)));
typedef float f32x2 __attribute__((ext_vector_type(2)));
#define LDS_WAIT() asm volatile("s_waitcnt lgkmcnt(0)" ::: "memory")
#define VM_WAIT() asm volatile("s_waitcnt vmcnt(0)" ::: "memory")
__device__ __forceinline__ unsigned pk2(float lo, float hi) { return pg8::cvt_pk_bf16(lo, hi); }
__device__ __forceinline__ float bf_lo(unsigned w) { return __uint_as_float(w << 16); }
__device__ __forceinline__ float bf_hi(unsigned w) { return __uint_as_float(w & 0xffff0000u); }


typedef __amdgpu_buffer_rsrc_t rsrc_t;
#define RSRC(p) __builtin_amdgcn_make_buffer_rsrc((void*)(p), 0, 0x7fffffff, 0x00020000)
__device__ __forceinline__ f32x4 bld4f(rsrc_t r, int vo, int so) { return __builtin_bit_cast(f32x4, __builtin_amdgcn_raw_buffer_load_b128(r, vo, so, 0)); }
__device__ __forceinline__ v4u bld4u(rsrc_t r, int vo, int so) { return __builtin_bit_cast(v4u, __builtin_amdgcn_raw_buffer_load_b128(r, vo, so, 0)); }
__device__ __forceinline__ v2u bld2u(rsrc_t r, int vo, int so) { return __builtin_bit_cast(v2u, __builtin_amdgcn_raw_buffer_load_b64(r, vo, so, 0)); }
__device__ __forceinline__ void bst2u(rsrc_t r, int vo, int so, v2u v) { __builtin_amdgcn_raw_buffer_store_b64(v, r, vo, so, 0); }
__device__ __forceinline__ void bst4u(rsrc_t r, int vo, int so, v4u v) { __builtin_amdgcn_raw_buffer_store_b128(v, r, vo, so, 0); }
__device__ __forceinline__ void bst4f(rsrc_t r, int vo, int so, f32x4 v) { __builtin_amdgcn_raw_buffer_store_b128(__builtin_bit_cast(v4u, v), r, vo, so, 0); }

#define XB_TMO      128
#define XB_XCNT(j)  (256  + 64 * (j))
#define XB_XSUB(j)  (1280 + 64 * (j))
#define XB_XGEN(j)  (2304 + 64 * (j))
#define XB_TOP      3328
#define XB_TOPGEN   3392
#define XCD_BAR_WORDS 3456
#define XB_SPIN_CAP (1u << 18)
__device__ __forceinline__ unsigned xb_ld(unsigned* p)              { return __hip_atomic_load(p, __ATOMIC_RELAXED, __HIP_MEMORY_SCOPE_AGENT); }
__device__ __forceinline__ unsigned xb_add(unsigned* p, unsigned v) { return __hip_atomic_fetch_add(p, v, __ATOMIC_RELAXED, __HIP_MEMORY_SCOPE_AGENT); }
__device__ __forceinline__ unsigned xb_xcc_id() { return (unsigned)__builtin_amdgcn_s_getreg((3 << 11) | 20) & 0xFu; }
#define XB_SPIN(cond, bar) do { unsigned _sp = 0; while (cond) { __builtin_amdgcn_s_sleep(1); \
    if ((++_sp & 255u) == 0u) { if (xb_ld(&(bar)[XB_TMO])) break; if (_sp > XB_SPIN_CAP) { atomicAdd(&(bar)[XB_TMO], 1u); break; } } } } while (0)
struct XcdBarrier { unsigned* bar; unsigned x; volatile LAS unsigned* st; };
__device__ __forceinline__ XcdBarrier xcd_barrier_post(unsigned* bar, volatile LAS unsigned* st, int tid) {
    XcdBarrier b; b.bar = bar; b.x = xb_xcc_id(); b.st = st;
    if (tid == 0) (void)xb_add(&bar[XB_XCNT(b.x)], 1u);
    return b;
}
__device__ __forceinline__ void xcd_barrier_complete(unsigned* bar, unsigned x, unsigned& nloc, unsigned& nx) {
    const unsigned G = gridDim.x * gridDim.y * gridDim.z;
    unsigned sum, cnt, mine, sp = 0u;
    for (;;) {
        sum = 0u; cnt = 0u; mine = 0u;
#pragma unroll
        for (unsigned j = 0; j < 16; ++j) { const unsigned c = xb_ld(&bar[XB_XCNT(j)]); sum += c; cnt += (c > 0u) ? 1u : 0u; mine = (j == x) ? c : mine; }
        if (sum == G) break;
        __builtin_amdgcn_s_sleep(1);
        if ((++sp & 255u) == 0u) { if (xb_ld(&bar[XB_TMO])) break; if (sp > XB_SPIN_CAP) { atomicAdd(&bar[XB_TMO], 1u); break; } }
    }
    nloc = mine > 0u ? mine : 1u; nx = cnt > 0u ? cnt : 1u;
}
__device__ __forceinline__ void xcd_barrier(const XcdBarrier& b, int tid) {
    asm volatile("s_waitcnt vmcnt(0)" ::: "memory");
    __syncthreads();
    if (tid == 0) {
        unsigned* bar = b.bar; asm volatile("" : "+s"(bar));
        __builtin_amdgcn_s_waitcnt(0);
        unsigned nloc = b.st[0], nx = b.st[1];
        if (nloc == 0u) { xcd_barrier_complete(bar, b.x, nloc, nx); b.st[0] = nloc; b.st[1] = nx; }
        const unsigned old = xb_add(&bar[XB_XSUB(b.x)], 1u);
        const unsigned gen = old / nloc;
        if (old + 1u == (gen + 1u) * nloc) {
            __builtin_amdgcn_fence(__ATOMIC_RELEASE, "agent");
            asm volatile("s_waitcnt vmcnt(0)" ::: "memory");
            const unsigned og = xb_add(&bar[XB_TOP], 1u);
            const unsigned tg = og / nx;
            if (og + 1u == (tg + 1u) * nx) xb_add(&bar[XB_TOPGEN], 1u);
            else XB_SPIN(xb_ld(&bar[XB_TOPGEN]) == tg, bar);
            __builtin_amdgcn_fence(__ATOMIC_ACQUIRE, "agent");
            xb_add(&bar[XB_XGEN(b.x)], 1u);
            asm volatile("s_waitcnt vmcnt(0)" ::: "memory");
        } else {
            XB_SPIN(xb_ld(&bar[XB_XGEN(b.x)]) == gen, bar);
            __builtin_amdgcn_fence(__ATOMIC_ACQUIRE, "agent");
            asm volatile("s_waitcnt vmcnt(0)" ::: "memory");
        }
    }
    __syncthreads();
}

struct Args {
    const float* in[20]; float* out; unsigned char* ws;
    float invf[32];
    int ph_lo, ph_hi, li, pad;
};
enum { I_X = 0, I_C, I_ADAW, I_ADAB, I_N1G, I_N2G, I_WIN, I_QNG, I_KVNG, I_WUQ, I_WUKV, I_ONA, I_ONB, I_WOUT, I_RW, I_RB, I_EG, I_EU, I_ED, I_FG };

struct Frame {
    LAS unsigned char* lds; unsigned char* ldsg;
    unsigned* ctl; unsigned char* ws;
    int tid, lane, wave, vcu, G;
};
__device__ __forceinline__ int lane_id() { int l; asm volatile("v_mbcnt_lo_u32_b32 %0, -1, 0\n\tv_mbcnt_hi_u32_b32 %0, -1, %0" : "=v"(l)); return l; }
#define DPP_ADD(v, ctrl) v += __int_as_float(__builtin_amdgcn_update_dpp(0, __float_as_int(v), ctrl, 0xF, 0xF, true))
__device__ __forceinline__ float wave_sum(float v) {
    DPP_ADD(v, 0xB1); DPP_ADD(v, 0x4E); DPP_ADD(v, 0x141); DPP_ADD(v, 0x140);
    v += __int_as_float(__builtin_amdgcn_ds_swizzle(__float_as_int(v), 0x401F));
    auto rr = __builtin_amdgcn_permlane32_swap(__float_as_uint(v), __float_as_uint(v), false, false);
    return __uint_as_float(rr[0]) + __uint_as_float(rr[1]);
}
__device__ __forceinline__ int il64(int j) { return j < 32 ? 2 * j : 2 * (j - 32) + 1; }
template <int MODE> __device__ __forceinline__ int dest_row(int n) {
    if constexpr (MODE == 0) return n;
    else if constexpr (MODE == 1) {
        if (n < 512) return C_CQ + n; if (n < 768) return C_CKV + (n - 512); if (n < 832) return C_KR + il64(n - 768);
        if (n < 1856) return C_QB + (n - 832); if (n < 2880) return C_KB + (n - 1856); return C_VB + (n - 2880); }
    else if constexpr (MODE == 2) { const int h = n / 192, j = n % 192; return j < 128 ? n : h * 192 + 128 + il64(j - 128); }
    else if constexpr (MODE == 3) return (n >> 7) * 256 + (n & 127);
    else return (n >> 7) * 256 + 128 + (n & 127);
}
template <int MODE>
__device__ __forceinline__ void transpose_item(const float* W, int ldw, int K, int N, bf16* WT, const float* kscale, LAS float* scr, int item, int lane) {
    const int nblk = N / 32, kb = item / nblk, nb = item % nblk, k0 = 64 * kb, n0 = 32 * nb;
    float tv[32];
#pragma unroll
    for (int i = 0; i < 32; ++i) { const int kk = 2 * i + (lane >> 5); tv[i] = W[(size_t)(k0 + kk) * ldw + n0 + (lane & 31)]; }
#pragma unroll
    for (int i = 0; i < 32; ++i) { const int kk = 2 * i + (lane >> 5); float v = tv[i]; if (kscale) v *= kscale[k0 + kk]; scr[kk * 33 + (lane & 31)] = v; }
    LDS_WAIT(); asm volatile("" ::: "memory");
    const int c = lane & 7;
#pragma unroll
    for (int j = 0; j < 4; ++j) { const int n = (lane >> 3) + 8 * j; const LAS float* s = scr + (8 * c) * 33 + n;
        v4u o; o.x = pk2(s[0 * 33], s[1 * 33]); o.y = pk2(s[2 * 33], s[3 * 33]); o.z = pk2(s[4 * 33], s[5 * 33]); o.w = pk2(s[6 * 33], s[7 * 33]);
        *(v4u*)(WT + (size_t)dest_row<MODE>(n0 + n) * K + k0 + 8 * c) = o; }
    LDS_WAIT(); asm volatile("s_waitcnt vmcnt(0)" ::: "memory");
}

__device__ __forceinline__ unsigned pk4_fp8(float a, float b, float c, float d) { int w = 0; w = __builtin_amdgcn_cvt_pk_fp8_f32(a, b, w, false); w = __builtin_amdgcn_cvt_pk_fp8_f32(c, d, w, true); return (unsigned)w; }
template <int MODE>
__device__ __forceinline__ void transpose_item8(const float* W, int ldw, int K, int N, unsigned char* WT, LAS float* scr, int item, int lane) {
    const int nblk = N / 32, kb = item / nblk, nb = item % nblk, k0 = 64 * kb, n0 = 32 * nb;
    float tv[32];
#pragma unroll
    for (int i = 0; i < 32; ++i) { const int kk = 2 * i + (lane >> 5); tv[i] = W[(size_t)(k0 + kk) * ldw + n0 + (lane & 31)]; }
#pragma unroll
    for (int i = 0; i < 32; ++i) { const int kk = 2 * i + (lane >> 5); scr[kk * 33 + (lane & 31)] = tv[i] * 256.0f; }
    LDS_WAIT(); asm volatile("" ::: "memory");
    const int c = lane & 7;
#pragma unroll
    for (int j = 0; j < 4; ++j) { const int n = (lane >> 3) + 8 * j; const LAS float* s = scr + (8 * c) * 33 + n;
        v2u o; o.x = pk4_fp8(s[0 * 33], s[1 * 33], s[2 * 33], s[3 * 33]); o.y = pk4_fp8(s[4 * 33], s[5 * 33], s[6 * 33], s[7 * 33]);
        *(v2u*)(WT + (size_t)dest_row<MODE>(n0 + n) * K + k0 + 8 * c) = o; }
    LDS_WAIT(); asm volatile("s_waitcnt vmcnt(0)" ::: "memory");
}

__device__ __forceinline__ void phase_prologue(Frame& F, const Args& A) {
    {
        const float* cc = A.in[I_C]; float* mod = (float*)(F.ws + WS_MOD);
        LAS float* red = (LAS float*)F.lds;
        for (int id = F.vcu; id < 2 * 96; id += F.G) {
            const int l = id / 96, ch = id % 96, cg = F.tid & 31, kg = F.tid >> 5, col = ch * 128 + cg * 4;
            const float* w = A.in[I_ADAW] + (size_t)l * DM * 12288 + col;
            f32x4 acc[4] = {};
#pragma unroll 4
            for (int kk = 0; kk < 128; ++kk) { const int k = kg * 128 + kk; const f32x4 wv = *(const f32x4*)(w + (size_t)k * 12288);
#pragma unroll
                for (int b = 0; b < 4; ++b) { const float cv = cc[b * DM + k]; const float ca = cv / (1.0f + __expf(-cv)); acc[b] += wv * ca; } }
#pragma unroll
            for (int b = 0; b < 4; ++b) *(LAS f32x4*)(red + ((kg * 32 + cg) * 16 + b * 4)) = acc[b];
            __syncthreads();
            if (F.tid < 128) { const int cg2 = F.tid & 31, b = F.tid >> 5; f32x4 s = {0.f, 0.f, 0.f, 0.f};
#pragma unroll
                for (int g = 0; g < 16; ++g) s += *(LAS f32x4*)(red + ((g * 32 + cg2) * 16 + b * 4));
                const int c2 = ch * 128 + cg2 * 4; const f32x4 bv = *(const f32x4*)(A.in[I_ADAB] + (size_t)l * 12288 + c2);
                *(f32x4*)(mod + ((size_t)l * 4 + b) * 12288 + c2) = s + bv; }
            asm volatile("s_waitcnt vmcnt(0)" ::: "memory");
            __syncthreads();
        }
    }
    {
        LAS float* scr = (LAS float*)(F.lds + F.wave * 16384);
        const int gw = F.vcu * NWAVES + F.wave, NGW = F.G * NWAVES;
        constexpr int I_IN = (DM / 64) * (IN_COLS / 32), I_UQ = (512 / 64) * (1536 / 32), I_UKV = (256 / 64) * (2048 / 32), I_OUT = (DM / 64) * (DM / 32), I_L = I_IN + I_UQ + I_UKV + I_OUT;
        for (int it = gw; it < 2 * I_L; it += NGW) {
            const int l = it / I_L; int r = it % I_L;
            if (r < I_IN) { transpose_item<1>(A.in[I_WIN] + (size_t)l * DM * IN_COLS, IN_COLS, DM, IN_COLS, (bf16*)(F.ws + WS_WIN) + (size_t)l * 4096 * DM, nullptr, scr, r, F.lane); continue; } r -= I_IN;
            if (r < I_UQ) { transpose_item<2>(A.in[I_WUQ] + (size_t)l * 512 * 1536, 1536, 512, 1536, (bf16*)(F.ws + WS_WUQ) + (size_t)l * 1536 * 512, A.in[I_QNG] + l * 512, scr, r, F.lane); continue; } r -= I_UQ;
            if (r < I_UKV) { transpose_item<0>(A.in[I_WUKV] + (size_t)l * 256 * 2048, 2048, 256, 2048, (bf16*)(F.ws + WS_WUKV) + (size_t)l * 2048 * 256, A.in[I_KVNG] + l * 256, scr, r, F.lane); continue; } r -= I_UKV;
#ifdef G3_FP8
            transpose_item8<0>(A.in[I_WOUT] + (size_t)l * DM * DM, DM, DM, DM, F.ws + WS_WOUT + (size_t)l * DM * DM, scr, r, F.lane);
#else
            transpose_item<0>(A.in[I_WOUT] + (size_t)l * DM * DM, DM, DM, DM, (bf16*)(F.ws + WS_WOUT) + (size_t)l * DM * DM, nullptr, scr, r, F.lane);
#endif
        }
    }
    {
        const int gt = F.vcu * (NWAVES * 64) + F.tid, NGT = F.G * NWAVES * 64;
        float* rope = (float*)(F.ws + WS_ROPE);
        for (int e = gt; e < SEQ * 32; e += NGT) { const int pos = e >> 5, i = e & 31;
            const float ang = (float)pos * A.invf[i];
            const double rev = (double)ang * 0.15915494309189535; const float fr = (float)(rev - __builtin_floor(rev));
            *(f32x2*)(rope + (size_t)e * 2) = (f32x2){__builtin_amdgcn_cosf(fr), __builtin_amdgcn_sinf(fr)}; }
        for (int e = gt; e < 2 * 192 * (DM / 8); e += NGT) { const int l = e / (192 * (DM / 8)), r = e % (192 * (DM / 8));
            *(v4u*)((bf16*)(F.ws + WS_WIN) + ((size_t)l * 4096 + IN_COLS) * DM + (size_t)r * 8) = (v4u){0u, 0u, 0u, 0u}; }
    }
}

__device__ __forceinline__ void phase_norm1(Frame& F, const Args& A, int l) {
    const int gw = F.vcu * NWAVES + F.wave, NGW = F.G * NWAVES;
    const float* mod = (const float*)(F.ws + WS_MOD);
    bf16* H = (bf16*)(F.ws + WS_H); const bf16* Y = (const bf16*)(F.ws + WS_Y);
    for (int ch = gw; ch < T / 16; ch += NGW) {
        const int row0 = ch * 16, b = row0 >> 13;
        const float* ml = mod + ((size_t)l * 4 + b) * 12288;
        f32x4 gsc[8], sh[8], g2p[8];
#pragma unroll
        for (int j = 0; j < 8; ++j) { const int c = 4 * F.lane + 256 * j; const f32x4 g = *(const f32x4*)(A.in[I_N1G] + l * DM + c), sc = *(const f32x4*)(ml + 1 * DM + c);
            gsc[j] = g * (sc + 1.0f); sh[j] = *(const f32x4*)(ml + 0 * DM + c);
            if (l > 0) g2p[j] = *(const f32x4*)(mod + ((size_t)(l - 1) * 4 + b) * 12288 + 5 * DM + c); }
#pragma unroll 1
        for (int rr = 0; rr < 16; ++rr) {
            const int row = row0 + rr; f32x4 v[8]; float s = 0.f;
            if (l == 0) {
#pragma unroll
                for (int j = 0; j < 8; ++j) v[j] = *(const f32x4*)(A.in[I_X] + (size_t)row * DM + 4 * F.lane + 256 * j);
            } else {
#pragma unroll
                for (int j = 0; j < 8; ++j) { const int c = 4 * F.lane + 256 * j;
#ifdef XRES_BF16
                    bf16* XB = (bf16*)(F.ws + WS_XB); const v2u xw = *(const v2u*)(XB + (size_t)row * DM + c); const f32x4 xr = {bf_lo(xw.x), bf_hi(xw.x), bf_lo(xw.y), bf_hi(xw.y)};
#else
                    const f32x4 xr = *(const f32x4*)(A.out + (size_t)row * DM + c);
#endif
                    const v2u y0 = *(const v2u*)(Y + (size_t)(2 * row) * DM + c), y1 = *(const v2u*)(Y + (size_t)(2 * row + 1) * DM + c);
                    const f32x4 ys = {bf_lo(y0.x) + bf_lo(y1.x), bf_hi(y0.x) + bf_hi(y1.x), bf_lo(y0.y) + bf_lo(y1.y), bf_hi(y0.y) + bf_hi(y1.y)};
                    v[j] = xr + g2p[j] * ys;
#ifdef XRES_BF16
                    { const v2u ow = {pk2(v[j].x, v[j].y), pk2(v[j].z, v[j].w)}; *(v2u*)(XB + (size_t)row * DM + c) = ow;
                      v[j] = (f32x4){bf_lo(ow.x), bf_hi(ow.x), bf_lo(ow.y), bf_hi(ow.y)}; }
#else
                    *(f32x4*)(A.out + (size_t)row * DM + c) = v[j];
#endif
                }
            }
#pragma unroll
            for (int j = 0; j < 8; ++j) s += (v[j].x * v[j].x + v[j].y * v[j].y) + (v[j].z * v[j].z + v[j].w * v[j].w);
            const float rstd = __builtin_amdgcn_rsqf(wave_sum(s) * (1.f / DM) + EPS);
#pragma unroll
            for (int j = 0; j < 8; ++j) { const f32x4 o = v[j] * rstd * gsc[j] + sh[j];
                *(v2u*)(H + (size_t)row * DM + 4 * F.lane + 256 * j) = (v2u){pk2(o.x, o.y), pk2(o.z, o.w)}; }
        }
    }
#ifndef ATT_CONV
    {
        LAS float* scr = (LAS float*)(F.lds + F.wave * 16384);
        constexpr int I_G = (DM / 64) * (DEXP / 32), I_D = (DEXP / 64) * (DM / 32), I_E = 2 * I_G + I_D;
        for (int it = gw; it < NEXP * I_E; it += NGW) {
            const int e = it / I_E; int r = it % I_E; const size_t eo = ((size_t)l * NEXP + e) * DM * DEXP;
            if (r < I_G) { transpose_item8<3>(A.in[I_EG] + eo, DEXP, DM, DEXP, F.ws + WS_W13 + (size_t)e * 2048 * DM, scr, r, F.lane); continue; } r -= I_G;
            if (r < I_G) { transpose_item8<4>(A.in[I_EU] + eo, DEXP, DM, DEXP, F.ws + WS_W13 + (size_t)e * 2048 * DM, scr, r, F.lane); continue; } r -= I_G;
            transpose_item8<0>(A.in[I_ED] + eo, DM, DEXP, DM, F.ws + WS_W2 + (size_t)e * DM * DEXP, scr, r, F.lane);
        }
    }
#endif
}
__device__ __forceinline__ void phase_final(Frame& F, const Args& A, int probe) {
    const int gw = F.vcu * NWAVES + F.wave, NGW = F.G * NWAVES;
    const float* mod = (const float*)(F.ws + WS_MOD); const bf16* Y = (const bf16*)(F.ws + WS_Y);
    for (int ch = gw; ch < T / 16; ch += NGW) {
        const int row0 = ch * 16, b = row0 >> 13;
        f32x4 fg[8], g2p[8];
#pragma unroll
        for (int j = 0; j < 8; ++j) { const int c = 4 * F.lane + 256 * j; fg[j] = *(const f32x4*)(A.in[I_FG] + c); g2p[j] = *(const f32x4*)(mod + ((size_t)(probe == 3 ? 0 : DEPTH - 1) * 4 + b) * 12288 + 5 * DM + c); }
#pragma unroll 1
        for (int rr = 0; rr < 16; ++rr) {
            const int row = row0 + rr; f32x4 v[8]; float s = 0.f;
#pragma unroll
            for (int j = 0; j < 8; ++j) { const int c = 4 * F.lane + 256 * j;
#ifdef XRES_BF16
                const v2u xw = *(const v2u*)((const bf16*)(F.ws + WS_XB) + (size_t)row * DM + c); const f32x4 xr = {bf_lo(xw.x), bf_hi(xw.x), bf_lo(xw.y), bf_hi(xw.y)};
#else
                const f32x4 xr = *(const f32x4*)((probe == 2 ? A.in[I_X] : A.out) + (size_t)row * DM + c);
#endif
                const v2u y0 = *(const v2u*)(Y + (size_t)(2 * row) * DM + c), y1 = *(const v2u*)(Y + (size_t)(2 * row + 1) * DM + c);
                const f32x4 ys = {bf_lo(y0.x) + bf_lo(y1.x), bf_hi(y0.x) + bf_hi(y1.x), bf_lo(y0.y) + bf_lo(y1.y), bf_hi(y0.y) + bf_hi(y1.y)};
                v[j] = (probe == 1 || probe == 2) ? xr : xr + g2p[j] * ys; }
#pragma unroll
            for (int j = 0; j < 8; ++j) s += (v[j].x * v[j].x + v[j].y * v[j].y) + (v[j].z * v[j].z + v[j].w * v[j].w);
            const float rstd = __builtin_amdgcn_rsqf(wave_sum(s) * (1.f / DM) + EPS);
#pragma unroll
            for (int j = 0; j < 8; ++j) *(f32x4*)(A.out + (size_t)row * DM + 4 * F.lane + 256 * j) = v[j] * rstd * fg[j];
        }
    }
}
#ifndef PROBE_DUMP_SCALE
#define PROBE_DUMP_SCALE 1.0f
#endif
#ifndef PROBE_DUMP_W
#define PROBE_DUMP_W 2048
#endif
__device__ __forceinline__ void phase_dump(Frame& F, const Args& A, size_t off, int pitch) {
    const int gw = F.vcu * NWAVES + F.wave, NGW = F.G * NWAVES;
    for (int row = gw; row < T; row += NGW) { const bf16* src = (const bf16*)(F.ws + off) + (size_t)row * pitch;
#ifdef PROBE_DUMP_F32
        for (int j = 0; j < 8; ++j) { const int c = 4 * F.lane + 256 * j; const float* sf = (const float*)(F.ws + off) + (size_t)row * pitch + c;
#ifdef PROBE_DUMP_SRC_OUT
            sf = A.out + (size_t)row * DM + c;
#endif
            f32x4 o = {0.f, 0.f, 0.f, 0.f}; if (c < PROBE_DUMP_W) o = *(const f32x4*)sf * PROBE_DUMP_SCALE;
#ifdef PROBE_DUMP_LOWBITS
            { const v4u ub = __builtin_bit_cast(v4u, o); o = (f32x4){(float)(ub.x & 0xFFFu), (float)(ub.y & 0xFFFu), (float)(ub.z & 0xFFFu), (float)(ub.w & 0xFFFu)}; }
#endif
            *(f32x4*)(A.out + (size_t)row * DM + c) = o; }
        continue;
#endif
        for (int j = 0; j < 8; ++j) { const int c = 4 * F.lane + 256 * j; const v2u w = *(const v2u*)(src + c);
#ifdef PROBE_DUMP_LOWBITS
            *(f32x4*)(A.out + (size_t)row * DM + c) = c < PROBE_DUMP_W ? (f32x4){(float)(w.x & 0x7Fu), (float)((w.x >> 16) & 0x7Fu), (float)(w.y & 0x7Fu), (float)((w.y >> 16) & 0x7Fu)} : (f32x4){0.f, 0.f, 0.f, 0.f}; } }
#else
            *(f32x4*)(A.out + (size_t)row * DM + c) = c < PROBE_DUMP_W ? (f32x4){bf_lo(w.x), bf_hi(w.x), bf_lo(w.y), bf_hi(w.y)} : (f32x4){0.f, 0.f, 0.f, 0.f}; } }
#endif
}
__device__ __forceinline__ void phase_mla_prep(Frame& F, const Args& A) {
    const int gw = F.vcu * NWAVES + F.wave, NGW = F.G * NWAVES;
    const bf16* P = (const bf16*)(F.ws + WS_PROJ); bf16* KF = (bf16*)(F.ws + WS_KF);
    float* rq = (float*)(F.ws + WS_RSTDQ); float* rkv = (float*)(F.ws + WS_RSTDKV); const float* rope = (const float*)(F.ws + WS_ROPE);
    for (int ch = gw; ch < T / 16; ch += NGW) {
#pragma unroll 1
        for (int r4 = 0; r4 < 16; r4 += 4) {
            v4u q[4]; v2u kv[4]; unsigned kr[4]; f32x2 cs[4];
#pragma unroll
            for (int u = 0; u < 4; ++u) { const int row = ch * 16 + r4 + u; const bf16* pr = P + (size_t)row * PROJ_LD;
                q[u] = *(const v4u*)(pr + C_CQ + 8 * F.lane); kv[u] = *(const v2u*)(pr + C_CKV + 4 * F.lane);
                kr[u] = *(const unsigned*)(pr + C_KR + 2 * (F.lane & 31)); cs[u] = *(const f32x2*)(rope + ((size_t)(row & (SEQ - 1)) * 32 + (F.lane & 31)) * 2); }
#pragma unroll
            for (int u = 0; u < 4; ++u) { const int row = ch * 16 + r4 + u;
                float sq = 0.f, skv = 0.f;
#pragma unroll
                for (int i = 0; i < 4; ++i) { const float a = bf_lo(q[u][i]), b2 = bf_hi(q[u][i]); sq += a * a + b2 * b2; }
#pragma unroll
                for (int i = 0; i < 2; ++i) { const float a = bf_lo(kv[u][i]), b2 = bf_hi(kv[u][i]); skv += a * a + b2 * b2; }
                sq = wave_sum(sq); skv = wave_sum(skv);
                if (F.lane == 0) { rq[row] = __builtin_amdgcn_rsqf(sq * (1.f / 512.f) + EPS); rkv[row] = __builtin_amdgcn_rsqf(skv * (1.f / 256.f) + EPS); }
                if (F.lane < 32) { const float x1 = bf_lo(kr[u]), x2 = bf_hi(kr[u]);
                    const unsigned o = pk2(x1 * cs[u].x - x2 * cs[u].y, x2 * cs[u].x + x1 * cs[u].y);
#pragma unroll
                    for (int h = 0; h < 8; ++h) *(unsigned*)(KF + (size_t)row * 1536 + h * 192 + 128 + 2 * F.lane) = o; } }
        }
    }
}
__device__ __forceinline__ void phase_q_rope(Frame& F, const Args& A) {
    const int gw = F.vcu * NWAVES + F.wave, NGW = F.G * NWAVES;
    bf16* QA = (bf16*)(F.ws + WS_QA); const float* rope = (const float*)(F.ws + WS_ROPE);
    for (int ch = gw; ch < T / 16; ch += NGW) {
#pragma unroll 1
        for (int r4 = 0; r4 < 16; r4 += 4) {
            v4u w[4]; f32x4 c01[4], c23[4];
#pragma unroll
            for (int u = 0; u < 4; ++u) { const int row = ch * 16 + r4 + u;
                w[u] = *(const v4u*)(QA + (size_t)row * 1536 + (F.lane >> 3) * 192 + 128 + (F.lane & 7) * 8);
                const f32x4* cs = (const f32x4*)(rope + ((size_t)(row & (SEQ - 1)) * 32 + (F.lane & 7) * 4) * 2); c01[u] = cs[0]; c23[u] = cs[1]; }
#pragma unroll
            for (int u = 0; u < 4; ++u) { const int row = ch * 16 + r4 + u; v4u o;
                { const float x1 = bf_lo(w[u].x), x2 = bf_hi(w[u].x); o.x = pk2(x1 * c01[u][0] - x2 * c01[u][1], x2 * c01[u][0] + x1 * c01[u][1]); }
                { const float x1 = bf_lo(w[u].y), x2 = bf_hi(w[u].y); o.y = pk2(x1 * c01[u][2] - x2 * c01[u][3], x2 * c01[u][2] + x1 * c01[u][3]); }
                { const float x1 = bf_lo(w[u].z), x2 = bf_hi(w[u].z); o.z = pk2(x1 * c23[u][0] - x2 * c23[u][1], x2 * c23[u][0] + x1 * c23[u][1]); }
                { const float x1 = bf_lo(w[u].w), x2 = bf_hi(w[u].w); o.w = pk2(x1 * c23[u][2] - x2 * c23[u][3], x2 * c23[u][2] + x1 * c23[u][3]); }
                *(v4u*)(QA + (size_t)row * 1536 + (F.lane >> 3) * 192 + 128 + (F.lane & 7) * 8) = o; }
        }
    }
}
__device__ __forceinline__ void phase_out_norm(Frame& F, const Args& A, int l) {
    const int gw = F.vcu * NWAVES + F.wave, NGW = F.G * NWAVES;
    const bf16* OA = (const bf16*)(F.ws + WS_OA); const bf16* OB = (const bf16*)(F.ws + WS_OB); const float* LSE = (const float*)(F.ws + WS_LSE); bf16* Yn = (bf16*)(F.ws + WS_H);
    for (int ch = gw; ch < T / 16; ch += NGW) {
        float ga[2][8], gb[2][8];
#pragma unroll
        for (int hf = 0; hf < 2; ++hf)
#pragma unroll
            for (int i = 0; i < 8; ++i) { ga[hf][i] = A.in[I_ONA][l * 1024 + hf * 512 + 8 * F.lane + i]; gb[hf][i] = A.in[I_ONB][l * 1024 + hf * 512 + 8 * F.lane + i]; }
#pragma unroll 1
        for (int rr = 0; rr < 16; ++rr) {
            const int row = ch * 16 + rr;
            float va[2][8], vb[2][8]; float sa = 0.f, sb = 0.f;
#pragma unroll
            for (int hf = 0; hf < 2; ++hf) {
                const int c = hf * 512 + 8 * F.lane, hd = c >> 7;
                const v4u a = *(const v4u*)(OA + (size_t)row * 1024 + c);
#pragma unroll
                for (int i = 0; i < 4; ++i) { va[hf][2 * i] = bf_lo(a[i]); va[hf][2 * i + 1] = bf_hi(a[i]); }
                const float l0 = LSE[((size_t)0 * T + row) * 8 + hd], l1 = LSE[((size_t)1 * T + row) * 8 + hd], l2 = LSE[((size_t)2 * T + row) * 8 + hd];
                const float mx = fmaxf(l0, fmaxf(l1, l2)); const float e0 = __expf(l0 - mx), e1 = __expf(l1 - mx), e2 = __expf(l2 - mx); const float inv = 1.0f / (e0 + e1 + e2);
                const float al[3] = {e0 * inv, e1 * inv, e2 * inv};
#pragma unroll
                for (int i = 0; i < 8; ++i) vb[hf][i] = 0.f;
#pragma unroll
                for (int n = 0; n < 3; ++n) { const v4u o = *(const v4u*)(OB + ((size_t)n * T + row) * 1024 + c);
#pragma unroll
                    for (int i = 0; i < 4; ++i) { vb[hf][2 * i] += al[n] * bf_lo(o[i]); vb[hf][2 * i + 1] += al[n] * bf_hi(o[i]); } }
#pragma unroll
                for (int i = 0; i < 8; ++i) { sa += va[hf][i] * va[hf][i]; sb += vb[hf][i] * vb[hf][i]; }
            }
            const float ra = __builtin_amdgcn_rsqf(wave_sum(sa) * (1.f / 1024.f) + EPS), rb = __builtin_amdgcn_rsqf(wave_sum(sb) * (1.f / 1024.f) + EPS);
#pragma unroll
            for (int hf = 0; hf < 2; ++hf) { const int c = hf * 512 + 8 * F.lane; v4u wa, wb;
#pragma unroll
                for (int i = 0; i < 4; ++i) { wa[i] = pk2(va[hf][2 * i] * ra * ga[hf][2 * i], va[hf][2 * i + 1] * ra * ga[hf][2 * i + 1]); wb[i] = pk2(vb[hf][2 * i] * rb * gb[hf][2 * i], vb[hf][2 * i + 1] * rb * gb[hf][2 * i + 1]); }
#ifdef G3_FP8
                { unsigned char* Y8 = (unsigned char*)Yn; float ya[8], yb[8];
#pragma unroll
                  for (int i = 0; i < 8; ++i) { ya[i] = va[hf][i] * ra * ga[hf][i]; yb[i] = vb[hf][i] * rb * gb[hf][i]; }
                  *(v2u*)(Y8 + (size_t)row * DM + c) = (v2u){pk4_fp8(ya[0], ya[1], ya[2], ya[3]), pk4_fp8(ya[4], ya[5], ya[6], ya[7])};
                  *(v2u*)(Y8 + (size_t)row * DM + 1024 + c) = (v2u){pk4_fp8(yb[0], yb[1], yb[2], yb[3]), pk4_fp8(yb[4], yb[5], yb[6], yb[7])}; }
#else
                *(v4u*)(Yn + (size_t)row * DM + c) = wa; *(v4u*)(Yn + (size_t)row * DM + 1024 + c) = wb;
#endif
            }
        }
    }
}
#ifndef ROUTER_SRC
#define ROUTER_SRC A.out
#endif
__device__ __forceinline__ void phase_router(Frame& F, const Args& A, int l, int dummy = 0) {
    const float* mod = (const float*)(F.ws + WS_MOD);
    bf16* H = (bf16*)(F.ws + WS_H);
    LAS f32x4* rwl = (LAS f32x4*)F.lds;
    LAS int* lcnt = (LAS int*)(F.lds + L_CNT); LAS int* gbase = lcnt + 16; LAS int* tokinfo = (LAS int*)(F.lds + L_TOK);
    unsigned* gcnt = F.ctl + CW_CNT + (dummy ? 3 : l) * 16;
    int* rowidx = (int*)(F.ws + (dummy ? WS_OB : WS_ROWIDX)); float* aw = (float*)(F.ws + (dummy ? WS_OB + 4 * MiB : WS_AW));
    for (int q = F.tid; q < 8192; q += NWAVES * 64) { const int k = q >> 2, e4 = q & 3, ln = (k & 255) >> 2, j = k >> 8, i = k & 3;
        rwl[((j * 4 + i) * 4 + e4) * 64 + ln] = *(const f32x4*)(A.in[I_RW] + (size_t)k * 16 + e4 * 4); }
    float rb[16];
#pragma unroll
    for (int e = 0; e < 16; ++e) rb[e] = __uint_as_float(__builtin_amdgcn_readfirstlane(__float_as_uint(A.in[I_RB][e])));
    __syncthreads();
    for (int bi = F.vcu; bi < T / 128; bi += F.G) {
        { const int t0_ = F.wave * 64 + lane_id(); if (t0_ < 16) lcnt[t0_] = 0; }
        __syncthreads();
        const int row0 = bi * 128 + F.wave * 16, b = row0 >> 13;
        const rsrc_t rml = RSRC(mod + ((size_t)l * 4 + b) * 12288), rgn = RSRC(A.in[I_N2G] + l * DM), rx = RSRC(ROUTER_SRC), rh = RSRC(H);
#ifdef XRES_BF16
        const rsrc_t rxb = RSRC(F.ws + WS_XB);
#endif
        const int lo16 = F.lane * 16, lo8 = F.lane * 8;
        float cst[16];
        { f32x4 ca[4] = {};
#pragma unroll
          for (int j = 0; j < 8; ++j) { const f32x4 sh = bld4f(rml, lo16 + j * 1024, 3 * DM * 4);
#pragma unroll
            for (int i = 0; i < 4; ++i)
#pragma unroll
                for (int e4 = 0; e4 < 4; ++e4) ca[e4] += rwl[((j * 4 + i) * 4 + e4) * 64 + F.lane] * sh[i];
            asm volatile("" ::: "memory"); }
#pragma unroll
          for (int e = 0; e < 16; ++e) cst[e] = __uint_as_float(__builtin_amdgcn_readfirstlane(__float_as_uint(wave_sum(ca[e >> 2][e & 3])))); }
        f32x4 gsv[8];
#pragma unroll
        for (int j = 0; j < 8; ++j) gsv[j] = bld4f(rgn, lo16 + j * 1024, 0) * (bld4f(rml, lo16 + j * 1024, 4 * DM * 4) + 1.0f);
#pragma unroll 1
        for (int rp = 0; rp < 8; ++rp) {
            float ss[2] = {0.f, 0.f}; f32x4 acc[2][4] = {};
            const int so0 = (row0 + rp * 2) * (DM * 4);
#ifdef XRES_BF16
            v2u xraw[2][8];
#pragma unroll
            for (int q = 0; q < 2; ++q)
#pragma unroll
                for (int j = 0; j < 8; ++j) xraw[q][j] = bld2u(rxb, lo8 + j * 512, (row0 + rp * 2 + q) * (DM * 2));
#define XV(q, j) ((f32x4){bf_lo(xraw[q][j].x), bf_hi(xraw[q][j].x), bf_lo(xraw[q][j].y), bf_hi(xraw[q][j].y)})
#else
            f32x4 xv[2][8];
#pragma unroll
            for (int q = 0; q < 2; ++q)
#pragma unroll
                for (int j = 0; j < 8; ++j) xv[q][j] = bld4f(rx, lo16 + j * 1024, so0 + q * (DM * 4));
#define XV(q, j) xv[q][j]
#endif
#pragma unroll
            for (int j = 0; j < 8; ++j) {
                f32x4 a[2];
#pragma unroll
                for (int q = 0; q < 2; ++q) { const f32x4 x = XV(q, j); ss[q] += (x.x * x.x + x.y * x.y) + (x.z * x.z + x.w * x.w); a[q] = x * gsv[j]; }
#pragma unroll
                for (int i = 0; i < 4; ++i) {
#pragma unroll
                    for (int e4 = 0; e4 < 4; ++e4) { const f32x4 w = rwl[((j * 4 + i) * 4 + e4) * 64 + F.lane]; acc[0][e4] += w * a[0][i]; acc[1][e4] += w * a[1][i]; }
                    asm volatile("" : "+v"(acc[0][0]), "+v"(acc[0][1]), "+v"(acc[0][2]), "+v"(acc[0][3]), "+v"(acc[1][0]), "+v"(acc[1][1]), "+v"(acc[1][2]), "+v"(acc[1][3]) :: "memory"); } }
            float rstd[2];
#pragma unroll
            for (int q = 0; q < 2; ++q) rstd[q] = __builtin_amdgcn_rsqf(wave_sum(ss[q]) * (1.f / DM) + EPS);
            asm volatile("" ::: "memory");
            f32x4 shv[8];
#pragma unroll
            for (int j = 0; j < 8; ++j) shv[j] = bld4f(rml, lo16 + j * 1024, 3 * DM * 4);
#pragma unroll
            for (int j = 0; j < 8; ++j) {
#pragma unroll
                for (int q = 0; q < 2; ++q) { const f32x4 o = XV(q, j) * rstd[q] * gsv[j] + shv[j]; __builtin_amdgcn_raw_buffer_store_b32(pk4_fp8(o.x, o.y, o.z, o.w), rh, F.lane * 4 + j * 256, (row0 + rp * 2 + q) * DM, 0); } }
#undef XV
#pragma unroll
            for (int q = 0; q < 2; ++q) {
                float sc[16], bs[16];
#pragma unroll
                for (int e = 0; e < 16; ++e) { const float lg = wave_sum(acc[q][e >> 2][e & 3]) * rstd[q] + cst[e]; sc[e] = 1.0f / (1.0f + __expf(-lg)); bs[e] = sc[e] + rb[e]; }
                float gs4[4];
#pragma unroll
                for (int g = 0; g < 4; ++g) { const float a = bs[4 * g], b2 = bs[4 * g + 1], c = bs[4 * g + 2], d = bs[4 * g + 3];
                    const float h1 = fmaxf(a, b2), l1 = fminf(a, b2), h2 = fmaxf(c, d), l2 = fminf(c, d);
                    gs4[g] = fmaxf(h1, h2) + fmaxf(fminf(h1, h2), fmaxf(l1, l2)); }
                int gsel = 0; float gbest = gs4[0];
#pragma unroll
                for (int g = 1; g < 4; ++g) if (gs4[g] > gbest) { gbest = gs4[g]; gsel = g; }
                float bv[4], sv[4];
#pragma unroll
                for (int i = 0; i < 4; ++i) { bv[i] = gsel == 0 ? bs[i] : gsel == 1 ? bs[4 + i] : gsel == 2 ? bs[8 + i] : bs[12 + i]; sv[i] = gsel == 0 ? sc[i] : gsel == 1 ? sc[4 + i] : gsel == 2 ? sc[8 + i] : sc[12 + i]; }
                int i1 = 0; float b1 = bv[0], s1 = sv[0];
#pragma unroll
                for (int i = 1; i < 4; ++i) if (bv[i] > b1) { b1 = bv[i]; s1 = sv[i]; i1 = i; }
                int i2 = -1; float b2v = -__builtin_inff(), s2 = 0.f;
#pragma unroll
                for (int i = 0; i < 4; ++i) if (i != i1 && bv[i] > b2v) { b2v = bv[i]; s2 = sv[i]; i2 = i; }
                const float inv = 1.0f / (s1 + s2);
                if (F.lane == 0) {
                    const int r = F.wave * 16 + rp * 2 + q, e0 = gsel * 4 + i1, e1 = gsel * 4 + i2;
                    tokinfo[r * 4 + 0] = e0; tokinfo[r * 4 + 2] = e1;
                    const int row = row0 + rp * 2 + q; *(f32x2*)(aw + (size_t)row * 2) = (f32x2){s1 * inv, s2 * inv};
                }
            }
        }
        __syncthreads();
        const int tb_ = F.wave * 64 + lane_id();
        if (tb_ < 16) {
            int c = 0;
            for (int r = 0; r < 128; ++r) { if (tokinfo[r * 4 + 0] == tb_) tokinfo[r * 4 + 1] = c++; if (tokinfo[r * 4 + 2] == tb_) tokinfo[r * 4 + 3] = c++; }
            gbase[tb_] = (int)__hip_atomic_fetch_add(gcnt + tb_, (unsigned)c, __ATOMIC_RELAXED, __HIP_MEMORY_SCOPE_AGENT); }
        __syncthreads();
        if (tb_ < 128) { const int e0 = tokinfo[tb_ * 4], p0 = tokinfo[tb_ * 4 + 1], e1 = tokinfo[tb_ * 4 + 2], p1 = tokinfo[tb_ * 4 + 3]; const int row = bi * 128 + tb_;
            rowidx[(size_t)e0 * 32768 + gbase[e0] + p0] = 2 * row; rowidx[(size_t)e1 * 32768 + gbase[e1] + p1] = 2 * row + 1; }
        __syncthreads();
    }
}
__device__ __forceinline__ int moe_setup(Frame& F, int l) {
    LAS int* ts = (LAS int*)(F.lds + L_TS);
    if (F.tid == 0) { int s = 0; for (int e = 0; e < 16; ++e) { ts[e] = s; s += ((int)__hip_atomic_load(F.ctl + CW_CNT + l * 16 + e, __ATOMIC_RELAXED, __HIP_MEMORY_SCOPE_AGENT) + 255) >> 8; } ts[16] = s; }
    __syncthreads();
    return __builtin_amdgcn_readfirstlane(ts[16]);
}

__device__ __forceinline__ att::Blk mla_blk(int bh, int qb) {
    const int b = bh >> 3, h = bh & 7; att::Blk k;
    k.qo = (unsigned)(WS_QA + ((size_t)b * SEQ * 1536 + h * 192) * 2); k.ko = (unsigned)(WS_KF + ((size_t)b * SEQ * 1536 + h * 192) * 2);
    k.vo = (unsigned)(WS_VB + ((size_t)b * SEQ * 1024 + h * 128) * 2); k.oo = (unsigned)(WS_OA + ((size_t)b * SEQ * 1024 + h * 128) * 2); k.lo = 0;
    k.P0 = qb * 256; k.rate = 1; k.beta = 0.f;
    return k;
}
__device__ __forceinline__ att::Blk dil_blk(int bh, int br, int blk) {
    const int b = bh >> 3, h = bh & 7, rate = br == 0 ? 1 : br == 1 ? 4 : 16, nqb = 32 / rate, cls = blk / nqb, qb = blk % nqb; att::Blk k;
    const size_t tok0 = (size_t)b * SEQ + cls;
    const unsigned p = (unsigned)(WS_PROJ + (tok0 * PROJ_LD + h * 128) * 2);
    k.qo = p + C_QB * 2; k.ko = p + C_KB * 2; k.vo = p + C_VB * 2;
    k.oo = (unsigned)(WS_OB + (((size_t)br * T + tok0) * 1024 + h * 128) * 2);
    k.lo = (unsigned)(WS_LSE + (((size_t)br * T + tok0) * 8 + h) * 4);
    k.P0 = qb * 256; k.rate = rate;
    const float slope = __builtin_amdgcn_exp2f(-(float)(h + 1));
    k.beta = slope * (float)rate * 11.313708498984761f;
    return k;
}
__device__ __forceinline__ void mla_decode(int id, int& bh, int& qb0, int& qb1) {
    const int v = id & 255, i = id >> 8, x = v >> 5, c = v & 31, j = i * 32 + c; bh = 4 * x + (j >> 4); const int s = j & 15; qb0 = s; qb1 = 31 - s;
}
__device__ __forceinline__ void dil_decode(int id, int& bh, int& br, int& blk) {
    const int v = id & 255, i = id >> 8, x = v >> 5, c = v & 31, j = i * 32 + c; bh = 4 * x + j / 96; const int r = j % 96; br = r >> 5; blk = r & 31;
}
#ifndef ATT_DIL_NS
#define ATT_DIL_NS 4
#endif
#ifndef ATT_SKEW_SEL
#define ATT_SKEW_SEL 0
#endif
#if ATT_SKEW_SEL == 0
#define ATT_SKEW_PICK(w) ((w) < 4)
#elif ATT_SKEW_SEL == 1
#define ATT_SKEW_PICK(w) (((w) & 1) == 0)
#elif ATT_SKEW_SEL == 2
#define ATT_SKEW_PICK(w) true
#else
#define ATT_SKEW_PICK(w) false
#endif
#ifdef ATT_DMA
#define ATT_SEAM(d) att::SeamD<d>
#define ATT_DMA_ON ATT_DMA
#else
#define ATT_SEAM(d) att::Seam<d>
#define ATT_DMA_ON 0
#endif
#if ATT_DMA_ON == 2
template <int ORD>
__device__ __forceinline__ void mla_stream2(Frame& F, char* lds) {
    constexpr int NIT = 512;
    int id = F.vcu;
    if (id < NIT) {
        att::SeamD<192> S; int bh, q0, q1; mla_decode(id, bh, q0, q1); int pass = 0;
        att::Blk cur = mla_blk(bh, q0);
        att::att_prime_dma2<192, false>(cur, (const char*)F.ws, lds, S, F.tid);
        for (;;) {
            const bool more_pass = pass == 0, more_item = id + F.G < NIT, last = !more_pass && !more_item;
            att::Blk nxt = cur; int idn = id, passn = pass + 1;
            if (more_pass) nxt = mla_blk(bh, q1);
            else if (more_item) { idn = id + F.G; passn = 0; mla_decode(idn, bh, q0, q1); nxt = mla_blk(bh, q0); }
            att::att_block_dma2<192, false, false, ORD>(cur, nxt, (const char*)F.ws, lds, S, F.tid);
            if (last) break;
            cur = nxt; id = idn; pass = passn;
        }
    }
}
template <int ORD>
__device__ __forceinline__ void dil_stream2(Frame& F, char* lds) {
    constexpr int NIT = 3072;
    int id = F.vcu;
    if (id < NIT) {
        att::SeamD<128> S; int bh, br, blk; dil_decode(id, bh, br, blk);
        att::Blk cur = dil_blk(bh, br, blk);
        att::att_prime_dma2<128, true>(cur, (const char*)F.ws, lds, S, F.tid);
        for (;;) {
            const bool last = id + F.G >= NIT;
            att::Blk nxt = cur;
            if (!last) { dil_decode(id + F.G, bh, br, blk); nxt = dil_blk(bh, br, blk); }
            att::att_block_dma2<128, true, true, ORD>(cur, nxt, (const char*)F.ws, lds, S, F.tid);
            if (last) break;
            cur = nxt; id += F.G;
        }
    }
}
#endif
template <int PV>
__device__ __forceinline__ void dil_stream_reg(Frame& F, char* lds, int rep_) {
        constexpr int NIT = 3072;
        int id = F.vcu;
        if (id < NIT) {
#if ATT_DMA_ON == 1
            att::SeamD<128> S;
#else
            att::Seam<128> S;
#endif
            int bh, br, blk; dil_decode(id, bh, br, blk);
            att::Blk cur = dil_blk(bh, br, blk);
#if ATT_DMA_ON == 1
            att::att_prime_dma<128, true, ATT_DIL_NS>(cur, (const char*)F.ws, lds, S, F.tid);
#else
            att::att_prime<128, true, PV>(cur, (const char*)F.ws, lds, S, F.tid);
#endif
            for (;;) {
                const bool last = id + F.G >= NIT;
                att::Blk nxt = cur;
                if (!last) { dil_decode(id + F.G, bh, br, blk); nxt = dil_blk(bh, br, blk); }
#if ATT_DMA_ON == 1
                att::att_block_dma<128, true, true, ATT_DIL_NS>(cur, nxt, (const char*)F.ws, lds, lds + RING_BYTES + 512, S, F.tid);
#else
                att::att_block<128, true, true, PV>(cur, nxt, (const char*)F.ws, lds, S, F.tid);
#endif
                if (last) break;
                cur = nxt; id += F.G;
            }
#if defined(ATT_DEFER) && ATT_DMA_ON != 1
            if (S.p_on) { const int ln_ = F.tid & 63; const char* stg_ = lds + att::DEFER_STG + __builtin_amdgcn_readfirstlane(F.tid >> 6) * 8192;
#pragma unroll
                for (int p = 0; p < 8; ++p) att::flush_piece(stg_, p, (const char*)F.ws + S.p_oo, S.p_rb, S.p_so0, ln_); }
#endif
        }
}
static_assert(WS_ROPE == att::ROPE_OFF, "rope table offset");
__device__ __forceinline__ void phase_attention(Frame& F, char* lds, const Args& A, int l) {
#ifdef ATT_PRIO
    if (__builtin_amdgcn_readfirstlane(F.tid >> 6) >= 4) __builtin_amdgcn_s_setprio(1);
#endif
#ifndef NO_MLA
#ifndef PROBE_REP_MLA
#define PROBE_REP_MLA 1
#endif
    for (int rep_ = 0; rep_ < PROBE_REP_MLA; ++rep_) {
        if (rep_) __syncthreads();
#if ATT_DMA_ON == 2
        { const int wsel_ = __builtin_amdgcn_readfirstlane(F.tid >> 6);
          if (ATT_SKEW_PICK(wsel_)) mla_stream2<0>(F, lds); else mla_stream2<1>(F, lds); }
#else
        constexpr int NIT = 512;
        int id = F.vcu;
        if (id < NIT) {
            ATT_SEAM(192) S; int bh, q0, q1; mla_decode(id, bh, q0, q1); int pass = 0;
            att::Blk cur = mla_blk(bh, q0);
#ifdef ATT_CONV
            const size_t eo_ = (size_t)l * NEXP * DM * DEXP;
            const att::ConvCtx X = {A.in[I_EG] + eo_, A.in[I_EU] + eo_, A.in[I_ED] + eo_, F.ws + WS_W13, F.ws + WS_W2, F.vcu * 8 + __builtin_amdgcn_readfirstlane(F.tid >> 6)};
#endif
#if ATT_DMA_ON
            att::att_prime_dma<192, false, 3>(cur, (const char*)F.ws, lds, S, F.tid);
#else
#ifdef ATT_QROPE
            att::att_prime<192, false, 0, true>(cur, (const char*)F.ws, lds, S, F.tid);
#else
            att::att_prime<192, false>(cur, (const char*)F.ws, lds, S, F.tid);
#endif
#endif
            for (;;) {
                const bool more_pass = pass == 0, more_item = id + F.G < NIT, last = !more_pass && !more_item;
                att::Blk nxt = cur; int idn = id, passn = pass + 1;
                if (more_pass) nxt = mla_blk(bh, q1);
                else if (more_item) { idn = id + F.G; passn = 0; mla_decode(idn, bh, q0, q1); nxt = mla_blk(bh, q0); }
#if ATT_DMA_ON
                att::att_block_dma<192, false, false, 3>(cur, nxt, (const char*)F.ws, lds, lds + 3 * att::SHM_V + 3 * att::Cfg<192>::SHM_K, S, F.tid);
#else
#ifdef ATT_CONV
                att::att_block<192, false, false, 0, true>(cur, nxt, (const char*)F.ws, lds, S, F.tid, &X);
#elif defined(ATT_QROPE)
                att::att_block<192, false, false, 0, false, true>(cur, nxt, (const char*)F.ws, lds, S, F.tid);
#else
                att::att_block<192, false, false>(cur, nxt, (const char*)F.ws, lds, S, F.tid);
#endif
#endif
                if (last) break;
                cur = nxt; id = idn; pass = passn;
            }
#ifdef ATT_CONV
            { const int ln_ = lane_id(); char* scr_ = lds + att::CONV_SCR + __builtin_amdgcn_readfirstlane(F.tid >> 6) * 4352;
              while (S.cv_j < att::CONV_NJ) { att::conv_load(X, S.cv_j, S.cv_q, S.cv, ln_); asm volatile("s_waitcnt vmcnt(0)" ::: "memory");
                  att::conv_put(X, S.cv_j, S.cv_q, S.cv, scr_, ln_); if (++S.cv_q == 4) { S.cv_q = 0; ++S.cv_j; } S.cl_j = S.cv_j; S.cl_q = S.cv_q; } }
#endif
        }
#endif
    }
#endif
#ifndef NO_DIL
#ifndef PROBE_REP_DIL
#define PROBE_REP_DIL 1
#endif
#ifndef PROBE_DIL_VAR
#define PROBE_DIL_VAR 0
#endif
#if ATT_DMA_ON == 2 && !defined(ATT_DIL_DMA2)
    asm volatile("s_waitcnt vmcnt(0)" ::: "memory"); __syncthreads();
#endif
    for (int rep_ = 0; rep_ < PROBE_REP_DIL; ++rep_) {
        if (rep_) __syncthreads();
#if ATT_DMA_ON == 2 && defined(ATT_DIL_DMA2)
        { const int wsel_ = __builtin_amdgcn_readfirstlane(F.tid >> 6);
          if (ATT_SKEW_PICK(wsel_)) dil_stream2<0>(F, lds); else dil_stream2<1>(F, lds); }
#else
        if (rep_ + 1 < PROBE_REP_DIL) dil_stream_reg<PROBE_DIL_VAR>(F, lds, rep_); else dil_stream_reg<0>(F, lds, rep_);
#endif
    }
#endif
#ifdef ATT_PRIO
    __builtin_amdgcn_s_setprio(0);
#endif
}
#ifndef MK_PER_PHASE
#define MK_PER_PHASE 0
#endif
constexpr int NPH = 2 + 11 * DEPTH;
__global__ void __launch_bounds__(NWAVES * 64, 2) mk_fwd(Args args) {
    extern __shared__ __attribute__((aligned(16))) unsigned char lds[];
    Frame F;
    F.lds = (LAS unsigned char*)lds; F.ldsg = lds;
    F.wave = __builtin_amdgcn_readfirstlane((int)threadIdx.x >> 6); F.lane = lane_id(); F.tid = F.wave * 64 + F.lane;
    F.G = gridDim.x; { const int bx = blockIdx.x; F.vcu = (F.G % 8 == 0) ? (bx % 8) * (F.G / 8) + bx / 8 : bx; }
    F.ws = args.ws; F.ctl = (unsigned*)(args.ws + WS_CTL);
    for (int u = F.tid; u < (LDS_BYTES - RING_BYTES) / 4; u += NWAVES * 64) ((LAS unsigned*)(F.lds + RING_BYTES))[u] = 0u;
    __syncthreads();
    volatile LAS unsigned* MISC = (volatile LAS unsigned*)(F.lds + L_MISC);
    XcdBarrier bar; bar.bar = F.ctl + CW_BAR; bar.x = 0; bar.st = nullptr;
    if (!MK_PER_PHASE) bar = xcd_barrier_post(F.ctl + CW_BAR, MISC + 8, F.tid);
    const int lo = args.ph_lo, hi = args.ph_hi;
#ifndef PROBE_GRID1_PHASE
#define PROBE_GRID1_PHASE (-1)
#endif
#define PROBE_GRID1(p) ((p) == PROBE_GRID1_PHASE)
#ifndef PROBE_MODE
#define PROBE_MODE 1
#endif
#ifndef PROBE_REP_MASK
#define PROBE_REP_MASK 0
#endif
#define NREP(j) ((((PROBE_REP_MASK) >> (j)) & 1) ? 2 : 1)
#ifndef PROBE_XIN
#define PROBE_XIN 0
#endif
#ifndef PH_MASK
#define PH_MASK 0x1FFF
#endif
#define IN(k) (lo <= (k) && (k) < hi)
#define MSK(j) (((PH_MASK) >> (j)) & 1)
#define FRESH(Fp) Frame Fp = F; { int l_ = lane_id(); int z_ = 0; asm volatile("" : "+v"(l_), "+s"(z_)); Fp.lane = l_; Fp.wave = F.wave + z_; Fp.tid = Fp.wave * 64 + l_; Fp.vcu = F.vcu + z_; Fp.ws = F.ws + z_; Fp.ctl = (unsigned*)(Fp.ws + WS_CTL); }
#define SEAM(k) do { if (IN(k) && IN((k) + 1)) xcd_barrier(bar, F.wave * 64 + lane_id()); } while (0)

    if (MSK(11) && IN(0)) { FRESH(P); phase_prologue(P, args);
#ifdef PROBE_REPEAT_PROLOGUE
        __syncthreads(); phase_prologue(P, args);
#endif
    }
    SEAM(0);
    for (int l = 0; l < DEPTH; ++l) {
        const int pb = 1 + 11 * l;
        const float* mod = (const float*)(F.ws + WS_MOD);
        if (MSK(0) && IN(pb + 0)) { for (int rep_ = 0; rep_ < (l == 0 ? NREP(0) : 1); ++rep_) { if (rep_) __syncthreads(); FRESH(P); phase_norm1(P, args, l); } }
        SEAM(pb + 0);
        if (MSK(1) && IN(pb + 1)) { for (int rep_ = 0; rep_ < NREP(1); ++rep_) { if (rep_) __syncthreads(); FRESH(P);
            pg8::Gemm g{(const bf16*)(P.ws + WS_H), (const bf16*)(P.ws + WS_WIN) + (size_t)l * 4096 * DM, DM * 2};
            pg8::StaticOrder S; S.init(T, PROJ_LD, P.G, (int)blockIdx.x);
            pg8::EpiPlain E{(bf16*)(P.ws + WS_PROJ), PROJ_LD};
            pg8::gemm_phase<pg8::EpiPlain, pg8::StaticOrder, pg8::ALinear>(P.lds, g, S, pg8::ALinear{}, E, P.tid);
        } }
        SEAM(pb + 1);
#ifdef PROBE_EXTRA_BARRIERS
        if (IN(pb + 2)) for (int xb_ = 0; xb_ < PROBE_EXTRA_BARRIERS; ++xb_) xcd_barrier(bar, F.wave * 64 + lane_id());
#endif
        if (MSK(2) && IN(pb + 2)) { for (int rep_ = 0; rep_ < NREP(2); ++rep_) { if (rep_) __syncthreads(); FRESH(P); phase_mla_prep(P, args); } }
        SEAM(pb + 2);
        if (MSK(3) && IN(pb + 3)) { for (int rep_ = 0; rep_ < NREP(3); ++rep_) { if (rep_) __syncthreads(); FRESH(P);
#ifdef PROBE_SWAP_UP
            { pg8::Gemm g{(const bf16*)(P.ws + WS_PROJ) + C_CKV, (const bf16*)(P.ws + WS_WUKV) + (size_t)l * 2048 * 256, 256 * 2};
              pg8::StaticOrder S; S.init(T, 2048, P.G, (int)blockIdx.x);
              pg8::EpiKVup E{(bf16*)(P.ws + WS_KF), (bf16*)(P.ws + WS_VB), (const float*)(P.ws + WS_RSTDKV)};
              pg8::gemm_phase<pg8::EpiKVup, pg8::StaticOrder, pg8::APitch>(P.lds, g, S, pg8::APitch{PROJ_LD * 2}, E, P.tid); }
            { pg8::Gemm g{(const bf16*)(P.ws + WS_PROJ) + C_CQ, (const bf16*)(P.ws + WS_WUQ) + (size_t)l * 1536 * 512, 512 * 2};
              pg8::StaticOrder S; S.init(T, 1536, P.G, (int)blockIdx.x);
              pg8::EpiQup E{(bf16*)(P.ws + WS_QA), (const float*)(P.ws + WS_RSTDQ)};
#ifdef PROBE_QUP_PLAIN
              { pg8::EpiPlain E2{(bf16*)(P.ws + WS_QA), 1536}; pg8::gemm_phase<pg8::EpiPlain, pg8::StaticOrder, pg8::APitch>(P.lds, g, S, pg8::APitch{PROJ_LD * 2}, E2, P.tid); }
#else
              pg8::gemm_phase<pg8::EpiQup, pg8::StaticOrder, pg8::APitch>(P.lds, g, S, pg8::APitch{PROJ_LD * 2}, E, P.tid);
#endif
            }
#else
            { pg8::Gemm g{(const bf16*)(P.ws + WS_PROJ) + C_CQ, (const bf16*)(P.ws + WS_WUQ) + (size_t)l * 1536 * 512, 512 * 2};
              pg8::StaticOrder S; S.init(T, 1536, P.G, (int)blockIdx.x);
              pg8::EpiQup E{(bf16*)(P.ws + WS_QA), (const float*)(P.ws + WS_RSTDQ)};
#ifdef PROBE_QUP_PLAIN
              { pg8::EpiPlain E2{(bf16*)(P.ws + WS_QA), 1536}; pg8::gemm_phase<pg8::EpiPlain, pg8::StaticOrder, pg8::APitch>(P.lds, g, S, pg8::APitch{PROJ_LD * 2}, E2, P.tid); }
#else
              pg8::gemm_phase<pg8::EpiQup, pg8::StaticOrder, pg8::APitch>(P.lds, g, S, pg8::APitch{PROJ_LD * 2}, E, P.tid);
#endif
            }
            { pg8::Gemm g{(const bf16*)(P.ws + WS_PROJ) + C_CKV, (const bf16*)(P.ws + WS_WUKV) + (size_t)l * 2048 * 256, 256 * 2};
              pg8::StaticOrder S; S.init(T, 2048, P.G, (int)blockIdx.x);
              pg8::EpiKVup E{(bf16*)(P.ws + WS_KF), (bf16*)(P.ws + WS_VB), (const float*)(P.ws + WS_RSTDKV)};
              pg8::gemm_phase<pg8::EpiKVup, pg8::StaticOrder, pg8::APitch>(P.lds, g, S, pg8::APitch{PROJ_LD * 2}, E, P.tid); }
#endif
        } }
        SEAM(pb + 3);
#ifndef ATT_QROPE
        if (MSK(4) && IN(pb + 4)) { FRESH(P); phase_q_rope(P, args); }
        SEAM(pb + 4);
#endif
        if (MSK(5) && IN(pb + 5)) { FRESH(P); phase_attention(P, (char*)lds, args, l);
#ifdef PROBE_REPEAT_ATT
            __syncthreads(); phase_attention(P, (char*)lds, args, l);
#endif
        }
        SEAM(pb + 5);
        if (MSK(6) && IN(pb + 6)) { for (int rep_ = 0; rep_ < NREP(6); ++rep_) { if (rep_) __syncthreads(); FRESH(P); phase_out_norm(P, args, l); } }
        SEAM(pb + 6);
        if (MSK(7) && IN(pb + 7)) { FRESH(P);
#ifdef G3_FP8
            pg8::Gemm g{P.ws + WS_H, P.ws + WS_WOUT + (size_t)l * DM * DM, DM};
            pg8::StaticOrder S; S.init(T, DM, P.G, (int)blockIdx.x);
#ifdef XRES_BF16
            pg8::EpiResidB E{l == 0 ? (const void*)args.in[I_X] : (const void*)(P.ws + WS_XB), (bf16*)(P.ws + WS_XB), mod + (size_t)l * 4 * 12288 + 2 * DM, 12288, 1.0f / 256.0f, l == 0 ? 1 : 0};
            pg8::gemm_phase<pg8::EpiResidB, pg8::StaticOrder, pg8::ALinear, true>(P.lds, g, S, pg8::ALinear{}, E, P.tid);
#else
            pg8::EpiResid E{l == 0 ? args.in[I_X] : args.out, args.out, mod + (size_t)l * 4 * 12288 + 2 * DM, DM, 12288, 1.0f / 256.0f};
            pg8::gemm_phase<pg8::EpiResid, pg8::StaticOrder, pg8::ALinear, true>(P.lds, g, S, pg8::ALinear{}, E, P.tid);
#endif
#elif defined(XRES_BF16)
            pg8::Gemm g{(const bf16*)(P.ws + WS_H), (const bf16*)(P.ws + WS_WOUT) + (size_t)l * DM * DM, DM * 2};
            pg8::StaticOrder S; S.init(T, DM, P.G, (int)blockIdx.x);
            pg8::EpiResidB E{l == 0 ? (const void*)args.in[I_X] : (const void*)(P.ws + WS_XB), (bf16*)(P.ws + WS_XB), mod + (size_t)l * 4 * 12288 + 2 * DM, 12288, 1.0f, l == 0 ? 1 : 0};
            pg8::gemm_phase<pg8::EpiResidB, pg8::StaticOrder, pg8::ALinear>(P.lds, g, S, pg8::ALinear{}, E, P.tid);
#else
            pg8::Gemm g{(const bf16*)(P.ws + WS_H), (const bf16*)(P.ws + WS_WOUT) + (size_t)l * DM * DM, DM * 2};
            pg8::StaticOrder S; S.init(T, DM, P.G, (int)blockIdx.x);
            pg8::EpiResid E{l == 0 ? args.in[I_X] : args.out, args.out, mod + (size_t)l * 4 * 12288 + 2 * DM, DM, 12288, 1.0f};
            pg8::gemm_phase<pg8::EpiResid, pg8::StaticOrder, pg8::ALinear>(P.lds, g, S, pg8::ALinear{}, E, P.tid);
#endif
        }
        SEAM(pb + 7);
        if (MSK(8) && IN(pb + 8)) { FRESH(P); phase_router(P, args, l);
#ifdef PROBE_REPEAT_ROUTER
            __syncthreads(); phase_router(P, args, l, 1);
#endif
        }
        SEAM(pb + 8);
        if (MSK(9) && IN(pb + 9)) { for (int rep_ = 0; rep_ < NREP(9); ++rep_) { if (rep_) __syncthreads(); FRESH(P);
            const int NT = moe_setup(P, l);
            pg8::MoeOrder S{NT, 8, P.G, (int)blockIdx.x, (const LAS int*)(P.lds + L_TS)};
            LAS unsigned* atab = (LAS unsigned*)(P.lds + L_ATAB); const int* rowidx = (const int*)(P.ws + WS_ROWIDX);
#pragma unroll 1
            for (int slot = 0; slot < MAXU; ++slot) { pg8::Unit u; if (!S.next(slot, u)) break;
                if (P.tid < 256) { const int lr = u.lt * 256 + P.tid; const int ce = (int)P.ctl[CW_CNT + l * 16 + u.e];
                    int tok = lr < ce ? (rowidx[(size_t)u.e * 32768 + lr] >> 1) : 0;
#ifdef PROBE_LINEAR_ATAB
                    tok = (int)(((unsigned)(u.pm * 256 + P.tid) * 2654435761u) >> 17) & 32767;
#endif
 atab[slot * 256 + P.tid] = (unsigned)tok * (unsigned)DM; } }
            __syncthreads();
            pg8::Gemm g{P.ws + WS_H, P.ws + WS_W13, DM};
            pg8::EpiSwiglu E{P.ws + WS_HMID, DEXP};
            pg8::gemm_phase<pg8::EpiSwiglu, pg8::MoeOrder, pg8::ATable, true>(P.lds, g, S, pg8::ATable{atab}, E, P.tid);
        } }
        SEAM(pb + 9);
        if (MSK(10) && IN(pb + 10)) { for (int rep_ = 0; rep_ < NREP(10); ++rep_) { if (rep_) __syncthreads(); FRESH(P);
            const int NT = moe_setup(P, l);
            pg8::MoeOrder S{NT, 8, P.G, (int)blockIdx.x, (const LAS int*)(P.lds + L_TS)};
            pg8::Gemm g{P.ws + WS_HMID, P.ws + WS_W2, DEXP};
            pg8::EpiMoeDown E{(bf16*)(P.ws + WS_Y), (const int*)(P.ws + WS_ROWIDX), (const float*)(P.ws + WS_AW), P.ctl + CW_CNT + l * 16};
            pg8::gemm_phase<pg8::EpiMoeDown, pg8::MoeOrder, pg8::ALinear, true>(P.lds, g, S, pg8::ALinear{}, E, P.tid);
        } }
        SEAM(pb + 10);
    }
    #ifdef PROBE_DUMP_OFF
    if (MSK(12) && IN(NPH - 1)) { FRESH(P); phase_dump(P, args, (size_t)(PROBE_DUMP_OFF), PROBE_DUMP_PITCH); }
#else
    if (MSK(12) && IN(NPH - 1)) { FRESH(P); phase_final(P, args, args.li != 0 ? (PROBE_XIN ? 2 : PROBE_MODE) : 0);
#ifdef PROBE_EXACT
        { const int gw = P.vcu * NWAVES + P.wave, NGW = P.G * NWAVES; __syncthreads();
          for (int ch = gw; ch < T / 16; ch += NGW) for (int rr = 0; rr < 16; ++rr) for (int j = 0; j < 8; ++j) { float* p = args.out + (size_t)(ch * 16 + rr) * DM + 4 * P.lane + 256 * j; asm volatile("s_waitcnt vmcnt(0)" ::: "memory");
              const v4u ub = *(const v4u*)p; *(f32x4*)p = (f32x4){(float)(ub.x & 0xFFFu), (float)(ub.y & 0xFFFu), (float)(ub.z & 0xFFFu), (float)(ub.w & 0xFFFu)}; } }
#endif
    }
#endif
#undef IN
#undef SEAM
}

extern "C" void kernel_launch(void* const* d_in, const int* in_sizes, int n_in, void* d_out, int out_size, void* d_ws, size_t ws_size, hipStream_t stream) {
    static int grid = 0;
    if (grid == 0) {
        if (n_in != 20 || in_sizes[0] != T * DM || out_size != T * DM || ws_size < WS_END) {
            fprintf(stderr, "kernel_launch: unexpected problem (n_in %d, in0 %d, out %d, ws %zu < %zu)\n", n_in, n_in > 0 ? in_sizes[0] : -1, out_size, ws_size, (size_t)WS_END); grid = -1; return; }
        int dev = 0, cus = 0;
        if (hipGetDevice(&dev) != hipSuccess || hipDeviceGetAttribute(&cus, hipDeviceAttributeMultiprocessorCount, dev) != hipSuccess) { grid = -1; return; }
        if (hipFuncSetAttribute((const void*)mk_fwd, hipFuncAttributeMaxDynamicSharedMemorySize, LDS_BYTES) != hipSuccess) { fprintf(stderr, "kernel_launch: hipFuncSetAttribute failed\n"); grid = -1; return; }
        int per_cu = 0;
        if (hipOccupancyMaxActiveBlocksPerMultiprocessor(&per_cu, (const void*)mk_fwd, NWAVES * 64, LDS_BYTES) != hipSuccess || per_cu < 1) fprintf(stderr, "kernel_launch: occupancy query says %d blocks per CU\n", per_cu);
        (void)hipGetLastError();
        grid = cus;
        if (grid != 256) fprintf(stderr, "kernel_launch: %d CUs (built for 256)\n", grid);
    }
    if (grid < 0) return;
    if (hipMemsetAsync((char*)d_ws + WS_CTL, 0, CTL_ZERO_BYTES, stream) != hipSuccess) return;
    Args a; memset(&a, 0, sizeof(a));
    for (int i = 0; i < 20; ++i) a.in[i] = (const float*)d_in[i];
    a.out = (float*)d_out; a.ws = (unsigned char*)d_ws;
    for (int i = 0; i < 32; ++i) a.invf[i] = (float)pow(10000.0, -(double)i / 32.0);
#if MK_PER_PHASE
#ifndef PROBE_LAST
#define PROBE_LAST (NPH - 2)
#endif
    for (int p = 0; p < NPH; ++p) { if (p > PROBE_LAST && p != NPH - 1) continue;
#ifdef PROBE_ONLY_MASK
        if (p != NPH - 1 && !((PROBE_ONLY_MASK >> p) & 1)) continue;
#endif
 a.ph_lo = p; a.ph_hi = p + 1; a.li = (PROBE_LAST != NPH - 2) ? 1 : 0; hipLaunchKernelGGL(mk_fwd, dim3(PROBE_GRID1(p) ? 1 : grid), dim3(NWAVES * 64), LDS_BYTES, stream, a); }
#else
    a.ph_lo = 0; a.ph_hi = NPH; a.li = 0;
    hipLaunchKernelGGL(mk_fwd, dim3(grid), dim3(NWAVES * 64), LDS_BYTES, stream, a);
#endif
    const hipError_t le = hipPeekAtLastError();
    if (le != hipSuccess) fprintf(stderr, "kernel_launch: launch failed: %s\n", hipGetErrorName(le));
}
```

```cpp
#define MK_PER_PHASE 0
#define XRES_BF16 1
#define G3_FP8 1
#define ATT_QROPE 1
#define ST16_IMM 1
#define ROUTER_MFMA 1
#include <hip/hip_runtime.h>
#include <cstdio>
#include <cstdint>
#include <cstring>
#include <cmath>
namespace pg8 {
#define PG8_LAS __attribute__((address_space(3)))
typedef unsigned short bf16_t;
typedef short bf16x8 __attribute__((ext_vector_type(8)));
typedef float f32x4 __attribute__((ext_vector_type(4)));
typedef float f32x2 __attribute__((ext_vector_type(2)));
typedef unsigned u32x4 __attribute__((ext_vector_type(4)));
typedef int v4i_t __attribute__((ext_vector_type(4)));
typedef int v8i_t __attribute__((ext_vector_type(8)));
constexpr int BM = 256, BK = 64, HALF = 128, HTB = HALF * BK * 2  , STAGE_BYTES = 8 * HTB, NXCD = 8, WGM = 8;

__host__ __device__ __forceinline__ int lds_byte(int r, int c) { const int st = (r >> 4) * 2 + (c >> 5), rr = r & 15, cc = c & 31, ob = rr * 64 + cc * 2; return st * 1024 + (ob ^ (((ob >> 9) & 1) << 5)); }
__host__ __device__ __forceinline__ void stage_rc(int b, int& R, int& C) { const int st = b / 1024, sb = b % 1024, swz = sb ^ (((sb >> 9) & 1) << 5); R = (st >> 1) * 16 + swz / 64; C = (st & 1) * 32 + (swz % 64) / 2; }
__host__ __device__ __forceinline__ int perm32(int rho) { const int n = rho >> 4, i = rho & 15; return 8 * (i >> 2) + 4 * n + (i & 3); }

struct Unit { int pm, pn, pb, e, lt; };
struct Gemm { const void* A; const void* Bt; int Kb; };

__device__ __forceinline__ bool order_tile(int i, int G, int c, int nM, int nN, int& pm, int& pn) {
    const int nwg = nM * nN; const long L = (long)i * G + c; if (L >= nwg) return false;
    int wgid = (int)L; { const int q = nwg / NXCD, r = nwg % NXCD, xcd = wgid % NXCD, off = wgid / NXCD; wgid = (xcd < r ? xcd * (q + 1) : r * (q + 1) + (xcd - r) * q) + off; }
    const int nig = WGM * nN, gid = wgid / nig, fm = gid * WGM, gsz = (nM - fm) < WGM ? (nM - fm) : WGM;
    pm = fm + ((wgid % nig) % gsz); pn = (wgid % nig) / gsz; return true;
}
struct StaticOrder {
    int nM, nN, G, c;
    __device__ __forceinline__ void init(int M, int N, int G_, int c_) { nM = M / BM; nN = N / BM; G = G_; c = c_; }
    __device__ __forceinline__ bool next(int i, Unit& u) const { int pm, pn; if (!order_tile(i, G, c, nM, nN, pm, pn)) return false; u.pm = pm; u.pn = pn; u.pb = pn; u.e = 0; u.lt = 0; return true; }
};
struct MoeOrder {
    int nM, nN, G, c; const PG8_LAS int* ts;
    __device__ __forceinline__ bool next(int i, Unit& u) const {
        int pm, pn; if (i >= 10 || !order_tile(i, G, c, nM, nN, pm, pn)) return false;
        int e = 0;
#pragma unroll
        for (int j = 1; j < 16; ++j) e += (__builtin_amdgcn_readfirstlane(ts[j]) <= pm) ? 1 : 0;
        e = __builtin_amdgcn_readfirstlane(e); u.pm = pm; u.pn = pn; u.e = e; u.lt = pm - __builtin_amdgcn_readfirstlane(ts[e]); u.pb = e * nN + pn; return true;
    }
};
struct ALinear { __device__ __forceinline__ unsigned off(const Unit& u, int slot, int r, int Kb) const { return (unsigned)(u.pm * BM + r) * (unsigned)Kb; } };
struct APitch  { unsigned pitchB; __device__ __forceinline__ unsigned off(const Unit& u, int slot, int r, int K) const { return (unsigned)(u.pm * BM + r) * pitchB; } };
struct ATable  { const PG8_LAS unsigned* tab; __device__ __forceinline__ unsigned off(const Unit& u, int slot, int r, int K) const { return tab[slot * BM + r]; } };

typedef __bf16 bf16x2_t __attribute__((ext_vector_type(2)));
__device__ __forceinline__ unsigned cvt_pk_bf16(float lo, float hi) { const f32x2 v = {lo, hi}; return __builtin_bit_cast(unsigned, __builtin_convertvector(v, bf16x2_t)); }

typedef f32x4 Acc[2][2][4][2];

typedef __amdgpu_buffer_rsrc_t rsrc_t;
#define PG8_RSRC(p) __builtin_amdgcn_make_buffer_rsrc((void*)(p), 0, 0x7fffffff, 0x00020000)
#ifdef ST16_IMM
__device__ __forceinline__ void st16(rsrc_t r, int vo, int so, u32x4 v) { __builtin_amdgcn_raw_buffer_store_b128(v, r, vo + so, 0, 0); }
#else
__device__ __forceinline__ void st16(rsrc_t r, int vo, int so, u32x4 v) { __builtin_amdgcn_raw_buffer_store_b128(v, r, vo, so, 0); }
#endif
__device__ __forceinline__ f32x4 ld16f(rsrc_t r, int vo, int so) { return __builtin_bit_cast(f32x4, __builtin_amdgcn_raw_buffer_load_b128(r, vo, so, 0)); }
__device__ __forceinline__ float ld4f(rsrc_t r, int vo, int so) { return __uint_as_float(__builtin_amdgcn_raw_buffer_load_b32(r, vo, so, 0)); }
__device__ __forceinline__ u32x4 pack8(const f32x4 v0, const f32x4 v1) { u32x4 w; w.x = cvt_pk_bf16(v0[0], v0[1]); w.y = cvt_pk_bf16(v0[2], v0[3]); w.z = cvt_pk_bf16(v1[0], v1[1]); w.w = cvt_pk_bf16(v1[2], v1[3]); return w; }
struct EpiPlain {
    static constexpr bool PERM = true;
    bf16_t* O; int ldc;
    __device__ __forceinline__ void operator()(const Acc& acc, const Unit& u, int wr, int wc, int fr, int fq) const {
        const rsrc_t ro = PG8_RSRC(O); const int vo = (fr * ldc + wc * 32 + 8 * fq) * 2;
#pragma unroll
        for (int ai = 0; ai < 2; ++ai)
#pragma unroll
            for (int m = 0; m < 4; ++m) { const int so = ((u.pm * BM + wr * 64 + ai * HALF + m * 16) * ldc + u.pn * BM) * 2;
#pragma unroll
                for (int bj = 0; bj < 2; ++bj) st16(ro, vo, so + bj * HALF * 2, pack8(acc[ai][bj][m][0], acc[ai][bj][m][1])); }
    }
};
struct EpiQup {
    static constexpr bool PERM = true;
    bf16_t* O; const float* rstd;
    __device__ __forceinline__ void operator()(const Acc& acc, const Unit& u, int wr, int wc, int fr, int fq) const {
        const rsrc_t ro = PG8_RSRC(O), rr = PG8_RSRC(rstd);
        const int vo = (fr * 1536 + wc * 32 + 8 * fq) * 2;
        float rs[2][4];
#pragma unroll
        for (int ai = 0; ai < 2; ++ai)
#pragma unroll
            for (int m = 0; m < 4; ++m) rs[ai][m] = ld4f(rr, fr * 4, (u.pm * BM + wr * 64 + ai * HALF + m * 16) * 4);
#pragma unroll
        for (int ai = 0; ai < 2; ++ai)
#pragma unroll
            for (int m = 0; m < 4; ++m) { const int rowu = u.pm * BM + wr * 64 + ai * HALF + m * 16; const float r1 = rs[ai][m];
                const int so = (rowu * 1536 + u.pn * BM) * 2;
                st16(ro, vo, so, pack8(acc[ai][0][m][0] * r1, acc[ai][0][m][1] * r1));
                st16(ro, vo, so + HALF * 2, pack8(acc[ai][1][m][0] * r1, acc[ai][1][m][1] * r1)); }
    }
};
struct EpiKVup {
    static constexpr bool PERM = true;
    bf16_t* KF; bf16_t* VB; const float* rstd;
    __device__ __forceinline__ void operator()(const Acc& acc, const Unit& u, int wr, int wc, int fr, int fq) const {
        const rsrc_t rk = PG8_RSRC(KF), rv = PG8_RSRC(VB), rr = PG8_RSRC(rstd);
        const int c0 = wc * 32 + 8 * fq, vok = (fr * 1536 + c0) * 2, vov = (fr * 1024 + c0) * 2;
        float rs[2][4];
#pragma unroll
        for (int ai = 0; ai < 2; ++ai)
#pragma unroll
            for (int m = 0; m < 4; ++m) rs[ai][m] = ld4f(rr, fr * 4, (u.pm * BM + wr * 64 + ai * HALF + m * 16) * 4);
#pragma unroll
        for (int ai = 0; ai < 2; ++ai)
#pragma unroll
            for (int m = 0; m < 4; ++m) { const int rowu = u.pm * BM + wr * 64 + ai * HALF + m * 16; const float r1 = rs[ai][m];
                st16(rk, vok, (rowu * 1536 + u.pn * 192) * 2, pack8(acc[ai][0][m][0] * r1, acc[ai][0][m][1] * r1));
                st16(rv, vov, (rowu * 1024 + u.pn * 128) * 2, pack8(acc[ai][1][m][0] * r1, acc[ai][1][m][1] * r1)); }
    }
};
struct EpiResid {
    static constexpr bool PERM = false;
    const float* base; float* out; const float* gate; int ldc; int gld; float ascale;
    __device__ __forceinline__ void operator()(const Acc& acc, const Unit& u, int wr, int wc, int fr, int fq) const {
        const rsrc_t rb = PG8_RSRC(base), ro = PG8_RSRC(out), rg = PG8_RSRC(gate);
        const int cl = (wc * 32 + 4 * fq) * 4, vo = fr * ldc * 4 + cl;
        f32x4 gv[2][2];
#pragma unroll
        for (int bj = 0; bj < 2; ++bj)
#pragma unroll
            for (int n = 0; n < 2; ++n) gv[bj][n] = ld16f(rg, cl, (((u.pm * BM) >> 13) * gld + u.pn * BM + bj * HALF + n * 16) * 4) * ascale;
#pragma unroll
        for (int ai = 0; ai < 2; ++ai) {
            f32x4 bs[4][2][2];
#pragma unroll
            for (int m = 0; m < 4; ++m) { const int so = ((u.pm * BM + ai * HALF + wr * 64 + m * 16) * ldc + u.pn * BM) * 4;
#pragma unroll
                for (int bj = 0; bj < 2; ++bj)
#pragma unroll
                    for (int n = 0; n < 2; ++n) bs[m][bj][n] = ld16f(rb, vo, so + (bj * HALF + n * 16) * 4); }
#pragma unroll
            for (int m = 0; m < 4; ++m) { const int so = ((u.pm * BM + ai * HALF + wr * 64 + m * 16) * ldc + u.pn * BM) * 4;
#pragma unroll
                for (int bj = 0; bj < 2; ++bj)
#pragma unroll
                    for (int n = 0; n < 2; ++n) st16(ro, vo, so + (bj * HALF + n * 16) * 4, __builtin_bit_cast(u32x4, bs[m][bj][n] + gv[bj][n] * acc[ai][bj][m][n])); }
            asm volatile("s_waitcnt vmcnt(0)" ::: "memory");
        }
    }
};
struct EpiResidB {
    static constexpr bool PERM = true;
    const void* base; bf16_t* out; const float* gate; int gld; float ascale; int BASE_F32;
    __device__ __forceinline__ void operator()(const Acc& acc, const Unit& u, int wr, int wc, int fr, int fq) const {
        const rsrc_t rb = PG8_RSRC(base), ro = PG8_RSRC(out), rg = PG8_RSRC(gate);
        const int c0 = wc * 32 + 8 * fq;
        f32x4 gv[2][2];
#pragma unroll
        for (int bj = 0; bj < 2; ++bj)
#pragma unroll
            for (int n = 0; n < 2; ++n) gv[bj][n] = ld16f(rg, (c0 + 4 * n) * 4, (((u.pm * BM) >> 13) * gld + u.pn * BM + bj * HALF) * 4) * ascale;
#pragma unroll
        for (int ai = 0; ai < 2; ++ai) {
            f32x4 bs[4][2][2];
#pragma unroll
            for (int m = 0; m < 4; ++m) { const int rowu = u.pm * BM + ai * HALF + wr * 64 + m * 16;
#pragma unroll
                for (int bj = 0; bj < 2; ++bj) {
                    if (BASE_F32) { const int so = (rowu * 2048 + u.pn * BM + bj * HALF) * 4, vo = (fr * 2048 + c0) * 4;
                        bs[m][bj][0] = ld16f(rb, vo, so); bs[m][bj][1] = ld16f(rb, vo + 16, so); }
                    else { const int so = (rowu * 2048 + u.pn * BM + bj * HALF) * 2, vo = (fr * 2048 + c0) * 2;
                        const u32x4 w = __builtin_bit_cast(u32x4, __builtin_amdgcn_raw_buffer_load_b128(rb, vo, so, 0));
                        bs[m][bj][0] = (f32x4){__uint_as_float(w.x << 16), __uint_as_float(w.x & 0xffff0000u), __uint_as_float(w.y << 16), __uint_as_float(w.y & 0xffff0000u)};
                        bs[m][bj][1] = (f32x4){__uint_as_float(w.z << 16), __uint_as_float(w.z & 0xffff0000u), __uint_as_float(w.w << 16), __uint_as_float(w.w & 0xffff0000u)}; } } }
#pragma unroll
            for (int m = 0; m < 4; ++m) { const int rowu = u.pm * BM + ai * HALF + wr * 64 + m * 16;
#pragma unroll
                for (int bj = 0; bj < 2; ++bj) st16(ro, (fr * 2048 + c0) * 2, (rowu * 2048 + u.pn * BM + bj * HALF) * 2,
                                                    pack8(bs[m][bj][0] + gv[bj][0] * acc[ai][bj][m][0], bs[m][bj][1] + gv[bj][1] * acc[ai][bj][m][1])); }
            asm volatile("s_waitcnt vmcnt(0)" ::: "memory");
        }
    }
};
struct EpiSwiglu {
    static constexpr bool PERM = true;
    unsigned char* O; int ldc;
    __device__ __forceinline__ void operator()(const Acc& acc, const Unit& u, int wr, int wc, int fr, int fq) const {
        const rsrc_t ro = PG8_RSRC(O); const int vo = fr * ldc + wc * 32 + 8 * fq;
#pragma unroll
        for (int ai = 0; ai < 2; ++ai)
#pragma unroll
            for (int m = 0; m < 4; ++m) { const int so = (u.pm * BM + wr * 64 + ai * HALF + m * 16) * ldc + u.pn * HALF; float r[8];
#pragma unroll
                for (int n = 0; n < 2; ++n)
#pragma unroll
                    for (int k = 0; k < 4; ++k) { const float g = acc[ai][0][m][n][k] * (1.0f / 256.0f), up = acc[ai][1][m][n][k] * (1.0f / 256.0f);
                        r[n * 4 + k] = g * __builtin_amdgcn_rcpf(1.0f + __builtin_amdgcn_exp2f(-1.4426950408889634f * g)) * up; }
                int w0 = 0, w1 = 0;
                w0 = __builtin_amdgcn_cvt_pk_fp8_f32(r[0], r[1], w0, false); w0 = __builtin_amdgcn_cvt_pk_fp8_f32(r[2], r[3], w0, true);
                w1 = __builtin_amdgcn_cvt_pk_fp8_f32(r[4], r[5], w1, false); w1 = __builtin_amdgcn_cvt_pk_fp8_f32(r[6], r[7], w1, true);
                typedef unsigned u32x2_t __attribute__((ext_vector_type(2)));
                __builtin_amdgcn_raw_buffer_store_b64((u32x2_t){(unsigned)w0, (unsigned)w1}, ro, vo, so, 0); }
    }
};
struct EpiMoeDown {
    static constexpr bool PERM = true;
    bf16_t* Y; const int* rowidx; const float* aw; const unsigned* cnt;
    __device__ __forceinline__ void operator()(const Acc& acc, const Unit& u, int wr, int wc, int fr, int fq) const {
        const rsrc_t ry = PG8_RSRC(Y), ri = PG8_RSRC(rowidx), ra = PG8_RSRC(aw);
        const int nvalid = (int)cnt[u.e] - u.lt * BM; const int cb = (u.pn * BM + wc * 32 + 8 * fq) * 2;
        int idx[2][4]; float w8[2][4];
#pragma unroll
        for (int ai = 0; ai < 2; ++ai)
#pragma unroll
            for (int m = 0; m < 4; ++m) { const int ru = ai * HALF + wr * 64 + m * 16; idx[ai][m] = -1; w8[ai][m] = 0.f;
                if (ru + fr < nvalid) { idx[ai][m] = (int)__builtin_amdgcn_raw_buffer_load_b32(ri, fr * 4, (u.e * 32768 + u.lt * BM + ru) * 4, 0); w8[ai][m] = ld4f(ra, idx[ai][m] * 4, 0); } }
#pragma unroll
        for (int ai = 0; ai < 2; ++ai)
#pragma unroll
            for (int m = 0; m < 4; ++m) if (idx[ai][m] >= 0) { const int vo = idx[ai][m] * 4096 + cb; const float w1 = w8[ai][m] * (1.0f / 256.0f);
#pragma unroll
                for (int bj = 0; bj < 2; ++bj) st16(ry, vo, bj * HALF * 2, pack8(acc[ai][bj][m][0] * w1, acc[ai][bj][m][1] * w1)); }
    }
};

template <class Epi, class Sched, class AOff, bool FP8 = false>
__device__ __forceinline__ void gemm_phase(PG8_LAS unsigned char* lds, const Gemm g, const Sched& S, const AOff& AO, const Epi& E, int tid_in) {
    int tid = tid_in; asm volatile("" : "+v"(tid));
    const int wid = __builtin_amdgcn_readfirstlane(tid >> 6), lane = tid & 63, wr = wid >> 2, wc = wid & 3, fr = lane & 15, fq = lane >> 4;
    int K = g.Kb; asm volatile("" : "+s"(K));
    const int nt = K / (BK * 2);
    int Ra[2], Ca[2]; unsigned voffB[2];
#pragma unroll
    for (int i = 0; i < 2; ++i) { int R, C; stage_rc(tid * 16 + i * 8192, R, C); const int Rb = Epi::PERM ? ((R & ~31) + perm32(R & 31)) : R;
        Ra[i] = R; Ca[i] = C * 2; voffB[i] = (unsigned)(Rb * K + C * 2); }
    const size_t kstep = (size_t)(BK * 2);
    const size_t hstep = (size_t)HALF * K;
    const size_t tstep = 2 * hstep;
    const unsigned ldsw = (unsigned)wid * 1024u;
    const unsigned lds0 = (unsigned)(uintptr_t)lds;
    const int aoff = lds_byte(wr * 64 + fr, fq * 8), boff = lds_byte(wc * 32 + fr, fq * 8);
#define PG8_SA(b, h) (((b) * 2 + (h)) * HTB)
#define PG8_SB(b, h) ((4 + (b) * 2 + (h)) * HTB)
#define PG8_STAGE(bufoff, gbase, voff) do { _Pragma("unroll") for (int _i = 0; _i < 2; ++_i) { unsigned keep_; \
        asm volatile("s_mov_b32 %0, m0\n\ts_mov_b32 m0, %2\n\ts_nop 0\n\tglobal_load_lds_dwordx4 %1, %3\n\ts_mov_b32 m0, %0" : "=&s"(keep_) \
            : "v"((voff)[_i]), "s"((unsigned)__builtin_amdgcn_readfirstlane((int)(lds0 + (bufoff) + ldsw + _i * 8192))), "s"((const void*)(gbase)) : "memory"); } } while (0)
#define PG8_LD8(addr) __builtin_shufflevector(*(const PG8_LAS v4i_t*)(addr), *(const PG8_LAS v4i_t*)((addr) + 1024), 0, 1, 2, 3, 4, 5, 6, 7)
#define PG8_LDA(dst, b, h) do { _Pragma("unroll") for (int m = 0; m < 4; ++m) dst[m] = PG8_LD8(lds + PG8_SA(b, h) + aoff + m * 2048); } while (0)
#define PG8_LDB(dst, b, h) do { _Pragma("unroll") for (int n = 0; n < 2; ++n) dst[n] = PG8_LD8(lds + PG8_SB(b, h) + boff + n * 2048); } while (0)
#define PG8_HALF(x, k) __builtin_bit_cast(bf16x8, __builtin_shufflevector(x, x, 4 * (k), 4 * (k) + 1, 4 * (k) + 2, 4 * (k) + 3))
#define PG8_MMA(ai, bj, At, Bt) do { __builtin_amdgcn_s_setprio(1); _Pragma("unroll") for (int m = 0; m < 4; ++m) _Pragma("unroll") for (int n = 0; n < 2; ++n) { \
        if constexpr (FP8) asm volatile("v_mfma_scale_f32_16x16x128_f8f6f4 %0, %1, %2, %0, %3, %3 op_sel_hi:[0,0,0]" : "+v"(acc[ai][bj][m][n]) : "v"(Bt[n]), "v"(At[m]), "v"(sc1_));   \
        else { acc[ai][bj][m][n] = __builtin_amdgcn_mfma_f32_16x16x32_bf16(PG8_HALF(Bt[n], 0), PG8_HALF(At[m], 0), acc[ai][bj][m][n], 0, 0, 0); \
               acc[ai][bj][m][n] = __builtin_amdgcn_mfma_f32_16x16x32_bf16(PG8_HALF(Bt[n], 1), PG8_HALF(At[m], 1), acc[ai][bj][m][n], 0, 0, 0); } } \
        __builtin_amdgcn_s_setprio(0); } while (0)
#define PG8_WAIT_V(n) asm volatile("s_waitcnt vmcnt(" #n ")" ::: "memory")
#define PG8_WAIT_L(n) asm volatile("s_waitcnt lgkmcnt(" #n ")" ::: "memory")
#define PG8_BAR __builtin_amdgcn_s_barrier()
#define PG8_SCHED __builtin_amdgcn_sched_barrier(0)
#define PG8_AOFF(dst, u, slot) do { _Pragma("unroll") for (int _h = 0; _h < 2; ++_h) _Pragma("unroll") for (int _i = 0; _i < 2; ++_i) dst[_h][_i] = AO.off(u, slot, _h * HALF + Ra[_i], K) + (unsigned)Ca[_i]; } while (0)
    Unit cur, nxt; int ui = 0;
    if (!S.next(0, cur)) return;
    Acc acc;
#pragma unroll
    for (int a = 0; a < 2; ++a)
#pragma unroll
        for (int b = 0; b < 2; ++b)
#pragma unroll
            for (int m = 0; m < 4; ++m)
#pragma unroll
                for (int n = 0; n < 2; ++n) acc[a][b][m][n] = (f32x4){0.f, 0.f, 0.f, 0.f};
    v8i_t At[4], B0[2], B1[2];
    int sc1_ = 0x7F7F7F7F; asm volatile("" : "+v"(sc1_));
    unsigned aoC[2][2];
    PG8_AOFF(aoC, cur, 0);
    const char* gA = (const char*)g.A; const char* gB = (const char*)g.Bt;
    asm volatile("" : "+s"(gA), "+s"(gB));
    const char* cB = gB + (size_t)cur.pb * tstep;
    PG8_STAGE(PG8_SB(0, 0), cB, voffB); PG8_STAGE(PG8_SB(0, 1), cB + hstep, voffB); PG8_STAGE(PG8_SA(0, 0), gA, aoC[0]); PG8_STAGE(PG8_SA(0, 1), gA, aoC[1]);
    if (wr == 1) PG8_BAR;
    PG8_WAIT_V(2); PG8_BAR;
    PG8_STAGE(PG8_SB(1, 0), cB + kstep, voffB); PG8_STAGE(PG8_SA(1, 0), gA + kstep, aoC[0]); PG8_STAGE(PG8_SB(1, 1), cB + hstep + kstep, voffB);
    PG8_WAIT_V(6); PG8_BAR;
    for (;;) {
        const bool has_next = S.next(ui + 1, nxt);
        const char* nB = has_next ? gB + (size_t)nxt.pb * tstep : cB;
        for (int t = 0; t < nt; t += 2) {
            const bool last = (t == nt - 2);
            const char* a1 = gA + (size_t)(t + 1) * kstep;
            const char* a2 = last ? gA : gA + (size_t)(t + 2) * kstep; const char* b2 = last ? nB : cB + (size_t)(t + 2) * kstep;
            const char* a3 = a2 + kstep; const char* b3 = b2 + kstep;
            unsigned ao2[2][2];
            if (last && has_next) { PG8_AOFF(ao2, nxt, ui + 1); }
            else {
#pragma unroll
                for (int _h = 0; _h < 2; ++_h)
#pragma unroll
                    for (int _i = 0; _i < 2; ++_i) ao2[_h][_i] = aoC[_h][_i]; }
            PG8_LDB(B0, 0, 0); PG8_LDB(B1, 0, 1); PG8_SCHED; PG8_LDA(At, 0, 0); PG8_STAGE(PG8_SA(1, 1), a1, aoC[1]);
            PG8_WAIT_V(8); PG8_WAIT_L(0); PG8_BAR; PG8_MMA(0, 0, At, B0); PG8_MMA(0, 1, At, B1); PG8_BAR; PG8_SCHED;
            PG8_LDA(At, 0, 1); PG8_STAGE(PG8_SB(0, 0), b2, voffB); PG8_STAGE(PG8_SB(0, 1), b2 + hstep, voffB); PG8_STAGE(PG8_SA(0, 0), a2, ao2[0]);
            PG8_WAIT_V(8); PG8_WAIT_L(0); PG8_BAR; PG8_MMA(1, 0, At, B0); PG8_MMA(1, 1, At, B1); PG8_BAR; PG8_SCHED;
            PG8_LDB(B0, 1, 0); PG8_LDB(B1, 1, 1); PG8_SCHED; PG8_LDA(At, 1, 0); PG8_STAGE(PG8_SA(0, 1), a2, ao2[1]);
            PG8_WAIT_V(8); PG8_WAIT_L(0); PG8_BAR; PG8_MMA(0, 0, At, B0); PG8_MMA(0, 1, At, B1); PG8_BAR; PG8_SCHED;
            PG8_LDA(At, 1, 1); PG8_STAGE(PG8_SB(1, 0), b3, voffB); PG8_STAGE(PG8_SB(1, 1), b3 + hstep, voffB); PG8_STAGE(PG8_SA(1, 0), a3, ao2[0]);
            PG8_WAIT_V(8); PG8_WAIT_L(0); PG8_BAR; PG8_MMA(1, 0, At, B0); PG8_MMA(1, 1, At, B1); PG8_BAR; PG8_SCHED;
        }
        if (wr == 0) PG8_BAR;
        E(acc, cur, wr, wc, fr, fq);
        if (!has_next) break;
#pragma unroll
        for (int a = 0; a < 2; ++a)
#pragma unroll
            for (int b = 0; b < 2; ++b)
#pragma unroll
                for (int m = 0; m < 4; ++m)
#pragma unroll
                    for (int n = 0; n < 2; ++n) acc[a][b][m][n] = (f32x4){0.f, 0.f, 0.f, 0.f};
        cur = nxt; cB = nB; ++ui;
        PG8_AOFF(aoC, cur, ui);
        if (wr == 1) PG8_BAR;
    }
    PG8_WAIT_V(0);
    PG8_BAR;
#undef PG8_SA
#undef PG8_SB
#undef PG8_STAGE
#undef PG8_LDA
#undef PG8_LDB
#undef PG8_MMA
#undef PG8_LD8
#undef PG8_HALF
#undef PG8_WAIT_V
#undef PG8_WAIT_L
#undef PG8_BAR
#undef PG8_SCHED
#undef PG8_AOFF
}
}
namespace att {
typedef unsigned short bf16;
typedef short bf16x8 __attribute__((ext_vector_type(8)));
typedef short s16x4 __attribute__((ext_vector_type(4)));
typedef float f32x16 __attribute__((ext_vector_type(16)));
typedef float f32x4 __attribute__((ext_vector_type(4)));
typedef unsigned u32x4 __attribute__((ext_vector_type(4)));
constexpr int NW = 8, QBLK = 32, KVBLK = 64, QB = NW * QBLK, DV = 128;
constexpr float THR = 8.f;
constexpr int SHM_V = KVBLK * DV * 2;
template <int DQK> struct Cfg { static constexpr int NKC = DQK / 8, KCH = NKC / 8, KPITCH = DQK * 2, SHM_K = KVBLK * KPITCH, NQF = DQK / 16, LDS_BYTES = 2 * SHM_V + 2 * SHM_K + NW * 64 * 4; };
#define SBAR() __builtin_amdgcn_sched_barrier(0)
__device__ __forceinline__ int v_st(int k, int c) { const int kk = (k & ~0xC) | ((k & 4) << 1) | ((k & 8) >> 1); return ((kk >> 3) * 4 + (c >> 5)) * 512 + ((kk & 7) * 32 + (c & 31)) * 2; }
__device__ __forceinline__ int v_rd_base(int lane) { return ((lane & 3) << 3) | (((lane >> 2) & 3) << 6) | (((lane >> 4) & 1) << 5) | (((lane >> 5) & 1) << 8); }
constexpr int v_rd_off(int d0, int ks, int half) { return d0 * 512 + ks * 4096 + half * 2048; }
__device__ __forceinline__ int crow(int r, int hi) { return (r & 3) + 8 * (r >> 2) + 4 * hi; }
__device__ __forceinline__ unsigned cvtpk(float lo, float hi) { return pg8::cvt_pk_bf16(lo, hi); }
__device__ __forceinline__ bf16x8 load8(const bf16* p) { return *reinterpret_cast<const bf16x8*>(p); }
__device__ __forceinline__ void mask_tile(f32x16& p0, f32x16& p1, int dq, unsigned W) {
    const float NEG = -__builtin_inff();
#pragma unroll
    for (int r = 0; r < 16; ++r) { const int c = (r & 3) + 8 * (r >> 2);
        if ((unsigned)(dq - c) >= W) p0[r] = NEG;
        if ((unsigned)(dq - c - 32) >= W) p1[r] = NEG; }
}
__device__ __forceinline__ void partialSM(f32x16& p0, f32x16& p1, float& m_reg, float& mn, float& alpha, float scale) {
    float pmax = p0[0];
#pragma unroll
    for (int r = 1; r < 16; ++r) pmax = fmaxf(pmax, p0[r]);
#pragma unroll
    for (int r = 0; r < 16; ++r) pmax = fmaxf(pmax, p1[r]);
    { auto rr = __builtin_amdgcn_permlane32_swap(__float_as_uint(pmax), __float_as_uint(pmax), false, false);
      pmax = fmaxf(__uint_as_float(rr[0]), __uint_as_float(rr[1])); }
    const float C2 = 1.4426950408889634f * scale;
    if (__builtin_expect(__all((pmax - m_reg) * scale <= THR), 1)) { mn = m_reg; alpha = 1.f; }
    else { mn = fmaxf(m_reg, pmax); alpha = __builtin_amdgcn_exp2f((m_reg - mn) * C2); m_reg = mn; }
    const float mnL = -mn * C2;
#pragma unroll
    for (int r = 0; r < 16; ++r) p0[r] = fmaf(p0[r], C2, mnL);
#pragma unroll
    for (int r = 0; r < 16; ++r) p1[r] = fmaf(p1[r], C2, mnL);
#pragma unroll
    for (int r = 0; r < 16; ++r) p0[r] = __builtin_amdgcn_exp2f(p0[r]);
}
__device__ __forceinline__ void finishSM(f32x16& p0, f32x16& p1, float alpha, float& l_reg, bf16x8& pa0, bf16x8& pa1, bf16x8& pa2, bf16x8& pa3) {
#pragma unroll
    for (int r = 0; r < 16; ++r) p1[r] = __builtin_amdgcn_exp2f(p1[r]);
    float ps = 0;
#pragma unroll
    for (int r = 0; r < 16; ++r) ps += p0[r];
#pragma unroll
    for (int r = 0; r < 16; ++r) ps += p1[r];
    { auto rr = __builtin_amdgcn_permlane32_swap(__float_as_uint(ps), __float_as_uint(ps), false, false);
      ps = __uint_as_float(rr[0]) + __uint_as_float(rr[1]); }
    l_reg = l_reg * alpha + ps;
#define PK4(P, B_, OUT) do { unsigned a0 = cvtpk(P[B_+0], P[B_+1]), a1 = cvtpk(P[B_+2], P[B_+3]);                          \
        unsigned b0 = cvtpk(P[B_+4], P[B_+5]), b1 = cvtpk(P[B_+6], P[B_+7]);                                             \
        auto r0 = __builtin_amdgcn_permlane32_swap(a0, b0, false, false); auto r1 = __builtin_amdgcn_permlane32_swap(a1, b1, false, false); \
        u32x4 w = {r0[0], r1[0], r0[1], r1[1]}; OUT = *reinterpret_cast<bf16x8*>(&w); } while (0)
    PK4(p0, 0, pa0); PK4(p0, 8, pa1); PK4(p1, 0, pa2); PK4(p1, 8, pa3);
#undef PK4
}
template <int KB, bool SK, int DQK, bool DIL>
__device__ __forceinline__ void qkt(f32x16& p0, f32x16& p1, const char* K_lds, int r32, int hi, const bf16x8* qr, bool act, float beta, int dq) {
    typedef Cfg<DQK> C;
    if (SK && !act) { const float NEG = -__builtin_inff();
#pragma unroll
        for (int r = 0; r < 16; ++r) { p0[r] = NEG; p1[r] = NEG; } return; }
    if constexpr (DIL) { const float b0 = -beta * (float)dq;
#pragma unroll
        for (int r = 0; r < 16; ++r) { const int c = (r & 3) + 8 * (r >> 2); p0[r] = fmaf(beta, (float)c, b0); p1[r] = fmaf(beta, (float)(c + 32), b0); } }
    else { p0 = f32x16{}; p1 = f32x16{}; }
    const char* kb[4];
#pragma unroll
    for (int dd = 0; dd < 4; ++dd) { const int colB = (dd * 16 + hi * 8) * 2; kb[dd] = K_lds + KB * C::SHM_K + r32 * C::KPITCH + (colB ^ ((r32 & 7) << 4)); }
#pragma unroll
    for (int d0 = 0; d0 < C::NQF; ++d0) { const char* a = kb[d0 & 3] + (d0 >> 2) * 128;
        bf16x8 b0 = *reinterpret_cast<const bf16x8*>(a);
        bf16x8 b1 = *reinterpret_cast<const bf16x8*>(a + 32 * C::KPITCH);
        p0 = __builtin_amdgcn_mfma_f32_32x32x16_bf16(b0, qr[d0], p0, 0, 0, 0);
        p1 = __builtin_amdgcn_mfma_f32_32x32x16_bf16(b1, qr[d0], p1, 0, 0, 0);
#ifndef ATT_NO_QKT_SBAR
        if ((d0 & 3) == 3) SBAR();
#endif
    }
}
template <int VB, bool SK>
__device__ __forceinline__ void pv_tile(f32x16* o, int vb0, bf16x8 pa0, bf16x8 pa1, bf16x8 pa2, bf16x8 pa3, bool act) {
    if (SK && !act) return;
#define TRRD(dst, off) asm volatile("ds_read_b64_tr_b16 %0, %1 offset:%2" : "=&v"(dst) : "v"(vb0), "i"(off) : "memory")
#define PV_D0(d0) do { s16x4 l0, l1, l2, l3, h0, h1, h2, h3; constexpr int b_ = VB * SHM_V + v_rd_off(d0, 0, 0); \
        TRRD(l0, b_); TRRD(h0, b_ + 2048); TRRD(l1, b_ + 4096); TRRD(h1, b_ + 6144); TRRD(l2, b_ + 8192); TRRD(h2, b_ + 10240); TRRD(l3, b_ + 12288); TRRD(h3, b_ + 14336); \
        asm volatile("s_waitcnt lgkmcnt(0)" ::: "memory"); SBAR();   \
        o[d0] = __builtin_amdgcn_mfma_f32_32x32x16_bf16(pa0, (bf16x8){l0[0], l0[1], l0[2], l0[3], h0[0], h0[1], h0[2], h0[3]}, o[d0], 0, 0, 0);   \
        o[d0] = __builtin_amdgcn_mfma_f32_32x32x16_bf16(pa1, (bf16x8){l1[0], l1[1], l1[2], l1[3], h1[0], h1[1], h1[2], h1[3]}, o[d0], 0, 0, 0);   \
        o[d0] = __builtin_amdgcn_mfma_f32_32x32x16_bf16(pa2, (bf16x8){l2[0], l2[1], l2[2], l2[3], h2[0], h2[1], h2[2], h2[3]}, o[d0], 0, 0, 0);   \
        o[d0] = __builtin_amdgcn_mfma_f32_32x32x16_bf16(pa3, (bf16x8){l3[0], l3[1], l3[2], l3[3], h3[0], h3[1], h3[2], h3[3]}, o[d0], 0, 0, 0); } while (0)
    PV_D0(0); PV_D0(1); PV_D0(2); PV_D0(3);
#undef PV_D0
#undef TRRD
}

struct Blk { unsigned qo, ko, vo, oo, lo; int P0, rate; float beta; };
constexpr int PVAR = 0;
#define QS_(B) (DIL ? ((PVAR & 4) ? 128 : (B).rate * 4096) : 1536)
#define KS_(B) (DIL ? ((PVAR & 2) ? 128 : (B).rate * 4096) : 1536)
#define VS_(B) (DIL ? ((PVAR & 2) ? 128 : (B).rate * 4096) : 1024)
#define OS_(B) (DIL ? (B).rate * 1024 : 1024)
#define LS_(B) ((B).rate * 8)
#define SKV_(B) (DIL ? 8192 / (B).rate : 8192)
#define W_(B) (DIL ? 129 : (1 << 30))
#define SCALE_ (DIL ? 0.08838834764831845f : 0.07216878364870322f)
template <int DQK> struct Seam { bf16x8 qr[Cfg<DQK>::NQF]; bf16x8 st_v0, st_v1; bf16x8 st_k[Cfg<DQK>::KCH]; unsigned p_oo = 0; int p_rb = 0, p_so0 = 0, p_on = 0; float cv[4], cw[4]; int cv_j = 0, cv_q = 0, cl_j = 0, cl_q = 0; f32x4 rt[8]; };
__device__ __forceinline__ int swa_jlo(int P0, int W) { const int lowk = P0 - W + 1; return lowk > 0 ? lowk / KVBLK : 0; }

#define VMW() asm volatile("s_waitcnt vmcnt(0)" ::: "memory")
#define VMWN(n) asm volatile("s_waitcnt vmcnt(%0)" :: "i"(n) : "memory")
#define A_RSRC(p) __builtin_amdgcn_make_buffer_rsrc((void*)(p), 0, 0x7fffffff, 0x00020000)
#define A_BLD(rs, vo, so) __builtin_bit_cast(bf16x8, __builtin_amdgcn_raw_buffer_load_b128((rs), (int)(vo), (int)(so), 0))
#ifdef ATT_SLOAD_RECOMP
#define A_SLOAD(B_, k0) do { const __amdgpu_buffer_rsrc_t rv_ = A_RSRC(wsb + (B_).vo), rk_ = A_RSRC(wsb + (B_).ko); const int sov_ = (k0) * VS_(B_) * 2, sok_ = (k0) * KS_(B_) * 2; \
        int t_ = tid; asm volatile("" : "+v"(t_)); const int sr_ = t_ >> 4, sc_ = (t_ & 15) * 8; \
        S.st_v0 = A_BLD(rv_, (sr_ * VS_(B_) + sc_) * 2, sov_); S.st_v1 = A_BLD(rv_, ((32 + sr_) * VS_(B_) + sc_) * 2, sov_); \
        _Pragma("unroll") for (int j_ = 0; j_ < C::KCH; ++j_) { const int q_ = t_ + 512 * j_; S.st_k[j_] = A_BLD(rk_, ((q_ / C::NKC) * KS_(B_) + (q_ % C::NKC) * 8) * 2, sok_); } } while (0)
#else
#define A_SLOAD(B_, k0) do { const __amdgpu_buffer_rsrc_t rv_ = A_RSRC(wsb + (B_).vo), rk_ = A_RSRC(wsb + (B_).ko); const int sov_ = (k0) * VS_(B_) * 2, sok_ = (k0) * KS_(B_) * 2; \
        S.st_v0 = A_BLD(rv_, (sr * VS_(B_) + sc) * 2, sov_); S.st_v1 = A_BLD(rv_, ((32 + sr) * VS_(B_) + sc) * 2, sov_); \
        _Pragma("unroll") for (int j_ = 0; j_ < C::KCH; ++j_) S.st_k[j_] = A_BLD(rk_, (krow[j_] * KS_(B_) + kcol[j_]) * 2, sok_); } while (0)
#endif
#define A_QLOAD(B_) do { const __amdgpu_buffer_rsrc_t rq_ = A_RSRC(wsb + (B_).qo); const int soq_ = ((B_).P0 + wid * QBLK) * QS_(B_) * 2; const int qo_ = r32 * QS_(B_) * 2 + hi * 16; \
        _Pragma("unroll") for (int d0 = 0; d0 < C::NQF; ++d0) S.qr[d0] = A_BLD(rq_, qo_ + d0 * 32, soq_); } while (0)
#define A_SWRITE_K(bf) do { _Pragma("unroll") for (int j_ = 0; j_ < C::KCH; ++j_) *(bf16x8*)(K_lds + (bf) * C::SHM_K + kws[j_]) = S.st_k[j_]; } while (0)
#define A_SWRITE_V(bf) do { *(bf16x8*)(V_lds + (bf) * SHM_V + vst0) = S.st_v0; *(bf16x8*)(V_lds + (bf) * SHM_V + vst1) = S.st_v1; } while (0)
#define A_STAGE_IDX() const int sr = tid >> 4, sc = (tid & 15) * 8; int krow[C::KCH], kcol[C::KCH], kws[C::KCH]; \
        _Pragma("unroll") for (int j_ = 0; j_ < C::KCH; ++j_) { const int q_ = tid + 512 * j_; krow[j_] = q_ / C::NKC; kcol[j_] = (q_ % C::NKC) * 8; kws[j_] = krow[j_] * C::KPITCH + ((kcol[j_] * 2) ^ ((krow[j_] & 7) << 4)); }

__device__ __forceinline__ void store_o_staged(const f32x16* o, const float* rli, char* stg, __amdgpu_buffer_rsrc_t ro_, int rowbytes, int so0_, int lane) {
    const int r32 = lane & 31, hi = lane >> 5, odd = lane & 1, g = odd | (hi << 1);
    char* wb = stg + (odd + 4 * hi) * 256 + (r32 >> 1) * 4;
    char* wa[4];
#pragma unroll
    for (int d0 = 0; d0 < 4; ++d0) wa[d0] = wb + ((d0 ^ g) << 6);
    const int lr = lane >> 4, ch = lane & 15, sp = ch >> 2, gl = lr & 1;
    const char* rb_e = stg + lr * 256 + ((sp ^ gl) << 6) + (lane & 3) * 16;
    const char* rb_o = stg + lr * 256 + ((sp ^ (gl | 2)) << 6) + (lane & 3) * 16;
    const int voff = lr * rowbytes + ch * 16;
#pragma unroll
    for (int h = 0; h < 2; ++h) {
#pragma unroll
        for (int rp = 0; rp < 4; ++rp) { const int r = 8 * h + 2 * rp, Rl = (r & 3) + 8 * ((r >> 2) & 1);
#pragma unroll
            for (int d0 = 0; d0 < 4; ++d0) { const float v0 = o[d0][r] * rli[r], v1 = o[d0][r + 1] * rli[r + 1];
                const float send = odd ? v0 : v1;
                const float recv = __int_as_float(__builtin_amdgcn_update_dpp(0, __float_as_int(send), 0xB1, 0xF, 0xF, true));
                *reinterpret_cast<unsigned*>(wa[d0] + Rl * 256) = cvtpk(odd ? recv : v0, odd ? v1 : recv); } }
        u32x4 d_[4];
#pragma unroll
        for (int i = 0; i < 4; ++i) d_[i] = *reinterpret_cast<const u32x4*>(((i & 1) ? rb_o : rb_e) + i * 1024);
#pragma unroll
        for (int i = 0; i < 4; ++i) __builtin_amdgcn_raw_buffer_store_b128(d_[i], ro_, voff + so0_ + (16 * h + 4 * i) * rowbytes, 0, 0);
    }
}
constexpr int DEFER_STG = 65536, DEFER_WS = 131072 + 512;
__device__ __forceinline__ void stage_write(const f32x16* o, const float* rli, char* stg, int lane) {
    const int r32 = lane & 31, hi = lane >> 5, odd = lane & 1, g = odd | (hi << 1);
    char* wb = stg + (odd + 4 * hi) * 256 + (r32 >> 1) * 4;
    char* wa[4];
#pragma unroll
    for (int d0 = 0; d0 < 4; ++d0) wa[d0] = wb + ((d0 ^ g) << 6);
#pragma unroll
    for (int h = 0; h < 2; ++h)
#pragma unroll
        for (int rp = 0; rp < 4; ++rp) { const int r = 8 * h + 2 * rp, Rl = (r & 3) + 8 * ((r >> 2) & 1);
#pragma unroll
            for (int d0 = 0; d0 < 4; ++d0) { const float v0 = o[d0][r] * rli[r], v1 = o[d0][r + 1] * rli[r + 1];
                const float send = odd ? v0 : v1;
                const float recv = __int_as_float(__builtin_amdgcn_update_dpp(0, __float_as_int(send), 0xB1, 0xF, 0xF, true));
                *reinterpret_cast<unsigned*>(wa[d0] + h * 4096 + Rl * 256) = cvtpk(odd ? recv : v0, odd ? v1 : recv); } }
}
__device__ __forceinline__ void flush_piece(const char* stg, int p, const char* obase, int rowbytes, int so0, int lane) {
    const int lr = lane >> 4, ch = lane & 15, sp = ch >> 2, g = (lr & 1) | ((p & 1) << 1);
    const u32x4 d = *reinterpret_cast<const u32x4*>(stg + p * 1024 + lr * 256 + ((sp ^ g) << 6) + (lane & 3) * 16);
    __builtin_amdgcn_raw_buffer_store_b128(d, A_RSRC(obase), lr * rowbytes + ch * 16 + so0 + 4 * p * rowbytes, 0, 0);
}
struct ConvCtx { const float* eg; const float* eu; const float* ed; unsigned char* w13; unsigned char* w2; int gw; };
constexpr int CONV_SCR = 86016, CONV_NJ = 48;
#ifndef CONV_AUX
#define CONV_AUX 2
#endif
struct ConvItem { const float* src; unsigned char* dst; int ldw, kd; };
__device__ __forceinline__ ConvItem conv_decode(const ConvCtx& X, int j) {
    const int q = X.gw + 2048 * j, e = q / 6144, r = q - e * 6144, m = r >> 11, r2 = r & 2047;
    ConvItem I;
    if (m < 2) { const int kb = r2 >> 6, nb = r2 & 63, n0 = nb * 16; I.ldw = 1024; I.kd = 2048;
        I.src = (m == 0 ? X.eg : X.eu) + (size_t)e * (2048 * 1024) + (size_t)kb * (64 * 1024) + n0;
        I.dst = X.w13 + (size_t)e * (2048 * 2048) + (size_t)((n0 >> 7) * 256 + (m == 1 ? 128 : 0) + (n0 & 127)) * 2048 + kb * 64; }
    else { const int kb = r2 >> 7, nb = r2 & 127; I.ldw = 2048; I.kd = 1024;
        I.src = X.ed + (size_t)e * (1024 * 2048) + (size_t)kb * (64 * 2048) + nb * 16;
        I.dst = X.w2 + (size_t)e * (2048 * 1024) + (size_t)(nb * 16) * 1024 + kb * 64; }
    return I;
}
__device__ __forceinline__ void conv_load(const ConvCtx& X, int j, int qd, float* cv, int lane) {
    const ConvItem I = conv_decode(X, j); const __amdgpu_buffer_rsrc_t rs = A_RSRC(I.src);
#pragma unroll
    for (int i = 0; i < 4; ++i) { const int k = 4 * (4 * qd + i) + (lane >> 4);
        cv[i] = __uint_as_float(__builtin_amdgcn_raw_buffer_load_b32(rs, (k * I.ldw + (lane & 15)) * 4, 0, CONV_AUX)); }
}
__device__ __forceinline__ void conv_put(const ConvCtx& X, int j, int qd, const float* cv, char* scr, int lane) {
    float* s = reinterpret_cast<float*>(scr);
#pragma unroll
    for (int i = 0; i < 4; ++i) { const int k = 4 * (4 * qd + i) + (lane >> 4); s[k * 17 + (lane & 15)] = cv[i] * 256.0f; }
    if (qd == 3) {
        const ConvItem I = conv_decode(X, j); const int n = lane & 15, kq = lane >> 4; const float* c = s + (16 * kq) * 17 + n;
        u32x4 w;
        { int w0 = 0, w1 = 0, w2 = 0, w3 = 0;
          w0 = __builtin_amdgcn_cvt_pk_fp8_f32(c[0 * 17], c[1 * 17], w0, false); w0 = __builtin_amdgcn_cvt_pk_fp8_f32(c[2 * 17], c[3 * 17], w0, true);
          w1 = __builtin_amdgcn_cvt_pk_fp8_f32(c[4 * 17], c[5 * 17], w1, false); w1 = __builtin_amdgcn_cvt_pk_fp8_f32(c[6 * 17], c[7 * 17], w1, true);
          w2 = __builtin_amdgcn_cvt_pk_fp8_f32(c[8 * 17], c[9 * 17], w2, false); w2 = __builtin_amdgcn_cvt_pk_fp8_f32(c[10 * 17], c[11 * 17], w2, true);
          w3 = __builtin_amdgcn_cvt_pk_fp8_f32(c[12 * 17], c[13 * 17], w3, false); w3 = __builtin_amdgcn_cvt_pk_fp8_f32(c[14 * 17], c[15 * 17], w3, true);
          w = (u32x4){(unsigned)w0, (unsigned)w1, (unsigned)w2, (unsigned)w3}; }
        __builtin_amdgcn_raw_buffer_store_b128(w, A_RSRC(I.dst), n * I.kd + 16 * kq, 0, CONV_AUX);
    }
}
constexpr unsigned ROPE_OFF = 2u << 20;
#define A_RTLOAD(B_) do { const __amdgpu_buffer_rsrc_t rr_ = A_RSRC(wsb + ROPE_OFF); const int vo_ = ((B_).P0 + wid * QBLK + r32) * 256 + hi * 32; \
        _Pragma("unroll") for (int d_ = 0; d_ < 4; ++d_) { S.rt[2 * d_] = __builtin_bit_cast(f32x4, __builtin_amdgcn_raw_buffer_load_b128(rr_, vo_ + d_ * 64, 0, 0)); \
                                                            S.rt[2 * d_ + 1] = __builtin_bit_cast(f32x4, __builtin_amdgcn_raw_buffer_load_b128(rr_, vo_ + d_ * 64 + 16, 0, 0)); } } while (0)
__device__ __forceinline__ unsigned rope_pair(unsigned w, float c, float s) { const float x1 = __uint_as_float(w << 16), x2 = __uint_as_float(w & 0xffff0000u); return cvtpk(x1 * c - x2 * s, x2 * c + x1 * s); }
#define A_ROTATE() do { _Pragma("unroll") for (int d_ = 0; d_ < 4; ++d_) { u32x4 w_ = __builtin_bit_cast(u32x4, S.qr[8 + d_]); const f32x4 c01_ = S.rt[2 * d_], c23_ = S.rt[2 * d_ + 1]; \
        w_.x = rope_pair(w_.x, c01_[0], c01_[1]); w_.y = rope_pair(w_.y, c01_[2], c01_[3]); w_.z = rope_pair(w_.z, c23_[0], c23_[1]); w_.w = rope_pair(w_.w, c23_[2], c23_[3]); \
        S.qr[8 + d_] = __builtin_bit_cast(bf16x8, w_); } } while (0)
template <int DQK, bool DIL, int PVAR = 0, bool ROPE = false>
__device__ __forceinline__ void att_prime(const Blk& cur, const char* wsb, char* lds, Seam<DQK>& S, int tid_in) {
    typedef Cfg<DQK> C;
    int tid = tid_in; asm volatile("" : "+v"(tid));
    const int wid = __builtin_amdgcn_readfirstlane(tid >> 6), lane = tid & 63, r32 = lane & 31, hi = lane >> 5;
    A_STAGE_IDX(); char* K_lds = lds + 2 * SHM_V;
    const int kb0 = swa_jlo(cur.P0, W_(cur)) * KVBLK;
    A_QLOAD(cur);
    if constexpr (ROPE) A_RTLOAD(cur);
    A_SLOAD(cur, kb0); VMW(); A_SWRITE_K(0);
    __syncthreads();
}
template <int DQK, bool DIL, bool SK, int PVAR = 0, bool CONV = false, bool ROPE = false>
__device__ __forceinline__ void att_block(const Blk& cur, const Blk& nxt, const char* wsb, char* lds, Seam<DQK>& S, int tid_in, const ConvCtx* X = nullptr) {
    typedef Cfg<DQK> C;
    int tid = tid_in; asm volatile("" : "+v"(tid));
    const int wid = __builtin_amdgcn_readfirstlane(tid >> 6), lane = tid & 63, r32 = lane & 31, hi = lane >> 5;
    const int W = W_(cur); const float scale = SCALE_, beta = cur.beta;
    int j_lo = swa_jlo(cur.P0, W);
    int j_hi = (cur.P0 + QB - 1) / KVBLK + 1; if (j_hi > SKV_(cur) / KVBLK) j_hi = SKV_(cur) / KVBLK;
    if (PVAR & 8) j_lo = j_hi - 2;
    const int NT = j_hi - j_lo;
    const int kbn = swa_jlo(nxt.P0, W_(nxt)) * KVBLK;
    const int qlo = cur.P0 + wid * QBLK, qm = qlo + r32 - 4 * hi;
    char* V_lds = lds; char* K_lds = lds + 2 * SHM_V;
#ifdef ATT_DEFER
    constexpr bool DEFER = DIL;
#else
    constexpr bool DEFER = false;
#endif
    float* ws = (float*)(lds + (DEFER ? DEFER_WS : 2 * SHM_V + 2 * C::SHM_K)) + wid * 64; float* li_l = ws, * al_l = ws + 32;
    char* stg = lds + DEFER_STG + wid * 8192;
    float m_reg = -1e30f, l_reg = 0; f32x16 o[4] = {};
    A_STAGE_IDX();
    const int vst0 = v_st(sr, sc), vst1 = v_st(32 + sr, sc);
    const int vb0 = (int)(uintptr_t)V_lds + v_rd_base(lane);
#define RESC(a) do { if (__any((a) < 1.f)) { if (hi == 0) al_l[r32] = (a); asm volatile("s_waitcnt lgkmcnt(0)" ::: "memory");              \
                     _Pragma("unroll") for (int d_ = 0; d_ < 4; ++d_) _Pragma("unroll") for (int r = 0; r < 16; ++r) o[d_][r] *= al_l[crow(r, hi)]; } } while (0)
#define KBASE(t) ((j_lo + (t)) * KVBLK)
#define ACT(t) (KBASE(t) <= qlo + QBLK - 1 && KBASE(t) + KVBLK - 1 >= qlo - W + 1)
#define MASKT(P0_, P1_, t) do { const int kb_ = KBASE(t); if ((!SK || ACT(t)) && (kb_ + KVBLK - 1 > qlo || kb_ <= qlo + QBLK - 1 - W)) mask_tile(P0_, P1_, qm - kb_, (unsigned)W); } while (0)
    A_SWRITE_V(0);
    __syncthreads();
    if constexpr (ROPE) { VMW(); A_ROTATE(); }
#define STEP(t, BUF) do { const bool more_ = (t) + 1 < NT;                                                                        \
        if (more_) { A_SLOAD(cur, KBASE((t) + 1)); } else { A_SLOAD(nxt, kbn); }                                                   \
        const bool cpend_ = CONV && (S.cv_j != S.cl_j || S.cv_q != S.cl_q); const bool cld_ = CONV && more_ && S.cl_j < CONV_NJ;        \
        if (cld_) { conv_load(*X, S.cl_j, S.cl_q, BUF ? S.cw : S.cv, lane); if (++S.cl_q == 4) { S.cl_q = 0; ++S.cl_j; } }               \
        if (DEFER && S.p_on && (t) < 4) { flush_piece(stg, 2 * (t), wsb + S.p_oo, S.p_rb, S.p_so0, lane); flush_piece(stg, 2 * (t) + 1, wsb + S.p_oo, S.p_rb, S.p_so0, lane); } \
        SBAR(); f32x16 p0, p1; float mn_, al_; bf16x8 pa0, pa1, pa2, pa3;                                                            \
        qkt<BUF, SK, DQK, DIL>(p0, p1, K_lds, r32, hi, S.qr, ACT(t), beta, qm - KBASE(t)); SBAR();                                  \
        if (!more_) { A_QLOAD(nxt); SBAR(); } \
        MASKT(p0, p1, t); partialSM(p0, p1, m_reg, mn_, al_, scale); finishSM(p0, p1, al_, l_reg, pa0, pa1, pa2, pa3); RESC(al_); SBAR(); \
        pv_tile<BUF, SK>(o, vb0, pa0, pa1, pa2, pa3, ACT(t));                                                                      \
        if (more_) { if (cld_) VMWN(4); else VMW();            \
            A_SWRITE_V(1 - BUF); A_SWRITE_K(1 - BUF);                                                                              \
            if (cpend_) { conv_put(*X, S.cv_j, S.cv_q, BUF ? S.cv : S.cw, lds + CONV_SCR + wid * 4352, lane); if (++S.cv_q == 4) { S.cv_q = 0; ++S.cv_j; } } } \
        __syncthreads(); } while (0)
    int t = 0;
    for (; t + 1 < NT; t += 2) { STEP(t, 0); STEP(t + 1, 1); }
    if (t < NT) { STEP(t, 0); }
    VMWN(C::NQF); A_SWRITE_K(0); SBAR();
    if (CONV && (S.cv_j != S.cl_j || S.cv_q != S.cl_q)) { conv_put(*X, S.cv_j, S.cv_q, S.cv, lds + CONV_SCR + wid * 4352, lane); if (++S.cv_q == 4) { S.cv_q = 0; ++S.cv_j; } }
    if (hi == 0) li_l[r32] = l_reg; asm volatile("s_waitcnt lgkmcnt(0)" ::: "memory");
    if constexpr (DIL) { if (hi == 0) __builtin_amdgcn_raw_buffer_store_b32(__float_as_uint(m_reg * scale + __logf(l_reg)), A_RSRC(wsb + cur.lo), r32 * LS_(cur) * 4, (cur.P0 + wid * QBLK) * LS_(cur) * 4, 0); }
    float rli[16];
#pragma unroll
    for (int r = 0; r < 16; ++r) rli[r] = __builtin_amdgcn_rcpf(li_l[crow(r, hi)]);
    if constexpr (DEFER) { stage_write(o, rli, stg, lane); S.p_oo = cur.oo; S.p_rb = OS_(cur) * 2; S.p_so0 = (cur.P0 + wid * QBLK) * OS_(cur) * 2; S.p_on = 1; }
    else {
#ifdef ATT_T21
    store_o_staged(o, rli, wid < 4 ? lds + SHM_V + wid * 4096 : lds + 2 * SHM_V + C::SHM_K + (wid - 4) * 4096, A_RSRC(wsb + cur.oo), OS_(cur) * 2, (cur.P0 + wid * QBLK) * OS_(cur) * 2, lane);
#else
    const int os_ = (PVAR & 1) ? 0 : OS_(cur);
    const __amdgpu_buffer_rsrc_t ro_ = A_RSRC(wsb + cur.oo); const int oo_ = (4 * hi * os_ + r32) * 2, so0_ = (cur.P0 + wid * QBLK) * os_ * 2;
#pragma unroll
    for (int r = 0; r < 16; ++r) { const int sor_ = so0_ + ((r & 3) + 8 * (r >> 2)) * os_ * 2;
#pragma unroll
        for (int d0 = 0; d0 < 4; ++d0) { const float v = o[d0][r] * rli[r];
            const float vn = __int_as_float(__builtin_amdgcn_update_dpp(0, __float_as_int(v), 0xB1, 0xF, 0xF, true));
            if ((r32 & 1) == 0) __builtin_amdgcn_raw_buffer_store_b32(cvtpk(v, vn), ro_, oo_ + d0 * 64, sor_, 0); } }
#endif
    }
    if constexpr (ROPE) A_RTLOAD(nxt);
#undef RESC
#undef KBASE
#undef ACT
#undef MASKT
#undef STEP
}

template <int DQK> struct SeamD { bf16x8 qr[Cfg<DQK>::NQF]; };
#define A_GLDS(voff, sbase, ldsdst) do { unsigned keep_; asm volatile("s_mov_b32 %0, m0\n\ts_mov_b32 m0, %2\n\ts_nop 0\n\tglobal_load_lds_dwordx4 %1, %3\n\ts_mov_b32 m0, %0" \
        : "=&s"(keep_) : "v"(voff), "s"((unsigned)__builtin_amdgcn_readfirstlane((int)(ldsdst))), "s"((const void*)(sbase)) : "memory"); } while (0)
#define A_DMA_IDX() int krow_[C::KCH], kcb_[C::KCH], vrow_[2], vcb_[2]; \
        _Pragma("unroll") for (int j_ = 0; j_ < C::KCH; ++j_) { const int p_ = (j_ * 8 + wid) * 1024 + lane * 16, row_ = p_ / C::KPITCH, pc_ = (p_ % C::KPITCH) / 16, lc_ = (pc_ & ~7) | ((pc_ & 7) ^ (row_ & 7)); \
            krow_[j_] = row_; kcb_[j_] = lc_ * 16; } \
        _Pragma("unroll") for (int j_ = 0; j_ < 2; ++j_) { const int p_ = (j_ * 8 + wid) * 1024 + lane * 16, s_ = p_ / 512, w_ = p_ % 512, kk_ = (s_ >> 2) * 8 + (w_ >> 6), col_ = (s_ & 3) * 32 + ((w_ & 63) >> 1); \
            vrow_[j_] = (kk_ & ~0xC) | ((kk_ & 4) << 1) | ((kk_ & 8) >> 1); vcb_[j_] = col_ * 2; }
#define A_DMA(B_, k0, sl_) do { const char* kb_ = wsb + (B_).ko + (size_t)(k0) * (size_t)(KS_(B_) * 2); const char* vb_ = wsb + (B_).vo + (size_t)(k0) * (size_t)(VS_(B_) * 2); \
        _Pragma("unroll") for (int j_ = 0; j_ < C::KCH; ++j_) A_GLDS((unsigned)(krow_[j_] * KS_(B_) * 2 + kcb_[j_]), kb_, lds0 + NS * SHM_V + (sl_) * C::SHM_K + (j_ * 8 + wid) * 1024); \
        _Pragma("unroll") for (int j_ = 0; j_ < 2; ++j_) A_GLDS((unsigned)(vrow_[j_] * VS_(B_) * 2 + vcb_[j_]), vb_, lds0 + (sl_) * SHM_V + (j_ * 8 + wid) * 1024); } while (0)
template <int DQK, bool DIL, int NS>
__device__ __forceinline__ void att_prime_dma(const Blk& cur, const char* wsb, char* lds, SeamD<DQK>& S, int tid_in) {
    typedef Cfg<DQK> C;
    int tid = tid_in; asm volatile("" : "+v"(tid));
    const int wid = __builtin_amdgcn_readfirstlane(tid >> 6), lane = tid & 63, r32 = lane & 31, hi = lane >> 5;
    const unsigned lds0 = (unsigned)(uintptr_t)lds;
    A_DMA_IDX();
    const int kb0 = swa_jlo(cur.P0, W_(cur)) * KVBLK;
    A_QLOAD(cur);
#pragma unroll
    for (int i_ = 0; i_ < NS - 1; ++i_) A_DMA(cur, kb0 + i_ * KVBLK, i_);
}
template <int DQK, bool DIL, bool SK, int NS>
__device__ __forceinline__ void att_block_dma(const Blk& cur, const Blk& nxt, const char* wsb, char* lds, char* wsl, SeamD<DQK>& S, int tid_in) {
    typedef Cfg<DQK> C;
    int tid = tid_in; asm volatile("" : "+v"(tid));
    const int wid = __builtin_amdgcn_readfirstlane(tid >> 6), lane = tid & 63, r32 = lane & 31, hi = lane >> 5;
    const int W = W_(cur); const float scale = SCALE_, beta = cur.beta;
    const int j_lo = swa_jlo(cur.P0, W);
    int j_hi = (cur.P0 + QB - 1) / KVBLK + 1; if (j_hi > SKV_(cur) / KVBLK) j_hi = SKV_(cur) / KVBLK;
    const int NT = j_hi - j_lo;
    const int kbn = swa_jlo(nxt.P0, W_(nxt)) * KVBLK;
    const int qlo = cur.P0 + wid * QBLK, qm = qlo + r32 - 4 * hi;
    const unsigned lds0 = (unsigned)(uintptr_t)lds;
    const char* K_lds = lds + NS * SHM_V;
    float* ws = (float*)wsl + wid * 64; float* li_l = ws, * al_l = ws + 32;
    float m_reg = -1e30f, l_reg = 0; f32x16 o[4] = {};
    A_DMA_IDX();
    const int vb0 = (int)lds0 + v_rd_base(lane);
    constexpr int NDMA = C::KCH + 2;
#define RESC(a) do { if (__any((a) < 1.f)) { if (hi == 0) al_l[r32] = (a); asm volatile("s_waitcnt lgkmcnt(0)" ::: "memory");              \
                     _Pragma("unroll") for (int d_ = 0; d_ < 4; ++d_) _Pragma("unroll") for (int r = 0; r < 16; ++r) o[d_][r] *= al_l[crow(r, hi)]; } } while (0)
#define KBASE(t) ((j_lo + (t)) * KVBLK)
#define ACT(t) (KBASE(t) <= qlo + QBLK - 1 && KBASE(t) + KVBLK - 1 >= qlo - W + 1)
#define MASKT(P0_, P1_, t) do { const int kb_ = KBASE(t); if ((!SK || ACT(t)) && (kb_ + KVBLK - 1 > qlo || kb_ <= qlo + QBLK - 1 - W)) mask_tile(P0_, P1_, qm - kb_, (unsigned)W); } while (0)
    VMW();
#pragma unroll
    for (int d0 = 0; d0 < C::NQF; ++d0) asm volatile("" : "+v"(S.qr[d0]));
    asm volatile("s_waitcnt lgkmcnt(0)" ::: "memory"); __builtin_amdgcn_s_barrier(); asm volatile("" ::: "memory");
    int sl = 0, sl2 = NS - 1;
#pragma unroll 1
    for (int t = 0; t < NT; ++t) {
        const bool pre = t + NS - 1 < NT;
        if (pre) A_DMA(cur, KBASE(t + NS - 1), sl2);
        SBAR(); f32x16 p0, p1; float mn_, al_; bf16x8 pa0, pa1, pa2, pa3;
        qkt<0, SK, DQK, DIL>(p0, p1, K_lds + sl * C::SHM_K, r32, hi, S.qr, ACT(t), beta, qm - KBASE(t)); SBAR();
        MASKT(p0, p1, t); partialSM(p0, p1, m_reg, mn_, al_, scale); finishSM(p0, p1, al_, l_reg, pa0, pa1, pa2, pa3); RESC(al_); SBAR();
        pv_tile<0, SK>(o, vb0 + sl * SHM_V, pa0, pa1, pa2, pa3, ACT(t));
        if (t + 1 < NT) { int infl = NT - 2 - t; if (infl > NS - 2) infl = NS - 2;
                          if (infl <= 0) VMW(); else if (infl == 1) VMWN(NDMA); else VMWN(2 * NDMA);
                          asm volatile("s_waitcnt lgkmcnt(0)" ::: "memory"); __builtin_amdgcn_s_barrier(); asm volatile("" ::: "memory"); }
        sl = sl == NS - 1 ? 0 : sl + 1; sl2 = sl2 == NS - 1 ? 0 : sl2 + 1;
    }
    asm volatile("s_waitcnt lgkmcnt(0)" ::: "memory"); __builtin_amdgcn_s_barrier(); asm volatile("" ::: "memory");
    A_QLOAD(nxt);
#pragma unroll
    for (int i_ = 0; i_ < NS - 1; ++i_) A_DMA(nxt, kbn + i_ * KVBLK, i_);
    if (hi == 0) li_l[r32] = l_reg; asm volatile("s_waitcnt lgkmcnt(0)" ::: "memory");
    if constexpr (DIL) { if (hi == 0) __builtin_amdgcn_raw_buffer_store_b32(__float_as_uint(m_reg * scale + __logf(l_reg)), A_RSRC(wsb + cur.lo), r32 * LS_(cur) * 4, (cur.P0 + wid * QBLK) * LS_(cur) * 4, 0); }
    float rli[16];
#pragma unroll
    for (int r = 0; r < 16; ++r) rli[r] = __builtin_amdgcn_rcpf(li_l[crow(r, hi)]);
    const __amdgpu_buffer_rsrc_t ro_ = A_RSRC(wsb + cur.oo); const int oo_ = (4 * hi * OS_(cur) + r32) * 2, so0_ = (cur.P0 + wid * QBLK) * OS_(cur) * 2;
#pragma unroll
    for (int r = 0; r < 16; ++r) { const int sor_ = so0_ + ((r & 3) + 8 * (r >> 2)) * OS_(cur) * 2;
#pragma unroll
        for (int d0 = 0; d0 < 4; ++d0) { const float v = o[d0][r] * rli[r];
            const float vn = __int_as_float(__builtin_amdgcn_update_dpp(0, __float_as_int(v), 0xB1, 0xF, 0xF, true));
            if ((r32 & 1) == 0) __builtin_amdgcn_raw_buffer_store_b32(cvtpk(v, vn), ro_, oo_ + d0 * 64, sor_, 0); } }
#undef RESC
#undef KBASE
#undef ACT
#undef MASKT
}

template <bool SK, int DQK, bool DIL>
__device__ __forceinline__ void qkt_fin(f32x16& p0, f32x16& p1, const char* K_lds, int r32, int hi, const bf16x8* qr, bool act, float beta, int dq,
                                        f32x16& y0, f32x16& y1, float alpha, float& l_reg, bf16x8& pa0, bf16x8& pa1, bf16x8& pa2, bf16x8& pa3) {
    typedef Cfg<DQK> C;
    const bool run = !(SK && !act);
    if (!run) { const float NEG = -__builtin_inff();
#pragma unroll
        for (int r = 0; r < 16; ++r) { p0[r] = NEG; p1[r] = NEG; } }
    else if constexpr (DIL) { const float b0 = -beta * (float)dq;
#pragma unroll
        for (int r = 0; r < 16; ++r) { const int c = (r & 3) + 8 * (r >> 2); p0[r] = fmaf(beta, (float)c, b0); p1[r] = fmaf(beta, (float)(c + 32), b0); } }
    else { p0 = f32x16{}; p1 = f32x16{}; }
    const char* kb[4];
#pragma unroll
    for (int dd = 0; dd < 4; ++dd) { const int colB = (dd * 16 + hi * 8) * 2; kb[dd] = K_lds + r32 * C::KPITCH + (colB ^ ((r32 & 7) << 4)); }
#define QK_CHUNK(c_) do { if (run) { _Pragma("unroll") for (int d0 = 4 * (c_); d0 < 4 * (c_) + 4 && d0 < C::NQF; ++d0) { const char* a = kb[d0 & 3] + (d0 >> 2) * 128; \
            bf16x8 b0 = *reinterpret_cast<const bf16x8*>(a); bf16x8 b1 = *reinterpret_cast<const bf16x8*>(a + 32 * C::KPITCH);                                  \
            p0 = __builtin_amdgcn_mfma_f32_32x32x16_bf16(b0, qr[d0], p0, 0, 0, 0); p1 = __builtin_amdgcn_mfma_f32_32x32x16_bf16(b1, qr[d0], p1, 0, 0, 0); } } } while (0)
#define PK4(P, B_, OUT) do { unsigned a0 = cvtpk(P[B_+0], P[B_+1]), a1 = cvtpk(P[B_+2], P[B_+3]);                          \
        unsigned b0 = cvtpk(P[B_+4], P[B_+5]), b1 = cvtpk(P[B_+6], P[B_+7]);                                             \
        auto r0 = __builtin_amdgcn_permlane32_swap(a0, b0, false, false); auto r1 = __builtin_amdgcn_permlane32_swap(a1, b1, false, false); \
        u32x4 w = {r0[0], r1[0], r0[1], r1[1]}; OUT = *reinterpret_cast<bf16x8*>(&w); } while (0)
    QK_CHUNK(0);
#pragma unroll
    for (int r = 0; r < 16; ++r) y1[r] = __builtin_amdgcn_exp2f(y1[r]);
    float ps = 0;
#pragma unroll
    for (int r = 0; r < 16; ++r) ps += y0[r];
#pragma unroll
    for (int r = 0; r < 16; ++r) ps += y1[r];
    SBAR();
    QK_CHUNK(1);
    { auto rr = __builtin_amdgcn_permlane32_swap(__float_as_uint(ps), __float_as_uint(ps), false, false);
      ps = __uint_as_float(rr[0]) + __uint_as_float(rr[1]); }
    l_reg = l_reg * alpha + ps;
    PK4(y0, 0, pa0); PK4(y0, 8, pa1);
    if constexpr (C::NQF > 8) { SBAR(); QK_CHUNK(2); }
    PK4(y1, 0, pa2); PK4(y1, 8, pa3);
#undef PK4
#undef QK_CHUNK
}
#ifndef ATT_SKEW_SEL
#define ATT_SKEW_SEL 0
#endif
#if ATT_SKEW_SEL == 0
#define ATT_SKEW_A (wid < 4)
#elif ATT_SKEW_SEL == 1
#define ATT_SKEW_A ((wid & 1) == 0)
#elif ATT_SKEW_SEL == 2
#define ATT_SKEW_A true
#else
#define ATT_SKEW_A false
#endif
#define A_DMA_K(B_, k0, sl_) do { const char* kb_ = wsb + (B_).ko + (size_t)(k0) * (size_t)(KS_(B_) * 2); int ln_ = lane; asm volatile("" : "+v"(ln_)); \
        _Pragma("unroll") for (int j_ = 0; j_ < C::KCH; ++j_) { const int p_ = (j_ * 8 + wid) * 1024 + ln_ * 16, row_ = p_ / C::KPITCH, pc_ = (p_ % C::KPITCH) / 16, lc_ = (pc_ & ~7) | ((pc_ & 7) ^ (row_ & 7)); \
            A_GLDS((unsigned)(row_ * KS_(B_) * 2 + lc_ * 16), kb_, lds0 + 3 * SHM_V + (sl_) * C::SHM_K + (j_ * 8 + wid) * 1024); } } while (0)
#define A_DMA_V(B_, k0, sl_) do { const char* vb_ = wsb + (B_).vo + (size_t)(k0) * (size_t)(VS_(B_) * 2); int ln_ = lane; asm volatile("" : "+v"(ln_)); \
        _Pragma("unroll") for (int j_ = 0; j_ < 2; ++j_) { const int p_ = (j_ * 8 + wid) * 1024 + ln_ * 16, s_ = p_ / 512, w_ = p_ % 512, kk_ = (s_ >> 2) * 8 + (w_ >> 6), col_ = (s_ & 3) * 32 + ((w_ & 63) >> 1); \
            const int vr_ = (kk_ & ~0xC) | ((kk_ & 4) << 1) | ((kk_ & 8) >> 1); \
            A_GLDS((unsigned)(vr_ * VS_(B_) * 2 + col_ * 2), vb_, lds0 + (sl_) * SHM_V + (j_ * 8 + wid) * 1024); } } while (0)
#define A_RAWBAR() do { asm volatile("s_waitcnt lgkmcnt(0)" ::: "memory"); __builtin_amdgcn_s_barrier(); asm volatile("" ::: "memory"); } while (0)
template <int DQK, bool DIL>
__device__ __forceinline__ void att_prime_dma2(const Blk& cur, const char* wsb, char* lds, SeamD<DQK>& S, int tid_in) {
    typedef Cfg<DQK> C; constexpr int NS = 3;
    int tid = tid_in; asm volatile("" : "+v"(tid));
    const int wid = __builtin_amdgcn_readfirstlane(tid >> 6), lane = tid & 63, r32 = lane & 31, hi = lane >> 5;
    const unsigned lds0 = (unsigned)(uintptr_t)lds;
    const int kb0 = swa_jlo(cur.P0, W_(cur)) * KVBLK;
    A_QLOAD(cur);
    A_DMA_K(cur, kb0, 0); A_DMA_V(cur, kb0, 0); A_DMA_K(cur, kb0 + KVBLK, 1);
}
template <int DQK, bool DIL, bool SK, int ORD>
__device__ __forceinline__ void att_block_dma2(const Blk& cur, const Blk& nxt, const char* wsb, char* lds, SeamD<DQK>& S, int tid_in) {
    typedef Cfg<DQK> C; constexpr int NS = 3;
    int tid = tid_in; asm volatile("" : "+v"(tid));
    const int wid = __builtin_amdgcn_readfirstlane(tid >> 6), lane = tid & 63, r32 = lane & 31, hi = lane >> 5;
    const int W = W_(cur); const float scale = SCALE_, beta = cur.beta;
    const int j_lo = swa_jlo(cur.P0, W);
    int j_hi = (cur.P0 + QB - 1) / KVBLK + 1; if (j_hi > SKV_(cur) / KVBLK) j_hi = SKV_(cur) / KVBLK;
    const int NT = j_hi - j_lo;
    const int kbn = swa_jlo(nxt.P0, W_(nxt)) * KVBLK;
    const int qlo = cur.P0 + wid * QBLK, qm = qlo + r32 - 4 * hi;
    const unsigned lds0 = (unsigned)(uintptr_t)lds;
    const char* K_lds = lds + 3 * SHM_V;
    float* ws = (float*)(lds + 3 * SHM_V + 3 * C::SHM_K) + wid * 64; float* li_l = ws, * al_l = ws + 32;
    float m_reg = -1e30f, l_reg = 0; f32x16 o[4] = {};
    const int vb0 = (int)lds0 + v_rd_base(lane);
#define RESC(a) do { if (__any((a) < 1.f)) { if (hi == 0) al_l[r32] = (a); asm volatile("s_waitcnt lgkmcnt(0)" ::: "memory");              \
                     _Pragma("unroll") for (int d_ = 0; d_ < 4; ++d_) _Pragma("unroll") for (int r = 0; r < 16; ++r) o[d_][r] *= al_l[crow(r, hi)]; } } while (0)
#define KBASE(t) ((j_lo + (t)) * KVBLK)
#define ACT(t) (KBASE(t) <= qlo + QBLK - 1 && KBASE(t) + KVBLK - 1 >= qlo - W + 1)
#define MASKT(P0_, P1_, t) do { const int kb_ = KBASE(t); if ((!SK || ACT(t)) && (kb_ + KVBLK - 1 > qlo || kb_ <= qlo + QBLK - 1 - W)) mask_tile(P0_, P1_, qm - kb_, (unsigned)W); } while (0)
#define ISSUE(t, n_) do { n_ = 0; if ((t) + 2 < NT) { int slotk_ = sl + 2; if (slotk_ >= 3) slotk_ -= 3; A_DMA_K(cur, KBASE((t) + 2), slotk_); n_ += C::KCH; } \
                          if ((t) + 1 < NT) { int slotv_ = sl + 1; if (slotv_ >= 3) slotv_ -= 3; A_DMA_V(cur, KBASE((t) + 1), slotv_); n_ += 2; } } while (0)
#define CLOSE(n_) do { if ((n_) == C::KCH + 2) VMWN(C::KCH + 2); else if ((n_) == 2) VMWN(2); else VMW(); A_RAWBAR(); } while (0)
    VMW();
#pragma unroll
    for (int d0 = 0; d0 < C::NQF; ++d0) asm volatile("" : "+v"(S.qr[d0]));
    A_RAWBAR();
    int sl = 0, slp = 2, nis;
    f32x16 pA0, pA1, pB0, pB1; float mnA, mnB, alA, alB; bf16x8 pa0, pa1, pa2, pa3;
    ISSUE(0, nis); SBAR();
    qkt<0, SK, DQK, DIL>(pA0, pA1, K_lds + sl * C::SHM_K, r32, hi, S.qr, ACT(0), beta, qm - KBASE(0)); SBAR();
    MASKT(pA0, pA1, 0); partialSM(pA0, pA1, m_reg, mnA, alA, scale);
    CLOSE(nis); slp = sl; sl = sl == 2 ? 0 : sl + 1;
#define STEPP(PX0, PX1, mnX, alX, PY0, PY1, alY, t) do { ISSUE(t, nis); SBAR();                                               \
        if constexpr (ORD == 0) {                                                                                               \
            qkt<0, SK, DQK, DIL>(PX0, PX1, K_lds + sl * C::SHM_K, r32, hi, S.qr, ACT(t), beta, qm - KBASE(t)); SBAR();           \
            finishSM(PY0, PY1, alY, l_reg, pa0, pa1, pa2, pa3); SBAR();                                                         \
            pv_tile<0, SK>(o, vb0 + slp * SHM_V, pa0, pa1, pa2, pa3, ACT((t) - 1)); SBAR();                                     \
        } else {                                                                                                                \
            finishSM(PY0, PY1, alY, l_reg, pa0, pa1, pa2, pa3); SBAR();                                                         \
            pv_tile<0, SK>(o, vb0 + slp * SHM_V, pa0, pa1, pa2, pa3, ACT((t) - 1)); SBAR();                                     \
            qkt<0, SK, DQK, DIL>(PX0, PX1, K_lds + sl * C::SHM_K, r32, hi, S.qr, ACT(t), beta, qm - KBASE(t)); SBAR();           \
        }                                                                                                                       \
        MASKT(PX0, PX1, (t)); partialSM(PX0, PX1, m_reg, mnX, alX, scale);                                                     \
        RESC(alX); CLOSE(nis); slp = sl; sl = sl == 2 ? 0 : sl + 1; } while (0)
    int t = 1;
#pragma unroll 1
    for (; t + 2 < NT; t += 2) {
        STEPP(pB0, pB1, mnB, alB, pA0, pA1, alA, t);
        STEPP(pA0, pA1, mnA, alA, pB0, pB1, alB, t + 1);
    }
    STEPP(pB0, pB1, mnB, alB, pA0, pA1, alA, t);
    finishSM(pB0, pB1, alB, l_reg, pa0, pa1, pa2, pa3); SBAR();
    pv_tile<0, SK>(o, vb0 + slp * SHM_V, pa0, pa1, pa2, pa3, ACT(NT - 1));
    A_RAWBAR();
    A_QLOAD(nxt);
    A_DMA_K(nxt, kbn, 0); A_DMA_V(nxt, kbn, 0); A_DMA_K(nxt, kbn + KVBLK, 1);
    if (hi == 0) li_l[r32] = l_reg; asm volatile("s_waitcnt lgkmcnt(0)" ::: "memory");
    if constexpr (DIL) { if (hi == 0) __builtin_amdgcn_raw_buffer_store_b32(__float_as_uint(m_reg * scale + __logf(l_reg)), A_RSRC(wsb + cur.lo), r32 * LS_(cur) * 4, (cur.P0 + wid * QBLK) * LS_(cur) * 4, 0); }
    float rli[16];
#pragma unroll
    for (int r = 0; r < 16; ++r) rli[r] = __builtin_amdgcn_rcpf(li_l[crow(r, hi)]);
    const __amdgpu_buffer_rsrc_t ro_ = A_RSRC(wsb + cur.oo); const int oo_ = (4 * hi * OS_(cur) + r32) * 2, so0_ = (cur.P0 + wid * QBLK) * OS_(cur) * 2;
#pragma unroll
    for (int r = 0; r < 16; ++r) { const int sor_ = so0_ + ((r & 3) + 8 * (r >> 2)) * OS_(cur) * 2;
#pragma unroll
        for (int d0 = 0; d0 < 4; ++d0) { const float v = o[d0][r] * rli[r];
            const float vn = __int_as_float(__builtin_amdgcn_update_dpp(0, __float_as_int(v), 0xB1, 0xF, 0xF, true));
            if ((r32 & 1) == 0) __builtin_amdgcn_raw_buffer_store_b32(cvtpk(v, vn), ro_, oo_ + d0 * 64, sor_, 0); } }
#undef RESC
#undef KBASE
#undef ACT
#undef MASKT
#undef ISSUE
#undef CLOSE
#undef STEPP
}
#undef A_DMA_K
#undef A_DMA_V
#undef A_RAWBAR
#undef A_GLDS
#undef A_DMA_IDX
#undef A_DMA
#undef VMW
#undef VMWN
#undef A_SLOAD
#undef A_RSRC
#undef A_BLD
#undef A_QLOAD
#undef A_SWRITE_K
#undef A_SWRITE_V
#undef A_STAGE_IDX
#undef SBAR
#undef QS_
#undef KS_
#undef VS_
#undef OS_
#undef LS_
#undef SKV_
#undef W_
#undef SCALE_
}
constexpr int NWAVES = 8;
constexpr int T = 32768, DM = 2048, SEQ = 8192, NB = 4, DEPTH = 2;
constexpr int IN_COLS = 3904, PROJ_LD = 4096, NEXP = 16, DEXP = 1024;
constexpr int C_QB = 0, C_KB = 1024, C_VB = 2048, C_CQ = 3072, C_CKV = 3584, C_KR = 3840;
constexpr float EPS = 1e-6f;
constexpr size_t MiB = 1u << 20;
constexpr size_t WS_CTL = 0, CTL_ZERO_BYTES = 1 * MiB;
constexpr size_t WS_MOD = 1 * MiB;
constexpr size_t WS_ROPE = 2 * MiB;
constexpr size_t WS_RSTDQ = 4 * MiB, WS_RSTDKV = 4 * MiB + 256 * 1024, WS_AW = 4 * MiB + 512 * 1024;
constexpr size_t WS_ROWIDX = 5 * MiB;
constexpr size_t WS_LSE = 8 * MiB;
constexpr size_t WS_WIN = 16 * MiB;
constexpr size_t WS_WUQ = 48 * MiB;
constexpr size_t WS_WUKV = 51 * MiB;
constexpr size_t WS_WOUT = 53 * MiB;
constexpr size_t WS_W13 = 72 * MiB;
constexpr size_t WS_W2 = 200 * MiB;
constexpr size_t WS_H = 264 * MiB;
constexpr size_t WS_PROJ = 392 * MiB;
constexpr size_t WS_QA = 648 * MiB;
constexpr size_t WS_KF = 744 * MiB;
constexpr size_t WS_VB = 840 * MiB;
constexpr size_t WS_OA = 904 * MiB;
constexpr size_t WS_OB = 968 * MiB;
constexpr size_t WS_XB = 1160 * MiB;
constexpr size_t WS_END = 1288 * MiB;
constexpr size_t WS_HMID = WS_PROJ;
constexpr size_t WS_Y = WS_QA;
constexpr int CW_TMO = 0;
constexpr int CW_CNT = 64;
constexpr int CW_BAR = 4096;
constexpr int RING_BYTES = 131072;
constexpr int L_MISC = RING_BYTES, L_TS = RING_BYTES + 256, L_CNT = RING_BYTES + 384, L_TOK = RING_BYTES + 512, L_ATAB = RING_BYTES + 2560;
constexpr int MAXU = 10;
constexpr int LDS_BYTES = 147456;
static_assert(L_ATAB + MAXU * 1024 <= LDS_BYTES, "LDS map");

#define GAS __attribute__((address_space(1)))
#define LAS __attribute__((address_space(3)))
typedef unsigned short bf16;
typedef unsigned v4u __attribute__((ext_vector_type(4)));
typedef unsigned v2u __attribute__((ext_vector_type(2)));
typedef float f32x4 __attribute__((ext_vector_type(4)));
typedef float f32x2 __attribute__((ext_vector_type(2)));
#define LDS_WAIT() asm volatile("s_waitcnt lgkmcnt(0)" ::: "memory")
#define VM_WAIT() asm volatile("s_waitcnt vmcnt(0)" ::: "memory")
__device__ __forceinline__ unsigned pk2(float lo, float hi) { return pg8::cvt_pk_bf16(lo, hi); }
__device__ __forceinline__ float bf_lo(unsigned w) { return __uint_as_float(w << 16); }
__device__ __forceinline__ float bf_hi(unsigned w) { return __uint_as_float(w & 0xffff0000u); }


typedef __amdgpu_buffer_rsrc_t rsrc_t;
#define RSRC(p) __builtin_amdgcn_make_buffer_rsrc((void*)(p), 0, 0x7fffffff, 0x00020000)
__device__ __forceinline__ f32x4 bld4f(rsrc_t r, int vo, int so) { return __builtin_bit_cast(f32x4, __builtin_amdgcn_raw_buffer_load_b128(r, vo, so, 0)); }
__device__ __forceinline__ v4u bld4u(rsrc_t r, int vo, int so) { return __builtin_bit_cast(v4u, __builtin_amdgcn_raw_buffer_load_b128(r, vo, so, 0)); }
__device__ __forceinline__ v2u bld2u(rsrc_t r, int vo, int so) { return __builtin_bit_cast(v2u, __builtin_amdgcn_raw_buffer_load_b64(r, vo, so, 0)); }
__device__ __forceinline__ void bst2u(rsrc_t r, int vo, int so, v2u v) { __builtin_amdgcn_raw_buffer_store_b64(v, r, vo, so, 0); }
__device__ __forceinline__ void bst4u(rsrc_t r, int vo, int so, v4u v) { __builtin_amdgcn_raw_buffer_store_b128(v, r, vo, so, 0); }
__device__ __forceinline__ void bst4f(rsrc_t r, int vo, int so, f32x4 v) { __builtin_amdgcn_raw_buffer_store_b128(__builtin_bit_cast(v4u, v), r, vo, so, 0); }

#define XB_TMO      128
#define XB_XCNT(j)  (256  + 64 * (j))
#define XB_XSUB(j)  (1280 + 64 * (j))
#define XB_XGEN(j)  (2304 + 64 * (j))
#define XB_TOP      3328
#define XB_TOPGEN   3392
#define XCD_BAR_WORDS 3456
#define XB_SPIN_CAP (1u << 18)
__device__ __forceinline__ unsigned xb_ld(unsigned* p)              { return __hip_atomic_load(p, __ATOMIC_RELAXED, __HIP_MEMORY_SCOPE_AGENT); }
__device__ __forceinline__ unsigned xb_add(unsigned* p, unsigned v) { return __hip_atomic_fetch_add(p, v, __ATOMIC_RELAXED, __HIP_MEMORY_SCOPE_AGENT); }
__device__ __forceinline__ unsigned xb_xcc_id() { return (unsigned)__builtin_amdgcn_s_getreg((3 << 11) | 20) & 0xFu; }
#define XB_SPIN(cond, bar) do { unsigned _sp = 0; while (cond) { __builtin_amdgcn_s_sleep(1); \
    if ((++_sp & 255u) == 0u) { if (xb_ld(&(bar)[XB_TMO])) break; if (_sp > XB_SPIN_CAP) { atomicAdd(&(bar)[XB_TMO], 1u); break; } } } } while (0)
struct XcdBarrier { unsigned* bar; unsigned x; volatile LAS unsigned* st; };
__device__ __forceinline__ XcdBarrier xcd_barrier_post(unsigned* bar, volatile LAS unsigned* st, int tid) {
    XcdBarrier b; b.bar = bar; b.x = xb_xcc_id(); b.st = st;
    if (tid == 0) (void)xb_add(&bar[XB_XCNT(b.x)], 1u);
    return b;
}
__device__ __forceinline__ void xcd_barrier_complete(unsigned* bar, unsigned x, unsigned& nloc, unsigned& nx) {
    const unsigned G = gridDim.x * gridDim.y * gridDim.z;
    unsigned sum, cnt, mine, sp = 0u;
    for (;;) {
        sum = 0u; cnt = 0u; mine = 0u;
#pragma unroll
        for (unsigned j = 0; j < 16; ++j) { const unsigned c = xb_ld(&bar[XB_XCNT(j)]); sum += c; cnt += (c > 0u) ? 1u : 0u; mine = (j == x) ? c : mine; }
        if (sum == G) break;
        __builtin_amdgcn_s_sleep(1);
        if ((++sp & 255u) == 0u) { if (xb_ld(&bar[XB_TMO])) break; if (sp > XB_SPIN_CAP) { atomicAdd(&bar[XB_TMO], 1u); break; } }
    }
    nloc = mine > 0u ? mine : 1u; nx = cnt > 0u ? cnt : 1u;
}
__device__ __forceinline__ void xcd_barrier(const XcdBarrier& b, int tid) {
    asm volatile("s_waitcnt vmcnt(0)" ::: "memory");
    __syncthreads();
    if (tid == 0) {
        unsigned* bar = b.bar; asm volatile("" : "+s"(bar));
        __builtin_amdgcn_s_waitcnt(0);
        unsigned nloc = b.st[0], nx = b.st[1];
        if (nloc == 0u) { xcd_barrier_complete(bar, b.x, nloc, nx); b.st[0] = nloc; b.st[1] = nx; }
        const unsigned old = xb_add(&bar[XB_XSUB(b.x)], 1u);
        const unsigned gen = old / nloc;
        if (old + 1u == (gen + 1u) * nloc) {
            __builtin_amdgcn_fence(__ATOMIC_RELEASE, "agent");
            asm volatile("s_waitcnt vmcnt(0)" ::: "memory");
            const unsigned og = xb_add(&bar[XB_TOP], 1u);
            const unsigned tg = og / nx;
            if (og + 1u == (tg + 1u) * nx) xb_add(&bar[XB_TOPGEN], 1u);
            else XB_SPIN(xb_ld(&bar[XB_TOPGEN]) == tg, bar);
            __builtin_amdgcn_fence(__ATOMIC_ACQUIRE, "agent");
            xb_add(&bar[XB_XGEN(b.x)], 1u);
            asm volatile("s_waitcnt vmcnt(0)" ::: "memory");
        } else {
            XB_SPIN(xb_ld(&bar[XB_XGEN(b.x)]) == gen, bar);
            __builtin_amdgcn_fence(__ATOMIC_ACQUIRE, "agent");
            asm volatile("s_waitcnt vmcnt(0)" ::: "memory");
        }
    }
    __syncthreads();
}

struct Args {
    const float* in[20]; float* out; unsigned char* ws;
    float invf[32];
    int ph_lo, ph_hi, li, pad;
};
enum { I_X = 0, I_C, I_ADAW, I_ADAB, I_N1G, I_N2G, I_WIN, I_QNG, I_KVNG, I_WUQ, I_WUKV, I_ONA, I_ONB, I_WOUT, I_RW, I_RB, I_EG, I_EU, I_ED, I_FG };

struct Frame {
    LAS unsigned char* lds; unsigned char* ldsg;
    unsigned* ctl; unsigned char* ws;
    int tid, lane, wave, vcu, G;
};
__device__ __forceinline__ int lane_id() { int l; asm volatile("v_mbcnt_lo_u32_b32 %0, -1, 0\n\tv_mbcnt_hi_u32_b32 %0, -1, %0" : "=v"(l)); return l; }
#define DPP_ADD(v, ctrl) v += __int_as_float(__builtin_amdgcn_update_dpp(0, __float_as_int(v), ctrl, 0xF, 0xF, true))
__device__ __forceinline__ float wave_sum(float v) {
    DPP_ADD(v, 0xB1); DPP_ADD(v, 0x4E); DPP_ADD(v, 0x141); DPP_ADD(v, 0x140);
    v += __int_as_float(__builtin_amdgcn_ds_swizzle(__float_as_int(v), 0x401F));
    auto rr = __builtin_amdgcn_permlane32_swap(__float_as_uint(v), __float_as_uint(v), false, false);
    return __uint_as_float(rr[0]) + __uint_as_float(rr[1]);
}
__device__ __forceinline__ int il64(int j) { return j < 32 ? 2 * j : 2 * (j - 32) + 1; }
template <int MODE> __device__ __forceinline__ int dest_row(int n) {
    if constexpr (MODE == 0) return n;
    else if constexpr (MODE == 1) {
        if (n < 512) return C_CQ + n; if (n < 768) return C_CKV + (n - 512); if (n < 832) return C_KR + il64(n - 768);
        if (n < 1856) return C_QB + (n - 832); if (n < 2880) return C_KB + (n - 1856); return C_VB + (n - 2880); }
    else if constexpr (MODE == 2) { const int h = n / 192, j = n % 192; return j < 128 ? n : h * 192 + 128 + il64(j - 128); }
    else if constexpr (MODE == 3) return (n >> 7) * 256 + (n & 127);
    else return (n >> 7) * 256 + 128 + (n & 127);
}
template <int MODE>
__device__ __forceinline__ void transpose_item(const float* W, int ldw, int K, int N, bf16* WT, const float* kscale, LAS float* scr, int item, int lane) {
    const int nblk = N / 32, kb = item / nblk, nb = item % nblk, k0 = 64 * kb, n0 = 32 * nb;
    float tv[32];
#pragma unroll
    for (int i = 0; i < 32; ++i) { const int kk = 2 * i + (lane >> 5); tv[i] = W[(size_t)(k0 + kk) * ldw + n0 + (lane & 31)]; }
#pragma unroll
    for (int i = 0; i < 32; ++i) { const int kk = 2 * i + (lane >> 5); float v = tv[i]; if (kscale) v *= kscale[k0 + kk]; scr[kk * 33 + (lane & 31)] = v; }
    LDS_WAIT(); asm volatile("" ::: "memory");
    const int c = lane & 7;
#pragma unroll
    for (int j = 0; j < 4; ++j) { const int n = (lane >> 3) + 8 * j; const LAS float* s = scr + (8 * c) * 33 + n;
        v4u o; o.x = pk2(s[0 * 33], s[1 * 33]); o.y = pk2(s[2 * 33], s[3 * 33]); o.z = pk2(s[4 * 33], s[5 * 33]); o.w = pk2(s[6 * 33], s[7 * 33]);
        *(v4u*)(WT + (size_t)dest_row<MODE>(n0 + n) * K + k0 + 8 * c) = o; }
    LDS_WAIT(); asm volatile("s_waitcnt vmcnt(0)" ::: "memory");
}

__device__ __forceinline__ unsigned pk4_fp8(float a, float b, float c, float d) { int w = 0; w = __builtin_amdgcn_cvt_pk_fp8_f32(a, b, w, false); w = __builtin_amdgcn_cvt_pk_fp8_f32(c, d, w, true); return (unsigned)w; }
template <int MODE>
__device__ __forceinline__ void transpose_item8(const float* W, int ldw, int K, int N, unsigned char* WT, LAS float* scr, int item, int lane) {
    const int nblk = N / 32, kb = item / nblk, nb = item % nblk, k0 = 64 * kb, n0 = 32 * nb;
    float tv[32];
#pragma unroll
    for (int i = 0; i < 32; ++i) { const int kk = 2 * i + (lane >> 5); tv[i] = W[(size_t)(k0 + kk) * ldw + n0 + (lane & 31)]; }
#pragma unroll
    for (int i = 0; i < 32; ++i) { const int kk = 2 * i + (lane >> 5); scr[kk * 33 + (lane & 31)] = tv[i] * 256.0f; }
    LDS_WAIT(); asm volatile("" ::: "memory");
    const int c = lane & 7;
#pragma unroll
    for (int j = 0; j < 4; ++j) { const int n = (lane >> 3) + 8 * j; const LAS float* s = scr + (8 * c) * 33 + n;
        v2u o; o.x = pk4_fp8(s[0 * 33], s[1 * 33], s[2 * 33], s[3 * 33]); o.y = pk4_fp8(s[4 * 33], s[5 * 33], s[6 * 33], s[7 * 33]);
        *(v2u*)(WT + (size_t)dest_row<MODE>(n0 + n) * K + k0 + 8 * c) = o; }
    LDS_WAIT(); asm volatile("s_waitcnt vmcnt(0)" ::: "memory");
}

__device__ __forceinline__ void phase_prologue(Frame& F, const Args& A) {
    {
        const float* cc = A.in[I_C]; float* mod = (float*)(F.ws + WS_MOD);
        LAS float* red = (LAS float*)F.lds;
        for (int id = F.vcu; id < 2 * 96; id += F.G) {
            const int l = id / 96, ch = id % 96, cg = F.tid & 31, kg = F.tid >> 5, col = ch * 128 + cg * 4;
            const float* w = A.in[I_ADAW] + (size_t)l * DM * 12288 + col;
            f32x4 acc[4] = {};
#pragma unroll 4
            for (int kk = 0; kk < 128; ++kk) { const int k = kg * 128 + kk; const f32x4 wv = *(const f32x4*)(w + (size_t)k * 12288);
#pragma unroll
                for (int b = 0; b < 4; ++b) { const float cv = cc[b * DM + k]; const float ca = cv / (1.0f + __expf(-cv)); acc[b] += wv * ca; } }
#pragma unroll
            for (int b = 0; b < 4; ++b) *(LAS f32x4*)(red + ((kg * 32 + cg) * 16 + b * 4)) = acc[b];
            __syncthreads();
            if (F.tid < 128) { const int cg2 = F.tid & 31, b = F.tid >> 5; f32x4 s = {0.f, 0.f, 0.f, 0.f};
#pragma unroll
                for (int g = 0; g < 16; ++g) s += *(LAS f32x4*)(red + ((g * 32 + cg2) * 16 + b * 4));
                const int c2 = ch * 128 + cg2 * 4; const f32x4 bv = *(const f32x4*)(A.in[I_ADAB] + (size_t)l * 12288 + c2);
                *(f32x4*)(mod + ((size_t)l * 4 + b) * 12288 + c2) = s + bv; }
            asm volatile("s_waitcnt vmcnt(0)" ::: "memory");
            __syncthreads();
        }
    }
    {
        LAS float* scr = (LAS float*)(F.lds + F.wave * 16384);
        const int gw = F.vcu * NWAVES + F.wave, NGW = F.G * NWAVES;
        constexpr int I_IN = (DM / 64) * (IN_COLS / 32), I_UQ = (512 / 64) * (1536 / 32), I_UKV = (256 / 64) * (2048 / 32), I_OUT = (DM / 64) * (DM / 32), I_L = I_IN + I_UQ + I_UKV + I_OUT;
        for (int it = gw; it < 2 * I_L; it += NGW) {
            const int l = it / I_L; int r = it % I_L;
            if (r < I_IN) { transpose_item<1>(A.in[I_WIN] + (size_t)l * DM * IN_COLS, IN_COLS, DM, IN_COLS, (bf16*)(F.ws + WS_WIN) + (size_t)l * 4096 * DM, nullptr, scr, r, F.lane); continue; } r -= I_IN;
            if (r < I_UQ) { transpose_item<2>(A.in[I_WUQ] + (size_t)l * 512 * 1536, 1536, 512, 1536, (bf16*)(F.ws + WS_WUQ) + (size_t)l * 1536 * 512, A.in[I_QNG] + l * 512, scr, r, F.lane); continue; } r -= I_UQ;
            if (r < I_UKV) { transpose_item<0>(A.in[I_WUKV] + (size_t)l * 256 * 2048, 2048, 256, 2048, (bf16*)(F.ws + WS_WUKV) + (size_t)l * 2048 * 256, A.in[I_KVNG] + l * 256, scr, r, F.lane); continue; } r -= I_UKV;
#ifdef G3_FP8
            transpose_item8<0>(A.in[I_WOUT] + (size_t)l * DM * DM, DM, DM, DM, F.ws + WS_WOUT + (size_t)l * DM * DM, scr, r, F.lane);
#else
            transpose_item<0>(A.in[I_WOUT] + (size_t)l * DM * DM, DM, DM, DM, (bf16*)(F.ws + WS_WOUT) + (size_t)l * DM * DM, nullptr, scr, r, F.lane);
#endif
        }
    }
    {
        const int gt = F.vcu * (NWAVES * 64) + F.tid, NGT = F.G * NWAVES * 64;
        float* rope = (float*)(F.ws + WS_ROPE);
        for (int e = gt; e < SEQ * 32; e += NGT) { const int pos = e >> 5, i = e & 31;
            const float ang = (float)pos * A.invf[i];
            const double rev = (double)ang * 0.15915494309189535; const float fr = (float)(rev - __builtin_floor(rev));
            *(f32x2*)(rope + (size_t)e * 2) = (f32x2){__builtin_amdgcn_cosf(fr), __builtin_amdgcn_sinf(fr)}; }
        for (int e = gt; e < 2 * 192 * (DM / 8); e += NGT) { const int l = e / (192 * (DM / 8)), r = e % (192 * (DM / 8));
            *(v4u*)((bf16*)(F.ws + WS_WIN) + ((size_t)l * 4096 + IN_COLS) * DM + (size_t)r * 8) = (v4u){0u, 0u, 0u, 0u}; }
    }
}

__device__ __forceinline__ void phase_norm1(Frame& F, const Args& A, int l) {
    const int gw = F.vcu * NWAVES + F.wave, NGW = F.G * NWAVES;
    const float* mod = (const float*)(F.ws + WS_MOD);
    bf16* H = (bf16*)(F.ws + WS_H); const bf16* Y = (const bf16*)(F.ws + WS_Y);
    for (int ch = gw; ch < T / 16; ch += NGW) {
        const int row0 = ch * 16, b = row0 >> 13;
        const float* ml = mod + ((size_t)l * 4 + b) * 12288;
        f32x4 gsc[8], sh[8], g2p[8];
#pragma unroll
        for (int j = 0; j < 8; ++j) { const int c = 4 * F.lane + 256 * j; const f32x4 g = *(const f32x4*)(A.in[I_N1G] + l * DM + c), sc = *(const f32x4*)(ml + 1 * DM + c);
            gsc[j] = g * (sc + 1.0f); sh[j] = *(const f32x4*)(ml + 0 * DM + c);
            if (l > 0) g2p[j] = *(const f32x4*)(mod + ((size_t)(l - 1) * 4 + b) * 12288 + 5 * DM + c); }
#pragma unroll 1
        for (int rr = 0; rr < 16; ++rr) {
            const int row = row0 + rr; f32x4 v[8]; float s = 0.f;
            if (l == 0) {
#pragma unroll
                for (int j = 0; j < 8; ++j) v[j] = *(const f32x4*)(A.in[I_X] + (size_t)row * DM + 4 * F.lane + 256 * j);
            } else {
#pragma unroll
                for (int j = 0; j < 8; ++j) { const int c = 4 * F.lane + 256 * j;
#ifdef XRES_BF16
                    bf16* XB = (bf16*)(F.ws + WS_XB); const v2u xw = *(const v2u*)(XB + (size_t)row * DM + c); const f32x4 xr = {bf_lo(xw.x), bf_hi(xw.x), bf_lo(xw.y), bf_hi(xw.y)};
#else
                    const f32x4 xr = *(const f32x4*)(A.out + (size_t)row * DM + c);
#endif
                    const v2u y0 = *(const v2u*)(Y + (size_t)(2 * row) * DM + c), y1 = *(const v2u*)(Y + (size_t)(2 * row + 1) * DM + c);
                    const f32x4 ys = {bf_lo(y0.x) + bf_lo(y1.x), bf_hi(y0.x) + bf_hi(y1.x), bf_lo(y0.y) + bf_lo(y1.y), bf_hi(y0.y) + bf_hi(y1.y)};
                    v[j] = xr + g2p[j] * ys;
#ifdef XRES_BF16
                    { const v2u ow = {pk2(v[j].x, v[j].y), pk2(v[j].z, v[j].w)}; *(v2u*)(XB + (size_t)row * DM + c) = ow;
                      v[j] = (f32x4){bf_lo(ow.x), bf_hi(ow.x), bf_lo(ow.y), bf_hi(ow.y)}; }
#else
                    *(f32x4*)(A.out + (size_t)row * DM + c) = v[j];
#endif
                }
            }
#pragma unroll
            for (int j = 0; j < 8; ++j) s += (v[j].x * v[j].x + v[j].y * v[j].y) + (v[j].z * v[j].z + v[j].w * v[j].w);
            const float rstd = __builtin_amdgcn_rsqf(wave_sum(s) * (1.f / DM) + EPS);
#pragma unroll
            for (int j = 0; j < 8; ++j) { const f32x4 o = v[j] * rstd * gsc[j] + sh[j];
                *(v2u*)(H + (size_t)row * DM + 4 * F.lane + 256 * j) = (v2u){pk2(o.x, o.y), pk2(o.z, o.w)}; }
        }
    }
#ifndef ATT_CONV
    {
        LAS float* scr = (LAS float*)(F.lds + F.wave * 16384);
        constexpr int I_G = (DM / 64) * (DEXP / 32), I_D = (DEXP / 64) * (DM / 32), I_E = 2 * I_G + I_D;
        for (int it = gw; it < NEXP * I_E; it += NGW) {
            const int e = it / I_E; int r = it % I_E; const size_t eo = ((size_t)l * NEXP + e) * DM * DEXP;
            if (r < I_G) { transpose_item8<3>(A.in[I_EG] + eo, DEXP, DM, DEXP, F.ws + WS_W13 + (size_t)e * 2048 * DM, scr, r, F.lane); continue; } r -= I_G;
            if (r < I_G) { transpose_item8<4>(A.in[I_EU] + eo, DEXP, DM, DEXP, F.ws + WS_W13 + (size_t)e * 2048 * DM, scr, r, F.lane); continue; } r -= I_G;
            transpose_item8<0>(A.in[I_ED] + eo, DM, DEXP, DM, F.ws + WS_W2 + (size_t)e * DM * DEXP, scr, r, F.lane);
        }
    }
#endif
}
__device__ __forceinline__ void phase_final(Frame& F, const Args& A, int probe) {
    const int gw = F.vcu * NWAVES + F.wave, NGW = F.G * NWAVES;
    const float* mod = (const float*)(F.ws + WS_MOD); const bf16* Y = (const bf16*)(F.ws + WS_Y);
    for (int ch = gw; ch < T / 16; ch += NGW) {
        const int row0 = ch * 16, b = row0 >> 13;
        f32x4 fg[8], g2p[8];
#pragma unroll
        for (int j = 0; j < 8; ++j) { const int c = 4 * F.lane + 256 * j; fg[j] = *(const f32x4*)(A.in[I_FG] + c); g2p[j] = *(const f32x4*)(mod + ((size_t)(probe == 3 ? 0 : DEPTH - 1) * 4 + b) * 12288 + 5 * DM + c); }
#pragma unroll 1
        for (int rr = 0; rr < 16; ++rr) {
            const int row = row0 + rr; f32x4 v[8]; float s = 0.f;
#pragma unroll
            for (int j = 0; j < 8; ++j) { const int c = 4 * F.lane + 256 * j;
#ifdef XRES_BF16
                const v2u xw = *(const v2u*)((const bf16*)(F.ws + WS_XB) + (size_t)row * DM + c); const f32x4 xr = {bf_lo(xw.x), bf_hi(xw.x), bf_lo(xw.y), bf_hi(xw.y)};
#else
                const f32x4 xr = *(const f32x4*)((probe == 2 ? A.in[I_X] : A.out) + (size_t)row * DM + c);
#endif
                const v2u y0 = *(const v2u*)(Y + (size_t)(2 * row) * DM + c), y1 = *(const v2u*)(Y + (size_t)(2 * row + 1) * DM + c);
                const f32x4 ys = {bf_lo(y0.x) + bf_lo(y1.x), bf_hi(y0.x) + bf_hi(y1.x), bf_lo(y0.y) + bf_lo(y1.y), bf_hi(y0.y) + bf_hi(y1.y)};
                v[j] = (probe == 1 || probe == 2) ? xr : xr + g2p[j] * ys; }
#pragma unroll
            for (int j = 0; j < 8; ++j) s += (v[j].x * v[j].x + v[j].y * v[j].y) + (v[j].z * v[j].z + v[j].w * v[j].w);
            const float rstd = __builtin_amdgcn_rsqf(wave_sum(s) * (1.f / DM) + EPS);
#pragma unroll
            for (int j = 0; j < 8; ++j) *(f32x4*)(A.out + (size_t)row * DM + 4 * F.lane + 256 * j) = v[j] * rstd * fg[j];
        }
    }
}
#ifndef PROBE_DUMP_SCALE
#define PROBE_DUMP_SCALE 1.0f
#endif
#ifndef PROBE_DUMP_W
#define PROBE_DUMP_W 2048
#endif
__device__ __forceinline__ void phase_dump(Frame& F, const Args& A, size_t off, int pitch) {
    const int gw = F.vcu * NWAVES + F.wave, NGW = F.G * NWAVES;
    for (int row = gw; row < T; row += NGW) { const bf16* src = (const bf16*)(F.ws + off) + (size_t)row * pitch;
#ifdef PROBE_DUMP_F32
        for (int j = 0; j < 8; ++j) { const int c = 4 * F.lane + 256 * j; const float* sf = (const float*)(F.ws + off) + (size_t)row * pitch + c;
#ifdef PROBE_DUMP_SRC_OUT
            sf = A.out + (size_t)row * DM + c;
#endif
            f32x4 o = {0.f, 0.f, 0.f, 0.f}; if (c < PROBE_DUMP_W) o = *(const f32x4*)sf * PROBE_DUMP_SCALE;
#ifdef PROBE_DUMP_LOWBITS
            { const v4u ub = __builtin_bit_cast(v4u, o); o = (f32x4){(float)(ub.x & 0xFFFu), (float)(ub.y & 0xFFFu), (float)(ub.z & 0xFFFu), (float)(ub.w & 0xFFFu)}; }
#endif
            *(f32x4*)(A.out + (size_t)row * DM + c) = o; }
        continue;
#endif
        for (int j = 0; j < 8; ++j) { const int c = 4 * F.lane + 256 * j; const v2u w = *(const v2u*)(src + c);
#ifdef PROBE_DUMP_LOWBITS
            *(f32x4*)(A.out + (size_t)row * DM + c) = c < PROBE_DUMP_W ? (f32x4){(float)(w.x & 0x7Fu), (float)((w.x >> 16) & 0x7Fu), (float)(w.y & 0x7Fu), (float)((w.y >> 16) & 0x7Fu)} : (f32x4){0.f, 0.f, 0.f, 0.f}; } }
#else
            *(f32x4*)(A.out + (size_t)row * DM + c) = c < PROBE_DUMP_W ? (f32x4){bf_lo(w.x), bf_hi(w.x), bf_lo(w.y), bf_hi(w.y)} : (f32x4){0.f, 0.f, 0.f, 0.f}; } }
#endif
}
__device__ __forceinline__ void phase_mla_prep(Frame& F, const Args& A) {
    const int gw = F.vcu * NWAVES + F.wave, NGW = F.G * NWAVES;
    const bf16* P = (const bf16*)(F.ws + WS_PROJ); bf16* KF = (bf16*)(F.ws + WS_KF);
    float* rq = (float*)(F.ws + WS_RSTDQ); float* rkv = (float*)(F.ws + WS_RSTDKV); const float* rope = (const float*)(F.ws + WS_ROPE);
    for (int ch = gw; ch < T / 16; ch += NGW) {
#pragma unroll 1
        for (int r4 = 0; r4 < 16; r4 += 4) {
            v4u q[4]; v2u kv[4]; unsigned kr[4]; f32x2 cs[4];
#pragma unroll
            for (int u = 0; u < 4; ++u) { const int row = ch * 16 + r4 + u; const bf16* pr = P + (size_t)row * PROJ_LD;
                q[u] = *(const v4u*)(pr + C_CQ + 8 * F.lane); kv[u] = *(const v2u*)(pr + C_CKV + 4 * F.lane);
                kr[u] = *(const unsigned*)(pr + C_KR + 2 * (F.lane & 31)); cs[u] = *(const f32x2*)(rope + ((size_t)(row & (SEQ - 1)) * 32 + (F.lane & 31)) * 2); }
#pragma unroll
            for (int u = 0; u < 4; ++u) { const int row = ch * 16 + r4 + u;
                float sq = 0.f, skv = 0.f;
#pragma unroll
                for (int i = 0; i < 4; ++i) { const float a = bf_lo(q[u][i]), b2 = bf_hi(q[u][i]); sq += a * a + b2 * b2; }
#pragma unroll
                for (int i = 0; i < 2; ++i) { const float a = bf_lo(kv[u][i]), b2 = bf_hi(kv[u][i]); skv += a * a + b2 * b2; }
                sq = wave_sum(sq); skv = wave_sum(skv);
                if (F.lane == 0) { rq[row] = __builtin_amdgcn_rsqf(sq * (1.f / 512.f) + EPS); rkv[row] = __builtin_amdgcn_rsqf(skv * (1.f / 256.f) + EPS); }
                if (F.lane < 32) { const float x1 = bf_lo(kr[u]), x2 = bf_hi(kr[u]);
                    const unsigned o = pk2(x1 * cs[u].x - x2 * cs[u].y, x2 * cs[u].x + x1 * cs[u].y);
#pragma unroll
                    for (int h = 0; h < 8; ++h) *(unsigned*)(KF + (size_t)row * 1536 + h * 192 + 128 + 2 * F.lane) = o; } }
        }
    }
}
__device__ __forceinline__ void phase_q_rope(Frame& F, const Args& A) {
    const int gw = F.vcu * NWAVES + F.wave, NGW = F.G * NWAVES;
    bf16* QA = (bf16*)(F.ws + WS_QA); const float* rope = (const float*)(F.ws + WS_ROPE);
    for (int ch = gw; ch < T / 16; ch += NGW) {
#pragma unroll 1
        for (int r4 = 0; r4 < 16; r4 += 4) {
            v4u w[4]; f32x4 c01[4], c23[4];
#pragma unroll
            for (int u = 0; u < 4; ++u) { const int row = ch * 16 + r4 + u;
                w[u] = *(const v4u*)(QA + (size_t)row * 1536 + (F.lane >> 3) * 192 + 128 + (F.lane & 7) * 8);
                const f32x4* cs = (const f32x4*)(rope + ((size_t)(row & (SEQ - 1)) * 32 + (F.lane & 7) * 4) * 2); c01[u] = cs[0]; c23[u] = cs[1]; }
#pragma unroll
            for (int u = 0; u < 4; ++u) { const int row = ch * 16 + r4 + u; v4u o;
                { const float x1 = bf_lo(w[u].x), x2 = bf_hi(w[u].x); o.x = pk2(x1 * c01[u][0] - x2 * c01[u][1], x2 * c01[u][0] + x1 * c01[u][1]); }
                { const float x1 = bf_lo(w[u].y), x2 = bf_hi(w[u].y); o.y = pk2(x1 * c01[u][2] - x2 * c01[u][3], x2 * c01[u][2] + x1 * c01[u][3]); }
                { const float x1 = bf_lo(w[u].z), x2 = bf_hi(w[u].z); o.z = pk2(x1 * c23[u][0] - x2 * c23[u][1], x2 * c23[u][0] + x1 * c23[u][1]); }
                { const float x1 = bf_lo(w[u].w), x2 = bf_hi(w[u].w); o.w = pk2(x1 * c23[u][2] - x2 * c23[u][3], x2 * c23[u][2] + x1 * c23[u][3]); }
                *(v4u*)(QA + (size_t)row * 1536 + (F.lane >> 3) * 192 + 128 + (F.lane & 7) * 8) = o; }
        }
    }
}
__device__ __forceinline__ void phase_out_norm(Frame& F, const Args& A, int l) {
    const int gw = F.vcu * NWAVES + F.wave, NGW = F.G * NWAVES;
    const bf16* OA = (const bf16*)(F.ws + WS_OA); const bf16* OB = (const bf16*)(F.ws + WS_OB); const float* LSE = (const float*)(F.ws + WS_LSE); bf16* Yn = (bf16*)(F.ws + WS_H);
    for (int ch = gw; ch < T / 16; ch += NGW) {
        float ga[2][8], gb[2][8];
#pragma unroll
        for (int hf = 0; hf < 2; ++hf)
#pragma unroll
            for (int i = 0; i < 8; ++i) { ga[hf][i] = A.in[I_ONA][l * 1024 + hf * 512 + 8 * F.lane + i]; gb[hf][i] = A.in[I_ONB][l * 1024 + hf * 512 + 8 * F.lane + i]; }
#pragma unroll 1
        for (int rr = 0; rr < 16; ++rr) {
            const int row = ch * 16 + rr;
            float va[2][8], vb[2][8]; float sa = 0.f, sb = 0.f;
#pragma unroll
            for (int hf = 0; hf < 2; ++hf) {
                const int c = hf * 512 + 8 * F.lane, hd = c >> 7;
                const v4u a = *(const v4u*)(OA + (size_t)row * 1024 + c);
#pragma unroll
                for (int i = 0; i < 4; ++i) { va[hf][2 * i] = bf_lo(a[i]); va[hf][2 * i + 1] = bf_hi(a[i]); }
                const float l0 = LSE[((size_t)0 * T + row) * 8 + hd], l1 = LSE[((size_t)1 * T + row) * 8 + hd], l2 = LSE[((size_t)2 * T + row) * 8 + hd];
                const float mx = fmaxf(l0, fmaxf(l1, l2)); const float e0 = __expf(l0 - mx), e1 = __expf(l1 - mx), e2 = __expf(l2 - mx); const float inv = 1.0f / (e0 + e1 + e2);
                const float al[3] = {e0 * inv, e1 * inv, e2 * inv};
#pragma unroll
                for (int i = 0; i < 8; ++i) vb[hf][i] = 0.f;
#pragma unroll
                for (int n = 0; n < 3; ++n) { const v4u o = *(const v4u*)(OB + ((size_t)n * T + row) * 1024 + c);
#pragma unroll
                    for (int i = 0; i < 4; ++i) { vb[hf][2 * i] += al[n] * bf_lo(o[i]); vb[hf][2 * i + 1] += al[n] * bf_hi(o[i]); } }
#pragma unroll
                for (int i = 0; i < 8; ++i) { sa += va[hf][i] * va[hf][i]; sb += vb[hf][i] * vb[hf][i]; }
            }
            const float ra = __builtin_amdgcn_rsqf(wave_sum(sa) * (1.f / 1024.f) + EPS), rb = __builtin_amdgcn_rsqf(wave_sum(sb) * (1.f / 1024.f) + EPS);
#pragma unroll
            for (int hf = 0; hf < 2; ++hf) { const int c = hf * 512 + 8 * F.lane; v4u wa, wb;
#pragma unroll
                for (int i = 0; i < 4; ++i) { wa[i] = pk2(va[hf][2 * i] * ra * ga[hf][2 * i], va[hf][2 * i + 1] * ra * ga[hf][2 * i + 1]); wb[i] = pk2(vb[hf][2 * i] * rb * gb[hf][2 * i], vb[hf][2 * i + 1] * rb * gb[hf][2 * i + 1]); }
#ifdef G3_FP8
                { unsigned char* Y8 = (unsigned char*)Yn; float ya[8], yb[8];
#pragma unroll
                  for (int i = 0; i < 8; ++i) { ya[i] = va[hf][i] * ra * ga[hf][i]; yb[i] = vb[hf][i] * rb * gb[hf][i]; }
                  *(v2u*)(Y8 + (size_t)row * DM + c) = (v2u){pk4_fp8(ya[0], ya[1], ya[2], ya[3]), pk4_fp8(ya[4], ya[5], ya[6], ya[7])};
                  *(v2u*)(Y8 + (size_t)row * DM + 1024 + c) = (v2u){pk4_fp8(yb[0], yb[1], yb[2], yb[3]), pk4_fp8(yb[4], yb[5], yb[6], yb[7])}; }
#else
                *(v4u*)(Yn + (size_t)row * DM + c) = wa; *(v4u*)(Yn + (size_t)row * DM + 1024 + c) = wb;
#endif
            }
        }
    }
}
#ifndef ROUTER_SRC
#define ROUTER_SRC A.out
#endif
#ifdef ROUTER_MFMA
typedef short r_bf16x8 __attribute__((ext_vector_type(8)));
__device__ __forceinline__ void phase_router(Frame& F, const Args& A, int l, int dummy = 0) {
    const float* mod = (const float*)(F.ws + WS_MOD);
    bf16* H = (bf16*)(F.ws + WS_H);
    LAS int* lcnt = (LAS int*)(F.lds + L_CNT); LAS int* gbase = lcnt + 16; LAS int* tokinfo = (LAS int*)(F.lds + L_TOK);
    LAS float* lgs = (LAS float*)(F.lds + L_ATAB);
    LAS float* rsl = (LAS float*)(F.lds + L_ATAB + 8704);
    LAS float* wsm = (LAS float*)(F.lds + L_ATAB + 8704 + 512);
    LAS float* cstl = (LAS float*)(F.lds + L_ATAB + 8704 + 1024);
    unsigned* gcnt = F.ctl + CW_CNT + (dummy ? 3 : l) * 16;
    int* rowidx = (int*)(F.ws + (dummy ? WS_OB : WS_ROWIDX)); float* aw = (float*)(F.ws + (dummy ? WS_OB + 4 * MiB : WS_AW));
    float rb[16];
#pragma unroll
    for (int e = 0; e < 16; ++e) rb[e] = __uint_as_float(__builtin_amdgcn_readfirstlane(__float_as_uint(A.in[I_RB][e])));
    for (int bi = F.vcu; bi < T / 128; bi += F.G) {
        const int row0 = bi * 128 + F.wave * 16, b = row0 >> 13;
        const rsrc_t rml = RSRC(mod + ((size_t)l * 4 + b) * 12288), rgn = RSRC(A.in[I_N2G] + l * DM), rh = RSRC(H), rxb = RSRC(F.ws + WS_XB), rrw = RSRC(A.in[I_RW]);
        __syncthreads();
        { const int t0_ = F.wave * 64 + lane_id(); if (t0_ < 16) lcnt[t0_] = 0;
          const int e4 = t0_ & 3; f32x4 ca = {0.f, 0.f, 0.f, 0.f};
#pragma unroll 4
          for (int i = 0; i < 16; ++i) { const int k = (t0_ >> 2) + 128 * i;
              const f32x4 w4 = bld4f(rrw, (k * 16 + e4 * 4) * 4, 0);
              const float g = __uint_as_float(__builtin_amdgcn_raw_buffer_load_b32(rgn, k * 4, 0, 0)) * (__uint_as_float(__builtin_amdgcn_raw_buffer_load_b32(rml, k * 4, 4 * DM * 4, 0)) + 1.0f);
              const float sh = __uint_as_float(__builtin_amdgcn_raw_buffer_load_b32(rml, k * 4, 3 * DM * 4, 0));
              ca += w4 * sh;
              const int ob = (k >> 5) * 1024 + (((k >> 3) & 3) * 16 + e4 * 4) * 16 + (k & 7) * 2;
#pragma unroll
              for (int c = 0; c < 4; ++c) { const float wp = w4[c] * g; const unsigned hi = pk2(wp, 0.f) & 0xffffu; const float rem = wp - __uint_as_float(hi << 16);
                  *(LAS unsigned short*)(F.lds + ob + c * 16) = (unsigned short)hi; *(LAS unsigned short*)(F.lds + 65536 + ob + c * 16) = (unsigned short)(pk2(rem, 0.f) & 0xffffu); } }
          const int ln = t0_ & 63;
#pragma unroll
          for (int q = 0; q < 4; ++q)
#pragma unroll
              for (int c = 0; c < 4; ++c) { const float s = wave_sum((ln & 3) == q ? ca[c] : 0.f); if (ln == 0) wsm[F.wave * 16 + q * 4 + c] = s; }
        }
        __syncthreads();
        { const int t0_ = F.wave * 64 + lane_id(); if (t0_ < 16) { float s = 0.f;
#pragma unroll
              for (int w = 0; w < 8; ++w) s += wsm[w * 16 + t0_];
              cstl[t0_] = s; } }
        __syncthreads();
        const int lo16 = F.lane * 16, lo8 = F.lane * 8;
        f32x4 gsv[8];
#pragma unroll
        for (int j = 0; j < 8; ++j) gsv[j] = bld4f(rgn, lo16 + j * 1024, 0) * (bld4f(rml, lo16 + j * 1024, 4 * DM * 4) + 1.0f);
#pragma unroll 1
        for (int rp = 0; rp < 8; ++rp) {
            float ss[2] = {0.f, 0.f};
            v2u xraw[2][8];
#pragma unroll
            for (int q = 0; q < 2; ++q)
#pragma unroll
                for (int j = 0; j < 8; ++j) xraw[q][j] = bld2u(rxb, lo8 + j * 512, (row0 + rp * 2 + q) * (DM * 2));
#define XV(q, j) ((f32x4){bf_lo(xraw[q][j].x), bf_hi(xraw[q][j].x), bf_lo(xraw[q][j].y), bf_hi(xraw[q][j].y)})
            f32x4 shv[8];
#pragma unroll
            for (int j = 0; j < 8; ++j) shv[j] = bld4f(rml, lo16 + j * 1024, 3 * DM * 4);
#pragma unroll
            for (int j = 0; j < 8; ++j)
#pragma unroll
                for (int q = 0; q < 2; ++q) { const f32x4 x = XV(q, j); ss[q] += (x.x * x.x + x.y * x.y) + (x.z * x.z + x.w * x.w); }
            float rstd[2];
#pragma unroll
            for (int q = 0; q < 2; ++q) rstd[q] = __builtin_amdgcn_rsqf(wave_sum(ss[q]) * (1.f / DM) + EPS);
            if (F.lane == 0) { rsl[F.wave * 16 + rp * 2] = rstd[0]; rsl[F.wave * 16 + rp * 2 + 1] = rstd[1]; }
#pragma unroll
            for (int j = 0; j < 8; ++j) {
#pragma unroll
                for (int q = 0; q < 2; ++q) { const f32x4 o = XV(q, j) * rstd[q] * gsv[j] + shv[j]; __builtin_amdgcn_raw_buffer_store_b32(pk4_fp8(o.x, o.y, o.z, o.w), rh, F.lane * 4 + j * 256, (row0 + rp * 2 + q) * DM, 0); } }
#undef XV
        }
        { const int ln = lane_id(), col = ln & 15, rq = ln >> 4;
          const int va = col * (DM * 2) + rq * 16, sa = row0 * (DM * 2);
          f32x4 acc = {0.f, 0.f, 0.f, 0.f};
          r_bf16x8 a0[8], a1[8];
#pragma unroll
          for (int i = 0; i < 8; ++i) a0[i] = __builtin_bit_cast(r_bf16x8, __builtin_amdgcn_raw_buffer_load_b128(rxb, va + i * 64, sa, 0));
#define RT_MM(AR, sb) do { _Pragma("unroll") for (int i = 0; i < 8; ++i) { const int st = (sb) * 8 + i; \
              const r_bf16x8 bh = *(const LAS r_bf16x8*)(F.lds + st * 1024 + ln * 16), bl = *(const LAS r_bf16x8*)(F.lds + 65536 + st * 1024 + ln * 16); \
              acc = __builtin_amdgcn_mfma_f32_16x16x32_bf16(AR[i], bh, acc, 0, 0, 0); acc = __builtin_amdgcn_mfma_f32_16x16x32_bf16(AR[i], bl, acc, 0, 0, 0); } } while (0)
#pragma unroll 1
          for (int sb = 0; sb < 8; sb += 2) {
#pragma unroll
              for (int i = 0; i < 8; ++i) a1[i] = __builtin_bit_cast(r_bf16x8, __builtin_amdgcn_raw_buffer_load_b128(rxb, va + ((sb + 1) * 8 + i) * 64, sa, 0));
              RT_MM(a0, sb);
              if (sb + 2 < 8) {
#pragma unroll
                  for (int i = 0; i < 8; ++i) a0[i] = __builtin_bit_cast(r_bf16x8, __builtin_amdgcn_raw_buffer_load_b128(rxb, va + ((sb + 2) * 8 + i) * 64, sa, 0)); }
              RT_MM(a1, sb + 1);
          }
#undef RT_MM
          LDS_WAIT();
          const float cs = cstl[col];
#pragma unroll
          for (int i = 0; i < 4; ++i) lgs[F.wave * 272 + (4 * rq + i) * 17 + col] = acc[i] * rsl[F.wave * 16 + 4 * rq + i] + cs;
          LDS_WAIT(); asm volatile("" ::: "memory");
          if (ln < 16) {
              float sc[16], bs[16];
#pragma unroll
              for (int e = 0; e < 16; ++e) { const float lg = lgs[F.wave * 272 + ln * 17 + e]; sc[e] = 1.0f / (1.0f + __expf(-lg)); bs[e] = sc[e] + rb[e]; }
              float gs4[4];
#pragma unroll
              for (int g = 0; g < 4; ++g) { const float a = bs[4 * g], b2 = bs[4 * g + 1], c = bs[4 * g + 2], d = bs[4 * g + 3];
                  const float h1 = fmaxf(a, b2), l1 = fminf(a, b2), h2 = fmaxf(c, d), l2 = fminf(c, d);
                  gs4[g] = fmaxf(h1, h2) + fmaxf(fminf(h1, h2), fmaxf(l1, l2)); }
              int gsel = 0; float gbest = gs4[0];
#pragma unroll
              for (int g = 1; g < 4; ++g) if (gs4[g] > gbest) { gbest = gs4[g]; gsel = g; }
              float bv[4], sv[4];
#pragma unroll
              for (int i = 0; i < 4; ++i) { bv[i] = gsel == 0 ? bs[i] : gsel == 1 ? bs[4 + i] : gsel == 2 ? bs[8 + i] : bs[12 + i]; sv[i] = gsel == 0 ? sc[i] : gsel == 1 ? sc[4 + i] : gsel == 2 ? sc[8 + i] : sc[12 + i]; }
              int i1 = 0; float b1 = bv[0], s1 = sv[0];
#pragma unroll
              for (int i = 1; i < 4; ++i) if (bv[i] > b1) { b1 = bv[i]; s1 = sv[i]; i1 = i; }
              int i2 = -1; float b2v = -__builtin_inff(), s2 = 0.f;
#pragma unroll
              for (int i = 0; i < 4; ++i) if (i != i1 && bv[i] > b2v) { b2v = bv[i]; s2 = sv[i]; i2 = i; }
              const float inv = 1.0f / (s1 + s2);
              const int r = F.wave * 16 + ln, e0 = gsel * 4 + i1, e1 = gsel * 4 + i2;
              tokinfo[r * 4 + 0] = e0; tokinfo[r * 4 + 2] = e1;
              const int row = row0 + ln; *(f32x2*)(aw + (size_t)row * 2) = (f32x2){s1 * inv, s2 * inv};
          }
        }
        __syncthreads();
        const int tb_ = F.wave * 64 + lane_id();
        if (tb_ < 16) {
            int c = 0;
            for (int r = 0; r < 128; ++r) { if (tokinfo[r * 4 + 0] == tb_) tokinfo[r * 4 + 1] = c++; if (tokinfo[r * 4 + 2] == tb_) tokinfo[r * 4 + 3] = c++; }
            gbase[tb_] = (int)__hip_atomic_fetch_add(gcnt + tb_, (unsigned)c, __ATOMIC_RELAXED, __HIP_MEMORY_SCOPE_AGENT); }
        __syncthreads();
        if (tb_ < 128) { const int e0 = tokinfo[tb_ * 4], p0 = tokinfo[tb_ * 4 + 1], e1 = tokinfo[tb_ * 4 + 2], p1 = tokinfo[tb_ * 4 + 3]; const int row = bi * 128 + tb_;
            rowidx[(size_t)e0 * 32768 + gbase[e0] + p0] = 2 * row; rowidx[(size_t)e1 * 32768 + gbase[e1] + p1] = 2 * row + 1; }
        __syncthreads();
    }
}
#else
__device__ __forceinline__ void phase_router(Frame& F, const Args& A, int l, int dummy = 0) {
    const float* mod = (const float*)(F.ws + WS_MOD);
    bf16* H = (bf16*)(F.ws + WS_H);
    LAS f32x4* rwl = (LAS f32x4*)F.lds;
    LAS int* lcnt = (LAS int*)(F.lds + L_CNT); LAS int* gbase = lcnt + 16; LAS int* tokinfo = (LAS int*)(F.lds + L_TOK);
    unsigned* gcnt = F.ctl + CW_CNT + (dummy ? 3 : l) * 16;
    int* rowidx = (int*)(F.ws + (dummy ? WS_OB : WS_ROWIDX)); float* aw = (float*)(F.ws + (dummy ? WS_OB + 4 * MiB : WS_AW));
    for (int q = F.tid; q < 8192; q += NWAVES * 64) { const int k = q >> 2, e4 = q & 3, ln = (k & 255) >> 2, j = k >> 8, i = k & 3;
        rwl[((j * 4 + i) * 4 + e4) * 64 + ln] = *(const f32x4*)(A.in[I_RW] + (size_t)k * 16 + e4 * 4); }
    float rb[16];
#pragma unroll
    for (int e = 0; e < 16; ++e) rb[e] = __uint_as_float(__builtin_amdgcn_readfirstlane(__float_as_uint(A.in[I_RB][e])));
    __syncthreads();
    for (int bi = F.vcu; bi < T / 128; bi += F.G) {
        { const int t0_ = F.wave * 64 + lane_id(); if (t0_ < 16) lcnt[t0_] = 0; }
        __syncthreads();
        const int row0 = bi * 128 + F.wave * 16, b = row0 >> 13;
        const rsrc_t rml = RSRC(mod + ((size_t)l * 4 + b) * 12288), rgn = RSRC(A.in[I_N2G] + l * DM), rx = RSRC(ROUTER_SRC), rh = RSRC(H);
#ifdef XRES_BF16
        const rsrc_t rxb = RSRC(F.ws + WS_XB);
#endif
        const int lo16 = F.lane * 16, lo8 = F.lane * 8;
        float cst[16];
        { f32x4 ca[4] = {};
#pragma unroll
          for (int j = 0; j < 8; ++j) { const f32x4 sh = bld4f(rml, lo16 + j * 1024, 3 * DM * 4);
#pragma unroll
            for (int i = 0; i < 4; ++i)
#pragma unroll
                for (int e4 = 0; e4 < 4; ++e4) ca[e4] += rwl[((j * 4 + i) * 4 + e4) * 64 + F.lane] * sh[i];
            asm volatile("" ::: "memory"); }
#pragma unroll
          for (int e = 0; e < 16; ++e) cst[e] = __uint_as_float(__builtin_amdgcn_readfirstlane(__float_as_uint(wave_sum(ca[e >> 2][e & 3])))); }
        f32x4 gsv[8];
#pragma unroll
        for (int j = 0; j < 8; ++j) gsv[j] = bld4f(rgn, lo16 + j * 1024, 0) * (bld4f(rml, lo16 + j * 1024, 4 * DM * 4) + 1.0f);
#pragma unroll 1
        for (int rp = 0; rp < 8; ++rp) {
            float ss[2] = {0.f, 0.f}; f32x4 acc[2][4] = {};
            const int so0 = (row0 + rp * 2) * (DM * 4);
#ifdef XRES_BF16
            v2u xraw[2][8];
#pragma unroll
            for (int q = 0; q < 2; ++q)
#pragma unroll
                for (int j = 0; j < 8; ++j) xraw[q][j] = bld2u(rxb, lo8 + j * 512, (row0 + rp * 2 + q) * (DM * 2));
#define XV(q, j) ((f32x4){bf_lo(xraw[q][j].x), bf_hi(xraw[q][j].x), bf_lo(xraw[q][j].y), bf_hi(xraw[q][j].y)})
#else
            f32x4 xv[2][8];
#pragma unroll
            for (int q = 0; q < 2; ++q)
#pragma unroll
                for (int j = 0; j < 8; ++j) xv[q][j] = bld4f(rx, lo16 + j * 1024, so0 + q * (DM * 4));
#define XV(q, j) xv[q][j]
#endif
#pragma unroll
            for (int j = 0; j < 8; ++j) {
                f32x4 a[2];
#pragma unroll
                for (int q = 0; q < 2; ++q) { const f32x4 x = XV(q, j); ss[q] += (x.x * x.x + x.y * x.y) + (x.z * x.z + x.w * x.w); a[q] = x * gsv[j]; }
#pragma unroll
                for (int i = 0; i < 4; ++i) {
#pragma unroll
                    for (int e4 = 0; e4 < 4; ++e4) { const f32x4 w = rwl[((j * 4 + i) * 4 + e4) * 64 + F.lane]; acc[0][e4] += w * a[0][i]; acc[1][e4] += w * a[1][i]; }
                    asm volatile("" : "+v"(acc[0][0]), "+v"(acc[0][1]), "+v"(acc[0][2]), "+v"(acc[0][3]), "+v"(acc[1][0]), "+v"(acc[1][1]), "+v"(acc[1][2]), "+v"(acc[1][3]) :: "memory"); } }
            float rstd[2];
#pragma unroll
            for (int q = 0; q < 2; ++q) rstd[q] = __builtin_amdgcn_rsqf(wave_sum(ss[q]) * (1.f / DM) + EPS);
            asm volatile("" ::: "memory");
            f32x4 shv[8];
#pragma unroll
            for (int j = 0; j < 8; ++j) shv[j] = bld4f(rml, lo16 + j * 1024, 3 * DM * 4);
#pragma unroll
            for (int j = 0; j < 8; ++j) {
#pragma unroll
                for (int q = 0; q < 2; ++q) { const f32x4 o = XV(q, j) * rstd[q] * gsv[j] + shv[j]; __builtin_amdgcn_raw_buffer_store_b32(pk4_fp8(o.x, o.y, o.z, o.w), rh, F.lane * 4 + j * 256, (row0 + rp * 2 + q) * DM, 0); } }
#undef XV
#pragma unroll
            for (int q = 0; q < 2; ++q) {
                float sc[16], bs[16];
#pragma unroll
                for (int e = 0; e < 16; ++e) { const float lg = wave_sum(acc[q][e >> 2][e & 3]) * rstd[q] + cst[e]; sc[e] = 1.0f / (1.0f + __expf(-lg)); bs[e] = sc[e] + rb[e]; }
                float gs4[4];
#pragma unroll
                for (int g = 0; g < 4; ++g) { const float a = bs[4 * g], b2 = bs[4 * g + 1], c = bs[4 * g + 2], d = bs[4 * g + 3];
                    const float h1 = fmaxf(a, b2), l1 = fminf(a, b2), h2 = fmaxf(c, d), l2 = fminf(c, d);
                    gs4[g] = fmaxf(h1, h2) + fmaxf(fminf(h1, h2), fmaxf(l1, l2)); }
                int gsel = 0; float gbest = gs4[0];
#pragma unroll
                for (int g = 1; g < 4; ++g) if (gs4[g] > gbest) { gbest = gs4[g]; gsel = g; }
                float bv[4], sv[4];
#pragma unroll
                for (int i = 0; i < 4; ++i) { bv[i] = gsel == 0 ? bs[i] : gsel == 1 ? bs[4 + i] : gsel == 2 ? bs[8 + i] : bs[12 + i]; sv[i] = gsel == 0 ? sc[i] : gsel == 1 ? sc[4 + i] : gsel == 2 ? sc[8 + i] : sc[12 + i]; }
                int i1 = 0; float b1 = bv[0], s1 = sv[0];
#pragma unroll
                for (int i = 1; i < 4; ++i) if (bv[i] > b1) { b1 = bv[i]; s1 = sv[i]; i1 = i; }
                int i2 = -1; float b2v = -__builtin_inff(), s2 = 0.f;
#pragma unroll
                for (int i = 0; i < 4; ++i) if (i != i1 && bv[i] > b2v) { b2v = bv[i]; s2 = sv[i]; i2 = i; }
                const float inv = 1.0f / (s1 + s2);
                if (F.lane == 0) {
                    const int r = F.wave * 16 + rp * 2 + q, e0 = gsel * 4 + i1, e1 = gsel * 4 + i2;
                    tokinfo[r * 4 + 0] = e0; tokinfo[r * 4 + 2] = e1;
                    const int row = row0 + rp * 2 + q; *(f32x2*)(aw + (size_t)row * 2) = (f32x2){s1 * inv, s2 * inv};
                }
            }
        }
        __syncthreads();
        const int tb_ = F.wave * 64 + lane_id();
        if (tb_ < 16) {
            int c = 0;
            for (int r = 0; r < 128; ++r) { if (tokinfo[r * 4 + 0] == tb_) tokinfo[r * 4 + 1] = c++; if (tokinfo[r * 4 + 2] == tb_) tokinfo[r * 4 + 3] = c++; }
            gbase[tb_] = (int)__hip_atomic_fetch_add(gcnt + tb_, (unsigned)c, __ATOMIC_RELAXED, __HIP_MEMORY_SCOPE_AGENT); }
        __syncthreads();
        if (tb_ < 128) { const int e0 = tokinfo[tb_ * 4], p0 = tokinfo[tb_ * 4 + 1], e1 = tokinfo[tb_ * 4 + 2], p1 = tokinfo[tb_ * 4 + 3]; const int row = bi * 128 + tb_;
            rowidx[(size_t)e0 * 32768 + gbase[e0] + p0] = 2 * row; rowidx[(size_t)e1 * 32768 + gbase[e1] + p1] = 2 * row + 1; }
        __syncthreads();
    }
}
#endif
__device__ __forceinline__ int moe_setup(Frame& F, int l) {
    LAS int* ts = (LAS int*)(F.lds + L_TS);
    if (F.tid == 0) { int s = 0; for (int e = 0; e < 16; ++e) { ts[e] = s; s += ((int)__hip_atomic_load(F.ctl + CW_CNT + l * 16 + e, __ATOMIC_RELAXED, __HIP_MEMORY_SCOPE_AGENT) + 255) >> 8; } ts[16] = s; }
    __syncthreads();
    return __builtin_amdgcn_readfirstlane(ts[16]);
}

__device__ __forceinline__ att::Blk mla_blk(int bh, int qb) {
    const int b = bh >> 3, h = bh & 7; att::Blk k;
    k.qo = (unsigned)(WS_QA + ((size_t)b * SEQ * 1536 + h * 192) * 2); k.ko = (unsigned)(WS_KF + ((size_t)b * SEQ * 1536 + h * 192) * 2);
    k.vo = (unsigned)(WS_VB + ((size_t)b * SEQ * 1024 + h * 128) * 2); k.oo = (unsigned)(WS_OA + ((size_t)b * SEQ * 1024 + h * 128) * 2); k.lo = 0;
    k.P0 = qb * 256; k.rate = 1; k.beta = 0.f;
    return k;
}
__device__ __forceinline__ att::Blk dil_blk(int bh, int br, int blk) {
    const int b = bh >> 3, h = bh & 7, rate = br == 0 ? 1 : br == 1 ? 4 : 16, nqb = 32 / rate, cls = blk / nqb, qb = blk % nqb; att::Blk k;
    const size_t tok0 = (size_t)b * SEQ + cls;
    const unsigned p = (unsigned)(WS_PROJ + (tok0 * PROJ_LD + h * 128) * 2);
    k.qo = p + C_QB * 2; k.ko = p + C_KB * 2; k.vo = p + C_VB * 2;
    k.oo = (unsigned)(WS_OB + (((size_t)br * T + tok0) * 1024 + h * 128) * 2);
    k.lo = (unsigned)(WS_LSE + (((size_t)br * T + tok0) * 8 + h) * 4);
    k.P0 = qb * 256; k.rate = rate;
    const float slope = __builtin_amdgcn_exp2f(-(float)(h + 1));
    k.beta = slope * (float)rate * 11.313708498984761f;
    return k;
}
__device__ __forceinline__ void mla_decode(int id, int& bh, int& qb0, int& qb1) {
    const int v = id & 255, i = id >> 8, x = v >> 5, c = v & 31, j = i * 32 + c; bh = 4 * x + (j >> 4); const int s = j & 15; qb0 = s; qb1 = 31 - s;
}
__device__ __forceinline__ void dil_decode(int id, int& bh, int& br, int& blk) {
    const int v = id & 255, i = id >> 8, x = v >> 5, c = v & 31, j = i * 32 + c; bh = 4 * x + j / 96; const int r = j % 96; br = r >> 5; blk = r & 31;
}
#ifndef ATT_DIL_NS
#define ATT_DIL_NS 4
#endif
#ifndef ATT_SKEW_SEL
#define ATT_SKEW_SEL 0
#endif
#if ATT_SKEW_SEL == 0
#define ATT_SKEW_PICK(w) ((w) < 4)
#elif ATT_SKEW_SEL == 1
#define ATT_SKEW_PICK(w) (((w) & 1) == 0)
#elif ATT_SKEW_SEL == 2
#define ATT_SKEW_PICK(w) true
#else
#define ATT_SKEW_PICK(w) false
#endif
#ifdef ATT_DMA
#define ATT_SEAM(d) att::SeamD<d>
#define ATT_DMA_ON ATT_DMA
#else
#define ATT_SEAM(d) att::Seam<d>
#define ATT_DMA_ON 0
#endif
#if ATT_DMA_ON == 2
template <int ORD>
__device__ __forceinline__ void mla_stream2(Frame& F, char* lds) {
    constexpr int NIT = 512;
    int id = F.vcu;
    if (id < NIT) {
        att::SeamD<192> S; int bh, q0, q1; mla_decode(id, bh, q0, q1); int pass = 0;
        att::Blk cur = mla_blk(bh, q0);
        att::att_prime_dma2<192, false>(cur, (const char*)F.ws, lds, S, F.tid);
        for (;;) {
            const bool more_pass = pass == 0, more_item = id + F.G < NIT, last = !more_pass && !more_item;
            att::Blk nxt = cur; int idn = id, passn = pass + 1;
            if (more_pass) nxt = mla_blk(bh, q1);
            else if (more_item) { idn = id + F.G; passn = 0; mla_decode(idn, bh, q0, q1); nxt = mla_blk(bh, q0); }
            att::att_block_dma2<192, false, false, ORD>(cur, nxt, (const char*)F.ws, lds, S, F.tid);
            if (last) break;
            cur = nxt; id = idn; pass = passn;
        }
    }
}
template <int ORD>
__device__ __forceinline__ void dil_stream2(Frame& F, char* lds) {
    constexpr int NIT = 3072;
    int id = F.vcu;
    if (id < NIT) {
        att::SeamD<128> S; int bh, br, blk; dil_decode(id, bh, br, blk);
        att::Blk cur = dil_blk(bh, br, blk);
        att::att_prime_dma2<128, true>(cur, (const char*)F.ws, lds, S, F.tid);
        for (;;) {
            const bool last = id + F.G >= NIT;
            att::Blk nxt = cur;
            if (!last) { dil_decode(id + F.G, bh, br, blk); nxt = dil_blk(bh, br, blk); }
            att::att_block_dma2<128, true, true, ORD>(cur, nxt, (const char*)F.ws, lds, S, F.tid);
            if (last) break;
            cur = nxt; id += F.G;
        }
    }
}
#endif
template <int PV>
__device__ __forceinline__ void dil_stream_reg(Frame& F, char* lds, int rep_) {
        constexpr int NIT = 3072;
        int id = F.vcu;
        if (id < NIT) {
#if ATT_DMA_ON == 1
            att::SeamD<128> S;
#else
            att::Seam<128> S;
#endif
            int bh, br, blk; dil_decode(id, bh, br, blk);
            att::Blk cur = dil_blk(bh, br, blk);
#if ATT_DMA_ON == 1
            att::att_prime_dma<128, true, ATT_DIL_NS>(cur, (const char*)F.ws, lds, S, F.tid);
#else
            att::att_prime<128, true, PV>(cur, (const char*)F.ws, lds, S, F.tid);
#endif
            for (;;) {
                const bool last = id + F.G >= NIT;
                att::Blk nxt = cur;
                if (!last) { dil_decode(id + F.G, bh, br, blk); nxt = dil_blk(bh, br, blk); }
#if ATT_DMA_ON == 1
                att::att_block_dma<128, true, true, ATT_DIL_NS>(cur, nxt, (const char*)F.ws, lds, lds + RING_BYTES + 512, S, F.tid);
#else
                att::att_block<128, true, true, PV>(cur, nxt, (const char*)F.ws, lds, S, F.tid);
#endif
                if (last) break;
                cur = nxt; id += F.G;
            }
#if defined(ATT_DEFER) && ATT_DMA_ON != 1
            if (S.p_on) { const int ln_ = F.tid & 63; const char* stg_ = lds + att::DEFER_STG + __builtin_amdgcn_readfirstlane(F.tid >> 6) * 8192;
#pragma unroll
                for (int p = 0; p < 8; ++p) att::flush_piece(stg_, p, (const char*)F.ws + S.p_oo, S.p_rb, S.p_so0, ln_); }
#endif
        }
}
static_assert(WS_ROPE == att::ROPE_OFF, "rope table offset");
__device__ __forceinline__ void phase_attention(Frame& F, char* lds, const Args& A, int l) {
#ifdef ATT_PRIO
    if (__builtin_amdgcn_readfirstlane(F.tid >> 6) >= 4) __builtin_amdgcn_s_setprio(1);
#endif
#ifndef NO_MLA
#ifndef PROBE_REP_MLA
#define PROBE_REP_MLA 1
#endif
    for (int rep_ = 0; rep_ < PROBE_REP_MLA; ++rep_) {
        if (rep_) __syncthreads();
#if ATT_DMA_ON == 2
        { const int wsel_ = __builtin_amdgcn_readfirstlane(F.tid >> 6);
          if (ATT_SKEW_PICK(wsel_)) mla_stream2<0>(F, lds); else mla_stream2<1>(F, lds); }
#else
        constexpr int NIT = 512;
        int id = F.vcu;
        if (id < NIT) {
            ATT_SEAM(192) S; int bh, q0, q1; mla_decode(id, bh, q0, q1); int pass = 0;
            att::Blk cur = mla_blk(bh, q0);
#ifdef ATT_CONV
            const size_t eo_ = (size_t)l * NEXP * DM * DEXP;
            const att::ConvCtx X = {A.in[I_EG] + eo_, A.in[I_EU] + eo_, A.in[I_ED] + eo_, F.ws + WS_W13, F.ws + WS_W2, F.vcu * 8 + __builtin_amdgcn_readfirstlane(F.tid >> 6)};
#endif
#if ATT_DMA_ON
            att::att_prime_dma<192, false, 3>(cur, (const char*)F.ws, lds, S, F.tid);
#else
#ifdef ATT_QROPE
            att::att_prime<192, false, 0, true>(cur, (const char*)F.ws, lds, S, F.tid);
#else
            att::att_prime<192, false>(cur, (const char*)F.ws, lds, S, F.tid);
#endif
#endif
            for (;;) {
                const bool more_pass = pass == 0, more_item = id + F.G < NIT, last = !more_pass && !more_item;
                att::Blk nxt = cur; int idn = id, passn = pass + 1;
                if (more_pass) nxt = mla_blk(bh, q1);
                else if (more_item) { idn = id + F.G; passn = 0; mla_decode(idn, bh, q0, q1); nxt = mla_blk(bh, q0); }
#if ATT_DMA_ON
                att::att_block_dma<192, false, false, 3>(cur, nxt, (const char*)F.ws, lds, lds + 3 * att::SHM_V + 3 * att::Cfg<192>::SHM_K, S, F.tid);
#else
#ifdef ATT_CONV
                att::att_block<192, false, false, 0, true>(cur, nxt, (const char*)F.ws, lds, S, F.tid, &X);
#elif defined(ATT_QROPE)
                att::att_block<192, false, false, 0, false, true>(cur, nxt, (const char*)F.ws, lds, S, F.tid);
#else
                att::att_block<192, false, false>(cur, nxt, (const char*)F.ws, lds, S, F.tid);
#endif
#endif
                if (last) break;
                cur = nxt; id = idn; pass = passn;
            }
#ifdef ATT_CONV
            { const int ln_ = lane_id(); char* scr_ = lds + att::CONV_SCR + __builtin_amdgcn_readfirstlane(F.tid >> 6) * 4352;
              while (S.cv_j < att::CONV_NJ) { att::conv_load(X, S.cv_j, S.cv_q, S.cv, ln_); asm volatile("s_waitcnt vmcnt(0)" ::: "memory");
                  att::conv_put(X, S.cv_j, S.cv_q, S.cv, scr_, ln_); if (++S.cv_q == 4) { S.cv_q = 0; ++S.cv_j; } S.cl_j = S.cv_j; S.cl_q = S.cv_q; } }
#endif
        }
#endif
    }
#endif
#ifndef NO_DIL
#ifndef PROBE_REP_DIL
#define PROBE_REP_DIL 1
#endif
#ifndef PROBE_DIL_VAR
#define PROBE_DIL_VAR 0
#endif
#if ATT_DMA_ON == 2 && !defined(ATT_DIL_DMA2)
    asm volatile("s_waitcnt vmcnt(0)" ::: "memory"); __syncthreads();
#endif
    for (int rep_ = 0; rep_ < PROBE_REP_DIL; ++rep_) {
        if (rep_) __syncthreads();
#if ATT_DMA_ON == 2 && defined(ATT_DIL_DMA2)
        { const int wsel_ = __builtin_amdgcn_readfirstlane(F.tid >> 6);
          if (ATT_SKEW_PICK(wsel_)) dil_stream2<0>(F, lds); else dil_stream2<1>(F, lds); }
#else
        if (rep_ + 1 < PROBE_REP_DIL) dil_stream_reg<PROBE_DIL_VAR>(F, lds, rep_); else dil_stream_reg<0>(F, lds, rep_);
#endif
    }
#endif
#ifdef ATT_PRIO
    __builtin_amdgcn_s_setprio(0);
#endif
}
#ifndef MK_PER_PHASE
#define MK_PER_PHASE 0
#endif
constexpr int NPH = 2 + 11 * DEPTH;
__global__ void __launch_bounds__(NWAVES * 64, 2) mk_fwd(Args args) {
    extern __shared__ __attribute__((aligned(16))) unsigned char lds[];
    Frame F;
    F.lds = (LAS unsigned char*)lds; F.ldsg = lds;
    F.wave = __builtin_amdgcn_readfirstlane((int)threadIdx.x >> 6); F.lane = lane_id(); F.tid = F.wave * 64 + F.lane;
    F.G = gridDim.x; { const int bx = blockIdx.x; F.vcu = (F.G % 8 == 0) ? (bx % 8) * (F.G / 8) + bx / 8 : bx; }
    F.ws = args.ws; F.ctl = (unsigned*)(args.ws + WS_CTL);
    for (int u = F.tid; u < (LDS_BYTES - RING_BYTES) / 4; u += NWAVES * 64) ((LAS unsigned*)(F.lds + RING_BYTES))[u] = 0u;
    __syncthreads();
    volatile LAS unsigned* MISC = (volatile LAS unsigned*)(F.lds + L_MISC);
    XcdBarrier bar; bar.bar = F.ctl + CW_BAR; bar.x = 0; bar.st = nullptr;
    if (!MK_PER_PHASE) bar = xcd_barrier_post(F.ctl + CW_BAR, MISC + 8, F.tid);
    const int lo = args.ph_lo, hi = args.ph_hi;
#ifndef PROBE_GRID1_PHASE
#define PROBE_GRID1_PHASE (-1)
#endif
#define PROBE_GRID1(p) ((p) == PROBE_GRID1_PHASE)
#ifndef PROBE_MODE
#define PROBE_MODE 1
#endif
#ifndef PROBE_REP_MASK
#define PROBE_REP_MASK 0
#endif
#define NREP(j) ((((PROBE_REP_MASK) >> (j)) & 1) ? 2 : 1)
#ifndef PROBE_XIN
#define PROBE_XIN 0
#endif
#ifndef PH_MASK
#define PH_MASK 0x1FFF
#endif
#define IN(k) (lo <= (k) && (k) < hi)
#define MSK(j) (((PH_MASK) >> (j)) & 1)
#define FRESH(Fp) Frame Fp = F; { int l_ = lane_id(); int z_ = 0; asm volatile("" : "+v"(l_), "+s"(z_)); Fp.lane = l_; Fp.wave = F.wave + z_; Fp.tid = Fp.wave * 64 + l_; Fp.vcu = F.vcu + z_; Fp.ws = F.ws + z_; Fp.ctl = (unsigned*)(Fp.ws + WS_CTL); }
#define SEAM(k) do { if (IN(k) && IN((k) + 1)) xcd_barrier(bar, F.wave * 64 + lane_id()); } while (0)

    if (MSK(11) && IN(0)) { FRESH(P); phase_prologue(P, args);
#ifdef PROBE_REPEAT_PROLOGUE
        __syncthreads(); phase_prologue(P, args);
#endif
    }
    SEAM(0);
    for (int l = 0; l < DEPTH; ++l) {
        const int pb = 1 + 11 * l;
        const float* mod = (const float*)(F.ws + WS_MOD);
        if (MSK(0) && IN(pb + 0)) { for (int rep_ = 0; rep_ < (l == 0 ? NREP(0) : 1); ++rep_) { if (rep_) __syncthreads(); FRESH(P); phase_norm1(P, args, l); } }
        SEAM(pb + 0);
        if (MSK(1) && IN(pb + 1)) { for (int rep_ = 0; rep_ < NREP(1); ++rep_) { if (rep_) __syncthreads(); FRESH(P);
            pg8::Gemm g{(const bf16*)(P.ws + WS_H), (const bf16*)(P.ws + WS_WIN) + (size_t)l * 4096 * DM, DM * 2};
            pg8::StaticOrder S; S.init(T, PROJ_LD, P.G, (int)blockIdx.x);
            pg8::EpiPlain E{(bf16*)(P.ws + WS_PROJ), PROJ_LD};
            pg8::gemm_phase<pg8::EpiPlain, pg8::StaticOrder, pg8::ALinear>(P.lds, g, S, pg8::ALinear{}, E, P.tid);
        } }
        SEAM(pb + 1);
#ifdef PROBE_EXTRA_BARRIERS
        if (IN(pb + 2)) for (int xb_ = 0; xb_ < PROBE_EXTRA_BARRIERS; ++xb_) xcd_barrier(bar, F.wave * 64 + lane_id());
#endif
        if (MSK(2) && IN(pb + 2)) { for (int rep_ = 0; rep_ < NREP(2); ++rep_) { if (rep_) __syncthreads(); FRESH(P); phase_mla_prep(P, args); } }
        SEAM(pb + 2);
        if (MSK(3) && IN(pb + 3)) { for (int rep_ = 0; rep_ < NREP(3); ++rep_) { if (rep_) __syncthreads(); FRESH(P);
#ifdef PROBE_SWAP_UP
            { pg8::Gemm g{(const bf16*)(P.ws + WS_PROJ) + C_CKV, (const bf16*)(P.ws + WS_WUKV) + (size_t)l * 2048 * 256, 256 * 2};
              pg8::StaticOrder S; S.init(T, 2048, P.G, (int)blockIdx.x);
              pg8::EpiKVup E{(bf16*)(P.ws + WS_KF), (bf16*)(P.ws + WS_VB), (const float*)(P.ws + WS_RSTDKV)};
              pg8::gemm_phase<pg8::EpiKVup, pg8::StaticOrder, pg8::APitch>(P.lds, g, S, pg8::APitch{PROJ_LD * 2}, E, P.tid); }
            { pg8::Gemm g{(const bf16*)(P.ws + WS_PROJ) + C_CQ, (const bf16*)(P.ws + WS_WUQ) + (size_t)l * 1536 * 512, 512 * 2};
              pg8::StaticOrder S; S.init(T, 1536, P.G, (int)blockIdx.x);
              pg8::EpiQup E{(bf16*)(P.ws + WS_QA), (const float*)(P.ws + WS_RSTDQ)};
#ifdef PROBE_QUP_PLAIN
              { pg8::EpiPlain E2{(bf16*)(P.ws + WS_QA), 1536}; pg8::gemm_phase<pg8::EpiPlain, pg8::StaticOrder, pg8::APitch>(P.lds, g, S, pg8::APitch{PROJ_LD * 2}, E2, P.tid); }
#else
              pg8::gemm_phase<pg8::EpiQup, pg8::StaticOrder, pg8::APitch>(P.lds, g, S, pg8::APitch{PROJ_LD * 2}, E, P.tid);
#endif
            }
#else
            { pg8::Gemm g{(const bf16*)(P.ws + WS_PROJ) + C_CQ, (const bf16*)(P.ws + WS_WUQ) + (size_t)l * 1536 * 512, 512 * 2};
              pg8::StaticOrder S; S.init(T, 1536, P.G, (int)blockIdx.x);
              pg8::EpiQup E{(bf16*)(P.ws + WS_QA), (const float*)(P.ws + WS_RSTDQ)};
#ifdef PROBE_QUP_PLAIN
              { pg8::EpiPlain E2{(bf16*)(P.ws + WS_QA), 1536}; pg8::gemm_phase<pg8::EpiPlain, pg8::StaticOrder, pg8::APitch>(P.lds, g, S, pg8::APitch{PROJ_LD * 2}, E2, P.tid); }
#else
              pg8::gemm_phase<pg8::EpiQup, pg8::StaticOrder, pg8::APitch>(P.lds, g, S, pg8::APitch{PROJ_LD * 2}, E, P.tid);
#endif
            }
            { pg8::Gemm g{(const bf16*)(P.ws + WS_PROJ) + C_CKV, (const bf16*)(P.ws + WS_WUKV) + (size_t)l * 2048 * 256, 256 * 2};
              pg8::StaticOrder S; S.init(T, 2048, P.G, (int)blockIdx.x);
              pg8::EpiKVup E{(bf16*)(P.ws + WS_KF), (bf16*)(P.ws + WS_VB), (const float*)(P.ws + WS_RSTDKV)};
              pg8::gemm_phase<pg8::EpiKVup, pg8::StaticOrder, pg8::APitch>(P.lds, g, S, pg8::APitch{PROJ_LD * 2}, E, P.tid); }
#endif
        } }
        SEAM(pb + 3);
#ifndef ATT_QROPE
        if (MSK(4) && IN(pb + 4)) { FRESH(P); phase_q_rope(P, args); }
        SEAM(pb + 4);
#endif
        if (MSK(5) && IN(pb + 5)) { FRESH(P); phase_attention(P, (char*)lds, args, l);
#ifdef PROBE_REPEAT_ATT
            __syncthreads(); phase_attention(P, (char*)lds, args, l);
#endif
        }
        SEAM(pb + 5);
        if (MSK(6) && IN(pb + 6)) { for (int rep_ = 0; rep_ < NREP(6); ++rep_) { if (rep_) __syncthreads(); FRESH(P); phase_out_norm(P, args, l); } }
        SEAM(pb + 6);
        if (MSK(7) && IN(pb + 7)) { FRESH(P);
#ifdef G3_FP8
            pg8::Gemm g{P.ws + WS_H, P.ws + WS_WOUT + (size_t)l * DM * DM, DM};
            pg8::StaticOrder S; S.init(T, DM, P.G, (int)blockIdx.x);
#ifdef XRES_BF16
            pg8::EpiResidB E{l == 0 ? (const void*)args.in[I_X] : (const void*)(P.ws + WS_XB), (bf16*)(P.ws + WS_XB), mod + (size_t)l * 4 * 12288 + 2 * DM, 12288, 1.0f / 256.0f, l == 0 ? 1 : 0};
            pg8::gemm_phase<pg8::EpiResidB, pg8::StaticOrder, pg8::ALinear, true>(P.lds, g, S, pg8::ALinear{}, E, P.tid);
#else
            pg8::EpiResid E{l == 0 ? args.in[I_X] : args.out, args.out, mod + (size_t)l * 4 * 12288 + 2 * DM, DM, 12288, 1.0f / 256.0f};
            pg8::gemm_phase<pg8::EpiResid, pg8::StaticOrder, pg8::ALinear, true>(P.lds, g, S, pg8::ALinear{}, E, P.tid);
#endif
#elif defined(XRES_BF16)
            pg8::Gemm g{(const bf16*)(P.ws + WS_H), (const bf16*)(P.ws + WS_WOUT) + (size_t)l * DM * DM, DM * 2};
            pg8::StaticOrder S; S.init(T, DM, P.G, (int)blockIdx.x);
            pg8::EpiResidB E{l == 0 ? (const void*)args.in[I_X] : (const void*)(P.ws + WS_XB), (bf16*)(P.ws + WS_XB), mod + (size_t)l * 4 * 12288 + 2 * DM, 12288, 1.0f, l == 0 ? 1 : 0};
            pg8::gemm_phase<pg8::EpiResidB, pg8::StaticOrder, pg8::ALinear>(P.lds, g, S, pg8::ALinear{}, E, P.tid);
#else
            pg8::Gemm g{(const bf16*)(P.ws + WS_H), (const bf16*)(P.ws + WS_WOUT) + (size_t)l * DM * DM, DM * 2};
            pg8::StaticOrder S; S.init(T, DM, P.G, (int)blockIdx.x);
            pg8::EpiResid E{l == 0 ? args.in[I_X] : args.out, args.out, mod + (size_t)l * 4 * 12288 + 2 * DM, DM, 12288, 1.0f};
            pg8::gemm_phase<pg8::EpiResid, pg8::StaticOrder, pg8::ALinear>(P.lds, g, S, pg8::ALinear{}, E, P.tid);
#endif
        }
        SEAM(pb + 7);
        if (MSK(8) && IN(pb + 8)) { FRESH(P); phase_router(P, args, l);
#ifdef PROBE_REPEAT_ROUTER
            __syncthreads(); phase_router(P, args, l, 1);
#endif
        }
        SEAM(pb + 8);
        if (MSK(9) && IN(pb + 9)) { for (int rep_ = 0; rep_ < NREP(9); ++rep_) { if (rep_) __syncthreads(); FRESH(P);
            const int NT = moe_setup(P, l);
            pg8::MoeOrder S{NT, 8, P.G, (int)blockIdx.x, (const LAS int*)(P.lds + L_TS)};
            LAS unsigned* atab = (LAS unsigned*)(P.lds + L_ATAB); const int* rowidx = (const int*)(P.ws + WS_ROWIDX);
#pragma unroll 1
            for (int slot = 0; slot < MAXU; ++slot) { pg8::Unit u; if (!S.next(slot, u)) break;
                if (P.tid < 256) { const int lr = u.lt * 256 + P.tid; const int ce = (int)P.ctl[CW_CNT + l * 16 + u.e];
                    int tok = lr < ce ? (rowidx[(size_t)u.e * 32768 + lr] >> 1) : 0;
#ifdef PROBE_LINEAR_ATAB
                    tok = (int)(((unsigned)(u.pm * 256 + P.tid) * 2654435761u) >> 17) & 32767;
#endif
 atab[slot * 256 + P.tid] = (unsigned)tok * (unsigned)DM; } }
            __syncthreads();
            pg8::Gemm g{P.ws + WS_H, P.ws + WS_W13, DM};
            pg8::EpiSwiglu E{P.ws + WS_HMID, DEXP};
            pg8::gemm_phase<pg8::EpiSwiglu, pg8::MoeOrder, pg8::ATable, true>(P.lds, g, S, pg8::ATable{atab}, E, P.tid);
        } }
        SEAM(pb + 9);
        if (MSK(10) && IN(pb + 10)) { for (int rep_ = 0; rep_ < NREP(10); ++rep_) { if (rep_) __syncthreads(); FRESH(P);
            const int NT = moe_setup(P, l);
            pg8::MoeOrder S{NT, 8, P.G, (int)blockIdx.x, (const LAS int*)(P.lds + L_TS)};
            pg8::Gemm g{P.ws + WS_HMID, P.ws + WS_W2, DEXP};
            pg8::EpiMoeDown E{(bf16*)(P.ws + WS_Y), (const int*)(P.ws + WS_ROWIDX), (const float*)(P.ws + WS_AW), P.ctl + CW_CNT + l * 16};
            pg8::gemm_phase<pg8::EpiMoeDown, pg8::MoeOrder, pg8::ALinear, true>(P.lds, g, S, pg8::ALinear{}, E, P.tid);
        } }
        SEAM(pb + 10);
    }
    #ifdef PROBE_DUMP_OFF
    if (MSK(12) && IN(NPH - 1)) { FRESH(P); phase_dump(P, args, (size_t)(PROBE_DUMP_OFF), PROBE_DUMP_PITCH); }
#else
    if (MSK(12) && IN(NPH - 1)) { FRESH(P); phase_final(P, args, args.li != 0 ? (PROBE_XIN ? 2 : PROBE_MODE) : 0);
#ifdef PROBE_EXACT
        { const int gw = P.vcu * NWAVES + P.wave, NGW = P.G * NWAVES; __syncthreads();
          for (int ch = gw; ch < T / 16; ch += NGW) for (int rr = 0; rr < 16; ++rr) for (int j = 0; j < 8; ++j) { float* p = args.out + (size_t)(ch * 16 + rr) * DM + 4 * P.lane + 256 * j; asm volatile("s_waitcnt vmcnt(0)" ::: "memory");
              const v4u ub = *(const v4u*)p; *(f32x4*)p = (f32x4){(float)(ub.x & 0xFFFu), (float)(ub.y & 0xFFFu), (float)(ub.z & 0xFFFu), (float)(ub.w & 0xFFFu)}; } }
#endif
    }
#endif
#undef IN
#undef SEAM
}

extern "C" void kernel_launch(void* const* d_in, const int* in_sizes, int n_in, void* d_out, int out_size, void* d_ws, size_t ws_size, hipStream_t stream) {
    static int grid = 0;
    if (grid == 0) {
        if (n_in != 20 || in_sizes[0] != T * DM || out_size != T * DM || ws_size < WS_END) {
            fprintf(stderr, "kernel_launch: unexpected problem (n_in %d, in0 %d, out %d, ws %zu < %zu)\n", n_in, n_in > 0 ? in_sizes[0] : -1, out_size, ws_size, (size_t)WS_END); grid = -1; return; }
        int dev = 0, cus = 0;
        if (hipGetDevice(&dev) != hipSuccess || hipDeviceGetAttribute(&cus, hipDeviceAttributeMultiprocessorCount, dev) != hipSuccess) { grid = -1; return; }
        if (hipFuncSetAttribute((const void*)mk_fwd, hipFuncAttributeMaxDynamicSharedMemorySize, LDS_BYTES) != hipSuccess) { fprintf(stderr, "kernel_launch: hipFuncSetAttribute failed\n"); grid = -1; return; }
        int per_cu = 0;
        if (hipOccupancyMaxActiveBlocksPerMultiprocessor(&per_cu, (const void*)mk_fwd, NWAVES * 64, LDS_BYTES) != hipSuccess || per_cu < 1) fprintf(stderr, "kernel_launch: occupancy query says %d blocks per CU\n", per_cu);
        (void)hipGetLastError();
        grid = cus;
        if (grid != 256) fprintf(stderr, "kernel_launch: %d CUs (built for 256)\n", grid);
    }
    if (grid < 0) return;
    if (hipMemsetAsync((char*)d_ws + WS_CTL, 0, CTL_ZERO_BYTES, stream) != hipSuccess) return;
    Args a; memset(&a, 0, sizeof(a));
    for (int i = 0; i < 20; ++i) a.in[i] = (const float*)d_in[i];
    a.out = (float*)d_out; a.ws = (unsigned char*)d_ws;
    for (int i = 0; i < 32; ++i) a.invf[i] = (float)pow(10000.0, -(double)i / 32.0);
#if MK_PER_PHASE
#ifndef PROBE_LAST
#define PROBE_LAST (NPH - 2)
#endif
    for (int p = 0; p < NPH; ++p) { if (p > PROBE_LAST && p != NPH - 1) continue;
#ifdef PROBE_ONLY_MASK
        if (p != NPH - 1 && !((PROBE_ONLY_MASK >> p) & 1)) continue;
#endif
 a.ph_lo = p; a.ph_hi = p + 1; a.li = (PROBE_LAST != NPH - 2) ? 1 : 0; hipLaunchKernelGGL(mk_fwd, dim3(PROBE_GRID1(p) ? 1 : grid), dim3(NWAVES * 64), LDS_BYTES, stream, a); }
#else
    a.ph_lo = 0; a.ph_hi = NPH; a.li = 0;
    hipLaunchKernelGGL(mk_fwd, dim3(grid), dim3(NWAVES * 64), LDS_BYTES, stream, a);
#endif
    const hipError_t le = hipPeekAtLastError();
    if (le != hipSuccess) fprintf(stderr, "kernel_launch: launch failed: %s\n", hipGetErrorName(le));
}
```

```cpp
#define MK_PER_PHASE 0
#define XRES_BF16 1
#define G3_FP8 1
#define ATT_QROPE 1
#define ST16_IMM 1
#define ROUTER_MFMA 1
#define ATT_CONV 2
#define ATT_SLOAD_RECOMP 1
#define ATT_RAWBAR 1
#include <hip/hip_runtime.h>
#include <cstdio>
#include <cstdint>
#include <cstring>
#include <cmath>
namespace pg8 {
#define PG8_LAS __attribute__((address_space(3)))
typedef unsigned short bf16_t;
typedef short bf16x8 __attribute__((ext_vector_type(8)));
typedef float f32x4 __attribute__((ext_vector_type(4)));
typedef float f32x2 __attribute__((ext_vector_type(2)));
typedef unsigned u32x4 __attribute__((ext_vector_type(4)));
typedef int v4i_t __attribute__((ext_vector_type(4)));
typedef int v8i_t __attribute__((ext_vector_type(8)));
constexpr int BM = 256, BK = 64, HALF = 128, HTB = HALF * BK * 2  , STAGE_BYTES = 8 * HTB, NXCD = 8, WGM = 8;

__host__ __device__ __forceinline__ int lds_byte(int r, int c) { const int st = (r >> 4) * 2 + (c >> 5), rr = r & 15, cc = c & 31, ob = rr * 64 + cc * 2; return st * 1024 + (ob ^ (((ob >> 9) & 1) << 5)); }
__host__ __device__ __forceinline__ void stage_rc(int b, int& R, int& C) { const int st = b / 1024, sb = b % 1024, swz = sb ^ (((sb >> 9) & 1) << 5); R = (st >> 1) * 16 + swz / 64; C = (st & 1) * 32 + (swz % 64) / 2; }
__host__ __device__ __forceinline__ int perm32(int rho) { const int n = rho >> 4, i = rho & 15; return 8 * (i >> 2) + 4 * n + (i & 3); }

struct Unit { int pm, pn, pb, e, lt; };
struct Gemm { const void* A; const void* Bt; int Kb; };

__device__ __forceinline__ bool order_tile(int i, int G, int c, int nM, int nN, int& pm, int& pn) {
    const int nwg = nM * nN; const long L = (long)i * G + c; if (L >= nwg) return false;
    int wgid = (int)L; { const int q = nwg / NXCD, r = nwg % NXCD, xcd = wgid % NXCD, off = wgid / NXCD; wgid = (xcd < r ? xcd * (q + 1) : r * (q + 1) + (xcd - r) * q) + off; }
    const int nig = WGM * nN, gid = wgid / nig, fm = gid * WGM, gsz = (nM - fm) < WGM ? (nM - fm) : WGM;
    pm = fm + ((wgid % nig) % gsz); pn = (wgid % nig) / gsz; return true;
}
struct StaticOrder {
    int nM, nN, G, c;
    __device__ __forceinline__ void init(int M, int N, int G_, int c_) { nM = M / BM; nN = N / BM; G = G_; c = c_; }
    __device__ __forceinline__ bool next(int i, Unit& u) const { int pm, pn; if (!order_tile(i, G, c, nM, nN, pm, pn)) return false; u.pm = pm; u.pn = pn; u.pb = pn; u.e = 0; u.lt = 0; return true; }
};
struct MoeOrder {
    int nM, nN, G, c; const PG8_LAS int* ts;
    __device__ __forceinline__ bool next(int i, Unit& u) const {
        int pm, pn; if (i >= 10 || !order_tile(i, G, c, nM, nN, pm, pn)) return false;
        int e = 0;
#pragma unroll
        for (int j = 1; j < 16; ++j) e += (__builtin_amdgcn_readfirstlane(ts[j]) <= pm) ? 1 : 0;
        e = __builtin_amdgcn_readfirstlane(e); u.pm = pm; u.pn = pn; u.e = e; u.lt = pm - __builtin_amdgcn_readfirstlane(ts[e]); u.pb = e * nN + pn; return true;
    }
};
struct ALinear { __device__ __forceinline__ unsigned off(const Unit& u, int slot, int r, int Kb) const { return (unsigned)(u.pm * BM + r) * (unsigned)Kb; } };
struct APitch  { unsigned pitchB; __device__ __forceinline__ unsigned off(const Unit& u, int slot, int r, int K) const { return (unsigned)(u.pm * BM + r) * pitchB; } };
struct ATable  { const PG8_LAS unsigned* tab; __device__ __forceinline__ unsigned off(const Unit& u, int slot, int r, int K) const { return tab[slot * BM + r]; } };

typedef __bf16 bf16x2_t __attribute__((ext_vector_type(2)));
__device__ __forceinline__ unsigned cvt_pk_bf16(float lo, float hi) { const f32x2 v = {lo, hi}; return __builtin_bit_cast(unsigned, __builtin_convertvector(v, bf16x2_t)); }

typedef f32x4 Acc[2][2][4][2];

typedef __amdgpu_buffer_rsrc_t rsrc_t;
#define PG8_RSRC(p) __builtin_amdgcn_make_buffer_rsrc((void*)(p), 0, 0x7fffffff, 0x00020000)
#ifdef ST16_IMM
__device__ __forceinline__ void st16(rsrc_t r, int vo, int so, u32x4 v) { __builtin_amdgcn_raw_buffer_store_b128(v, r, vo + so, 0, 0); }
#else
__device__ __forceinline__ void st16(rsrc_t r, int vo, int so, u32x4 v) { __builtin_amdgcn_raw_buffer_store_b128(v, r, vo, so, 0); }
#endif
__device__ __forceinline__ f32x4 ld16f(rsrc_t r, int vo, int so) { return __builtin_bit_cast(f32x4, __builtin_amdgcn_raw_buffer_load_b128(r, vo, so, 0)); }
__device__ __forceinline__ float ld4f(rsrc_t r, int vo, int so) { return __uint_as_float(__builtin_amdgcn_raw_buffer_load_b32(r, vo, so, 0)); }
__device__ __forceinline__ u32x4 pack8(const f32x4 v0, const f32x4 v1) { u32x4 w; w.x = cvt_pk_bf16(v0[0], v0[1]); w.y = cvt_pk_bf16(v0[2], v0[3]); w.z = cvt_pk_bf16(v1[0], v1[1]); w.w = cvt_pk_bf16(v1[2], v1[3]); return w; }
struct EpiPlain {
    static constexpr bool PERM = true;
    bf16_t* O; int ldc;
    __device__ __forceinline__ void operator()(const Acc& acc, const Unit& u, int wr, int wc, int fr, int fq) const {
        const rsrc_t ro = PG8_RSRC(O); const int vo = (fr * ldc + wc * 32 + 8 * fq) * 2;
#pragma unroll
        for (int ai = 0; ai < 2; ++ai)
#pragma unroll
            for (int m = 0; m < 4; ++m) { const int so = ((u.pm * BM + wr * 64 + ai * HALF + m * 16) * ldc + u.pn * BM) * 2;
#pragma unroll
                for (int bj = 0; bj < 2; ++bj) st16(ro, vo, so + bj * HALF * 2, pack8(acc[ai][bj][m][0], acc[ai][bj][m][1])); }
    }
};
struct EpiQup {
    static constexpr bool PERM = true;
    bf16_t* O; const float* rstd;
    __device__ __forceinline__ void operator()(const Acc& acc, const Unit& u, int wr, int wc, int fr, int fq) const {
        const rsrc_t ro = PG8_RSRC(O), rr = PG8_RSRC(rstd);
        const int vo = (fr * 1536 + wc * 32 + 8 * fq) * 2;
        float rs[2][4];
#pragma unroll
        for (int ai = 0; ai < 2; ++ai)
#pragma unroll
            for (int m = 0; m < 4; ++m) rs[ai][m] = ld4f(rr, fr * 4, (u.pm * BM + wr * 64 + ai * HALF + m * 16) * 4);
#pragma unroll
        for (int ai = 0; ai < 2; ++ai)
#pragma unroll
            for (int m = 0; m < 4; ++m) { const int rowu = u.pm * BM + wr * 64 + ai * HALF + m * 16; const float r1 = rs[ai][m];
                const int so = (rowu * 1536 + u.pn * BM) * 2;
                st16(ro, vo, so, pack8(acc[ai][0][m][0] * r1, acc[ai][0][m][1] * r1));
                st16(ro, vo, so + HALF * 2, pack8(acc[ai][1][m][0] * r1, acc[ai][1][m][1] * r1)); }
    }
};
struct EpiKVup {
    static constexpr bool PERM = true;
    bf16_t* KF; bf16_t* VB; const float* rstd;
    __device__ __forceinline__ void operator()(const Acc& acc, const Unit& u, int wr, int wc, int fr, int fq) const {
        const rsrc_t rk = PG8_RSRC(KF), rv = PG8_RSRC(VB), rr = PG8_RSRC(rstd);
        const int c0 = wc * 32 + 8 * fq, vok = (fr * 1536 + c0) * 2, vov = (fr * 1024 + c0) * 2;
        float rs[2][4];
#pragma unroll
        for (int ai = 0; ai < 2; ++ai)
#pragma unroll
            for (int m = 0; m < 4; ++m) rs[ai][m] = ld4f(rr, fr * 4, (u.pm * BM + wr * 64 + ai * HALF + m * 16) * 4);
#pragma unroll
        for (int ai = 0; ai < 2; ++ai)
#pragma unroll
            for (int m = 0; m < 4; ++m) { const int rowu = u.pm * BM + wr * 64 + ai * HALF + m * 16; const float r1 = rs[ai][m];
                st16(rk, vok, (rowu * 1536 + u.pn * 192) * 2, pack8(acc[ai][0][m][0] * r1, acc[ai][0][m][1] * r1));
                st16(rv, vov, (rowu * 1024 + u.pn * 128) * 2, pack8(acc[ai][1][m][0] * r1, acc[ai][1][m][1] * r1)); }
    }
};
struct EpiResid {
    static constexpr bool PERM = false;
    const float* base; float* out; const float* gate; int ldc; int gld; float ascale;
    __device__ __forceinline__ void operator()(const Acc& acc, const Unit& u, int wr, int wc, int fr, int fq) const {
        const rsrc_t rb = PG8_RSRC(base), ro = PG8_RSRC(out), rg = PG8_RSRC(gate);
        const int cl = (wc * 32 + 4 * fq) * 4, vo = fr * ldc * 4 + cl;
        f32x4 gv[2][2];
#pragma unroll
        for (int bj = 0; bj < 2; ++bj)
#pragma unroll
            for (int n = 0; n < 2; ++n) gv[bj][n] = ld16f(rg, cl, (((u.pm * BM) >> 13) * gld + u.pn * BM + bj * HALF + n * 16) * 4) * ascale;
#pragma unroll
        for (int ai = 0; ai < 2; ++ai) {
            f32x4 bs[4][2][2];
#pragma unroll
            for (int m = 0; m < 4; ++m) { const int so = ((u.pm * BM + ai * HALF + wr * 64 + m * 16) * ldc + u.pn * BM) * 4;
#pragma unroll
                for (int bj = 0; bj < 2; ++bj)
#pragma unroll
                    for (int n = 0; n < 2; ++n) bs[m][bj][n] = ld16f(rb, vo, so + (bj * HALF + n * 16) * 4); }
#pragma unroll
            for (int m = 0; m < 4; ++m) { const int so = ((u.pm * BM + ai * HALF + wr * 64 + m * 16) * ldc + u.pn * BM) * 4;
#pragma unroll
                for (int bj = 0; bj < 2; ++bj)
#pragma unroll
                    for (int n = 0; n < 2; ++n) st16(ro, vo, so + (bj * HALF + n * 16) * 4, __builtin_bit_cast(u32x4, bs[m][bj][n] + gv[bj][n] * acc[ai][bj][m][n])); }
            asm volatile("s_waitcnt vmcnt(0)" ::: "memory");
        }
    }
};
struct EpiResidB {
    static constexpr bool PERM = true;
    const void* base; bf16_t* out; const float* gate; int gld; float ascale; int BASE_F32;
    __device__ __forceinline__ void operator()(const Acc& acc, const Unit& u, int wr, int wc, int fr, int fq) const {
        const rsrc_t rb = PG8_RSRC(base), ro = PG8_RSRC(out), rg = PG8_RSRC(gate);
        const int c0 = wc * 32 + 8 * fq;
        f32x4 gv[2][2];
#pragma unroll
        for (int bj = 0; bj < 2; ++bj)
#pragma unroll
            for (int n = 0; n < 2; ++n) gv[bj][n] = ld16f(rg, (c0 + 4 * n) * 4, (((u.pm * BM) >> 13) * gld + u.pn * BM + bj * HALF) * 4) * ascale;
#pragma unroll
        for (int ai = 0; ai < 2; ++ai) {
            f32x4 bs[4][2][2];
#pragma unroll
            for (int m = 0; m < 4; ++m) { const int rowu = u.pm * BM + ai * HALF + wr * 64 + m * 16;
#pragma unroll
                for (int bj = 0; bj < 2; ++bj) {
                    if (BASE_F32) { const int so = (rowu * 2048 + u.pn * BM + bj * HALF) * 4, vo = (fr * 2048 + c0) * 4;
                        bs[m][bj][0] = ld16f(rb, vo, so); bs[m][bj][1] = ld16f(rb, vo + 16, so); }
                    else { const int so = (rowu * 2048 + u.pn * BM + bj * HALF) * 2, vo = (fr * 2048 + c0) * 2;
                        const u32x4 w = __builtin_bit_cast(u32x4, __builtin_amdgcn_raw_buffer_load_b128(rb, vo, so, 0));
                        bs[m][bj][0] = (f32x4){__uint_as_float(w.x << 16), __uint_as_float(w.x & 0xffff0000u), __uint_as_float(w.y << 16), __uint_as_float(w.y & 0xffff0000u)};
                        bs[m][bj][1] = (f32x4){__uint_as_float(w.z << 16), __uint_as_float(w.z & 0xffff0000u), __uint_as_float(w.w << 16), __uint_as_float(w.w & 0xffff0000u)}; } } }
#pragma unroll
            for (int m = 0; m < 4; ++m) { const int rowu = u.pm * BM + ai * HALF + wr * 64 + m * 16;
#pragma unroll
                for (int bj = 0; bj < 2; ++bj) st16(ro, (fr * 2048 + c0) * 2, (rowu * 2048 + u.pn * BM + bj * HALF) * 2,
                                                    pack8(bs[m][bj][0] + gv[bj][0] * acc[ai][bj][m][0], bs[m][bj][1] + gv[bj][1] * acc[ai][bj][m][1])); }
            asm volatile("s_waitcnt vmcnt(0)" ::: "memory");
        }
    }
};
struct EpiSwiglu {
    static constexpr bool PERM = true;
    unsigned char* O; int ldc;
    __device__ __forceinline__ void operator()(const Acc& acc, const Unit& u, int wr, int wc, int fr, int fq) const {
        const rsrc_t ro = PG8_RSRC(O); const int vo = fr * ldc + wc * 32 + 8 * fq;
#pragma unroll
        for (int ai = 0; ai < 2; ++ai)
#pragma unroll
            for (int m = 0; m < 4; ++m) { const int so = (u.pm * BM + wr * 64 + ai * HALF + m * 16) * ldc + u.pn * HALF; float r[8];
#pragma unroll
                for (int n = 0; n < 2; ++n)
#pragma unroll
                    for (int k = 0; k < 4; ++k) { const float g = acc[ai][0][m][n][k] * (1.0f / 256.0f), up = acc[ai][1][m][n][k] * (1.0f / 256.0f);
                        r[n * 4 + k] = g * __builtin_amdgcn_rcpf(1.0f + __builtin_amdgcn_exp2f(-1.4426950408889634f * g)) * up; }
                int w0 = 0, w1 = 0;
                w0 = __builtin_amdgcn_cvt_pk_fp8_f32(r[0], r[1], w0, false); w0 = __builtin_amdgcn_cvt_pk_fp8_f32(r[2], r[3], w0, true);
                w1 = __builtin_amdgcn_cvt_pk_fp8_f32(r[4], r[5], w1, false); w1 = __builtin_amdgcn_cvt_pk_fp8_f32(r[6], r[7], w1, true);
                typedef unsigned u32x2_t __attribute__((ext_vector_type(2)));
                __builtin_amdgcn_raw_buffer_store_b64((u32x2_t){(unsigned)w0, (unsigned)w1}, ro, vo, so, 0); }
    }
};
struct EpiMoeDown {
    static constexpr bool PERM = true;
    bf16_t* Y; const int* rowidx; const float* aw; const unsigned* cnt;
    __device__ __forceinline__ void operator()(const Acc& acc, const Unit& u, int wr, int wc, int fr, int fq) const {
        const rsrc_t ry = PG8_RSRC(Y), ri = PG8_RSRC(rowidx), ra = PG8_RSRC(aw);
        const int nvalid = (int)cnt[u.e] - u.lt * BM; const int cb = (u.pn * BM + wc * 32 + 8 * fq) * 2;
        int idx[2][4]; float w8[2][4];
#pragma unroll
        for (int ai = 0; ai < 2; ++ai)
#pragma unroll
            for (int m = 0; m < 4; ++m) { const int ru = ai * HALF + wr * 64 + m * 16; idx[ai][m] = -1; w8[ai][m] = 0.f;
                if (ru + fr < nvalid) { idx[ai][m] = (int)__builtin_amdgcn_raw_buffer_load_b32(ri, fr * 4, (u.e * 32768 + u.lt * BM + ru) * 4, 0); w8[ai][m] = ld4f(ra, idx[ai][m] * 4, 0); } }
#pragma unroll
        for (int ai = 0; ai < 2; ++ai)
#pragma unroll
            for (int m = 0; m < 4; ++m) if (idx[ai][m] >= 0) { const int vo = idx[ai][m] * 4096 + cb; const float w1 = w8[ai][m] * (1.0f / 256.0f);
#pragma unroll
                for (int bj = 0; bj < 2; ++bj) st16(ry, vo, bj * HALF * 2, pack8(acc[ai][bj][m][0] * w1, acc[ai][bj][m][1] * w1)); }
    }
};

template <class Epi, class Sched, class AOff, bool FP8 = false>
__device__ __forceinline__ void gemm_phase(PG8_LAS unsigned char* lds, const Gemm g, const Sched& S, const AOff& AO, const Epi& E, int tid_in) {
    int tid = tid_in; asm volatile("" : "+v"(tid));
    const int wid = __builtin_amdgcn_readfirstlane(tid >> 6), lane = tid & 63, wr = wid >> 2, wc = wid & 3, fr = lane & 15, fq = lane >> 4;
    int K = g.Kb; asm volatile("" : "+s"(K));
    const int nt = K / (BK * 2);
    int Ra[2], Ca[2]; unsigned voffB[2];
#pragma unroll
    for (int i = 0; i < 2; ++i) { int R, C; stage_rc(tid * 16 + i * 8192, R, C); const int Rb = Epi::PERM ? ((R & ~31) + perm32(R & 31)) : R;
        Ra[i] = R; Ca[i] = C * 2; voffB[i] = (unsigned)(Rb * K + C * 2); }
    const size_t kstep = (size_t)(BK * 2);
    const size_t hstep = (size_t)HALF * K;
    const size_t tstep = 2 * hstep;
    const unsigned ldsw = (unsigned)wid * 1024u;
    const unsigned lds0 = (unsigned)(uintptr_t)lds;
    const int aoff = lds_byte(wr * 64 + fr, fq * 8), boff = lds_byte(wc * 32 + fr, fq * 8);
#define PG8_SA(b, h) (((b) * 2 + (h)) * HTB)
#define PG8_SB(b, h) ((4 + (b) * 2 + (h)) * HTB)
#define PG8_STAGE(bufoff, gbase, voff) do { _Pragma("unroll") for (int _i = 0; _i < 2; ++_i) { unsigned keep_; \
        asm volatile("s_mov_b32 %0, m0\n\ts_mov_b32 m0, %2\n\ts_nop 0\n\tglobal_load_lds_dwordx4 %1, %3\n\ts_mov_b32 m0, %0" : "=&s"(keep_) \
            : "v"((voff)[_i]), "s"((unsigned)__builtin_amdgcn_readfirstlane((int)(lds0 + (bufoff) + ldsw + _i * 8192))), "s"((const void*)(gbase)) : "memory"); } } while (0)
#define PG8_LD8(addr) __builtin_shufflevector(*(const PG8_LAS v4i_t*)(addr), *(const PG8_LAS v4i_t*)((addr) + 1024), 0, 1, 2, 3, 4, 5, 6, 7)
#define PG8_LDA(dst, b, h) do { _Pragma("unroll") for (int m = 0; m < 4; ++m) dst[m] = PG8_LD8(lds + PG8_SA(b, h) + aoff + m * 2048); } while (0)
#define PG8_LDB(dst, b, h) do { _Pragma("unroll") for (int n = 0; n < 2; ++n) dst[n] = PG8_LD8(lds + PG8_SB(b, h) + boff + n * 2048); } while (0)
#define PG8_HALF(x, k) __builtin_bit_cast(bf16x8, __builtin_shufflevector(x, x, 4 * (k), 4 * (k) + 1, 4 * (k) + 2, 4 * (k) + 3))
#define PG8_MMA(ai, bj, At, Bt) do { __builtin_amdgcn_s_setprio(1); _Pragma("unroll") for (int m = 0; m < 4; ++m) _Pragma("unroll") for (int n = 0; n < 2; ++n) { \
        if constexpr (FP8) asm volatile("v_mfma_scale_f32_16x16x128_f8f6f4 %0, %1, %2, %0, %3, %3 op_sel_hi:[0,0,0]" : "+v"(acc[ai][bj][m][n]) : "v"(Bt[n]), "v"(At[m]), "v"(sc1_));   \
        else { acc[ai][bj][m][n] = __builtin_amdgcn_mfma_f32_16x16x32_bf16(PG8_HALF(Bt[n], 0), PG8_HALF(At[m], 0), acc[ai][bj][m][n], 0, 0, 0); \
               acc[ai][bj][m][n] = __builtin_amdgcn_mfma_f32_16x16x32_bf16(PG8_HALF(Bt[n], 1), PG8_HALF(At[m], 1), acc[ai][bj][m][n], 0, 0, 0); } } \
        __builtin_amdgcn_s_setprio(0); } while (0)
#define PG8_WAIT_V(n) asm volatile("s_waitcnt vmcnt(" #n ")" ::: "memory")
#define PG8_WAIT_L(n) asm volatile("s_waitcnt lgkmcnt(" #n ")" ::: "memory")
#define PG8_BAR __builtin_amdgcn_s_barrier()
#define PG8_SCHED __builtin_amdgcn_sched_barrier(0)
#define PG8_AOFF(dst, u, slot) do { _Pragma("unroll") for (int _h = 0; _h < 2; ++_h) _Pragma("unroll") for (int _i = 0; _i < 2; ++_i) dst[_h][_i] = AO.off(u, slot, _h * HALF + Ra[_i], K) + (unsigned)Ca[_i]; } while (0)
    Unit cur, nxt; int ui = 0;
    if (!S.next(0, cur)) return;
    Acc acc;
#pragma unroll
    for (int a = 0; a < 2; ++a)
#pragma unroll
        for (int b = 0; b < 2; ++b)
#pragma unroll
            for (int m = 0; m < 4; ++m)
#pragma unroll
                for (int n = 0; n < 2; ++n) acc[a][b][m][n] = (f32x4){0.f, 0.f, 0.f, 0.f};
    v8i_t At[4], B0[2], B1[2];
    int sc1_ = 0x7F7F7F7F; asm volatile("" : "+v"(sc1_));
    unsigned aoC[2][2];
    PG8_AOFF(aoC, cur, 0);
    const char* gA = (const char*)g.A; const char* gB = (const char*)g.Bt;
    asm volatile("" : "+s"(gA), "+s"(gB));
    const char* cB = gB + (size_t)cur.pb * tstep;
    PG8_STAGE(PG8_SB(0, 0), cB, voffB); PG8_STAGE(PG8_SB(0, 1), cB + hstep, voffB); PG8_STAGE(PG8_SA(0, 0), gA, aoC[0]); PG8_STAGE(PG8_SA(0, 1), gA, aoC[1]);
    if (wr == 1) PG8_BAR;
    PG8_WAIT_V(2); PG8_BAR;
    PG8_STAGE(PG8_SB(1, 0), cB + kstep, voffB); PG8_STAGE(PG8_SA(1, 0), gA + kstep, aoC[0]); PG8_STAGE(PG8_SB(1, 1), cB + hstep + kstep, voffB);
    PG8_WAIT_V(6); PG8_BAR;
    for (;;) {
        const bool has_next = S.next(ui + 1, nxt);
        const char* nB = has_next ? gB + (size_t)nxt.pb * tstep : cB;
        for (int t = 0; t < nt; t += 2) {
            const bool last = (t == nt - 2);
            const char* a1 = gA + (size_t)(t + 1) * kstep;
            const char* a2 = last ? gA : gA + (size_t)(t + 2) * kstep; const char* b2 = last ? nB : cB + (size_t)(t + 2) * kstep;
            const char* a3 = a2 + kstep; const char* b3 = b2 + kstep;
            unsigned ao2[2][2];
            if (last && has_next) { PG8_AOFF(ao2, nxt, ui + 1); }
            else {
#pragma unroll
                for (int _h = 0; _h < 2; ++_h)
#pragma unroll
                    for (int _i = 0; _i < 2; ++_i) ao2[_h][_i] = aoC[_h][_i]; }
            PG8_LDB(B0, 0, 0); PG8_LDB(B1, 0, 1); PG8_SCHED; PG8_LDA(At, 0, 0); PG8_STAGE(PG8_SA(1, 1), a1, aoC[1]);
            PG8_WAIT_V(8); PG8_WAIT_L(0); PG8_BAR; PG8_MMA(0, 0, At, B0); PG8_MMA(0, 1, At, B1); PG8_BAR; PG8_SCHED;
            PG8_LDA(At, 0, 1); PG8_STAGE(PG8_SB(0, 0), b2, voffB); PG8_STAGE(PG8_SB(0, 1), b2 + hstep, voffB); PG8_STAGE(PG8_SA(0, 0), a2, ao2[0]);
            PG8_WAIT_V(8); PG8_WAIT_L(0); PG8_BAR; PG8_MMA(1, 0, At, B0); PG8_MMA(1, 1, At, B1); PG8_BAR; PG8_SCHED;
            PG8_LDB(B0, 1, 0); PG8_LDB(B1, 1, 1); PG8_SCHED; PG8_LDA(At, 1, 0); PG8_STAGE(PG8_SA(0, 1), a2, ao2[1]);
            PG8_WAIT_V(8); PG8_WAIT_L(0); PG8_BAR; PG8_MMA(0, 0, At, B0); PG8_MMA(0, 1, At, B1); PG8_BAR; PG8_SCHED;
            PG8_LDA(At, 1, 1); PG8_STAGE(PG8_SB(1, 0), b3, voffB); PG8_STAGE(PG8_SB(1, 1), b3 + hstep, voffB); PG8_STAGE(PG8_SA(1, 0), a3, ao2[0]);
            PG8_WAIT_V(8); PG8_WAIT_L(0); PG8_BAR; PG8_MMA(1, 0, At, B0); PG8_MMA(1, 1, At, B1); PG8_BAR; PG8_SCHED;
        }
        if (wr == 0) PG8_BAR;
        E(acc, cur, wr, wc, fr, fq);
        if (!has_next) break;
#pragma unroll
        for (int a = 0; a < 2; ++a)
#pragma unroll
            for (int b = 0; b < 2; ++b)
#pragma unroll
                for (int m = 0; m < 4; ++m)
#pragma unroll
                    for (int n = 0; n < 2; ++n) acc[a][b][m][n] = (f32x4){0.f, 0.f, 0.f, 0.f};
        cur = nxt; cB = nB; ++ui;
        PG8_AOFF(aoC, cur, ui);
        if (wr == 1) PG8_BAR;
    }
    PG8_WAIT_V(0);
    PG8_BAR;
#undef PG8_SA
#undef PG8_SB
#undef PG8_STAGE
#undef PG8_LDA
#undef PG8_LDB
#undef PG8_MMA
#undef PG8_LD8
#undef PG8_HALF
#undef PG8_WAIT_V
#undef PG8_WAIT_L
#undef PG8_BAR
#undef PG8_SCHED
#undef PG8_AOFF
}
}
namespace att {
typedef unsigned short bf16;
typedef short bf16x8 __attribute__((ext_vector_type(8)));
typedef short s16x4 __attribute__((ext_vector_type(4)));
typedef float f32x16 __attribute__((ext_vector_type(16)));
typedef float f32x4 __attribute__((ext_vector_type(4)));
typedef unsigned u32x4 __attribute__((ext_vector_type(4)));
constexpr int NW = 8, QBLK = 32, KVBLK = 64, QB = NW * QBLK, DV = 128;
constexpr float THR = 8.f;
constexpr int SHM_V = KVBLK * DV * 2;
template <int DQK> struct Cfg { static constexpr int NKC = DQK / 8, KCH = NKC / 8, KPITCH = DQK * 2, SHM_K = KVBLK * KPITCH, NQF = DQK / 16, LDS_BYTES = 2 * SHM_V + 2 * SHM_K + NW * 64 * 4; };
#define SBAR() __builtin_amdgcn_sched_barrier(0)
__device__ __forceinline__ int v_st(int k, int c) { const int kk = (k & ~0xC) | ((k & 4) << 1) | ((k & 8) >> 1); return ((kk >> 3) * 4 + (c >> 5)) * 512 + ((kk & 7) * 32 + (c & 31)) * 2; }
__device__ __forceinline__ int v_rd_base(int lane) { return ((lane & 3) << 3) | (((lane >> 2) & 3) << 6) | (((lane >> 4) & 1) << 5) | (((lane >> 5) & 1) << 8); }
constexpr int v_rd_off(int d0, int ks, int half) { return d0 * 512 + ks * 4096 + half * 2048; }
__device__ __forceinline__ int crow(int r, int hi) { return (r & 3) + 8 * (r >> 2) + 4 * hi; }
__device__ __forceinline__ unsigned cvtpk(float lo, float hi) { return pg8::cvt_pk_bf16(lo, hi); }
__device__ __forceinline__ bf16x8 load8(const bf16* p) { return *reinterpret_cast<const bf16x8*>(p); }
__device__ __forceinline__ void mask_tile(f32x16& p0, f32x16& p1, int dq, unsigned W) {
    const float NEG = -__builtin_inff();
#pragma unroll
    for (int r = 0; r < 16; ++r) { const int c = (r & 3) + 8 * (r >> 2);
        if ((unsigned)(dq - c) >= W) p0[r] = NEG;
        if ((unsigned)(dq - c - 32) >= W) p1[r] = NEG; }
}
__device__ __forceinline__ void partialSM(f32x16& p0, f32x16& p1, float& m_reg, float& mn, float& alpha, float scale) {
    float pmax = p0[0];
#pragma unroll
    for (int r = 1; r < 16; ++r) pmax = fmaxf(pmax, p0[r]);
#pragma unroll
    for (int r = 0; r < 16; ++r) pmax = fmaxf(pmax, p1[r]);
    { auto rr = __builtin_amdgcn_permlane32_swap(__float_as_uint(pmax), __float_as_uint(pmax), false, false);
      pmax = fmaxf(__uint_as_float(rr[0]), __uint_as_float(rr[1])); }
    const float C2 = 1.4426950408889634f * scale;
    if (__builtin_expect(__all((pmax - m_reg) * scale <= THR), 1)) { mn = m_reg; alpha = 1.f; }
    else { mn = fmaxf(m_reg, pmax); alpha = __builtin_amdgcn_exp2f((m_reg - mn) * C2); m_reg = mn; }
    const float mnL = -mn * C2;
#pragma unroll
    for (int r = 0; r < 16; ++r) p0[r] = fmaf(p0[r], C2, mnL);
#pragma unroll
    for (int r = 0; r < 16; ++r) p1[r] = fmaf(p1[r], C2, mnL);
#pragma unroll
    for (int r = 0; r < 16; ++r) p0[r] = __builtin_amdgcn_exp2f(p0[r]);
}
__device__ __forceinline__ void finishSM(f32x16& p0, f32x16& p1, float alpha, float& l_reg, bf16x8& pa0, bf16x8& pa1, bf16x8& pa2, bf16x8& pa3) {
#pragma unroll
    for (int r = 0; r < 16; ++r) p1[r] = __builtin_amdgcn_exp2f(p1[r]);
    float ps = 0;
#pragma unroll
    for (int r = 0; r < 16; ++r) ps += p0[r];
#pragma unroll
    for (int r = 0; r < 16; ++r) ps += p1[r];
    { auto rr = __builtin_amdgcn_permlane32_swap(__float_as_uint(ps), __float_as_uint(ps), false, false);
      ps = __uint_as_float(rr[0]) + __uint_as_float(rr[1]); }
    l_reg = l_reg * alpha + ps;
#define PK4(P, B_, OUT) do { unsigned a0 = cvtpk(P[B_+0], P[B_+1]), a1 = cvtpk(P[B_+2], P[B_+3]);                          \
        unsigned b0 = cvtpk(P[B_+4], P[B_+5]), b1 = cvtpk(P[B_+6], P[B_+7]);                                             \
        auto r0 = __builtin_amdgcn_permlane32_swap(a0, b0, false, false); auto r1 = __builtin_amdgcn_permlane32_swap(a1, b1, false, false); \
        u32x4 w = {r0[0], r1[0], r0[1], r1[1]}; OUT = *reinterpret_cast<bf16x8*>(&w); } while (0)
    PK4(p0, 0, pa0); PK4(p0, 8, pa1); PK4(p1, 0, pa2); PK4(p1, 8, pa3);
#undef PK4
}
template <int KB, bool SK, int DQK, bool DIL>
__device__ __forceinline__ void qkt(f32x16& p0, f32x16& p1, const char* K_lds, int r32, int hi, const bf16x8* qr, bool act, float beta, int dq) {
    typedef Cfg<DQK> C;
    if (SK && !act) { const float NEG = -__builtin_inff();
#pragma unroll
        for (int r = 0; r < 16; ++r) { p0[r] = NEG; p1[r] = NEG; } return; }
    if constexpr (DIL) { const float b0 = -beta * (float)dq;
#pragma unroll
        for (int r = 0; r < 16; ++r) { const int c = (r & 3) + 8 * (r >> 2); p0[r] = fmaf(beta, (float)c, b0); p1[r] = fmaf(beta, (float)(c + 32), b0); } }
    else { p0 = f32x16{}; p1 = f32x16{}; }
    const char* kb[4];
#pragma unroll
    for (int dd = 0; dd < 4; ++dd) { const int colB = (dd * 16 + hi * 8) * 2; kb[dd] = K_lds + KB * C::SHM_K + r32 * C::KPITCH + (colB ^ ((r32 & 7) << 4)); }
#pragma unroll
    for (int d0 = 0; d0 < C::NQF; ++d0) { const char* a = kb[d0 & 3] + (d0 >> 2) * 128;
        bf16x8 b0 = *reinterpret_cast<const bf16x8*>(a);
        bf16x8 b1 = *reinterpret_cast<const bf16x8*>(a + 32 * C::KPITCH);
        p0 = __builtin_amdgcn_mfma_f32_32x32x16_bf16(b0, qr[d0], p0, 0, 0, 0);
        p1 = __builtin_amdgcn_mfma_f32_32x32x16_bf16(b1, qr[d0], p1, 0, 0, 0);
#ifndef ATT_NO_QKT_SBAR
        if ((d0 & 3) == 3) SBAR();
#endif
    }
}
template <int VB, bool SK>
__device__ __forceinline__ void pv_tile(f32x16* o, int vb0, bf16x8 pa0, bf16x8 pa1, bf16x8 pa2, bf16x8 pa3, bool act) {
    if (SK && !act) return;
#define TRRD(dst, off) asm volatile("ds_read_b64_tr_b16 %0, %1 offset:%2" : "=&v"(dst) : "v"(vb0), "i"(off) : "memory")
#define PV_D0(d0) do { s16x4 l0, l1, l2, l3, h0, h1, h2, h3; constexpr int b_ = VB * SHM_V + v_rd_off(d0, 0, 0); \
        TRRD(l0, b_); TRRD(h0, b_ + 2048); TRRD(l1, b_ + 4096); TRRD(h1, b_ + 6144); TRRD(l2, b_ + 8192); TRRD(h2, b_ + 10240); TRRD(l3, b_ + 12288); TRRD(h3, b_ + 14336); \
        asm volatile("s_waitcnt lgkmcnt(0)" ::: "memory"); SBAR();   \
        o[d0] = __builtin_amdgcn_mfma_f32_32x32x16_bf16(pa0, (bf16x8){l0[0], l0[1], l0[2], l0[3], h0[0], h0[1], h0[2], h0[3]}, o[d0], 0, 0, 0);   \
        o[d0] = __builtin_amdgcn_mfma_f32_32x32x16_bf16(pa1, (bf16x8){l1[0], l1[1], l1[2], l1[3], h1[0], h1[1], h1[2], h1[3]}, o[d0], 0, 0, 0);   \
        o[d0] = __builtin_amdgcn_mfma_f32_32x32x16_bf16(pa2, (bf16x8){l2[0], l2[1], l2[2], l2[3], h2[0], h2[1], h2[2], h2[3]}, o[d0], 0, 0, 0);   \
        o[d0] = __builtin_amdgcn_mfma_f32_32x32x16_bf16(pa3, (bf16x8){l3[0], l3[1], l3[2], l3[3], h3[0], h3[1], h3[2], h3[3]}, o[d0], 0, 0, 0); } while (0)
    PV_D0(0); PV_D0(1); PV_D0(2); PV_D0(3);
#undef PV_D0
#undef TRRD
}

struct Blk { unsigned qo, ko, vo, oo, lo; int P0, rate; float beta; };
constexpr int PVAR = 0;
#define QS_(B) (DIL ? ((PVAR & 4) ? 128 : (B).rate * 4096) : 1536)
#define KS_(B) (DIL ? ((PVAR & 2) ? 128 : (B).rate * 4096) : 1536)
#define VS_(B) (DIL ? ((PVAR & 2) ? 128 : (B).rate * 4096) : 1024)
#define OS_(B) (DIL ? (B).rate * 1024 : 1024)
#define LS_(B) ((B).rate * 8)
#define SKV_(B) (DIL ? 8192 / (B).rate : 8192)
#define W_(B) (DIL ? 129 : (1 << 30))
#define SCALE_ (DIL ? 0.08838834764831845f : 0.07216878364870322f)
template <int DQK> struct Seam { bf16x8 qr[Cfg<DQK>::NQF]; bf16x8 st_v0, st_v1; bf16x8 st_k[Cfg<DQK>::KCH]; unsigned p_oo = 0; int p_rb = 0, p_so0 = 0, p_on = 0; float cv[4], cw[4]; int cv_j = 0, cv_q = 0, cl_j = 0, cl_q = 0; f32x4 rt[8]; float cvf[16]; int cv_pend = 0; };
__device__ __forceinline__ int swa_jlo(int P0, int W) { const int lowk = P0 - W + 1; return lowk > 0 ? lowk / KVBLK : 0; }

#define VMW() asm volatile("s_waitcnt vmcnt(0)" ::: "memory")
#ifdef ATT_RAWBAR
#define A_STEPBAR() do { asm volatile("s_waitcnt lgkmcnt(0)" ::: "memory"); __builtin_amdgcn_s_barrier(); asm volatile("" ::: "memory"); } while (0)
#else
#define A_STEPBAR() __syncthreads()
#endif
#define VMWN(n) asm volatile("s_waitcnt vmcnt(%0)" :: "i"(n) : "memory")
#define A_RSRC(p) __builtin_amdgcn_make_buffer_rsrc((void*)(p), 0, 0x7fffffff, 0x00020000)
#define A_BLD(rs, vo, so) __builtin_bit_cast(bf16x8, __builtin_amdgcn_raw_buffer_load_b128((rs), (int)(vo), (int)(so), 0))
#ifdef ATT_SLOAD_RECOMP
#define A_SLOAD(B_, k0) do { const __amdgpu_buffer_rsrc_t rv_ = A_RSRC(wsb + (B_).vo), rk_ = A_RSRC(wsb + (B_).ko); const int sov_ = (k0) * VS_(B_) * 2, sok_ = (k0) * KS_(B_) * 2; \
        int t_ = tid; asm volatile("" : "+v"(t_)); const int sr_ = t_ >> 4, sc_ = (t_ & 15) * 8; \
        S.st_v0 = A_BLD(rv_, (sr_ * VS_(B_) + sc_) * 2, sov_); S.st_v1 = A_BLD(rv_, ((32 + sr_) * VS_(B_) + sc_) * 2, sov_); \
        _Pragma("unroll") for (int j_ = 0; j_ < C::KCH; ++j_) { const int q_ = t_ + 512 * j_; S.st_k[j_] = A_BLD(rk_, ((q_ / C::NKC) * KS_(B_) + (q_ % C::NKC) * 8) * 2, sok_); } } while (0)
#else
#define A_SLOAD(B_, k0) do { const __amdgpu_buffer_rsrc_t rv_ = A_RSRC(wsb + (B_).vo), rk_ = A_RSRC(wsb + (B_).ko); const int sov_ = (k0) * VS_(B_) * 2, sok_ = (k0) * KS_(B_) * 2; \
        S.st_v0 = A_BLD(rv_, (sr * VS_(B_) + sc) * 2, sov_); S.st_v1 = A_BLD(rv_, ((32 + sr) * VS_(B_) + sc) * 2, sov_); \
        _Pragma("unroll") for (int j_ = 0; j_ < C::KCH; ++j_) S.st_k[j_] = A_BLD(rk_, (krow[j_] * KS_(B_) + kcol[j_]) * 2, sok_); } while (0)
#endif
#define A_QLOAD(B_) do { const __amdgpu_buffer_rsrc_t rq_ = A_RSRC(wsb + (B_).qo); const int soq_ = ((B_).P0 + wid * QBLK) * QS_(B_) * 2; const int qo_ = r32 * QS_(B_) * 2 + hi * 16; \
        _Pragma("unroll") for (int d0 = 0; d0 < C::NQF; ++d0) S.qr[d0] = A_BLD(rq_, qo_ + d0 * 32, soq_); } while (0)
#define A_SWRITE_K(bf) do { _Pragma("unroll") for (int j_ = 0; j_ < C::KCH; ++j_) *(bf16x8*)(K_lds + (bf) * C::SHM_K + kws[j_]) = S.st_k[j_]; } while (0)
#define A_SWRITE_V(bf) do { *(bf16x8*)(V_lds + (bf) * SHM_V + vst0) = S.st_v0; *(bf16x8*)(V_lds + (bf) * SHM_V + vst1) = S.st_v1; } while (0)
#define A_STAGE_IDX() const int sr = tid >> 4, sc = (tid & 15) * 8; int krow[C::KCH], kcol[C::KCH], kws[C::KCH]; \
        _Pragma("unroll") for (int j_ = 0; j_ < C::KCH; ++j_) { const int q_ = tid + 512 * j_; krow[j_] = q_ / C::NKC; kcol[j_] = (q_ % C::NKC) * 8; kws[j_] = krow[j_] * C::KPITCH + ((kcol[j_] * 2) ^ ((krow[j_] & 7) << 4)); }

__device__ __forceinline__ void store_o_staged(const f32x16* o, const float* rli, char* stg, __amdgpu_buffer_rsrc_t ro_, int rowbytes, int so0_, int lane) {
    const int r32 = lane & 31, hi = lane >> 5, odd = lane & 1, g = odd | (hi << 1);
    char* wb = stg + (odd + 4 * hi) * 256 + (r32 >> 1) * 4;
    char* wa[4];
#pragma unroll
    for (int d0 = 0; d0 < 4; ++d0) wa[d0] = wb + ((d0 ^ g) << 6);
    const int lr = lane >> 4, ch = lane & 15, sp = ch >> 2, gl = lr & 1;
    const char* rb_e = stg + lr * 256 + ((sp ^ gl) << 6) + (lane & 3) * 16;
    const char* rb_o = stg + lr * 256 + ((sp ^ (gl | 2)) << 6) + (lane & 3) * 16;
    const int voff = lr * rowbytes + ch * 16;
#pragma unroll
    for (int h = 0; h < 2; ++h) {
#pragma unroll
        for (int rp = 0; rp < 4; ++rp) { const int r = 8 * h + 2 * rp, Rl = (r & 3) + 8 * ((r >> 2) & 1);
#pragma unroll
            for (int d0 = 0; d0 < 4; ++d0) { const float v0 = o[d0][r] * rli[r], v1 = o[d0][r + 1] * rli[r + 1];
                const float send = odd ? v0 : v1;
                const float recv = __int_as_float(__builtin_amdgcn_update_dpp(0, __float_as_int(send), 0xB1, 0xF, 0xF, true));
                *reinterpret_cast<unsigned*>(wa[d0] + Rl * 256) = cvtpk(odd ? recv : v0, odd ? v1 : recv); } }
        u32x4 d_[4];
#pragma unroll
        for (int i = 0; i < 4; ++i) d_[i] = *reinterpret_cast<const u32x4*>(((i & 1) ? rb_o : rb_e) + i * 1024);
#pragma unroll
        for (int i = 0; i < 4; ++i) __builtin_amdgcn_raw_buffer_store_b128(d_[i], ro_, voff + so0_ + (16 * h + 4 * i) * rowbytes, 0, 0);
    }
}
constexpr int DEFER_STG = 65536, DEFER_WS = 131072 + 512;
__device__ __forceinline__ void stage_write(const f32x16* o, const float* rli, char* stg, int lane) {
    const int r32 = lane & 31, hi = lane >> 5, odd = lane & 1, g = odd | (hi << 1);
    char* wb = stg + (odd + 4 * hi) * 256 + (r32 >> 1) * 4;
    char* wa[4];
#pragma unroll
    for (int d0 = 0; d0 < 4; ++d0) wa[d0] = wb + ((d0 ^ g) << 6);
#pragma unroll
    for (int h = 0; h < 2; ++h)
#pragma unroll
        for (int rp = 0; rp < 4; ++rp) { const int r = 8 * h + 2 * rp, Rl = (r & 3) + 8 * ((r >> 2) & 1);
#pragma unroll
            for (int d0 = 0; d0 < 4; ++d0) { const float v0 = o[d0][r] * rli[r], v1 = o[d0][r + 1] * rli[r + 1];
                const float send = odd ? v0 : v1;
                const float recv = __int_as_float(__builtin_amdgcn_update_dpp(0, __float_as_int(send), 0xB1, 0xF, 0xF, true));
                *reinterpret_cast<unsigned*>(wa[d0] + h * 4096 + Rl * 256) = cvtpk(odd ? recv : v0, odd ? v1 : recv); } }
}
__device__ __forceinline__ void flush_piece(const char* stg, int p, const char* obase, int rowbytes, int so0, int lane) {
    const int lr = lane >> 4, ch = lane & 15, sp = ch >> 2, g = (lr & 1) | ((p & 1) << 1);
    const u32x4 d = *reinterpret_cast<const u32x4*>(stg + p * 1024 + lr * 256 + ((sp ^ g) << 6) + (lane & 3) * 16);
    __builtin_amdgcn_raw_buffer_store_b128(d, A_RSRC(obase), lr * rowbytes + ch * 16 + so0 + 4 * p * rowbytes, 0, 0);
}
struct ConvCtx { const float* eg; const float* eu; const float* ed; unsigned char* w13; unsigned char* w2; int gw; };
constexpr int CONV_SCR = 86016, CONV_NJ = 48;
#ifndef CONV_AUX
#define CONV_AUX 2
#endif
struct ConvItem { const float* src; unsigned char* dst; int ldw, kd; };
__device__ __forceinline__ ConvItem conv_decode(const ConvCtx& X, int j) {
    const int q = X.gw + 2048 * j, e = q / 6144, r = q - e * 6144, m = r >> 11, r2 = r & 2047;
    ConvItem I;
    if (m < 2) { const int kb = r2 >> 6, nb = r2 & 63, n0 = nb * 16; I.ldw = 1024; I.kd = 2048;
        I.src = (m == 0 ? X.eg : X.eu) + (size_t)e * (2048 * 1024) + (size_t)kb * (64 * 1024) + n0;
        I.dst = X.w13 + (size_t)e * (2048 * 2048) + (size_t)((n0 >> 7) * 256 + (m == 1 ? 128 : 0) + (n0 & 127)) * 2048 + kb * 64; }
    else { const int kb = r2 >> 7, nb = r2 & 127; I.ldw = 2048; I.kd = 1024;
        I.src = X.ed + (size_t)e * (1024 * 2048) + (size_t)kb * (64 * 2048) + nb * 16;
        I.dst = X.w2 + (size_t)e * (2048 * 1024) + (size_t)(nb * 16) * 1024 + kb * 64; }
    return I;
}
__device__ __forceinline__ void conv_load(const ConvCtx& X, int j, int qd, float* cv, int lane) {
    const ConvItem I = conv_decode(X, j); const __amdgpu_buffer_rsrc_t rs = A_RSRC(I.src);
#pragma unroll
    for (int i = 0; i < 4; ++i) { const int k = 4 * (4 * qd + i) + (lane >> 4);
        cv[i] = __uint_as_float(__builtin_amdgcn_raw_buffer_load_b32(rs, (k * I.ldw + (lane & 15)) * 4, 0, CONV_AUX)); }
}
__device__ __forceinline__ void conv_put(const ConvCtx& X, int j, int qd, const float* cv, char* scr, int lane, bool finish_only = false) {
    float* s = reinterpret_cast<float*>(scr);
    if (!finish_only) {
#pragma unroll
    for (int i = 0; i < 4; ++i) { const int k = 4 * (4 * qd + i) + (lane >> 4); s[k * 17 + (lane & 15)] = cv[i] * 256.0f; } }
    if (qd == 3) {
        const ConvItem I = conv_decode(X, j); const int n = lane & 15, kq = lane >> 4; const float* c = s + (16 * kq) * 17 + n;
        u32x4 w;
        { int w0 = 0, w1 = 0, w2 = 0, w3 = 0;
          w0 = __builtin_amdgcn_cvt_pk_fp8_f32(c[0 * 17], c[1 * 17], w0, false); w0 = __builtin_amdgcn_cvt_pk_fp8_f32(c[2 * 17], c[3 * 17], w0, true);
          w1 = __builtin_amdgcn_cvt_pk_fp8_f32(c[4 * 17], c[5 * 17], w1, false); w1 = __builtin_amdgcn_cvt_pk_fp8_f32(c[6 * 17], c[7 * 17], w1, true);
          w2 = __builtin_amdgcn_cvt_pk_fp8_f32(c[8 * 17], c[9 * 17], w2, false); w2 = __builtin_amdgcn_cvt_pk_fp8_f32(c[10 * 17], c[11 * 17], w2, true);
          w3 = __builtin_amdgcn_cvt_pk_fp8_f32(c[12 * 17], c[13 * 17], w3, false); w3 = __builtin_amdgcn_cvt_pk_fp8_f32(c[14 * 17], c[15 * 17], w3, true);
          w = (u32x4){(unsigned)w0, (unsigned)w1, (unsigned)w2, (unsigned)w3}; }
        __builtin_amdgcn_raw_buffer_store_b128(w, A_RSRC(I.dst), n * I.kd + 16 * kq, 0, CONV_AUX);
    }
}
constexpr unsigned ROPE_OFF = 2u << 20;
#define A_RTLOAD(B_) do { const __amdgpu_buffer_rsrc_t rr_ = A_RSRC(wsb + ROPE_OFF); const int vo_ = ((B_).P0 + wid * QBLK + r32) * 256 + hi * 32; \
        _Pragma("unroll") for (int d_ = 0; d_ < 4; ++d_) { S.rt[2 * d_] = __builtin_bit_cast(f32x4, __builtin_amdgcn_raw_buffer_load_b128(rr_, vo_ + d_ * 64, 0, 0)); \
                                                            S.rt[2 * d_ + 1] = __builtin_bit_cast(f32x4, __builtin_amdgcn_raw_buffer_load_b128(rr_, vo_ + d_ * 64 + 16, 0, 0)); } } while (0)
__device__ __forceinline__ unsigned rope_pair(unsigned w, float c, float s) { const float x1 = __uint_as_float(w << 16), x2 = __uint_as_float(w & 0xffff0000u); return cvtpk(x1 * c - x2 * s, x2 * c + x1 * s); }
#define A_ROTATE() do { _Pragma("unroll") for (int d_ = 0; d_ < 4; ++d_) { u32x4 w_ = __builtin_bit_cast(u32x4, S.qr[8 + d_]); const f32x4 c01_ = S.rt[2 * d_], c23_ = S.rt[2 * d_ + 1]; \
        w_.x = rope_pair(w_.x, c01_[0], c01_[1]); w_.y = rope_pair(w_.y, c01_[2], c01_[3]); w_.z = rope_pair(w_.z, c23_[0], c23_[1]); w_.w = rope_pair(w_.w, c23_[2], c23_[3]); \
        S.qr[8 + d_] = __builtin_bit_cast(bf16x8, w_); } } while (0)
constexpr int CONV_SCR_DIL = 67584;
__device__ __forceinline__ void conv_load_full(const ConvCtx& X, int j, float* cv, int lane) {
    const ConvItem I = conv_decode(X, j); const __amdgpu_buffer_rsrc_t rs = A_RSRC(I.src);
#pragma unroll
    for (int i = 0; i < 16; ++i) { const int k = 4 * i + (lane >> 4); cv[i] = __uint_as_float(__builtin_amdgcn_raw_buffer_load_b32(rs, (k * I.ldw + (lane & 15)) * 4, 0, CONV_AUX)); }
}
__device__ __forceinline__ void conv_put_full(const ConvCtx& X, int j, const float* cv, char* scr, int lane) {
    float* s = reinterpret_cast<float*>(scr);
#pragma unroll
    for (int i = 0; i < 16; ++i) { const int k = 4 * i + (lane >> 4); s[k * 17 + (lane & 15)] = cv[i] * 256.0f; }
    float dummy_[4] = {0.f, 0.f, 0.f, 0.f};
    conv_put(X, j, 3, dummy_, scr, lane, true);
}
template <int DQK, bool DIL, int PVAR = 0, bool ROPE = false>
__device__ __forceinline__ void att_prime(const Blk& cur, const char* wsb, char* lds, Seam<DQK>& S, int tid_in) {
    typedef Cfg<DQK> C;
    int tid = tid_in; asm volatile("" : "+v"(tid));
    const int wid = __builtin_amdgcn_readfirstlane(tid >> 6), lane = tid & 63, r32 = lane & 31, hi = lane >> 5;
    A_STAGE_IDX(); char* K_lds = lds + 2 * SHM_V;
    const int kb0 = swa_jlo(cur.P0, W_(cur)) * KVBLK;
    A_QLOAD(cur);
    if constexpr (ROPE) A_RTLOAD(cur);
    A_SLOAD(cur, kb0); VMW(); A_SWRITE_K(0);
    __syncthreads();
}
template <int DQK, bool DIL, bool SK, int PVAR = 0, int CONV = 0, bool ROPE = false>
__device__ __forceinline__ void att_block(const Blk& cur, const Blk& nxt, const char* wsb, char* lds, Seam<DQK>& S, int tid_in, const ConvCtx* X = nullptr) {
    typedef Cfg<DQK> C;
    int tid = tid_in; asm volatile("" : "+v"(tid));
    const int wid = __builtin_amdgcn_readfirstlane(tid >> 6), lane = tid & 63, r32 = lane & 31, hi = lane >> 5;
    const int W = W_(cur); const float scale = SCALE_, beta = cur.beta;
    int j_lo = swa_jlo(cur.P0, W);
    int j_hi = (cur.P0 + QB - 1) / KVBLK + 1; if (j_hi > SKV_(cur) / KVBLK) j_hi = SKV_(cur) / KVBLK;
    if (PVAR & 8) j_lo = j_hi - 2;
    const int NT = j_hi - j_lo;
    const int kbn = swa_jlo(nxt.P0, W_(nxt)) * KVBLK;
    const int qlo = cur.P0 + wid * QBLK, qm = qlo + r32 - 4 * hi;
    char* V_lds = lds; char* K_lds = lds + 2 * SHM_V;
#ifdef ATT_DEFER
    constexpr bool DEFER = DIL;
#else
    constexpr bool DEFER = false;
#endif
    float* ws = (float*)(lds + (DEFER ? DEFER_WS : 2 * SHM_V + 2 * C::SHM_K)) + wid * 64; float* li_l = ws, * al_l = ws + 32;
    char* stg = lds + DEFER_STG + wid * 8192;
    float m_reg = -1e30f, l_reg = 0; f32x16 o[4] = {};
    A_STAGE_IDX();
    const int vst0 = v_st(sr, sc), vst1 = v_st(32 + sr, sc);
    const int vb0 = (int)(uintptr_t)V_lds + v_rd_base(lane);
#define RESC(a) do { if (__any((a) < 1.f)) { if (hi == 0) al_l[r32] = (a); asm volatile("s_waitcnt lgkmcnt(0)" ::: "memory");              \
                     _Pragma("unroll") for (int d_ = 0; d_ < 4; ++d_) _Pragma("unroll") for (int r = 0; r < 16; ++r) o[d_][r] *= al_l[crow(r, hi)]; } } while (0)
#define KBASE(t) ((j_lo + (t)) * KVBLK)
#define ACT(t) (KBASE(t) <= qlo + QBLK - 1 && KBASE(t) + KVBLK - 1 >= qlo - W + 1)
#define MASKT(P0_, P1_, t) do { const int kb_ = KBASE(t); if ((!SK || ACT(t)) && (kb_ + KVBLK - 1 > qlo || kb_ <= qlo + QBLK - 1 - W)) mask_tile(P0_, P1_, qm - kb_, (unsigned)W); } while (0)
    A_SWRITE_V(0);
    __syncthreads();
    if constexpr (ROPE) { VMW(); A_ROTATE(); }
#define STEP(t, BUF) do { const bool more_ = (t) + 1 < NT;                                                                        \
        if (more_) { A_SLOAD(cur, KBASE((t) + 1)); } else { A_SLOAD(nxt, kbn); }                                                   \
        const bool cpend_ = CONV == 1 && (S.cv_j != S.cl_j || S.cv_q != S.cl_q); const bool cld_ = CONV == 1 && more_ && S.cl_j < CONV_NJ;        \
        const bool act_ = !SK || ACT(t); const bool cidle_ = CONV == 2 && more_ && !act_ && (S.cv_j < CONV_NJ);                                \
        bool cnew_ = false;                                                                                                    \
        if (cidle_) { if (S.cv_pend) { VMWN(C::KCH + 2);        \
                          conv_put_full(*X, S.cv_j, S.cvf, lds + CONV_SCR_DIL + wid * 4352, lane); ++S.cv_j; S.cv_pend = 0; }                \
                      if (S.cv_j < CONV_NJ) { conv_load_full(*X, S.cv_j, S.cvf, lane); S.cv_pend = 1; cnew_ = true; } }                       \
        if (cld_) { conv_load(*X, S.cl_j, S.cl_q, BUF ? S.cw : S.cv, lane); if (++S.cl_q == 4) { S.cl_q = 0; ++S.cl_j; } }               \
        if (DEFER && S.p_on && (t) < 4) { flush_piece(stg, 2 * (t), wsb + S.p_oo, S.p_rb, S.p_so0, lane); flush_piece(stg, 2 * (t) + 1, wsb + S.p_oo, S.p_rb, S.p_so0, lane); } \
        SBAR();                                                                                                                 \
        if (act_) { f32x16 p0, p1; float mn_, al_; bf16x8 pa0, pa1, pa2, pa3;      \
            qkt<BUF, false, DQK, DIL>(p0, p1, K_lds, r32, hi, S.qr, true, beta, qm - KBASE(t)); SBAR();                              \
            MASKT(p0, p1, t); partialSM(p0, p1, m_reg, mn_, al_, scale); finishSM(p0, p1, al_, l_reg, pa0, pa1, pa2, pa3); RESC(al_); SBAR(); \
            pv_tile<BUF, false>(o, vb0, pa0, pa1, pa2, pa3, true); }                                                             \
        if (!more_) { SBAR(); A_QLOAD(nxt); SBAR(); }                                 \
        if (more_) { if (cnew_) VMWN(16); else if (cld_) VMWN(4); else VMW();            \
            A_SWRITE_V(1 - BUF); A_SWRITE_K(1 - BUF);                                                                              \
            if (cpend_) { conv_put(*X, S.cv_j, S.cv_q, BUF ? S.cv : S.cw, lds + CONV_SCR + wid * 4352, lane); if (++S.cv_q == 4) { S.cv_q = 0; ++S.cv_j; } } \
        }                                                                                                                       \
        A_STEPBAR(); } while (0)
    int t = 0;
    for (; t + 1 < NT; t += 2) { STEP(t, 0); STEP(t + 1, 1); }
    if (t < NT) { STEP(t, 0); }
    VMWN(C::NQF); A_SWRITE_K(0); SBAR();
    if (CONV == 1 && (S.cv_j != S.cl_j || S.cv_q != S.cl_q)) { conv_put(*X, S.cv_j, S.cv_q, S.cv, lds + CONV_SCR + wid * 4352, lane); if (++S.cv_q == 4) { S.cv_q = 0; ++S.cv_j; } }
    if (hi == 0) li_l[r32] = l_reg; asm volatile("s_waitcnt lgkmcnt(0)" ::: "memory");
    if constexpr (DIL) { if (hi == 0) __builtin_amdgcn_raw_buffer_store_b32(__float_as_uint(m_reg * scale + __logf(l_reg)), A_RSRC(wsb + cur.lo), r32 * LS_(cur) * 4, (cur.P0 + wid * QBLK) * LS_(cur) * 4, 0); }
    float rli[16];
#pragma unroll
    for (int r = 0; r < 16; ++r) rli[r] = __builtin_amdgcn_rcpf(li_l[crow(r, hi)]);
    if constexpr (DEFER) { stage_write(o, rli, stg, lane); S.p_oo = cur.oo; S.p_rb = OS_(cur) * 2; S.p_so0 = (cur.P0 + wid * QBLK) * OS_(cur) * 2; S.p_on = 1; }
    else {
#ifdef ATT_T21
    store_o_staged(o, rli, wid < 4 ? lds + SHM_V + wid * 4096 : lds + 2 * SHM_V + C::SHM_K + (wid - 4) * 4096, A_RSRC(wsb + cur.oo), OS_(cur) * 2, (cur.P0 + wid * QBLK) * OS_(cur) * 2, lane);
#else
    const int os_ = (PVAR & 1) ? 0 : OS_(cur);
    const __amdgpu_buffer_rsrc_t ro_ = A_RSRC(wsb + cur.oo); const int oo_ = (4 * hi * os_ + r32) * 2, so0_ = (cur.P0 + wid * QBLK) * os_ * 2;
#pragma unroll
    for (int r = 0; r < 16; ++r) { const int sor_ = so0_ + ((r & 3) + 8 * (r >> 2)) * os_ * 2;
#pragma unroll
        for (int d0 = 0; d0 < 4; ++d0) { const float v = o[d0][r] * rli[r];
            const float vn = __int_as_float(__builtin_amdgcn_update_dpp(0, __float_as_int(v), 0xB1, 0xF, 0xF, true));
            if ((r32 & 1) == 0) __builtin_amdgcn_raw_buffer_store_b32(cvtpk(v, vn), ro_, oo_ + d0 * 64, sor_, 0); } }
#endif
    }
    if constexpr (ROPE) A_RTLOAD(nxt);
#undef RESC
#undef KBASE
#undef ACT
#undef MASKT
#undef STEP
}

template <int DQK> struct SeamD { bf16x8 qr[Cfg<DQK>::NQF]; };
#define A_GLDS(voff, sbase, ldsdst) do { unsigned keep_; asm volatile("s_mov_b32 %0, m0\n\ts_mov_b32 m0, %2\n\ts_nop 0\n\tglobal_load_lds_dwordx4 %1, %3\n\ts_mov_b32 m0, %0" \
        : "=&s"(keep_) : "v"(voff), "s"((unsigned)__builtin_amdgcn_readfirstlane((int)(ldsdst))), "s"((const void*)(sbase)) : "memory"); } while (0)
#define A_DMA_IDX() int krow_[C::KCH], kcb_[C::KCH], vrow_[2], vcb_[2]; \
        _Pragma("unroll") for (int j_ = 0; j_ < C::KCH; ++j_) { const int p_ = (j_ * 8 + wid) * 1024 + lane * 16, row_ = p_ / C::KPITCH, pc_ = (p_ % C::KPITCH) / 16, lc_ = (pc_ & ~7) | ((pc_ & 7) ^ (row_ & 7)); \
            krow_[j_] = row_; kcb_[j_] = lc_ * 16; } \
        _Pragma("unroll") for (int j_ = 0; j_ < 2; ++j_) { const int p_ = (j_ * 8 + wid) * 1024 + lane * 16, s_ = p_ / 512, w_ = p_ % 512, kk_ = (s_ >> 2) * 8 + (w_ >> 6), col_ = (s_ & 3) * 32 + ((w_ & 63) >> 1); \
            vrow_[j_] = (kk_ & ~0xC) | ((kk_ & 4) << 1) | ((kk_ & 8) >> 1); vcb_[j_] = col_ * 2; }
#define A_DMA(B_, k0, sl_) do { const char* kb_ = wsb + (B_).ko + (size_t)(k0) * (size_t)(KS_(B_) * 2); const char* vb_ = wsb + (B_).vo + (size_t)(k0) * (size_t)(VS_(B_) * 2); \
        _Pragma("unroll") for (int j_ = 0; j_ < C::KCH; ++j_) A_GLDS((unsigned)(krow_[j_] * KS_(B_) * 2 + kcb_[j_]), kb_, lds0 + NS * SHM_V + (sl_) * C::SHM_K + (j_ * 8 + wid) * 1024); \
        _Pragma("unroll") for (int j_ = 0; j_ < 2; ++j_) A_GLDS((unsigned)(vrow_[j_] * VS_(B_) * 2 + vcb_[j_]), vb_, lds0 + (sl_) * SHM_V + (j_ * 8 + wid) * 1024); } while (0)
template <int DQK, bool DIL, int NS>
__device__ __forceinline__ void att_prime_dma(const Blk& cur, const char* wsb, char* lds, SeamD<DQK>& S, int tid_in) {
    typedef Cfg<DQK> C;
    int tid = tid_in; asm volatile("" : "+v"(tid));
    const int wid = __builtin_amdgcn_readfirstlane(tid >> 6), lane = tid & 63, r32 = lane & 31, hi = lane >> 5;
    const unsigned lds0 = (unsigned)(uintptr_t)lds;
    A_DMA_IDX();
    const int kb0 = swa_jlo(cur.P0, W_(cur)) * KVBLK;
    A_QLOAD(cur);
#pragma unroll
    for (int i_ = 0; i_ < NS - 1; ++i_) A_DMA(cur, kb0 + i_ * KVBLK, i_);
}
template <int DQK, bool DIL, bool SK, int NS>
__device__ __forceinline__ void att_block_dma(const Blk& cur, const Blk& nxt, const char* wsb, char* lds, char* wsl, SeamD<DQK>& S, int tid_in) {
    typedef Cfg<DQK> C;
    int tid = tid_in; asm volatile("" : "+v"(tid));
    const int wid = __builtin_amdgcn_readfirstlane(tid >> 6), lane = tid & 63, r32 = lane & 31, hi = lane >> 5;
    const int W = W_(cur); const float scale = SCALE_, beta = cur.beta;
    const int j_lo = swa_jlo(cur.P0, W);
    int j_hi = (cur.P0 + QB - 1) / KVBLK + 1; if (j_hi > SKV_(cur) / KVBLK) j_hi = SKV_(cur) / KVBLK;
    const int NT = j_hi - j_lo;
    const int kbn = swa_jlo(nxt.P0, W_(nxt)) * KVBLK;
    const int qlo = cur.P0 + wid * QBLK, qm = qlo + r32 - 4 * hi;
    const unsigned lds0 = (unsigned)(uintptr_t)lds;
    const char* K_lds = lds + NS * SHM_V;
    float* ws = (float*)wsl + wid * 64; float* li_l = ws, * al_l = ws + 32;
    float m_reg = -1e30f, l_reg = 0; f32x16 o[4] = {};
    A_DMA_IDX();
    const int vb0 = (int)lds0 + v_rd_base(lane);
    constexpr int NDMA = C::KCH + 2;
#define RESC(a) do { if (__any((a) < 1.f)) { if (hi == 0) al_l[r32] = (a); asm volatile("s_waitcnt lgkmcnt(0)" ::: "memory");              \
                     _Pragma("unroll") for (int d_ = 0; d_ < 4; ++d_) _Pragma("unroll") for (int r = 0; r < 16; ++r) o[d_][r] *= al_l[crow(r, hi)]; } } while (0)
#define KBASE(t) ((j_lo + (t)) * KVBLK)
#define ACT(t) (KBASE(t) <= qlo + QBLK - 1 && KBASE(t) + KVBLK - 1 >= qlo - W + 1)
#define MASKT(P0_, P1_, t) do { const int kb_ = KBASE(t); if ((!SK || ACT(t)) && (kb_ + KVBLK - 1 > qlo || kb_ <= qlo + QBLK - 1 - W)) mask_tile(P0_, P1_, qm - kb_, (unsigned)W); } while (0)
    VMW();
#pragma unroll
    for (int d0 = 0; d0 < C::NQF; ++d0) asm volatile("" : "+v"(S.qr[d0]));
    asm volatile("s_waitcnt lgkmcnt(0)" ::: "memory"); __builtin_amdgcn_s_barrier(); asm volatile("" ::: "memory");
    int sl = 0, sl2 = NS - 1;
#pragma unroll 1
    for (int t = 0; t < NT; ++t) {
        const bool pre = t + NS - 1 < NT;
        if (pre) A_DMA(cur, KBASE(t + NS - 1), sl2);
        SBAR(); f32x16 p0, p1; float mn_, al_; bf16x8 pa0, pa1, pa2, pa3;
        qkt<0, SK, DQK, DIL>(p0, p1, K_lds + sl * C::SHM_K, r32, hi, S.qr, ACT(t), beta, qm - KBASE(t)); SBAR();
        MASKT(p0, p1, t); partialSM(p0, p1, m_reg, mn_, al_, scale); finishSM(p0, p1, al_, l_reg, pa0, pa1, pa2, pa3); RESC(al_); SBAR();
        pv_tile<0, SK>(o, vb0 + sl * SHM_V, pa0, pa1, pa2, pa3, ACT(t));
        if (t + 1 < NT) { int infl = NT - 2 - t; if (infl > NS - 2) infl = NS - 2;
                          if (infl <= 0) VMW(); else if (infl == 1) VMWN(NDMA); else VMWN(2 * NDMA);
                          asm volatile("s_waitcnt lgkmcnt(0)" ::: "memory"); __builtin_amdgcn_s_barrier(); asm volatile("" ::: "memory"); }
        sl = sl == NS - 1 ? 0 : sl + 1; sl2 = sl2 == NS - 1 ? 0 : sl2 + 1;
    }
    asm volatile("s_waitcnt lgkmcnt(0)" ::: "memory"); __builtin_amdgcn_s_barrier(); asm volatile("" ::: "memory");
    A_QLOAD(nxt);
#pragma unroll
    for (int i_ = 0; i_ < NS - 1; ++i_) A_DMA(nxt, kbn + i_ * KVBLK, i_);
    if (hi == 0) li_l[r32] = l_reg; asm volatile("s_waitcnt lgkmcnt(0)" ::: "memory");
    if constexpr (DIL) { if (hi == 0) __builtin_amdgcn_raw_buffer_store_b32(__float_as_uint(m_reg * scale + __logf(l_reg)), A_RSRC(wsb + cur.lo), r32 * LS_(cur) * 4, (cur.P0 + wid * QBLK) * LS_(cur) * 4, 0); }
    float rli[16];
#pragma unroll
    for (int r = 0; r < 16; ++r) rli[r] = __builtin_amdgcn_rcpf(li_l[crow(r, hi)]);
    const __amdgpu_buffer_rsrc_t ro_ = A_RSRC(wsb + cur.oo); const int oo_ = (4 * hi * OS_(cur) + r32) * 2, so0_ = (cur.P0 + wid * QBLK) * OS_(cur) * 2;
#pragma unroll
    for (int r = 0; r < 16; ++r) { const int sor_ = so0_ + ((r & 3) + 8 * (r >> 2)) * OS_(cur) * 2;
#pragma unroll
        for (int d0 = 0; d0 < 4; ++d0) { const float v = o[d0][r] * rli[r];
            const float vn = __int_as_float(__builtin_amdgcn_update_dpp(0, __float_as_int(v), 0xB1, 0xF, 0xF, true));
            if ((r32 & 1) == 0) __builtin_amdgcn_raw_buffer_store_b32(cvtpk(v, vn), ro_, oo_ + d0 * 64, sor_, 0); } }
#undef RESC
#undef KBASE
#undef ACT
#undef MASKT
}

template <bool SK, int DQK, bool DIL>
__device__ __forceinline__ void qkt_fin(f32x16& p0, f32x16& p1, const char* K_lds, int r32, int hi, const bf16x8* qr, bool act, float beta, int dq,
                                        f32x16& y0, f32x16& y1, float alpha, float& l_reg, bf16x8& pa0, bf16x8& pa1, bf16x8& pa2, bf16x8& pa3) {
    typedef Cfg<DQK> C;
    const bool run = !(SK && !act);
    if (!run) { const float NEG = -__builtin_inff();
#pragma unroll
        for (int r = 0; r < 16; ++r) { p0[r] = NEG; p1[r] = NEG; } }
    else if constexpr (DIL) { const float b0 = -beta * (float)dq;
#pragma unroll
        for (int r = 0; r < 16; ++r) { const int c = (r & 3) + 8 * (r >> 2); p0[r] = fmaf(beta, (float)c, b0); p1[r] = fmaf(beta, (float)(c + 32), b0); } }
    else { p0 = f32x16{}; p1 = f32x16{}; }
    const char* kb[4];
#pragma unroll
    for (int dd = 0; dd < 4; ++dd) { const int colB = (dd * 16 + hi * 8) * 2; kb[dd] = K_lds + r32 * C::KPITCH + (colB ^ ((r32 & 7) << 4)); }
#define QK_CHUNK(c_) do { if (run) { _Pragma("unroll") for (int d0 = 4 * (c_); d0 < 4 * (c_) + 4 && d0 < C::NQF; ++d0) { const char* a = kb[d0 & 3] + (d0 >> 2) * 128; \
            bf16x8 b0 = *reinterpret_cast<const bf16x8*>(a); bf16x8 b1 = *reinterpret_cast<const bf16x8*>(a + 32 * C::KPITCH);                                  \
            p0 = __builtin_amdgcn_mfma_f32_32x32x16_bf16(b0, qr[d0], p0, 0, 0, 0); p1 = __builtin_amdgcn_mfma_f32_32x32x16_bf16(b1, qr[d0], p1, 0, 0, 0); } } } while (0)
#define PK4(P, B_, OUT) do { unsigned a0 = cvtpk(P[B_+0], P[B_+1]), a1 = cvtpk(P[B_+2], P[B_+3]);                          \
        unsigned b0 = cvtpk(P[B_+4], P[B_+5]), b1 = cvtpk(P[B_+6], P[B_+7]);                                             \
        auto r0 = __builtin_amdgcn_permlane32_swap(a0, b0, false, false); auto r1 = __builtin_amdgcn_permlane32_swap(a1, b1, false, false); \
        u32x4 w = {r0[0], r1[0], r0[1], r1[1]}; OUT = *reinterpret_cast<bf16x8*>(&w); } while (0)
    QK_CHUNK(0);
#pragma unroll
    for (int r = 0; r < 16; ++r) y1[r] = __builtin_amdgcn_exp2f(y1[r]);
    float ps = 0;
#pragma unroll
    for (int r = 0; r < 16; ++r) ps += y0[r];
#pragma unroll
    for (int r = 0; r < 16; ++r) ps += y1[r];
    SBAR();
    QK_CHUNK(1);
    { auto rr = __builtin_amdgcn_permlane32_swap(__float_as_uint(ps), __float_as_uint(ps), false, false);
      ps = __uint_as_float(rr[0]) + __uint_as_float(rr[1]); }
    l_reg = l_reg * alpha + ps;
    PK4(y0, 0, pa0); PK4(y0, 8, pa1);
    if constexpr (C::NQF > 8) { SBAR(); QK_CHUNK(2); }
    PK4(y1, 0, pa2); PK4(y1, 8, pa3);
#undef PK4
#undef QK_CHUNK
}
#ifndef ATT_SKEW_SEL
#define ATT_SKEW_SEL 0
#endif
#if ATT_SKEW_SEL == 0
#define ATT_SKEW_A (wid < 4)
#elif ATT_SKEW_SEL == 1
#define ATT_SKEW_A ((wid & 1) == 0)
#elif ATT_SKEW_SEL == 2
#define ATT_SKEW_A true
#else
#define ATT_SKEW_A false
#endif
#define A_DMA_K(B_, k0, sl_) do { const char* kb_ = wsb + (B_).ko + (size_t)(k0) * (size_t)(KS_(B_) * 2); int ln_ = lane; asm volatile("" : "+v"(ln_)); \
        _Pragma("unroll") for (int j_ = 0; j_ < C::KCH; ++j_) { const int p_ = (j_ * 8 + wid) * 1024 + ln_ * 16, row_ = p_ / C::KPITCH, pc_ = (p_ % C::KPITCH) / 16, lc_ = (pc_ & ~7) | ((pc_ & 7) ^ (row_ & 7)); \
            A_GLDS((unsigned)(row_ * KS_(B_) * 2 + lc_ * 16), kb_, lds0 + 3 * SHM_V + (sl_) * C::SHM_K + (j_ * 8 + wid) * 1024); } } while (0)
#define A_DMA_V(B_, k0, sl_) do { const char* vb_ = wsb + (B_).vo + (size_t)(k0) * (size_t)(VS_(B_) * 2); int ln_ = lane; asm volatile("" : "+v"(ln_)); \
        _Pragma("unroll") for (int j_ = 0; j_ < 2; ++j_) { const int p_ = (j_ * 8 + wid) * 1024 + ln_ * 16, s_ = p_ / 512, w_ = p_ % 512, kk_ = (s_ >> 2) * 8 + (w_ >> 6), col_ = (s_ & 3) * 32 + ((w_ & 63) >> 1); \
            const int vr_ = (kk_ & ~0xC) | ((kk_ & 4) << 1) | ((kk_ & 8) >> 1); \
            A_GLDS((unsigned)(vr_ * VS_(B_) * 2 + col_ * 2), vb_, lds0 + (sl_) * SHM_V + (j_ * 8 + wid) * 1024); } } while (0)
#define A_RAWBAR() do { asm volatile("s_waitcnt lgkmcnt(0)" ::: "memory"); __builtin_amdgcn_s_barrier(); asm volatile("" ::: "memory"); } while (0)
template <int DQK, bool DIL>
__device__ __forceinline__ void att_prime_dma2(const Blk& cur, const char* wsb, char* lds, SeamD<DQK>& S, int tid_in) {
    typedef Cfg<DQK> C; constexpr int NS = 3;
    int tid = tid_in; asm volatile("" : "+v"(tid));
    const int wid = __builtin_amdgcn_readfirstlane(tid >> 6), lane = tid & 63, r32 = lane & 31, hi = lane >> 5;
    const unsigned lds0 = (unsigned)(uintptr_t)lds;
    const int kb0 = swa_jlo(cur.P0, W_(cur)) * KVBLK;
    A_QLOAD(cur);
    A_DMA_K(cur, kb0, 0); A_DMA_V(cur, kb0, 0); A_DMA_K(cur, kb0 + KVBLK, 1);
}
template <int DQK, bool DIL, bool SK, int ORD>
__device__ __forceinline__ void att_block_dma2(const Blk& cur, const Blk& nxt, const char* wsb, char* lds, SeamD<DQK>& S, int tid_in) {
    typedef Cfg<DQK> C; constexpr int NS = 3;
    int tid = tid_in; asm volatile("" : "+v"(tid));
    const int wid = __builtin_amdgcn_readfirstlane(tid >> 6), lane = tid & 63, r32 = lane & 31, hi = lane >> 5;
    const int W = W_(cur); const float scale = SCALE_, beta = cur.beta;
    const int j_lo = swa_jlo(cur.P0, W);
    int j_hi = (cur.P0 + QB - 1) / KVBLK + 1; if (j_hi > SKV_(cur) / KVBLK) j_hi = SKV_(cur) / KVBLK;
    const int NT = j_hi - j_lo;
    const int kbn = swa_jlo(nxt.P0, W_(nxt)) * KVBLK;
    const int qlo = cur.P0 + wid * QBLK, qm = qlo + r32 - 4 * hi;
    const unsigned lds0 = (unsigned)(uintptr_t)lds;
    const char* K_lds = lds + 3 * SHM_V;
    float* ws = (float*)(lds + 3 * SHM_V + 3 * C::SHM_K) + wid * 64; float* li_l = ws, * al_l = ws + 32;
    float m_reg = -1e30f, l_reg = 0; f32x16 o[4] = {};
    const int vb0 = (int)lds0 + v_rd_base(lane);
#define RESC(a) do { if (__any((a) < 1.f)) { if (hi == 0) al_l[r32] = (a); asm volatile("s_waitcnt lgkmcnt(0)" ::: "memory");              \
                     _Pragma("unroll") for (int d_ = 0; d_ < 4; ++d_) _Pragma("unroll") for (int r = 0; r < 16; ++r) o[d_][r] *= al_l[crow(r, hi)]; } } while (0)
#define KBASE(t) ((j_lo + (t)) * KVBLK)
#define ACT(t) (KBASE(t) <= qlo + QBLK - 1 && KBASE(t) + KVBLK - 1 >= qlo - W + 1)
#define MASKT(P0_, P1_, t) do { const int kb_ = KBASE(t); if ((!SK || ACT(t)) && (kb_ + KVBLK - 1 > qlo || kb_ <= qlo + QBLK - 1 - W)) mask_tile(P0_, P1_, qm - kb_, (unsigned)W); } while (0)
#define ISSUE(t, n_) do { n_ = 0; if ((t) + 2 < NT) { int slotk_ = sl + 2; if (slotk_ >= 3) slotk_ -= 3; A_DMA_K(cur, KBASE((t) + 2), slotk_); n_ += C::KCH; } \
                          if ((t) + 1 < NT) { int slotv_ = sl + 1; if (slotv_ >= 3) slotv_ -= 3; A_DMA_V(cur, KBASE((t) + 1), slotv_); n_ += 2; } } while (0)
#define CLOSE(n_) do { if ((n_) == C::KCH + 2) VMWN(C::KCH + 2); else if ((n_) == 2) VMWN(2); else VMW(); A_RAWBAR(); } while (0)
    VMW();
#pragma unroll
    for (int d0 = 0; d0 < C::NQF; ++d0) asm volatile("" : "+v"(S.qr[d0]));
    A_RAWBAR();
    int sl = 0, slp = 2, nis;
    f32x16 pA0, pA1, pB0, pB1; float mnA, mnB, alA, alB; bf16x8 pa0, pa1, pa2, pa3;
    ISSUE(0, nis); SBAR();
    qkt<0, SK, DQK, DIL>(pA0, pA1, K_lds + sl * C::SHM_K, r32, hi, S.qr, ACT(0), beta, qm - KBASE(0)); SBAR();
    MASKT(pA0, pA1, 0); partialSM(pA0, pA1, m_reg, mnA, alA, scale);
    CLOSE(nis); slp = sl; sl = sl == 2 ? 0 : sl + 1;
#define STEPP(PX0, PX1, mnX, alX, PY0, PY1, alY, t) do { ISSUE(t, nis); SBAR();                                               \
        if constexpr (ORD == 0) {                                                                                               \
            qkt<0, SK, DQK, DIL>(PX0, PX1, K_lds + sl * C::SHM_K, r32, hi, S.qr, ACT(t), beta, qm - KBASE(t)); SBAR();           \
            finishSM(PY0, PY1, alY, l_reg, pa0, pa1, pa2, pa3); SBAR();                                                         \
            pv_tile<0, SK>(o, vb0 + slp * SHM_V, pa0, pa1, pa2, pa3, ACT((t) - 1)); SBAR();                                     \
        } else {                                                                                                                \
            finishSM(PY0, PY1, alY, l_reg, pa0, pa1, pa2, pa3); SBAR();                                                         \
            pv_tile<0, SK>(o, vb0 + slp * SHM_V, pa0, pa1, pa2, pa3, ACT((t) - 1)); SBAR();                                     \
            qkt<0, SK, DQK, DIL>(PX0, PX1, K_lds + sl * C::SHM_K, r32, hi, S.qr, ACT(t), beta, qm - KBASE(t)); SBAR();           \
        }                                                                                                                       \
        MASKT(PX0, PX1, (t)); partialSM(PX0, PX1, m_reg, mnX, alX, scale);                                                     \
        RESC(alX); CLOSE(nis); slp = sl; sl = sl == 2 ? 0 : sl + 1; } while (0)
    int t = 1;
#pragma unroll 1
    for (; t + 2 < NT; t += 2) {
        STEPP(pB0, pB1, mnB, alB, pA0, pA1, alA, t);
        STEPP(pA0, pA1, mnA, alA, pB0, pB1, alB, t + 1);
    }
    STEPP(pB0, pB1, mnB, alB, pA0, pA1, alA, t);
    finishSM(pB0, pB1, alB, l_reg, pa0, pa1, pa2, pa3); SBAR();
    pv_tile<0, SK>(o, vb0 + slp * SHM_V, pa0, pa1, pa2, pa3, ACT(NT - 1));
    A_RAWBAR();
    A_QLOAD(nxt);
    A_DMA_K(nxt, kbn, 0); A_DMA_V(nxt, kbn, 0); A_DMA_K(nxt, kbn + KVBLK, 1);
    if (hi == 0) li_l[r32] = l_reg; asm volatile("s_waitcnt lgkmcnt(0)" ::: "memory");
    if constexpr (DIL) { if (hi == 0) __builtin_amdgcn_raw_buffer_store_b32(__float_as_uint(m_reg * scale + __logf(l_reg)), A_RSRC(wsb + cur.lo), r32 * LS_(cur) * 4, (cur.P0 + wid * QBLK) * LS_(cur) * 4, 0); }
    float rli[16];
#pragma unroll
    for (int r = 0; r < 16; ++r) rli[r] = __builtin_amdgcn_rcpf(li_l[crow(r, hi)]);
    const __amdgpu_buffer_rsrc_t ro_ = A_RSRC(wsb + cur.oo); const int oo_ = (4 * hi * OS_(cur) + r32) * 2, so0_ = (cur.P0 + wid * QBLK) * OS_(cur) * 2;
#pragma unroll
    for (int r = 0; r < 16; ++r) { const int sor_ = so0_ + ((r & 3) + 8 * (r >> 2)) * OS_(cur) * 2;
#pragma unroll
        for (int d0 = 0; d0 < 4; ++d0) { const float v = o[d0][r] * rli[r];
            const float vn = __int_as_float(__builtin_amdgcn_update_dpp(0, __float_as_int(v), 0xB1, 0xF, 0xF, true));
            if ((r32 & 1) == 0) __builtin_amdgcn_raw_buffer_store_b32(cvtpk(v, vn), ro_, oo_ + d0 * 64, sor_, 0); } }
#undef RESC
#undef KBASE
#undef ACT
#undef MASKT
#undef ISSUE
#undef CLOSE
#undef STEPP
}
#undef A_DMA_K
#undef A_DMA_V
#undef A_RAWBAR
#undef A_GLDS
#undef A_DMA_IDX
#undef A_DMA
#undef VMW
#undef VMWN
#undef A_SLOAD
#undef A_RSRC
#undef A_BLD
#undef A_QLOAD
#undef A_SWRITE_K
#undef A_SWRITE_V
#undef A_STAGE_IDX
#undef SBAR
#undef QS_
#undef KS_
#undef VS_
#undef OS_
#undef LS_
#undef SKV_
#undef W_
#undef SCALE_
}
constexpr int NWAVES = 8;
constexpr int T = 32768, DM = 2048, SEQ = 8192, NB = 4, DEPTH = 2;
constexpr int IN_COLS = 3904, PROJ_LD = 4096, NEXP = 16, DEXP = 1024;
constexpr int C_QB = 0, C_KB = 1024, C_VB = 2048, C_CQ = 3072, C_CKV = 3584, C_KR = 3840;
constexpr float EPS = 1e-6f;
constexpr size_t MiB = 1u << 20;
constexpr size_t WS_CTL = 0, CTL_ZERO_BYTES = 1 * MiB;
constexpr size_t WS_MOD = 1 * MiB;
constexpr size_t WS_ROPE = 2 * MiB;
constexpr size_t WS_RSTDQ = 4 * MiB, WS_RSTDKV = 4 * MiB + 256 * 1024, WS_AW = 4 * MiB + 512 * 1024;
constexpr size_t WS_ROWIDX = 5 * MiB;
constexpr size_t WS_LSE = 8 * MiB;
constexpr size_t WS_WIN = 16 * MiB;
constexpr size_t WS_WUQ = 48 * MiB;
constexpr size_t WS_WUKV = 51 * MiB;
constexpr size_t WS_WOUT = 53 * MiB;
constexpr size_t WS_W13 = 72 * MiB;
constexpr size_t WS_W2 = 200 * MiB;
constexpr size_t WS_H = 264 * MiB;
constexpr size_t WS_PROJ = 392 * MiB;
constexpr size_t WS_QA = 648 * MiB;
constexpr size_t WS_KF = 744 * MiB;
constexpr size_t WS_VB = 840 * MiB;
constexpr size_t WS_OA = 904 * MiB;
constexpr size_t WS_OB = 968 * MiB;
constexpr size_t WS_XB = 1160 * MiB;
constexpr size_t WS_END = 1288 * MiB;
constexpr size_t WS_HMID = WS_PROJ;
constexpr size_t WS_Y = WS_QA;
constexpr int CW_TMO = 0;
constexpr int CW_CNT = 64;
constexpr int CW_BAR = 4096;
constexpr int RING_BYTES = 131072;
constexpr int L_MISC = RING_BYTES, L_TS = RING_BYTES + 256, L_CNT = RING_BYTES + 384, L_TOK = RING_BYTES + 512, L_ATAB = RING_BYTES + 2560;
constexpr int MAXU = 10;
constexpr int LDS_BYTES = 147456;
static_assert(L_ATAB + MAXU * 1024 <= LDS_BYTES, "LDS map");

#define GAS __attribute__((address_space(1)))
#define LAS __attribute__((address_space(3)))
typedef unsigned short bf16;
typedef unsigned v4u __attribute__((ext_vector_type(4)));
typedef unsigned v2u __attribute__((ext_vector_type(2)));
typedef float f32x4 __attribute__((ext_vector_type(4)));
typedef float f32x2 __attribute__((ext_vector_type(2)));
#define LDS_WAIT() asm volatile("s_waitcnt lgkmcnt(0)" ::: "memory")
#define VM_WAIT() asm volatile("s_waitcnt vmcnt(0)" ::: "memory")
__device__ __forceinline__ unsigned pk2(float lo, float hi) { return pg8::cvt_pk_bf16(lo, hi); }
__device__ __forceinline__ float bf_lo(unsigned w) { return __uint_as_float(w << 16); }
__device__ __forceinline__ float bf_hi(unsigned w) { return __uint_as_float(w & 0xffff0000u); }


typedef __amdgpu_buffer_rsrc_t rsrc_t;
#define RSRC(p) __builtin_amdgcn_make_buffer_rsrc((void*)(p), 0, 0x7fffffff, 0x00020000)
__device__ __forceinline__ f32x4 bld4f(rsrc_t r, int vo, int so) { return __builtin_bit_cast(f32x4, __builtin_amdgcn_raw_buffer_load_b128(r, vo, so, 0)); }
__device__ __forceinline__ v4u bld4u(rsrc_t r, int vo, int so) { return __builtin_bit_cast(v4u, __builtin_amdgcn_raw_buffer_load_b128(r, vo, so, 0)); }
__device__ __forceinline__ v2u bld2u(rsrc_t r, int vo, int so) { return __builtin_bit_cast(v2u, __builtin_amdgcn_raw_buffer_load_b64(r, vo, so, 0)); }
__device__ __forceinline__ void bst2u(rsrc_t r, int vo, int so, v2u v) { __builtin_amdgcn_raw_buffer_store_b64(v, r, vo, so, 0); }
__device__ __forceinline__ void bst4u(rsrc_t r, int vo, int so, v4u v) { __builtin_amdgcn_raw_buffer_store_b128(v, r, vo, so, 0); }
__device__ __forceinline__ void bst4f(rsrc_t r, int vo, int so, f32x4 v) { __builtin_amdgcn_raw_buffer_store_b128(__builtin_bit_cast(v4u, v), r, vo, so, 0); }

#define XB_TMO      128
#define XB_XCNT(j)  (256  + 64 * (j))
#define XB_XSUB(j)  (1280 + 64 * (j))
#define XB_XGEN(j)  (2304 + 64 * (j))
#define XB_TOP      3328
#define XB_TOPGEN   3392
#define XCD_BAR_WORDS 3456
#define XB_SPIN_CAP (1u << 18)
__device__ __forceinline__ unsigned xb_ld(unsigned* p)              { return __hip_atomic_load(p, __ATOMIC_RELAXED, __HIP_MEMORY_SCOPE_AGENT); }
__device__ __forceinline__ unsigned xb_add(unsigned* p, unsigned v) { return __hip_atomic_fetch_add(p, v, __ATOMIC_RELAXED, __HIP_MEMORY_SCOPE_AGENT); }
__device__ __forceinline__ unsigned xb_xcc_id() { return (unsigned)__builtin_amdgcn_s_getreg((3 << 11) | 20) & 0xFu; }
#define XB_SPIN(cond, bar) do { unsigned _sp = 0; while (cond) { __builtin_amdgcn_s_sleep(1); \
    if ((++_sp & 255u) == 0u) { if (xb_ld(&(bar)[XB_TMO])) break; if (_sp > XB_SPIN_CAP) { atomicAdd(&(bar)[XB_TMO], 1u); break; } } } } while (0)
struct XcdBarrier { unsigned* bar; unsigned x; volatile LAS unsigned* st; };
__device__ __forceinline__ XcdBarrier xcd_barrier_post(unsigned* bar, volatile LAS unsigned* st, int tid) {
    XcdBarrier b; b.bar = bar; b.x = xb_xcc_id(); b.st = st;
    if (tid == 0) (void)xb_add(&bar[XB_XCNT(b.x)], 1u);
    return b;
}
__device__ __forceinline__ void xcd_barrier_complete(unsigned* bar, unsigned x, unsigned& nloc, unsigned& nx) {
    const unsigned G = gridDim.x * gridDim.y * gridDim.z;
    unsigned sum, cnt, mine, sp = 0u;
    for (;;) {
        sum = 0u; cnt = 0u; mine = 0u;
#pragma unroll
        for (unsigned j = 0; j < 16; ++j) { const unsigned c = xb_ld(&bar[XB_XCNT(j)]); sum += c; cnt += (c > 0u) ? 1u : 0u; mine = (j == x) ? c : mine; }
        if (sum == G) break;
        __builtin_amdgcn_s_sleep(1);
        if ((++sp & 255u) == 0u) { if (xb_ld(&bar[XB_TMO])) break; if (sp > XB_SPIN_CAP) { atomicAdd(&bar[XB_TMO], 1u); break; } }
    }
    nloc = mine > 0u ? mine : 1u; nx = cnt > 0u ? cnt : 1u;
}
__device__ __forceinline__ void xcd_barrier(const XcdBarrier& b, int tid) {
    asm volatile("s_waitcnt vmcnt(0)" ::: "memory");
    __syncthreads();
    if (tid == 0) {
        unsigned* bar = b.bar; asm volatile("" : "+s"(bar));
        __builtin_amdgcn_s_waitcnt(0);
        unsigned nloc = b.st[0], nx = b.st[1];
        if (nloc == 0u) { xcd_barrier_complete(bar, b.x, nloc, nx); b.st[0] = nloc; b.st[1] = nx; }
        const unsigned old = xb_add(&bar[XB_XSUB(b.x)], 1u);
        const unsigned gen = old / nloc;
        if (old + 1u == (gen + 1u) * nloc) {
            __builtin_amdgcn_fence(__ATOMIC_RELEASE, "agent");
            asm volatile("s_waitcnt vmcnt(0)" ::: "memory");
            const unsigned og = xb_add(&bar[XB_TOP], 1u);
            const unsigned tg = og / nx;
            if (og + 1u == (tg + 1u) * nx) xb_add(&bar[XB_TOPGEN], 1u);
            else XB_SPIN(xb_ld(&bar[XB_TOPGEN]) == tg, bar);
            __builtin_amdgcn_fence(__ATOMIC_ACQUIRE, "agent");
            xb_add(&bar[XB_XGEN(b.x)], 1u);
            asm volatile("s_waitcnt vmcnt(0)" ::: "memory");
        } else {
            XB_SPIN(xb_ld(&bar[XB_XGEN(b.x)]) == gen, bar);
            __builtin_amdgcn_fence(__ATOMIC_ACQUIRE, "agent");
            asm volatile("s_waitcnt vmcnt(0)" ::: "memory");
        }
    }
    __syncthreads();
}

struct Args {
    const float* in[20]; float* out; unsigned char* ws;
    float invf[32];
    int ph_lo, ph_hi, li, pad;
};
enum { I_X = 0, I_C, I_ADAW, I_ADAB, I_N1G, I_N2G, I_WIN, I_QNG, I_KVNG, I_WUQ, I_WUKV, I_ONA, I_ONB, I_WOUT, I_RW, I_RB, I_EG, I_EU, I_ED, I_FG };

struct Frame {
    LAS unsigned char* lds; unsigned char* ldsg;
    unsigned* ctl; unsigned char* ws;
    int tid, lane, wave, vcu, G;
};
__device__ __forceinline__ int lane_id() { int l; asm volatile("v_mbcnt_lo_u32_b32 %0, -1, 0\n\tv_mbcnt_hi_u32_b32 %0, -1, %0" : "=v"(l)); return l; }
#define DPP_ADD(v, ctrl) v += __int_as_float(__builtin_amdgcn_update_dpp(0, __float_as_int(v), ctrl, 0xF, 0xF, true))
__device__ __forceinline__ float wave_sum(float v) {
    DPP_ADD(v, 0xB1); DPP_ADD(v, 0x4E); DPP_ADD(v, 0x141); DPP_ADD(v, 0x140);
    v += __int_as_float(__builtin_amdgcn_ds_swizzle(__float_as_int(v), 0x401F));
    auto rr = __builtin_amdgcn_permlane32_swap(__float_as_uint(v), __float_as_uint(v), false, false);
    return __uint_as_float(rr[0]) + __uint_as_float(rr[1]);
}
__device__ __forceinline__ int il64(int j) { return j < 32 ? 2 * j : 2 * (j - 32) + 1; }
template <int MODE> __device__ __forceinline__ int dest_row(int n) {
    if constexpr (MODE == 0) return n;
    else if constexpr (MODE == 1) {
        if (n < 512) return C_CQ + n; if (n < 768) return C_CKV + (n - 512); if (n < 832) return C_KR + il64(n - 768);
        if (n < 1856) return C_QB + (n - 832); if (n < 2880) return C_KB + (n - 1856); return C_VB + (n - 2880); }
    else if constexpr (MODE == 2) { const int h = n / 192, j = n % 192; return j < 128 ? n : h * 192 + 128 + il64(j - 128); }
    else if constexpr (MODE == 3) return (n >> 7) * 256 + (n & 127);
    else return (n >> 7) * 256 + 128 + (n & 127);
}
template <int MODE>
__device__ __forceinline__ void transpose_item(const float* W, int ldw, int K, int N, bf16* WT, const float* kscale, LAS float* scr, int item, int lane) {
    const int nblk = N / 32, kb = item / nblk, nb = item % nblk, k0 = 64 * kb, n0 = 32 * nb;
    float tv[32];
#pragma unroll
    for (int i = 0; i < 32; ++i) { const int kk = 2 * i + (lane >> 5); tv[i] = W[(size_t)(k0 + kk) * ldw + n0 + (lane & 31)]; }
#pragma unroll
    for (int i = 0; i < 32; ++i) { const int kk = 2 * i + (lane >> 5); float v = tv[i]; if (kscale) v *= kscale[k0 + kk]; scr[kk * 33 + (lane & 31)] = v; }
    LDS_WAIT(); asm volatile("" ::: "memory");
    const int c = lane & 7;
#pragma unroll
    for (int j = 0; j < 4; ++j) { const int n = (lane >> 3) + 8 * j; const LAS float* s = scr + (8 * c) * 33 + n;
        v4u o; o.x = pk2(s[0 * 33], s[1 * 33]); o.y = pk2(s[2 * 33], s[3 * 33]); o.z = pk2(s[4 * 33], s[5 * 33]); o.w = pk2(s[6 * 33], s[7 * 33]);
        *(v4u*)(WT + (size_t)dest_row<MODE>(n0 + n) * K + k0 + 8 * c) = o; }
    LDS_WAIT(); asm volatile("s_waitcnt vmcnt(0)" ::: "memory");
}

__device__ __forceinline__ unsigned pk4_fp8(float a, float b, float c, float d) { int w = 0; w = __builtin_amdgcn_cvt_pk_fp8_f32(a, b, w, false); w = __builtin_amdgcn_cvt_pk_fp8_f32(c, d, w, true); return (unsigned)w; }
template <int MODE>
__device__ __forceinline__ void transpose_item8(const float* W, int ldw, int K, int N, unsigned char* WT, LAS float* scr, int item, int lane) {
    const int nblk = N / 32, kb = item / nblk, nb = item % nblk, k0 = 64 * kb, n0 = 32 * nb;
    float tv[32];
#pragma unroll
    for (int i = 0; i < 32; ++i) { const int kk = 2 * i + (lane >> 5); tv[i] = W[(size_t)(k0 + kk) * ldw + n0 + (lane & 31)]; }
#pragma unroll
    for (int i = 0; i < 32; ++i) { const int kk = 2 * i + (lane >> 5); scr[kk * 33 + (lane & 31)] = tv[i] * 256.0f; }
    LDS_WAIT(); asm volatile("" ::: "memory");
    const int c = lane & 7;
#pragma unroll
    for (int j = 0; j < 4; ++j) { const int n = (lane >> 3) + 8 * j; const LAS float* s = scr + (8 * c) * 33 + n;
        v2u o; o.x = pk4_fp8(s[0 * 33], s[1 * 33], s[2 * 33], s[3 * 33]); o.y = pk4_fp8(s[4 * 33], s[5 * 33], s[6 * 33], s[7 * 33]);
        *(v2u*)(WT + (size_t)dest_row<MODE>(n0 + n) * K + k0 + 8 * c) = o; }
    LDS_WAIT(); asm volatile("s_waitcnt vmcnt(0)" ::: "memory");
}

__device__ __forceinline__ void phase_prologue(Frame& F, const Args& A) {
    {
        const float* cc = A.in[I_C]; float* mod = (float*)(F.ws + WS_MOD);
        LAS float* red = (LAS float*)F.lds;
        for (int id = F.vcu; id < 2 * 96; id += F.G) {
            const int l = id / 96, ch = id % 96, cg = F.tid & 31, kg = F.tid >> 5, col = ch * 128 + cg * 4;
            const float* w = A.in[I_ADAW] + (size_t)l * DM * 12288 + col;
            f32x4 acc[4] = {};
#pragma unroll 4
            for (int kk = 0; kk < 128; ++kk) { const int k = kg * 128 + kk; const f32x4 wv = *(const f32x4*)(w + (size_t)k * 12288);
#pragma unroll
                for (int b = 0; b < 4; ++b) { const float cv = cc[b * DM + k]; const float ca = cv / (1.0f + __expf(-cv)); acc[b] += wv * ca; } }
#pragma unroll
            for (int b = 0; b < 4; ++b) *(LAS f32x4*)(red + ((kg * 32 + cg) * 16 + b * 4)) = acc[b];
            __syncthreads();
            if (F.tid < 128) { const int cg2 = F.tid & 31, b = F.tid >> 5; f32x4 s = {0.f, 0.f, 0.f, 0.f};
#pragma unroll
                for (int g = 0; g < 16; ++g) s += *(LAS f32x4*)(red + ((g * 32 + cg2) * 16 + b * 4));
                const int c2 = ch * 128 + cg2 * 4; const f32x4 bv = *(const f32x4*)(A.in[I_ADAB] + (size_t)l * 12288 + c2);
                *(f32x4*)(mod + ((size_t)l * 4 + b) * 12288 + c2) = s + bv; }
            asm volatile("s_waitcnt vmcnt(0)" ::: "memory");
            __syncthreads();
        }
    }
    {
        LAS float* scr = (LAS float*)(F.lds + F.wave * 16384);
        const int gw = F.vcu * NWAVES + F.wave, NGW = F.G * NWAVES;
        constexpr int I_IN = (DM / 64) * (IN_COLS / 32), I_UQ = (512 / 64) * (1536 / 32), I_UKV = (256 / 64) * (2048 / 32), I_OUT = (DM / 64) * (DM / 32), I_L = I_IN + I_UQ + I_UKV + I_OUT;
        for (int it = gw; it < 2 * I_L; it += NGW) {
            const int l = it / I_L; int r = it % I_L;
            if (r < I_IN) { transpose_item<1>(A.in[I_WIN] + (size_t)l * DM * IN_COLS, IN_COLS, DM, IN_COLS, (bf16*)(F.ws + WS_WIN) + (size_t)l * 4096 * DM, nullptr, scr, r, F.lane); continue; } r -= I_IN;
            if (r < I_UQ) { transpose_item<2>(A.in[I_WUQ] + (size_t)l * 512 * 1536, 1536, 512, 1536, (bf16*)(F.ws + WS_WUQ) + (size_t)l * 1536 * 512, A.in[I_QNG] + l * 512, scr, r, F.lane); continue; } r -= I_UQ;
            if (r < I_UKV) { transpose_item<0>(A.in[I_WUKV] + (size_t)l * 256 * 2048, 2048, 256, 2048, (bf16*)(F.ws + WS_WUKV) + (size_t)l * 2048 * 256, A.in[I_KVNG] + l * 256, scr, r, F.lane); continue; } r -= I_UKV;
#ifdef G3_FP8
            transpose_item8<0>(A.in[I_WOUT] + (size_t)l * DM * DM, DM, DM, DM, F.ws + WS_WOUT + (size_t)l * DM * DM, scr, r, F.lane);
#else
            transpose_item<0>(A.in[I_WOUT] + (size_t)l * DM * DM, DM, DM, DM, (bf16*)(F.ws + WS_WOUT) + (size_t)l * DM * DM, nullptr, scr, r, F.lane);
#endif
        }
    }
    {
        const int gt = F.vcu * (NWAVES * 64) + F.tid, NGT = F.G * NWAVES * 64;
        float* rope = (float*)(F.ws + WS_ROPE);
        for (int e = gt; e < SEQ * 32; e += NGT) { const int pos = e >> 5, i = e & 31;
            const float ang = (float)pos * A.invf[i];
            const double rev = (double)ang * 0.15915494309189535; const float fr = (float)(rev - __builtin_floor(rev));
            *(f32x2*)(rope + (size_t)e * 2) = (f32x2){__builtin_amdgcn_cosf(fr), __builtin_amdgcn_sinf(fr)}; }
        for (int e = gt; e < 2 * 192 * (DM / 8); e += NGT) { const int l = e / (192 * (DM / 8)), r = e % (192 * (DM / 8));
            *(v4u*)((bf16*)(F.ws + WS_WIN) + ((size_t)l * 4096 + IN_COLS) * DM + (size_t)r * 8) = (v4u){0u, 0u, 0u, 0u}; }
    }
}

__device__ __forceinline__ void phase_norm1(Frame& F, const Args& A, int l) {
    const int gw = F.vcu * NWAVES + F.wave, NGW = F.G * NWAVES;
    const float* mod = (const float*)(F.ws + WS_MOD);
    bf16* H = (bf16*)(F.ws + WS_H); const bf16* Y = (const bf16*)(F.ws + WS_Y);
#ifdef THIN_MLP
    for (int ch = gw; ch < T / 16; ch += NGW) {
        const int row0 = ch * 16, b = row0 >> 13;
        const float* ml = mod + ((size_t)l * 4 + b) * 12288;
#pragma unroll 1
        for (int rr = 0; rr < 16; rr += 2) {
            f32x4 v[2][8];
            if (l == 0) {
#pragma unroll
                for (int q = 0; q < 2; ++q)
#pragma unroll
                    for (int j = 0; j < 8; ++j) v[q][j] = *(const f32x4*)(A.in[I_X] + (size_t)(row0 + rr + q) * DM + 4 * F.lane + 256 * j);
            } else {
                bf16* XB = (bf16*)(F.ws + WS_XB);
                v2u xw[2][8], ya[2][8], yb[2][8]; f32x4 g2p[8];
#pragma unroll
                for (int q = 0; q < 2; ++q)
#pragma unroll
                    for (int j = 0; j < 8; ++j) { const int c = 4 * F.lane + 256 * j; const int row = row0 + rr + q;
                        xw[q][j] = *(const v2u*)(XB + (size_t)row * DM + c); ya[q][j] = *(const v2u*)(Y + (size_t)(2 * row) * DM + c); yb[q][j] = *(const v2u*)(Y + (size_t)(2 * row + 1) * DM + c); }
#pragma unroll
                for (int j = 0; j < 8; ++j) g2p[j] = *(const f32x4*)(mod + ((size_t)(l - 1) * 4 + b) * 12288 + 5 * DM + 4 * F.lane + 256 * j);
#pragma unroll
                for (int q = 0; q < 2; ++q)
#pragma unroll
                    for (int j = 0; j < 8; ++j) { const int c = 4 * F.lane + 256 * j; const int row = row0 + rr + q;
                        const f32x4 xr = {bf_lo(xw[q][j].x), bf_hi(xw[q][j].x), bf_lo(xw[q][j].y), bf_hi(xw[q][j].y)};
                        const v2u y0 = ya[q][j], y1 = yb[q][j];
                        const f32x4 ys = {bf_lo(y0.x) + bf_lo(y1.x), bf_hi(y0.x) + bf_hi(y1.x), bf_lo(y0.y) + bf_lo(y1.y), bf_hi(y0.y) + bf_hi(y1.y)};
                        const f32x4 t = xr + g2p[j] * ys;
                        const v2u ow = {pk2(t.x, t.y), pk2(t.z, t.w)}; *(v2u*)(XB + (size_t)row * DM + c) = ow;
                        v[q][j] = (f32x4){bf_lo(ow.x), bf_hi(ow.x), bf_lo(ow.y), bf_hi(ow.y)}; }
            }
            float rstd[2];
#pragma unroll
            for (int q = 0; q < 2; ++q) { float s = 0.f;
#pragma unroll
                for (int j = 0; j < 8; ++j) s += (v[q][j].x * v[q][j].x + v[q][j].y * v[q][j].y) + (v[q][j].z * v[q][j].z + v[q][j].w * v[q][j].w);
                rstd[q] = __builtin_amdgcn_rsqf(wave_sum(s) * (1.f / DM) + EPS); }
#pragma unroll
            for (int j = 0; j < 8; ++j) { const int c = 4 * F.lane + 256 * j;
                const f32x4 gsc = *(const f32x4*)(A.in[I_N1G] + l * DM + c) * (*(const f32x4*)(ml + 1 * DM + c) + 1.0f), sh = *(const f32x4*)(ml + 0 * DM + c);
#pragma unroll
                for (int q = 0; q < 2; ++q) { const f32x4 o = v[q][j] * rstd[q] * gsc + sh;
                    *(v2u*)(H + (size_t)(row0 + rr + q) * DM + c) = (v2u){pk2(o.x, o.y), pk2(o.z, o.w)}; } }
        }
    }
#else
    for (int ch = gw; ch < T / 16; ch += NGW) {
        const int row0 = ch * 16, b = row0 >> 13;
        const float* ml = mod + ((size_t)l * 4 + b) * 12288;
        f32x4 gsc[8], sh[8], g2p[8];
#pragma unroll
        for (int j = 0; j < 8; ++j) { const int c = 4 * F.lane + 256 * j; const f32x4 g = *(const f32x4*)(A.in[I_N1G] + l * DM + c), sc = *(const f32x4*)(ml + 1 * DM + c);
            gsc[j] = g * (sc + 1.0f); sh[j] = *(const f32x4*)(ml + 0 * DM + c);
            if (l > 0) g2p[j] = *(const f32x4*)(mod + ((size_t)(l - 1) * 4 + b) * 12288 + 5 * DM + c); }
#pragma unroll 1
        for (int rr = 0; rr < 16; ++rr) {
            const int row = row0 + rr; f32x4 v[8]; float s = 0.f;
            if (l == 0) {
#pragma unroll
                for (int j = 0; j < 8; ++j) v[j] = *(const f32x4*)(A.in[I_X] + (size_t)row * DM + 4 * F.lane + 256 * j);
            } else {
#pragma unroll
                for (int j = 0; j < 8; ++j) { const int c = 4 * F.lane + 256 * j;
#ifdef XRES_BF16
                    bf16* XB = (bf16*)(F.ws + WS_XB); const v2u xw = *(const v2u*)(XB + (size_t)row * DM + c); const f32x4 xr = {bf_lo(xw.x), bf_hi(xw.x), bf_lo(xw.y), bf_hi(xw.y)};
#else
                    const f32x4 xr = *(const f32x4*)(A.out + (size_t)row * DM + c);
#endif
                    const v2u y0 = *(const v2u*)(Y + (size_t)(2 * row) * DM + c), y1 = *(const v2u*)(Y + (size_t)(2 * row + 1) * DM + c);
                    const f32x4 ys = {bf_lo(y0.x) + bf_lo(y1.x), bf_hi(y0.x) + bf_hi(y1.x), bf_lo(y0.y) + bf_lo(y1.y), bf_hi(y0.y) + bf_hi(y1.y)};
                    v[j] = xr + g2p[j] * ys;
#ifdef XRES_BF16
                    { const v2u ow = {pk2(v[j].x, v[j].y), pk2(v[j].z, v[j].w)}; *(v2u*)(XB + (size_t)row * DM + c) = ow;
                      v[j] = (f32x4){bf_lo(ow.x), bf_hi(ow.x), bf_lo(ow.y), bf_hi(ow.y)}; }
#else
                    *(f32x4*)(A.out + (size_t)row * DM + c) = v[j];
#endif
                }
            }
#pragma unroll
            for (int j = 0; j < 8; ++j) s += (v[j].x * v[j].x + v[j].y * v[j].y) + (v[j].z * v[j].z + v[j].w * v[j].w);
            const float rstd = __builtin_amdgcn_rsqf(wave_sum(s) * (1.f / DM) + EPS);
#pragma unroll
            for (int j = 0; j < 8; ++j) { const f32x4 o = v[j] * rstd * gsc[j] + sh[j];
                *(v2u*)(H + (size_t)row * DM + 4 * F.lane + 256 * j) = (v2u){pk2(o.x, o.y), pk2(o.z, o.w)}; }
        }
    }
#endif
#ifndef ATT_CONV
    {
        LAS float* scr = (LAS float*)(F.lds + F.wave * 16384);
        constexpr int I_G = (DM / 64) * (DEXP / 32), I_D = (DEXP / 64) * (DM / 32), I_E = 2 * I_G + I_D;
        for (int it = gw; it < NEXP * I_E; it += NGW) {
            const int e = it / I_E; int r = it % I_E; const size_t eo = ((size_t)l * NEXP + e) * DM * DEXP;
            if (r < I_G) { transpose_item8<3>(A.in[I_EG] + eo, DEXP, DM, DEXP, F.ws + WS_W13 + (size_t)e * 2048 * DM, scr, r, F.lane); continue; } r -= I_G;
            if (r < I_G) { transpose_item8<4>(A.in[I_EU] + eo, DEXP, DM, DEXP, F.ws + WS_W13 + (size_t)e * 2048 * DM, scr, r, F.lane); continue; } r -= I_G;
            transpose_item8<0>(A.in[I_ED] + eo, DM, DEXP, DM, F.ws + WS_W2 + (size_t)e * DM * DEXP, scr, r, F.lane);
        }
    }
#endif
}
__device__ __forceinline__ void phase_final(Frame& F, const Args& A, int probe) {
    const int gw = F.vcu * NWAVES + F.wave, NGW = F.G * NWAVES;
    const float* mod = (const float*)(F.ws + WS_MOD); const bf16* Y = (const bf16*)(F.ws + WS_Y);
    for (int ch = gw; ch < T / 16; ch += NGW) {
        const int row0 = ch * 16, b = row0 >> 13;
#if defined(THIN_MLP) && defined(XRES_BF16)
#pragma unroll 1
        for (int rr = 0; rr < 16; rr += 2) {
            v2u xw[2][8], ya[2][8], yb[2][8]; f32x4 g2p[8]; f32x4 v[2][8];
#pragma unroll
            for (int q = 0; q < 2; ++q)
#pragma unroll
                for (int j = 0; j < 8; ++j) { const int c = 4 * F.lane + 256 * j; const int row = row0 + rr + q;
                    xw[q][j] = *(const v2u*)((const bf16*)(F.ws + WS_XB) + (size_t)row * DM + c); ya[q][j] = *(const v2u*)(Y + (size_t)(2 * row) * DM + c); yb[q][j] = *(const v2u*)(Y + (size_t)(2 * row + 1) * DM + c); }
#pragma unroll
            for (int j = 0; j < 8; ++j) g2p[j] = *(const f32x4*)(mod + ((size_t)(probe == 3 ? 0 : DEPTH - 1) * 4 + b) * 12288 + 5 * DM + 4 * F.lane + 256 * j);
            float rstd[2];
#pragma unroll
            for (int q = 0; q < 2; ++q) { float s = 0.f;
#pragma unroll
                for (int j = 0; j < 8; ++j) { const f32x4 xr = {bf_lo(xw[q][j].x), bf_hi(xw[q][j].x), bf_lo(xw[q][j].y), bf_hi(xw[q][j].y)};
                    const v2u y0 = ya[q][j], y1 = yb[q][j];
                    const f32x4 ys = {bf_lo(y0.x) + bf_lo(y1.x), bf_hi(y0.x) + bf_hi(y1.x), bf_lo(y0.y) + bf_lo(y1.y), bf_hi(y0.y) + bf_hi(y1.y)};
                    v[q][j] = (probe == 1 || probe == 2) ? xr : xr + g2p[j] * ys; }
#pragma unroll
                for (int j = 0; j < 8; ++j) s += (v[q][j].x * v[q][j].x + v[q][j].y * v[q][j].y) + (v[q][j].z * v[q][j].z + v[q][j].w * v[q][j].w);
                rstd[q] = __builtin_amdgcn_rsqf(wave_sum(s) * (1.f / DM) + EPS); }
#pragma unroll
            for (int j = 0; j < 8; ++j) { const int c = 4 * F.lane + 256 * j; const f32x4 fg = *(const f32x4*)(A.in[I_FG] + c);
#pragma unroll
                for (int q = 0; q < 2; ++q) *(f32x4*)(A.out + (size_t)(row0 + rr + q) * DM + c) = v[q][j] * rstd[q] * fg; }
        }
#else
        f32x4 fg[8], g2p[8];
#pragma unroll
        for (int j = 0; j < 8; ++j) { const int c = 4 * F.lane + 256 * j; fg[j] = *(const f32x4*)(A.in[I_FG] + c); g2p[j] = *(const f32x4*)(mod + ((size_t)(probe == 3 ? 0 : DEPTH - 1) * 4 + b) * 12288 + 5 * DM + c); }
#pragma unroll 1
        for (int rr = 0; rr < 16; ++rr) {
            const int row = row0 + rr; f32x4 v[8]; float s = 0.f;
#pragma unroll
            for (int j = 0; j < 8; ++j) { const int c = 4 * F.lane + 256 * j;
#ifdef XRES_BF16
                const v2u xw = *(const v2u*)((const bf16*)(F.ws + WS_XB) + (size_t)row * DM + c); const f32x4 xr = {bf_lo(xw.x), bf_hi(xw.x), bf_lo(xw.y), bf_hi(xw.y)};
#else
                const f32x4 xr = *(const f32x4*)((probe == 2 ? A.in[I_X] : A.out) + (size_t)row * DM + c);
#endif
                const v2u y0 = *(const v2u*)(Y + (size_t)(2 * row) * DM + c), y1 = *(const v2u*)(Y + (size_t)(2 * row + 1) * DM + c);
                const f32x4 ys = {bf_lo(y0.x) + bf_lo(y1.x), bf_hi(y0.x) + bf_hi(y1.x), bf_lo(y0.y) + bf_lo(y1.y), bf_hi(y0.y) + bf_hi(y1.y)};
                v[j] = (probe == 1 || probe == 2) ? xr : xr + g2p[j] * ys; }
#pragma unroll
            for (int j = 0; j < 8; ++j) s += (v[j].x * v[j].x + v[j].y * v[j].y) + (v[j].z * v[j].z + v[j].w * v[j].w);
            const float rstd = __builtin_amdgcn_rsqf(wave_sum(s) * (1.f / DM) + EPS);
#pragma unroll
            for (int j = 0; j < 8; ++j) *(f32x4*)(A.out + (size_t)row * DM + 4 * F.lane + 256 * j) = v[j] * rstd * fg[j];
        }
#endif
    }
}
#ifndef PROBE_DUMP_SCALE
#define PROBE_DUMP_SCALE 1.0f
#endif
#ifndef PROBE_DUMP_W
#define PROBE_DUMP_W 2048
#endif
__device__ __forceinline__ void phase_dump(Frame& F, const Args& A, size_t off, int pitch) {
    const int gw = F.vcu * NWAVES + F.wave, NGW = F.G * NWAVES;
    for (int row = gw; row < T; row += NGW) { const bf16* src = (const bf16*)(F.ws + off) + (size_t)row * pitch;
#ifdef PROBE_DUMP_F32
        for (int j = 0; j < 8; ++j) { const int c = 4 * F.lane + 256 * j; const float* sf = (const float*)(F.ws + off) + (size_t)row * pitch + c;
#ifdef PROBE_DUMP_SRC_OUT
            sf = A.out + (size_t)row * DM + c;
#endif
            f32x4 o = {0.f, 0.f, 0.f, 0.f}; if (c < PROBE_DUMP_W) o = *(const f32x4*)sf * PROBE_DUMP_SCALE;
#ifdef PROBE_DUMP_LOWBITS
            { const v4u ub = __builtin_bit_cast(v4u, o); o = (f32x4){(float)(ub.x & 0xFFFu), (float)(ub.y & 0xFFFu), (float)(ub.z & 0xFFFu), (float)(ub.w & 0xFFFu)}; }
#endif
            *(f32x4*)(A.out + (size_t)row * DM + c) = o; }
        continue;
#endif
        for (int j = 0; j < 8; ++j) { const int c = 4 * F.lane + 256 * j; const v2u w = *(const v2u*)(src + c);
#ifdef PROBE_DUMP_LOWBITS
            *(f32x4*)(A.out + (size_t)row * DM + c) = c < PROBE_DUMP_W ? (f32x4){(float)(w.x & 0x7Fu), (float)((w.x >> 16) & 0x7Fu), (float)(w.y & 0x7Fu), (float)((w.y >> 16) & 0x7Fu)} : (f32x4){0.f, 0.f, 0.f, 0.f}; } }
#else
            *(f32x4*)(A.out + (size_t)row * DM + c) = c < PROBE_DUMP_W ? (f32x4){bf_lo(w.x), bf_hi(w.x), bf_lo(w.y), bf_hi(w.y)} : (f32x4){0.f, 0.f, 0.f, 0.f}; } }
#endif
}
__device__ __forceinline__ void phase_mla_prep(Frame& F, const Args& A) {
    const int gw = F.vcu * NWAVES + F.wave, NGW = F.G * NWAVES;
    const bf16* P = (const bf16*)(F.ws + WS_PROJ); bf16* KF = (bf16*)(F.ws + WS_KF);
    float* rq = (float*)(F.ws + WS_RSTDQ); float* rkv = (float*)(F.ws + WS_RSTDKV); const float* rope = (const float*)(F.ws + WS_ROPE);
    for (int ch = gw; ch < T / 16; ch += NGW) {
#pragma unroll 1
        for (int r4 = 0; r4 < 16; r4 += 4) {
            v4u q[4]; v2u kv[4]; unsigned kr[4]; f32x2 cs[4];
#pragma unroll
            for (int u = 0; u < 4; ++u) { const int row = ch * 16 + r4 + u; const bf16* pr = P + (size_t)row * PROJ_LD;
                q[u] = *(const v4u*)(pr + C_CQ + 8 * F.lane); kv[u] = *(const v2u*)(pr + C_CKV + 4 * F.lane);
                kr[u] = *(const unsigned*)(pr + C_KR + 2 * (F.lane & 31)); cs[u] = *(const f32x2*)(rope + ((size_t)(row & (SEQ - 1)) * 32 + (F.lane & 31)) * 2); }
#pragma unroll
            for (int u = 0; u < 4; ++u) { const int row = ch * 16 + r4 + u;
                float sq = 0.f, skv = 0.f;
#pragma unroll
                for (int i = 0; i < 4; ++i) { const float a = bf_lo(q[u][i]), b2 = bf_hi(q[u][i]); sq += a * a + b2 * b2; }
#pragma unroll
                for (int i = 0; i < 2; ++i) { const float a = bf_lo(kv[u][i]), b2 = bf_hi(kv[u][i]); skv += a * a + b2 * b2; }
                sq = wave_sum(sq); skv = wave_sum(skv);
                if (F.lane == 0) { rq[row] = __builtin_amdgcn_rsqf(sq * (1.f / 512.f) + EPS); rkv[row] = __builtin_amdgcn_rsqf(skv * (1.f / 256.f) + EPS); }
                if (F.lane < 32) { const float x1 = bf_lo(kr[u]), x2 = bf_hi(kr[u]);
                    const unsigned o = pk2(x1 * cs[u].x - x2 * cs[u].y, x2 * cs[u].x + x1 * cs[u].y);
#pragma unroll
                    for (int h = 0; h < 8; ++h) *(unsigned*)(KF + (size_t)row * 1536 + h * 192 + 128 + 2 * F.lane) = o; } }
        }
    }
}
__device__ __forceinline__ void phase_q_rope(Frame& F, const Args& A) {
    const int gw = F.vcu * NWAVES + F.wave, NGW = F.G * NWAVES;
    bf16* QA = (bf16*)(F.ws + WS_QA); const float* rope = (const float*)(F.ws + WS_ROPE);
    for (int ch = gw; ch < T / 16; ch += NGW) {
#pragma unroll 1
        for (int r4 = 0; r4 < 16; r4 += 4) {
            v4u w[4]; f32x4 c01[4], c23[4];
#pragma unroll
            for (int u = 0; u < 4; ++u) { const int row = ch * 16 + r4 + u;
                w[u] = *(const v4u*)(QA + (size_t)row * 1536 + (F.lane >> 3) * 192 + 128 + (F.lane & 7) * 8);
                const f32x4* cs = (const f32x4*)(rope + ((size_t)(row & (SEQ - 1)) * 32 + (F.lane & 7) * 4) * 2); c01[u] = cs[0]; c23[u] = cs[1]; }
#pragma unroll
            for (int u = 0; u < 4; ++u) { const int row = ch * 16 + r4 + u; v4u o;
                { const float x1 = bf_lo(w[u].x), x2 = bf_hi(w[u].x); o.x = pk2(x1 * c01[u][0] - x2 * c01[u][1], x2 * c01[u][0] + x1 * c01[u][1]); }
                { const float x1 = bf_lo(w[u].y), x2 = bf_hi(w[u].y); o.y = pk2(x1 * c01[u][2] - x2 * c01[u][3], x2 * c01[u][2] + x1 * c01[u][3]); }
                { const float x1 = bf_lo(w[u].z), x2 = bf_hi(w[u].z); o.z = pk2(x1 * c23[u][0] - x2 * c23[u][1], x2 * c23[u][0] + x1 * c23[u][1]); }
                { const float x1 = bf_lo(w[u].w), x2 = bf_hi(w[u].w); o.w = pk2(x1 * c23[u][2] - x2 * c23[u][3], x2 * c23[u][2] + x1 * c23[u][3]); }
                *(v4u*)(QA + (size_t)row * 1536 + (F.lane >> 3) * 192 + 128 + (F.lane & 7) * 8) = o; }
        }
    }
}
__device__ __forceinline__ void phase_out_norm(Frame& F, const Args& A, int l) {
    const int gw = F.vcu * NWAVES + F.wave, NGW = F.G * NWAVES;
    const bf16* OA = (const bf16*)(F.ws + WS_OA); const bf16* OB = (const bf16*)(F.ws + WS_OB); const float* LSE = (const float*)(F.ws + WS_LSE); bf16* Yn = (bf16*)(F.ws + WS_H);
    for (int ch = gw; ch < T / 16; ch += NGW) {
        float ga[2][8], gb[2][8];
#pragma unroll
        for (int hf = 0; hf < 2; ++hf)
#pragma unroll
            for (int i = 0; i < 8; ++i) { ga[hf][i] = A.in[I_ONA][l * 1024 + hf * 512 + 8 * F.lane + i]; gb[hf][i] = A.in[I_ONB][l * 1024 + hf * 512 + 8 * F.lane + i]; }
#ifdef THIN_MLP
#pragma unroll 1
        for (int rr = 0; rr < 16; rr += 2) {
            v4u ra_[2][2], ro_[2][2][3]; float ls_[2][2][3];
#pragma unroll
            for (int q = 0; q < 2; ++q)
#pragma unroll
                for (int hf = 0; hf < 2; ++hf) { const int row = ch * 16 + rr + q, c = hf * 512 + 8 * F.lane, hd = c >> 7;
                    ra_[q][hf] = *(const v4u*)(OA + (size_t)row * 1024 + c);
#pragma unroll
                    for (int n = 0; n < 3; ++n) { ro_[q][hf][n] = *(const v4u*)(OB + ((size_t)n * T + row) * 1024 + c); ls_[q][hf][n] = LSE[((size_t)n * T + row) * 8 + hd]; } }
#pragma unroll
            for (int q = 0; q < 2; ++q) {
                const int row = ch * 16 + rr + q;
                float va[2][8], vb[2][8]; float sa = 0.f, sb = 0.f;
#pragma unroll
                for (int hf = 0; hf < 2; ++hf) {
                    const v4u a = ra_[q][hf];
#pragma unroll
                    for (int i = 0; i < 4; ++i) { va[hf][2 * i] = bf_lo(a[i]); va[hf][2 * i + 1] = bf_hi(a[i]); }
                    const float l0 = ls_[q][hf][0], l1 = ls_[q][hf][1], l2 = ls_[q][hf][2];
                    const float mx = fmaxf(l0, fmaxf(l1, l2)); const float e0 = __expf(l0 - mx), e1 = __expf(l1 - mx), e2 = __expf(l2 - mx); const float inv = 1.0f / (e0 + e1 + e2);
                    const float al[3] = {e0 * inv, e1 * inv, e2 * inv};
#pragma unroll
                    for (int i = 0; i < 8; ++i) vb[hf][i] = 0.f;
#pragma unroll
                    for (int n = 0; n < 3; ++n) { const v4u o = ro_[q][hf][n];
#pragma unroll
                        for (int i = 0; i < 4; ++i) { vb[hf][2 * i] += al[n] * bf_lo(o[i]); vb[hf][2 * i + 1] += al[n] * bf_hi(o[i]); } }
#pragma unroll
                    for (int i = 0; i < 8; ++i) { sa += va[hf][i] * va[hf][i]; sb += vb[hf][i] * vb[hf][i]; }
                }
                const float ra = __builtin_amdgcn_rsqf(wave_sum(sa) * (1.f / 1024.f) + EPS), rb = __builtin_amdgcn_rsqf(wave_sum(sb) * (1.f / 1024.f) + EPS);
#pragma unroll
                for (int hf = 0; hf < 2; ++hf) { const int c = hf * 512 + 8 * F.lane;
#ifdef G3_FP8
                    { unsigned char* Y8 = (unsigned char*)Yn; float ya[8], yb[8];
#pragma unroll
                      for (int i = 0; i < 8; ++i) { ya[i] = va[hf][i] * ra * ga[hf][i]; yb[i] = vb[hf][i] * rb * gb[hf][i]; }
                      *(v2u*)(Y8 + (size_t)row * DM + c) = (v2u){pk4_fp8(ya[0], ya[1], ya[2], ya[3]), pk4_fp8(ya[4], ya[5], ya[6], ya[7])};
                      *(v2u*)(Y8 + (size_t)row * DM + 1024 + c) = (v2u){pk4_fp8(yb[0], yb[1], yb[2], yb[3]), pk4_fp8(yb[4], yb[5], yb[6], yb[7])}; }
#else
                    { v4u wa, wb;
#pragma unroll
                      for (int i = 0; i < 4; ++i) { wa[i] = pk2(va[hf][2 * i] * ra * ga[hf][2 * i], va[hf][2 * i + 1] * ra * ga[hf][2 * i + 1]); wb[i] = pk2(vb[hf][2 * i] * rb * gb[hf][2 * i], vb[hf][2 * i + 1] * rb * gb[hf][2 * i + 1]); }
                      *(v4u*)(Yn + (size_t)row * DM + c) = wa; *(v4u*)(Yn + (size_t)row * DM + 1024 + c) = wb; }
#endif
                }
            }
        }
#else
#pragma unroll 1
        for (int rr = 0; rr < 16; ++rr) {
            const int row = ch * 16 + rr;
            float va[2][8], vb[2][8]; float sa = 0.f, sb = 0.f;
#pragma unroll
            for (int hf = 0; hf < 2; ++hf) {
                const int c = hf * 512 + 8 * F.lane, hd = c >> 7;
                const v4u a = *(const v4u*)(OA + (size_t)row * 1024 + c);
#pragma unroll
                for (int i = 0; i < 4; ++i) { va[hf][2 * i] = bf_lo(a[i]); va[hf][2 * i + 1] = bf_hi(a[i]); }
                const float l0 = LSE[((size_t)0 * T + row) * 8 + hd], l1 = LSE[((size_t)1 * T + row) * 8 + hd], l2 = LSE[((size_t)2 * T + row) * 8 + hd];
                const float mx = fmaxf(l0, fmaxf(l1, l2)); const float e0 = __expf(l0 - mx), e1 = __expf(l1 - mx), e2 = __expf(l2 - mx); const float inv = 1.0f / (e0 + e1 + e2);
                const float al[3] = {e0 * inv, e1 * inv, e2 * inv};
#pragma unroll
                for (int i = 0; i < 8; ++i) vb[hf][i] = 0.f;
#pragma unroll
                for (int n = 0; n < 3; ++n) { const v4u o = *(const v4u*)(OB + ((size_t)n * T + row) * 1024 + c);
#pragma unroll
                    for (int i = 0; i < 4; ++i) { vb[hf][2 * i] += al[n] * bf_lo(o[i]); vb[hf][2 * i + 1] += al[n] * bf_hi(o[i]); } }
#pragma unroll
                for (int i = 0; i < 8; ++i) { sa += va[hf][i] * va[hf][i]; sb += vb[hf][i] * vb[hf][i]; }
            }
            const float ra = __builtin_amdgcn_rsqf(wave_sum(sa) * (1.f / 1024.f) + EPS), rb = __builtin_amdgcn_rsqf(wave_sum(sb) * (1.f / 1024.f) + EPS);
#pragma unroll
            for (int hf = 0; hf < 2; ++hf) { const int c = hf * 512 + 8 * F.lane; v4u wa, wb;
#pragma unroll
                for (int i = 0; i < 4; ++i) { wa[i] = pk2(va[hf][2 * i] * ra * ga[hf][2 * i], va[hf][2 * i + 1] * ra * ga[hf][2 * i + 1]); wb[i] = pk2(vb[hf][2 * i] * rb * gb[hf][2 * i], vb[hf][2 * i + 1] * rb * gb[hf][2 * i + 1]); }
#ifdef G3_FP8
                { unsigned char* Y8 = (unsigned char*)Yn; float ya[8], yb[8];
#pragma unroll
                  for (int i = 0; i < 8; ++i) { ya[i] = va[hf][i] * ra * ga[hf][i]; yb[i] = vb[hf][i] * rb * gb[hf][i]; }
                  *(v2u*)(Y8 + (size_t)row * DM + c) = (v2u){pk4_fp8(ya[0], ya[1], ya[2], ya[3]), pk4_fp8(ya[4], ya[5], ya[6], ya[7])};
                  *(v2u*)(Y8 + (size_t)row * DM + 1024 + c) = (v2u){pk4_fp8(yb[0], yb[1], yb[2], yb[3]), pk4_fp8(yb[4], yb[5], yb[6], yb[7])}; }
#else
                *(v4u*)(Yn + (size_t)row * DM + c) = wa; *(v4u*)(Yn + (size_t)row * DM + 1024 + c) = wb;
#endif
            }
        }
#endif
    }
}
#ifndef ROUTER_SRC
#define ROUTER_SRC A.out
#endif
#ifdef ROUTER_MFMA
typedef short r_bf16x8 __attribute__((ext_vector_type(8)));
__device__ __forceinline__ void phase_router(Frame& F, const Args& A, int l, int dummy = 0) {
    const float* mod = (const float*)(F.ws + WS_MOD);
    bf16* H = (bf16*)(F.ws + WS_H);
    LAS int* lcnt = (LAS int*)(F.lds + L_CNT); LAS int* gbase = lcnt + 16; LAS int* tokinfo = (LAS int*)(F.lds + L_TOK);
    LAS float* lgs = (LAS float*)(F.lds + L_ATAB);
    LAS float* rsl = (LAS float*)(F.lds + L_ATAB + 8704);
    LAS float* wsm = (LAS float*)(F.lds + L_ATAB + 8704 + 512);
    LAS float* cstl = (LAS float*)(F.lds + L_ATAB + 8704 + 1024);
    unsigned* gcnt = F.ctl + CW_CNT + (dummy ? 3 : l) * 16;
    int* rowidx = (int*)(F.ws + (dummy ? WS_OB : WS_ROWIDX)); float* aw = (float*)(F.ws + (dummy ? WS_OB + 4 * MiB : WS_AW));
    float rb[16];
#pragma unroll
    for (int e = 0; e < 16; ++e) rb[e] = __uint_as_float(__builtin_amdgcn_readfirstlane(__float_as_uint(A.in[I_RB][e])));
    for (int bi = F.vcu; bi < T / 128; bi += F.G) {
        const int row0 = bi * 128 + F.wave * 16, b = row0 >> 13;
        const rsrc_t rml = RSRC(mod + ((size_t)l * 4 + b) * 12288), rgn = RSRC(A.in[I_N2G] + l * DM), rh = RSRC(H), rxb = RSRC(F.ws + WS_XB), rrw = RSRC(A.in[I_RW]);
        __syncthreads();
        { const int t0_ = F.wave * 64 + lane_id(); if (t0_ < 16) lcnt[t0_] = 0;
          const int e4 = t0_ & 3; f32x4 ca = {0.f, 0.f, 0.f, 0.f};
#pragma unroll 4
          for (int i = 0; i < 16; ++i) { const int k = (t0_ >> 2) + 128 * i;
              const f32x4 w4 = bld4f(rrw, (k * 16 + e4 * 4) * 4, 0);
              const float g = __uint_as_float(__builtin_amdgcn_raw_buffer_load_b32(rgn, k * 4, 0, 0)) * (__uint_as_float(__builtin_amdgcn_raw_buffer_load_b32(rml, k * 4, 4 * DM * 4, 0)) + 1.0f);
              const float sh = __uint_as_float(__builtin_amdgcn_raw_buffer_load_b32(rml, k * 4, 3 * DM * 4, 0));
              ca += w4 * sh;
              const int ob = (k >> 5) * 1024 + (((k >> 3) & 3) * 16 + e4 * 4) * 16 + (k & 7) * 2;
#pragma unroll
              for (int c = 0; c < 4; ++c) { const float wp = w4[c] * g; const unsigned hi = pk2(wp, 0.f) & 0xffffu; const float rem = wp - __uint_as_float(hi << 16);
                  *(LAS unsigned short*)(F.lds + ob + c * 16) = (unsigned short)hi; *(LAS unsigned short*)(F.lds + 65536 + ob + c * 16) = (unsigned short)(pk2(rem, 0.f) & 0xffffu); } }
          const int ln = t0_ & 63;
#pragma unroll
          for (int q = 0; q < 4; ++q)
#pragma unroll
              for (int c = 0; c < 4; ++c) { const float s = wave_sum((ln & 3) == q ? ca[c] : 0.f); if (ln == 0) wsm[F.wave * 16 + q * 4 + c] = s; }
        }
        __syncthreads();
        { const int t0_ = F.wave * 64 + lane_id(); if (t0_ < 16) { float s = 0.f;
#pragma unroll
              for (int w = 0; w < 8; ++w) s += wsm[w * 16 + t0_];
              cstl[t0_] = s; } }
        __syncthreads();
        const int lo16 = F.lane * 16, lo8 = F.lane * 8;
        f32x4 gsv[8];
#pragma unroll
        for (int j = 0; j < 8; ++j) gsv[j] = bld4f(rgn, lo16 + j * 1024, 0) * (bld4f(rml, lo16 + j * 1024, 4 * DM * 4) + 1.0f);
#pragma unroll 1
        for (int rp = 0; rp < 8; ++rp) {
            float ss[2] = {0.f, 0.f};
            v2u xraw[2][8];
#pragma unroll
            for (int q = 0; q < 2; ++q)
#pragma unroll
                for (int j = 0; j < 8; ++j) xraw[q][j] = bld2u(rxb, lo8 + j * 512, (row0 + rp * 2 + q) * (DM * 2));
#define XV(q, j) ((f32x4){bf_lo(xraw[q][j].x), bf_hi(xraw[q][j].x), bf_lo(xraw[q][j].y), bf_hi(xraw[q][j].y)})
            f32x4 shv[8];
#pragma unroll
            for (int j = 0; j < 8; ++j) shv[j] = bld4f(rml, lo16 + j * 1024, 3 * DM * 4);
#pragma unroll
            for (int j = 0; j < 8; ++j)
#pragma unroll
                for (int q = 0; q < 2; ++q) { const f32x4 x = XV(q, j); ss[q] += (x.x * x.x + x.y * x.y) + (x.z * x.z + x.w * x.w); }
            float rstd[2];
#pragma unroll
            for (int q = 0; q < 2; ++q) rstd[q] = __builtin_amdgcn_rsqf(wave_sum(ss[q]) * (1.f / DM) + EPS);
            if (F.lane == 0) { rsl[F.wave * 16 + rp * 2] = rstd[0]; rsl[F.wave * 16 + rp * 2 + 1] = rstd[1]; }
#pragma unroll
            for (int j = 0; j < 8; ++j) {
#pragma unroll
                for (int q = 0; q < 2; ++q) { const f32x4 o = XV(q, j) * rstd[q] * gsv[j] + shv[j]; __builtin_amdgcn_raw_buffer_store_b32(pk4_fp8(o.x, o.y, o.z, o.w), rh, F.lane * 4 + j * 256, (row0 + rp * 2 + q) * DM, 0); } }
#undef XV
        }
        { const int ln = lane_id(), col = ln & 15, rq = ln >> 4;
          const int va = col * (DM * 2) + rq * 16, sa = row0 * (DM * 2);
          f32x4 acc = {0.f, 0.f, 0.f, 0.f};
          r_bf16x8 a0[8], a1[8];
#pragma unroll
          for (int i = 0; i < 8; ++i) a0[i] = __builtin_bit_cast(r_bf16x8, __builtin_amdgcn_raw_buffer_load_b128(rxb, va + i * 64, sa, 0));
#define RT_MM(AR, sb) do { _Pragma("unroll") for (int i = 0; i < 8; ++i) { const int st = (sb) * 8 + i; \
              const r_bf16x8 bh = *(const LAS r_bf16x8*)(F.lds + st * 1024 + ln * 16), bl = *(const LAS r_bf16x8*)(F.lds + 65536 + st * 1024 + ln * 16); \
              acc = __builtin_amdgcn_mfma_f32_16x16x32_bf16(AR[i], bh, acc, 0, 0, 0); acc = __builtin_amdgcn_mfma_f32_16x16x32_bf16(AR[i], bl, acc, 0, 0, 0); } } while (0)
#pragma unroll 1
          for (int sb = 0; sb < 8; sb += 2) {
#pragma unroll
              for (int i = 0; i < 8; ++i) a1[i] = __builtin_bit_cast(r_bf16x8, __builtin_amdgcn_raw_buffer_load_b128(rxb, va + ((sb + 1) * 8 + i) * 64, sa, 0));
              RT_MM(a0, sb);
              if (sb + 2 < 8) {
#pragma unroll
                  for (int i = 0; i < 8; ++i) a0[i] = __builtin_bit_cast(r_bf16x8, __builtin_amdgcn_raw_buffer_load_b128(rxb, va + ((sb + 2) * 8 + i) * 64, sa, 0)); }
              RT_MM(a1, sb + 1);
          }
#undef RT_MM
          LDS_WAIT();
          const float cs = cstl[col];
#pragma unroll
          for (int i = 0; i < 4; ++i) lgs[F.wave * 272 + (4 * rq + i) * 17 + col] = acc[i] * rsl[F.wave * 16 + 4 * rq + i] + cs;
          LDS_WAIT(); asm volatile("" ::: "memory");
          if (ln < 16) {
              float sc[16], bs[16];
#pragma unroll
              for (int e = 0; e < 16; ++e) { const float lg = lgs[F.wave * 272 + ln * 17 + e]; sc[e] = 1.0f / (1.0f + __expf(-lg)); bs[e] = sc[e] + rb[e]; }
              float gs4[4];
#pragma unroll
              for (int g = 0; g < 4; ++g) { const float a = bs[4 * g], b2 = bs[4 * g + 1], c = bs[4 * g + 2], d = bs[4 * g + 3];
                  const float h1 = fmaxf(a, b2), l1 = fminf(a, b2), h2 = fmaxf(c, d), l2 = fminf(c, d);
                  gs4[g] = fmaxf(h1, h2) + fmaxf(fminf(h1, h2), fmaxf(l1, l2)); }
              int gsel = 0; float gbest = gs4[0];
#pragma unroll
              for (int g = 1; g < 4; ++g) if (gs4[g] > gbest) { gbest = gs4[g]; gsel = g; }
              float bv[4], sv[4];
#pragma unroll
              for (int i = 0; i < 4; ++i) { bv[i] = gsel == 0 ? bs[i] : gsel == 1 ? bs[4 + i] : gsel == 2 ? bs[8 + i] : bs[12 + i]; sv[i] = gsel == 0 ? sc[i] : gsel == 1 ? sc[4 + i] : gsel == 2 ? sc[8 + i] : sc[12 + i]; }
              int i1 = 0; float b1 = bv[0], s1 = sv[0];
#pragma unroll
              for (int i = 1; i < 4; ++i) if (bv[i] > b1) { b1 = bv[i]; s1 = sv[i]; i1 = i; }
              int i2 = -1; float b2v = -__builtin_inff(), s2 = 0.f;
#pragma unroll
              for (int i = 0; i < 4; ++i) if (i != i1 && bv[i] > b2v) { b2v = bv[i]; s2 = sv[i]; i2 = i; }
              const float inv = 1.0f / (s1 + s2);
              const int r = F.wave * 16 + ln, e0 = gsel * 4 + i1, e1 = gsel * 4 + i2;
              tokinfo[r * 4 + 0] = e0; tokinfo[r * 4 + 2] = e1;
              const int row = row0 + ln; *(f32x2*)(aw + (size_t)row * 2) = (f32x2){s1 * inv, s2 * inv};
          }
        }
        __syncthreads();
        const int tb_ = F.wave * 64 + lane_id();
        if (tb_ < 16) {
            int c = 0;
            for (int r = 0; r < 128; ++r) { if (tokinfo[r * 4 + 0] == tb_) tokinfo[r * 4 + 1] = c++; if (tokinfo[r * 4 + 2] == tb_) tokinfo[r * 4 + 3] = c++; }
            gbase[tb_] = (int)__hip_atomic_fetch_add(gcnt + tb_, (unsigned)c, __ATOMIC_RELAXED, __HIP_MEMORY_SCOPE_AGENT); }
        __syncthreads();
        if (tb_ < 128) { const int e0 = tokinfo[tb_ * 4], p0 = tokinfo[tb_ * 4 + 1], e1 = tokinfo[tb_ * 4 + 2], p1 = tokinfo[tb_ * 4 + 3]; const int row = bi * 128 + tb_;
            rowidx[(size_t)e0 * 32768 + gbase[e0] + p0] = 2 * row; rowidx[(size_t)e1 * 32768 + gbase[e1] + p1] = 2 * row + 1; }
        __syncthreads();
    }
}
#else
__device__ __forceinline__ void phase_router(Frame& F, const Args& A, int l, int dummy = 0) {
    const float* mod = (const float*)(F.ws + WS_MOD);
    bf16* H = (bf16*)(F.ws + WS_H);
    LAS f32x4* rwl = (LAS f32x4*)F.lds;
    LAS int* lcnt = (LAS int*)(F.lds + L_CNT); LAS int* gbase = lcnt + 16; LAS int* tokinfo = (LAS int*)(F.lds + L_TOK);
    unsigned* gcnt = F.ctl + CW_CNT + (dummy ? 3 : l) * 16;
    int* rowidx = (int*)(F.ws + (dummy ? WS_OB : WS_ROWIDX)); float* aw = (float*)(F.ws + (dummy ? WS_OB + 4 * MiB : WS_AW));
    for (int q = F.tid; q < 8192; q += NWAVES * 64) { const int k = q >> 2, e4 = q & 3, ln = (k & 255) >> 2, j = k >> 8, i = k & 3;
        rwl[((j * 4 + i) * 4 + e4) * 64 + ln] = *(const f32x4*)(A.in[I_RW] + (size_t)k * 16 + e4 * 4); }
    float rb[16];
#pragma unroll
    for (int e = 0; e < 16; ++e) rb[e] = __uint_as_float(__builtin_amdgcn_readfirstlane(__float_as_uint(A.in[I_RB][e])));
    __syncthreads();
    for (int bi = F.vcu; bi < T / 128; bi += F.G) {
        { const int t0_ = F.wave * 64 + lane_id(); if (t0_ < 16) lcnt[t0_] = 0; }
        __syncthreads();
        const int row0 = bi * 128 + F.wave * 16, b = row0 >> 13;
        const rsrc_t rml = RSRC(mod + ((size_t)l * 4 + b) * 12288), rgn = RSRC(A.in[I_N2G] + l * DM), rx = RSRC(ROUTER_SRC), rh = RSRC(H);
#ifdef XRES_BF16
        const rsrc_t rxb = RSRC(F.ws + WS_XB);
#endif
        const int lo16 = F.lane * 16, lo8 = F.lane * 8;
        float cst[16];
        { f32x4 ca[4] = {};
#pragma unroll
          for (int j = 0; j < 8; ++j) { const f32x4 sh = bld4f(rml, lo16 + j * 1024, 3 * DM * 4);
#pragma unroll
            for (int i = 0; i < 4; ++i)
#pragma unroll
                for (int e4 = 0; e4 < 4; ++e4) ca[e4] += rwl[((j * 4 + i) * 4 + e4) * 64 + F.lane] * sh[i];
            asm volatile("" ::: "memory"); }
#pragma unroll
          for (int e = 0; e < 16; ++e) cst[e] = __uint_as_float(__builtin_amdgcn_readfirstlane(__float_as_uint(wave_sum(ca[e >> 2][e & 3])))); }
        f32x4 gsv[8];
#pragma unroll
        for (int j = 0; j < 8; ++j) gsv[j] = bld4f(rgn, lo16 + j * 1024, 0) * (bld4f(rml, lo16 + j * 1024, 4 * DM * 4) + 1.0f);
#pragma unroll 1
        for (int rp = 0; rp < 8; ++rp) {
            float ss[2] = {0.f, 0.f}; f32x4 acc[2][4] = {};
            const int so0 = (row0 + rp * 2) * (DM * 4);
#ifdef XRES_BF16
            v2u xraw[2][8];
#pragma unroll
            for (int q = 0; q < 2; ++q)
#pragma unroll
                for (int j = 0; j < 8; ++j) xraw[q][j] = bld2u(rxb, lo8 + j * 512, (row0 + rp * 2 + q) * (DM * 2));
#define XV(q, j) ((f32x4){bf_lo(xraw[q][j].x), bf_hi(xraw[q][j].x), bf_lo(xraw[q][j].y), bf_hi(xraw[q][j].y)})
#else
            f32x4 xv[2][8];
#pragma unroll
            for (int q = 0; q < 2; ++q)
#pragma unroll
                for (int j = 0; j < 8; ++j) xv[q][j] = bld4f(rx, lo16 + j * 1024, so0 + q * (DM * 4));
#define XV(q, j) xv[q][j]
#endif
#pragma unroll
            for (int j = 0; j < 8; ++j) {
                f32x4 a[2];
#pragma unroll
                for (int q = 0; q < 2; ++q) { const f32x4 x = XV(q, j); ss[q] += (x.x * x.x + x.y * x.y) + (x.z * x.z + x.w * x.w); a[q] = x * gsv[j]; }
#pragma unroll
                for (int i = 0; i < 4; ++i) {
#pragma unroll
                    for (int e4 = 0; e4 < 4; ++e4) { const f32x4 w = rwl[((j * 4 + i) * 4 + e4) * 64 + F.lane]; acc[0][e4] += w * a[0][i]; acc[1][e4] += w * a[1][i]; }
                    asm volatile("" : "+v"(acc[0][0]), "+v"(acc[0][1]), "+v"(acc[0][2]), "+v"(acc[0][3]), "+v"(acc[1][0]), "+v"(acc[1][1]), "+v"(acc[1][2]), "+v"(acc[1][3]) :: "memory"); } }
            float rstd[2];
#pragma unroll
            for (int q = 0; q < 2; ++q) rstd[q] = __builtin_amdgcn_rsqf(wave_sum(ss[q]) * (1.f / DM) + EPS);
            asm volatile("" ::: "memory");
            f32x4 shv[8];
#pragma unroll
            for (int j = 0; j < 8; ++j) shv[j] = bld4f(rml, lo16 + j * 1024, 3 * DM * 4);
#pragma unroll
            for (int j = 0; j < 8; ++j) {
#pragma unroll
                for (int q = 0; q < 2; ++q) { const f32x4 o = XV(q, j) * rstd[q] * gsv[j] + shv[j]; __builtin_amdgcn_raw_buffer_store_b32(pk4_fp8(o.x, o.y, o.z, o.w), rh, F.lane * 4 + j * 256, (row0 + rp * 2 + q) * DM, 0); } }
#undef XV
#pragma unroll
            for (int q = 0; q < 2; ++q) {
                float sc[16], bs[16];
#pragma unroll
                for (int e = 0; e < 16; ++e) { const float lg = wave_sum(acc[q][e >> 2][e & 3]) * rstd[q] + cst[e]; sc[e] = 1.0f / (1.0f + __expf(-lg)); bs[e] = sc[e] + rb[e]; }
                float gs4[4];
#pragma unroll
                for (int g = 0; g < 4; ++g) { const float a = bs[4 * g], b2 = bs[4 * g + 1], c = bs[4 * g + 2], d = bs[4 * g + 3];
                    const float h1 = fmaxf(a, b2), l1 = fminf(a, b2), h2 = fmaxf(c, d), l2 = fminf(c, d);
                    gs4[g] = fmaxf(h1, h2) + fmaxf(fminf(h1, h2), fmaxf(l1, l2)); }
                int gsel = 0; float gbest = gs4[0];
#pragma unroll
                for (int g = 1; g < 4; ++g) if (gs4[g] > gbest) { gbest = gs4[g]; gsel = g; }
                float bv[4], sv[4];
#pragma unroll
                for (int i = 0; i < 4; ++i) { bv[i] = gsel == 0 ? bs[i] : gsel == 1 ? bs[4 + i] : gsel == 2 ? bs[8 + i] : bs[12 + i]; sv[i] = gsel == 0 ? sc[i] : gsel == 1 ? sc[4 + i] : gsel == 2 ? sc[8 + i] : sc[12 + i]; }
                int i1 = 0; float b1 = bv[0], s1 = sv[0];
#pragma unroll
                for (int i = 1; i < 4; ++i) if (bv[i] > b1) { b1 = bv[i]; s1 = sv[i]; i1 = i; }
                int i2 = -1; float b2v = -__builtin_inff(), s2 = 0.f;
#pragma unroll
                for (int i = 0; i < 4; ++i) if (i != i1 && bv[i] > b2v) { b2v = bv[i]; s2 = sv[i]; i2 = i; }
                const float inv = 1.0f / (s1 + s2);
                if (F.lane == 0) {
                    const int r = F.wave * 16 + rp * 2 + q, e0 = gsel * 4 + i1, e1 = gsel * 4 + i2;
                    tokinfo[r * 4 + 0] = e0; tokinfo[r * 4 + 2] = e1;
                    const int row = row0 + rp * 2 + q; *(f32x2*)(aw + (size_t)row * 2) = (f32x2){s1 * inv, s2 * inv};
                }
            }
        }
        __syncthreads();
        const int tb_ = F.wave * 64 + lane_id();
        if (tb_ < 16) {
            int c = 0;
            for (int r = 0; r < 128; ++r) { if (tokinfo[r * 4 + 0] == tb_) tokinfo[r * 4 + 1] = c++; if (tokinfo[r * 4 + 2] == tb_) tokinfo[r * 4 + 3] = c++; }
            gbase[tb_] = (int)__hip_atomic_fetch_add(gcnt + tb_, (unsigned)c, __ATOMIC_RELAXED, __HIP_MEMORY_SCOPE_AGENT); }
        __syncthreads();
        if (tb_ < 128) { const int e0 = tokinfo[tb_ * 4], p0 = tokinfo[tb_ * 4 + 1], e1 = tokinfo[tb_ * 4 + 2], p1 = tokinfo[tb_ * 4 + 3]; const int row = bi * 128 + tb_;
            rowidx[(size_t)e0 * 32768 + gbase[e0] + p0] = 2 * row; rowidx[(size_t)e1 * 32768 + gbase[e1] + p1] = 2 * row + 1; }
        __syncthreads();
    }
}
#endif
__device__ __forceinline__ int moe_setup(Frame& F, int l) {
    LAS int* ts = (LAS int*)(F.lds + L_TS);
    if (F.tid == 0) { int s = 0; for (int e = 0; e < 16; ++e) { ts[e] = s; s += ((int)__hip_atomic_load(F.ctl + CW_CNT + l * 16 + e, __ATOMIC_RELAXED, __HIP_MEMORY_SCOPE_AGENT) + 255) >> 8; } ts[16] = s; }
    __syncthreads();
    return __builtin_amdgcn_readfirstlane(ts[16]);
}

__device__ __forceinline__ att::Blk mla_blk(int bh, int qb) {
    const int b = bh >> 3, h = bh & 7; att::Blk k;
    k.qo = (unsigned)(WS_QA + ((size_t)b * SEQ * 1536 + h * 192) * 2); k.ko = (unsigned)(WS_KF + ((size_t)b * SEQ * 1536 + h * 192) * 2);
    k.vo = (unsigned)(WS_VB + ((size_t)b * SEQ * 1024 + h * 128) * 2); k.oo = (unsigned)(WS_OA + ((size_t)b * SEQ * 1024 + h * 128) * 2); k.lo = 0;
    k.P0 = qb * 256; k.rate = 1; k.beta = 0.f;
    return k;
}
__device__ __forceinline__ att::Blk dil_blk(int bh, int br, int blk) {
    const int b = bh >> 3, h = bh & 7, rate = br == 0 ? 1 : br == 1 ? 4 : 16, nqb = 32 / rate, cls = blk / nqb, qb = blk % nqb; att::Blk k;
    const size_t tok0 = (size_t)b * SEQ + cls;
    const unsigned p = (unsigned)(WS_PROJ + (tok0 * PROJ_LD + h * 128) * 2);
    k.qo = p + C_QB * 2; k.ko = p + C_KB * 2; k.vo = p + C_VB * 2;
    k.oo = (unsigned)(WS_OB + (((size_t)br * T + tok0) * 1024 + h * 128) * 2);
    k.lo = (unsigned)(WS_LSE + (((size_t)br * T + tok0) * 8 + h) * 4);
    k.P0 = qb * 256; k.rate = rate;
    const float slope = __builtin_amdgcn_exp2f(-(float)(h + 1));
    k.beta = slope * (float)rate * 11.313708498984761f;
    return k;
}
__device__ __forceinline__ void mla_decode(int id, int& bh, int& qb0, int& qb1) {
    const int v = id & 255, i = id >> 8, x = v >> 5, c = v & 31, j = i * 32 + c; bh = 4 * x + (j >> 4); const int s = j & 15; qb0 = s; qb1 = 31 - s;
}
__device__ __forceinline__ void dil_decode(int id, int& bh, int& br, int& blk) {
    const int v = id & 255, i = id >> 8, x = v >> 5, c = v & 31, j = i * 32 + c; bh = 4 * x + j / 96; const int r = j % 96; br = r >> 5; blk = r & 31;
}
#ifndef ATT_DIL_NS
#define ATT_DIL_NS 4
#endif
#ifndef ATT_SKEW_SEL
#define ATT_SKEW_SEL 0
#endif
#if ATT_SKEW_SEL == 0
#define ATT_SKEW_PICK(w) ((w) < 4)
#elif ATT_SKEW_SEL == 1
#define ATT_SKEW_PICK(w) (((w) & 1) == 0)
#elif ATT_SKEW_SEL == 2
#define ATT_SKEW_PICK(w) true
#else
#define ATT_SKEW_PICK(w) false
#endif
#ifdef ATT_DMA
#define ATT_SEAM(d) att::SeamD<d>
#define ATT_DMA_ON ATT_DMA
#else
#define ATT_SEAM(d) att::Seam<d>
#define ATT_DMA_ON 0
#endif
#if ATT_DMA_ON == 2
template <int ORD>
__device__ __forceinline__ void mla_stream2(Frame& F, char* lds) {
    constexpr int NIT = 512;
    int id = F.vcu;
    if (id < NIT) {
        att::SeamD<192> S; int bh, q0, q1; mla_decode(id, bh, q0, q1); int pass = 0;
        att::Blk cur = mla_blk(bh, q0);
        att::att_prime_dma2<192, false>(cur, (const char*)F.ws, lds, S, F.tid);
        for (;;) {
            const bool more_pass = pass == 0, more_item = id + F.G < NIT, last = !more_pass && !more_item;
            att::Blk nxt = cur; int idn = id, passn = pass + 1;
            if (more_pass) nxt = mla_blk(bh, q1);
            else if (more_item) { idn = id + F.G; passn = 0; mla_decode(idn, bh, q0, q1); nxt = mla_blk(bh, q0); }
            att::att_block_dma2<192, false, false, ORD>(cur, nxt, (const char*)F.ws, lds, S, F.tid);
            if (last) break;
            cur = nxt; id = idn; pass = passn;
        }
    }
}
template <int ORD>
__device__ __forceinline__ void dil_stream2(Frame& F, char* lds) {
    constexpr int NIT = 3072;
    int id = F.vcu;
    if (id < NIT) {
        att::SeamD<128> S; int bh, br, blk; dil_decode(id, bh, br, blk);
        att::Blk cur = dil_blk(bh, br, blk);
        att::att_prime_dma2<128, true>(cur, (const char*)F.ws, lds, S, F.tid);
        for (;;) {
            const bool last = id + F.G >= NIT;
            att::Blk nxt = cur;
            if (!last) { dil_decode(id + F.G, bh, br, blk); nxt = dil_blk(bh, br, blk); }
            att::att_block_dma2<128, true, true, ORD>(cur, nxt, (const char*)F.ws, lds, S, F.tid);
            if (last) break;
            cur = nxt; id += F.G;
        }
    }
}
#endif
template <int PV>
__device__ __forceinline__ void dil_stream_reg(Frame& F, char* lds, int rep_, const Args& A, int l) {
        constexpr int NIT = 3072;
        int id = F.vcu;
        if (id < NIT) {
#if ATT_DMA_ON == 1
            att::SeamD<128> S;
#else
            att::Seam<128> S;
#endif
            int bh, br, blk; dil_decode(id, bh, br, blk);
            att::Blk cur = dil_blk(bh, br, blk);
#if defined(ATT_CONV) && ATT_CONV == 2
            const size_t eo_ = (size_t)l * NEXP * DM * DEXP;
            const att::ConvCtx X = {A.in[I_EG] + eo_, A.in[I_EU] + eo_, A.in[I_ED] + eo_, F.ws + WS_W13, F.ws + WS_W2, F.vcu * 8 + __builtin_amdgcn_readfirstlane(F.tid >> 6)};
#endif
#if ATT_DMA_ON == 1
            att::att_prime_dma<128, true, ATT_DIL_NS>(cur, (const char*)F.ws, lds, S, F.tid);
#else
            att::att_prime<128, true, PV>(cur, (const char*)F.ws, lds, S, F.tid);
#endif
            for (;;) {
                const bool last = id + F.G >= NIT;
                att::Blk nxt = cur;
                if (!last) { dil_decode(id + F.G, bh, br, blk); nxt = dil_blk(bh, br, blk); }
#if ATT_DMA_ON == 1
                att::att_block_dma<128, true, true, ATT_DIL_NS>(cur, nxt, (const char*)F.ws, lds, lds + RING_BYTES + 512, S, F.tid);
#else
#if defined(ATT_CONV) && ATT_CONV == 2
                att::att_block<128, true, true, PV, 2>(cur, nxt, (const char*)F.ws, lds, S, F.tid, &X);
#else
                att::att_block<128, true, true, PV>(cur, nxt, (const char*)F.ws, lds, S, F.tid);
#endif
#endif
                if (last) break;
                cur = nxt; id += F.G;
            }
#if defined(ATT_CONV) && ATT_CONV == 2
            { const int ln_ = lane_id(); char* scr_ = lds + att::CONV_SCR_DIL + __builtin_amdgcn_readfirstlane(F.tid >> 6) * 4352;
              if (S.cv_pend) { asm volatile("s_waitcnt vmcnt(0)" ::: "memory"); att::conv_put_full(X, S.cv_j, S.cvf, scr_, ln_); ++S.cv_j; S.cv_pend = 0; }
              while (S.cv_j < att::CONV_NJ) { att::conv_load_full(X, S.cv_j, S.cvf, ln_); asm volatile("s_waitcnt vmcnt(0)" ::: "memory"); att::conv_put_full(X, S.cv_j, S.cvf, scr_, ln_); ++S.cv_j; } }
#endif
#if defined(ATT_DEFER) && ATT_DMA_ON != 1
            if (S.p_on) { const int ln_ = F.tid & 63; const char* stg_ = lds + att::DEFER_STG + __builtin_amdgcn_readfirstlane(F.tid >> 6) * 8192;
#pragma unroll
                for (int p = 0; p < 8; ++p) att::flush_piece(stg_, p, (const char*)F.ws + S.p_oo, S.p_rb, S.p_so0, ln_); }
#endif
        }
}
static_assert(WS_ROPE == att::ROPE_OFF, "rope table offset");
#ifdef ATT_QROPE
#define ATT_ROPE_FLAG true
#else
#define ATT_ROPE_FLAG false
#endif
__device__ __forceinline__ void phase_attention(Frame& F, char* lds, const Args& A, int l) {
#ifdef ATT_PRIO
    if (__builtin_amdgcn_readfirstlane(F.tid >> 6) >= 4) __builtin_amdgcn_s_setprio(1);
#endif
#ifndef NO_MLA
#ifndef PROBE_REP_MLA
#define PROBE_REP_MLA 1
#endif
    for (int rep_ = 0; rep_ < PROBE_REP_MLA; ++rep_) {
        if (rep_) __syncthreads();
#if ATT_DMA_ON == 2
        { const int wsel_ = __builtin_amdgcn_readfirstlane(F.tid >> 6);
          if (ATT_SKEW_PICK(wsel_)) mla_stream2<0>(F, lds); else mla_stream2<1>(F, lds); }
#else
        constexpr int NIT = 512;
        int id = F.vcu;
        if (id < NIT) {
            ATT_SEAM(192) S; int bh, q0, q1; mla_decode(id, bh, q0, q1); int pass = 0;
            att::Blk cur = mla_blk(bh, q0);
#if defined(ATT_CONV) && ATT_CONV == 1
            const size_t eo_ = (size_t)l * NEXP * DM * DEXP;
            const att::ConvCtx X = {A.in[I_EG] + eo_, A.in[I_EU] + eo_, A.in[I_ED] + eo_, F.ws + WS_W13, F.ws + WS_W2, F.vcu * 8 + __builtin_amdgcn_readfirstlane(F.tid >> 6)};
#endif
#if ATT_DMA_ON
            att::att_prime_dma<192, false, 3>(cur, (const char*)F.ws, lds, S, F.tid);
#else
#ifdef ATT_QROPE
            att::att_prime<192, false, 0, true>(cur, (const char*)F.ws, lds, S, F.tid);
#else
            att::att_prime<192, false>(cur, (const char*)F.ws, lds, S, F.tid);
#endif
#endif
            for (;;) {
                const bool more_pass = pass == 0, more_item = id + F.G < NIT, last = !more_pass && !more_item;
                att::Blk nxt = cur; int idn = id, passn = pass + 1;
                if (more_pass) nxt = mla_blk(bh, q1);
                else if (more_item) { idn = id + F.G; passn = 0; mla_decode(idn, bh, q0, q1); nxt = mla_blk(bh, q0); }
#if ATT_DMA_ON
                att::att_block_dma<192, false, false, 3>(cur, nxt, (const char*)F.ws, lds, lds + 3 * att::SHM_V + 3 * att::Cfg<192>::SHM_K, S, F.tid);
#else
#if defined(ATT_CONV) && ATT_CONV == 1
                att::att_block<192, false, false, 0, 1, ATT_ROPE_FLAG>(cur, nxt, (const char*)F.ws, lds, S, F.tid, &X);
#elif defined(ATT_QROPE)
                att::att_block<192, false, false, 0, 0, true>(cur, nxt, (const char*)F.ws, lds, S, F.tid);
#else
                att::att_block<192, false, false>(cur, nxt, (const char*)F.ws, lds, S, F.tid);
#endif
#endif
                if (last) break;
                cur = nxt; id = idn; pass = passn;
            }
#if defined(ATT_CONV) && ATT_CONV == 1
            { const int ln_ = lane_id(); char* scr_ = lds + att::CONV_SCR + __builtin_amdgcn_readfirstlane(F.tid >> 6) * 4352;
              while (S.cv_j < att::CONV_NJ) { att::conv_load(X, S.cv_j, S.cv_q, S.cv, ln_); asm volatile("s_waitcnt vmcnt(0)" ::: "memory");
                  att::conv_put(X, S.cv_j, S.cv_q, S.cv, scr_, ln_); if (++S.cv_q == 4) { S.cv_q = 0; ++S.cv_j; } S.cl_j = S.cv_j; S.cl_q = S.cv_q; } }
#endif
        }
#endif
    }
#endif
#ifndef NO_DIL
#ifndef PROBE_REP_DIL
#define PROBE_REP_DIL 1
#endif
#ifndef PROBE_DIL_VAR
#define PROBE_DIL_VAR 0
#endif
#if ATT_DMA_ON == 2 && !defined(ATT_DIL_DMA2)
    asm volatile("s_waitcnt vmcnt(0)" ::: "memory"); __syncthreads();
#endif
    for (int rep_ = 0; rep_ < PROBE_REP_DIL; ++rep_) {
        if (rep_) __syncthreads();
#if ATT_DMA_ON == 2 && defined(ATT_DIL_DMA2)
        { const int wsel_ = __builtin_amdgcn_readfirstlane(F.tid >> 6);
          if (ATT_SKEW_PICK(wsel_)) dil_stream2<0>(F, lds); else dil_stream2<1>(F, lds); }
#else
        if (rep_ + 1 < PROBE_REP_DIL) dil_stream_reg<PROBE_DIL_VAR>(F, lds, rep_, A, l); else dil_stream_reg<0>(F, lds, rep_, A, l);
#endif
    }
#endif
#ifdef ATT_PRIO
    __builtin_amdgcn_s_setprio(0);
#endif
}
#ifndef MK_PER_PHASE
#define MK_PER_PHASE 0
#endif
constexpr int NPH = 2 + 11 * DEPTH;
__global__ void __launch_bounds__(NWAVES * 64, 2) mk_fwd(Args args) {
    extern __shared__ __attribute__((aligned(16))) unsigned char lds[];
    Frame F;
    F.lds = (LAS unsigned char*)lds; F.ldsg = lds;
    F.wave = __builtin_amdgcn_readfirstlane((int)threadIdx.x >> 6); F.lane = lane_id(); F.tid = F.wave * 64 + F.lane;
    F.G = gridDim.x; { const int bx = blockIdx.x; F.vcu = (F.G % 8 == 0) ? (bx % 8) * (F.G / 8) + bx / 8 : bx; }
    F.ws = args.ws; F.ctl = (unsigned*)(args.ws + WS_CTL);
    for (int u = F.tid; u < (LDS_BYTES - RING_BYTES) / 4; u += NWAVES * 64) ((LAS unsigned*)(F.lds + RING_BYTES))[u] = 0u;
    __syncthreads();
    volatile LAS unsigned* MISC = (volatile LAS unsigned*)(F.lds + L_MISC);
    XcdBarrier bar; bar.bar = F.ctl + CW_BAR; bar.x = 0; bar.st = nullptr;
    if (!MK_PER_PHASE) bar = xcd_barrier_post(F.ctl + CW_BAR, MISC + 8, F.tid);
    const int lo = args.ph_lo, hi = args.ph_hi;
#ifndef PROBE_GRID1_PHASE
#define PROBE_GRID1_PHASE (-1)
#endif
#define PROBE_GRID1(p) ((p) == PROBE_GRID1_PHASE)
#ifndef PROBE_MODE
#define PROBE_MODE 1
#endif
#ifndef PROBE_REP_MASK
#define PROBE_REP_MASK 0
#endif
#define NREP(j) ((((PROBE_REP_MASK) >> (j)) & 1) ? 2 : 1)
#ifndef PROBE_XIN
#define PROBE_XIN 0
#endif
#ifndef PH_MASK
#define PH_MASK 0x1FFF
#endif
#define IN(k) (lo <= (k) && (k) < hi)
#define MSK(j) (((PH_MASK) >> (j)) & 1)
#define FRESH(Fp) Frame Fp = F; { int l_ = lane_id(); int z_ = 0; asm volatile("" : "+v"(l_), "+s"(z_)); Fp.lane = l_; Fp.wave = F.wave + z_; Fp.tid = Fp.wave * 64 + l_; Fp.vcu = F.vcu + z_; Fp.ws = F.ws + z_; Fp.ctl = (unsigned*)(Fp.ws + WS_CTL); }
#define SEAM(k) do { if (IN(k) && IN((k) + 1)) xcd_barrier(bar, F.wave * 64 + lane_id()); } while (0)

    if (MSK(11) && IN(0)) { FRESH(P); phase_prologue(P, args);
#ifdef PROBE_REPEAT_PROLOGUE
        __syncthreads(); phase_prologue(P, args);
#endif
    }
    SEAM(0);
    for (int l = 0; l < DEPTH; ++l) {
        const int pb = 1 + 11 * l;
        const float* mod = (const float*)(F.ws + WS_MOD);
        if (MSK(0) && IN(pb + 0)) { for (int rep_ = 0; rep_ < (l == 0 ? NREP(0) : 1); ++rep_) { if (rep_) __syncthreads(); FRESH(P); phase_norm1(P, args, l); } }
        SEAM(pb + 0);
        if (MSK(1) && IN(pb + 1)) { for (int rep_ = 0; rep_ < NREP(1); ++rep_) { if (rep_) __syncthreads(); FRESH(P);
            pg8::Gemm g{(const bf16*)(P.ws + WS_H), (const bf16*)(P.ws + WS_WIN) + (size_t)l * 4096 * DM, DM * 2};
            pg8::StaticOrder S; S.init(T, PROJ_LD, P.G, (int)blockIdx.x);
            pg8::EpiPlain E{(bf16*)(P.ws + WS_PROJ), PROJ_LD};
            pg8::gemm_phase<pg8::EpiPlain, pg8::StaticOrder, pg8::ALinear>(P.lds, g, S, pg8::ALinear{}, E, P.tid);
        } }
        SEAM(pb + 1);
#ifdef PROBE_EXTRA_BARRIERS
        if (IN(pb + 2)) for (int xb_ = 0; xb_ < PROBE_EXTRA_BARRIERS; ++xb_) xcd_barrier(bar, F.wave * 64 + lane_id());
#endif
        if (MSK(2) && IN(pb + 2)) { for (int rep_ = 0; rep_ < NREP(2); ++rep_) { if (rep_) __syncthreads(); FRESH(P); phase_mla_prep(P, args); } }
        SEAM(pb + 2);
        if (MSK(3) && IN(pb + 3)) { for (int rep_ = 0; rep_ < NREP(3); ++rep_) { if (rep_) __syncthreads(); FRESH(P);
#ifdef PROBE_SWAP_UP
            { pg8::Gemm g{(const bf16*)(P.ws + WS_PROJ) + C_CKV, (const bf16*)(P.ws + WS_WUKV) + (size_t)l * 2048 * 256, 256 * 2};
              pg8::StaticOrder S; S.init(T, 2048, P.G, (int)blockIdx.x);
              pg8::EpiKVup E{(bf16*)(P.ws + WS_KF), (bf16*)(P.ws + WS_VB), (const float*)(P.ws + WS_RSTDKV)};
              pg8::gemm_phase<pg8::EpiKVup, pg8::StaticOrder, pg8::APitch>(P.lds, g, S, pg8::APitch{PROJ_LD * 2}, E, P.tid); }
            { pg8::Gemm g{(const bf16*)(P.ws + WS_PROJ) + C_CQ, (const bf16*)(P.ws + WS_WUQ) + (size_t)l * 1536 * 512, 512 * 2};
              pg8::StaticOrder S; S.init(T, 1536, P.G, (int)blockIdx.x);
              pg8::EpiQup E{(bf16*)(P.ws + WS_QA), (const float*)(P.ws + WS_RSTDQ)};
#ifdef PROBE_QUP_PLAIN
              { pg8::EpiPlain E2{(bf16*)(P.ws + WS_QA), 1536}; pg8::gemm_phase<pg8::EpiPlain, pg8::StaticOrder, pg8::APitch>(P.lds, g, S, pg8::APitch{PROJ_LD * 2}, E2, P.tid); }
#else
              pg8::gemm_phase<pg8::EpiQup, pg8::StaticOrder, pg8::APitch>(P.lds, g, S, pg8::APitch{PROJ_LD * 2}, E, P.tid);
#endif
            }
#else
            { pg8::Gemm g{(const bf16*)(P.ws + WS_PROJ) + C_CQ, (const bf16*)(P.ws + WS_WUQ) + (size_t)l * 1536 * 512, 512 * 2};
              pg8::StaticOrder S; S.init(T, 1536, P.G, (int)blockIdx.x);
              pg8::EpiQup E{(bf16*)(P.ws + WS_QA), (const float*)(P.ws + WS_RSTDQ)};
#ifdef PROBE_QUP_PLAIN
              { pg8::EpiPlain E2{(bf16*)(P.ws + WS_QA), 1536}; pg8::gemm_phase<pg8::EpiPlain, pg8::StaticOrder, pg8::APitch>(P.lds, g, S, pg8::APitch{PROJ_LD * 2}, E2, P.tid); }
#else
              pg8::gemm_phase<pg8::EpiQup, pg8::StaticOrder, pg8::APitch>(P.lds, g, S, pg8::APitch{PROJ_LD * 2}, E, P.tid);
#endif
            }
            { pg8::Gemm g{(const bf16*)(P.ws + WS_PROJ) + C_CKV, (const bf16*)(P.ws + WS_WUKV) + (size_t)l * 2048 * 256, 256 * 2};
              pg8::StaticOrder S; S.init(T, 2048, P.G, (int)blockIdx.x);
              pg8::EpiKVup E{(bf16*)(P.ws + WS_KF), (bf16*)(P.ws + WS_VB), (const float*)(P.ws + WS_RSTDKV)};
              pg8::gemm_phase<pg8::EpiKVup, pg8::StaticOrder, pg8::APitch>(P.lds, g, S, pg8::APitch{PROJ_LD * 2}, E, P.tid); }
#endif
        } }
        SEAM(pb + 3);
#ifndef ATT_QROPE
        if (MSK(4) && IN(pb + 4)) { FRESH(P); phase_q_rope(P, args); }
        SEAM(pb + 4);
#endif
        if (MSK(5) && IN(pb + 5)) { FRESH(P); phase_attention(P, (char*)lds, args, l);
#ifdef PROBE_REPEAT_ATT
            __syncthreads(); phase_attention(P, (char*)lds, args, l);
#endif
        }
        SEAM(pb + 5);
        if (MSK(6) && IN(pb + 6)) { for (int rep_ = 0; rep_ < NREP(6); ++rep_) { if (rep_) __syncthreads(); FRESH(P); phase_out_norm(P, args, l); } }
        SEAM(pb + 6);
        if (MSK(7) && IN(pb + 7)) { FRESH(P);
#ifdef G3_FP8
            pg8::Gemm g{P.ws + WS_H, P.ws + WS_WOUT + (size_t)l * DM * DM, DM};
            pg8::StaticOrder S; S.init(T, DM, P.G, (int)blockIdx.x);
#ifdef XRES_BF16
            pg8::EpiResidB E{l == 0 ? (const void*)args.in[I_X] : (const void*)(P.ws + WS_XB), (bf16*)(P.ws + WS_XB), mod + (size_t)l * 4 * 12288 + 2 * DM, 12288, 1.0f / 256.0f, l == 0 ? 1 : 0};
            pg8::gemm_phase<pg8::EpiResidB, pg8::StaticOrder, pg8::ALinear, true>(P.lds, g, S, pg8::ALinear{}, E, P.tid);
#else
            pg8::EpiResid E{l == 0 ? args.in[I_X] : args.out, args.out, mod + (size_t)l * 4 * 12288 + 2 * DM, DM, 12288, 1.0f / 256.0f};
            pg8::gemm_phase<pg8::EpiResid, pg8::StaticOrder, pg8::ALinear, true>(P.lds, g, S, pg8::ALinear{}, E, P.tid);
#endif
#elif defined(XRES_BF16)
            pg8::Gemm g{(const bf16*)(P.ws + WS_H), (const bf16*)(P.ws + WS_WOUT) + (size_t)l * DM * DM, DM * 2};
            pg8::StaticOrder S; S.init(T, DM, P.G, (int)blockIdx.x);
            pg8::EpiResidB E{l == 0 ? (const void*)args.in[I_X] : (const void*)(P.ws + WS_XB), (bf16*)(P.ws + WS_XB), mod + (size_t)l * 4 * 12288 + 2 * DM, 12288, 1.0f, l == 0 ? 1 : 0};
            pg8::gemm_phase<pg8::EpiResidB, pg8::StaticOrder, pg8::ALinear>(P.lds, g, S, pg8::ALinear{}, E, P.tid);
#else
            pg8::Gemm g{(const bf16*)(P.ws + WS_H), (const bf16*)(P.ws + WS_WOUT) + (size_t)l * DM * DM, DM * 2};
            pg8::StaticOrder S; S.init(T, DM, P.G, (int)blockIdx.x);
            pg8::EpiResid E{l == 0 ? args.in[I_X] : args.out, args.out, mod + (size_t)l * 4 * 12288 + 2 * DM, DM, 12288, 1.0f};
            pg8::gemm_phase<pg8::EpiResid, pg8::StaticOrder, pg8::ALinear>(P.lds, g, S, pg8::ALinear{}, E, P.tid);
#endif
        }
        SEAM(pb + 7);
        if (MSK(8) && IN(pb + 8)) { FRESH(P); phase_router(P, args, l);
#ifdef PROBE_REPEAT_ROUTER
            __syncthreads(); phase_router(P, args, l, 1);
#endif
        }
        SEAM(pb + 8);
        if (MSK(9) && IN(pb + 9)) { for (int rep_ = 0; rep_ < NREP(9); ++rep_) { if (rep_) __syncthreads(); FRESH(P);
            const int NT = moe_setup(P, l);
            pg8::MoeOrder S{NT, 8, P.G, (int)blockIdx.x, (const LAS int*)(P.lds + L_TS)};
            LAS unsigned* atab = (LAS unsigned*)(P.lds + L_ATAB); const int* rowidx = (const int*)(P.ws + WS_ROWIDX);
#pragma unroll 1
            for (int slot = 0; slot < MAXU; ++slot) { pg8::Unit u; if (!S.next(slot, u)) break;
                if (P.tid < 256) { const int lr = u.lt * 256 + P.tid; const int ce = (int)P.ctl[CW_CNT + l * 16 + u.e];
                    int tok = lr < ce ? (rowidx[(size_t)u.e * 32768 + lr] >> 1) : 0;
#ifdef PROBE_LINEAR_ATAB
                    tok = (int)(((unsigned)(u.pm * 256 + P.tid) * 2654435761u) >> 17) & 32767;
#endif
 atab[slot * 256 + P.tid] = (unsigned)tok * (unsigned)DM; } }
            __syncthreads();
            pg8::Gemm g{P.ws + WS_H, P.ws + WS_W13, DM};
            pg8::EpiSwiglu E{P.ws + WS_HMID, DEXP};
            pg8::gemm_phase<pg8::EpiSwiglu, pg8::MoeOrder, pg8::ATable, true>(P.lds, g, S, pg8::ATable{atab}, E, P.tid);
        } }
        SEAM(pb + 9);
        if (MSK(10) && IN(pb + 10)) { for (int rep_ = 0; rep_ < NREP(10); ++rep_) { if (rep_) __syncthreads(); FRESH(P);
            const int NT = moe_setup(P, l);
            pg8::MoeOrder S{NT, 8, P.G, (int)blockIdx.x, (const LAS int*)(P.lds + L_TS)};
            pg8::Gemm g{P.ws + WS_HMID, P.ws + WS_W2, DEXP};
            pg8::EpiMoeDown E{(bf16*)(P.ws + WS_Y), (const int*)(P.ws + WS_ROWIDX), (const float*)(P.ws + WS_AW), P.ctl + CW_CNT + l * 16};
            pg8::gemm_phase<pg8::EpiMoeDown, pg8::MoeOrder, pg8::ALinear, true>(P.lds, g, S, pg8::ALinear{}, E, P.tid);
        } }
        SEAM(pb + 10);
    }
    #ifdef PROBE_DUMP_OFF
    if (MSK(12) && IN(NPH - 1)) { FRESH(P); phase_dump(P, args, (size_t)(PROBE_DUMP_OFF), PROBE_DUMP_PITCH); }
#else
    if (MSK(12) && IN(NPH - 1)) { FRESH(P); phase_final(P, args, args.li != 0 ? (PROBE_XIN ? 2 : PROBE_MODE) : 0);
#ifdef PROBE_EXACT
        { const int gw = P.vcu * NWAVES + P.wave, NGW = P.G * NWAVES; __syncthreads();
          for (int ch = gw; ch < T / 16; ch += NGW) for (int rr = 0; rr < 16; ++rr) for (int j = 0; j < 8; ++j) { float* p = args.out + (size_t)(ch * 16 + rr) * DM + 4 * P.lane + 256 * j; asm volatile("s_waitcnt vmcnt(0)" ::: "memory");
              const v4u ub = *(const v4u*)p; *(f32x4*)p = (f32x4){(float)(ub.x & 0xFFFu), (float)(ub.y & 0xFFFu), (float)(ub.z & 0xFFFu), (float)(ub.w & 0xFFFu)}; } }
#endif
    }
#endif
#undef IN
#undef SEAM
}

extern "C" void kernel_launch(void* const* d_in, const int* in_sizes, int n_in, void* d_out, int out_size, void* d_ws, size_t ws_size, hipStream_t stream) {
    static int grid = 0;
    if (grid == 0) {
        if (n_in != 20 || in_sizes[0] != T * DM || out_size != T * DM || ws_size < WS_END) {
            fprintf(stderr, "kernel_launch: unexpected problem (n_in %d, in0 %d, out %d, ws %zu < %zu)\n", n_in, n_in > 0 ? in_sizes[0] : -1, out_size, ws_size, (size_t)WS_END); grid = -1; return; }
        int dev = 0, cus = 0;
        if (hipGetDevice(&dev) != hipSuccess || hipDeviceGetAttribute(&cus, hipDeviceAttributeMultiprocessorCount, dev) != hipSuccess) { grid = -1; return; }
        if (hipFuncSetAttribute((const void*)mk_fwd, hipFuncAttributeMaxDynamicSharedMemorySize, LDS_BYTES) != hipSuccess) { fprintf(stderr, "kernel_launch: hipFuncSetAttribute failed\n"); grid = -1; return; }
        int per_cu = 0;
        if (hipOccupancyMaxActiveBlocksPerMultiprocessor(&per_cu, (const void*)mk_fwd, NWAVES * 64, LDS_BYTES) != hipSuccess || per_cu < 1) fprintf(stderr, "kernel_launch: occupancy query says %d blocks per CU\n", per_cu);
        (void)hipGetLastError();
        grid = cus;
        if (grid != 256) fprintf(stderr, "kernel_launch: %d CUs (built for 256)\n", grid);
    }
    if (grid < 0) return;
    if (hipMemsetAsync((char*)d_ws + WS_CTL, 0, CTL_ZERO_BYTES, stream) != hipSuccess) return;
    Args a; memset(&a, 0, sizeof(a));
    for (int i = 0; i < 20; ++i) a.in[i] = (const float*)d_in[i];
    a.out = (float*)d_out; a.ws = (unsigned char*)d_ws;
    for (int i = 0; i < 32; ++i) a.invf[i] = (float)pow(10000.0, -(double)i / 32.0);
#if MK_PER_PHASE
#ifndef PROBE_LAST
#define PROBE_LAST (NPH - 2)
#endif
    for (int p = 0; p < NPH; ++p) { if (p > PROBE_LAST && p != NPH - 1) continue;
#ifdef PROBE_ONLY_MASK
        if (p != NPH - 1 && !((PROBE_ONLY_MASK >> p) & 1)) continue;
#endif
 a.ph_lo = p; a.ph_hi = p + 1; a.li = (PROBE_LAST != NPH - 2) ? 1 : 0; hipLaunchKernelGGL(mk_fwd, dim3(PROBE_GRID1(p) ? 1 : grid), dim3(NWAVES * 64), LDS_BYTES, stream, a); }
#else
    a.ph_lo = 0; a.ph_hi = NPH; a.li = 0;
    hipLaunchKernelGGL(mk_fwd, dim3(grid), dim3(NWAVES * 64), LDS_BYTES, stream, a);
#endif
    const hipError_t le = hipPeekAtLastError();
    if (le != hipSuccess) fprintf(stderr, "kernel_launch: launch failed: %s\n", hipGetErrorName(le));
}
```

```cpp
#define MK_PER_PHASE 0
#define XRES_BF16 1
#define G3_FP8 1
#define ATT_QROPE 1
#define ST16_IMM 1
#define ROUTER_MFMA 1
#define ATT_CONV 2
#define ATT_SLOAD_RECOMP 1
#define ATT_RAWBAR 1
#define ATT_MLA_SK 1
#include <hip/hip_runtime.h>
#include <cstdio>
#include <cstdint>
#include <cstring>
#include <cmath>
namespace pg8 {
#define PG8_LAS __attribute__((address_space(3)))
typedef unsigned short bf16_t;
typedef short bf16x8 __attribute__((ext_vector_type(8)));
typedef float f32x4 __attribute__((ext_vector_type(4)));
typedef float f32x2 __attribute__((ext_vector_type(2)));
typedef unsigned u32x4 __attribute__((ext_vector_type(4)));
typedef int v4i_t __attribute__((ext_vector_type(4)));
typedef int v8i_t __attribute__((ext_vector_type(8)));
constexpr int BM = 256, BK = 64, HALF = 128, HTB = HALF * BK * 2  , STAGE_BYTES = 8 * HTB, NXCD = 8, WGM = 8;

__host__ __device__ __forceinline__ int lds_byte(int r, int c) { const int st = (r >> 4) * 2 + (c >> 5), rr = r & 15, cc = c & 31, ob = rr * 64 + cc * 2; return st * 1024 + (ob ^ (((ob >> 9) & 1) << 5)); }
__host__ __device__ __forceinline__ void stage_rc(int b, int& R, int& C) { const int st = b / 1024, sb = b % 1024, swz = sb ^ (((sb >> 9) & 1) << 5); R = (st >> 1) * 16 + swz / 64; C = (st & 1) * 32 + (swz % 64) / 2; }
__host__ __device__ __forceinline__ int perm32(int rho) { const int n = rho >> 4, i = rho & 15; return 8 * (i >> 2) + 4 * n + (i & 3); }

struct Unit { int pm, pn, pb, e, lt; };
struct Gemm { const void* A; const void* Bt; int Kb; };

__device__ __forceinline__ bool order_tile(int i, int G, int c, int nM, int nN, int& pm, int& pn) {
    const int nwg = nM * nN; const long L = (long)i * G + c; if (L >= nwg) return false;
    int wgid = (int)L; { const int q = nwg / NXCD, r = nwg % NXCD, xcd = wgid % NXCD, off = wgid / NXCD; wgid = (xcd < r ? xcd * (q + 1) : r * (q + 1) + (xcd - r) * q) + off; }
    const int nig = WGM * nN, gid = wgid / nig, fm = gid * WGM, gsz = (nM - fm) < WGM ? (nM - fm) : WGM;
    pm = fm + ((wgid % nig) % gsz); pn = (wgid % nig) / gsz; return true;
}
struct StaticOrder {
    int nM, nN, G, c;
    __device__ __forceinline__ void init(int M, int N, int G_, int c_) { nM = M / BM; nN = N / BM; G = G_; c = c_; }
    __device__ __forceinline__ bool next(int i, Unit& u) const { int pm, pn; if (!order_tile(i, G, c, nM, nN, pm, pn)) return false; u.pm = pm; u.pn = pn; u.pb = pn; u.e = 0; u.lt = 0; return true; }
};
struct MoeOrder {
    int nM, nN, G, c; const PG8_LAS int* ts;
    __device__ __forceinline__ bool next(int i, Unit& u) const {
        int pm, pn; if (i >= 10 || !order_tile(i, G, c, nM, nN, pm, pn)) return false;
        int e = 0;
#pragma unroll
        for (int j = 1; j < 16; ++j) e += (__builtin_amdgcn_readfirstlane(ts[j]) <= pm) ? 1 : 0;
        e = __builtin_amdgcn_readfirstlane(e); u.pm = pm; u.pn = pn; u.e = e; u.lt = pm - __builtin_amdgcn_readfirstlane(ts[e]); u.pb = e * nN + pn; return true;
    }
};
struct ALinear { __device__ __forceinline__ unsigned off(const Unit& u, int slot, int r, int Kb) const { return (unsigned)(u.pm * BM + r) * (unsigned)Kb; } };
struct APitch  { unsigned pitchB; __device__ __forceinline__ unsigned off(const Unit& u, int slot, int r, int K) const { return (unsigned)(u.pm * BM + r) * pitchB; } };
struct ATable  { const PG8_LAS unsigned* tab; __device__ __forceinline__ unsigned off(const Unit& u, int slot, int r, int K) const { return tab[slot * BM + r]; } };

typedef __bf16 bf16x2_t __attribute__((ext_vector_type(2)));
__device__ __forceinline__ unsigned cvt_pk_bf16(float lo, float hi) { const f32x2 v = {lo, hi}; return __builtin_bit_cast(unsigned, __builtin_convertvector(v, bf16x2_t)); }

typedef f32x4 Acc[2][2][4][2];

typedef __amdgpu_buffer_rsrc_t rsrc_t;
#define PG8_RSRC(p) __builtin_amdgcn_make_buffer_rsrc((void*)(p), 0, 0x7fffffff, 0x00020000)
#ifdef ST16_IMM
__device__ __forceinline__ void st16(rsrc_t r, int vo, int so, u32x4 v) { __builtin_amdgcn_raw_buffer_store_b128(v, r, vo + so, 0, 0); }
#else
__device__ __forceinline__ void st16(rsrc_t r, int vo, int so, u32x4 v) { __builtin_amdgcn_raw_buffer_store_b128(v, r, vo, so, 0); }
#endif
__device__ __forceinline__ f32x4 ld16f(rsrc_t r, int vo, int so) { return __builtin_bit_cast(f32x4, __builtin_amdgcn_raw_buffer_load_b128(r, vo, so, 0)); }
__device__ __forceinline__ float ld4f(rsrc_t r, int vo, int so) { return __uint_as_float(__builtin_amdgcn_raw_buffer_load_b32(r, vo, so, 0)); }
__device__ __forceinline__ u32x4 pack8(const f32x4 v0, const f32x4 v1) { u32x4 w; w.x = cvt_pk_bf16(v0[0], v0[1]); w.y = cvt_pk_bf16(v0[2], v0[3]); w.z = cvt_pk_bf16(v1[0], v1[1]); w.w = cvt_pk_bf16(v1[2], v1[3]); return w; }
struct EpiPlain {
    static constexpr bool PERM = true;
    bf16_t* O; int ldc;
    __device__ __forceinline__ void operator()(const Acc& acc, const Unit& u, int wr, int wc, int fr, int fq) const {
        const rsrc_t ro = PG8_RSRC(O); const int vo = (fr * ldc + wc * 32 + 8 * fq) * 2;
#pragma unroll
        for (int ai = 0; ai < 2; ++ai)
#pragma unroll
            for (int m = 0; m < 4; ++m) { const int so = ((u.pm * BM + wr * 64 + ai * HALF + m * 16) * ldc + u.pn * BM) * 2;
#pragma unroll
                for (int bj = 0; bj < 2; ++bj) st16(ro, vo, so + bj * HALF * 2, pack8(acc[ai][bj][m][0], acc[ai][bj][m][1])); }
    }
};
struct EpiQup {
    static constexpr bool PERM = true;
    bf16_t* O; const float* rstd;
    __device__ __forceinline__ void operator()(const Acc& acc, const Unit& u, int wr, int wc, int fr, int fq) const {
        const rsrc_t ro = PG8_RSRC(O), rr = PG8_RSRC(rstd);
        const int vo = (fr * 1536 + wc * 32 + 8 * fq) * 2;
        float rs[2][4];
#pragma unroll
        for (int ai = 0; ai < 2; ++ai)
#pragma unroll
            for (int m = 0; m < 4; ++m) rs[ai][m] = ld4f(rr, fr * 4, (u.pm * BM + wr * 64 + ai * HALF + m * 16) * 4);
#pragma unroll
        for (int ai = 0; ai < 2; ++ai)
#pragma unroll
            for (int m = 0; m < 4; ++m) { const int rowu = u.pm * BM + wr * 64 + ai * HALF + m * 16; const float r1 = rs[ai][m];
                const int so = (rowu * 1536 + u.pn * BM) * 2;
                st16(ro, vo, so, pack8(acc[ai][0][m][0] * r1, acc[ai][0][m][1] * r1));
                st16(ro, vo, so + HALF * 2, pack8(acc[ai][1][m][0] * r1, acc[ai][1][m][1] * r1)); }
    }
};
struct EpiKVup {
    static constexpr bool PERM = true;
    bf16_t* KF; bf16_t* VB; const float* rstd;
    __device__ __forceinline__ void operator()(const Acc& acc, const Unit& u, int wr, int wc, int fr, int fq) const {
        const rsrc_t rk = PG8_RSRC(KF), rv = PG8_RSRC(VB), rr = PG8_RSRC(rstd);
        const int c0 = wc * 32 + 8 * fq, vok = (fr * 1536 + c0) * 2, vov = (fr * 1024 + c0) * 2;
        float rs[2][4];
#pragma unroll
        for (int ai = 0; ai < 2; ++ai)
#pragma unroll
            for (int m = 0; m < 4; ++m) rs[ai][m] = ld4f(rr, fr * 4, (u.pm * BM + wr * 64 + ai * HALF + m * 16) * 4);
#pragma unroll
        for (int ai = 0; ai < 2; ++ai)
#pragma unroll
            for (int m = 0; m < 4; ++m) { const int rowu = u.pm * BM + wr * 64 + ai * HALF + m * 16; const float r1 = rs[ai][m];
                st16(rk, vok, (rowu * 1536 + u.pn * 192) * 2, pack8(acc[ai][0][m][0] * r1, acc[ai][0][m][1] * r1));
                st16(rv, vov, (rowu * 1024 + u.pn * 128) * 2, pack8(acc[ai][1][m][0] * r1, acc[ai][1][m][1] * r1)); }
    }
};
struct EpiResid {
    static constexpr bool PERM = false;
    const float* base; float* out; const float* gate; int ldc; int gld; float ascale;
    __device__ __forceinline__ void operator()(const Acc& acc, const Unit& u, int wr, int wc, int fr, int fq) const {
        const rsrc_t rb = PG8_RSRC(base), ro = PG8_RSRC(out), rg = PG8_RSRC(gate);
        const int cl = (wc * 32 + 4 * fq) * 4, vo = fr * ldc * 4 + cl;
        f32x4 gv[2][2];
#pragma unroll
        for (int bj = 0; bj < 2; ++bj)
#pragma unroll
            for (int n = 0; n < 2; ++n) gv[bj][n] = ld16f(rg, cl, (((u.pm * BM) >> 13) * gld + u.pn * BM + bj * HALF + n * 16) * 4) * ascale;
#pragma unroll
        for (int ai = 0; ai < 2; ++ai) {
            f32x4 bs[4][2][2];
#pragma unroll
            for (int m = 0; m < 4; ++m) { const int so = ((u.pm * BM + ai * HALF + wr * 64 + m * 16) * ldc + u.pn * BM) * 4;
#pragma unroll
                for (int bj = 0; bj < 2; ++bj)
#pragma unroll
                    for (int n = 0; n < 2; ++n) bs[m][bj][n] = ld16f(rb, vo, so + (bj * HALF + n * 16) * 4); }
#pragma unroll
            for (int m = 0; m < 4; ++m) { const int so = ((u.pm * BM + ai * HALF + wr * 64 + m * 16) * ldc + u.pn * BM) * 4;
#pragma unroll
                for (int bj = 0; bj < 2; ++bj)
#pragma unroll
                    for (int n = 0; n < 2; ++n) st16(ro, vo, so + (bj * HALF + n * 16) * 4, __builtin_bit_cast(u32x4, bs[m][bj][n] + gv[bj][n] * acc[ai][bj][m][n])); }
            asm volatile("s_waitcnt vmcnt(0)" ::: "memory");
        }
    }
};
struct EpiResidB {
    static constexpr bool PERM = true;
    const void* base; bf16_t* out; const float* gate; int gld; float ascale; int BASE_F32;
    __device__ __forceinline__ void operator()(const Acc& acc, const Unit& u, int wr, int wc, int fr, int fq) const {
        const rsrc_t rb = PG8_RSRC(base), ro = PG8_RSRC(out), rg = PG8_RSRC(gate);
        const int c0 = wc * 32 + 8 * fq;
        f32x4 gv[2][2];
#pragma unroll
        for (int bj = 0; bj < 2; ++bj)
#pragma unroll
            for (int n = 0; n < 2; ++n) gv[bj][n] = ld16f(rg, (c0 + 4 * n) * 4, (((u.pm * BM) >> 13) * gld + u.pn * BM + bj * HALF) * 4) * ascale;
#pragma unroll
        for (int ai = 0; ai < 2; ++ai) {
            f32x4 bs[4][2][2];
#pragma unroll
            for (int m = 0; m < 4; ++m) { const int rowu = u.pm * BM + ai * HALF + wr * 64 + m * 16;
#pragma unroll
                for (int bj = 0; bj < 2; ++bj) {
                    if (BASE_F32) { const int so = (rowu * 2048 + u.pn * BM + bj * HALF) * 4, vo = (fr * 2048 + c0) * 4;
                        bs[m][bj][0] = ld16f(rb, vo, so); bs[m][bj][1] = ld16f(rb, vo + 16, so); }
                    else { const int so = (rowu * 2048 + u.pn * BM + bj * HALF) * 2, vo = (fr * 2048 + c0) * 2;
                        const u32x4 w = __builtin_bit_cast(u32x4, __builtin_amdgcn_raw_buffer_load_b128(rb, vo, so, 0));
                        bs[m][bj][0] = (f32x4){__uint_as_float(w.x << 16), __uint_as_float(w.x & 0xffff0000u), __uint_as_float(w.y << 16), __uint_as_float(w.y & 0xffff0000u)};
                        bs[m][bj][1] = (f32x4){__uint_as_float(w.z << 16), __uint_as_float(w.z & 0xffff0000u), __uint_as_float(w.w << 16), __uint_as_float(w.w & 0xffff0000u)}; } } }
#pragma unroll
            for (int m = 0; m < 4; ++m) { const int rowu = u.pm * BM + ai * HALF + wr * 64 + m * 16;
#pragma unroll
                for (int bj = 0; bj < 2; ++bj) st16(ro, (fr * 2048 + c0) * 2, (rowu * 2048 + u.pn * BM + bj * HALF) * 2,
                                                    pack8(bs[m][bj][0] + gv[bj][0] * acc[ai][bj][m][0], bs[m][bj][1] + gv[bj][1] * acc[ai][bj][m][1])); }
            asm volatile("s_waitcnt vmcnt(0)" ::: "memory");
        }
    }
};
struct EpiSwiglu {
    static constexpr bool PERM = true;
    unsigned char* O; int ldc;
    __device__ __forceinline__ void operator()(const Acc& acc, const Unit& u, int wr, int wc, int fr, int fq) const {
        const rsrc_t ro = PG8_RSRC(O); const int vo = fr * ldc + wc * 32 + 8 * fq;
#pragma unroll
        for (int ai = 0; ai < 2; ++ai)
#pragma unroll
            for (int m = 0; m < 4; ++m) { const int so = (u.pm * BM + wr * 64 + ai * HALF + m * 16) * ldc + u.pn * HALF; float r[8];
#pragma unroll
                for (int n = 0; n < 2; ++n)
#pragma unroll
                    for (int k = 0; k < 4; ++k) { const float g = acc[ai][0][m][n][k] * (1.0f / 256.0f), up = acc[ai][1][m][n][k] * (1.0f / 256.0f);
                        r[n * 4 + k] = g * __builtin_amdgcn_rcpf(1.0f + __builtin_amdgcn_exp2f(-1.4426950408889634f * g)) * up; }
                int w0 = 0, w1 = 0;
                w0 = __builtin_amdgcn_cvt_pk_fp8_f32(r[0], r[1], w0, false); w0 = __builtin_amdgcn_cvt_pk_fp8_f32(r[2], r[3], w0, true);
                w1 = __builtin_amdgcn_cvt_pk_fp8_f32(r[4], r[5], w1, false); w1 = __builtin_amdgcn_cvt_pk_fp8_f32(r[6], r[7], w1, true);
                typedef unsigned u32x2_t __attribute__((ext_vector_type(2)));
                __builtin_amdgcn_raw_buffer_store_b64((u32x2_t){(unsigned)w0, (unsigned)w1}, ro, vo, so, 0); }
    }
};
struct EpiMoeDown {
    static constexpr bool PERM = true;
    bf16_t* Y; const int* rowidx; const float* aw; const unsigned* cnt;
    __device__ __forceinline__ void operator()(const Acc& acc, const Unit& u, int wr, int wc, int fr, int fq) const {
        const rsrc_t ry = PG8_RSRC(Y), ri = PG8_RSRC(rowidx), ra = PG8_RSRC(aw);
        const int nvalid = (int)cnt[u.e] - u.lt * BM; const int cb = (u.pn * BM + wc * 32 + 8 * fq) * 2;
        int idx[2][4]; float w8[2][4];
#pragma unroll
        for (int ai = 0; ai < 2; ++ai)
#pragma unroll
            for (int m = 0; m < 4; ++m) { const int ru = ai * HALF + wr * 64 + m * 16; idx[ai][m] = -1; w8[ai][m] = 0.f;
                if (ru + fr < nvalid) { idx[ai][m] = (int)__builtin_amdgcn_raw_buffer_load_b32(ri, fr * 4, (u.e * 32768 + u.lt * BM + ru) * 4, 0); w8[ai][m] = ld4f(ra, idx[ai][m] * 4, 0); } }
#pragma unroll
        for (int ai = 0; ai < 2; ++ai)
#pragma unroll
            for (int m = 0; m < 4; ++m) if (idx[ai][m] >= 0) { const int vo = idx[ai][m] * 4096 + cb; const float w1 = w8[ai][m] * (1.0f / 256.0f);
#pragma unroll
                for (int bj = 0; bj < 2; ++bj) st16(ry, vo, bj * HALF * 2, pack8(acc[ai][bj][m][0] * w1, acc[ai][bj][m][1] * w1)); }
    }
};

template <class Epi, class Sched, class AOff, bool FP8 = false>
__device__ __forceinline__ void gemm_phase(PG8_LAS unsigned char* lds, const Gemm g, const Sched& S, const AOff& AO, const Epi& E, int tid_in) {
    int tid = tid_in; asm volatile("" : "+v"(tid));
    const int wid = __builtin_amdgcn_readfirstlane(tid >> 6), lane = tid & 63, wr = wid >> 2, wc = wid & 3, fr = lane & 15, fq = lane >> 4;
    int K = g.Kb; asm volatile("" : "+s"(K));
    const int nt = K / (BK * 2);
    int Ra[2], Ca[2]; unsigned voffB[2];
#pragma unroll
    for (int i = 0; i < 2; ++i) { int R, C; stage_rc(tid * 16 + i * 8192, R, C); const int Rb = Epi::PERM ? ((R & ~31) + perm32(R & 31)) : R;
        Ra[i] = R; Ca[i] = C * 2; voffB[i] = (unsigned)(Rb * K + C * 2); }
    const size_t kstep = (size_t)(BK * 2);
    const size_t hstep = (size_t)HALF * K;
    const size_t tstep = 2 * hstep;
    const unsigned ldsw = (unsigned)wid * 1024u;
    const unsigned lds0 = (unsigned)(uintptr_t)lds;
    const int aoff = lds_byte(wr * 64 + fr, fq * 8), boff = lds_byte(wc * 32 + fr, fq * 8);
#define PG8_SA(b, h) (((b) * 2 + (h)) * HTB)
#define PG8_SB(b, h) ((4 + (b) * 2 + (h)) * HTB)
#define PG8_STAGE(bufoff, gbase, voff) do { _Pragma("unroll") for (int _i = 0; _i < 2; ++_i) { unsigned keep_; \
        asm volatile("s_mov_b32 %0, m0\n\ts_mov_b32 m0, %2\n\ts_nop 0\n\tglobal_load_lds_dwordx4 %1, %3\n\ts_mov_b32 m0, %0" : "=&s"(keep_) \
            : "v"((voff)[_i]), "s"((unsigned)__builtin_amdgcn_readfirstlane((int)(lds0 + (bufoff) + ldsw + _i * 8192))), "s"((const void*)(gbase)) : "memory"); } } while (0)
#define PG8_LD8(addr) __builtin_shufflevector(*(const PG8_LAS v4i_t*)(addr), *(const PG8_LAS v4i_t*)((addr) + 1024), 0, 1, 2, 3, 4, 5, 6, 7)
#define PG8_LDA(dst, b, h) do { _Pragma("unroll") for (int m = 0; m < 4; ++m) dst[m] = PG8_LD8(lds + PG8_SA(b, h) + aoff + m * 2048); } while (0)
#define PG8_LDB(dst, b, h) do { _Pragma("unroll") for (int n = 0; n < 2; ++n) dst[n] = PG8_LD8(lds + PG8_SB(b, h) + boff + n * 2048); } while (0)
#define PG8_HALF(x, k) __builtin_bit_cast(bf16x8, __builtin_shufflevector(x, x, 4 * (k), 4 * (k) + 1, 4 * (k) + 2, 4 * (k) + 3))
#define PG8_MMA(ai, bj, At, Bt) do { __builtin_amdgcn_s_setprio(1); _Pragma("unroll") for (int m = 0; m < 4; ++m) _Pragma("unroll") for (int n = 0; n < 2; ++n) { \
        if constexpr (FP8) asm volatile("v_mfma_scale_f32_16x16x128_f8f6f4 %0, %1, %2, %0, %3, %3 op_sel_hi:[0,0,0]" : "+v"(acc[ai][bj][m][n]) : "v"(Bt[n]), "v"(At[m]), "v"(sc1_));   \
        else { acc[ai][bj][m][n] = __builtin_amdgcn_mfma_f32_16x16x32_bf16(PG8_HALF(Bt[n], 0), PG8_HALF(At[m], 0), acc[ai][bj][m][n], 0, 0, 0); \
               acc[ai][bj][m][n] = __builtin_amdgcn_mfma_f32_16x16x32_bf16(PG8_HALF(Bt[n], 1), PG8_HALF(At[m], 1), acc[ai][bj][m][n], 0, 0, 0); } } \
        __builtin_amdgcn_s_setprio(0); } while (0)
#define PG8_WAIT_V(n) asm volatile("s_waitcnt vmcnt(" #n ")" ::: "memory")
#define PG8_WAIT_L(n) asm volatile("s_waitcnt lgkmcnt(" #n ")" ::: "memory")
#define PG8_BAR __builtin_amdgcn_s_barrier()
#define PG8_SCHED __builtin_amdgcn_sched_barrier(0)
#define PG8_AOFF(dst, u, slot) do { _Pragma("unroll") for (int _h = 0; _h < 2; ++_h) _Pragma("unroll") for (int _i = 0; _i < 2; ++_i) dst[_h][_i] = AO.off(u, slot, _h * HALF + Ra[_i], K) + (unsigned)Ca[_i]; } while (0)
    Unit cur, nxt; int ui = 0;
    if (!S.next(0, cur)) return;
    Acc acc;
#pragma unroll
    for (int a = 0; a < 2; ++a)
#pragma unroll
        for (int b = 0; b < 2; ++b)
#pragma unroll
            for (int m = 0; m < 4; ++m)
#pragma unroll
                for (int n = 0; n < 2; ++n) acc[a][b][m][n] = (f32x4){0.f, 0.f, 0.f, 0.f};
    v8i_t At[4], B0[2], B1[2];
    int sc1_ = 0x7F7F7F7F; asm volatile("" : "+v"(sc1_));
    unsigned aoC[2][2];
    PG8_AOFF(aoC, cur, 0);
    const char* gA = (const char*)g.A; const char* gB = (const char*)g.Bt;
    asm volatile("" : "+s"(gA), "+s"(gB));
    const char* cB = gB + (size_t)cur.pb * tstep;
    PG8_STAGE(PG8_SB(0, 0), cB, voffB); PG8_STAGE(PG8_SB(0, 1), cB + hstep, voffB); PG8_STAGE(PG8_SA(0, 0), gA, aoC[0]); PG8_STAGE(PG8_SA(0, 1), gA, aoC[1]);
    if (wr == 1) PG8_BAR;
    PG8_WAIT_V(2); PG8_BAR;
    PG8_STAGE(PG8_SB(1, 0), cB + kstep, voffB); PG8_STAGE(PG8_SA(1, 0), gA + kstep, aoC[0]); PG8_STAGE(PG8_SB(1, 1), cB + hstep + kstep, voffB);
    PG8_WAIT_V(6); PG8_BAR;
    for (;;) {
        const bool has_next = S.next(ui + 1, nxt);
        const char* nB = has_next ? gB + (size_t)nxt.pb * tstep : cB;
        for (int t = 0; t < nt; t += 2) {
            const bool last = (t == nt - 2);
            const char* a1 = gA + (size_t)(t + 1) * kstep;
            const char* a2 = last ? gA : gA + (size_t)(t + 2) * kstep; const char* b2 = last ? nB : cB + (size_t)(t + 2) * kstep;
            const char* a3 = a2 + kstep; const char* b3 = b2 + kstep;
            unsigned ao2[2][2];
            if (last && has_next) { PG8_AOFF(ao2, nxt, ui + 1); }
            else {
#pragma unroll
                for (int _h = 0; _h < 2; ++_h)
#pragma unroll
                    for (int _i = 0; _i < 2; ++_i) ao2[_h][_i] = aoC[_h][_i]; }
            PG8_LDB(B0, 0, 0); PG8_LDB(B1, 0, 1); PG8_SCHED; PG8_LDA(At, 0, 0); PG8_STAGE(PG8_SA(1, 1), a1, aoC[1]);
            PG8_WAIT_V(8); PG8_WAIT_L(0); PG8_BAR; PG8_MMA(0, 0, At, B0); PG8_MMA(0, 1, At, B1); PG8_BAR; PG8_SCHED;
            PG8_LDA(At, 0, 1); PG8_STAGE(PG8_SB(0, 0), b2, voffB); PG8_STAGE(PG8_SB(0, 1), b2 + hstep, voffB); PG8_STAGE(PG8_SA(0, 0), a2, ao2[0]);
            PG8_WAIT_V(8); PG8_WAIT_L(0); PG8_BAR; PG8_MMA(1, 0, At, B0); PG8_MMA(1, 1, At, B1); PG8_BAR; PG8_SCHED;
            PG8_LDB(B0, 1, 0); PG8_LDB(B1, 1, 1); PG8_SCHED; PG8_LDA(At, 1, 0); PG8_STAGE(PG8_SA(0, 1), a2, ao2[1]);
            PG8_WAIT_V(8); PG8_WAIT_L(0); PG8_BAR; PG8_MMA(0, 0, At, B0); PG8_MMA(0, 1, At, B1); PG8_BAR; PG8_SCHED;
            PG8_LDA(At, 1, 1); PG8_STAGE(PG8_SB(1, 0), b3, voffB); PG8_STAGE(PG8_SB(1, 1), b3 + hstep, voffB); PG8_STAGE(PG8_SA(1, 0), a3, ao2[0]);
            PG8_WAIT_V(8); PG8_WAIT_L(0); PG8_BAR; PG8_MMA(1, 0, At, B0); PG8_MMA(1, 1, At, B1); PG8_BAR; PG8_SCHED;
        }
        if (wr == 0) PG8_BAR;
        E(acc, cur, wr, wc, fr, fq);
        if (!has_next) break;
#pragma unroll
        for (int a = 0; a < 2; ++a)
#pragma unroll
            for (int b = 0; b < 2; ++b)
#pragma unroll
                for (int m = 0; m < 4; ++m)
#pragma unroll
                    for (int n = 0; n < 2; ++n) acc[a][b][m][n] = (f32x4){0.f, 0.f, 0.f, 0.f};
        cur = nxt; cB = nB; ++ui;
        PG8_AOFF(aoC, cur, ui);
        if (wr == 1) PG8_BAR;
    }
    PG8_WAIT_V(0);
    PG8_BAR;
#undef PG8_SA
#undef PG8_SB
#undef PG8_STAGE
#undef PG8_LDA
#undef PG8_LDB
#undef PG8_MMA
#undef PG8_LD8
#undef PG8_HALF
#undef PG8_WAIT_V
#undef PG8_WAIT_L
#undef PG8_BAR
#undef PG8_SCHED
#undef PG8_AOFF
}
}
namespace att {
typedef unsigned short bf16;
typedef short bf16x8 __attribute__((ext_vector_type(8)));
typedef short s16x4 __attribute__((ext_vector_type(4)));
typedef float f32x16 __attribute__((ext_vector_type(16)));
typedef float f32x4 __attribute__((ext_vector_type(4)));
typedef unsigned u32x4 __attribute__((ext_vector_type(4)));
constexpr int NW = 8, QBLK = 32, KVBLK = 64, QB = NW * QBLK, DV = 128;
constexpr float THR = 8.f;
constexpr int SHM_V = KVBLK * DV * 2;
template <int DQK> struct Cfg { static constexpr int NKC = DQK / 8, KCH = NKC / 8, KPITCH = DQK * 2, SHM_K = KVBLK * KPITCH, NQF = DQK / 16, LDS_BYTES = 2 * SHM_V + 2 * SHM_K + NW * 64 * 4; };
#define SBAR() __builtin_amdgcn_sched_barrier(0)
__device__ __forceinline__ int v_st(int k, int c) { const int kk = (k & ~0xC) | ((k & 4) << 1) | ((k & 8) >> 1); return ((kk >> 3) * 4 + (c >> 5)) * 512 + ((kk & 7) * 32 + (c & 31)) * 2; }
__device__ __forceinline__ int v_rd_base(int lane) { return ((lane & 3) << 3) | (((lane >> 2) & 3) << 6) | (((lane >> 4) & 1) << 5) | (((lane >> 5) & 1) << 8); }
constexpr int v_rd_off(int d0, int ks, int half) { return d0 * 512 + ks * 4096 + half * 2048; }
__device__ __forceinline__ int crow(int r, int hi) { return (r & 3) + 8 * (r >> 2) + 4 * hi; }
__device__ __forceinline__ unsigned cvtpk(float lo, float hi) { return pg8::cvt_pk_bf16(lo, hi); }
__device__ __forceinline__ bf16x8 load8(const bf16* p) { return *reinterpret_cast<const bf16x8*>(p); }
__device__ __forceinline__ void mask_tile(f32x16& p0, f32x16& p1, int dq, unsigned W) {
    const float NEG = -__builtin_inff();
#pragma unroll
    for (int r = 0; r < 16; ++r) { const int c = (r & 3) + 8 * (r >> 2);
        if ((unsigned)(dq - c) >= W) p0[r] = NEG;
        if ((unsigned)(dq - c - 32) >= W) p1[r] = NEG; }
}
__device__ __forceinline__ void partialSM(f32x16& p0, f32x16& p1, float& m_reg, float& mn, float& alpha, float scale) {
    float pmax = p0[0];
#pragma unroll
    for (int r = 1; r < 16; ++r) pmax = fmaxf(pmax, p0[r]);
#pragma unroll
    for (int r = 0; r < 16; ++r) pmax = fmaxf(pmax, p1[r]);
    { auto rr = __builtin_amdgcn_permlane32_swap(__float_as_uint(pmax), __float_as_uint(pmax), false, false);
      pmax = fmaxf(__uint_as_float(rr[0]), __uint_as_float(rr[1])); }
    const float C2 = 1.4426950408889634f * scale;
    if (__builtin_expect(__all((pmax - m_reg) * scale <= THR), 1)) { mn = m_reg; alpha = 1.f; }
    else { mn = fmaxf(m_reg, pmax); alpha = __builtin_amdgcn_exp2f((m_reg - mn) * C2); m_reg = mn; }
    const float mnL = -mn * C2;
#pragma unroll
    for (int r = 0; r < 16; ++r) p0[r] = fmaf(p0[r], C2, mnL);
#pragma unroll
    for (int r = 0; r < 16; ++r) p1[r] = fmaf(p1[r], C2, mnL);
#pragma unroll
    for (int r = 0; r < 16; ++r) p0[r] = __builtin_amdgcn_exp2f(p0[r]);
}
__device__ __forceinline__ void finishSM(f32x16& p0, f32x16& p1, float alpha, float& l_reg, bf16x8& pa0, bf16x8& pa1, bf16x8& pa2, bf16x8& pa3) {
#pragma unroll
    for (int r = 0; r < 16; ++r) p1[r] = __builtin_amdgcn_exp2f(p1[r]);
    float ps = 0;
#pragma unroll
    for (int r = 0; r < 16; ++r) ps += p0[r];
#pragma unroll
    for (int r = 0; r < 16; ++r) ps += p1[r];
    { auto rr = __builtin_amdgcn_permlane32_swap(__float_as_uint(ps), __float_as_uint(ps), false, false);
      ps = __uint_as_float(rr[0]) + __uint_as_float(rr[1]); }
    l_reg = l_reg * alpha + ps;
#define PK4(P, B_, OUT) do { unsigned a0 = cvtpk(P[B_+0], P[B_+1]), a1 = cvtpk(P[B_+2], P[B_+3]);                          \
        unsigned b0 = cvtpk(P[B_+4], P[B_+5]), b1 = cvtpk(P[B_+6], P[B_+7]);                                             \
        auto r0 = __builtin_amdgcn_permlane32_swap(a0, b0, false, false); auto r1 = __builtin_amdgcn_permlane32_swap(a1, b1, false, false); \
        u32x4 w = {r0[0], r1[0], r0[1], r1[1]}; OUT = *reinterpret_cast<bf16x8*>(&w); } while (0)
    PK4(p0, 0, pa0); PK4(p0, 8, pa1); PK4(p1, 0, pa2); PK4(p1, 8, pa3);
#undef PK4
}
template <int KB, bool SK, int DQK, bool DIL>
__device__ __forceinline__ void qkt(f32x16& p0, f32x16& p1, const char* K_lds, int r32, int hi, const bf16x8* qr, bool act, float beta, int dq) {
    typedef Cfg<DQK> C;
    if (SK && !act) { const float NEG = -__builtin_inff();
#pragma unroll
        for (int r = 0; r < 16; ++r) { p0[r] = NEG; p1[r] = NEG; } return; }
    if constexpr (DIL) { const float b0 = -beta * (float)dq;
#pragma unroll
        for (int r = 0; r < 16; ++r) { const int c = (r & 3) + 8 * (r >> 2); p0[r] = fmaf(beta, (float)c, b0); p1[r] = fmaf(beta, (float)(c + 32), b0); } }
    else { p0 = f32x16{}; p1 = f32x16{}; }
    const char* kb[4];
#pragma unroll
    for (int dd = 0; dd < 4; ++dd) { const int colB = (dd * 16 + hi * 8) * 2; kb[dd] = K_lds + KB * C::SHM_K + r32 * C::KPITCH + (colB ^ ((r32 & 7) << 4)); }
#pragma unroll
    for (int d0 = 0; d0 < C::NQF; ++d0) { const char* a = kb[d0 & 3] + (d0 >> 2) * 128;
        bf16x8 b0 = *reinterpret_cast<const bf16x8*>(a);
        bf16x8 b1 = *reinterpret_cast<const bf16x8*>(a + 32 * C::KPITCH);
        p0 = __builtin_amdgcn_mfma_f32_32x32x16_bf16(b0, qr[d0], p0, 0, 0, 0);
        p1 = __builtin_amdgcn_mfma_f32_32x32x16_bf16(b1, qr[d0], p1, 0, 0, 0);
#ifndef ATT_NO_QKT_SBAR
        if ((d0 & 3) == 3) SBAR();
#endif
    }
}
#ifdef ATT_PV_PIPE
template <int VB, bool SK>
__device__ __forceinline__ void pv_tile(f32x16* o, int vb0, bf16x8 pa0, bf16x8 pa1, bf16x8 pa2, bf16x8 pa3, bool act) {
    if (SK && !act) return;
#define TRRD(dst, off) asm volatile("ds_read_b64_tr_b16 %0, %1 offset:%2" : "=&v"(dst) : "v"(vb0), "i"(off) : "memory")
#define PV_RD(S_, d0) do { constexpr int b_ = VB * SHM_V + v_rd_off(d0, 0, 0); \
        TRRD(S_##l0, b_); TRRD(S_##h0, b_ + 2048); TRRD(S_##l1, b_ + 4096); TRRD(S_##h1, b_ + 6144); TRRD(S_##l2, b_ + 8192); TRRD(S_##h2, b_ + 10240); TRRD(S_##l3, b_ + 12288); TRRD(S_##h3, b_ + 14336); } while (0)
#define PV_MM(S_, d0) do { \
        o[d0] = __builtin_amdgcn_mfma_f32_32x32x16_bf16(pa0, (bf16x8){S_##l0[0], S_##l0[1], S_##l0[2], S_##l0[3], S_##h0[0], S_##h0[1], S_##h0[2], S_##h0[3]}, o[d0], 0, 0, 0);   \
        o[d0] = __builtin_amdgcn_mfma_f32_32x32x16_bf16(pa1, (bf16x8){S_##l1[0], S_##l1[1], S_##l1[2], S_##l1[3], S_##h1[0], S_##h1[1], S_##h1[2], S_##h1[3]}, o[d0], 0, 0, 0);   \
        o[d0] = __builtin_amdgcn_mfma_f32_32x32x16_bf16(pa2, (bf16x8){S_##l2[0], S_##l2[1], S_##l2[2], S_##l2[3], S_##h2[0], S_##h2[1], S_##h2[2], S_##h2[3]}, o[d0], 0, 0, 0);   \
        o[d0] = __builtin_amdgcn_mfma_f32_32x32x16_bf16(pa3, (bf16x8){S_##l3[0], S_##l3[1], S_##l3[2], S_##l3[3], S_##h3[0], S_##h3[1], S_##h3[2], S_##h3[3]}, o[d0], 0, 0, 0); } while (0)
#define PV_W8() do { asm volatile("s_waitcnt lgkmcnt(8)" ::: "memory"); SBAR(); } while (0)
#define PV_W0() do { asm volatile("s_waitcnt lgkmcnt(0)" ::: "memory"); SBAR(); } while (0)
    s16x4 al0, al1, al2, al3, ah0, ah1, ah2, ah3, bl0, bl1, bl2, bl3, bh0, bh1, bh2, bh3;
    PV_RD(a, 0); PV_RD(b, 1); PV_W8(); PV_MM(a, 0); SBAR();
    PV_RD(a, 2); PV_W8(); PV_MM(b, 1); SBAR();
    PV_RD(b, 3); PV_W8(); PV_MM(a, 2); SBAR();
    PV_W0(); PV_MM(b, 3);
#undef PV_RD
#undef PV_MM
#undef PV_W8
#undef PV_W0
#undef TRRD
}
#else
template <int VB, bool SK>
__device__ __forceinline__ void pv_tile(f32x16* o, int vb0, bf16x8 pa0, bf16x8 pa1, bf16x8 pa2, bf16x8 pa3, bool act) {
    if (SK && !act) return;
#define TRRD(dst, off) asm volatile("ds_read_b64_tr_b16 %0, %1 offset:%2" : "=&v"(dst) : "v"(vb0), "i"(off) : "memory")
#define PV_D0(d0) do { s16x4 l0, l1, l2, l3, h0, h1, h2, h3; constexpr int b_ = VB * SHM_V + v_rd_off(d0, 0, 0); \
        TRRD(l0, b_); TRRD(h0, b_ + 2048); TRRD(l1, b_ + 4096); TRRD(h1, b_ + 6144); TRRD(l2, b_ + 8192); TRRD(h2, b_ + 10240); TRRD(l3, b_ + 12288); TRRD(h3, b_ + 14336); \
        asm volatile("s_waitcnt lgkmcnt(0)" ::: "memory"); SBAR();   \
        o[d0] = __builtin_amdgcn_mfma_f32_32x32x16_bf16(pa0, (bf16x8){l0[0], l0[1], l0[2], l0[3], h0[0], h0[1], h0[2], h0[3]}, o[d0], 0, 0, 0);   \
        o[d0] = __builtin_amdgcn_mfma_f32_32x32x16_bf16(pa1, (bf16x8){l1[0], l1[1], l1[2], l1[3], h1[0], h1[1], h1[2], h1[3]}, o[d0], 0, 0, 0);   \
        o[d0] = __builtin_amdgcn_mfma_f32_32x32x16_bf16(pa2, (bf16x8){l2[0], l2[1], l2[2], l2[3], h2[0], h2[1], h2[2], h2[3]}, o[d0], 0, 0, 0);   \
        o[d0] = __builtin_amdgcn_mfma_f32_32x32x16_bf16(pa3, (bf16x8){l3[0], l3[1], l3[2], l3[3], h3[0], h3[1], h3[2], h3[3]}, o[d0], 0, 0, 0); } while (0)
    PV_D0(0); PV_D0(1); PV_D0(2); PV_D0(3);
#undef PV_D0
#undef TRRD
}
#endif

struct Blk { unsigned qo, ko, vo, oo, lo; int P0, rate; float beta; };
constexpr int PVAR = 0;
#define QS_(B) (DIL ? ((PVAR & 4) ? 128 : (B).rate * 4096) : 1536)
#define KS_(B) (DIL ? ((PVAR & 2) ? 128 : (B).rate * 4096) : 1536)
#define VS_(B) (DIL ? ((PVAR & 2) ? 128 : (B).rate * 4096) : 1024)
#define OS_(B) (DIL ? (B).rate * 1024 : 1024)
#define LS_(B) ((B).rate * 8)
#define SKV_(B) (DIL ? 8192 / (B).rate : 8192)
#define W_(B) (DIL ? 129 : (1 << 30))
#define SCALE_ (DIL ? 0.08838834764831845f : 0.07216878364870322f)
template <int DQK> struct Seam { bf16x8 qr[Cfg<DQK>::NQF]; bf16x8 st_v0, st_v1; bf16x8 st_k[Cfg<DQK>::KCH]; unsigned p_oo = 0; int p_rb = 0, p_so0 = 0, p_on = 0; float cv[4], cw[4]; int cv_j = 0, cv_q = 0, cl_j = 0, cl_q = 0; f32x4 rt[8]; float cvf[32]; int cv_pend = 0; };
__device__ __forceinline__ int swa_jlo(int P0, int W) { const int lowk = P0 - W + 1; return lowk > 0 ? lowk / KVBLK : 0; }

#define VMW() asm volatile("s_waitcnt vmcnt(0)" ::: "memory")
#ifdef ATT_RAWBAR
#define A_STEPBAR() do { asm volatile("s_waitcnt lgkmcnt(0)" ::: "memory"); __builtin_amdgcn_s_barrier(); asm volatile("" ::: "memory"); } while (0)
#else
#define A_STEPBAR() __syncthreads()
#endif
#define VMWN(n) asm volatile("s_waitcnt vmcnt(%0)" :: "i"(n) : "memory")
#define A_RSRC(p) __builtin_amdgcn_make_buffer_rsrc((void*)(p), 0, 0x7fffffff, 0x00020000)
#define A_BLD(rs, vo, so) __builtin_bit_cast(bf16x8, __builtin_amdgcn_raw_buffer_load_b128((rs), (int)(vo), (int)(so), 0))
#ifdef ATT_SLOAD_RECOMP
#define A_SLOAD(B_, k0) do { const __amdgpu_buffer_rsrc_t rv_ = A_RSRC(wsb + (B_).vo), rk_ = A_RSRC(wsb + (B_).ko); const int sov_ = (k0) * VS_(B_) * 2, sok_ = (k0) * KS_(B_) * 2; \
        int t_ = tid; asm volatile("" : "+v"(t_)); const int sr_ = t_ >> 4, sc_ = (t_ & 15) * 8; \
        S.st_v0 = A_BLD(rv_, (sr_ * VS_(B_) + sc_) * 2, sov_); S.st_v1 = A_BLD(rv_, ((32 + sr_) * VS_(B_) + sc_) * 2, sov_); \
        _Pragma("unroll") for (int j_ = 0; j_ < C::KCH; ++j_) { const int q_ = t_ + 512 * j_; S.st_k[j_] = A_BLD(rk_, ((q_ / C::NKC) * KS_(B_) + (q_ % C::NKC) * 8) * 2, sok_); } } while (0)
#else
#define A_SLOAD(B_, k0) do { const __amdgpu_buffer_rsrc_t rv_ = A_RSRC(wsb + (B_).vo), rk_ = A_RSRC(wsb + (B_).ko); const int sov_ = (k0) * VS_(B_) * 2, sok_ = (k0) * KS_(B_) * 2; \
        S.st_v0 = A_BLD(rv_, (sr * VS_(B_) + sc) * 2, sov_); S.st_v1 = A_BLD(rv_, ((32 + sr) * VS_(B_) + sc) * 2, sov_); \
        _Pragma("unroll") for (int j_ = 0; j_ < C::KCH; ++j_) S.st_k[j_] = A_BLD(rk_, (krow[j_] * KS_(B_) + kcol[j_]) * 2, sok_); } while (0)
#endif
#define A_QLOAD(B_) do { const __amdgpu_buffer_rsrc_t rq_ = A_RSRC(wsb + (B_).qo); const int soq_ = ((B_).P0 + wid * QBLK) * QS_(B_) * 2; const int qo_ = r32 * QS_(B_) * 2 + hi * 16; \
        _Pragma("unroll") for (int d0 = 0; d0 < C::NQF; ++d0) S.qr[d0] = A_BLD(rq_, qo_ + d0 * 32, soq_); } while (0)
#define A_SWRITE_K(bf) do { _Pragma("unroll") for (int j_ = 0; j_ < C::KCH; ++j_) *(bf16x8*)(K_lds + (bf) * C::SHM_K + kws[j_]) = S.st_k[j_]; } while (0)
#define A_SWRITE_V(bf) do { *(bf16x8*)(V_lds + (bf) * SHM_V + vst0) = S.st_v0; *(bf16x8*)(V_lds + (bf) * SHM_V + vst1) = S.st_v1; } while (0)
#define A_STAGE_IDX() const int sr = tid >> 4, sc = (tid & 15) * 8; int krow[C::KCH], kcol[C::KCH], kws[C::KCH]; \
        _Pragma("unroll") for (int j_ = 0; j_ < C::KCH; ++j_) { const int q_ = tid + 512 * j_; krow[j_] = q_ / C::NKC; kcol[j_] = (q_ % C::NKC) * 8; kws[j_] = krow[j_] * C::KPITCH + ((kcol[j_] * 2) ^ ((krow[j_] & 7) << 4)); }

__device__ __forceinline__ void store_o_staged(const f32x16* o, const float* rli, char* stg, __amdgpu_buffer_rsrc_t ro_, int rowbytes, int so0_, int lane) {
    const int r32 = lane & 31, hi = lane >> 5, odd = lane & 1, g = odd | (hi << 1);
    char* wb = stg + (odd + 4 * hi) * 256 + (r32 >> 1) * 4;
    char* wa[4];
#pragma unroll
    for (int d0 = 0; d0 < 4; ++d0) wa[d0] = wb + ((d0 ^ g) << 6);
    const int lr = lane >> 4, ch = lane & 15, sp = ch >> 2, gl = lr & 1;
    const char* rb_e = stg + lr * 256 + ((sp ^ gl) << 6) + (lane & 3) * 16;
    const char* rb_o = stg + lr * 256 + ((sp ^ (gl | 2)) << 6) + (lane & 3) * 16;
    const int voff = lr * rowbytes + ch * 16;
#pragma unroll
    for (int h = 0; h < 2; ++h) {
#pragma unroll
        for (int rp = 0; rp < 4; ++rp) { const int r = 8 * h + 2 * rp, Rl = (r & 3) + 8 * ((r >> 2) & 1);
#pragma unroll
            for (int d0 = 0; d0 < 4; ++d0) { const float v0 = o[d0][r] * rli[r], v1 = o[d0][r + 1] * rli[r + 1];
                const float send = odd ? v0 : v1;
                const float recv = __int_as_float(__builtin_amdgcn_update_dpp(0, __float_as_int(send), 0xB1, 0xF, 0xF, true));
                *reinterpret_cast<unsigned*>(wa[d0] + Rl * 256) = cvtpk(odd ? recv : v0, odd ? v1 : recv); } }
        u32x4 d_[4];
#pragma unroll
        for (int i = 0; i < 4; ++i) d_[i] = *reinterpret_cast<const u32x4*>(((i & 1) ? rb_o : rb_e) + i * 1024);
#pragma unroll
        for (int i = 0; i < 4; ++i) __builtin_amdgcn_raw_buffer_store_b128(d_[i], ro_, voff + so0_ + (16 * h + 4 * i) * rowbytes, 0, 0);
    }
}
constexpr int DEFER_STG = 65536, DEFER_WS = 131072 + 512;
__device__ __forceinline__ void stage_write(const f32x16* o, const float* rli, char* stg, int lane) {
    const int r32 = lane & 31, hi = lane >> 5, odd = lane & 1, g = odd | (hi << 1);
    char* wb = stg + (odd + 4 * hi) * 256 + (r32 >> 1) * 4;
    char* wa[4];
#pragma unroll
    for (int d0 = 0; d0 < 4; ++d0) wa[d0] = wb + ((d0 ^ g) << 6);
#pragma unroll
    for (int h = 0; h < 2; ++h)
#pragma unroll
        for (int rp = 0; rp < 4; ++rp) { const int r = 8 * h + 2 * rp, Rl = (r & 3) + 8 * ((r >> 2) & 1);
#pragma unroll
            for (int d0 = 0; d0 < 4; ++d0) { const float v0 = o[d0][r] * rli[r], v1 = o[d0][r + 1] * rli[r + 1];
                const float send = odd ? v0 : v1;
                const float recv = __int_as_float(__builtin_amdgcn_update_dpp(0, __float_as_int(send), 0xB1, 0xF, 0xF, true));
                *reinterpret_cast<unsigned*>(wa[d0] + h * 4096 + Rl * 256) = cvtpk(odd ? recv : v0, odd ? v1 : recv); } }
}
__device__ __forceinline__ void flush_piece(const char* stg, int p, const char* obase, int rowbytes, int so0, int lane) {
    const int lr = lane >> 4, ch = lane & 15, sp = ch >> 2, g = (lr & 1) | ((p & 1) << 1);
    const u32x4 d = *reinterpret_cast<const u32x4*>(stg + p * 1024 + lr * 256 + ((sp ^ g) << 6) + (lane & 3) * 16);
    __builtin_amdgcn_raw_buffer_store_b128(d, A_RSRC(obase), lr * rowbytes + ch * 16 + so0 + 4 * p * rowbytes, 0, 0);
}
struct ConvCtx { const float* eg; const float* eu; const float* ed; unsigned char* w13; unsigned char* w2; int gw; };
constexpr int CONV_SCR = 86016, CONV_NJ = 48;
#ifndef CONV_AUX
#define CONV_AUX 2
#endif
struct ConvItem { const float* src; unsigned char* dst; int ldw, kd; };
__device__ __forceinline__ ConvItem conv_decode(const ConvCtx& X, int j) {
    const int q = X.gw + 2048 * j, e = q / 6144, r = q - e * 6144, m = r >> 11, r2 = r & 2047;
    ConvItem I;
    if (m < 2) { const int kb = r2 >> 6, nb = r2 & 63, n0 = nb * 16; I.ldw = 1024; I.kd = 2048;
        I.src = (m == 0 ? X.eg : X.eu) + (size_t)e * (2048 * 1024) + (size_t)kb * (64 * 1024) + n0;
        I.dst = X.w13 + (size_t)e * (2048 * 2048) + (size_t)((n0 >> 7) * 256 + (m == 1 ? 128 : 0) + (n0 & 127)) * 2048 + kb * 64; }
    else { const int kb = r2 >> 7, nb = r2 & 127; I.ldw = 2048; I.kd = 1024;
        I.src = X.ed + (size_t)e * (1024 * 2048) + (size_t)kb * (64 * 2048) + nb * 16;
        I.dst = X.w2 + (size_t)e * (2048 * 1024) + (size_t)(nb * 16) * 1024 + kb * 64; }
    return I;
}
__device__ __forceinline__ void conv_load(const ConvCtx& X, int j, int qd, float* cv, int lane) {
    const ConvItem I = conv_decode(X, j); const __amdgpu_buffer_rsrc_t rs = A_RSRC(I.src);
#pragma unroll
    for (int i = 0; i < 4; ++i) { const int k = 4 * (4 * qd + i) + (lane >> 4);
        cv[i] = __uint_as_float(__builtin_amdgcn_raw_buffer_load_b32(rs, (k * I.ldw + (lane & 15)) * 4, 0, CONV_AUX)); }
}
__device__ __forceinline__ void conv_put(const ConvCtx& X, int j, int qd, const float* cv, char* scr, int lane, bool finish_only = false) {
    float* s = reinterpret_cast<float*>(scr);
    if (!finish_only) {
#pragma unroll
    for (int i = 0; i < 4; ++i) { const int k = 4 * (4 * qd + i) + (lane >> 4); s[k * 17 + (lane & 15)] = cv[i] * 256.0f; } }
    if (qd == 3) {
        const ConvItem I = conv_decode(X, j); const int n = lane & 15, kq = lane >> 4; const float* c = s + (16 * kq) * 17 + n;
        u32x4 w;
        { int w0 = 0, w1 = 0, w2 = 0, w3 = 0;
          w0 = __builtin_amdgcn_cvt_pk_fp8_f32(c[0 * 17], c[1 * 17], w0, false); w0 = __builtin_amdgcn_cvt_pk_fp8_f32(c[2 * 17], c[3 * 17], w0, true);
          w1 = __builtin_amdgcn_cvt_pk_fp8_f32(c[4 * 17], c[5 * 17], w1, false); w1 = __builtin_amdgcn_cvt_pk_fp8_f32(c[6 * 17], c[7 * 17], w1, true);
          w2 = __builtin_amdgcn_cvt_pk_fp8_f32(c[8 * 17], c[9 * 17], w2, false); w2 = __builtin_amdgcn_cvt_pk_fp8_f32(c[10 * 17], c[11 * 17], w2, true);
          w3 = __builtin_amdgcn_cvt_pk_fp8_f32(c[12 * 17], c[13 * 17], w3, false); w3 = __builtin_amdgcn_cvt_pk_fp8_f32(c[14 * 17], c[15 * 17], w3, true);
          w = (u32x4){(unsigned)w0, (unsigned)w1, (unsigned)w2, (unsigned)w3}; }
        __builtin_amdgcn_raw_buffer_store_b128(w, A_RSRC(I.dst), n * I.kd + 16 * kq, 0, CONV_AUX);
    }
}
constexpr unsigned ROPE_OFF = 2u << 20;
#define A_RTLOAD(B_) do { const __amdgpu_buffer_rsrc_t rr_ = A_RSRC(wsb + ROPE_OFF); const int vo_ = ((B_).P0 + wid * QBLK + r32) * 256 + hi * 32; \
        _Pragma("unroll") for (int d_ = 0; d_ < 4; ++d_) { S.rt[2 * d_] = __builtin_bit_cast(f32x4, __builtin_amdgcn_raw_buffer_load_b128(rr_, vo_ + d_ * 64, 0, 0)); \
                                                            S.rt[2 * d_ + 1] = __builtin_bit_cast(f32x4, __builtin_amdgcn_raw_buffer_load_b128(rr_, vo_ + d_ * 64 + 16, 0, 0)); } } while (0)
__device__ __forceinline__ unsigned rope_pair(unsigned w, float c, float s) { const float x1 = __uint_as_float(w << 16), x2 = __uint_as_float(w & 0xffff0000u); return cvtpk(x1 * c - x2 * s, x2 * c + x1 * s); }
#define A_ROTATE() do { _Pragma("unroll") for (int d_ = 0; d_ < 4; ++d_) { u32x4 w_ = __builtin_bit_cast(u32x4, S.qr[8 + d_]); const f32x4 c01_ = S.rt[2 * d_], c23_ = S.rt[2 * d_ + 1]; \
        w_.x = rope_pair(w_.x, c01_[0], c01_[1]); w_.y = rope_pair(w_.y, c01_[2], c01_[3]); w_.z = rope_pair(w_.z, c23_[0], c23_[1]); w_.w = rope_pair(w_.w, c23_[2], c23_[3]); \
        S.qr[8 + d_] = __builtin_bit_cast(bf16x8, w_); } } while (0)
constexpr int CONV_SCR_DIL = 67584;
#ifndef CONV_PER_IDLE
#define CONV_PER_IDLE 1
#endif
#ifndef CONV_LAST_STEP
#define CONV_LAST_STEP 0
#endif
__device__ __forceinline__ void conv_load_full(const ConvCtx& X, int j, float* cv, int lane) {
    const ConvItem I = conv_decode(X, j); const __amdgpu_buffer_rsrc_t rs = A_RSRC(I.src);
#pragma unroll
    for (int i = 0; i < 16; ++i) { const int k = 4 * i + (lane >> 4); cv[i] = __uint_as_float(__builtin_amdgcn_raw_buffer_load_b32(rs, (k * I.ldw + (lane & 15)) * 4, 0, CONV_AUX)); }
}
__device__ __forceinline__ void conv_put_full(const ConvCtx& X, int j, const float* cv, char* scr, int lane) {
    float* s = reinterpret_cast<float*>(scr);
#pragma unroll
    for (int i = 0; i < 16; ++i) { const int k = 4 * i + (lane >> 4); s[k * 17 + (lane & 15)] = cv[i] * 256.0f; }
    float dummy_[4] = {0.f, 0.f, 0.f, 0.f};
    conv_put(X, j, 3, dummy_, scr, lane, true);
}
template <int DQK, bool DIL, int PVAR = 0, bool ROPE = false>
__device__ __forceinline__ void att_prime(const Blk& cur, const char* wsb, char* lds, Seam<DQK>& S, int tid_in) {
    typedef Cfg<DQK> C;
    int tid = tid_in; asm volatile("" : "+v"(tid));
    const int wid = __builtin_amdgcn_readfirstlane(tid >> 6), lane = tid & 63, r32 = lane & 31, hi = lane >> 5;
    A_STAGE_IDX(); char* K_lds = lds + 2 * SHM_V;
    const int kb0 = swa_jlo(cur.P0, W_(cur)) * KVBLK;
    A_QLOAD(cur);
    if constexpr (ROPE) A_RTLOAD(cur);
    A_SLOAD(cur, kb0); VMW(); A_SWRITE_K(0);
    __syncthreads();
}
template <int DQK, bool DIL, bool SK, int PVAR = 0, int CONV = 0, bool ROPE = false>
__device__ __forceinline__ void att_block(const Blk& cur, const Blk& nxt, const char* wsb, char* lds, Seam<DQK>& S, int tid_in, const ConvCtx* X = nullptr) {
    typedef Cfg<DQK> C;
    int tid = tid_in; asm volatile("" : "+v"(tid));
    const int wid = __builtin_amdgcn_readfirstlane(tid >> 6), lane = tid & 63, r32 = lane & 31, hi = lane >> 5;
    const int W = W_(cur); const float scale = SCALE_, beta = cur.beta;
    int j_lo = swa_jlo(cur.P0, W);
    int j_hi = (cur.P0 + QB - 1) / KVBLK + 1; if (j_hi > SKV_(cur) / KVBLK) j_hi = SKV_(cur) / KVBLK;
    if (PVAR & 8) j_lo = j_hi - 2;
    const int NT = j_hi - j_lo;
    const int kbn = swa_jlo(nxt.P0, W_(nxt)) * KVBLK;
    const int qlo = cur.P0 + wid * QBLK, qm = qlo + r32 - 4 * hi;
    char* V_lds = lds; char* K_lds = lds + 2 * SHM_V;
#ifdef ATT_DEFER
    constexpr bool DEFER = DIL;
#else
    constexpr bool DEFER = false;
#endif
    float* ws = (float*)(lds + (DEFER ? DEFER_WS : 2 * SHM_V + 2 * C::SHM_K)) + wid * 64; float* li_l = ws, * al_l = ws + 32;
    char* stg = lds + DEFER_STG + wid * 8192;
    float m_reg = -1e30f, l_reg = 0; f32x16 o[4] = {};
    A_STAGE_IDX();
    const int vst0 = v_st(sr, sc), vst1 = v_st(32 + sr, sc);
    const int vb0 = (int)(uintptr_t)V_lds + v_rd_base(lane);
#define RESC(a) do { if (__any((a) < 1.f)) { if (hi == 0) al_l[r32] = (a); asm volatile("s_waitcnt lgkmcnt(0)" ::: "memory");              \
                     _Pragma("unroll") for (int d_ = 0; d_ < 4; ++d_) _Pragma("unroll") for (int r = 0; r < 16; ++r) o[d_][r] *= al_l[crow(r, hi)]; } } while (0)
#define KBASE(t) ((j_lo + (t)) * KVBLK)
#define ACT(t) (KBASE(t) <= qlo + QBLK - 1 && KBASE(t) + KVBLK - 1 >= qlo - W + 1)
#define MASKT(P0_, P1_, t) do { const int kb_ = KBASE(t); if ((!SK || ACT(t)) && (kb_ + KVBLK - 1 > qlo || kb_ <= qlo + QBLK - 1 - W)) mask_tile(P0_, P1_, qm - kb_, (unsigned)W); } while (0)
    A_SWRITE_V(0);
    __syncthreads();
    if constexpr (ROPE) { VMW(); A_ROTATE(); }
#define STEP(t, BUF) do { const bool more_ = (t) + 1 < NT;                                                                        \
        if (more_) { A_SLOAD(cur, KBASE((t) + 1)); } else { A_SLOAD(nxt, kbn); }                                                   \
        const bool cpend_ = CONV == 1 && (S.cv_j != S.cl_j || S.cv_q != S.cl_q); const bool cld_ = CONV == 1 && more_ && S.cl_j < CONV_NJ;        \
        const bool act_ = !SK || ACT(t); const bool cidle_ = CONV == 2 && (more_ || CONV_LAST_STEP) && !act_ && (S.cv_j < CONV_NJ);                                \
        bool cnew_ = false;                                                                                                    \
        if (cidle_) { if (S.cv_pend) { VMWN(C::KCH + 2);        \
                          conv_put_full(*X, S.cv_j, S.cvf, lds + (DIL ? CONV_SCR_DIL : CONV_SCR) + wid * 4352, lane); ++S.cv_j;                 \
                          if (S.cv_pend > 1) { conv_put_full(*X, S.cv_j, S.cvf + 16, lds + (DIL ? CONV_SCR_DIL : CONV_SCR) + wid * 4352, lane); ++S.cv_j; } S.cv_pend = 0; } \
                      if (S.cv_j < CONV_NJ) { conv_load_full(*X, S.cv_j, S.cvf, lane); S.cv_pend = 1; cnew_ = true;                                \
                          if (CONV_PER_IDLE > 1 && S.cv_j + 1 < CONV_NJ) { conv_load_full(*X, S.cv_j + 1, S.cvf + 16, lane); S.cv_pend = 2; } } }        \
        if (cld_) { conv_load(*X, S.cl_j, S.cl_q, BUF ? S.cw : S.cv, lane); if (++S.cl_q == 4) { S.cl_q = 0; ++S.cl_j; } }               \
        if (DEFER && S.p_on && (t) < 4) { flush_piece(stg, 2 * (t), wsb + S.p_oo, S.p_rb, S.p_so0, lane); flush_piece(stg, 2 * (t) + 1, wsb + S.p_oo, S.p_rb, S.p_so0, lane); } \
        SBAR();                                                                                                                 \
        if (act_) { f32x16 p0, p1; float mn_, al_; bf16x8 pa0, pa1, pa2, pa3;      \
            qkt<BUF, false, DQK, DIL>(p0, p1, K_lds, r32, hi, S.qr, true, beta, qm - KBASE(t)); SBAR();                              \
            MASKT(p0, p1, t); partialSM(p0, p1, m_reg, mn_, al_, scale); finishSM(p0, p1, al_, l_reg, pa0, pa1, pa2, pa3); RESC(al_); SBAR(); \
            pv_tile<BUF, false>(o, vb0, pa0, pa1, pa2, pa3, true); }                                                             \
        if (!more_) { SBAR(); A_QLOAD(nxt); SBAR(); }                                 \
        if (more_) { if (cnew_) { if (S.cv_pend > 1) VMWN(32); else VMWN(16); } else if (cld_) VMWN(4); else VMW();            \
            A_SWRITE_V(1 - BUF); A_SWRITE_K(1 - BUF);                                                                              \
            if (cpend_) { conv_put(*X, S.cv_j, S.cv_q, BUF ? S.cv : S.cw, lds + CONV_SCR + wid * 4352, lane); if (++S.cv_q == 4) { S.cv_q = 0; ++S.cv_j; } } \
        }                                                                                                                       \
        A_STEPBAR(); } while (0)
    int t = 0;
    for (; t + 1 < NT; t += 2) { STEP(t, 0); STEP(t + 1, 1); }
    if (t < NT) { STEP(t, 0); }
    VMWN(C::NQF); A_SWRITE_K(0); SBAR();
    if (CONV == 1 && (S.cv_j != S.cl_j || S.cv_q != S.cl_q)) { conv_put(*X, S.cv_j, S.cv_q, S.cv, lds + CONV_SCR + wid * 4352, lane); if (++S.cv_q == 4) { S.cv_q = 0; ++S.cv_j; } }
    if (hi == 0) li_l[r32] = l_reg; asm volatile("s_waitcnt lgkmcnt(0)" ::: "memory");
    if constexpr (DIL) { if (hi == 0) __builtin_amdgcn_raw_buffer_store_b32(__float_as_uint(m_reg * scale + __logf(l_reg)), A_RSRC(wsb + cur.lo), r32 * LS_(cur) * 4, (cur.P0 + wid * QBLK) * LS_(cur) * 4, 0); }
    float rli[16];
#pragma unroll
    for (int r = 0; r < 16; ++r) rli[r] = __builtin_amdgcn_rcpf(li_l[crow(r, hi)]);
    if constexpr (DEFER) { stage_write(o, rli, stg, lane); S.p_oo = cur.oo; S.p_rb = OS_(cur) * 2; S.p_so0 = (cur.P0 + wid * QBLK) * OS_(cur) * 2; S.p_on = 1; }
    else {
#ifdef ATT_T21
    store_o_staged(o, rli, wid < 4 ? lds + SHM_V + wid * 4096 : lds + 2 * SHM_V + C::SHM_K + (wid - 4) * 4096, A_RSRC(wsb + cur.oo), OS_(cur) * 2, (cur.P0 + wid * QBLK) * OS_(cur) * 2, lane);
#else
    const int os_ = (PVAR & 1) ? 0 : OS_(cur);
    const __amdgpu_buffer_rsrc_t ro_ = A_RSRC(wsb + cur.oo); const int oo_ = (4 * hi * os_ + r32) * 2, so0_ = (cur.P0 + wid * QBLK) * os_ * 2;
#pragma unroll
    for (int r = 0; r < 16; ++r) { const int sor_ = so0_ + ((r & 3) + 8 * (r >> 2)) * os_ * 2;
#pragma unroll
        for (int d0 = 0; d0 < 4; ++d0) { const float v = o[d0][r] * rli[r];
            const float vn = __int_as_float(__builtin_amdgcn_update_dpp(0, __float_as_int(v), 0xB1, 0xF, 0xF, true));
            if ((r32 & 1) == 0) __builtin_amdgcn_raw_buffer_store_b32(cvtpk(v, vn), ro_, oo_ + d0 * 64, sor_, 0); } }
#endif
    }
    if constexpr (ROPE) A_RTLOAD(nxt);
#undef RESC
#undef KBASE
#undef ACT
#undef MASKT
#undef STEP
}

template <int DQK> struct SeamD { bf16x8 qr[Cfg<DQK>::NQF]; };
#define A_GLDS(voff, sbase, ldsdst) do { unsigned keep_; asm volatile("s_mov_b32 %0, m0\n\ts_mov_b32 m0, %2\n\ts_nop 0\n\tglobal_load_lds_dwordx4 %1, %3\n\ts_mov_b32 m0, %0" \
        : "=&s"(keep_) : "v"(voff), "s"((unsigned)__builtin_amdgcn_readfirstlane((int)(ldsdst))), "s"((const void*)(sbase)) : "memory"); } while (0)
#define A_DMA_IDX() int krow_[C::KCH], kcb_[C::KCH], vrow_[2], vcb_[2]; \
        _Pragma("unroll") for (int j_ = 0; j_ < C::KCH; ++j_) { const int p_ = (j_ * 8 + wid) * 1024 + lane * 16, row_ = p_ / C::KPITCH, pc_ = (p_ % C::KPITCH) / 16, lc_ = (pc_ & ~7) | ((pc_ & 7) ^ (row_ & 7)); \
            krow_[j_] = row_; kcb_[j_] = lc_ * 16; } \
        _Pragma("unroll") for (int j_ = 0; j_ < 2; ++j_) { const int p_ = (j_ * 8 + wid) * 1024 + lane * 16, s_ = p_ / 512, w_ = p_ % 512, kk_ = (s_ >> 2) * 8 + (w_ >> 6), col_ = (s_ & 3) * 32 + ((w_ & 63) >> 1); \
            vrow_[j_] = (kk_ & ~0xC) | ((kk_ & 4) << 1) | ((kk_ & 8) >> 1); vcb_[j_] = col_ * 2; }
#define A_DMA(B_, k0, sl_) do { const char* kb_ = wsb + (B_).ko + (size_t)(k0) * (size_t)(KS_(B_) * 2); const char* vb_ = wsb + (B_).vo + (size_t)(k0) * (size_t)(VS_(B_) * 2); \
        _Pragma("unroll") for (int j_ = 0; j_ < C::KCH; ++j_) A_GLDS((unsigned)(krow_[j_] * KS_(B_) * 2 + kcb_[j_]), kb_, lds0 + NS * SHM_V + (sl_) * C::SHM_K + (j_ * 8 + wid) * 1024); \
        _Pragma("unroll") for (int j_ = 0; j_ < 2; ++j_) A_GLDS((unsigned)(vrow_[j_] * VS_(B_) * 2 + vcb_[j_]), vb_, lds0 + (sl_) * SHM_V + (j_ * 8 + wid) * 1024); } while (0)
template <int DQK, bool DIL, int NS>
__device__ __forceinline__ void att_prime_dma(const Blk& cur, const char* wsb, char* lds, SeamD<DQK>& S, int tid_in) {
    typedef Cfg<DQK> C;
    int tid = tid_in; asm volatile("" : "+v"(tid));
    const int wid = __builtin_amdgcn_readfirstlane(tid >> 6), lane = tid & 63, r32 = lane & 31, hi = lane >> 5;
    const unsigned lds0 = (unsigned)(uintptr_t)lds;
    A_DMA_IDX();
    const int kb0 = swa_jlo(cur.P0, W_(cur)) * KVBLK;
    A_QLOAD(cur);
#pragma unroll
    for (int i_ = 0; i_ < NS - 1; ++i_) A_DMA(cur, kb0 + i_ * KVBLK, i_);
}
template <int DQK, bool DIL, bool SK, int NS>
__device__ __forceinline__ void att_block_dma(const Blk& cur, const Blk& nxt, const char* wsb, char* lds, char* wsl, SeamD<DQK>& S, int tid_in) {
    typedef Cfg<DQK> C;
    int tid = tid_in; asm volatile("" : "+v"(tid));
    const int wid = __builtin_amdgcn_readfirstlane(tid >> 6), lane = tid & 63, r32 = lane & 31, hi = lane >> 5;
    const int W = W_(cur); const float scale = SCALE_, beta = cur.beta;
    const int j_lo = swa_jlo(cur.P0, W);
    int j_hi = (cur.P0 + QB - 1) / KVBLK + 1; if (j_hi > SKV_(cur) / KVBLK) j_hi = SKV_(cur) / KVBLK;
    const int NT = j_hi - j_lo;
    const int kbn = swa_jlo(nxt.P0, W_(nxt)) * KVBLK;
    const int qlo = cur.P0 + wid * QBLK, qm = qlo + r32 - 4 * hi;
    const unsigned lds0 = (unsigned)(uintptr_t)lds;
    const char* K_lds = lds + NS * SHM_V;
    float* ws = (float*)wsl + wid * 64; float* li_l = ws, * al_l = ws + 32;
    float m_reg = -1e30f, l_reg = 0; f32x16 o[4] = {};
    A_DMA_IDX();
    const int vb0 = (int)lds0 + v_rd_base(lane);
    constexpr int NDMA = C::KCH + 2;
#define RESC(a) do { if (__any((a) < 1.f)) { if (hi == 0) al_l[r32] = (a); asm volatile("s_waitcnt lgkmcnt(0)" ::: "memory");              \
                     _Pragma("unroll") for (int d_ = 0; d_ < 4; ++d_) _Pragma("unroll") for (int r = 0; r < 16; ++r) o[d_][r] *= al_l[crow(r, hi)]; } } while (0)
#define KBASE(t) ((j_lo + (t)) * KVBLK)
#define ACT(t) (KBASE(t) <= qlo + QBLK - 1 && KBASE(t) + KVBLK - 1 >= qlo - W + 1)
#define MASKT(P0_, P1_, t) do { const int kb_ = KBASE(t); if ((!SK || ACT(t)) && (kb_ + KVBLK - 1 > qlo || kb_ <= qlo + QBLK - 1 - W)) mask_tile(P0_, P1_, qm - kb_, (unsigned)W); } while (0)
    VMW();
#pragma unroll
    for (int d0 = 0; d0 < C::NQF; ++d0) asm volatile("" : "+v"(S.qr[d0]));
    asm volatile("s_waitcnt lgkmcnt(0)" ::: "memory"); __builtin_amdgcn_s_barrier(); asm volatile("" ::: "memory");
    int sl = 0, sl2 = NS - 1;
#pragma unroll 1
    for (int t = 0; t < NT; ++t) {
        const bool pre = t + NS - 1 < NT;
        if (pre) A_DMA(cur, KBASE(t + NS - 1), sl2);
        SBAR(); f32x16 p0, p1; float mn_, al_; bf16x8 pa0, pa1, pa2, pa3;
        qkt<0, SK, DQK, DIL>(p0, p1, K_lds + sl * C::SHM_K, r32, hi, S.qr, ACT(t), beta, qm - KBASE(t)); SBAR();
        MASKT(p0, p1, t); partialSM(p0, p1, m_reg, mn_, al_, scale); finishSM(p0, p1, al_, l_reg, pa0, pa1, pa2, pa3); RESC(al_); SBAR();
        pv_tile<0, SK>(o, vb0 + sl * SHM_V, pa0, pa1, pa2, pa3, ACT(t));
        if (t + 1 < NT) { int infl = NT - 2 - t; if (infl > NS - 2) infl = NS - 2;
                          if (infl <= 0) VMW(); else if (infl == 1) VMWN(NDMA); else VMWN(2 * NDMA);
                          asm volatile("s_waitcnt lgkmcnt(0)" ::: "memory"); __builtin_amdgcn_s_barrier(); asm volatile("" ::: "memory"); }
        sl = sl == NS - 1 ? 0 : sl + 1; sl2 = sl2 == NS - 1 ? 0 : sl2 + 1;
    }
    asm volatile("s_waitcnt lgkmcnt(0)" ::: "memory"); __builtin_amdgcn_s_barrier(); asm volatile("" ::: "memory");
    A_QLOAD(nxt);
#pragma unroll
    for (int i_ = 0; i_ < NS - 1; ++i_) A_DMA(nxt, kbn + i_ * KVBLK, i_);
    if (hi == 0) li_l[r32] = l_reg; asm volatile("s_waitcnt lgkmcnt(0)" ::: "memory");
    if constexpr (DIL) { if (hi == 0) __builtin_amdgcn_raw_buffer_store_b32(__float_as_uint(m_reg * scale + __logf(l_reg)), A_RSRC(wsb + cur.lo), r32 * LS_(cur) * 4, (cur.P0 + wid * QBLK) * LS_(cur) * 4, 0); }
    float rli[16];
#pragma unroll
    for (int r = 0; r < 16; ++r) rli[r] = __builtin_amdgcn_rcpf(li_l[crow(r, hi)]);
    const __amdgpu_buffer_rsrc_t ro_ = A_RSRC(wsb + cur.oo); const int oo_ = (4 * hi * OS_(cur) + r32) * 2, so0_ = (cur.P0 + wid * QBLK) * OS_(cur) * 2;
#pragma unroll
    for (int r = 0; r < 16; ++r) { const int sor_ = so0_ + ((r & 3) + 8 * (r >> 2)) * OS_(cur) * 2;
#pragma unroll
        for (int d0 = 0; d0 < 4; ++d0) { const float v = o[d0][r] * rli[r];
            const float vn = __int_as_float(__builtin_amdgcn_update_dpp(0, __float_as_int(v), 0xB1, 0xF, 0xF, true));
            if ((r32 & 1) == 0) __builtin_amdgcn_raw_buffer_store_b32(cvtpk(v, vn), ro_, oo_ + d0 * 64, sor_, 0); } }
#undef RESC
#undef KBASE
#undef ACT
#undef MASKT
}

template <bool SK, int DQK, bool DIL>
__device__ __forceinline__ void qkt_fin(f32x16& p0, f32x16& p1, const char* K_lds, int r32, int hi, const bf16x8* qr, bool act, float beta, int dq,
                                        f32x16& y0, f32x16& y1, float alpha, float& l_reg, bf16x8& pa0, bf16x8& pa1, bf16x8& pa2, bf16x8& pa3) {
    typedef Cfg<DQK> C;
    const bool run = !(SK && !act);
    if (!run) { const float NEG = -__builtin_inff();
#pragma unroll
        for (int r = 0; r < 16; ++r) { p0[r] = NEG; p1[r] = NEG; } }
    else if constexpr (DIL) { const float b0 = -beta * (float)dq;
#pragma unroll
        for (int r = 0; r < 16; ++r) { const int c = (r & 3) + 8 * (r >> 2); p0[r] = fmaf(beta, (float)c, b0); p1[r] = fmaf(beta, (float)(c + 32), b0); } }
    else { p0 = f32x16{}; p1 = f32x16{}; }
    const char* kb[4];
#pragma unroll
    for (int dd = 0; dd < 4; ++dd) { const int colB = (dd * 16 + hi * 8) * 2; kb[dd] = K_lds + r32 * C::KPITCH + (colB ^ ((r32 & 7) << 4)); }
#define QK_CHUNK(c_) do { if (run) { _Pragma("unroll") for (int d0 = 4 * (c_); d0 < 4 * (c_) + 4 && d0 < C::NQF; ++d0) { const char* a = kb[d0 & 3] + (d0 >> 2) * 128; \
            bf16x8 b0 = *reinterpret_cast<const bf16x8*>(a); bf16x8 b1 = *reinterpret_cast<const bf16x8*>(a + 32 * C::KPITCH);                                  \
            p0 = __builtin_amdgcn_mfma_f32_32x32x16_bf16(b0, qr[d0], p0, 0, 0, 0); p1 = __builtin_amdgcn_mfma_f32_32x32x16_bf16(b1, qr[d0], p1, 0, 0, 0); } } } while (0)
#define PK4(P, B_, OUT) do { unsigned a0 = cvtpk(P[B_+0], P[B_+1]), a1 = cvtpk(P[B_+2], P[B_+3]);                          \
        unsigned b0 = cvtpk(P[B_+4], P[B_+5]), b1 = cvtpk(P[B_+6], P[B_+7]);                                             \
        auto r0 = __builtin_amdgcn_permlane32_swap(a0, b0, false, false); auto r1 = __builtin_amdgcn_permlane32_swap(a1, b1, false, false); \
        u32x4 w = {r0[0], r1[0], r0[1], r1[1]}; OUT = *reinterpret_cast<bf16x8*>(&w); } while (0)
    QK_CHUNK(0);
#pragma unroll
    for (int r = 0; r < 16; ++r) y1[r] = __builtin_amdgcn_exp2f(y1[r]);
    float ps = 0;
#pragma unroll
    for (int r = 0; r < 16; ++r) ps += y0[r];
#pragma unroll
    for (int r = 0; r < 16; ++r) ps += y1[r];
    SBAR();
    QK_CHUNK(1);
    { auto rr = __builtin_amdgcn_permlane32_swap(__float_as_uint(ps), __float_as_uint(ps), false, false);
      ps = __uint_as_float(rr[0]) + __uint_as_float(rr[1]); }
    l_reg = l_reg * alpha + ps;
    PK4(y0, 0, pa0); PK4(y0, 8, pa1);
    if constexpr (C::NQF > 8) { SBAR(); QK_CHUNK(2); }
    PK4(y1, 0, pa2); PK4(y1, 8, pa3);
#undef PK4
#undef QK_CHUNK
}
#ifndef ATT_SKEW_SEL
#define ATT_SKEW_SEL 0
#endif
#if ATT_SKEW_SEL == 0
#define ATT_SKEW_A (wid < 4)
#elif ATT_SKEW_SEL == 1
#define ATT_SKEW_A ((wid & 1) == 0)
#elif ATT_SKEW_SEL == 2
#define ATT_SKEW_A true
#else
#define ATT_SKEW_A false
#endif
#define A_DMA_K(B_, k0, sl_) do { const char* kb_ = wsb + (B_).ko + (size_t)(k0) * (size_t)(KS_(B_) * 2); int ln_ = lane; asm volatile("" : "+v"(ln_)); \
        _Pragma("unroll") for (int j_ = 0; j_ < C::KCH; ++j_) { const int p_ = (j_ * 8 + wid) * 1024 + ln_ * 16, row_ = p_ / C::KPITCH, pc_ = (p_ % C::KPITCH) / 16, lc_ = (pc_ & ~7) | ((pc_ & 7) ^ (row_ & 7)); \
            A_GLDS((unsigned)(row_ * KS_(B_) * 2 + lc_ * 16), kb_, lds0 + 3 * SHM_V + (sl_) * C::SHM_K + (j_ * 8 + wid) * 1024); } } while (0)
#define A_DMA_V(B_, k0, sl_) do { const char* vb_ = wsb + (B_).vo + (size_t)(k0) * (size_t)(VS_(B_) * 2); int ln_ = lane; asm volatile("" : "+v"(ln_)); \
        _Pragma("unroll") for (int j_ = 0; j_ < 2; ++j_) { const int p_ = (j_ * 8 + wid) * 1024 + ln_ * 16, s_ = p_ / 512, w_ = p_ % 512, kk_ = (s_ >> 2) * 8 + (w_ >> 6), col_ = (s_ & 3) * 32 + ((w_ & 63) >> 1); \
            const int vr_ = (kk_ & ~0xC) | ((kk_ & 4) << 1) | ((kk_ & 8) >> 1); \
            A_GLDS((unsigned)(vr_ * VS_(B_) * 2 + col_ * 2), vb_, lds0 + (sl_) * SHM_V + (j_ * 8 + wid) * 1024); } } while (0)
#define A_RAWBAR() do { asm volatile("s_waitcnt lgkmcnt(0)" ::: "memory"); __builtin_amdgcn_s_barrier(); asm volatile("" ::: "memory"); } while (0)
template <int DQK, bool DIL>
__device__ __forceinline__ void att_prime_dma2(const Blk& cur, const char* wsb, char* lds, SeamD<DQK>& S, int tid_in) {
    typedef Cfg<DQK> C; constexpr int NS = 3;
    int tid = tid_in; asm volatile("" : "+v"(tid));
    const int wid = __builtin_amdgcn_readfirstlane(tid >> 6), lane = tid & 63, r32 = lane & 31, hi = lane >> 5;
    const unsigned lds0 = (unsigned)(uintptr_t)lds;
    const int kb0 = swa_jlo(cur.P0, W_(cur)) * KVBLK;
    A_QLOAD(cur);
    A_DMA_K(cur, kb0, 0); A_DMA_V(cur, kb0, 0); A_DMA_K(cur, kb0 + KVBLK, 1);
}
template <int DQK, bool DIL, bool SK, int ORD>
__device__ __forceinline__ void att_block_dma2(const Blk& cur, const Blk& nxt, const char* wsb, char* lds, SeamD<DQK>& S, int tid_in) {
    typedef Cfg<DQK> C; constexpr int NS = 3;
    int tid = tid_in; asm volatile("" : "+v"(tid));
    const int wid = __builtin_amdgcn_readfirstlane(tid >> 6), lane = tid & 63, r32 = lane & 31, hi = lane >> 5;
    const int W = W_(cur); const float scale = SCALE_, beta = cur.beta;
    const int j_lo = swa_jlo(cur.P0, W);
    int j_hi = (cur.P0 + QB - 1) / KVBLK + 1; if (j_hi > SKV_(cur) / KVBLK) j_hi = SKV_(cur) / KVBLK;
    const int NT = j_hi - j_lo;
    const int kbn = swa_jlo(nxt.P0, W_(nxt)) * KVBLK;
    const int qlo = cur.P0 + wid * QBLK, qm = qlo + r32 - 4 * hi;
    const unsigned lds0 = (unsigned)(uintptr_t)lds;
    const char* K_lds = lds + 3 * SHM_V;
    float* ws = (float*)(lds + 3 * SHM_V + 3 * C::SHM_K) + wid * 64; float* li_l = ws, * al_l = ws + 32;
    float m_reg = -1e30f, l_reg = 0; f32x16 o[4] = {};
    const int vb0 = (int)lds0 + v_rd_base(lane);
#define RESC(a) do { if (__any((a) < 1.f)) { if (hi == 0) al_l[r32] = (a); asm volatile("s_waitcnt lgkmcnt(0)" ::: "memory");              \
                     _Pragma("unroll") for (int d_ = 0; d_ < 4; ++d_) _Pragma("unroll") for (int r = 0; r < 16; ++r) o[d_][r] *= al_l[crow(r, hi)]; } } while (0)
#define KBASE(t) ((j_lo + (t)) * KVBLK)
#define ACT(t) (KBASE(t) <= qlo + QBLK - 1 && KBASE(t) + KVBLK - 1 >= qlo - W + 1)
#define MASKT(P0_, P1_, t) do { const int kb_ = KBASE(t); if ((!SK || ACT(t)) && (kb_ + KVBLK - 1 > qlo || kb_ <= qlo + QBLK - 1 - W)) mask_tile(P0_, P1_, qm - kb_, (unsigned)W); } while (0)
#define ISSUE(t, n_) do { n_ = 0; if ((t) + 2 < NT) { int slotk_ = sl + 2; if (slotk_ >= 3) slotk_ -= 3; A_DMA_K(cur, KBASE((t) + 2), slotk_); n_ += C::KCH; } \
                          if ((t) + 1 < NT) { int slotv_ = sl + 1; if (slotv_ >= 3) slotv_ -= 3; A_DMA_V(cur, KBASE((t) + 1), slotv_); n_ += 2; } } while (0)
#define CLOSE(n_) do { if ((n_) == C::KCH + 2) VMWN(C::KCH + 2); else if ((n_) == 2) VMWN(2); else VMW(); A_RAWBAR(); } while (0)
    VMW();
#pragma unroll
    for (int d0 = 0; d0 < C::NQF; ++d0) asm volatile("" : "+v"(S.qr[d0]));
    A_RAWBAR();
    int sl = 0, slp = 2, nis;
    f32x16 pA0, pA1, pB0, pB1; float mnA, mnB, alA, alB; bf16x8 pa0, pa1, pa2, pa3;
    ISSUE(0, nis); SBAR();
    qkt<0, SK, DQK, DIL>(pA0, pA1, K_lds + sl * C::SHM_K, r32, hi, S.qr, ACT(0), beta, qm - KBASE(0)); SBAR();
    MASKT(pA0, pA1, 0); partialSM(pA0, pA1, m_reg, mnA, alA, scale);
    CLOSE(nis); slp = sl; sl = sl == 2 ? 0 : sl + 1;
#define STEPP(PX0, PX1, mnX, alX, PY0, PY1, alY, t) do { ISSUE(t, nis); SBAR();                                               \
        if constexpr (ORD == 0) {                                                                                               \
            qkt<0, SK, DQK, DIL>(PX0, PX1, K_lds + sl * C::SHM_K, r32, hi, S.qr, ACT(t), beta, qm - KBASE(t)); SBAR();           \
            finishSM(PY0, PY1, alY, l_reg, pa0, pa1, pa2, pa3); SBAR();                                                         \
            pv_tile<0, SK>(o, vb0 + slp * SHM_V, pa0, pa1, pa2, pa3, ACT((t) - 1)); SBAR();                                     \
        } else {                                                                                                                \
            finishSM(PY0, PY1, alY, l_reg, pa0, pa1, pa2, pa3); SBAR();                                                         \
            pv_tile<0, SK>(o, vb0 + slp * SHM_V, pa0, pa1, pa2, pa3, ACT((t) - 1)); SBAR();                                     \
            qkt<0, SK, DQK, DIL>(PX0, PX1, K_lds + sl * C::SHM_K, r32, hi, S.qr, ACT(t), beta, qm - KBASE(t)); SBAR();           \
        }                                                                                                                       \
        MASKT(PX0, PX1, (t)); partialSM(PX0, PX1, m_reg, mnX, alX, scale);                                                     \
        RESC(alX); CLOSE(nis); slp = sl; sl = sl == 2 ? 0 : sl + 1; } while (0)
    int t = 1;
#pragma unroll 1
    for (; t + 2 < NT; t += 2) {
        STEPP(pB0, pB1, mnB, alB, pA0, pA1, alA, t);
        STEPP(pA0, pA1, mnA, alA, pB0, pB1, alB, t + 1);
    }
    STEPP(pB0, pB1, mnB, alB, pA0, pA1, alA, t);
    finishSM(pB0, pB1, alB, l_reg, pa0, pa1, pa2, pa3); SBAR();
    pv_tile<0, SK>(o, vb0 + slp * SHM_V, pa0, pa1, pa2, pa3, ACT(NT - 1));
    A_RAWBAR();
    A_QLOAD(nxt);
    A_DMA_K(nxt, kbn, 0); A_DMA_V(nxt, kbn, 0); A_DMA_K(nxt, kbn + KVBLK, 1);
    if (hi == 0) li_l[r32] = l_reg; asm volatile("s_waitcnt lgkmcnt(0)" ::: "memory");
    if constexpr (DIL) { if (hi == 0) __builtin_amdgcn_raw_buffer_store_b32(__float_as_uint(m_reg * scale + __logf(l_reg)), A_RSRC(wsb + cur.lo), r32 * LS_(cur) * 4, (cur.P0 + wid * QBLK) * LS_(cur) * 4, 0); }
    float rli[16];
#pragma unroll
    for (int r = 0; r < 16; ++r) rli[r] = __builtin_amdgcn_rcpf(li_l[crow(r, hi)]);
    const __amdgpu_buffer_rsrc_t ro_ = A_RSRC(wsb + cur.oo); const int oo_ = (4 * hi * OS_(cur) + r32) * 2, so0_ = (cur.P0 + wid * QBLK) * OS_(cur) * 2;
#pragma unroll
    for (int r = 0; r < 16; ++r) { const int sor_ = so0_ + ((r & 3) + 8 * (r >> 2)) * OS_(cur) * 2;
#pragma unroll
        for (int d0 = 0; d0 < 4; ++d0) { const float v = o[d0][r] * rli[r];
            const float vn = __int_as_float(__builtin_amdgcn_update_dpp(0, __float_as_int(v), 0xB1, 0xF, 0xF, true));
            if ((r32 & 1) == 0) __builtin_amdgcn_raw_buffer_store_b32(cvtpk(v, vn), ro_, oo_ + d0 * 64, sor_, 0); } }
#undef RESC
#undef KBASE
#undef ACT
#undef MASKT
#undef ISSUE
#undef CLOSE
#undef STEPP
}
#undef A_DMA_K
#undef A_DMA_V
#undef A_RAWBAR
#undef A_GLDS
#undef A_DMA_IDX
#undef A_DMA
#undef VMW
#undef VMWN
#undef A_SLOAD
#undef A_RSRC
#undef A_BLD
#undef A_QLOAD
#undef A_SWRITE_K
#undef A_SWRITE_V
#undef A_STAGE_IDX
#undef SBAR
#undef QS_
#undef KS_
#undef VS_
#undef OS_
#undef LS_
#undef SKV_
#undef W_
#undef SCALE_
}
constexpr int NWAVES = 8;
constexpr int T = 32768, DM = 2048, SEQ = 8192, NB = 4, DEPTH = 2;
constexpr int IN_COLS = 3904, PROJ_LD = 4096, NEXP = 16, DEXP = 1024;
constexpr int C_QB = 0, C_KB = 1024, C_VB = 2048, C_CQ = 3072, C_CKV = 3584, C_KR = 3840;
constexpr float EPS = 1e-6f;
constexpr size_t MiB = 1u << 20;
constexpr size_t WS_CTL = 0, CTL_ZERO_BYTES = 1 * MiB;
constexpr size_t WS_MOD = 1 * MiB;
constexpr size_t WS_ROPE = 2 * MiB;
constexpr size_t WS_RSTDQ = 4 * MiB, WS_RSTDKV = 4 * MiB + 256 * 1024, WS_AW = 4 * MiB + 512 * 1024;
constexpr size_t WS_ROWIDX = 5 * MiB;
constexpr size_t WS_LSE = 8 * MiB;
constexpr size_t WS_WIN = 16 * MiB;
constexpr size_t WS_WUQ = 48 * MiB;
constexpr size_t WS_WUKV = 51 * MiB;
constexpr size_t WS_WOUT = 53 * MiB;
constexpr size_t WS_W13 = 72 * MiB;
constexpr size_t WS_W2 = 200 * MiB;
constexpr size_t WS_H = 264 * MiB;
constexpr size_t WS_PROJ = 392 * MiB;
constexpr size_t WS_QA = 648 * MiB;
constexpr size_t WS_KF = 744 * MiB;
constexpr size_t WS_VB = 840 * MiB;
constexpr size_t WS_OA = 904 * MiB;
constexpr size_t WS_OB = 968 * MiB;
constexpr size_t WS_XB = 1160 * MiB;
constexpr size_t WS_END = 1288 * MiB;
constexpr size_t WS_HMID = WS_PROJ;
constexpr size_t WS_Y = WS_QA;
constexpr int CW_TMO = 0;
constexpr int CW_CNT = 64;
constexpr int CW_BAR = 4096;
constexpr int RING_BYTES = 131072;
constexpr int L_MISC = RING_BYTES, L_TS = RING_BYTES + 256, L_CNT = RING_BYTES + 384, L_TOK = RING_BYTES + 512, L_ATAB = RING_BYTES + 2560;
constexpr int MAXU = 10;
constexpr int LDS_BYTES = 147456;
static_assert(L_ATAB + MAXU * 1024 <= LDS_BYTES, "LDS map");

#define GAS __attribute__((address_space(1)))
#define LAS __attribute__((address_space(3)))
typedef unsigned short bf16;
typedef unsigned v4u __attribute__((ext_vector_type(4)));
typedef unsigned v2u __attribute__((ext_vector_type(2)));
typedef float f32x4 __attribute__((ext_vector_type(4)));
typedef float f32x2 __attribute__((ext_vector_type(2)));
#define LDS_WAIT() asm volatile("s_waitcnt lgkmcnt(0)" ::: "memory")
#define VM_WAIT() asm volatile("s_waitcnt vmcnt(0)" ::: "memory")
__device__ __forceinline__ unsigned pk2(float lo, float hi) { return pg8::cvt_pk_bf16(lo, hi); }
__device__ __forceinline__ float bf_lo(unsigned w) { return __uint_as_float(w << 16); }
__device__ __forceinline__ float bf_hi(unsigned w) { return __uint_as_float(w & 0xffff0000u); }


typedef __amdgpu_buffer_rsrc_t rsrc_t;
#define RSRC(p) __builtin_amdgcn_make_buffer_rsrc((void*)(p), 0, 0x7fffffff, 0x00020000)
__device__ __forceinline__ f32x4 bld4f(rsrc_t r, int vo, int so) { return __builtin_bit_cast(f32x4, __builtin_amdgcn_raw_buffer_load_b128(r, vo, so, 0)); }
__device__ __forceinline__ v4u bld4u(rsrc_t r, int vo, int so) { return __builtin_bit_cast(v4u, __builtin_amdgcn_raw_buffer_load_b128(r, vo, so, 0)); }
__device__ __forceinline__ v2u bld2u(rsrc_t r, int vo, int so) { return __builtin_bit_cast(v2u, __builtin_amdgcn_raw_buffer_load_b64(r, vo, so, 0)); }
__device__ __forceinline__ void bst2u(rsrc_t r, int vo, int so, v2u v) { __builtin_amdgcn_raw_buffer_store_b64(v, r, vo, so, 0); }
__device__ __forceinline__ void bst4u(rsrc_t r, int vo, int so, v4u v) { __builtin_amdgcn_raw_buffer_store_b128(v, r, vo, so, 0); }
__device__ __forceinline__ void bst4f(rsrc_t r, int vo, int so, f32x4 v) { __builtin_amdgcn_raw_buffer_store_b128(__builtin_bit_cast(v4u, v), r, vo, so, 0); }

#define XB_TMO      128
#define XB_XCNT(j)  (256  + 64 * (j))
#define XB_XSUB(j)  (1280 + 64 * (j))
#define XB_XGEN(j)  (2304 + 64 * (j))
#define XB_TOP      3328
#define XB_TOPGEN   3392
#define XCD_BAR_WORDS 3456
#define XB_SPIN_CAP (1u << 18)
__device__ __forceinline__ unsigned xb_ld(unsigned* p)              { return __hip_atomic_load(p, __ATOMIC_RELAXED, __HIP_MEMORY_SCOPE_AGENT); }
__device__ __forceinline__ unsigned xb_add(unsigned* p, unsigned v) { return __hip_atomic_fetch_add(p, v, __ATOMIC_RELAXED, __HIP_MEMORY_SCOPE_AGENT); }
__device__ __forceinline__ unsigned xb_xcc_id() { return (unsigned)__builtin_amdgcn_s_getreg((3 << 11) | 20) & 0xFu; }
#define XB_SPIN(cond, bar) do { unsigned _sp = 0; while (cond) { __builtin_amdgcn_s_sleep(1); \
    if ((++_sp & 255u) == 0u) { if (xb_ld(&(bar)[XB_TMO])) break; if (_sp > XB_SPIN_CAP) { atomicAdd(&(bar)[XB_TMO], 1u); break; } } } } while (0)
struct XcdBarrier { unsigned* bar; unsigned x; volatile LAS unsigned* st; };
__device__ __forceinline__ XcdBarrier xcd_barrier_post(unsigned* bar, volatile LAS unsigned* st, int tid) {
    XcdBarrier b; b.bar = bar; b.x = xb_xcc_id(); b.st = st;
    if (tid == 0) (void)xb_add(&bar[XB_XCNT(b.x)], 1u);
    return b;
}
__device__ __forceinline__ void xcd_barrier_complete(unsigned* bar, unsigned x, unsigned& nloc, unsigned& nx) {
    const unsigned G = gridDim.x * gridDim.y * gridDim.z;
    unsigned sum, cnt, mine, sp = 0u;
    for (;;) {
        sum = 0u; cnt = 0u; mine = 0u;
#pragma unroll
        for (unsigned j = 0; j < 16; ++j) { const unsigned c = xb_ld(&bar[XB_XCNT(j)]); sum += c; cnt += (c > 0u) ? 1u : 0u; mine = (j == x) ? c : mine; }
        if (sum == G) break;
        __builtin_amdgcn_s_sleep(1);
        if ((++sp & 255u) == 0u) { if (xb_ld(&bar[XB_TMO])) break; if (sp > XB_SPIN_CAP) { atomicAdd(&bar[XB_TMO], 1u); break; } }
    }
    nloc = mine > 0u ? mine : 1u; nx = cnt > 0u ? cnt : 1u;
}
__device__ __forceinline__ void xcd_barrier(const XcdBarrier& b, int tid) {
    asm volatile("s_waitcnt vmcnt(0)" ::: "memory");
    __syncthreads();
    if (tid == 0) {
        unsigned* bar = b.bar; asm volatile("" : "+s"(bar));
        __builtin_amdgcn_s_waitcnt(0);
        unsigned nloc = b.st[0], nx = b.st[1];
        if (nloc == 0u) { xcd_barrier_complete(bar, b.x, nloc, nx); b.st[0] = nloc; b.st[1] = nx; }
        const unsigned old = xb_add(&bar[XB_XSUB(b.x)], 1u);
        const unsigned gen = old / nloc;
        if (old + 1u == (gen + 1u) * nloc) {
            __builtin_amdgcn_fence(__ATOMIC_RELEASE, "agent");
            asm volatile("s_waitcnt vmcnt(0)" ::: "memory");
            const unsigned og = xb_add(&bar[XB_TOP], 1u);
            const unsigned tg = og / nx;
            if (og + 1u == (tg + 1u) * nx) xb_add(&bar[XB_TOPGEN], 1u);
            else XB_SPIN(xb_ld(&bar[XB_TOPGEN]) == tg, bar);
            __builtin_amdgcn_fence(__ATOMIC_ACQUIRE, "agent");
            xb_add(&bar[XB_XGEN(b.x)], 1u);
            asm volatile("s_waitcnt vmcnt(0)" ::: "memory");
        } else {
            XB_SPIN(xb_ld(&bar[XB_XGEN(b.x)]) == gen, bar);
            __builtin_amdgcn_fence(__ATOMIC_ACQUIRE, "agent");
            asm volatile("s_waitcnt vmcnt(0)" ::: "memory");
        }
    }
    __syncthreads();
}

struct Args {
    const float* in[20]; float* out; unsigned char* ws;
    float invf[32];
    int ph_lo, ph_hi, li, pad;
};
enum { I_X = 0, I_C, I_ADAW, I_ADAB, I_N1G, I_N2G, I_WIN, I_QNG, I_KVNG, I_WUQ, I_WUKV, I_ONA, I_ONB, I_WOUT, I_RW, I_RB, I_EG, I_EU, I_ED, I_FG };

struct Frame {
    LAS unsigned char* lds; unsigned char* ldsg;
    unsigned* ctl; unsigned char* ws;
    int tid, lane, wave, vcu, G;
};
__device__ __forceinline__ int lane_id() { int l; asm volatile("v_mbcnt_lo_u32_b32 %0, -1, 0\n\tv_mbcnt_hi_u32_b32 %0, -1, %0" : "=v"(l)); return l; }
#define DPP_ADD(v, ctrl) v += __int_as_float(__builtin_amdgcn_update_dpp(0, __float_as_int(v), ctrl, 0xF, 0xF, true))
__device__ __forceinline__ float wave_sum(float v) {
    DPP_ADD(v, 0xB1); DPP_ADD(v, 0x4E); DPP_ADD(v, 0x141); DPP_ADD(v, 0x140);
    v += __int_as_float(__builtin_amdgcn_ds_swizzle(__float_as_int(v), 0x401F));
    auto rr = __builtin_amdgcn_permlane32_swap(__float_as_uint(v), __float_as_uint(v), false, false);
    return __uint_as_float(rr[0]) + __uint_as_float(rr[1]);
}
__device__ __forceinline__ int il64(int j) { return j < 32 ? 2 * j : 2 * (j - 32) + 1; }
template <int MODE> __device__ __forceinline__ int dest_row(int n) {
    if constexpr (MODE == 0) return n;
    else if constexpr (MODE == 1) {
        if (n < 512) return C_CQ + n; if (n < 768) return C_CKV + (n - 512); if (n < 832) return C_KR + il64(n - 768);
        if (n < 1856) return C_QB + (n - 832); if (n < 2880) return C_KB + (n - 1856); return C_VB + (n - 2880); }
    else if constexpr (MODE == 2) { const int h = n / 192, j = n % 192; return j < 128 ? n : h * 192 + 128 + il64(j - 128); }
    else if constexpr (MODE == 3) return (n >> 7) * 256 + (n & 127);
    else return (n >> 7) * 256 + 128 + (n & 127);
}
template <int MODE>
__device__ __forceinline__ void transpose_item(const float* W, int ldw, int K, int N, bf16* WT, const float* kscale, LAS float* scr, int item, int lane) {
    const int nblk = N / 32, kb = item / nblk, nb = item % nblk, k0 = 64 * kb, n0 = 32 * nb;
    float tv[32];
#pragma unroll
    for (int i = 0; i < 32; ++i) { const int kk = 2 * i + (lane >> 5); tv[i] = W[(size_t)(k0 + kk) * ldw + n0 + (lane & 31)]; }
#pragma unroll
    for (int i = 0; i < 32; ++i) { const int kk = 2 * i + (lane >> 5); float v = tv[i]; if (kscale) v *= kscale[k0 + kk]; scr[kk * 33 + (lane & 31)] = v; }
    LDS_WAIT(); asm volatile("" ::: "memory");
    const int c = lane & 7;
#pragma unroll
    for (int j = 0; j < 4; ++j) { const int n = (lane >> 3) + 8 * j; const LAS float* s = scr + (8 * c) * 33 + n;
        v4u o; o.x = pk2(s[0 * 33], s[1 * 33]); o.y = pk2(s[2 * 33], s[3 * 33]); o.z = pk2(s[4 * 33], s[5 * 33]); o.w = pk2(s[6 * 33], s[7 * 33]);
        *(v4u*)(WT + (size_t)dest_row<MODE>(n0 + n) * K + k0 + 8 * c) = o; }
    LDS_WAIT(); asm volatile("s_waitcnt vmcnt(0)" ::: "memory");
}

__device__ __forceinline__ unsigned pk4_fp8(float a, float b, float c, float d) { int w = 0; w = __builtin_amdgcn_cvt_pk_fp8_f32(a, b, w, false); w = __builtin_amdgcn_cvt_pk_fp8_f32(c, d, w, true); return (unsigned)w; }
template <int MODE>
__device__ __forceinline__ void transpose_item8(const float* W, int ldw, int K, int N, unsigned char* WT, LAS float* scr, int item, int lane) {
    const int nblk = N / 32, kb = item / nblk, nb = item % nblk, k0 = 64 * kb, n0 = 32 * nb;
    float tv[32];
#pragma unroll
    for (int i = 0; i < 32; ++i) { const int kk = 2 * i + (lane >> 5); tv[i] = W[(size_t)(k0 + kk) * ldw + n0 + (lane & 31)]; }
#pragma unroll
    for (int i = 0; i < 32; ++i) { const int kk = 2 * i + (lane >> 5); scr[kk * 33 + (lane & 31)] = tv[i] * 256.0f; }
    LDS_WAIT(); asm volatile("" ::: "memory");
    const int c = lane & 7;
#pragma unroll
    for (int j = 0; j < 4; ++j) { const int n = (lane >> 3) + 8 * j; const LAS float* s = scr + (8 * c) * 33 + n;
        v2u o; o.x = pk4_fp8(s[0 * 33], s[1 * 33], s[2 * 33], s[3 * 33]); o.y = pk4_fp8(s[4 * 33], s[5 * 33], s[6 * 33], s[7 * 33]);
        *(v2u*)(WT + (size_t)dest_row<MODE>(n0 + n) * K + k0 + 8 * c) = o; }
    LDS_WAIT(); asm volatile("s_waitcnt vmcnt(0)" ::: "memory");
}

__device__ __forceinline__ void phase_prologue(Frame& F, const Args& A) {
    {
        const float* cc = A.in[I_C]; float* mod = (float*)(F.ws + WS_MOD);
        LAS float* red = (LAS float*)F.lds;
        for (int id = F.vcu; id < 2 * 96; id += F.G) {
            const int l = id / 96, ch = id % 96, cg = F.tid & 31, kg = F.tid >> 5, col = ch * 128 + cg * 4;
            const float* w = A.in[I_ADAW] + (size_t)l * DM * 12288 + col;
            f32x4 acc[4] = {};
#pragma unroll 4
            for (int kk = 0; kk < 128; ++kk) { const int k = kg * 128 + kk; const f32x4 wv = *(const f32x4*)(w + (size_t)k * 12288);
#pragma unroll
                for (int b = 0; b < 4; ++b) { const float cv = cc[b * DM + k]; const float ca = cv / (1.0f + __expf(-cv)); acc[b] += wv * ca; } }
#pragma unroll
            for (int b = 0; b < 4; ++b) *(LAS f32x4*)(red + ((kg * 32 + cg) * 16 + b * 4)) = acc[b];
            __syncthreads();
            if (F.tid < 128) { const int cg2 = F.tid & 31, b = F.tid >> 5; f32x4 s = {0.f, 0.f, 0.f, 0.f};
#pragma unroll
                for (int g = 0; g < 16; ++g) s += *(LAS f32x4*)(red + ((g * 32 + cg2) * 16 + b * 4));
                const int c2 = ch * 128 + cg2 * 4; const f32x4 bv = *(const f32x4*)(A.in[I_ADAB] + (size_t)l * 12288 + c2);
                *(f32x4*)(mod + ((size_t)l * 4 + b) * 12288 + c2) = s + bv; }
            asm volatile("s_waitcnt vmcnt(0)" ::: "memory");
            __syncthreads();
        }
    }
    {
        LAS float* scr = (LAS float*)(F.lds + F.wave * 16384);
        const int gw = F.vcu * NWAVES + F.wave, NGW = F.G * NWAVES;
        constexpr int I_IN = (DM / 64) * (IN_COLS / 32), I_UQ = (512 / 64) * (1536 / 32), I_UKV = (256 / 64) * (2048 / 32), I_OUT = (DM / 64) * (DM / 32), I_L = I_IN + I_UQ + I_UKV + I_OUT;
        for (int it = gw; it < 2 * I_L; it += NGW) {
            const int l = it / I_L; int r = it % I_L;
            if (r < I_IN) { transpose_item<1>(A.in[I_WIN] + (size_t)l * DM * IN_COLS, IN_COLS, DM, IN_COLS, (bf16*)(F.ws + WS_WIN) + (size_t)l * 4096 * DM, nullptr, scr, r, F.lane); continue; } r -= I_IN;
            if (r < I_UQ) { transpose_item<2>(A.in[I_WUQ] + (size_t)l * 512 * 1536, 1536, 512, 1536, (bf16*)(F.ws + WS_WUQ) + (size_t)l * 1536 * 512, A.in[I_QNG] + l * 512, scr, r, F.lane); continue; } r -= I_UQ;
            if (r < I_UKV) { transpose_item<0>(A.in[I_WUKV] + (size_t)l * 256 * 2048, 2048, 256, 2048, (bf16*)(F.ws + WS_WUKV) + (size_t)l * 2048 * 256, A.in[I_KVNG] + l * 256, scr, r, F.lane); continue; } r -= I_UKV;
#ifdef G3_FP8
            transpose_item8<0>(A.in[I_WOUT] + (size_t)l * DM * DM, DM, DM, DM, F.ws + WS_WOUT + (size_t)l * DM * DM, scr, r, F.lane);
#else
            transpose_item<0>(A.in[I_WOUT] + (size_t)l * DM * DM, DM, DM, DM, (bf16*)(F.ws + WS_WOUT) + (size_t)l * DM * DM, nullptr, scr, r, F.lane);
#endif
        }
    }
    {
        const int gt = F.vcu * (NWAVES * 64) + F.tid, NGT = F.G * NWAVES * 64;
        float* rope = (float*)(F.ws + WS_ROPE);
        for (int e = gt; e < SEQ * 32; e += NGT) { const int pos = e >> 5, i = e & 31;
            const float ang = (float)pos * A.invf[i];
            const double rev = (double)ang * 0.15915494309189535; const float fr = (float)(rev - __builtin_floor(rev));
            *(f32x2*)(rope + (size_t)e * 2) = (f32x2){__builtin_amdgcn_cosf(fr), __builtin_amdgcn_sinf(fr)}; }
        for (int e = gt; e < 2 * 192 * (DM / 8); e += NGT) { const int l = e / (192 * (DM / 8)), r = e % (192 * (DM / 8));
            *(v4u*)((bf16*)(F.ws + WS_WIN) + ((size_t)l * 4096 + IN_COLS) * DM + (size_t)r * 8) = (v4u){0u, 0u, 0u, 0u}; }
    }
}

__device__ __forceinline__ void phase_norm1(Frame& F, const Args& A, int l) {
    const int gw = F.vcu * NWAVES + F.wave, NGW = F.G * NWAVES;
    const float* mod = (const float*)(F.ws + WS_MOD);
    bf16* H = (bf16*)(F.ws + WS_H); const bf16* Y = (const bf16*)(F.ws + WS_Y);
#ifdef THIN_MLP
    for (int ch = gw; ch < T / 16; ch += NGW) {
        const int row0 = ch * 16, b = row0 >> 13;
        const float* ml = mod + ((size_t)l * 4 + b) * 12288;
#pragma unroll 1
        for (int rr = 0; rr < 16; rr += 2) {
            f32x4 v[2][8];
            if (l == 0) {
#pragma unroll
                for (int q = 0; q < 2; ++q)
#pragma unroll
                    for (int j = 0; j < 8; ++j) v[q][j] = *(const f32x4*)(A.in[I_X] + (size_t)(row0 + rr + q) * DM + 4 * F.lane + 256 * j);
            } else {
                bf16* XB = (bf16*)(F.ws + WS_XB);
                v2u xw[2][8], ya[2][8], yb[2][8]; f32x4 g2p[8];
#pragma unroll
                for (int q = 0; q < 2; ++q)
#pragma unroll
                    for (int j = 0; j < 8; ++j) { const int c = 4 * F.lane + 256 * j; const int row = row0 + rr + q;
                        xw[q][j] = *(const v2u*)(XB + (size_t)row * DM + c); ya[q][j] = *(const v2u*)(Y + (size_t)(2 * row) * DM + c); yb[q][j] = *(const v2u*)(Y + (size_t)(2 * row + 1) * DM + c); }
#pragma unroll
                for (int j = 0; j < 8; ++j) g2p[j] = *(const f32x4*)(mod + ((size_t)(l - 1) * 4 + b) * 12288 + 5 * DM + 4 * F.lane + 256 * j);
#pragma unroll
                for (int q = 0; q < 2; ++q)
#pragma unroll
                    for (int j = 0; j < 8; ++j) { const int c = 4 * F.lane + 256 * j; const int row = row0 + rr + q;
                        const f32x4 xr = {bf_lo(xw[q][j].x), bf_hi(xw[q][j].x), bf_lo(xw[q][j].y), bf_hi(xw[q][j].y)};
                        const v2u y0 = ya[q][j], y1 = yb[q][j];
                        const f32x4 ys = {bf_lo(y0.x) + bf_lo(y1.x), bf_hi(y0.x) + bf_hi(y1.x), bf_lo(y0.y) + bf_lo(y1.y), bf_hi(y0.y) + bf_hi(y1.y)};
                        const f32x4 t = xr + g2p[j] * ys;
                        const v2u ow = {pk2(t.x, t.y), pk2(t.z, t.w)}; *(v2u*)(XB + (size_t)row * DM + c) = ow;
                        v[q][j] = (f32x4){bf_lo(ow.x), bf_hi(ow.x), bf_lo(ow.y), bf_hi(ow.y)}; }
            }
            float rstd[2];
#pragma unroll
            for (int q = 0; q < 2; ++q) { float s = 0.f;
#pragma unroll
                for (int j = 0; j < 8; ++j) s += (v[q][j].x * v[q][j].x + v[q][j].y * v[q][j].y) + (v[q][j].z * v[q][j].z + v[q][j].w * v[q][j].w);
                rstd[q] = __builtin_amdgcn_rsqf(wave_sum(s) * (1.f / DM) + EPS); }
#pragma unroll
            for (int j = 0; j < 8; ++j) { const int c = 4 * F.lane + 256 * j;
                const f32x4 gsc = *(const f32x4*)(A.in[I_N1G] + l * DM + c) * (*(const f32x4*)(ml + 1 * DM + c) + 1.0f), sh = *(const f32x4*)(ml + 0 * DM + c);
#pragma unroll
                for (int q = 0; q < 2; ++q) { const f32x4 o = v[q][j] * rstd[q] * gsc + sh;
                    *(v2u*)(H + (size_t)(row0 + rr + q) * DM + c) = (v2u){pk2(o.x, o.y), pk2(o.z, o.w)}; } }
        }
    }
#else
    for (int ch = gw; ch < T / 16; ch += NGW) {
        const int row0 = ch * 16, b = row0 >> 13;
        const float* ml = mod + ((size_t)l * 4 + b) * 12288;
        f32x4 gsc[8], sh[8], g2p[8];
#pragma unroll
        for (int j = 0; j < 8; ++j) { const int c = 4 * F.lane + 256 * j; const f32x4 g = *(const f32x4*)(A.in[I_N1G] + l * DM + c), sc = *(const f32x4*)(ml + 1 * DM + c);
            gsc[j] = g * (sc + 1.0f); sh[j] = *(const f32x4*)(ml + 0 * DM + c);
            if (l > 0) g2p[j] = *(const f32x4*)(mod + ((size_t)(l - 1) * 4 + b) * 12288 + 5 * DM + c); }
#pragma unroll 1
        for (int rr = 0; rr < 16; ++rr) {
            const int row = row0 + rr; f32x4 v[8]; float s = 0.f;
            if (l == 0) {
#pragma unroll
                for (int j = 0; j < 8; ++j) v[j] = *(const f32x4*)(A.in[I_X] + (size_t)row * DM + 4 * F.lane + 256 * j);
            } else {
#pragma unroll
                for (int j = 0; j < 8; ++j) { const int c = 4 * F.lane + 256 * j;
#ifdef XRES_BF16
                    bf16* XB = (bf16*)(F.ws + WS_XB); const v2u xw = *(const v2u*)(XB + (size_t)row * DM + c); const f32x4 xr = {bf_lo(xw.x), bf_hi(xw.x), bf_lo(xw.y), bf_hi(xw.y)};
#else
                    const f32x4 xr = *(const f32x4*)(A.out + (size_t)row * DM + c);
#endif
                    const v2u y0 = *(const v2u*)(Y + (size_t)(2 * row) * DM + c), y1 = *(const v2u*)(Y + (size_t)(2 * row + 1) * DM + c);
                    const f32x4 ys = {bf_lo(y0.x) + bf_lo(y1.x), bf_hi(y0.x) + bf_hi(y1.x), bf_lo(y0.y) + bf_lo(y1.y), bf_hi(y0.y) + bf_hi(y1.y)};
                    v[j] = xr + g2p[j] * ys;
#ifdef XRES_BF16
                    { const v2u ow = {pk2(v[j].x, v[j].y), pk2(v[j].z, v[j].w)}; *(v2u*)(XB + (size_t)row * DM + c) = ow;
                      v[j] = (f32x4){bf_lo(ow.x), bf_hi(ow.x), bf_lo(ow.y), bf_hi(ow.y)}; }
#else
                    *(f32x4*)(A.out + (size_t)row * DM + c) = v[j];
#endif
                }
            }
#pragma unroll
            for (int j = 0; j < 8; ++j) s += (v[j].x * v[j].x + v[j].y * v[j].y) + (v[j].z * v[j].z + v[j].w * v[j].w);
            const float rstd = __builtin_amdgcn_rsqf(wave_sum(s) * (1.f / DM) + EPS);
#pragma unroll
            for (int j = 0; j < 8; ++j) { const f32x4 o = v[j] * rstd * gsc[j] + sh[j];
                *(v2u*)(H + (size_t)row * DM + 4 * F.lane + 256 * j) = (v2u){pk2(o.x, o.y), pk2(o.z, o.w)}; }
        }
    }
#endif
#ifndef ATT_CONV
    {
        LAS float* scr = (LAS float*)(F.lds + F.wave * 16384);
        constexpr int I_G = (DM / 64) * (DEXP / 32), I_D = (DEXP / 64) * (DM / 32), I_E = 2 * I_G + I_D;
        for (int it = gw; it < NEXP * I_E; it += NGW) {
            const int e = it / I_E; int r = it % I_E; const size_t eo = ((size_t)l * NEXP + e) * DM * DEXP;
            if (r < I_G) { transpose_item8<3>(A.in[I_EG] + eo, DEXP, DM, DEXP, F.ws + WS_W13 + (size_t)e * 2048 * DM, scr, r, F.lane); continue; } r -= I_G;
            if (r < I_G) { transpose_item8<4>(A.in[I_EU] + eo, DEXP, DM, DEXP, F.ws + WS_W13 + (size_t)e * 2048 * DM, scr, r, F.lane); continue; } r -= I_G;
            transpose_item8<0>(A.in[I_ED] + eo, DM, DEXP, DM, F.ws + WS_W2 + (size_t)e * DM * DEXP, scr, r, F.lane);
        }
    }
#endif
}
__device__ __forceinline__ void phase_final(Frame& F, const Args& A, int probe) {
    const int gw = F.vcu * NWAVES + F.wave, NGW = F.G * NWAVES;
    const float* mod = (const float*)(F.ws + WS_MOD); const bf16* Y = (const bf16*)(F.ws + WS_Y);
    for (int ch = gw; ch < T / 16; ch += NGW) {
        const int row0 = ch * 16, b = row0 >> 13;
#if defined(THIN_MLP) && defined(XRES_BF16)
#pragma unroll 1
        for (int rr = 0; rr < 16; rr += 2) {
            v2u xw[2][8], ya[2][8], yb[2][8]; f32x4 g2p[8]; f32x4 v[2][8];
#pragma unroll
            for (int q = 0; q < 2; ++q)
#pragma unroll
                for (int j = 0; j < 8; ++j) { const int c = 4 * F.lane + 256 * j; const int row = row0 + rr + q;
                    xw[q][j] = *(const v2u*)((const bf16*)(F.ws + WS_XB) + (size_t)row * DM + c); ya[q][j] = *(const v2u*)(Y + (size_t)(2 * row) * DM + c); yb[q][j] = *(const v2u*)(Y + (size_t)(2 * row + 1) * DM + c); }
#pragma unroll
            for (int j = 0; j < 8; ++j) g2p[j] = *(const f32x4*)(mod + ((size_t)(probe == 3 ? 0 : DEPTH - 1) * 4 + b) * 12288 + 5 * DM + 4 * F.lane + 256 * j);
            float rstd[2];
#pragma unroll
            for (int q = 0; q < 2; ++q) { float s = 0.f;
#pragma unroll
                for (int j = 0; j < 8; ++j) { const f32x4 xr = {bf_lo(xw[q][j].x), bf_hi(xw[q][j].x), bf_lo(xw[q][j].y), bf_hi(xw[q][j].y)};
                    const v2u y0 = ya[q][j], y1 = yb[q][j];
                    const f32x4 ys = {bf_lo(y0.x) + bf_lo(y1.x), bf_hi(y0.x) + bf_hi(y1.x), bf_lo(y0.y) + bf_lo(y1.y), bf_hi(y0.y) + bf_hi(y1.y)};
                    v[q][j] = (probe == 1 || probe == 2) ? xr : xr + g2p[j] * ys; }
#pragma unroll
                for (int j = 0; j < 8; ++j) s += (v[q][j].x * v[q][j].x + v[q][j].y * v[q][j].y) + (v[q][j].z * v[q][j].z + v[q][j].w * v[q][j].w);
                rstd[q] = __builtin_amdgcn_rsqf(wave_sum(s) * (1.f / DM) + EPS); }
#pragma unroll
            for (int j = 0; j < 8; ++j) { const int c = 4 * F.lane + 256 * j; const f32x4 fg = *(const f32x4*)(A.in[I_FG] + c);
#pragma unroll
                for (int q = 0; q < 2; ++q) *(f32x4*)(A.out + (size_t)(row0 + rr + q) * DM + c) = v[q][j] * rstd[q] * fg; }
        }
#else
        f32x4 fg[8], g2p[8];
#pragma unroll
        for (int j = 0; j < 8; ++j) { const int c = 4 * F.lane + 256 * j; fg[j] = *(const f32x4*)(A.in[I_FG] + c); g2p[j] = *(const f32x4*)(mod + ((size_t)(probe == 3 ? 0 : DEPTH - 1) * 4 + b) * 12288 + 5 * DM + c); }
#pragma unroll 1
        for (int rr = 0; rr < 16; ++rr) {
            const int row = row0 + rr; f32x4 v[8]; float s = 0.f;
#pragma unroll
            for (int j = 0; j < 8; ++j) { const int c = 4 * F.lane + 256 * j;
#ifdef XRES_BF16
                const v2u xw = *(const v2u*)((const bf16*)(F.ws + WS_XB) + (size_t)row * DM + c); const f32x4 xr = {bf_lo(xw.x), bf_hi(xw.x), bf_lo(xw.y), bf_hi(xw.y)};
#else
                const f32x4 xr = *(const f32x4*)((probe == 2 ? A.in[I_X] : A.out) + (size_t)row * DM + c);
#endif
                const v2u y0 = *(const v2u*)(Y + (size_t)(2 * row) * DM + c), y1 = *(const v2u*)(Y + (size_t)(2 * row + 1) * DM + c);
                const f32x4 ys = {bf_lo(y0.x) + bf_lo(y1.x), bf_hi(y0.x) + bf_hi(y1.x), bf_lo(y0.y) + bf_lo(y1.y), bf_hi(y0.y) + bf_hi(y1.y)};
                v[j] = (probe == 1 || probe == 2) ? xr : xr + g2p[j] * ys; }
#pragma unroll
            for (int j = 0; j < 8; ++j) s += (v[j].x * v[j].x + v[j].y * v[j].y) + (v[j].z * v[j].z + v[j].w * v[j].w);
            const float rstd = __builtin_amdgcn_rsqf(wave_sum(s) * (1.f / DM) + EPS);
#pragma unroll
            for (int j = 0; j < 8; ++j) *(f32x4*)(A.out + (size_t)row * DM + 4 * F.lane + 256 * j) = v[j] * rstd * fg[j];
        }
#endif
    }
}
#ifndef PROBE_DUMP_SCALE
#define PROBE_DUMP_SCALE 1.0f
#endif
#ifndef PROBE_DUMP_W
#define PROBE_DUMP_W 2048
#endif
__device__ __forceinline__ void phase_dump(Frame& F, const Args& A, size_t off, int pitch) {
    const int gw = F.vcu * NWAVES + F.wave, NGW = F.G * NWAVES;
    for (int row = gw; row < T; row += NGW) { const bf16* src = (const bf16*)(F.ws + off) + (size_t)row * pitch;
#ifdef PROBE_DUMP_F32
        for (int j = 0; j < 8; ++j) { const int c = 4 * F.lane + 256 * j; const float* sf = (const float*)(F.ws + off) + (size_t)row * pitch + c;
#ifdef PROBE_DUMP_SRC_OUT
            sf = A.out + (size_t)row * DM + c;
#endif
            f32x4 o = {0.f, 0.f, 0.f, 0.f}; if (c < PROBE_DUMP_W) o = *(const f32x4*)sf * PROBE_DUMP_SCALE;
#ifdef PROBE_DUMP_LOWBITS
            { const v4u ub = __builtin_bit_cast(v4u, o); o = (f32x4){(float)(ub.x & 0xFFFu), (float)(ub.y & 0xFFFu), (float)(ub.z & 0xFFFu), (float)(ub.w & 0xFFFu)}; }
#endif
            *(f32x4*)(A.out + (size_t)row * DM + c) = o; }
        continue;
#endif
        for (int j = 0; j < 8; ++j) { const int c = 4 * F.lane + 256 * j; const v2u w = *(const v2u*)(src + c);
#ifdef PROBE_DUMP_LOWBITS
            *(f32x4*)(A.out + (size_t)row * DM + c) = c < PROBE_DUMP_W ? (f32x4){(float)(w.x & 0x7Fu), (float)((w.x >> 16) & 0x7Fu), (float)(w.y & 0x7Fu), (float)((w.y >> 16) & 0x7Fu)} : (f32x4){0.f, 0.f, 0.f, 0.f}; } }
#else
            *(f32x4*)(A.out + (size_t)row * DM + c) = c < PROBE_DUMP_W ? (f32x4){bf_lo(w.x), bf_hi(w.x), bf_lo(w.y), bf_hi(w.y)} : (f32x4){0.f, 0.f, 0.f, 0.f}; } }
#endif
}
__device__ __forceinline__ void phase_mla_prep(Frame& F, const Args& A) {
    const int gw = F.vcu * NWAVES + F.wave, NGW = F.G * NWAVES;
    const bf16* P = (const bf16*)(F.ws + WS_PROJ); bf16* KF = (bf16*)(F.ws + WS_KF);
    float* rq = (float*)(F.ws + WS_RSTDQ); float* rkv = (float*)(F.ws + WS_RSTDKV); const float* rope = (const float*)(F.ws + WS_ROPE);
    for (int ch = gw; ch < T / 16; ch += NGW) {
#pragma unroll 1
        for (int r4 = 0; r4 < 16; r4 += 4) {
            v4u q[4]; v2u kv[4]; unsigned kr[4]; f32x2 cs[4];
#pragma unroll
            for (int u = 0; u < 4; ++u) { const int row = ch * 16 + r4 + u; const bf16* pr = P + (size_t)row * PROJ_LD;
                q[u] = *(const v4u*)(pr + C_CQ + 8 * F.lane); kv[u] = *(const v2u*)(pr + C_CKV + 4 * F.lane);
                kr[u] = *(const unsigned*)(pr + C_KR + 2 * (F.lane & 31)); cs[u] = *(const f32x2*)(rope + ((size_t)(row & (SEQ - 1)) * 32 + (F.lane & 31)) * 2); }
#pragma unroll
            for (int u = 0; u < 4; ++u) { const int row = ch * 16 + r4 + u;
                float sq = 0.f, skv = 0.f;
#pragma unroll
                for (int i = 0; i < 4; ++i) { const float a = bf_lo(q[u][i]), b2 = bf_hi(q[u][i]); sq += a * a + b2 * b2; }
#pragma unroll
                for (int i = 0; i < 2; ++i) { const float a = bf_lo(kv[u][i]), b2 = bf_hi(kv[u][i]); skv += a * a + b2 * b2; }
                sq = wave_sum(sq); skv = wave_sum(skv);
                if (F.lane == 0) { rq[row] = __builtin_amdgcn_rsqf(sq * (1.f / 512.f) + EPS); rkv[row] = __builtin_amdgcn_rsqf(skv * (1.f / 256.f) + EPS); }
                if (F.lane < 32) { const float x1 = bf_lo(kr[u]), x2 = bf_hi(kr[u]);
                    const unsigned o = pk2(x1 * cs[u].x - x2 * cs[u].y, x2 * cs[u].x + x1 * cs[u].y);
#pragma unroll
                    for (int h = 0; h < 8; ++h) *(unsigned*)(KF + (size_t)row * 1536 + h * 192 + 128 + 2 * F.lane) = o; } }
        }
    }
}
__device__ __forceinline__ void phase_q_rope(Frame& F, const Args& A) {
    const int gw = F.vcu * NWAVES + F.wave, NGW = F.G * NWAVES;
    bf16* QA = (bf16*)(F.ws + WS_QA); const float* rope = (const float*)(F.ws + WS_ROPE);
    for (int ch = gw; ch < T / 16; ch += NGW) {
#pragma unroll 1
        for (int r4 = 0; r4 < 16; r4 += 4) {
            v4u w[4]; f32x4 c01[4], c23[4];
#pragma unroll
            for (int u = 0; u < 4; ++u) { const int row = ch * 16 + r4 + u;
                w[u] = *(const v4u*)(QA + (size_t)row * 1536 + (F.lane >> 3) * 192 + 128 + (F.lane & 7) * 8);
                const f32x4* cs = (const f32x4*)(rope + ((size_t)(row & (SEQ - 1)) * 32 + (F.lane & 7) * 4) * 2); c01[u] = cs[0]; c23[u] = cs[1]; }
#pragma unroll
            for (int u = 0; u < 4; ++u) { const int row = ch * 16 + r4 + u; v4u o;
                { const float x1 = bf_lo(w[u].x), x2 = bf_hi(w[u].x); o.x = pk2(x1 * c01[u][0] - x2 * c01[u][1], x2 * c01[u][0] + x1 * c01[u][1]); }
                { const float x1 = bf_lo(w[u].y), x2 = bf_hi(w[u].y); o.y = pk2(x1 * c01[u][2] - x2 * c01[u][3], x2 * c01[u][2] + x1 * c01[u][3]); }
                { const float x1 = bf_lo(w[u].z), x2 = bf_hi(w[u].z); o.z = pk2(x1 * c23[u][0] - x2 * c23[u][1], x2 * c23[u][0] + x1 * c23[u][1]); }
                { const float x1 = bf_lo(w[u].w), x2 = bf_hi(w[u].w); o.w = pk2(x1 * c23[u][2] - x2 * c23[u][3], x2 * c23[u][2] + x1 * c23[u][3]); }
                *(v4u*)(QA + (size_t)row * 1536 + (F.lane >> 3) * 192 + 128 + (F.lane & 7) * 8) = o; }
        }
    }
}
__device__ __forceinline__ void phase_out_norm(Frame& F, const Args& A, int l) {
    const int gw = F.vcu * NWAVES + F.wave, NGW = F.G * NWAVES;
    const bf16* OA = (const bf16*)(F.ws + WS_OA); const bf16* OB = (const bf16*)(F.ws + WS_OB); const float* LSE = (const float*)(F.ws + WS_LSE); bf16* Yn = (bf16*)(F.ws + WS_H);
    for (int ch = gw; ch < T / 16; ch += NGW) {
        float ga[2][8], gb[2][8];
#pragma unroll
        for (int hf = 0; hf < 2; ++hf)
#pragma unroll
            for (int i = 0; i < 8; ++i) { ga[hf][i] = A.in[I_ONA][l * 1024 + hf * 512 + 8 * F.lane + i]; gb[hf][i] = A.in[I_ONB][l * 1024 + hf * 512 + 8 * F.lane + i]; }
#ifdef THIN_MLP
#pragma unroll 1
        for (int rr = 0; rr < 16; rr += 2) {
            v4u ra_[2][2], ro_[2][2][3]; float ls_[2][2][3];
#pragma unroll
            for (int q = 0; q < 2; ++q)
#pragma unroll
                for (int hf = 0; hf < 2; ++hf) { const int row = ch * 16 + rr + q, c = hf * 512 + 8 * F.lane, hd = c >> 7;
                    ra_[q][hf] = *(const v4u*)(OA + (size_t)row * 1024 + c);
#pragma unroll
                    for (int n = 0; n < 3; ++n) { ro_[q][hf][n] = *(const v4u*)(OB + ((size_t)n * T + row) * 1024 + c); ls_[q][hf][n] = LSE[((size_t)n * T + row) * 8 + hd]; } }
#pragma unroll
            for (int q = 0; q < 2; ++q) {
                const int row = ch * 16 + rr + q;
                float va[2][8], vb[2][8]; float sa = 0.f, sb = 0.f;
#pragma unroll
                for (int hf = 0; hf < 2; ++hf) {
                    const v4u a = ra_[q][hf];
#pragma unroll
                    for (int i = 0; i < 4; ++i) { va[hf][2 * i] = bf_lo(a[i]); va[hf][2 * i + 1] = bf_hi(a[i]); }
                    const float l0 = ls_[q][hf][0], l1 = ls_[q][hf][1], l2 = ls_[q][hf][2];
                    const float mx = fmaxf(l0, fmaxf(l1, l2)); const float e0 = __expf(l0 - mx), e1 = __expf(l1 - mx), e2 = __expf(l2 - mx); const float inv = 1.0f / (e0 + e1 + e2);
                    const float al[3] = {e0 * inv, e1 * inv, e2 * inv};
#pragma unroll
                    for (int i = 0; i < 8; ++i) vb[hf][i] = 0.f;
#pragma unroll
                    for (int n = 0; n < 3; ++n) { const v4u o = ro_[q][hf][n];
#pragma unroll
                        for (int i = 0; i < 4; ++i) { vb[hf][2 * i] += al[n] * bf_lo(o[i]); vb[hf][2 * i + 1] += al[n] * bf_hi(o[i]); } }
#pragma unroll
                    for (int i = 0; i < 8; ++i) { sa += va[hf][i] * va[hf][i]; sb += vb[hf][i] * vb[hf][i]; }
                }
                const float ra = __builtin_amdgcn_rsqf(wave_sum(sa) * (1.f / 1024.f) + EPS), rb = __builtin_amdgcn_rsqf(wave_sum(sb) * (1.f / 1024.f) + EPS);
#pragma unroll
                for (int hf = 0; hf < 2; ++hf) { const int c = hf * 512 + 8 * F.lane;
#ifdef G3_FP8
                    { unsigned char* Y8 = (unsigned char*)Yn; float ya[8], yb[8];
#pragma unroll
                      for (int i = 0; i < 8; ++i) { ya[i] = va[hf][i] * ra * ga[hf][i]; yb[i] = vb[hf][i] * rb * gb[hf][i]; }
                      *(v2u*)(Y8 + (size_t)row * DM + c) = (v2u){pk4_fp8(ya[0], ya[1], ya[2], ya[3]), pk4_fp8(ya[4], ya[5], ya[6], ya[7])};
                      *(v2u*)(Y8 + (size_t)row * DM + 1024 + c) = (v2u){pk4_fp8(yb[0], yb[1], yb[2], yb[3]), pk4_fp8(yb[4], yb[5], yb[6], yb[7])}; }
#else
                    { v4u wa, wb;
#pragma unroll
                      for (int i = 0; i < 4; ++i) { wa[i] = pk2(va[hf][2 * i] * ra * ga[hf][2 * i], va[hf][2 * i + 1] * ra * ga[hf][2 * i + 1]); wb[i] = pk2(vb[hf][2 * i] * rb * gb[hf][2 * i], vb[hf][2 * i + 1] * rb * gb[hf][2 * i + 1]); }
                      *(v4u*)(Yn + (size_t)row * DM + c) = wa; *(v4u*)(Yn + (size_t)row * DM + 1024 + c) = wb; }
#endif
                }
            }
        }
#else
#pragma unroll 1
        for (int rr = 0; rr < 16; ++rr) {
            const int row = ch * 16 + rr;
            float va[2][8], vb[2][8]; float sa = 0.f, sb = 0.f;
#pragma unroll
            for (int hf = 0; hf < 2; ++hf) {
                const int c = hf * 512 + 8 * F.lane, hd = c >> 7;
                const v4u a = *(const v4u*)(OA + (size_t)row * 1024 + c);
#pragma unroll
                for (int i = 0; i < 4; ++i) { va[hf][2 * i] = bf_lo(a[i]); va[hf][2 * i + 1] = bf_hi(a[i]); }
                const float l0 = LSE[((size_t)0 * T + row) * 8 + hd], l1 = LSE[((size_t)1 * T + row) * 8 + hd], l2 = LSE[((size_t)2 * T + row) * 8 + hd];
                const float mx = fmaxf(l0, fmaxf(l1, l2)); const float e0 = __expf(l0 - mx), e1 = __expf(l1 - mx), e2 = __expf(l2 - mx); const float inv = 1.0f / (e0 + e1 + e2);
                const float al[3] = {e0 * inv, e1 * inv, e2 * inv};
#pragma unroll
                for (int i = 0; i < 8; ++i) vb[hf][i] = 0.f;
#pragma unroll
                for (int n = 0; n < 3; ++n) { const v4u o = *(const v4u*)(OB + ((size_t)n * T + row) * 1024 + c);
#pragma unroll
                    for (int i = 0; i < 4; ++i) { vb[hf][2 * i] += al[n] * bf_lo(o[i]); vb[hf][2 * i + 1] += al[n] * bf_hi(o[i]); } }
#pragma unroll
                for (int i = 0; i < 8; ++i) { sa += va[hf][i] * va[hf][i]; sb += vb[hf][i] * vb[hf][i]; }
            }
            const float ra = __builtin_amdgcn_rsqf(wave_sum(sa) * (1.f / 1024.f) + EPS), rb = __builtin_amdgcn_rsqf(wave_sum(sb) * (1.f / 1024.f) + EPS);
#pragma unroll
            for (int hf = 0; hf < 2; ++hf) { const int c = hf * 512 + 8 * F.lane; v4u wa, wb;
#pragma unroll
                for (int i = 0; i < 4; ++i) { wa[i] = pk2(va[hf][2 * i] * ra * ga[hf][2 * i], va[hf][2 * i + 1] * ra * ga[hf][2 * i + 1]); wb[i] = pk2(vb[hf][2 * i] * rb * gb[hf][2 * i], vb[hf][2 * i + 1] * rb * gb[hf][2 * i + 1]); }
#ifdef G3_FP8
                { unsigned char* Y8 = (unsigned char*)Yn; float ya[8], yb[8];
#pragma unroll
                  for (int i = 0; i < 8; ++i) { ya[i] = va[hf][i] * ra * ga[hf][i]; yb[i] = vb[hf][i] * rb * gb[hf][i]; }
                  *(v2u*)(Y8 + (size_t)row * DM + c) = (v2u){pk4_fp8(ya[0], ya[1], ya[2], ya[3]), pk4_fp8(ya[4], ya[5], ya[6], ya[7])};
                  *(v2u*)(Y8 + (size_t)row * DM + 1024 + c) = (v2u){pk4_fp8(yb[0], yb[1], yb[2], yb[3]), pk4_fp8(yb[4], yb[5], yb[6], yb[7])}; }
#else
                *(v4u*)(Yn + (size_t)row * DM + c) = wa; *(v4u*)(Yn + (size_t)row * DM + 1024 + c) = wb;
#endif
            }
        }
#endif
    }
}
#ifndef ROUTER_SRC
#define ROUTER_SRC A.out
#endif
#ifdef ROUTER_MFMA
typedef short r_bf16x8 __attribute__((ext_vector_type(8)));
__device__ __forceinline__ void phase_router(Frame& F, const Args& A, int l, int dummy = 0) {
    const float* mod = (const float*)(F.ws + WS_MOD);
    bf16* H = (bf16*)(F.ws + WS_H);
    LAS int* lcnt = (LAS int*)(F.lds + L_CNT); LAS int* gbase = lcnt + 16; LAS int* tokinfo = (LAS int*)(F.lds + L_TOK);
    LAS float* lgs = (LAS float*)(F.lds + L_ATAB);
    LAS float* rsl = (LAS float*)(F.lds + L_ATAB + 8704);
    LAS float* wsm = (LAS float*)(F.lds + L_ATAB + 8704 + 512);
    LAS float* cstl = (LAS float*)(F.lds + L_ATAB + 8704 + 1024);
    unsigned* gcnt = F.ctl + CW_CNT + (dummy ? 3 : l) * 16;
    int* rowidx = (int*)(F.ws + (dummy ? WS_OB : WS_ROWIDX)); float* aw = (float*)(F.ws + (dummy ? WS_OB + 4 * MiB : WS_AW));
    float rb[16];
#pragma unroll
    for (int e = 0; e < 16; ++e) rb[e] = __uint_as_float(__builtin_amdgcn_readfirstlane(__float_as_uint(A.in[I_RB][e])));
    for (int bi = F.vcu; bi < T / 128; bi += F.G) {
        const int row0 = bi * 128 + F.wave * 16, b = row0 >> 13;
        const rsrc_t rml = RSRC(mod + ((size_t)l * 4 + b) * 12288), rgn = RSRC(A.in[I_N2G] + l * DM), rh = RSRC(H), rxb = RSRC(F.ws + WS_XB), rrw = RSRC(A.in[I_RW]);
        __syncthreads();
        { const int t0_ = F.wave * 64 + lane_id(); if (t0_ < 16) lcnt[t0_] = 0;
          const int e4 = t0_ & 3; f32x4 ca = {0.f, 0.f, 0.f, 0.f};
#pragma unroll 4
          for (int i = 0; i < 16; ++i) { const int k = (t0_ >> 2) + 128 * i;
              const f32x4 w4 = bld4f(rrw, (k * 16 + e4 * 4) * 4, 0);
              const float g = __uint_as_float(__builtin_amdgcn_raw_buffer_load_b32(rgn, k * 4, 0, 0)) * (__uint_as_float(__builtin_amdgcn_raw_buffer_load_b32(rml, k * 4, 4 * DM * 4, 0)) + 1.0f);
              const float sh = __uint_as_float(__builtin_amdgcn_raw_buffer_load_b32(rml, k * 4, 3 * DM * 4, 0));
              ca += w4 * sh;
              const int ob = (k >> 5) * 1024 + (((k >> 3) & 3) * 16 + e4 * 4) * 16 + (k & 7) * 2;
#pragma unroll
              for (int c = 0; c < 4; ++c) { const float wp = w4[c] * g; const unsigned hi = pk2(wp, 0.f) & 0xffffu; const float rem = wp - __uint_as_float(hi << 16);
                  *(LAS unsigned short*)(F.lds + ob + c * 16) = (unsigned short)hi; *(LAS unsigned short*)(F.lds + 65536 + ob + c * 16) = (unsigned short)(pk2(rem, 0.f) & 0xffffu); } }
          const int ln = t0_ & 63;
#pragma unroll
          for (int q = 0; q < 4; ++q)
#pragma unroll
              for (int c = 0; c < 4; ++c) { const float s = wave_sum((ln & 3) == q ? ca[c] : 0.f); if (ln == 0) wsm[F.wave * 16 + q * 4 + c] = s; }
        }
        __syncthreads();
        { const int t0_ = F.wave * 64 + lane_id(); if (t0_ < 16) { float s = 0.f;
#pragma unroll
              for (int w = 0; w < 8; ++w) s += wsm[w * 16 + t0_];
              cstl[t0_] = s; } }
        __syncthreads();
        const int lo16 = F.lane * 16, lo8 = F.lane * 8;
        f32x4 gsv[8];
#pragma unroll
        for (int j = 0; j < 8; ++j) gsv[j] = bld4f(rgn, lo16 + j * 1024, 0) * (bld4f(rml, lo16 + j * 1024, 4 * DM * 4) + 1.0f);
#pragma unroll 1
        for (int rp = 0; rp < 8; ++rp) {
            float ss[2] = {0.f, 0.f};
            v2u xraw[2][8];
#pragma unroll
            for (int q = 0; q < 2; ++q)
#pragma unroll
                for (int j = 0; j < 8; ++j) xraw[q][j] = bld2u(rxb, lo8 + j * 512, (row0 + rp * 2 + q) * (DM * 2));
#define XV(q, j) ((f32x4){bf_lo(xraw[q][j].x), bf_hi(xraw[q][j].x), bf_lo(xraw[q][j].y), bf_hi(xraw[q][j].y)})
            f32x4 shv[8];
#pragma unroll
            for (int j = 0; j < 8; ++j) shv[j] = bld4f(rml, lo16 + j * 1024, 3 * DM * 4);
#pragma unroll
            for (int j = 0; j < 8; ++j)
#pragma unroll
                for (int q = 0; q < 2; ++q) { const f32x4 x = XV(q, j); ss[q] += (x.x * x.x + x.y * x.y) + (x.z * x.z + x.w * x.w); }
            float rstd[2];
#pragma unroll
            for (int q = 0; q < 2; ++q) rstd[q] = __builtin_amdgcn_rsqf(wave_sum(ss[q]) * (1.f / DM) + EPS);
            if (F.lane == 0) { rsl[F.wave * 16 + rp * 2] = rstd[0]; rsl[F.wave * 16 + rp * 2 + 1] = rstd[1]; }
#pragma unroll
            for (int j = 0; j < 8; ++j) {
#pragma unroll
                for (int q = 0; q < 2; ++q) { const f32x4 o = XV(q, j) * rstd[q] * gsv[j] + shv[j]; __builtin_amdgcn_raw_buffer_store_b32(pk4_fp8(o.x, o.y, o.z, o.w), rh, F.lane * 4 + j * 256, (row0 + rp * 2 + q) * DM, 0); } }
#undef XV
        }
        { const int ln = lane_id(), col = ln & 15, rq = ln >> 4;
          const int va = col * (DM * 2) + rq * 16, sa = row0 * (DM * 2);
          f32x4 acc = {0.f, 0.f, 0.f, 0.f};
          r_bf16x8 a0[8], a1[8];
#pragma unroll
          for (int i = 0; i < 8; ++i) a0[i] = __builtin_bit_cast(r_bf16x8, __builtin_amdgcn_raw_buffer_load_b128(rxb, va + i * 64, sa, 0));
#define RT_MM(AR, sb) do { _Pragma("unroll") for (int i = 0; i < 8; ++i) { const int st = (sb) * 8 + i; \
              const r_bf16x8 bh = *(const LAS r_bf16x8*)(F.lds + st * 1024 + ln * 16), bl = *(const LAS r_bf16x8*)(F.lds + 65536 + st * 1024 + ln * 16); \
              acc = __builtin_amdgcn_mfma_f32_16x16x32_bf16(AR[i], bh, acc, 0, 0, 0); acc = __builtin_amdgcn_mfma_f32_16x16x32_bf16(AR[i], bl, acc, 0, 0, 0); } } while (0)
#pragma unroll 1
          for (int sb = 0; sb < 8; sb += 2) {
#pragma unroll
              for (int i = 0; i < 8; ++i) a1[i] = __builtin_bit_cast(r_bf16x8, __builtin_amdgcn_raw_buffer_load_b128(rxb, va + ((sb + 1) * 8 + i) * 64, sa, 0));
              RT_MM(a0, sb);
              if (sb + 2 < 8) {
#pragma unroll
                  for (int i = 0; i < 8; ++i) a0[i] = __builtin_bit_cast(r_bf16x8, __builtin_amdgcn_raw_buffer_load_b128(rxb, va + ((sb + 2) * 8 + i) * 64, sa, 0)); }
              RT_MM(a1, sb + 1);
          }
#undef RT_MM
          LDS_WAIT();
          const float cs = cstl[col];
#pragma unroll
          for (int i = 0; i < 4; ++i) lgs[F.wave * 272 + (4 * rq + i) * 17 + col] = acc[i] * rsl[F.wave * 16 + 4 * rq + i] + cs;
          LDS_WAIT(); asm volatile("" ::: "memory");
          if (ln < 16) {
              float sc[16], bs[16];
#pragma unroll
              for (int e = 0; e < 16; ++e) { const float lg = lgs[F.wave * 272 + ln * 17 + e]; sc[e] = 1.0f / (1.0f + __expf(-lg)); bs[e] = sc[e] + rb[e]; }
              float gs4[4];
#pragma unroll
              for (int g = 0; g < 4; ++g) { const float a = bs[4 * g], b2 = bs[4 * g + 1], c = bs[4 * g + 2], d = bs[4 * g + 3];
                  const float h1 = fmaxf(a, b2), l1 = fminf(a, b2), h2 = fmaxf(c, d), l2 = fminf(c, d);
                  gs4[g] = fmaxf(h1, h2) + fmaxf(fminf(h1, h2), fmaxf(l1, l2)); }
              int gsel = 0; float gbest = gs4[0];
#pragma unroll
              for (int g = 1; g < 4; ++g) if (gs4[g] > gbest) { gbest = gs4[g]; gsel = g; }
              float bv[4], sv[4];
#pragma unroll
              for (int i = 0; i < 4; ++i) { bv[i] = gsel == 0 ? bs[i] : gsel == 1 ? bs[4 + i] : gsel == 2 ? bs[8 + i] : bs[12 + i]; sv[i] = gsel == 0 ? sc[i] : gsel == 1 ? sc[4 + i] : gsel == 2 ? sc[8 + i] : sc[12 + i]; }
              int i1 = 0; float b1 = bv[0], s1 = sv[0];
#pragma unroll
              for (int i = 1; i < 4; ++i) if (bv[i] > b1) { b1 = bv[i]; s1 = sv[i]; i1 = i; }
              int i2 = -1; float b2v = -__builtin_inff(), s2 = 0.f;
#pragma unroll
              for (int i = 0; i < 4; ++i) if (i != i1 && bv[i] > b2v) { b2v = bv[i]; s2 = sv[i]; i2 = i; }
              const float inv = 1.0f / (s1 + s2);
              const int r = F.wave * 16 + ln, e0 = gsel * 4 + i1, e1 = gsel * 4 + i2;
              tokinfo[r * 4 + 0] = e0; tokinfo[r * 4 + 2] = e1;
              const int row = row0 + ln; *(f32x2*)(aw + (size_t)row * 2) = (f32x2){s1 * inv, s2 * inv};
          }
        }
        __syncthreads();
        const int tb_ = F.wave * 64 + lane_id();
        if (tb_ < 16) {
            int c = 0;
            for (int r = 0; r < 128; ++r) { if (tokinfo[r * 4 + 0] == tb_) tokinfo[r * 4 + 1] = c++; if (tokinfo[r * 4 + 2] == tb_) tokinfo[r * 4 + 3] = c++; }
            gbase[tb_] = (int)__hip_atomic_fetch_add(gcnt + tb_, (unsigned)c, __ATOMIC_RELAXED, __HIP_MEMORY_SCOPE_AGENT); }
        __syncthreads();
        if (tb_ < 128) { const int e0 = tokinfo[tb_ * 4], p0 = tokinfo[tb_ * 4 + 1], e1 = tokinfo[tb_ * 4 + 2], p1 = tokinfo[tb_ * 4 + 3]; const int row = bi * 128 + tb_;
            rowidx[(size_t)e0 * 32768 + gbase[e0] + p0] = 2 * row; rowidx[(size_t)e1 * 32768 + gbase[e1] + p1] = 2 * row + 1; }
        __syncthreads();
    }
}
#else
__device__ __forceinline__ void phase_router(Frame& F, const Args& A, int l, int dummy = 0) {
    const float* mod = (const float*)(F.ws + WS_MOD);
    bf16* H = (bf16*)(F.ws + WS_H);
    LAS f32x4* rwl = (LAS f32x4*)F.lds;
    LAS int* lcnt = (LAS int*)(F.lds + L_CNT); LAS int* gbase = lcnt + 16; LAS int* tokinfo = (LAS int*)(F.lds + L_TOK);
    unsigned* gcnt = F.ctl + CW_CNT + (dummy ? 3 : l) * 16;
    int* rowidx = (int*)(F.ws + (dummy ? WS_OB : WS_ROWIDX)); float* aw = (float*)(F.ws + (dummy ? WS_OB + 4 * MiB : WS_AW));
    for (int q = F.tid; q < 8192; q += NWAVES * 64) { const int k = q >> 2, e4 = q & 3, ln = (k & 255) >> 2, j = k >> 8, i = k & 3;
        rwl[((j * 4 + i) * 4 + e4) * 64 + ln] = *(const f32x4*)(A.in[I_RW] + (size_t)k * 16 + e4 * 4); }
    float rb[16];
#pragma unroll
    for (int e = 0; e < 16; ++e) rb[e] = __uint_as_float(__builtin_amdgcn_readfirstlane(__float_as_uint(A.in[I_RB][e])));
    __syncthreads();
    for (int bi = F.vcu; bi < T / 128; bi += F.G) {
        { const int t0_ = F.wave * 64 + lane_id(); if (t0_ < 16) lcnt[t0_] = 0; }
        __syncthreads();
        const int row0 = bi * 128 + F.wave * 16, b = row0 >> 13;
        const rsrc_t rml = RSRC(mod + ((size_t)l * 4 + b) * 12288), rgn = RSRC(A.in[I_N2G] + l * DM), rx = RSRC(ROUTER_SRC), rh = RSRC(H);
#ifdef XRES_BF16
        const rsrc_t rxb = RSRC(F.ws + WS_XB);
#endif
        const int lo16 = F.lane * 16, lo8 = F.lane * 8;
        float cst[16];
        { f32x4 ca[4] = {};
#pragma unroll
          for (int j = 0; j < 8; ++j) { const f32x4 sh = bld4f(rml, lo16 + j * 1024, 3 * DM * 4);
#pragma unroll
            for (int i = 0; i < 4; ++i)
#pragma unroll
                for (int e4 = 0; e4 < 4; ++e4) ca[e4] += rwl[((j * 4 + i) * 4 + e4) * 64 + F.lane] * sh[i];
            asm volatile("" ::: "memory"); }
#pragma unroll
          for (int e = 0; e < 16; ++e) cst[e] = __uint_as_float(__builtin_amdgcn_readfirstlane(__float_as_uint(wave_sum(ca[e >> 2][e & 3])))); }
        f32x4 gsv[8];
#pragma unroll
        for (int j = 0; j < 8; ++j) gsv[j] = bld4f(rgn, lo16 + j * 1024, 0) * (bld4f(rml, lo16 + j * 1024, 4 * DM * 4) + 1.0f);
#pragma unroll 1
        for (int rp = 0; rp < 8; ++rp) {
            float ss[2] = {0.f, 0.f}; f32x4 acc[2][4] = {};
            const int so0 = (row0 + rp * 2) * (DM * 4);
#ifdef XRES_BF16
            v2u xraw[2][8];
#pragma unroll
            for (int q = 0; q < 2; ++q)
#pragma unroll
                for (int j = 0; j < 8; ++j) xraw[q][j] = bld2u(rxb, lo8 + j * 512, (row0 + rp * 2 + q) * (DM * 2));
#define XV(q, j) ((f32x4){bf_lo(xraw[q][j].x), bf_hi(xraw[q][j].x), bf_lo(xraw[q][j].y), bf_hi(xraw[q][j].y)})
#else
            f32x4 xv[2][8];
#pragma unroll
            for (int q = 0; q < 2; ++q)
#pragma unroll
                for (int j = 0; j < 8; ++j) xv[q][j] = bld4f(rx, lo16 + j * 1024, so0 + q * (DM * 4));
#define XV(q, j) xv[q][j]
#endif
#pragma unroll
            for (int j = 0; j < 8; ++j) {
                f32x4 a[2];
#pragma unroll
                for (int q = 0; q < 2; ++q) { const f32x4 x = XV(q, j); ss[q] += (x.x * x.x + x.y * x.y) + (x.z * x.z + x.w * x.w); a[q] = x * gsv[j]; }
#pragma unroll
                for (int i = 0; i < 4; ++i) {
#pragma unroll
                    for (int e4 = 0; e4 < 4; ++e4) { const f32x4 w = rwl[((j * 4 + i) * 4 + e4) * 64 + F.lane]; acc[0][e4] += w * a[0][i]; acc[1][e4] += w * a[1][i]; }
                    asm volatile("" : "+v"(acc[0][0]), "+v"(acc[0][1]), "+v"(acc[0][2]), "+v"(acc[0][3]), "+v"(acc[1][0]), "+v"(acc[1][1]), "+v"(acc[1][2]), "+v"(acc[1][3]) :: "memory"); } }
            float rstd[2];
#pragma unroll
            for (int q = 0; q < 2; ++q) rstd[q] = __builtin_amdgcn_rsqf(wave_sum(ss[q]) * (1.f / DM) + EPS);
            asm volatile("" ::: "memory");
            f32x4 shv[8];
#pragma unroll
            for (int j = 0; j < 8; ++j) shv[j] = bld4f(rml, lo16 + j * 1024, 3 * DM * 4);
#pragma unroll
            for (int j = 0; j < 8; ++j) {
#pragma unroll
                for (int q = 0; q < 2; ++q) { const f32x4 o = XV(q, j) * rstd[q] * gsv[j] + shv[j]; __builtin_amdgcn_raw_buffer_store_b32(pk4_fp8(o.x, o.y, o.z, o.w), rh, F.lane * 4 + j * 256, (row0 + rp * 2 + q) * DM, 0); } }
#undef XV
#pragma unroll
            for (int q = 0; q < 2; ++q) {
                float sc[16], bs[16];
#pragma unroll
                for (int e = 0; e < 16; ++e) { const float lg = wave_sum(acc[q][e >> 2][e & 3]) * rstd[q] + cst[e]; sc[e] = 1.0f / (1.0f + __expf(-lg)); bs[e] = sc[e] + rb[e]; }
                float gs4[4];
#pragma unroll
                for (int g = 0; g < 4; ++g) { const float a = bs[4 * g], b2 = bs[4 * g + 1], c = bs[4 * g + 2], d = bs[4 * g + 3];
                    const float h1 = fmaxf(a, b2), l1 = fminf(a, b2), h2 = fmaxf(c, d), l2 = fminf(c, d);
                    gs4[g] = fmaxf(h1, h2) + fmaxf(fminf(h1, h2), fmaxf(l1, l2)); }
                int gsel = 0; float gbest = gs4[0];
#pragma unroll
                for (int g = 1; g < 4; ++g) if (gs4[g] > gbest) { gbest = gs4[g]; gsel = g; }
                float bv[4], sv[4];
#pragma unroll
                for (int i = 0; i < 4; ++i) { bv[i] = gsel == 0 ? bs[i] : gsel == 1 ? bs[4 + i] : gsel == 2 ? bs[8 + i] : bs[12 + i]; sv[i] = gsel == 0 ? sc[i] : gsel == 1 ? sc[4 + i] : gsel == 2 ? sc[8 + i] : sc[12 + i]; }
                int i1 = 0; float b1 = bv[0], s1 = sv[0];
#pragma unroll
                for (int i = 1; i < 4; ++i) if (bv[i] > b1) { b1 = bv[i]; s1 = sv[i]; i1 = i; }
                int i2 = -1; float b2v = -__builtin_inff(), s2 = 0.f;
#pragma unroll
                for (int i = 0; i < 4; ++i) if (i != i1 && bv[i] > b2v) { b2v = bv[i]; s2 = sv[i]; i2 = i; }
                const float inv = 1.0f / (s1 + s2);
                if (F.lane == 0) {
                    const int r = F.wave * 16 + rp * 2 + q, e0 = gsel * 4 + i1, e1 = gsel * 4 + i2;
                    tokinfo[r * 4 + 0] = e0; tokinfo[r * 4 + 2] = e1;
                    const int row = row0 + rp * 2 + q; *(f32x2*)(aw + (size_t)row * 2) = (f32x2){s1 * inv, s2 * inv};
                }
            }
        }
        __syncthreads();
        const int tb_ = F.wave * 64 + lane_id();
        if (tb_ < 16) {
            int c = 0;
            for (int r = 0; r < 128; ++r) { if (tokinfo[r * 4 + 0] == tb_) tokinfo[r * 4 + 1] = c++; if (tokinfo[r * 4 + 2] == tb_) tokinfo[r * 4 + 3] = c++; }
            gbase[tb_] = (int)__hip_atomic_fetch_add(gcnt + tb_, (unsigned)c, __ATOMIC_RELAXED, __HIP_MEMORY_SCOPE_AGENT); }
        __syncthreads();
        if (tb_ < 128) { const int e0 = tokinfo[tb_ * 4], p0 = tokinfo[tb_ * 4 + 1], e1 = tokinfo[tb_ * 4 + 2], p1 = tokinfo[tb_ * 4 + 3]; const int row = bi * 128 + tb_;
            rowidx[(size_t)e0 * 32768 + gbase[e0] + p0] = 2 * row; rowidx[(size_t)e1 * 32768 + gbase[e1] + p1] = 2 * row + 1; }
        __syncthreads();
    }
}
#endif
__device__ __forceinline__ int moe_setup(Frame& F, int l) {
    LAS int* ts = (LAS int*)(F.lds + L_TS);
    if (F.tid == 0) { int s = 0; for (int e = 0; e < 16; ++e) { ts[e] = s; s += ((int)__hip_atomic_load(F.ctl + CW_CNT + l * 16 + e, __ATOMIC_RELAXED, __HIP_MEMORY_SCOPE_AGENT) + 255) >> 8; } ts[16] = s; }
    __syncthreads();
    return __builtin_amdgcn_readfirstlane(ts[16]);
}

__device__ __forceinline__ att::Blk mla_blk(int bh, int qb) {
    const int b = bh >> 3, h = bh & 7; att::Blk k;
    k.qo = (unsigned)(WS_QA + ((size_t)b * SEQ * 1536 + h * 192) * 2); k.ko = (unsigned)(WS_KF + ((size_t)b * SEQ * 1536 + h * 192) * 2);
    k.vo = (unsigned)(WS_VB + ((size_t)b * SEQ * 1024 + h * 128) * 2); k.oo = (unsigned)(WS_OA + ((size_t)b * SEQ * 1024 + h * 128) * 2); k.lo = 0;
    k.P0 = qb * 256; k.rate = 1; k.beta = 0.f;
    return k;
}
__device__ __forceinline__ att::Blk dil_blk(int bh, int br, int blk) {
    const int b = bh >> 3, h = bh & 7, rate = br == 0 ? 1 : br == 1 ? 4 : 16, nqb = 32 / rate, cls = blk / nqb, qb = blk % nqb; att::Blk k;
    const size_t tok0 = (size_t)b * SEQ + cls;
    const unsigned p = (unsigned)(WS_PROJ + (tok0 * PROJ_LD + h * 128) * 2);
    k.qo = p + C_QB * 2; k.ko = p + C_KB * 2; k.vo = p + C_VB * 2;
    k.oo = (unsigned)(WS_OB + (((size_t)br * T + tok0) * 1024 + h * 128) * 2);
    k.lo = (unsigned)(WS_LSE + (((size_t)br * T + tok0) * 8 + h) * 4);
    k.P0 = qb * 256; k.rate = rate;
    const float slope = __builtin_amdgcn_exp2f(-(float)(h + 1));
    k.beta = slope * (float)rate * 11.313708498984761f;
    return k;
}
__device__ __forceinline__ void mla_decode(int id, int& bh, int& qb0, int& qb1) {
    const int v = id & 255, i = id >> 8, x = v >> 5, c = v & 31, j = i * 32 + c; bh = 4 * x + (j >> 4); const int s = j & 15; qb0 = s; qb1 = 31 - s;
}
__device__ __forceinline__ void dil_decode(int id, int& bh, int& br, int& blk) {
    const int v = id & 255, i = id >> 8, x = v >> 5, c = v & 31, j = i * 32 + c; bh = 4 * x + j / 96; const int r = j % 96; br = r >> 5; blk = r & 31;
}
#ifndef ATT_DIL_NS
#define ATT_DIL_NS 4
#endif
#ifndef ATT_SKEW_SEL
#define ATT_SKEW_SEL 0
#endif
#if ATT_SKEW_SEL == 0
#define ATT_SKEW_PICK(w) ((w) < 4)
#elif ATT_SKEW_SEL == 1
#define ATT_SKEW_PICK(w) (((w) & 1) == 0)
#elif ATT_SKEW_SEL == 2
#define ATT_SKEW_PICK(w) true
#else
#define ATT_SKEW_PICK(w) false
#endif
#ifdef ATT_DMA
#define ATT_SEAM(d) att::SeamD<d>
#define ATT_DMA_ON ATT_DMA
#else
#define ATT_SEAM(d) att::Seam<d>
#define ATT_DMA_ON 0
#endif
#if ATT_DMA_ON == 2
template <int ORD>
__device__ __forceinline__ void mla_stream2(Frame& F, char* lds) {
    constexpr int NIT = 512;
    int id = F.vcu;
    if (id < NIT) {
        att::SeamD<192> S; int bh, q0, q1; mla_decode(id, bh, q0, q1); int pass = 0;
        att::Blk cur = mla_blk(bh, q0);
        att::att_prime_dma2<192, false>(cur, (const char*)F.ws, lds, S, F.tid);
        for (;;) {
            const bool more_pass = pass == 0, more_item = id + F.G < NIT, last = !more_pass && !more_item;
            att::Blk nxt = cur; int idn = id, passn = pass + 1;
            if (more_pass) nxt = mla_blk(bh, q1);
            else if (more_item) { idn = id + F.G; passn = 0; mla_decode(idn, bh, q0, q1); nxt = mla_blk(bh, q0); }
            att::att_block_dma2<192, false, false, ORD>(cur, nxt, (const char*)F.ws, lds, S, F.tid);
            if (last) break;
            cur = nxt; id = idn; pass = passn;
        }
    }
}
template <int ORD>
__device__ __forceinline__ void dil_stream2(Frame& F, char* lds) {
    constexpr int NIT = 3072;
    int id = F.vcu;
    if (id < NIT) {
        att::SeamD<128> S; int bh, br, blk; dil_decode(id, bh, br, blk);
        att::Blk cur = dil_blk(bh, br, blk);
        att::att_prime_dma2<128, true>(cur, (const char*)F.ws, lds, S, F.tid);
        for (;;) {
            const bool last = id + F.G >= NIT;
            att::Blk nxt = cur;
            if (!last) { dil_decode(id + F.G, bh, br, blk); nxt = dil_blk(bh, br, blk); }
            att::att_block_dma2<128, true, true, ORD>(cur, nxt, (const char*)F.ws, lds, S, F.tid);
            if (last) break;
            cur = nxt; id += F.G;
        }
    }
}
#endif
template <int PV>
__device__ __forceinline__ void dil_stream_reg(Frame& F, char* lds, int rep_, const Args& A, int l, int cvj0) {
        constexpr int NIT = 3072;
        int id = F.vcu;
        if (id < NIT) {
#if ATT_DMA_ON == 1
            att::SeamD<128> S;
#else
            att::Seam<128> S;
#endif
            S.cv_j = cvj0;
            int bh, br, blk; dil_decode(id, bh, br, blk);
            att::Blk cur = dil_blk(bh, br, blk);
#if defined(ATT_CONV) && ATT_CONV == 2
            const size_t eo_ = (size_t)l * NEXP * DM * DEXP;
            const att::ConvCtx X = {A.in[I_EG] + eo_, A.in[I_EU] + eo_, A.in[I_ED] + eo_, F.ws + WS_W13, F.ws + WS_W2, F.vcu * 8 + __builtin_amdgcn_readfirstlane(F.tid >> 6)};
#endif
#if ATT_DMA_ON == 1
            att::att_prime_dma<128, true, ATT_DIL_NS>(cur, (const char*)F.ws, lds, S, F.tid);
#else
            att::att_prime<128, true, PV>(cur, (const char*)F.ws, lds, S, F.tid);
#endif
            for (;;) {
                const bool last = id + F.G >= NIT;
                att::Blk nxt = cur;
                if (!last) { dil_decode(id + F.G, bh, br, blk); nxt = dil_blk(bh, br, blk); }
#if ATT_DMA_ON == 1
                att::att_block_dma<128, true, true, ATT_DIL_NS>(cur, nxt, (const char*)F.ws, lds, lds + RING_BYTES + 512, S, F.tid);
#else
#if defined(ATT_CONV) && ATT_CONV == 2
                att::att_block<128, true, true, PV, 2>(cur, nxt, (const char*)F.ws, lds, S, F.tid, &X);
#else
                att::att_block<128, true, true, PV>(cur, nxt, (const char*)F.ws, lds, S, F.tid);
#endif
#endif
                if (last) break;
                cur = nxt; id += F.G;
            }
#if defined(ATT_CONV) && ATT_CONV == 2
            { const int ln_ = lane_id(); char* scr_ = lds + att::CONV_SCR_DIL + __builtin_amdgcn_readfirstlane(F.tid >> 6) * 4352;
              if (S.cv_pend) { asm volatile("s_waitcnt vmcnt(0)" ::: "memory"); att::conv_put_full(X, S.cv_j, S.cvf, scr_, ln_); ++S.cv_j; if (S.cv_pend > 1) { att::conv_put_full(X, S.cv_j, S.cvf + 16, scr_, ln_); ++S.cv_j; } S.cv_pend = 0; }
              while (S.cv_j < att::CONV_NJ) { att::conv_load_full(X, S.cv_j, S.cvf, ln_); asm volatile("s_waitcnt vmcnt(0)" ::: "memory"); att::conv_put_full(X, S.cv_j, S.cvf, scr_, ln_); ++S.cv_j; } }
#endif
#if defined(ATT_DEFER) && ATT_DMA_ON != 1
            if (S.p_on) { const int ln_ = F.tid & 63; const char* stg_ = lds + att::DEFER_STG + __builtin_amdgcn_readfirstlane(F.tid >> 6) * 8192;
#pragma unroll
                for (int p = 0; p < 8; ++p) att::flush_piece(stg_, p, (const char*)F.ws + S.p_oo, S.p_rb, S.p_so0, ln_); }
#endif
        }
}
static_assert(WS_ROPE == att::ROPE_OFF, "rope table offset");
#ifdef ATT_QROPE
#define ATT_ROPE_FLAG true
#else
#define ATT_ROPE_FLAG false
#endif
__device__ __forceinline__ void phase_attention(Frame& F, char* lds, const Args& A, int l) {
#ifdef ATT_PRIO
    if (__builtin_amdgcn_readfirstlane(F.tid >> 6) >= 4) __builtin_amdgcn_s_setprio(1);
#endif
#ifndef ATT_MLA_SKCONV
#define ATT_MLA_SKCONV 0
#endif
    int cvj_ = 0;
#ifndef NO_MLA
#ifndef PROBE_REP_MLA
#define PROBE_REP_MLA 1
#endif
    for (int rep_ = 0; rep_ < PROBE_REP_MLA; ++rep_) {
        if (rep_) __syncthreads();
#if ATT_DMA_ON == 2
        { const int wsel_ = __builtin_amdgcn_readfirstlane(F.tid >> 6);
          if (ATT_SKEW_PICK(wsel_)) mla_stream2<0>(F, lds); else mla_stream2<1>(F, lds); }
#else
        constexpr int NIT = 512;
        int id = F.vcu;
        if (id < NIT) {
            ATT_SEAM(192) S; int bh, q0, q1; mla_decode(id, bh, q0, q1); int pass = 0;
            att::Blk cur = mla_blk(bh, q0);
#if defined(ATT_CONV) && (ATT_CONV == 1 || defined(ATT_MLA_SK))
            const size_t eo_ = (size_t)l * NEXP * DM * DEXP;
            const att::ConvCtx X = {A.in[I_EG] + eo_, A.in[I_EU] + eo_, A.in[I_ED] + eo_, F.ws + WS_W13, F.ws + WS_W2, F.vcu * 8 + __builtin_amdgcn_readfirstlane(F.tid >> 6)};
#endif
#if ATT_DMA_ON
            att::att_prime_dma<192, false, 3>(cur, (const char*)F.ws, lds, S, F.tid);
#else
#ifdef ATT_QROPE
            att::att_prime<192, false, 0, true>(cur, (const char*)F.ws, lds, S, F.tid);
#else
            att::att_prime<192, false>(cur, (const char*)F.ws, lds, S, F.tid);
#endif
#endif
            for (;;) {
                const bool more_pass = pass == 0, more_item = id + F.G < NIT, last = !more_pass && !more_item;
                att::Blk nxt = cur; int idn = id, passn = pass + 1;
                if (more_pass) nxt = mla_blk(bh, q1);
                else if (more_item) { idn = id + F.G; passn = 0; mla_decode(idn, bh, q0, q1); nxt = mla_blk(bh, q0); }
#if ATT_DMA_ON
                att::att_block_dma<192, false, false, 3>(cur, nxt, (const char*)F.ws, lds, lds + 3 * att::SHM_V + 3 * att::Cfg<192>::SHM_K, S, F.tid);
#else
#if defined(ATT_CONV) && ATT_CONV == 1
                att::att_block<192, false, false, 0, 1, ATT_ROPE_FLAG>(cur, nxt, (const char*)F.ws, lds, S, F.tid, &X);
#elif defined(ATT_MLA_SK)
                att::att_block<192, false, true, 0, ATT_MLA_SKCONV, ATT_ROPE_FLAG>(cur, nxt, (const char*)F.ws, lds, S, F.tid, &X);
#elif defined(ATT_QROPE)
                att::att_block<192, false, false, 0, 0, true>(cur, nxt, (const char*)F.ws, lds, S, F.tid);
#else
                att::att_block<192, false, false>(cur, nxt, (const char*)F.ws, lds, S, F.tid);
#endif
#endif
                if (last) break;
                cur = nxt; id = idn; pass = passn;
            }
#ifdef ATT_MLA_SK
            { const int ln_ = lane_id(); char* scr_ = lds + att::CONV_SCR + __builtin_amdgcn_readfirstlane(F.tid >> 6) * 4352;
              if (S.cv_pend) { asm volatile("s_waitcnt vmcnt(0)" ::: "memory"); att::conv_put_full(X, S.cv_j, S.cvf, scr_, ln_); ++S.cv_j; if (S.cv_pend > 1) { att::conv_put_full(X, S.cv_j, S.cvf + 16, scr_, ln_); ++S.cv_j; } S.cv_pend = 0; }
              cvj_ = S.cv_j; }
#endif
#if defined(ATT_CONV) && ATT_CONV == 1
            { const int ln_ = lane_id(); char* scr_ = lds + att::CONV_SCR + __builtin_amdgcn_readfirstlane(F.tid >> 6) * 4352;
              while (S.cv_j < att::CONV_NJ) { att::conv_load(X, S.cv_j, S.cv_q, S.cv, ln_); asm volatile("s_waitcnt vmcnt(0)" ::: "memory");
                  att::conv_put(X, S.cv_j, S.cv_q, S.cv, scr_, ln_); if (++S.cv_q == 4) { S.cv_q = 0; ++S.cv_j; } S.cl_j = S.cv_j; S.cl_q = S.cv_q; } }
#endif
        }
#endif
    }
#endif
#ifndef NO_DIL
#ifndef PROBE_REP_DIL
#define PROBE_REP_DIL 1
#endif
#ifndef PROBE_DIL_VAR
#define PROBE_DIL_VAR 0
#endif
#if ATT_DMA_ON == 2 && !defined(ATT_DIL_DMA2)
    asm volatile("s_waitcnt vmcnt(0)" ::: "memory"); __syncthreads();
#endif
    for (int rep_ = 0; rep_ < PROBE_REP_DIL; ++rep_) {
        if (rep_) __syncthreads();
#if ATT_DMA_ON == 2 && defined(ATT_DIL_DMA2)
        { const int wsel_ = __builtin_amdgcn_readfirstlane(F.tid >> 6);
          if (ATT_SKEW_PICK(wsel_)) dil_stream2<0>(F, lds); else dil_stream2<1>(F, lds); }
#else
        if (rep_ + 1 < PROBE_REP_DIL) dil_stream_reg<PROBE_DIL_VAR>(F, lds, rep_, A, l, cvj_); else dil_stream_reg<0>(F, lds, rep_, A, l, cvj_);
#endif
    }
#endif
#ifdef ATT_PRIO
    __builtin_amdgcn_s_setprio(0);
#endif
}
#ifndef MK_PER_PHASE
#define MK_PER_PHASE 0
#endif
constexpr int NPH = 2 + 11 * DEPTH;
__global__ void __launch_bounds__(NWAVES * 64, 2) mk_fwd(Args args) {
    extern __shared__ __attribute__((aligned(16))) unsigned char lds[];
    Frame F;
    F.lds = (LAS unsigned char*)lds; F.ldsg = lds;
    F.wave = __builtin_amdgcn_readfirstlane((int)threadIdx.x >> 6); F.lane = lane_id(); F.tid = F.wave * 64 + F.lane;
    F.G = gridDim.x; { const int bx = blockIdx.x; F.vcu = (F.G % 8 == 0) ? (bx % 8) * (F.G / 8) + bx / 8 : bx; }
    F.ws = args.ws; F.ctl = (unsigned*)(args.ws + WS_CTL);
    for (int u = F.tid; u < (LDS_BYTES - RING_BYTES) / 4; u += NWAVES * 64) ((LAS unsigned*)(F.lds + RING_BYTES))[u] = 0u;
    __syncthreads();
    volatile LAS unsigned* MISC = (volatile LAS unsigned*)(F.lds + L_MISC);
    XcdBarrier bar; bar.bar = F.ctl + CW_BAR; bar.x = 0; bar.st = nullptr;
    if (!MK_PER_PHASE) bar = xcd_barrier_post(F.ctl + CW_BAR, MISC + 8, F.tid);
    const int lo = args.ph_lo, hi = args.ph_hi;
#ifndef PROBE_GRID1_PHASE
#define PROBE_GRID1_PHASE (-1)
#endif
#define PROBE_GRID1(p) ((p) == PROBE_GRID1_PHASE)
#ifndef PROBE_MODE
#define PROBE_MODE 1
#endif
#ifndef PROBE_REP_MASK
#define PROBE_REP_MASK 0
#endif
#define NREP(j) ((((PROBE_REP_MASK) >> (j)) & 1) ? 2 : 1)
#ifndef PROBE_XIN
#define PROBE_XIN 0
#endif
#ifndef PH_MASK
#define PH_MASK 0x1FFF
#endif
#define IN(k) (lo <= (k) && (k) < hi)
#define MSK(j) (((PH_MASK) >> (j)) & 1)
#define FRESH(Fp) Frame Fp = F; { int l_ = lane_id(); int z_ = 0; asm volatile("" : "+v"(l_), "+s"(z_)); Fp.lane = l_; Fp.wave = F.wave + z_; Fp.tid = Fp.wave * 64 + l_; Fp.vcu = F.vcu + z_; Fp.ws = F.ws + z_; Fp.ctl = (unsigned*)(Fp.ws + WS_CTL); }
#define SEAM(k) do { if (IN(k) && IN((k) + 1)) xcd_barrier(bar, F.wave * 64 + lane_id()); } while (0)

    if (MSK(11) && IN(0)) { FRESH(P); phase_prologue(P, args);
#ifdef PROBE_REPEAT_PROLOGUE
        __syncthreads(); phase_prologue(P, args);
#endif
    }
    SEAM(0);
    for (int l = 0; l < DEPTH; ++l) {
        const int pb = 1 + 11 * l;
        const float* mod = (const float*)(F.ws + WS_MOD);
        if (MSK(0) && IN(pb + 0)) { for (int rep_ = 0; rep_ < (l == 0 ? NREP(0) : 1); ++rep_) { if (rep_) __syncthreads(); FRESH(P); phase_norm1(P, args, l); } }
        SEAM(pb + 0);
        if (MSK(1) && IN(pb + 1)) { for (int rep_ = 0; rep_ < NREP(1); ++rep_) { if (rep_) __syncthreads(); FRESH(P);
            pg8::Gemm g{(const bf16*)(P.ws + WS_H), (const bf16*)(P.ws + WS_WIN) + (size_t)l * 4096 * DM, DM * 2};
            pg8::StaticOrder S; S.init(T, PROJ_LD, P.G, (int)blockIdx.x);
            pg8::EpiPlain E{(bf16*)(P.ws + WS_PROJ), PROJ_LD};
            pg8::gemm_phase<pg8::EpiPlain, pg8::StaticOrder, pg8::ALinear>(P.lds, g, S, pg8::ALinear{}, E, P.tid);
        } }
        SEAM(pb + 1);
#ifdef PROBE_EXTRA_BARRIERS
        if (IN(pb + 2)) for (int xb_ = 0; xb_ < PROBE_EXTRA_BARRIERS; ++xb_) xcd_barrier(bar, F.wave * 64 + lane_id());
#endif
        if (MSK(2) && IN(pb + 2)) { for (int rep_ = 0; rep_ < NREP(2); ++rep_) { if (rep_) __syncthreads(); FRESH(P); phase_mla_prep(P, args); } }
        SEAM(pb + 2);
        if (MSK(3) && IN(pb + 3)) { for (int rep_ = 0; rep_ < NREP(3); ++rep_) { if (rep_) __syncthreads(); FRESH(P);
#ifdef PROBE_SWAP_UP
            { pg8::Gemm g{(const bf16*)(P.ws + WS_PROJ) + C_CKV, (const bf16*)(P.ws + WS_WUKV) + (size_t)l * 2048 * 256, 256 * 2};
              pg8::StaticOrder S; S.init(T, 2048, P.G, (int)blockIdx.x);
              pg8::EpiKVup E{(bf16*)(P.ws + WS_KF), (bf16*)(P.ws + WS_VB), (const float*)(P.ws + WS_RSTDKV)};
              pg8::gemm_phase<pg8::EpiKVup, pg8::StaticOrder, pg8::APitch>(P.lds, g, S, pg8::APitch{PROJ_LD * 2}, E, P.tid); }
            { pg8::Gemm g{(const bf16*)(P.ws + WS_PROJ) + C_CQ, (const bf16*)(P.ws + WS_WUQ) + (size_t)l * 1536 * 512, 512 * 2};
              pg8::StaticOrder S; S.init(T, 1536, P.G, (int)blockIdx.x);
              pg8::EpiQup E{(bf16*)(P.ws + WS_QA), (const float*)(P.ws + WS_RSTDQ)};
#ifdef PROBE_QUP_PLAIN
              { pg8::EpiPlain E2{(bf16*)(P.ws + WS_QA), 1536}; pg8::gemm_phase<pg8::EpiPlain, pg8::StaticOrder, pg8::APitch>(P.lds, g, S, pg8::APitch{PROJ_LD * 2}, E2, P.tid); }
#else
              pg8::gemm_phase<pg8::EpiQup, pg8::StaticOrder, pg8::APitch>(P.lds, g, S, pg8::APitch{PROJ_LD * 2}, E, P.tid);
#endif
            }
#else
            { pg8::Gemm g{(const bf16*)(P.ws + WS_PROJ) + C_CQ, (const bf16*)(P.ws + WS_WUQ) + (size_t)l * 1536 * 512, 512 * 2};
              pg8::StaticOrder S; S.init(T, 1536, P.G, (int)blockIdx.x);
              pg8::EpiQup E{(bf16*)(P.ws + WS_QA), (const float*)(P.ws + WS_RSTDQ)};
#ifdef PROBE_QUP_PLAIN
              { pg8::EpiPlain E2{(bf16*)(P.ws + WS_QA), 1536}; pg8::gemm_phase<pg8::EpiPlain, pg8::StaticOrder, pg8::APitch>(P.lds, g, S, pg8::APitch{PROJ_LD * 2}, E2, P.tid); }
#else
              pg8::gemm_phase<pg8::EpiQup, pg8::StaticOrder, pg8::APitch>(P.lds, g, S, pg8::APitch{PROJ_LD * 2}, E, P.tid);
#endif
            }
            { pg8::Gemm g{(const bf16*)(P.ws + WS_PROJ) + C_CKV, (const bf16*)(P.ws + WS_WUKV) + (size_t)l * 2048 * 256, 256 * 2};
              pg8::StaticOrder S; S.init(T, 2048, P.G, (int)blockIdx.x);
              pg8::EpiKVup E{(bf16*)(P.ws + WS_KF), (bf16*)(P.ws + WS_VB), (const float*)(P.ws + WS_RSTDKV)};
              pg8::gemm_phase<pg8::EpiKVup, pg8::StaticOrder, pg8::APitch>(P.lds, g, S, pg8::APitch{PROJ_LD * 2}, E, P.tid); }
#endif
        } }
        SEAM(pb + 3);
#ifndef ATT_QROPE
        if (MSK(4) && IN(pb + 4)) { FRESH(P); phase_q_rope(P, args); }
        SEAM(pb + 4);
#endif
        if (MSK(5) && IN(pb + 5)) { FRESH(P); phase_attention(P, (char*)lds, args, l);
#ifdef PROBE_REPEAT_ATT
            __syncthreads(); phase_attention(P, (char*)lds, args, l);
#endif
        }
        SEAM(pb + 5);
        if (MSK(6) && IN(pb + 6)) { for (int rep_ = 0; rep_ < NREP(6); ++rep_) { if (rep_) __syncthreads(); FRESH(P); phase_out_norm(P, args, l); } }
        SEAM(pb + 6);
        if (MSK(7) && IN(pb + 7)) { FRESH(P);
#ifdef G3_FP8
            pg8::Gemm g{P.ws + WS_H, P.ws + WS_WOUT + (size_t)l * DM * DM, DM};
            pg8::StaticOrder S; S.init(T, DM, P.G, (int)blockIdx.x);
#ifdef XRES_BF16
            pg8::EpiResidB E{l == 0 ? (const void*)args.in[I_X] : (const void*)(P.ws + WS_XB), (bf16*)(P.ws + WS_XB), mod + (size_t)l * 4 * 12288 + 2 * DM, 12288, 1.0f / 256.0f, l == 0 ? 1 : 0};
            pg8::gemm_phase<pg8::EpiResidB, pg8::StaticOrder, pg8::ALinear, true>(P.lds, g, S, pg8::ALinear{}, E, P.tid);
#else
            pg8::EpiResid E{l == 0 ? args.in[I_X] : args.out, args.out, mod + (size_t)l * 4 * 12288 + 2 * DM, DM, 12288, 1.0f / 256.0f};
            pg8::gemm_phase<pg8::EpiResid, pg8::StaticOrder, pg8::ALinear, true>(P.lds, g, S, pg8::ALinear{}, E, P.tid);
#endif
#elif defined(XRES_BF16)
            pg8::Gemm g{(const bf16*)(P.ws + WS_H), (const bf16*)(P.ws + WS_WOUT) + (size_t)l * DM * DM, DM * 2};
            pg8::StaticOrder S; S.init(T, DM, P.G, (int)blockIdx.x);
            pg8::EpiResidB E{l == 0 ? (const void*)args.in[I_X] : (const void*)(P.ws + WS_XB), (bf16*)(P.ws + WS_XB), mod + (size_t)l * 4 * 12288 + 2 * DM, 12288, 1.0f, l == 0 ? 1 : 0};
            pg8::gemm_phase<pg8::EpiResidB, pg8::StaticOrder, pg8::ALinear>(P.lds, g, S, pg8::ALinear{}, E, P.tid);
#else
            pg8::Gemm g{(const bf16*)(P.ws + WS_H), (const bf16*)(P.ws + WS_WOUT) + (size_t)l * DM * DM, DM * 2};
            pg8::StaticOrder S; S.init(T, DM, P.G, (int)blockIdx.x);
            pg8::EpiResid E{l == 0 ? args.in[I_X] : args.out, args.out, mod + (size_t)l * 4 * 12288 + 2 * DM, DM, 12288, 1.0f};
            pg8::gemm_phase<pg8::EpiResid, pg8::StaticOrder, pg8::ALinear>(P.lds, g, S, pg8::ALinear{}, E, P.tid);
#endif
        }
        SEAM(pb + 7);
        if (MSK(8) && IN(pb + 8)) { FRESH(P); phase_router(P, args, l);
#ifdef PROBE_REPEAT_ROUTER
            __syncthreads(); phase_router(P, args, l, 1);
#endif
        }
        SEAM(pb + 8);
        if (MSK(9) && IN(pb + 9)) { for (int rep_ = 0; rep_ < NREP(9); ++rep_) { if (rep_) __syncthreads(); FRESH(P);
            const int NT = moe_setup(P, l);
            pg8::MoeOrder S{NT, 8, P.G, (int)blockIdx.x, (const LAS int*)(P.lds + L_TS)};
            LAS unsigned* atab = (LAS unsigned*)(P.lds + L_ATAB); const int* rowidx = (const int*)(P.ws + WS_ROWIDX);
#pragma unroll 1
            for (int slot = 0; slot < MAXU; ++slot) { pg8::Unit u; if (!S.next(slot, u)) break;
                if (P.tid < 256) { const int lr = u.lt * 256 + P.tid; const int ce = (int)P.ctl[CW_CNT + l * 16 + u.e];
                    int tok = lr < ce ? (rowidx[(size_t)u.e * 32768 + lr] >> 1) : 0;
#ifdef PROBE_LINEAR_ATAB
                    tok = (int)(((unsigned)(u.pm * 256 + P.tid) * 2654435761u) >> 17) & 32767;
#endif
 atab[slot * 256 + P.tid] = (unsigned)tok * (unsigned)DM; } }
            __syncthreads();
            pg8::Gemm g{P.ws + WS_H, P.ws + WS_W13, DM};
            pg8::EpiSwiglu E{P.ws + WS_HMID, DEXP};
            pg8::gemm_phase<pg8::EpiSwiglu, pg8::MoeOrder, pg8::ATable, true>(P.lds, g, S, pg8::ATable{atab}, E, P.tid);
        } }
        SEAM(pb + 9);
        if (MSK(10) && IN(pb + 10)) { for (int rep_ = 0; rep_ < NREP(10); ++rep_) { if (rep_) __syncthreads(); FRESH(P);
            const int NT = moe_setup(P, l);
            pg8::MoeOrder S{NT, 8, P.G, (int)blockIdx.x, (const LAS int*)(P.lds + L_TS)};
            pg8::Gemm g{P.ws + WS_HMID, P.ws + WS_W2, DEXP};
            pg8::EpiMoeDown E{(bf16*)(P.ws + WS_Y), (const int*)(P.ws + WS_ROWIDX), (const float*)(P.ws + WS_AW), P.ctl + CW_CNT + l * 16};
            pg8::gemm_phase<pg8::EpiMoeDown, pg8::MoeOrder, pg8::ALinear, true>(P.lds, g, S, pg8::ALinear{}, E, P.tid);
        } }
        SEAM(pb + 10);
    }
    #ifdef PROBE_DUMP_OFF
    if (MSK(12) && IN(NPH - 1)) { FRESH(P); phase_dump(P, args, (size_t)(PROBE_DUMP_OFF), PROBE_DUMP_PITCH); }
#else
    if (MSK(12) && IN(NPH - 1)) { FRESH(P); phase_final(P, args, args.li != 0 ? (PROBE_XIN ? 2 : PROBE_MODE) : 0);
#ifdef PROBE_EXACT
        { const int gw = P.vcu * NWAVES + P.wave, NGW = P.G * NWAVES; __syncthreads();
          for (int ch = gw; ch < T / 16; ch += NGW) for (int rr = 0; rr < 16; ++rr) for (int j = 0; j < 8; ++j) { float* p = args.out + (size_t)(ch * 16 + rr) * DM + 4 * P.lane + 256 * j; asm volatile("s_waitcnt vmcnt(0)" ::: "memory");
              const v4u ub = *(const v4u*)p; *(f32x4*)p = (f32x4){(float)(ub.x & 0xFFFu), (float)(ub.y & 0xFFFu), (float)(ub.z & 0xFFFu), (float)(ub.w & 0xFFFu)}; } }
#endif
    }
#endif
#undef IN
#undef SEAM
}

extern "C" void kernel_launch(void* const* d_in, const int* in_sizes, int n_in, void* d_out, int out_size, void* d_ws, size_t ws_size, hipStream_t stream) {
    static int grid = 0;
    if (grid == 0) {
        if (n_in != 20 || in_sizes[0] != T * DM || out_size != T * DM || ws_size < WS_END) {
            fprintf(stderr, "kernel_launch: unexpected problem (n_in %d, in0 %d, out %d, ws %zu < %zu)\n", n_in, n_in > 0 ? in_sizes[0] : -1, out_size, ws_size, (size_t)WS_END); grid = -1; return; }
        int dev = 0, cus = 0;
        if (hipGetDevice(&dev) != hipSuccess || hipDeviceGetAttribute(&cus, hipDeviceAttributeMultiprocessorCount, dev) != hipSuccess) { grid = -1; return; }
        if (hipFuncSetAttribute((const void*)mk_fwd, hipFuncAttributeMaxDynamicSharedMemorySize, LDS_BYTES) != hipSuccess) { fprintf(stderr, "kernel_launch: hipFuncSetAttribute failed\n"); grid = -1; return; }
        int per_cu = 0;
        if (hipOccupancyMaxActiveBlocksPerMultiprocessor(&per_cu, (const void*)mk_fwd, NWAVES * 64, LDS_BYTES) != hipSuccess || per_cu < 1) fprintf(stderr, "kernel_launch: occupancy query says %d blocks per CU\n", per_cu);
        (void)hipGetLastError();
        grid = cus;
        if (grid != 256) fprintf(stderr, "kernel_launch: %d CUs (built for 256)\n", grid);
    }
    if (grid < 0) return;
    if (hipMemsetAsync((char*)d_ws + WS_CTL, 0, CTL_ZERO_BYTES, stream) != hipSuccess) return;
    Args a; memset(&a, 0, sizeof(a));
    for (int i = 0; i < 20; ++i) a.in[i] = (const float*)d_in[i];
    a.out = (float*)d_out; a.ws = (unsigned char*)d_ws;
    for (int i = 0; i < 32; ++i) a.invf[i] = (float)pow(10000.0, -(double)i / 32.0);
#if MK_PER_PHASE
#ifndef PROBE_LAST
#define PROBE_LAST (NPH - 2)
#endif
    for (int p = 0; p < NPH; ++p) { if (p > PROBE_LAST && p != NPH - 1) continue;
#ifdef PROBE_ONLY_MASK
        if (p != NPH - 1 && !((PROBE_ONLY_MASK >> p) & 1)) continue;
#endif
 a.ph_lo = p; a.ph_hi = p + 1; a.li = (PROBE_LAST != NPH - 2) ? 1 : 0; hipLaunchKernelGGL(mk_fwd, dim3(PROBE_GRID1(p) ? 1 : grid), dim3(NWAVES * 64), LDS_BYTES, stream, a); }
#else
    a.ph_lo = 0; a.ph_hi = NPH; a.li = 0;
    hipLaunchKernelGGL(mk_fwd, dim3(grid), dim3(NWAVES * 64), LDS_BYTES, stream, a);
#endif
    const hipError_t le = hipPeekAtLastError();
    if (le != hipSuccess) fprintf(stderr, "kernel_launch: launch failed: %s\n", hipGetErrorName(le));
}
```

```cpp
#define MK_PER_PHASE 0
#define XRES_BF16 1
#define G3_FP8 1
#define ATT_QROPE 1
#define ST16_IMM 1
#define ROUTER_MFMA 1
#define ATT_CONV 2
#define ATT_SLOAD_RECOMP 1
#define ATT_RAWBAR 1
#define ATT_MLA_SK 1
#define THIN_MLP 1
#define CONV_LAST_STEP 1
#include <hip/hip_runtime.h>
#include <cstdio>
#include <cstdint>
#include <cstring>
#include <cmath>
namespace pg8 {
#define PG8_LAS __attribute__((address_space(3)))
typedef unsigned short bf16_t;
typedef short bf16x8 __attribute__((ext_vector_type(8)));
typedef float f32x4 __attribute__((ext_vector_type(4)));
typedef float f32x2 __attribute__((ext_vector_type(2)));
typedef unsigned u32x4 __attribute__((ext_vector_type(4)));
typedef int v4i_t __attribute__((ext_vector_type(4)));
typedef int v8i_t __attribute__((ext_vector_type(8)));
constexpr int BM = 256, BK = 64, HALF = 128, HTB = HALF * BK * 2  , STAGE_BYTES = 8 * HTB, NXCD = 8, WGM = 8;

__host__ __device__ __forceinline__ int lds_byte(int r, int c) { const int st = (r >> 4) * 2 + (c >> 5), rr = r & 15, cc = c & 31, ob = rr * 64 + cc * 2; return st * 1024 + (ob ^ (((ob >> 9) & 1) << 5)); }
__host__ __device__ __forceinline__ void stage_rc(int b, int& R, int& C) { const int st = b / 1024, sb = b % 1024, swz = sb ^ (((sb >> 9) & 1) << 5); R = (st >> 1) * 16 + swz / 64; C = (st & 1) * 32 + (swz % 64) / 2; }
__host__ __device__ __forceinline__ int perm32(int rho) { const int n = rho >> 4, i = rho & 15; return 8 * (i >> 2) + 4 * n + (i & 3); }

struct Unit { int pm, pn, pb, e, lt; };
struct Gemm { const void* A; const void* Bt; int Kb; };

__device__ __forceinline__ bool order_tile(int i, int G, int c, int nM, int nN, int& pm, int& pn) {
    const int nwg = nM * nN; const long L = (long)i * G + c; if (L >= nwg) return false;
    int wgid = (int)L; { const int q = nwg / NXCD, r = nwg % NXCD, xcd = wgid % NXCD, off = wgid / NXCD; wgid = (xcd < r ? xcd * (q + 1) : r * (q + 1) + (xcd - r) * q) + off; }
    const int nig = WGM * nN, gid = wgid / nig, fm = gid * WGM, gsz = (nM - fm) < WGM ? (nM - fm) : WGM;
    pm = fm + ((wgid % nig) % gsz); pn = (wgid % nig) / gsz; return true;
}
struct StaticOrder {
    int nM, nN, G, c;
    __device__ __forceinline__ void init(int M, int N, int G_, int c_) { nM = M / BM; nN = N / BM; G = G_; c = c_; }
    __device__ __forceinline__ bool next(int i, Unit& u) const { int pm, pn; if (!order_tile(i, G, c, nM, nN, pm, pn)) return false; u.pm = pm; u.pn = pn; u.pb = pn; u.e = 0; u.lt = 0; return true; }
};
struct MoeOrder {
    int nM, nN, G, c; const PG8_LAS int* ts;
    __device__ __forceinline__ bool next(int i, Unit& u) const {
        int pm, pn; if (i >= 10 || !order_tile(i, G, c, nM, nN, pm, pn)) return false;
        int e = 0;
#pragma unroll
        for (int j = 1; j < 16; ++j) e += (__builtin_amdgcn_readfirstlane(ts[j]) <= pm) ? 1 : 0;
        e = __builtin_amdgcn_readfirstlane(e); u.pm = pm; u.pn = pn; u.e = e; u.lt = pm - __builtin_amdgcn_readfirstlane(ts[e]); u.pb = e * nN + pn; return true;
    }
};
struct ALinear { __device__ __forceinline__ unsigned off(const Unit& u, int slot, int r, int Kb) const { return (unsigned)(u.pm * BM + r) * (unsigned)Kb; } };
struct APitch  { unsigned pitchB; __device__ __forceinline__ unsigned off(const Unit& u, int slot, int r, int K) const { return (unsigned)(u.pm * BM + r) * pitchB; } };
struct ATable  { const PG8_LAS unsigned* tab; __device__ __forceinline__ unsigned off(const Unit& u, int slot, int r, int K) const { return tab[slot * BM + r]; } };

typedef __bf16 bf16x2_t __attribute__((ext_vector_type(2)));
__device__ __forceinline__ unsigned cvt_pk_bf16(float lo, float hi) { const f32x2 v = {lo, hi}; return __builtin_bit_cast(unsigned, __builtin_convertvector(v, bf16x2_t)); }

typedef f32x4 Acc[2][2][4][2];

typedef __amdgpu_buffer_rsrc_t rsrc_t;
#define PG8_RSRC(p) __builtin_amdgcn_make_buffer_rsrc((void*)(p), 0, 0x7fffffff, 0x00020000)
#ifdef ST16_IMM
__device__ __forceinline__ void st16(rsrc_t r, int vo, int so, u32x4 v) { __builtin_amdgcn_raw_buffer_store_b128(v, r, vo + so, 0, 0); }
#else
__device__ __forceinline__ void st16(rsrc_t r, int vo, int so, u32x4 v) { __builtin_amdgcn_raw_buffer_store_b128(v, r, vo, so, 0); }
#endif
__device__ __forceinline__ f32x4 ld16f(rsrc_t r, int vo, int so) { return __builtin_bit_cast(f32x4, __builtin_amdgcn_raw_buffer_load_b128(r, vo, so, 0)); }
__device__ __forceinline__ float ld4f(rsrc_t r, int vo, int so) { return __uint_as_float(__builtin_amdgcn_raw_buffer_load_b32(r, vo, so, 0)); }
__device__ __forceinline__ u32x4 pack8(const f32x4 v0, const f32x4 v1) { u32x4 w; w.x = cvt_pk_bf16(v0[0], v0[1]); w.y = cvt_pk_bf16(v0[2], v0[3]); w.z = cvt_pk_bf16(v1[0], v1[1]); w.w = cvt_pk_bf16(v1[2], v1[3]); return w; }
struct EpiPlain {
    static constexpr bool PERM = true;
    bf16_t* O; int ldc;
    __device__ __forceinline__ void operator()(const Acc& acc, const Unit& u, int wr, int wc, int fr, int fq) const {
        const rsrc_t ro = PG8_RSRC(O); const int vo = (fr * ldc + wc * 32 + 8 * fq) * 2;
#pragma unroll
        for (int ai = 0; ai < 2; ++ai)
#pragma unroll
            for (int m = 0; m < 4; ++m) { const int so = ((u.pm * BM + wr * 64 + ai * HALF + m * 16) * ldc + u.pn * BM) * 2;
#pragma unroll
                for (int bj = 0; bj < 2; ++bj) st16(ro, vo, so + bj * HALF * 2, pack8(acc[ai][bj][m][0], acc[ai][bj][m][1])); }
    }
};
struct EpiQup {
    static constexpr bool PERM = true;
    bf16_t* O; const float* rstd;
    __device__ __forceinline__ void operator()(const Acc& acc, const Unit& u, int wr, int wc, int fr, int fq) const {
        const rsrc_t ro = PG8_RSRC(O), rr = PG8_RSRC(rstd);
        const int vo = (fr * 1536 + wc * 32 + 8 * fq) * 2;
        float rs[2][4];
#pragma unroll
        for (int ai = 0; ai < 2; ++ai)
#pragma unroll
            for (int m = 0; m < 4; ++m) rs[ai][m] = ld4f(rr, fr * 4, (u.pm * BM + wr * 64 + ai * HALF + m * 16) * 4);
#pragma unroll
        for (int ai = 0; ai < 2; ++ai)
#pragma unroll
            for (int m = 0; m < 4; ++m) { const int rowu = u.pm * BM + wr * 64 + ai * HALF + m * 16; const float r1 = rs[ai][m];
                const int so = (rowu * 1536 + u.pn * BM) * 2;
                st16(ro, vo, so, pack8(acc[ai][0][m][0] * r1, acc[ai][0][m][1] * r1));
                st16(ro, vo, so + HALF * 2, pack8(acc[ai][1][m][0] * r1, acc[ai][1][m][1] * r1)); }
    }
};
struct EpiKVup {
    static constexpr bool PERM = true;
    bf16_t* KF; bf16_t* VB; const float* rstd;
    __device__ __forceinline__ void operator()(const Acc& acc, const Unit& u, int wr, int wc, int fr, int fq) const {
        const rsrc_t rk = PG8_RSRC(KF), rv = PG8_RSRC(VB), rr = PG8_RSRC(rstd);
        const int c0 = wc * 32 + 8 * fq, vok = (fr * 1536 + c0) * 2, vov = (fr * 1024 + c0) * 2;
        float rs[2][4];
#pragma unroll
        for (int ai = 0; ai < 2; ++ai)
#pragma unroll
            for (int m = 0; m < 4; ++m) rs[ai][m] = ld4f(rr, fr * 4, (u.pm * BM + wr * 64 + ai * HALF + m * 16) * 4);
#pragma unroll
        for (int ai = 0; ai < 2; ++ai)
#pragma unroll
            for (int m = 0; m < 4; ++m) { const int rowu = u.pm * BM + wr * 64 + ai * HALF + m * 16; const float r1 = rs[ai][m];
                st16(rk, vok, (rowu * 1536 + u.pn * 192) * 2, pack8(acc[ai][0][m][0] * r1, acc[ai][0][m][1] * r1));
                st16(rv, vov, (rowu * 1024 + u.pn * 128) * 2, pack8(acc[ai][1][m][0] * r1, acc[ai][1][m][1] * r1)); }
    }
};
struct EpiResid {
    static constexpr bool PERM = false;
    const float* base; float* out; const float* gate; int ldc; int gld; float ascale;
    __device__ __forceinline__ void operator()(const Acc& acc, const Unit& u, int wr, int wc, int fr, int fq) const {
        const rsrc_t rb = PG8_RSRC(base), ro = PG8_RSRC(out), rg = PG8_RSRC(gate);
        const int cl = (wc * 32 + 4 * fq) * 4, vo = fr * ldc * 4 + cl;
        f32x4 gv[2][2];
#pragma unroll
        for (int bj = 0; bj < 2; ++bj)
#pragma unroll
            for (int n = 0; n < 2; ++n) gv[bj][n] = ld16f(rg, cl, (((u.pm * BM) >> 13) * gld + u.pn * BM + bj * HALF + n * 16) * 4) * ascale;
#pragma unroll
        for (int ai = 0; ai < 2; ++ai) {
            f32x4 bs[4][2][2];
#pragma unroll
            for (int m = 0; m < 4; ++m) { const int so = ((u.pm * BM + ai * HALF + wr * 64 + m * 16) * ldc + u.pn * BM) * 4;
#pragma unroll
                for (int bj = 0; bj < 2; ++bj)
#pragma unroll
                    for (int n = 0; n < 2; ++n) bs[m][bj][n] = ld16f(rb, vo, so + (bj * HALF + n * 16) * 4); }
#pragma unroll
            for (int m = 0; m < 4; ++m) { const int so = ((u.pm * BM + ai * HALF + wr * 64 + m * 16) * ldc + u.pn * BM) * 4;
#pragma unroll
                for (int bj = 0; bj < 2; ++bj)
#pragma unroll
                    for (int n = 0; n < 2; ++n) st16(ro, vo, so + (bj * HALF + n * 16) * 4, __builtin_bit_cast(u32x4, bs[m][bj][n] + gv[bj][n] * acc[ai][bj][m][n])); }
            asm volatile("s_waitcnt vmcnt(0)" ::: "memory");
        }
    }
};
struct EpiResidB {
    static constexpr bool PERM = true;
    const void* base; bf16_t* out; const float* gate; int gld; float ascale; int BASE_F32;
    __device__ __forceinline__ void operator()(const Acc& acc, const Unit& u, int wr, int wc, int fr, int fq) const {
        const rsrc_t rb = PG8_RSRC(base), ro = PG8_RSRC(out), rg = PG8_RSRC(gate);
        const int c0 = wc * 32 + 8 * fq;
        f32x4 gv[2][2];
#pragma unroll
        for (int bj = 0; bj < 2; ++bj)
#pragma unroll
            for (int n = 0; n < 2; ++n) gv[bj][n] = ld16f(rg, (c0 + 4 * n) * 4, (((u.pm * BM) >> 13) * gld + u.pn * BM + bj * HALF) * 4) * ascale;
#pragma unroll
        for (int ai = 0; ai < 2; ++ai) {
            f32x4 bs[4][2][2];
#pragma unroll
            for (int m = 0; m < 4; ++m) { const int rowu = u.pm * BM + ai * HALF + wr * 64 + m * 16;
#pragma unroll
                for (int bj = 0; bj < 2; ++bj) {
                    if (BASE_F32) { const int so = (rowu * 2048 + u.pn * BM + bj * HALF) * 4, vo = (fr * 2048 + c0) * 4;
                        bs[m][bj][0] = ld16f(rb, vo, so); bs[m][bj][1] = ld16f(rb, vo + 16, so); }
                    else { const int so = (rowu * 2048 + u.pn * BM + bj * HALF) * 2, vo = (fr * 2048 + c0) * 2;
                        const u32x4 w = __builtin_bit_cast(u32x4, __builtin_amdgcn_raw_buffer_load_b128(rb, vo, so, 0));
                        bs[m][bj][0] = (f32x4){__uint_as_float(w.x << 16), __uint_as_float(w.x & 0xffff0000u), __uint_as_float(w.y << 16), __uint_as_float(w.y & 0xffff0000u)};
                        bs[m][bj][1] = (f32x4){__uint_as_float(w.z << 16), __uint_as_float(w.z & 0xffff0000u), __uint_as_float(w.w << 16), __uint_as_float(w.w & 0xffff0000u)}; } } }
#pragma unroll
            for (int m = 0; m < 4; ++m) { const int rowu = u.pm * BM + ai * HALF + wr * 64 + m * 16;
#pragma unroll
                for (int bj = 0; bj < 2; ++bj) st16(ro, (fr * 2048 + c0) * 2, (rowu * 2048 + u.pn * BM + bj * HALF) * 2,
                                                    pack8(bs[m][bj][0] + gv[bj][0] * acc[ai][bj][m][0], bs[m][bj][1] + gv[bj][1] * acc[ai][bj][m][1])); }
            asm volatile("s_waitcnt vmcnt(0)" ::: "memory");
        }
    }
};
struct EpiSwiglu {
    static constexpr bool PERM = true;
    unsigned char* O; int ldc;
    __device__ __forceinline__ void operator()(const Acc& acc, const Unit& u, int wr, int wc, int fr, int fq) const {
        const rsrc_t ro = PG8_RSRC(O); const int vo = fr * ldc + wc * 32 + 8 * fq;
#pragma unroll
        for (int ai = 0; ai < 2; ++ai)
#pragma unroll
            for (int m = 0; m < 4; ++m) { const int so = (u.pm * BM + wr * 64 + ai * HALF + m * 16) * ldc + u.pn * HALF; float r[8];
#pragma unroll
                for (int n = 0; n < 2; ++n)
#pragma unroll
                    for (int k = 0; k < 4; ++k) { const float g = acc[ai][0][m][n][k] * (1.0f / 256.0f), up = acc[ai][1][m][n][k] * (1.0f / 256.0f);
                        r[n * 4 + k] = g * __builtin_amdgcn_rcpf(1.0f + __builtin_amdgcn_exp2f(-1.4426950408889634f * g)) * up; }
                int w0 = 0, w1 = 0;
                w0 = __builtin_amdgcn_cvt_pk_fp8_f32(r[0], r[1], w0, false); w0 = __builtin_amdgcn_cvt_pk_fp8_f32(r[2], r[3], w0, true);
                w1 = __builtin_amdgcn_cvt_pk_fp8_f32(r[4], r[5], w1, false); w1 = __builtin_amdgcn_cvt_pk_fp8_f32(r[6], r[7], w1, true);
                typedef unsigned u32x2_t __attribute__((ext_vector_type(2)));
                __builtin_amdgcn_raw_buffer_store_b64((u32x2_t){(unsigned)w0, (unsigned)w1}, ro, vo, so, 0); }
    }
};
struct EpiMoeDown {
    static constexpr bool PERM = true;
    bf16_t* Y; const int* rowidx; const float* aw; const unsigned* cnt;
    __device__ __forceinline__ void operator()(const Acc& acc, const Unit& u, int wr, int wc, int fr, int fq) const {
        const rsrc_t ry = PG8_RSRC(Y), ri = PG8_RSRC(rowidx), ra = PG8_RSRC(aw);
        const int nvalid = (int)cnt[u.e] - u.lt * BM; const int cb = (u.pn * BM + wc * 32 + 8 * fq) * 2;
        int idx[2][4]; float w8[2][4];
#pragma unroll
        for (int ai = 0; ai < 2; ++ai)
#pragma unroll
            for (int m = 0; m < 4; ++m) { const int ru = ai * HALF + wr * 64 + m * 16; idx[ai][m] = -1; w8[ai][m] = 0.f;
                if (ru + fr < nvalid) { idx[ai][m] = (int)__builtin_amdgcn_raw_buffer_load_b32(ri, fr * 4, (u.e * 32768 + u.lt * BM + ru) * 4, 0); w8[ai][m] = ld4f(ra, idx[ai][m] * 4, 0); } }
#pragma unroll
        for (int ai = 0; ai < 2; ++ai)
#pragma unroll
            for (int m = 0; m < 4; ++m) if (idx[ai][m] >= 0) { const int vo = idx[ai][m] * 4096 + cb; const float w1 = w8[ai][m] * (1.0f / 256.0f);
#pragma unroll
                for (int bj = 0; bj < 2; ++bj) st16(ry, vo, bj * HALF * 2, pack8(acc[ai][bj][m][0] * w1, acc[ai][bj][m][1] * w1)); }
    }
};

template <class Epi, class Sched, class AOff, bool FP8 = false>
__device__ __forceinline__ void gemm_phase(PG8_LAS unsigned char* lds, const Gemm g, const Sched& S, const AOff& AO, const Epi& E, int tid_in) {
    int tid = tid_in; asm volatile("" : "+v"(tid));
    const int wid = __builtin_amdgcn_readfirstlane(tid >> 6), lane = tid & 63, wr = wid >> 2, wc = wid & 3, fr = lane & 15, fq = lane >> 4;
    int K = g.Kb; asm volatile("" : "+s"(K));
    const int nt = K / (BK * 2);
    int Ra[2], Ca[2]; unsigned voffB[2];
#pragma unroll
    for (int i = 0; i < 2; ++i) { int R, C; stage_rc(tid * 16 + i * 8192, R, C); const int Rb = Epi::PERM ? ((R & ~31) + perm32(R & 31)) : R;
        Ra[i] = R; Ca[i] = C * 2; voffB[i] = (unsigned)(Rb * K + C * 2); }
    const size_t kstep = (size_t)(BK * 2);
    const size_t hstep = (size_t)HALF * K;
    const size_t tstep = 2 * hstep;
    const unsigned ldsw = (unsigned)wid * 1024u;
    const unsigned lds0 = (unsigned)(uintptr_t)lds;
    const int aoff = lds_byte(wr * 64 + fr, fq * 8), boff = lds_byte(wc * 32 + fr, fq * 8);
#define PG8_SA(b, h) (((b) * 2 + (h)) * HTB)
#define PG8_SB(b, h) ((4 + (b) * 2 + (h)) * HTB)
#define PG8_STAGE(bufoff, gbase, voff) do { _Pragma("unroll") for (int _i = 0; _i < 2; ++_i) { unsigned keep_; \
        asm volatile("s_mov_b32 %0, m0\n\ts_mov_b32 m0, %2\n\ts_nop 0\n\tglobal_load_lds_dwordx4 %1, %3\n\ts_mov_b32 m0, %0" : "=&s"(keep_) \
            : "v"((voff)[_i]), "s"((unsigned)__builtin_amdgcn_readfirstlane((int)(lds0 + (bufoff) + ldsw + _i * 8192))), "s"((const void*)(gbase)) : "memory"); } } while (0)
#define PG8_LD8(addr) __builtin_shufflevector(*(const PG8_LAS v4i_t*)(addr), *(const PG8_LAS v4i_t*)((addr) + 1024), 0, 1, 2, 3, 4, 5, 6, 7)
#define PG8_LDA(dst, b, h) do { _Pragma("unroll") for (int m = 0; m < 4; ++m) dst[m] = PG8_LD8(lds + PG8_SA(b, h) + aoff + m * 2048); } while (0)
#define PG8_LDB(dst, b, h) do { _Pragma("unroll") for (int n = 0; n < 2; ++n) dst[n] = PG8_LD8(lds + PG8_SB(b, h) + boff + n * 2048); } while (0)
#define PG8_HALF(x, k) __builtin_bit_cast(bf16x8, __builtin_shufflevector(x, x, 4 * (k), 4 * (k) + 1, 4 * (k) + 2, 4 * (k) + 3))
#define PG8_MMA(ai, bj, At, Bt) do { __builtin_amdgcn_s_setprio(1); _Pragma("unroll") for (int m = 0; m < 4; ++m) _Pragma("unroll") for (int n = 0; n < 2; ++n) { \
        if constexpr (FP8) asm volatile("v_mfma_scale_f32_16x16x128_f8f6f4 %0, %1, %2, %0, %3, %3 op_sel_hi:[0,0,0]" : "+v"(acc[ai][bj][m][n]) : "v"(Bt[n]), "v"(At[m]), "v"(sc1_));   \
        else { acc[ai][bj][m][n] = __builtin_amdgcn_mfma_f32_16x16x32_bf16(PG8_HALF(Bt[n], 0), PG8_HALF(At[m], 0), acc[ai][bj][m][n], 0, 0, 0); \
               acc[ai][bj][m][n] = __builtin_amdgcn_mfma_f32_16x16x32_bf16(PG8_HALF(Bt[n], 1), PG8_HALF(At[m], 1), acc[ai][bj][m][n], 0, 0, 0); } } \
        __builtin_amdgcn_s_setprio(0); } while (0)
#define PG8_WAIT_V(n) asm volatile("s_waitcnt vmcnt(" #n ")" ::: "memory")
#define PG8_WAIT_L(n) asm volatile("s_waitcnt lgkmcnt(" #n ")" ::: "memory")
#define PG8_BAR __builtin_amdgcn_s_barrier()
#define PG8_SCHED __builtin_amdgcn_sched_barrier(0)
#define PG8_AOFF(dst, u, slot) do { _Pragma("unroll") for (int _h = 0; _h < 2; ++_h) _Pragma("unroll") for (int _i = 0; _i < 2; ++_i) dst[_h][_i] = AO.off(u, slot, _h * HALF + Ra[_i], K) + (unsigned)Ca[_i]; } while (0)
    Unit cur, nxt; int ui = 0;
    if (!S.next(0, cur)) return;
    Acc acc;
#pragma unroll
    for (int a = 0; a < 2; ++a)
#pragma unroll
        for (int b = 0; b < 2; ++b)
#pragma unroll
            for (int m = 0; m < 4; ++m)
#pragma unroll
                for (int n = 0; n < 2; ++n) acc[a][b][m][n] = (f32x4){0.f, 0.f, 0.f, 0.f};
    v8i_t At[4], B0[2], B1[2];
    int sc1_ = 0x7F7F7F7F; asm volatile("" : "+v"(sc1_));
    unsigned aoC[2][2];
    PG8_AOFF(aoC, cur, 0);
    const char* gA = (const char*)g.A; const char* gB = (const char*)g.Bt;
    asm volatile("" : "+s"(gA), "+s"(gB));
    const char* cB = gB + (size_t)cur.pb * tstep;
    PG8_STAGE(PG8_SB(0, 0), cB, voffB); PG8_STAGE(PG8_SB(0, 1), cB + hstep, voffB); PG8_STAGE(PG8_SA(0, 0), gA, aoC[0]); PG8_STAGE(PG8_SA(0, 1), gA, aoC[1]);
    if (wr == 1) PG8_BAR;
    PG8_WAIT_V(2); PG8_BAR;
    PG8_STAGE(PG8_SB(1, 0), cB + kstep, voffB); PG8_STAGE(PG8_SA(1, 0), gA + kstep, aoC[0]); PG8_STAGE(PG8_SB(1, 1), cB + hstep + kstep, voffB);
    PG8_WAIT_V(6); PG8_BAR;
    for (;;) {
        const bool has_next = S.next(ui + 1, nxt);
        const char* nB = has_next ? gB + (size_t)nxt.pb * tstep : cB;
        for (int t = 0; t < nt; t += 2) {
            const bool last = (t == nt - 2);
            const char* a1 = gA + (size_t)(t + 1) * kstep;
            const char* a2 = last ? gA : gA + (size_t)(t + 2) * kstep; const char* b2 = last ? nB : cB + (size_t)(t + 2) * kstep;
            const char* a3 = a2 + kstep; const char* b3 = b2 + kstep;
            unsigned ao2[2][2];
            if (last && has_next) { PG8_AOFF(ao2, nxt, ui + 1); }
            else {
#pragma unroll
                for (int _h = 0; _h < 2; ++_h)
#pragma unroll
                    for (int _i = 0; _i < 2; ++_i) ao2[_h][_i] = aoC[_h][_i]; }
            PG8_LDB(B0, 0, 0); PG8_LDB(B1, 0, 1); PG8_SCHED; PG8_LDA(At, 0, 0); PG8_STAGE(PG8_SA(1, 1), a1, aoC[1]);
            PG8_WAIT_V(8); PG8_WAIT_L(0); PG8_BAR; PG8_MMA(0, 0, At, B0); PG8_MMA(0, 1, At, B1); PG8_BAR; PG8_SCHED;
            PG8_LDA(At, 0, 1); PG8_STAGE(PG8_SB(0, 0), b2, voffB); PG8_STAGE(PG8_SB(0, 1), b2 + hstep, voffB); PG8_STAGE(PG8_SA(0, 0), a2, ao2[0]);
            PG8_WAIT_V(8); PG8_WAIT_L(0); PG8_BAR; PG8_MMA(1, 0, At, B0); PG8_MMA(1, 1, At, B1); PG8_BAR; PG8_SCHED;
            PG8_LDB(B0, 1, 0); PG8_LDB(B1, 1, 1); PG8_SCHED; PG8_LDA(At, 1, 0); PG8_STAGE(PG8_SA(0, 1), a2, ao2[1]);
            PG8_WAIT_V(8); PG8_WAIT_L(0); PG8_BAR; PG8_MMA(0, 0, At, B0); PG8_MMA(0, 1, At, B1); PG8_BAR; PG8_SCHED;
            PG8_LDA(At, 1, 1); PG8_STAGE(PG8_SB(1, 0), b3, voffB); PG8_STAGE(PG8_SB(1, 1), b3 + hstep, voffB); PG8_STAGE(PG8_SA(1, 0), a3, ao2[0]);
            PG8_WAIT_V(8); PG8_WAIT_L(0); PG8_BAR; PG8_MMA(1, 0, At, B0); PG8_MMA(1, 1, At, B1); PG8_BAR; PG8_SCHED;
        }
        if (wr == 0) PG8_BAR;
        E(acc, cur, wr, wc, fr, fq);
        if (!has_next) break;
#pragma unroll
        for (int a = 0; a < 2; ++a)
#pragma unroll
            for (int b = 0; b < 2; ++b)
#pragma unroll
                for (int m = 0; m < 4; ++m)
#pragma unroll
                    for (int n = 0; n < 2; ++n) acc[a][b][m][n] = (f32x4){0.f, 0.f, 0.f, 0.f};
        cur = nxt; cB = nB; ++ui;
        PG8_AOFF(aoC, cur, ui);
        if (wr == 1) PG8_BAR;
    }
    PG8_WAIT_V(0);
    PG8_BAR;
#undef PG8_SA
#undef PG8_SB
#undef PG8_STAGE
#undef PG8_LDA
#undef PG8_LDB
#undef PG8_MMA
#undef PG8_LD8
#undef PG8_HALF
#undef PG8_WAIT_V
#undef PG8_WAIT_L
#undef PG8_BAR
#undef PG8_SCHED
#undef PG8_AOFF
}
}
namespace att {
typedef unsigned short bf16;
typedef short bf16x8 __attribute__((ext_vector_type(8)));
typedef short s16x4 __attribute__((ext_vector_type(4)));
typedef float f32x16 __attribute__((ext_vector_type(16)));
typedef float f32x4 __attribute__((ext_vector_type(4)));
typedef unsigned u32x4 __attribute__((ext_vector_type(4)));
constexpr int NW = 8, QBLK = 32, KVBLK = 64, QB = NW * QBLK, DV = 128;
constexpr float THR = 8.f;
constexpr int SHM_V = KVBLK * DV * 2;
template <int DQK> struct Cfg { static constexpr int NKC = DQK / 8, KCH = NKC / 8, KPITCH = DQK * 2, SHM_K = KVBLK * KPITCH, NQF = DQK / 16, LDS_BYTES = 2 * SHM_V + 2 * SHM_K + NW * 64 * 4; };
#define SBAR() __builtin_amdgcn_sched_barrier(0)
__device__ __forceinline__ int v_st(int k, int c) { const int kk = (k & ~0xC) | ((k & 4) << 1) | ((k & 8) >> 1); return ((kk >> 3) * 4 + (c >> 5)) * 512 + ((kk & 7) * 32 + (c & 31)) * 2; }
__device__ __forceinline__ int v_rd_base(int lane) { return ((lane & 3) << 3) | (((lane >> 2) & 3) << 6) | (((lane >> 4) & 1) << 5) | (((lane >> 5) & 1) << 8); }
constexpr int v_rd_off(int d0, int ks, int half) { return d0 * 512 + ks * 4096 + half * 2048; }
__device__ __forceinline__ int crow(int r, int hi) { return (r & 3) + 8 * (r >> 2) + 4 * hi; }
__device__ __forceinline__ unsigned cvtpk(float lo, float hi) { return pg8::cvt_pk_bf16(lo, hi); }
__device__ __forceinline__ bf16x8 load8(const bf16* p) { return *reinterpret_cast<const bf16x8*>(p); }
__device__ __forceinline__ void mask_tile(f32x16& p0, f32x16& p1, int dq, unsigned W) {
    const float NEG = -__builtin_inff();
#pragma unroll
    for (int r = 0; r < 16; ++r) { const int c = (r & 3) + 8 * (r >> 2);
        if ((unsigned)(dq - c) >= W) p0[r] = NEG;
        if ((unsigned)(dq - c - 32) >= W) p1[r] = NEG; }
}
__device__ __forceinline__ void partialSM(f32x16& p0, f32x16& p1, float& m_reg, float& mn, float& alpha, float scale) {
    float pmax = p0[0];
#pragma unroll
    for (int r = 1; r < 16; ++r) pmax = fmaxf(pmax, p0[r]);
#pragma unroll
    for (int r = 0; r < 16; ++r) pmax = fmaxf(pmax, p1[r]);
    { auto rr = __builtin_amdgcn_permlane32_swap(__float_as_uint(pmax), __float_as_uint(pmax), false, false);
      pmax = fmaxf(__uint_as_float(rr[0]), __uint_as_float(rr[1])); }
    const float C2 = 1.4426950408889634f * scale;
    if (__builtin_expect(__all((pmax - m_reg) * scale <= THR), 1)) { mn = m_reg; alpha = 1.f; }
    else { mn = fmaxf(m_reg, pmax); alpha = __builtin_amdgcn_exp2f((m_reg - mn) * C2); m_reg = mn; }
    const float mnL = -mn * C2;
#pragma unroll
    for (int r = 0; r < 16; ++r) p0[r] = fmaf(p0[r], C2, mnL);
#pragma unroll
    for (int r = 0; r < 16; ++r) p1[r] = fmaf(p1[r], C2, mnL);
#pragma unroll
    for (int r = 0; r < 16; ++r) p0[r] = __builtin_amdgcn_exp2f(p0[r]);
}
__device__ __forceinline__ void finishSM(f32x16& p0, f32x16& p1, float alpha, float& l_reg, bf16x8& pa0, bf16x8& pa1, bf16x8& pa2, bf16x8& pa3) {
#pragma unroll
    for (int r = 0; r < 16; ++r) p1[r] = __builtin_amdgcn_exp2f(p1[r]);
    float ps = 0;
#pragma unroll
    for (int r = 0; r < 16; ++r) ps += p0[r];
#pragma unroll
    for (int r = 0; r < 16; ++r) ps += p1[r];
    { auto rr = __builtin_amdgcn_permlane32_swap(__float_as_uint(ps), __float_as_uint(ps), false, false);
      ps = __uint_as_float(rr[0]) + __uint_as_float(rr[1]); }
    l_reg = l_reg * alpha + ps;
#define PK4(P, B_, OUT) do { unsigned a0 = cvtpk(P[B_+0], P[B_+1]), a1 = cvtpk(P[B_+2], P[B_+3]);                          \
        unsigned b0 = cvtpk(P[B_+4], P[B_+5]), b1 = cvtpk(P[B_+6], P[B_+7]);                                             \
        auto r0 = __builtin_amdgcn_permlane32_swap(a0, b0, false, false); auto r1 = __builtin_amdgcn_permlane32_swap(a1, b1, false, false); \
        u32x4 w = {r0[0], r1[0], r0[1], r1[1]}; OUT = *reinterpret_cast<bf16x8*>(&w); } while (0)
    PK4(p0, 0, pa0); PK4(p0, 8, pa1); PK4(p1, 0, pa2); PK4(p1, 8, pa3);
#undef PK4
}
template <int KB, bool SK, int DQK, bool DIL>
__device__ __forceinline__ void qkt(f32x16& p0, f32x16& p1, const char* K_lds, int r32, int hi, const bf16x8* qr, bool act, float beta, int dq) {
    typedef Cfg<DQK> C;
    if (SK && !act) { const float NEG = -__builtin_inff();
#pragma unroll
        for (int r = 0; r < 16; ++r) { p0[r] = NEG; p1[r] = NEG; } return; }
    if constexpr (DIL) { const float b0 = -beta * (float)dq;
#pragma unroll
        for (int r = 0; r < 16; ++r) { const int c = (r & 3) + 8 * (r >> 2); p0[r] = fmaf(beta, (float)c, b0); p1[r] = fmaf(beta, (float)(c + 32), b0); } }
    else { p0 = f32x16{}; p1 = f32x16{}; }
    const char* kb[4];
#pragma unroll
    for (int dd = 0; dd < 4; ++dd) { const int colB = (dd * 16 + hi * 8) * 2; kb[dd] = K_lds + KB * C::SHM_K + r32 * C::KPITCH + (colB ^ ((r32 & 7) << 4)); }
#pragma unroll
    for (int d0 = 0; d0 < C::NQF; ++d0) { const char* a = kb[d0 & 3] + (d0 >> 2) * 128;
        bf16x8 b0 = *reinterpret_cast<const bf16x8*>(a);
        bf16x8 b1 = *reinterpret_cast<const bf16x8*>(a + 32 * C::KPITCH);
        p0 = __builtin_amdgcn_mfma_f32_32x32x16_bf16(b0, qr[d0], p0, 0, 0, 0);
        p1 = __builtin_amdgcn_mfma_f32_32x32x16_bf16(b1, qr[d0], p1, 0, 0, 0);
#ifndef ATT_NO_QKT_SBAR
        if ((d0 & 3) == 3) SBAR();
#endif
    }
}
#ifdef ATT_PV_PIPE
template <int VB, bool SK>
__device__ __forceinline__ void pv_tile(f32x16* o, int vb0, bf16x8 pa0, bf16x8 pa1, bf16x8 pa2, bf16x8 pa3, bool act) {
    if (SK && !act) return;
#define TRRD(dst, off) asm volatile("ds_read_b64_tr_b16 %0, %1 offset:%2" : "=&v"(dst) : "v"(vb0), "i"(off) : "memory")
#define PV_RD(S_, d0) do { constexpr int b_ = VB * SHM_V + v_rd_off(d0, 0, 0); \
        TRRD(S_##l0, b_); TRRD(S_##h0, b_ + 2048); TRRD(S_##l1, b_ + 4096); TRRD(S_##h1, b_ + 6144); TRRD(S_##l2, b_ + 8192); TRRD(S_##h2, b_ + 10240); TRRD(S_##l3, b_ + 12288); TRRD(S_##h3, b_ + 14336); } while (0)
#define PV_MM(S_, d0) do { \
        o[d0] = __builtin_amdgcn_mfma_f32_32x32x16_bf16(pa0, (bf16x8){S_##l0[0], S_##l0[1], S_##l0[2], S_##l0[3], S_##h0[0], S_##h0[1], S_##h0[2], S_##h0[3]}, o[d0], 0, 0, 0);   \
        o[d0] = __builtin_amdgcn_mfma_f32_32x32x16_bf16(pa1, (bf16x8){S_##l1[0], S_##l1[1], S_##l1[2], S_##l1[3], S_##h1[0], S_##h1[1], S_##h1[2], S_##h1[3]}, o[d0], 0, 0, 0);   \
        o[d0] = __builtin_amdgcn_mfma_f32_32x32x16_bf16(pa2, (bf16x8){S_##l2[0], S_##l2[1], S_##l2[2], S_##l2[3], S_##h2[0], S_##h2[1], S_##h2[2], S_##h2[3]}, o[d0], 0, 0, 0);   \
        o[d0] = __builtin_amdgcn_mfma_f32_32x32x16_bf16(pa3, (bf16x8){S_##l3[0], S_##l3[1], S_##l3[2], S_##l3[3], S_##h3[0], S_##h3[1], S_##h3[2], S_##h3[3]}, o[d0], 0, 0, 0); } while (0)
#define PV_W8() do { asm volatile("s_waitcnt lgkmcnt(8)" ::: "memory"); SBAR(); } while (0)
#define PV_W0() do { asm volatile("s_waitcnt lgkmcnt(0)" ::: "memory"); SBAR(); } while (0)
    s16x4 al0, al1, al2, al3, ah0, ah1, ah2, ah3, bl0, bl1, bl2, bl3, bh0, bh1, bh2, bh3;
    PV_RD(a, 0); PV_RD(b, 1); PV_W8(); PV_MM(a, 0); SBAR();
    PV_RD(a, 2); PV_W8(); PV_MM(b, 1); SBAR();
    PV_RD(b, 3); PV_W8(); PV_MM(a, 2); SBAR();
    PV_W0(); PV_MM(b, 3);
#undef PV_RD
#undef PV_MM
#undef PV_W8
#undef PV_W0
#undef TRRD
}
#else
template <int VB, bool SK>
__device__ __forceinline__ void pv_tile(f32x16* o, int vb0, bf16x8 pa0, bf16x8 pa1, bf16x8 pa2, bf16x8 pa3, bool act) {
    if (SK && !act) return;
#define TRRD(dst, off) asm volatile("ds_read_b64_tr_b16 %0, %1 offset:%2" : "=&v"(dst) : "v"(vb0), "i"(off) : "memory")
#define PV_D0(d0) do { s16x4 l0, l1, l2, l3, h0, h1, h2, h3; constexpr int b_ = VB * SHM_V + v_rd_off(d0, 0, 0); \
        TRRD(l0, b_); TRRD(h0, b_ + 2048); TRRD(l1, b_ + 4096); TRRD(h1, b_ + 6144); TRRD(l2, b_ + 8192); TRRD(h2, b_ + 10240); TRRD(l3, b_ + 12288); TRRD(h3, b_ + 14336); \
        asm volatile("s_waitcnt lgkmcnt(0)" ::: "memory"); SBAR();   \
        o[d0] = __builtin_amdgcn_mfma_f32_32x32x16_bf16(pa0, (bf16x8){l0[0], l0[1], l0[2], l0[3], h0[0], h0[1], h0[2], h0[3]}, o[d0], 0, 0, 0);   \
        o[d0] = __builtin_amdgcn_mfma_f32_32x32x16_bf16(pa1, (bf16x8){l1[0], l1[1], l1[2], l1[3], h1[0], h1[1], h1[2], h1[3]}, o[d0], 0, 0, 0);   \
        o[d0] = __builtin_amdgcn_mfma_f32_32x32x16_bf16(pa2, (bf16x8){l2[0], l2[1], l2[2], l2[3], h2[0], h2[1], h2[2], h2[3]}, o[d0], 0, 0, 0);   \
        o[d0] = __builtin_amdgcn_mfma_f32_32x32x16_bf16(pa3, (bf16x8){l3[0], l3[1], l3[2], l3[3], h3[0], h3[1], h3[2], h3[3]}, o[d0], 0, 0, 0); } while (0)
    PV_D0(0); PV_D0(1); PV_D0(2); PV_D0(3);
#undef PV_D0
#undef TRRD
}
#endif

struct Blk { unsigned qo, ko, vo, oo, lo; int P0, rate; float beta; };
constexpr int PVAR = 0;
#define QS_(B) (DIL ? ((PVAR & 4) ? 128 : (B).rate * 4096) : 1536)
#define KS_(B) (DIL ? ((PVAR & 2) ? 128 : (B).rate * 4096) : 1536)
#define VS_(B) (DIL ? ((PVAR & 2) ? 128 : (B).rate * 4096) : 1024)
#define OS_(B) (DIL ? (B).rate * 1024 : 1024)
#define LS_(B) ((B).rate * 8)
#define SKV_(B) (DIL ? 8192 / (B).rate : 8192)
#define W_(B) (DIL ? 129 : (1 << 30))
#define SCALE_ (DIL ? 0.08838834764831845f : 0.07216878364870322f)
template <int DQK> struct Seam { bf16x8 qr[Cfg<DQK>::NQF]; bf16x8 st_v0, st_v1; bf16x8 st_k[Cfg<DQK>::KCH]; unsigned p_oo = 0; int p_rb = 0, p_so0 = 0, p_on = 0; float cv[4], cw[4]; int cv_j = 0, cv_q = 0, cl_j = 0, cl_q = 0; f32x4 rt[8]; float cvf[32]; int cv_pend = 0; };
__device__ __forceinline__ int swa_jlo(int P0, int W) { const int lowk = P0 - W + 1; return lowk > 0 ? lowk / KVBLK : 0; }

#define VMW() asm volatile("s_waitcnt vmcnt(0)" ::: "memory")
#ifdef ATT_RAWBAR
#define A_STEPBAR() do { asm volatile("s_waitcnt lgkmcnt(0)" ::: "memory"); __builtin_amdgcn_s_barrier(); asm volatile("" ::: "memory"); } while (0)
#else
#define A_STEPBAR() __syncthreads()
#endif
#define VMWN(n) asm volatile("s_waitcnt vmcnt(%0)" :: "i"(n) : "memory")
#define A_RSRC(p) __builtin_amdgcn_make_buffer_rsrc((void*)(p), 0, 0x7fffffff, 0x00020000)
#define A_BLD(rs, vo, so) __builtin_bit_cast(bf16x8, __builtin_amdgcn_raw_buffer_load_b128((rs), (int)(vo), (int)(so), 0))
#ifdef ATT_SLOAD_RECOMP
#define A_SLOAD(B_, k0) do { const __amdgpu_buffer_rsrc_t rv_ = A_RSRC(wsb + (B_).vo), rk_ = A_RSRC(wsb + (B_).ko); const int sov_ = (k0) * VS_(B_) * 2, sok_ = (k0) * KS_(B_) * 2; \
        int t_ = tid; asm volatile("" : "+v"(t_)); const int sr_ = t_ >> 4, sc_ = (t_ & 15) * 8; \
        S.st_v0 = A_BLD(rv_, (sr_ * VS_(B_) + sc_) * 2, sov_); S.st_v1 = A_BLD(rv_, ((32 + sr_) * VS_(B_) + sc_) * 2, sov_); \
        _Pragma("unroll") for (int j_ = 0; j_ < C::KCH; ++j_) { const int q_ = t_ + 512 * j_; S.st_k[j_] = A_BLD(rk_, ((q_ / C::NKC) * KS_(B_) + (q_ % C::NKC) * 8) * 2, sok_); } } while (0)
#else
#define A_SLOAD(B_, k0) do { const __amdgpu_buffer_rsrc_t rv_ = A_RSRC(wsb + (B_).vo), rk_ = A_RSRC(wsb + (B_).ko); const int sov_ = (k0) * VS_(B_) * 2, sok_ = (k0) * KS_(B_) * 2; \
        S.st_v0 = A_BLD(rv_, (sr * VS_(B_) + sc) * 2, sov_); S.st_v1 = A_BLD(rv_, ((32 + sr) * VS_(B_) + sc) * 2, sov_); \
        _Pragma("unroll") for (int j_ = 0; j_ < C::KCH; ++j_) S.st_k[j_] = A_BLD(rk_, (krow[j_] * KS_(B_) + kcol[j_]) * 2, sok_); } while (0)
#endif
#define A_QLOAD(B_) do { const __amdgpu_buffer_rsrc_t rq_ = A_RSRC(wsb + (B_).qo); const int soq_ = ((B_).P0 + wid * QBLK) * QS_(B_) * 2; const int qo_ = r32 * QS_(B_) * 2 + hi * 16; \
        _Pragma("unroll") for (int d0 = 0; d0 < C::NQF; ++d0) S.qr[d0] = A_BLD(rq_, qo_ + d0 * 32, soq_); } while (0)
#define A_SWRITE_K(bf) do { _Pragma("unroll") for (int j_ = 0; j_ < C::KCH; ++j_) *(bf16x8*)(K_lds + (bf) * C::SHM_K + kws[j_]) = S.st_k[j_]; } while (0)
#define A_SWRITE_V(bf) do { *(bf16x8*)(V_lds + (bf) * SHM_V + vst0) = S.st_v0; *(bf16x8*)(V_lds + (bf) * SHM_V + vst1) = S.st_v1; } while (0)
#define A_STAGE_IDX() const int sr = tid >> 4, sc = (tid & 15) * 8; int krow[C::KCH], kcol[C::KCH], kws[C::KCH]; \
        _Pragma("unroll") for (int j_ = 0; j_ < C::KCH; ++j_) { const int q_ = tid + 512 * j_; krow[j_] = q_ / C::NKC; kcol[j_] = (q_ % C::NKC) * 8; kws[j_] = krow[j_] * C::KPITCH + ((kcol[j_] * 2) ^ ((krow[j_] & 7) << 4)); }

__device__ __forceinline__ void store_o_staged(const f32x16* o, const float* rli, char* stg, __amdgpu_buffer_rsrc_t ro_, int rowbytes, int so0_, int lane) {
    const int r32 = lane & 31, hi = lane >> 5, odd = lane & 1, g = odd | (hi << 1);
    char* wb = stg + (odd + 4 * hi) * 256 + (r32 >> 1) * 4;
    char* wa[4];
#pragma unroll
    for (int d0 = 0; d0 < 4; ++d0) wa[d0] = wb + ((d0 ^ g) << 6);
    const int lr = lane >> 4, ch = lane & 15, sp = ch >> 2, gl = lr & 1;
    const char* rb_e = stg + lr * 256 + ((sp ^ gl) << 6) + (lane & 3) * 16;
    const char* rb_o = stg + lr * 256 + ((sp ^ (gl | 2)) << 6) + (lane & 3) * 16;
    const int voff = lr * rowbytes + ch * 16;
#pragma unroll
    for (int h = 0; h < 2; ++h) {
#pragma unroll
        for (int rp = 0; rp < 4; ++rp) { const int r = 8 * h + 2 * rp, Rl = (r & 3) + 8 * ((r >> 2) & 1);
#pragma unroll
            for (int d0 = 0; d0 < 4; ++d0) { const float v0 = o[d0][r] * rli[r], v1 = o[d0][r + 1] * rli[r + 1];
                const float send = odd ? v0 : v1;
                const float recv = __int_as_float(__builtin_amdgcn_update_dpp(0, __float_as_int(send), 0xB1, 0xF, 0xF, true));
                *reinterpret_cast<unsigned*>(wa[d0] + Rl * 256) = cvtpk(odd ? recv : v0, odd ? v1 : recv); } }
        u32x4 d_[4];
#pragma unroll
        for (int i = 0; i < 4; ++i) d_[i] = *reinterpret_cast<const u32x4*>(((i & 1) ? rb_o : rb_e) + i * 1024);
#pragma unroll
        for (int i = 0; i < 4; ++i) __builtin_amdgcn_raw_buffer_store_b128(d_[i], ro_, voff + so0_ + (16 * h + 4 * i) * rowbytes, 0, 0);
    }
}
constexpr int DEFER_STG = 65536, DEFER_WS = 131072 + 512;
__device__ __forceinline__ void stage_write(const f32x16* o, const float* rli, char* stg, int lane) {
    const int r32 = lane & 31, hi = lane >> 5, odd = lane & 1, g = odd | (hi << 1);
    char* wb = stg + (odd + 4 * hi) * 256 + (r32 >> 1) * 4;
    char* wa[4];
#pragma unroll
    for (int d0 = 0; d0 < 4; ++d0) wa[d0] = wb + ((d0 ^ g) << 6);
#pragma unroll
    for (int h = 0; h < 2; ++h)
#pragma unroll
        for (int rp = 0; rp < 4; ++rp) { const int r = 8 * h + 2 * rp, Rl = (r & 3) + 8 * ((r >> 2) & 1);
#pragma unroll
            for (int d0 = 0; d0 < 4; ++d0) { const float v0 = o[d0][r] * rli[r], v1 = o[d0][r + 1] * rli[r + 1];
                const float send = odd ? v0 : v1;
                const float recv = __int_as_float(__builtin_amdgcn_update_dpp(0, __float_as_int(send), 0xB1, 0xF, 0xF, true));
                *reinterpret_cast<unsigned*>(wa[d0] + h * 4096 + Rl * 256) = cvtpk(odd ? recv : v0, odd ? v1 : recv); } }
}
__device__ __forceinline__ void flush_piece(const char* stg, int p, const char* obase, int rowbytes, int so0, int lane) {
    const int lr = lane >> 4, ch = lane & 15, sp = ch >> 2, g = (lr & 1) | ((p & 1) << 1);
    const u32x4 d = *reinterpret_cast<const u32x4*>(stg + p * 1024 + lr * 256 + ((sp ^ g) << 6) + (lane & 3) * 16);
    __builtin_amdgcn_raw_buffer_store_b128(d, A_RSRC(obase), lr * rowbytes + ch * 16 + so0 + 4 * p * rowbytes, 0, 0);
}
struct ConvCtx { const float* eg; const float* eu; const float* ed; unsigned char* w13; unsigned char* w2; int gw; };
constexpr int CONV_SCR = 86016, CONV_NJ = 48;
#ifndef CONV_AUX
#define CONV_AUX 2
#endif
struct ConvItem { const float* src; unsigned char* dst; int ldw, kd; };
__device__ __forceinline__ ConvItem conv_decode(const ConvCtx& X, int j) {
    const int q = X.gw + 2048 * j, e = q / 6144, r = q - e * 6144, m = r >> 11, r2 = r & 2047;
    ConvItem I;
    if (m < 2) { const int kb = r2 >> 6, nb = r2 & 63, n0 = nb * 16; I.ldw = 1024; I.kd = 2048;
        I.src = (m == 0 ? X.eg : X.eu) + (size_t)e * (2048 * 1024) + (size_t)kb * (64 * 1024) + n0;
        I.dst = X.w13 + (size_t)e * (2048 * 2048) + (size_t)((n0 >> 7) * 256 + (m == 1 ? 128 : 0) + (n0 & 127)) * 2048 + kb * 64; }
    else { const int kb = r2 >> 7, nb = r2 & 127; I.ldw = 2048; I.kd = 1024;
        I.src = X.ed + (size_t)e * (1024 * 2048) + (size_t)kb * (64 * 2048) + nb * 16;
        I.dst = X.w2 + (size_t)e * (2048 * 1024) + (size_t)(nb * 16) * 1024 + kb * 64; }
    return I;
}
__device__ __forceinline__ void conv_load(const ConvCtx& X, int j, int qd, float* cv, int lane) {
    const ConvItem I = conv_decode(X, j); const __amdgpu_buffer_rsrc_t rs = A_RSRC(I.src);
#pragma unroll
    for (int i = 0; i < 4; ++i) { const int k = 4 * (4 * qd + i) + (lane >> 4);
        cv[i] = __uint_as_float(__builtin_amdgcn_raw_buffer_load_b32(rs, (k * I.ldw + (lane & 15)) * 4, 0, CONV_AUX)); }
}
__device__ __forceinline__ void conv_put(const ConvCtx& X, int j, int qd, const float* cv, char* scr, int lane, bool finish_only = false) {
    float* s = reinterpret_cast<float*>(scr);
    if (!finish_only) {
#pragma unroll
    for (int i = 0; i < 4; ++i) { const int k = 4 * (4 * qd + i) + (lane >> 4); s[k * 17 + (lane & 15)] = cv[i] * 256.0f; } }
    if (qd == 3) {
        const ConvItem I = conv_decode(X, j); const int n = lane & 15, kq = lane >> 4; const float* c = s + (16 * kq) * 17 + n;
        u32x4 w;
        { int w0 = 0, w1 = 0, w2 = 0, w3 = 0;
          w0 = __builtin_amdgcn_cvt_pk_fp8_f32(c[0 * 17], c[1 * 17], w0, false); w0 = __builtin_amdgcn_cvt_pk_fp8_f32(c[2 * 17], c[3 * 17], w0, true);
          w1 = __builtin_amdgcn_cvt_pk_fp8_f32(c[4 * 17], c[5 * 17], w1, false); w1 = __builtin_amdgcn_cvt_pk_fp8_f32(c[6 * 17], c[7 * 17], w1, true);
          w2 = __builtin_amdgcn_cvt_pk_fp8_f32(c[8 * 17], c[9 * 17], w2, false); w2 = __builtin_amdgcn_cvt_pk_fp8_f32(c[10 * 17], c[11 * 17], w2, true);
          w3 = __builtin_amdgcn_cvt_pk_fp8_f32(c[12 * 17], c[13 * 17], w3, false); w3 = __builtin_amdgcn_cvt_pk_fp8_f32(c[14 * 17], c[15 * 17], w3, true);
          w = (u32x4){(unsigned)w0, (unsigned)w1, (unsigned)w2, (unsigned)w3}; }
        __builtin_amdgcn_raw_buffer_store_b128(w, A_RSRC(I.dst), n * I.kd + 16 * kq, 0, CONV_AUX);
    }
}
constexpr unsigned ROPE_OFF = 2u << 20;
#define A_RTLOAD(B_) do { const __amdgpu_buffer_rsrc_t rr_ = A_RSRC(wsb + ROPE_OFF); const int vo_ = ((B_).P0 + wid * QBLK + r32) * 256 + hi * 32; \
        _Pragma("unroll") for (int d_ = 0; d_ < 4; ++d_) { S.rt[2 * d_] = __builtin_bit_cast(f32x4, __builtin_amdgcn_raw_buffer_load_b128(rr_, vo_ + d_ * 64, 0, 0)); \
                                                            S.rt[2 * d_ + 1] = __builtin_bit_cast(f32x4, __builtin_amdgcn_raw_buffer_load_b128(rr_, vo_ + d_ * 64 + 16, 0, 0)); } } while (0)
__device__ __forceinline__ unsigned rope_pair(unsigned w, float c, float s) { const float x1 = __uint_as_float(w << 16), x2 = __uint_as_float(w & 0xffff0000u); return cvtpk(x1 * c - x2 * s, x2 * c + x1 * s); }
#define A_ROTATE() do { _Pragma("unroll") for (int d_ = 0; d_ < 4; ++d_) { u32x4 w_ = __builtin_bit_cast(u32x4, S.qr[8 + d_]); const f32x4 c01_ = S.rt[2 * d_], c23_ = S.rt[2 * d_ + 1]; \
        w_.x = rope_pair(w_.x, c01_[0], c01_[1]); w_.y = rope_pair(w_.y, c01_[2], c01_[3]); w_.z = rope_pair(w_.z, c23_[0], c23_[1]); w_.w = rope_pair(w_.w, c23_[2], c23_[3]); \
        S.qr[8 + d_] = __builtin_bit_cast(bf16x8, w_); } } while (0)
constexpr int CONV_SCR_DIL = 67584;
#ifndef CONV_PER_IDLE
#define CONV_PER_IDLE 1
#endif
#ifndef CONV_LAST_STEP
#define CONV_LAST_STEP 0
#endif
__device__ __forceinline__ void conv_load_full(const ConvCtx& X, int j, float* cv, int lane) {
    const ConvItem I = conv_decode(X, j); const __amdgpu_buffer_rsrc_t rs = A_RSRC(I.src);
#pragma unroll
    for (int i = 0; i < 16; ++i) { const int k = 4 * i + (lane >> 4); cv[i] = __uint_as_float(__builtin_amdgcn_raw_buffer_load_b32(rs, (k * I.ldw + (lane & 15)) * 4, 0, CONV_AUX)); }
}
__device__ __forceinline__ void conv_put_full(const ConvCtx& X, int j, const float* cv, char* scr, int lane) {
    float* s = reinterpret_cast<float*>(scr);
#pragma unroll
    for (int i = 0; i < 16; ++i) { const int k = 4 * i + (lane >> 4); s[k * 17 + (lane & 15)] = cv[i] * 256.0f; }
    float dummy_[4] = {0.f, 0.f, 0.f, 0.f};
    conv_put(X, j, 3, dummy_, scr, lane, true);
}
template <int DQK, bool DIL, int PVAR = 0, bool ROPE = false>
__device__ __forceinline__ void att_prime(const Blk& cur, const char* wsb, char* lds, Seam<DQK>& S, int tid_in) {
    typedef Cfg<DQK> C;
    int tid = tid_in; asm volatile("" : "+v"(tid));
    const int wid = __builtin_amdgcn_readfirstlane(tid >> 6), lane = tid & 63, r32 = lane & 31, hi = lane >> 5;
    A_STAGE_IDX(); char* K_lds = lds + 2 * SHM_V;
    const int kb0 = swa_jlo(cur.P0, W_(cur)) * KVBLK;
    A_QLOAD(cur);
    if constexpr (ROPE) A_RTLOAD(cur);
    A_SLOAD(cur, kb0); VMW(); A_SWRITE_K(0);
    __syncthreads();
}
template <int DQK, bool DIL, bool SK, int PVAR = 0, int CONV = 0, bool ROPE = false>
__device__ __forceinline__ void att_block(const Blk& cur, const Blk& nxt, const char* wsb, char* lds, Seam<DQK>& S, int tid_in, const ConvCtx* X = nullptr) {
    typedef Cfg<DQK> C;
    int tid = tid_in; asm volatile("" : "+v"(tid));
    const int wid = __builtin_amdgcn_readfirstlane(tid >> 6), lane = tid & 63, r32 = lane & 31, hi = lane >> 5;
    const int W = W_(cur); const float scale = SCALE_, beta = cur.beta;
    int j_lo = swa_jlo(cur.P0, W);
    int j_hi = (cur.P0 + QB - 1) / KVBLK + 1; if (j_hi > SKV_(cur) / KVBLK) j_hi = SKV_(cur) / KVBLK;
    if (PVAR & 8) j_lo = j_hi - 2;
    const int NT = j_hi - j_lo;
    const int kbn = swa_jlo(nxt.P0, W_(nxt)) * KVBLK;
    const int qlo = cur.P0 + wid * QBLK, qm = qlo + r32 - 4 * hi;
    char* V_lds = lds; char* K_lds = lds + 2 * SHM_V;
#ifdef ATT_DEFER
    constexpr bool DEFER = DIL;
#else
    constexpr bool DEFER = false;
#endif
    float* ws = (float*)(lds + (DEFER ? DEFER_WS : 2 * SHM_V + 2 * C::SHM_K)) + wid * 64; float* li_l = ws, * al_l = ws + 32;
    char* stg = lds + DEFER_STG + wid * 8192;
    float m_reg = -1e30f, l_reg = 0; f32x16 o[4] = {};
    A_STAGE_IDX();
    const int vst0 = v_st(sr, sc), vst1 = v_st(32 + sr, sc);
    const int vb0 = (int)(uintptr_t)V_lds + v_rd_base(lane);
#define RESC(a) do { if (__any((a) < 1.f)) { if (hi == 0) al_l[r32] = (a); asm volatile("s_waitcnt lgkmcnt(0)" ::: "memory");              \
                     _Pragma("unroll") for (int d_ = 0; d_ < 4; ++d_) _Pragma("unroll") for (int r = 0; r < 16; ++r) o[d_][r] *= al_l[crow(r, hi)]; } } while (0)
#define KBASE(t) ((j_lo + (t)) * KVBLK)
#define ACT(t) (KBASE(t) <= qlo + QBLK - 1 && KBASE(t) + KVBLK - 1 >= qlo - W + 1)
#define MASKT(P0_, P1_, t) do { const int kb_ = KBASE(t); if ((!SK || ACT(t)) && (kb_ + KVBLK - 1 > qlo || kb_ <= qlo + QBLK - 1 - W)) mask_tile(P0_, P1_, qm - kb_, (unsigned)W); } while (0)
    A_SWRITE_V(0);
    __syncthreads();
    if constexpr (ROPE) { VMW(); A_ROTATE(); }
#define STEP(t, BUF) do { const bool more_ = (t) + 1 < NT;                                                                        \
        if (more_) { A_SLOAD(cur, KBASE((t) + 1)); } else { A_SLOAD(nxt, kbn); }                                                   \
        const bool cpend_ = CONV == 1 && (S.cv_j != S.cl_j || S.cv_q != S.cl_q); const bool cld_ = CONV == 1 && more_ && S.cl_j < CONV_NJ;        \
        const bool act_ = !SK || ACT(t); const bool cidle_ = CONV == 2 && (more_ || CONV_LAST_STEP) && !act_ && (S.cv_j < CONV_NJ);                                \
        bool cnew_ = false;                                                                                                    \
        if (cidle_) { if (S.cv_pend) { VMWN(C::KCH + 2);        \
                          conv_put_full(*X, S.cv_j, S.cvf, lds + (DIL ? CONV_SCR_DIL : CONV_SCR) + wid * 4352, lane); ++S.cv_j;                 \
                          if (S.cv_pend > 1) { conv_put_full(*X, S.cv_j, S.cvf + 16, lds + (DIL ? CONV_SCR_DIL : CONV_SCR) + wid * 4352, lane); ++S.cv_j; } S.cv_pend = 0; } \
                      if (S.cv_j < CONV_NJ) { conv_load_full(*X, S.cv_j, S.cvf, lane); S.cv_pend = 1; cnew_ = true;                                \
                          if (CONV_PER_IDLE > 1 && S.cv_j + 1 < CONV_NJ) { conv_load_full(*X, S.cv_j + 1, S.cvf + 16, lane); S.cv_pend = 2; } } }        \
        if (cld_) { conv_load(*X, S.cl_j, S.cl_q, BUF ? S.cw : S.cv, lane); if (++S.cl_q == 4) { S.cl_q = 0; ++S.cl_j; } }               \
        if (DEFER && S.p_on && (t) < 4) { flush_piece(stg, 2 * (t), wsb + S.p_oo, S.p_rb, S.p_so0, lane); flush_piece(stg, 2 * (t) + 1, wsb + S.p_oo, S.p_rb, S.p_so0, lane); } \
        SBAR();                                                                                                                 \
        if (act_) { f32x16 p0, p1; float mn_, al_; bf16x8 pa0, pa1, pa2, pa3;      \
            qkt<BUF, false, DQK, DIL>(p0, p1, K_lds, r32, hi, S.qr, true, beta, qm - KBASE(t)); SBAR();                              \
            MASKT(p0, p1, t); partialSM(p0, p1, m_reg, mn_, al_, scale); finishSM(p0, p1, al_, l_reg, pa0, pa1, pa2, pa3); RESC(al_); SBAR(); \
            pv_tile<BUF, false>(o, vb0, pa0, pa1, pa2, pa3, true); }                                                             \
        if (!more_) { SBAR(); A_QLOAD(nxt); SBAR(); }                                 \
        if (more_) { if (cnew_) { if (S.cv_pend > 1) VMWN(32); else VMWN(16); } else if (cld_) VMWN(4); else VMW();            \
            A_SWRITE_V(1 - BUF); A_SWRITE_K(1 - BUF);                                                                              \
            if (cpend_) { conv_put(*X, S.cv_j, S.cv_q, BUF ? S.cv : S.cw, lds + CONV_SCR + wid * 4352, lane); if (++S.cv_q == 4) { S.cv_q = 0; ++S.cv_j; } } \
        }                                                                                                                       \
        A_STEPBAR(); } while (0)
    int t = 0;
    for (; t + 1 < NT; t += 2) { STEP(t, 0); STEP(t + 1, 1); }
    if (t < NT) { STEP(t, 0); }
    VMWN(C::NQF); A_SWRITE_K(0); SBAR();
    if (CONV == 1 && (S.cv_j != S.cl_j || S.cv_q != S.cl_q)) { conv_put(*X, S.cv_j, S.cv_q, S.cv, lds + CONV_SCR + wid * 4352, lane); if (++S.cv_q == 4) { S.cv_q = 0; ++S.cv_j; } }
    if (hi == 0) li_l[r32] = l_reg; asm volatile("s_waitcnt lgkmcnt(0)" ::: "memory");
    if constexpr (DIL) { if (hi == 0) __builtin_amdgcn_raw_buffer_store_b32(__float_as_uint(m_reg * scale + __logf(l_reg)), A_RSRC(wsb + cur.lo), r32 * LS_(cur) * 4, (cur.P0 + wid * QBLK) * LS_(cur) * 4, 0); }
    float rli[16];
#pragma unroll
    for (int r = 0; r < 16; ++r) rli[r] = __builtin_amdgcn_rcpf(li_l[crow(r, hi)]);
    if constexpr (DEFER) { stage_write(o, rli, stg, lane); S.p_oo = cur.oo; S.p_rb = OS_(cur) * 2; S.p_so0 = (cur.P0 + wid * QBLK) * OS_(cur) * 2; S.p_on = 1; }
    else {
#ifdef ATT_T21
    store_o_staged(o, rli, wid < 4 ? lds + SHM_V + wid * 4096 : lds + 2 * SHM_V + C::SHM_K + (wid - 4) * 4096, A_RSRC(wsb + cur.oo), OS_(cur) * 2, (cur.P0 + wid * QBLK) * OS_(cur) * 2, lane);
#else
    const int os_ = (PVAR & 1) ? 0 : OS_(cur);
    const __amdgpu_buffer_rsrc_t ro_ = A_RSRC(wsb + cur.oo); const int oo_ = (4 * hi * os_ + r32) * 2, so0_ = (cur.P0 + wid * QBLK) * os_ * 2;
#pragma unroll
    for (int r = 0; r < 16; ++r) { const int sor_ = so0_ + ((r & 3) + 8 * (r >> 2)) * os_ * 2;
#pragma unroll
        for (int d0 = 0; d0 < 4; ++d0) { const float v = o[d0][r] * rli[r];
            const float vn = __int_as_float(__builtin_amdgcn_update_dpp(0, __float_as_int(v), 0xB1, 0xF, 0xF, true));
            if ((r32 & 1) == 0) __builtin_amdgcn_raw_buffer_store_b32(cvtpk(v, vn), ro_, oo_ + d0 * 64, sor_, 0); } }
#endif
    }
    if constexpr (ROPE) A_RTLOAD(nxt);
#undef RESC
#undef KBASE
#undef ACT
#undef MASKT
#undef STEP
}

template <int DQK> struct SeamD { bf16x8 qr[Cfg<DQK>::NQF]; };
#define A_GLDS(voff, sbase, ldsdst) do { unsigned keep_; asm volatile("s_mov_b32 %0, m0\n\ts_mov_b32 m0, %2\n\ts_nop 0\n\tglobal_load_lds_dwordx4 %1, %3\n\ts_mov_b32 m0, %0" \
        : "=&s"(keep_) : "v"(voff), "s"((unsigned)__builtin_amdgcn_readfirstlane((int)(ldsdst))), "s"((const void*)(sbase)) : "memory"); } while (0)
#define A_DMA_IDX() int krow_[C::KCH], kcb_[C::KCH], vrow_[2], vcb_[2]; \
        _Pragma("unroll") for (int j_ = 0; j_ < C::KCH; ++j_) { const int p_ = (j_ * 8 + wid) * 1024 + lane * 16, row_ = p_ / C::KPITCH, pc_ = (p_ % C::KPITCH) / 16, lc_ = (pc_ & ~7) | ((pc_ & 7) ^ (row_ & 7)); \
            krow_[j_] = row_; kcb_[j_] = lc_ * 16; } \
        _Pragma("unroll") for (int j_ = 0; j_ < 2; ++j_) { const int p_ = (j_ * 8 + wid) * 1024 + lane * 16, s_ = p_ / 512, w_ = p_ % 512, kk_ = (s_ >> 2) * 8 + (w_ >> 6), col_ = (s_ & 3) * 32 + ((w_ & 63) >> 1); \
            vrow_[j_] = (kk_ & ~0xC) | ((kk_ & 4) << 1) | ((kk_ & 8) >> 1); vcb_[j_] = col_ * 2; }
#define A_DMA(B_, k0, sl_) do { const char* kb_ = wsb + (B_).ko + (size_t)(k0) * (size_t)(KS_(B_) * 2); const char* vb_ = wsb + (B_).vo + (size_t)(k0) * (size_t)(VS_(B_) * 2); \
        _Pragma("unroll") for (int j_ = 0; j_ < C::KCH; ++j_) A_GLDS((unsigned)(krow_[j_] * KS_(B_) * 2 + kcb_[j_]), kb_, lds0 + NS * SHM_V + (sl_) * C::SHM_K + (j_ * 8 + wid) * 1024); \
        _Pragma("unroll") for (int j_ = 0; j_ < 2; ++j_) A_GLDS((unsigned)(vrow_[j_] * VS_(B_) * 2 + vcb_[j_]), vb_, lds0 + (sl_) * SHM_V + (j_ * 8 + wid) * 1024); } while (0)
template <int DQK, bool DIL, int NS>
__device__ __forceinline__ void att_prime_dma(const Blk& cur, const char* wsb, char* lds, SeamD<DQK>& S, int tid_in) {
    typedef Cfg<DQK> C;
    int tid = tid_in; asm volatile("" : "+v"(tid));
    const int wid = __builtin_amdgcn_readfirstlane(tid >> 6), lane = tid & 63, r32 = lane & 31, hi = lane >> 5;
    const unsigned lds0 = (unsigned)(uintptr_t)lds;
    A_DMA_IDX();
    const int kb0 = swa_jlo(cur.P0, W_(cur)) * KVBLK;
    A_QLOAD(cur);
#pragma unroll
    for (int i_ = 0; i_ < NS - 1; ++i_) A_DMA(cur, kb0 + i_ * KVBLK, i_);
}
template <int DQK, bool DIL, bool SK, int NS>
__device__ __forceinline__ void att_block_dma(const Blk& cur, const Blk& nxt, const char* wsb, char* lds, char* wsl, SeamD<DQK>& S, int tid_in) {
    typedef Cfg<DQK> C;
    int tid = tid_in; asm volatile("" : "+v"(tid));
    const int wid = __builtin_amdgcn_readfirstlane(tid >> 6), lane = tid & 63, r32 = lane & 31, hi = lane >> 5;
    const int W = W_(cur); const float scale = SCALE_, beta = cur.beta;
    const int j_lo = swa_jlo(cur.P0, W);
    int j_hi = (cur.P0 + QB - 1) / KVBLK + 1; if (j_hi > SKV_(cur) / KVBLK) j_hi = SKV_(cur) / KVBLK;
    const int NT = j_hi - j_lo;
    const int kbn = swa_jlo(nxt.P0, W_(nxt)) * KVBLK;
    const int qlo = cur.P0 + wid * QBLK, qm = qlo + r32 - 4 * hi;
    const unsigned lds0 = (unsigned)(uintptr_t)lds;
    const char* K_lds = lds + NS * SHM_V;
    float* ws = (float*)wsl + wid * 64; float* li_l = ws, * al_l = ws + 32;
    float m_reg = -1e30f, l_reg = 0; f32x16 o[4] = {};
    A_DMA_IDX();
    const int vb0 = (int)lds0 + v_rd_base(lane);
    constexpr int NDMA = C::KCH + 2;
#define RESC(a) do { if (__any((a) < 1.f)) { if (hi == 0) al_l[r32] = (a); asm volatile("s_waitcnt lgkmcnt(0)" ::: "memory");              \
                     _Pragma("unroll") for (int d_ = 0; d_ < 4; ++d_) _Pragma("unroll") for (int r = 0; r < 16; ++r) o[d_][r] *= al_l[crow(r, hi)]; } } while (0)
#define KBASE(t) ((j_lo + (t)) * KVBLK)
#define ACT(t) (KBASE(t) <= qlo + QBLK - 1 && KBASE(t) + KVBLK - 1 >= qlo - W + 1)
#define MASKT(P0_, P1_, t) do { const int kb_ = KBASE(t); if ((!SK || ACT(t)) && (kb_ + KVBLK - 1 > qlo || kb_ <= qlo + QBLK - 1 - W)) mask_tile(P0_, P1_, qm - kb_, (unsigned)W); } while (0)
    VMW();
#pragma unroll
    for (int d0 = 0; d0 < C::NQF; ++d0) asm volatile("" : "+v"(S.qr[d0]));
    asm volatile("s_waitcnt lgkmcnt(0)" ::: "memory"); __builtin_amdgcn_s_barrier(); asm volatile("" ::: "memory");
    int sl = 0, sl2 = NS - 1;
#pragma unroll 1
    for (int t = 0; t < NT; ++t) {
        const bool pre = t + NS - 1 < NT;
        if (pre) A_DMA(cur, KBASE(t + NS - 1), sl2);
        SBAR(); f32x16 p0, p1; float mn_, al_; bf16x8 pa0, pa1, pa2, pa3;
        qkt<0, SK, DQK, DIL>(p0, p1, K_lds + sl * C::SHM_K, r32, hi, S.qr, ACT(t), beta, qm - KBASE(t)); SBAR();
        MASKT(p0, p1, t); partialSM(p0, p1, m_reg, mn_, al_, scale); finishSM(p0, p1, al_, l_reg, pa0, pa1, pa2, pa3); RESC(al_); SBAR();
        pv_tile<0, SK>(o, vb0 + sl * SHM_V, pa0, pa1, pa2, pa3, ACT(t));
        if (t + 1 < NT) { int infl = NT - 2 - t; if (infl > NS - 2) infl = NS - 2;
                          if (infl <= 0) VMW(); else if (infl == 1) VMWN(NDMA); else VMWN(2 * NDMA);
                          asm volatile("s_waitcnt lgkmcnt(0)" ::: "memory"); __builtin_amdgcn_s_barrier(); asm volatile("" ::: "memory"); }
        sl = sl == NS - 1 ? 0 : sl + 1; sl2 = sl2 == NS - 1 ? 0 : sl2 + 1;
    }
    asm volatile("s_waitcnt lgkmcnt(0)" ::: "memory"); __builtin_amdgcn_s_barrier(); asm volatile("" ::: "memory");
    A_QLOAD(nxt);
#pragma unroll
    for (int i_ = 0; i_ < NS - 1; ++i_) A_DMA(nxt, kbn + i_ * KVBLK, i_);
    if (hi == 0) li_l[r32] = l_reg; asm volatile("s_waitcnt lgkmcnt(0)" ::: "memory");
    if constexpr (DIL) { if (hi == 0) __builtin_amdgcn_raw_buffer_store_b32(__float_as_uint(m_reg * scale + __logf(l_reg)), A_RSRC(wsb + cur.lo), r32 * LS_(cur) * 4, (cur.P0 + wid * QBLK) * LS_(cur) * 4, 0); }
    float rli[16];
#pragma unroll
    for (int r = 0; r < 16; ++r) rli[r] = __builtin_amdgcn_rcpf(li_l[crow(r, hi)]);
    const __amdgpu_buffer_rsrc_t ro_ = A_RSRC(wsb + cur.oo); const int oo_ = (4 * hi * OS_(cur) + r32) * 2, so0_ = (cur.P0 + wid * QBLK) * OS_(cur) * 2;
#pragma unroll
    for (int r = 0; r < 16; ++r) { const int sor_ = so0_ + ((r & 3) + 8 * (r >> 2)) * OS_(cur) * 2;
#pragma unroll
        for (int d0 = 0; d0 < 4; ++d0) { const float v = o[d0][r] * rli[r];
            const float vn = __int_as_float(__builtin_amdgcn_update_dpp(0, __float_as_int(v), 0xB1, 0xF, 0xF, true));
            if ((r32 & 1) == 0) __builtin_amdgcn_raw_buffer_store_b32(cvtpk(v, vn), ro_, oo_ + d0 * 64, sor_, 0); } }
#undef RESC
#undef KBASE
#undef ACT
#undef MASKT
}

template <bool SK, int DQK, bool DIL>
__device__ __forceinline__ void qkt_fin(f32x16& p0, f32x16& p1, const char* K_lds, int r32, int hi, const bf16x8* qr, bool act, float beta, int dq,
                                        f32x16& y0, f32x16& y1, float alpha, float& l_reg, bf16x8& pa0, bf16x8& pa1, bf16x8& pa2, bf16x8& pa3) {
    typedef Cfg<DQK> C;
    const bool run = !(SK && !act);
    if (!run) { const float NEG = -__builtin_inff();
#pragma unroll
        for (int r = 0; r < 16; ++r) { p0[r] = NEG; p1[r] = NEG; } }
    else if constexpr (DIL) { const float b0 = -beta * (float)dq;
#pragma unroll
        for (int r = 0; r < 16; ++r) { const int c = (r & 3) + 8 * (r >> 2); p0[r] = fmaf(beta, (float)c, b0); p1[r] = fmaf(beta, (float)(c + 32), b0); } }
    else { p0 = f32x16{}; p1 = f32x16{}; }
    const char* kb[4];
#pragma unroll
    for (int dd = 0; dd < 4; ++dd) { const int colB = (dd * 16 + hi * 8) * 2; kb[dd] = K_lds + r32 * C::KPITCH + (colB ^ ((r32 & 7) << 4)); }
#define QK_CHUNK(c_) do { if (run) { _Pragma("unroll") for (int d0 = 4 * (c_); d0 < 4 * (c_) + 4 && d0 < C::NQF; ++d0) { const char* a = kb[d0 & 3] + (d0 >> 2) * 128; \
            bf16x8 b0 = *reinterpret_cast<const bf16x8*>(a); bf16x8 b1 = *reinterpret_cast<const bf16x8*>(a + 32 * C::KPITCH);                                  \
            p0 = __builtin_amdgcn_mfma_f32_32x32x16_bf16(b0, qr[d0], p0, 0, 0, 0); p1 = __builtin_amdgcn_mfma_f32_32x32x16_bf16(b1, qr[d0], p1, 0, 0, 0); } } } while (0)
#define PK4(P, B_, OUT) do { unsigned a0 = cvtpk(P[B_+0], P[B_+1]), a1 = cvtpk(P[B_+2], P[B_+3]);                          \
        unsigned b0 = cvtpk(P[B_+4], P[B_+5]), b1 = cvtpk(P[B_+6], P[B_+7]);                                             \
        auto r0 = __builtin_amdgcn_permlane32_swap(a0, b0, false, false); auto r1 = __builtin_amdgcn_permlane32_swap(a1, b1, false, false); \
        u32x4 w = {r0[0], r1[0], r0[1], r1[1]}; OUT = *reinterpret_cast<bf16x8*>(&w); } while (0)
    QK_CHUNK(0);
#pragma unroll
    for (int r = 0; r < 16; ++r) y1[r] = __builtin_amdgcn_exp2f(y1[r]);
    float ps = 0;
#pragma unroll
    for (int r = 0; r < 16; ++r) ps += y0[r];
#pragma unroll
    for (int r = 0; r < 16; ++r) ps += y1[r];
    SBAR();
    QK_CHUNK(1);
    { auto rr = __builtin_amdgcn_permlane32_swap(__float_as_uint(ps), __float_as_uint(ps), false, false);
      ps = __uint_as_float(rr[0]) + __uint_as_float(rr[1]); }
    l_reg = l_reg * alpha + ps;
    PK4(y0, 0, pa0); PK4(y0, 8, pa1);
    if constexpr (C::NQF > 8) { SBAR(); QK_CHUNK(2); }
    PK4(y1, 0, pa2); PK4(y1, 8, pa3);
#undef PK4
#undef QK_CHUNK
}
#ifndef ATT_SKEW_SEL
#define ATT_SKEW_SEL 0
#endif
#if ATT_SKEW_SEL == 0
#define ATT_SKEW_A (wid < 4)
#elif ATT_SKEW_SEL == 1
#define ATT_SKEW_A ((wid & 1) == 0)
#elif ATT_SKEW_SEL == 2
#define ATT_SKEW_A true
#else
#define ATT_SKEW_A false
#endif
#define A_DMA_K(B_, k0, sl_) do { const char* kb_ = wsb + (B_).ko + (size_t)(k0) * (size_t)(KS_(B_) * 2); int ln_ = lane; asm volatile("" : "+v"(ln_)); \
        _Pragma("unroll") for (int j_ = 0; j_ < C::KCH; ++j_) { const int p_ = (j_ * 8 + wid) * 1024 + ln_ * 16, row_ = p_ / C::KPITCH, pc_ = (p_ % C::KPITCH) / 16, lc_ = (pc_ & ~7) | ((pc_ & 7) ^ (row_ & 7)); \
            A_GLDS((unsigned)(row_ * KS_(B_) * 2 + lc_ * 16), kb_, lds0 + 3 * SHM_V + (sl_) * C::SHM_K + (j_ * 8 + wid) * 1024); } } while (0)
#define A_DMA_V(B_, k0, sl_) do { const char* vb_ = wsb + (B_).vo + (size_t)(k0) * (size_t)(VS_(B_) * 2); int ln_ = lane; asm volatile("" : "+v"(ln_)); \
        _Pragma("unroll") for (int j_ = 0; j_ < 2; ++j_) { const int p_ = (j_ * 8 + wid) * 1024 + ln_ * 16, s_ = p_ / 512, w_ = p_ % 512, kk_ = (s_ >> 2) * 8 + (w_ >> 6), col_ = (s_ & 3) * 32 + ((w_ & 63) >> 1); \
            const int vr_ = (kk_ & ~0xC) | ((kk_ & 4) << 1) | ((kk_ & 8) >> 1); \
            A_GLDS((unsigned)(vr_ * VS_(B_) * 2 + col_ * 2), vb_, lds0 + (sl_) * SHM_V + (j_ * 8 + wid) * 1024); } } while (0)
#define A_RAWBAR() do { asm volatile("s_waitcnt lgkmcnt(0)" ::: "memory"); __builtin_amdgcn_s_barrier(); asm volatile("" ::: "memory"); } while (0)
template <int DQK, bool DIL>
__device__ __forceinline__ void att_prime_dma2(const Blk& cur, const char* wsb, char* lds, SeamD<DQK>& S, int tid_in) {
    typedef Cfg<DQK> C; constexpr int NS = 3;
    int tid = tid_in; asm volatile("" : "+v"(tid));
    const int wid = __builtin_amdgcn_readfirstlane(tid >> 6), lane = tid & 63, r32 = lane & 31, hi = lane >> 5;
    const unsigned lds0 = (unsigned)(uintptr_t)lds;
    const int kb0 = swa_jlo(cur.P0, W_(cur)) * KVBLK;
    A_QLOAD(cur);
    A_DMA_K(cur, kb0, 0); A_DMA_V(cur, kb0, 0); A_DMA_K(cur, kb0 + KVBLK, 1);
}
template <int DQK, bool DIL, bool SK, int ORD>
__device__ __forceinline__ void att_block_dma2(const Blk& cur, const Blk& nxt, const char* wsb, char* lds, SeamD<DQK>& S, int tid_in) {
    typedef Cfg<DQK> C; constexpr int NS = 3;
    int tid = tid_in; asm volatile("" : "+v"(tid));
    const int wid = __builtin_amdgcn_readfirstlane(tid >> 6), lane = tid & 63, r32 = lane & 31, hi = lane >> 5;
    const int W = W_(cur); const float scale = SCALE_, beta = cur.beta;
    const int j_lo = swa_jlo(cur.P0, W);
    int j_hi = (cur.P0 + QB - 1) / KVBLK + 1; if (j_hi > SKV_(cur) / KVBLK) j_hi = SKV_(cur) / KVBLK;
    const int NT = j_hi - j_lo;
    const int kbn = swa_jlo(nxt.P0, W_(nxt)) * KVBLK;
    const int qlo = cur.P0 + wid * QBLK, qm = qlo + r32 - 4 * hi;
    const unsigned lds0 = (unsigned)(uintptr_t)lds;
    const char* K_lds = lds + 3 * SHM_V;
    float* ws = (float*)(lds + 3 * SHM_V + 3 * C::SHM_K) + wid * 64; float* li_l = ws, * al_l = ws + 32;
    float m_reg = -1e30f, l_reg = 0; f32x16 o[4] = {};
    const int vb0 = (int)lds0 + v_rd_base(lane);
#define RESC(a) do { if (__any((a) < 1.f)) { if (hi == 0) al_l[r32] = (a); asm volatile("s_waitcnt lgkmcnt(0)" ::: "memory");              \
                     _Pragma("unroll") for (int d_ = 0; d_ < 4; ++d_) _Pragma("unroll") for (int r = 0; r < 16; ++r) o[d_][r] *= al_l[crow(r, hi)]; } } while (0)
#define KBASE(t) ((j_lo + (t)) * KVBLK)
#define ACT(t) (KBASE(t) <= qlo + QBLK - 1 && KBASE(t) + KVBLK - 1 >= qlo - W + 1)
#define MASKT(P0_, P1_, t) do { const int kb_ = KBASE(t); if ((!SK || ACT(t)) && (kb_ + KVBLK - 1 > qlo || kb_ <= qlo + QBLK - 1 - W)) mask_tile(P0_, P1_, qm - kb_, (unsigned)W); } while (0)
#define ISSUE(t, n_) do { n_ = 0; if ((t) + 2 < NT) { int slotk_ = sl + 2; if (slotk_ >= 3) slotk_ -= 3; A_DMA_K(cur, KBASE((t) + 2), slotk_); n_ += C::KCH; } \
                          if ((t) + 1 < NT) { int slotv_ = sl + 1; if (slotv_ >= 3) slotv_ -= 3; A_DMA_V(cur, KBASE((t) + 1), slotv_); n_ += 2; } } while (0)
#define CLOSE(n_) do { if ((n_) == C::KCH + 2) VMWN(C::KCH + 2); else if ((n_) == 2) VMWN(2); else VMW(); A_RAWBAR(); } while (0)
    VMW();
#pragma unroll
    for (int d0 = 0; d0 < C::NQF; ++d0) asm volatile("" : "+v"(S.qr[d0]));
    A_RAWBAR();
    int sl = 0, slp = 2, nis;
    f32x16 pA0, pA1, pB0, pB1; float mnA, mnB, alA, alB; bf16x8 pa0, pa1, pa2, pa3;
    ISSUE(0, nis); SBAR();
    qkt<0, SK, DQK, DIL>(pA0, pA1, K_lds + sl * C::SHM_K, r32, hi, S.qr, ACT(0), beta, qm - KBASE(0)); SBAR();
    MASKT(pA0, pA1, 0); partialSM(pA0, pA1, m_reg, mnA, alA, scale);
    CLOSE(nis); slp = sl; sl = sl == 2 ? 0 : sl + 1;
#define STEPP(PX0, PX1, mnX, alX, PY0, PY1, alY, t) do { ISSUE(t, nis); SBAR();                                               \
        if constexpr (ORD == 0) {                                                                                               \
            qkt<0, SK, DQK, DIL>(PX0, PX1, K_lds + sl * C::SHM_K, r32, hi, S.qr, ACT(t), beta, qm - KBASE(t)); SBAR();           \
            finishSM(PY0, PY1, alY, l_reg, pa0, pa1, pa2, pa3); SBAR();                                                         \
            pv_tile<0, SK>(o, vb0 + slp * SHM_V, pa0, pa1, pa2, pa3, ACT((t) - 1)); SBAR();                                     \
        } else {                                                                                                                \
            finishSM(PY0, PY1, alY, l_reg, pa0, pa1, pa2, pa3); SBAR();                                                         \
            pv_tile<0, SK>(o, vb0 + slp * SHM_V, pa0, pa1, pa2, pa3, ACT((t) - 1)); SBAR();                                     \
            qkt<0, SK, DQK, DIL>(PX0, PX1, K_lds + sl * C::SHM_K, r32, hi, S.qr, ACT(t), beta, qm - KBASE(t)); SBAR();           \
        }                                                                                                                       \
        MASKT(PX0, PX1, (t)); partialSM(PX0, PX1, m_reg, mnX, alX, scale);                                                     \
        RESC(alX); CLOSE(nis); slp = sl; sl = sl == 2 ? 0 : sl + 1; } while (0)
    int t = 1;
#pragma unroll 1
    for (; t + 2 < NT; t += 2) {
        STEPP(pB0, pB1, mnB, alB, pA0, pA1, alA, t);
        STEPP(pA0, pA1, mnA, alA, pB0, pB1, alB, t + 1);
    }
    STEPP(pB0, pB1, mnB, alB, pA0, pA1, alA, t);
    finishSM(pB0, pB1, alB, l_reg, pa0, pa1, pa2, pa3); SBAR();
    pv_tile<0, SK>(o, vb0 + slp * SHM_V, pa0, pa1, pa2, pa3, ACT(NT - 1));
    A_RAWBAR();
    A_QLOAD(nxt);
    A_DMA_K(nxt, kbn, 0); A_DMA_V(nxt, kbn, 0); A_DMA_K(nxt, kbn + KVBLK, 1);
    if (hi == 0) li_l[r32] = l_reg; asm volatile("s_waitcnt lgkmcnt(0)" ::: "memory");
    if constexpr (DIL) { if (hi == 0) __builtin_amdgcn_raw_buffer_store_b32(__float_as_uint(m_reg * scale + __logf(l_reg)), A_RSRC(wsb + cur.lo), r32 * LS_(cur) * 4, (cur.P0 + wid * QBLK) * LS_(cur) * 4, 0); }
    float rli[16];
#pragma unroll
    for (int r = 0; r < 16; ++r) rli[r] = __builtin_amdgcn_rcpf(li_l[crow(r, hi)]);
    const __amdgpu_buffer_rsrc_t ro_ = A_RSRC(wsb + cur.oo); const int oo_ = (4 * hi * OS_(cur) + r32) * 2, so0_ = (cur.P0 + wid * QBLK) * OS_(cur) * 2;
#pragma unroll
    for (int r = 0; r < 16; ++r) { const int sor_ = so0_ + ((r & 3) + 8 * (r >> 2)) * OS_(cur) * 2;
#pragma unroll
        for (int d0 = 0; d0 < 4; ++d0) { const float v = o[d0][r] * rli[r];
            const float vn = __int_as_float(__builtin_amdgcn_update_dpp(0, __float_as_int(v), 0xB1, 0xF, 0xF, true));
            if ((r32 & 1) == 0) __builtin_amdgcn_raw_buffer_store_b32(cvtpk(v, vn), ro_, oo_ + d0 * 64, sor_, 0); } }
#undef RESC
#undef KBASE
#undef ACT
#undef MASKT
#undef ISSUE
#undef CLOSE
#undef STEPP
}
#undef A_DMA_K
#undef A_DMA_V
#undef A_RAWBAR
#undef A_GLDS
#undef A_DMA_IDX
#undef A_DMA
#undef VMW
#undef VMWN
#undef A_SLOAD
#undef A_RSRC
#undef A_BLD
#undef A_QLOAD
#undef A_SWRITE_K
#undef A_SWRITE_V
#undef A_STAGE_IDX
#undef SBAR
#undef QS_
#undef KS_
#undef VS_
#undef OS_
#undef LS_
#undef SKV_
#undef W_
#undef SCALE_
}
constexpr int NWAVES = 8;
constexpr int T = 32768, DM = 2048, SEQ = 8192, NB = 4, DEPTH = 2;
constexpr int IN_COLS = 3904, PROJ_LD = 4096, NEXP = 16, DEXP = 1024;
constexpr int C_QB = 0, C_KB = 1024, C_VB = 2048, C_CQ = 3072, C_CKV = 3584, C_KR = 3840;
constexpr float EPS = 1e-6f;
constexpr size_t MiB = 1u << 20;
constexpr size_t WS_CTL = 0, CTL_ZERO_BYTES = 1 * MiB;
constexpr size_t WS_MOD = 1 * MiB;
constexpr size_t WS_ROPE = 2 * MiB;
constexpr size_t WS_RSTDQ = 4 * MiB, WS_RSTDKV = 4 * MiB + 256 * 1024, WS_AW = 4 * MiB + 512 * 1024;
constexpr size_t WS_ROWIDX = 5 * MiB;
constexpr size_t WS_LSE = 8 * MiB;
constexpr size_t WS_WIN = 16 * MiB;
constexpr size_t WS_WUQ = 48 * MiB;
constexpr size_t WS_WUKV = 51 * MiB;
constexpr size_t WS_WOUT = 53 * MiB;
constexpr size_t WS_W13 = 72 * MiB;
constexpr size_t WS_W2 = 200 * MiB;
constexpr size_t WS_H = 264 * MiB;
constexpr size_t WS_PROJ = 392 * MiB;
constexpr size_t WS_QA = 648 * MiB;
constexpr size_t WS_KF = 744 * MiB;
constexpr size_t WS_VB = 840 * MiB;
constexpr size_t WS_OA = 904 * MiB;
constexpr size_t WS_OB = 968 * MiB;
constexpr size_t WS_XB = 1160 * MiB;
constexpr size_t WS_END = 1288 * MiB;
constexpr size_t WS_HMID = WS_PROJ;
constexpr size_t WS_Y = WS_QA;
constexpr int CW_TMO = 0;
constexpr int CW_CNT = 64;
constexpr int CW_BAR = 4096;
constexpr int RING_BYTES = 131072;
constexpr int L_MISC = RING_BYTES, L_TS = RING_BYTES + 256, L_CNT = RING_BYTES + 384, L_TOK = RING_BYTES + 512, L_ATAB = RING_BYTES + 2560;
constexpr int MAXU = 10;
constexpr int LDS_BYTES = 147456;
static_assert(L_ATAB + MAXU * 1024 <= LDS_BYTES, "LDS map");

#define GAS __attribute__((address_space(1)))
#define LAS __attribute__((address_space(3)))
typedef unsigned short bf16;
typedef unsigned v4u __attribute__((ext_vector_type(4)));
typedef unsigned v2u __attribute__((ext_vector_type(2)));
typedef float f32x4 __attribute__((ext_vector_type(4)));
typedef float f32x2 __attribute__((ext_vector_type(2)));
#define LDS_WAIT() asm volatile("s_waitcnt lgkmcnt(0)" ::: "memory")
#define VM_WAIT() asm volatile("s_waitcnt vmcnt(0)" ::: "memory")
__device__ __forceinline__ unsigned pk2(float lo, float hi) { return pg8::cvt_pk_bf16(lo, hi); }
__device__ __forceinline__ float bf_lo(unsigned w) { return __uint_as_float(w << 16); }
__device__ __forceinline__ float bf_hi(unsigned w) { return __uint_as_float(w & 0xffff0000u); }


typedef __amdgpu_buffer_rsrc_t rsrc_t;
#define RSRC(p) __builtin_amdgcn_make_buffer_rsrc((void*)(p), 0, 0x7fffffff, 0x00020000)
__device__ __forceinline__ f32x4 bld4f(rsrc_t r, int vo, int so) { return __builtin_bit_cast(f32x4, __builtin_amdgcn_raw_buffer_load_b128(r, vo, so, 0)); }
__device__ __forceinline__ v4u bld4u(rsrc_t r, int vo, int so) { return __builtin_bit_cast(v4u, __builtin_amdgcn_raw_buffer_load_b128(r, vo, so, 0)); }
__device__ __forceinline__ v2u bld2u(rsrc_t r, int vo, int so) { return __builtin_bit_cast(v2u, __builtin_amdgcn_raw_buffer_load_b64(r, vo, so, 0)); }
__device__ __forceinline__ void bst2u(rsrc_t r, int vo, int so, v2u v) { __builtin_amdgcn_raw_buffer_store_b64(v, r, vo, so, 0); }
__device__ __forceinline__ void bst4u(rsrc_t r, int vo, int so, v4u v) { __builtin_amdgcn_raw_buffer_store_b128(v, r, vo, so, 0); }
__device__ __forceinline__ void bst4f(rsrc_t r, int vo, int so, f32x4 v) { __builtin_amdgcn_raw_buffer_store_b128(__builtin_bit_cast(v4u, v), r, vo, so, 0); }

#define XB_TMO      128
#define XB_XCNT(j)  (256  + 64 * (j))
#define XB_XSUB(j)  (1280 + 64 * (j))
#define XB_XGEN(j)  (2304 + 64 * (j))
#define XB_TOP      3328
#define XB_TOPGEN   3392
#define XCD_BAR_WORDS 3456
#define XB_SPIN_CAP (1u << 18)
__device__ __forceinline__ unsigned xb_ld(unsigned* p)              { return __hip_atomic_load(p, __ATOMIC_RELAXED, __HIP_MEMORY_SCOPE_AGENT); }
__device__ __forceinline__ unsigned xb_add(unsigned* p, unsigned v) { return __hip_atomic_fetch_add(p, v, __ATOMIC_RELAXED, __HIP_MEMORY_SCOPE_AGENT); }
__device__ __forceinline__ unsigned xb_xcc_id() { return (unsigned)__builtin_amdgcn_s_getreg((3 << 11) | 20) & 0xFu; }
#define XB_SPIN(cond, bar) do { unsigned _sp = 0; while (cond) { __builtin_amdgcn_s_sleep(1); \
    if ((++_sp & 255u) == 0u) { if (xb_ld(&(bar)[XB_TMO])) break; if (_sp > XB_SPIN_CAP) { atomicAdd(&(bar)[XB_TMO], 1u); break; } } } } while (0)
struct XcdBarrier { unsigned* bar; unsigned x; volatile LAS unsigned* st; };
__device__ __forceinline__ XcdBarrier xcd_barrier_post(unsigned* bar, volatile LAS unsigned* st, int tid) {
    XcdBarrier b; b.bar = bar; b.x = xb_xcc_id(); b.st = st;
    if (tid == 0) (void)xb_add(&bar[XB_XCNT(b.x)], 1u);
    return b;
}
__device__ __forceinline__ void xcd_barrier_complete(unsigned* bar, unsigned x, unsigned& nloc, unsigned& nx) {
    const unsigned G = gridDim.x * gridDim.y * gridDim.z;
    unsigned sum, cnt, mine, sp = 0u;
    for (;;) {
        sum = 0u; cnt = 0u; mine = 0u;
#pragma unroll
        for (unsigned j = 0; j < 16; ++j) { const unsigned c = xb_ld(&bar[XB_XCNT(j)]); sum += c; cnt += (c > 0u) ? 1u : 0u; mine = (j == x) ? c : mine; }
        if (sum == G) break;
        __builtin_amdgcn_s_sleep(1);
        if ((++sp & 255u) == 0u) { if (xb_ld(&bar[XB_TMO])) break; if (sp > XB_SPIN_CAP) { atomicAdd(&bar[XB_TMO], 1u); break; } }
    }
    nloc = mine > 0u ? mine : 1u; nx = cnt > 0u ? cnt : 1u;
}
__device__ __forceinline__ void xcd_barrier(const XcdBarrier& b, int tid) {
    asm volatile("s_waitcnt vmcnt(0)" ::: "memory");
    __syncthreads();
    if (tid == 0) {
        unsigned* bar = b.bar; asm volatile("" : "+s"(bar));
        __builtin_amdgcn_s_waitcnt(0);
        unsigned nloc = b.st[0], nx = b.st[1];
        if (nloc == 0u) { xcd_barrier_complete(bar, b.x, nloc, nx); b.st[0] = nloc; b.st[1] = nx; }
        const unsigned old = xb_add(&bar[XB_XSUB(b.x)], 1u);
        const unsigned gen = old / nloc;
        if (old + 1u == (gen + 1u) * nloc) {
            __builtin_amdgcn_fence(__ATOMIC_RELEASE, "agent");
            asm volatile("s_waitcnt vmcnt(0)" ::: "memory");
            const unsigned og = xb_add(&bar[XB_TOP], 1u);
            const unsigned tg = og / nx;
            if (og + 1u == (tg + 1u) * nx) xb_add(&bar[XB_TOPGEN], 1u);
            else XB_SPIN(xb_ld(&bar[XB_TOPGEN]) == tg, bar);
            __builtin_amdgcn_fence(__ATOMIC_ACQUIRE, "agent");
            xb_add(&bar[XB_XGEN(b.x)], 1u);
            asm volatile("s_waitcnt vmcnt(0)" ::: "memory");
        } else {
            XB_SPIN(xb_ld(&bar[XB_XGEN(b.x)]) == gen, bar);
            __builtin_amdgcn_fence(__ATOMIC_ACQUIRE, "agent");
            asm volatile("s_waitcnt vmcnt(0)" ::: "memory");
        }
    }
    __syncthreads();
}

struct Args {
    const float* in[20]; float* out; unsigned char* ws;
    float invf[32];
    int ph_lo, ph_hi, li, pad;
};
enum { I_X = 0, I_C, I_ADAW, I_ADAB, I_N1G, I_N2G, I_WIN, I_QNG, I_KVNG, I_WUQ, I_WUKV, I_ONA, I_ONB, I_WOUT, I_RW, I_RB, I_EG, I_EU, I_ED, I_FG };

struct Frame {
    LAS unsigned char* lds; unsigned char* ldsg;
    unsigned* ctl; unsigned char* ws;
    int tid, lane, wave, vcu, G;
};
__device__ __forceinline__ int lane_id() { int l; asm volatile("v_mbcnt_lo_u32_b32 %0, -1, 0\n\tv_mbcnt_hi_u32_b32 %0, -1, %0" : "=v"(l)); return l; }
#define DPP_ADD(v, ctrl) v += __int_as_float(__builtin_amdgcn_update_dpp(0, __float_as_int(v), ctrl, 0xF, 0xF, true))
__device__ __forceinline__ float wave_sum(float v) {
    DPP_ADD(v, 0xB1); DPP_ADD(v, 0x4E); DPP_ADD(v, 0x141); DPP_ADD(v, 0x140);
    v += __int_as_float(__builtin_amdgcn_ds_swizzle(__float_as_int(v), 0x401F));
    auto rr = __builtin_amdgcn_permlane32_swap(__float_as_uint(v), __float_as_uint(v), false, false);
    return __uint_as_float(rr[0]) + __uint_as_float(rr[1]);
}
__device__ __forceinline__ int il64(int j) { return j < 32 ? 2 * j : 2 * (j - 32) + 1; }
template <int MODE> __device__ __forceinline__ int dest_row(int n) {
    if constexpr (MODE == 0) return n;
    else if constexpr (MODE == 1) {
        if (n < 512) return C_CQ + n; if (n < 768) return C_CKV + (n - 512); if (n < 832) return C_KR + il64(n - 768);
        if (n < 1856) return C_QB + (n - 832); if (n < 2880) return C_KB + (n - 1856); return C_VB + (n - 2880); }
    else if constexpr (MODE == 2) { const int h = n / 192, j = n % 192; return j < 128 ? n : h * 192 + 128 + il64(j - 128); }
    else if constexpr (MODE == 3) return (n >> 7) * 256 + (n & 127);
    else return (n >> 7) * 256 + 128 + (n & 127);
}
template <int MODE>
__device__ __forceinline__ void transpose_item(const float* W, int ldw, int K, int N, bf16* WT, const float* kscale, LAS float* scr, int item, int lane) {
    const int nblk = N / 32, kb = item / nblk, nb = item % nblk, k0 = 64 * kb, n0 = 32 * nb;
    float tv[32];
#pragma unroll
    for (int i = 0; i < 32; ++i) { const int kk = 2 * i + (lane >> 5); tv[i] = W[(size_t)(k0 + kk) * ldw + n0 + (lane & 31)]; }
#pragma unroll
    for (int i = 0; i < 32; ++i) { const int kk = 2 * i + (lane >> 5); float v = tv[i]; if (kscale) v *= kscale[k0 + kk]; scr[kk * 33 + (lane & 31)] = v; }
    LDS_WAIT(); asm volatile("" ::: "memory");
    const int c = lane & 7;
#pragma unroll
    for (int j = 0; j < 4; ++j) { const int n = (lane >> 3) + 8 * j; const LAS float* s = scr + (8 * c) * 33 + n;
        v4u o; o.x = pk2(s[0 * 33], s[1 * 33]); o.y = pk2(s[2 * 33], s[3 * 33]); o.z = pk2(s[4 * 33], s[5 * 33]); o.w = pk2(s[6 * 33], s[7 * 33]);
        *(v4u*)(WT + (size_t)dest_row<MODE>(n0 + n) * K + k0 + 8 * c) = o; }
    LDS_WAIT(); asm volatile("s_waitcnt vmcnt(0)" ::: "memory");
}

__device__ __forceinline__ unsigned pk4_fp8(float a, float b, float c, float d) { int w = 0; w = __builtin_amdgcn_cvt_pk_fp8_f32(a, b, w, false); w = __builtin_amdgcn_cvt_pk_fp8_f32(c, d, w, true); return (unsigned)w; }
template <int MODE>
__device__ __forceinline__ void transpose_item8(const float* W, int ldw, int K, int N, unsigned char* WT, LAS float* scr, int item, int lane) {
    const int nblk = N / 32, kb = item / nblk, nb = item % nblk, k0 = 64 * kb, n0 = 32 * nb;
    float tv[32];
#pragma unroll
    for (int i = 0; i < 32; ++i) { const int kk = 2 * i + (lane >> 5); tv[i] = W[(size_t)(k0 + kk) * ldw + n0 + (lane & 31)]; }
#pragma unroll
    for (int i = 0; i < 32; ++i) { const int kk = 2 * i + (lane >> 5); scr[kk * 33 + (lane & 31)] = tv[i] * 256.0f; }
    LDS_WAIT(); asm volatile("" ::: "memory");
    const int c = lane & 7;
#pragma unroll
    for (int j = 0; j < 4; ++j) { const int n = (lane >> 3) + 8 * j; const LAS float* s = scr + (8 * c) * 33 + n;
        v2u o; o.x = pk4_fp8(s[0 * 33], s[1 * 33], s[2 * 33], s[3 * 33]); o.y = pk4_fp8(s[4 * 33], s[5 * 33], s[6 * 33], s[7 * 33]);
        *(v2u*)(WT + (size_t)dest_row<MODE>(n0 + n) * K + k0 + 8 * c) = o; }
    LDS_WAIT(); asm volatile("s_waitcnt vmcnt(0)" ::: "memory");
}

__device__ __forceinline__ void phase_prologue(Frame& F, const Args& A) {
    {
        const float* cc = A.in[I_C]; float* mod = (float*)(F.ws + WS_MOD);
        LAS float* red = (LAS float*)F.lds;
        for (int id = F.vcu; id < 2 * 96; id += F.G) {
            const int l = id / 96, ch = id % 96, cg = F.tid & 31, kg = F.tid >> 5, col = ch * 128 + cg * 4;
            const float* w = A.in[I_ADAW] + (size_t)l * DM * 12288 + col;
            f32x4 acc[4] = {};
#pragma unroll 4
            for (int kk = 0; kk < 128; ++kk) { const int k = kg * 128 + kk; const f32x4 wv = *(const f32x4*)(w + (size_t)k * 12288);
#pragma unroll
                for (int b = 0; b < 4; ++b) { const float cv = cc[b * DM + k]; const float ca = cv / (1.0f + __expf(-cv)); acc[b] += wv * ca; } }
#pragma unroll
            for (int b = 0; b < 4; ++b) *(LAS f32x4*)(red + ((kg * 32 + cg) * 16 + b * 4)) = acc[b];
            __syncthreads();
            if (F.tid < 128) { const int cg2 = F.tid & 31, b = F.tid >> 5; f32x4 s = {0.f, 0.f, 0.f, 0.f};
#pragma unroll
                for (int g = 0; g < 16; ++g) s += *(LAS f32x4*)(red + ((g * 32 + cg2) * 16 + b * 4));
                const int c2 = ch * 128 + cg2 * 4; const f32x4 bv = *(const f32x4*)(A.in[I_ADAB] + (size_t)l * 12288 + c2);
                *(f32x4*)(mod + ((size_t)l * 4 + b) * 12288 + c2) = s + bv; }
            asm volatile("s_waitcnt vmcnt(0)" ::: "memory");
            __syncthreads();
        }
    }
    {
        LAS float* scr = (LAS float*)(F.lds + F.wave * 16384);
        const int gw = F.vcu * NWAVES + F.wave, NGW = F.G * NWAVES;
        constexpr int I_IN = (DM / 64) * (IN_COLS / 32), I_UQ = (512 / 64) * (1536 / 32), I_UKV = (256 / 64) * (2048 / 32), I_OUT = (DM / 64) * (DM / 32), I_L = I_IN + I_UQ + I_UKV + I_OUT;
        for (int it = gw; it < 2 * I_L; it += NGW) {
            const int l = it / I_L; int r = it % I_L;
            if (r < I_IN) { transpose_item<1>(A.in[I_WIN] + (size_t)l * DM * IN_COLS, IN_COLS, DM, IN_COLS, (bf16*)(F.ws + WS_WIN) + (size_t)l * 4096 * DM, nullptr, scr, r, F.lane); continue; } r -= I_IN;
            if (r < I_UQ) { transpose_item<2>(A.in[I_WUQ] + (size_t)l * 512 * 1536, 1536, 512, 1536, (bf16*)(F.ws + WS_WUQ) + (size_t)l * 1536 * 512, A.in[I_QNG] + l * 512, scr, r, F.lane); continue; } r -= I_UQ;
            if (r < I_UKV) { transpose_item<0>(A.in[I_WUKV] + (size_t)l * 256 * 2048, 2048, 256, 2048, (bf16*)(F.ws + WS_WUKV) + (size_t)l * 2048 * 256, A.in[I_KVNG] + l * 256, scr, r, F.lane); continue; } r -= I_UKV;
#ifdef G3_FP8
            transpose_item8<0>(A.in[I_WOUT] + (size_t)l * DM * DM, DM, DM, DM, F.ws + WS_WOUT + (size_t)l * DM * DM, scr, r, F.lane);
#else
            transpose_item<0>(A.in[I_WOUT] + (size_t)l * DM * DM, DM, DM, DM, (bf16*)(F.ws + WS_WOUT) + (size_t)l * DM * DM, nullptr, scr, r, F.lane);
#endif
        }
    }
    {
        const int gt = F.vcu * (NWAVES * 64) + F.tid, NGT = F.G * NWAVES * 64;
        float* rope = (float*)(F.ws + WS_ROPE);
        for (int e = gt; e < SEQ * 32; e += NGT) { const int pos = e >> 5, i = e & 31;
            const float ang = (float)pos * A.invf[i];
            const double rev = (double)ang * 0.15915494309189535; const float fr = (float)(rev - __builtin_floor(rev));
            *(f32x2*)(rope + (size_t)e * 2) = (f32x2){__builtin_amdgcn_cosf(fr), __builtin_amdgcn_sinf(fr)}; }
        for (int e = gt; e < 2 * 192 * (DM / 8); e += NGT) { const int l = e / (192 * (DM / 8)), r = e % (192 * (DM / 8));
            *(v4u*)((bf16*)(F.ws + WS_WIN) + ((size_t)l * 4096 + IN_COLS) * DM + (size_t)r * 8) = (v4u){0u, 0u, 0u, 0u}; }
    }
}

__device__ __forceinline__ void phase_norm1(Frame& F, const Args& A, int l) {
    const int gw = F.vcu * NWAVES + F.wave, NGW = F.G * NWAVES;
    const float* mod = (const float*)(F.ws + WS_MOD);
    bf16* H = (bf16*)(F.ws + WS_H); const bf16* Y = (const bf16*)(F.ws + WS_Y);
#ifdef THIN_MLP
    for (int ch = gw; ch < T / 16; ch += NGW) {
        const int row0 = ch * 16, b = row0 >> 13;
        const float* ml = mod + ((size_t)l * 4 + b) * 12288;
#pragma unroll 1
        for (int rr = 0; rr < 16; rr += 2) {
            f32x4 v[2][8];
            if (l == 0) {
#pragma unroll
                for (int q = 0; q < 2; ++q)
#pragma unroll
                    for (int j = 0; j < 8; ++j) v[q][j] = *(const f32x4*)(A.in[I_X] + (size_t)(row0 + rr + q) * DM + 4 * F.lane + 256 * j);
            } else {
                bf16* XB = (bf16*)(F.ws + WS_XB);
                v2u xw[2][8], ya[2][8], yb[2][8]; f32x4 g2p[8];
#pragma unroll
                for (int q = 0; q < 2; ++q)
#pragma unroll
                    for (int j = 0; j < 8; ++j) { const int c = 4 * F.lane + 256 * j; const int row = row0 + rr + q;
                        xw[q][j] = *(const v2u*)(XB + (size_t)row * DM + c); ya[q][j] = *(const v2u*)(Y + (size_t)(2 * row) * DM + c); yb[q][j] = *(const v2u*)(Y + (size_t)(2 * row + 1) * DM + c); }
#pragma unroll
                for (int j = 0; j < 8; ++j) g2p[j] = *(const f32x4*)(mod + ((size_t)(l - 1) * 4 + b) * 12288 + 5 * DM + 4 * F.lane + 256 * j);
#pragma unroll
                for (int q = 0; q < 2; ++q)
#pragma unroll
                    for (int j = 0; j < 8; ++j) { const int c = 4 * F.lane + 256 * j; const int row = row0 + rr + q;
                        const f32x4 xr = {bf_lo(xw[q][j].x), bf_hi(xw[q][j].x), bf_lo(xw[q][j].y), bf_hi(xw[q][j].y)};
                        const v2u y0 = ya[q][j], y1 = yb[q][j];
                        const f32x4 ys = {bf_lo(y0.x) + bf_lo(y1.x), bf_hi(y0.x) + bf_hi(y1.x), bf_lo(y0.y) + bf_lo(y1.y), bf_hi(y0.y) + bf_hi(y1.y)};
                        const f32x4 t = xr + g2p[j] * ys;
                        const v2u ow = {pk2(t.x, t.y), pk2(t.z, t.w)}; *(v2u*)(XB + (size_t)row * DM + c) = ow;
                        v[q][j] = (f32x4){bf_lo(ow.x), bf_hi(ow.x), bf_lo(ow.y), bf_hi(ow.y)}; }
            }
            float rstd[2];
#pragma unroll
            for (int q = 0; q < 2; ++q) { float s = 0.f;
#pragma unroll
                for (int j = 0; j < 8; ++j) s += (v[q][j].x * v[q][j].x + v[q][j].y * v[q][j].y) + (v[q][j].z * v[q][j].z + v[q][j].w * v[q][j].w);
                rstd[q] = __builtin_amdgcn_rsqf(wave_sum(s) * (1.f / DM) + EPS); }
#pragma unroll
            for (int j = 0; j < 8; ++j) { const int c = 4 * F.lane + 256 * j;
                const f32x4 gsc = *(const f32x4*)(A.in[I_N1G] + l * DM + c) * (*(const f32x4*)(ml + 1 * DM + c) + 1.0f), sh = *(const f32x4*)(ml + 0 * DM + c);
#pragma unroll
                for (int q = 0; q < 2; ++q) { const f32x4 o = v[q][j] * rstd[q] * gsc + sh;
                    *(v2u*)(H + (size_t)(row0 + rr + q) * DM + c) = (v2u){pk2(o.x, o.y), pk2(o.z, o.w)}; } }
        }
    }
#else
    for (int ch = gw; ch < T / 16; ch += NGW) {
        const int row0 = ch * 16, b = row0 >> 13;
        const float* ml = mod + ((size_t)l * 4 + b) * 12288;
        f32x4 gsc[8], sh[8], g2p[8];
#pragma unroll
        for (int j = 0; j < 8; ++j) { const int c = 4 * F.lane + 256 * j; const f32x4 g = *(const f32x4*)(A.in[I_N1G] + l * DM + c), sc = *(const f32x4*)(ml + 1 * DM + c);
            gsc[j] = g * (sc + 1.0f); sh[j] = *(const f32x4*)(ml + 0 * DM + c);
            if (l > 0) g2p[j] = *(const f32x4*)(mod + ((size_t)(l - 1) * 4 + b) * 12288 + 5 * DM + c); }
#pragma unroll 1
        for (int rr = 0; rr < 16; ++rr) {
            const int row = row0 + rr; f32x4 v[8]; float s = 0.f;
            if (l == 0) {
#pragma unroll
                for (int j = 0; j < 8; ++j) v[j] = *(const f32x4*)(A.in[I_X] + (size_t)row * DM + 4 * F.lane + 256 * j);
            } else {
#pragma unroll
                for (int j = 0; j < 8; ++j) { const int c = 4 * F.lane + 256 * j;
#ifdef XRES_BF16
                    bf16* XB = (bf16*)(F.ws + WS_XB); const v2u xw = *(const v2u*)(XB + (size_t)row * DM + c); const f32x4 xr = {bf_lo(xw.x), bf_hi(xw.x), bf_lo(xw.y), bf_hi(xw.y)};
#else
                    const f32x4 xr = *(const f32x4*)(A.out + (size_t)row * DM + c);
#endif
                    const v2u y0 = *(const v2u*)(Y + (size_t)(2 * row) * DM + c), y1 = *(const v2u*)(Y + (size_t)(2 * row + 1) * DM + c);
                    const f32x4 ys = {bf_lo(y0.x) + bf_lo(y1.x), bf_hi(y0.x) + bf_hi(y1.x), bf_lo(y0.y) + bf_lo(y1.y), bf_hi(y0.y) + bf_hi(y1.y)};
                    v[j] = xr + g2p[j] * ys;
#ifdef XRES_BF16
                    { const v2u ow = {pk2(v[j].x, v[j].y), pk2(v[j].z, v[j].w)}; *(v2u*)(XB + (size_t)row * DM + c) = ow;
                      v[j] = (f32x4){bf_lo(ow.x), bf_hi(ow.x), bf_lo(ow.y), bf_hi(ow.y)}; }
#else
                    *(f32x4*)(A.out + (size_t)row * DM + c) = v[j];
#endif
                }
            }
#pragma unroll
            for (int j = 0; j < 8; ++j) s += (v[j].x * v[j].x + v[j].y * v[j].y) + (v[j].z * v[j].z + v[j].w * v[j].w);
            const float rstd = __builtin_amdgcn_rsqf(wave_sum(s) * (1.f / DM) + EPS);
#pragma unroll
            for (int j = 0; j < 8; ++j) { const f32x4 o = v[j] * rstd * gsc[j] + sh[j];
                *(v2u*)(H + (size_t)row * DM + 4 * F.lane + 256 * j) = (v2u){pk2(o.x, o.y), pk2(o.z, o.w)}; }
        }
    }
#endif
#ifndef ATT_CONV
    {
        LAS float* scr = (LAS float*)(F.lds + F.wave * 16384);
        constexpr int I_G = (DM / 64) * (DEXP / 32), I_D = (DEXP / 64) * (DM / 32), I_E = 2 * I_G + I_D;
        for (int it = gw; it < NEXP * I_E; it += NGW) {
            const int e = it / I_E; int r = it % I_E; const size_t eo = ((size_t)l * NEXP + e) * DM * DEXP;
            if (r < I_G) { transpose_item8<3>(A.in[I_EG] + eo, DEXP, DM, DEXP, F.ws + WS_W13 + (size_t)e * 2048 * DM, scr, r, F.lane); continue; } r -= I_G;
            if (r < I_G) { transpose_item8<4>(A.in[I_EU] + eo, DEXP, DM, DEXP, F.ws + WS_W13 + (size_t)e * 2048 * DM, scr, r, F.lane); continue; } r -= I_G;
            transpose_item8<0>(A.in[I_ED] + eo, DM, DEXP, DM, F.ws + WS_W2 + (size_t)e * DM * DEXP, scr, r, F.lane);
        }
    }
#endif
}
__device__ __forceinline__ void phase_final(Frame& F, const Args& A, int probe) {
    const int gw = F.vcu * NWAVES + F.wave, NGW = F.G * NWAVES;
    const float* mod = (const float*)(F.ws + WS_MOD); const bf16* Y = (const bf16*)(F.ws + WS_Y);
    for (int ch = gw; ch < T / 16; ch += NGW) {
        const int row0 = ch * 16, b = row0 >> 13;
#if defined(THIN_MLP) && defined(XRES_BF16)
#pragma unroll 1
        for (int rr = 0; rr < 16; rr += 2) {
            v2u xw[2][8], ya[2][8], yb[2][8]; f32x4 g2p[8]; f32x4 v[2][8];
#pragma unroll
            for (int q = 0; q < 2; ++q)
#pragma unroll
                for (int j = 0; j < 8; ++j) { const int c = 4 * F.lane + 256 * j; const int row = row0 + rr + q;
                    xw[q][j] = *(const v2u*)((const bf16*)(F.ws + WS_XB) + (size_t)row * DM + c); ya[q][j] = *(const v2u*)(Y + (size_t)(2 * row) * DM + c); yb[q][j] = *(const v2u*)(Y + (size_t)(2 * row + 1) * DM + c); }
#pragma unroll
            for (int j = 0; j < 8; ++j) g2p[j] = *(const f32x4*)(mod + ((size_t)(probe == 3 ? 0 : DEPTH - 1) * 4 + b) * 12288 + 5 * DM + 4 * F.lane + 256 * j);
            float rstd[2];
#pragma unroll
            for (int q = 0; q < 2; ++q) { float s = 0.f;
#pragma unroll
                for (int j = 0; j < 8; ++j) { const f32x4 xr = {bf_lo(xw[q][j].x), bf_hi(xw[q][j].x), bf_lo(xw[q][j].y), bf_hi(xw[q][j].y)};
                    const v2u y0 = ya[q][j], y1 = yb[q][j];
                    const f32x4 ys = {bf_lo(y0.x) + bf_lo(y1.x), bf_hi(y0.x) + bf_hi(y1.x), bf_lo(y0.y) + bf_lo(y1.y), bf_hi(y0.y) + bf_hi(y1.y)};
                    v[q][j] = (probe == 1 || probe == 2) ? xr : xr + g2p[j] * ys; }
#pragma unroll
                for (int j = 0; j < 8; ++j) s += (v[q][j].x * v[q][j].x + v[q][j].y * v[q][j].y) + (v[q][j].z * v[q][j].z + v[q][j].w * v[q][j].w);
                rstd[q] = __builtin_amdgcn_rsqf(wave_sum(s) * (1.f / DM) + EPS); }
#pragma unroll
            for (int j = 0; j < 8; ++j) { const int c = 4 * F.lane + 256 * j; const f32x4 fg = *(const f32x4*)(A.in[I_FG] + c);
#pragma unroll
                for (int q = 0; q < 2; ++q) *(f32x4*)(A.out + (size_t)(row0 + rr + q) * DM + c) = v[q][j] * rstd[q] * fg; }
        }
#else
        f32x4 fg[8], g2p[8];
#pragma unroll
        for (int j = 0; j < 8; ++j) { const int c = 4 * F.lane + 256 * j; fg[j] = *(const f32x4*)(A.in[I_FG] + c); g2p[j] = *(const f32x4*)(mod + ((size_t)(probe == 3 ? 0 : DEPTH - 1) * 4 + b) * 12288 + 5 * DM + c); }
#pragma unroll 1
        for (int rr = 0; rr < 16; ++rr) {
            const int row = row0 + rr; f32x4 v[8]; float s = 0.f;
#pragma unroll
            for (int j = 0; j < 8; ++j) { const int c = 4 * F.lane + 256 * j;
#ifdef XRES_BF16
                const v2u xw = *(const v2u*)((const bf16*)(F.ws + WS_XB) + (size_t)row * DM + c); const f32x4 xr = {bf_lo(xw.x), bf_hi(xw.x), bf_lo(xw.y), bf_hi(xw.y)};
#else
                const f32x4 xr = *(const f32x4*)((probe == 2 ? A.in[I_X] : A.out) + (size_t)row * DM + c);
#endif
                const v2u y0 = *(const v2u*)(Y + (size_t)(2 * row) * DM + c), y1 = *(const v2u*)(Y + (size_t)(2 * row + 1) * DM + c);
                const f32x4 ys = {bf_lo(y0.x) + bf_lo(y1.x), bf_hi(y0.x) + bf_hi(y1.x), bf_lo(y0.y) + bf_lo(y1.y), bf_hi(y0.y) + bf_hi(y1.y)};
                v[j] = (probe == 1 || probe == 2) ? xr : xr + g2p[j] * ys; }
#pragma unroll
            for (int j = 0; j < 8; ++j) s += (v[j].x * v[j].x + v[j].y * v[j].y) + (v[j].z * v[j].z + v[j].w * v[j].w);
            const float rstd = __builtin_amdgcn_rsqf(wave_sum(s) * (1.f / DM) + EPS);
#pragma unroll
            for (int j = 0; j < 8; ++j) *(f32x4*)(A.out + (size_t)row * DM + 4 * F.lane + 256 * j) = v[j] * rstd * fg[j];
        }
#endif
    }
}
#ifndef PROBE_DUMP_SCALE
#define PROBE_DUMP_SCALE 1.0f
#endif
#ifndef PROBE_DUMP_W
#define PROBE_DUMP_W 2048
#endif
__device__ __forceinline__ void phase_dump(Frame& F, const Args& A, size_t off, int pitch) {
    const int gw = F.vcu * NWAVES + F.wave, NGW = F.G * NWAVES;
    for (int row = gw; row < T; row += NGW) { const bf16* src = (const bf16*)(F.ws + off) + (size_t)row * pitch;
#ifdef PROBE_DUMP_F32
        for (int j = 0; j < 8; ++j) { const int c = 4 * F.lane + 256 * j; const float* sf = (const float*)(F.ws + off) + (size_t)row * pitch + c;
#ifdef PROBE_DUMP_SRC_OUT
            sf = A.out + (size_t)row * DM + c;
#endif
            f32x4 o = {0.f, 0.f, 0.f, 0.f}; if (c < PROBE_DUMP_W) o = *(const f32x4*)sf * PROBE_DUMP_SCALE;
#ifdef PROBE_DUMP_LOWBITS
            { const v4u ub = __builtin_bit_cast(v4u, o); o = (f32x4){(float)(ub.x & 0xFFFu), (float)(ub.y & 0xFFFu), (float)(ub.z & 0xFFFu), (float)(ub.w & 0xFFFu)}; }
#endif
            *(f32x4*)(A.out + (size_t)row * DM + c) = o; }
        continue;
#endif
        for (int j = 0; j < 8; ++j) { const int c = 4 * F.lane + 256 * j; const v2u w = *(const v2u*)(src + c);
#ifdef PROBE_DUMP_LOWBITS
            *(f32x4*)(A.out + (size_t)row * DM + c) = c < PROBE_DUMP_W ? (f32x4){(float)(w.x & 0x7Fu), (float)((w.x >> 16) & 0x7Fu), (float)(w.y & 0x7Fu), (float)((w.y >> 16) & 0x7Fu)} : (f32x4){0.f, 0.f, 0.f, 0.f}; } }
#else
            *(f32x4*)(A.out + (size_t)row * DM + c) = c < PROBE_DUMP_W ? (f32x4){bf_lo(w.x), bf_hi(w.x), bf_lo(w.y), bf_hi(w.y)} : (f32x4){0.f, 0.f, 0.f, 0.f}; } }
#endif
}
__device__ __forceinline__ void phase_mla_prep(Frame& F, const Args& A) {
    const int gw = F.vcu * NWAVES + F.wave, NGW = F.G * NWAVES;
    const bf16* P = (const bf16*)(F.ws + WS_PROJ); bf16* KF = (bf16*)(F.ws + WS_KF);
    float* rq = (float*)(F.ws + WS_RSTDQ); float* rkv = (float*)(F.ws + WS_RSTDKV); const float* rope = (const float*)(F.ws + WS_ROPE);
    for (int ch = gw; ch < T / 16; ch += NGW) {
#pragma unroll 1
        for (int r4 = 0; r4 < 16; r4 += 4) {
            v4u q[4]; v2u kv[4]; unsigned kr[4]; f32x2 cs[4];
#pragma unroll
            for (int u = 0; u < 4; ++u) { const int row = ch * 16 + r4 + u; const bf16* pr = P + (size_t)row * PROJ_LD;
                q[u] = *(const v4u*)(pr + C_CQ + 8 * F.lane); kv[u] = *(const v2u*)(pr + C_CKV + 4 * F.lane);
                kr[u] = *(const unsigned*)(pr + C_KR + 2 * (F.lane & 31)); cs[u] = *(const f32x2*)(rope + ((size_t)(row & (SEQ - 1)) * 32 + (F.lane & 31)) * 2); }
#pragma unroll
            for (int u = 0; u < 4; ++u) { const int row = ch * 16 + r4 + u;
                float sq = 0.f, skv = 0.f;
#pragma unroll
                for (int i = 0; i < 4; ++i) { const float a = bf_lo(q[u][i]), b2 = bf_hi(q[u][i]); sq += a * a + b2 * b2; }
#pragma unroll
                for (int i = 0; i < 2; ++i) { const float a = bf_lo(kv[u][i]), b2 = bf_hi(kv[u][i]); skv += a * a + b2 * b2; }
                sq = wave_sum(sq); skv = wave_sum(skv);
                if (F.lane == 0) { rq[row] = __builtin_amdgcn_rsqf(sq * (1.f / 512.f) + EPS); rkv[row] = __builtin_amdgcn_rsqf(skv * (1.f / 256.f) + EPS); }
                if (F.lane < 32) { const float x1 = bf_lo(kr[u]), x2 = bf_hi(kr[u]);
                    const unsigned o = pk2(x1 * cs[u].x - x2 * cs[u].y, x2 * cs[u].x + x1 * cs[u].y);
#pragma unroll
                    for (int h = 0; h < 8; ++h) *(unsigned*)(KF + (size_t)row * 1536 + h * 192 + 128 + 2 * F.lane) = o; } }
        }
    }
}
__device__ __forceinline__ void phase_q_rope(Frame& F, const Args& A) {
    const int gw = F.vcu * NWAVES + F.wave, NGW = F.G * NWAVES;
    bf16* QA = (bf16*)(F.ws + WS_QA); const float* rope = (const float*)(F.ws + WS_ROPE);
    for (int ch = gw; ch < T / 16; ch += NGW) {
#pragma unroll 1
        for (int r4 = 0; r4 < 16; r4 += 4) {
            v4u w[4]; f32x4 c01[4], c23[4];
#pragma unroll
            for (int u = 0; u < 4; ++u) { const int row = ch * 16 + r4 + u;
                w[u] = *(const v4u*)(QA + (size_t)row * 1536 + (F.lane >> 3) * 192 + 128 + (F.lane & 7) * 8);
                const f32x4* cs = (const f32x4*)(rope + ((size_t)(row & (SEQ - 1)) * 32 + (F.lane & 7) * 4) * 2); c01[u] = cs[0]; c23[u] = cs[1]; }
#pragma unroll
            for (int u = 0; u < 4; ++u) { const int row = ch * 16 + r4 + u; v4u o;
                { const float x1 = bf_lo(w[u].x), x2 = bf_hi(w[u].x); o.x = pk2(x1 * c01[u][0] - x2 * c01[u][1], x2 * c01[u][0] + x1 * c01[u][1]); }
                { const float x1 = bf_lo(w[u].y), x2 = bf_hi(w[u].y); o.y = pk2(x1 * c01[u][2] - x2 * c01[u][3], x2 * c01[u][2] + x1 * c01[u][3]); }
                { const float x1 = bf_lo(w[u].z), x2 = bf_hi(w[u].z); o.z = pk2(x1 * c23[u][0] - x2 * c23[u][1], x2 * c23[u][0] + x1 * c23[u][1]); }
                { const float x1 = bf_lo(w[u].w), x2 = bf_hi(w[u].w); o.w = pk2(x1 * c23[u][2] - x2 * c23[u][3], x2 * c23[u][2] + x1 * c23[u][3]); }
                *(v4u*)(QA + (size_t)row * 1536 + (F.lane >> 3) * 192 + 128 + (F.lane & 7) * 8) = o; }
        }
    }
}
__device__ __forceinline__ void phase_out_norm(Frame& F, const Args& A, int l) {
    const int gw = F.vcu * NWAVES + F.wave, NGW = F.G * NWAVES;
    const bf16* OA = (const bf16*)(F.ws + WS_OA); const bf16* OB = (const bf16*)(F.ws + WS_OB); const float* LSE = (const float*)(F.ws + WS_LSE); bf16* Yn = (bf16*)(F.ws + WS_H);
    for (int ch = gw; ch < T / 16; ch += NGW) {
        float ga[2][8], gb[2][8];
#pragma unroll
        for (int hf = 0; hf < 2; ++hf)
#pragma unroll
            for (int i = 0; i < 8; ++i) { ga[hf][i] = A.in[I_ONA][l * 1024 + hf * 512 + 8 * F.lane + i]; gb[hf][i] = A.in[I_ONB][l * 1024 + hf * 512 + 8 * F.lane + i]; }
#ifdef THIN_MLP
#pragma unroll 1
        for (int rr = 0; rr < 16; rr += 2) {
            v4u ra_[2][2], ro_[2][2][3]; float ls_[2][2][3];
#pragma unroll
            for (int q = 0; q < 2; ++q)
#pragma unroll
                for (int hf = 0; hf < 2; ++hf) { const int row = ch * 16 + rr + q, c = hf * 512 + 8 * F.lane, hd = c >> 7;
                    ra_[q][hf] = *(const v4u*)(OA + (size_t)row * 1024 + c);
#pragma unroll
                    for (int n = 0; n < 3; ++n) { ro_[q][hf][n] = *(const v4u*)(OB + ((size_t)n * T + row) * 1024 + c); ls_[q][hf][n] = LSE[((size_t)n * T + row) * 8 + hd]; } }
#pragma unroll
            for (int q = 0; q < 2; ++q) {
                const int row = ch * 16 + rr + q;
                float va[2][8], vb[2][8]; float sa = 0.f, sb = 0.f;
#pragma unroll
                for (int hf = 0; hf < 2; ++hf) {
                    const v4u a = ra_[q][hf];
#pragma unroll
                    for (int i = 0; i < 4; ++i) { va[hf][2 * i] = bf_lo(a[i]); va[hf][2 * i + 1] = bf_hi(a[i]); }
                    const float l0 = ls_[q][hf][0], l1 = ls_[q][hf][1], l2 = ls_[q][hf][2];
                    const float mx = fmaxf(l0, fmaxf(l1, l2)); const float e0 = __expf(l0 - mx), e1 = __expf(l1 - mx), e2 = __expf(l2 - mx); const float inv = 1.0f / (e0 + e1 + e2);
                    const float al[3] = {e0 * inv, e1 * inv, e2 * inv};
#pragma unroll
                    for (int i = 0; i < 8; ++i) vb[hf][i] = 0.f;
#pragma unroll
                    for (int n = 0; n < 3; ++n) { const v4u o = ro_[q][hf][n];
#pragma unroll
                        for (int i = 0; i < 4; ++i) { vb[hf][2 * i] += al[n] * bf_lo(o[i]); vb[hf][2 * i + 1] += al[n] * bf_hi(o[i]); } }
#pragma unroll
                    for (int i = 0; i < 8; ++i) { sa += va[hf][i] * va[hf][i]; sb += vb[hf][i] * vb[hf][i]; }
                }
                const float ra = __builtin_amdgcn_rsqf(wave_sum(sa) * (1.f / 1024.f) + EPS), rb = __builtin_amdgcn_rsqf(wave_sum(sb) * (1.f / 1024.f) + EPS);
#pragma unroll
                for (int hf = 0; hf < 2; ++hf) { const int c = hf * 512 + 8 * F.lane;
#ifdef G3_FP8
                    { unsigned char* Y8 = (unsigned char*)Yn; float ya[8], yb[8];
#pragma unroll
                      for (int i = 0; i < 8; ++i) { ya[i] = va[hf][i] * ra * ga[hf][i]; yb[i] = vb[hf][i] * rb * gb[hf][i]; }
                      *(v2u*)(Y8 + (size_t)row * DM + c) = (v2u){pk4_fp8(ya[0], ya[1], ya[2], ya[3]), pk4_fp8(ya[4], ya[5], ya[6], ya[7])};
                      *(v2u*)(Y8 + (size_t)row * DM + 1024 + c) = (v2u){pk4_fp8(yb[0], yb[1], yb[2], yb[3]), pk4_fp8(yb[4], yb[5], yb[6], yb[7])}; }
#else
                    { v4u wa, wb;
#pragma unroll
                      for (int i = 0; i < 4; ++i) { wa[i] = pk2(va[hf][2 * i] * ra * ga[hf][2 * i], va[hf][2 * i + 1] * ra * ga[hf][2 * i + 1]); wb[i] = pk2(vb[hf][2 * i] * rb * gb[hf][2 * i], vb[hf][2 * i + 1] * rb * gb[hf][2 * i + 1]); }
                      *(v4u*)(Yn + (size_t)row * DM + c) = wa; *(v4u*)(Yn + (size_t)row * DM + 1024 + c) = wb; }
#endif
                }
            }
        }
#else
#pragma unroll 1
        for (int rr = 0; rr < 16; ++rr) {
            const int row = ch * 16 + rr;
            float va[2][8], vb[2][8]; float sa = 0.f, sb = 0.f;
#pragma unroll
            for (int hf = 0; hf < 2; ++hf) {
                const int c = hf * 512 + 8 * F.lane, hd = c >> 7;
                const v4u a = *(const v4u*)(OA + (size_t)row * 1024 + c);
#pragma unroll
                for (int i = 0; i < 4; ++i) { va[hf][2 * i] = bf_lo(a[i]); va[hf][2 * i + 1] = bf_hi(a[i]); }
                const float l0 = LSE[((size_t)0 * T + row) * 8 + hd], l1 = LSE[((size_t)1 * T + row) * 8 + hd], l2 = LSE[((size_t)2 * T + row) * 8 + hd];
                const float mx = fmaxf(l0, fmaxf(l1, l2)); const float e0 = __expf(l0 - mx), e1 = __expf(l1 - mx), e2 = __expf(l2 - mx); const float inv = 1.0f / (e0 + e1 + e2);
                const float al[3] = {e0 * inv, e1 * inv, e2 * inv};
#pragma unroll
                for (int i = 0; i < 8; ++i) vb[hf][i] = 0.f;
#pragma unroll
                for (int n = 0; n < 3; ++n) { const v4u o = *(const v4u*)(OB + ((size_t)n * T + row) * 1024 + c);
#pragma unroll
                    for (int i = 0; i < 4; ++i) { vb[hf][2 * i] += al[n] * bf_lo(o[i]); vb[hf][2 * i + 1] += al[n] * bf_hi(o[i]); } }
#pragma unroll
                for (int i = 0; i < 8; ++i) { sa += va[hf][i] * va[hf][i]; sb += vb[hf][i] * vb[hf][i]; }
            }
            const float ra = __builtin_amdgcn_rsqf(wave_sum(sa) * (1.f / 1024.f) + EPS), rb = __builtin_amdgcn_rsqf(wave_sum(sb) * (1.f / 1024.f) + EPS);
#pragma unroll
            for (int hf = 0; hf < 2; ++hf) { const int c = hf * 512 + 8 * F.lane; v4u wa, wb;
#pragma unroll
                for (int i = 0; i < 4; ++i) { wa[i] = pk2(va[hf][2 * i] * ra * ga[hf][2 * i], va[hf][2 * i + 1] * ra * ga[hf][2 * i + 1]); wb[i] = pk2(vb[hf][2 * i] * rb * gb[hf][2 * i], vb[hf][2 * i + 1] * rb * gb[hf][2 * i + 1]); }
#ifdef G3_FP8
                { unsigned char* Y8 = (unsigned char*)Yn; float ya[8], yb[8];
#pragma unroll
                  for (int i = 0; i < 8; ++i) { ya[i] = va[hf][i] * ra * ga[hf][i]; yb[i] = vb[hf][i] * rb * gb[hf][i]; }
                  *(v2u*)(Y8 + (size_t)row * DM + c) = (v2u){pk4_fp8(ya[0], ya[1], ya[2], ya[3]), pk4_fp8(ya[4], ya[5], ya[6], ya[7])};
                  *(v2u*)(Y8 + (size_t)row * DM + 1024 + c) = (v2u){pk4_fp8(yb[0], yb[1], yb[2], yb[3]), pk4_fp8(yb[4], yb[5], yb[6], yb[7])}; }
#else
                *(v4u*)(Yn + (size_t)row * DM + c) = wa; *(v4u*)(Yn + (size_t)row * DM + 1024 + c) = wb;
#endif
            }
        }
#endif
    }
}
#ifndef ROUTER_SRC
#define ROUTER_SRC A.out
#endif
#ifdef ROUTER_MFMA
typedef short r_bf16x8 __attribute__((ext_vector_type(8)));
__device__ __forceinline__ void phase_router(Frame& F, const Args& A, int l, int dummy = 0) {
    const float* mod = (const float*)(F.ws + WS_MOD);
    bf16* H = (bf16*)(F.ws + WS_H);
    LAS int* lcnt = (LAS int*)(F.lds + L_CNT); LAS int* gbase = lcnt + 16; LAS int* tokinfo = (LAS int*)(F.lds + L_TOK);
    LAS float* lgs = (LAS float*)(F.lds + L_ATAB);
    LAS float* rsl = (LAS float*)(F.lds + L_ATAB + 8704);
    LAS float* wsm = (LAS float*)(F.lds + L_ATAB + 8704 + 512);
    LAS float* cstl = (LAS float*)(F.lds + L_ATAB + 8704 + 1024);
    unsigned* gcnt = F.ctl + CW_CNT + (dummy ? 3 : l) * 16;
    int* rowidx = (int*)(F.ws + (dummy ? WS_OB : WS_ROWIDX)); float* aw = (float*)(F.ws + (dummy ? WS_OB + 4 * MiB : WS_AW));
    float rb[16];
#pragma unroll
    for (int e = 0; e < 16; ++e) rb[e] = __uint_as_float(__builtin_amdgcn_readfirstlane(__float_as_uint(A.in[I_RB][e])));
    for (int bi = F.vcu; bi < T / 128; bi += F.G) {
        const int row0 = bi * 128 + F.wave * 16, b = row0 >> 13;
        const rsrc_t rml = RSRC(mod + ((size_t)l * 4 + b) * 12288), rgn = RSRC(A.in[I_N2G] + l * DM), rh = RSRC(H), rxb = RSRC(F.ws + WS_XB), rrw = RSRC(A.in[I_RW]);
        __syncthreads();
        { const int t0_ = F.wave * 64 + lane_id(); if (t0_ < 16) lcnt[t0_] = 0;
          const int e4 = t0_ & 3; f32x4 ca = {0.f, 0.f, 0.f, 0.f};
#pragma unroll 4
          for (int i = 0; i < 16; ++i) { const int k = (t0_ >> 2) + 128 * i;
              const f32x4 w4 = bld4f(rrw, (k * 16 + e4 * 4) * 4, 0);
              const float g = __uint_as_float(__builtin_amdgcn_raw_buffer_load_b32(rgn, k * 4, 0, 0)) * (__uint_as_float(__builtin_amdgcn_raw_buffer_load_b32(rml, k * 4, 4 * DM * 4, 0)) + 1.0f);
              const float sh = __uint_as_float(__builtin_amdgcn_raw_buffer_load_b32(rml, k * 4, 3 * DM * 4, 0));
              ca += w4 * sh;
              const int ob = (k >> 5) * 1024 + (((k >> 3) & 3) * 16 + e4 * 4) * 16 + (k & 7) * 2;
#pragma unroll
              for (int c = 0; c < 4; ++c) { const float wp = w4[c] * g; const unsigned hi = pk2(wp, 0.f) & 0xffffu; const float rem = wp - __uint_as_float(hi << 16);
                  *(LAS unsigned short*)(F.lds + ob + c * 16) = (unsigned short)hi; *(LAS unsigned short*)(F.lds + 65536 + ob + c * 16) = (unsigned short)(pk2(rem, 0.f) & 0xffffu); } }
          const int ln = t0_ & 63;
#pragma unroll
          for (int q = 0; q < 4; ++q)
#pragma unroll
              for (int c = 0; c < 4; ++c) { const float s = wave_sum((ln & 3) == q ? ca[c] : 0.f); if (ln == 0) wsm[F.wave * 16 + q * 4 + c] = s; }
        }
        __syncthreads();
        { const int t0_ = F.wave * 64 + lane_id(); if (t0_ < 16) { float s = 0.f;
#pragma unroll
              for (int w = 0; w < 8; ++w) s += wsm[w * 16 + t0_];
              cstl[t0_] = s; } }
        __syncthreads();
        const int lo16 = F.lane * 16, lo8 = F.lane * 8;
        f32x4 gsv[8];
#pragma unroll
        for (int j = 0; j < 8; ++j) gsv[j] = bld4f(rgn, lo16 + j * 1024, 0) * (bld4f(rml, lo16 + j * 1024, 4 * DM * 4) + 1.0f);
#pragma unroll 1
        for (int rp = 0; rp < 8; ++rp) {
            float ss[2] = {0.f, 0.f};
            v2u xraw[2][8];
#pragma unroll
            for (int q = 0; q < 2; ++q)
#pragma unroll
                for (int j = 0; j < 8; ++j) xraw[q][j] = bld2u(rxb, lo8 + j * 512, (row0 + rp * 2 + q) * (DM * 2));
#define XV(q, j) ((f32x4){bf_lo(xraw[q][j].x), bf_hi(xraw[q][j].x), bf_lo(xraw[q][j].y), bf_hi(xraw[q][j].y)})
            f32x4 shv[8];
#pragma unroll
            for (int j = 0; j < 8; ++j) shv[j] = bld4f(rml, lo16 + j * 1024, 3 * DM * 4);
#pragma unroll
            for (int j = 0; j < 8; ++j)
#pragma unroll
                for (int q = 0; q < 2; ++q) { const f32x4 x = XV(q, j); ss[q] += (x.x * x.x + x.y * x.y) + (x.z * x.z + x.w * x.w); }
            float rstd[2];
#pragma unroll
            for (int q = 0; q < 2; ++q) rstd[q] = __builtin_amdgcn_rsqf(wave_sum(ss[q]) * (1.f / DM) + EPS);
            if (F.lane == 0) { rsl[F.wave * 16 + rp * 2] = rstd[0]; rsl[F.wave * 16 + rp * 2 + 1] = rstd[1]; }
#pragma unroll
            for (int j = 0; j < 8; ++j) {
#pragma unroll
                for (int q = 0; q < 2; ++q) { const f32x4 o = XV(q, j) * rstd[q] * gsv[j] + shv[j]; __builtin_amdgcn_raw_buffer_store_b32(pk4_fp8(o.x, o.y, o.z, o.w), rh, F.lane * 4 + j * 256, (row0 + rp * 2 + q) * DM, 0); } }
#undef XV
        }
        { const int ln = lane_id(), col = ln & 15, rq = ln >> 4;
          const int va = col * (DM * 2) + rq * 16, sa = row0 * (DM * 2);
          f32x4 acc = {0.f, 0.f, 0.f, 0.f};
          r_bf16x8 a0[8], a1[8];
#pragma unroll
          for (int i = 0; i < 8; ++i) a0[i] = __builtin_bit_cast(r_bf16x8, __builtin_amdgcn_raw_buffer_load_b128(rxb, va + i * 64, sa, 0));
#define RT_MM(AR, sb) do { _Pragma("unroll") for (int i = 0; i < 8; ++i) { const int st = (sb) * 8 + i; \
              const r_bf16x8 bh = *(const LAS r_bf16x8*)(F.lds + st * 1024 + ln * 16), bl = *(const LAS r_bf16x8*)(F.lds + 65536 + st * 1024 + ln * 16); \
              acc = __builtin_amdgcn_mfma_f32_16x16x32_bf16(AR[i], bh, acc, 0, 0, 0); acc = __builtin_amdgcn_mfma_f32_16x16x32_bf16(AR[i], bl, acc, 0, 0, 0); } } while (0)
#pragma unroll 1
          for (int sb = 0; sb < 8; sb += 2) {
#pragma unroll
              for (int i = 0; i < 8; ++i) a1[i] = __builtin_bit_cast(r_bf16x8, __builtin_amdgcn_raw_buffer_load_b128(rxb, va + ((sb + 1) * 8 + i) * 64, sa, 0));
              RT_MM(a0, sb);
              if (sb + 2 < 8) {
#pragma unroll
                  for (int i = 0; i < 8; ++i) a0[i] = __builtin_bit_cast(r_bf16x8, __builtin_amdgcn_raw_buffer_load_b128(rxb, va + ((sb + 2) * 8 + i) * 64, sa, 0)); }
              RT_MM(a1, sb + 1);
          }
#undef RT_MM
          LDS_WAIT();
          const float cs = cstl[col];
#pragma unroll
          for (int i = 0; i < 4; ++i) lgs[F.wave * 272 + (4 * rq + i) * 17 + col] = acc[i] * rsl[F.wave * 16 + 4 * rq + i] + cs;
          LDS_WAIT(); asm volatile("" ::: "memory");
          if (ln < 16) {
              float sc[16], bs[16];
#pragma unroll
              for (int e = 0; e < 16; ++e) { const float lg = lgs[F.wave * 272 + ln * 17 + e]; sc[e] = 1.0f / (1.0f + __expf(-lg)); bs[e] = sc[e] + rb[e]; }
              float gs4[4];
#pragma unroll
              for (int g = 0; g < 4; ++g) { const float a = bs[4 * g], b2 = bs[4 * g + 1], c = bs[4 * g + 2], d = bs[4 * g + 3];
                  const float h1 = fmaxf(a, b2), l1 = fminf(a, b2), h2 = fmaxf(c, d), l2 = fminf(c, d);
                  gs4[g] = fmaxf(h1, h2) + fmaxf(fminf(h1, h2), fmaxf(l1, l2)); }
              int gsel = 0; float gbest = gs4[0];
#pragma unroll
              for (int g = 1; g < 4; ++g) if (gs4[g] > gbest) { gbest = gs4[g]; gsel = g; }
              float bv[4], sv[4];
#pragma unroll
              for (int i = 0; i < 4; ++i) { bv[i] = gsel == 0 ? bs[i] : gsel == 1 ? bs[4 + i] : gsel == 2 ? bs[8 + i] : bs[12 + i]; sv[i] = gsel == 0 ? sc[i] : gsel == 1 ? sc[4 + i] : gsel == 2 ? sc[8 + i] : sc[12 + i]; }
              int i1 = 0; float b1 = bv[0], s1 = sv[0];
#pragma unroll
              for (int i = 1; i < 4; ++i) if (bv[i] > b1) { b1 = bv[i]; s1 = sv[i]; i1 = i; }
              int i2 = -1; float b2v = -__builtin_inff(), s2 = 0.f;
#pragma unroll
              for (int i = 0; i < 4; ++i) if (i != i1 && bv[i] > b2v) { b2v = bv[i]; s2 = sv[i]; i2 = i; }
              const float inv = 1.0f / (s1 + s2);
              const int r = F.wave * 16 + ln, e0 = gsel * 4 + i1, e1 = gsel * 4 + i2;
              tokinfo[r * 4 + 0] = e0; tokinfo[r * 4 + 2] = e1;
              const int row = row0 + ln; *(f32x2*)(aw + (size_t)row * 2) = (f32x2){s1 * inv, s2 * inv};
          }
        }
        __syncthreads();
        const int tb_ = F.wave * 64 + lane_id();
        if (tb_ < 16) {
            int c = 0;
            for (int r = 0; r < 128; ++r) { if (tokinfo[r * 4 + 0] == tb_) tokinfo[r * 4 + 1] = c++; if (tokinfo[r * 4 + 2] == tb_) tokinfo[r * 4 + 3] = c++; }
            gbase[tb_] = (int)__hip_atomic_fetch_add(gcnt + tb_, (unsigned)c, __ATOMIC_RELAXED, __HIP_MEMORY_SCOPE_AGENT); }
        __syncthreads();
        if (tb_ < 128) { const int e0 = tokinfo[tb_ * 4], p0 = tokinfo[tb_ * 4 + 1], e1 = tokinfo[tb_ * 4 + 2], p1 = tokinfo[tb_ * 4 + 3]; const int row = bi * 128 + tb_;
            rowidx[(size_t)e0 * 32768 + gbase[e0] + p0] = 2 * row; rowidx[(size_t)e1 * 32768 + gbase[e1] + p1] = 2 * row + 1; }
        __syncthreads();
    }
}
#else
__device__ __forceinline__ void phase_router(Frame& F, const Args& A, int l, int dummy = 0) {
    const float* mod = (const float*)(F.ws + WS_MOD);
    bf16* H = (bf16*)(F.ws + WS_H);
    LAS f32x4* rwl = (LAS f32x4*)F.lds;
    LAS int* lcnt = (LAS int*)(F.lds + L_CNT); LAS int* gbase = lcnt + 16; LAS int* tokinfo = (LAS int*)(F.lds + L_TOK);
    unsigned* gcnt = F.ctl + CW_CNT + (dummy ? 3 : l) * 16;
    int* rowidx = (int*)(F.ws + (dummy ? WS_OB : WS_ROWIDX)); float* aw = (float*)(F.ws + (dummy ? WS_OB + 4 * MiB : WS_AW));
    for (int q = F.tid; q < 8192; q += NWAVES * 64) { const int k = q >> 2, e4 = q & 3, ln = (k & 255) >> 2, j = k >> 8, i = k & 3;
        rwl[((j * 4 + i) * 4 + e4) * 64 + ln] = *(const f32x4*)(A.in[I_RW] + (size_t)k * 16 + e4 * 4); }
    float rb[16];
#pragma unroll
    for (int e = 0; e < 16; ++e) rb[e] = __uint_as_float(__builtin_amdgcn_readfirstlane(__float_as_uint(A.in[I_RB][e])));
    __syncthreads();
    for (int bi = F.vcu; bi < T / 128; bi += F.G) {
        { const int t0_ = F.wave * 64 + lane_id(); if (t0_ < 16) lcnt[t0_] = 0; }
        __syncthreads();
        const int row0 = bi * 128 + F.wave * 16, b = row0 >> 13;
        const rsrc_t rml = RSRC(mod + ((size_t)l * 4 + b) * 12288), rgn = RSRC(A.in[I_N2G] + l * DM), rx = RSRC(ROUTER_SRC), rh = RSRC(H);
#ifdef XRES_BF16
        const rsrc_t rxb = RSRC(F.ws + WS_XB);
#endif
        const int lo16 = F.lane * 16, lo8 = F.lane * 8;
        float cst[16];
        { f32x4 ca[4] = {};
#pragma unroll
          for (int j = 0; j < 8; ++j) { const f32x4 sh = bld4f(rml, lo16 + j * 1024, 3 * DM * 4);
#pragma unroll
            for (int i = 0; i < 4; ++i)
#pragma unroll
                for (int e4 = 0; e4 < 4; ++e4) ca[e4] += rwl[((j * 4 + i) * 4 + e4) * 64 + F.lane] * sh[i];
            asm volatile("" ::: "memory"); }
#pragma unroll
          for (int e = 0; e < 16; ++e) cst[e] = __uint_as_float(__builtin_amdgcn_readfirstlane(__float_as_uint(wave_sum(ca[e >> 2][e & 3])))); }
        f32x4 gsv[8];
#pragma unroll
        for (int j = 0; j < 8; ++j) gsv[j] = bld4f(rgn, lo16 + j * 1024, 0) * (bld4f(rml, lo16 + j * 1024, 4 * DM * 4) + 1.0f);
#pragma unroll 1
        for (int rp = 0; rp < 8; ++rp) {
            float ss[2] = {0.f, 0.f}; f32x4 acc[2][4] = {};
            const int so0 = (row0 + rp * 2) * (DM * 4);
#ifdef XRES_BF16
            v2u xraw[2][8];
#pragma unroll
            for (int q = 0; q < 2; ++q)
#pragma unroll
                for (int j = 0; j < 8; ++j) xraw[q][j] = bld2u(rxb, lo8 + j * 512, (row0 + rp * 2 + q) * (DM * 2));
#define XV(q, j) ((f32x4){bf_lo(xraw[q][j].x), bf_hi(xraw[q][j].x), bf_lo(xraw[q][j].y), bf_hi(xraw[q][j].y)})
#else
            f32x4 xv[2][8];
#pragma unroll
            for (int q = 0; q < 2; ++q)
#pragma unroll
                for (int j = 0; j < 8; ++j) xv[q][j] = bld4f(rx, lo16 + j * 1024, so0 + q * (DM * 4));
#define XV(q, j) xv[q][j]
#endif
#pragma unroll
            for (int j = 0; j < 8; ++j) {
                f32x4 a[2];
#pragma unroll
                for (int q = 0; q < 2; ++q) { const f32x4 x = XV(q, j); ss[q] += (x.x * x.x + x.y * x.y) + (x.z * x.z + x.w * x.w); a[q] = x * gsv[j]; }
#pragma unroll
                for (int i = 0; i < 4; ++i) {
#pragma unroll
                    for (int e4 = 0; e4 < 4; ++e4) { const f32x4 w = rwl[((j * 4 + i) * 4 + e4) * 64 + F.lane]; acc[0][e4] += w * a[0][i]; acc[1][e4] += w * a[1][i]; }
                    asm volatile("" : "+v"(acc[0][0]), "+v"(acc[0][1]), "+v"(acc[0][2]), "+v"(acc[0][3]), "+v"(acc[1][0]), "+v"(acc[1][1]), "+v"(acc[1][2]), "+v"(acc[1][3]) :: "memory"); } }
            float rstd[2];
#pragma unroll
            for (int q = 0; q < 2; ++q) rstd[q] = __builtin_amdgcn_rsqf(wave_sum(ss[q]) * (1.f / DM) + EPS);
            asm volatile("" ::: "memory");
            f32x4 shv[8];
#pragma unroll
            for (int j = 0; j < 8; ++j) shv[j] = bld4f(rml, lo16 + j * 1024, 3 * DM * 4);
#pragma unroll
            for (int j = 0; j < 8; ++j) {
#pragma unroll
                for (int q = 0; q < 2; ++q) { const f32x4 o = XV(q, j) * rstd[q] * gsv[j] + shv[j]; __builtin_amdgcn_raw_buffer_store_b32(pk4_fp8(o.x, o.y, o.z, o.w), rh, F.lane * 4 + j * 256, (row0 + rp * 2 + q) * DM, 0); } }
#undef XV
#pragma unroll
            for (int q = 0; q < 2; ++q) {
                float sc[16], bs[16];
#pragma unroll
                for (int e = 0; e < 16; ++e) { const float lg = wave_sum(acc[q][e >> 2][e & 3]) * rstd[q] + cst[e]; sc[e] = 1.0f / (1.0f + __expf(-lg)); bs[e] = sc[e] + rb[e]; }
                float gs4[4];
#pragma unroll
                for (int g = 0; g < 4; ++g) { const float a = bs[4 * g], b2 = bs[4 * g + 1], c = bs[4 * g + 2], d = bs[4 * g + 3];
                    const float h1 = fmaxf(a, b2), l1 = fminf(a, b2), h2 = fmaxf(c, d), l2 = fminf(c, d);
                    gs4[g] = fmaxf(h1, h2) + fmaxf(fminf(h1, h2), fmaxf(l1, l2)); }
                int gsel = 0; float gbest = gs4[0];
#pragma unroll
                for (int g = 1; g < 4; ++g) if (gs4[g] > gbest) { gbest = gs4[g]; gsel = g; }
                float bv[4], sv[4];
#pragma unroll
                for (int i = 0; i < 4; ++i) { bv[i] = gsel == 0 ? bs[i] : gsel == 1 ? bs[4 + i] : gsel == 2 ? bs[8 + i] : bs[12 + i]; sv[i] = gsel == 0 ? sc[i] : gsel == 1 ? sc[4 + i] : gsel == 2 ? sc[8 + i] : sc[12 + i]; }
                int i1 = 0; float b1 = bv[0], s1 = sv[0];
#pragma unroll
                for (int i = 1; i < 4; ++i) if (bv[i] > b1) { b1 = bv[i]; s1 = sv[i]; i1 = i; }
                int i2 = -1; float b2v = -__builtin_inff(), s2 = 0.f;
#pragma unroll
                for (int i = 0; i < 4; ++i) if (i != i1 && bv[i] > b2v) { b2v = bv[i]; s2 = sv[i]; i2 = i; }
                const float inv = 1.0f / (s1 + s2);
                if (F.lane == 0) {
                    const int r = F.wave * 16 + rp * 2 + q, e0 = gsel * 4 + i1, e1 = gsel * 4 + i2;
                    tokinfo[r * 4 + 0] = e0; tokinfo[r * 4 + 2] = e1;
                    const int row = row0 + rp * 2 + q; *(f32x2*)(aw + (size_t)row * 2) = (f32x2){s1 * inv, s2 * inv};
                }
            }
        }
        __syncthreads();
        const int tb_ = F.wave * 64 + lane_id();
        if (tb_ < 16) {
            int c = 0;
            for (int r = 0; r < 128; ++r) { if (tokinfo[r * 4 + 0] == tb_) tokinfo[r * 4 + 1] = c++; if (tokinfo[r * 4 + 2] == tb_) tokinfo[r * 4 + 3] = c++; }
            gbase[tb_] = (int)__hip_atomic_fetch_add(gcnt + tb_, (unsigned)c, __ATOMIC_RELAXED, __HIP_MEMORY_SCOPE_AGENT); }
        __syncthreads();
        if (tb_ < 128) { const int e0 = tokinfo[tb_ * 4], p0 = tokinfo[tb_ * 4 + 1], e1 = tokinfo[tb_ * 4 + 2], p1 = tokinfo[tb_ * 4 + 3]; const int row = bi * 128 + tb_;
            rowidx[(size_t)e0 * 32768 + gbase[e0] + p0] = 2 * row; rowidx[(size_t)e1 * 32768 + gbase[e1] + p1] = 2 * row + 1; }
        __syncthreads();
    }
}
#endif
__device__ __forceinline__ int moe_setup(Frame& F, int l) {
    LAS int* ts = (LAS int*)(F.lds + L_TS);
    if (F.tid == 0) { int s = 0; for (int e = 0; e < 16; ++e) { ts[e] = s; s += ((int)__hip_atomic_load(F.ctl + CW_CNT + l * 16 + e, __ATOMIC_RELAXED, __HIP_MEMORY_SCOPE_AGENT) + 255) >> 8; } ts[16] = s; }
    __syncthreads();
    return __builtin_amdgcn_readfirstlane(ts[16]);
}

__device__ __forceinline__ att::Blk mla_blk(int bh, int qb) {
    const int b = bh >> 3, h = bh & 7; att::Blk k;
    k.qo = (unsigned)(WS_QA + ((size_t)b * SEQ * 1536 + h * 192) * 2); k.ko = (unsigned)(WS_KF + ((size_t)b * SEQ * 1536 + h * 192) * 2);
    k.vo = (unsigned)(WS_VB + ((size_t)b * SEQ * 1024 + h * 128) * 2); k.oo = (unsigned)(WS_OA + ((size_t)b * SEQ * 1024 + h * 128) * 2); k.lo = 0;
    k.P0 = qb * 256; k.rate = 1; k.beta = 0.f;
    return k;
}
__device__ __forceinline__ att::Blk dil_blk(int bh, int br, int blk) {
    const int b = bh >> 3, h = bh & 7, rate = br == 0 ? 1 : br == 1 ? 4 : 16, nqb = 32 / rate, cls = blk / nqb, qb = blk % nqb; att::Blk k;
    const size_t tok0 = (size_t)b * SEQ + cls;
    const unsigned p = (unsigned)(WS_PROJ + (tok0 * PROJ_LD + h * 128) * 2);
    k.qo = p + C_QB * 2; k.ko = p + C_KB * 2; k.vo = p + C_VB * 2;
    k.oo = (unsigned)(WS_OB + (((size_t)br * T + tok0) * 1024 + h * 128) * 2);
    k.lo = (unsigned)(WS_LSE + (((size_t)br * T + tok0) * 8 + h) * 4);
    k.P0 = qb * 256; k.rate = rate;
    const float slope = __builtin_amdgcn_exp2f(-(float)(h + 1));
    k.beta = slope * (float)rate * 11.313708498984761f;
    return k;
}
__device__ __forceinline__ void mla_decode(int id, int& bh, int& qb0, int& qb1) {
    const int v = id & 255, i = id >> 8, x = v >> 5, c = v & 31, j = i * 32 + c; bh = 4 * x + (j >> 4); const int s = j & 15; qb0 = s; qb1 = 31 - s;
}
__device__ __forceinline__ void dil_decode(int id, int& bh, int& br, int& blk) {
    const int v = id & 255, i = id >> 8, x = v >> 5, c = v & 31, j = i * 32 + c; bh = 4 * x + j / 96; const int r = j % 96; br = r >> 5; blk = r & 31;
}
#ifndef ATT_DIL_NS
#define ATT_DIL_NS 4
#endif
#ifndef ATT_SKEW_SEL
#define ATT_SKEW_SEL 0
#endif
#if ATT_SKEW_SEL == 0
#define ATT_SKEW_PICK(w) ((w) < 4)
#elif ATT_SKEW_SEL == 1
#define ATT_SKEW_PICK(w) (((w) & 1) == 0)
#elif ATT_SKEW_SEL == 2
#define ATT_SKEW_PICK(w) true
#else
#define ATT_SKEW_PICK(w) false
#endif
#ifdef ATT_DMA
#define ATT_SEAM(d) att::SeamD<d>
#define ATT_DMA_ON ATT_DMA
#else
#define ATT_SEAM(d) att::Seam<d>
#define ATT_DMA_ON 0
#endif
#if ATT_DMA_ON == 2
template <int ORD>
__device__ __forceinline__ void mla_stream2(Frame& F, char* lds) {
    constexpr int NIT = 512;
    int id = F.vcu;
    if (id < NIT) {
        att::SeamD<192> S; int bh, q0, q1; mla_decode(id, bh, q0, q1); int pass = 0;
        att::Blk cur = mla_blk(bh, q0);
        att::att_prime_dma2<192, false>(cur, (const char*)F.ws, lds, S, F.tid);
        for (;;) {
            const bool more_pass = pass == 0, more_item = id + F.G < NIT, last = !more_pass && !more_item;
            att::Blk nxt = cur; int idn = id, passn = pass + 1;
            if (more_pass) nxt = mla_blk(bh, q1);
            else if (more_item) { idn = id + F.G; passn = 0; mla_decode(idn, bh, q0, q1); nxt = mla_blk(bh, q0); }
            att::att_block_dma2<192, false, false, ORD>(cur, nxt, (const char*)F.ws, lds, S, F.tid);
            if (last) break;
            cur = nxt; id = idn; pass = passn;
        }
    }
}
template <int ORD>
__device__ __forceinline__ void dil_stream2(Frame& F, char* lds) {
    constexpr int NIT = 3072;
    int id = F.vcu;
    if (id < NIT) {
        att::SeamD<128> S; int bh, br, blk; dil_decode(id, bh, br, blk);
        att::Blk cur = dil_blk(bh, br, blk);
        att::att_prime_dma2<128, true>(cur, (const char*)F.ws, lds, S, F.tid);
        for (;;) {
            const bool last = id + F.G >= NIT;
            att::Blk nxt = cur;
            if (!last) { dil_decode(id + F.G, bh, br, blk); nxt = dil_blk(bh, br, blk); }
            att::att_block_dma2<128, true, true, ORD>(cur, nxt, (const char*)F.ws, lds, S, F.tid);
            if (last) break;
            cur = nxt; id += F.G;
        }
    }
}
#endif
template <int PV>
__device__ __forceinline__ void dil_stream_reg(Frame& F, char* lds, int rep_, const Args& A, int l, int cvj0) {
        constexpr int NIT = 3072;
        int id = F.vcu;
        if (id < NIT) {
#if ATT_DMA_ON == 1
            att::SeamD<128> S;
#else
            att::Seam<128> S;
#endif
            S.cv_j = cvj0;
            int bh, br, blk; dil_decode(id, bh, br, blk);
            att::Blk cur = dil_blk(bh, br, blk);
#if defined(ATT_CONV) && ATT_CONV == 2
            const size_t eo_ = (size_t)l * NEXP * DM * DEXP;
            const att::ConvCtx X = {A.in[I_EG] + eo_, A.in[I_EU] + eo_, A.in[I_ED] + eo_, F.ws + WS_W13, F.ws + WS_W2, F.vcu * 8 + __builtin_amdgcn_readfirstlane(F.tid >> 6)};
#endif
#if ATT_DMA_ON == 1
            att::att_prime_dma<128, true, ATT_DIL_NS>(cur, (const char*)F.ws, lds, S, F.tid);
#else
            att::att_prime<128, true, PV>(cur, (const char*)F.ws, lds, S, F.tid);
#endif
            for (;;) {
                const bool last = id + F.G >= NIT;
                att::Blk nxt = cur;
                if (!last) { dil_decode(id + F.G, bh, br, blk); nxt = dil_blk(bh, br, blk); }
#if ATT_DMA_ON == 1
                att::att_block_dma<128, true, true, ATT_DIL_NS>(cur, nxt, (const char*)F.ws, lds, lds + RING_BYTES + 512, S, F.tid);
#else
#if defined(ATT_CONV) && ATT_CONV == 2
                att::att_block<128, true, true, PV, 2>(cur, nxt, (const char*)F.ws, lds, S, F.tid, &X);
#else
                att::att_block<128, true, true, PV>(cur, nxt, (const char*)F.ws, lds, S, F.tid);
#endif
#endif
                if (last) break;
                cur = nxt; id += F.G;
            }
#if defined(ATT_CONV) && ATT_CONV == 2
            { const int ln_ = lane_id(); char* scr_ = lds + att::CONV_SCR_DIL + __builtin_amdgcn_readfirstlane(F.tid >> 6) * 4352;
              if (S.cv_pend) { asm volatile("s_waitcnt vmcnt(0)" ::: "memory"); att::conv_put_full(X, S.cv_j, S.cvf, scr_, ln_); ++S.cv_j; if (S.cv_pend > 1) { att::conv_put_full(X, S.cv_j, S.cvf + 16, scr_, ln_); ++S.cv_j; } S.cv_pend = 0; }
              while (S.cv_j < att::CONV_NJ) { att::conv_load_full(X, S.cv_j, S.cvf, ln_); asm volatile("s_waitcnt vmcnt(0)" ::: "memory"); att::conv_put_full(X, S.cv_j, S.cvf, scr_, ln_); ++S.cv_j; } }
#endif
#if defined(ATT_DEFER) && ATT_DMA_ON != 1
            if (S.p_on) { const int ln_ = F.tid & 63; const char* stg_ = lds + att::DEFER_STG + __builtin_amdgcn_readfirstlane(F.tid >> 6) * 8192;
#pragma unroll
                for (int p = 0; p < 8; ++p) att::flush_piece(stg_, p, (const char*)F.ws + S.p_oo, S.p_rb, S.p_so0, ln_); }
#endif
        }
}
static_assert(WS_ROPE == att::ROPE_OFF, "rope table offset");
#ifdef ATT_QROPE
#define ATT_ROPE_FLAG true
#else
#define ATT_ROPE_FLAG false
#endif
__device__ __forceinline__ void phase_attention(Frame& F, char* lds, const Args& A, int l) {
#ifdef ATT_PRIO
    if (__builtin_amdgcn_readfirstlane(F.tid >> 6) >= 4) __builtin_amdgcn_s_setprio(1);
#endif
#ifndef ATT_MLA_SKCONV
#define ATT_MLA_SKCONV 0
#endif
    int cvj_ = 0;
#ifndef NO_MLA
#ifndef PROBE_REP_MLA
#define PROBE_REP_MLA 1
#endif
    for (int rep_ = 0; rep_ < PROBE_REP_MLA; ++rep_) {
        if (rep_) __syncthreads();
#if ATT_DMA_ON == 2
        { const int wsel_ = __builtin_amdgcn_readfirstlane(F.tid >> 6);
          if (ATT_SKEW_PICK(wsel_)) mla_stream2<0>(F, lds); else mla_stream2<1>(F, lds); }
#else
        constexpr int NIT = 512;
        int id = F.vcu;
        if (id < NIT) {
            ATT_SEAM(192) S; int bh, q0, q1; mla_decode(id, bh, q0, q1); int pass = 0;
            att::Blk cur = mla_blk(bh, q0);
#if defined(ATT_CONV) && (ATT_CONV == 1 || defined(ATT_MLA_SK))
            const size_t eo_ = (size_t)l * NEXP * DM * DEXP;
            const att::ConvCtx X = {A.in[I_EG] + eo_, A.in[I_EU] + eo_, A.in[I_ED] + eo_, F.ws + WS_W13, F.ws + WS_W2, F.vcu * 8 + __builtin_amdgcn_readfirstlane(F.tid >> 6)};
#endif
#if ATT_DMA_ON
            att::att_prime_dma<192, false, 3>(cur, (const char*)F.ws, lds, S, F.tid);
#else
#ifdef ATT_QROPE
            att::att_prime<192, false, 0, true>(cur, (const char*)F.ws, lds, S, F.tid);
#else
            att::att_prime<192, false>(cur, (const char*)F.ws, lds, S, F.tid);
#endif
#endif
            for (;;) {
                const bool more_pass = pass == 0, more_item = id + F.G < NIT, last = !more_pass && !more_item;
                att::Blk nxt = cur; int idn = id, passn = pass + 1;
                if (more_pass) nxt = mla_blk(bh, q1);
                else if (more_item) { idn = id + F.G; passn = 0; mla_decode(idn, bh, q0, q1); nxt = mla_blk(bh, q0); }
#if ATT_DMA_ON
                att::att_block_dma<192, false, false, 3>(cur, nxt, (const char*)F.ws, lds, lds + 3 * att::SHM_V + 3 * att::Cfg<192>::SHM_K, S, F.tid);
#else
#if defined(ATT_CONV) && ATT_CONV == 1
                att::att_block<192, false, false, 0, 1, ATT_ROPE_FLAG>(cur, nxt, (const char*)F.ws, lds, S, F.tid, &X);
#elif defined(ATT_MLA_SK)
                att::att_block<192, false, true, 0, ATT_MLA_SKCONV, ATT_ROPE_FLAG>(cur, nxt, (const char*)F.ws, lds, S, F.tid, &X);
#elif defined(ATT_QROPE)
                att::att_block<192, false, false, 0, 0, true>(cur, nxt, (const char*)F.ws, lds, S, F.tid);
#else
                att::att_block<192, false, false>(cur, nxt, (const char*)F.ws, lds, S, F.tid);
#endif
#endif
                if (last) break;
                cur = nxt; id = idn; pass = passn;
            }
#ifdef ATT_MLA_SK
            { const int ln_ = lane_id(); char* scr_ = lds + att::CONV_SCR + __builtin_amdgcn_readfirstlane(F.tid >> 6) * 4352;
              if (S.cv_pend) { asm volatile("s_waitcnt vmcnt(0)" ::: "memory"); att::conv_put_full(X, S.cv_j, S.cvf, scr_, ln_); ++S.cv_j; if (S.cv_pend > 1) { att::conv_put_full(X, S.cv_j, S.cvf + 16, scr_, ln_); ++S.cv_j; } S.cv_pend = 0; }
              cvj_ = S.cv_j; }
#endif
#if defined(ATT_CONV) && ATT_CONV == 1
            { const int ln_ = lane_id(); char* scr_ = lds + att::CONV_SCR + __builtin_amdgcn_readfirstlane(F.tid >> 6) * 4352;
              while (S.cv_j < att::CONV_NJ) { att::conv_load(X, S.cv_j, S.cv_q, S.cv, ln_); asm volatile("s_waitcnt vmcnt(0)" ::: "memory");
                  att::conv_put(X, S.cv_j, S.cv_q, S.cv, scr_, ln_); if (++S.cv_q == 4) { S.cv_q = 0; ++S.cv_j; } S.cl_j = S.cv_j; S.cl_q = S.cv_q; } }
#endif
        }
#endif
    }
#endif
#ifndef NO_DIL
#ifndef PROBE_REP_DIL
#define PROBE_REP_DIL 1
#endif
#ifndef PROBE_DIL_VAR
#define PROBE_DIL_VAR 0
#endif
#if ATT_DMA_ON == 2 && !defined(ATT_DIL_DMA2)
    asm volatile("s_waitcnt vmcnt(0)" ::: "memory"); __syncthreads();
#endif
    for (int rep_ = 0; rep_ < PROBE_REP_DIL; ++rep_) {
        if (rep_) __syncthreads();
#if ATT_DMA_ON == 2 && defined(ATT_DIL_DMA2)
        { const int wsel_ = __builtin_amdgcn_readfirstlane(F.tid >> 6);
          if (ATT_SKEW_PICK(wsel_)) dil_stream2<0>(F, lds); else dil_stream2<1>(F, lds); }
#else
        if (rep_ + 1 < PROBE_REP_DIL) dil_stream_reg<PROBE_DIL_VAR>(F, lds, rep_, A, l, cvj_); else dil_stream_reg<0>(F, lds, rep_, A, l, cvj_);
#endif
    }
#endif
#ifdef ATT_PRIO
    __builtin_amdgcn_s_setprio(0);
#endif
}
#ifndef MK_PER_PHASE
#define MK_PER_PHASE 0
#endif
constexpr int NPH = 2 + 11 * DEPTH;
__global__ void __launch_bounds__(NWAVES * 64, 2) mk_fwd(Args args) {
    extern __shared__ __attribute__((aligned(16))) unsigned char lds[];
    Frame F;
    F.lds = (LAS unsigned char*)lds; F.ldsg = lds;
    F.wave = __builtin_amdgcn_readfirstlane((int)threadIdx.x >> 6); F.lane = lane_id(); F.tid = F.wave * 64 + F.lane;
    F.G = gridDim.x; { const int bx = blockIdx.x; F.vcu = (F.G % 8 == 0) ? (bx % 8) * (F.G / 8) + bx / 8 : bx; }
    F.ws = args.ws; F.ctl = (unsigned*)(args.ws + WS_CTL);
    for (int u = F.tid; u < (LDS_BYTES - RING_BYTES) / 4; u += NWAVES * 64) ((LAS unsigned*)(F.lds + RING_BYTES))[u] = 0u;
    __syncthreads();
    volatile LAS unsigned* MISC = (volatile LAS unsigned*)(F.lds + L_MISC);
    XcdBarrier bar; bar.bar = F.ctl + CW_BAR; bar.x = 0; bar.st = nullptr;
    if (!MK_PER_PHASE) bar = xcd_barrier_post(F.ctl + CW_BAR, MISC + 8, F.tid);
    const int lo = args.ph_lo, hi = args.ph_hi;
#ifndef PROBE_GRID1_PHASE
#define PROBE_GRID1_PHASE (-1)
#endif
#define PROBE_GRID1(p) ((p) == PROBE_GRID1_PHASE)
#ifndef PROBE_MODE
#define PROBE_MODE 1
#endif
#ifndef PROBE_REP_MASK
#define PROBE_REP_MASK 0
#endif
#define NREP(j) ((((PROBE_REP_MASK) >> (j)) & 1) ? 2 : 1)
#ifndef PROBE_XIN
#define PROBE_XIN 0
#endif
#ifndef PH_MASK
#define PH_MASK 0x1FFF
#endif
#define IN(k) (lo <= (k) && (k) < hi)
#define MSK(j) (((PH_MASK) >> (j)) & 1)
#define FRESH(Fp) Frame Fp = F; { int l_ = lane_id(); int z_ = 0; asm volatile("" : "+v"(l_), "+s"(z_)); Fp.lane = l_; Fp.wave = F.wave + z_; Fp.tid = Fp.wave * 64 + l_; Fp.vcu = F.vcu + z_; Fp.ws = F.ws + z_; Fp.ctl = (unsigned*)(Fp.ws + WS_CTL); }
#define SEAM(k) do { if (IN(k) && IN((k) + 1)) xcd_barrier(bar, F.wave * 64 + lane_id()); } while (0)

    if (MSK(11) && IN(0)) { FRESH(P); phase_prologue(P, args);
#ifdef PROBE_REPEAT_PROLOGUE
        __syncthreads(); phase_prologue(P, args);
#endif
    }
    SEAM(0);
    for (int l = 0; l < DEPTH; ++l) {
        const int pb = 1 + 11 * l;
        const float* mod = (const float*)(F.ws + WS_MOD);
        if (MSK(0) && IN(pb + 0)) { for (int rep_ = 0; rep_ < (l == 0 ? NREP(0) : 1); ++rep_) { if (rep_) __syncthreads(); FRESH(P); phase_norm1(P, args, l); } }
        SEAM(pb + 0);
        if (MSK(1) && IN(pb + 1)) { for (int rep_ = 0; rep_ < NREP(1); ++rep_) { if (rep_) __syncthreads(); FRESH(P);
            pg8::Gemm g{(const bf16*)(P.ws + WS_H), (const bf16*)(P.ws + WS_WIN) + (size_t)l * 4096 * DM, DM * 2};
            pg8::StaticOrder S; S.init(T, PROJ_LD, P.G, (int)blockIdx.x);
            pg8::EpiPlain E{(bf16*)(P.ws + WS_PROJ), PROJ_LD};
            pg8::gemm_phase<pg8::EpiPlain, pg8::StaticOrder, pg8::ALinear>(P.lds, g, S, pg8::ALinear{}, E, P.tid);
        } }
        SEAM(pb + 1);
#ifdef PROBE_EXTRA_BARRIERS
        if (IN(pb + 2)) for (int xb_ = 0; xb_ < PROBE_EXTRA_BARRIERS; ++xb_) xcd_barrier(bar, F.wave * 64 + lane_id());
#endif
        if (MSK(2) && IN(pb + 2)) { for (int rep_ = 0; rep_ < NREP(2); ++rep_) { if (rep_) __syncthreads(); FRESH(P); phase_mla_prep(P, args); } }
        SEAM(pb + 2);
        if (MSK(3) && IN(pb + 3)) { for (int rep_ = 0; rep_ < NREP(3); ++rep_) { if (rep_) __syncthreads(); FRESH(P);
#ifdef PROBE_SWAP_UP
            { pg8::Gemm g{(const bf16*)(P.ws + WS_PROJ) + C_CKV, (const bf16*)(P.ws + WS_WUKV) + (size_t)l * 2048 * 256, 256 * 2};
              pg8::StaticOrder S; S.init(T, 2048, P.G, (int)blockIdx.x);
              pg8::EpiKVup E{(bf16*)(P.ws + WS_KF), (bf16*)(P.ws + WS_VB), (const float*)(P.ws + WS_RSTDKV)};
              pg8::gemm_phase<pg8::EpiKVup, pg8::StaticOrder, pg8::APitch>(P.lds, g, S, pg8::APitch{PROJ_LD * 2}, E, P.tid); }
            { pg8::Gemm g{(const bf16*)(P.ws + WS_PROJ) + C_CQ, (const bf16*)(P.ws + WS_WUQ) + (size_t)l * 1536 * 512, 512 * 2};
              pg8::StaticOrder S; S.init(T, 1536, P.G, (int)blockIdx.x);
              pg8::EpiQup E{(bf16*)(P.ws + WS_QA), (const float*)(P.ws + WS_RSTDQ)};
#ifdef PROBE_QUP_PLAIN
              { pg8::EpiPlain E2{(bf16*)(P.ws + WS_QA), 1536}; pg8::gemm_phase<pg8::EpiPlain, pg8::StaticOrder, pg8::APitch>(P.lds, g, S, pg8::APitch{PROJ_LD * 2}, E2, P.tid); }
#else
              pg8::gemm_phase<pg8::EpiQup, pg8::StaticOrder, pg8::APitch>(P.lds, g, S, pg8::APitch{PROJ_LD * 2}, E, P.tid);
#endif
            }
#else
            { pg8::Gemm g{(const bf16*)(P.ws + WS_PROJ) + C_CQ, (const bf16*)(P.ws + WS_WUQ) + (size_t)l * 1536 * 512, 512 * 2};
              pg8::StaticOrder S; S.init(T, 1536, P.G, (int)blockIdx.x);
              pg8::EpiQup E{(bf16*)(P.ws + WS_QA), (const float*)(P.ws + WS_RSTDQ)};
#ifdef PROBE_QUP_PLAIN
              { pg8::EpiPlain E2{(bf16*)(P.ws + WS_QA), 1536}; pg8::gemm_phase<pg8::EpiPlain, pg8::StaticOrder, pg8::APitch>(P.lds, g, S, pg8::APitch{PROJ_LD * 2}, E2, P.tid); }
#else
              pg8::gemm_phase<pg8::EpiQup, pg8::StaticOrder, pg8::APitch>(P.lds, g, S, pg8::APitch{PROJ_LD * 2}, E, P.tid);
#endif
            }
            { pg8::Gemm g{(const bf16*)(P.ws + WS_PROJ) + C_CKV, (const bf16*)(P.ws + WS_WUKV) + (size_t)l * 2048 * 256, 256 * 2};
              pg8::StaticOrder S; S.init(T, 2048, P.G, (int)blockIdx.x);
              pg8::EpiKVup E{(bf16*)(P.ws + WS_KF), (bf16*)(P.ws + WS_VB), (const float*)(P.ws + WS_RSTDKV)};
              pg8::gemm_phase<pg8::EpiKVup, pg8::StaticOrder, pg8::APitch>(P.lds, g, S, pg8::APitch{PROJ_LD * 2}, E, P.tid); }
#endif
        } }
        SEAM(pb + 3);
#ifndef ATT_QROPE
        if (MSK(4) && IN(pb + 4)) { FRESH(P); phase_q_rope(P, args); }
        SEAM(pb + 4);
#endif
        if (MSK(5) && IN(pb + 5)) { FRESH(P); phase_attention(P, (char*)lds, args, l);
#ifdef PROBE_REPEAT_ATT
            __syncthreads(); phase_attention(P, (char*)lds, args, l);
#endif
        }
        SEAM(pb + 5);
        if (MSK(6) && IN(pb + 6)) { for (int rep_ = 0; rep_ < NREP(6); ++rep_) { if (rep_) __syncthreads(); FRESH(P); phase_out_norm(P, args, l); } }
        SEAM(pb + 6);
        if (MSK(7) && IN(pb + 7)) { FRESH(P);
#ifdef G3_FP8
            pg8::Gemm g{P.ws + WS_H, P.ws + WS_WOUT + (size_t)l * DM * DM, DM};
            pg8::StaticOrder S; S.init(T, DM, P.G, (int)blockIdx.x);
#ifdef XRES_BF16
            pg8::EpiResidB E{l == 0 ? (const void*)args.in[I_X] : (const void*)(P.ws + WS_XB), (bf16*)(P.ws + WS_XB), mod + (size_t)l * 4 * 12288 + 2 * DM, 12288, 1.0f / 256.0f, l == 0 ? 1 : 0};
            pg8::gemm_phase<pg8::EpiResidB, pg8::StaticOrder, pg8::ALinear, true>(P.lds, g, S, pg8::ALinear{}, E, P.tid);
#else
            pg8::EpiResid E{l == 0 ? args.in[I_X] : args.out, args.out, mod + (size_t)l * 4 * 12288 + 2 * DM, DM, 12288, 1.0f / 256.0f};
            pg8::gemm_phase<pg8::EpiResid, pg8::StaticOrder, pg8::ALinear, true>(P.lds, g, S, pg8::ALinear{}, E, P.tid);
#endif
#elif defined(XRES_BF16)
            pg8::Gemm g{(const bf16*)(P.ws + WS_H), (const bf16*)(P.ws + WS_WOUT) + (size_t)l * DM * DM, DM * 2};
            pg8::StaticOrder S; S.init(T, DM, P.G, (int)blockIdx.x);
            pg8::EpiResidB E{l == 0 ? (const void*)args.in[I_X] : (const void*)(P.ws + WS_XB), (bf16*)(P.ws + WS_XB), mod + (size_t)l * 4 * 12288 + 2 * DM, 12288, 1.0f, l == 0 ? 1 : 0};
            pg8::gemm_phase<pg8::EpiResidB, pg8::StaticOrder, pg8::ALinear>(P.lds, g, S, pg8::ALinear{}, E, P.tid);
#else
            pg8::Gemm g{(const bf16*)(P.ws + WS_H), (const bf16*)(P.ws + WS_WOUT) + (size_t)l * DM * DM, DM * 2};
            pg8::StaticOrder S; S.init(T, DM, P.G, (int)blockIdx.x);
            pg8::EpiResid E{l == 0 ? args.in[I_X] : args.out, args.out, mod + (size_t)l * 4 * 12288 + 2 * DM, DM, 12288, 1.0f};
            pg8::gemm_phase<pg8::EpiResid, pg8::StaticOrder, pg8::ALinear>(P.lds, g, S, pg8::ALinear{}, E, P.tid);
#endif
        }
        SEAM(pb + 7);
        if (MSK(8) && IN(pb + 8)) { FRESH(P); phase_router(P, args, l);
#ifdef PROBE_REPEAT_ROUTER
            __syncthreads(); phase_router(P, args, l, 1);
#endif
        }
        SEAM(pb + 8);
        if (MSK(9) && IN(pb + 9)) { for (int rep_ = 0; rep_ < NREP(9); ++rep_) { if (rep_) __syncthreads(); FRESH(P);
            const int NT = moe_setup(P, l);
            pg8::MoeOrder S{NT, 8, P.G, (int)blockIdx.x, (const LAS int*)(P.lds + L_TS)};
            LAS unsigned* atab = (LAS unsigned*)(P.lds + L_ATAB); const int* rowidx = (const int*)(P.ws + WS_ROWIDX);
#pragma unroll 1
            for (int slot = 0; slot < MAXU; ++slot) { pg8::Unit u; if (!S.next(slot, u)) break;
                if (P.tid < 256) { const int lr = u.lt * 256 + P.tid; const int ce = (int)P.ctl[CW_CNT + l * 16 + u.e];
                    int tok = lr < ce ? (rowidx[(size_t)u.e * 32768 + lr] >> 1) : 0;
#ifdef PROBE_LINEAR_ATAB
                    tok = (int)(((unsigned)(u.pm * 256 + P.tid) * 2654435761u) >> 17) & 32767;
#endif
 atab[slot * 256 + P.tid] = (unsigned)tok * (unsigned)DM; } }
            __syncthreads();
            pg8::Gemm g{P.ws + WS_H, P.ws + WS_W13, DM};
            pg8::EpiSwiglu E{P.ws + WS_HMID, DEXP};
            pg8::gemm_phase<pg8::EpiSwiglu, pg8::MoeOrder, pg8::ATable, true>(P.lds, g, S, pg8::ATable{atab}, E, P.tid);
        } }
        SEAM(pb + 9);
        if (MSK(10) && IN(pb + 10)) { for (int rep_ = 0; rep_ < NREP(10); ++rep_) { if (rep_) __syncthreads(); FRESH(P);
            const int NT = moe_setup(P, l);
            pg8::MoeOrder S{NT, 8, P.G, (int)blockIdx.x, (const LAS int*)(P.lds + L_TS)};
            pg8::Gemm g{P.ws + WS_HMID, P.ws + WS_W2, DEXP};
            pg8::EpiMoeDown E{(bf16*)(P.ws + WS_Y), (const int*)(P.ws + WS_ROWIDX), (const float*)(P.ws + WS_AW), P.ctl + CW_CNT + l * 16};
            pg8::gemm_phase<pg8::EpiMoeDown, pg8::MoeOrder, pg8::ALinear, true>(P.lds, g, S, pg8::ALinear{}, E, P.tid);
        } }
        SEAM(pb + 10);
    }
    #ifdef PROBE_DUMP_OFF
    if (MSK(12) && IN(NPH - 1)) { FRESH(P); phase_dump(P, args, (size_t)(PROBE_DUMP_OFF), PROBE_DUMP_PITCH); }
#else
    if (MSK(12) && IN(NPH - 1)) { FRESH(P); phase_final(P, args, args.li != 0 ? (PROBE_XIN ? 2 : PROBE_MODE) : 0);
#ifdef PROBE_EXACT
        { const int gw = P.vcu * NWAVES + P.wave, NGW = P.G * NWAVES; __syncthreads();
          for (int ch = gw; ch < T / 16; ch += NGW) for (int rr = 0; rr < 16; ++rr) for (int j = 0; j < 8; ++j) { float* p = args.out + (size_t)(ch * 16 + rr) * DM + 4 * P.lane + 256 * j; asm volatile("s_waitcnt vmcnt(0)" ::: "memory");
              const v4u ub = *(const v4u*)p; *(f32x4*)p = (f32x4){(float)(ub.x & 0xFFFu), (float)(ub.y & 0xFFFu), (float)(ub.z & 0xFFFu), (float)(ub.w & 0xFFFu)}; } }
#endif
    }
#endif
#undef IN
#undef SEAM
}

extern "C" void kernel_launch(void* const* d_in, const int* in_sizes, int n_in, void* d_out, int out_size, void* d_ws, size_t ws_size, hipStream_t stream) {
    static int grid = 0;
    if (grid == 0) {
        if (n_in != 20 || in_sizes[0] != T * DM || out_size != T * DM || ws_size < WS_END) {
            fprintf(stderr, "kernel_launch: unexpected problem (n_in %d, in0 %d, out %d, ws %zu < %zu)\n", n_in, n_in > 0 ? in_sizes[0] : -1, out_size, ws_size, (size_t)WS_END); grid = -1; return; }
        int dev = 0, cus = 0;
        if (hipGetDevice(&dev) != hipSuccess || hipDeviceGetAttribute(&cus, hipDeviceAttributeMultiprocessorCount, dev) != hipSuccess) { grid = -1; return; }
        if (hipFuncSetAttribute((const void*)mk_fwd, hipFuncAttributeMaxDynamicSharedMemorySize, LDS_BYTES) != hipSuccess) { fprintf(stderr, "kernel_launch: hipFuncSetAttribute failed\n"); grid = -1; return; }
        int per_cu = 0;
        if (hipOccupancyMaxActiveBlocksPerMultiprocessor(&per_cu, (const void*)mk_fwd, NWAVES * 64, LDS_BYTES) != hipSuccess || per_cu < 1) fprintf(stderr, "kernel_launch: occupancy query says %d blocks per CU\n", per_cu);
        (void)hipGetLastError();
        grid = cus;
        if (grid != 256) fprintf(stderr, "kernel_launch: %d CUs (built for 256)\n", grid);
    }
    if (grid < 0) return;
    if (hipMemsetAsync((char*)d_ws + WS_CTL, 0, CTL_ZERO_BYTES, stream) != hipSuccess) return;
    Args a; memset(&a, 0, sizeof(a));
    for (int i = 0; i < 20; ++i) a.in[i] = (const float*)d_in[i];
    a.out = (float*)d_out; a.ws = (unsigned char*)d_ws;
    for (int i = 0; i < 32; ++i) a.invf[i] = (float)pow(10000.0, -(double)i / 32.0);
#if MK_PER_PHASE
#ifndef PROBE_LAST
#define PROBE_LAST (NPH - 2)
#endif
    for (int p = 0; p < NPH; ++p) { if (p > PROBE_LAST && p != NPH - 1) continue;
#ifdef PROBE_ONLY_MASK
        if (p != NPH - 1 && !((PROBE_ONLY_MASK >> p) & 1)) continue;
#endif
 a.ph_lo = p; a.ph_hi = p + 1; a.li = (PROBE_LAST != NPH - 2) ? 1 : 0; hipLaunchKernelGGL(mk_fwd, dim3(PROBE_GRID1(p) ? 1 : grid), dim3(NWAVES * 64), LDS_BYTES, stream, a); }
#else
    a.ph_lo = 0; a.ph_hi = NPH; a.li = 0;
    hipLaunchKernelGGL(mk_fwd, dim3(grid), dim3(NWAVES * 64), LDS_BYTES, stream, a);
#endif
    const hipError_t le = hipPeekAtLastError();
    if (le != hipSuccess) fprintf(stderr, "kernel_launch: launch failed: %s\n", hipGetErrorName(le));
}
```

```cpp
#define MK_PER_PHASE 0
#define XRES_BF16 1
#define G3_FP8 1
#define ATT_QROPE 1
#define ST16_IMM 1
#define ROUTER_MFMA 1
#define ATT_CONV 2
#define ATT_SLOAD_RECOMP 1
#define ATT_RAWBAR 1
#define ATT_MLA_SK 1
#define THIN_MLP 1
#define CONV_LAST_STEP 1
#define THIN_RO 4
#define RPA 4
#include <hip/hip_runtime.h>
#include <cstdio>
#include <cstdint>
#include <cstring>
#include <cmath>
namespace pg8 {
#define PG8_LAS __attribute__((address_space(3)))
typedef unsigned short bf16_t;
typedef short bf16x8 __attribute__((ext_vector_type(8)));
typedef float f32x4 __attribute__((ext_vector_type(4)));
typedef float f32x2 __attribute__((ext_vector_type(2)));
typedef unsigned u32x4 __attribute__((ext_vector_type(4)));
typedef int v4i_t __attribute__((ext_vector_type(4)));
typedef int v8i_t __attribute__((ext_vector_type(8)));
constexpr int BM = 256, BK = 64, HALF = 128, HTB = HALF * BK * 2  , STAGE_BYTES = 8 * HTB, NXCD = 8, WGM = 8;

__host__ __device__ __forceinline__ int lds_byte(int r, int c) { const int st = (r >> 4) * 2 + (c >> 5), rr = r & 15, cc = c & 31, ob = rr * 64 + cc * 2; return st * 1024 + (ob ^ (((ob >> 9) & 1) << 5)); }
__host__ __device__ __forceinline__ void stage_rc(int b, int& R, int& C) { const int st = b / 1024, sb = b % 1024, swz = sb ^ (((sb >> 9) & 1) << 5); R = (st >> 1) * 16 + swz / 64; C = (st & 1) * 32 + (swz % 64) / 2; }
__host__ __device__ __forceinline__ int perm32(int rho) { const int n = rho >> 4, i = rho & 15; return 8 * (i >> 2) + 4 * n + (i & 3); }

struct Unit { int pm, pn, pb, e, lt; };
struct Gemm { const void* A; const void* Bt; int Kb; };

__device__ __forceinline__ bool order_tile(int i, int G, int c, int nM, int nN, int& pm, int& pn) {
    const int nwg = nM * nN; const long L = (long)i * G + c; if (L >= nwg) return false;
    int wgid = (int)L; { const int q = nwg / NXCD, r = nwg % NXCD, xcd = wgid % NXCD, off = wgid / NXCD; wgid = (xcd < r ? xcd * (q + 1) : r * (q + 1) + (xcd - r) * q) + off; }
    const int nig = WGM * nN, gid = wgid / nig, fm = gid * WGM, gsz = (nM - fm) < WGM ? (nM - fm) : WGM;
    pm = fm + ((wgid % nig) % gsz); pn = (wgid % nig) / gsz; return true;
}
struct StaticOrder {
    int nM, nN, G, c;
    __device__ __forceinline__ void init(int M, int N, int G_, int c_) { nM = M / BM; nN = N / BM; G = G_; c = c_; }
    __device__ __forceinline__ bool next(int i, Unit& u) const { int pm, pn; if (!order_tile(i, G, c, nM, nN, pm, pn)) return false; u.pm = pm; u.pn = pn; u.pb = pn; u.e = 0; u.lt = 0; return true; }
};
struct MoeOrder {
    int nM, nN, G, c; const PG8_LAS int* ts;
    __device__ __forceinline__ bool next(int i, Unit& u) const {
        int pm, pn; if (i >= 10 || !order_tile(i, G, c, nM, nN, pm, pn)) return false;
        int e = 0;
#pragma unroll
        for (int j = 1; j < 16; ++j) e += (__builtin_amdgcn_readfirstlane(ts[j]) <= pm) ? 1 : 0;
        e = __builtin_amdgcn_readfirstlane(e); u.pm = pm; u.pn = pn; u.e = e; u.lt = pm - __builtin_amdgcn_readfirstlane(ts[e]); u.pb = e * nN + pn; return true;
    }
};
struct ALinear { __device__ __forceinline__ unsigned off(const Unit& u, int slot, int r, int Kb) const { return (unsigned)(u.pm * BM + r) * (unsigned)Kb; } };
struct APitch  { unsigned pitchB; __device__ __forceinline__ unsigned off(const Unit& u, int slot, int r, int K) const { return (unsigned)(u.pm * BM + r) * pitchB; } };
struct ATable  { const PG8_LAS unsigned* tab; __device__ __forceinline__ unsigned off(const Unit& u, int slot, int r, int K) const { return tab[slot * BM + r]; } };

typedef __bf16 bf16x2_t __attribute__((ext_vector_type(2)));
__device__ __forceinline__ unsigned cvt_pk_bf16(float lo, float hi) { const f32x2 v = {lo, hi}; return __builtin_bit_cast(unsigned, __builtin_convertvector(v, bf16x2_t)); }

typedef f32x4 Acc[2][2][4][2];

typedef __amdgpu_buffer_rsrc_t rsrc_t;
#define PG8_RSRC(p) __builtin_amdgcn_make_buffer_rsrc((void*)(p), 0, 0x7fffffff, 0x00020000)
#ifdef ST16_IMM
__device__ __forceinline__ void st16(rsrc_t r, int vo, int so, u32x4 v) { __builtin_amdgcn_raw_buffer_store_b128(v, r, vo + so, 0, 0); }
#else
__device__ __forceinline__ void st16(rsrc_t r, int vo, int so, u32x4 v) { __builtin_amdgcn_raw_buffer_store_b128(v, r, vo, so, 0); }
#endif
__device__ __forceinline__ f32x4 ld16f(rsrc_t r, int vo, int so) { return __builtin_bit_cast(f32x4, __builtin_amdgcn_raw_buffer_load_b128(r, vo, so, 0)); }
__device__ __forceinline__ float ld4f(rsrc_t r, int vo, int so) { return __uint_as_float(__builtin_amdgcn_raw_buffer_load_b32(r, vo, so, 0)); }
__device__ __forceinline__ u32x4 pack8(const f32x4 v0, const f32x4 v1) { u32x4 w; w.x = cvt_pk_bf16(v0[0], v0[1]); w.y = cvt_pk_bf16(v0[2], v0[3]); w.z = cvt_pk_bf16(v1[0], v1[1]); w.w = cvt_pk_bf16(v1[2], v1[3]); return w; }
struct EpiPlain {
    static constexpr bool PERM = true;
    bf16_t* O; int ldc;
    __device__ __forceinline__ void operator()(const Acc& acc, const Unit& u, int wr, int wc, int fr, int fq) const {
        const rsrc_t ro = PG8_RSRC(O); const int vo = (fr * ldc + wc * 32 + 8 * fq) * 2;
#pragma unroll
        for (int ai = 0; ai < 2; ++ai)
#pragma unroll
            for (int m = 0; m < 4; ++m) { const int so = ((u.pm * BM + wr * 64 + ai * HALF + m * 16) * ldc + u.pn * BM) * 2;
#pragma unroll
                for (int bj = 0; bj < 2; ++bj) st16(ro, vo, so + bj * HALF * 2, pack8(acc[ai][bj][m][0], acc[ai][bj][m][1])); }
    }
};
struct EpiQup {
    static constexpr bool PERM = true;
    bf16_t* O; const float* rstd;
    __device__ __forceinline__ void operator()(const Acc& acc, const Unit& u, int wr, int wc, int fr, int fq) const {
        const rsrc_t ro = PG8_RSRC(O), rr = PG8_RSRC(rstd);
        const int vo = (fr * 1536 + wc * 32 + 8 * fq) * 2;
        float rs[2][4];
#pragma unroll
        for (int ai = 0; ai < 2; ++ai)
#pragma unroll
            for (int m = 0; m < 4; ++m) rs[ai][m] = ld4f(rr, fr * 4, (u.pm * BM + wr * 64 + ai * HALF + m * 16) * 4);
#pragma unroll
        for (int ai = 0; ai < 2; ++ai)
#pragma unroll
            for (int m = 0; m < 4; ++m) { const int rowu = u.pm * BM + wr * 64 + ai * HALF + m * 16; const float r1 = rs[ai][m];
                const int so = (rowu * 1536 + u.pn * BM) * 2;
                st16(ro, vo, so, pack8(acc[ai][0][m][0] * r1, acc[ai][0][m][1] * r1));
                st16(ro, vo, so + HALF * 2, pack8(acc[ai][1][m][0] * r1, acc[ai][1][m][1] * r1)); }
    }
};
struct EpiKVup {
    static constexpr bool PERM = true;
    bf16_t* KF; bf16_t* VB; const float* rstd;
    __device__ __forceinline__ void operator()(const Acc& acc, const Unit& u, int wr, int wc, int fr, int fq) const {
        const rsrc_t rk = PG8_RSRC(KF), rv = PG8_RSRC(VB), rr = PG8_RSRC(rstd);
        const int c0 = wc * 32 + 8 * fq, vok = (fr * 1536 + c0) * 2, vov = (fr * 1024 + c0) * 2;
        float rs[2][4];
#pragma unroll
        for (int ai = 0; ai < 2; ++ai)
#pragma unroll
            for (int m = 0; m < 4; ++m) rs[ai][m] = ld4f(rr, fr * 4, (u.pm * BM + wr * 64 + ai * HALF + m * 16) * 4);
#pragma unroll
        for (int ai = 0; ai < 2; ++ai)
#pragma unroll
            for (int m = 0; m < 4; ++m) { const int rowu = u.pm * BM + wr * 64 + ai * HALF + m * 16; const float r1 = rs[ai][m];
                st16(rk, vok, (rowu * 1536 + u.pn * 192) * 2, pack8(acc[ai][0][m][0] * r1, acc[ai][0][m][1] * r1));
                st16(rv, vov, (rowu * 1024 + u.pn * 128) * 2, pack8(acc[ai][1][m][0] * r1, acc[ai][1][m][1] * r1)); }
    }
};
struct EpiResid {
    static constexpr bool PERM = false;
    const float* base; float* out; const float* gate; int ldc; int gld; float ascale;
    __device__ __forceinline__ void operator()(const Acc& acc, const Unit& u, int wr, int wc, int fr, int fq) const {
        const rsrc_t rb = PG8_RSRC(base), ro = PG8_RSRC(out), rg = PG8_RSRC(gate);
        const int cl = (wc * 32 + 4 * fq) * 4, vo = fr * ldc * 4 + cl;
        f32x4 gv[2][2];
#pragma unroll
        for (int bj = 0; bj < 2; ++bj)
#pragma unroll
            for (int n = 0; n < 2; ++n) gv[bj][n] = ld16f(rg, cl, (((u.pm * BM) >> 13) * gld + u.pn * BM + bj * HALF + n * 16) * 4) * ascale;
#pragma unroll
        for (int ai = 0; ai < 2; ++ai) {
            f32x4 bs[4][2][2];
#pragma unroll
            for (int m = 0; m < 4; ++m) { const int so = ((u.pm * BM + ai * HALF + wr * 64 + m * 16) * ldc + u.pn * BM) * 4;
#pragma unroll
                for (int bj = 0; bj < 2; ++bj)
#pragma unroll
                    for (int n = 0; n < 2; ++n) bs[m][bj][n] = ld16f(rb, vo, so + (bj * HALF + n * 16) * 4); }
#pragma unroll
            for (int m = 0; m < 4; ++m) { const int so = ((u.pm * BM + ai * HALF + wr * 64 + m * 16) * ldc + u.pn * BM) * 4;
#pragma unroll
                for (int bj = 0; bj < 2; ++bj)
#pragma unroll
                    for (int n = 0; n < 2; ++n) st16(ro, vo, so + (bj * HALF + n * 16) * 4, __builtin_bit_cast(u32x4, bs[m][bj][n] + gv[bj][n] * acc[ai][bj][m][n])); }
            asm volatile("s_waitcnt vmcnt(0)" ::: "memory");
        }
    }
};
struct EpiResidB {
    static constexpr bool PERM = true;
    const void* base; bf16_t* out; const float* gate; int gld; float ascale; int BASE_F32;
    __device__ __forceinline__ void operator()(const Acc& acc, const Unit& u, int wr, int wc, int fr, int fq) const {
        const rsrc_t rb = PG8_RSRC(base), ro = PG8_RSRC(out), rg = PG8_RSRC(gate);
        const int c0 = wc * 32 + 8 * fq;
        f32x4 gv[2][2];
#pragma unroll
        for (int bj = 0; bj < 2; ++bj)
#pragma unroll
            for (int n = 0; n < 2; ++n) gv[bj][n] = ld16f(rg, (c0 + 4 * n) * 4, (((u.pm * BM) >> 13) * gld + u.pn * BM + bj * HALF) * 4) * ascale;
#pragma unroll
        for (int ai = 0; ai < 2; ++ai) {
            f32x4 bs[4][2][2];
#pragma unroll
            for (int m = 0; m < 4; ++m) { const int rowu = u.pm * BM + ai * HALF + wr * 64 + m * 16;
#pragma unroll
                for (int bj = 0; bj < 2; ++bj) {
                    if (BASE_F32) { const int so = (rowu * 2048 + u.pn * BM + bj * HALF) * 4, vo = (fr * 2048 + c0) * 4;
                        bs[m][bj][0] = ld16f(rb, vo, so); bs[m][bj][1] = ld16f(rb, vo + 16, so); }
                    else { const int so = (rowu * 2048 + u.pn * BM + bj * HALF) * 2, vo = (fr * 2048 + c0) * 2;
                        const u32x4 w = __builtin_bit_cast(u32x4, __builtin_amdgcn_raw_buffer_load_b128(rb, vo, so, 0));
                        bs[m][bj][0] = (f32x4){__uint_as_float(w.x << 16), __uint_as_float(w.x & 0xffff0000u), __uint_as_float(w.y << 16), __uint_as_float(w.y & 0xffff0000u)};
                        bs[m][bj][1] = (f32x4){__uint_as_float(w.z << 16), __uint_as_float(w.z & 0xffff0000u), __uint_as_float(w.w << 16), __uint_as_float(w.w & 0xffff0000u)}; } } }
#pragma unroll
            for (int m = 0; m < 4; ++m) { const int rowu = u.pm * BM + ai * HALF + wr * 64 + m * 16;
#pragma unroll
                for (int bj = 0; bj < 2; ++bj) st16(ro, (fr * 2048 + c0) * 2, (rowu * 2048 + u.pn * BM + bj * HALF) * 2,
                                                    pack8(bs[m][bj][0] + gv[bj][0] * acc[ai][bj][m][0], bs[m][bj][1] + gv[bj][1] * acc[ai][bj][m][1])); }
            asm volatile("s_waitcnt vmcnt(0)" ::: "memory");
        }
    }
};
struct EpiSwiglu {
    static constexpr bool PERM = true;
    unsigned char* O; int ldc;
    __device__ __forceinline__ void operator()(const Acc& acc, const Unit& u, int wr, int wc, int fr, int fq) const {
        const rsrc_t ro = PG8_RSRC(O); const int vo = fr * ldc + wc * 32 + 8 * fq;
#pragma unroll
        for (int ai = 0; ai < 2; ++ai)
#pragma unroll
            for (int m = 0; m < 4; ++m) { const int so = (u.pm * BM + wr * 64 + ai * HALF + m * 16) * ldc + u.pn * HALF; float r[8];
#pragma unroll
                for (int n = 0; n < 2; ++n)
#pragma unroll
                    for (int k = 0; k < 4; ++k) { const float g = acc[ai][0][m][n][k] * (1.0f / 256.0f), up = acc[ai][1][m][n][k] * (1.0f / 256.0f);
                        r[n * 4 + k] = g * __builtin_amdgcn_rcpf(1.0f + __builtin_amdgcn_exp2f(-1.4426950408889634f * g)) * up; }
                int w0 = 0, w1 = 0;
                w0 = __builtin_amdgcn_cvt_pk_fp8_f32(r[0], r[1], w0, false); w0 = __builtin_amdgcn_cvt_pk_fp8_f32(r[2], r[3], w0, true);
                w1 = __builtin_amdgcn_cvt_pk_fp8_f32(r[4], r[5], w1, false); w1 = __builtin_amdgcn_cvt_pk_fp8_f32(r[6], r[7], w1, true);
                typedef unsigned u32x2_t __attribute__((ext_vector_type(2)));
                __builtin_amdgcn_raw_buffer_store_b64((u32x2_t){(unsigned)w0, (unsigned)w1}, ro, vo, so, 0); }
    }
};
struct EpiMoeDown {
    static constexpr bool PERM = true;
    bf16_t* Y; const int* rowidx; const float* aw; const unsigned* cnt;
    __device__ __forceinline__ void operator()(const Acc& acc, const Unit& u, int wr, int wc, int fr, int fq) const {
        const rsrc_t ry = PG8_RSRC(Y), ri = PG8_RSRC(rowidx), ra = PG8_RSRC(aw);
        const int nvalid = (int)cnt[u.e] - u.lt * BM; const int cb = (u.pn * BM + wc * 32 + 8 * fq) * 2;
        int idx[2][4]; float w8[2][4];
#pragma unroll
        for (int ai = 0; ai < 2; ++ai)
#pragma unroll
            for (int m = 0; m < 4; ++m) { const int ru = ai * HALF + wr * 64 + m * 16; idx[ai][m] = -1; w8[ai][m] = 0.f;
                if (ru + fr < nvalid) { idx[ai][m] = (int)__builtin_amdgcn_raw_buffer_load_b32(ri, fr * 4, (u.e * 32768 + u.lt * BM + ru) * 4, 0); w8[ai][m] = ld4f(ra, idx[ai][m] * 4, 0); } }
#pragma unroll
        for (int ai = 0; ai < 2; ++ai)
#pragma unroll
            for (int m = 0; m < 4; ++m) if (idx[ai][m] >= 0) { const int vo = idx[ai][m] * 4096 + cb; const float w1 = w8[ai][m] * (1.0f / 256.0f);
#pragma unroll
                for (int bj = 0; bj < 2; ++bj) st16(ry, vo, bj * HALF * 2, pack8(acc[ai][bj][m][0] * w1, acc[ai][bj][m][1] * w1)); }
    }
};

template <class Epi, class Sched, class AOff, bool FP8 = false>
__device__ __forceinline__ void gemm_phase(PG8_LAS unsigned char* lds, const Gemm g, const Sched& S, const AOff& AO, const Epi& E, int tid_in) {
    int tid = tid_in; asm volatile("" : "+v"(tid));
    const int wid = __builtin_amdgcn_readfirstlane(tid >> 6), lane = tid & 63, wr = wid >> 2, wc = wid & 3, fr = lane & 15, fq = lane >> 4;
    int K = g.Kb; asm volatile("" : "+s"(K));
    const int nt = K / (BK * 2);
    int Ra[2], Ca[2]; unsigned voffB[2];
#pragma unroll
    for (int i = 0; i < 2; ++i) { int R, C; stage_rc(tid * 16 + i * 8192, R, C); const int Rb = Epi::PERM ? ((R & ~31) + perm32(R & 31)) : R;
        Ra[i] = R; Ca[i] = C * 2; voffB[i] = (unsigned)(Rb * K + C * 2); }
    const size_t kstep = (size_t)(BK * 2);
    const size_t hstep = (size_t)HALF * K;
    const size_t tstep = 2 * hstep;
    const unsigned ldsw = (unsigned)wid * 1024u;
    const unsigned lds0 = (unsigned)(uintptr_t)lds;
    const int aoff = lds_byte(wr * 64 + fr, fq * 8), boff = lds_byte(wc * 32 + fr, fq * 8);
#define PG8_SA(b, h) (((b) * 2 + (h)) * HTB)
#define PG8_SB(b, h) ((4 + (b) * 2 + (h)) * HTB)
#define PG8_STAGE(bufoff, gbase, voff) do { _Pragma("unroll") for (int _i = 0; _i < 2; ++_i) { unsigned keep_; \
        asm volatile("s_mov_b32 %0, m0\n\ts_mov_b32 m0, %2\n\ts_nop 0\n\tglobal_load_lds_dwordx4 %1, %3\n\ts_mov_b32 m0, %0" : "=&s"(keep_) \
            : "v"((voff)[_i]), "s"((unsigned)__builtin_amdgcn_readfirstlane((int)(lds0 + (bufoff) + ldsw + _i * 8192))), "s"((const void*)(gbase)) : "memory"); } } while (0)
#define PG8_LD8(addr) __builtin_shufflevector(*(const PG8_LAS v4i_t*)(addr), *(const PG8_LAS v4i_t*)((addr) + 1024), 0, 1, 2, 3, 4, 5, 6, 7)
#define PG8_LDA(dst, b, h) do { _Pragma("unroll") for (int m = 0; m < 4; ++m) dst[m] = PG8_LD8(lds + PG8_SA(b, h) + aoff + m * 2048); } while (0)
#define PG8_LDB(dst, b, h) do { _Pragma("unroll") for (int n = 0; n < 2; ++n) dst[n] = PG8_LD8(lds + PG8_SB(b, h) + boff + n * 2048); } while (0)
#define PG8_HALF(x, k) __builtin_bit_cast(bf16x8, __builtin_shufflevector(x, x, 4 * (k), 4 * (k) + 1, 4 * (k) + 2, 4 * (k) + 3))
#define PG8_MMA(ai, bj, At, Bt) do { __builtin_amdgcn_s_setprio(1); _Pragma("unroll") for (int m = 0; m < 4; ++m) _Pragma("unroll") for (int n = 0; n < 2; ++n) { \
        if constexpr (FP8) asm volatile("v_mfma_scale_f32_16x16x128_f8f6f4 %0, %1, %2, %0, %3, %3 op_sel_hi:[0,0,0]" : "+v"(acc[ai][bj][m][n]) : "v"(Bt[n]), "v"(At[m]), "v"(sc1_));   \
        else { acc[ai][bj][m][n] = __builtin_amdgcn_mfma_f32_16x16x32_bf16(PG8_HALF(Bt[n], 0), PG8_HALF(At[m], 0), acc[ai][bj][m][n], 0, 0, 0); \
               acc[ai][bj][m][n] = __builtin_amdgcn_mfma_f32_16x16x32_bf16(PG8_HALF(Bt[n], 1), PG8_HALF(At[m], 1), acc[ai][bj][m][n], 0, 0, 0); } } \
        __builtin_amdgcn_s_setprio(0); } while (0)
#define PG8_WAIT_V(n) asm volatile("s_waitcnt vmcnt(" #n ")" ::: "memory")
#define PG8_WAIT_L(n) asm volatile("s_waitcnt lgkmcnt(" #n ")" ::: "memory")
#define PG8_BAR __builtin_amdgcn_s_barrier()
#define PG8_SCHED __builtin_amdgcn_sched_barrier(0)
#define PG8_AOFF(dst, u, slot) do { _Pragma("unroll") for (int _h = 0; _h < 2; ++_h) _Pragma("unroll") for (int _i = 0; _i < 2; ++_i) dst[_h][_i] = AO.off(u, slot, _h * HALF + Ra[_i], K) + (unsigned)Ca[_i]; } while (0)
    Unit cur, nxt; int ui = 0;
    if (!S.next(0, cur)) return;
    Acc acc;
#pragma unroll
    for (int a = 0; a < 2; ++a)
#pragma unroll
        for (int b = 0; b < 2; ++b)
#pragma unroll
            for (int m = 0; m < 4; ++m)
#pragma unroll
                for (int n = 0; n < 2; ++n) acc[a][b][m][n] = (f32x4){0.f, 0.f, 0.f, 0.f};
    v8i_t At[4], B0[2], B1[2];
    int sc1_ = 0x7F7F7F7F; asm volatile("" : "+v"(sc1_));
    unsigned aoC[2][2];
    PG8_AOFF(aoC, cur, 0);
    const char* gA = (const char*)g.A; const char* gB = (const char*)g.Bt;
    asm volatile("" : "+s"(gA), "+s"(gB));
    const char* cB = gB + (size_t)cur.pb * tstep;
    PG8_STAGE(PG8_SB(0, 0), cB, voffB); PG8_STAGE(PG8_SB(0, 1), cB + hstep, voffB); PG8_STAGE(PG8_SA(0, 0), gA, aoC[0]); PG8_STAGE(PG8_SA(0, 1), gA, aoC[1]);
    if (wr == 1) PG8_BAR;
    PG8_WAIT_V(2); PG8_BAR;
    PG8_STAGE(PG8_SB(1, 0), cB + kstep, voffB); PG8_STAGE(PG8_SA(1, 0), gA + kstep, aoC[0]); PG8_STAGE(PG8_SB(1, 1), cB + hstep + kstep, voffB);
    PG8_WAIT_V(6); PG8_BAR;
    for (;;) {
        const bool has_next = S.next(ui + 1, nxt);
        const char* nB = has_next ? gB + (size_t)nxt.pb * tstep : cB;
        for (int t = 0; t < nt; t += 2) {
            const bool last = (t == nt - 2);
            const char* a1 = gA + (size_t)(t + 1) * kstep;
            const char* a2 = last ? gA : gA + (size_t)(t + 2) * kstep; const char* b2 = last ? nB : cB + (size_t)(t + 2) * kstep;
            const char* a3 = a2 + kstep; const char* b3 = b2 + kstep;
            unsigned ao2[2][2];
            if (last && has_next) { PG8_AOFF(ao2, nxt, ui + 1); }
            else {
#pragma unroll
                for (int _h = 0; _h < 2; ++_h)
#pragma unroll
                    for (int _i = 0; _i < 2; ++_i) ao2[_h][_i] = aoC[_h][_i]; }
            PG8_LDB(B0, 0, 0); PG8_LDB(B1, 0, 1); PG8_SCHED; PG8_LDA(At, 0, 0); PG8_STAGE(PG8_SA(1, 1), a1, aoC[1]);
            PG8_WAIT_V(8); PG8_WAIT_L(0); PG8_BAR; PG8_MMA(0, 0, At, B0); PG8_MMA(0, 1, At, B1); PG8_BAR; PG8_SCHED;
            PG8_LDA(At, 0, 1); PG8_STAGE(PG8_SB(0, 0), b2, voffB); PG8_STAGE(PG8_SB(0, 1), b2 + hstep, voffB); PG8_STAGE(PG8_SA(0, 0), a2, ao2[0]);
            PG8_WAIT_V(8); PG8_WAIT_L(0); PG8_BAR; PG8_MMA(1, 0, At, B0); PG8_MMA(1, 1, At, B1); PG8_BAR; PG8_SCHED;
            PG8_LDB(B0, 1, 0); PG8_LDB(B1, 1, 1); PG8_SCHED; PG8_LDA(At, 1, 0); PG8_STAGE(PG8_SA(0, 1), a2, ao2[1]);
            PG8_WAIT_V(8); PG8_WAIT_L(0); PG8_BAR; PG8_MMA(0, 0, At, B0); PG8_MMA(0, 1, At, B1); PG8_BAR; PG8_SCHED;
            PG8_LDA(At, 1, 1); PG8_STAGE(PG8_SB(1, 0), b3, voffB); PG8_STAGE(PG8_SB(1, 1), b3 + hstep, voffB); PG8_STAGE(PG8_SA(1, 0), a3, ao2[0]);
            PG8_WAIT_V(8); PG8_WAIT_L(0); PG8_BAR; PG8_MMA(1, 0, At, B0); PG8_MMA(1, 1, At, B1); PG8_BAR; PG8_SCHED;
        }
        if (wr == 0) PG8_BAR;
        E(acc, cur, wr, wc, fr, fq);
        if (!has_next) break;
#pragma unroll
        for (int a = 0; a < 2; ++a)
#pragma unroll
            for (int b = 0; b < 2; ++b)
#pragma unroll
                for (int m = 0; m < 4; ++m)
#pragma unroll
                    for (int n = 0; n < 2; ++n) acc[a][b][m][n] = (f32x4){0.f, 0.f, 0.f, 0.f};
        cur = nxt; cB = nB; ++ui;
        PG8_AOFF(aoC, cur, ui);
        if (wr == 1) PG8_BAR;
    }
    PG8_WAIT_V(0);
    PG8_BAR;
#undef PG8_SA
#undef PG8_SB
#undef PG8_STAGE
#undef PG8_LDA
#undef PG8_LDB
#undef PG8_MMA
#undef PG8_LD8
#undef PG8_HALF
#undef PG8_WAIT_V
#undef PG8_WAIT_L
#undef PG8_BAR
#undef PG8_SCHED
#undef PG8_AOFF
}
}
namespace att {
typedef unsigned short bf16;
typedef short bf16x8 __attribute__((ext_vector_type(8)));
typedef short s16x4 __attribute__((ext_vector_type(4)));
typedef float f32x16 __attribute__((ext_vector_type(16)));
typedef float f32x4 __attribute__((ext_vector_type(4)));
typedef unsigned u32x4 __attribute__((ext_vector_type(4)));
constexpr int NW = 8, QBLK = 32, KVBLK = 64, QB = NW * QBLK, DV = 128;
constexpr float THR = 8.f;
constexpr int SHM_V = KVBLK * DV * 2;
template <int DQK> struct Cfg { static constexpr int NKC = DQK / 8, KCH = NKC / 8, KPITCH = DQK * 2, SHM_K = KVBLK * KPITCH, NQF = DQK / 16, LDS_BYTES = 2 * SHM_V + 2 * SHM_K + NW * 64 * 4; };
#define SBAR() __builtin_amdgcn_sched_barrier(0)
__device__ __forceinline__ int v_st(int k, int c) { const int kk = (k & ~0xC) | ((k & 4) << 1) | ((k & 8) >> 1); return ((kk >> 3) * 4 + (c >> 5)) * 512 + ((kk & 7) * 32 + (c & 31)) * 2; }
__device__ __forceinline__ int v_rd_base(int lane) { return ((lane & 3) << 3) | (((lane >> 2) & 3) << 6) | (((lane >> 4) & 1) << 5) | (((lane >> 5) & 1) << 8); }
constexpr int v_rd_off(int d0, int ks, int half) { return d0 * 512 + ks * 4096 + half * 2048; }
__device__ __forceinline__ int crow(int r, int hi) { return (r & 3) + 8 * (r >> 2) + 4 * hi; }
__device__ __forceinline__ unsigned cvtpk(float lo, float hi) { return pg8::cvt_pk_bf16(lo, hi); }
__device__ __forceinline__ bf16x8 load8(const bf16* p) { return *reinterpret_cast<const bf16x8*>(p); }
__device__ __forceinline__ void mask_tile(f32x16& p0, f32x16& p1, int dq, unsigned W) {
    const float NEG = -__builtin_inff();
#pragma unroll
    for (int r = 0; r < 16; ++r) { const int c = (r & 3) + 8 * (r >> 2);
        if ((unsigned)(dq - c) >= W) p0[r] = NEG;
        if ((unsigned)(dq - c - 32) >= W) p1[r] = NEG; }
}
__device__ __forceinline__ void partialSM(f32x16& p0, f32x16& p1, float& m_reg, float& mn, float& alpha, float scale) {
    float pmax = p0[0];
#pragma unroll
    for (int r = 1; r < 16; ++r) pmax = fmaxf(pmax, p0[r]);
#pragma unroll
    for (int r = 0; r < 16; ++r) pmax = fmaxf(pmax, p1[r]);
    { auto rr = __builtin_amdgcn_permlane32_swap(__float_as_uint(pmax), __float_as_uint(pmax), false, false);
      pmax = fmaxf(__uint_as_float(rr[0]), __uint_as_float(rr[1])); }
    const float C2 = 1.4426950408889634f * scale;
    if (__builtin_expect(__all((pmax - m_reg) * scale <= THR), 1)) { mn = m_reg; alpha = 1.f; }
    else { mn = fmaxf(m_reg, pmax); alpha = __builtin_amdgcn_exp2f((m_reg - mn) * C2); m_reg = mn; }
    const float mnL = -mn * C2;
#pragma unroll
    for (int r = 0; r < 16; ++r) p0[r] = fmaf(p0[r], C2, mnL);
#pragma unroll
    for (int r = 0; r < 16; ++r) p1[r] = fmaf(p1[r], C2, mnL);
#pragma unroll
    for (int r = 0; r < 16; ++r) p0[r] = __builtin_amdgcn_exp2f(p0[r]);
}
__device__ __forceinline__ void finishSM(f32x16& p0, f32x16& p1, float alpha, float& l_reg, bf16x8& pa0, bf16x8& pa1, bf16x8& pa2, bf16x8& pa3) {
#pragma unroll
    for (int r = 0; r < 16; ++r) p1[r] = __builtin_amdgcn_exp2f(p1[r]);
    float ps = 0;
#pragma unroll
    for (int r = 0; r < 16; ++r) ps += p0[r];
#pragma unroll
    for (int r = 0; r < 16; ++r) ps += p1[r];
    { auto rr = __builtin_amdgcn_permlane32_swap(__float_as_uint(ps), __float_as_uint(ps), false, false);
      ps = __uint_as_float(rr[0]) + __uint_as_float(rr[1]); }
    l_reg = l_reg * alpha + ps;
#define PK4(P, B_, OUT) do { unsigned a0 = cvtpk(P[B_+0], P[B_+1]), a1 = cvtpk(P[B_+2], P[B_+3]);                          \
        unsigned b0 = cvtpk(P[B_+4], P[B_+5]), b1 = cvtpk(P[B_+6], P[B_+7]);                                             \
        auto r0 = __builtin_amdgcn_permlane32_swap(a0, b0, false, false); auto r1 = __builtin_amdgcn_permlane32_swap(a1, b1, false, false); \
        u32x4 w = {r0[0], r1[0], r0[1], r1[1]}; OUT = *reinterpret_cast<bf16x8*>(&w); } while (0)
    PK4(p0, 0, pa0); PK4(p0, 8, pa1); PK4(p1, 0, pa2); PK4(p1, 8, pa3);
#undef PK4
}
template <int KB, bool SK, int DQK, bool DIL>
__device__ __forceinline__ void qkt(f32x16& p0, f32x16& p1, const char* K_lds, int r32, int hi, const bf16x8* qr, bool act, float beta, int dq) {
    typedef Cfg<DQK> C;
    if (SK && !act) { const float NEG = -__builtin_inff();
#pragma unroll
        for (int r = 0; r < 16; ++r) { p0[r] = NEG; p1[r] = NEG; } return; }
    if constexpr (DIL) { const float b0 = -beta * (float)dq;
#pragma unroll
        for (int r = 0; r < 16; ++r) { const int c = (r & 3) + 8 * (r >> 2); p0[r] = fmaf(beta, (float)c, b0); p1[r] = fmaf(beta, (float)(c + 32), b0); } }
    else { p0 = f32x16{}; p1 = f32x16{}; }
    const char* kb[4];
#pragma unroll
    for (int dd = 0; dd < 4; ++dd) { const int colB = (dd * 16 + hi * 8) * 2; kb[dd] = K_lds + KB * C::SHM_K + r32 * C::KPITCH + (colB ^ ((r32 & 7) << 4)); }
#pragma unroll
    for (int d0 = 0; d0 < C::NQF; ++d0) { const char* a = kb[d0 & 3] + (d0 >> 2) * 128;
        bf16x8 b0 = *reinterpret_cast<const bf16x8*>(a);
        bf16x8 b1 = *reinterpret_cast<const bf16x8*>(a + 32 * C::KPITCH);
        p0 = __builtin_amdgcn_mfma_f32_32x32x16_bf16(b0, qr[d0], p0, 0, 0, 0);
        p1 = __builtin_amdgcn_mfma_f32_32x32x16_bf16(b1, qr[d0], p1, 0, 0, 0);
#ifndef ATT_NO_QKT_SBAR
        if ((d0 & 3) == 3) SBAR();
#endif
    }
}
#ifdef ATT_PV_PIPE
template <int VB, bool SK>
__device__ __forceinline__ void pv_tile(f32x16* o, int vb0, bf16x8 pa0, bf16x8 pa1, bf16x8 pa2, bf16x8 pa3, bool act) {
    if (SK && !act) return;
#define TRRD(dst, off) asm volatile("ds_read_b64_tr_b16 %0, %1 offset:%2" : "=&v"(dst) : "v"(vb0), "i"(off) : "memory")
#define PV_RD(S_, d0) do { constexpr int b_ = VB * SHM_V + v_rd_off(d0, 0, 0); \
        TRRD(S_##l0, b_); TRRD(S_##h0, b_ + 2048); TRRD(S_##l1, b_ + 4096); TRRD(S_##h1, b_ + 6144); TRRD(S_##l2, b_ + 8192); TRRD(S_##h2, b_ + 10240); TRRD(S_##l3, b_ + 12288); TRRD(S_##h3, b_ + 14336); } while (0)
#define PV_MM(S_, d0) do { \
        o[d0] = __builtin_amdgcn_mfma_f32_32x32x16_bf16(pa0, (bf16x8){S_##l0[0], S_##l0[1], S_##l0[2], S_##l0[3], S_##h0[0], S_##h0[1], S_##h0[2], S_##h0[3]}, o[d0], 0, 0, 0);   \
        o[d0] = __builtin_amdgcn_mfma_f32_32x32x16_bf16(pa1, (bf16x8){S_##l1[0], S_##l1[1], S_##l1[2], S_##l1[3], S_##h1[0], S_##h1[1], S_##h1[2], S_##h1[3]}, o[d0], 0, 0, 0);   \
        o[d0] = __builtin_amdgcn_mfma_f32_32x32x16_bf16(pa2, (bf16x8){S_##l2[0], S_##l2[1], S_##l2[2], S_##l2[3], S_##h2[0], S_##h2[1], S_##h2[2], S_##h2[3]}, o[d0], 0, 0, 0);   \
        o[d0] = __builtin_amdgcn_mfma_f32_32x32x16_bf16(pa3, (bf16x8){S_##l3[0], S_##l3[1], S_##l3[2], S_##l3[3], S_##h3[0], S_##h3[1], S_##h3[2], S_##h3[3]}, o[d0], 0, 0, 0); } while (0)
#define PV_W8() do { asm volatile("s_waitcnt lgkmcnt(8)" ::: "memory"); SBAR(); } while (0)
#define PV_W0() do { asm volatile("s_waitcnt lgkmcnt(0)" ::: "memory"); SBAR(); } while (0)
    s16x4 al0, al1, al2, al3, ah0, ah1, ah2, ah3, bl0, bl1, bl2, bl3, bh0, bh1, bh2, bh3;
    PV_RD(a, 0); PV_RD(b, 1); PV_W8(); PV_MM(a, 0); SBAR();
    PV_RD(a, 2); PV_W8(); PV_MM(b, 1); SBAR();
    PV_RD(b, 3); PV_W8(); PV_MM(a, 2); SBAR();
    PV_W0(); PV_MM(b, 3);
#undef PV_RD
#undef PV_MM
#undef PV_W8
#undef PV_W0
#undef TRRD
}
#else
template <int VB, bool SK>
__device__ __forceinline__ void pv_tile(f32x16* o, int vb0, bf16x8 pa0, bf16x8 pa1, bf16x8 pa2, bf16x8 pa3, bool act) {
    if (SK && !act) return;
#define TRRD(dst, off) asm volatile("ds_read_b64_tr_b16 %0, %1 offset:%2" : "=&v"(dst) : "v"(vb0), "i"(off) : "memory")
#define PV_D0(d0) do { s16x4 l0, l1, l2, l3, h0, h1, h2, h3; constexpr int b_ = VB * SHM_V + v_rd_off(d0, 0, 0); \
        TRRD(l0, b_); TRRD(h0, b_ + 2048); TRRD(l1, b_ + 4096); TRRD(h1, b_ + 6144); TRRD(l2, b_ + 8192); TRRD(h2, b_ + 10240); TRRD(l3, b_ + 12288); TRRD(h3, b_ + 14336); \
        asm volatile("s_waitcnt lgkmcnt(0)" ::: "memory"); SBAR();   \
        o[d0] = __builtin_amdgcn_mfma_f32_32x32x16_bf16(pa0, (bf16x8){l0[0], l0[1], l0[2], l0[3], h0[0], h0[1], h0[2], h0[3]}, o[d0], 0, 0, 0);   \
        o[d0] = __builtin_amdgcn_mfma_f32_32x32x16_bf16(pa1, (bf16x8){l1[0], l1[1], l1[2], l1[3], h1[0], h1[1], h1[2], h1[3]}, o[d0], 0, 0, 0);   \
        o[d0] = __builtin_amdgcn_mfma_f32_32x32x16_bf16(pa2, (bf16x8){l2[0], l2[1], l2[2], l2[3], h2[0], h2[1], h2[2], h2[3]}, o[d0], 0, 0, 0);   \
        o[d0] = __builtin_amdgcn_mfma_f32_32x32x16_bf16(pa3, (bf16x8){l3[0], l3[1], l3[2], l3[3], h3[0], h3[1], h3[2], h3[3]}, o[d0], 0, 0, 0); } while (0)
    PV_D0(0); PV_D0(1); PV_D0(2); PV_D0(3);
#undef PV_D0
#undef TRRD
}
#endif

struct Blk { unsigned qo, ko, vo, oo, lo; int P0, rate; float beta; };
constexpr int PVAR = 0;
#define QS_(B) (DIL ? ((PVAR & 4) ? 128 : (B).rate * 4096) : 1536)
#define KS_(B) (DIL ? ((PVAR & 2) ? 128 : (B).rate * 4096) : 1536)
#define VS_(B) (DIL ? ((PVAR & 2) ? 128 : (B).rate * 4096) : 1024)
#define OS_(B) (DIL ? (B).rate * 1024 : 1024)
#define LS_(B) ((B).rate * 8)
#define SKV_(B) (DIL ? 8192 / (B).rate : 8192)
#define W_(B) (DIL ? 129 : (1 << 30))
#define SCALE_ (DIL ? 0.08838834764831845f : 0.07216878364870322f)
template <int DQK> struct Seam { bf16x8 qr[Cfg<DQK>::NQF]; bf16x8 st_v0, st_v1; bf16x8 st_k[Cfg<DQK>::KCH]; unsigned p_oo = 0; int p_rb = 0, p_so0 = 0, p_on = 0; float cv[4], cw[4]; int cv_j = 0, cv_q = 0, cl_j = 0, cl_q = 0; f32x4 rt[8]; float cvf[32]; int cv_pend = 0; };
__device__ __forceinline__ int swa_jlo(int P0, int W) { const int lowk = P0 - W + 1; return lowk > 0 ? lowk / KVBLK : 0; }

#define VMW() asm volatile("s_waitcnt vmcnt(0)" ::: "memory")
#ifdef ATT_RAWBAR
#define A_STEPBAR() do { asm volatile("s_waitcnt lgkmcnt(0)" ::: "memory"); __builtin_amdgcn_s_barrier(); asm volatile("" ::: "memory"); } while (0)
#else
#define A_STEPBAR() __syncthreads()
#endif
#define VMWN(n) asm volatile("s_waitcnt vmcnt(%0)" :: "i"(n) : "memory")
#define A_RSRC(p) __builtin_amdgcn_make_buffer_rsrc((void*)(p), 0, 0x7fffffff, 0x00020000)
#define A_BLD(rs, vo, so) __builtin_bit_cast(bf16x8, __builtin_amdgcn_raw_buffer_load_b128((rs), (int)(vo), (int)(so), 0))
#ifdef ATT_SLOAD_RECOMP
#define A_SLOAD(B_, k0) do { const __amdgpu_buffer_rsrc_t rv_ = A_RSRC(wsb + (B_).vo), rk_ = A_RSRC(wsb + (B_).ko); const int sov_ = (k0) * VS_(B_) * 2, sok_ = (k0) * KS_(B_) * 2; \
        int t_ = tid; asm volatile("" : "+v"(t_)); const int sr_ = t_ >> 4, sc_ = (t_ & 15) * 8; \
        S.st_v0 = A_BLD(rv_, (sr_ * VS_(B_) + sc_) * 2, sov_); S.st_v1 = A_BLD(rv_, ((32 + sr_) * VS_(B_) + sc_) * 2, sov_); \
        _Pragma("unroll") for (int j_ = 0; j_ < C::KCH; ++j_) { const int q_ = t_ + 512 * j_; S.st_k[j_] = A_BLD(rk_, ((q_ / C::NKC) * KS_(B_) + (q_ % C::NKC) * 8) * 2, sok_); } } while (0)
#else
#define A_SLOAD(B_, k0) do { const __amdgpu_buffer_rsrc_t rv_ = A_RSRC(wsb + (B_).vo), rk_ = A_RSRC(wsb + (B_).ko); const int sov_ = (k0) * VS_(B_) * 2, sok_ = (k0) * KS_(B_) * 2; \
        S.st_v0 = A_BLD(rv_, (sr * VS_(B_) + sc) * 2, sov_); S.st_v1 = A_BLD(rv_, ((32 + sr) * VS_(B_) + sc) * 2, sov_); \
        _Pragma("unroll") for (int j_ = 0; j_ < C::KCH; ++j_) S.st_k[j_] = A_BLD(rk_, (krow[j_] * KS_(B_) + kcol[j_]) * 2, sok_); } while (0)
#endif
#define A_QLOAD(B_) do { const __amdgpu_buffer_rsrc_t rq_ = A_RSRC(wsb + (B_).qo); const int soq_ = ((B_).P0 + wid * QBLK) * QS_(B_) * 2; const int qo_ = r32 * QS_(B_) * 2 + hi * 16; \
        _Pragma("unroll") for (int d0 = 0; d0 < C::NQF; ++d0) S.qr[d0] = A_BLD(rq_, qo_ + d0 * 32, soq_); } while (0)
#define A_SWRITE_K(bf) do { _Pragma("unroll") for (int j_ = 0; j_ < C::KCH; ++j_) *(bf16x8*)(K_lds + (bf) * C::SHM_K + kws[j_]) = S.st_k[j_]; } while (0)
#define A_SWRITE_V(bf) do { *(bf16x8*)(V_lds + (bf) * SHM_V + vst0) = S.st_v0; *(bf16x8*)(V_lds + (bf) * SHM_V + vst1) = S.st_v1; } while (0)
#define A_STAGE_IDX() const int sr = tid >> 4, sc = (tid & 15) * 8; int krow[C::KCH], kcol[C::KCH], kws[C::KCH]; \
        _Pragma("unroll") for (int j_ = 0; j_ < C::KCH; ++j_) { const int q_ = tid + 512 * j_; krow[j_] = q_ / C::NKC; kcol[j_] = (q_ % C::NKC) * 8; kws[j_] = krow[j_] * C::KPITCH + ((kcol[j_] * 2) ^ ((krow[j_] & 7) << 4)); }

__device__ __forceinline__ void store_o_staged(const f32x16* o, const float* rli, char* stg, __amdgpu_buffer_rsrc_t ro_, int rowbytes, int so0_, int lane) {
    const int r32 = lane & 31, hi = lane >> 5, odd = lane & 1, g = odd | (hi << 1);
    char* wb = stg + (odd + 4 * hi) * 256 + (r32 >> 1) * 4;
    char* wa[4];
#pragma unroll
    for (int d0 = 0; d0 < 4; ++d0) wa[d0] = wb + ((d0 ^ g) << 6);
    const int lr = lane >> 4, ch = lane & 15, sp = ch >> 2, gl = lr & 1;
    const char* rb_e = stg + lr * 256 + ((sp ^ gl) << 6) + (lane & 3) * 16;
    const char* rb_o = stg + lr * 256 + ((sp ^ (gl | 2)) << 6) + (lane & 3) * 16;
    const int voff = lr * rowbytes + ch * 16;
#pragma unroll
    for (int h = 0; h < 2; ++h) {
#pragma unroll
        for (int rp = 0; rp < 4; ++rp) { const int r = 8 * h + 2 * rp, Rl = (r & 3) + 8 * ((r >> 2) & 1);
#pragma unroll
            for (int d0 = 0; d0 < 4; ++d0) { const float v0 = o[d0][r] * rli[r], v1 = o[d0][r + 1] * rli[r + 1];
                const float send = odd ? v0 : v1;
                const float recv = __int_as_float(__builtin_amdgcn_update_dpp(0, __float_as_int(send), 0xB1, 0xF, 0xF, true));
                *reinterpret_cast<unsigned*>(wa[d0] + Rl * 256) = cvtpk(odd ? recv : v0, odd ? v1 : recv); } }
        u32x4 d_[4];
#pragma unroll
        for (int i = 0; i < 4; ++i) d_[i] = *reinterpret_cast<const u32x4*>(((i & 1) ? rb_o : rb_e) + i * 1024);
#pragma unroll
        for (int i = 0; i < 4; ++i) __builtin_amdgcn_raw_buffer_store_b128(d_[i], ro_, voff + so0_ + (16 * h + 4 * i) * rowbytes, 0, 0);
    }
}
constexpr int DEFER_STG = 65536, DEFER_WS = 131072 + 512;
__device__ __forceinline__ void stage_write(const f32x16* o, const float* rli, char* stg, int lane) {
    const int r32 = lane & 31, hi = lane >> 5, odd = lane & 1, g = odd | (hi << 1);
    char* wb = stg + (odd + 4 * hi) * 256 + (r32 >> 1) * 4;
    char* wa[4];
#pragma unroll
    for (int d0 = 0; d0 < 4; ++d0) wa[d0] = wb + ((d0 ^ g) << 6);
#pragma unroll
    for (int h = 0; h < 2; ++h)
#pragma unroll
        for (int rp = 0; rp < 4; ++rp) { const int r = 8 * h + 2 * rp, Rl = (r & 3) + 8 * ((r >> 2) & 1);
#pragma unroll
            for (int d0 = 0; d0 < 4; ++d0) { const float v0 = o[d0][r] * rli[r], v1 = o[d0][r + 1] * rli[r + 1];
                const float send = odd ? v0 : v1;
                const float recv = __int_as_float(__builtin_amdgcn_update_dpp(0, __float_as_int(send), 0xB1, 0xF, 0xF, true));
                *reinterpret_cast<unsigned*>(wa[d0] + h * 4096 + Rl * 256) = cvtpk(odd ? recv : v0, odd ? v1 : recv); } }
}
__device__ __forceinline__ void flush_piece(const char* stg, int p, const char* obase, int rowbytes, int so0, int lane) {
    const int lr = lane >> 4, ch = lane & 15, sp = ch >> 2, g = (lr & 1) | ((p & 1) << 1);
    const u32x4 d = *reinterpret_cast<const u32x4*>(stg + p * 1024 + lr * 256 + ((sp ^ g) << 6) + (lane & 3) * 16);
    __builtin_amdgcn_raw_buffer_store_b128(d, A_RSRC(obase), lr * rowbytes + ch * 16 + so0 + 4 * p * rowbytes, 0, 0);
}
struct ConvCtx { const float* eg; const float* eu; const float* ed; unsigned char* w13; unsigned char* w2; int gw; };
constexpr int CONV_SCR = 86016, CONV_NJ = 48;
#ifndef CONV_AUX
#define CONV_AUX 2
#endif
struct ConvItem { const float* src; unsigned char* dst; int ldw, kd; };
__device__ __forceinline__ ConvItem conv_decode(const ConvCtx& X, int j) {
    const int q = X.gw + 2048 * j, e = q / 6144, r = q - e * 6144, m = r >> 11, r2 = r & 2047;
    ConvItem I;
    if (m < 2) { const int kb = r2 >> 6, nb = r2 & 63, n0 = nb * 16; I.ldw = 1024; I.kd = 2048;
        I.src = (m == 0 ? X.eg : X.eu) + (size_t)e * (2048 * 1024) + (size_t)kb * (64 * 1024) + n0;
        I.dst = X.w13 + (size_t)e * (2048 * 2048) + (size_t)((n0 >> 7) * 256 + (m == 1 ? 128 : 0) + (n0 & 127)) * 2048 + kb * 64; }
    else { const int kb = r2 >> 7, nb = r2 & 127; I.ldw = 2048; I.kd = 1024;
        I.src = X.ed + (size_t)e * (1024 * 2048) + (size_t)kb * (64 * 2048) + nb * 16;
        I.dst = X.w2 + (size_t)e * (2048 * 1024) + (size_t)(nb * 16) * 1024 + kb * 64; }
    return I;
}
__device__ __forceinline__ void conv_load(const ConvCtx& X, int j, int qd, float* cv, int lane) {
    const ConvItem I = conv_decode(X, j); const __amdgpu_buffer_rsrc_t rs = A_RSRC(I.src);
#pragma unroll
    for (int i = 0; i < 4; ++i) { const int k = 4 * (4 * qd + i) + (lane >> 4);
        cv[i] = __uint_as_float(__builtin_amdgcn_raw_buffer_load_b32(rs, (k * I.ldw + (lane & 15)) * 4, 0, CONV_AUX)); }
}
__device__ __forceinline__ void conv_put(const ConvCtx& X, int j, int qd, const float* cv, char* scr, int lane, bool finish_only = false) {
    float* s = reinterpret_cast<float*>(scr);
    if (!finish_only) {
#pragma unroll
    for (int i = 0; i < 4; ++i) { const int k = 4 * (4 * qd + i) + (lane >> 4); s[k * 17 + (lane & 15)] = cv[i] * 256.0f; } }
    if (qd == 3) {
        const ConvItem I = conv_decode(X, j); const int n = lane & 15, kq = lane >> 4; const float* c = s + (16 * kq) * 17 + n;
        u32x4 w;
        { int w0 = 0, w1 = 0, w2 = 0, w3 = 0;
          w0 = __builtin_amdgcn_cvt_pk_fp8_f32(c[0 * 17], c[1 * 17], w0, false); w0 = __builtin_amdgcn_cvt_pk_fp8_f32(c[2 * 17], c[3 * 17], w0, true);
          w1 = __builtin_amdgcn_cvt_pk_fp8_f32(c[4 * 17], c[5 * 17], w1, false); w1 = __builtin_amdgcn_cvt_pk_fp8_f32(c[6 * 17], c[7 * 17], w1, true);
          w2 = __builtin_amdgcn_cvt_pk_fp8_f32(c[8 * 17], c[9 * 17], w2, false); w2 = __builtin_amdgcn_cvt_pk_fp8_f32(c[10 * 17], c[11 * 17], w2, true);
          w3 = __builtin_amdgcn_cvt_pk_fp8_f32(c[12 * 17], c[13 * 17], w3, false); w3 = __builtin_amdgcn_cvt_pk_fp8_f32(c[14 * 17], c[15 * 17], w3, true);
          w = (u32x4){(unsigned)w0, (unsigned)w1, (unsigned)w2, (unsigned)w3}; }
        __builtin_amdgcn_raw_buffer_store_b128(w, A_RSRC(I.dst), n * I.kd + 16 * kq, 0, CONV_AUX);
    }
}
constexpr unsigned ROPE_OFF = 2u << 20;
#define A_RTLOAD(B_) do { const __amdgpu_buffer_rsrc_t rr_ = A_RSRC(wsb + ROPE_OFF); const int vo_ = ((B_).P0 + wid * QBLK + r32) * 256 + hi * 32; \
        _Pragma("unroll") for (int d_ = 0; d_ < 4; ++d_) { S.rt[2 * d_] = __builtin_bit_cast(f32x4, __builtin_amdgcn_raw_buffer_load_b128(rr_, vo_ + d_ * 64, 0, 0)); \
                                                            S.rt[2 * d_ + 1] = __builtin_bit_cast(f32x4, __builtin_amdgcn_raw_buffer_load_b128(rr_, vo_ + d_ * 64 + 16, 0, 0)); } } while (0)
__device__ __forceinline__ unsigned rope_pair(unsigned w, float c, float s) { const float x1 = __uint_as_float(w << 16), x2 = __uint_as_float(w & 0xffff0000u); return cvtpk(x1 * c - x2 * s, x2 * c + x1 * s); }
#define A_ROTATE() do { _Pragma("unroll") for (int d_ = 0; d_ < 4; ++d_) { u32x4 w_ = __builtin_bit_cast(u32x4, S.qr[8 + d_]); const f32x4 c01_ = S.rt[2 * d_], c23_ = S.rt[2 * d_ + 1]; \
        w_.x = rope_pair(w_.x, c01_[0], c01_[1]); w_.y = rope_pair(w_.y, c01_[2], c01_[3]); w_.z = rope_pair(w_.z, c23_[0], c23_[1]); w_.w = rope_pair(w_.w, c23_[2], c23_[3]); \
        S.qr[8 + d_] = __builtin_bit_cast(bf16x8, w_); } } while (0)
constexpr int CONV_SCR_DIL = 67584;
#ifndef CONV_PER_IDLE
#define CONV_PER_IDLE 1
#endif
#ifndef CONV_LAST_STEP
#define CONV_LAST_STEP 0
#endif
__device__ __forceinline__ void conv_load_full(const ConvCtx& X, int j, float* cv, int lane) {
    const ConvItem I = conv_decode(X, j); const __amdgpu_buffer_rsrc_t rs = A_RSRC(I.src);
#pragma unroll
    for (int i = 0; i < 16; ++i) { const int k = 4 * i + (lane >> 4); cv[i] = __uint_as_float(__builtin_amdgcn_raw_buffer_load_b32(rs, (k * I.ldw + (lane & 15)) * 4, 0, CONV_AUX)); }
}
__device__ __forceinline__ void conv_put_full(const ConvCtx& X, int j, const float* cv, char* scr, int lane) {
    float* s = reinterpret_cast<float*>(scr);
#pragma unroll
    for (int i = 0; i < 16; ++i) { const int k = 4 * i + (lane >> 4); s[k * 17 + (lane & 15)] = cv[i] * 256.0f; }
    float dummy_[4] = {0.f, 0.f, 0.f, 0.f};
    conv_put(X, j, 3, dummy_, scr, lane, true);
}
template <int DQK, bool DIL, int PVAR = 0, bool ROPE = false>
__device__ __forceinline__ void att_prime(const Blk& cur, const char* wsb, char* lds, Seam<DQK>& S, int tid_in) {
    typedef Cfg<DQK> C;
    int tid = tid_in; asm volatile("" : "+v"(tid));
    const int wid = __builtin_amdgcn_readfirstlane(tid >> 6), lane = tid & 63, r32 = lane & 31, hi = lane >> 5;
    A_STAGE_IDX(); char* K_lds = lds + 2 * SHM_V;
    const int kb0 = swa_jlo(cur.P0, W_(cur)) * KVBLK;
    A_QLOAD(cur);
    if constexpr (ROPE) A_RTLOAD(cur);
    A_SLOAD(cur, kb0); VMW(); A_SWRITE_K(0);
    __syncthreads();
}
template <int DQK, bool DIL, bool SK, int PVAR = 0, int CONV = 0, bool ROPE = false>
__device__ __forceinline__ void att_block(const Blk& cur, const Blk& nxt, const char* wsb, char* lds, Seam<DQK>& S, int tid_in, const ConvCtx* X = nullptr) {
    typedef Cfg<DQK> C;
    int tid = tid_in; asm volatile("" : "+v"(tid));
    const int wid = __builtin_amdgcn_readfirstlane(tid >> 6), lane = tid & 63, r32 = lane & 31, hi = lane >> 5;
    const int W = W_(cur); const float scale = SCALE_, beta = cur.beta;
    int j_lo = swa_jlo(cur.P0, W);
    int j_hi = (cur.P0 + QB - 1) / KVBLK + 1; if (j_hi > SKV_(cur) / KVBLK) j_hi = SKV_(cur) / KVBLK;
    if (PVAR & 8) j_lo = j_hi - 2;
    const int NT = j_hi - j_lo;
    const int kbn = swa_jlo(nxt.P0, W_(nxt)) * KVBLK;
    const int qlo = cur.P0 + wid * QBLK, qm = qlo + r32 - 4 * hi;
    char* V_lds = lds; char* K_lds = lds + 2 * SHM_V;
#ifdef ATT_DEFER
    constexpr bool DEFER = DIL;
#else
    constexpr bool DEFER = false;
#endif
    float* ws = (float*)(lds + (DEFER ? DEFER_WS : 2 * SHM_V + 2 * C::SHM_K)) + wid * 64; float* li_l = ws, * al_l = ws + 32;
    char* stg = lds + DEFER_STG + wid * 8192;
    float m_reg = -1e30f, l_reg = 0; f32x16 o[4] = {};
    A_STAGE_IDX();
    const int vst0 = v_st(sr, sc), vst1 = v_st(32 + sr, sc);
    const int vb0 = (int)(uintptr_t)V_lds + v_rd_base(lane);
#define RESC(a) do { if (__any((a) < 1.f)) { if (hi == 0) al_l[r32] = (a); asm volatile("s_waitcnt lgkmcnt(0)" ::: "memory");              \
                     _Pragma("unroll") for (int d_ = 0; d_ < 4; ++d_) _Pragma("unroll") for (int r = 0; r < 16; ++r) o[d_][r] *= al_l[crow(r, hi)]; } } while (0)
#define KBASE(t) ((j_lo + (t)) * KVBLK)
#define ACT(t) (KBASE(t) <= qlo + QBLK - 1 && KBASE(t) + KVBLK - 1 >= qlo - W + 1)
#define MASKT(P0_, P1_, t) do { const int kb_ = KBASE(t); if ((!SK || ACT(t)) && (kb_ + KVBLK - 1 > qlo || kb_ <= qlo + QBLK - 1 - W)) mask_tile(P0_, P1_, qm - kb_, (unsigned)W); } while (0)
    A_SWRITE_V(0);
    __syncthreads();
    if constexpr (ROPE) { VMW(); A_ROTATE(); }
#define STEP(t, BUF) do { const bool more_ = (t) + 1 < NT;                                                                        \
        if (more_) { A_SLOAD(cur, KBASE((t) + 1)); } else { A_SLOAD(nxt, kbn); }                                                   \
        const bool cpend_ = CONV == 1 && (S.cv_j != S.cl_j || S.cv_q != S.cl_q); const bool cld_ = CONV == 1 && more_ && S.cl_j < CONV_NJ;        \
        const bool act_ = !SK || ACT(t); const bool cidle_ = CONV == 2 && (more_ || CONV_LAST_STEP) && !act_ && (S.cv_j < CONV_NJ);                                \
        bool cnew_ = false;                                                                                                    \
        if (cidle_) { if (S.cv_pend) { VMWN(C::KCH + 2);        \
                          conv_put_full(*X, S.cv_j, S.cvf, lds + (DIL ? CONV_SCR_DIL : CONV_SCR) + wid * 4352, lane); ++S.cv_j;                 \
                          if (S.cv_pend > 1) { conv_put_full(*X, S.cv_j, S.cvf + 16, lds + (DIL ? CONV_SCR_DIL : CONV_SCR) + wid * 4352, lane); ++S.cv_j; } S.cv_pend = 0; } \
                      if (S.cv_j < CONV_NJ) { conv_load_full(*X, S.cv_j, S.cvf, lane); S.cv_pend = 1; cnew_ = true;                                \
                          if (CONV_PER_IDLE > 1 && S.cv_j + 1 < CONV_NJ) { conv_load_full(*X, S.cv_j + 1, S.cvf + 16, lane); S.cv_pend = 2; } } }        \
        if (cld_) { conv_load(*X, S.cl_j, S.cl_q, BUF ? S.cw : S.cv, lane); if (++S.cl_q == 4) { S.cl_q = 0; ++S.cl_j; } }               \
        if (DEFER && S.p_on && (t) < 4) { flush_piece(stg, 2 * (t), wsb + S.p_oo, S.p_rb, S.p_so0, lane); flush_piece(stg, 2 * (t) + 1, wsb + S.p_oo, S.p_rb, S.p_so0, lane); } \
        SBAR();                                                                                                                 \
        if (act_) { f32x16 p0, p1; float mn_, al_; bf16x8 pa0, pa1, pa2, pa3;      \
            qkt<BUF, false, DQK, DIL>(p0, p1, K_lds, r32, hi, S.qr, true, beta, qm - KBASE(t)); SBAR();                              \
            MASKT(p0, p1, t); partialSM(p0, p1, m_reg, mn_, al_, scale); finishSM(p0, p1, al_, l_reg, pa0, pa1, pa2, pa3); RESC(al_); SBAR(); \
            pv_tile<BUF, false>(o, vb0, pa0, pa1, pa2, pa3, true); }                                                             \
        if (!more_) { SBAR(); A_QLOAD(nxt); SBAR(); }                                 \
        if (more_) { if (cnew_) { if (S.cv_pend > 1) VMWN(32); else VMWN(16); } else if (cld_) VMWN(4); else VMW();            \
            A_SWRITE_V(1 - BUF); A_SWRITE_K(1 - BUF);                                                                              \
            if (cpend_) { conv_put(*X, S.cv_j, S.cv_q, BUF ? S.cv : S.cw, lds + CONV_SCR + wid * 4352, lane); if (++S.cv_q == 4) { S.cv_q = 0; ++S.cv_j; } } \
        }                                                                                                                       \
        A_STEPBAR(); } while (0)
    int t = 0;
    for (; t + 1 < NT; t += 2) { STEP(t, 0); STEP(t + 1, 1); }
    if (t < NT) { STEP(t, 0); }
    VMWN(C::NQF); A_SWRITE_K(0); SBAR();
    if (CONV == 1 && (S.cv_j != S.cl_j || S.cv_q != S.cl_q)) { conv_put(*X, S.cv_j, S.cv_q, S.cv, lds + CONV_SCR + wid * 4352, lane); if (++S.cv_q == 4) { S.cv_q = 0; ++S.cv_j; } }
    if (hi == 0) li_l[r32] = l_reg; asm volatile("s_waitcnt lgkmcnt(0)" ::: "memory");
    if constexpr (DIL) { if (hi == 0) __builtin_amdgcn_raw_buffer_store_b32(__float_as_uint(m_reg * scale + __logf(l_reg)), A_RSRC(wsb + cur.lo), r32 * LS_(cur) * 4, (cur.P0 + wid * QBLK) * LS_(cur) * 4, 0); }
    float rli[16];
#pragma unroll
    for (int r = 0; r < 16; ++r) rli[r] = __builtin_amdgcn_rcpf(li_l[crow(r, hi)]);
    if constexpr (DEFER) { stage_write(o, rli, stg, lane); S.p_oo = cur.oo; S.p_rb = OS_(cur) * 2; S.p_so0 = (cur.P0 + wid * QBLK) * OS_(cur) * 2; S.p_on = 1; }
    else {
#ifdef ATT_T21
    store_o_staged(o, rli, wid < 4 ? lds + SHM_V + wid * 4096 : lds + 2 * SHM_V + C::SHM_K + (wid - 4) * 4096, A_RSRC(wsb + cur.oo), OS_(cur) * 2, (cur.P0 + wid * QBLK) * OS_(cur) * 2, lane);
#else
    const int os_ = (PVAR & 1) ? 0 : OS_(cur);
    const __amdgpu_buffer_rsrc_t ro_ = A_RSRC(wsb + cur.oo); const int oo_ = (4 * hi * os_ + r32) * 2, so0_ = (cur.P0 + wid * QBLK) * os_ * 2;
#pragma unroll
    for (int r = 0; r < 16; ++r) { const int sor_ = so0_ + ((r & 3) + 8 * (r >> 2)) * os_ * 2;
#pragma unroll
        for (int d0 = 0; d0 < 4; ++d0) { const float v = o[d0][r] * rli[r];
            const float vn = __int_as_float(__builtin_amdgcn_update_dpp(0, __float_as_int(v), 0xB1, 0xF, 0xF, true));
            if ((r32 & 1) == 0) __builtin_amdgcn_raw_buffer_store_b32(cvtpk(v, vn), ro_, oo_ + d0 * 64, sor_, 0); } }
#endif
    }
    if constexpr (ROPE) A_RTLOAD(nxt);
#undef RESC
#undef KBASE
#undef ACT
#undef MASKT
#undef STEP
}

template <int DQK> struct SeamD { bf16x8 qr[Cfg<DQK>::NQF]; };
#define A_GLDS(voff, sbase, ldsdst) do { unsigned keep_; asm volatile("s_mov_b32 %0, m0\n\ts_mov_b32 m0, %2\n\ts_nop 0\n\tglobal_load_lds_dwordx4 %1, %3\n\ts_mov_b32 m0, %0" \
        : "=&s"(keep_) : "v"(voff), "s"((unsigned)__builtin_amdgcn_readfirstlane((int)(ldsdst))), "s"((const void*)(sbase)) : "memory"); } while (0)
#define A_DMA_IDX() int krow_[C::KCH], kcb_[C::KCH], vrow_[2], vcb_[2]; \
        _Pragma("unroll") for (int j_ = 0; j_ < C::KCH; ++j_) { const int p_ = (j_ * 8 + wid) * 1024 + lane * 16, row_ = p_ / C::KPITCH, pc_ = (p_ % C::KPITCH) / 16, lc_ = (pc_ & ~7) | ((pc_ & 7) ^ (row_ & 7)); \
            krow_[j_] = row_; kcb_[j_] = lc_ * 16; } \
        _Pragma("unroll") for (int j_ = 0; j_ < 2; ++j_) { const int p_ = (j_ * 8 + wid) * 1024 + lane * 16, s_ = p_ / 512, w_ = p_ % 512, kk_ = (s_ >> 2) * 8 + (w_ >> 6), col_ = (s_ & 3) * 32 + ((w_ & 63) >> 1); \
            vrow_[j_] = (kk_ & ~0xC) | ((kk_ & 4) << 1) | ((kk_ & 8) >> 1); vcb_[j_] = col_ * 2; }
#define A_DMA(B_, k0, sl_) do { const char* kb_ = wsb + (B_).ko + (size_t)(k0) * (size_t)(KS_(B_) * 2); const char* vb_ = wsb + (B_).vo + (size_t)(k0) * (size_t)(VS_(B_) * 2); \
        _Pragma("unroll") for (int j_ = 0; j_ < C::KCH; ++j_) A_GLDS((unsigned)(krow_[j_] * KS_(B_) * 2 + kcb_[j_]), kb_, lds0 + NS * SHM_V + (sl_) * C::SHM_K + (j_ * 8 + wid) * 1024); \
        _Pragma("unroll") for (int j_ = 0; j_ < 2; ++j_) A_GLDS((unsigned)(vrow_[j_] * VS_(B_) * 2 + vcb_[j_]), vb_, lds0 + (sl_) * SHM_V + (j_ * 8 + wid) * 1024); } while (0)
template <int DQK, bool DIL, int NS>
__device__ __forceinline__ void att_prime_dma(const Blk& cur, const char* wsb, char* lds, SeamD<DQK>& S, int tid_in) {
    typedef Cfg<DQK> C;
    int tid = tid_in; asm volatile("" : "+v"(tid));
    const int wid = __builtin_amdgcn_readfirstlane(tid >> 6), lane = tid & 63, r32 = lane & 31, hi = lane >> 5;
    const unsigned lds0 = (unsigned)(uintptr_t)lds;
    A_DMA_IDX();
    const int kb0 = swa_jlo(cur.P0, W_(cur)) * KVBLK;
    A_QLOAD(cur);
#pragma unroll
    for (int i_ = 0; i_ < NS - 1; ++i_) A_DMA(cur, kb0 + i_ * KVBLK, i_);
}
template <int DQK, bool DIL, bool SK, int NS>
__device__ __forceinline__ void att_block_dma(const Blk& cur, const Blk& nxt, const char* wsb, char* lds, char* wsl, SeamD<DQK>& S, int tid_in) {
    typedef Cfg<DQK> C;
    int tid = tid_in; asm volatile("" : "+v"(tid));
    const int wid = __builtin_amdgcn_readfirstlane(tid >> 6), lane = tid & 63, r32 = lane & 31, hi = lane >> 5;
    const int W = W_(cur); const float scale = SCALE_, beta = cur.beta;
    const int j_lo = swa_jlo(cur.P0, W);
    int j_hi = (cur.P0 + QB - 1) / KVBLK + 1; if (j_hi > SKV_(cur) / KVBLK) j_hi = SKV_(cur) / KVBLK;
    const int NT = j_hi - j_lo;
    const int kbn = swa_jlo(nxt.P0, W_(nxt)) * KVBLK;
    const int qlo = cur.P0 + wid * QBLK, qm = qlo + r32 - 4 * hi;
    const unsigned lds0 = (unsigned)(uintptr_t)lds;
    const char* K_lds = lds + NS * SHM_V;
    float* ws = (float*)wsl + wid * 64; float* li_l = ws, * al_l = ws + 32;
    float m_reg = -1e30f, l_reg = 0; f32x16 o[4] = {};
    A_DMA_IDX();
    const int vb0 = (int)lds0 + v_rd_base(lane);
    constexpr int NDMA = C::KCH + 2;
#define RESC(a) do { if (__any((a) < 1.f)) { if (hi == 0) al_l[r32] = (a); asm volatile("s_waitcnt lgkmcnt(0)" ::: "memory");              \
                     _Pragma("unroll") for (int d_ = 0; d_ < 4; ++d_) _Pragma("unroll") for (int r = 0; r < 16; ++r) o[d_][r] *= al_l[crow(r, hi)]; } } while (0)
#define KBASE(t) ((j_lo + (t)) * KVBLK)
#define ACT(t) (KBASE(t) <= qlo + QBLK - 1 && KBASE(t) + KVBLK - 1 >= qlo - W + 1)
#define MASKT(P0_, P1_, t) do { const int kb_ = KBASE(t); if ((!SK || ACT(t)) && (kb_ + KVBLK - 1 > qlo || kb_ <= qlo + QBLK - 1 - W)) mask_tile(P0_, P1_, qm - kb_, (unsigned)W); } while (0)
    VMW();
#pragma unroll
    for (int d0 = 0; d0 < C::NQF; ++d0) asm volatile("" : "+v"(S.qr[d0]));
    asm volatile("s_waitcnt lgkmcnt(0)" ::: "memory"); __builtin_amdgcn_s_barrier(); asm volatile("" ::: "memory");
    int sl = 0, sl2 = NS - 1;
#pragma unroll 1
    for (int t = 0; t < NT; ++t) {
        const bool pre = t + NS - 1 < NT;
        if (pre) A_DMA(cur, KBASE(t + NS - 1), sl2);
        SBAR(); f32x16 p0, p1; float mn_, al_; bf16x8 pa0, pa1, pa2, pa3;
        qkt<0, SK, DQK, DIL>(p0, p1, K_lds + sl * C::SHM_K, r32, hi, S.qr, ACT(t), beta, qm - KBASE(t)); SBAR();
        MASKT(p0, p1, t); partialSM(p0, p1, m_reg, mn_, al_, scale); finishSM(p0, p1, al_, l_reg, pa0, pa1, pa2, pa3); RESC(al_); SBAR();
        pv_tile<0, SK>(o, vb0 + sl * SHM_V, pa0, pa1, pa2, pa3, ACT(t));
        if (t + 1 < NT) { int infl = NT - 2 - t; if (infl > NS - 2) infl = NS - 2;
                          if (infl <= 0) VMW(); else if (infl == 1) VMWN(NDMA); else VMWN(2 * NDMA);
                          asm volatile("s_waitcnt lgkmcnt(0)" ::: "memory"); __builtin_amdgcn_s_barrier(); asm volatile("" ::: "memory"); }
        sl = sl == NS - 1 ? 0 : sl + 1; sl2 = sl2 == NS - 1 ? 0 : sl2 + 1;
    }
    asm volatile("s_waitcnt lgkmcnt(0)" ::: "memory"); __builtin_amdgcn_s_barrier(); asm volatile("" ::: "memory");
    A_QLOAD(nxt);
#pragma unroll
    for (int i_ = 0; i_ < NS - 1; ++i_) A_DMA(nxt, kbn + i_ * KVBLK, i_);
    if (hi == 0) li_l[r32] = l_reg; asm volatile("s_waitcnt lgkmcnt(0)" ::: "memory");
    if constexpr (DIL) { if (hi == 0) __builtin_amdgcn_raw_buffer_store_b32(__float_as_uint(m_reg * scale + __logf(l_reg)), A_RSRC(wsb + cur.lo), r32 * LS_(cur) * 4, (cur.P0 + wid * QBLK) * LS_(cur) * 4, 0); }
    float rli[16];
#pragma unroll
    for (int r = 0; r < 16; ++r) rli[r] = __builtin_amdgcn_rcpf(li_l[crow(r, hi)]);
    const __amdgpu_buffer_rsrc_t ro_ = A_RSRC(wsb + cur.oo); const int oo_ = (4 * hi * OS_(cur) + r32) * 2, so0_ = (cur.P0 + wid * QBLK) * OS_(cur) * 2;
#pragma unroll
    for (int r = 0; r < 16; ++r) { const int sor_ = so0_ + ((r & 3) + 8 * (r >> 2)) * OS_(cur) * 2;
#pragma unroll
        for (int d0 = 0; d0 < 4; ++d0) { const float v = o[d0][r] * rli[r];
            const float vn = __int_as_float(__builtin_amdgcn_update_dpp(0, __float_as_int(v), 0xB1, 0xF, 0xF, true));
            if ((r32 & 1) == 0) __builtin_amdgcn_raw_buffer_store_b32(cvtpk(v, vn), ro_, oo_ + d0 * 64, sor_, 0); } }
#undef RESC
#undef KBASE
#undef ACT
#undef MASKT
}

template <bool SK, int DQK, bool DIL>
__device__ __forceinline__ void qkt_fin(f32x16& p0, f32x16& p1, const char* K_lds, int r32, int hi, const bf16x8* qr, bool act, float beta, int dq,
                                        f32x16& y0, f32x16& y1, float alpha, float& l_reg, bf16x8& pa0, bf16x8& pa1, bf16x8& pa2, bf16x8& pa3) {
    typedef Cfg<DQK> C;
    const bool run = !(SK && !act);
    if (!run) { const float NEG = -__builtin_inff();
#pragma unroll
        for (int r = 0; r < 16; ++r) { p0[r] = NEG; p1[r] = NEG; } }
    else if constexpr (DIL) { const float b0 = -beta * (float)dq;
#pragma unroll
        for (int r = 0; r < 16; ++r) { const int c = (r & 3) + 8 * (r >> 2); p0[r] = fmaf(beta, (float)c, b0); p1[r] = fmaf(beta, (float)(c + 32), b0); } }
    else { p0 = f32x16{}; p1 = f32x16{}; }
    const char* kb[4];
#pragma unroll
    for (int dd = 0; dd < 4; ++dd) { const int colB = (dd * 16 + hi * 8) * 2; kb[dd] = K_lds + r32 * C::KPITCH + (colB ^ ((r32 & 7) << 4)); }
#define QK_CHUNK(c_) do { if (run) { _Pragma("unroll") for (int d0 = 4 * (c_); d0 < 4 * (c_) + 4 && d0 < C::NQF; ++d0) { const char* a = kb[d0 & 3] + (d0 >> 2) * 128; \
            bf16x8 b0 = *reinterpret_cast<const bf16x8*>(a); bf16x8 b1 = *reinterpret_cast<const bf16x8*>(a + 32 * C::KPITCH);                                  \
            p0 = __builtin_amdgcn_mfma_f32_32x32x16_bf16(b0, qr[d0], p0, 0, 0, 0); p1 = __builtin_amdgcn_mfma_f32_32x32x16_bf16(b1, qr[d0], p1, 0, 0, 0); } } } while (0)
#define PK4(P, B_, OUT) do { unsigned a0 = cvtpk(P[B_+0], P[B_+1]), a1 = cvtpk(P[B_+2], P[B_+3]);                          \
        unsigned b0 = cvtpk(P[B_+4], P[B_+5]), b1 = cvtpk(P[B_+6], P[B_+7]);                                             \
        auto r0 = __builtin_amdgcn_permlane32_swap(a0, b0, false, false); auto r1 = __builtin_amdgcn_permlane32_swap(a1, b1, false, false); \
        u32x4 w = {r0[0], r1[0], r0[1], r1[1]}; OUT = *reinterpret_cast<bf16x8*>(&w); } while (0)
    QK_CHUNK(0);
#pragma unroll
    for (int r = 0; r < 16; ++r) y1[r] = __builtin_amdgcn_exp2f(y1[r]);
    float ps = 0;
#pragma unroll
    for (int r = 0; r < 16; ++r) ps += y0[r];
#pragma unroll
    for (int r = 0; r < 16; ++r) ps += y1[r];
    SBAR();
    QK_CHUNK(1);
    { auto rr = __builtin_amdgcn_permlane32_swap(__float_as_uint(ps), __float_as_uint(ps), false, false);
      ps = __uint_as_float(rr[0]) + __uint_as_float(rr[1]); }
    l_reg = l_reg * alpha + ps;
    PK4(y0, 0, pa0); PK4(y0, 8, pa1);
    if constexpr (C::NQF > 8) { SBAR(); QK_CHUNK(2); }
    PK4(y1, 0, pa2); PK4(y1, 8, pa3);
#undef PK4
#undef QK_CHUNK
}
#ifndef ATT_SKEW_SEL
#define ATT_SKEW_SEL 0
#endif
#if ATT_SKEW_SEL == 0
#define ATT_SKEW_A (wid < 4)
#elif ATT_SKEW_SEL == 1
#define ATT_SKEW_A ((wid & 1) == 0)
#elif ATT_SKEW_SEL == 2
#define ATT_SKEW_A true
#else
#define ATT_SKEW_A false
#endif
#define A_DMA_K(B_, k0, sl_) do { const char* kb_ = wsb + (B_).ko + (size_t)(k0) * (size_t)(KS_(B_) * 2); int ln_ = lane; asm volatile("" : "+v"(ln_)); \
        _Pragma("unroll") for (int j_ = 0; j_ < C::KCH; ++j_) { const int p_ = (j_ * 8 + wid) * 1024 + ln_ * 16, row_ = p_ / C::KPITCH, pc_ = (p_ % C::KPITCH) / 16, lc_ = (pc_ & ~7) | ((pc_ & 7) ^ (row_ & 7)); \
            A_GLDS((unsigned)(row_ * KS_(B_) * 2 + lc_ * 16), kb_, lds0 + 3 * SHM_V + (sl_) * C::SHM_K + (j_ * 8 + wid) * 1024); } } while (0)
#define A_DMA_V(B_, k0, sl_) do { const char* vb_ = wsb + (B_).vo + (size_t)(k0) * (size_t)(VS_(B_) * 2); int ln_ = lane; asm volatile("" : "+v"(ln_)); \
        _Pragma("unroll") for (int j_ = 0; j_ < 2; ++j_) { const int p_ = (j_ * 8 + wid) * 1024 + ln_ * 16, s_ = p_ / 512, w_ = p_ % 512, kk_ = (s_ >> 2) * 8 + (w_ >> 6), col_ = (s_ & 3) * 32 + ((w_ & 63) >> 1); \
            const int vr_ = (kk_ & ~0xC) | ((kk_ & 4) << 1) | ((kk_ & 8) >> 1); \
            A_GLDS((unsigned)(vr_ * VS_(B_) * 2 + col_ * 2), vb_, lds0 + (sl_) * SHM_V + (j_ * 8 + wid) * 1024); } } while (0)
#define A_RAWBAR() do { asm volatile("s_waitcnt lgkmcnt(0)" ::: "memory"); __builtin_amdgcn_s_barrier(); asm volatile("" ::: "memory"); } while (0)
template <int DQK, bool DIL>
__device__ __forceinline__ void att_prime_dma2(const Blk& cur, const char* wsb, char* lds, SeamD<DQK>& S, int tid_in) {
    typedef Cfg<DQK> C; constexpr int NS = 3;
    int tid = tid_in; asm volatile("" : "+v"(tid));
    const int wid = __builtin_amdgcn_readfirstlane(tid >> 6), lane = tid & 63, r32 = lane & 31, hi = lane >> 5;
    const unsigned lds0 = (unsigned)(uintptr_t)lds;
    const int kb0 = swa_jlo(cur.P0, W_(cur)) * KVBLK;
    A_QLOAD(cur);
    A_DMA_K(cur, kb0, 0); A_DMA_V(cur, kb0, 0); A_DMA_K(cur, kb0 + KVBLK, 1);
}
template <int DQK, bool DIL, bool SK, int ORD>
__device__ __forceinline__ void att_block_dma2(const Blk& cur, const Blk& nxt, const char* wsb, char* lds, SeamD<DQK>& S, int tid_in) {
    typedef Cfg<DQK> C; constexpr int NS = 3;
    int tid = tid_in; asm volatile("" : "+v"(tid));
    const int wid = __builtin_amdgcn_readfirstlane(tid >> 6), lane = tid & 63, r32 = lane & 31, hi = lane >> 5;
    const int W = W_(cur); const float scale = SCALE_, beta = cur.beta;
    const int j_lo = swa_jlo(cur.P0, W);
    int j_hi = (cur.P0 + QB - 1) / KVBLK + 1; if (j_hi > SKV_(cur) / KVBLK) j_hi = SKV_(cur) / KVBLK;
    const int NT = j_hi - j_lo;
    const int kbn = swa_jlo(nxt.P0, W_(nxt)) * KVBLK;
    const int qlo = cur.P0 + wid * QBLK, qm = qlo + r32 - 4 * hi;
    const unsigned lds0 = (unsigned)(uintptr_t)lds;
    const char* K_lds = lds + 3 * SHM_V;
    float* ws = (float*)(lds + 3 * SHM_V + 3 * C::SHM_K) + wid * 64; float* li_l = ws, * al_l = ws + 32;
    float m_reg = -1e30f, l_reg = 0; f32x16 o[4] = {};
    const int vb0 = (int)lds0 + v_rd_base(lane);
#define RESC(a) do { if (__any((a) < 1.f)) { if (hi == 0) al_l[r32] = (a); asm volatile("s_waitcnt lgkmcnt(0)" ::: "memory");              \
                     _Pragma("unroll") for (int d_ = 0; d_ < 4; ++d_) _Pragma("unroll") for (int r = 0; r < 16; ++r) o[d_][r] *= al_l[crow(r, hi)]; } } while (0)
#define KBASE(t) ((j_lo + (t)) * KVBLK)
#define ACT(t) (KBASE(t) <= qlo + QBLK - 1 && KBASE(t) + KVBLK - 1 >= qlo - W + 1)
#define MASKT(P0_, P1_, t) do { const int kb_ = KBASE(t); if ((!SK || ACT(t)) && (kb_ + KVBLK - 1 > qlo || kb_ <= qlo + QBLK - 1 - W)) mask_tile(P0_, P1_, qm - kb_, (unsigned)W); } while (0)
#define ISSUE(t, n_) do { n_ = 0; if ((t) + 2 < NT) { int slotk_ = sl + 2; if (slotk_ >= 3) slotk_ -= 3; A_DMA_K(cur, KBASE((t) + 2), slotk_); n_ += C::KCH; } \
                          if ((t) + 1 < NT) { int slotv_ = sl + 1; if (slotv_ >= 3) slotv_ -= 3; A_DMA_V(cur, KBASE((t) + 1), slotv_); n_ += 2; } } while (0)
#define CLOSE(n_) do { if ((n_) == C::KCH + 2) VMWN(C::KCH + 2); else if ((n_) == 2) VMWN(2); else VMW(); A_RAWBAR(); } while (0)
    VMW();
#pragma unroll
    for (int d0 = 0; d0 < C::NQF; ++d0) asm volatile("" : "+v"(S.qr[d0]));
    A_RAWBAR();
    int sl = 0, slp = 2, nis;
    f32x16 pA0, pA1, pB0, pB1; float mnA, mnB, alA, alB; bf16x8 pa0, pa1, pa2, pa3;
    ISSUE(0, nis); SBAR();
    qkt<0, SK, DQK, DIL>(pA0, pA1, K_lds + sl * C::SHM_K, r32, hi, S.qr, ACT(0), beta, qm - KBASE(0)); SBAR();
    MASKT(pA0, pA1, 0); partialSM(pA0, pA1, m_reg, mnA, alA, scale);
    CLOSE(nis); slp = sl; sl = sl == 2 ? 0 : sl + 1;
#define STEPP(PX0, PX1, mnX, alX, PY0, PY1, alY, t) do { ISSUE(t, nis); SBAR();                                               \
        if constexpr (ORD == 0) {                                                                                               \
            qkt<0, SK, DQK, DIL>(PX0, PX1, K_lds + sl * C::SHM_K, r32, hi, S.qr, ACT(t), beta, qm - KBASE(t)); SBAR();           \
            finishSM(PY0, PY1, alY, l_reg, pa0, pa1, pa2, pa3); SBAR();                                                         \
            pv_tile<0, SK>(o, vb0 + slp * SHM_V, pa0, pa1, pa2, pa3, ACT((t) - 1)); SBAR();                                     \
        } else {                                                                                                                \
            finishSM(PY0, PY1, alY, l_reg, pa0, pa1, pa2, pa3); SBAR();                                                         \
            pv_tile<0, SK>(o, vb0 + slp * SHM_V, pa0, pa1, pa2, pa3, ACT((t) - 1)); SBAR();                                     \
            qkt<0, SK, DQK, DIL>(PX0, PX1, K_lds + sl * C::SHM_K, r32, hi, S.qr, ACT(t), beta, qm - KBASE(t)); SBAR();           \
        }                                                                                                                       \
        MASKT(PX0, PX1, (t)); partialSM(PX0, PX1, m_reg, mnX, alX, scale);                                                     \
        RESC(alX); CLOSE(nis); slp = sl; sl = sl == 2 ? 0 : sl + 1; } while (0)
    int t = 1;
#pragma unroll 1
    for (; t + 2 < NT; t += 2) {
        STEPP(pB0, pB1, mnB, alB, pA0, pA1, alA, t);
        STEPP(pA0, pA1, mnA, alA, pB0, pB1, alB, t + 1);
    }
    STEPP(pB0, pB1, mnB, alB, pA0, pA1, alA, t);
    finishSM(pB0, pB1, alB, l_reg, pa0, pa1, pa2, pa3); SBAR();
    pv_tile<0, SK>(o, vb0 + slp * SHM_V, pa0, pa1, pa2, pa3, ACT(NT - 1));
    A_RAWBAR();
    A_QLOAD(nxt);
    A_DMA_K(nxt, kbn, 0); A_DMA_V(nxt, kbn, 0); A_DMA_K(nxt, kbn + KVBLK, 1);
    if (hi == 0) li_l[r32] = l_reg; asm volatile("s_waitcnt lgkmcnt(0)" ::: "memory");
    if constexpr (DIL) { if (hi == 0) __builtin_amdgcn_raw_buffer_store_b32(__float_as_uint(m_reg * scale + __logf(l_reg)), A_RSRC(wsb + cur.lo), r32 * LS_(cur) * 4, (cur.P0 + wid * QBLK) * LS_(cur) * 4, 0); }
    float rli[16];
#pragma unroll
    for (int r = 0; r < 16; ++r) rli[r] = __builtin_amdgcn_rcpf(li_l[crow(r, hi)]);
    const __amdgpu_buffer_rsrc_t ro_ = A_RSRC(wsb + cur.oo); const int oo_ = (4 * hi * OS_(cur) + r32) * 2, so0_ = (cur.P0 + wid * QBLK) * OS_(cur) * 2;
#pragma unroll
    for (int r = 0; r < 16; ++r) { const int sor_ = so0_ + ((r & 3) + 8 * (r >> 2)) * OS_(cur) * 2;
#pragma unroll
        for (int d0 = 0; d0 < 4; ++d0) { const float v = o[d0][r] * rli[r];
            const float vn = __int_as_float(__builtin_amdgcn_update_dpp(0, __float_as_int(v), 0xB1, 0xF, 0xF, true));
            if ((r32 & 1) == 0) __builtin_amdgcn_raw_buffer_store_b32(cvtpk(v, vn), ro_, oo_ + d0 * 64, sor_, 0); } }
#undef RESC
#undef KBASE
#undef ACT
#undef MASKT
#undef ISSUE
#undef CLOSE
#undef STEPP
}
#undef A_DMA_K
#undef A_DMA_V
#undef A_RAWBAR
#undef A_GLDS
#undef A_DMA_IDX
#undef A_DMA
#undef VMW
#undef VMWN
#undef A_SLOAD
#undef A_RSRC
#undef A_BLD
#undef A_QLOAD
#undef A_SWRITE_K
#undef A_SWRITE_V
#undef A_STAGE_IDX
#undef SBAR
#undef QS_
#undef KS_
#undef VS_
#undef OS_
#undef LS_
#undef SKV_
#undef W_
#undef SCALE_
}
constexpr int NWAVES = 8;
constexpr int T = 32768, DM = 2048, SEQ = 8192, NB = 4, DEPTH = 2;
constexpr int IN_COLS = 3904, PROJ_LD = 4096, NEXP = 16, DEXP = 1024;
constexpr int C_QB = 0, C_KB = 1024, C_VB = 2048, C_CQ = 3072, C_CKV = 3584, C_KR = 3840;
constexpr float EPS = 1e-6f;
constexpr size_t MiB = 1u << 20;
constexpr size_t WS_CTL = 0, CTL_ZERO_BYTES = 1 * MiB;
constexpr size_t WS_MOD = 1 * MiB;
constexpr size_t WS_ROPE = 2 * MiB;
constexpr size_t WS_RSTDQ = 4 * MiB, WS_RSTDKV = 4 * MiB + 256 * 1024, WS_AW = 4 * MiB + 512 * 1024;
constexpr size_t WS_ROWIDX = 5 * MiB;
constexpr size_t WS_LSE = 8 * MiB;
constexpr size_t WS_WIN = 16 * MiB;
constexpr size_t WS_WUQ = 48 * MiB;
constexpr size_t WS_WUKV = 51 * MiB;
constexpr size_t WS_WOUT = 53 * MiB;
constexpr size_t WS_W13 = 72 * MiB;
constexpr size_t WS_W2 = 200 * MiB;
constexpr size_t WS_H = 264 * MiB;
constexpr size_t WS_PROJ = 392 * MiB;
constexpr size_t WS_QA = 648 * MiB;
constexpr size_t WS_KF = 744 * MiB;
constexpr size_t WS_VB = 840 * MiB;
constexpr size_t WS_OA = 904 * MiB;
constexpr size_t WS_OB = 968 * MiB;
constexpr size_t WS_XB = 1160 * MiB;
constexpr size_t WS_END = 1288 * MiB;
constexpr size_t WS_HMID = WS_PROJ;
constexpr size_t WS_Y = WS_QA;
constexpr int CW_TMO = 0;
constexpr int CW_CNT = 64;
constexpr int CW_BAR = 4096;
constexpr int RING_BYTES = 131072;
constexpr int L_MISC = RING_BYTES, L_TS = RING_BYTES + 256, L_CNT = RING_BYTES + 384, L_TOK = RING_BYTES + 512, L_ATAB = RING_BYTES + 2560;
constexpr int MAXU = 10;
constexpr int LDS_BYTES = 147456;
static_assert(L_ATAB + MAXU * 1024 <= LDS_BYTES, "LDS map");

#define GAS __attribute__((address_space(1)))
#define LAS __attribute__((address_space(3)))
typedef unsigned short bf16;
typedef unsigned v4u __attribute__((ext_vector_type(4)));
typedef unsigned v2u __attribute__((ext_vector_type(2)));
typedef float f32x4 __attribute__((ext_vector_type(4)));
typedef float f32x2 __attribute__((ext_vector_type(2)));
#define LDS_WAIT() asm volatile("s_waitcnt lgkmcnt(0)" ::: "memory")
#define VM_WAIT() asm volatile("s_waitcnt vmcnt(0)" ::: "memory")
__device__ __forceinline__ unsigned pk2(float lo, float hi) { return pg8::cvt_pk_bf16(lo, hi); }
__device__ __forceinline__ float bf_lo(unsigned w) { return __uint_as_float(w << 16); }
__device__ __forceinline__ float bf_hi(unsigned w) { return __uint_as_float(w & 0xffff0000u); }


typedef __amdgpu_buffer_rsrc_t rsrc_t;
#define RSRC(p) __builtin_amdgcn_make_buffer_rsrc((void*)(p), 0, 0x7fffffff, 0x00020000)
__device__ __forceinline__ f32x4 bld4f(rsrc_t r, int vo, int so) { return __builtin_bit_cast(f32x4, __builtin_amdgcn_raw_buffer_load_b128(r, vo, so, 0)); }
__device__ __forceinline__ v4u bld4u(rsrc_t r, int vo, int so) { return __builtin_bit_cast(v4u, __builtin_amdgcn_raw_buffer_load_b128(r, vo, so, 0)); }
__device__ __forceinline__ v2u bld2u(rsrc_t r, int vo, int so) { return __builtin_bit_cast(v2u, __builtin_amdgcn_raw_buffer_load_b64(r, vo, so, 0)); }
__device__ __forceinline__ void bst2u(rsrc_t r, int vo, int so, v2u v) { __builtin_amdgcn_raw_buffer_store_b64(v, r, vo, so, 0); }
__device__ __forceinline__ void bst4u(rsrc_t r, int vo, int so, v4u v) { __builtin_amdgcn_raw_buffer_store_b128(v, r, vo, so, 0); }
__device__ __forceinline__ void bst4f(rsrc_t r, int vo, int so, f32x4 v) { __builtin_amdgcn_raw_buffer_store_b128(__builtin_bit_cast(v4u, v), r, vo, so, 0); }

#define XB_TMO      128
#define XB_XCNT(j)  (256  + 64 * (j))
#define XB_XSUB(j)  (1280 + 64 * (j))
#define XB_XGEN(j)  (2304 + 64 * (j))
#define XB_TOP      3328
#define XB_TOPGEN   3392
#define XCD_BAR_WORDS 3456
#define XB_SPIN_CAP (1u << 18)
__device__ __forceinline__ unsigned xb_ld(unsigned* p)              { return __hip_atomic_load(p, __ATOMIC_RELAXED, __HIP_MEMORY_SCOPE_AGENT); }
__device__ __forceinline__ unsigned xb_add(unsigned* p, unsigned v) { return __hip_atomic_fetch_add(p, v, __ATOMIC_RELAXED, __HIP_MEMORY_SCOPE_AGENT); }
__device__ __forceinline__ unsigned xb_xcc_id() { return (unsigned)__builtin_amdgcn_s_getreg((3 << 11) | 20) & 0xFu; }
#define XB_SPIN(cond, bar) do { unsigned _sp = 0; while (cond) { __builtin_amdgcn_s_sleep(1); \
    if ((++_sp & 255u) == 0u) { if (xb_ld(&(bar)[XB_TMO])) break; if (_sp > XB_SPIN_CAP) { atomicAdd(&(bar)[XB_TMO], 1u); break; } } } } while (0)
struct XcdBarrier { unsigned* bar; unsigned x; volatile LAS unsigned* st; };
__device__ __forceinline__ XcdBarrier xcd_barrier_post(unsigned* bar, volatile LAS unsigned* st, int tid) {
    XcdBarrier b; b.bar = bar; b.x = xb_xcc_id(); b.st = st;
    if (tid == 0) (void)xb_add(&bar[XB_XCNT(b.x)], 1u);
    return b;
}
__device__ __forceinline__ void xcd_barrier_complete(unsigned* bar, unsigned x, unsigned& nloc, unsigned& nx) {
    const unsigned G = gridDim.x * gridDim.y * gridDim.z;
    unsigned sum, cnt, mine, sp = 0u;
    for (;;) {
        sum = 0u; cnt = 0u; mine = 0u;
#pragma unroll
        for (unsigned j = 0; j < 16; ++j) { const unsigned c = xb_ld(&bar[XB_XCNT(j)]); sum += c; cnt += (c > 0u) ? 1u : 0u; mine = (j == x) ? c : mine; }
        if (sum == G) break;
        __builtin_amdgcn_s_sleep(1);
        if ((++sp & 255u) == 0u) { if (xb_ld(&bar[XB_TMO])) break; if (sp > XB_SPIN_CAP) { atomicAdd(&bar[XB_TMO], 1u); break; } }
    }
    nloc = mine > 0u ? mine : 1u; nx = cnt > 0u ? cnt : 1u;
}
__device__ __forceinline__ void xcd_barrier(const XcdBarrier& b, int tid) {
    asm volatile("s_waitcnt vmcnt(0)" ::: "memory");
    __syncthreads();
    if (tid == 0) {
        unsigned* bar = b.bar; asm volatile("" : "+s"(bar));
        __builtin_amdgcn_s_waitcnt(0);
        unsigned nloc = b.st[0], nx = b.st[1];
        if (nloc == 0u) { xcd_barrier_complete(bar, b.x, nloc, nx); b.st[0] = nloc; b.st[1] = nx; }
        const unsigned old = xb_add(&bar[XB_XSUB(b.x)], 1u);
        const unsigned gen = old / nloc;
        if (old + 1u == (gen + 1u) * nloc) {
            __builtin_amdgcn_fence(__ATOMIC_RELEASE, "agent");
            asm volatile("s_waitcnt vmcnt(0)" ::: "memory");
            const unsigned og = xb_add(&bar[XB_TOP], 1u);
            const unsigned tg = og / nx;
            if (og + 1u == (tg + 1u) * nx) xb_add(&bar[XB_TOPGEN], 1u);
            else XB_SPIN(xb_ld(&bar[XB_TOPGEN]) == tg, bar);
            __builtin_amdgcn_fence(__ATOMIC_ACQUIRE, "agent");
            xb_add(&bar[XB_XGEN(b.x)], 1u);
            asm volatile("s_waitcnt vmcnt(0)" ::: "memory");
        } else {
            XB_SPIN(xb_ld(&bar[XB_XGEN(b.x)]) == gen, bar);
            __builtin_amdgcn_fence(__ATOMIC_ACQUIRE, "agent");
            asm volatile("s_waitcnt vmcnt(0)" ::: "memory");
        }
    }
    __syncthreads();
}

struct Args {
    const float* in[20]; float* out; unsigned char* ws;
    float invf[32];
    int ph_lo, ph_hi, li, pad;
};
enum { I_X = 0, I_C, I_ADAW, I_ADAB, I_N1G, I_N2G, I_WIN, I_QNG, I_KVNG, I_WUQ, I_WUKV, I_ONA, I_ONB, I_WOUT, I_RW, I_RB, I_EG, I_EU, I_ED, I_FG };

struct Frame {
    LAS unsigned char* lds; unsigned char* ldsg;
    unsigned* ctl; unsigned char* ws;
    int tid, lane, wave, vcu, G;
};
__device__ __forceinline__ int lane_id() { int l; asm volatile("v_mbcnt_lo_u32_b32 %0, -1, 0\n\tv_mbcnt_hi_u32_b32 %0, -1, %0" : "=v"(l)); return l; }
#define DPP_ADD(v, ctrl) v += __int_as_float(__builtin_amdgcn_update_dpp(0, __float_as_int(v), ctrl, 0xF, 0xF, true))
__device__ __forceinline__ float wave_sum(float v) {
    DPP_ADD(v, 0xB1); DPP_ADD(v, 0x4E); DPP_ADD(v, 0x141); DPP_ADD(v, 0x140);
    v += __int_as_float(__builtin_amdgcn_ds_swizzle(__float_as_int(v), 0x401F));
    auto rr = __builtin_amdgcn_permlane32_swap(__float_as_uint(v), __float_as_uint(v), false, false);
    return __uint_as_float(rr[0]) + __uint_as_float(rr[1]);
}
__device__ __forceinline__ int il64(int j) { return j < 32 ? 2 * j : 2 * (j - 32) + 1; }
template <int MODE> __device__ __forceinline__ int dest_row(int n) {
    if constexpr (MODE == 0) return n;
    else if constexpr (MODE == 1) {
        if (n < 512) return C_CQ + n; if (n < 768) return C_CKV + (n - 512); if (n < 832) return C_KR + il64(n - 768);
        if (n < 1856) return C_QB + (n - 832); if (n < 2880) return C_KB + (n - 1856); return C_VB + (n - 2880); }
    else if constexpr (MODE == 2) { const int h = n / 192, j = n % 192; return j < 128 ? n : h * 192 + 128 + il64(j - 128); }
    else if constexpr (MODE == 3) return (n >> 7) * 256 + (n & 127);
    else return (n >> 7) * 256 + 128 + (n & 127);
}
template <int MODE>
__device__ __forceinline__ void transpose_item(const float* W, int ldw, int K, int N, bf16* WT, const float* kscale, LAS float* scr, int item, int lane) {
    const int nblk = N / 32, kb = item / nblk, nb = item % nblk, k0 = 64 * kb, n0 = 32 * nb;
    float tv[32];
#pragma unroll
    for (int i = 0; i < 32; ++i) { const int kk = 2 * i + (lane >> 5); tv[i] = W[(size_t)(k0 + kk) * ldw + n0 + (lane & 31)]; }
#pragma unroll
    for (int i = 0; i < 32; ++i) { const int kk = 2 * i + (lane >> 5); float v = tv[i]; if (kscale) v *= kscale[k0 + kk]; scr[kk * 33 + (lane & 31)] = v; }
    LDS_WAIT(); asm volatile("" ::: "memory");
    const int c = lane & 7;
#pragma unroll
    for (int j = 0; j < 4; ++j) { const int n = (lane >> 3) + 8 * j; const LAS float* s = scr + (8 * c) * 33 + n;
        v4u o; o.x = pk2(s[0 * 33], s[1 * 33]); o.y = pk2(s[2 * 33], s[3 * 33]); o.z = pk2(s[4 * 33], s[5 * 33]); o.w = pk2(s[6 * 33], s[7 * 33]);
        *(v4u*)(WT + (size_t)dest_row<MODE>(n0 + n) * K + k0 + 8 * c) = o; }
    LDS_WAIT(); asm volatile("s_waitcnt vmcnt(0)" ::: "memory");
}

__device__ __forceinline__ unsigned pk4_fp8(float a, float b, float c, float d) { int w = 0; w = __builtin_amdgcn_cvt_pk_fp8_f32(a, b, w, false); w = __builtin_amdgcn_cvt_pk_fp8_f32(c, d, w, true); return (unsigned)w; }
template <int MODE>
__device__ __forceinline__ void transpose_item8(const float* W, int ldw, int K, int N, unsigned char* WT, LAS float* scr, int item, int lane) {
    const int nblk = N / 32, kb = item / nblk, nb = item % nblk, k0 = 64 * kb, n0 = 32 * nb;
    float tv[32];
#pragma unroll
    for (int i = 0; i < 32; ++i) { const int kk = 2 * i + (lane >> 5); tv[i] = W[(size_t)(k0 + kk) * ldw + n0 + (lane & 31)]; }
#pragma unroll
    for (int i = 0; i < 32; ++i) { const int kk = 2 * i + (lane >> 5); scr[kk * 33 + (lane & 31)] = tv[i] * 256.0f; }
    LDS_WAIT(); asm volatile("" ::: "memory");
    const int c = lane & 7;
#pragma unroll
    for (int j = 0; j < 4; ++j) { const int n = (lane >> 3) + 8 * j; const LAS float* s = scr + (8 * c) * 33 + n;
        v2u o; o.x = pk4_fp8(s[0 * 33], s[1 * 33], s[2 * 33], s[3 * 33]); o.y = pk4_fp8(s[4 * 33], s[5 * 33], s[6 * 33], s[7 * 33]);
        *(v2u*)(WT + (size_t)dest_row<MODE>(n0 + n) * K + k0 + 8 * c) = o; }
    LDS_WAIT(); asm volatile("s_waitcnt vmcnt(0)" ::: "memory");
}

__device__ __forceinline__ void phase_prologue(Frame& F, const Args& A) {
    {
        const float* cc = A.in[I_C]; float* mod = (float*)(F.ws + WS_MOD);
        LAS float* red = (LAS float*)F.lds;
        for (int id = F.vcu; id < 2 * 96; id += F.G) {
            const int l = id / 96, ch = id % 96, cg = F.tid & 31, kg = F.tid >> 5, col = ch * 128 + cg * 4;
            const float* w = A.in[I_ADAW] + (size_t)l * DM * 12288 + col;
            f32x4 acc[4] = {};
#pragma unroll 4
            for (int kk = 0; kk < 128; ++kk) { const int k = kg * 128 + kk; const f32x4 wv = *(const f32x4*)(w + (size_t)k * 12288);
#pragma unroll
                for (int b = 0; b < 4; ++b) { const float cv = cc[b * DM + k]; const float ca = cv / (1.0f + __expf(-cv)); acc[b] += wv * ca; } }
#pragma unroll
            for (int b = 0; b < 4; ++b) *(LAS f32x4*)(red + ((kg * 32 + cg) * 16 + b * 4)) = acc[b];
            __syncthreads();
            if (F.tid < 128) { const int cg2 = F.tid & 31, b = F.tid >> 5; f32x4 s = {0.f, 0.f, 0.f, 0.f};
#pragma unroll
                for (int g = 0; g < 16; ++g) s += *(LAS f32x4*)(red + ((g * 32 + cg2) * 16 + b * 4));
                const int c2 = ch * 128 + cg2 * 4; const f32x4 bv = *(const f32x4*)(A.in[I_ADAB] + (size_t)l * 12288 + c2);
                *(f32x4*)(mod + ((size_t)l * 4 + b) * 12288 + c2) = s + bv; }
            asm volatile("s_waitcnt vmcnt(0)" ::: "memory");
            __syncthreads();
        }
    }
    {
        LAS float* scr = (LAS float*)(F.lds + F.wave * 16384);
        const int gw = F.vcu * NWAVES + F.wave, NGW = F.G * NWAVES;
        constexpr int I_IN = (DM / 64) * (IN_COLS / 32), I_UQ = (512 / 64) * (1536 / 32), I_UKV = (256 / 64) * (2048 / 32), I_OUT = (DM / 64) * (DM / 32), I_L = I_IN + I_UQ + I_UKV + I_OUT;
        for (int it = gw; it < 2 * I_L; it += NGW) {
            const int l = it / I_L; int r = it % I_L;
            if (r < I_IN) { transpose_item<1>(A.in[I_WIN] + (size_t)l * DM * IN_COLS, IN_COLS, DM, IN_COLS, (bf16*)(F.ws + WS_WIN) + (size_t)l * 4096 * DM, nullptr, scr, r, F.lane); continue; } r -= I_IN;
            if (r < I_UQ) { transpose_item<2>(A.in[I_WUQ] + (size_t)l * 512 * 1536, 1536, 512, 1536, (bf16*)(F.ws + WS_WUQ) + (size_t)l * 1536 * 512, A.in[I_QNG] + l * 512, scr, r, F.lane); continue; } r -= I_UQ;
            if (r < I_UKV) { transpose_item<0>(A.in[I_WUKV] + (size_t)l * 256 * 2048, 2048, 256, 2048, (bf16*)(F.ws + WS_WUKV) + (size_t)l * 2048 * 256, A.in[I_KVNG] + l * 256, scr, r, F.lane); continue; } r -= I_UKV;
#ifdef G3_FP8
            transpose_item8<0>(A.in[I_WOUT] + (size_t)l * DM * DM, DM, DM, DM, F.ws + WS_WOUT + (size_t)l * DM * DM, scr, r, F.lane);
#else
            transpose_item<0>(A.in[I_WOUT] + (size_t)l * DM * DM, DM, DM, DM, (bf16*)(F.ws + WS_WOUT) + (size_t)l * DM * DM, nullptr, scr, r, F.lane);
#endif
        }
    }
    {
        const int gt = F.vcu * (NWAVES * 64) + F.tid, NGT = F.G * NWAVES * 64;
        float* rope = (float*)(F.ws + WS_ROPE);
        for (int e = gt; e < SEQ * 32; e += NGT) { const int pos = e >> 5, i = e & 31;
            const float ang = (float)pos * A.invf[i];
            const double rev = (double)ang * 0.15915494309189535; const float fr = (float)(rev - __builtin_floor(rev));
            *(f32x2*)(rope + (size_t)e * 2) = (f32x2){__builtin_amdgcn_cosf(fr), __builtin_amdgcn_sinf(fr)}; }
        for (int e = gt; e < 2 * 192 * (DM / 8); e += NGT) { const int l = e / (192 * (DM / 8)), r = e % (192 * (DM / 8));
            *(v4u*)((bf16*)(F.ws + WS_WIN) + ((size_t)l * 4096 + IN_COLS) * DM + (size_t)r * 8) = (v4u){0u, 0u, 0u, 0u}; }
    }
}

__device__ __forceinline__ void phase_norm1(Frame& F, const Args& A, int l) {
    const int gw = F.vcu * NWAVES + F.wave, NGW = F.G * NWAVES;
    const float* mod = (const float*)(F.ws + WS_MOD);
    bf16* H = (bf16*)(F.ws + WS_H); const bf16* Y = (const bf16*)(F.ws + WS_Y);
#ifdef THIN_MLP
    for (int ch = gw; ch < T / 16; ch += NGW) {
        const int row0 = ch * 16, b = row0 >> 13;
        const float* ml = mod + ((size_t)l * 4 + b) * 12288;
#pragma unroll 1
        for (int rr = 0; rr < 16; rr += 2) {
            f32x4 v[2][8];
            if (l == 0) {
#pragma unroll
                for (int q = 0; q < 2; ++q)
#pragma unroll
                    for (int j = 0; j < 8; ++j) v[q][j] = *(const f32x4*)(A.in[I_X] + (size_t)(row0 + rr + q) * DM + 4 * F.lane + 256 * j);
            } else {
                bf16* XB = (bf16*)(F.ws + WS_XB);
                v2u xw[2][8], ya[2][8], yb[2][8]; f32x4 g2p[8];
#pragma unroll
                for (int q = 0; q < 2; ++q)
#pragma unroll
                    for (int j = 0; j < 8; ++j) { const int c = 4 * F.lane + 256 * j; const int row = row0 + rr + q;
                        xw[q][j] = *(const v2u*)(XB + (size_t)row * DM + c); ya[q][j] = *(const v2u*)(Y + (size_t)(2 * row) * DM + c); yb[q][j] = *(const v2u*)(Y + (size_t)(2 * row + 1) * DM + c); }
#pragma unroll
                for (int j = 0; j < 8; ++j) g2p[j] = *(const f32x4*)(mod + ((size_t)(l - 1) * 4 + b) * 12288 + 5 * DM + 4 * F.lane + 256 * j);
#pragma unroll
                for (int q = 0; q < 2; ++q)
#pragma unroll
                    for (int j = 0; j < 8; ++j) { const int c = 4 * F.lane + 256 * j; const int row = row0 + rr + q;
                        const f32x4 xr = {bf_lo(xw[q][j].x), bf_hi(xw[q][j].x), bf_lo(xw[q][j].y), bf_hi(xw[q][j].y)};
                        const v2u y0 = ya[q][j], y1 = yb[q][j];
                        const f32x4 ys = {bf_lo(y0.x) + bf_lo(y1.x), bf_hi(y0.x) + bf_hi(y1.x), bf_lo(y0.y) + bf_lo(y1.y), bf_hi(y0.y) + bf_hi(y1.y)};
                        const f32x4 t = xr + g2p[j] * ys;
                        const v2u ow = {pk2(t.x, t.y), pk2(t.z, t.w)}; *(v2u*)(XB + (size_t)row * DM + c) = ow;
                        v[q][j] = (f32x4){bf_lo(ow.x), bf_hi(ow.x), bf_lo(ow.y), bf_hi(ow.y)}; }
            }
            float rstd[2];
#pragma unroll
            for (int q = 0; q < 2; ++q) { float s = 0.f;
#pragma unroll
                for (int j = 0; j < 8; ++j) s += (v[q][j].x * v[q][j].x + v[q][j].y * v[q][j].y) + (v[q][j].z * v[q][j].z + v[q][j].w * v[q][j].w);
                rstd[q] = __builtin_amdgcn_rsqf(wave_sum(s) * (1.f / DM) + EPS); }
#pragma unroll
            for (int j = 0; j < 8; ++j) { const int c = 4 * F.lane + 256 * j;
                const f32x4 gsc = *(const f32x4*)(A.in[I_N1G] + l * DM + c) * (*(const f32x4*)(ml + 1 * DM + c) + 1.0f), sh = *(const f32x4*)(ml + 0 * DM + c);
#pragma unroll
                for (int q = 0; q < 2; ++q) { const f32x4 o = v[q][j] * rstd[q] * gsc + sh;
                    *(v2u*)(H + (size_t)(row0 + rr + q) * DM + c) = (v2u){pk2(o.x, o.y), pk2(o.z, o.w)}; } }
        }
    }
#else
    for (int ch = gw; ch < T / 16; ch += NGW) {
        const int row0 = ch * 16, b = row0 >> 13;
        const float* ml = mod + ((size_t)l * 4 + b) * 12288;
        f32x4 gsc[8], sh[8], g2p[8];
#pragma unroll
        for (int j = 0; j < 8; ++j) { const int c = 4 * F.lane + 256 * j; const f32x4 g = *(const f32x4*)(A.in[I_N1G] + l * DM + c), sc = *(const f32x4*)(ml + 1 * DM + c);
            gsc[j] = g * (sc + 1.0f); sh[j] = *(const f32x4*)(ml + 0 * DM + c);
            if (l > 0) g2p[j] = *(const f32x4*)(mod + ((size_t)(l - 1) * 4 + b) * 12288 + 5 * DM + c); }
#pragma unroll 1
        for (int rr = 0; rr < 16; ++rr) {
            const int row = row0 + rr; f32x4 v[8]; float s = 0.f;
            if (l == 0) {
#pragma unroll
                for (int j = 0; j < 8; ++j) v[j] = *(const f32x4*)(A.in[I_X] + (size_t)row * DM + 4 * F.lane + 256 * j);
            } else {
#pragma unroll
                for (int j = 0; j < 8; ++j) { const int c = 4 * F.lane + 256 * j;
#ifdef XRES_BF16
                    bf16* XB = (bf16*)(F.ws + WS_XB); const v2u xw = *(const v2u*)(XB + (size_t)row * DM + c); const f32x4 xr = {bf_lo(xw.x), bf_hi(xw.x), bf_lo(xw.y), bf_hi(xw.y)};
#else
                    const f32x4 xr = *(const f32x4*)(A.out + (size_t)row * DM + c);
#endif
                    const v2u y0 = *(const v2u*)(Y + (size_t)(2 * row) * DM + c), y1 = *(const v2u*)(Y + (size_t)(2 * row + 1) * DM + c);
                    const f32x4 ys = {bf_lo(y0.x) + bf_lo(y1.x), bf_hi(y0.x) + bf_hi(y1.x), bf_lo(y0.y) + bf_lo(y1.y), bf_hi(y0.y) + bf_hi(y1.y)};
                    v[j] = xr + g2p[j] * ys;
#ifdef XRES_BF16
                    { const v2u ow = {pk2(v[j].x, v[j].y), pk2(v[j].z, v[j].w)}; *(v2u*)(XB + (size_t)row * DM + c) = ow;
                      v[j] = (f32x4){bf_lo(ow.x), bf_hi(ow.x), bf_lo(ow.y), bf_hi(ow.y)}; }
#else
                    *(f32x4*)(A.out + (size_t)row * DM + c) = v[j];
#endif
                }
            }
#pragma unroll
            for (int j = 0; j < 8; ++j) s += (v[j].x * v[j].x + v[j].y * v[j].y) + (v[j].z * v[j].z + v[j].w * v[j].w);
            const float rstd = __builtin_amdgcn_rsqf(wave_sum(s) * (1.f / DM) + EPS);
#pragma unroll
            for (int j = 0; j < 8; ++j) { const f32x4 o = v[j] * rstd * gsc[j] + sh[j];
                *(v2u*)(H + (size_t)row * DM + 4 * F.lane + 256 * j) = (v2u){pk2(o.x, o.y), pk2(o.z, o.w)}; }
        }
    }
#endif
#ifndef ATT_CONV
    {
        LAS float* scr = (LAS float*)(F.lds + F.wave * 16384);
        constexpr int I_G = (DM / 64) * (DEXP / 32), I_D = (DEXP / 64) * (DM / 32), I_E = 2 * I_G + I_D;
        for (int it = gw; it < NEXP * I_E; it += NGW) {
            const int e = it / I_E; int r = it % I_E; const size_t eo = ((size_t)l * NEXP + e) * DM * DEXP;
            if (r < I_G) { transpose_item8<3>(A.in[I_EG] + eo, DEXP, DM, DEXP, F.ws + WS_W13 + (size_t)e * 2048 * DM, scr, r, F.lane); continue; } r -= I_G;
            if (r < I_G) { transpose_item8<4>(A.in[I_EU] + eo, DEXP, DM, DEXP, F.ws + WS_W13 + (size_t)e * 2048 * DM, scr, r, F.lane); continue; } r -= I_G;
            transpose_item8<0>(A.in[I_ED] + eo, DM, DEXP, DM, F.ws + WS_W2 + (size_t)e * DM * DEXP, scr, r, F.lane);
        }
    }
#endif
}
__device__ __forceinline__ void phase_final(Frame& F, const Args& A, int probe) {
    const int gw = F.vcu * NWAVES + F.wave, NGW = F.G * NWAVES;
    const float* mod = (const float*)(F.ws + WS_MOD); const bf16* Y = (const bf16*)(F.ws + WS_Y);
    for (int ch = gw; ch < T / 16; ch += NGW) {
        const int row0 = ch * 16, b = row0 >> 13;
#if defined(THIN_MLP) && defined(XRES_BF16)
#pragma unroll 1
        for (int rr = 0; rr < 16; rr += 2) {
            v2u xw[2][8], ya[2][8], yb[2][8]; f32x4 g2p[8]; f32x4 v[2][8];
#pragma unroll
            for (int q = 0; q < 2; ++q)
#pragma unroll
                for (int j = 0; j < 8; ++j) { const int c = 4 * F.lane + 256 * j; const int row = row0 + rr + q;
                    xw[q][j] = *(const v2u*)((const bf16*)(F.ws + WS_XB) + (size_t)row * DM + c); ya[q][j] = *(const v2u*)(Y + (size_t)(2 * row) * DM + c); yb[q][j] = *(const v2u*)(Y + (size_t)(2 * row + 1) * DM + c); }
#pragma unroll
            for (int j = 0; j < 8; ++j) g2p[j] = *(const f32x4*)(mod + ((size_t)(probe == 3 ? 0 : DEPTH - 1) * 4 + b) * 12288 + 5 * DM + 4 * F.lane + 256 * j);
            float rstd[2];
#pragma unroll
            for (int q = 0; q < 2; ++q) { float s = 0.f;
#pragma unroll
                for (int j = 0; j < 8; ++j) { const f32x4 xr = {bf_lo(xw[q][j].x), bf_hi(xw[q][j].x), bf_lo(xw[q][j].y), bf_hi(xw[q][j].y)};
                    const v2u y0 = ya[q][j], y1 = yb[q][j];
                    const f32x4 ys = {bf_lo(y0.x) + bf_lo(y1.x), bf_hi(y0.x) + bf_hi(y1.x), bf_lo(y0.y) + bf_lo(y1.y), bf_hi(y0.y) + bf_hi(y1.y)};
                    v[q][j] = (probe == 1 || probe == 2) ? xr : xr + g2p[j] * ys; }
#pragma unroll
                for (int j = 0; j < 8; ++j) s += (v[q][j].x * v[q][j].x + v[q][j].y * v[q][j].y) + (v[q][j].z * v[q][j].z + v[q][j].w * v[q][j].w);
                rstd[q] = __builtin_amdgcn_rsqf(wave_sum(s) * (1.f / DM) + EPS); }
#pragma unroll
            for (int j = 0; j < 8; ++j) { const int c = 4 * F.lane + 256 * j; const f32x4 fg = *(const f32x4*)(A.in[I_FG] + c);
#pragma unroll
                for (int q = 0; q < 2; ++q) *(f32x4*)(A.out + (size_t)(row0 + rr + q) * DM + c) = v[q][j] * rstd[q] * fg; }
        }
#else
        f32x4 fg[8], g2p[8];
#pragma unroll
        for (int j = 0; j < 8; ++j) { const int c = 4 * F.lane + 256 * j; fg[j] = *(const f32x4*)(A.in[I_FG] + c); g2p[j] = *(const f32x4*)(mod + ((size_t)(probe == 3 ? 0 : DEPTH - 1) * 4 + b) * 12288 + 5 * DM + c); }
#pragma unroll 1
        for (int rr = 0; rr < 16; ++rr) {
            const int row = row0 + rr; f32x4 v[8]; float s = 0.f;
#pragma unroll
            for (int j = 0; j < 8; ++j) { const int c = 4 * F.lane + 256 * j;
#ifdef XRES_BF16
                const v2u xw = *(const v2u*)((const bf16*)(F.ws + WS_XB) + (size_t)row * DM + c); const f32x4 xr = {bf_lo(xw.x), bf_hi(xw.x), bf_lo(xw.y), bf_hi(xw.y)};
#else
                const f32x4 xr = *(const f32x4*)((probe == 2 ? A.in[I_X] : A.out) + (size_t)row * DM + c);
#endif
                const v2u y0 = *(const v2u*)(Y + (size_t)(2 * row) * DM + c), y1 = *(const v2u*)(Y + (size_t)(2 * row + 1) * DM + c);
                const f32x4 ys = {bf_lo(y0.x) + bf_lo(y1.x), bf_hi(y0.x) + bf_hi(y1.x), bf_lo(y0.y) + bf_lo(y1.y), bf_hi(y0.y) + bf_hi(y1.y)};
                v[j] = (probe == 1 || probe == 2) ? xr : xr + g2p[j] * ys; }
#pragma unroll
            for (int j = 0; j < 8; ++j) s += (v[j].x * v[j].x + v[j].y * v[j].y) + (v[j].z * v[j].z + v[j].w * v[j].w);
            const float rstd = __builtin_amdgcn_rsqf(wave_sum(s) * (1.f / DM) + EPS);
#pragma unroll
            for (int j = 0; j < 8; ++j) *(f32x4*)(A.out + (size_t)row * DM + 4 * F.lane + 256 * j) = v[j] * rstd * fg[j];
        }
#endif
    }
}
#ifndef PROBE_DUMP_SCALE
#define PROBE_DUMP_SCALE 1.0f
#endif
#ifndef PROBE_DUMP_W
#define PROBE_DUMP_W 2048
#endif
__device__ __forceinline__ void phase_dump(Frame& F, const Args& A, size_t off, int pitch) {
    const int gw = F.vcu * NWAVES + F.wave, NGW = F.G * NWAVES;
    for (int row = gw; row < T; row += NGW) { const bf16* src = (const bf16*)(F.ws + off) + (size_t)row * pitch;
#ifdef PROBE_DUMP_F32
        for (int j = 0; j < 8; ++j) { const int c = 4 * F.lane + 256 * j; const float* sf = (const float*)(F.ws + off) + (size_t)row * pitch + c;
#ifdef PROBE_DUMP_SRC_OUT
            sf = A.out + (size_t)row * DM + c;
#endif
            f32x4 o = {0.f, 0.f, 0.f, 0.f}; if (c < PROBE_DUMP_W) o = *(const f32x4*)sf * PROBE_DUMP_SCALE;
#ifdef PROBE_DUMP_LOWBITS
            { const v4u ub = __builtin_bit_cast(v4u, o); o = (f32x4){(float)(ub.x & 0xFFFu), (float)(ub.y & 0xFFFu), (float)(ub.z & 0xFFFu), (float)(ub.w & 0xFFFu)}; }
#endif
            *(f32x4*)(A.out + (size_t)row * DM + c) = o; }
        continue;
#endif
        for (int j = 0; j < 8; ++j) { const int c = 4 * F.lane + 256 * j; const v2u w = *(const v2u*)(src + c);
#ifdef PROBE_DUMP_LOWBITS
            *(f32x4*)(A.out + (size_t)row * DM + c) = c < PROBE_DUMP_W ? (f32x4){(float)(w.x & 0x7Fu), (float)((w.x >> 16) & 0x7Fu), (float)(w.y & 0x7Fu), (float)((w.y >> 16) & 0x7Fu)} : (f32x4){0.f, 0.f, 0.f, 0.f}; } }
#else
            *(f32x4*)(A.out + (size_t)row * DM + c) = c < PROBE_DUMP_W ? (f32x4){bf_lo(w.x), bf_hi(w.x), bf_lo(w.y), bf_hi(w.y)} : (f32x4){0.f, 0.f, 0.f, 0.f}; } }
#endif
}
__device__ __forceinline__ void phase_mla_prep(Frame& F, const Args& A) {
    const int gw = F.vcu * NWAVES + F.wave, NGW = F.G * NWAVES;
    const bf16* P = (const bf16*)(F.ws + WS_PROJ); bf16* KF = (bf16*)(F.ws + WS_KF);
    float* rq = (float*)(F.ws + WS_RSTDQ); float* rkv = (float*)(F.ws + WS_RSTDKV); const float* rope = (const float*)(F.ws + WS_ROPE);
    for (int ch = gw; ch < T / 16; ch += NGW) {
#pragma unroll 1
        for (int r4 = 0; r4 < 16; r4 += 4) {
            v4u q[4]; v2u kv[4]; unsigned kr[4]; f32x2 cs[4];
#pragma unroll
            for (int u = 0; u < 4; ++u) { const int row = ch * 16 + r4 + u; const bf16* pr = P + (size_t)row * PROJ_LD;
                q[u] = *(const v4u*)(pr + C_CQ + 8 * F.lane); kv[u] = *(const v2u*)(pr + C_CKV + 4 * F.lane);
                kr[u] = *(const unsigned*)(pr + C_KR + 2 * (F.lane & 31)); cs[u] = *(const f32x2*)(rope + ((size_t)(row & (SEQ - 1)) * 32 + (F.lane & 31)) * 2); }
#pragma unroll
            for (int u = 0; u < 4; ++u) { const int row = ch * 16 + r4 + u;
                float sq = 0.f, skv = 0.f;
#pragma unroll
                for (int i = 0; i < 4; ++i) { const float a = bf_lo(q[u][i]), b2 = bf_hi(q[u][i]); sq += a * a + b2 * b2; }
#pragma unroll
                for (int i = 0; i < 2; ++i) { const float a = bf_lo(kv[u][i]), b2 = bf_hi(kv[u][i]); skv += a * a + b2 * b2; }
                sq = wave_sum(sq); skv = wave_sum(skv);
                if (F.lane == 0) { rq[row] = __builtin_amdgcn_rsqf(sq * (1.f / 512.f) + EPS); rkv[row] = __builtin_amdgcn_rsqf(skv * (1.f / 256.f) + EPS); }
                if (F.lane < 32) { const float x1 = bf_lo(kr[u]), x2 = bf_hi(kr[u]);
                    const unsigned o = pk2(x1 * cs[u].x - x2 * cs[u].y, x2 * cs[u].x + x1 * cs[u].y);
#pragma unroll
                    for (int h = 0; h < 8; ++h) *(unsigned*)(KF + (size_t)row * 1536 + h * 192 + 128 + 2 * F.lane) = o; } }
        }
    }
}
__device__ __forceinline__ void phase_q_rope(Frame& F, const Args& A) {
    const int gw = F.vcu * NWAVES + F.wave, NGW = F.G * NWAVES;
    bf16* QA = (bf16*)(F.ws + WS_QA); const float* rope = (const float*)(F.ws + WS_ROPE);
    for (int ch = gw; ch < T / 16; ch += NGW) {
#pragma unroll 1
        for (int r4 = 0; r4 < 16; r4 += 4) {
            v4u w[4]; f32x4 c01[4], c23[4];
#pragma unroll
            for (int u = 0; u < 4; ++u) { const int row = ch * 16 + r4 + u;
                w[u] = *(const v4u*)(QA + (size_t)row * 1536 + (F.lane >> 3) * 192 + 128 + (F.lane & 7) * 8);
                const f32x4* cs = (const f32x4*)(rope + ((size_t)(row & (SEQ - 1)) * 32 + (F.lane & 7) * 4) * 2); c01[u] = cs[0]; c23[u] = cs[1]; }
#pragma unroll
            for (int u = 0; u < 4; ++u) { const int row = ch * 16 + r4 + u; v4u o;
                { const float x1 = bf_lo(w[u].x), x2 = bf_hi(w[u].x); o.x = pk2(x1 * c01[u][0] - x2 * c01[u][1], x2 * c01[u][0] + x1 * c01[u][1]); }
                { const float x1 = bf_lo(w[u].y), x2 = bf_hi(w[u].y); o.y = pk2(x1 * c01[u][2] - x2 * c01[u][3], x2 * c01[u][2] + x1 * c01[u][3]); }
                { const float x1 = bf_lo(w[u].z), x2 = bf_hi(w[u].z); o.z = pk2(x1 * c23[u][0] - x2 * c23[u][1], x2 * c23[u][0] + x1 * c23[u][1]); }
                { const float x1 = bf_lo(w[u].w), x2 = bf_hi(w[u].w); o.w = pk2(x1 * c23[u][2] - x2 * c23[u][3], x2 * c23[u][2] + x1 * c23[u][3]); }
                *(v4u*)(QA + (size_t)row * 1536 + (F.lane >> 3) * 192 + 128 + (F.lane & 7) * 8) = o; }
        }
    }
}
#ifndef THIN_RO
#define THIN_RO 2
#endif
__device__ __forceinline__ void phase_out_norm(Frame& F, const Args& A, int l) {
    const int gw = F.vcu * NWAVES + F.wave, NGW = F.G * NWAVES;
    const bf16* OA = (const bf16*)(F.ws + WS_OA); const bf16* OB = (const bf16*)(F.ws + WS_OB); const float* LSE = (const float*)(F.ws + WS_LSE); bf16* Yn = (bf16*)(F.ws + WS_H);
    for (int ch = gw; ch < T / 16; ch += NGW) {
        float ga[2][8], gb[2][8];
#pragma unroll
        for (int hf = 0; hf < 2; ++hf)
#pragma unroll
            for (int i = 0; i < 8; ++i) { ga[hf][i] = A.in[I_ONA][l * 1024 + hf * 512 + 8 * F.lane + i]; gb[hf][i] = A.in[I_ONB][l * 1024 + hf * 512 + 8 * F.lane + i]; }
#ifdef THIN_MLP
#pragma unroll 1
        for (int rr = 0; rr < 16; rr += THIN_RO) {
            v4u ra_[THIN_RO][2], ro_[THIN_RO][2][3]; float ls_[THIN_RO][2][3];
#pragma unroll
            for (int q = 0; q < THIN_RO; ++q)
#pragma unroll
                for (int hf = 0; hf < 2; ++hf) { const int row = ch * 16 + rr + q, c = hf * 512 + 8 * F.lane, hd = c >> 7;
                    ra_[q][hf] = *(const v4u*)(OA + (size_t)row * 1024 + c);
#pragma unroll
                    for (int n = 0; n < 3; ++n) { ro_[q][hf][n] = *(const v4u*)(OB + ((size_t)n * T + row) * 1024 + c); ls_[q][hf][n] = LSE[((size_t)n * T + row) * 8 + hd]; } }
#pragma unroll
            for (int q = 0; q < THIN_RO; ++q) {
                const int row = ch * 16 + rr + q;
                float va[2][8], vb[2][8]; float sa = 0.f, sb = 0.f;
#pragma unroll
                for (int hf = 0; hf < 2; ++hf) {
                    const v4u a = ra_[q][hf];
#pragma unroll
                    for (int i = 0; i < 4; ++i) { va[hf][2 * i] = bf_lo(a[i]); va[hf][2 * i + 1] = bf_hi(a[i]); }
                    const float l0 = ls_[q][hf][0], l1 = ls_[q][hf][1], l2 = ls_[q][hf][2];
                    const float mx = fmaxf(l0, fmaxf(l1, l2)); const float e0 = __expf(l0 - mx), e1 = __expf(l1 - mx), e2 = __expf(l2 - mx); const float inv = 1.0f / (e0 + e1 + e2);
                    const float al[3] = {e0 * inv, e1 * inv, e2 * inv};
#pragma unroll
                    for (int i = 0; i < 8; ++i) vb[hf][i] = 0.f;
#pragma unroll
                    for (int n = 0; n < 3; ++n) { const v4u o = ro_[q][hf][n];
#pragma unroll
                        for (int i = 0; i < 4; ++i) { vb[hf][2 * i] += al[n] * bf_lo(o[i]); vb[hf][2 * i + 1] += al[n] * bf_hi(o[i]); } }
#pragma unroll
                    for (int i = 0; i < 8; ++i) { sa += va[hf][i] * va[hf][i]; sb += vb[hf][i] * vb[hf][i]; }
                }
                const float ra = __builtin_amdgcn_rsqf(wave_sum(sa) * (1.f / 1024.f) + EPS), rb = __builtin_amdgcn_rsqf(wave_sum(sb) * (1.f / 1024.f) + EPS);
#pragma unroll
                for (int hf = 0; hf < 2; ++hf) { const int c = hf * 512 + 8 * F.lane;
#ifdef G3_FP8
                    { unsigned char* Y8 = (unsigned char*)Yn; float ya[8], yb[8];
#pragma unroll
                      for (int i = 0; i < 8; ++i) { ya[i] = va[hf][i] * ra * ga[hf][i]; yb[i] = vb[hf][i] * rb * gb[hf][i]; }
                      *(v2u*)(Y8 + (size_t)row * DM + c) = (v2u){pk4_fp8(ya[0], ya[1], ya[2], ya[3]), pk4_fp8(ya[4], ya[5], ya[6], ya[7])};
                      *(v2u*)(Y8 + (size_t)row * DM + 1024 + c) = (v2u){pk4_fp8(yb[0], yb[1], yb[2], yb[3]), pk4_fp8(yb[4], yb[5], yb[6], yb[7])}; }
#else
                    { v4u wa, wb;
#pragma unroll
                      for (int i = 0; i < 4; ++i) { wa[i] = pk2(va[hf][2 * i] * ra * ga[hf][2 * i], va[hf][2 * i + 1] * ra * ga[hf][2 * i + 1]); wb[i] = pk2(vb[hf][2 * i] * rb * gb[hf][2 * i], vb[hf][2 * i + 1] * rb * gb[hf][2 * i + 1]); }
                      *(v4u*)(Yn + (size_t)row * DM + c) = wa; *(v4u*)(Yn + (size_t)row * DM + 1024 + c) = wb; }
#endif
                }
            }
        }
#else
#pragma unroll 1
        for (int rr = 0; rr < 16; ++rr) {
            const int row = ch * 16 + rr;
            float va[2][8], vb[2][8]; float sa = 0.f, sb = 0.f;
#pragma unroll
            for (int hf = 0; hf < 2; ++hf) {
                const int c = hf * 512 + 8 * F.lane, hd = c >> 7;
                const v4u a = *(const v4u*)(OA + (size_t)row * 1024 + c);
#pragma unroll
                for (int i = 0; i < 4; ++i) { va[hf][2 * i] = bf_lo(a[i]); va[hf][2 * i + 1] = bf_hi(a[i]); }
                const float l0 = LSE[((size_t)0 * T + row) * 8 + hd], l1 = LSE[((size_t)1 * T + row) * 8 + hd], l2 = LSE[((size_t)2 * T + row) * 8 + hd];
                const float mx = fmaxf(l0, fmaxf(l1, l2)); const float e0 = __expf(l0 - mx), e1 = __expf(l1 - mx), e2 = __expf(l2 - mx); const float inv = 1.0f / (e0 + e1 + e2);
                const float al[3] = {e0 * inv, e1 * inv, e2 * inv};
#pragma unroll
                for (int i = 0; i < 8; ++i) vb[hf][i] = 0.f;
#pragma unroll
                for (int n = 0; n < 3; ++n) { const v4u o = *(const v4u*)(OB + ((size_t)n * T + row) * 1024 + c);
#pragma unroll
                    for (int i = 0; i < 4; ++i) { vb[hf][2 * i] += al[n] * bf_lo(o[i]); vb[hf][2 * i + 1] += al[n] * bf_hi(o[i]); } }
#pragma unroll
                for (int i = 0; i < 8; ++i) { sa += va[hf][i] * va[hf][i]; sb += vb[hf][i] * vb[hf][i]; }
            }
            const float ra = __builtin_amdgcn_rsqf(wave_sum(sa) * (1.f / 1024.f) + EPS), rb = __builtin_amdgcn_rsqf(wave_sum(sb) * (1.f / 1024.f) + EPS);
#pragma unroll
            for (int hf = 0; hf < 2; ++hf) { const int c = hf * 512 + 8 * F.lane; v4u wa, wb;
#pragma unroll
                for (int i = 0; i < 4; ++i) { wa[i] = pk2(va[hf][2 * i] * ra * ga[hf][2 * i], va[hf][2 * i + 1] * ra * ga[hf][2 * i + 1]); wb[i] = pk2(vb[hf][2 * i] * rb * gb[hf][2 * i], vb[hf][2 * i + 1] * rb * gb[hf][2 * i + 1]); }
#ifdef G3_FP8
                { unsigned char* Y8 = (unsigned char*)Yn; float ya[8], yb[8];
#pragma unroll
                  for (int i = 0; i < 8; ++i) { ya[i] = va[hf][i] * ra * ga[hf][i]; yb[i] = vb[hf][i] * rb * gb[hf][i]; }
                  *(v2u*)(Y8 + (size_t)row * DM + c) = (v2u){pk4_fp8(ya[0], ya[1], ya[2], ya[3]), pk4_fp8(ya[4], ya[5], ya[6], ya[7])};
                  *(v2u*)(Y8 + (size_t)row * DM + 1024 + c) = (v2u){pk4_fp8(yb[0], yb[1], yb[2], yb[3]), pk4_fp8(yb[4], yb[5], yb[6], yb[7])}; }
#else
                *(v4u*)(Yn + (size_t)row * DM + c) = wa; *(v4u*)(Yn + (size_t)row * DM + 1024 + c) = wb;
#endif
            }
        }
#endif
    }
}
#ifndef ROUTER_SRC
#define ROUTER_SRC A.out
#endif
#ifdef ROUTER_MFMA
typedef short r_bf16x8 __attribute__((ext_vector_type(8)));
#ifndef RPA
#define RPA 2
#endif
__device__ __forceinline__ void phase_router(Frame& F, const Args& A, int l, int dummy = 0) {
    const float* mod = (const float*)(F.ws + WS_MOD);
    bf16* H = (bf16*)(F.ws + WS_H);
    LAS int* lcnt = (LAS int*)(F.lds + L_CNT); LAS int* gbase = lcnt + 16; LAS int* tokinfo = (LAS int*)(F.lds + L_TOK);
    LAS float* lgs = (LAS float*)(F.lds + L_ATAB);
    LAS float* rsl = (LAS float*)(F.lds + L_ATAB + 8704);
    LAS float* wsm = (LAS float*)(F.lds + L_ATAB + 8704 + 512);
    LAS float* cstl = (LAS float*)(F.lds + L_ATAB + 8704 + 1024);
    unsigned* gcnt = F.ctl + CW_CNT + (dummy ? 3 : l) * 16;
    int* rowidx = (int*)(F.ws + (dummy ? WS_OB : WS_ROWIDX)); float* aw = (float*)(F.ws + (dummy ? WS_OB + 4 * MiB : WS_AW));
    float rb[16];
#pragma unroll
    for (int e = 0; e < 16; ++e) rb[e] = __uint_as_float(__builtin_amdgcn_readfirstlane(__float_as_uint(A.in[I_RB][e])));
    for (int bi = F.vcu; bi < T / 128; bi += F.G) {
        const int row0 = bi * 128 + F.wave * 16, b = row0 >> 13;
        const rsrc_t rml = RSRC(mod + ((size_t)l * 4 + b) * 12288), rgn = RSRC(A.in[I_N2G] + l * DM), rh = RSRC(H), rxb = RSRC(F.ws + WS_XB), rrw = RSRC(A.in[I_RW]);
        __syncthreads();
        { const int t0_ = F.wave * 64 + lane_id(); if (t0_ < 16) lcnt[t0_] = 0;
          const int e4 = t0_ & 3; f32x4 ca = {0.f, 0.f, 0.f, 0.f};
#pragma unroll 4
          for (int i = 0; i < 16; ++i) { const int k = (t0_ >> 2) + 128 * i;
              const f32x4 w4 = bld4f(rrw, (k * 16 + e4 * 4) * 4, 0);
              const float g = __uint_as_float(__builtin_amdgcn_raw_buffer_load_b32(rgn, k * 4, 0, 0)) * (__uint_as_float(__builtin_amdgcn_raw_buffer_load_b32(rml, k * 4, 4 * DM * 4, 0)) + 1.0f);
              const float sh = __uint_as_float(__builtin_amdgcn_raw_buffer_load_b32(rml, k * 4, 3 * DM * 4, 0));
              ca += w4 * sh;
              const int ob = (k >> 5) * 1024 + (((k >> 3) & 3) * 16 + e4 * 4) * 16 + (k & 7) * 2;
#pragma unroll
              for (int c = 0; c < 4; ++c) { const float wp = w4[c] * g; const unsigned hi = pk2(wp, 0.f) & 0xffffu; const float rem = wp - __uint_as_float(hi << 16);
                  *(LAS unsigned short*)(F.lds + ob + c * 16) = (unsigned short)hi; *(LAS unsigned short*)(F.lds + 65536 + ob + c * 16) = (unsigned short)(pk2(rem, 0.f) & 0xffffu); } }
          const int ln = t0_ & 63;
#pragma unroll
          for (int q = 0; q < 4; ++q)
#pragma unroll
              for (int c = 0; c < 4; ++c) { const float s = wave_sum((ln & 3) == q ? ca[c] : 0.f); if (ln == 0) wsm[F.wave * 16 + q * 4 + c] = s; }
        }
        __syncthreads();
        { const int t0_ = F.wave * 64 + lane_id(); if (t0_ < 16) { float s = 0.f;
#pragma unroll
              for (int w = 0; w < 8; ++w) s += wsm[w * 16 + t0_];
              cstl[t0_] = s; } }
        __syncthreads();
        const int lo16 = F.lane * 16, lo8 = F.lane * 8;
        f32x4 gsv[8];
#pragma unroll
        for (int j = 0; j < 8; ++j) gsv[j] = bld4f(rgn, lo16 + j * 1024, 0) * (bld4f(rml, lo16 + j * 1024, 4 * DM * 4) + 1.0f);
#pragma unroll 1
        for (int rp = 0; rp < 16 / RPA; ++rp) {
            float ss[RPA] = {};
            v2u xraw[RPA][8];
#pragma unroll
            for (int q = 0; q < RPA; ++q)
#pragma unroll
                for (int j = 0; j < 8; ++j) xraw[q][j] = bld2u(rxb, lo8 + j * 512, (row0 + rp * RPA + q) * (DM * 2));
#define XV(q, j) ((f32x4){bf_lo(xraw[q][j].x), bf_hi(xraw[q][j].x), bf_lo(xraw[q][j].y), bf_hi(xraw[q][j].y)})
            f32x4 shv[8];
#pragma unroll
            for (int j = 0; j < 8; ++j) shv[j] = bld4f(rml, lo16 + j * 1024, 3 * DM * 4);
#pragma unroll
            for (int j = 0; j < 8; ++j)
#pragma unroll
                for (int q = 0; q < RPA; ++q) { const f32x4 x = XV(q, j); ss[q] += (x.x * x.x + x.y * x.y) + (x.z * x.z + x.w * x.w); }
            float rstd[RPA];
#pragma unroll
            for (int q = 0; q < RPA; ++q) rstd[q] = __builtin_amdgcn_rsqf(wave_sum(ss[q]) * (1.f / DM) + EPS);
            if (F.lane == 0) {
#pragma unroll
                for (int q = 0; q < RPA; ++q) rsl[F.wave * 16 + rp * RPA + q] = rstd[q]; }
#pragma unroll
            for (int j = 0; j < 8; ++j) {
#pragma unroll
                for (int q = 0; q < RPA; ++q) { const f32x4 o = XV(q, j) * rstd[q] * gsv[j] + shv[j]; __builtin_amdgcn_raw_buffer_store_b32(pk4_fp8(o.x, o.y, o.z, o.w), rh, F.lane * 4 + j * 256, (row0 + rp * RPA + q) * DM, 0); } }
#undef XV
        }
        { const int ln = lane_id(), col = ln & 15, rq = ln >> 4;
          const int va = col * (DM * 2) + rq * 16, sa = row0 * (DM * 2);
          f32x4 acc = {0.f, 0.f, 0.f, 0.f};
          r_bf16x8 a0[8], a1[8];
#pragma unroll
          for (int i = 0; i < 8; ++i) a0[i] = __builtin_bit_cast(r_bf16x8, __builtin_amdgcn_raw_buffer_load_b128(rxb, va + i * 64, sa, 0));
#define RT_MM(AR, sb) do { _Pragma("unroll") for (int i = 0; i < 8; ++i) { const int st = (sb) * 8 + i; \
              const r_bf16x8 bh = *(const LAS r_bf16x8*)(F.lds + st * 1024 + ln * 16), bl = *(const LAS r_bf16x8*)(F.lds + 65536 + st * 1024 + ln * 16); \
              acc = __builtin_amdgcn_mfma_f32_16x16x32_bf16(AR[i], bh, acc, 0, 0, 0); acc = __builtin_amdgcn_mfma_f32_16x16x32_bf16(AR[i], bl, acc, 0, 0, 0); } } while (0)
#pragma unroll 1
          for (int sb = 0; sb < 8; sb += 2) {
#pragma unroll
              for (int i = 0; i < 8; ++i) a1[i] = __builtin_bit_cast(r_bf16x8, __builtin_amdgcn_raw_buffer_load_b128(rxb, va + ((sb + 1) * 8 + i) * 64, sa, 0));
              RT_MM(a0, sb);
              if (sb + 2 < 8) {
#pragma unroll
                  for (int i = 0; i < 8; ++i) a0[i] = __builtin_bit_cast(r_bf16x8, __builtin_amdgcn_raw_buffer_load_b128(rxb, va + ((sb + 2) * 8 + i) * 64, sa, 0)); }
              RT_MM(a1, sb + 1);
          }
#undef RT_MM
          LDS_WAIT();
          const float cs = cstl[col];
#pragma unroll
          for (int i = 0; i < 4; ++i) lgs[F.wave * 272 + (4 * rq + i) * 17 + col] = acc[i] * rsl[F.wave * 16 + 4 * rq + i] + cs;
          LDS_WAIT(); asm volatile("" ::: "memory");
          if (ln < 16) {
              float sc[16], bs[16];
#pragma unroll
              for (int e = 0; e < 16; ++e) { const float lg = lgs[F.wave * 272 + ln * 17 + e]; sc[e] = 1.0f / (1.0f + __expf(-lg)); bs[e] = sc[e] + rb[e]; }
              float gs4[4];
#pragma unroll
              for (int g = 0; g < 4; ++g) { const float a = bs[4 * g], b2 = bs[4 * g + 1], c = bs[4 * g + 2], d = bs[4 * g + 3];
                  const float h1 = fmaxf(a, b2), l1 = fminf(a, b2), h2 = fmaxf(c, d), l2 = fminf(c, d);
                  gs4[g] = fmaxf(h1, h2) + fmaxf(fminf(h1, h2), fmaxf(l1, l2)); }
              int gsel = 0; float gbest = gs4[0];
#pragma unroll
              for (int g = 1; g < 4; ++g) if (gs4[g] > gbest) { gbest = gs4[g]; gsel = g; }
              float bv[4], sv[4];
#pragma unroll
              for (int i = 0; i < 4; ++i) { bv[i] = gsel == 0 ? bs[i] : gsel == 1 ? bs[4 + i] : gsel == 2 ? bs[8 + i] : bs[12 + i]; sv[i] = gsel == 0 ? sc[i] : gsel == 1 ? sc[4 + i] : gsel == 2 ? sc[8 + i] : sc[12 + i]; }
              int i1 = 0; float b1 = bv[0], s1 = sv[0];
#pragma unroll
              for (int i = 1; i < 4; ++i) if (bv[i] > b1) { b1 = bv[i]; s1 = sv[i]; i1 = i; }
              int i2 = -1; float b2v = -__builtin_inff(), s2 = 0.f;
#pragma unroll
              for (int i = 0; i < 4; ++i) if (i != i1 && bv[i] > b2v) { b2v = bv[i]; s2 = sv[i]; i2 = i; }
              const float inv = 1.0f / (s1 + s2);
              const int r = F.wave * 16 + ln, e0 = gsel * 4 + i1, e1 = gsel * 4 + i2;
              tokinfo[r * 4 + 0] = e0; tokinfo[r * 4 + 2] = e1;
              const int row = row0 + ln; *(f32x2*)(aw + (size_t)row * 2) = (f32x2){s1 * inv, s2 * inv};
          }
        }
        __syncthreads();
        const int tb_ = F.wave * 64 + lane_id();
        {
            const int ln = tb_ & 63;
#pragma unroll
            for (int ee = 0; ee < 2; ++ee) { const int e = 2 * F.wave + ee; int base = 0;
#pragma unroll
                for (int hh = 0; hh < 2; ++hh) { const int r = hh * 64 + ln; const bool m0 = tokinfo[r * 4 + 0] == e, m1 = tokinfo[r * 4 + 2] == e;
                    const unsigned long long bal = __ballot(m0 || m1);
                    const int pos = base + __builtin_amdgcn_mbcnt_hi((unsigned)(bal >> 32), __builtin_amdgcn_mbcnt_lo((unsigned)bal, 0));
                    if (m0) tokinfo[r * 4 + 1] = pos; if (m1) tokinfo[r * 4 + 3] = pos;
                    base += __popcll(bal); }
                if (ln == 0) lcnt[e] = base; } }
        __syncthreads();
        if (tb_ < 16) gbase[tb_] = (int)__hip_atomic_fetch_add(gcnt + tb_, (unsigned)lcnt[tb_], __ATOMIC_RELAXED, __HIP_MEMORY_SCOPE_AGENT);
        __syncthreads();
        if (tb_ < 128) { const int e0 = tokinfo[tb_ * 4], p0 = tokinfo[tb_ * 4 + 1], e1 = tokinfo[tb_ * 4 + 2], p1 = tokinfo[tb_ * 4 + 3]; const int row = bi * 128 + tb_;
            rowidx[(size_t)e0 * 32768 + gbase[e0] + p0] = 2 * row; rowidx[(size_t)e1 * 32768 + gbase[e1] + p1] = 2 * row + 1; }
        __syncthreads();
    }
}
#else
__device__ __forceinline__ void phase_router(Frame& F, const Args& A, int l, int dummy = 0) {
    const float* mod = (const float*)(F.ws + WS_MOD);
    bf16* H = (bf16*)(F.ws + WS_H);
    LAS f32x4* rwl = (LAS f32x4*)F.lds;
    LAS int* lcnt = (LAS int*)(F.lds + L_CNT); LAS int* gbase = lcnt + 16; LAS int* tokinfo = (LAS int*)(F.lds + L_TOK);
    unsigned* gcnt = F.ctl + CW_CNT + (dummy ? 3 : l) * 16;
    int* rowidx = (int*)(F.ws + (dummy ? WS_OB : WS_ROWIDX)); float* aw = (float*)(F.ws + (dummy ? WS_OB + 4 * MiB : WS_AW));
    for (int q = F.tid; q < 8192; q += NWAVES * 64) { const int k = q >> 2, e4 = q & 3, ln = (k & 255) >> 2, j = k >> 8, i = k & 3;
        rwl[((j * 4 + i) * 4 + e4) * 64 + ln] = *(const f32x4*)(A.in[I_RW] + (size_t)k * 16 + e4 * 4); }
    float rb[16];
#pragma unroll
    for (int e = 0; e < 16; ++e) rb[e] = __uint_as_float(__builtin_amdgcn_readfirstlane(__float_as_uint(A.in[I_RB][e])));
    __syncthreads();
    for (int bi = F.vcu; bi < T / 128; bi += F.G) {
        { const int t0_ = F.wave * 64 + lane_id(); if (t0_ < 16) lcnt[t0_] = 0; }
        __syncthreads();
        const int row0 = bi * 128 + F.wave * 16, b = row0 >> 13;
        const rsrc_t rml = RSRC(mod + ((size_t)l * 4 + b) * 12288), rgn = RSRC(A.in[I_N2G] + l * DM), rx = RSRC(ROUTER_SRC), rh = RSRC(H);
#ifdef XRES_BF16
        const rsrc_t rxb = RSRC(F.ws + WS_XB);
#endif
        const int lo16 = F.lane * 16, lo8 = F.lane * 8;
        float cst[16];
        { f32x4 ca[4] = {};
#pragma unroll
          for (int j = 0; j < 8; ++j) { const f32x4 sh = bld4f(rml, lo16 + j * 1024, 3 * DM * 4);
#pragma unroll
            for (int i = 0; i < 4; ++i)
#pragma unroll
                for (int e4 = 0; e4 < 4; ++e4) ca[e4] += rwl[((j * 4 + i) * 4 + e4) * 64 + F.lane] * sh[i];
            asm volatile("" ::: "memory"); }
#pragma unroll
          for (int e = 0; e < 16; ++e) cst[e] = __uint_as_float(__builtin_amdgcn_readfirstlane(__float_as_uint(wave_sum(ca[e >> 2][e & 3])))); }
        f32x4 gsv[8];
#pragma unroll
        for (int j = 0; j < 8; ++j) gsv[j] = bld4f(rgn, lo16 + j * 1024, 0) * (bld4f(rml, lo16 + j * 1024, 4 * DM * 4) + 1.0f);
#pragma unroll 1
        for (int rp = 0; rp < 8; ++rp) {
            float ss[2] = {0.f, 0.f}; f32x4 acc[2][4] = {};
            const int so0 = (row0 + rp * 2) * (DM * 4);
#ifdef XRES_BF16
            v2u xraw[2][8];
#pragma unroll
            for (int q = 0; q < 2; ++q)
#pragma unroll
                for (int j = 0; j < 8; ++j) xraw[q][j] = bld2u(rxb, lo8 + j * 512, (row0 + rp * 2 + q) * (DM * 2));
#define XV(q, j) ((f32x4){bf_lo(xraw[q][j].x), bf_hi(xraw[q][j].x), bf_lo(xraw[q][j].y), bf_hi(xraw[q][j].y)})
#else
            f32x4 xv[2][8];
#pragma unroll
            for (int q = 0; q < 2; ++q)
#pragma unroll
                for (int j = 0; j < 8; ++j) xv[q][j] = bld4f(rx, lo16 + j * 1024, so0 + q * (DM * 4));
#define XV(q, j) xv[q][j]
#endif
#pragma unroll
            for (int j = 0; j < 8; ++j) {
                f32x4 a[2];
#pragma unroll
                for (int q = 0; q < 2; ++q) { const f32x4 x = XV(q, j); ss[q] += (x.x * x.x + x.y * x.y) + (x.z * x.z + x.w * x.w); a[q] = x * gsv[j]; }
#pragma unroll
                for (int i = 0; i < 4; ++i) {
#pragma unroll
                    for (int e4 = 0; e4 < 4; ++e4) { const f32x4 w = rwl[((j * 4 + i) * 4 + e4) * 64 + F.lane]; acc[0][e4] += w * a[0][i]; acc[1][e4] += w * a[1][i]; }
                    asm volatile("" : "+v"(acc[0][0]), "+v"(acc[0][1]), "+v"(acc[0][2]), "+v"(acc[0][3]), "+v"(acc[1][0]), "+v"(acc[1][1]), "+v"(acc[1][2]), "+v"(acc[1][3]) :: "memory"); } }
            float rstd[2];
#pragma unroll
            for (int q = 0; q < 2; ++q) rstd[q] = __builtin_amdgcn_rsqf(wave_sum(ss[q]) * (1.f / DM) + EPS);
            asm volatile("" ::: "memory");
            f32x4 shv[8];
#pragma unroll
            for (int j = 0; j < 8; ++j) shv[j] = bld4f(rml, lo16 + j * 1024, 3 * DM * 4);
#pragma unroll
            for (int j = 0; j < 8; ++j) {
#pragma unroll
                for (int q = 0; q < 2; ++q) { const f32x4 o = XV(q, j) * rstd[q] * gsv[j] + shv[j]; __builtin_amdgcn_raw_buffer_store_b32(pk4_fp8(o.x, o.y, o.z, o.w), rh, F.lane * 4 + j * 256, (row0 + rp * 2 + q) * DM, 0); } }
#undef XV
#pragma unroll
            for (int q = 0; q < 2; ++q) {
                float sc[16], bs[16];
#pragma unroll
                for (int e = 0; e < 16; ++e) { const float lg = wave_sum(acc[q][e >> 2][e & 3]) * rstd[q] + cst[e]; sc[e] = 1.0f / (1.0f + __expf(-lg)); bs[e] = sc[e] + rb[e]; }
                float gs4[4];
#pragma unroll
                for (int g = 0; g < 4; ++g) { const float a = bs[4 * g], b2 = bs[4 * g + 1], c = bs[4 * g + 2], d = bs[4 * g + 3];
                    const float h1 = fmaxf(a, b2), l1 = fminf(a, b2), h2 = fmaxf(c, d), l2 = fminf(c, d);
                    gs4[g] = fmaxf(h1, h2) + fmaxf(fminf(h1, h2), fmaxf(l1, l2)); }
                int gsel = 0; float gbest = gs4[0];
#pragma unroll
                for (int g = 1; g < 4; ++g) if (gs4[g] > gbest) { gbest = gs4[g]; gsel = g; }
                float bv[4], sv[4];
#pragma unroll
                for (int i = 0; i < 4; ++i) { bv[i] = gsel == 0 ? bs[i] : gsel == 1 ? bs[4 + i] : gsel == 2 ? bs[8 + i] : bs[12 + i]; sv[i] = gsel == 0 ? sc[i] : gsel == 1 ? sc[4 + i] : gsel == 2 ? sc[8 + i] : sc[12 + i]; }
                int i1 = 0; float b1 = bv[0], s1 = sv[0];
#pragma unroll
                for (int i = 1; i < 4; ++i) if (bv[i] > b1) { b1 = bv[i]; s1 = sv[i]; i1 = i; }
                int i2 = -1; float b2v = -__builtin_inff(), s2 = 0.f;
#pragma unroll
                for (int i = 0; i < 4; ++i) if (i != i1 && bv[i] > b2v) { b2v = bv[i]; s2 = sv[i]; i2 = i; }
                const float inv = 1.0f / (s1 + s2);
                if (F.lane == 0) {
                    const int r = F.wave * 16 + rp * 2 + q, e0 = gsel * 4 + i1, e1 = gsel * 4 + i2;
                    tokinfo[r * 4 + 0] = e0; tokinfo[r * 4 + 2] = e1;
                    const int row = row0 + rp * 2 + q; *(f32x2*)(aw + (size_t)row * 2) = (f32x2){s1 * inv, s2 * inv};
                }
            }
        }
        __syncthreads();
        const int tb_ = F.wave * 64 + lane_id();
        if (tb_ < 16) {
            int c = 0;
            for (int r = 0; r < 128; ++r) { if (tokinfo[r * 4 + 0] == tb_) tokinfo[r * 4 + 1] = c++; if (tokinfo[r * 4 + 2] == tb_) tokinfo[r * 4 + 3] = c++; }
            gbase[tb_] = (int)__hip_atomic_fetch_add(gcnt + tb_, (unsigned)c, __ATOMIC_RELAXED, __HIP_MEMORY_SCOPE_AGENT); }
        __syncthreads();
        if (tb_ < 128) { const int e0 = tokinfo[tb_ * 4], p0 = tokinfo[tb_ * 4 + 1], e1 = tokinfo[tb_ * 4 + 2], p1 = tokinfo[tb_ * 4 + 3]; const int row = bi * 128 + tb_;
            rowidx[(size_t)e0 * 32768 + gbase[e0] + p0] = 2 * row; rowidx[(size_t)e1 * 32768 + gbase[e1] + p1] = 2 * row + 1; }
        __syncthreads();
    }
}
#endif
__device__ __forceinline__ int moe_setup(Frame& F, int l) {
    LAS int* ts = (LAS int*)(F.lds + L_TS);
    if (F.tid == 0) { int s = 0; for (int e = 0; e < 16; ++e) { ts[e] = s; s += ((int)__hip_atomic_load(F.ctl + CW_CNT + l * 16 + e, __ATOMIC_RELAXED, __HIP_MEMORY_SCOPE_AGENT) + 255) >> 8; } ts[16] = s; }
    __syncthreads();
    return __builtin_amdgcn_readfirstlane(ts[16]);
}

__device__ __forceinline__ att::Blk mla_blk(int bh, int qb) {
    const int b = bh >> 3, h = bh & 7; att::Blk k;
    k.qo = (unsigned)(WS_QA + ((size_t)b * SEQ * 1536 + h * 192) * 2); k.ko = (unsigned)(WS_KF + ((size_t)b * SEQ * 1536 + h * 192) * 2);
    k.vo = (unsigned)(WS_VB + ((size_t)b * SEQ * 1024 + h * 128) * 2); k.oo = (unsigned)(WS_OA + ((size_t)b * SEQ * 1024 + h * 128) * 2); k.lo = 0;
    k.P0 = qb * 256; k.rate = 1; k.beta = 0.f;
    return k;
}
__device__ __forceinline__ att::Blk dil_blk(int bh, int br, int blk) {
    const int b = bh >> 3, h = bh & 7, rate = br == 0 ? 1 : br == 1 ? 4 : 16, nqb = 32 / rate, cls = blk / nqb, qb = blk % nqb; att::Blk k;
    const size_t tok0 = (size_t)b * SEQ + cls;
    const unsigned p = (unsigned)(WS_PROJ + (tok0 * PROJ_LD + h * 128) * 2);
    k.qo = p + C_QB * 2; k.ko = p + C_KB * 2; k.vo = p + C_VB * 2;
    k.oo = (unsigned)(WS_OB + (((size_t)br * T + tok0) * 1024 + h * 128) * 2);
    k.lo = (unsigned)(WS_LSE + (((size_t)br * T + tok0) * 8 + h) * 4);
    k.P0 = qb * 256; k.rate = rate;
    const float slope = __builtin_amdgcn_exp2f(-(float)(h + 1));
    k.beta = slope * (float)rate * 11.313708498984761f;
    return k;
}
__device__ __forceinline__ void mla_decode(int id, int& bh, int& qb0, int& qb1) {
    const int v = id & 255, i = id >> 8, x = v >> 5, c = v & 31, j = i * 32 + c; bh = 4 * x + (j >> 4); const int s = j & 15; qb0 = s; qb1 = 31 - s;
}
__device__ __forceinline__ void dil_decode(int id, int& bh, int& br, int& blk) {
    const int v = id & 255, i = id >> 8, x = v >> 5, c = v & 31, j = i * 32 + c; bh = 4 * x + j / 96; const int r = j % 96; br = r >> 5; blk = r & 31;
}
#ifndef ATT_DIL_NS
#define ATT_DIL_NS 4
#endif
#ifndef ATT_SKEW_SEL
#define ATT_SKEW_SEL 0
#endif
#if ATT_SKEW_SEL == 0
#define ATT_SKEW_PICK(w) ((w) < 4)
#elif ATT_SKEW_SEL == 1
#define ATT_SKEW_PICK(w) (((w) & 1) == 0)
#elif ATT_SKEW_SEL == 2
#define ATT_SKEW_PICK(w) true
#else
#define ATT_SKEW_PICK(w) false
#endif
#ifdef ATT_DMA
#define ATT_SEAM(d) att::SeamD<d>
#define ATT_DMA_ON ATT_DMA
#else
#define ATT_SEAM(d) att::Seam<d>
#define ATT_DMA_ON 0
#endif
#if ATT_DMA_ON == 2
template <int ORD>
__device__ __forceinline__ void mla_stream2(Frame& F, char* lds) {
    constexpr int NIT = 512;
    int id = F.vcu;
    if (id < NIT) {
        att::SeamD<192> S; int bh, q0, q1; mla_decode(id, bh, q0, q1); int pass = 0;
        att::Blk cur = mla_blk(bh, q0);
        att::att_prime_dma2<192, false>(cur, (const char*)F.ws, lds, S, F.tid);
        for (;;) {
            const bool more_pass = pass == 0, more_item = id + F.G < NIT, last = !more_pass && !more_item;
            att::Blk nxt = cur; int idn = id, passn = pass + 1;
            if (more_pass) nxt = mla_blk(bh, q1);
            else if (more_item) { idn = id + F.G; passn = 0; mla_decode(idn, bh, q0, q1); nxt = mla_blk(bh, q0); }
            att::att_block_dma2<192, false, false, ORD>(cur, nxt, (const char*)F.ws, lds, S, F.tid);
            if (last) break;
            cur = nxt; id = idn; pass = passn;
        }
    }
}
template <int ORD>
__device__ __forceinline__ void dil_stream2(Frame& F, char* lds) {
    constexpr int NIT = 3072;
    int id = F.vcu;
    if (id < NIT) {
        att::SeamD<128> S; int bh, br, blk; dil_decode(id, bh, br, blk);
        att::Blk cur = dil_blk(bh, br, blk);
        att::att_prime_dma2<128, true>(cur, (const char*)F.ws, lds, S, F.tid);
        for (;;) {
            const bool last = id + F.G >= NIT;
            att::Blk nxt = cur;
            if (!last) { dil_decode(id + F.G, bh, br, blk); nxt = dil_blk(bh, br, blk); }
            att::att_block_dma2<128, true, true, ORD>(cur, nxt, (const char*)F.ws, lds, S, F.tid);
            if (last) break;
            cur = nxt; id += F.G;
        }
    }
}
#endif
template <int PV>
__device__ __forceinline__ void dil_stream_reg(Frame& F, char* lds, int rep_, const Args& A, int l, int cvj0) {
        constexpr int NIT = 3072;
        int id = F.vcu;
        if (id < NIT) {
#if ATT_DMA_ON == 1
            att::SeamD<128> S;
#else
            att::Seam<128> S;
#endif
            S.cv_j = cvj0;
            int bh, br, blk; dil_decode(id, bh, br, blk);
            att::Blk cur = dil_blk(bh, br, blk);
#if defined(ATT_CONV) && ATT_CONV == 2
            const size_t eo_ = (size_t)l * NEXP * DM * DEXP;
            const att::ConvCtx X = {A.in[I_EG] + eo_, A.in[I_EU] + eo_, A.in[I_ED] + eo_, F.ws + WS_W13, F.ws + WS_W2, F.vcu * 8 + __builtin_amdgcn_readfirstlane(F.tid >> 6)};
#endif
#if ATT_DMA_ON == 1
            att::att_prime_dma<128, true, ATT_DIL_NS>(cur, (const char*)F.ws, lds, S, F.tid);
#else
            att::att_prime<128, true, PV>(cur, (const char*)F.ws, lds, S, F.tid);
#endif
            for (;;) {
                const bool last = id + F.G >= NIT;
                att::Blk nxt = cur;
                if (!last) { dil_decode(id + F.G, bh, br, blk); nxt = dil_blk(bh, br, blk); }
#if ATT_DMA_ON == 1
                att::att_block_dma<128, true, true, ATT_DIL_NS>(cur, nxt, (const char*)F.ws, lds, lds + RING_BYTES + 512, S, F.tid);
#else
#if defined(ATT_CONV) && ATT_CONV == 2
                att::att_block<128, true, true, PV, 2>(cur, nxt, (const char*)F.ws, lds, S, F.tid, &X);
#else
                att::att_block<128, true, true, PV>(cur, nxt, (const char*)F.ws, lds, S, F.tid);
#endif
#endif
                if (last) break;
                cur = nxt; id += F.G;
            }
#if defined(ATT_CONV) && ATT_CONV == 2
            { const int ln_ = lane_id(); char* scr_ = lds + att::CONV_SCR_DIL + __builtin_amdgcn_readfirstlane(F.tid >> 6) * 4352;
              if (S.cv_pend) { asm volatile("s_waitcnt vmcnt(0)" ::: "memory"); att::conv_put_full(X, S.cv_j, S.cvf, scr_, ln_); ++S.cv_j; if (S.cv_pend > 1) { att::conv_put_full(X, S.cv_j, S.cvf + 16, scr_, ln_); ++S.cv_j; } S.cv_pend = 0; }
              int jj_ = S.cv_j;
#pragma unroll 1
              while (jj_ < att::CONV_NJ) { float cb_[4][16];
#pragma unroll
                  for (int u = 0; u < 4; ++u) if (jj_ + u < att::CONV_NJ) att::conv_load_full(X, jj_ + u, cb_[u], ln_);
                  asm volatile("s_waitcnt vmcnt(0)" ::: "memory");
#pragma unroll
                  for (int u = 0; u < 4; ++u) if (jj_ + u < att::CONV_NJ) att::conv_put_full(X, jj_ + u, cb_[u], scr_, ln_);
                  jj_ += 4; }
              S.cv_j = att::CONV_NJ; }
#endif
#if defined(ATT_DEFER) && ATT_DMA_ON != 1
            if (S.p_on) { const int ln_ = F.tid & 63; const char* stg_ = lds + att::DEFER_STG + __builtin_amdgcn_readfirstlane(F.tid >> 6) * 8192;
#pragma unroll
                for (int p = 0; p < 8; ++p) att::flush_piece(stg_, p, (const char*)F.ws + S.p_oo, S.p_rb, S.p_so0, ln_); }
#endif
        }
}
static_assert(WS_ROPE == att::ROPE_OFF, "rope table offset");
#ifdef ATT_QROPE
#define ATT_ROPE_FLAG true
#else
#define ATT_ROPE_FLAG false
#endif
__device__ __forceinline__ void phase_attention(Frame& F, char* lds, const Args& A, int l) {
#ifdef ATT_PRIO
    if (__builtin_amdgcn_readfirstlane(F.tid >> 6) >= 4) __builtin_amdgcn_s_setprio(1);
#endif
#ifndef ATT_MLA_SKCONV
#define ATT_MLA_SKCONV 0
#endif
    int cvj_ = 0;
#ifndef NO_MLA
#ifndef PROBE_REP_MLA
#define PROBE_REP_MLA 1
#endif
    for (int rep_ = 0; rep_ < PROBE_REP_MLA; ++rep_) {
        if (rep_) __syncthreads();
#if ATT_DMA_ON == 2
        { const int wsel_ = __builtin_amdgcn_readfirstlane(F.tid >> 6);
          if (ATT_SKEW_PICK(wsel_)) mla_stream2<0>(F, lds); else mla_stream2<1>(F, lds); }
#else
        constexpr int NIT = 512;
        int id = F.vcu;
        if (id < NIT) {
            ATT_SEAM(192) S; int bh, q0, q1; mla_decode(id, bh, q0, q1); int pass = 0;
            att::Blk cur = mla_blk(bh, q0);
#if defined(ATT_CONV) && (ATT_CONV == 1 || defined(ATT_MLA_SK))
            const size_t eo_ = (size_t)l * NEXP * DM * DEXP;
            const att::ConvCtx X = {A.in[I_EG] + eo_, A.in[I_EU] + eo_, A.in[I_ED] + eo_, F.ws + WS_W13, F.ws + WS_W2, F.vcu * 8 + __builtin_amdgcn_readfirstlane(F.tid >> 6)};
#endif
#if ATT_DMA_ON
            att::att_prime_dma<192, false, 3>(cur, (const char*)F.ws, lds, S, F.tid);
#else
#ifdef ATT_QROPE
            att::att_prime<192, false, 0, true>(cur, (const char*)F.ws, lds, S, F.tid);
#else
            att::att_prime<192, false>(cur, (const char*)F.ws, lds, S, F.tid);
#endif
#endif
            for (;;) {
                const bool more_pass = pass == 0, more_item = id + F.G < NIT, last = !more_pass && !more_item;
                att::Blk nxt = cur; int idn = id, passn = pass + 1;
                if (more_pass) nxt = mla_blk(bh, q1);
                else if (more_item) { idn = id + F.G; passn = 0; mla_decode(idn, bh, q0, q1); nxt = mla_blk(bh, q0); }
#if ATT_DMA_ON
                att::att_block_dma<192, false, false, 3>(cur, nxt, (const char*)F.ws, lds, lds + 3 * att::SHM_V + 3 * att::Cfg<192>::SHM_K, S, F.tid);
#else
#if defined(ATT_CONV) && ATT_CONV == 1
                att::att_block<192, false, false, 0, 1, ATT_ROPE_FLAG>(cur, nxt, (const char*)F.ws, lds, S, F.tid, &X);
#elif defined(ATT_MLA_SK)
                att::att_block<192, false, true, 0, ATT_MLA_SKCONV, ATT_ROPE_FLAG>(cur, nxt, (const char*)F.ws, lds, S, F.tid, &X);
#elif defined(ATT_QROPE)
                att::att_block<192, false, false, 0, 0, true>(cur, nxt, (const char*)F.ws, lds, S, F.tid);
#else
                att::att_block<192, false, false>(cur, nxt, (const char*)F.ws, lds, S, F.tid);
#endif
#endif
                if (last) break;
                cur = nxt; id = idn; pass = passn;
            }
#ifdef ATT_MLA_SK
            { const int ln_ = lane_id(); char* scr_ = lds + att::CONV_SCR + __builtin_amdgcn_readfirstlane(F.tid >> 6) * 4352;
              if (S.cv_pend) { asm volatile("s_waitcnt vmcnt(0)" ::: "memory"); att::conv_put_full(X, S.cv_j, S.cvf, scr_, ln_); ++S.cv_j; if (S.cv_pend > 1) { att::conv_put_full(X, S.cv_j, S.cvf + 16, scr_, ln_); ++S.cv_j; } S.cv_pend = 0; }
              cvj_ = S.cv_j; }
#endif
#if defined(ATT_CONV) && ATT_CONV == 1
            { const int ln_ = lane_id(); char* scr_ = lds + att::CONV_SCR + __builtin_amdgcn_readfirstlane(F.tid >> 6) * 4352;
              while (S.cv_j < att::CONV_NJ) { att::conv_load(X, S.cv_j, S.cv_q, S.cv, ln_); asm volatile("s_waitcnt vmcnt(0)" ::: "memory");
                  att::conv_put(X, S.cv_j, S.cv_q, S.cv, scr_, ln_); if (++S.cv_q == 4) { S.cv_q = 0; ++S.cv_j; } S.cl_j = S.cv_j; S.cl_q = S.cv_q; } }
#endif
        }
#endif
    }
#endif
#ifndef NO_DIL
#ifndef PROBE_REP_DIL
#define PROBE_REP_DIL 1
#endif
#ifndef PROBE_DIL_VAR
#define PROBE_DIL_VAR 0
#endif
#if ATT_DMA_ON == 2 && !defined(ATT_DIL_DMA2)
    asm volatile("s_waitcnt vmcnt(0)" ::: "memory"); __syncthreads();
#endif
    for (int rep_ = 0; rep_ < PROBE_REP_DIL; ++rep_) {
        if (rep_) __syncthreads();
#if ATT_DMA_ON == 2 && defined(ATT_DIL_DMA2)
        { const int wsel_ = __builtin_amdgcn_readfirstlane(F.tid >> 6);
          if (ATT_SKEW_PICK(wsel_)) dil_stream2<0>(F, lds); else dil_stream2<1>(F, lds); }
#else
        if (rep_ + 1 < PROBE_REP_DIL) dil_stream_reg<PROBE_DIL_VAR>(F, lds, rep_, A, l, cvj_); else dil_stream_reg<0>(F, lds, rep_, A, l, cvj_);
#endif
    }
#endif
#ifdef ATT_PRIO
    __builtin_amdgcn_s_setprio(0);
#endif
}
#ifndef MK_PER_PHASE
#define MK_PER_PHASE 0
#endif
constexpr int NPH = 2 + 11 * DEPTH;
__global__ void __launch_bounds__(NWAVES * 64, 2) mk_fwd(Args args) {
    extern __shared__ __attribute__((aligned(16))) unsigned char lds[];
    Frame F;
    F.lds = (LAS unsigned char*)lds; F.ldsg = lds;
    F.wave = __builtin_amdgcn_readfirstlane((int)threadIdx.x >> 6); F.lane = lane_id(); F.tid = F.wave * 64 + F.lane;
    F.G = gridDim.x; { const int bx = blockIdx.x; F.vcu = (F.G % 8 == 0) ? (bx % 8) * (F.G / 8) + bx / 8 : bx; }
    F.ws = args.ws; F.ctl = (unsigned*)(args.ws + WS_CTL);
    for (int u = F.tid; u < (LDS_BYTES - RING_BYTES) / 4; u += NWAVES * 64) ((LAS unsigned*)(F.lds + RING_BYTES))[u] = 0u;
    __syncthreads();
    volatile LAS unsigned* MISC = (volatile LAS unsigned*)(F.lds + L_MISC);
    XcdBarrier bar; bar.bar = F.ctl + CW_BAR; bar.x = 0; bar.st = nullptr;
    if (!MK_PER_PHASE) bar = xcd_barrier_post(F.ctl + CW_BAR, MISC + 8, F.tid);
    const int lo = args.ph_lo, hi = args.ph_hi;
#ifndef PROBE_GRID1_PHASE
#define PROBE_GRID1_PHASE (-1)
#endif
#define PROBE_GRID1(p) ((p) == PROBE_GRID1_PHASE)
#ifndef PROBE_MODE
#define PROBE_MODE 1
#endif
#ifndef PROBE_REP_MASK
#define PROBE_REP_MASK 0
#endif
#define NREP(j) ((((PROBE_REP_MASK) >> (j)) & 1) ? 2 : 1)
#ifndef PROBE_XIN
#define PROBE_XIN 0
#endif
#ifndef PH_MASK
#define PH_MASK 0x1FFF
#endif
#define IN(k) (lo <= (k) && (k) < hi)
#define MSK(j) (((PH_MASK) >> (j)) & 1)
#define FRESH(Fp) Frame Fp = F; { int l_ = lane_id(); int z_ = 0; asm volatile("" : "+v"(l_), "+s"(z_)); Fp.lane = l_; Fp.wave = F.wave + z_; Fp.tid = Fp.wave * 64 + l_; Fp.vcu = F.vcu + z_; Fp.ws = F.ws + z_; Fp.ctl = (unsigned*)(Fp.ws + WS_CTL); }
#define SEAM(k) do { if (IN(k) && IN((k) + 1)) xcd_barrier(bar, F.wave * 64 + lane_id()); } while (0)

    if (MSK(11) && IN(0)) { FRESH(P); phase_prologue(P, args);
#ifdef PROBE_REPEAT_PROLOGUE
        __syncthreads(); phase_prologue(P, args);
#endif
    }
    SEAM(0);
    for (int l = 0; l < DEPTH; ++l) {
        const int pb = 1 + 11 * l;
        const float* mod = (const float*)(F.ws + WS_MOD);
        if (MSK(0) && IN(pb + 0)) { for (int rep_ = 0; rep_ < (l == 0 ? NREP(0) : 1); ++rep_) { if (rep_) __syncthreads(); FRESH(P); phase_norm1(P, args, l); } }
        SEAM(pb + 0);
        if (MSK(1) && IN(pb + 1)) { for (int rep_ = 0; rep_ < NREP(1); ++rep_) { if (rep_) __syncthreads(); FRESH(P);
            pg8::Gemm g{(const bf16*)(P.ws + WS_H), (const bf16*)(P.ws + WS_WIN) + (size_t)l * 4096 * DM, DM * 2};
            pg8::StaticOrder S; S.init(T, PROJ_LD, P.G, (int)blockIdx.x);
            pg8::EpiPlain E{(bf16*)(P.ws + WS_PROJ), PROJ_LD};
            pg8::gemm_phase<pg8::EpiPlain, pg8::StaticOrder, pg8::ALinear>(P.lds, g, S, pg8::ALinear{}, E, P.tid);
        } }
        SEAM(pb + 1);
#ifdef PROBE_EXTRA_BARRIERS
        if (IN(pb + 2)) for (int xb_ = 0; xb_ < PROBE_EXTRA_BARRIERS; ++xb_) xcd_barrier(bar, F.wave * 64 + lane_id());
#endif
        if (MSK(2) && IN(pb + 2)) { for (int rep_ = 0; rep_ < NREP(2); ++rep_) { if (rep_) __syncthreads(); FRESH(P); phase_mla_prep(P, args); } }
        SEAM(pb + 2);
        if (MSK(3) && IN(pb + 3)) { for (int rep_ = 0; rep_ < NREP(3); ++rep_) { if (rep_) __syncthreads(); FRESH(P);
#ifdef PROBE_SWAP_UP
            { pg8::Gemm g{(const bf16*)(P.ws + WS_PROJ) + C_CKV, (const bf16*)(P.ws + WS_WUKV) + (size_t)l * 2048 * 256, 256 * 2};
              pg8::StaticOrder S; S.init(T, 2048, P.G, (int)blockIdx.x);
              pg8::EpiKVup E{(bf16*)(P.ws + WS_KF), (bf16*)(P.ws + WS_VB), (const float*)(P.ws + WS_RSTDKV)};
              pg8::gemm_phase<pg8::EpiKVup, pg8::StaticOrder, pg8::APitch>(P.lds, g, S, pg8::APitch{PROJ_LD * 2}, E, P.tid); }
            { pg8::Gemm g{(const bf16*)(P.ws + WS_PROJ) + C_CQ, (const bf16*)(P.ws + WS_WUQ) + (size_t)l * 1536 * 512, 512 * 2};
              pg8::StaticOrder S; S.init(T, 1536, P.G, (int)blockIdx.x);
              pg8::EpiQup E{(bf16*)(P.ws + WS_QA), (const float*)(P.ws + WS_RSTDQ)};
#ifdef PROBE_QUP_PLAIN
              { pg8::EpiPlain E2{(bf16*)(P.ws + WS_QA), 1536}; pg8::gemm_phase<pg8::EpiPlain, pg8::StaticOrder, pg8::APitch>(P.lds, g, S, pg8::APitch{PROJ_LD * 2}, E2, P.tid); }
#else
              pg8::gemm_phase<pg8::EpiQup, pg8::StaticOrder, pg8::APitch>(P.lds, g, S, pg8::APitch{PROJ_LD * 2}, E, P.tid);
#endif
            }
#else
            { pg8::Gemm g{(const bf16*)(P.ws + WS_PROJ) + C_CQ, (const bf16*)(P.ws + WS_WUQ) + (size_t)l * 1536 * 512, 512 * 2};
              pg8::StaticOrder S; S.init(T, 1536, P.G, (int)blockIdx.x);
              pg8::EpiQup E{(bf16*)(P.ws + WS_QA), (const float*)(P.ws + WS_RSTDQ)};
#ifdef PROBE_QUP_PLAIN
              { pg8::EpiPlain E2{(bf16*)(P.ws + WS_QA), 1536}; pg8::gemm_phase<pg8::EpiPlain, pg8::StaticOrder, pg8::APitch>(P.lds, g, S, pg8::APitch{PROJ_LD * 2}, E2, P.tid); }
#else
              pg8::gemm_phase<pg8::EpiQup, pg8::StaticOrder, pg8::APitch>(P.lds, g, S, pg8::APitch{PROJ_LD * 2}, E, P.tid);
#endif
            }
            { pg8::Gemm g{(const bf16*)(P.ws + WS_PROJ) + C_CKV, (const bf16*)(P.ws + WS_WUKV) + (size_t)l * 2048 * 256, 256 * 2};
              pg8::StaticOrder S; S.init(T, 2048, P.G, (int)blockIdx.x);
              pg8::EpiKVup E{(bf16*)(P.ws + WS_KF), (bf16*)(P.ws + WS_VB), (const float*)(P.ws + WS_RSTDKV)};
              pg8::gemm_phase<pg8::EpiKVup, pg8::StaticOrder, pg8::APitch>(P.lds, g, S, pg8::APitch{PROJ_LD * 2}, E, P.tid); }
#endif
        } }
        SEAM(pb + 3);
#ifndef ATT_QROPE
        if (MSK(4) && IN(pb + 4)) { FRESH(P); phase_q_rope(P, args); }
        SEAM(pb + 4);
#endif
        if (MSK(5) && IN(pb + 5)) { FRESH(P); phase_attention(P, (char*)lds, args, l);
#ifdef PROBE_REPEAT_ATT
            __syncthreads(); phase_attention(P, (char*)lds, args, l);
#endif
        }
        SEAM(pb + 5);
        if (MSK(6) && IN(pb + 6)) { for (int rep_ = 0; rep_ < NREP(6); ++rep_) { if (rep_) __syncthreads(); FRESH(P); phase_out_norm(P, args, l); } }
        SEAM(pb + 6);
        if (MSK(7) && IN(pb + 7)) { FRESH(P);
#ifdef G3_FP8
            pg8::Gemm g{P.ws + WS_H, P.ws + WS_WOUT + (size_t)l * DM * DM, DM};
            pg8::StaticOrder S; S.init(T, DM, P.G, (int)blockIdx.x);
#ifdef XRES_BF16
            pg8::EpiResidB E{l == 0 ? (const void*)args.in[I_X] : (const void*)(P.ws + WS_XB), (bf16*)(P.ws + WS_XB), mod + (size_t)l * 4 * 12288 + 2 * DM, 12288, 1.0f / 256.0f, l == 0 ? 1 : 0};
            pg8::gemm_phase<pg8::EpiResidB, pg8::StaticOrder, pg8::ALinear, true>(P.lds, g, S, pg8::ALinear{}, E, P.tid);
#else
            pg8::EpiResid E{l == 0 ? args.in[I_X] : args.out, args.out, mod + (size_t)l * 4 * 12288 + 2 * DM, DM, 12288, 1.0f / 256.0f};
            pg8::gemm_phase<pg8::EpiResid, pg8::StaticOrder, pg8::ALinear, true>(P.lds, g, S, pg8::ALinear{}, E, P.tid);
#endif
#elif defined(XRES_BF16)
            pg8::Gemm g{(const bf16*)(P.ws + WS_H), (const bf16*)(P.ws + WS_WOUT) + (size_t)l * DM * DM, DM * 2};
            pg8::StaticOrder S; S.init(T, DM, P.G, (int)blockIdx.x);
            pg8::EpiResidB E{l == 0 ? (const void*)args.in[I_X] : (const void*)(P.ws + WS_XB), (bf16*)(P.ws + WS_XB), mod + (size_t)l * 4 * 12288 + 2 * DM, 12288, 1.0f, l == 0 ? 1 : 0};
            pg8::gemm_phase<pg8::EpiResidB, pg8::StaticOrder, pg8::ALinear>(P.lds, g, S, pg8::ALinear{}, E, P.tid);
#else
            pg8::Gemm g{(const bf16*)(P.ws + WS_H), (const bf16*)(P.ws + WS_WOUT) + (size_t)l * DM * DM, DM * 2};
            pg8::StaticOrder S; S.init(T, DM, P.G, (int)blockIdx.x);
            pg8::EpiResid E{l == 0 ? args.in[I_X] : args.out, args.out, mod + (size_t)l * 4 * 12288 + 2 * DM, DM, 12288, 1.0f};
            pg8::gemm_phase<pg8::EpiResid, pg8::StaticOrder, pg8::ALinear>(P.lds, g, S, pg8::ALinear{}, E, P.tid);
#endif
        }
        SEAM(pb + 7);
        if (MSK(8) && IN(pb + 8)) { FRESH(P); phase_router(P, args, l);
#ifdef PROBE_REPEAT_ROUTER
            __syncthreads(); phase_router(P, args, l, 1);
#endif
        }
        SEAM(pb + 8);
        if (MSK(9) && IN(pb + 9)) { for (int rep_ = 0; rep_ < NREP(9); ++rep_) { if (rep_) __syncthreads(); FRESH(P);
            const int NT = moe_setup(P, l);
            pg8::MoeOrder S{NT, 8, P.G, (int)blockIdx.x, (const LAS int*)(P.lds + L_TS)};
            LAS unsigned* atab = (LAS unsigned*)(P.lds + L_ATAB); const int* rowidx = (const int*)(P.ws + WS_ROWIDX);
#pragma unroll 1
            for (int slot = 0; slot < MAXU; ++slot) { pg8::Unit u; if (!S.next(slot, u)) break;
                if (P.tid < 256) { const int lr = u.lt * 256 + P.tid; const int ce = (int)P.ctl[CW_CNT + l * 16 + u.e];
                    int tok = lr < ce ? (rowidx[(size_t)u.e * 32768 + lr] >> 1) : 0;
#ifdef PROBE_LINEAR_ATAB
                    tok = (int)(((unsigned)(u.pm * 256 + P.tid) * 2654435761u) >> 17) & 32767;
#endif
 atab[slot * 256 + P.tid] = (unsigned)tok * (unsigned)DM; } }
            __syncthreads();
            pg8::Gemm g{P.ws + WS_H, P.ws + WS_W13, DM};
            pg8::EpiSwiglu E{P.ws + WS_HMID, DEXP};
            pg8::gemm_phase<pg8::EpiSwiglu, pg8::MoeOrder, pg8::ATable, true>(P.lds, g, S, pg8::ATable{atab}, E, P.tid);
        } }
        SEAM(pb + 9);
        if (MSK(10) && IN(pb + 10)) { for (int rep_ = 0; rep_ < NREP(10); ++rep_) { if (rep_) __syncthreads(); FRESH(P);
            const int NT = moe_setup(P, l);
            pg8::MoeOrder S{NT, 8, P.G, (int)blockIdx.x, (const LAS int*)(P.lds + L_TS)};
            pg8::Gemm g{P.ws + WS_HMID, P.ws + WS_W2, DEXP};
            pg8::EpiMoeDown E{(bf16*)(P.ws + WS_Y), (const int*)(P.ws + WS_ROWIDX), (const float*)(P.ws + WS_AW), P.ctl + CW_CNT + l * 16};
            pg8::gemm_phase<pg8::EpiMoeDown, pg8::MoeOrder, pg8::ALinear, true>(P.lds, g, S, pg8::ALinear{}, E, P.tid);
        } }
        SEAM(pb + 10);
    }
    #ifdef PROBE_DUMP_OFF
    if (MSK(12) && IN(NPH - 1)) { FRESH(P); phase_dump(P, args, (size_t)(PROBE_DUMP_OFF), PROBE_DUMP_PITCH); }
#else
    if (MSK(12) && IN(NPH - 1)) { FRESH(P); phase_final(P, args, args.li != 0 ? (PROBE_XIN ? 2 : PROBE_MODE) : 0);
#ifdef PROBE_EXACT
        { const int gw = P.vcu * NWAVES + P.wave, NGW = P.G * NWAVES; __syncthreads();
          for (int ch = gw; ch < T / 16; ch += NGW) for (int rr = 0; rr < 16; ++rr) for (int j = 0; j < 8; ++j) { float* p = args.out + (size_t)(ch * 16 + rr) * DM + 4 * P.lane + 256 * j; asm volatile("s_waitcnt vmcnt(0)" ::: "memory");
              const v4u ub = *(const v4u*)p; *(f32x4*)p = (f32x4){(float)(ub.x & 0xFFFu), (float)(ub.y & 0xFFFu), (float)(ub.z & 0xFFFu), (float)(ub.w & 0xFFFu)}; } }
#endif
    }
#endif
#undef IN
#undef SEAM
}

extern "C" void kernel_launch(void* const* d_in, const int* in_sizes, int n_in, void* d_out, int out_size, void* d_ws, size_t ws_size, hipStream_t stream) {
    static int grid = 0;
    if (grid == 0) {
        if (n_in != 20 || in_sizes[0] != T * DM || out_size != T * DM || ws_size < WS_END) {
            fprintf(stderr, "kernel_launch: unexpected problem (n_in %d, in0 %d, out %d, ws %zu < %zu)\n", n_in, n_in > 0 ? in_sizes[0] : -1, out_size, ws_size, (size_t)WS_END); grid = -1; return; }
        int dev = 0, cus = 0;
        if (hipGetDevice(&dev) != hipSuccess || hipDeviceGetAttribute(&cus, hipDeviceAttributeMultiprocessorCount, dev) != hipSuccess) { grid = -1; return; }
        if (hipFuncSetAttribute((const void*)mk_fwd, hipFuncAttributeMaxDynamicSharedMemorySize, LDS_BYTES) != hipSuccess) { fprintf(stderr, "kernel_launch: hipFuncSetAttribute failed\n"); grid = -1; return; }
        int per_cu = 0;
        if (hipOccupancyMaxActiveBlocksPerMultiprocessor(&per_cu, (const void*)mk_fwd, NWAVES * 64, LDS_BYTES) != hipSuccess || per_cu < 1) fprintf(stderr, "kernel_launch: occupancy query says %d blocks per CU\n", per_cu);
        (void)hipGetLastError();
        grid = cus;
        if (grid != 256) fprintf(stderr, "kernel_launch: %d CUs (built for 256)\n", grid);
    }
    if (grid < 0) return;
    if (hipMemsetAsync((char*)d_ws + WS_CTL, 0, CTL_ZERO_BYTES, stream) != hipSuccess) return;
    Args a; memset(&a, 0, sizeof(a));
    for (int i = 0; i < 20; ++i) a.in[i] = (const float*)d_in[i];
    a.out = (float*)d_out; a.ws = (unsigned char*)d_ws;
    for (int i = 0; i < 32; ++i) a.invf[i] = (float)pow(10000.0, -(double)i / 32.0);
#if MK_PER_PHASE
#ifndef PROBE_LAST
#define PROBE_LAST (NPH - 2)
#endif
    for (int p = 0; p < NPH; ++p) { if (p > PROBE_LAST && p != NPH - 1) continue;
#ifdef PROBE_ONLY_MASK
        if (p != NPH - 1 && !((PROBE_ONLY_MASK >> p) & 1)) continue;
#endif
 a.ph_lo = p; a.ph_hi = p + 1; a.li = (PROBE_LAST != NPH - 2) ? 1 : 0; hipLaunchKernelGGL(mk_fwd, dim3(PROBE_GRID1(p) ? 1 : grid), dim3(NWAVES * 64), LDS_BYTES, stream, a); }
#else
    a.ph_lo = 0; a.ph_hi = NPH; a.li = 0;
    hipLaunchKernelGGL(mk_fwd, dim3(grid), dim3(NWAVES * 64), LDS_BYTES, stream, a);
#endif
    const hipError_t le = hipPeekAtLastError();
    if (le != hipSuccess) fprintf(stderr, "kernel_launch: launch failed: %s\n", hipGetErrorName(le));
}
```

```cpp
#define MK_PER_PHASE 0
#define XRES_BF16 1
#define G3_FP8 1
#define ATT_QROPE 1
#define ST16_IMM 1
#define ROUTER_MFMA 1
#define ATT_CONV 2
#define ATT_SLOAD_RECOMP 1
#define ATT_RAWBAR 1
#define ATT_MLA_SK 1
#define THIN_MLP 1
#define CONV_LAST_STEP 1
#define THIN_RO 4
#define RPA 4
#define ADA_FAST 1
#include <hip/hip_runtime.h>
#include <cstdio>
#include <cstdint>
#include <cstring>
#include <cmath>
namespace pg8 {
#define PG8_LAS __attribute__((address_space(3)))
typedef unsigned short bf16_t;
typedef short bf16x8 __attribute__((ext_vector_type(8)));
typedef float f32x4 __attribute__((ext_vector_type(4)));
typedef float f32x2 __attribute__((ext_vector_type(2)));
typedef unsigned u32x4 __attribute__((ext_vector_type(4)));
typedef int v4i_t __attribute__((ext_vector_type(4)));
typedef int v8i_t __attribute__((ext_vector_type(8)));
constexpr int BM = 256, BK = 64, HALF = 128, HTB = HALF * BK * 2  , STAGE_BYTES = 8 * HTB, NXCD = 8, WGM = 8;

__host__ __device__ __forceinline__ int lds_byte(int r, int c) { const int st = (r >> 4) * 2 + (c >> 5), rr = r & 15, cc = c & 31, ob = rr * 64 + cc * 2; return st * 1024 + (ob ^ (((ob >> 9) & 1) << 5)); }
__host__ __device__ __forceinline__ void stage_rc(int b, int& R, int& C) { const int st = b / 1024, sb = b % 1024, swz = sb ^ (((sb >> 9) & 1) << 5); R = (st >> 1) * 16 + swz / 64; C = (st & 1) * 32 + (swz % 64) / 2; }
__host__ __device__ __forceinline__ int perm32(int rho) { const int n = rho >> 4, i = rho & 15; return 8 * (i >> 2) + 4 * n + (i & 3); }

struct Unit { int pm, pn, pb, e, lt; };
struct Gemm { const void* A; const void* Bt; int Kb; };

__device__ __forceinline__ bool order_tile(int i, int G, int c, int nM, int nN, int& pm, int& pn) {
    const int nwg = nM * nN; const long L = (long)i * G + c; if (L >= nwg) return false;
    int wgid = (int)L; { const int q = nwg / NXCD, r = nwg % NXCD, xcd = wgid % NXCD, off = wgid / NXCD; wgid = (xcd < r ? xcd * (q + 1) : r * (q + 1) + (xcd - r) * q) + off; }
    const int nig = WGM * nN, gid = wgid / nig, fm = gid * WGM, gsz = (nM - fm) < WGM ? (nM - fm) : WGM;
    pm = fm + ((wgid % nig) % gsz); pn = (wgid % nig) / gsz; return true;
}
struct StaticOrder {
    int nM, nN, G, c;
    __device__ __forceinline__ void init(int M, int N, int G_, int c_) { nM = M / BM; nN = N / BM; G = G_; c = c_; }
    __device__ __forceinline__ bool next(int i, Unit& u) const { int pm, pn; if (!order_tile(i, G, c, nM, nN, pm, pn)) return false; u.pm = pm; u.pn = pn; u.pb = pn; u.e = 0; u.lt = 0; return true; }
};
struct MoeOrder {
    int nM, nN, G, c; const PG8_LAS int* ts;
    __device__ __forceinline__ bool next(int i, Unit& u) const {
        int pm, pn; if (i >= 10 || !order_tile(i, G, c, nM, nN, pm, pn)) return false;
        int e = 0;
#pragma unroll
        for (int j = 1; j < 16; ++j) e += (__builtin_amdgcn_readfirstlane(ts[j]) <= pm) ? 1 : 0;
        e = __builtin_amdgcn_readfirstlane(e); u.pm = pm; u.pn = pn; u.e = e; u.lt = pm - __builtin_amdgcn_readfirstlane(ts[e]); u.pb = e * nN + pn; return true;
    }
};
struct ALinear { __device__ __forceinline__ unsigned off(const Unit& u, int slot, int r, int Kb) const { return (unsigned)(u.pm * BM + r) * (unsigned)Kb; } };
struct APitch  { unsigned pitchB; __device__ __forceinline__ unsigned off(const Unit& u, int slot, int r, int K) const { return (unsigned)(u.pm * BM + r) * pitchB; } };
struct ATable  { const PG8_LAS unsigned* tab; __device__ __forceinline__ unsigned off(const Unit& u, int slot, int r, int K) const { return tab[slot * BM + r]; } };

typedef __bf16 bf16x2_t __attribute__((ext_vector_type(2)));
__device__ __forceinline__ unsigned cvt_pk_bf16(float lo, float hi) { const f32x2 v = {lo, hi}; return __builtin_bit_cast(unsigned, __builtin_convertvector(v, bf16x2_t)); }

typedef f32x4 Acc[2][2][4][2];

typedef __amdgpu_buffer_rsrc_t rsrc_t;
#define PG8_RSRC(p) __builtin_amdgcn_make_buffer_rsrc((void*)(p), 0, 0x7fffffff, 0x00020000)
#ifdef ST16_IMM
__device__ __forceinline__ void st16(rsrc_t r, int vo, int so, u32x4 v) { __builtin_amdgcn_raw_buffer_store_b128(v, r, vo + so, 0, 0); }
#else
__device__ __forceinline__ void st16(rsrc_t r, int vo, int so, u32x4 v) { __builtin_amdgcn_raw_buffer_store_b128(v, r, vo, so, 0); }
#endif
__device__ __forceinline__ f32x4 ld16f(rsrc_t r, int vo, int so) { return __builtin_bit_cast(f32x4, __builtin_amdgcn_raw_buffer_load_b128(r, vo, so, 0)); }
__device__ __forceinline__ float ld4f(rsrc_t r, int vo, int so) { return __uint_as_float(__builtin_amdgcn_raw_buffer_load_b32(r, vo, so, 0)); }
__device__ __forceinline__ u32x4 pack8(const f32x4 v0, const f32x4 v1) { u32x4 w; w.x = cvt_pk_bf16(v0[0], v0[1]); w.y = cvt_pk_bf16(v0[2], v0[3]); w.z = cvt_pk_bf16(v1[0], v1[1]); w.w = cvt_pk_bf16(v1[2], v1[3]); return w; }
struct EpiPlain {
    static constexpr bool PERM = true;
    bf16_t* O; int ldc;
    __device__ __forceinline__ void operator()(const Acc& acc, const Unit& u, int wr, int wc, int fr, int fq) const {
        const rsrc_t ro = PG8_RSRC(O); const int vo = (fr * ldc + wc * 32 + 8 * fq) * 2;
#pragma unroll
        for (int ai = 0; ai < 2; ++ai)
#pragma unroll
            for (int m = 0; m < 4; ++m) { const int so = ((u.pm * BM + wr * 64 + ai * HALF + m * 16) * ldc + u.pn * BM) * 2;
#pragma unroll
                for (int bj = 0; bj < 2; ++bj) st16(ro, vo, so + bj * HALF * 2, pack8(acc[ai][bj][m][0], acc[ai][bj][m][1])); }
    }
};
struct EpiQup {
    static constexpr bool PERM = true;
    bf16_t* O; const float* rstd;
    __device__ __forceinline__ void operator()(const Acc& acc, const Unit& u, int wr, int wc, int fr, int fq) const {
        const rsrc_t ro = PG8_RSRC(O), rr = PG8_RSRC(rstd);
        const int vo = (fr * 1536 + wc * 32 + 8 * fq) * 2;
        float rs[2][4];
#pragma unroll
        for (int ai = 0; ai < 2; ++ai)
#pragma unroll
            for (int m = 0; m < 4; ++m) rs[ai][m] = ld4f(rr, fr * 4, (u.pm * BM + wr * 64 + ai * HALF + m * 16) * 4);
#pragma unroll
        for (int ai = 0; ai < 2; ++ai)
#pragma unroll
            for (int m = 0; m < 4; ++m) { const int rowu = u.pm * BM + wr * 64 + ai * HALF + m * 16; const float r1 = rs[ai][m];
                const int so = (rowu * 1536 + u.pn * BM) * 2;
                st16(ro, vo, so, pack8(acc[ai][0][m][0] * r1, acc[ai][0][m][1] * r1));
                st16(ro, vo, so + HALF * 2, pack8(acc[ai][1][m][0] * r1, acc[ai][1][m][1] * r1)); }
    }
};
struct EpiKVup {
    static constexpr bool PERM = true;
    bf16_t* KF; bf16_t* VB; const float* rstd;
    __device__ __forceinline__ void operator()(const Acc& acc, const Unit& u, int wr, int wc, int fr, int fq) const {
        const rsrc_t rk = PG8_RSRC(KF), rv = PG8_RSRC(VB), rr = PG8_RSRC(rstd);
        const int c0 = wc * 32 + 8 * fq, vok = (fr * 1536 + c0) * 2, vov = (fr * 1024 + c0) * 2;
        float rs[2][4];
#pragma unroll
        for (int ai = 0; ai < 2; ++ai)
#pragma unroll
            for (int m = 0; m < 4; ++m) rs[ai][m] = ld4f(rr, fr * 4, (u.pm * BM + wr * 64 + ai * HALF + m * 16) * 4);
#pragma unroll
        for (int ai = 0; ai < 2; ++ai)
#pragma unroll
            for (int m = 0; m < 4; ++m) { const int rowu = u.pm * BM + wr * 64 + ai * HALF + m * 16; const float r1 = rs[ai][m];
                st16(rk, vok, (rowu * 1536 + u.pn * 192) * 2, pack8(acc[ai][0][m][0] * r1, acc[ai][0][m][1] * r1));
                st16(rv, vov, (rowu * 1024 + u.pn * 128) * 2, pack8(acc[ai][1][m][0] * r1, acc[ai][1][m][1] * r1)); }
    }
};
struct EpiResid {
    static constexpr bool PERM = false;
    const float* base; float* out; const float* gate; int ldc; int gld; float ascale;
    __device__ __forceinline__ void operator()(const Acc& acc, const Unit& u, int wr, int wc, int fr, int fq) const {
        const rsrc_t rb = PG8_RSRC(base), ro = PG8_RSRC(out), rg = PG8_RSRC(gate);
        const int cl = (wc * 32 + 4 * fq) * 4, vo = fr * ldc * 4 + cl;
        f32x4 gv[2][2];
#pragma unroll
        for (int bj = 0; bj < 2; ++bj)
#pragma unroll
            for (int n = 0; n < 2; ++n) gv[bj][n] = ld16f(rg, cl, (((u.pm * BM) >> 13) * gld + u.pn * BM + bj * HALF + n * 16) * 4) * ascale;
#pragma unroll
        for (int ai = 0; ai < 2; ++ai) {
            f32x4 bs[4][2][2];
#pragma unroll
            for (int m = 0; m < 4; ++m) { const int so = ((u.pm * BM + ai * HALF + wr * 64 + m * 16) * ldc + u.pn * BM) * 4;
#pragma unroll
                for (int bj = 0; bj < 2; ++bj)
#pragma unroll
                    for (int n = 0; n < 2; ++n) bs[m][bj][n] = ld16f(rb, vo, so + (bj * HALF + n * 16) * 4); }
#pragma unroll
            for (int m = 0; m < 4; ++m) { const int so = ((u.pm * BM + ai * HALF + wr * 64 + m * 16) * ldc + u.pn * BM) * 4;
#pragma unroll
                for (int bj = 0; bj < 2; ++bj)
#pragma unroll
                    for (int n = 0; n < 2; ++n) st16(ro, vo, so + (bj * HALF + n * 16) * 4, __builtin_bit_cast(u32x4, bs[m][bj][n] + gv[bj][n] * acc[ai][bj][m][n])); }
            asm volatile("s_waitcnt vmcnt(0)" ::: "memory");
        }
    }
};
struct EpiResidB {
    static constexpr bool PERM = true;
    const void* base; bf16_t* out; const float* gate; int gld; float ascale; int BASE_F32;
    __device__ __forceinline__ void operator()(const Acc& acc, const Unit& u, int wr, int wc, int fr, int fq) const {
        const rsrc_t rb = PG8_RSRC(base), ro = PG8_RSRC(out), rg = PG8_RSRC(gate);
        const int c0 = wc * 32 + 8 * fq;
        f32x4 gv[2][2];
#pragma unroll
        for (int bj = 0; bj < 2; ++bj)
#pragma unroll
            for (int n = 0; n < 2; ++n) gv[bj][n] = ld16f(rg, (c0 + 4 * n) * 4, (((u.pm * BM) >> 13) * gld + u.pn * BM + bj * HALF) * 4) * ascale;
#pragma unroll
        for (int ai = 0; ai < 2; ++ai) {
            f32x4 bs[4][2][2];
#pragma unroll
            for (int m = 0; m < 4; ++m) { const int rowu = u.pm * BM + ai * HALF + wr * 64 + m * 16;
#pragma unroll
                for (int bj = 0; bj < 2; ++bj) {
                    if (BASE_F32) { const int so = (rowu * 2048 + u.pn * BM + bj * HALF) * 4, vo = (fr * 2048 + c0) * 4;
                        bs[m][bj][0] = ld16f(rb, vo, so); bs[m][bj][1] = ld16f(rb, vo + 16, so); }
                    else { const int so = (rowu * 2048 + u.pn * BM + bj * HALF) * 2, vo = (fr * 2048 + c0) * 2;
                        const u32x4 w = __builtin_bit_cast(u32x4, __builtin_amdgcn_raw_buffer_load_b128(rb, vo, so, 0));
                        bs[m][bj][0] = (f32x4){__uint_as_float(w.x << 16), __uint_as_float(w.x & 0xffff0000u), __uint_as_float(w.y << 16), __uint_as_float(w.y & 0xffff0000u)};
                        bs[m][bj][1] = (f32x4){__uint_as_float(w.z << 16), __uint_as_float(w.z & 0xffff0000u), __uint_as_float(w.w << 16), __uint_as_float(w.w & 0xffff0000u)}; } } }
#pragma unroll
            for (int m = 0; m < 4; ++m) { const int rowu = u.pm * BM + ai * HALF + wr * 64 + m * 16;
#pragma unroll
                for (int bj = 0; bj < 2; ++bj) st16(ro, (fr * 2048 + c0) * 2, (rowu * 2048 + u.pn * BM + bj * HALF) * 2,
                                                    pack8(bs[m][bj][0] + gv[bj][0] * acc[ai][bj][m][0], bs[m][bj][1] + gv[bj][1] * acc[ai][bj][m][1])); }
            asm volatile("s_waitcnt vmcnt(0)" ::: "memory");
        }
    }
};
struct EpiSwiglu {
    static constexpr bool PERM = true;
    unsigned char* O; int ldc;
    __device__ __forceinline__ void operator()(const Acc& acc, const Unit& u, int wr, int wc, int fr, int fq) const {
        const rsrc_t ro = PG8_RSRC(O); const int vo = fr * ldc + wc * 32 + 8 * fq;
#pragma unroll
        for (int ai = 0; ai < 2; ++ai)
#pragma unroll
            for (int m = 0; m < 4; ++m) { const int so = (u.pm * BM + wr * 64 + ai * HALF + m * 16) * ldc + u.pn * HALF; float r[8];
#pragma unroll
                for (int n = 0; n < 2; ++n)
#pragma unroll
                    for (int k = 0; k < 4; ++k) { const float g = acc[ai][0][m][n][k] * (1.0f / 256.0f), up = acc[ai][1][m][n][k] * (1.0f / 256.0f);
                        r[n * 4 + k] = g * __builtin_amdgcn_rcpf(1.0f + __builtin_amdgcn_exp2f(-1.4426950408889634f * g)) * up; }
                int w0 = 0, w1 = 0;
                w0 = __builtin_amdgcn_cvt_pk_fp8_f32(r[0], r[1], w0, false); w0 = __builtin_amdgcn_cvt_pk_fp8_f32(r[2], r[3], w0, true);
                w1 = __builtin_amdgcn_cvt_pk_fp8_f32(r[4], r[5], w1, false); w1 = __builtin_amdgcn_cvt_pk_fp8_f32(r[6], r[7], w1, true);
                typedef unsigned u32x2_t __attribute__((ext_vector_type(2)));
                __builtin_amdgcn_raw_buffer_store_b64((u32x2_t){(unsigned)w0, (unsigned)w1}, ro, vo, so, 0); }
    }
};
struct EpiMoeDown {
    static constexpr bool PERM = true;
    bf16_t* Y; const int* rowidx; const float* aw; const unsigned* cnt;
    __device__ __forceinline__ void operator()(const Acc& acc, const Unit& u, int wr, int wc, int fr, int fq) const {
        const rsrc_t ry = PG8_RSRC(Y), ri = PG8_RSRC(rowidx), ra = PG8_RSRC(aw);
        const int nvalid = (int)cnt[u.e] - u.lt * BM; const int cb = (u.pn * BM + wc * 32 + 8 * fq) * 2;
        int idx[2][4]; float w8[2][4];
#pragma unroll
        for (int ai = 0; ai < 2; ++ai)
#pragma unroll
            for (int m = 0; m < 4; ++m) { const int ru = ai * HALF + wr * 64 + m * 16; idx[ai][m] = -1; w8[ai][m] = 0.f;
                if (ru + fr < nvalid) { idx[ai][m] = (int)__builtin_amdgcn_raw_buffer_load_b32(ri, fr * 4, (u.e * 32768 + u.lt * BM + ru) * 4, 0); w8[ai][m] = ld4f(ra, idx[ai][m] * 4, 0); } }
#pragma unroll
        for (int ai = 0; ai < 2; ++ai)
#pragma unroll
            for (int m = 0; m < 4; ++m) if (idx[ai][m] >= 0) { const int vo = idx[ai][m] * 4096 + cb; const float w1 = w8[ai][m] * (1.0f / 256.0f);
#pragma unroll
                for (int bj = 0; bj < 2; ++bj) st16(ry, vo, bj * HALF * 2, pack8(acc[ai][bj][m][0] * w1, acc[ai][bj][m][1] * w1)); }
    }
};

template <class Epi, class Sched, class AOff, bool FP8 = false>
__device__ __forceinline__ void gemm_phase(PG8_LAS unsigned char* lds, const Gemm g, const Sched& S, const AOff& AO, const Epi& E, int tid_in) {
    int tid = tid_in; asm volatile("" : "+v"(tid));
    const int wid = __builtin_amdgcn_readfirstlane(tid >> 6), lane = tid & 63, wr = wid >> 2, wc = wid & 3, fr = lane & 15, fq = lane >> 4;
    int K = g.Kb; asm volatile("" : "+s"(K));
    const int nt = K / (BK * 2);
    int Ra[2], Ca[2]; unsigned voffB[2];
#pragma unroll
    for (int i = 0; i < 2; ++i) { int R, C; stage_rc(tid * 16 + i * 8192, R, C); const int Rb = Epi::PERM ? ((R & ~31) + perm32(R & 31)) : R;
        Ra[i] = R; Ca[i] = C * 2; voffB[i] = (unsigned)(Rb * K + C * 2); }
    const size_t kstep = (size_t)(BK * 2);
    const size_t hstep = (size_t)HALF * K;
    const size_t tstep = 2 * hstep;
    const unsigned ldsw = (unsigned)wid * 1024u;
    const unsigned lds0 = (unsigned)(uintptr_t)lds;
    const int aoff = lds_byte(wr * 64 + fr, fq * 8), boff = lds_byte(wc * 32 + fr, fq * 8);
#define PG8_SA(b, h) (((b) * 2 + (h)) * HTB)
#define PG8_SB(b, h) ((4 + (b) * 2 + (h)) * HTB)
#define PG8_STAGE(bufoff, gbase, voff) do { _Pragma("unroll") for (int _i = 0; _i < 2; ++_i) { unsigned keep_; \
        asm volatile("s_mov_b32 %0, m0\n\ts_mov_b32 m0, %2\n\ts_nop 0\n\tglobal_load_lds_dwordx4 %1, %3\n\ts_mov_b32 m0, %0" : "=&s"(keep_) \
            : "v"((voff)[_i]), "s"((unsigned)__builtin_amdgcn_readfirstlane((int)(lds0 + (bufoff) + ldsw + _i * 8192))), "s"((const void*)(gbase)) : "memory"); } } while (0)
#define PG8_LD8(addr) __builtin_shufflevector(*(const PG8_LAS v4i_t*)(addr), *(const PG8_LAS v4i_t*)((addr) + 1024), 0, 1, 2, 3, 4, 5, 6, 7)
#define PG8_LDA(dst, b, h) do { _Pragma("unroll") for (int m = 0; m < 4; ++m) dst[m] = PG8_LD8(lds + PG8_SA(b, h) + aoff + m * 2048); } while (0)
#define PG8_LDB(dst, b, h) do { _Pragma("unroll") for (int n = 0; n < 2; ++n) dst[n] = PG8_LD8(lds + PG8_SB(b, h) + boff + n * 2048); } while (0)
#define PG8_HALF(x, k) __builtin_bit_cast(bf16x8, __builtin_shufflevector(x, x, 4 * (k), 4 * (k) + 1, 4 * (k) + 2, 4 * (k) + 3))
#define PG8_MMA(ai, bj, At, Bt) do { __builtin_amdgcn_s_setprio(1); _Pragma("unroll") for (int m = 0; m < 4; ++m) _Pragma("unroll") for (int n = 0; n < 2; ++n) { \
        if constexpr (FP8) asm volatile("v_mfma_scale_f32_16x16x128_f8f6f4 %0, %1, %2, %0, %3, %3 op_sel_hi:[0,0,0]" : "+v"(acc[ai][bj][m][n]) : "v"(Bt[n]), "v"(At[m]), "v"(sc1_));   \
        else { acc[ai][bj][m][n] = __builtin_amdgcn_mfma_f32_16x16x32_bf16(PG8_HALF(Bt[n], 0), PG8_HALF(At[m], 0), acc[ai][bj][m][n], 0, 0, 0); \
               acc[ai][bj][m][n] = __builtin_amdgcn_mfma_f32_16x16x32_bf16(PG8_HALF(Bt[n], 1), PG8_HALF(At[m], 1), acc[ai][bj][m][n], 0, 0, 0); } } \
        __builtin_amdgcn_s_setprio(0); } while (0)
#define PG8_WAIT_V(n) asm volatile("s_waitcnt vmcnt(" #n ")" ::: "memory")
#define PG8_WAIT_L(n) asm volatile("s_waitcnt lgkmcnt(" #n ")" ::: "memory")
#define PG8_BAR __builtin_amdgcn_s_barrier()
#define PG8_SCHED __builtin_amdgcn_sched_barrier(0)
#define PG8_AOFF(dst, u, slot) do { _Pragma("unroll") for (int _h = 0; _h < 2; ++_h) _Pragma("unroll") for (int _i = 0; _i < 2; ++_i) dst[_h][_i] = AO.off(u, slot, _h * HALF + Ra[_i], K) + (unsigned)Ca[_i]; } while (0)
    Unit cur, nxt; int ui = 0;
    if (!S.next(0, cur)) return;
    Acc acc;
#pragma unroll
    for (int a = 0; a < 2; ++a)
#pragma unroll
        for (int b = 0; b < 2; ++b)
#pragma unroll
            for (int m = 0; m < 4; ++m)
#pragma unroll
                for (int n = 0; n < 2; ++n) acc[a][b][m][n] = (f32x4){0.f, 0.f, 0.f, 0.f};
    v8i_t At[4], B0[2], B1[2];
    int sc1_ = 0x7F7F7F7F; asm volatile("" : "+v"(sc1_));
    unsigned aoC[2][2];
    PG8_AOFF(aoC, cur, 0);
    const char* gA = (const char*)g.A; const char* gB = (const char*)g.Bt;
    asm volatile("" : "+s"(gA), "+s"(gB));
    const char* cB = gB + (size_t)cur.pb * tstep;
    PG8_STAGE(PG8_SB(0, 0), cB, voffB); PG8_STAGE(PG8_SB(0, 1), cB + hstep, voffB); PG8_STAGE(PG8_SA(0, 0), gA, aoC[0]); PG8_STAGE(PG8_SA(0, 1), gA, aoC[1]);
    if (wr == 1) PG8_BAR;
    PG8_WAIT_V(2); PG8_BAR;
    PG8_STAGE(PG8_SB(1, 0), cB + kstep, voffB); PG8_STAGE(PG8_SA(1, 0), gA + kstep, aoC[0]); PG8_STAGE(PG8_SB(1, 1), cB + hstep + kstep, voffB);
    PG8_WAIT_V(6); PG8_BAR;
    for (;;) {
        const bool has_next = S.next(ui + 1, nxt);
        const char* nB = has_next ? gB + (size_t)nxt.pb * tstep : cB;
        for (int t = 0; t < nt; t += 2) {
            const bool last = (t == nt - 2);
            const char* a1 = gA + (size_t)(t + 1) * kstep;
            const char* a2 = last ? gA : gA + (size_t)(t + 2) * kstep; const char* b2 = last ? nB : cB + (size_t)(t + 2) * kstep;
            const char* a3 = a2 + kstep; const char* b3 = b2 + kstep;
            unsigned ao2[2][2];
            if (last && has_next) { PG8_AOFF(ao2, nxt, ui + 1); }
            else {
#pragma unroll
                for (int _h = 0; _h < 2; ++_h)
#pragma unroll
                    for (int _i = 0; _i < 2; ++_i) ao2[_h][_i] = aoC[_h][_i]; }
            PG8_LDB(B0, 0, 0); PG8_LDB(B1, 0, 1); PG8_SCHED; PG8_LDA(At, 0, 0); PG8_STAGE(PG8_SA(1, 1), a1, aoC[1]);
            PG8_WAIT_V(8); PG8_WAIT_L(0); PG8_BAR; PG8_MMA(0, 0, At, B0); PG8_MMA(0, 1, At, B1); PG8_BAR; PG8_SCHED;
            PG8_LDA(At, 0, 1); PG8_STAGE(PG8_SB(0, 0), b2, voffB); PG8_STAGE(PG8_SB(0, 1), b2 + hstep, voffB); PG8_STAGE(PG8_SA(0, 0), a2, ao2[0]);
            PG8_WAIT_V(8); PG8_WAIT_L(0); PG8_BAR; PG8_MMA(1, 0, At, B0); PG8_MMA(1, 1, At, B1); PG8_BAR; PG8_SCHED;
            PG8_LDB(B0, 1, 0); PG8_LDB(B1, 1, 1); PG8_SCHED; PG8_LDA(At, 1, 0); PG8_STAGE(PG8_SA(0, 1), a2, ao2[1]);
            PG8_WAIT_V(8); PG8_WAIT_L(0); PG8_BAR; PG8_MMA(0, 0, At, B0); PG8_MMA(0, 1, At, B1); PG8_BAR; PG8_SCHED;
            PG8_LDA(At, 1, 1); PG8_STAGE(PG8_SB(1, 0), b3, voffB); PG8_STAGE(PG8_SB(1, 1), b3 + hstep, voffB); PG8_STAGE(PG8_SA(1, 0), a3, ao2[0]);
            PG8_WAIT_V(8); PG8_WAIT_L(0); PG8_BAR; PG8_MMA(1, 0, At, B0); PG8_MMA(1, 1, At, B1); PG8_BAR; PG8_SCHED;
        }
        if (wr == 0) PG8_BAR;
        E(acc, cur, wr, wc, fr, fq);
        if (!has_next) break;
#pragma unroll
        for (int a = 0; a < 2; ++a)
#pragma unroll
            for (int b = 0; b < 2; ++b)
#pragma unroll
                for (int m = 0; m < 4; ++m)
#pragma unroll
                    for (int n = 0; n < 2; ++n) acc[a][b][m][n] = (f32x4){0.f, 0.f, 0.f, 0.f};
        cur = nxt; cB = nB; ++ui;
        PG8_AOFF(aoC, cur, ui);
        if (wr == 1) PG8_BAR;
    }
    PG8_WAIT_V(0);
    PG8_BAR;
#undef PG8_SA
#undef PG8_SB
#undef PG8_STAGE
#undef PG8_LDA
#undef PG8_LDB
#undef PG8_MMA
#undef PG8_LD8
#undef PG8_HALF
#undef PG8_WAIT_V
#undef PG8_WAIT_L
#undef PG8_BAR
#undef PG8_SCHED
#undef PG8_AOFF
}
}
namespace att {
typedef unsigned short bf16;
typedef short bf16x8 __attribute__((ext_vector_type(8)));
typedef short s16x4 __attribute__((ext_vector_type(4)));
typedef float f32x16 __attribute__((ext_vector_type(16)));
typedef float f32x4 __attribute__((ext_vector_type(4)));
typedef unsigned u32x4 __attribute__((ext_vector_type(4)));
constexpr int NW = 8, QBLK = 32, KVBLK = 64, QB = NW * QBLK, DV = 128;
constexpr float THR = 8.f;
constexpr int SHM_V = KVBLK * DV * 2;
template <int DQK> struct Cfg { static constexpr int NKC = DQK / 8, KCH = NKC / 8, KPITCH = DQK * 2, SHM_K = KVBLK * KPITCH, NQF = DQK / 16, LDS_BYTES = 2 * SHM_V + 2 * SHM_K + NW * 64 * 4; };
#define SBAR() __builtin_amdgcn_sched_barrier(0)
__device__ __forceinline__ int v_st(int k, int c) { const int kk = (k & ~0xC) | ((k & 4) << 1) | ((k & 8) >> 1); return ((kk >> 3) * 4 + (c >> 5)) * 512 + ((kk & 7) * 32 + (c & 31)) * 2; }
__device__ __forceinline__ int v_rd_base(int lane) { return ((lane & 3) << 3) | (((lane >> 2) & 3) << 6) | (((lane >> 4) & 1) << 5) | (((lane >> 5) & 1) << 8); }
constexpr int v_rd_off(int d0, int ks, int half) { return d0 * 512 + ks * 4096 + half * 2048; }
__device__ __forceinline__ int crow(int r, int hi) { return (r & 3) + 8 * (r >> 2) + 4 * hi; }
__device__ __forceinline__ unsigned cvtpk(float lo, float hi) { return pg8::cvt_pk_bf16(lo, hi); }
__device__ __forceinline__ bf16x8 load8(const bf16* p) { return *reinterpret_cast<const bf16x8*>(p); }
__device__ __forceinline__ void mask_tile(f32x16& p0, f32x16& p1, int dq, unsigned W) {
    const float NEG = -__builtin_inff();
#pragma unroll
    for (int r = 0; r < 16; ++r) { const int c = (r & 3) + 8 * (r >> 2);
        if ((unsigned)(dq - c) >= W) p0[r] = NEG;
        if ((unsigned)(dq - c - 32) >= W) p1[r] = NEG; }
}
__device__ __forceinline__ void partialSM(f32x16& p0, f32x16& p1, float& m_reg, float& mn, float& alpha, float scale) {
    float pmax = p0[0];
#pragma unroll
    for (int r = 1; r < 16; ++r) pmax = fmaxf(pmax, p0[r]);
#pragma unroll
    for (int r = 0; r < 16; ++r) pmax = fmaxf(pmax, p1[r]);
    { auto rr = __builtin_amdgcn_permlane32_swap(__float_as_uint(pmax), __float_as_uint(pmax), false, false);
      pmax = fmaxf(__uint_as_float(rr[0]), __uint_as_float(rr[1])); }
    const float C2 = 1.4426950408889634f * scale;
    if (__builtin_expect(__all((pmax - m_reg) * scale <= THR), 1)) { mn = m_reg; alpha = 1.f; }
    else { mn = fmaxf(m_reg, pmax); alpha = __builtin_amdgcn_exp2f((m_reg - mn) * C2); m_reg = mn; }
    const float mnL = -mn * C2;
#pragma unroll
    for (int r = 0; r < 16; ++r) p0[r] = fmaf(p0[r], C2, mnL);
#pragma unroll
    for (int r = 0; r < 16; ++r) p1[r] = fmaf(p1[r], C2, mnL);
#pragma unroll
    for (int r = 0; r < 16; ++r) p0[r] = __builtin_amdgcn_exp2f(p0[r]);
}
__device__ __forceinline__ void finishSM(f32x16& p0, f32x16& p1, float alpha, float& l_reg, bf16x8& pa0, bf16x8& pa1, bf16x8& pa2, bf16x8& pa3) {
#pragma unroll
    for (int r = 0; r < 16; ++r) p1[r] = __builtin_amdgcn_exp2f(p1[r]);
    float ps = 0;
#pragma unroll
    for (int r = 0; r < 16; ++r) ps += p0[r];
#pragma unroll
    for (int r = 0; r < 16; ++r) ps += p1[r];
    { auto rr = __builtin_amdgcn_permlane32_swap(__float_as_uint(ps), __float_as_uint(ps), false, false);
      ps = __uint_as_float(rr[0]) + __uint_as_float(rr[1]); }
    l_reg = l_reg * alpha + ps;
#define PK4(P, B_, OUT) do { unsigned a0 = cvtpk(P[B_+0], P[B_+1]), a1 = cvtpk(P[B_+2], P[B_+3]);                          \
        unsigned b0 = cvtpk(P[B_+4], P[B_+5]), b1 = cvtpk(P[B_+6], P[B_+7]);                                             \
        auto r0 = __builtin_amdgcn_permlane32_swap(a0, b0, false, false); auto r1 = __builtin_amdgcn_permlane32_swap(a1, b1, false, false); \
        u32x4 w = {r0[0], r1[0], r0[1], r1[1]}; OUT = *reinterpret_cast<bf16x8*>(&w); } while (0)
    PK4(p0, 0, pa0); PK4(p0, 8, pa1); PK4(p1, 0, pa2); PK4(p1, 8, pa3);
#undef PK4
}
template <int KB, bool SK, int DQK, bool DIL>
__device__ __forceinline__ void qkt(f32x16& p0, f32x16& p1, const char* K_lds, int r32, int hi, const bf16x8* qr, bool act, float beta, int dq) {
    typedef Cfg<DQK> C;
    if (SK && !act) { const float NEG = -__builtin_inff();
#pragma unroll
        for (int r = 0; r < 16; ++r) { p0[r] = NEG; p1[r] = NEG; } return; }
    if constexpr (DIL) { const float b0 = -beta * (float)dq;
#pragma unroll
        for (int r = 0; r < 16; ++r) { const int c = (r & 3) + 8 * (r >> 2); p0[r] = fmaf(beta, (float)c, b0); p1[r] = fmaf(beta, (float)(c + 32), b0); } }
    else { p0 = f32x16{}; p1 = f32x16{}; }
    const char* kb[4];
#pragma unroll
    for (int dd = 0; dd < 4; ++dd) { const int colB = (dd * 16 + hi * 8) * 2; kb[dd] = K_lds + KB * C::SHM_K + r32 * C::KPITCH + (colB ^ ((r32 & 7) << 4)); }
#pragma unroll
    for (int d0 = 0; d0 < C::NQF; ++d0) { const char* a = kb[d0 & 3] + (d0 >> 2) * 128;
        bf16x8 b0 = *reinterpret_cast<const bf16x8*>(a);
        bf16x8 b1 = *reinterpret_cast<const bf16x8*>(a + 32 * C::KPITCH);
        p0 = __builtin_amdgcn_mfma_f32_32x32x16_bf16(b0, qr[d0], p0, 0, 0, 0);
        p1 = __builtin_amdgcn_mfma_f32_32x32x16_bf16(b1, qr[d0], p1, 0, 0, 0);
#ifndef ATT_NO_QKT_SBAR
        if ((d0 & 3) == 3) SBAR();
#endif
    }
}
#ifdef ATT_PV_PIPE
template <int VB, bool SK>
__device__ __forceinline__ void pv_tile(f32x16* o, int vb0, bf16x8 pa0, bf16x8 pa1, bf16x8 pa2, bf16x8 pa3, bool act) {
    if (SK && !act) return;
#define TRRD(dst, off) asm volatile("ds_read_b64_tr_b16 %0, %1 offset:%2" : "=&v"(dst) : "v"(vb0), "i"(off) : "memory")
#define PV_RD(S_, d0) do { constexpr int b_ = VB * SHM_V + v_rd_off(d0, 0, 0); \
        TRRD(S_##l0, b_); TRRD(S_##h0, b_ + 2048); TRRD(S_##l1, b_ + 4096); TRRD(S_##h1, b_ + 6144); TRRD(S_##l2, b_ + 8192); TRRD(S_##h2, b_ + 10240); TRRD(S_##l3, b_ + 12288); TRRD(S_##h3, b_ + 14336); } while (0)
#define PV_MM(S_, d0) do { \
        o[d0] = __builtin_amdgcn_mfma_f32_32x32x16_bf16(pa0, (bf16x8){S_##l0[0], S_##l0[1], S_##l0[2], S_##l0[3], S_##h0[0], S_##h0[1], S_##h0[2], S_##h0[3]}, o[d0], 0, 0, 0);   \
        o[d0] = __builtin_amdgcn_mfma_f32_32x32x16_bf16(pa1, (bf16x8){S_##l1[0], S_##l1[1], S_##l1[2], S_##l1[3], S_##h1[0], S_##h1[1], S_##h1[2], S_##h1[3]}, o[d0], 0, 0, 0);   \
        o[d0] = __builtin_amdgcn_mfma_f32_32x32x16_bf16(pa2, (bf16x8){S_##l2[0], S_##l2[1], S_##l2[2], S_##l2[3], S_##h2[0], S_##h2[1], S_##h2[2], S_##h2[3]}, o[d0], 0, 0, 0);   \
        o[d0] = __builtin_amdgcn_mfma_f32_32x32x16_bf16(pa3, (bf16x8){S_##l3[0], S_##l3[1], S_##l3[2], S_##l3[3], S_##h3[0], S_##h3[1], S_##h3[2], S_##h3[3]}, o[d0], 0, 0, 0); } while (0)
#define PV_W8() do { asm volatile("s_waitcnt lgkmcnt(8)" ::: "memory"); SBAR(); } while (0)
#define PV_W0() do { asm volatile("s_waitcnt lgkmcnt(0)" ::: "memory"); SBAR(); } while (0)
    s16x4 al0, al1, al2, al3, ah0, ah1, ah2, ah3, bl0, bl1, bl2, bl3, bh0, bh1, bh2, bh3;
    PV_RD(a, 0); PV_RD(b, 1); PV_W8(); PV_MM(a, 0); SBAR();
    PV_RD(a, 2); PV_W8(); PV_MM(b, 1); SBAR();
    PV_RD(b, 3); PV_W8(); PV_MM(a, 2); SBAR();
    PV_W0(); PV_MM(b, 3);
#undef PV_RD
#undef PV_MM
#undef PV_W8
#undef PV_W0
#undef TRRD
}
#else
template <int VB, bool SK>
__device__ __forceinline__ void pv_tile(f32x16* o, int vb0, bf16x8 pa0, bf16x8 pa1, bf16x8 pa2, bf16x8 pa3, bool act) {
    if (SK && !act) return;
#define TRRD(dst, off) asm volatile("ds_read_b64_tr_b16 %0, %1 offset:%2" : "=&v"(dst) : "v"(vb0), "i"(off) : "memory")
#define PV_D0(d0) do { s16x4 l0, l1, l2, l3, h0, h1, h2, h3; constexpr int b_ = VB * SHM_V + v_rd_off(d0, 0, 0); \
        TRRD(l0, b_); TRRD(h0, b_ + 2048); TRRD(l1, b_ + 4096); TRRD(h1, b_ + 6144); TRRD(l2, b_ + 8192); TRRD(h2, b_ + 10240); TRRD(l3, b_ + 12288); TRRD(h3, b_ + 14336); \
        asm volatile("s_waitcnt lgkmcnt(0)" ::: "memory"); SBAR();   \
        o[d0] = __builtin_amdgcn_mfma_f32_32x32x16_bf16(pa0, (bf16x8){l0[0], l0[1], l0[2], l0[3], h0[0], h0[1], h0[2], h0[3]}, o[d0], 0, 0, 0);   \
        o[d0] = __builtin_amdgcn_mfma_f32_32x32x16_bf16(pa1, (bf16x8){l1[0], l1[1], l1[2], l1[3], h1[0], h1[1], h1[2], h1[3]}, o[d0], 0, 0, 0);   \
        o[d0] = __builtin_amdgcn_mfma_f32_32x32x16_bf16(pa2, (bf16x8){l2[0], l2[1], l2[2], l2[3], h2[0], h2[1], h2[2], h2[3]}, o[d0], 0, 0, 0);   \
        o[d0] = __builtin_amdgcn_mfma_f32_32x32x16_bf16(pa3, (bf16x8){l3[0], l3[1], l3[2], l3[3], h3[0], h3[1], h3[2], h3[3]}, o[d0], 0, 0, 0); } while (0)
    PV_D0(0); PV_D0(1); PV_D0(2); PV_D0(3);
#undef PV_D0
#undef TRRD
}
#endif

struct Blk { unsigned qo, ko, vo, oo, lo; int P0, rate; float beta; };
constexpr int PVAR = 0;
#define QS_(B) (DIL ? ((PVAR & 4) ? 128 : (B).rate * 4096) : 1536)
#define KS_(B) (DIL ? ((PVAR & 2) ? 128 : (B).rate * 4096) : 1536)
#define VS_(B) (DIL ? ((PVAR & 2) ? 128 : (B).rate * 4096) : 1024)
#define OS_(B) (DIL ? (B).rate * 1024 : 1024)
#define LS_(B) ((B).rate * 8)
#define SKV_(B) (DIL ? 8192 / (B).rate : 8192)
#define W_(B) (DIL ? 129 : (1 << 30))
#define SCALE_ (DIL ? 0.08838834764831845f : 0.07216878364870322f)
template <int DQK> struct Seam { bf16x8 qr[Cfg<DQK>::NQF]; bf16x8 st_v0, st_v1; bf16x8 st_k[Cfg<DQK>::KCH]; unsigned p_oo = 0; int p_rb = 0, p_so0 = 0, p_on = 0; float cv[4], cw[4]; int cv_j = 0, cv_q = 0, cl_j = 0, cl_q = 0; f32x4 rt[8]; float cvf[32]; int cv_pend = 0; };
__device__ __forceinline__ int swa_jlo(int P0, int W) { const int lowk = P0 - W + 1; return lowk > 0 ? lowk / KVBLK : 0; }

#define VMW() asm volatile("s_waitcnt vmcnt(0)" ::: "memory")
#ifdef ATT_RAWBAR
#define A_STEPBAR() do { asm volatile("s_waitcnt lgkmcnt(0)" ::: "memory"); __builtin_amdgcn_s_barrier(); asm volatile("" ::: "memory"); } while (0)
#else
#define A_STEPBAR() __syncthreads()
#endif
#define VMWN(n) asm volatile("s_waitcnt vmcnt(%0)" :: "i"(n) : "memory")
#define A_RSRC(p) __builtin_amdgcn_make_buffer_rsrc((void*)(p), 0, 0x7fffffff, 0x00020000)
#define A_BLD(rs, vo, so) __builtin_bit_cast(bf16x8, __builtin_amdgcn_raw_buffer_load_b128((rs), (int)(vo), (int)(so), 0))
#ifdef ATT_SLOAD_RECOMP
#define A_SLOAD(B_, k0) do { const __amdgpu_buffer_rsrc_t rv_ = A_RSRC(wsb + (B_).vo), rk_ = A_RSRC(wsb + (B_).ko); const int sov_ = (k0) * VS_(B_) * 2, sok_ = (k0) * KS_(B_) * 2; \
        int t_ = tid; asm volatile("" : "+v"(t_)); const int sr_ = t_ >> 4, sc_ = (t_ & 15) * 8; \
        S.st_v0 = A_BLD(rv_, (sr_ * VS_(B_) + sc_) * 2, sov_); S.st_v1 = A_BLD(rv_, ((32 + sr_) * VS_(B_) + sc_) * 2, sov_); \
        _Pragma("unroll") for (int j_ = 0; j_ < C::KCH; ++j_) { const int q_ = t_ + 512 * j_; S.st_k[j_] = A_BLD(rk_, ((q_ / C::NKC) * KS_(B_) + (q_ % C::NKC) * 8) * 2, sok_); } } while (0)
#else
#define A_SLOAD(B_, k0) do { const __amdgpu_buffer_rsrc_t rv_ = A_RSRC(wsb + (B_).vo), rk_ = A_RSRC(wsb + (B_).ko); const int sov_ = (k0) * VS_(B_) * 2, sok_ = (k0) * KS_(B_) * 2; \
        S.st_v0 = A_BLD(rv_, (sr * VS_(B_) + sc) * 2, sov_); S.st_v1 = A_BLD(rv_, ((32 + sr) * VS_(B_) + sc) * 2, sov_); \
        _Pragma("unroll") for (int j_ = 0; j_ < C::KCH; ++j_) S.st_k[j_] = A_BLD(rk_, (krow[j_] * KS_(B_) + kcol[j_]) * 2, sok_); } while (0)
#endif
#define A_QLOAD(B_) do { const __amdgpu_buffer_rsrc_t rq_ = A_RSRC(wsb + (B_).qo); const int soq_ = ((B_).P0 + wid * QBLK) * QS_(B_) * 2; const int qo_ = r32 * QS_(B_) * 2 + hi * 16; \
        _Pragma("unroll") for (int d0 = 0; d0 < C::NQF; ++d0) S.qr[d0] = A_BLD(rq_, qo_ + d0 * 32, soq_); } while (0)
#define A_SWRITE_K(bf) do { _Pragma("unroll") for (int j_ = 0; j_ < C::KCH; ++j_) *(bf16x8*)(K_lds + (bf) * C::SHM_K + kws[j_]) = S.st_k[j_]; } while (0)
#define A_SWRITE_V(bf) do { *(bf16x8*)(V_lds + (bf) * SHM_V + vst0) = S.st_v0; *(bf16x8*)(V_lds + (bf) * SHM_V + vst1) = S.st_v1; } while (0)
#define A_STAGE_IDX() const int sr = tid >> 4, sc = (tid & 15) * 8; int krow[C::KCH], kcol[C::KCH], kws[C::KCH]; \
        _Pragma("unroll") for (int j_ = 0; j_ < C::KCH; ++j_) { const int q_ = tid + 512 * j_; krow[j_] = q_ / C::NKC; kcol[j_] = (q_ % C::NKC) * 8; kws[j_] = krow[j_] * C::KPITCH + ((kcol[j_] * 2) ^ ((krow[j_] & 7) << 4)); }

__device__ __forceinline__ void store_o_staged(const f32x16* o, const float* rli, char* stg, __amdgpu_buffer_rsrc_t ro_, int rowbytes, int so0_, int lane) {
    const int r32 = lane & 31, hi = lane >> 5, odd = lane & 1, g = odd | (hi << 1);
    char* wb = stg + (odd + 4 * hi) * 256 + (r32 >> 1) * 4;
    char* wa[4];
#pragma unroll
    for (int d0 = 0; d0 < 4; ++d0) wa[d0] = wb + ((d0 ^ g) << 6);
    const int lr = lane >> 4, ch = lane & 15, sp = ch >> 2, gl = lr & 1;
    const char* rb_e = stg + lr * 256 + ((sp ^ gl) << 6) + (lane & 3) * 16;
    const char* rb_o = stg + lr * 256 + ((sp ^ (gl | 2)) << 6) + (lane & 3) * 16;
    const int voff = lr * rowbytes + ch * 16;
#pragma unroll
    for (int h = 0; h < 2; ++h) {
#pragma unroll
        for (int rp = 0; rp < 4; ++rp) { const int r = 8 * h + 2 * rp, Rl = (r & 3) + 8 * ((r >> 2) & 1);
#pragma unroll
            for (int d0 = 0; d0 < 4; ++d0) { const float v0 = o[d0][r] * rli[r], v1 = o[d0][r + 1] * rli[r + 1];
                const float send = odd ? v0 : v1;
                const float recv = __int_as_float(__builtin_amdgcn_update_dpp(0, __float_as_int(send), 0xB1, 0xF, 0xF, true));
                *reinterpret_cast<unsigned*>(wa[d0] + Rl * 256) = cvtpk(odd ? recv : v0, odd ? v1 : recv); } }
        u32x4 d_[4];
#pragma unroll
        for (int i = 0; i < 4; ++i) d_[i] = *reinterpret_cast<const u32x4*>(((i & 1) ? rb_o : rb_e) + i * 1024);
#pragma unroll
        for (int i = 0; i < 4; ++i) __builtin_amdgcn_raw_buffer_store_b128(d_[i], ro_, voff + so0_ + (16 * h + 4 * i) * rowbytes, 0, 0);
    }
}
constexpr int DEFER_STG = 65536, DEFER_WS = 131072 + 512;
__device__ __forceinline__ void stage_write(const f32x16* o, const float* rli, char* stg, int lane) {
    const int r32 = lane & 31, hi = lane >> 5, odd = lane & 1, g = odd | (hi << 1);
    char* wb = stg + (odd + 4 * hi) * 256 + (r32 >> 1) * 4;
    char* wa[4];
#pragma unroll
    for (int d0 = 0; d0 < 4; ++d0) wa[d0] = wb + ((d0 ^ g) << 6);
#pragma unroll
    for (int h = 0; h < 2; ++h)
#pragma unroll
        for (int rp = 0; rp < 4; ++rp) { const int r = 8 * h + 2 * rp, Rl = (r & 3) + 8 * ((r >> 2) & 1);
#pragma unroll
            for (int d0 = 0; d0 < 4; ++d0) { const float v0 = o[d0][r] * rli[r], v1 = o[d0][r + 1] * rli[r + 1];
                const float send = odd ? v0 : v1;
                const float recv = __int_as_float(__builtin_amdgcn_update_dpp(0, __float_as_int(send), 0xB1, 0xF, 0xF, true));
                *reinterpret_cast<unsigned*>(wa[d0] + h * 4096 + Rl * 256) = cvtpk(odd ? recv : v0, odd ? v1 : recv); } }
}
__device__ __forceinline__ void flush_piece(const char* stg, int p, const char* obase, int rowbytes, int so0, int lane) {
    const int lr = lane >> 4, ch = lane & 15, sp = ch >> 2, g = (lr & 1) | ((p & 1) << 1);
    const u32x4 d = *reinterpret_cast<const u32x4*>(stg + p * 1024 + lr * 256 + ((sp ^ g) << 6) + (lane & 3) * 16);
    __builtin_amdgcn_raw_buffer_store_b128(d, A_RSRC(obase), lr * rowbytes + ch * 16 + so0 + 4 * p * rowbytes, 0, 0);
}
struct ConvCtx { const float* eg; const float* eu; const float* ed; unsigned char* w13; unsigned char* w2; int gw; };
constexpr int CONV_SCR = 86016, CONV_NJ = 48;
#ifndef CONV_AUX
#define CONV_AUX 2
#endif
struct ConvItem { const float* src; unsigned char* dst; int ldw, kd; };
__device__ __forceinline__ ConvItem conv_decode(const ConvCtx& X, int j) {
    const int q = X.gw + 2048 * j, e = q / 6144, r = q - e * 6144, m = r >> 11, r2 = r & 2047;
    ConvItem I;
    if (m < 2) { const int kb = r2 >> 6, nb = r2 & 63, n0 = nb * 16; I.ldw = 1024; I.kd = 2048;
        I.src = (m == 0 ? X.eg : X.eu) + (size_t)e * (2048 * 1024) + (size_t)kb * (64 * 1024) + n0;
        I.dst = X.w13 + (size_t)e * (2048 * 2048) + (size_t)((n0 >> 7) * 256 + (m == 1 ? 128 : 0) + (n0 & 127)) * 2048 + kb * 64; }
    else { const int kb = r2 >> 7, nb = r2 & 127; I.ldw = 2048; I.kd = 1024;
        I.src = X.ed + (size_t)e * (1024 * 2048) + (size_t)kb * (64 * 2048) + nb * 16;
        I.dst = X.w2 + (size_t)e * (2048 * 1024) + (size_t)(nb * 16) * 1024 + kb * 64; }
    return I;
}
__device__ __forceinline__ void conv_load(const ConvCtx& X, int j, int qd, float* cv, int lane) {
    const ConvItem I = conv_decode(X, j); const __amdgpu_buffer_rsrc_t rs = A_RSRC(I.src);
#pragma unroll
    for (int i = 0; i < 4; ++i) { const int k = 4 * (4 * qd + i) + (lane >> 4);
        cv[i] = __uint_as_float(__builtin_amdgcn_raw_buffer_load_b32(rs, (k * I.ldw + (lane & 15)) * 4, 0, CONV_AUX)); }
}
__device__ __forceinline__ void conv_put(const ConvCtx& X, int j, int qd, const float* cv, char* scr, int lane, bool finish_only = false) {
    float* s = reinterpret_cast<float*>(scr);
    if (!finish_only) {
#pragma unroll
    for (int i = 0; i < 4; ++i) { const int k = 4 * (4 * qd + i) + (lane >> 4); s[k * 17 + (lane & 15)] = cv[i] * 256.0f; } }
    if (qd == 3) {
        const ConvItem I = conv_decode(X, j); const int n = lane & 15, kq = lane >> 4; const float* c = s + (16 * kq) * 17 + n;
        u32x4 w;
        { int w0 = 0, w1 = 0, w2 = 0, w3 = 0;
          w0 = __builtin_amdgcn_cvt_pk_fp8_f32(c[0 * 17], c[1 * 17], w0, false); w0 = __builtin_amdgcn_cvt_pk_fp8_f32(c[2 * 17], c[3 * 17], w0, true);
          w1 = __builtin_amdgcn_cvt_pk_fp8_f32(c[4 * 17], c[5 * 17], w1, false); w1 = __builtin_amdgcn_cvt_pk_fp8_f32(c[6 * 17], c[7 * 17], w1, true);
          w2 = __builtin_amdgcn_cvt_pk_fp8_f32(c[8 * 17], c[9 * 17], w2, false); w2 = __builtin_amdgcn_cvt_pk_fp8_f32(c[10 * 17], c[11 * 17], w2, true);
          w3 = __builtin_amdgcn_cvt_pk_fp8_f32(c[12 * 17], c[13 * 17], w3, false); w3 = __builtin_amdgcn_cvt_pk_fp8_f32(c[14 * 17], c[15 * 17], w3, true);
          w = (u32x4){(unsigned)w0, (unsigned)w1, (unsigned)w2, (unsigned)w3}; }
        __builtin_amdgcn_raw_buffer_store_b128(w, A_RSRC(I.dst), n * I.kd + 16 * kq, 0, CONV_AUX);
    }
}
constexpr unsigned ROPE_OFF = 2u << 20;
#define A_RTLOAD(B_) do { const __amdgpu_buffer_rsrc_t rr_ = A_RSRC(wsb + ROPE_OFF); const int vo_ = ((B_).P0 + wid * QBLK + r32) * 256 + hi * 32; \
        _Pragma("unroll") for (int d_ = 0; d_ < 4; ++d_) { S.rt[2 * d_] = __builtin_bit_cast(f32x4, __builtin_amdgcn_raw_buffer_load_b128(rr_, vo_ + d_ * 64, 0, 0)); \
                                                            S.rt[2 * d_ + 1] = __builtin_bit_cast(f32x4, __builtin_amdgcn_raw_buffer_load_b128(rr_, vo_ + d_ * 64 + 16, 0, 0)); } } while (0)
__device__ __forceinline__ unsigned rope_pair(unsigned w, float c, float s) { const float x1 = __uint_as_float(w << 16), x2 = __uint_as_float(w & 0xffff0000u); return cvtpk(x1 * c - x2 * s, x2 * c + x1 * s); }
#define A_ROTATE() do { _Pragma("unroll") for (int d_ = 0; d_ < 4; ++d_) { u32x4 w_ = __builtin_bit_cast(u32x4, S.qr[8 + d_]); const f32x4 c01_ = S.rt[2 * d_], c23_ = S.rt[2 * d_ + 1]; \
        w_.x = rope_pair(w_.x, c01_[0], c01_[1]); w_.y = rope_pair(w_.y, c01_[2], c01_[3]); w_.z = rope_pair(w_.z, c23_[0], c23_[1]); w_.w = rope_pair(w_.w, c23_[2], c23_[3]); \
        S.qr[8 + d_] = __builtin_bit_cast(bf16x8, w_); } } while (0)
constexpr int CONV_SCR_DIL = 67584;
#ifndef CONV_PER_IDLE
#define CONV_PER_IDLE 1
#endif
#ifndef CONV_LAST_STEP
#define CONV_LAST_STEP 0
#endif
__device__ __forceinline__ void conv_load_full(const ConvCtx& X, int j, float* cv, int lane) {
    const ConvItem I = conv_decode(X, j); const __amdgpu_buffer_rsrc_t rs = A_RSRC(I.src);
#pragma unroll
    for (int i = 0; i < 16; ++i) { const int k = 4 * i + (lane >> 4); cv[i] = __uint_as_float(__builtin_amdgcn_raw_buffer_load_b32(rs, (k * I.ldw + (lane & 15)) * 4, 0, CONV_AUX)); }
}
__device__ __forceinline__ void conv_put_full(const ConvCtx& X, int j, const float* cv, char* scr, int lane) {
    float* s = reinterpret_cast<float*>(scr);
#pragma unroll
    for (int i = 0; i < 16; ++i) { const int k = 4 * i + (lane >> 4); s[k * 17 + (lane & 15)] = cv[i] * 256.0f; }
    float dummy_[4] = {0.f, 0.f, 0.f, 0.f};
    conv_put(X, j, 3, dummy_, scr, lane, true);
}
template <int DQK, bool DIL, int PVAR = 0, bool ROPE = false>
__device__ __forceinline__ void att_prime(const Blk& cur, const char* wsb, char* lds, Seam<DQK>& S, int tid_in) {
    typedef Cfg<DQK> C;
    int tid = tid_in; asm volatile("" : "+v"(tid));
    const int wid = __builtin_amdgcn_readfirstlane(tid >> 6), lane = tid & 63, r32 = lane & 31, hi = lane >> 5;
    A_STAGE_IDX(); char* K_lds = lds + 2 * SHM_V;
    const int kb0 = swa_jlo(cur.P0, W_(cur)) * KVBLK;
    A_QLOAD(cur);
    if constexpr (ROPE) A_RTLOAD(cur);
    A_SLOAD(cur, kb0); VMW(); A_SWRITE_K(0);
    __syncthreads();
}
template <int DQK, bool DIL, bool SK, int PVAR = 0, int CONV = 0, bool ROPE = false>
__device__ __forceinline__ void att_block(const Blk& cur, const Blk& nxt, const char* wsb, char* lds, Seam<DQK>& S, int tid_in, const ConvCtx* X = nullptr) {
    typedef Cfg<DQK> C;
    int tid = tid_in; asm volatile("" : "+v"(tid));
    const int wid = __builtin_amdgcn_readfirstlane(tid >> 6), lane = tid & 63, r32 = lane & 31, hi = lane >> 5;
    const int W = W_(cur); const float scale = SCALE_, beta = cur.beta;
    int j_lo = swa_jlo(cur.P0, W);
    int j_hi = (cur.P0 + QB - 1) / KVBLK + 1; if (j_hi > SKV_(cur) / KVBLK) j_hi = SKV_(cur) / KVBLK;
    if (PVAR & 8) j_lo = j_hi - 2;
    const int NT = j_hi - j_lo;
    const int kbn = swa_jlo(nxt.P0, W_(nxt)) * KVBLK;
    const int qlo = cur.P0 + wid * QBLK, qm = qlo + r32 - 4 * hi;
    char* V_lds = lds; char* K_lds = lds + 2 * SHM_V;
#ifdef ATT_DEFER
    constexpr bool DEFER = DIL;
#else
    constexpr bool DEFER = false;
#endif
    float* ws = (float*)(lds + (DEFER ? DEFER_WS : 2 * SHM_V + 2 * C::SHM_K)) + wid * 64; float* li_l = ws, * al_l = ws + 32;
    char* stg = lds + DEFER_STG + wid * 8192;
    float m_reg = -1e30f, l_reg = 0; f32x16 o[4] = {};
    A_STAGE_IDX();
    const int vst0 = v_st(sr, sc), vst1 = v_st(32 + sr, sc);
    const int vb0 = (int)(uintptr_t)V_lds + v_rd_base(lane);
#define RESC(a) do { if (__any((a) < 1.f)) { if (hi == 0) al_l[r32] = (a); asm volatile("s_waitcnt lgkmcnt(0)" ::: "memory");              \
                     _Pragma("unroll") for (int d_ = 0; d_ < 4; ++d_) _Pragma("unroll") for (int r = 0; r < 16; ++r) o[d_][r] *= al_l[crow(r, hi)]; } } while (0)
#define KBASE(t) ((j_lo + (t)) * KVBLK)
#define ACT(t) (KBASE(t) <= qlo + QBLK - 1 && KBASE(t) + KVBLK - 1 >= qlo - W + 1)
#define MASKT(P0_, P1_, t) do { const int kb_ = KBASE(t); if ((!SK || ACT(t)) && (kb_ + KVBLK - 1 > qlo || kb_ <= qlo + QBLK - 1 - W)) mask_tile(P0_, P1_, qm - kb_, (unsigned)W); } while (0)
    A_SWRITE_V(0);
    __syncthreads();
    if constexpr (ROPE) { VMW(); A_ROTATE(); }
#define STEP(t, BUF) do { const bool more_ = (t) + 1 < NT;                                                                        \
        if (more_) { A_SLOAD(cur, KBASE((t) + 1)); } else { A_SLOAD(nxt, kbn); }                                                   \
        const bool cpend_ = CONV == 1 && (S.cv_j != S.cl_j || S.cv_q != S.cl_q); const bool cld_ = CONV == 1 && more_ && S.cl_j < CONV_NJ;        \
        const bool act_ = !SK || ACT(t); const bool cidle_ = CONV == 2 && (more_ || CONV_LAST_STEP) && !act_ && (S.cv_j < CONV_NJ);                                \
        bool cnew_ = false;                                                                                                    \
        if (cidle_) { if (S.cv_pend) { VMWN(C::KCH + 2);        \
                          conv_put_full(*X, S.cv_j, S.cvf, lds + (DIL ? CONV_SCR_DIL : CONV_SCR) + wid * 4352, lane); ++S.cv_j;                 \
                          if (S.cv_pend > 1) { conv_put_full(*X, S.cv_j, S.cvf + 16, lds + (DIL ? CONV_SCR_DIL : CONV_SCR) + wid * 4352, lane); ++S.cv_j; } S.cv_pend = 0; } \
                      if (S.cv_j < CONV_NJ) { conv_load_full(*X, S.cv_j, S.cvf, lane); S.cv_pend = 1; cnew_ = true;                                \
                          if (CONV_PER_IDLE > 1 && S.cv_j + 1 < CONV_NJ) { conv_load_full(*X, S.cv_j + 1, S.cvf + 16, lane); S.cv_pend = 2; } } }        \
        if (cld_) { conv_load(*X, S.cl_j, S.cl_q, BUF ? S.cw : S.cv, lane); if (++S.cl_q == 4) { S.cl_q = 0; ++S.cl_j; } }               \
        if (DEFER && S.p_on && (t) < 4) { flush_piece(stg, 2 * (t), wsb + S.p_oo, S.p_rb, S.p_so0, lane); flush_piece(stg, 2 * (t) + 1, wsb + S.p_oo, S.p_rb, S.p_so0, lane); } \
        SBAR();                                                                                                                 \
        if (act_) { f32x16 p0, p1; float mn_, al_; bf16x8 pa0, pa1, pa2, pa3;      \
            qkt<BUF, false, DQK, DIL>(p0, p1, K_lds, r32, hi, S.qr, true, beta, qm - KBASE(t)); SBAR();                              \
            MASKT(p0, p1, t); partialSM(p0, p1, m_reg, mn_, al_, scale); finishSM(p0, p1, al_, l_reg, pa0, pa1, pa2, pa3); RESC(al_); SBAR(); \
            pv_tile<BUF, false>(o, vb0, pa0, pa1, pa2, pa3, true); }                                                             \
        if (!more_) { SBAR(); A_QLOAD(nxt); SBAR(); }                                 \
        if (more_) { if (cnew_) { if (S.cv_pend > 1) VMWN(32); else VMWN(16); } else if (cld_) VMWN(4); else VMW();            \
            A_SWRITE_V(1 - BUF); A_SWRITE_K(1 - BUF);                                                                              \
            if (cpend_) { conv_put(*X, S.cv_j, S.cv_q, BUF ? S.cv : S.cw, lds + CONV_SCR + wid * 4352, lane); if (++S.cv_q == 4) { S.cv_q = 0; ++S.cv_j; } } \
        }                                                                                                                       \
        A_STEPBAR(); } while (0)
    int t = 0;
    for (; t + 1 < NT; t += 2) { STEP(t, 0); STEP(t + 1, 1); }
    if (t < NT) { STEP(t, 0); }
    VMWN(C::NQF); A_SWRITE_K(0); SBAR();
    if (CONV == 1 && (S.cv_j != S.cl_j || S.cv_q != S.cl_q)) { conv_put(*X, S.cv_j, S.cv_q, S.cv, lds + CONV_SCR + wid * 4352, lane); if (++S.cv_q == 4) { S.cv_q = 0; ++S.cv_j; } }
    if (hi == 0) li_l[r32] = l_reg; asm volatile("s_waitcnt lgkmcnt(0)" ::: "memory");
    if constexpr (DIL) { if (hi == 0) __builtin_amdgcn_raw_buffer_store_b32(__float_as_uint(m_reg * scale + __logf(l_reg)), A_RSRC(wsb + cur.lo), r32 * LS_(cur) * 4, (cur.P0 + wid * QBLK) * LS_(cur) * 4, 0); }
    float rli[16];
#pragma unroll
    for (int r = 0; r < 16; ++r) rli[r] = __builtin_amdgcn_rcpf(li_l[crow(r, hi)]);
    if constexpr (DEFER) { stage_write(o, rli, stg, lane); S.p_oo = cur.oo; S.p_rb = OS_(cur) * 2; S.p_so0 = (cur.P0 + wid * QBLK) * OS_(cur) * 2; S.p_on = 1; }
    else {
#ifdef ATT_T21
    store_o_staged(o, rli, wid < 4 ? lds + SHM_V + wid * 4096 : lds + 2 * SHM_V + C::SHM_K + (wid - 4) * 4096, A_RSRC(wsb + cur.oo), OS_(cur) * 2, (cur.P0 + wid * QBLK) * OS_(cur) * 2, lane);
#else
    const int os_ = (PVAR & 1) ? 0 : OS_(cur);
    const __amdgpu_buffer_rsrc_t ro_ = A_RSRC(wsb + cur.oo); const int oo_ = (4 * hi * os_ + r32) * 2, so0_ = (cur.P0 + wid * QBLK) * os_ * 2;
#pragma unroll
    for (int r = 0; r < 16; ++r) { const int sor_ = so0_ + ((r & 3) + 8 * (r >> 2)) * os_ * 2;
#pragma unroll
        for (int d0 = 0; d0 < 4; ++d0) { const float v = o[d0][r] * rli[r];
            const float vn = __int_as_float(__builtin_amdgcn_update_dpp(0, __float_as_int(v), 0xB1, 0xF, 0xF, true));
            if ((r32 & 1) == 0) __builtin_amdgcn_raw_buffer_store_b32(cvtpk(v, vn), ro_, oo_ + d0 * 64, sor_, 0); } }
#endif
    }
    if constexpr (ROPE) A_RTLOAD(nxt);
#undef RESC
#undef KBASE
#undef ACT
#undef MASKT
#undef STEP
}

template <int DQK> struct SeamD { bf16x8 qr[Cfg<DQK>::NQF]; };
#define A_GLDS(voff, sbase, ldsdst) do { unsigned keep_; asm volatile("s_mov_b32 %0, m0\n\ts_mov_b32 m0, %2\n\ts_nop 0\n\tglobal_load_lds_dwordx4 %1, %3\n\ts_mov_b32 m0, %0" \
        : "=&s"(keep_) : "v"(voff), "s"((unsigned)__builtin_amdgcn_readfirstlane((int)(ldsdst))), "s"((const void*)(sbase)) : "memory"); } while (0)
#define A_DMA_IDX() int krow_[C::KCH], kcb_[C::KCH], vrow_[2], vcb_[2]; \
        _Pragma("unroll") for (int j_ = 0; j_ < C::KCH; ++j_) { const int p_ = (j_ * 8 + wid) * 1024 + lane * 16, row_ = p_ / C::KPITCH, pc_ = (p_ % C::KPITCH) / 16, lc_ = (pc_ & ~7) | ((pc_ & 7) ^ (row_ & 7)); \
            krow_[j_] = row_; kcb_[j_] = lc_ * 16; } \
        _Pragma("unroll") for (int j_ = 0; j_ < 2; ++j_) { const int p_ = (j_ * 8 + wid) * 1024 + lane * 16, s_ = p_ / 512, w_ = p_ % 512, kk_ = (s_ >> 2) * 8 + (w_ >> 6), col_ = (s_ & 3) * 32 + ((w_ & 63) >> 1); \
            vrow_[j_] = (kk_ & ~0xC) | ((kk_ & 4) << 1) | ((kk_ & 8) >> 1); vcb_[j_] = col_ * 2; }
#define A_DMA(B_, k0, sl_) do { const char* kb_ = wsb + (B_).ko + (size_t)(k0) * (size_t)(KS_(B_) * 2); const char* vb_ = wsb + (B_).vo + (size_t)(k0) * (size_t)(VS_(B_) * 2); \
        _Pragma("unroll") for (int j_ = 0; j_ < C::KCH; ++j_) A_GLDS((unsigned)(krow_[j_] * KS_(B_) * 2 + kcb_[j_]), kb_, lds0 + NS * SHM_V + (sl_) * C::SHM_K + (j_ * 8 + wid) * 1024); \
        _Pragma("unroll") for (int j_ = 0; j_ < 2; ++j_) A_GLDS((unsigned)(vrow_[j_] * VS_(B_) * 2 + vcb_[j_]), vb_, lds0 + (sl_) * SHM_V + (j_ * 8 + wid) * 1024); } while (0)
template <int DQK, bool DIL, int NS>
__device__ __forceinline__ void att_prime_dma(const Blk& cur, const char* wsb, char* lds, SeamD<DQK>& S, int tid_in) {
    typedef Cfg<DQK> C;
    int tid = tid_in; asm volatile("" : "+v"(tid));
    const int wid = __builtin_amdgcn_readfirstlane(tid >> 6), lane = tid & 63, r32 = lane & 31, hi = lane >> 5;
    const unsigned lds0 = (unsigned)(uintptr_t)lds;
    A_DMA_IDX();
    const int kb0 = swa_jlo(cur.P0, W_(cur)) * KVBLK;
    A_QLOAD(cur);
#pragma unroll
    for (int i_ = 0; i_ < NS - 1; ++i_) A_DMA(cur, kb0 + i_ * KVBLK, i_);
}
template <int DQK, bool DIL, bool SK, int NS>
__device__ __forceinline__ void att_block_dma(const Blk& cur, const Blk& nxt, const char* wsb, char* lds, char* wsl, SeamD<DQK>& S, int tid_in) {
    typedef Cfg<DQK> C;
    int tid = tid_in; asm volatile("" : "+v"(tid));
    const int wid = __builtin_amdgcn_readfirstlane(tid >> 6), lane = tid & 63, r32 = lane & 31, hi = lane >> 5;
    const int W = W_(cur); const float scale = SCALE_, beta = cur.beta;
    const int j_lo = swa_jlo(cur.P0, W);
    int j_hi = (cur.P0 + QB - 1) / KVBLK + 1; if (j_hi > SKV_(cur) / KVBLK) j_hi = SKV_(cur) / KVBLK;
    const int NT = j_hi - j_lo;
    const int kbn = swa_jlo(nxt.P0, W_(nxt)) * KVBLK;
    const int qlo = cur.P0 + wid * QBLK, qm = qlo + r32 - 4 * hi;
    const unsigned lds0 = (unsigned)(uintptr_t)lds;
    const char* K_lds = lds + NS * SHM_V;
    float* ws = (float*)wsl + wid * 64; float* li_l = ws, * al_l = ws + 32;
    float m_reg = -1e30f, l_reg = 0; f32x16 o[4] = {};
    A_DMA_IDX();
    const int vb0 = (int)lds0 + v_rd_base(lane);
    constexpr int NDMA = C::KCH + 2;
#define RESC(a) do { if (__any((a) < 1.f)) { if (hi == 0) al_l[r32] = (a); asm volatile("s_waitcnt lgkmcnt(0)" ::: "memory");              \
                     _Pragma("unroll") for (int d_ = 0; d_ < 4; ++d_) _Pragma("unroll") for (int r = 0; r < 16; ++r) o[d_][r] *= al_l[crow(r, hi)]; } } while (0)
#define KBASE(t) ((j_lo + (t)) * KVBLK)
#define ACT(t) (KBASE(t) <= qlo + QBLK - 1 && KBASE(t) + KVBLK - 1 >= qlo - W + 1)
#define MASKT(P0_, P1_, t) do { const int kb_ = KBASE(t); if ((!SK || ACT(t)) && (kb_ + KVBLK - 1 > qlo || kb_ <= qlo + QBLK - 1 - W)) mask_tile(P0_, P1_, qm - kb_, (unsigned)W); } while (0)
    VMW();
#pragma unroll
    for (int d0 = 0; d0 < C::NQF; ++d0) asm volatile("" : "+v"(S.qr[d0]));
    asm volatile("s_waitcnt lgkmcnt(0)" ::: "memory"); __builtin_amdgcn_s_barrier(); asm volatile("" ::: "memory");
    int sl = 0, sl2 = NS - 1;
#pragma unroll 1
    for (int t = 0; t < NT; ++t) {
        const bool pre = t + NS - 1 < NT;
        if (pre) A_DMA(cur, KBASE(t + NS - 1), sl2);
        SBAR(); f32x16 p0, p1; float mn_, al_; bf16x8 pa0, pa1, pa2, pa3;
        qkt<0, SK, DQK, DIL>(p0, p1, K_lds + sl * C::SHM_K, r32, hi, S.qr, ACT(t), beta, qm - KBASE(t)); SBAR();
        MASKT(p0, p1, t); partialSM(p0, p1, m_reg, mn_, al_, scale); finishSM(p0, p1, al_, l_reg, pa0, pa1, pa2, pa3); RESC(al_); SBAR();
        pv_tile<0, SK>(o, vb0 + sl * SHM_V, pa0, pa1, pa2, pa3, ACT(t));
        if (t + 1 < NT) { int infl = NT - 2 - t; if (infl > NS - 2) infl = NS - 2;
                          if (infl <= 0) VMW(); else if (infl == 1) VMWN(NDMA); else VMWN(2 * NDMA);
                          asm volatile("s_waitcnt lgkmcnt(0)" ::: "memory"); __builtin_amdgcn_s_barrier(); asm volatile("" ::: "memory"); }
        sl = sl == NS - 1 ? 0 : sl + 1; sl2 = sl2 == NS - 1 ? 0 : sl2 + 1;
    }
    asm volatile("s_waitcnt lgkmcnt(0)" ::: "memory"); __builtin_amdgcn_s_barrier(); asm volatile("" ::: "memory");
    A_QLOAD(nxt);
#pragma unroll
    for (int i_ = 0; i_ < NS - 1; ++i_) A_DMA(nxt, kbn + i_ * KVBLK, i_);
    if (hi == 0) li_l[r32] = l_reg; asm volatile("s_waitcnt lgkmcnt(0)" ::: "memory");
    if constexpr (DIL) { if (hi == 0) __builtin_amdgcn_raw_buffer_store_b32(__float_as_uint(m_reg * scale + __logf(l_reg)), A_RSRC(wsb + cur.lo), r32 * LS_(cur) * 4, (cur.P0 + wid * QBLK) * LS_(cur) * 4, 0); }
    float rli[16];
#pragma unroll
    for (int r = 0; r < 16; ++r) rli[r] = __builtin_amdgcn_rcpf(li_l[crow(r, hi)]);
    const __amdgpu_buffer_rsrc_t ro_ = A_RSRC(wsb + cur.oo); const int oo_ = (4 * hi * OS_(cur) + r32) * 2, so0_ = (cur.P0 + wid * QBLK) * OS_(cur) * 2;
#pragma unroll
    for (int r = 0; r < 16; ++r) { const int sor_ = so0_ + ((r & 3) + 8 * (r >> 2)) * OS_(cur) * 2;
#pragma unroll
        for (int d0 = 0; d0 < 4; ++d0) { const float v = o[d0][r] * rli[r];
            const float vn = __int_as_float(__builtin_amdgcn_update_dpp(0, __float_as_int(v), 0xB1, 0xF, 0xF, true));
            if ((r32 & 1) == 0) __builtin_amdgcn_raw_buffer_store_b32(cvtpk(v, vn), ro_, oo_ + d0 * 64, sor_, 0); } }
#undef RESC
#undef KBASE
#undef ACT
#undef MASKT
}

template <bool SK, int DQK, bool DIL>
__device__ __forceinline__ void qkt_fin(f32x16& p0, f32x16& p1, const char* K_lds, int r32, int hi, const bf16x8* qr, bool act, float beta, int dq,
                                        f32x16& y0, f32x16& y1, float alpha, float& l_reg, bf16x8& pa0, bf16x8& pa1, bf16x8& pa2, bf16x8& pa3) {
    typedef Cfg<DQK> C;
    const bool run = !(SK && !act);
    if (!run) { const float NEG = -__builtin_inff();
#pragma unroll
        for (int r = 0; r < 16; ++r) { p0[r] = NEG; p1[r] = NEG; } }
    else if constexpr (DIL) { const float b0 = -beta * (float)dq;
#pragma unroll
        for (int r = 0; r < 16; ++r) { const int c = (r & 3) + 8 * (r >> 2); p0[r] = fmaf(beta, (float)c, b0); p1[r] = fmaf(beta, (float)(c + 32), b0); } }
    else { p0 = f32x16{}; p1 = f32x16{}; }
    const char* kb[4];
#pragma unroll
    for (int dd = 0; dd < 4; ++dd) { const int colB = (dd * 16 + hi * 8) * 2; kb[dd] = K_lds + r32 * C::KPITCH + (colB ^ ((r32 & 7) << 4)); }
#define QK_CHUNK(c_) do { if (run) { _Pragma("unroll") for (int d0 = 4 * (c_); d0 < 4 * (c_) + 4 && d0 < C::NQF; ++d0) { const char* a = kb[d0 & 3] + (d0 >> 2) * 128; \
            bf16x8 b0 = *reinterpret_cast<const bf16x8*>(a); bf16x8 b1 = *reinterpret_cast<const bf16x8*>(a + 32 * C::KPITCH);                                  \
            p0 = __builtin_amdgcn_mfma_f32_32x32x16_bf16(b0, qr[d0], p0, 0, 0, 0); p1 = __builtin_amdgcn_mfma_f32_32x32x16_bf16(b1, qr[d0], p1, 0, 0, 0); } } } while (0)
#define PK4(P, B_, OUT) do { unsigned a0 = cvtpk(P[B_+0], P[B_+1]), a1 = cvtpk(P[B_+2], P[B_+3]);                          \
        unsigned b0 = cvtpk(P[B_+4], P[B_+5]), b1 = cvtpk(P[B_+6], P[B_+7]);                                             \
        auto r0 = __builtin_amdgcn_permlane32_swap(a0, b0, false, false); auto r1 = __builtin_amdgcn_permlane32_swap(a1, b1, false, false); \
        u32x4 w = {r0[0], r1[0], r0[1], r1[1]}; OUT = *reinterpret_cast<bf16x8*>(&w); } while (0)
    QK_CHUNK(0);
#pragma unroll
    for (int r = 0; r < 16; ++r) y1[r] = __builtin_amdgcn_exp2f(y1[r]);
    float ps = 0;
#pragma unroll
    for (int r = 0; r < 16; ++r) ps += y0[r];
#pragma unroll
    for (int r = 0; r < 16; ++r) ps += y1[r];
    SBAR();
    QK_CHUNK(1);
    { auto rr = __builtin_amdgcn_permlane32_swap(__float_as_uint(ps), __float_as_uint(ps), false, false);
      ps = __uint_as_float(rr[0]) + __uint_as_float(rr[1]); }
    l_reg = l_reg * alpha + ps;
    PK4(y0, 0, pa0); PK4(y0, 8, pa1);
    if constexpr (C::NQF > 8) { SBAR(); QK_CHUNK(2); }
    PK4(y1, 0, pa2); PK4(y1, 8, pa3);
#undef PK4
#undef QK_CHUNK
}
#ifndef ATT_SKEW_SEL
#define ATT_SKEW_SEL 0
#endif
#if ATT_SKEW_SEL == 0
#define ATT_SKEW_A (wid < 4)
#elif ATT_SKEW_SEL == 1
#define ATT_SKEW_A ((wid & 1) == 0)
#elif ATT_SKEW_SEL == 2
#define ATT_SKEW_A true
#else
#define ATT_SKEW_A false
#endif
#define A_DMA_K(B_, k0, sl_) do { const char* kb_ = wsb + (B_).ko + (size_t)(k0) * (size_t)(KS_(B_) * 2); int ln_ = lane; asm volatile("" : "+v"(ln_)); \
        _Pragma("unroll") for (int j_ = 0; j_ < C::KCH; ++j_) { const int p_ = (j_ * 8 + wid) * 1024 + ln_ * 16, row_ = p_ / C::KPITCH, pc_ = (p_ % C::KPITCH) / 16, lc_ = (pc_ & ~7) | ((pc_ & 7) ^ (row_ & 7)); \
            A_GLDS((unsigned)(row_ * KS_(B_) * 2 + lc_ * 16), kb_, lds0 + 3 * SHM_V + (sl_) * C::SHM_K + (j_ * 8 + wid) * 1024); } } while (0)
#define A_DMA_V(B_, k0, sl_) do { const char* vb_ = wsb + (B_).vo + (size_t)(k0) * (size_t)(VS_(B_) * 2); int ln_ = lane; asm volatile("" : "+v"(ln_)); \
        _Pragma("unroll") for (int j_ = 0; j_ < 2; ++j_) { const int p_ = (j_ * 8 + wid) * 1024 + ln_ * 16, s_ = p_ / 512, w_ = p_ % 512, kk_ = (s_ >> 2) * 8 + (w_ >> 6), col_ = (s_ & 3) * 32 + ((w_ & 63) >> 1); \
            const int vr_ = (kk_ & ~0xC) | ((kk_ & 4) << 1) | ((kk_ & 8) >> 1); \
            A_GLDS((unsigned)(vr_ * VS_(B_) * 2 + col_ * 2), vb_, lds0 + (sl_) * SHM_V + (j_ * 8 + wid) * 1024); } } while (0)
#define A_RAWBAR() do { asm volatile("s_waitcnt lgkmcnt(0)" ::: "memory"); __builtin_amdgcn_s_barrier(); asm volatile("" ::: "memory"); } while (0)
template <int DQK, bool DIL>
__device__ __forceinline__ void att_prime_dma2(const Blk& cur, const char* wsb, char* lds, SeamD<DQK>& S, int tid_in) {
    typedef Cfg<DQK> C; constexpr int NS = 3;
    int tid = tid_in; asm volatile("" : "+v"(tid));
    const int wid = __builtin_amdgcn_readfirstlane(tid >> 6), lane = tid & 63, r32 = lane & 31, hi = lane >> 5;
    const unsigned lds0 = (unsigned)(uintptr_t)lds;
    const int kb0 = swa_jlo(cur.P0, W_(cur)) * KVBLK;
    A_QLOAD(cur);
    A_DMA_K(cur, kb0, 0); A_DMA_V(cur, kb0, 0); A_DMA_K(cur, kb0 + KVBLK, 1);
}
template <int DQK, bool DIL, bool SK, int ORD>
__device__ __forceinline__ void att_block_dma2(const Blk& cur, const Blk& nxt, const char* wsb, char* lds, SeamD<DQK>& S, int tid_in) {
    typedef Cfg<DQK> C; constexpr int NS = 3;
    int tid = tid_in; asm volatile("" : "+v"(tid));
    const int wid = __builtin_amdgcn_readfirstlane(tid >> 6), lane = tid & 63, r32 = lane & 31, hi = lane >> 5;
    const int W = W_(cur); const float scale = SCALE_, beta = cur.beta;
    const int j_lo = swa_jlo(cur.P0, W);
    int j_hi = (cur.P0 + QB - 1) / KVBLK + 1; if (j_hi > SKV_(cur) / KVBLK) j_hi = SKV_(cur) / KVBLK;
    const int NT = j_hi - j_lo;
    const int kbn = swa_jlo(nxt.P0, W_(nxt)) * KVBLK;
    const int qlo = cur.P0 + wid * QBLK, qm = qlo + r32 - 4 * hi;
    const unsigned lds0 = (unsigned)(uintptr_t)lds;
    const char* K_lds = lds + 3 * SHM_V;
    float* ws = (float*)(lds + 3 * SHM_V + 3 * C::SHM_K) + wid * 64; float* li_l = ws, * al_l = ws + 32;
    float m_reg = -1e30f, l_reg = 0; f32x16 o[4] = {};
    const int vb0 = (int)lds0 + v_rd_base(lane);
#define RESC(a) do { if (__any((a) < 1.f)) { if (hi == 0) al_l[r32] = (a); asm volatile("s_waitcnt lgkmcnt(0)" ::: "memory");              \
                     _Pragma("unroll") for (int d_ = 0; d_ < 4; ++d_) _Pragma("unroll") for (int r = 0; r < 16; ++r) o[d_][r] *= al_l[crow(r, hi)]; } } while (0)
#define KBASE(t) ((j_lo + (t)) * KVBLK)
#define ACT(t) (KBASE(t) <= qlo + QBLK - 1 && KBASE(t) + KVBLK - 1 >= qlo - W + 1)
#define MASKT(P0_, P1_, t) do { const int kb_ = KBASE(t); if ((!SK || ACT(t)) && (kb_ + KVBLK - 1 > qlo || kb_ <= qlo + QBLK - 1 - W)) mask_tile(P0_, P1_, qm - kb_, (unsigned)W); } while (0)
#define ISSUE(t, n_) do { n_ = 0; if ((t) + 2 < NT) { int slotk_ = sl + 2; if (slotk_ >= 3) slotk_ -= 3; A_DMA_K(cur, KBASE((t) + 2), slotk_); n_ += C::KCH; } \
                          if ((t) + 1 < NT) { int slotv_ = sl + 1; if (slotv_ >= 3) slotv_ -= 3; A_DMA_V(cur, KBASE((t) + 1), slotv_); n_ += 2; } } while (0)
#define CLOSE(n_) do { if ((n_) == C::KCH + 2) VMWN(C::KCH + 2); else if ((n_) == 2) VMWN(2); else VMW(); A_RAWBAR(); } while (0)
    VMW();
#pragma unroll
    for (int d0 = 0; d0 < C::NQF; ++d0) asm volatile("" : "+v"(S.qr[d0]));
    A_RAWBAR();
    int sl = 0, slp = 2, nis;
    f32x16 pA0, pA1, pB0, pB1; float mnA, mnB, alA, alB; bf16x8 pa0, pa1, pa2, pa3;
    ISSUE(0, nis); SBAR();
    qkt<0, SK, DQK, DIL>(pA0, pA1, K_lds + sl * C::SHM_K, r32, hi, S.qr, ACT(0), beta, qm - KBASE(0)); SBAR();
    MASKT(pA0, pA1, 0); partialSM(pA0, pA1, m_reg, mnA, alA, scale);
    CLOSE(nis); slp = sl; sl = sl == 2 ? 0 : sl + 1;
#define STEPP(PX0, PX1, mnX, alX, PY0, PY1, alY, t) do { ISSUE(t, nis); SBAR();                                               \
        if constexpr (ORD == 0) {                                                                                               \
            qkt<0, SK, DQK, DIL>(PX0, PX1, K_lds + sl * C::SHM_K, r32, hi, S.qr, ACT(t), beta, qm - KBASE(t)); SBAR();           \
            finishSM(PY0, PY1, alY, l_reg, pa0, pa1, pa2, pa3); SBAR();                                                         \
            pv_tile<0, SK>(o, vb0 + slp * SHM_V, pa0, pa1, pa2, pa3, ACT((t) - 1)); SBAR();                                     \
        } else {                                                                                                                \
            finishSM(PY0, PY1, alY, l_reg, pa0, pa1, pa2, pa3); SBAR();                                                         \
            pv_tile<0, SK>(o, vb0 + slp * SHM_V, pa0, pa1, pa2, pa3, ACT((t) - 1)); SBAR();                                     \
            qkt<0, SK, DQK, DIL>(PX0, PX1, K_lds + sl * C::SHM_K, r32, hi, S.qr, ACT(t), beta, qm - KBASE(t)); SBAR();           \
        }                                                                                                                       \
        MASKT(PX0, PX1, (t)); partialSM(PX0, PX1, m_reg, mnX, alX, scale);                                                     \
        RESC(alX); CLOSE(nis); slp = sl; sl = sl == 2 ? 0 : sl + 1; } while (0)
    int t = 1;
#pragma unroll 1
    for (; t + 2 < NT; t += 2) {
        STEPP(pB0, pB1, mnB, alB, pA0, pA1, alA, t);
        STEPP(pA0, pA1, mnA, alA, pB0, pB1, alB, t + 1);
    }
    STEPP(pB0, pB1, mnB, alB, pA0, pA1, alA, t);
    finishSM(pB0, pB1, alB, l_reg, pa0, pa1, pa2, pa3); SBAR();
    pv_tile<0, SK>(o, vb0 + slp * SHM_V, pa0, pa1, pa2, pa3, ACT(NT - 1));
    A_RAWBAR();
    A_QLOAD(nxt);
    A_DMA_K(nxt, kbn, 0); A_DMA_V(nxt, kbn, 0); A_DMA_K(nxt, kbn + KVBLK, 1);
    if (hi == 0) li_l[r32] = l_reg; asm volatile("s_waitcnt lgkmcnt(0)" ::: "memory");
    if constexpr (DIL) { if (hi == 0) __builtin_amdgcn_raw_buffer_store_b32(__float_as_uint(m_reg * scale + __logf(l_reg)), A_RSRC(wsb + cur.lo), r32 * LS_(cur) * 4, (cur.P0 + wid * QBLK) * LS_(cur) * 4, 0); }
    float rli[16];
#pragma unroll
    for (int r = 0; r < 16; ++r) rli[r] = __builtin_amdgcn_rcpf(li_l[crow(r, hi)]);
    const __amdgpu_buffer_rsrc_t ro_ = A_RSRC(wsb + cur.oo); const int oo_ = (4 * hi * OS_(cur) + r32) * 2, so0_ = (cur.P0 + wid * QBLK) * OS_(cur) * 2;
#pragma unroll
    for (int r = 0; r < 16; ++r) { const int sor_ = so0_ + ((r & 3) + 8 * (r >> 2)) * OS_(cur) * 2;
#pragma unroll
        for (int d0 = 0; d0 < 4; ++d0) { const float v = o[d0][r] * rli[r];
            const float vn = __int_as_float(__builtin_amdgcn_update_dpp(0, __float_as_int(v), 0xB1, 0xF, 0xF, true));
            if ((r32 & 1) == 0) __builtin_amdgcn_raw_buffer_store_b32(cvtpk(v, vn), ro_, oo_ + d0 * 64, sor_, 0); } }
#undef RESC
#undef KBASE
#undef ACT
#undef MASKT
#undef ISSUE
#undef CLOSE
#undef STEPP
}
#undef A_DMA_K
#undef A_DMA_V
#undef A_RAWBAR
#undef A_GLDS
#undef A_DMA_IDX
#undef A_DMA
#undef VMW
#undef VMWN
#undef A_SLOAD
#undef A_RSRC
#undef A_BLD
#undef A_QLOAD
#undef A_SWRITE_K
#undef A_SWRITE_V
#undef A_STAGE_IDX
#undef SBAR
#undef QS_
#undef KS_
#undef VS_
#undef OS_
#undef LS_
#undef SKV_
#undef W_
#undef SCALE_
}
constexpr int NWAVES = 8;
constexpr int T = 32768, DM = 2048, SEQ = 8192, NB = 4, DEPTH = 2;
constexpr int IN_COLS = 3904, PROJ_LD = 4096, NEXP = 16, DEXP = 1024;
constexpr int C_QB = 0, C_KB = 1024, C_VB = 2048, C_CQ = 3072, C_CKV = 3584, C_KR = 3840;
constexpr float EPS = 1e-6f;
constexpr size_t MiB = 1u << 20;
constexpr size_t WS_CTL = 0, CTL_ZERO_BYTES = 1 * MiB;
constexpr size_t WS_MOD = 1 * MiB;
constexpr size_t WS_ROPE = 2 * MiB;
constexpr size_t WS_RSTDQ = 4 * MiB, WS_RSTDKV = 4 * MiB + 256 * 1024, WS_AW = 4 * MiB + 512 * 1024;
constexpr size_t WS_ROWIDX = 5 * MiB;
constexpr size_t WS_LSE = 8 * MiB;
constexpr size_t WS_WIN = 16 * MiB;
constexpr size_t WS_WUQ = 48 * MiB;
constexpr size_t WS_WUKV = 51 * MiB;
constexpr size_t WS_WOUT = 53 * MiB;
constexpr size_t WS_W13 = 72 * MiB;
constexpr size_t WS_W2 = 200 * MiB;
constexpr size_t WS_H = 264 * MiB;
constexpr size_t WS_PROJ = 392 * MiB;
constexpr size_t WS_QA = 648 * MiB;
constexpr size_t WS_KF = 744 * MiB;
constexpr size_t WS_VB = 840 * MiB;
constexpr size_t WS_OA = 904 * MiB;
constexpr size_t WS_OB = 968 * MiB;
constexpr size_t WS_XB = 1160 * MiB;
constexpr size_t WS_END = 1288 * MiB;
constexpr size_t WS_HMID = WS_PROJ;
constexpr size_t WS_Y = WS_QA;
constexpr int CW_TMO = 0;
constexpr int CW_CNT = 64;
constexpr int CW_BAR = 4096;
constexpr int RING_BYTES = 131072;
constexpr int L_MISC = RING_BYTES, L_TS = RING_BYTES + 256, L_CNT = RING_BYTES + 384, L_TOK = RING_BYTES + 512, L_ATAB = RING_BYTES + 2560;
constexpr int MAXU = 10;
constexpr int LDS_BYTES = 147456;
static_assert(L_ATAB + MAXU * 1024 <= LDS_BYTES, "LDS map");

#define GAS __attribute__((address_space(1)))
#define LAS __attribute__((address_space(3)))
typedef unsigned short bf16;
typedef unsigned v4u __attribute__((ext_vector_type(4)));
typedef unsigned v2u __attribute__((ext_vector_type(2)));
typedef float f32x4 __attribute__((ext_vector_type(4)));
typedef float f32x2 __attribute__((ext_vector_type(2)));
#define LDS_WAIT() asm volatile("s_waitcnt lgkmcnt(0)" ::: "memory")
#define VM_WAIT() asm volatile("s_waitcnt vmcnt(0)" ::: "memory")
__device__ __forceinline__ unsigned pk2(float lo, float hi) { return pg8::cvt_pk_bf16(lo, hi); }
__device__ __forceinline__ float bf_lo(unsigned w) { return __uint_as_float(w << 16); }
__device__ __forceinline__ float bf_hi(unsigned w) { return __uint_as_float(w & 0xffff0000u); }


typedef __amdgpu_buffer_rsrc_t rsrc_t;
#define RSRC(p) __builtin_amdgcn_make_buffer_rsrc((void*)(p), 0, 0x7fffffff, 0x00020000)
__device__ __forceinline__ f32x4 bld4f(rsrc_t r, int vo, int so) { return __builtin_bit_cast(f32x4, __builtin_amdgcn_raw_buffer_load_b128(r, vo, so, 0)); }
__device__ __forceinline__ v4u bld4u(rsrc_t r, int vo, int so) { return __builtin_bit_cast(v4u, __builtin_amdgcn_raw_buffer_load_b128(r, vo, so, 0)); }
__device__ __forceinline__ v2u bld2u(rsrc_t r, int vo, int so) { return __builtin_bit_cast(v2u, __builtin_amdgcn_raw_buffer_load_b64(r, vo, so, 0)); }
__device__ __forceinline__ void bst2u(rsrc_t r, int vo, int so, v2u v) { __builtin_amdgcn_raw_buffer_store_b64(v, r, vo, so, 0); }
__device__ __forceinline__ void bst4u(rsrc_t r, int vo, int so, v4u v) { __builtin_amdgcn_raw_buffer_store_b128(v, r, vo, so, 0); }
__device__ __forceinline__ void bst4f(rsrc_t r, int vo, int so, f32x4 v) { __builtin_amdgcn_raw_buffer_store_b128(__builtin_bit_cast(v4u, v), r, vo, so, 0); }

#define XB_TMO      128
#define XB_XCNT(j)  (256  + 64 * (j))
#define XB_XSUB(j)  (1280 + 64 * (j))
#define XB_XGEN(j)  (2304 + 64 * (j))
#define XB_TOP      3328
#define XB_TOPGEN   3392
#define XCD_BAR_WORDS 3456
#define XB_SPIN_CAP (1u << 18)
__device__ __forceinline__ unsigned xb_ld(unsigned* p)              { return __hip_atomic_load(p, __ATOMIC_RELAXED, __HIP_MEMORY_SCOPE_AGENT); }
__device__ __forceinline__ unsigned xb_add(unsigned* p, unsigned v) { return __hip_atomic_fetch_add(p, v, __ATOMIC_RELAXED, __HIP_MEMORY_SCOPE_AGENT); }
__device__ __forceinline__ unsigned xb_xcc_id() { return (unsigned)__builtin_amdgcn_s_getreg((3 << 11) | 20) & 0xFu; }
#define XB_SPIN(cond, bar) do { unsigned _sp = 0; while (cond) { __builtin_amdgcn_s_sleep(1); \
    if ((++_sp & 255u) == 0u) { if (xb_ld(&(bar)[XB_TMO])) break; if (_sp > XB_SPIN_CAP) { atomicAdd(&(bar)[XB_TMO], 1u); break; } } } } while (0)
struct XcdBarrier { unsigned* bar; unsigned x; volatile LAS unsigned* st; };
__device__ __forceinline__ XcdBarrier xcd_barrier_post(unsigned* bar, volatile LAS unsigned* st, int tid) {
    XcdBarrier b; b.bar = bar; b.x = xb_xcc_id(); b.st = st;
    if (tid == 0) (void)xb_add(&bar[XB_XCNT(b.x)], 1u);
    return b;
}
__device__ __forceinline__ void xcd_barrier_complete(unsigned* bar, unsigned x, unsigned& nloc, unsigned& nx) {
    const unsigned G = gridDim.x * gridDim.y * gridDim.z;
    unsigned sum, cnt, mine, sp = 0u;
    for (;;) {
        sum = 0u; cnt = 0u; mine = 0u;
#pragma unroll
        for (unsigned j = 0; j < 16; ++j) { const unsigned c = xb_ld(&bar[XB_XCNT(j)]); sum += c; cnt += (c > 0u) ? 1u : 0u; mine = (j == x) ? c : mine; }
        if (sum == G) break;
        __builtin_amdgcn_s_sleep(1);
        if ((++sp & 255u) == 0u) { if (xb_ld(&bar[XB_TMO])) break; if (sp > XB_SPIN_CAP) { atomicAdd(&bar[XB_TMO], 1u); break; } }
    }
    nloc = mine > 0u ? mine : 1u; nx = cnt > 0u ? cnt : 1u;
}
__device__ __forceinline__ void xcd_barrier(const XcdBarrier& b, int tid) {
    asm volatile("s_waitcnt vmcnt(0)" ::: "memory");
    __syncthreads();
    if (tid == 0) {
        unsigned* bar = b.bar; asm volatile("" : "+s"(bar));
        __builtin_amdgcn_s_waitcnt(0);
        unsigned nloc = b.st[0], nx = b.st[1];
        if (nloc == 0u) { xcd_barrier_complete(bar, b.x, nloc, nx); b.st[0] = nloc; b.st[1] = nx; }
        const unsigned old = xb_add(&bar[XB_XSUB(b.x)], 1u);
        const unsigned gen = old / nloc;
        if (old + 1u == (gen + 1u) * nloc) {
            __builtin_amdgcn_fence(__ATOMIC_RELEASE, "agent");
            asm volatile("s_waitcnt vmcnt(0)" ::: "memory");
            const unsigned og = xb_add(&bar[XB_TOP], 1u);
            const unsigned tg = og / nx;
            if (og + 1u == (tg + 1u) * nx) xb_add(&bar[XB_TOPGEN], 1u);
            else XB_SPIN(xb_ld(&bar[XB_TOPGEN]) == tg, bar);
            __builtin_amdgcn_fence(__ATOMIC_ACQUIRE, "agent");
            xb_add(&bar[XB_XGEN(b.x)], 1u);
            asm volatile("s_waitcnt vmcnt(0)" ::: "memory");
        } else {
            XB_SPIN(xb_ld(&bar[XB_XGEN(b.x)]) == gen, bar);
            __builtin_amdgcn_fence(__ATOMIC_ACQUIRE, "agent");
            asm volatile("s_waitcnt vmcnt(0)" ::: "memory");
        }
    }
    __syncthreads();
}

struct Args {
    const float* in[20]; float* out; unsigned char* ws;
    float invf[32];
    int ph_lo, ph_hi, li, pad;
};
enum { I_X = 0, I_C, I_ADAW, I_ADAB, I_N1G, I_N2G, I_WIN, I_QNG, I_KVNG, I_WUQ, I_WUKV, I_ONA, I_ONB, I_WOUT, I_RW, I_RB, I_EG, I_EU, I_ED, I_FG };

struct Frame {
    LAS unsigned char* lds; unsigned char* ldsg;
    unsigned* ctl; unsigned char* ws;
    int tid, lane, wave, vcu, G;
};
__device__ __forceinline__ int lane_id() { int l; asm volatile("v_mbcnt_lo_u32_b32 %0, -1, 0\n\tv_mbcnt_hi_u32_b32 %0, -1, %0" : "=v"(l)); return l; }
#define DPP_ADD(v, ctrl) v += __int_as_float(__builtin_amdgcn_update_dpp(0, __float_as_int(v), ctrl, 0xF, 0xF, true))
__device__ __forceinline__ float wave_sum(float v) {
    DPP_ADD(v, 0xB1); DPP_ADD(v, 0x4E); DPP_ADD(v, 0x141); DPP_ADD(v, 0x140);
    v += __int_as_float(__builtin_amdgcn_ds_swizzle(__float_as_int(v), 0x401F));
    auto rr = __builtin_amdgcn_permlane32_swap(__float_as_uint(v), __float_as_uint(v), false, false);
    return __uint_as_float(rr[0]) + __uint_as_float(rr[1]);
}
__device__ __forceinline__ int il64(int j) { return j < 32 ? 2 * j : 2 * (j - 32) + 1; }
template <int MODE> __device__ __forceinline__ int dest_row(int n) {
    if constexpr (MODE == 0) return n;
    else if constexpr (MODE == 1) {
        if (n < 512) return C_CQ + n; if (n < 768) return C_CKV + (n - 512); if (n < 832) return C_KR + il64(n - 768);
        if (n < 1856) return C_QB + (n - 832); if (n < 2880) return C_KB + (n - 1856); return C_VB + (n - 2880); }
    else if constexpr (MODE == 2) { const int h = n / 192, j = n % 192; return j < 128 ? n : h * 192 + 128 + il64(j - 128); }
    else if constexpr (MODE == 3) return (n >> 7) * 256 + (n & 127);
    else return (n >> 7) * 256 + 128 + (n & 127);
}
template <int MODE>
__device__ __forceinline__ void transpose_item(const float* W, int ldw, int K, int N, bf16* WT, const float* kscale, LAS float* scr, int item, int lane) {
    const int nblk = N / 32, kb = item / nblk, nb = item % nblk, k0 = 64 * kb, n0 = 32 * nb;
    float tv[32];
#pragma unroll
    for (int i = 0; i < 32; ++i) { const int kk = 2 * i + (lane >> 5); tv[i] = W[(size_t)(k0 + kk) * ldw + n0 + (lane & 31)]; }
#pragma unroll
    for (int i = 0; i < 32; ++i) { const int kk = 2 * i + (lane >> 5); float v = tv[i]; if (kscale) v *= kscale[k0 + kk]; scr[kk * 33 + (lane & 31)] = v; }
    LDS_WAIT(); asm volatile("" ::: "memory");
    const int c = lane & 7;
#pragma unroll
    for (int j = 0; j < 4; ++j) { const int n = (lane >> 3) + 8 * j; const LAS float* s = scr + (8 * c) * 33 + n;
        v4u o; o.x = pk2(s[0 * 33], s[1 * 33]); o.y = pk2(s[2 * 33], s[3 * 33]); o.z = pk2(s[4 * 33], s[5 * 33]); o.w = pk2(s[6 * 33], s[7 * 33]);
        *(v4u*)(WT + (size_t)dest_row<MODE>(n0 + n) * K + k0 + 8 * c) = o; }
    LDS_WAIT(); asm volatile("s_waitcnt vmcnt(0)" ::: "memory");
}

__device__ __forceinline__ unsigned pk4_fp8(float a, float b, float c, float d) { int w = 0; w = __builtin_amdgcn_cvt_pk_fp8_f32(a, b, w, false); w = __builtin_amdgcn_cvt_pk_fp8_f32(c, d, w, true); return (unsigned)w; }
template <int MODE>
__device__ __forceinline__ void transpose_item8(const float* W, int ldw, int K, int N, unsigned char* WT, LAS float* scr, int item, int lane) {
    const int nblk = N / 32, kb = item / nblk, nb = item % nblk, k0 = 64 * kb, n0 = 32 * nb;
    float tv[32];
#pragma unroll
    for (int i = 0; i < 32; ++i) { const int kk = 2 * i + (lane >> 5); tv[i] = W[(size_t)(k0 + kk) * ldw + n0 + (lane & 31)]; }
#pragma unroll
    for (int i = 0; i < 32; ++i) { const int kk = 2 * i + (lane >> 5); scr[kk * 33 + (lane & 31)] = tv[i] * 256.0f; }
    LDS_WAIT(); asm volatile("" ::: "memory");
    const int c = lane & 7;
#pragma unroll
    for (int j = 0; j < 4; ++j) { const int n = (lane >> 3) + 8 * j; const LAS float* s = scr + (8 * c) * 33 + n;
        v2u o; o.x = pk4_fp8(s[0 * 33], s[1 * 33], s[2 * 33], s[3 * 33]); o.y = pk4_fp8(s[4 * 33], s[5 * 33], s[6 * 33], s[7 * 33]);
        *(v2u*)(WT + (size_t)dest_row<MODE>(n0 + n) * K + k0 + 8 * c) = o; }
    LDS_WAIT(); asm volatile("s_waitcnt vmcnt(0)" ::: "memory");
}

__device__ __forceinline__ void phase_prologue(Frame& F, const Args& A) {
#ifdef ADA_FAST
    {
        const float* cc = A.in[I_C]; float* mod = (float*)(F.ws + WS_MOD);
        LAS float* red = (LAS float*)F.lds;
        LAS float* scl = (LAS float*)(F.lds + 32768);
        for (int q = F.tid; q < 4 * DM; q += NWAVES * 64) { const int b = q >> 11, k = q & (DM - 1); const float cv = cc[b * DM + k]; scl[k * 4 + b] = cv / (1.0f + __expf(-cv)); }
        __syncthreads();
        for (int id = F.vcu; id < 2 * 128; id += F.G) {
            const int l = id >> 7, ch = id & 127, cg = F.tid & 31, kg = F.tid >> 5, col = ch * 96 + cg * 4;
            const float* w = A.in[I_ADAW] + (size_t)l * DM * 12288 + col;
            f32x4 acc[4] = {};
            if (cg < 24) {
#pragma unroll 1
                for (int k0 = 0; k0 < 128; k0 += 16) { f32x4 wv[16];
#pragma unroll
                    for (int u = 0; u < 16; ++u) wv[u] = *(const f32x4*)(w + (size_t)(kg * 128 + k0 + u) * 12288);
#pragma unroll
                    for (int u = 0; u < 16; ++u) { const f32x4 ca = *(LAS f32x4*)(scl + (kg * 128 + k0 + u) * 4);
#pragma unroll
                        for (int b = 0; b < 4; ++b) acc[b] += wv[u] * ca[b]; } } }
#pragma unroll
            for (int b = 0; b < 4; ++b) *(LAS f32x4*)(red + ((kg * 32 + cg) * 16 + b * 4)) = acc[b];
            __syncthreads();
            if (F.tid < 128 && (F.tid & 31) < 24) { const int cg2 = F.tid & 31, b = F.tid >> 5; f32x4 s = {0.f, 0.f, 0.f, 0.f};
#pragma unroll
                for (int g = 0; g < 16; ++g) s += *(LAS f32x4*)(red + ((g * 32 + cg2) * 16 + b * 4));
                const int c2 = ch * 96 + cg2 * 4; const f32x4 bv = *(const f32x4*)(A.in[I_ADAB] + (size_t)l * 12288 + c2);
                *(f32x4*)(mod + ((size_t)l * 4 + b) * 12288 + c2) = s + bv; }
            asm volatile("s_waitcnt vmcnt(0)" ::: "memory");
            __syncthreads();
        }
    }
#else
    {
        const float* cc = A.in[I_C]; float* mod = (float*)(F.ws + WS_MOD);
        LAS float* red = (LAS float*)F.lds;
        for (int id = F.vcu; id < 2 * 96; id += F.G) {
            const int l = id / 96, ch = id % 96, cg = F.tid & 31, kg = F.tid >> 5, col = ch * 128 + cg * 4;
            const float* w = A.in[I_ADAW] + (size_t)l * DM * 12288 + col;
            f32x4 acc[4] = {};
#pragma unroll 4
            for (int kk = 0; kk < 128; ++kk) { const int k = kg * 128 + kk; const f32x4 wv = *(const f32x4*)(w + (size_t)k * 12288);
#pragma unroll
                for (int b = 0; b < 4; ++b) { const float cv = cc[b * DM + k]; const float ca = cv / (1.0f + __expf(-cv)); acc[b] += wv * ca; } }
#pragma unroll
            for (int b = 0; b < 4; ++b) *(LAS f32x4*)(red + ((kg * 32 + cg) * 16 + b * 4)) = acc[b];
            __syncthreads();
            if (F.tid < 128) { const int cg2 = F.tid & 31, b = F.tid >> 5; f32x4 s = {0.f, 0.f, 0.f, 0.f};
#pragma unroll
                for (int g = 0; g < 16; ++g) s += *(LAS f32x4*)(red + ((g * 32 + cg2) * 16 + b * 4));
                const int c2 = ch * 128 + cg2 * 4; const f32x4 bv = *(const f32x4*)(A.in[I_ADAB] + (size_t)l * 12288 + c2);
                *(f32x4*)(mod + ((size_t)l * 4 + b) * 12288 + c2) = s + bv; }
            asm volatile("s_waitcnt vmcnt(0)" ::: "memory");
            __syncthreads();
        }
    }
#endif
    {
        LAS float* scr = (LAS float*)(F.lds + F.wave * 16384);
        const int gw = F.vcu * NWAVES + F.wave, NGW = F.G * NWAVES;
        constexpr int I_IN = (DM / 64) * (IN_COLS / 32), I_UQ = (512 / 64) * (1536 / 32), I_UKV = (256 / 64) * (2048 / 32), I_OUT = (DM / 64) * (DM / 32), I_L = I_IN + I_UQ + I_UKV + I_OUT;
        for (int it = gw; it < 2 * I_L; it += NGW) {
            const int l = it / I_L; int r = it % I_L;
            if (r < I_IN) { transpose_item<1>(A.in[I_WIN] + (size_t)l * DM * IN_COLS, IN_COLS, DM, IN_COLS, (bf16*)(F.ws + WS_WIN) + (size_t)l * 4096 * DM, nullptr, scr, r, F.lane); continue; } r -= I_IN;
            if (r < I_UQ) { transpose_item<2>(A.in[I_WUQ] + (size_t)l * 512 * 1536, 1536, 512, 1536, (bf16*)(F.ws + WS_WUQ) + (size_t)l * 1536 * 512, A.in[I_QNG] + l * 512, scr, r, F.lane); continue; } r -= I_UQ;
            if (r < I_UKV) { transpose_item<0>(A.in[I_WUKV] + (size_t)l * 256 * 2048, 2048, 256, 2048, (bf16*)(F.ws + WS_WUKV) + (size_t)l * 2048 * 256, A.in[I_KVNG] + l * 256, scr, r, F.lane); continue; } r -= I_UKV;
#ifdef G3_FP8
            transpose_item8<0>(A.in[I_WOUT] + (size_t)l * DM * DM, DM, DM, DM, F.ws + WS_WOUT + (size_t)l * DM * DM, scr, r, F.lane);
#else
            transpose_item<0>(A.in[I_WOUT] + (size_t)l * DM * DM, DM, DM, DM, (bf16*)(F.ws + WS_WOUT) + (size_t)l * DM * DM, nullptr, scr, r, F.lane);
#endif
        }
    }
    {
        const int gt = F.vcu * (NWAVES * 64) + F.tid, NGT = F.G * NWAVES * 64;
        float* rope = (float*)(F.ws + WS_ROPE);
        for (int e = gt; e < SEQ * 32; e += NGT) { const int pos = e >> 5, i = e & 31;
            const float ang = (float)pos * A.invf[i];
            const double rev = (double)ang * 0.15915494309189535; const float fr = (float)(rev - __builtin_floor(rev));
            *(f32x2*)(rope + (size_t)e * 2) = (f32x2){__builtin_amdgcn_cosf(fr), __builtin_amdgcn_sinf(fr)}; }
        for (int e = gt; e < 2 * 192 * (DM / 8); e += NGT) { const int l = e / (192 * (DM / 8)), r = e % (192 * (DM / 8));
            *(v4u*)((bf16*)(F.ws + WS_WIN) + ((size_t)l * 4096 + IN_COLS) * DM + (size_t)r * 8) = (v4u){0u, 0u, 0u, 0u}; }
    }
}

__device__ __forceinline__ void phase_norm1(Frame& F, const Args& A, int l) {
    const int gw = F.vcu * NWAVES + F.wave, NGW = F.G * NWAVES;
    const float* mod = (const float*)(F.ws + WS_MOD);
    bf16* H = (bf16*)(F.ws + WS_H); const bf16* Y = (const bf16*)(F.ws + WS_Y);
#ifdef THIN_MLP
    for (int ch = gw; ch < T / 16; ch += NGW) {
        const int row0 = ch * 16, b = row0 >> 13;
        const float* ml = mod + ((size_t)l * 4 + b) * 12288;
#pragma unroll 1
        for (int rr = 0; rr < 16; rr += 2) {
            f32x4 v[2][8];
            if (l == 0) {
#pragma unroll
                for (int q = 0; q < 2; ++q)
#pragma unroll
                    for (int j = 0; j < 8; ++j) v[q][j] = *(const f32x4*)(A.in[I_X] + (size_t)(row0 + rr + q) * DM + 4 * F.lane + 256 * j);
            } else {
                bf16* XB = (bf16*)(F.ws + WS_XB);
                v2u xw[2][8], ya[2][8], yb[2][8]; f32x4 g2p[8];
#pragma unroll
                for (int q = 0; q < 2; ++q)
#pragma unroll
                    for (int j = 0; j < 8; ++j) { const int c = 4 * F.lane + 256 * j; const int row = row0 + rr + q;
                        xw[q][j] = *(const v2u*)(XB + (size_t)row * DM + c); ya[q][j] = *(const v2u*)(Y + (size_t)(2 * row) * DM + c); yb[q][j] = *(const v2u*)(Y + (size_t)(2 * row + 1) * DM + c); }
#pragma unroll
                for (int j = 0; j < 8; ++j) g2p[j] = *(const f32x4*)(mod + ((size_t)(l - 1) * 4 + b) * 12288 + 5 * DM + 4 * F.lane + 256 * j);
#pragma unroll
                for (int q = 0; q < 2; ++q)
#pragma unroll
                    for (int j = 0; j < 8; ++j) { const int c = 4 * F.lane + 256 * j; const int row = row0 + rr + q;
                        const f32x4 xr = {bf_lo(xw[q][j].x), bf_hi(xw[q][j].x), bf_lo(xw[q][j].y), bf_hi(xw[q][j].y)};
                        const v2u y0 = ya[q][j], y1 = yb[q][j];
                        const f32x4 ys = {bf_lo(y0.x) + bf_lo(y1.x), bf_hi(y0.x) + bf_hi(y1.x), bf_lo(y0.y) + bf_lo(y1.y), bf_hi(y0.y) + bf_hi(y1.y)};
                        const f32x4 t = xr + g2p[j] * ys;
                        const v2u ow = {pk2(t.x, t.y), pk2(t.z, t.w)}; *(v2u*)(XB + (size_t)row * DM + c) = ow;
                        v[q][j] = (f32x4){bf_lo(ow.x), bf_hi(ow.x), bf_lo(ow.y), bf_hi(ow.y)}; }
            }
            float rstd[2];
#pragma unroll
            for (int q = 0; q < 2; ++q) { float s = 0.f;
#pragma unroll
                for (int j = 0; j < 8; ++j) s += (v[q][j].x * v[q][j].x + v[q][j].y * v[q][j].y) + (v[q][j].z * v[q][j].z + v[q][j].w * v[q][j].w);
                rstd[q] = __builtin_amdgcn_rsqf(wave_sum(s) * (1.f / DM) + EPS); }
#pragma unroll
            for (int j = 0; j < 8; ++j) { const int c = 4 * F.lane + 256 * j;
                const f32x4 gsc = *(const f32x4*)(A.in[I_N1G] + l * DM + c) * (*(const f32x4*)(ml + 1 * DM + c) + 1.0f), sh = *(const f32x4*)(ml + 0 * DM + c);
#pragma unroll
                for (int q = 0; q < 2; ++q) { const f32x4 o = v[q][j] * rstd[q] * gsc + sh;
                    *(v2u*)(H + (size_t)(row0 + rr + q) * DM + c) = (v2u){pk2(o.x, o.y), pk2(o.z, o.w)}; } }
        }
    }
#else
    for (int ch = gw; ch < T / 16; ch += NGW) {
        const int row0 = ch * 16, b = row0 >> 13;
        const float* ml = mod + ((size_t)l * 4 + b) * 12288;
        f32x4 gsc[8], sh[8], g2p[8];
#pragma unroll
        for (int j = 0; j < 8; ++j) { const int c = 4 * F.lane + 256 * j; const f32x4 g = *(const f32x4*)(A.in[I_N1G] + l * DM + c), sc = *(const f32x4*)(ml + 1 * DM + c);
            gsc[j] = g * (sc + 1.0f); sh[j] = *(const f32x4*)(ml + 0 * DM + c);
            if (l > 0) g2p[j] = *(const f32x4*)(mod + ((size_t)(l - 1) * 4 + b) * 12288 + 5 * DM + c); }
#pragma unroll 1
        for (int rr = 0; rr < 16; ++rr) {
            const int row = row0 + rr; f32x4 v[8]; float s = 0.f;
            if (l == 0) {
#pragma unroll
                for (int j = 0; j < 8; ++j) v[j] = *(const f32x4*)(A.in[I_X] + (size_t)row * DM + 4 * F.lane + 256 * j);
            } else {
#pragma unroll
                for (int j = 0; j < 8; ++j) { const int c = 4 * F.lane + 256 * j;
#ifdef XRES_BF16
                    bf16* XB = (bf16*)(F.ws + WS_XB); const v2u xw = *(const v2u*)(XB + (size_t)row * DM + c); const f32x4 xr = {bf_lo(xw.x), bf_hi(xw.x), bf_lo(xw.y), bf_hi(xw.y)};
#else
                    const f32x4 xr = *(const f32x4*)(A.out + (size_t)row * DM + c);
#endif
                    const v2u y0 = *(const v2u*)(Y + (size_t)(2 * row) * DM + c), y1 = *(const v2u*)(Y + (size_t)(2 * row + 1) * DM + c);
                    const f32x4 ys = {bf_lo(y0.x) + bf_lo(y1.x), bf_hi(y0.x) + bf_hi(y1.x), bf_lo(y0.y) + bf_lo(y1.y), bf_hi(y0.y) + bf_hi(y1.y)};
                    v[j] = xr + g2p[j] * ys;
#ifdef XRES_BF16
                    { const v2u ow = {pk2(v[j].x, v[j].y), pk2(v[j].z, v[j].w)}; *(v2u*)(XB + (size_t)row * DM + c) = ow;
                      v[j] = (f32x4){bf_lo(ow.x), bf_hi(ow.x), bf_lo(ow.y), bf_hi(ow.y)}; }
#else
                    *(f32x4*)(A.out + (size_t)row * DM + c) = v[j];
#endif
                }
            }
#pragma unroll
            for (int j = 0; j < 8; ++j) s += (v[j].x * v[j].x + v[j].y * v[j].y) + (v[j].z * v[j].z + v[j].w * v[j].w);
            const float rstd = __builtin_amdgcn_rsqf(wave_sum(s) * (1.f / DM) + EPS);
#pragma unroll
            for (int j = 0; j < 8; ++j) { const f32x4 o = v[j] * rstd * gsc[j] + sh[j];
                *(v2u*)(H + (size_t)row * DM + 4 * F.lane + 256 * j) = (v2u){pk2(o.x, o.y), pk2(o.z, o.w)}; }
        }
    }
#endif
#ifndef ATT_CONV
    {
        LAS float* scr = (LAS float*)(F.lds + F.wave * 16384);
        constexpr int I_G = (DM / 64) * (DEXP / 32), I_D = (DEXP / 64) * (DM / 32), I_E = 2 * I_G + I_D;
        for (int it = gw; it < NEXP * I_E; it += NGW) {
            const int e = it / I_E; int r = it % I_E; const size_t eo = ((size_t)l * NEXP + e) * DM * DEXP;
            if (r < I_G) { transpose_item8<3>(A.in[I_EG] + eo, DEXP, DM, DEXP, F.ws + WS_W13 + (size_t)e * 2048 * DM, scr, r, F.lane); continue; } r -= I_G;
            if (r < I_G) { transpose_item8<4>(A.in[I_EU] + eo, DEXP, DM, DEXP, F.ws + WS_W13 + (size_t)e * 2048 * DM, scr, r, F.lane); continue; } r -= I_G;
            transpose_item8<0>(A.in[I_ED] + eo, DM, DEXP, DM, F.ws + WS_W2 + (size_t)e * DM * DEXP, scr, r, F.lane);
        }
    }
#endif
}
__device__ __forceinline__ void phase_final(Frame& F, const Args& A, int probe) {
    const int gw = F.vcu * NWAVES + F.wave, NGW = F.G * NWAVES;
    const float* mod = (const float*)(F.ws + WS_MOD); const bf16* Y = (const bf16*)(F.ws + WS_Y);
    for (int ch = gw; ch < T / 16; ch += NGW) {
        const int row0 = ch * 16, b = row0 >> 13;
#if defined(THIN_MLP) && defined(XRES_BF16)
#pragma unroll 1
        for (int rr = 0; rr < 16; rr += 2) {
            v2u xw[2][8], ya[2][8], yb[2][8]; f32x4 g2p[8]; f32x4 v[2][8];
#pragma unroll
            for (int q = 0; q < 2; ++q)
#pragma unroll
                for (int j = 0; j < 8; ++j) { const int c = 4 * F.lane + 256 * j; const int row = row0 + rr + q;
                    xw[q][j] = *(const v2u*)((const bf16*)(F.ws + WS_XB) + (size_t)row * DM + c); ya[q][j] = *(const v2u*)(Y + (size_t)(2 * row) * DM + c); yb[q][j] = *(const v2u*)(Y + (size_t)(2 * row + 1) * DM + c); }
#pragma unroll
            for (int j = 0; j < 8; ++j) g2p[j] = *(const f32x4*)(mod + ((size_t)(probe == 3 ? 0 : DEPTH - 1) * 4 + b) * 12288 + 5 * DM + 4 * F.lane + 256 * j);
            float rstd[2];
#pragma unroll
            for (int q = 0; q < 2; ++q) { float s = 0.f;
#pragma unroll
                for (int j = 0; j < 8; ++j) { const f32x4 xr = {bf_lo(xw[q][j].x), bf_hi(xw[q][j].x), bf_lo(xw[q][j].y), bf_hi(xw[q][j].y)};
                    const v2u y0 = ya[q][j], y1 = yb[q][j];
                    const f32x4 ys = {bf_lo(y0.x) + bf_lo(y1.x), bf_hi(y0.x) + bf_hi(y1.x), bf_lo(y0.y) + bf_lo(y1.y), bf_hi(y0.y) + bf_hi(y1.y)};
                    v[q][j] = (probe == 1 || probe == 2) ? xr : xr + g2p[j] * ys; }
#pragma unroll
                for (int j = 0; j < 8; ++j) s += (v[q][j].x * v[q][j].x + v[q][j].y * v[q][j].y) + (v[q][j].z * v[q][j].z + v[q][j].w * v[q][j].w);
                rstd[q] = __builtin_amdgcn_rsqf(wave_sum(s) * (1.f / DM) + EPS); }
#pragma unroll
            for (int j = 0; j < 8; ++j) { const int c = 4 * F.lane + 256 * j; const f32x4 fg = *(const f32x4*)(A.in[I_FG] + c);
#pragma unroll
                for (int q = 0; q < 2; ++q) *(f32x4*)(A.out + (size_t)(row0 + rr + q) * DM + c) = v[q][j] * rstd[q] * fg; }
        }
#else
        f32x4 fg[8], g2p[8];
#pragma unroll
        for (int j = 0; j < 8; ++j) { const int c = 4 * F.lane + 256 * j; fg[j] = *(const f32x4*)(A.in[I_FG] + c); g2p[j] = *(const f32x4*)(mod + ((size_t)(probe == 3 ? 0 : DEPTH - 1) * 4 + b) * 12288 + 5 * DM + c); }
#pragma unroll 1
        for (int rr = 0; rr < 16; ++rr) {
            const int row = row0 + rr; f32x4 v[8]; float s = 0.f;
#pragma unroll
            for (int j = 0; j < 8; ++j) { const int c = 4 * F.lane + 256 * j;
#ifdef XRES_BF16
                const v2u xw = *(const v2u*)((const bf16*)(F.ws + WS_XB) + (size_t)row * DM + c); const f32x4 xr = {bf_lo(xw.x), bf_hi(xw.x), bf_lo(xw.y), bf_hi(xw.y)};
#else
                const f32x4 xr = *(const f32x4*)((probe == 2 ? A.in[I_X] : A.out) + (size_t)row * DM + c);
#endif
                const v2u y0 = *(const v2u*)(Y + (size_t)(2 * row) * DM + c), y1 = *(const v2u*)(Y + (size_t)(2 * row + 1) * DM + c);
                const f32x4 ys = {bf_lo(y0.x) + bf_lo(y1.x), bf_hi(y0.x) + bf_hi(y1.x), bf_lo(y0.y) + bf_lo(y1.y), bf_hi(y0.y) + bf_hi(y1.y)};
                v[j] = (probe == 1 || probe == 2) ? xr : xr + g2p[j] * ys; }
#pragma unroll
            for (int j = 0; j < 8; ++j) s += (v[j].x * v[j].x + v[j].y * v[j].y) + (v[j].z * v[j].z + v[j].w * v[j].w);
            const float rstd = __builtin_amdgcn_rsqf(wave_sum(s) * (1.f / DM) + EPS);
#pragma unroll
            for (int j = 0; j < 8; ++j) *(f32x4*)(A.out + (size_t)row * DM + 4 * F.lane + 256 * j) = v[j] * rstd * fg[j];
        }
#endif
    }
}
#ifndef PROBE_DUMP_SCALE
#define PROBE_DUMP_SCALE 1.0f
#endif
#ifndef PROBE_DUMP_W
#define PROBE_DUMP_W 2048
#endif
__device__ __forceinline__ void phase_dump(Frame& F, const Args& A, size_t off, int pitch) {
    const int gw = F.vcu * NWAVES + F.wave, NGW = F.G * NWAVES;
    for (int row = gw; row < T; row += NGW) { const bf16* src = (const bf16*)(F.ws + off) + (size_t)row * pitch;
#ifdef PROBE_DUMP_F32
        for (int j = 0; j < 8; ++j) { const int c = 4 * F.lane + 256 * j; const float* sf = (const float*)(F.ws + off) + (size_t)row * pitch + c;
#ifdef PROBE_DUMP_SRC_OUT
            sf = A.out + (size_t)row * DM + c;
#endif
            f32x4 o = {0.f, 0.f, 0.f, 0.f}; if (c < PROBE_DUMP_W) o = *(const f32x4*)sf * PROBE_DUMP_SCALE;
#ifdef PROBE_DUMP_LOWBITS
            { const v4u ub = __builtin_bit_cast(v4u, o); o = (f32x4){(float)(ub.x & 0xFFFu), (float)(ub.y & 0xFFFu), (float)(ub.z & 0xFFFu), (float)(ub.w & 0xFFFu)}; }
#endif
            *(f32x4*)(A.out + (size_t)row * DM + c) = o; }
        continue;
#endif
        for (int j = 0; j < 8; ++j) { const int c = 4 * F.lane + 256 * j; const v2u w = *(const v2u*)(src + c);
#ifdef PROBE_DUMP_LOWBITS
            *(f32x4*)(A.out + (size_t)row * DM + c) = c < PROBE_DUMP_W ? (f32x4){(float)(w.x & 0x7Fu), (float)((w.x >> 16) & 0x7Fu), (float)(w.y & 0x7Fu), (float)((w.y >> 16) & 0x7Fu)} : (f32x4){0.f, 0.f, 0.f, 0.f}; } }
#else
            *(f32x4*)(A.out + (size_t)row * DM + c) = c < PROBE_DUMP_W ? (f32x4){bf_lo(w.x), bf_hi(w.x), bf_lo(w.y), bf_hi(w.y)} : (f32x4){0.f, 0.f, 0.f, 0.f}; } }
#endif
}
__device__ __forceinline__ void phase_mla_prep(Frame& F, const Args& A) {
    const int gw = F.vcu * NWAVES + F.wave, NGW = F.G * NWAVES;
    const bf16* P = (const bf16*)(F.ws + WS_PROJ); bf16* KF = (bf16*)(F.ws + WS_KF);
    float* rq = (float*)(F.ws + WS_RSTDQ); float* rkv = (float*)(F.ws + WS_RSTDKV); const float* rope = (const float*)(F.ws + WS_ROPE);
    for (int ch = gw; ch < T / 16; ch += NGW) {
#pragma unroll 1
        for (int r4 = 0; r4 < 16; r4 += 4) {
            v4u q[4]; v2u kv[4]; unsigned kr[4]; f32x2 cs[4];
#pragma unroll
            for (int u = 0; u < 4; ++u) { const int row = ch * 16 + r4 + u; const bf16* pr = P + (size_t)row * PROJ_LD;
                q[u] = *(const v4u*)(pr + C_CQ + 8 * F.lane); kv[u] = *(const v2u*)(pr + C_CKV + 4 * F.lane);
                kr[u] = *(const unsigned*)(pr + C_KR + 2 * (F.lane & 31)); cs[u] = *(const f32x2*)(rope + ((size_t)(row & (SEQ - 1)) * 32 + (F.lane & 31)) * 2); }
#pragma unroll
            for (int u = 0; u < 4; ++u) { const int row = ch * 16 + r4 + u;
                float sq = 0.f, skv = 0.f;
#pragma unroll
                for (int i = 0; i < 4; ++i) { const float a = bf_lo(q[u][i]), b2 = bf_hi(q[u][i]); sq += a * a + b2 * b2; }
#pragma unroll
                for (int i = 0; i < 2; ++i) { const float a = bf_lo(kv[u][i]), b2 = bf_hi(kv[u][i]); skv += a * a + b2 * b2; }
                sq = wave_sum(sq); skv = wave_sum(skv);
                if (F.lane == 0) { rq[row] = __builtin_amdgcn_rsqf(sq * (1.f / 512.f) + EPS); rkv[row] = __builtin_amdgcn_rsqf(skv * (1.f / 256.f) + EPS); }
                if (F.lane < 32) { const float x1 = bf_lo(kr[u]), x2 = bf_hi(kr[u]);
                    const unsigned o = pk2(x1 * cs[u].x - x2 * cs[u].y, x2 * cs[u].x + x1 * cs[u].y);
#pragma unroll
                    for (int h = 0; h < 8; ++h) *(unsigned*)(KF + (size_t)row * 1536 + h * 192 + 128 + 2 * F.lane) = o; } }
        }
    }
}
__device__ __forceinline__ void phase_q_rope(Frame& F, const Args& A) {
    const int gw = F.vcu * NWAVES + F.wave, NGW = F.G * NWAVES;
    bf16* QA = (bf16*)(F.ws + WS_QA); const float* rope = (const float*)(F.ws + WS_ROPE);
    for (int ch = gw; ch < T / 16; ch += NGW) {
#pragma unroll 1
        for (int r4 = 0; r4 < 16; r4 += 4) {
            v4u w[4]; f32x4 c01[4], c23[4];
#pragma unroll
            for (int u = 0; u < 4; ++u) { const int row = ch * 16 + r4 + u;
                w[u] = *(const v4u*)(QA + (size_t)row * 1536 + (F.lane >> 3) * 192 + 128 + (F.lane & 7) * 8);
                const f32x4* cs = (const f32x4*)(rope + ((size_t)(row & (SEQ - 1)) * 32 + (F.lane & 7) * 4) * 2); c01[u] = cs[0]; c23[u] = cs[1]; }
#pragma unroll
            for (int u = 0; u < 4; ++u) { const int row = ch * 16 + r4 + u; v4u o;
                { const float x1 = bf_lo(w[u].x), x2 = bf_hi(w[u].x); o.x = pk2(x1 * c01[u][0] - x2 * c01[u][1], x2 * c01[u][0] + x1 * c01[u][1]); }
                { const float x1 = bf_lo(w[u].y), x2 = bf_hi(w[u].y); o.y = pk2(x1 * c01[u][2] - x2 * c01[u][3], x2 * c01[u][2] + x1 * c01[u][3]); }
                { const float x1 = bf_lo(w[u].z), x2 = bf_hi(w[u].z); o.z = pk2(x1 * c23[u][0] - x2 * c23[u][1], x2 * c23[u][0] + x1 * c23[u][1]); }
                { const float x1 = bf_lo(w[u].w), x2 = bf_hi(w[u].w); o.w = pk2(x1 * c23[u][2] - x2 * c23[u][3], x2 * c23[u][2] + x1 * c23[u][3]); }
                *(v4u*)(QA + (size_t)row * 1536 + (F.lane >> 3) * 192 + 128 + (F.lane & 7) * 8) = o; }
        }
    }
}
#ifndef THIN_RO
#define THIN_RO 2
#endif
__device__ __forceinline__ void phase_out_norm(Frame& F, const Args& A, int l) {
    const int gw = F.vcu * NWAVES + F.wave, NGW = F.G * NWAVES;
    const bf16* OA = (const bf16*)(F.ws + WS_OA); const bf16* OB = (const bf16*)(F.ws + WS_OB); const float* LSE = (const float*)(F.ws + WS_LSE); bf16* Yn = (bf16*)(F.ws + WS_H);
    for (int ch = gw; ch < T / 16; ch += NGW) {
        float ga[2][8], gb[2][8];
#pragma unroll
        for (int hf = 0; hf < 2; ++hf)
#pragma unroll
            for (int i = 0; i < 8; ++i) { ga[hf][i] = A.in[I_ONA][l * 1024 + hf * 512 + 8 * F.lane + i]; gb[hf][i] = A.in[I_ONB][l * 1024 + hf * 512 + 8 * F.lane + i]; }
#ifdef THIN_MLP
#pragma unroll 1
        for (int rr = 0; rr < 16; rr += THIN_RO) {
            v4u ra_[THIN_RO][2], ro_[THIN_RO][2][3]; float ls_[THIN_RO][2][3];
#pragma unroll
            for (int q = 0; q < THIN_RO; ++q)
#pragma unroll
                for (int hf = 0; hf < 2; ++hf) { const int row = ch * 16 + rr + q, c = hf * 512 + 8 * F.lane, hd = c >> 7;
                    ra_[q][hf] = *(const v4u*)(OA + (size_t)row * 1024 + c);
#pragma unroll
                    for (int n = 0; n < 3; ++n) { ro_[q][hf][n] = *(const v4u*)(OB + ((size_t)n * T + row) * 1024 + c); ls_[q][hf][n] = LSE[((size_t)n * T + row) * 8 + hd]; } }
#pragma unroll
            for (int q = 0; q < THIN_RO; ++q) {
                const int row = ch * 16 + rr + q;
                float va[2][8], vb[2][8]; float sa = 0.f, sb = 0.f;
#pragma unroll
                for (int hf = 0; hf < 2; ++hf) {
                    const v4u a = ra_[q][hf];
#pragma unroll
                    for (int i = 0; i < 4; ++i) { va[hf][2 * i] = bf_lo(a[i]); va[hf][2 * i + 1] = bf_hi(a[i]); }
                    const float l0 = ls_[q][hf][0], l1 = ls_[q][hf][1], l2 = ls_[q][hf][2];
                    const float mx = fmaxf(l0, fmaxf(l1, l2)); const float e0 = __expf(l0 - mx), e1 = __expf(l1 - mx), e2 = __expf(l2 - mx); const float inv = 1.0f / (e0 + e1 + e2);
                    const float al[3] = {e0 * inv, e1 * inv, e2 * inv};
#pragma unroll
                    for (int i = 0; i < 8; ++i) vb[hf][i] = 0.f;
#pragma unroll
                    for (int n = 0; n < 3; ++n) { const v4u o = ro_[q][hf][n];
#pragma unroll
                        for (int i = 0; i < 4; ++i) { vb[hf][2 * i] += al[n] * bf_lo(o[i]); vb[hf][2 * i + 1] += al[n] * bf_hi(o[i]); } }
#pragma unroll
                    for (int i = 0; i < 8; ++i) { sa += va[hf][i] * va[hf][i]; sb += vb[hf][i] * vb[hf][i]; }
                }
                const float ra = __builtin_amdgcn_rsqf(wave_sum(sa) * (1.f / 1024.f) + EPS), rb = __builtin_amdgcn_rsqf(wave_sum(sb) * (1.f / 1024.f) + EPS);
#pragma unroll
                for (int hf = 0; hf < 2; ++hf) { const int c = hf * 512 + 8 * F.lane;
#ifdef G3_FP8
                    { unsigned char* Y8 = (unsigned char*)Yn; float ya[8], yb[8];
#pragma unroll
                      for (int i = 0; i < 8; ++i) { ya[i] = va[hf][i] * ra * ga[hf][i]; yb[i] = vb[hf][i] * rb * gb[hf][i]; }
                      *(v2u*)(Y8 + (size_t)row * DM + c) = (v2u){pk4_fp8(ya[0], ya[1], ya[2], ya[3]), pk4_fp8(ya[4], ya[5], ya[6], ya[7])};
                      *(v2u*)(Y8 + (size_t)row * DM + 1024 + c) = (v2u){pk4_fp8(yb[0], yb[1], yb[2], yb[3]), pk4_fp8(yb[4], yb[5], yb[6], yb[7])}; }
#else
                    { v4u wa, wb;
#pragma unroll
                      for (int i = 0; i < 4; ++i) { wa[i] = pk2(va[hf][2 * i] * ra * ga[hf][2 * i], va[hf][2 * i + 1] * ra * ga[hf][2 * i + 1]); wb[i] = pk2(vb[hf][2 * i] * rb * gb[hf][2 * i], vb[hf][2 * i + 1] * rb * gb[hf][2 * i + 1]); }
                      *(v4u*)(Yn + (size_t)row * DM + c) = wa; *(v4u*)(Yn + (size_t)row * DM + 1024 + c) = wb; }
#endif
                }
            }
        }
#else
#pragma unroll 1
        for (int rr = 0; rr < 16; ++rr) {
            const int row = ch * 16 + rr;
            float va[2][8], vb[2][8]; float sa = 0.f, sb = 0.f;
#pragma unroll
            for (int hf = 0; hf < 2; ++hf) {
                const int c = hf * 512 + 8 * F.lane, hd = c >> 7;
                const v4u a = *(const v4u*)(OA + (size_t)row * 1024 + c);
#pragma unroll
                for (int i = 0; i < 4; ++i) { va[hf][2 * i] = bf_lo(a[i]); va[hf][2 * i + 1] = bf_hi(a[i]); }
                const float l0 = LSE[((size_t)0 * T + row) * 8 + hd], l1 = LSE[((size_t)1 * T + row) * 8 + hd], l2 = LSE[((size_t)2 * T + row) * 8 + hd];
                const float mx = fmaxf(l0, fmaxf(l1, l2)); const float e0 = __expf(l0 - mx), e1 = __expf(l1 - mx), e2 = __expf(l2 - mx); const float inv = 1.0f / (e0 + e1 + e2);
                const float al[3] = {e0 * inv, e1 * inv, e2 * inv};
#pragma unroll
                for (int i = 0; i < 8; ++i) vb[hf][i] = 0.f;
#pragma unroll
                for (int n = 0; n < 3; ++n) { const v4u o = *(const v4u*)(OB + ((size_t)n * T + row) * 1024 + c);
#pragma unroll
                    for (int i = 0; i < 4; ++i) { vb[hf][2 * i] += al[n] * bf_lo(o[i]); vb[hf][2 * i + 1] += al[n] * bf_hi(o[i]); } }
#pragma unroll
                for (int i = 0; i < 8; ++i) { sa += va[hf][i] * va[hf][i]; sb += vb[hf][i] * vb[hf][i]; }
            }
            const float ra = __builtin_amdgcn_rsqf(wave_sum(sa) * (1.f / 1024.f) + EPS), rb = __builtin_amdgcn_rsqf(wave_sum(sb) * (1.f / 1024.f) + EPS);
#pragma unroll
            for (int hf = 0; hf < 2; ++hf) { const int c = hf * 512 + 8 * F.lane; v4u wa, wb;
#pragma unroll
                for (int i = 0; i < 4; ++i) { wa[i] = pk2(va[hf][2 * i] * ra * ga[hf][2 * i], va[hf][2 * i + 1] * ra * ga[hf][2 * i + 1]); wb[i] = pk2(vb[hf][2 * i] * rb * gb[hf][2 * i], vb[hf][2 * i + 1] * rb * gb[hf][2 * i + 1]); }
#ifdef G3_FP8
                { unsigned char* Y8 = (unsigned char*)Yn; float ya[8], yb[8];
#pragma unroll
                  for (int i = 0; i < 8; ++i) { ya[i] = va[hf][i] * ra * ga[hf][i]; yb[i] = vb[hf][i] * rb * gb[hf][i]; }
                  *(v2u*)(Y8 + (size_t)row * DM + c) = (v2u){pk4_fp8(ya[0], ya[1], ya[2], ya[3]), pk4_fp8(ya[4], ya[5], ya[6], ya[7])};
                  *(v2u*)(Y8 + (size_t)row * DM + 1024 + c) = (v2u){pk4_fp8(yb[0], yb[1], yb[2], yb[3]), pk4_fp8(yb[4], yb[5], yb[6], yb[7])}; }
#else
                *(v4u*)(Yn + (size_t)row * DM + c) = wa; *(v4u*)(Yn + (size_t)row * DM + 1024 + c) = wb;
#endif
            }
        }
#endif
    }
}
#ifndef ROUTER_SRC
#define ROUTER_SRC A.out
#endif
#ifdef ROUTER_MFMA
typedef short r_bf16x8 __attribute__((ext_vector_type(8)));
#ifndef RPA
#define RPA 2
#endif
__device__ __forceinline__ void phase_router(Frame& F, const Args& A, int l, int dummy = 0) {
    const float* mod = (const float*)(F.ws + WS_MOD);
    bf16* H = (bf16*)(F.ws + WS_H);
    LAS int* lcnt = (LAS int*)(F.lds + L_CNT); LAS int* gbase = lcnt + 16; LAS int* tokinfo = (LAS int*)(F.lds + L_TOK);
    LAS float* lgs = (LAS float*)(F.lds + L_ATAB);
    LAS float* rsl = (LAS float*)(F.lds + L_ATAB + 8704);
    LAS float* wsm = (LAS float*)(F.lds + L_ATAB + 8704 + 512);
    LAS float* cstl = (LAS float*)(F.lds + L_ATAB + 8704 + 1024);
    unsigned* gcnt = F.ctl + CW_CNT + (dummy ? 3 : l) * 16;
    int* rowidx = (int*)(F.ws + (dummy ? WS_OB : WS_ROWIDX)); float* aw = (float*)(F.ws + (dummy ? WS_OB + 4 * MiB : WS_AW));
    float rb[16];
#pragma unroll
    for (int e = 0; e < 16; ++e) rb[e] = __uint_as_float(__builtin_amdgcn_readfirstlane(__float_as_uint(A.in[I_RB][e])));
    for (int bi = F.vcu; bi < T / 128; bi += F.G) {
        const int row0 = bi * 128 + F.wave * 16, b = row0 >> 13;
        const rsrc_t rml = RSRC(mod + ((size_t)l * 4 + b) * 12288), rgn = RSRC(A.in[I_N2G] + l * DM), rh = RSRC(H), rxb = RSRC(F.ws + WS_XB), rrw = RSRC(A.in[I_RW]);
        __syncthreads();
        { const int t0_ = F.wave * 64 + lane_id(); if (t0_ < 16) lcnt[t0_] = 0;
          const int e4 = t0_ & 3; f32x4 ca = {0.f, 0.f, 0.f, 0.f};
#pragma unroll 4
          for (int i = 0; i < 16; ++i) { const int k = (t0_ >> 2) + 128 * i;
              const f32x4 w4 = bld4f(rrw, (k * 16 + e4 * 4) * 4, 0);
              const float g = __uint_as_float(__builtin_amdgcn_raw_buffer_load_b32(rgn, k * 4, 0, 0)) * (__uint_as_float(__builtin_amdgcn_raw_buffer_load_b32(rml, k * 4, 4 * DM * 4, 0)) + 1.0f);
              const float sh = __uint_as_float(__builtin_amdgcn_raw_buffer_load_b32(rml, k * 4, 3 * DM * 4, 0));
              ca += w4 * sh;
              const int ob = (k >> 5) * 1024 + (((k >> 3) & 3) * 16 + e4 * 4) * 16 + (k & 7) * 2;
#pragma unroll
              for (int c = 0; c < 4; ++c) { const float wp = w4[c] * g; const unsigned hi = pk2(wp, 0.f) & 0xffffu; const float rem = wp - __uint_as_float(hi << 16);
                  *(LAS unsigned short*)(F.lds + ob + c * 16) = (unsigned short)hi; *(LAS unsigned short*)(F.lds + 65536 + ob + c * 16) = (unsigned short)(pk2(rem, 0.f) & 0xffffu); } }
          const int ln = t0_ & 63;
#pragma unroll
          for (int q = 0; q < 4; ++q)
#pragma unroll
              for (int c = 0; c < 4; ++c) { const float s = wave_sum((ln & 3) == q ? ca[c] : 0.f); if (ln == 0) wsm[F.wave * 16 + q * 4 + c] = s; }
        }
        __syncthreads();
        { const int t0_ = F.wave * 64 + lane_id(); if (t0_ < 16) { float s = 0.f;
#pragma unroll
              for (int w = 0; w < 8; ++w) s += wsm[w * 16 + t0_];
              cstl[t0_] = s; } }
        __syncthreads();
        const int lo16 = F.lane * 16, lo8 = F.lane * 8;
        f32x4 gsv[8];
#pragma unroll
        for (int j = 0; j < 8; ++j) gsv[j] = bld4f(rgn, lo16 + j * 1024, 0) * (bld4f(rml, lo16 + j * 1024, 4 * DM * 4) + 1.0f);
#pragma unroll 1
        for (int rp = 0; rp < 16 / RPA; ++rp) {
            float ss[RPA] = {};
            v2u xraw[RPA][8];
#pragma unroll
            for (int q = 0; q < RPA; ++q)
#pragma unroll
                for (int j = 0; j < 8; ++j) xraw[q][j] = bld2u(rxb, lo8 + j * 512, (row0 + rp * RPA + q) * (DM * 2));
#define XV(q, j) ((f32x4){bf_lo(xraw[q][j].x), bf_hi(xraw[q][j].x), bf_lo(xraw[q][j].y), bf_hi(xraw[q][j].y)})
            f32x4 shv[8];
#pragma unroll
            for (int j = 0; j < 8; ++j) shv[j] = bld4f(rml, lo16 + j * 1024, 3 * DM * 4);
#pragma unroll
            for (int j = 0; j < 8; ++j)
#pragma unroll
                for (int q = 0; q < RPA; ++q) { const f32x4 x = XV(q, j); ss[q] += (x.x * x.x + x.y * x.y) + (x.z * x.z + x.w * x.w); }
            float rstd[RPA];
#pragma unroll
            for (int q = 0; q < RPA; ++q) rstd[q] = __builtin_amdgcn_rsqf(wave_sum(ss[q]) * (1.f / DM) + EPS);
            if (F.lane == 0) {
#pragma unroll
                for (int q = 0; q < RPA; ++q) rsl[F.wave * 16 + rp * RPA + q] = rstd[q]; }
#pragma unroll
            for (int j = 0; j < 8; ++j) {
#pragma unroll
                for (int q = 0; q < RPA; ++q) { const f32x4 o = XV(q, j) * rstd[q] * gsv[j] + shv[j]; __builtin_amdgcn_raw_buffer_store_b32(pk4_fp8(o.x, o.y, o.z, o.w), rh, F.lane * 4 + j * 256, (row0 + rp * RPA + q) * DM, 0); } }
#undef XV
        }
        { const int ln = lane_id(), col = ln & 15, rq = ln >> 4;
          const int va = col * (DM * 2) + rq * 16, sa = row0 * (DM * 2);
          f32x4 acc = {0.f, 0.f, 0.f, 0.f};
          r_bf16x8 a0[8], a1[8];
#pragma unroll
          for (int i = 0; i < 8; ++i) a0[i] = __builtin_bit_cast(r_bf16x8, __builtin_amdgcn_raw_buffer_load_b128(rxb, va + i * 64, sa, 0));
#define RT_MM(AR, sb) do { _Pragma("unroll") for (int i = 0; i < 8; ++i) { const int st = (sb) * 8 + i; \
              const r_bf16x8 bh = *(const LAS r_bf16x8*)(F.lds + st * 1024 + ln * 16), bl = *(const LAS r_bf16x8*)(F.lds + 65536 + st * 1024 + ln * 16); \
              acc = __builtin_amdgcn_mfma_f32_16x16x32_bf16(AR[i], bh, acc, 0, 0, 0); acc = __builtin_amdgcn_mfma_f32_16x16x32_bf16(AR[i], bl, acc, 0, 0, 0); } } while (0)
#pragma unroll 1
          for (int sb = 0; sb < 8; sb += 2) {
#pragma unroll
              for (int i = 0; i < 8; ++i) a1[i] = __builtin_bit_cast(r_bf16x8, __builtin_amdgcn_raw_buffer_load_b128(rxb, va + ((sb + 1) * 8 + i) * 64, sa, 0));
              RT_MM(a0, sb);
              if (sb + 2 < 8) {
#pragma unroll
                  for (int i = 0; i < 8; ++i) a0[i] = __builtin_bit_cast(r_bf16x8, __builtin_amdgcn_raw_buffer_load_b128(rxb, va + ((sb + 2) * 8 + i) * 64, sa, 0)); }
              RT_MM(a1, sb + 1);
          }
#undef RT_MM
          LDS_WAIT();
          const float cs = cstl[col];
#pragma unroll
          for (int i = 0; i < 4; ++i) lgs[F.wave * 272 + (4 * rq + i) * 17 + col] = acc[i] * rsl[F.wave * 16 + 4 * rq + i] + cs;
          LDS_WAIT(); asm volatile("" ::: "memory");
          if (ln < 16) {
              float sc[16], bs[16];
#pragma unroll
              for (int e = 0; e < 16; ++e) { const float lg = lgs[F.wave * 272 + ln * 17 + e]; sc[e] = 1.0f / (1.0f + __expf(-lg)); bs[e] = sc[e] + rb[e]; }
              float gs4[4];
#pragma unroll
              for (int g = 0; g < 4; ++g) { const float a = bs[4 * g], b2 = bs[4 * g + 1], c = bs[4 * g + 2], d = bs[4 * g + 3];
                  const float h1 = fmaxf(a, b2), l1 = fminf(a, b2), h2 = fmaxf(c, d), l2 = fminf(c, d);
                  gs4[g] = fmaxf(h1, h2) + fmaxf(fminf(h1, h2), fmaxf(l1, l2)); }
              int gsel = 0; float gbest = gs4[0];
#pragma unroll
              for (int g = 1; g < 4; ++g) if (gs4[g] > gbest) { gbest = gs4[g]; gsel = g; }
              float bv[4], sv[4];
#pragma unroll
              for (int i = 0; i < 4; ++i) { bv[i] = gsel == 0 ? bs[i] : gsel == 1 ? bs[4 + i] : gsel == 2 ? bs[8 + i] : bs[12 + i]; sv[i] = gsel == 0 ? sc[i] : gsel == 1 ? sc[4 + i] : gsel == 2 ? sc[8 + i] : sc[12 + i]; }
              int i1 = 0; float b1 = bv[0], s1 = sv[0];
#pragma unroll
              for (int i = 1; i < 4; ++i) if (bv[i] > b1) { b1 = bv[i]; s1 = sv[i]; i1 = i; }
              int i2 = -1; float b2v = -__builtin_inff(), s2 = 0.f;
#pragma unroll
              for (int i = 0; i < 4; ++i) if (i != i1 && bv[i] > b2v) { b2v = bv[i]; s2 = sv[i]; i2 = i; }
              const float inv = 1.0f / (s1 + s2);
              const int r = F.wave * 16 + ln, e0 = gsel * 4 + i1, e1 = gsel * 4 + i2;
              tokinfo[r * 4 + 0] = e0; tokinfo[r * 4 + 2] = e1;
              const int row = row0 + ln; *(f32x2*)(aw + (size_t)row * 2) = (f32x2){s1 * inv, s2 * inv};
          }
        }
        __syncthreads();
        const int tb_ = F.wave * 64 + lane_id();
        {
            const int ln = tb_ & 63;
#pragma unroll
            for (int ee = 0; ee < 2; ++ee) { const int e = 2 * F.wave + ee; int base = 0;
#pragma unroll
                for (int hh = 0; hh < 2; ++hh) { const int r = hh * 64 + ln; const bool m0 = tokinfo[r * 4 + 0] == e, m1 = tokinfo[r * 4 + 2] == e;
                    const unsigned long long bal = __ballot(m0 || m1);
                    const int pos = base + __builtin_amdgcn_mbcnt_hi((unsigned)(bal >> 32), __builtin_amdgcn_mbcnt_lo((unsigned)bal, 0));
                    if (m0) tokinfo[r * 4 + 1] = pos; if (m1) tokinfo[r * 4 + 3] = pos;
                    base += __popcll(bal); }
                if (ln == 0) lcnt[e] = base; } }
        __syncthreads();
        if (tb_ < 16) gbase[tb_] = (int)__hip_atomic_fetch_add(gcnt + tb_, (unsigned)lcnt[tb_], __ATOMIC_RELAXED, __HIP_MEMORY_SCOPE_AGENT);
        __syncthreads();
        if (tb_ < 128) { const int e0 = tokinfo[tb_ * 4], p0 = tokinfo[tb_ * 4 + 1], e1 = tokinfo[tb_ * 4 + 2], p1 = tokinfo[tb_ * 4 + 3]; const int row = bi * 128 + tb_;
            rowidx[(size_t)e0 * 32768 + gbase[e0] + p0] = 2 * row; rowidx[(size_t)e1 * 32768 + gbase[e1] + p1] = 2 * row + 1; }
        __syncthreads();
    }
}
#else
__device__ __forceinline__ void phase_router(Frame& F, const Args& A, int l, int dummy = 0) {
    const float* mod = (const float*)(F.ws + WS_MOD);
    bf16* H = (bf16*)(F.ws + WS_H);
    LAS f32x4* rwl = (LAS f32x4*)F.lds;
    LAS int* lcnt = (LAS int*)(F.lds + L_CNT); LAS int* gbase = lcnt + 16; LAS int* tokinfo = (LAS int*)(F.lds + L_TOK);
    unsigned* gcnt = F.ctl + CW_CNT + (dummy ? 3 : l) * 16;
    int* rowidx = (int*)(F.ws + (dummy ? WS_OB : WS_ROWIDX)); float* aw = (float*)(F.ws + (dummy ? WS_OB + 4 * MiB : WS_AW));
    for (int q = F.tid; q < 8192; q += NWAVES * 64) { const int k = q >> 2, e4 = q & 3, ln = (k & 255) >> 2, j = k >> 8, i = k & 3;
        rwl[((j * 4 + i) * 4 + e4) * 64 + ln] = *(const f32x4*)(A.in[I_RW] + (size_t)k * 16 + e4 * 4); }
    float rb[16];
#pragma unroll
    for (int e = 0; e < 16; ++e) rb[e] = __uint_as_float(__builtin_amdgcn_readfirstlane(__float_as_uint(A.in[I_RB][e])));
    __syncthreads();
    for (int bi = F.vcu; bi < T / 128; bi += F.G) {
        { const int t0_ = F.wave * 64 + lane_id(); if (t0_ < 16) lcnt[t0_] = 0; }
        __syncthreads();
        const int row0 = bi * 128 + F.wave * 16, b = row0 >> 13;
        const rsrc_t rml = RSRC(mod + ((size_t)l * 4 + b) * 12288), rgn = RSRC(A.in[I_N2G] + l * DM), rx = RSRC(ROUTER_SRC), rh = RSRC(H);
#ifdef XRES_BF16
        const rsrc_t rxb = RSRC(F.ws + WS_XB);
#endif
        const int lo16 = F.lane * 16, lo8 = F.lane * 8;
        float cst[16];
        { f32x4 ca[4] = {};
#pragma unroll
          for (int j = 0; j < 8; ++j) { const f32x4 sh = bld4f(rml, lo16 + j * 1024, 3 * DM * 4);
#pragma unroll
            for (int i = 0; i < 4; ++i)
#pragma unroll
                for (int e4 = 0; e4 < 4; ++e4) ca[e4] += rwl[((j * 4 + i) * 4 + e4) * 64 + F.lane] * sh[i];
            asm volatile("" ::: "memory"); }
#pragma unroll
          for (int e = 0; e < 16; ++e) cst[e] = __uint_as_float(__builtin_amdgcn_readfirstlane(__float_as_uint(wave_sum(ca[e >> 2][e & 3])))); }
        f32x4 gsv[8];
#pragma unroll
        for (int j = 0; j < 8; ++j) gsv[j] = bld4f(rgn, lo16 + j * 1024, 0) * (bld4f(rml, lo16 + j * 1024, 4 * DM * 4) + 1.0f);
#pragma unroll 1
        for (int rp = 0; rp < 8; ++rp) {
            float ss[2] = {0.f, 0.f}; f32x4 acc[2][4] = {};
            const int so0 = (row0 + rp * 2) * (DM * 4);
#ifdef XRES_BF16
            v2u xraw[2][8];
#pragma unroll
            for (int q = 0; q < 2; ++q)
#pragma unroll
                for (int j = 0; j < 8; ++j) xraw[q][j] = bld2u(rxb, lo8 + j * 512, (row0 + rp * 2 + q) * (DM * 2));
#define XV(q, j) ((f32x4){bf_lo(xraw[q][j].x), bf_hi(xraw[q][j].x), bf_lo(xraw[q][j].y), bf_hi(xraw[q][j].y)})
#else
            f32x4 xv[2][8];
#pragma unroll
            for (int q = 0; q < 2; ++q)
#pragma unroll
                for (int j = 0; j < 8; ++j) xv[q][j] = bld4f(rx, lo16 + j * 1024, so0 + q * (DM * 4));
#define XV(q, j) xv[q][j]
#endif
#pragma unroll
            for (int j = 0; j < 8; ++j) {
                f32x4 a[2];
#pragma unroll
                for (int q = 0; q < 2; ++q) { const f32x4 x = XV(q, j); ss[q] += (x.x * x.x + x.y * x.y) + (x.z * x.z + x.w * x.w); a[q] = x * gsv[j]; }
#pragma unroll
                for (int i = 0; i < 4; ++i) {
#pragma unroll
                    for (int e4 = 0; e4 < 4; ++e4) { const f32x4 w = rwl[((j * 4 + i) * 4 + e4) * 64 + F.lane]; acc[0][e4] += w * a[0][i]; acc[1][e4] += w * a[1][i]; }
                    asm volatile("" : "+v"(acc[0][0]), "+v"(acc[0][1]), "+v"(acc[0][2]), "+v"(acc[0][3]), "+v"(acc[1][0]), "+v"(acc[1][1]), "+v"(acc[1][2]), "+v"(acc[1][3]) :: "memory"); } }
            float rstd[2];
#pragma unroll
            for (int q = 0; q < 2; ++q) rstd[q] = __builtin_amdgcn_rsqf(wave_sum(ss[q]) * (1.f / DM) + EPS);
            asm volatile("" ::: "memory");
            f32x4 shv[8];
#pragma unroll
            for (int j = 0; j < 8; ++j) shv[j] = bld4f(rml, lo16 + j * 1024, 3 * DM * 4);
#pragma unroll
            for (int j = 0; j < 8; ++j) {
#pragma unroll
                for (int q = 0; q < 2; ++q) { const f32x4 o = XV(q, j) * rstd[q] * gsv[j] + shv[j]; __builtin_amdgcn_raw_buffer_store_b32(pk4_fp8(o.x, o.y, o.z, o.w), rh, F.lane * 4 + j * 256, (row0 + rp * 2 + q) * DM, 0); } }
#undef XV
#pragma unroll
            for (int q = 0; q < 2; ++q) {
                float sc[16], bs[16];
#pragma unroll
                for (int e = 0; e < 16; ++e) { const float lg = wave_sum(acc[q][e >> 2][e & 3]) * rstd[q] + cst[e]; sc[e] = 1.0f / (1.0f + __expf(-lg)); bs[e] = sc[e] + rb[e]; }
                float gs4[4];
#pragma unroll
                for (int g = 0; g < 4; ++g) { const float a = bs[4 * g], b2 = bs[4 * g + 1], c = bs[4 * g + 2], d = bs[4 * g + 3];
                    const float h1 = fmaxf(a, b2), l1 = fminf(a, b2), h2 = fmaxf(c, d), l2 = fminf(c, d);
                    gs4[g] = fmaxf(h1, h2) + fmaxf(fminf(h1, h2), fmaxf(l1, l2)); }
                int gsel = 0; float gbest = gs4[0];
#pragma unroll
                for (int g = 1; g < 4; ++g) if (gs4[g] > gbest) { gbest = gs4[g]; gsel = g; }
                float bv[4], sv[4];
#pragma unroll
                for (int i = 0; i < 4; ++i) { bv[i] = gsel == 0 ? bs[i] : gsel == 1 ? bs[4 + i] : gsel == 2 ? bs[8 + i] : bs[12 + i]; sv[i] = gsel == 0 ? sc[i] : gsel == 1 ? sc[4 + i] : gsel == 2 ? sc[8 + i] : sc[12 + i]; }
                int i1 = 0; float b1 = bv[0], s1 = sv[0];
#pragma unroll
                for (int i = 1; i < 4; ++i) if (bv[i] > b1) { b1 = bv[i]; s1 = sv[i]; i1 = i; }
                int i2 = -1; float b2v = -__builtin_inff(), s2 = 0.f;
#pragma unroll
                for (int i = 0; i < 4; ++i) if (i != i1 && bv[i] > b2v) { b2v = bv[i]; s2 = sv[i]; i2 = i; }
                const float inv = 1.0f / (s1 + s2);
                if (F.lane == 0) {
                    const int r = F.wave * 16 + rp * 2 + q, e0 = gsel * 4 + i1, e1 = gsel * 4 + i2;
                    tokinfo[r * 4 + 0] = e0; tokinfo[r * 4 + 2] = e1;
                    const int row = row0 + rp * 2 + q; *(f32x2*)(aw + (size_t)row * 2) = (f32x2){s1 * inv, s2 * inv};
                }
            }
        }
        __syncthreads();
        const int tb_ = F.wave * 64 + lane_id();
        if (tb_ < 16) {
            int c = 0;
            for (int r = 0; r < 128; ++r) { if (tokinfo[r * 4 + 0] == tb_) tokinfo[r * 4 + 1] = c++; if (tokinfo[r * 4 + 2] == tb_) tokinfo[r * 4 + 3] = c++; }
            gbase[tb_] = (int)__hip_atomic_fetch_add(gcnt + tb_, (unsigned)c, __ATOMIC_RELAXED, __HIP_MEMORY_SCOPE_AGENT); }
        __syncthreads();
        if (tb_ < 128) { const int e0 = tokinfo[tb_ * 4], p0 = tokinfo[tb_ * 4 + 1], e1 = tokinfo[tb_ * 4 + 2], p1 = tokinfo[tb_ * 4 + 3]; const int row = bi * 128 + tb_;
            rowidx[(size_t)e0 * 32768 + gbase[e0] + p0] = 2 * row; rowidx[(size_t)e1 * 32768 + gbase[e1] + p1] = 2 * row + 1; }
        __syncthreads();
    }
}
#endif
__device__ __forceinline__ int moe_setup(Frame& F, int l) {
    LAS int* ts = (LAS int*)(F.lds + L_TS);
    if (F.tid == 0) { int s = 0; for (int e = 0; e < 16; ++e) { ts[e] = s; s += ((int)__hip_atomic_load(F.ctl + CW_CNT + l * 16 + e, __ATOMIC_RELAXED, __HIP_MEMORY_SCOPE_AGENT) + 255) >> 8; } ts[16] = s; }
    __syncthreads();
    return __builtin_amdgcn_readfirstlane(ts[16]);
}

__device__ __forceinline__ att::Blk mla_blk(int bh, int qb) {
    const int b = bh >> 3, h = bh & 7; att::Blk k;
    k.qo = (unsigned)(WS_QA + ((size_t)b * SEQ * 1536 + h * 192) * 2); k.ko = (unsigned)(WS_KF + ((size_t)b * SEQ * 1536 + h * 192) * 2);
    k.vo = (unsigned)(WS_VB + ((size_t)b * SEQ * 1024 + h * 128) * 2); k.oo = (unsigned)(WS_OA + ((size_t)b * SEQ * 1024 + h * 128) * 2); k.lo = 0;
    k.P0 = qb * 256; k.rate = 1; k.beta = 0.f;
    return k;
}
__device__ __forceinline__ att::Blk dil_blk(int bh, int br, int blk) {
    const int b = bh >> 3, h = bh & 7, rate = br == 0 ? 1 : br == 1 ? 4 : 16, nqb = 32 / rate, cls = blk / nqb, qb = blk % nqb; att::Blk k;
    const size_t tok0 = (size_t)b * SEQ + cls;
    const unsigned p = (unsigned)(WS_PROJ + (tok0 * PROJ_LD + h * 128) * 2);
    k.qo = p + C_QB * 2; k.ko = p + C_KB * 2; k.vo = p + C_VB * 2;
    k.oo = (unsigned)(WS_OB + (((size_t)br * T + tok0) * 1024 + h * 128) * 2);
    k.lo = (unsigned)(WS_LSE + (((size_t)br * T + tok0) * 8 + h) * 4);
    k.P0 = qb * 256; k.rate = rate;
    const float slope = __builtin_amdgcn_exp2f(-(float)(h + 1));
    k.beta = slope * (float)rate * 11.313708498984761f;
    return k;
}
__device__ __forceinline__ void mla_decode(int id, int& bh, int& qb0, int& qb1) {
    const int v = id & 255, i = id >> 8, x = v >> 5, c = v & 31, j = i * 32 + c; bh = 4 * x + (j >> 4); const int s = j & 15; qb0 = s; qb1 = 31 - s;
}
__device__ __forceinline__ void dil_decode(int id, int& bh, int& br, int& blk) {
    const int v = id & 255, i = id >> 8, x = v >> 5, c = v & 31, j = i * 32 + c; bh = 4 * x + j / 96; const int r = j % 96; br = r >> 5; blk = r & 31;
}
#ifndef ATT_DIL_NS
#define ATT_DIL_NS 4
#endif
#ifndef ATT_SKEW_SEL
#define ATT_SKEW_SEL 0
#endif
#if ATT_SKEW_SEL == 0
#define ATT_SKEW_PICK(w) ((w) < 4)
#elif ATT_SKEW_SEL == 1
#define ATT_SKEW_PICK(w) (((w) & 1) == 0)
#elif ATT_SKEW_SEL == 2
#define ATT_SKEW_PICK(w) true
#else
#define ATT_SKEW_PICK(w) false
#endif
#ifdef ATT_DMA
#define ATT_SEAM(d) att::SeamD<d>
#define ATT_DMA_ON ATT_DMA
#else
#define ATT_SEAM(d) att::Seam<d>
#define ATT_DMA_ON 0
#endif
#if ATT_DMA_ON == 2
template <int ORD>
__device__ __forceinline__ void mla_stream2(Frame& F, char* lds) {
    constexpr int NIT = 512;
    int id = F.vcu;
    if (id < NIT) {
        att::SeamD<192> S; int bh, q0, q1; mla_decode(id, bh, q0, q1); int pass = 0;
        att::Blk cur = mla_blk(bh, q0);
        att::att_prime_dma2<192, false>(cur, (const char*)F.ws, lds, S, F.tid);
        for (;;) {
            const bool more_pass = pass == 0, more_item = id + F.G < NIT, last = !more_pass && !more_item;
            att::Blk nxt = cur; int idn = id, passn = pass + 1;
            if (more_pass) nxt = mla_blk(bh, q1);
            else if (more_item) { idn = id + F.G; passn = 0; mla_decode(idn, bh, q0, q1); nxt = mla_blk(bh, q0); }
            att::att_block_dma2<192, false, false, ORD>(cur, nxt, (const char*)F.ws, lds, S, F.tid);
            if (last) break;
            cur = nxt; id = idn; pass = passn;
        }
    }
}
template <int ORD>
__device__ __forceinline__ void dil_stream2(Frame& F, char* lds) {
    constexpr int NIT = 3072;
    int id = F.vcu;
    if (id < NIT) {
        att::SeamD<128> S; int bh, br, blk; dil_decode(id, bh, br, blk);
        att::Blk cur = dil_blk(bh, br, blk);
        att::att_prime_dma2<128, true>(cur, (const char*)F.ws, lds, S, F.tid);
        for (;;) {
            const bool last = id + F.G >= NIT;
            att::Blk nxt = cur;
            if (!last) { dil_decode(id + F.G, bh, br, blk); nxt = dil_blk(bh, br, blk); }
            att::att_block_dma2<128, true, true, ORD>(cur, nxt, (const char*)F.ws, lds, S, F.tid);
            if (last) break;
            cur = nxt; id += F.G;
        }
    }
}
#endif
template <int PV>
__device__ __forceinline__ void dil_stream_reg(Frame& F, char* lds, int rep_, const Args& A, int l, int cvj0) {
        constexpr int NIT = 3072;
        int id = F.vcu;
        if (id < NIT) {
#if ATT_DMA_ON == 1
            att::SeamD<128> S;
#else
            att::Seam<128> S;
#endif
            S.cv_j = cvj0;
            int bh, br, blk; dil_decode(id, bh, br, blk);
            att::Blk cur = dil_blk(bh, br, blk);
#if defined(ATT_CONV) && ATT_CONV == 2
            const size_t eo_ = (size_t)l * NEXP * DM * DEXP;
            const att::ConvCtx X = {A.in[I_EG] + eo_, A.in[I_EU] + eo_, A.in[I_ED] + eo_, F.ws + WS_W13, F.ws + WS_W2, F.vcu * 8 + __builtin_amdgcn_readfirstlane(F.tid >> 6)};
#endif
#if ATT_DMA_ON == 1
            att::att_prime_dma<128, true, ATT_DIL_NS>(cur, (const char*)F.ws, lds, S, F.tid);
#else
            att::att_prime<128, true, PV>(cur, (const char*)F.ws, lds, S, F.tid);
#endif
            for (;;) {
                const bool last = id + F.G >= NIT;
                att::Blk nxt = cur;
                if (!last) { dil_decode(id + F.G, bh, br, blk); nxt = dil_blk(bh, br, blk); }
#if ATT_DMA_ON == 1
                att::att_block_dma<128, true, true, ATT_DIL_NS>(cur, nxt, (const char*)F.ws, lds, lds + RING_BYTES + 512, S, F.tid);
#else
#if defined(ATT_CONV) && ATT_CONV == 2
                att::att_block<128, true, true, PV, 2>(cur, nxt, (const char*)F.ws, lds, S, F.tid, &X);
#else
                att::att_block<128, true, true, PV>(cur, nxt, (const char*)F.ws, lds, S, F.tid);
#endif
#endif
                if (last) break;
                cur = nxt; id += F.G;
            }
#if defined(ATT_CONV) && ATT_CONV == 2
            { const int ln_ = lane_id(); char* scr_ = lds + att::CONV_SCR_DIL + __builtin_amdgcn_readfirstlane(F.tid >> 6) * 4352;
              if (S.cv_pend) { asm volatile("s_waitcnt vmcnt(0)" ::: "memory"); att::conv_put_full(X, S.cv_j, S.cvf, scr_, ln_); ++S.cv_j; if (S.cv_pend > 1) { att::conv_put_full(X, S.cv_j, S.cvf + 16, scr_, ln_); ++S.cv_j; } S.cv_pend = 0; }
              int jj_ = S.cv_j;
#pragma unroll 1
              while (jj_ < att::CONV_NJ) { float cb_[4][16];
#pragma unroll
                  for (int u = 0; u < 4; ++u) if (jj_ + u < att::CONV_NJ) att::conv_load_full(X, jj_ + u, cb_[u], ln_);
                  asm volatile("s_waitcnt vmcnt(0)" ::: "memory");
#pragma unroll
                  for (int u = 0; u < 4; ++u) if (jj_ + u < att::CONV_NJ) att::conv_put_full(X, jj_ + u, cb_[u], scr_, ln_);
                  jj_ += 4; }
              S.cv_j = att::CONV_NJ; }
#endif
#if defined(ATT_DEFER) && ATT_DMA_ON != 1
            if (S.p_on) { const int ln_ = F.tid & 63; const char* stg_ = lds + att::DEFER_STG + __builtin_amdgcn_readfirstlane(F.tid >> 6) * 8192;
#pragma unroll
                for (int p = 0; p < 8; ++p) att::flush_piece(stg_, p, (const char*)F.ws + S.p_oo, S.p_rb, S.p_so0, ln_); }
#endif
        }
}
static_assert(WS_ROPE == att::ROPE_OFF, "rope table offset");
#ifdef ATT_QROPE
#define ATT_ROPE_FLAG true
#else
#define ATT_ROPE_FLAG false
#endif
__device__ __forceinline__ void phase_attention(Frame& F, char* lds, const Args& A, int l) {
#ifdef ATT_PRIO
    if (__builtin_amdgcn_readfirstlane(F.tid >> 6) >= 4) __builtin_amdgcn_s_setprio(1);
#endif
#ifndef ATT_MLA_SKCONV
#define ATT_MLA_SKCONV 0
#endif
    int cvj_ = 0;
#ifndef NO_MLA
#ifndef PROBE_REP_MLA
#define PROBE_REP_MLA 1
#endif
    for (int rep_ = 0; rep_ < PROBE_REP_MLA; ++rep_) {
        if (rep_) __syncthreads();
#if ATT_DMA_ON == 2
        { const int wsel_ = __builtin_amdgcn_readfirstlane(F.tid >> 6);
          if (ATT_SKEW_PICK(wsel_)) mla_stream2<0>(F, lds); else mla_stream2<1>(F, lds); }
#else
        constexpr int NIT = 512;
        int id = F.vcu;
        if (id < NIT) {
            ATT_SEAM(192) S; int bh, q0, q1; mla_decode(id, bh, q0, q1); int pass = 0;
            att::Blk cur = mla_blk(bh, q0);
#if defined(ATT_CONV) && (ATT_CONV == 1 || defined(ATT_MLA_SK))
            const size_t eo_ = (size_t)l * NEXP * DM * DEXP;
            const att::ConvCtx X = {A.in[I_EG] + eo_, A.in[I_EU] + eo_, A.in[I_ED] + eo_, F.ws + WS_W13, F.ws + WS_W2, F.vcu * 8 + __builtin_amdgcn_readfirstlane(F.tid >> 6)};
#endif
#if ATT_DMA_ON
            att::att_prime_dma<192, false, 3>(cur, (const char*)F.ws, lds, S, F.tid);
#else
#ifdef ATT_QROPE
            att::att_prime<192, false, 0, true>(cur, (const char*)F.ws, lds, S, F.tid);
#else
            att::att_prime<192, false>(cur, (const char*)F.ws, lds, S, F.tid);
#endif
#endif
            for (;;) {
                const bool more_pass = pass == 0, more_item = id + F.G < NIT, last = !more_pass && !more_item;
                att::Blk nxt = cur; int idn = id, passn = pass + 1;
                if (more_pass) nxt = mla_blk(bh, q1);
                else if (more_item) { idn = id + F.G; passn = 0; mla_decode(idn, bh, q0, q1); nxt = mla_blk(bh, q0); }
#if ATT_DMA_ON
                att::att_block_dma<192, false, false, 3>(cur, nxt, (const char*)F.ws, lds, lds + 3 * att::SHM_V + 3 * att::Cfg<192>::SHM_K, S, F.tid);
#else
#if defined(ATT_CONV) && ATT_CONV == 1
                att::att_block<192, false, false, 0, 1, ATT_ROPE_FLAG>(cur, nxt, (const char*)F.ws, lds, S, F.tid, &X);
#elif defined(ATT_MLA_SK)
                att::att_block<192, false, true, 0, ATT_MLA_SKCONV, ATT_ROPE_FLAG>(cur, nxt, (const char*)F.ws, lds, S, F.tid, &X);
#elif defined(ATT_QROPE)
                att::att_block<192, false, false, 0, 0, true>(cur, nxt, (const char*)F.ws, lds, S, F.tid);
#else
                att::att_block<192, false, false>(cur, nxt, (const char*)F.ws, lds, S, F.tid);
#endif
#endif
                if (last) break;
                cur = nxt; id = idn; pass = passn;
            }
#ifdef ATT_MLA_SK
            { const int ln_ = lane_id(); char* scr_ = lds + att::CONV_SCR + __builtin_amdgcn_readfirstlane(F.tid >> 6) * 4352;
              if (S.cv_pend) { asm volatile("s_waitcnt vmcnt(0)" ::: "memory"); att::conv_put_full(X, S.cv_j, S.cvf, scr_, ln_); ++S.cv_j; if (S.cv_pend > 1) { att::conv_put_full(X, S.cv_j, S.cvf + 16, scr_, ln_); ++S.cv_j; } S.cv_pend = 0; }
              cvj_ = S.cv_j; }
#endif
#if defined(ATT_CONV) && ATT_CONV == 1
            { const int ln_ = lane_id(); char* scr_ = lds + att::CONV_SCR + __builtin_amdgcn_readfirstlane(F.tid >> 6) * 4352;
              while (S.cv_j < att::CONV_NJ) { att::conv_load(X, S.cv_j, S.cv_q, S.cv, ln_); asm volatile("s_waitcnt vmcnt(0)" ::: "memory");
                  att::conv_put(X, S.cv_j, S.cv_q, S.cv, scr_, ln_); if (++S.cv_q == 4) { S.cv_q = 0; ++S.cv_j; } S.cl_j = S.cv_j; S.cl_q = S.cv_q; } }
#endif
        }
#endif
    }
#endif
#ifndef NO_DIL
#ifndef PROBE_REP_DIL
#define PROBE_REP_DIL 1
#endif
#ifndef PROBE_DIL_VAR
#define PROBE_DIL_VAR 0
#endif
#if ATT_DMA_ON == 2 && !defined(ATT_DIL_DMA2)
    asm volatile("s_waitcnt vmcnt(0)" ::: "memory"); __syncthreads();
#endif
    for (int rep_ = 0; rep_ < PROBE_REP_DIL; ++rep_) {
        if (rep_) __syncthreads();
#if ATT_DMA_ON == 2 && defined(ATT_DIL_DMA2)
        { const int wsel_ = __builtin_amdgcn_readfirstlane(F.tid >> 6);
          if (ATT_SKEW_PICK(wsel_)) dil_stream2<0>(F, lds); else dil_stream2<1>(F, lds); }
#else
        if (rep_ + 1 < PROBE_REP_DIL) dil_stream_reg<PROBE_DIL_VAR>(F, lds, rep_, A, l, cvj_); else dil_stream_reg<0>(F, lds, rep_, A, l, cvj_);
#endif
    }
#endif
#ifdef ATT_PRIO
    __builtin_amdgcn_s_setprio(0);
#endif
}
#ifndef MK_PER_PHASE
#define MK_PER_PHASE 0
#endif
constexpr int NPH = 2 + 11 * DEPTH;
__global__ void __launch_bounds__(NWAVES * 64, 2) mk_fwd(Args args) {
    extern __shared__ __attribute__((aligned(16))) unsigned char lds[];
    Frame F;
    F.lds = (LAS unsigned char*)lds; F.ldsg = lds;
    F.wave = __builtin_amdgcn_readfirstlane((int)threadIdx.x >> 6); F.lane = lane_id(); F.tid = F.wave * 64 + F.lane;
    F.G = gridDim.x; { const int bx = blockIdx.x; F.vcu = (F.G % 8 == 0) ? (bx % 8) * (F.G / 8) + bx / 8 : bx; }
    F.ws = args.ws; F.ctl = (unsigned*)(args.ws + WS_CTL);
    for (int u = F.tid; u < (LDS_BYTES - RING_BYTES) / 4; u += NWAVES * 64) ((LAS unsigned*)(F.lds + RING_BYTES))[u] = 0u;
    __syncthreads();
    volatile LAS unsigned* MISC = (volatile LAS unsigned*)(F.lds + L_MISC);
    XcdBarrier bar; bar.bar = F.ctl + CW_BAR; bar.x = 0; bar.st = nullptr;
    if (!MK_PER_PHASE) bar = xcd_barrier_post(F.ctl + CW_BAR, MISC + 8, F.tid);
    const int lo = args.ph_lo, hi = args.ph_hi;
#ifndef PROBE_GRID1_PHASE
#define PROBE_GRID1_PHASE (-1)
#endif
#define PROBE_GRID1(p) ((p) == PROBE_GRID1_PHASE)
#ifndef PROBE_MODE
#define PROBE_MODE 1
#endif
#ifndef PROBE_REP_MASK
#define PROBE_REP_MASK 0
#endif
#define NREP(j) ((((PROBE_REP_MASK) >> (j)) & 1) ? 2 : 1)
#ifndef PROBE_XIN
#define PROBE_XIN 0
#endif
#ifndef PH_MASK
#define PH_MASK 0x1FFF
#endif
#define IN(k) (lo <= (k) && (k) < hi)
#define MSK(j) (((PH_MASK) >> (j)) & 1)
#define FRESH(Fp) Frame Fp = F; { int l_ = lane_id(); int z_ = 0; asm volatile("" : "+v"(l_), "+s"(z_)); Fp.lane = l_; Fp.wave = F.wave + z_; Fp.tid = Fp.wave * 64 + l_; Fp.vcu = F.vcu + z_; Fp.ws = F.ws + z_; Fp.ctl = (unsigned*)(Fp.ws + WS_CTL); }
#define SEAM(k) do { if (IN(k) && IN((k) + 1)) xcd_barrier(bar, F.wave * 64 + lane_id()); } while (0)

    if (MSK(11) && IN(0)) { FRESH(P); phase_prologue(P, args);
#ifdef PROBE_REPEAT_PROLOGUE
        __syncthreads(); phase_prologue(P, args);
#endif
    }
    SEAM(0);
    for (int l = 0; l < DEPTH; ++l) {
        const int pb = 1 + 11 * l;
        const float* mod = (const float*)(F.ws + WS_MOD);
        if (MSK(0) && IN(pb + 0)) { for (int rep_ = 0; rep_ < (l == 0 ? NREP(0) : 1); ++rep_) { if (rep_) __syncthreads(); FRESH(P); phase_norm1(P, args, l); } }
        SEAM(pb + 0);
        if (MSK(1) && IN(pb + 1)) { for (int rep_ = 0; rep_ < NREP(1); ++rep_) { if (rep_) __syncthreads(); FRESH(P);
            pg8::Gemm g{(const bf16*)(P.ws + WS_H), (const bf16*)(P.ws + WS_WIN) + (size_t)l * 4096 * DM, DM * 2};
            pg8::StaticOrder S; S.init(T, PROJ_LD, P.G, (int)blockIdx.x);
            pg8::EpiPlain E{(bf16*)(P.ws + WS_PROJ), PROJ_LD};
            pg8::gemm_phase<pg8::EpiPlain, pg8::StaticOrder, pg8::ALinear>(P.lds, g, S, pg8::ALinear{}, E, P.tid);
        } }
        SEAM(pb + 1);
#ifdef PROBE_EXTRA_BARRIERS
        if (IN(pb + 2)) for (int xb_ = 0; xb_ < PROBE_EXTRA_BARRIERS; ++xb_) xcd_barrier(bar, F.wave * 64 + lane_id());
#endif
        if (MSK(2) && IN(pb + 2)) { for (int rep_ = 0; rep_ < NREP(2); ++rep_) { if (rep_) __syncthreads(); FRESH(P); phase_mla_prep(P, args); } }
        SEAM(pb + 2);
        if (MSK(3) && IN(pb + 3)) { for (int rep_ = 0; rep_ < NREP(3); ++rep_) { if (rep_) __syncthreads(); FRESH(P);
#ifdef PROBE_SWAP_UP
            { pg8::Gemm g{(const bf16*)(P.ws + WS_PROJ) + C_CKV, (const bf16*)(P.ws + WS_WUKV) + (size_t)l * 2048 * 256, 256 * 2};
              pg8::StaticOrder S; S.init(T, 2048, P.G, (int)blockIdx.x);
              pg8::EpiKVup E{(bf16*)(P.ws + WS_KF), (bf16*)(P.ws + WS_VB), (const float*)(P.ws + WS_RSTDKV)};
              pg8::gemm_phase<pg8::EpiKVup, pg8::StaticOrder, pg8::APitch>(P.lds, g, S, pg8::APitch{PROJ_LD * 2}, E, P.tid); }
            { pg8::Gemm g{(const bf16*)(P.ws + WS_PROJ) + C_CQ, (const bf16*)(P.ws + WS_WUQ) + (size_t)l * 1536 * 512, 512 * 2};
              pg8::StaticOrder S; S.init(T, 1536, P.G, (int)blockIdx.x);
              pg8::EpiQup E{(bf16*)(P.ws + WS_QA), (const float*)(P.ws + WS_RSTDQ)};
#ifdef PROBE_QUP_PLAIN
              { pg8::EpiPlain E2{(bf16*)(P.ws + WS_QA), 1536}; pg8::gemm_phase<pg8::EpiPlain, pg8::StaticOrder, pg8::APitch>(P.lds, g, S, pg8::APitch{PROJ_LD * 2}, E2, P.tid); }
#else
              pg8::gemm_phase<pg8::EpiQup, pg8::StaticOrder, pg8::APitch>(P.lds, g, S, pg8::APitch{PROJ_LD * 2}, E, P.tid);
#endif
            }
#else
            { pg8::Gemm g{(const bf16*)(P.ws + WS_PROJ) + C_CQ, (const bf16*)(P.ws + WS_WUQ) + (size_t)l * 1536 * 512, 512 * 2};
              pg8::StaticOrder S; S.init(T, 1536, P.G, (int)blockIdx.x);
              pg8::EpiQup E{(bf16*)(P.ws + WS_QA), (const float*)(P.ws + WS_RSTDQ)};
#ifdef PROBE_QUP_PLAIN
              { pg8::EpiPlain E2{(bf16*)(P.ws + WS_QA), 1536}; pg8::gemm_phase<pg8::EpiPlain, pg8::StaticOrder, pg8::APitch>(P.lds, g, S, pg8::APitch{PROJ_LD * 2}, E2, P.tid); }
#else
              pg8::gemm_phase<pg8::EpiQup, pg8::StaticOrder, pg8::APitch>(P.lds, g, S, pg8::APitch{PROJ_LD * 2}, E, P.tid);
#endif
            }
            { pg8::Gemm g{(const bf16*)(P.ws + WS_PROJ) + C_CKV, (const bf16*)(P.ws + WS_WUKV) + (size_t)l * 2048 * 256, 256 * 2};
              pg8::StaticOrder S; S.init(T, 2048, P.G, (int)blockIdx.x);
              pg8::EpiKVup E{(bf16*)(P.ws + WS_KF), (bf16*)(P.ws + WS_VB), (const float*)(P.ws + WS_RSTDKV)};
              pg8::gemm_phase<pg8::EpiKVup, pg8::StaticOrder, pg8::APitch>(P.lds, g, S, pg8::APitch{PROJ_LD * 2}, E, P.tid); }
#endif
        } }
        SEAM(pb + 3);
#ifndef ATT_QROPE
        if (MSK(4) && IN(pb + 4)) { FRESH(P); phase_q_rope(P, args); }
        SEAM(pb + 4);
#endif
        if (MSK(5) && IN(pb + 5)) { FRESH(P); phase_attention(P, (char*)lds, args, l);
#ifdef PROBE_REPEAT_ATT
            __syncthreads(); phase_attention(P, (char*)lds, args, l);
#endif
        }
        SEAM(pb + 5);
        if (MSK(6) && IN(pb + 6)) { for (int rep_ = 0; rep_ < NREP(6); ++rep_) { if (rep_) __syncthreads(); FRESH(P); phase_out_norm(P, args, l); } }
        SEAM(pb + 6);
        if (MSK(7) && IN(pb + 7)) { FRESH(P);
#ifdef G3_FP8
            pg8::Gemm g{P.ws + WS_H, P.ws + WS_WOUT + (size_t)l * DM * DM, DM};
            pg8::StaticOrder S; S.init(T, DM, P.G, (int)blockIdx.x);
#ifdef XRES_BF16
            pg8::EpiResidB E{l == 0 ? (const void*)args.in[I_X] : (const void*)(P.ws + WS_XB), (bf16*)(P.ws + WS_XB), mod + (size_t)l * 4 * 12288 + 2 * DM, 12288, 1.0f / 256.0f, l == 0 ? 1 : 0};
            pg8::gemm_phase<pg8::EpiResidB, pg8::StaticOrder, pg8::ALinear, true>(P.lds, g, S, pg8::ALinear{}, E, P.tid);
#else
            pg8::EpiResid E{l == 0 ? args.in[I_X] : args.out, args.out, mod + (size_t)l * 4 * 12288 + 2 * DM, DM, 12288, 1.0f / 256.0f};
            pg8::gemm_phase<pg8::EpiResid, pg8::StaticOrder, pg8::ALinear, true>(P.lds, g, S, pg8::ALinear{}, E, P.tid);
#endif
#elif defined(XRES_BF16)
            pg8::Gemm g{(const bf16*)(P.ws + WS_H), (const bf16*)(P.ws + WS_WOUT) + (size_t)l * DM * DM, DM * 2};
            pg8::StaticOrder S; S.init(T, DM, P.G, (int)blockIdx.x);
            pg8::EpiResidB E{l == 0 ? (const void*)args.in[I_X] : (const void*)(P.ws + WS_XB), (bf16*)(P.ws + WS_XB), mod + (size_t)l * 4 * 12288 + 2 * DM, 12288, 1.0f, l == 0 ? 1 : 0};
            pg8::gemm_phase<pg8::EpiResidB, pg8::StaticOrder, pg8::ALinear>(P.lds, g, S, pg8::ALinear{}, E, P.tid);
#else
            pg8::Gemm g{(const bf16*)(P.ws + WS_H), (const bf16*)(P.ws + WS_WOUT) + (size_t)l * DM * DM, DM * 2};
            pg8::StaticOrder S; S.init(T, DM, P.G, (int)blockIdx.x);
            pg8::EpiResid E{l == 0 ? args.in[I_X] : args.out, args.out, mod + (size_t)l * 4 * 12288 + 2 * DM, DM, 12288, 1.0f};
            pg8::gemm_phase<pg8::EpiResid, pg8::StaticOrder, pg8::ALinear>(P.lds, g, S, pg8::ALinear{}, E, P.tid);
#endif
        }
        SEAM(pb + 7);
        if (MSK(8) && IN(pb + 8)) { FRESH(P); phase_router(P, args, l);
#ifdef PROBE_REPEAT_ROUTER
            __syncthreads(); phase_router(P, args, l, 1);
#endif
        }
        SEAM(pb + 8);
        if (MSK(9) && IN(pb + 9)) { for (int rep_ = 0; rep_ < NREP(9); ++rep_) { if (rep_) __syncthreads(); FRESH(P);
            const int NT = moe_setup(P, l);
            pg8::MoeOrder S{NT, 8, P.G, (int)blockIdx.x, (const LAS int*)(P.lds + L_TS)};
            LAS unsigned* atab = (LAS unsigned*)(P.lds + L_ATAB); const int* rowidx = (const int*)(P.ws + WS_ROWIDX);
#pragma unroll 1
            for (int slot = 0; slot < MAXU; ++slot) { pg8::Unit u; if (!S.next(slot, u)) break;
                if (P.tid < 256) { const int lr = u.lt * 256 + P.tid; const int ce = (int)P.ctl[CW_CNT + l * 16 + u.e];
                    int tok = lr < ce ? (rowidx[(size_t)u.e * 32768 + lr] >> 1) : 0;
#ifdef PROBE_LINEAR_ATAB
                    tok = (int)(((unsigned)(u.pm * 256 + P.tid) * 2654435761u) >> 17) & 32767;
#endif
 atab[slot * 256 + P.tid] = (unsigned)tok * (unsigned)DM; } }
            __syncthreads();
            pg8::Gemm g{P.ws + WS_H, P.ws + WS_W13, DM};
            pg8::EpiSwiglu E{P.ws + WS_HMID, DEXP};
            pg8::gemm_phase<pg8::EpiSwiglu, pg8::MoeOrder, pg8::ATable, true>(P.lds, g, S, pg8::ATable{atab}, E, P.tid);
        } }
        SEAM(pb + 9);
        if (MSK(10) && IN(pb + 10)) { for (int rep_ = 0; rep_ < NREP(10); ++rep_) { if (rep_) __syncthreads(); FRESH(P);
            const int NT = moe_setup(P, l);
            pg8::MoeOrder S{NT, 8, P.G, (int)blockIdx.x, (const LAS int*)(P.lds + L_TS)};
            pg8::Gemm g{P.ws + WS_HMID, P.ws + WS_W2, DEXP};
            pg8::EpiMoeDown E{(bf16*)(P.ws + WS_Y), (const int*)(P.ws + WS_ROWIDX), (const float*)(P.ws + WS_AW), P.ctl + CW_CNT + l * 16};
            pg8::gemm_phase<pg8::EpiMoeDown, pg8::MoeOrder, pg8::ALinear, true>(P.lds, g, S, pg8::ALinear{}, E, P.tid);
        } }
        SEAM(pb + 10);
    }
    #ifdef PROBE_DUMP_OFF
    if (MSK(12) && IN(NPH - 1)) { FRESH(P); phase_dump(P, args, (size_t)(PROBE_DUMP_OFF), PROBE_DUMP_PITCH); }
#else
    if (MSK(12) && IN(NPH - 1)) { FRESH(P); phase_final(P, args, args.li != 0 ? (PROBE_XIN ? 2 : PROBE_MODE) : 0);
#ifdef PROBE_EXACT
        { const int gw = P.vcu * NWAVES + P.wave, NGW = P.G * NWAVES; __syncthreads();
          for (int ch = gw; ch < T / 16; ch += NGW) for (int rr = 0; rr < 16; ++rr) for (int j = 0; j < 8; ++j) { float* p = args.out + (size_t)(ch * 16 + rr) * DM + 4 * P.lane + 256 * j; asm volatile("s_waitcnt vmcnt(0)" ::: "memory");
              const v4u ub = *(const v4u*)p; *(f32x4*)p = (f32x4){(float)(ub.x & 0xFFFu), (float)(ub.y & 0xFFFu), (float)(ub.z & 0xFFFu), (float)(ub.w & 0xFFFu)}; } }
#endif
    }
#endif
#undef IN
#undef SEAM
}

extern "C" void kernel_launch(void* const* d_in, const int* in_sizes, int n_in, void* d_out, int out_size, void* d_ws, size_t ws_size, hipStream_t stream) {
    static int grid = 0;
    if (grid == 0) {
        if (n_in != 20 || in_sizes[0] != T * DM || out_size != T * DM || ws_size < WS_END) {
            fprintf(stderr, "kernel_launch: unexpected problem (n_in %d, in0 %d, out %d, ws %zu < %zu)\n", n_in, n_in > 0 ? in_sizes[0] : -1, out_size, ws_size, (size_t)WS_END); grid = -1; return; }
        int dev = 0, cus = 0;
        if (hipGetDevice(&dev) != hipSuccess || hipDeviceGetAttribute(&cus, hipDeviceAttributeMultiprocessorCount, dev) != hipSuccess) { grid = -1; return; }
        if (hipFuncSetAttribute((const void*)mk_fwd, hipFuncAttributeMaxDynamicSharedMemorySize, LDS_BYTES) != hipSuccess) { fprintf(stderr, "kernel_launch: hipFuncSetAttribute failed\n"); grid = -1; return; }
        int per_cu = 0;
        if (hipOccupancyMaxActiveBlocksPerMultiprocessor(&per_cu, (const void*)mk_fwd, NWAVES * 64, LDS_BYTES) != hipSuccess || per_cu < 1) fprintf(stderr, "kernel_launch: occupancy query says %d blocks per CU\n", per_cu);
        (void)hipGetLastError();
        grid = cus;
        if (grid != 256) fprintf(stderr, "kernel_launch: %d CUs (built for 256)\n", grid);
    }
    if (grid < 0) return;
    if (hipMemsetAsync((char*)d_ws + WS_CTL, 0, CTL_ZERO_BYTES, stream) != hipSuccess) return;
    Args a; memset(&a, 0, sizeof(a));
    for (int i = 0; i < 20; ++i) a.in[i] = (const float*)d_in[i];
    a.out = (float*)d_out; a.ws = (unsigned char*)d_ws;
    for (int i = 0; i < 32; ++i) a.invf[i] = (float)pow(10000.0, -(double)i / 32.0);
#if MK_PER_PHASE
#ifndef PROBE_LAST
#define PROBE_LAST (NPH - 2)
#endif
    for (int p = 0; p < NPH; ++p) { if (p > PROBE_LAST && p != NPH - 1) continue;
#ifdef PROBE_ONLY_MASK
        if (p != NPH - 1 && !((PROBE_ONLY_MASK >> p) & 1)) continue;
#endif
 a.ph_lo = p; a.ph_hi = p + 1; a.li = (PROBE_LAST != NPH - 2) ? 1 : 0; hipLaunchKernelGGL(mk_fwd, dim3(PROBE_GRID1(p) ? 1 : grid), dim3(NWAVES * 64), LDS_BYTES, stream, a); }
#else
    a.ph_lo = 0; a.ph_hi = NPH; a.li = 0;
    hipLaunchKernelGGL(mk_fwd, dim3(grid), dim3(NWAVES * 64), LDS_BYTES, stream, a);
#endif
    const hipError_t le = hipPeekAtLastError();
    if (le != hipSuccess) fprintf(stderr, "kernel_launch: launch failed: %s\n", hipGetErrorName(le));
}
```

```cpp
#define MK_PER_PHASE 0
#define XRES_BF16 1
#define G3_FP8 1
#define ATT_QROPE 1
#define ST16_IMM 1
#define ROUTER_MFMA 1
#define ATT_CONV 2
#define ATT_SLOAD_RECOMP 1
#define ATT_RAWBAR 1
#define ATT_MLA_SK 1
#define THIN_MLP 1
#define CONV_LAST_STEP 1
#define THIN_RO 4
#define RPA 4
#define ADA_FAST 1
#define Y_FP8 1
#include <hip/hip_runtime.h>
#include <cstdio>
#include <cstdint>
#include <cstring>
#include <cmath>
namespace pg8 {
#define PG8_LAS __attribute__((address_space(3)))
typedef unsigned short bf16_t;
typedef short bf16x8 __attribute__((ext_vector_type(8)));
typedef float f32x4 __attribute__((ext_vector_type(4)));
typedef float f32x2 __attribute__((ext_vector_type(2)));
typedef unsigned u32x4 __attribute__((ext_vector_type(4)));
typedef int v4i_t __attribute__((ext_vector_type(4)));
typedef int v8i_t __attribute__((ext_vector_type(8)));
constexpr int BM = 256, BK = 64, HALF = 128, HTB = HALF * BK * 2  , STAGE_BYTES = 8 * HTB, NXCD = 8, WGM = 8;

__host__ __device__ __forceinline__ int lds_byte(int r, int c) { const int st = (r >> 4) * 2 + (c >> 5), rr = r & 15, cc = c & 31, ob = rr * 64 + cc * 2; return st * 1024 + (ob ^ (((ob >> 9) & 1) << 5)); }
__host__ __device__ __forceinline__ void stage_rc(int b, int& R, int& C) { const int st = b / 1024, sb = b % 1024, swz = sb ^ (((sb >> 9) & 1) << 5); R = (st >> 1) * 16 + swz / 64; C = (st & 1) * 32 + (swz % 64) / 2; }
__host__ __device__ __forceinline__ int perm32(int rho) { const int n = rho >> 4, i = rho & 15; return 8 * (i >> 2) + 4 * n + (i & 3); }

struct Unit { int pm, pn, pb, e, lt; };
struct Gemm { const void* A; const void* Bt; int Kb; };

__device__ __forceinline__ bool order_tile(int i, int G, int c, int nM, int nN, int& pm, int& pn) {
    const int nwg = nM * nN; const long L = (long)i * G + c; if (L >= nwg) return false;
    int wgid = (int)L; { const int q = nwg / NXCD, r = nwg % NXCD, xcd = wgid % NXCD, off = wgid / NXCD; wgid = (xcd < r ? xcd * (q + 1) : r * (q + 1) + (xcd - r) * q) + off; }
    const int nig = WGM * nN, gid = wgid / nig, fm = gid * WGM, gsz = (nM - fm) < WGM ? (nM - fm) : WGM;
    pm = fm + ((wgid % nig) % gsz); pn = (wgid % nig) / gsz; return true;
}
struct StaticOrder {
    int nM, nN, G, c;
    __device__ __forceinline__ void init(int M, int N, int G_, int c_) { nM = M / BM; nN = N / BM; G = G_; c = c_; }
    __device__ __forceinline__ bool next(int i, Unit& u) const { int pm, pn; if (!order_tile(i, G, c, nM, nN, pm, pn)) return false; u.pm = pm; u.pn = pn; u.pb = pn; u.e = 0; u.lt = 0; return true; }
};
struct MoeOrder {
    int nM, nN, G, c; const PG8_LAS int* ts;
    __device__ __forceinline__ bool next(int i, Unit& u) const {
        int pm, pn; if (i >= 10 || !order_tile(i, G, c, nM, nN, pm, pn)) return false;
        int e = 0;
#pragma unroll
        for (int j = 1; j < 16; ++j) e += (__builtin_amdgcn_readfirstlane(ts[j]) <= pm) ? 1 : 0;
        e = __builtin_amdgcn_readfirstlane(e); u.pm = pm; u.pn = pn; u.e = e; u.lt = pm - __builtin_amdgcn_readfirstlane(ts[e]); u.pb = e * nN + pn; return true;
    }
};
struct ALinear { __device__ __forceinline__ unsigned off(const Unit& u, int slot, int r, int Kb) const { return (unsigned)(u.pm * BM + r) * (unsigned)Kb; } };
struct APitch  { unsigned pitchB; __device__ __forceinline__ unsigned off(const Unit& u, int slot, int r, int K) const { return (unsigned)(u.pm * BM + r) * pitchB; } };
struct ATable  { const PG8_LAS unsigned* tab; __device__ __forceinline__ unsigned off(const Unit& u, int slot, int r, int K) const { return tab[slot * BM + r]; } };

typedef __bf16 bf16x2_t __attribute__((ext_vector_type(2)));
__device__ __forceinline__ unsigned cvt_pk_bf16(float lo, float hi) { const f32x2 v = {lo, hi}; return __builtin_bit_cast(unsigned, __builtin_convertvector(v, bf16x2_t)); }

typedef f32x4 Acc[2][2][4][2];

typedef __amdgpu_buffer_rsrc_t rsrc_t;
#define PG8_RSRC(p) __builtin_amdgcn_make_buffer_rsrc((void*)(p), 0, 0x7fffffff, 0x00020000)
#ifdef ST16_IMM
__device__ __forceinline__ void st16(rsrc_t r, int vo, int so, u32x4 v) { __builtin_amdgcn_raw_buffer_store_b128(v, r, vo + so, 0, 0); }
#else
__device__ __forceinline__ void st16(rsrc_t r, int vo, int so, u32x4 v) { __builtin_amdgcn_raw_buffer_store_b128(v, r, vo, so, 0); }
#endif
__device__ __forceinline__ f32x4 ld16f(rsrc_t r, int vo, int so) { return __builtin_bit_cast(f32x4, __builtin_amdgcn_raw_buffer_load_b128(r, vo, so, 0)); }
__device__ __forceinline__ float ld4f(rsrc_t r, int vo, int so) { return __uint_as_float(__builtin_amdgcn_raw_buffer_load_b32(r, vo, so, 0)); }
__device__ __forceinline__ u32x4 pack8(const f32x4 v0, const f32x4 v1) { u32x4 w; w.x = cvt_pk_bf16(v0[0], v0[1]); w.y = cvt_pk_bf16(v0[2], v0[3]); w.z = cvt_pk_bf16(v1[0], v1[1]); w.w = cvt_pk_bf16(v1[2], v1[3]); return w; }
struct EpiPlain {
    static constexpr bool PERM = true;
    bf16_t* O; int ldc;
    __device__ __forceinline__ void operator()(const Acc& acc, const Unit& u, int wr, int wc, int fr, int fq) const {
        const rsrc_t ro = PG8_RSRC(O); const int vo = (fr * ldc + wc * 32 + 8 * fq) * 2;
#pragma unroll
        for (int ai = 0; ai < 2; ++ai)
#pragma unroll
            for (int m = 0; m < 4; ++m) { const int so = ((u.pm * BM + wr * 64 + ai * HALF + m * 16) * ldc + u.pn * BM) * 2;
#pragma unroll
                for (int bj = 0; bj < 2; ++bj) st16(ro, vo, so + bj * HALF * 2, pack8(acc[ai][bj][m][0], acc[ai][bj][m][1])); }
    }
};
struct EpiQup {
    static constexpr bool PERM = true;
    bf16_t* O; const float* rstd;
    __device__ __forceinline__ void operator()(const Acc& acc, const Unit& u, int wr, int wc, int fr, int fq) const {
        const rsrc_t ro = PG8_RSRC(O), rr = PG8_RSRC(rstd);
        const int vo = (fr * 1536 + wc * 32 + 8 * fq) * 2;
        float rs[2][4];
#pragma unroll
        for (int ai = 0; ai < 2; ++ai)
#pragma unroll
            for (int m = 0; m < 4; ++m) rs[ai][m] = ld4f(rr, fr * 4, (u.pm * BM + wr * 64 + ai * HALF + m * 16) * 4);
#pragma unroll
        for (int ai = 0; ai < 2; ++ai)
#pragma unroll
            for (int m = 0; m < 4; ++m) { const int rowu = u.pm * BM + wr * 64 + ai * HALF + m * 16; const float r1 = rs[ai][m];
                const int so = (rowu * 1536 + u.pn * BM) * 2;
                st16(ro, vo, so, pack8(acc[ai][0][m][0] * r1, acc[ai][0][m][1] * r1));
                st16(ro, vo, so + HALF * 2, pack8(acc[ai][1][m][0] * r1, acc[ai][1][m][1] * r1)); }
    }
};
struct EpiKVup {
    static constexpr bool PERM = true;
    bf16_t* KF; bf16_t* VB; const float* rstd;
    __device__ __forceinline__ void operator()(const Acc& acc, const Unit& u, int wr, int wc, int fr, int fq) const {
        const rsrc_t rk = PG8_RSRC(KF), rv = PG8_RSRC(VB), rr = PG8_RSRC(rstd);
        const int c0 = wc * 32 + 8 * fq, vok = (fr * 1536 + c0) * 2, vov = (fr * 1024 + c0) * 2;
        float rs[2][4];
#pragma unroll
        for (int ai = 0; ai < 2; ++ai)
#pragma unroll
            for (int m = 0; m < 4; ++m) rs[ai][m] = ld4f(rr, fr * 4, (u.pm * BM + wr * 64 + ai * HALF + m * 16) * 4);
#pragma unroll
        for (int ai = 0; ai < 2; ++ai)
#pragma unroll
            for (int m = 0; m < 4; ++m) { const int rowu = u.pm * BM + wr * 64 + ai * HALF + m * 16; const float r1 = rs[ai][m];
                st16(rk, vok, (rowu * 1536 + u.pn * 192) * 2, pack8(acc[ai][0][m][0] * r1, acc[ai][0][m][1] * r1));
                st16(rv, vov, (rowu * 1024 + u.pn * 128) * 2, pack8(acc[ai][1][m][0] * r1, acc[ai][1][m][1] * r1)); }
    }
};
struct EpiResid {
    static constexpr bool PERM = false;
    const float* base; float* out; const float* gate; int ldc; int gld; float ascale;
    __device__ __forceinline__ void operator()(const Acc& acc, const Unit& u, int wr, int wc, int fr, int fq) const {
        const rsrc_t rb = PG8_RSRC(base), ro = PG8_RSRC(out), rg = PG8_RSRC(gate);
        const int cl = (wc * 32 + 4 * fq) * 4, vo = fr * ldc * 4 + cl;
        f32x4 gv[2][2];
#pragma unroll
        for (int bj = 0; bj < 2; ++bj)
#pragma unroll
            for (int n = 0; n < 2; ++n) gv[bj][n] = ld16f(rg, cl, (((u.pm * BM) >> 13) * gld + u.pn * BM + bj * HALF + n * 16) * 4) * ascale;
#pragma unroll
        for (int ai = 0; ai < 2; ++ai) {
            f32x4 bs[4][2][2];
#pragma unroll
            for (int m = 0; m < 4; ++m) { const int so = ((u.pm * BM + ai * HALF + wr * 64 + m * 16) * ldc + u.pn * BM) * 4;
#pragma unroll
                for (int bj = 0; bj < 2; ++bj)
#pragma unroll
                    for (int n = 0; n < 2; ++n) bs[m][bj][n] = ld16f(rb, vo, so + (bj * HALF + n * 16) * 4); }
#pragma unroll
            for (int m = 0; m < 4; ++m) { const int so = ((u.pm * BM + ai * HALF + wr * 64 + m * 16) * ldc + u.pn * BM) * 4;
#pragma unroll
                for (int bj = 0; bj < 2; ++bj)
#pragma unroll
                    for (int n = 0; n < 2; ++n) st16(ro, vo, so + (bj * HALF + n * 16) * 4, __builtin_bit_cast(u32x4, bs[m][bj][n] + gv[bj][n] * acc[ai][bj][m][n])); }
            asm volatile("s_waitcnt vmcnt(0)" ::: "memory");
        }
    }
};
struct EpiResidB {
    static constexpr bool PERM = true;
    const void* base; bf16_t* out; const float* gate; int gld; float ascale; int BASE_F32;
    __device__ __forceinline__ void operator()(const Acc& acc, const Unit& u, int wr, int wc, int fr, int fq) const {
        const rsrc_t rb = PG8_RSRC(base), ro = PG8_RSRC(out), rg = PG8_RSRC(gate);
        const int c0 = wc * 32 + 8 * fq;
        f32x4 gv[2][2];
#pragma unroll
        for (int bj = 0; bj < 2; ++bj)
#pragma unroll
            for (int n = 0; n < 2; ++n) gv[bj][n] = ld16f(rg, (c0 + 4 * n) * 4, (((u.pm * BM) >> 13) * gld + u.pn * BM + bj * HALF) * 4) * ascale;
#pragma unroll
        for (int ai = 0; ai < 2; ++ai) {
            f32x4 bs[4][2][2];
#pragma unroll
            for (int m = 0; m < 4; ++m) { const int rowu = u.pm * BM + ai * HALF + wr * 64 + m * 16;
#pragma unroll
                for (int bj = 0; bj < 2; ++bj) {
                    if (BASE_F32) { const int so = (rowu * 2048 + u.pn * BM + bj * HALF) * 4, vo = (fr * 2048 + c0) * 4;
                        bs[m][bj][0] = ld16f(rb, vo, so); bs[m][bj][1] = ld16f(rb, vo + 16, so); }
                    else { const int so = (rowu * 2048 + u.pn * BM + bj * HALF) * 2, vo = (fr * 2048 + c0) * 2;
                        const u32x4 w = __builtin_bit_cast(u32x4, __builtin_amdgcn_raw_buffer_load_b128(rb, vo, so, 0));
                        bs[m][bj][0] = (f32x4){__uint_as_float(w.x << 16), __uint_as_float(w.x & 0xffff0000u), __uint_as_float(w.y << 16), __uint_as_float(w.y & 0xffff0000u)};
                        bs[m][bj][1] = (f32x4){__uint_as_float(w.z << 16), __uint_as_float(w.z & 0xffff0000u), __uint_as_float(w.w << 16), __uint_as_float(w.w & 0xffff0000u)}; } } }
#pragma unroll
            for (int m = 0; m < 4; ++m) { const int rowu = u.pm * BM + ai * HALF + wr * 64 + m * 16;
#pragma unroll
                for (int bj = 0; bj < 2; ++bj) st16(ro, (fr * 2048 + c0) * 2, (rowu * 2048 + u.pn * BM + bj * HALF) * 2,
                                                    pack8(bs[m][bj][0] + gv[bj][0] * acc[ai][bj][m][0], bs[m][bj][1] + gv[bj][1] * acc[ai][bj][m][1])); }
            asm volatile("s_waitcnt vmcnt(0)" ::: "memory");
        }
    }
};
struct EpiSwiglu {
    static constexpr bool PERM = true;
    unsigned char* O; int ldc;
    __device__ __forceinline__ void operator()(const Acc& acc, const Unit& u, int wr, int wc, int fr, int fq) const {
        const rsrc_t ro = PG8_RSRC(O); const int vo = fr * ldc + wc * 32 + 8 * fq;
#pragma unroll
        for (int ai = 0; ai < 2; ++ai)
#pragma unroll
            for (int m = 0; m < 4; ++m) { const int so = (u.pm * BM + wr * 64 + ai * HALF + m * 16) * ldc + u.pn * HALF; float r[8];
#pragma unroll
                for (int n = 0; n < 2; ++n)
#pragma unroll
                    for (int k = 0; k < 4; ++k) { const float g = acc[ai][0][m][n][k] * (1.0f / 256.0f), up = acc[ai][1][m][n][k] * (1.0f / 256.0f);
                        r[n * 4 + k] = g * __builtin_amdgcn_rcpf(1.0f + __builtin_amdgcn_exp2f(-1.4426950408889634f * g)) * up; }
                int w0 = 0, w1 = 0;
                w0 = __builtin_amdgcn_cvt_pk_fp8_f32(r[0], r[1], w0, false); w0 = __builtin_amdgcn_cvt_pk_fp8_f32(r[2], r[3], w0, true);
                w1 = __builtin_amdgcn_cvt_pk_fp8_f32(r[4], r[5], w1, false); w1 = __builtin_amdgcn_cvt_pk_fp8_f32(r[6], r[7], w1, true);
                typedef unsigned u32x2_t __attribute__((ext_vector_type(2)));
                __builtin_amdgcn_raw_buffer_store_b64((u32x2_t){(unsigned)w0, (unsigned)w1}, ro, vo, so, 0); }
    }
};
struct EpiMoeDown {
    static constexpr bool PERM = true;
    bf16_t* Y; const int* rowidx; const float* aw; const unsigned* cnt;
    __device__ __forceinline__ void operator()(const Acc& acc, const Unit& u, int wr, int wc, int fr, int fq) const {
        const rsrc_t ry = PG8_RSRC(Y), ri = PG8_RSRC(rowidx), ra = PG8_RSRC(aw);
        const int nvalid = (int)cnt[u.e] - u.lt * BM; const int cb = (u.pn * BM + wc * 32 + 8 * fq) * 2;
        int idx[2][4]; float w8[2][4];
#pragma unroll
        for (int ai = 0; ai < 2; ++ai)
#pragma unroll
            for (int m = 0; m < 4; ++m) { const int ru = ai * HALF + wr * 64 + m * 16; idx[ai][m] = -1; w8[ai][m] = 0.f;
                if (ru + fr < nvalid) { idx[ai][m] = (int)__builtin_amdgcn_raw_buffer_load_b32(ri, fr * 4, (u.e * 32768 + u.lt * BM + ru) * 4, 0); w8[ai][m] = ld4f(ra, idx[ai][m] * 4, 0); } }
#pragma unroll
        for (int ai = 0; ai < 2; ++ai)
#pragma unroll
            for (int m = 0; m < 4; ++m) if (idx[ai][m] >= 0) { const int vo = idx[ai][m] * 4096 + cb; const float w1 = w8[ai][m] * (1.0f / 256.0f);
#pragma unroll
#ifdef Y_FP8
                for (int bj = 0; bj < 2; ++bj) { const f32x4 a0 = acc[ai][bj][m][0] * (w1 * 16.0f), a1 = acc[ai][bj][m][1] * (w1 * 16.0f);
                    int w0 = 0, w1i = 0; w0 = __builtin_amdgcn_cvt_pk_fp8_f32(a0[0], a0[1], w0, false); w0 = __builtin_amdgcn_cvt_pk_fp8_f32(a0[2], a0[3], w0, true);
                    w1i = __builtin_amdgcn_cvt_pk_fp8_f32(a1[0], a1[1], w1i, false); w1i = __builtin_amdgcn_cvt_pk_fp8_f32(a1[2], a1[3], w1i, true);
                    typedef unsigned u32x2y_t __attribute__((ext_vector_type(2)));
                    __builtin_amdgcn_raw_buffer_store_b64((u32x2y_t){(unsigned)w0, (unsigned)w1i}, ry, idx[ai][m] * 2048 + (cb >> 1), bj * HALF, 0); } }
#else
                for (int bj = 0; bj < 2; ++bj) st16(ry, vo, bj * HALF * 2, pack8(acc[ai][bj][m][0] * w1, acc[ai][bj][m][1] * w1)); }
#endif
    }
};

template <class Epi, class Sched, class AOff, bool FP8 = false>
__device__ __forceinline__ void gemm_phase(PG8_LAS unsigned char* lds, const Gemm g, const Sched& S, const AOff& AO, const Epi& E, int tid_in) {
    int tid = tid_in; asm volatile("" : "+v"(tid));
    const int wid = __builtin_amdgcn_readfirstlane(tid >> 6), lane = tid & 63, wr = wid >> 2, wc = wid & 3, fr = lane & 15, fq = lane >> 4;
    int K = g.Kb; asm volatile("" : "+s"(K));
    const int nt = K / (BK * 2);
    int Ra[2], Ca[2]; unsigned voffB[2];
#pragma unroll
    for (int i = 0; i < 2; ++i) { int R, C; stage_rc(tid * 16 + i * 8192, R, C); const int Rb = Epi::PERM ? ((R & ~31) + perm32(R & 31)) : R;
        Ra[i] = R; Ca[i] = C * 2; voffB[i] = (unsigned)(Rb * K + C * 2); }
    const size_t kstep = (size_t)(BK * 2);
    const size_t hstep = (size_t)HALF * K;
    const size_t tstep = 2 * hstep;
    const unsigned ldsw = (unsigned)wid * 1024u;
    const unsigned lds0 = (unsigned)(uintptr_t)lds;
    const int aoff = lds_byte(wr * 64 + fr, fq * 8), boff = lds_byte(wc * 32 + fr, fq * 8);
#define PG8_SA(b, h) (((b) * 2 + (h)) * HTB)
#define PG8_SB(b, h) ((4 + (b) * 2 + (h)) * HTB)
#define PG8_STAGE(bufoff, gbase, voff) do { _Pragma("unroll") for (int _i = 0; _i < 2; ++_i) { unsigned keep_; \
        asm volatile("s_mov_b32 %0, m0\n\ts_mov_b32 m0, %2\n\ts_nop 0\n\tglobal_load_lds_dwordx4 %1, %3\n\ts_mov_b32 m0, %0" : "=&s"(keep_) \
            : "v"((voff)[_i]), "s"((unsigned)__builtin_amdgcn_readfirstlane((int)(lds0 + (bufoff) + ldsw + _i * 8192))), "s"((const void*)(gbase)) : "memory"); } } while (0)
#define PG8_LD8(addr) __builtin_shufflevector(*(const PG8_LAS v4i_t*)(addr), *(const PG8_LAS v4i_t*)((addr) + 1024), 0, 1, 2, 3, 4, 5, 6, 7)
#define PG8_LDA(dst, b, h) do { _Pragma("unroll") for (int m = 0; m < 4; ++m) dst[m] = PG8_LD8(lds + PG8_SA(b, h) + aoff + m * 2048); } while (0)
#define PG8_LDB(dst, b, h) do { _Pragma("unroll") for (int n = 0; n < 2; ++n) dst[n] = PG8_LD8(lds + PG8_SB(b, h) + boff + n * 2048); } while (0)
#define PG8_HALF(x, k) __builtin_bit_cast(bf16x8, __builtin_shufflevector(x, x, 4 * (k), 4 * (k) + 1, 4 * (k) + 2, 4 * (k) + 3))
#define PG8_MMA(ai, bj, At, Bt) do { __builtin_amdgcn_s_setprio(1); _Pragma("unroll") for (int m = 0; m < 4; ++m) _Pragma("unroll") for (int n = 0; n < 2; ++n) { \
        if constexpr (FP8) asm volatile("v_mfma_scale_f32_16x16x128_f8f6f4 %0, %1, %2, %0, %3, %3 op_sel_hi:[0,0,0]" : "+v"(acc[ai][bj][m][n]) : "v"(Bt[n]), "v"(At[m]), "v"(sc1_));   \
        else { acc[ai][bj][m][n] = __builtin_amdgcn_mfma_f32_16x16x32_bf16(PG8_HALF(Bt[n], 0), PG8_HALF(At[m], 0), acc[ai][bj][m][n], 0, 0, 0); \
               acc[ai][bj][m][n] = __builtin_amdgcn_mfma_f32_16x16x32_bf16(PG8_HALF(Bt[n], 1), PG8_HALF(At[m], 1), acc[ai][bj][m][n], 0, 0, 0); } } \
        __builtin_amdgcn_s_setprio(0); } while (0)
#define PG8_WAIT_V(n) asm volatile("s_waitcnt vmcnt(" #n ")" ::: "memory")
#define PG8_WAIT_L(n) asm volatile("s_waitcnt lgkmcnt(" #n ")" ::: "memory")
#define PG8_BAR __builtin_amdgcn_s_barrier()
#define PG8_SCHED __builtin_amdgcn_sched_barrier(0)
#define PG8_AOFF(dst, u, slot) do { _Pragma("unroll") for (int _h = 0; _h < 2; ++_h) _Pragma("unroll") for (int _i = 0; _i < 2; ++_i) dst[_h][_i] = AO.off(u, slot, _h * HALF + Ra[_i], K) + (unsigned)Ca[_i]; } while (0)
    Unit cur, nxt; int ui = 0;
    if (!S.next(0, cur)) return;
    Acc acc;
#pragma unroll
    for (int a = 0; a < 2; ++a)
#pragma unroll
        for (int b = 0; b < 2; ++b)
#pragma unroll
            for (int m = 0; m < 4; ++m)
#pragma unroll
                for (int n = 0; n < 2; ++n) acc[a][b][m][n] = (f32x4){0.f, 0.f, 0.f, 0.f};
    v8i_t At[4], B0[2], B1[2];
    int sc1_ = 0x7F7F7F7F; asm volatile("" : "+v"(sc1_));
    unsigned aoC[2][2];
    PG8_AOFF(aoC, cur, 0);
    const char* gA = (const char*)g.A; const char* gB = (const char*)g.Bt;
    asm volatile("" : "+s"(gA), "+s"(gB));
    const char* cB = gB + (size_t)cur.pb * tstep;
    PG8_STAGE(PG8_SB(0, 0), cB, voffB); PG8_STAGE(PG8_SB(0, 1), cB + hstep, voffB); PG8_STAGE(PG8_SA(0, 0), gA, aoC[0]); PG8_STAGE(PG8_SA(0, 1), gA, aoC[1]);
    if (wr == 1) PG8_BAR;
    PG8_WAIT_V(2); PG8_BAR;
    PG8_STAGE(PG8_SB(1, 0), cB + kstep, voffB); PG8_STAGE(PG8_SA(1, 0), gA + kstep, aoC[0]); PG8_STAGE(PG8_SB(1, 1), cB + hstep + kstep, voffB);
    PG8_WAIT_V(6); PG8_BAR;
    for (;;) {
        const bool has_next = S.next(ui + 1, nxt);
        const char* nB = has_next ? gB + (size_t)nxt.pb * tstep : cB;
        for (int t = 0; t < nt; t += 2) {
            const bool last = (t == nt - 2);
            const char* a1 = gA + (size_t)(t + 1) * kstep;
            const char* a2 = last ? gA : gA + (size_t)(t + 2) * kstep; const char* b2 = last ? nB : cB + (size_t)(t + 2) * kstep;
            const char* a3 = a2 + kstep; const char* b3 = b2 + kstep;
            unsigned ao2[2][2];
            if (last && has_next) { PG8_AOFF(ao2, nxt, ui + 1); }
            else {
#pragma unroll
                for (int _h = 0; _h < 2; ++_h)
#pragma unroll
                    for (int _i = 0; _i < 2; ++_i) ao2[_h][_i] = aoC[_h][_i]; }
            PG8_LDB(B0, 0, 0); PG8_LDB(B1, 0, 1); PG8_SCHED; PG8_LDA(At, 0, 0); PG8_STAGE(PG8_SA(1, 1), a1, aoC[1]);
            PG8_WAIT_V(8); PG8_WAIT_L(0); PG8_BAR; PG8_MMA(0, 0, At, B0); PG8_MMA(0, 1, At, B1); PG8_BAR; PG8_SCHED;
            PG8_LDA(At, 0, 1); PG8_STAGE(PG8_SB(0, 0), b2, voffB); PG8_STAGE(PG8_SB(0, 1), b2 + hstep, voffB); PG8_STAGE(PG8_SA(0, 0), a2, ao2[0]);
            PG8_WAIT_V(8); PG8_WAIT_L(0); PG8_BAR; PG8_MMA(1, 0, At, B0); PG8_MMA(1, 1, At, B1); PG8_BAR; PG8_SCHED;
            PG8_LDB(B0, 1, 0); PG8_LDB(B1, 1, 1); PG8_SCHED; PG8_LDA(At, 1, 0); PG8_STAGE(PG8_SA(0, 1), a2, ao2[1]);
            PG8_WAIT_V(8); PG8_WAIT_L(0); PG8_BAR; PG8_MMA(0, 0, At, B0); PG8_MMA(0, 1, At, B1); PG8_BAR; PG8_SCHED;
            PG8_LDA(At, 1, 1); PG8_STAGE(PG8_SB(1, 0), b3, voffB); PG8_STAGE(PG8_SB(1, 1), b3 + hstep, voffB); PG8_STAGE(PG8_SA(1, 0), a3, ao2[0]);
            PG8_WAIT_V(8); PG8_WAIT_L(0); PG8_BAR; PG8_MMA(1, 0, At, B0); PG8_MMA(1, 1, At, B1); PG8_BAR; PG8_SCHED;
        }
        if (wr == 0) PG8_BAR;
        E(acc, cur, wr, wc, fr, fq);
        if (!has_next) break;
#pragma unroll
        for (int a = 0; a < 2; ++a)
#pragma unroll
            for (int b = 0; b < 2; ++b)
#pragma unroll
                for (int m = 0; m < 4; ++m)
#pragma unroll
                    for (int n = 0; n < 2; ++n) acc[a][b][m][n] = (f32x4){0.f, 0.f, 0.f, 0.f};
        cur = nxt; cB = nB; ++ui;
        PG8_AOFF(aoC, cur, ui);
        if (wr == 1) PG8_BAR;
    }
    PG8_WAIT_V(0);
    PG8_BAR;
#undef PG8_SA
#undef PG8_SB
#undef PG8_STAGE
#undef PG8_LDA
#undef PG8_LDB
#undef PG8_MMA
#undef PG8_LD8
#undef PG8_HALF
#undef PG8_WAIT_V
#undef PG8_WAIT_L
#undef PG8_BAR
#undef PG8_SCHED
#undef PG8_AOFF
}
}
namespace att {
typedef unsigned short bf16;
typedef short bf16x8 __attribute__((ext_vector_type(8)));
typedef short s16x4 __attribute__((ext_vector_type(4)));
typedef float f32x16 __attribute__((ext_vector_type(16)));
typedef float f32x4 __attribute__((ext_vector_type(4)));
typedef unsigned u32x4 __attribute__((ext_vector_type(4)));
constexpr int NW = 8, QBLK = 32, KVBLK = 64, QB = NW * QBLK, DV = 128;
constexpr float THR = 8.f;
constexpr int SHM_V = KVBLK * DV * 2;
template <int DQK> struct Cfg { static constexpr int NKC = DQK / 8, KCH = NKC / 8, KPITCH = DQK * 2, SHM_K = KVBLK * KPITCH, NQF = DQK / 16, LDS_BYTES = 2 * SHM_V + 2 * SHM_K + NW * 64 * 4; };
#define SBAR() __builtin_amdgcn_sched_barrier(0)
__device__ __forceinline__ int v_st(int k, int c) { const int kk = (k & ~0xC) | ((k & 4) << 1) | ((k & 8) >> 1); return ((kk >> 3) * 4 + (c >> 5)) * 512 + ((kk & 7) * 32 + (c & 31)) * 2; }
__device__ __forceinline__ int v_rd_base(int lane) { return ((lane & 3) << 3) | (((lane >> 2) & 3) << 6) | (((lane >> 4) & 1) << 5) | (((lane >> 5) & 1) << 8); }
constexpr int v_rd_off(int d0, int ks, int half) { return d0 * 512 + ks * 4096 + half * 2048; }
__device__ __forceinline__ int crow(int r, int hi) { return (r & 3) + 8 * (r >> 2) + 4 * hi; }
__device__ __forceinline__ unsigned cvtpk(float lo, float hi) { return pg8::cvt_pk_bf16(lo, hi); }
__device__ __forceinline__ bf16x8 load8(const bf16* p) { return *reinterpret_cast<const bf16x8*>(p); }
__device__ __forceinline__ void mask_tile(f32x16& p0, f32x16& p1, int dq, unsigned W) {
    const float NEG = -__builtin_inff();
#pragma unroll
    for (int r = 0; r < 16; ++r) { const int c = (r & 3) + 8 * (r >> 2);
        if ((unsigned)(dq - c) >= W) p0[r] = NEG;
        if ((unsigned)(dq - c - 32) >= W) p1[r] = NEG; }
}
__device__ __forceinline__ void partialSM(f32x16& p0, f32x16& p1, float& m_reg, float& mn, float& alpha, float scale) {
    float pmax = p0[0];
#pragma unroll
    for (int r = 1; r < 16; ++r) pmax = fmaxf(pmax, p0[r]);
#pragma unroll
    for (int r = 0; r < 16; ++r) pmax = fmaxf(pmax, p1[r]);
    { auto rr = __builtin_amdgcn_permlane32_swap(__float_as_uint(pmax), __float_as_uint(pmax), false, false);
      pmax = fmaxf(__uint_as_float(rr[0]), __uint_as_float(rr[1])); }
    const float C2 = 1.4426950408889634f * scale;
    if (__builtin_expect(__all((pmax - m_reg) * scale <= THR), 1)) { mn = m_reg; alpha = 1.f; }
    else { mn = fmaxf(m_reg, pmax); alpha = __builtin_amdgcn_exp2f((m_reg - mn) * C2); m_reg = mn; }
    const float mnL = -mn * C2;
#pragma unroll
    for (int r = 0; r < 16; ++r) p0[r] = fmaf(p0[r], C2, mnL);
#pragma unroll
    for (int r = 0; r < 16; ++r) p1[r] = fmaf(p1[r], C2, mnL);
#pragma unroll
    for (int r = 0; r < 16; ++r) p0[r] = __builtin_amdgcn_exp2f(p0[r]);
}
__device__ __forceinline__ void finishSM(f32x16& p0, f32x16& p1, float alpha, float& l_reg, bf16x8& pa0, bf16x8& pa1, bf16x8& pa2, bf16x8& pa3) {
#pragma unroll
    for (int r = 0; r < 16; ++r) p1[r] = __builtin_amdgcn_exp2f(p1[r]);
    float ps = 0;
#pragma unroll
    for (int r = 0; r < 16; ++r) ps += p0[r];
#pragma unroll
    for (int r = 0; r < 16; ++r) ps += p1[r];
    { auto rr = __builtin_amdgcn_permlane32_swap(__float_as_uint(ps), __float_as_uint(ps), false, false);
      ps = __uint_as_float(rr[0]) + __uint_as_float(rr[1]); }
    l_reg = l_reg * alpha + ps;
#define PK4(P, B_, OUT) do { unsigned a0 = cvtpk(P[B_+0], P[B_+1]), a1 = cvtpk(P[B_+2], P[B_+3]);                          \
        unsigned b0 = cvtpk(P[B_+4], P[B_+5]), b1 = cvtpk(P[B_+6], P[B_+7]);                                             \
        auto r0 = __builtin_amdgcn_permlane32_swap(a0, b0, false, false); auto r1 = __builtin_amdgcn_permlane32_swap(a1, b1, false, false); \
        u32x4 w = {r0[0], r1[0], r0[1], r1[1]}; OUT = *reinterpret_cast<bf16x8*>(&w); } while (0)
    PK4(p0, 0, pa0); PK4(p0, 8, pa1); PK4(p1, 0, pa2); PK4(p1, 8, pa3);
#undef PK4
}
template <int KB, bool SK, int DQK, bool DIL>
__device__ __forceinline__ void qkt(f32x16& p0, f32x16& p1, const char* K_lds, int r32, int hi, const bf16x8* qr, bool act, float beta, int dq) {
    typedef Cfg<DQK> C;
    if (SK && !act) { const float NEG = -__builtin_inff();
#pragma unroll
        for (int r = 0; r < 16; ++r) { p0[r] = NEG; p1[r] = NEG; } return; }
    if constexpr (DIL) { const float b0 = -beta * (float)dq;
#pragma unroll
        for (int r = 0; r < 16; ++r) { const int c = (r & 3) + 8 * (r >> 2); p0[r] = fmaf(beta, (float)c, b0); p1[r] = fmaf(beta, (float)(c + 32), b0); } }
    else { p0 = f32x16{}; p1 = f32x16{}; }
    const char* kb[4];
#pragma unroll
    for (int dd = 0; dd < 4; ++dd) { const int colB = (dd * 16 + hi * 8) * 2; kb[dd] = K_lds + KB * C::SHM_K + r32 * C::KPITCH + (colB ^ ((r32 & 7) << 4)); }
#pragma unroll
    for (int d0 = 0; d0 < C::NQF; ++d0) { const char* a = kb[d0 & 3] + (d0 >> 2) * 128;
        bf16x8 b0 = *reinterpret_cast<const bf16x8*>(a);
        bf16x8 b1 = *reinterpret_cast<const bf16x8*>(a + 32 * C::KPITCH);
        p0 = __builtin_amdgcn_mfma_f32_32x32x16_bf16(b0, qr[d0], p0, 0, 0, 0);
        p1 = __builtin_amdgcn_mfma_f32_32x32x16_bf16(b1, qr[d0], p1, 0, 0, 0);
#ifndef ATT_NO_QKT_SBAR
        if ((d0 & 3) == 3) SBAR();
#endif
    }
}
#ifdef ATT_PV_PIPE
template <int VB, bool SK>
__device__ __forceinline__ void pv_tile(f32x16* o, int vb0, bf16x8 pa0, bf16x8 pa1, bf16x8 pa2, bf16x8 pa3, bool act) {
    if (SK && !act) return;
#define TRRD(dst, off) asm volatile("ds_read_b64_tr_b16 %0, %1 offset:%2" : "=&v"(dst) : "v"(vb0), "i"(off) : "memory")
#define PV_RD(S_, d0) do { constexpr int b_ = VB * SHM_V + v_rd_off(d0, 0, 0); \
        TRRD(S_##l0, b_); TRRD(S_##h0, b_ + 2048); TRRD(S_##l1, b_ + 4096); TRRD(S_##h1, b_ + 6144); TRRD(S_##l2, b_ + 8192); TRRD(S_##h2, b_ + 10240); TRRD(S_##l3, b_ + 12288); TRRD(S_##h3, b_ + 14336); } while (0)
#define PV_MM(S_, d0) do { \
        o[d0] = __builtin_amdgcn_mfma_f32_32x32x16_bf16(pa0, (bf16x8){S_##l0[0], S_##l0[1], S_##l0[2], S_##l0[3], S_##h0[0], S_##h0[1], S_##h0[2], S_##h0[3]}, o[d0], 0, 0, 0);   \
        o[d0] = __builtin_amdgcn_mfma_f32_32x32x16_bf16(pa1, (bf16x8){S_##l1[0], S_##l1[1], S_##l1[2], S_##l1[3], S_##h1[0], S_##h1[1], S_##h1[2], S_##h1[3]}, o[d0], 0, 0, 0);   \
        o[d0] = __builtin_amdgcn_mfma_f32_32x32x16_bf16(pa2, (bf16x8){S_##l2[0], S_##l2[1], S_##l2[2], S_##l2[3], S_##h2[0], S_##h2[1], S_##h2[2], S_##h2[3]}, o[d0], 0, 0, 0);   \
        o[d0] = __builtin_amdgcn_mfma_f32_32x32x16_bf16(pa3, (bf16x8){S_##l3[0], S_##l3[1], S_##l3[2], S_##l3[3], S_##h3[0], S_##h3[1], S_##h3[2], S_##h3[3]}, o[d0], 0, 0, 0); } while (0)
#define PV_W8() do { asm volatile("s_waitcnt lgkmcnt(8)" ::: "memory"); SBAR(); } while (0)
#define PV_W0() do { asm volatile("s_waitcnt lgkmcnt(0)" ::: "memory"); SBAR(); } while (0)
    s16x4 al0, al1, al2, al3, ah0, ah1, ah2, ah3, bl0, bl1, bl2, bl3, bh0, bh1, bh2, bh3;
    PV_RD(a, 0); PV_RD(b, 1); PV_W8(); PV_MM(a, 0); SBAR();
    PV_RD(a, 2); PV_W8(); PV_MM(b, 1); SBAR();
    PV_RD(b, 3); PV_W8(); PV_MM(a, 2); SBAR();
    PV_W0(); PV_MM(b, 3);
#undef PV_RD
#undef PV_MM
#undef PV_W8
#undef PV_W0
#undef TRRD
}
#else
template <int VB, bool SK>
__device__ __forceinline__ void pv_tile(f32x16* o, int vb0, bf16x8 pa0, bf16x8 pa1, bf16x8 pa2, bf16x8 pa3, bool act) {
    if (SK && !act) return;
#define TRRD(dst, off) asm volatile("ds_read_b64_tr_b16 %0, %1 offset:%2" : "=&v"(dst) : "v"(vb0), "i"(off) : "memory")
#define PV_D0(d0) do { s16x4 l0, l1, l2, l3, h0, h1, h2, h3; constexpr int b_ = VB * SHM_V + v_rd_off(d0, 0, 0); \
        TRRD(l0, b_); TRRD(h0, b_ + 2048); TRRD(l1, b_ + 4096); TRRD(h1, b_ + 6144); TRRD(l2, b_ + 8192); TRRD(h2, b_ + 10240); TRRD(l3, b_ + 12288); TRRD(h3, b_ + 14336); \
        asm volatile("s_waitcnt lgkmcnt(0)" ::: "memory"); SBAR();   \
        o[d0] = __builtin_amdgcn_mfma_f32_32x32x16_bf16(pa0, (bf16x8){l0[0], l0[1], l0[2], l0[3], h0[0], h0[1], h0[2], h0[3]}, o[d0], 0, 0, 0);   \
        o[d0] = __builtin_amdgcn_mfma_f32_32x32x16_bf16(pa1, (bf16x8){l1[0], l1[1], l1[2], l1[3], h1[0], h1[1], h1[2], h1[3]}, o[d0], 0, 0, 0);   \
        o[d0] = __builtin_amdgcn_mfma_f32_32x32x16_bf16(pa2, (bf16x8){l2[0], l2[1], l2[2], l2[3], h2[0], h2[1], h2[2], h2[3]}, o[d0], 0, 0, 0);   \
        o[d0] = __builtin_amdgcn_mfma_f32_32x32x16_bf16(pa3, (bf16x8){l3[0], l3[1], l3[2], l3[3], h3[0], h3[1], h3[2], h3[3]}, o[d0], 0, 0, 0); } while (0)
    PV_D0(0); PV_D0(1); PV_D0(2); PV_D0(3);
#undef PV_D0
#undef TRRD
}
#endif

struct Blk { unsigned qo, ko, vo, oo, lo; int P0, rate; float beta; };
constexpr int PVAR = 0;
#define QS_(B) (DIL ? ((PVAR & 4) ? 128 : (B).rate * 4096) : 1536)
#define KS_(B) (DIL ? ((PVAR & 2) ? 128 : (B).rate * 4096) : 1536)
#define VS_(B) (DIL ? ((PVAR & 2) ? 128 : (B).rate * 4096) : 1024)
#define OS_(B) (DIL ? (B).rate * 1024 : 1024)
#define LS_(B) ((B).rate * 8)
#define SKV_(B) (DIL ? 8192 / (B).rate : 8192)
#define W_(B) (DIL ? 129 : (1 << 30))
#define SCALE_ (DIL ? 0.08838834764831845f : 0.07216878364870322f)
template <int DQK> struct Seam { bf16x8 qr[Cfg<DQK>::NQF]; bf16x8 st_v0, st_v1; bf16x8 st_k[Cfg<DQK>::KCH]; unsigned p_oo = 0; int p_rb = 0, p_so0 = 0, p_on = 0; float cv[4], cw[4]; int cv_j = 0, cv_q = 0, cl_j = 0, cl_q = 0; f32x4 rt[8]; float cvf[32]; int cv_pend = 0; };
__device__ __forceinline__ int swa_jlo(int P0, int W) { const int lowk = P0 - W + 1; return lowk > 0 ? lowk / KVBLK : 0; }

#define VMW() asm volatile("s_waitcnt vmcnt(0)" ::: "memory")
#ifdef ATT_RAWBAR
#define A_STEPBAR() do { asm volatile("s_waitcnt lgkmcnt(0)" ::: "memory"); __builtin_amdgcn_s_barrier(); asm volatile("" ::: "memory"); } while (0)
#else
#define A_STEPBAR() __syncthreads()
#endif
#define VMWN(n) asm volatile("s_waitcnt vmcnt(%0)" :: "i"(n) : "memory")
#define A_RSRC(p) __builtin_amdgcn_make_buffer_rsrc((void*)(p), 0, 0x7fffffff, 0x00020000)
#define A_BLD(rs, vo, so) __builtin_bit_cast(bf16x8, __builtin_amdgcn_raw_buffer_load_b128((rs), (int)(vo), (int)(so), 0))
#ifdef ATT_SLOAD_RECOMP
#define A_SLOAD(B_, k0) do { const __amdgpu_buffer_rsrc_t rv_ = A_RSRC(wsb + (B_).vo), rk_ = A_RSRC(wsb + (B_).ko); const int sov_ = (k0) * VS_(B_) * 2, sok_ = (k0) * KS_(B_) * 2; \
        int t_ = tid; asm volatile("" : "+v"(t_)); const int sr_ = t_ >> 4, sc_ = (t_ & 15) * 8; \
        S.st_v0 = A_BLD(rv_, (sr_ * VS_(B_) + sc_) * 2, sov_); S.st_v1 = A_BLD(rv_, ((32 + sr_) * VS_(B_) + sc_) * 2, sov_); \
        _Pragma("unroll") for (int j_ = 0; j_ < C::KCH; ++j_) { const int q_ = t_ + 512 * j_; S.st_k[j_] = A_BLD(rk_, ((q_ / C::NKC) * KS_(B_) + (q_ % C::NKC) * 8) * 2, sok_); } } while (0)
#else
#define A_SLOAD(B_, k0) do { const __amdgpu_buffer_rsrc_t rv_ = A_RSRC(wsb + (B_).vo), rk_ = A_RSRC(wsb + (B_).ko); const int sov_ = (k0) * VS_(B_) * 2, sok_ = (k0) * KS_(B_) * 2; \
        S.st_v0 = A_BLD(rv_, (sr * VS_(B_) + sc) * 2, sov_); S.st_v1 = A_BLD(rv_, ((32 + sr) * VS_(B_) + sc) * 2, sov_); \
        _Pragma("unroll") for (int j_ = 0; j_ < C::KCH; ++j_) S.st_k[j_] = A_BLD(rk_, (krow[j_] * KS_(B_) + kcol[j_]) * 2, sok_); } while (0)
#endif
#define A_QLOAD(B_) do { const __amdgpu_buffer_rsrc_t rq_ = A_RSRC(wsb + (B_).qo); const int soq_ = ((B_).P0 + wid * QBLK) * QS_(B_) * 2; const int qo_ = r32 * QS_(B_) * 2 + hi * 16; \
        _Pragma("unroll") for (int d0 = 0; d0 < C::NQF; ++d0) S.qr[d0] = A_BLD(rq_, qo_ + d0 * 32, soq_); } while (0)
#define A_SWRITE_K(bf) do { _Pragma("unroll") for (int j_ = 0; j_ < C::KCH; ++j_) *(bf16x8*)(K_lds + (bf) * C::SHM_K + kws[j_]) = S.st_k[j_]; } while (0)
#define A_SWRITE_V(bf) do { *(bf16x8*)(V_lds + (bf) * SHM_V + vst0) = S.st_v0; *(bf16x8*)(V_lds + (bf) * SHM_V + vst1) = S.st_v1; } while (0)
#define A_STAGE_IDX() const int sr = tid >> 4, sc = (tid & 15) * 8; int krow[C::KCH], kcol[C::KCH], kws[C::KCH]; \
        _Pragma("unroll") for (int j_ = 0; j_ < C::KCH; ++j_) { const int q_ = tid + 512 * j_; krow[j_] = q_ / C::NKC; kcol[j_] = (q_ % C::NKC) * 8; kws[j_] = krow[j_] * C::KPITCH + ((kcol[j_] * 2) ^ ((krow[j_] & 7) << 4)); }

__device__ __forceinline__ void store_o_staged(const f32x16* o, const float* rli, char* stg, __amdgpu_buffer_rsrc_t ro_, int rowbytes, int so0_, int lane) {
    const int r32 = lane & 31, hi = lane >> 5, odd = lane & 1, g = odd | (hi << 1);
    char* wb = stg + (odd + 4 * hi) * 256 + (r32 >> 1) * 4;
    char* wa[4];
#pragma unroll
    for (int d0 = 0; d0 < 4; ++d0) wa[d0] = wb + ((d0 ^ g) << 6);
    const int lr = lane >> 4, ch = lane & 15, sp = ch >> 2, gl = lr & 1;
    const char* rb_e = stg + lr * 256 + ((sp ^ gl) << 6) + (lane & 3) * 16;
    const char* rb_o = stg + lr * 256 + ((sp ^ (gl | 2)) << 6) + (lane & 3) * 16;
    const int voff = lr * rowbytes + ch * 16;
#pragma unroll
    for (int h = 0; h < 2; ++h) {
#pragma unroll
        for (int rp = 0; rp < 4; ++rp) { const int r = 8 * h + 2 * rp, Rl = (r & 3) + 8 * ((r >> 2) & 1);
#pragma unroll
            for (int d0 = 0; d0 < 4; ++d0) { const float v0 = o[d0][r] * rli[r], v1 = o[d0][r + 1] * rli[r + 1];
                const float send = odd ? v0 : v1;
                const float recv = __int_as_float(__builtin_amdgcn_update_dpp(0, __float_as_int(send), 0xB1, 0xF, 0xF, true));
                *reinterpret_cast<unsigned*>(wa[d0] + Rl * 256) = cvtpk(odd ? recv : v0, odd ? v1 : recv); } }
        u32x4 d_[4];
#pragma unroll
        for (int i = 0; i < 4; ++i) d_[i] = *reinterpret_cast<const u32x4*>(((i & 1) ? rb_o : rb_e) + i * 1024);
#pragma unroll
        for (int i = 0; i < 4; ++i) __builtin_amdgcn_raw_buffer_store_b128(d_[i], ro_, voff + so0_ + (16 * h + 4 * i) * rowbytes, 0, 0);
    }
}
constexpr int DEFER_STG = 65536, DEFER_WS = 131072 + 512;
__device__ __forceinline__ void stage_write(const f32x16* o, const float* rli, char* stg, int lane) {
    const int r32 = lane & 31, hi = lane >> 5, odd = lane & 1, g = odd | (hi << 1);
    char* wb = stg + (odd + 4 * hi) * 256 + (r32 >> 1) * 4;
    char* wa[4];
#pragma unroll
    for (int d0 = 0; d0 < 4; ++d0) wa[d0] = wb + ((d0 ^ g) << 6);
#pragma unroll
    for (int h = 0; h < 2; ++h)
#pragma unroll
        for (int rp = 0; rp < 4; ++rp) { const int r = 8 * h + 2 * rp, Rl = (r & 3) + 8 * ((r >> 2) & 1);
#pragma unroll
            for (int d0 = 0; d0 < 4; ++d0) { const float v0 = o[d0][r] * rli[r], v1 = o[d0][r + 1] * rli[r + 1];
                const float send = odd ? v0 : v1;
                const float recv = __int_as_float(__builtin_amdgcn_update_dpp(0, __float_as_int(send), 0xB1, 0xF, 0xF, true));
                *reinterpret_cast<unsigned*>(wa[d0] + h * 4096 + Rl * 256) = cvtpk(odd ? recv : v0, odd ? v1 : recv); } }
}
__device__ __forceinline__ void flush_piece(const char* stg, int p, const char* obase, int rowbytes, int so0, int lane) {
    const int lr = lane >> 4, ch = lane & 15, sp = ch >> 2, g = (lr & 1) | ((p & 1) << 1);
    const u32x4 d = *reinterpret_cast<const u32x4*>(stg + p * 1024 + lr * 256 + ((sp ^ g) << 6) + (lane & 3) * 16);
    __builtin_amdgcn_raw_buffer_store_b128(d, A_RSRC(obase), lr * rowbytes + ch * 16 + so0 + 4 * p * rowbytes, 0, 0);
}
struct ConvCtx { const float* eg; const float* eu; const float* ed; unsigned char* w13; unsigned char* w2; int gw; };
constexpr int CONV_SCR = 86016, CONV_NJ = 48;
#ifndef CONV_AUX
#define CONV_AUX 2
#endif
struct ConvItem { const float* src; unsigned char* dst; int ldw, kd; };
__device__ __forceinline__ ConvItem conv_decode(const ConvCtx& X, int j) {
    const int q = X.gw + 2048 * j, e = q / 6144, r = q - e * 6144, m = r >> 11, r2 = r & 2047;
    ConvItem I;
    if (m < 2) { const int kb = r2 >> 6, nb = r2 & 63, n0 = nb * 16; I.ldw = 1024; I.kd = 2048;
        I.src = (m == 0 ? X.eg : X.eu) + (size_t)e * (2048 * 1024) + (size_t)kb * (64 * 1024) + n0;
        I.dst = X.w13 + (size_t)e * (2048 * 2048) + (size_t)((n0 >> 7) * 256 + (m == 1 ? 128 : 0) + (n0 & 127)) * 2048 + kb * 64; }
    else { const int kb = r2 >> 7, nb = r2 & 127; I.ldw = 2048; I.kd = 1024;
        I.src = X.ed + (size_t)e * (1024 * 2048) + (size_t)kb * (64 * 2048) + nb * 16;
        I.dst = X.w2 + (size_t)e * (2048 * 1024) + (size_t)(nb * 16) * 1024 + kb * 64; }
    return I;
}
__device__ __forceinline__ void conv_load(const ConvCtx& X, int j, int qd, float* cv, int lane) {
    const ConvItem I = conv_decode(X, j); const __amdgpu_buffer_rsrc_t rs = A_RSRC(I.src);
#pragma unroll
    for (int i = 0; i < 4; ++i) { const int k = 4 * (4 * qd + i) + (lane >> 4);
        cv[i] = __uint_as_float(__builtin_amdgcn_raw_buffer_load_b32(rs, (k * I.ldw + (lane & 15)) * 4, 0, CONV_AUX)); }
}
__device__ __forceinline__ void conv_put(const ConvCtx& X, int j, int qd, const float* cv, char* scr, int lane, bool finish_only = false) {
    float* s = reinterpret_cast<float*>(scr);
    if (!finish_only) {
#pragma unroll
    for (int i = 0; i < 4; ++i) { const int k = 4 * (4 * qd + i) + (lane >> 4); s[k * 17 + (lane & 15)] = cv[i] * 256.0f; } }
    if (qd == 3) {
        const ConvItem I = conv_decode(X, j); const int n = lane & 15, kq = lane >> 4; const float* c = s + (16 * kq) * 17 + n;
        u32x4 w;
        { int w0 = 0, w1 = 0, w2 = 0, w3 = 0;
          w0 = __builtin_amdgcn_cvt_pk_fp8_f32(c[0 * 17], c[1 * 17], w0, false); w0 = __builtin_amdgcn_cvt_pk_fp8_f32(c[2 * 17], c[3 * 17], w0, true);
          w1 = __builtin_amdgcn_cvt_pk_fp8_f32(c[4 * 17], c[5 * 17], w1, false); w1 = __builtin_amdgcn_cvt_pk_fp8_f32(c[6 * 17], c[7 * 17], w1, true);
          w2 = __builtin_amdgcn_cvt_pk_fp8_f32(c[8 * 17], c[9 * 17], w2, false); w2 = __builtin_amdgcn_cvt_pk_fp8_f32(c[10 * 17], c[11 * 17], w2, true);
          w3 = __builtin_amdgcn_cvt_pk_fp8_f32(c[12 * 17], c[13 * 17], w3, false); w3 = __builtin_amdgcn_cvt_pk_fp8_f32(c[14 * 17], c[15 * 17], w3, true);
          w = (u32x4){(unsigned)w0, (unsigned)w1, (unsigned)w2, (unsigned)w3}; }
        __builtin_amdgcn_raw_buffer_store_b128(w, A_RSRC(I.dst), n * I.kd + 16 * kq, 0, CONV_AUX);
    }
}
constexpr unsigned ROPE_OFF = 2u << 20;
#define A_RTLOAD(B_) do { const __amdgpu_buffer_rsrc_t rr_ = A_RSRC(wsb + ROPE_OFF); const int vo_ = ((B_).P0 + wid * QBLK + r32) * 256 + hi * 32; \
        _Pragma("unroll") for (int d_ = 0; d_ < 4; ++d_) { S.rt[2 * d_] = __builtin_bit_cast(f32x4, __builtin_amdgcn_raw_buffer_load_b128(rr_, vo_ + d_ * 64, 0, 0)); \
                                                            S.rt[2 * d_ + 1] = __builtin_bit_cast(f32x4, __builtin_amdgcn_raw_buffer_load_b128(rr_, vo_ + d_ * 64 + 16, 0, 0)); } } while (0)
__device__ __forceinline__ unsigned rope_pair(unsigned w, float c, float s) { const float x1 = __uint_as_float(w << 16), x2 = __uint_as_float(w & 0xffff0000u); return cvtpk(x1 * c - x2 * s, x2 * c + x1 * s); }
#define A_ROTATE() do { _Pragma("unroll") for (int d_ = 0; d_ < 4; ++d_) { u32x4 w_ = __builtin_bit_cast(u32x4, S.qr[8 + d_]); const f32x4 c01_ = S.rt[2 * d_], c23_ = S.rt[2 * d_ + 1]; \
        w_.x = rope_pair(w_.x, c01_[0], c01_[1]); w_.y = rope_pair(w_.y, c01_[2], c01_[3]); w_.z = rope_pair(w_.z, c23_[0], c23_[1]); w_.w = rope_pair(w_.w, c23_[2], c23_[3]); \
        S.qr[8 + d_] = __builtin_bit_cast(bf16x8, w_); } } while (0)
constexpr int CONV_SCR_DIL = 67584;
#ifndef CONV_PER_IDLE
#define CONV_PER_IDLE 1
#endif
#ifndef CONV_LAST_STEP
#define CONV_LAST_STEP 0
#endif
__device__ __forceinline__ void conv_load_full(const ConvCtx& X, int j, float* cv, int lane) {
    const ConvItem I = conv_decode(X, j); const __amdgpu_buffer_rsrc_t rs = A_RSRC(I.src);
#pragma unroll
    for (int i = 0; i < 16; ++i) { const int k = 4 * i + (lane >> 4); cv[i] = __uint_as_float(__builtin_amdgcn_raw_buffer_load_b32(rs, (k * I.ldw + (lane & 15)) * 4, 0, CONV_AUX)); }
}
__device__ __forceinline__ void conv_put_full(const ConvCtx& X, int j, const float* cv, char* scr, int lane) {
    float* s = reinterpret_cast<float*>(scr);
#pragma unroll
    for (int i = 0; i < 16; ++i) { const int k = 4 * i + (lane >> 4); s[k * 17 + (lane & 15)] = cv[i] * 256.0f; }
    float dummy_[4] = {0.f, 0.f, 0.f, 0.f};
    conv_put(X, j, 3, dummy_, scr, lane, true);
}
template <int DQK, bool DIL, int PVAR = 0, bool ROPE = false>
__device__ __forceinline__ void att_prime(const Blk& cur, const char* wsb, char* lds, Seam<DQK>& S, int tid_in) {
    typedef Cfg<DQK> C;
    int tid = tid_in; asm volatile("" : "+v"(tid));
    const int wid = __builtin_amdgcn_readfirstlane(tid >> 6), lane = tid & 63, r32 = lane & 31, hi = lane >> 5;
    A_STAGE_IDX(); char* K_lds = lds + 2 * SHM_V;
    const int kb0 = swa_jlo(cur.P0, W_(cur)) * KVBLK;
    A_QLOAD(cur);
    if constexpr (ROPE) A_RTLOAD(cur);
    A_SLOAD(cur, kb0); VMW(); A_SWRITE_K(0);
    __syncthreads();
}
template <int DQK, bool DIL, bool SK, int PVAR = 0, int CONV = 0, bool ROPE = false>
__device__ __forceinline__ void att_block(const Blk& cur, const Blk& nxt, const char* wsb, char* lds, Seam<DQK>& S, int tid_in, const ConvCtx* X = nullptr) {
    typedef Cfg<DQK> C;
    int tid = tid_in; asm volatile("" : "+v"(tid));
    const int wid = __builtin_amdgcn_readfirstlane(tid >> 6), lane = tid & 63, r32 = lane & 31, hi = lane >> 5;
    const int W = W_(cur); const float scale = SCALE_, beta = cur.beta;
    int j_lo = swa_jlo(cur.P0, W);
    int j_hi = (cur.P0 + QB - 1) / KVBLK + 1; if (j_hi > SKV_(cur) / KVBLK) j_hi = SKV_(cur) / KVBLK;
    if (PVAR & 8) j_lo = j_hi - 2;
    const int NT = j_hi - j_lo;
    const int kbn = swa_jlo(nxt.P0, W_(nxt)) * KVBLK;
    const int qlo = cur.P0 + wid * QBLK, qm = qlo + r32 - 4 * hi;
    char* V_lds = lds; char* K_lds = lds + 2 * SHM_V;
#ifdef ATT_DEFER
    constexpr bool DEFER = DIL;
#else
    constexpr bool DEFER = false;
#endif
    float* ws = (float*)(lds + (DEFER ? DEFER_WS : 2 * SHM_V + 2 * C::SHM_K)) + wid * 64; float* li_l = ws, * al_l = ws + 32;
    char* stg = lds + DEFER_STG + wid * 8192;
    float m_reg = -1e30f, l_reg = 0; f32x16 o[4] = {};
    A_STAGE_IDX();
    const int vst0 = v_st(sr, sc), vst1 = v_st(32 + sr, sc);
    const int vb0 = (int)(uintptr_t)V_lds + v_rd_base(lane);
#define RESC(a) do { if (__any((a) < 1.f)) { if (hi == 0) al_l[r32] = (a); asm volatile("s_waitcnt lgkmcnt(0)" ::: "memory");              \
                     _Pragma("unroll") for (int d_ = 0; d_ < 4; ++d_) _Pragma("unroll") for (int r = 0; r < 16; ++r) o[d_][r] *= al_l[crow(r, hi)]; } } while (0)
#define KBASE(t) ((j_lo + (t)) * KVBLK)
#define ACT(t) (KBASE(t) <= qlo + QBLK - 1 && KBASE(t) + KVBLK - 1 >= qlo - W + 1)
#define MASKT(P0_, P1_, t) do { const int kb_ = KBASE(t); if ((!SK || ACT(t)) && (kb_ + KVBLK - 1 > qlo || kb_ <= qlo + QBLK - 1 - W)) mask_tile(P0_, P1_, qm - kb_, (unsigned)W); } while (0)
    A_SWRITE_V(0);
    __syncthreads();
    if constexpr (ROPE) { VMW(); A_ROTATE(); }
#define STEP(t, BUF) do { const bool more_ = (t) + 1 < NT;                                                                        \
        if (more_) { A_SLOAD(cur, KBASE((t) + 1)); } else { A_SLOAD(nxt, kbn); }                                                   \
        const bool cpend_ = CONV == 1 && (S.cv_j != S.cl_j || S.cv_q != S.cl_q); const bool cld_ = CONV == 1 && more_ && S.cl_j < CONV_NJ;        \
        const bool act_ = !SK || ACT(t); const bool cidle_ = CONV == 2 && (more_ || CONV_LAST_STEP) && !act_ && (S.cv_j < CONV_NJ);                                \
        bool cnew_ = false;                                                                                                    \
        if (cidle_) { if (S.cv_pend) { VMWN(C::KCH + 2);        \
                          conv_put_full(*X, S.cv_j, S.cvf, lds + (DIL ? CONV_SCR_DIL : CONV_SCR) + wid * 4352, lane); ++S.cv_j;                 \
                          if (S.cv_pend > 1) { conv_put_full(*X, S.cv_j, S.cvf + 16, lds + (DIL ? CONV_SCR_DIL : CONV_SCR) + wid * 4352, lane); ++S.cv_j; } S.cv_pend = 0; } \
                      if (S.cv_j < CONV_NJ) { conv_load_full(*X, S.cv_j, S.cvf, lane); S.cv_pend = 1; cnew_ = true;                                \
                          if (CONV_PER_IDLE > 1 && S.cv_j + 1 < CONV_NJ) { conv_load_full(*X, S.cv_j + 1, S.cvf + 16, lane); S.cv_pend = 2; } } }        \
        if (cld_) { conv_load(*X, S.cl_j, S.cl_q, BUF ? S.cw : S.cv, lane); if (++S.cl_q == 4) { S.cl_q = 0; ++S.cl_j; } }               \
        if (DEFER && S.p_on && (t) < 4) { flush_piece(stg, 2 * (t), wsb + S.p_oo, S.p_rb, S.p_so0, lane); flush_piece(stg, 2 * (t) + 1, wsb + S.p_oo, S.p_rb, S.p_so0, lane); } \
        SBAR();                                                                                                                 \
        if (act_) { f32x16 p0, p1; float mn_, al_; bf16x8 pa0, pa1, pa2, pa3;      \
            qkt<BUF, false, DQK, DIL>(p0, p1, K_lds, r32, hi, S.qr, true, beta, qm - KBASE(t)); SBAR();                              \
            MASKT(p0, p1, t); partialSM(p0, p1, m_reg, mn_, al_, scale); finishSM(p0, p1, al_, l_reg, pa0, pa1, pa2, pa3); RESC(al_); SBAR(); \
            pv_tile<BUF, false>(o, vb0, pa0, pa1, pa2, pa3, true); }                                                             \
        if (!more_) { SBAR(); A_QLOAD(nxt); SBAR(); }                                 \
        if (more_) { if (cnew_) { if (S.cv_pend > 1) VMWN(32); else VMWN(16); } else if (cld_) VMWN(4); else VMW();            \
            A_SWRITE_V(1 - BUF); A_SWRITE_K(1 - BUF);                                                                              \
            if (cpend_) { conv_put(*X, S.cv_j, S.cv_q, BUF ? S.cv : S.cw, lds + CONV_SCR + wid * 4352, lane); if (++S.cv_q == 4) { S.cv_q = 0; ++S.cv_j; } } \
        }                                                                                                                       \
        A_STEPBAR(); } while (0)
    int t = 0;
    for (; t + 1 < NT; t += 2) { STEP(t, 0); STEP(t + 1, 1); }
    if (t < NT) { STEP(t, 0); }
    VMWN(C::NQF); A_SWRITE_K(0); SBAR();
    if (CONV == 1 && (S.cv_j != S.cl_j || S.cv_q != S.cl_q)) { conv_put(*X, S.cv_j, S.cv_q, S.cv, lds + CONV_SCR + wid * 4352, lane); if (++S.cv_q == 4) { S.cv_q = 0; ++S.cv_j; } }
    if (hi == 0) li_l[r32] = l_reg; asm volatile("s_waitcnt lgkmcnt(0)" ::: "memory");
    if constexpr (DIL) { if (hi == 0) __builtin_amdgcn_raw_buffer_store_b32(__float_as_uint(m_reg * scale + __logf(l_reg)), A_RSRC(wsb + cur.lo), r32 * LS_(cur) * 4, (cur.P0 + wid * QBLK) * LS_(cur) * 4, 0); }
    float rli[16];
#pragma unroll
    for (int r = 0; r < 16; ++r) rli[r] = __builtin_amdgcn_rcpf(li_l[crow(r, hi)]);
    if constexpr (DEFER) { stage_write(o, rli, stg, lane); S.p_oo = cur.oo; S.p_rb = OS_(cur) * 2; S.p_so0 = (cur.P0 + wid * QBLK) * OS_(cur) * 2; S.p_on = 1; }
    else {
#ifdef ATT_T21
    store_o_staged(o, rli, wid < 4 ? lds + SHM_V + wid * 4096 : lds + 2 * SHM_V + C::SHM_K + (wid - 4) * 4096, A_RSRC(wsb + cur.oo), OS_(cur) * 2, (cur.P0 + wid * QBLK) * OS_(cur) * 2, lane);
#else
    const int os_ = (PVAR & 1) ? 0 : OS_(cur);
    const __amdgpu_buffer_rsrc_t ro_ = A_RSRC(wsb + cur.oo); const int oo_ = (4 * hi * os_ + r32) * 2, so0_ = (cur.P0 + wid * QBLK) * os_ * 2;
#pragma unroll
    for (int r = 0; r < 16; ++r) { const int sor_ = so0_ + ((r & 3) + 8 * (r >> 2)) * os_ * 2;
#pragma unroll
        for (int d0 = 0; d0 < 4; ++d0) { const float v = o[d0][r] * rli[r];
            const float vn = __int_as_float(__builtin_amdgcn_update_dpp(0, __float_as_int(v), 0xB1, 0xF, 0xF, true));
            if ((r32 & 1) == 0) __builtin_amdgcn_raw_buffer_store_b32(cvtpk(v, vn), ro_, oo_ + d0 * 64, sor_, 0); } }
#endif
    }
    if constexpr (ROPE) A_RTLOAD(nxt);
#undef RESC
#undef KBASE
#undef ACT
#undef MASKT
#undef STEP
}

template <int DQK> struct SeamD { bf16x8 qr[Cfg<DQK>::NQF]; };
#define A_GLDS(voff, sbase, ldsdst) do { unsigned keep_; asm volatile("s_mov_b32 %0, m0\n\ts_mov_b32 m0, %2\n\ts_nop 0\n\tglobal_load_lds_dwordx4 %1, %3\n\ts_mov_b32 m0, %0" \
        : "=&s"(keep_) : "v"(voff), "s"((unsigned)__builtin_amdgcn_readfirstlane((int)(ldsdst))), "s"((const void*)(sbase)) : "memory"); } while (0)
#define A_DMA_IDX() int krow_[C::KCH], kcb_[C::KCH], vrow_[2], vcb_[2]; \
        _Pragma("unroll") for (int j_ = 0; j_ < C::KCH; ++j_) { const int p_ = (j_ * 8 + wid) * 1024 + lane * 16, row_ = p_ / C::KPITCH, pc_ = (p_ % C::KPITCH) / 16, lc_ = (pc_ & ~7) | ((pc_ & 7) ^ (row_ & 7)); \
            krow_[j_] = row_; kcb_[j_] = lc_ * 16; } \
        _Pragma("unroll") for (int j_ = 0; j_ < 2; ++j_) { const int p_ = (j_ * 8 + wid) * 1024 + lane * 16, s_ = p_ / 512, w_ = p_ % 512, kk_ = (s_ >> 2) * 8 + (w_ >> 6), col_ = (s_ & 3) * 32 + ((w_ & 63) >> 1); \
            vrow_[j_] = (kk_ & ~0xC) | ((kk_ & 4) << 1) | ((kk_ & 8) >> 1); vcb_[j_] = col_ * 2; }
#define A_DMA(B_, k0, sl_) do { const char* kb_ = wsb + (B_).ko + (size_t)(k0) * (size_t)(KS_(B_) * 2); const char* vb_ = wsb + (B_).vo + (size_t)(k0) * (size_t)(VS_(B_) * 2); \
        _Pragma("unroll") for (int j_ = 0; j_ < C::KCH; ++j_) A_GLDS((unsigned)(krow_[j_] * KS_(B_) * 2 + kcb_[j_]), kb_, lds0 + NS * SHM_V + (sl_) * C::SHM_K + (j_ * 8 + wid) * 1024); \
        _Pragma("unroll") for (int j_ = 0; j_ < 2; ++j_) A_GLDS((unsigned)(vrow_[j_] * VS_(B_) * 2 + vcb_[j_]), vb_, lds0 + (sl_) * SHM_V + (j_ * 8 + wid) * 1024); } while (0)
template <int DQK, bool DIL, int NS>
__device__ __forceinline__ void att_prime_dma(const Blk& cur, const char* wsb, char* lds, SeamD<DQK>& S, int tid_in) {
    typedef Cfg<DQK> C;
    int tid = tid_in; asm volatile("" : "+v"(tid));
    const int wid = __builtin_amdgcn_readfirstlane(tid >> 6), lane = tid & 63, r32 = lane & 31, hi = lane >> 5;
    const unsigned lds0 = (unsigned)(uintptr_t)lds;
    A_DMA_IDX();
    const int kb0 = swa_jlo(cur.P0, W_(cur)) * KVBLK;
    A_QLOAD(cur);
#pragma unroll
    for (int i_ = 0; i_ < NS - 1; ++i_) A_DMA(cur, kb0 + i_ * KVBLK, i_);
}
template <int DQK, bool DIL, bool SK, int NS>
__device__ __forceinline__ void att_block_dma(const Blk& cur, const Blk& nxt, const char* wsb, char* lds, char* wsl, SeamD<DQK>& S, int tid_in) {
    typedef Cfg<DQK> C;
    int tid = tid_in; asm volatile("" : "+v"(tid));
    const int wid = __builtin_amdgcn_readfirstlane(tid >> 6), lane = tid & 63, r32 = lane & 31, hi = lane >> 5;
    const int W = W_(cur); const float scale = SCALE_, beta = cur.beta;
    const int j_lo = swa_jlo(cur.P0, W);
    int j_hi = (cur.P0 + QB - 1) / KVBLK + 1; if (j_hi > SKV_(cur) / KVBLK) j_hi = SKV_(cur) / KVBLK;
    const int NT = j_hi - j_lo;
    const int kbn = swa_jlo(nxt.P0, W_(nxt)) * KVBLK;
    const int qlo = cur.P0 + wid * QBLK, qm = qlo + r32 - 4 * hi;
    const unsigned lds0 = (unsigned)(uintptr_t)lds;
    const char* K_lds = lds + NS * SHM_V;
    float* ws = (float*)wsl + wid * 64; float* li_l = ws, * al_l = ws + 32;
    float m_reg = -1e30f, l_reg = 0; f32x16 o[4] = {};
    A_DMA_IDX();
    const int vb0 = (int)lds0 + v_rd_base(lane);
    constexpr int NDMA = C::KCH + 2;
#define RESC(a) do { if (__any((a) < 1.f)) { if (hi == 0) al_l[r32] = (a); asm volatile("s_waitcnt lgkmcnt(0)" ::: "memory");              \
                     _Pragma("unroll") for (int d_ = 0; d_ < 4; ++d_) _Pragma("unroll") for (int r = 0; r < 16; ++r) o[d_][r] *= al_l[crow(r, hi)]; } } while (0)
#define KBASE(t) ((j_lo + (t)) * KVBLK)
#define ACT(t) (KBASE(t) <= qlo + QBLK - 1 && KBASE(t) + KVBLK - 1 >= qlo - W + 1)
#define MASKT(P0_, P1_, t) do { const int kb_ = KBASE(t); if ((!SK || ACT(t)) && (kb_ + KVBLK - 1 > qlo || kb_ <= qlo + QBLK - 1 - W)) mask_tile(P0_, P1_, qm - kb_, (unsigned)W); } while (0)
    VMW();
#pragma unroll
    for (int d0 = 0; d0 < C::NQF; ++d0) asm volatile("" : "+v"(S.qr[d0]));
    asm volatile("s_waitcnt lgkmcnt(0)" ::: "memory"); __builtin_amdgcn_s_barrier(); asm volatile("" ::: "memory");
    int sl = 0, sl2 = NS - 1;
#pragma unroll 1
    for (int t = 0; t < NT; ++t) {
        const bool pre = t + NS - 1 < NT;
        if (pre) A_DMA(cur, KBASE(t + NS - 1), sl2);
        SBAR(); f32x16 p0, p1; float mn_, al_; bf16x8 pa0, pa1, pa2, pa3;
        qkt<0, SK, DQK, DIL>(p0, p1, K_lds + sl * C::SHM_K, r32, hi, S.qr, ACT(t), beta, qm - KBASE(t)); SBAR();
        MASKT(p0, p1, t); partialSM(p0, p1, m_reg, mn_, al_, scale); finishSM(p0, p1, al_, l_reg, pa0, pa1, pa2, pa3); RESC(al_); SBAR();
        pv_tile<0, SK>(o, vb0 + sl * SHM_V, pa0, pa1, pa2, pa3, ACT(t));
        if (t + 1 < NT) { int infl = NT - 2 - t; if (infl > NS - 2) infl = NS - 2;
                          if (infl <= 0) VMW(); else if (infl == 1) VMWN(NDMA); else VMWN(2 * NDMA);
                          asm volatile("s_waitcnt lgkmcnt(0)" ::: "memory"); __builtin_amdgcn_s_barrier(); asm volatile("" ::: "memory"); }
        sl = sl == NS - 1 ? 0 : sl + 1; sl2 = sl2 == NS - 1 ? 0 : sl2 + 1;
    }
    asm volatile("s_waitcnt lgkmcnt(0)" ::: "memory"); __builtin_amdgcn_s_barrier(); asm volatile("" ::: "memory");
    A_QLOAD(nxt);
#pragma unroll
    for (int i_ = 0; i_ < NS - 1; ++i_) A_DMA(nxt, kbn + i_ * KVBLK, i_);
    if (hi == 0) li_l[r32] = l_reg; asm volatile("s_waitcnt lgkmcnt(0)" ::: "memory");
    if constexpr (DIL) { if (hi == 0) __builtin_amdgcn_raw_buffer_store_b32(__float_as_uint(m_reg * scale + __logf(l_reg)), A_RSRC(wsb + cur.lo), r32 * LS_(cur) * 4, (cur.P0 + wid * QBLK) * LS_(cur) * 4, 0); }
    float rli[16];
#pragma unroll
    for (int r = 0; r < 16; ++r) rli[r] = __builtin_amdgcn_rcpf(li_l[crow(r, hi)]);
    const __amdgpu_buffer_rsrc_t ro_ = A_RSRC(wsb + cur.oo); const int oo_ = (4 * hi * OS_(cur) + r32) * 2, so0_ = (cur.P0 + wid * QBLK) * OS_(cur) * 2;
#pragma unroll
    for (int r = 0; r < 16; ++r) { const int sor_ = so0_ + ((r & 3) + 8 * (r >> 2)) * OS_(cur) * 2;
#pragma unroll
        for (int d0 = 0; d0 < 4; ++d0) { const float v = o[d0][r] * rli[r];
            const float vn = __int_as_float(__builtin_amdgcn_update_dpp(0, __float_as_int(v), 0xB1, 0xF, 0xF, true));
            if ((r32 & 1) == 0) __builtin_amdgcn_raw_buffer_store_b32(cvtpk(v, vn), ro_, oo_ + d0 * 64, sor_, 0); } }
#undef RESC
#undef KBASE
#undef ACT
#undef MASKT
}

template <bool SK, int DQK, bool DIL>
__device__ __forceinline__ void qkt_fin(f32x16& p0, f32x16& p1, const char* K_lds, int r32, int hi, const bf16x8* qr, bool act, float beta, int dq,
                                        f32x16& y0, f32x16& y1, float alpha, float& l_reg, bf16x8& pa0, bf16x8& pa1, bf16x8& pa2, bf16x8& pa3) {
    typedef Cfg<DQK> C;
    const bool run = !(SK && !act);
    if (!run) { const float NEG = -__builtin_inff();
#pragma unroll
        for (int r = 0; r < 16; ++r) { p0[r] = NEG; p1[r] = NEG; } }
    else if constexpr (DIL) { const float b0 = -beta * (float)dq;
#pragma unroll
        for (int r = 0; r < 16; ++r) { const int c = (r & 3) + 8 * (r >> 2); p0[r] = fmaf(beta, (float)c, b0); p1[r] = fmaf(beta, (float)(c + 32), b0); } }
    else { p0 = f32x16{}; p1 = f32x16{}; }
    const char* kb[4];
#pragma unroll
    for (int dd = 0; dd < 4; ++dd) { const int colB = (dd * 16 + hi * 8) * 2; kb[dd] = K_lds + r32 * C::KPITCH + (colB ^ ((r32 & 7) << 4)); }
#define QK_CHUNK(c_) do { if (run) { _Pragma("unroll") for (int d0 = 4 * (c_); d0 < 4 * (c_) + 4 && d0 < C::NQF; ++d0) { const char* a = kb[d0 & 3] + (d0 >> 2) * 128; \
            bf16x8 b0 = *reinterpret_cast<const bf16x8*>(a); bf16x8 b1 = *reinterpret_cast<const bf16x8*>(a + 32 * C::KPITCH);                                  \
            p0 = __builtin_amdgcn_mfma_f32_32x32x16_bf16(b0, qr[d0], p0, 0, 0, 0); p1 = __builtin_amdgcn_mfma_f32_32x32x16_bf16(b1, qr[d0], p1, 0, 0, 0); } } } while (0)
#define PK4(P, B_, OUT) do { unsigned a0 = cvtpk(P[B_+0], P[B_+1]), a1 = cvtpk(P[B_+2], P[B_+3]);                          \
        unsigned b0 = cvtpk(P[B_+4], P[B_+5]), b1 = cvtpk(P[B_+6], P[B_+7]);                                             \
        auto r0 = __builtin_amdgcn_permlane32_swap(a0, b0, false, false); auto r1 = __builtin_amdgcn_permlane32_swap(a1, b1, false, false); \
        u32x4 w = {r0[0], r1[0], r0[1], r1[1]}; OUT = *reinterpret_cast<bf16x8*>(&w); } while (0)
    QK_CHUNK(0);
#pragma unroll
    for (int r = 0; r < 16; ++r) y1[r] = __builtin_amdgcn_exp2f(y1[r]);
    float ps = 0;
#pragma unroll
    for (int r = 0; r < 16; ++r) ps += y0[r];
#pragma unroll
    for (int r = 0; r < 16; ++r) ps += y1[r];
    SBAR();
    QK_CHUNK(1);
    { auto rr = __builtin_amdgcn_permlane32_swap(__float_as_uint(ps), __float_as_uint(ps), false, false);
      ps = __uint_as_float(rr[0]) + __uint_as_float(rr[1]); }
    l_reg = l_reg * alpha + ps;
    PK4(y0, 0, pa0); PK4(y0, 8, pa1);
    if constexpr (C::NQF > 8) { SBAR(); QK_CHUNK(2); }
    PK4(y1, 0, pa2); PK4(y1, 8, pa3);
#undef PK4
#undef QK_CHUNK
}
#ifndef ATT_SKEW_SEL
#define ATT_SKEW_SEL 0
#endif
#if ATT_SKEW_SEL == 0
#define ATT_SKEW_A (wid < 4)
#elif ATT_SKEW_SEL == 1
#define ATT_SKEW_A ((wid & 1) == 0)
#elif ATT_SKEW_SEL == 2
#define ATT_SKEW_A true
#else
#define ATT_SKEW_A false
#endif
#define A_DMA_K(B_, k0, sl_) do { const char* kb_ = wsb + (B_).ko + (size_t)(k0) * (size_t)(KS_(B_) * 2); int ln_ = lane; asm volatile("" : "+v"(ln_)); \
        _Pragma("unroll") for (int j_ = 0; j_ < C::KCH; ++j_) { const int p_ = (j_ * 8 + wid) * 1024 + ln_ * 16, row_ = p_ / C::KPITCH, pc_ = (p_ % C::KPITCH) / 16, lc_ = (pc_ & ~7) | ((pc_ & 7) ^ (row_ & 7)); \
            A_GLDS((unsigned)(row_ * KS_(B_) * 2 + lc_ * 16), kb_, lds0 + 3 * SHM_V + (sl_) * C::SHM_K + (j_ * 8 + wid) * 1024); } } while (0)
#define A_DMA_V(B_, k0, sl_) do { const char* vb_ = wsb + (B_).vo + (size_t)(k0) * (size_t)(VS_(B_) * 2); int ln_ = lane; asm volatile("" : "+v"(ln_)); \
        _Pragma("unroll") for (int j_ = 0; j_ < 2; ++j_) { const int p_ = (j_ * 8 + wid) * 1024 + ln_ * 16, s_ = p_ / 512, w_ = p_ % 512, kk_ = (s_ >> 2) * 8 + (w_ >> 6), col_ = (s_ & 3) * 32 + ((w_ & 63) >> 1); \
            const int vr_ = (kk_ & ~0xC) | ((kk_ & 4) << 1) | ((kk_ & 8) >> 1); \
            A_GLDS((unsigned)(vr_ * VS_(B_) * 2 + col_ * 2), vb_, lds0 + (sl_) * SHM_V + (j_ * 8 + wid) * 1024); } } while (0)
#define A_RAWBAR() do { asm volatile("s_waitcnt lgkmcnt(0)" ::: "memory"); __builtin_amdgcn_s_barrier(); asm volatile("" ::: "memory"); } while (0)
template <int DQK, bool DIL>
__device__ __forceinline__ void att_prime_dma2(const Blk& cur, const char* wsb, char* lds, SeamD<DQK>& S, int tid_in) {
    typedef Cfg<DQK> C; constexpr int NS = 3;
    int tid = tid_in; asm volatile("" : "+v"(tid));
    const int wid = __builtin_amdgcn_readfirstlane(tid >> 6), lane = tid & 63, r32 = lane & 31, hi = lane >> 5;
    const unsigned lds0 = (unsigned)(uintptr_t)lds;
    const int kb0 = swa_jlo(cur.P0, W_(cur)) * KVBLK;
    A_QLOAD(cur);
    A_DMA_K(cur, kb0, 0); A_DMA_V(cur, kb0, 0); A_DMA_K(cur, kb0 + KVBLK, 1);
}
template <int DQK, bool DIL, bool SK, int ORD>
__device__ __forceinline__ void att_block_dma2(const Blk& cur, const Blk& nxt, const char* wsb, char* lds, SeamD<DQK>& S, int tid_in) {
    typedef Cfg<DQK> C; constexpr int NS = 3;
    int tid = tid_in; asm volatile("" : "+v"(tid));
    const int wid = __builtin_amdgcn_readfirstlane(tid >> 6), lane = tid & 63, r32 = lane & 31, hi = lane >> 5;
    const int W = W_(cur); const float scale = SCALE_, beta = cur.beta;
    const int j_lo = swa_jlo(cur.P0, W);
    int j_hi = (cur.P0 + QB - 1) / KVBLK + 1; if (j_hi > SKV_(cur) / KVBLK) j_hi = SKV_(cur) / KVBLK;
    const int NT = j_hi - j_lo;
    const int kbn = swa_jlo(nxt.P0, W_(nxt)) * KVBLK;
    const int qlo = cur.P0 + wid * QBLK, qm = qlo + r32 - 4 * hi;
    const unsigned lds0 = (unsigned)(uintptr_t)lds;
    const char* K_lds = lds + 3 * SHM_V;
    float* ws = (float*)(lds + 3 * SHM_V + 3 * C::SHM_K) + wid * 64; float* li_l = ws, * al_l = ws + 32;
    float m_reg = -1e30f, l_reg = 0; f32x16 o[4] = {};
    const int vb0 = (int)lds0 + v_rd_base(lane);
#define RESC(a) do { if (__any((a) < 1.f)) { if (hi == 0) al_l[r32] = (a); asm volatile("s_waitcnt lgkmcnt(0)" ::: "memory");              \
                     _Pragma("unroll") for (int d_ = 0; d_ < 4; ++d_) _Pragma("unroll") for (int r = 0; r < 16; ++r) o[d_][r] *= al_l[crow(r, hi)]; } } while (0)
#define KBASE(t) ((j_lo + (t)) * KVBLK)
#define ACT(t) (KBASE(t) <= qlo + QBLK - 1 && KBASE(t) + KVBLK - 1 >= qlo - W + 1)
#define MASKT(P0_, P1_, t) do { const int kb_ = KBASE(t); if ((!SK || ACT(t)) && (kb_ + KVBLK - 1 > qlo || kb_ <= qlo + QBLK - 1 - W)) mask_tile(P0_, P1_, qm - kb_, (unsigned)W); } while (0)
#define ISSUE(t, n_) do { n_ = 0; if ((t) + 2 < NT) { int slotk_ = sl + 2; if (slotk_ >= 3) slotk_ -= 3; A_DMA_K(cur, KBASE((t) + 2), slotk_); n_ += C::KCH; } \
                          if ((t) + 1 < NT) { int slotv_ = sl + 1; if (slotv_ >= 3) slotv_ -= 3; A_DMA_V(cur, KBASE((t) + 1), slotv_); n_ += 2; } } while (0)
#define CLOSE(n_) do { if ((n_) == C::KCH + 2) VMWN(C::KCH + 2); else if ((n_) == 2) VMWN(2); else VMW(); A_RAWBAR(); } while (0)
    VMW();
#pragma unroll
    for (int d0 = 0; d0 < C::NQF; ++d0) asm volatile("" : "+v"(S.qr[d0]));
    A_RAWBAR();
    int sl = 0, slp = 2, nis;
    f32x16 pA0, pA1, pB0, pB1; float mnA, mnB, alA, alB; bf16x8 pa0, pa1, pa2, pa3;
    ISSUE(0, nis); SBAR();
    qkt<0, SK, DQK, DIL>(pA0, pA1, K_lds + sl * C::SHM_K, r32, hi, S.qr, ACT(0), beta, qm - KBASE(0)); SBAR();
    MASKT(pA0, pA1, 0); partialSM(pA0, pA1, m_reg, mnA, alA, scale);
    CLOSE(nis); slp = sl; sl = sl == 2 ? 0 : sl + 1;
#define STEPP(PX0, PX1, mnX, alX, PY0, PY1, alY, t) do { ISSUE(t, nis); SBAR();                                               \
        if constexpr (ORD == 0) {                                                                                               \
            qkt<0, SK, DQK, DIL>(PX0, PX1, K_lds + sl * C::SHM_K, r32, hi, S.qr, ACT(t), beta, qm - KBASE(t)); SBAR();           \
            finishSM(PY0, PY1, alY, l_reg, pa0, pa1, pa2, pa3); SBAR();                                                         \
            pv_tile<0, SK>(o, vb0 + slp * SHM_V, pa0, pa1, pa2, pa3, ACT((t) - 1)); SBAR();                                     \
        } else {                                                                                                                \
            finishSM(PY0, PY1, alY, l_reg, pa0, pa1, pa2, pa3); SBAR();                                                         \
            pv_tile<0, SK>(o, vb0 + slp * SHM_V, pa0, pa1, pa2, pa3, ACT((t) - 1)); SBAR();                                     \
            qkt<0, SK, DQK, DIL>(PX0, PX1, K_lds + sl * C::SHM_K, r32, hi, S.qr, ACT(t), beta, qm - KBASE(t)); SBAR();           \
        }                                                                                                                       \
        MASKT(PX0, PX1, (t)); partialSM(PX0, PX1, m_reg, mnX, alX, scale);                                                     \
        RESC(alX); CLOSE(nis); slp = sl; sl = sl == 2 ? 0 : sl + 1; } while (0)
    int t = 1;
#pragma unroll 1
    for (; t + 2 < NT; t += 2) {
        STEPP(pB0, pB1, mnB, alB, pA0, pA1, alA, t);
        STEPP(pA0, pA1, mnA, alA, pB0, pB1, alB, t + 1);
    }
    STEPP(pB0, pB1, mnB, alB, pA0, pA1, alA, t);
    finishSM(pB0, pB1, alB, l_reg, pa0, pa1, pa2, pa3); SBAR();
    pv_tile<0, SK>(o, vb0 + slp * SHM_V, pa0, pa1, pa2, pa3, ACT(NT - 1));
    A_RAWBAR();
    A_QLOAD(nxt);
    A_DMA_K(nxt, kbn, 0); A_DMA_V(nxt, kbn, 0); A_DMA_K(nxt, kbn + KVBLK, 1);
    if (hi == 0) li_l[r32] = l_reg; asm volatile("s_waitcnt lgkmcnt(0)" ::: "memory");
    if constexpr (DIL) { if (hi == 0) __builtin_amdgcn_raw_buffer_store_b32(__float_as_uint(m_reg * scale + __logf(l_reg)), A_RSRC(wsb + cur.lo), r32 * LS_(cur) * 4, (cur.P0 + wid * QBLK) * LS_(cur) * 4, 0); }
    float rli[16];
#pragma unroll
    for (int r = 0; r < 16; ++r) rli[r] = __builtin_amdgcn_rcpf(li_l[crow(r, hi)]);
    const __amdgpu_buffer_rsrc_t ro_ = A_RSRC(wsb + cur.oo); const int oo_ = (4 * hi * OS_(cur) + r32) * 2, so0_ = (cur.P0 + wid * QBLK) * OS_(cur) * 2;
#pragma unroll
    for (int r = 0; r < 16; ++r) { const int sor_ = so0_ + ((r & 3) + 8 * (r >> 2)) * OS_(cur) * 2;
#pragma unroll
        for (int d0 = 0; d0 < 4; ++d0) { const float v = o[d0][r] * rli[r];
            const float vn = __int_as_float(__builtin_amdgcn_update_dpp(0, __float_as_int(v), 0xB1, 0xF, 0xF, true));
            if ((r32 & 1) == 0) __builtin_amdgcn_raw_buffer_store_b32(cvtpk(v, vn), ro_, oo_ + d0 * 64, sor_, 0); } }
#undef RESC
#undef KBASE
#undef ACT
#undef MASKT
#undef ISSUE
#undef CLOSE
#undef STEPP
}
#undef A_DMA_K
#undef A_DMA_V
#undef A_RAWBAR
#undef A_GLDS
#undef A_DMA_IDX
#undef A_DMA
#undef VMW
#undef VMWN
#undef A_SLOAD
#undef A_RSRC
#undef A_BLD
#undef A_QLOAD
#undef A_SWRITE_K
#undef A_SWRITE_V
#undef A_STAGE_IDX
#undef SBAR
#undef QS_
#undef KS_
#undef VS_
#undef OS_
#undef LS_
#undef SKV_
#undef W_
#undef SCALE_
}
constexpr int NWAVES = 8;
constexpr int T = 32768, DM = 2048, SEQ = 8192, NB = 4, DEPTH = 2;
constexpr int IN_COLS = 3904, PROJ_LD = 4096, NEXP = 16, DEXP = 1024;
constexpr int C_QB = 0, C_KB = 1024, C_VB = 2048, C_CQ = 3072, C_CKV = 3584, C_KR = 3840;
constexpr float EPS = 1e-6f;
constexpr size_t MiB = 1u << 20;
constexpr size_t WS_CTL = 0, CTL_ZERO_BYTES = 1 * MiB;
constexpr size_t WS_MOD = 1 * MiB;
constexpr size_t WS_ROPE = 2 * MiB;
constexpr size_t WS_RSTDQ = 4 * MiB, WS_RSTDKV = 4 * MiB + 256 * 1024, WS_AW = 4 * MiB + 512 * 1024;
constexpr size_t WS_ROWIDX = 5 * MiB;
constexpr size_t WS_LSE = 8 * MiB;
constexpr size_t WS_WIN = 16 * MiB;
constexpr size_t WS_WUQ = 48 * MiB;
constexpr size_t WS_WUKV = 51 * MiB;
constexpr size_t WS_WOUT = 53 * MiB;
constexpr size_t WS_W13 = 72 * MiB;
constexpr size_t WS_W2 = 200 * MiB;
constexpr size_t WS_H = 264 * MiB;
constexpr size_t WS_PROJ = 392 * MiB;
constexpr size_t WS_QA = 648 * MiB;
constexpr size_t WS_KF = 744 * MiB;
constexpr size_t WS_VB = 840 * MiB;
constexpr size_t WS_OA = 904 * MiB;
constexpr size_t WS_OB = 968 * MiB;
constexpr size_t WS_XB = 1160 * MiB;
constexpr size_t WS_END = 1288 * MiB;
constexpr size_t WS_HMID = WS_PROJ;
constexpr size_t WS_Y = WS_QA;
constexpr int CW_TMO = 0;
constexpr int CW_CNT = 64;
constexpr int CW_BAR = 4096;
constexpr int RING_BYTES = 131072;
constexpr int L_MISC = RING_BYTES, L_TS = RING_BYTES + 256, L_CNT = RING_BYTES + 384, L_TOK = RING_BYTES + 512, L_ATAB = RING_BYTES + 2560;
constexpr int MAXU = 10;
constexpr int LDS_BYTES = 147456;
static_assert(L_ATAB + MAXU * 1024 <= LDS_BYTES, "LDS map");

#define GAS __attribute__((address_space(1)))
#define LAS __attribute__((address_space(3)))
typedef unsigned short bf16;
typedef unsigned v4u __attribute__((ext_vector_type(4)));
typedef unsigned v2u __attribute__((ext_vector_type(2)));
typedef float f32x4 __attribute__((ext_vector_type(4)));
typedef float f32x2 __attribute__((ext_vector_type(2)));
#define LDS_WAIT() asm volatile("s_waitcnt lgkmcnt(0)" ::: "memory")
#define VM_WAIT() asm volatile("s_waitcnt vmcnt(0)" ::: "memory")
__device__ __forceinline__ unsigned pk2(float lo, float hi) { return pg8::cvt_pk_bf16(lo, hi); }
__device__ __forceinline__ float bf_lo(unsigned w) { return __uint_as_float(w << 16); }
__device__ __forceinline__ float bf_hi(unsigned w) { return __uint_as_float(w & 0xffff0000u); }


typedef __amdgpu_buffer_rsrc_t rsrc_t;
#define RSRC(p) __builtin_amdgcn_make_buffer_rsrc((void*)(p), 0, 0x7fffffff, 0x00020000)
__device__ __forceinline__ f32x4 bld4f(rsrc_t r, int vo, int so) { return __builtin_bit_cast(f32x4, __builtin_amdgcn_raw_buffer_load_b128(r, vo, so, 0)); }
__device__ __forceinline__ v4u bld4u(rsrc_t r, int vo, int so) { return __builtin_bit_cast(v4u, __builtin_amdgcn_raw_buffer_load_b128(r, vo, so, 0)); }
__device__ __forceinline__ v2u bld2u(rsrc_t r, int vo, int so) { return __builtin_bit_cast(v2u, __builtin_amdgcn_raw_buffer_load_b64(r, vo, so, 0)); }
__device__ __forceinline__ void bst2u(rsrc_t r, int vo, int so, v2u v) { __builtin_amdgcn_raw_buffer_store_b64(v, r, vo, so, 0); }
__device__ __forceinline__ void bst4u(rsrc_t r, int vo, int so, v4u v) { __builtin_amdgcn_raw_buffer_store_b128(v, r, vo, so, 0); }
__device__ __forceinline__ void bst4f(rsrc_t r, int vo, int so, f32x4 v) { __builtin_amdgcn_raw_buffer_store_b128(__builtin_bit_cast(v4u, v), r, vo, so, 0); }

#define XB_TMO      128
#define XB_XCNT(j)  (256  + 64 * (j))
#define XB_XSUB(j)  (1280 + 64 * (j))
#define XB_XGEN(j)  (2304 + 64 * (j))
#define XB_TOP      3328
#define XB_TOPGEN   3392
#define XCD_BAR_WORDS 3456
#define XB_SPIN_CAP (1u << 18)
__device__ __forceinline__ unsigned xb_ld(unsigned* p)              { return __hip_atomic_load(p, __ATOMIC_RELAXED, __HIP_MEMORY_SCOPE_AGENT); }
__device__ __forceinline__ unsigned xb_add(unsigned* p, unsigned v) { return __hip_atomic_fetch_add(p, v, __ATOMIC_RELAXED, __HIP_MEMORY_SCOPE_AGENT); }
__device__ __forceinline__ unsigned xb_xcc_id() { return (unsigned)__builtin_amdgcn_s_getreg((3 << 11) | 20) & 0xFu; }
#define XB_SPIN(cond, bar) do { unsigned _sp = 0; while (cond) { __builtin_amdgcn_s_sleep(1); \
    if ((++_sp & 255u) == 0u) { if (xb_ld(&(bar)[XB_TMO])) break; if (_sp > XB_SPIN_CAP) { atomicAdd(&(bar)[XB_TMO], 1u); break; } } } } while (0)
struct XcdBarrier { unsigned* bar; unsigned x; volatile LAS unsigned* st; };
__device__ __forceinline__ XcdBarrier xcd_barrier_post(unsigned* bar, volatile LAS unsigned* st, int tid) {
    XcdBarrier b; b.bar = bar; b.x = xb_xcc_id(); b.st = st;
    if (tid == 0) (void)xb_add(&bar[XB_XCNT(b.x)], 1u);
    return b;
}
__device__ __forceinline__ void xcd_barrier_complete(unsigned* bar, unsigned x, unsigned& nloc, unsigned& nx) {
    const unsigned G = gridDim.x * gridDim.y * gridDim.z;
    unsigned sum, cnt, mine, sp = 0u;
    for (;;) {
        sum = 0u; cnt = 0u; mine = 0u;
#pragma unroll
        for (unsigned j = 0; j < 16; ++j) { const unsigned c = xb_ld(&bar[XB_XCNT(j)]); sum += c; cnt += (c > 0u) ? 1u : 0u; mine = (j == x) ? c : mine; }
        if (sum == G) break;
        __builtin_amdgcn_s_sleep(1);
        if ((++sp & 255u) == 0u) { if (xb_ld(&bar[XB_TMO])) break; if (sp > XB_SPIN_CAP) { atomicAdd(&bar[XB_TMO], 1u); break; } }
    }
    nloc = mine > 0u ? mine : 1u; nx = cnt > 0u ? cnt : 1u;
}
__device__ __forceinline__ void xcd_barrier(const XcdBarrier& b, int tid) {
    asm volatile("s_waitcnt vmcnt(0)" ::: "memory");
    __syncthreads();
    if (tid == 0) {
        unsigned* bar = b.bar; asm volatile("" : "+s"(bar));
        __builtin_amdgcn_s_waitcnt(0);
        unsigned nloc = b.st[0], nx = b.st[1];
        if (nloc == 0u) { xcd_barrier_complete(bar, b.x, nloc, nx); b.st[0] = nloc; b.st[1] = nx; }
        const unsigned old = xb_add(&bar[XB_XSUB(b.x)], 1u);
        const unsigned gen = old / nloc;
        if (old + 1u == (gen + 1u) * nloc) {
            __builtin_amdgcn_fence(__ATOMIC_RELEASE, "agent");
            asm volatile("s_waitcnt vmcnt(0)" ::: "memory");
            const unsigned og = xb_add(&bar[XB_TOP], 1u);
            const unsigned tg = og / nx;
            if (og + 1u == (tg + 1u) * nx) xb_add(&bar[XB_TOPGEN], 1u);
            else XB_SPIN(xb_ld(&bar[XB_TOPGEN]) == tg, bar);
            __builtin_amdgcn_fence(__ATOMIC_ACQUIRE, "agent");
            xb_add(&bar[XB_XGEN(b.x)], 1u);
            asm volatile("s_waitcnt vmcnt(0)" ::: "memory");
        } else {
            XB_SPIN(xb_ld(&bar[XB_XGEN(b.x)]) == gen, bar);
            __builtin_amdgcn_fence(__ATOMIC_ACQUIRE, "agent");
            asm volatile("s_waitcnt vmcnt(0)" ::: "memory");
        }
    }
    __syncthreads();
}

struct Args {
    const float* in[20]; float* out; unsigned char* ws;
    float invf[32];
    int ph_lo, ph_hi, li, pad;
};
enum { I_X = 0, I_C, I_ADAW, I_ADAB, I_N1G, I_N2G, I_WIN, I_QNG, I_KVNG, I_WUQ, I_WUKV, I_ONA, I_ONB, I_WOUT, I_RW, I_RB, I_EG, I_EU, I_ED, I_FG };

struct Frame {
    LAS unsigned char* lds; unsigned char* ldsg;
    unsigned* ctl; unsigned char* ws;
    int tid, lane, wave, vcu, G;
};
__device__ __forceinline__ int lane_id() { int l; asm volatile("v_mbcnt_lo_u32_b32 %0, -1, 0\n\tv_mbcnt_hi_u32_b32 %0, -1, %0" : "=v"(l)); return l; }
#define DPP_ADD(v, ctrl) v += __int_as_float(__builtin_amdgcn_update_dpp(0, __float_as_int(v), ctrl, 0xF, 0xF, true))
__device__ __forceinline__ float wave_sum(float v) {
    DPP_ADD(v, 0xB1); DPP_ADD(v, 0x4E); DPP_ADD(v, 0x141); DPP_ADD(v, 0x140);
    v += __int_as_float(__builtin_amdgcn_ds_swizzle(__float_as_int(v), 0x401F));
    auto rr = __builtin_amdgcn_permlane32_swap(__float_as_uint(v), __float_as_uint(v), false, false);
    return __uint_as_float(rr[0]) + __uint_as_float(rr[1]);
}
__device__ __forceinline__ int il64(int j) { return j < 32 ? 2 * j : 2 * (j - 32) + 1; }
template <int MODE> __device__ __forceinline__ int dest_row(int n) {
    if constexpr (MODE == 0) return n;
    else if constexpr (MODE == 1) {
        if (n < 512) return C_CQ + n; if (n < 768) return C_CKV + (n - 512); if (n < 832) return C_KR + il64(n - 768);
        if (n < 1856) return C_QB + (n - 832); if (n < 2880) return C_KB + (n - 1856); return C_VB + (n - 2880); }
    else if constexpr (MODE == 2) { const int h = n / 192, j = n % 192; return j < 128 ? n : h * 192 + 128 + il64(j - 128); }
    else if constexpr (MODE == 3) return (n >> 7) * 256 + (n & 127);
    else return (n >> 7) * 256 + 128 + (n & 127);
}
template <int MODE>
__device__ __forceinline__ void transpose_item(const float* W, int ldw, int K, int N, bf16* WT, const float* kscale, LAS float* scr, int item, int lane) {
    const int nblk = N / 32, kb = item / nblk, nb = item % nblk, k0 = 64 * kb, n0 = 32 * nb;
    float tv[32];
#pragma unroll
    for (int i = 0; i < 32; ++i) { const int kk = 2 * i + (lane >> 5); tv[i] = W[(size_t)(k0 + kk) * ldw + n0 + (lane & 31)]; }
#pragma unroll
    for (int i = 0; i < 32; ++i) { const int kk = 2 * i + (lane >> 5); float v = tv[i]; if (kscale) v *= kscale[k0 + kk]; scr[kk * 33 + (lane & 31)] = v; }
    LDS_WAIT(); asm volatile("" ::: "memory");
    const int c = lane & 7;
#pragma unroll
    for (int j = 0; j < 4; ++j) { const int n = (lane >> 3) + 8 * j; const LAS float* s = scr + (8 * c) * 33 + n;
        v4u o; o.x = pk2(s[0 * 33], s[1 * 33]); o.y = pk2(s[2 * 33], s[3 * 33]); o.z = pk2(s[4 * 33], s[5 * 33]); o.w = pk2(s[6 * 33], s[7 * 33]);
        *(v4u*)(WT + (size_t)dest_row<MODE>(n0 + n) * K + k0 + 8 * c) = o; }
    LDS_WAIT(); asm volatile("s_waitcnt vmcnt(0)" ::: "memory");
}

__device__ __forceinline__ unsigned pk4_fp8(float a, float b, float c, float d) { int w = 0; w = __builtin_amdgcn_cvt_pk_fp8_f32(a, b, w, false); w = __builtin_amdgcn_cvt_pk_fp8_f32(c, d, w, true); return (unsigned)w; }
template <int MODE>
__device__ __forceinline__ void transpose_item8(const float* W, int ldw, int K, int N, unsigned char* WT, LAS float* scr, int item, int lane) {
    const int nblk = N / 32, kb = item / nblk, nb = item % nblk, k0 = 64 * kb, n0 = 32 * nb;
    float tv[32];
#pragma unroll
    for (int i = 0; i < 32; ++i) { const int kk = 2 * i + (lane >> 5); tv[i] = W[(size_t)(k0 + kk) * ldw + n0 + (lane & 31)]; }
#pragma unroll
    for (int i = 0; i < 32; ++i) { const int kk = 2 * i + (lane >> 5); scr[kk * 33 + (lane & 31)] = tv[i] * 256.0f; }
    LDS_WAIT(); asm volatile("" ::: "memory");
    const int c = lane & 7;
#pragma unroll
    for (int j = 0; j < 4; ++j) { const int n = (lane >> 3) + 8 * j; const LAS float* s = scr + (8 * c) * 33 + n;
        v2u o; o.x = pk4_fp8(s[0 * 33], s[1 * 33], s[2 * 33], s[3 * 33]); o.y = pk4_fp8(s[4 * 33], s[5 * 33], s[6 * 33], s[7 * 33]);
        *(v2u*)(WT + (size_t)dest_row<MODE>(n0 + n) * K + k0 + 8 * c) = o; }
    LDS_WAIT(); asm volatile("s_waitcnt vmcnt(0)" ::: "memory");
}

__device__ __forceinline__ void phase_prologue(Frame& F, const Args& A) {
#ifdef ADA_FAST
    {
        const float* cc = A.in[I_C]; float* mod = (float*)(F.ws + WS_MOD);
        LAS float* red = (LAS float*)F.lds;
        LAS float* scl = (LAS float*)(F.lds + 32768);
        for (int q = F.tid; q < 4 * DM; q += NWAVES * 64) { const int b = q >> 11, k = q & (DM - 1); const float cv = cc[b * DM + k]; scl[k * 4 + b] = cv / (1.0f + __expf(-cv)); }
        __syncthreads();
        for (int id = F.vcu; id < 2 * 128; id += F.G) {
            const int l = id >> 7, ch = id & 127, cg = F.tid & 31, kg = F.tid >> 5, col = ch * 96 + cg * 4;
            const float* w = A.in[I_ADAW] + (size_t)l * DM * 12288 + col;
            f32x4 acc[4] = {};
            if (cg < 24) {
#pragma unroll 1
                for (int k0 = 0; k0 < 128; k0 += 16) { f32x4 wv[16];
#pragma unroll
                    for (int u = 0; u < 16; ++u) wv[u] = *(const f32x4*)(w + (size_t)(kg * 128 + k0 + u) * 12288);
#pragma unroll
                    for (int u = 0; u < 16; ++u) { const f32x4 ca = *(LAS f32x4*)(scl + (kg * 128 + k0 + u) * 4);
#pragma unroll
                        for (int b = 0; b < 4; ++b) acc[b] += wv[u] * ca[b]; } } }
#pragma unroll
            for (int b = 0; b < 4; ++b) *(LAS f32x4*)(red + ((kg * 32 + cg) * 16 + b * 4)) = acc[b];
            __syncthreads();
            if (F.tid < 128 && (F.tid & 31) < 24) { const int cg2 = F.tid & 31, b = F.tid >> 5; f32x4 s = {0.f, 0.f, 0.f, 0.f};
#pragma unroll
                for (int g = 0; g < 16; ++g) s += *(LAS f32x4*)(red + ((g * 32 + cg2) * 16 + b * 4));
                const int c2 = ch * 96 + cg2 * 4; const f32x4 bv = *(const f32x4*)(A.in[I_ADAB] + (size_t)l * 12288 + c2);
                *(f32x4*)(mod + ((size_t)l * 4 + b) * 12288 + c2) = s + bv; }
            asm volatile("s_waitcnt vmcnt(0)" ::: "memory");
            __syncthreads();
        }
    }
#else
    {
        const float* cc = A.in[I_C]; float* mod = (float*)(F.ws + WS_MOD);
        LAS float* red = (LAS float*)F.lds;
        for (int id = F.vcu; id < 2 * 96; id += F.G) {
            const int l = id / 96, ch = id % 96, cg = F.tid & 31, kg = F.tid >> 5, col = ch * 128 + cg * 4;
            const float* w = A.in[I_ADAW] + (size_t)l * DM * 12288 + col;
            f32x4 acc[4] = {};
#pragma unroll 4
            for (int kk = 0; kk < 128; ++kk) { const int k = kg * 128 + kk; const f32x4 wv = *(const f32x4*)(w + (size_t)k * 12288);
#pragma unroll
                for (int b = 0; b < 4; ++b) { const float cv = cc[b * DM + k]; const float ca = cv / (1.0f + __expf(-cv)); acc[b] += wv * ca; } }
#pragma unroll
            for (int b = 0; b < 4; ++b) *(LAS f32x4*)(red + ((kg * 32 + cg) * 16 + b * 4)) = acc[b];
            __syncthreads();
            if (F.tid < 128) { const int cg2 = F.tid & 31, b = F.tid >> 5; f32x4 s = {0.f, 0.f, 0.f, 0.f};
#pragma unroll
                for (int g = 0; g < 16; ++g) s += *(LAS f32x4*)(red + ((g * 32 + cg2) * 16 + b * 4));
                const int c2 = ch * 128 + cg2 * 4; const f32x4 bv = *(const f32x4*)(A.in[I_ADAB] + (size_t)l * 12288 + c2);
                *(f32x4*)(mod + ((size_t)l * 4 + b) * 12288 + c2) = s + bv; }
            asm volatile("s_waitcnt vmcnt(0)" ::: "memory");
            __syncthreads();
        }
    }
#endif
    {
        LAS float* scr = (LAS float*)(F.lds + F.wave * 16384);
        const int gw = F.vcu * NWAVES + F.wave, NGW = F.G * NWAVES;
        constexpr int I_IN = (DM / 64) * (IN_COLS / 32), I_UQ = (512 / 64) * (1536 / 32), I_UKV = (256 / 64) * (2048 / 32), I_OUT = (DM / 64) * (DM / 32), I_L = I_IN + I_UQ + I_UKV + I_OUT;
        for (int it = gw; it < 2 * I_L; it += NGW) {
            const int l = it / I_L; int r = it % I_L;
            if (r < I_IN) { transpose_item<1>(A.in[I_WIN] + (size_t)l * DM * IN_COLS, IN_COLS, DM, IN_COLS, (bf16*)(F.ws + WS_WIN) + (size_t)l * 4096 * DM, nullptr, scr, r, F.lane); continue; } r -= I_IN;
            if (r < I_UQ) { transpose_item<2>(A.in[I_WUQ] + (size_t)l * 512 * 1536, 1536, 512, 1536, (bf16*)(F.ws + WS_WUQ) + (size_t)l * 1536 * 512, A.in[I_QNG] + l * 512, scr, r, F.lane); continue; } r -= I_UQ;
            if (r < I_UKV) { transpose_item<0>(A.in[I_WUKV] + (size_t)l * 256 * 2048, 2048, 256, 2048, (bf16*)(F.ws + WS_WUKV) + (size_t)l * 2048 * 256, A.in[I_KVNG] + l * 256, scr, r, F.lane); continue; } r -= I_UKV;
#ifdef G3_FP8
            transpose_item8<0>(A.in[I_WOUT] + (size_t)l * DM * DM, DM, DM, DM, F.ws + WS_WOUT + (size_t)l * DM * DM, scr, r, F.lane);
#else
            transpose_item<0>(A.in[I_WOUT] + (size_t)l * DM * DM, DM, DM, DM, (bf16*)(F.ws + WS_WOUT) + (size_t)l * DM * DM, nullptr, scr, r, F.lane);
#endif
        }
    }
    {
        const int gt = F.vcu * (NWAVES * 64) + F.tid, NGT = F.G * NWAVES * 64;
        float* rope = (float*)(F.ws + WS_ROPE);
        for (int e = gt; e < SEQ * 32; e += NGT) { const int pos = e >> 5, i = e & 31;
            const float ang = (float)pos * A.invf[i];
            const double rev = (double)ang * 0.15915494309189535; const float fr = (float)(rev - __builtin_floor(rev));
            *(f32x2*)(rope + (size_t)e * 2) = (f32x2){__builtin_amdgcn_cosf(fr), __builtin_amdgcn_sinf(fr)}; }
        for (int e = gt; e < 2 * 192 * (DM / 8); e += NGT) { const int l = e / (192 * (DM / 8)), r = e % (192 * (DM / 8));
            *(v4u*)((bf16*)(F.ws + WS_WIN) + ((size_t)l * 4096 + IN_COLS) * DM + (size_t)r * 8) = (v4u){0u, 0u, 0u, 0u}; }
    }
}

#ifdef Y_FP8
typedef unsigned YRAW;
#define YLD(Yp, r, c) (*(const unsigned*)((const unsigned char*)(Yp) + (size_t)(r) * DM + (c)))
__device__ __forceinline__ f32x4 ysum8(unsigned a, unsigned b) {
    const f32x2 a0 = __builtin_amdgcn_cvt_pk_f32_fp8((int)a, false), a1 = __builtin_amdgcn_cvt_pk_f32_fp8((int)a, true), b0 = __builtin_amdgcn_cvt_pk_f32_fp8((int)b, false), b1 = __builtin_amdgcn_cvt_pk_f32_fp8((int)b, true);
    return (f32x4){a0[0] + b0[0], a0[1] + b0[1], a1[0] + b1[0], a1[1] + b1[1]} * (1.0f / 16.0f); }
#define YSUM(a, b) ysum8(a, b)
#else
typedef v2u YRAW;
#define YLD(Yp, r, c) (*(const v2u*)((Yp) + (size_t)(r) * DM + (c)))
#define YSUM(y0, y1) ((f32x4){bf_lo((y0).x) + bf_lo((y1).x), bf_hi((y0).x) + bf_hi((y1).x), bf_lo((y0).y) + bf_lo((y1).y), bf_hi((y0).y) + bf_hi((y1).y)})
#endif
__device__ __forceinline__ void phase_norm1(Frame& F, const Args& A, int l) {
    const int gw = F.vcu * NWAVES + F.wave, NGW = F.G * NWAVES;
    const float* mod = (const float*)(F.ws + WS_MOD);
    bf16* H = (bf16*)(F.ws + WS_H); const bf16* Y = (const bf16*)(F.ws + WS_Y);
#ifdef THIN_MLP
    for (int ch = gw; ch < T / 16; ch += NGW) {
        const int row0 = ch * 16, b = row0 >> 13;
        const float* ml = mod + ((size_t)l * 4 + b) * 12288;
#pragma unroll 1
        for (int rr = 0; rr < 16; rr += 2) {
            f32x4 v[2][8];
            if (l == 0) {
#pragma unroll
                for (int q = 0; q < 2; ++q)
#pragma unroll
                    for (int j = 0; j < 8; ++j) v[q][j] = *(const f32x4*)(A.in[I_X] + (size_t)(row0 + rr + q) * DM + 4 * F.lane + 256 * j);
            } else {
                bf16* XB = (bf16*)(F.ws + WS_XB);
                v2u xw[2][8]; YRAW ya[2][8], yb[2][8]; f32x4 g2p[8];
#pragma unroll
                for (int q = 0; q < 2; ++q)
#pragma unroll
                    for (int j = 0; j < 8; ++j) { const int c = 4 * F.lane + 256 * j; const int row = row0 + rr + q;
                        xw[q][j] = *(const v2u*)(XB + (size_t)row * DM + c); ya[q][j] = YLD(Y, 2 * row, c); yb[q][j] = YLD(Y, 2 * row + 1, c); }
#pragma unroll
                for (int j = 0; j < 8; ++j) g2p[j] = *(const f32x4*)(mod + ((size_t)(l - 1) * 4 + b) * 12288 + 5 * DM + 4 * F.lane + 256 * j);
#pragma unroll
                for (int q = 0; q < 2; ++q)
#pragma unroll
                    for (int j = 0; j < 8; ++j) { const int c = 4 * F.lane + 256 * j; const int row = row0 + rr + q;
                        const f32x4 xr = {bf_lo(xw[q][j].x), bf_hi(xw[q][j].x), bf_lo(xw[q][j].y), bf_hi(xw[q][j].y)};
                        const f32x4 ys = YSUM(ya[q][j], yb[q][j]);
                        const f32x4 t = xr + g2p[j] * ys;
                        const v2u ow = {pk2(t.x, t.y), pk2(t.z, t.w)}; *(v2u*)(XB + (size_t)row * DM + c) = ow;
                        v[q][j] = (f32x4){bf_lo(ow.x), bf_hi(ow.x), bf_lo(ow.y), bf_hi(ow.y)}; }
            }
            float rstd[2];
#pragma unroll
            for (int q = 0; q < 2; ++q) { float s = 0.f;
#pragma unroll
                for (int j = 0; j < 8; ++j) s += (v[q][j].x * v[q][j].x + v[q][j].y * v[q][j].y) + (v[q][j].z * v[q][j].z + v[q][j].w * v[q][j].w);
                rstd[q] = __builtin_amdgcn_rsqf(wave_sum(s) * (1.f / DM) + EPS); }
#pragma unroll
            for (int j = 0; j < 8; ++j) { const int c = 4 * F.lane + 256 * j;
                const f32x4 gsc = *(const f32x4*)(A.in[I_N1G] + l * DM + c) * (*(const f32x4*)(ml + 1 * DM + c) + 1.0f), sh = *(const f32x4*)(ml + 0 * DM + c);
#pragma unroll
                for (int q = 0; q < 2; ++q) { const f32x4 o = v[q][j] * rstd[q] * gsc + sh;
                    *(v2u*)(H + (size_t)(row0 + rr + q) * DM + c) = (v2u){pk2(o.x, o.y), pk2(o.z, o.w)}; } }
        }
    }
#else
    for (int ch = gw; ch < T / 16; ch += NGW) {
        const int row0 = ch * 16, b = row0 >> 13;
        const float* ml = mod + ((size_t)l * 4 + b) * 12288;
        f32x4 gsc[8], sh[8], g2p[8];
#pragma unroll
        for (int j = 0; j < 8; ++j) { const int c = 4 * F.lane + 256 * j; const f32x4 g = *(const f32x4*)(A.in[I_N1G] + l * DM + c), sc = *(const f32x4*)(ml + 1 * DM + c);
            gsc[j] = g * (sc + 1.0f); sh[j] = *(const f32x4*)(ml + 0 * DM + c);
            if (l > 0) g2p[j] = *(const f32x4*)(mod + ((size_t)(l - 1) * 4 + b) * 12288 + 5 * DM + c); }
#pragma unroll 1
        for (int rr = 0; rr < 16; ++rr) {
            const int row = row0 + rr; f32x4 v[8]; float s = 0.f;
            if (l == 0) {
#pragma unroll
                for (int j = 0; j < 8; ++j) v[j] = *(const f32x4*)(A.in[I_X] + (size_t)row * DM + 4 * F.lane + 256 * j);
            } else {
#pragma unroll
                for (int j = 0; j < 8; ++j) { const int c = 4 * F.lane + 256 * j;
#ifdef XRES_BF16
                    bf16* XB = (bf16*)(F.ws + WS_XB); const v2u xw = *(const v2u*)(XB + (size_t)row * DM + c); const f32x4 xr = {bf_lo(xw.x), bf_hi(xw.x), bf_lo(xw.y), bf_hi(xw.y)};
#else
                    const f32x4 xr = *(const f32x4*)(A.out + (size_t)row * DM + c);
#endif
                    const v2u y0 = *(const v2u*)(Y + (size_t)(2 * row) * DM + c), y1 = *(const v2u*)(Y + (size_t)(2 * row + 1) * DM + c);
                    const f32x4 ys = {bf_lo(y0.x) + bf_lo(y1.x), bf_hi(y0.x) + bf_hi(y1.x), bf_lo(y0.y) + bf_lo(y1.y), bf_hi(y0.y) + bf_hi(y1.y)};
                    v[j] = xr + g2p[j] * ys;
#ifdef XRES_BF16
                    { const v2u ow = {pk2(v[j].x, v[j].y), pk2(v[j].z, v[j].w)}; *(v2u*)(XB + (size_t)row * DM + c) = ow;
                      v[j] = (f32x4){bf_lo(ow.x), bf_hi(ow.x), bf_lo(ow.y), bf_hi(ow.y)}; }
#else
                    *(f32x4*)(A.out + (size_t)row * DM + c) = v[j];
#endif
                }
            }
#pragma unroll
            for (int j = 0; j < 8; ++j) s += (v[j].x * v[j].x + v[j].y * v[j].y) + (v[j].z * v[j].z + v[j].w * v[j].w);
            const float rstd = __builtin_amdgcn_rsqf(wave_sum(s) * (1.f / DM) + EPS);
#pragma unroll
            for (int j = 0; j < 8; ++j) { const f32x4 o = v[j] * rstd * gsc[j] + sh[j];
                *(v2u*)(H + (size_t)row * DM + 4 * F.lane + 256 * j) = (v2u){pk2(o.x, o.y), pk2(o.z, o.w)}; }
        }
    }
#endif
#ifndef ATT_CONV
    {
        LAS float* scr = (LAS float*)(F.lds + F.wave * 16384);
        constexpr int I_G = (DM / 64) * (DEXP / 32), I_D = (DEXP / 64) * (DM / 32), I_E = 2 * I_G + I_D;
        for (int it = gw; it < NEXP * I_E; it += NGW) {
            const int e = it / I_E; int r = it % I_E; const size_t eo = ((size_t)l * NEXP + e) * DM * DEXP;
            if (r < I_G) { transpose_item8<3>(A.in[I_EG] + eo, DEXP, DM, DEXP, F.ws + WS_W13 + (size_t)e * 2048 * DM, scr, r, F.lane); continue; } r -= I_G;
            if (r < I_G) { transpose_item8<4>(A.in[I_EU] + eo, DEXP, DM, DEXP, F.ws + WS_W13 + (size_t)e * 2048 * DM, scr, r, F.lane); continue; } r -= I_G;
            transpose_item8<0>(A.in[I_ED] + eo, DM, DEXP, DM, F.ws + WS_W2 + (size_t)e * DM * DEXP, scr, r, F.lane);
        }
    }
#endif
}
__device__ __forceinline__ void phase_final(Frame& F, const Args& A, int probe) {
    const int gw = F.vcu * NWAVES + F.wave, NGW = F.G * NWAVES;
    const float* mod = (const float*)(F.ws + WS_MOD); const bf16* Y = (const bf16*)(F.ws + WS_Y);
    for (int ch = gw; ch < T / 16; ch += NGW) {
        const int row0 = ch * 16, b = row0 >> 13;
#if defined(THIN_MLP) && defined(XRES_BF16)
#pragma unroll 1
        for (int rr = 0; rr < 16; rr += 2) {
            v2u xw[2][8]; YRAW ya[2][8], yb[2][8]; f32x4 g2p[8]; f32x4 v[2][8];
#pragma unroll
            for (int q = 0; q < 2; ++q)
#pragma unroll
                for (int j = 0; j < 8; ++j) { const int c = 4 * F.lane + 256 * j; const int row = row0 + rr + q;
                    xw[q][j] = *(const v2u*)((const bf16*)(F.ws + WS_XB) + (size_t)row * DM + c); ya[q][j] = YLD(Y, 2 * row, c); yb[q][j] = YLD(Y, 2 * row + 1, c); }
#pragma unroll
            for (int j = 0; j < 8; ++j) g2p[j] = *(const f32x4*)(mod + ((size_t)(probe == 3 ? 0 : DEPTH - 1) * 4 + b) * 12288 + 5 * DM + 4 * F.lane + 256 * j);
            float rstd[2];
#pragma unroll
            for (int q = 0; q < 2; ++q) { float s = 0.f;
#pragma unroll
                for (int j = 0; j < 8; ++j) { const f32x4 xr = {bf_lo(xw[q][j].x), bf_hi(xw[q][j].x), bf_lo(xw[q][j].y), bf_hi(xw[q][j].y)};
                    const f32x4 ys = YSUM(ya[q][j], yb[q][j]);
                    v[q][j] = (probe == 1 || probe == 2) ? xr : xr + g2p[j] * ys; }
#pragma unroll
                for (int j = 0; j < 8; ++j) s += (v[q][j].x * v[q][j].x + v[q][j].y * v[q][j].y) + (v[q][j].z * v[q][j].z + v[q][j].w * v[q][j].w);
                rstd[q] = __builtin_amdgcn_rsqf(wave_sum(s) * (1.f / DM) + EPS); }
#pragma unroll
            for (int j = 0; j < 8; ++j) { const int c = 4 * F.lane + 256 * j; const f32x4 fg = *(const f32x4*)(A.in[I_FG] + c);
#pragma unroll
                for (int q = 0; q < 2; ++q) *(f32x4*)(A.out + (size_t)(row0 + rr + q) * DM + c) = v[q][j] * rstd[q] * fg; }
        }
#else
        f32x4 fg[8], g2p[8];
#pragma unroll
        for (int j = 0; j < 8; ++j) { const int c = 4 * F.lane + 256 * j; fg[j] = *(const f32x4*)(A.in[I_FG] + c); g2p[j] = *(const f32x4*)(mod + ((size_t)(probe == 3 ? 0 : DEPTH - 1) * 4 + b) * 12288 + 5 * DM + c); }
#pragma unroll 1
        for (int rr = 0; rr < 16; ++rr) {
            const int row = row0 + rr; f32x4 v[8]; float s = 0.f;
#pragma unroll
            for (int j = 0; j < 8; ++j) { const int c = 4 * F.lane + 256 * j;
#ifdef XRES_BF16
                const v2u xw = *(const v2u*)((const bf16*)(F.ws + WS_XB) + (size_t)row * DM + c); const f32x4 xr = {bf_lo(xw.x), bf_hi(xw.x), bf_lo(xw.y), bf_hi(xw.y)};
#else
                const f32x4 xr = *(const f32x4*)((probe == 2 ? A.in[I_X] : A.out) + (size_t)row * DM + c);
#endif
                const v2u y0 = *(const v2u*)(Y + (size_t)(2 * row) * DM + c), y1 = *(const v2u*)(Y + (size_t)(2 * row + 1) * DM + c);
                const f32x4 ys = {bf_lo(y0.x) + bf_lo(y1.x), bf_hi(y0.x) + bf_hi(y1.x), bf_lo(y0.y) + bf_lo(y1.y), bf_hi(y0.y) + bf_hi(y1.y)};
                v[j] = (probe == 1 || probe == 2) ? xr : xr + g2p[j] * ys; }
#pragma unroll
            for (int j = 0; j < 8; ++j) s += (v[j].x * v[j].x + v[j].y * v[j].y) + (v[j].z * v[j].z + v[j].w * v[j].w);
            const float rstd = __builtin_amdgcn_rsqf(wave_sum(s) * (1.f / DM) + EPS);
#pragma unroll
            for (int j = 0; j < 8; ++j) *(f32x4*)(A.out + (size_t)row * DM + 4 * F.lane + 256 * j) = v[j] * rstd * fg[j];
        }
#endif
    }
}
#ifndef PROBE_DUMP_SCALE
#define PROBE_DUMP_SCALE 1.0f
#endif
#ifndef PROBE_DUMP_W
#define PROBE_DUMP_W 2048
#endif
__device__ __forceinline__ void phase_dump(Frame& F, const Args& A, size_t off, int pitch) {
    const int gw = F.vcu * NWAVES + F.wave, NGW = F.G * NWAVES;
    for (int row = gw; row < T; row += NGW) { const bf16* src = (const bf16*)(F.ws + off) + (size_t)row * pitch;
#ifdef PROBE_DUMP_F32
        for (int j = 0; j < 8; ++j) { const int c = 4 * F.lane + 256 * j; const float* sf = (const float*)(F.ws + off) + (size_t)row * pitch + c;
#ifdef PROBE_DUMP_SRC_OUT
            sf = A.out + (size_t)row * DM + c;
#endif
            f32x4 o = {0.f, 0.f, 0.f, 0.f}; if (c < PROBE_DUMP_W) o = *(const f32x4*)sf * PROBE_DUMP_SCALE;
#ifdef PROBE_DUMP_LOWBITS
            { const v4u ub = __builtin_bit_cast(v4u, o); o = (f32x4){(float)(ub.x & 0xFFFu), (float)(ub.y & 0xFFFu), (float)(ub.z & 0xFFFu), (float)(ub.w & 0xFFFu)}; }
#endif
            *(f32x4*)(A.out + (size_t)row * DM + c) = o; }
        continue;
#endif
        for (int j = 0; j < 8; ++j) { const int c = 4 * F.lane + 256 * j; const v2u w = *(const v2u*)(src + c);
#ifdef PROBE_DUMP_LOWBITS
            *(f32x4*)(A.out + (size_t)row * DM + c) = c < PROBE_DUMP_W ? (f32x4){(float)(w.x & 0x7Fu), (float)((w.x >> 16) & 0x7Fu), (float)(w.y & 0x7Fu), (float)((w.y >> 16) & 0x7Fu)} : (f32x4){0.f, 0.f, 0.f, 0.f}; } }
#else
            *(f32x4*)(A.out + (size_t)row * DM + c) = c < PROBE_DUMP_W ? (f32x4){bf_lo(w.x), bf_hi(w.x), bf_lo(w.y), bf_hi(w.y)} : (f32x4){0.f, 0.f, 0.f, 0.f}; } }
#endif
}
__device__ __forceinline__ void phase_mla_prep(Frame& F, const Args& A) {
    const int gw = F.vcu * NWAVES + F.wave, NGW = F.G * NWAVES;
    const bf16* P = (const bf16*)(F.ws + WS_PROJ); bf16* KF = (bf16*)(F.ws + WS_KF);
    float* rq = (float*)(F.ws + WS_RSTDQ); float* rkv = (float*)(F.ws + WS_RSTDKV); const float* rope = (const float*)(F.ws + WS_ROPE);
    for (int ch = gw; ch < T / 16; ch += NGW) {
#pragma unroll 1
        for (int r4 = 0; r4 < 16; r4 += 4) {
            v4u q[4]; v2u kv[4]; unsigned kr[4]; f32x2 cs[4];
#pragma unroll
            for (int u = 0; u < 4; ++u) { const int row = ch * 16 + r4 + u; const bf16* pr = P + (size_t)row * PROJ_LD;
                q[u] = *(const v4u*)(pr + C_CQ + 8 * F.lane); kv[u] = *(const v2u*)(pr + C_CKV + 4 * F.lane);
                kr[u] = *(const unsigned*)(pr + C_KR + 2 * (F.lane & 31)); cs[u] = *(const f32x2*)(rope + ((size_t)(row & (SEQ - 1)) * 32 + (F.lane & 31)) * 2); }
#pragma unroll
            for (int u = 0; u < 4; ++u) { const int row = ch * 16 + r4 + u;
                float sq = 0.f, skv = 0.f;
#pragma unroll
                for (int i = 0; i < 4; ++i) { const float a = bf_lo(q[u][i]), b2 = bf_hi(q[u][i]); sq += a * a + b2 * b2; }
#pragma unroll
                for (int i = 0; i < 2; ++i) { const float a = bf_lo(kv[u][i]), b2 = bf_hi(kv[u][i]); skv += a * a + b2 * b2; }
                sq = wave_sum(sq); skv = wave_sum(skv);
                if (F.lane == 0) { rq[row] = __builtin_amdgcn_rsqf(sq * (1.f / 512.f) + EPS); rkv[row] = __builtin_amdgcn_rsqf(skv * (1.f / 256.f) + EPS); }
                if (F.lane < 32) { const float x1 = bf_lo(kr[u]), x2 = bf_hi(kr[u]);
                    const unsigned o = pk2(x1 * cs[u].x - x2 * cs[u].y, x2 * cs[u].x + x1 * cs[u].y);
#pragma unroll
                    for (int h = 0; h < 8; ++h) *(unsigned*)(KF + (size_t)row * 1536 + h * 192 + 128 + 2 * F.lane) = o; } }
        }
    }
}
__device__ __forceinline__ void phase_q_rope(Frame& F, const Args& A) {
    const int gw = F.vcu * NWAVES + F.wave, NGW = F.G * NWAVES;
    bf16* QA = (bf16*)(F.ws + WS_QA); const float* rope = (const float*)(F.ws + WS_ROPE);
    for (int ch = gw; ch < T / 16; ch += NGW) {
#pragma unroll 1
        for (int r4 = 0; r4 < 16; r4 += 4) {
            v4u w[4]; f32x4 c01[4], c23[4];
#pragma unroll
            for (int u = 0; u < 4; ++u) { const int row = ch * 16 + r4 + u;
                w[u] = *(const v4u*)(QA + (size_t)row * 1536 + (F.lane >> 3) * 192 + 128 + (F.lane & 7) * 8);
                const f32x4* cs = (const f32x4*)(rope + ((size_t)(row & (SEQ - 1)) * 32 + (F.lane & 7) * 4) * 2); c01[u] = cs[0]; c23[u] = cs[1]; }
#pragma unroll
            for (int u = 0; u < 4; ++u) { const int row = ch * 16 + r4 + u; v4u o;
                { const float x1 = bf_lo(w[u].x), x2 = bf_hi(w[u].x); o.x = pk2(x1 * c01[u][0] - x2 * c01[u][1], x2 * c01[u][0] + x1 * c01[u][1]); }
                { const float x1 = bf_lo(w[u].y), x2 = bf_hi(w[u].y); o.y = pk2(x1 * c01[u][2] - x2 * c01[u][3], x2 * c01[u][2] + x1 * c01[u][3]); }
                { const float x1 = bf_lo(w[u].z), x2 = bf_hi(w[u].z); o.z = pk2(x1 * c23[u][0] - x2 * c23[u][1], x2 * c23[u][0] + x1 * c23[u][1]); }
                { const float x1 = bf_lo(w[u].w), x2 = bf_hi(w[u].w); o.w = pk2(x1 * c23[u][2] - x2 * c23[u][3], x2 * c23[u][2] + x1 * c23[u][3]); }
                *(v4u*)(QA + (size_t)row * 1536 + (F.lane >> 3) * 192 + 128 + (F.lane & 7) * 8) = o; }
        }
    }
}
#ifndef THIN_RO
#define THIN_RO 2
#endif
__device__ __forceinline__ void phase_out_norm(Frame& F, const Args& A, int l) {
    const int gw = F.vcu * NWAVES + F.wave, NGW = F.G * NWAVES;
    const bf16* OA = (const bf16*)(F.ws + WS_OA); const bf16* OB = (const bf16*)(F.ws + WS_OB); const float* LSE = (const float*)(F.ws + WS_LSE); bf16* Yn = (bf16*)(F.ws + WS_H);
    for (int ch = gw; ch < T / 16; ch += NGW) {
        float ga[2][8], gb[2][8];
#pragma unroll
        for (int hf = 0; hf < 2; ++hf)
#pragma unroll
            for (int i = 0; i < 8; ++i) { ga[hf][i] = A.in[I_ONA][l * 1024 + hf * 512 + 8 * F.lane + i]; gb[hf][i] = A.in[I_ONB][l * 1024 + hf * 512 + 8 * F.lane + i]; }
#ifdef THIN_MLP
#pragma unroll 1
        for (int rr = 0; rr < 16; rr += THIN_RO) {
            v4u ra_[THIN_RO][2], ro_[THIN_RO][2][3]; float ls_[THIN_RO][2][3];
#pragma unroll
            for (int q = 0; q < THIN_RO; ++q)
#pragma unroll
                for (int hf = 0; hf < 2; ++hf) { const int row = ch * 16 + rr + q, c = hf * 512 + 8 * F.lane, hd = c >> 7;
                    ra_[q][hf] = *(const v4u*)(OA + (size_t)row * 1024 + c);
#pragma unroll
                    for (int n = 0; n < 3; ++n) { ro_[q][hf][n] = *(const v4u*)(OB + ((size_t)n * T + row) * 1024 + c); ls_[q][hf][n] = LSE[((size_t)n * T + row) * 8 + hd]; } }
#pragma unroll
            for (int q = 0; q < THIN_RO; ++q) {
                const int row = ch * 16 + rr + q;
                float va[2][8], vb[2][8]; float sa = 0.f, sb = 0.f;
#pragma unroll
                for (int hf = 0; hf < 2; ++hf) {
                    const v4u a = ra_[q][hf];
#pragma unroll
                    for (int i = 0; i < 4; ++i) { va[hf][2 * i] = bf_lo(a[i]); va[hf][2 * i + 1] = bf_hi(a[i]); }
                    const float l0 = ls_[q][hf][0], l1 = ls_[q][hf][1], l2 = ls_[q][hf][2];
                    const float mx = fmaxf(l0, fmaxf(l1, l2)); const float e0 = __expf(l0 - mx), e1 = __expf(l1 - mx), e2 = __expf(l2 - mx); const float inv = 1.0f / (e0 + e1 + e2);
                    const float al[3] = {e0 * inv, e1 * inv, e2 * inv};
#pragma unroll
                    for (int i = 0; i < 8; ++i) vb[hf][i] = 0.f;
#pragma unroll
                    for (int n = 0; n < 3; ++n) { const v4u o = ro_[q][hf][n];
#pragma unroll
                        for (int i = 0; i < 4; ++i) { vb[hf][2 * i] += al[n] * bf_lo(o[i]); vb[hf][2 * i + 1] += al[n] * bf_hi(o[i]); } }
#pragma unroll
                    for (int i = 0; i < 8; ++i) { sa += va[hf][i] * va[hf][i]; sb += vb[hf][i] * vb[hf][i]; }
                }
                const float ra = __builtin_amdgcn_rsqf(wave_sum(sa) * (1.f / 1024.f) + EPS), rb = __builtin_amdgcn_rsqf(wave_sum(sb) * (1.f / 1024.f) + EPS);
#pragma unroll
                for (int hf = 0; hf < 2; ++hf) { const int c = hf * 512 + 8 * F.lane;
#ifdef G3_FP8
                    { unsigned char* Y8 = (unsigned char*)Yn; float ya[8], yb[8];
#pragma unroll
                      for (int i = 0; i < 8; ++i) { ya[i] = va[hf][i] * ra * ga[hf][i]; yb[i] = vb[hf][i] * rb * gb[hf][i]; }
                      *(v2u*)(Y8 + (size_t)row * DM + c) = (v2u){pk4_fp8(ya[0], ya[1], ya[2], ya[3]), pk4_fp8(ya[4], ya[5], ya[6], ya[7])};
                      *(v2u*)(Y8 + (size_t)row * DM + 1024 + c) = (v2u){pk4_fp8(yb[0], yb[1], yb[2], yb[3]), pk4_fp8(yb[4], yb[5], yb[6], yb[7])}; }
#else
                    { v4u wa, wb;
#pragma unroll
                      for (int i = 0; i < 4; ++i) { wa[i] = pk2(va[hf][2 * i] * ra * ga[hf][2 * i], va[hf][2 * i + 1] * ra * ga[hf][2 * i + 1]); wb[i] = pk2(vb[hf][2 * i] * rb * gb[hf][2 * i], vb[hf][2 * i + 1] * rb * gb[hf][2 * i + 1]); }
                      *(v4u*)(Yn + (size_t)row * DM + c) = wa; *(v4u*)(Yn + (size_t)row * DM + 1024 + c) = wb; }
#endif
                }
            }
        }
#else
#pragma unroll 1
        for (int rr = 0; rr < 16; ++rr) {
            const int row = ch * 16 + rr;
            float va[2][8], vb[2][8]; float sa = 0.f, sb = 0.f;
#pragma unroll
            for (int hf = 0; hf < 2; ++hf) {
                const int c = hf * 512 + 8 * F.lane, hd = c >> 7;
                const v4u a = *(const v4u*)(OA + (size_t)row * 1024 + c);
#pragma unroll
                for (int i = 0; i < 4; ++i) { va[hf][2 * i] = bf_lo(a[i]); va[hf][2 * i + 1] = bf_hi(a[i]); }
                const float l0 = LSE[((size_t)0 * T + row) * 8 + hd], l1 = LSE[((size_t)1 * T + row) * 8 + hd], l2 = LSE[((size_t)2 * T + row) * 8 + hd];
                const float mx = fmaxf(l0, fmaxf(l1, l2)); const float e0 = __expf(l0 - mx), e1 = __expf(l1 - mx), e2 = __expf(l2 - mx); const float inv = 1.0f / (e0 + e1 + e2);
                const float al[3] = {e0 * inv, e1 * inv, e2 * inv};
#pragma unroll
                for (int i = 0; i < 8; ++i) vb[hf][i] = 0.f;
#pragma unroll
                for (int n = 0; n < 3; ++n) { const v4u o = *(const v4u*)(OB + ((size_t)n * T + row) * 1024 + c);
#pragma unroll
                    for (int i = 0; i < 4; ++i) { vb[hf][2 * i] += al[n] * bf_lo(o[i]); vb[hf][2 * i + 1] += al[n] * bf_hi(o[i]); } }
#pragma unroll
                for (int i = 0; i < 8; ++i) { sa += va[hf][i] * va[hf][i]; sb += vb[hf][i] * vb[hf][i]; }
            }
            const float ra = __builtin_amdgcn_rsqf(wave_sum(sa) * (1.f / 1024.f) + EPS), rb = __builtin_amdgcn_rsqf(wave_sum(sb) * (1.f / 1024.f) + EPS);
#pragma unroll
            for (int hf = 0; hf < 2; ++hf) { const int c = hf * 512 + 8 * F.lane; v4u wa, wb;
#pragma unroll
                for (int i = 0; i < 4; ++i) { wa[i] = pk2(va[hf][2 * i] * ra * ga[hf][2 * i], va[hf][2 * i + 1] * ra * ga[hf][2 * i + 1]); wb[i] = pk2(vb[hf][2 * i] * rb * gb[hf][2 * i], vb[hf][2 * i + 1] * rb * gb[hf][2 * i + 1]); }
#ifdef G3_FP8
                { unsigned char* Y8 = (unsigned char*)Yn; float ya[8], yb[8];
#pragma unroll
                  for (int i = 0; i < 8; ++i) { ya[i] = va[hf][i] * ra * ga[hf][i]; yb[i] = vb[hf][i] * rb * gb[hf][i]; }
                  *(v2u*)(Y8 + (size_t)row * DM + c) = (v2u){pk4_fp8(ya[0], ya[1], ya[2], ya[3]), pk4_fp8(ya[4], ya[5], ya[6], ya[7])};
                  *(v2u*)(Y8 + (size_t)row * DM + 1024 + c) = (v2u){pk4_fp8(yb[0], yb[1], yb[2], yb[3]), pk4_fp8(yb[4], yb[5], yb[6], yb[7])}; }
#else
                *(v4u*)(Yn + (size_t)row * DM + c) = wa; *(v4u*)(Yn + (size_t)row * DM + 1024 + c) = wb;
#endif
            }
        }
#endif
    }
}
#ifndef ROUTER_SRC
#define ROUTER_SRC A.out
#endif
#ifdef ROUTER_MFMA
typedef short r_bf16x8 __attribute__((ext_vector_type(8)));
#ifndef RPA
#define RPA 2
#endif
__device__ __forceinline__ void phase_router(Frame& F, const Args& A, int l, int dummy = 0) {
    const float* mod = (const float*)(F.ws + WS_MOD);
    bf16* H = (bf16*)(F.ws + WS_H);
    LAS int* lcnt = (LAS int*)(F.lds + L_CNT); LAS int* gbase = lcnt + 16; LAS int* tokinfo = (LAS int*)(F.lds + L_TOK);
    LAS float* lgs = (LAS float*)(F.lds + L_ATAB);
    LAS float* rsl = (LAS float*)(F.lds + L_ATAB + 8704);
    LAS float* wsm = (LAS float*)(F.lds + L_ATAB + 8704 + 512);
    LAS float* cstl = (LAS float*)(F.lds + L_ATAB + 8704 + 1024);
    unsigned* gcnt = F.ctl + CW_CNT + (dummy ? 3 : l) * 16;
    int* rowidx = (int*)(F.ws + (dummy ? WS_OB : WS_ROWIDX)); float* aw = (float*)(F.ws + (dummy ? WS_OB + 4 * MiB : WS_AW));
    float rb[16];
#pragma unroll
    for (int e = 0; e < 16; ++e) rb[e] = __uint_as_float(__builtin_amdgcn_readfirstlane(__float_as_uint(A.in[I_RB][e])));
    for (int bi = F.vcu; bi < T / 128; bi += F.G) {
        const int row0 = bi * 128 + F.wave * 16, b = row0 >> 13;
        const rsrc_t rml = RSRC(mod + ((size_t)l * 4 + b) * 12288), rgn = RSRC(A.in[I_N2G] + l * DM), rh = RSRC(H), rxb = RSRC(F.ws + WS_XB), rrw = RSRC(A.in[I_RW]);
        __syncthreads();
        { const int t0_ = F.wave * 64 + lane_id(); if (t0_ < 16) lcnt[t0_] = 0;
          const int e4 = t0_ & 3; f32x4 ca = {0.f, 0.f, 0.f, 0.f};
#pragma unroll 4
          for (int i = 0; i < 16; ++i) { const int k = (t0_ >> 2) + 128 * i;
              const f32x4 w4 = bld4f(rrw, (k * 16 + e4 * 4) * 4, 0);
              const float g = __uint_as_float(__builtin_amdgcn_raw_buffer_load_b32(rgn, k * 4, 0, 0)) * (__uint_as_float(__builtin_amdgcn_raw_buffer_load_b32(rml, k * 4, 4 * DM * 4, 0)) + 1.0f);
              const float sh = __uint_as_float(__builtin_amdgcn_raw_buffer_load_b32(rml, k * 4, 3 * DM * 4, 0));
              ca += w4 * sh;
              const int ob = (k >> 5) * 1024 + (((k >> 3) & 3) * 16 + e4 * 4) * 16 + (k & 7) * 2;
#pragma unroll
              for (int c = 0; c < 4; ++c) { const float wp = w4[c] * g; const unsigned hi = pk2(wp, 0.f) & 0xffffu; const float rem = wp - __uint_as_float(hi << 16);
                  *(LAS unsigned short*)(F.lds + ob + c * 16) = (unsigned short)hi; *(LAS unsigned short*)(F.lds + 65536 + ob + c * 16) = (unsigned short)(pk2(rem, 0.f) & 0xffffu); } }
          const int ln = t0_ & 63;
#pragma unroll
          for (int q = 0; q < 4; ++q)
#pragma unroll
              for (int c = 0; c < 4; ++c) { const float s = wave_sum((ln & 3) == q ? ca[c] : 0.f); if (ln == 0) wsm[F.wave * 16 + q * 4 + c] = s; }
        }
        __syncthreads();
        { const int t0_ = F.wave * 64 + lane_id(); if (t0_ < 16) { float s = 0.f;
#pragma unroll
              for (int w = 0; w < 8; ++w) s += wsm[w * 16 + t0_];
              cstl[t0_] = s; } }
        __syncthreads();
        const int lo16 = F.lane * 16, lo8 = F.lane * 8;
        f32x4 gsv[8];
#pragma unroll
        for (int j = 0; j < 8; ++j) gsv[j] = bld4f(rgn, lo16 + j * 1024, 0) * (bld4f(rml, lo16 + j * 1024, 4 * DM * 4) + 1.0f);
#pragma unroll 1
        for (int rp = 0; rp < 16 / RPA; ++rp) {
            float ss[RPA] = {};
            v2u xraw[RPA][8];
#pragma unroll
            for (int q = 0; q < RPA; ++q)
#pragma unroll
                for (int j = 0; j < 8; ++j) xraw[q][j] = bld2u(rxb, lo8 + j * 512, (row0 + rp * RPA + q) * (DM * 2));
#define XV(q, j) ((f32x4){bf_lo(xraw[q][j].x), bf_hi(xraw[q][j].x), bf_lo(xraw[q][j].y), bf_hi(xraw[q][j].y)})
            f32x4 shv[8];
#pragma unroll
            for (int j = 0; j < 8; ++j) shv[j] = bld4f(rml, lo16 + j * 1024, 3 * DM * 4);
#pragma unroll
            for (int j = 0; j < 8; ++j)
#pragma unroll
                for (int q = 0; q < RPA; ++q) { const f32x4 x = XV(q, j); ss[q] += (x.x * x.x + x.y * x.y) + (x.z * x.z + x.w * x.w); }
            float rstd[RPA];
#pragma unroll
            for (int q = 0; q < RPA; ++q) rstd[q] = __builtin_amdgcn_rsqf(wave_sum(ss[q]) * (1.f / DM) + EPS);
            if (F.lane == 0) {
#pragma unroll
                for (int q = 0; q < RPA; ++q) rsl[F.wave * 16 + rp * RPA + q] = rstd[q]; }
#pragma unroll
            for (int j = 0; j < 8; ++j) {
#pragma unroll
                for (int q = 0; q < RPA; ++q) { const f32x4 o = XV(q, j) * rstd[q] * gsv[j] + shv[j]; __builtin_amdgcn_raw_buffer_store_b32(pk4_fp8(o.x, o.y, o.z, o.w), rh, F.lane * 4 + j * 256, (row0 + rp * RPA + q) * DM, 0); } }
#undef XV
        }
        { const int ln = lane_id(), col = ln & 15, rq = ln >> 4;
          const int va = col * (DM * 2) + rq * 16, sa = row0 * (DM * 2);
          f32x4 acc = {0.f, 0.f, 0.f, 0.f};
          r_bf16x8 a0[8], a1[8];
#pragma unroll
          for (int i = 0; i < 8; ++i) a0[i] = __builtin_bit_cast(r_bf16x8, __builtin_amdgcn_raw_buffer_load_b128(rxb, va + i * 64, sa, 0));
#define RT_MM(AR, sb) do { _Pragma("unroll") for (int i = 0; i < 8; ++i) { const int st = (sb) * 8 + i; \
              const r_bf16x8 bh = *(const LAS r_bf16x8*)(F.lds + st * 1024 + ln * 16), bl = *(const LAS r_bf16x8*)(F.lds + 65536 + st * 1024 + ln * 16); \
              acc = __builtin_amdgcn_mfma_f32_16x16x32_bf16(AR[i], bh, acc, 0, 0, 0); acc = __builtin_amdgcn_mfma_f32_16x16x32_bf16(AR[i], bl, acc, 0, 0, 0); } } while (0)
#pragma unroll 1
          for (int sb = 0; sb < 8; sb += 2) {
#pragma unroll
              for (int i = 0; i < 8; ++i) a1[i] = __builtin_bit_cast(r_bf16x8, __builtin_amdgcn_raw_buffer_load_b128(rxb, va + ((sb + 1) * 8 + i) * 64, sa, 0));
              RT_MM(a0, sb);
              if (sb + 2 < 8) {
#pragma unroll
                  for (int i = 0; i < 8; ++i) a0[i] = __builtin_bit_cast(r_bf16x8, __builtin_amdgcn_raw_buffer_load_b128(rxb, va + ((sb + 2) * 8 + i) * 64, sa, 0)); }
              RT_MM(a1, sb + 1);
          }
#undef RT_MM
          LDS_WAIT();
          const float cs = cstl[col];
#pragma unroll
          for (int i = 0; i < 4; ++i) lgs[F.wave * 272 + (4 * rq + i) * 17 + col] = acc[i] * rsl[F.wave * 16 + 4 * rq + i] + cs;
          LDS_WAIT(); asm volatile("" ::: "memory");
          if (ln < 16) {
              float sc[16], bs[16];
#pragma unroll
              for (int e = 0; e < 16; ++e) { const float lg = lgs[F.wave * 272 + ln * 17 + e]; sc[e] = 1.0f / (1.0f + __expf(-lg)); bs[e] = sc[e] + rb[e]; }
              float gs4[4];
#pragma unroll
              for (int g = 0; g < 4; ++g) { const float a = bs[4 * g], b2 = bs[4 * g + 1], c = bs[4 * g + 2], d = bs[4 * g + 3];
                  const float h1 = fmaxf(a, b2), l1 = fminf(a, b2), h2 = fmaxf(c, d), l2 = fminf(c, d);
                  gs4[g] = fmaxf(h1, h2) + fmaxf(fminf(h1, h2), fmaxf(l1, l2)); }
              int gsel = 0; float gbest = gs4[0];
#pragma unroll
              for (int g = 1; g < 4; ++g) if (gs4[g] > gbest) { gbest = gs4[g]; gsel = g; }
              float bv[4], sv[4];
#pragma unroll
              for (int i = 0; i < 4; ++i) { bv[i] = gsel == 0 ? bs[i] : gsel == 1 ? bs[4 + i] : gsel == 2 ? bs[8 + i] : bs[12 + i]; sv[i] = gsel == 0 ? sc[i] : gsel == 1 ? sc[4 + i] : gsel == 2 ? sc[8 + i] : sc[12 + i]; }
              int i1 = 0; float b1 = bv[0], s1 = sv[0];
#pragma unroll
              for (int i = 1; i < 4; ++i) if (bv[i] > b1) { b1 = bv[i]; s1 = sv[i]; i1 = i; }
              int i2 = -1; float b2v = -__builtin_inff(), s2 = 0.f;
#pragma unroll
              for (int i = 0; i < 4; ++i) if (i != i1 && bv[i] > b2v) { b2v = bv[i]; s2 = sv[i]; i2 = i; }
              const float inv = 1.0f / (s1 + s2);
              const int r = F.wave * 16 + ln, e0 = gsel * 4 + i1, e1 = gsel * 4 + i2;
              tokinfo[r * 4 + 0] = e0; tokinfo[r * 4 + 2] = e1;
              const int row = row0 + ln; *(f32x2*)(aw + (size_t)row * 2) = (f32x2){s1 * inv, s2 * inv};
          }
        }
        __syncthreads();
        const int tb_ = F.wave * 64 + lane_id();
        {
            const int ln = tb_ & 63;
#pragma unroll
            for (int ee = 0; ee < 2; ++ee) { const int e = 2 * F.wave + ee; int base = 0;
#pragma unroll
                for (int hh = 0; hh < 2; ++hh) { const int r = hh * 64 + ln; const bool m0 = tokinfo[r * 4 + 0] == e, m1 = tokinfo[r * 4 + 2] == e;
                    const unsigned long long bal = __ballot(m0 || m1);
                    const int pos = base + __builtin_amdgcn_mbcnt_hi((unsigned)(bal >> 32), __builtin_amdgcn_mbcnt_lo((unsigned)bal, 0));
                    if (m0) tokinfo[r * 4 + 1] = pos; if (m1) tokinfo[r * 4 + 3] = pos;
                    base += __popcll(bal); }
                if (ln == 0) lcnt[e] = base; } }
        __syncthreads();
        if (tb_ < 16) gbase[tb_] = (int)__hip_atomic_fetch_add(gcnt + tb_, (unsigned)lcnt[tb_], __ATOMIC_RELAXED, __HIP_MEMORY_SCOPE_AGENT);
        __syncthreads();
        if (tb_ < 128) { const int e0 = tokinfo[tb_ * 4], p0 = tokinfo[tb_ * 4 + 1], e1 = tokinfo[tb_ * 4 + 2], p1 = tokinfo[tb_ * 4 + 3]; const int row = bi * 128 + tb_;
            rowidx[(size_t)e0 * 32768 + gbase[e0] + p0] = 2 * row; rowidx[(size_t)e1 * 32768 + gbase[e1] + p1] = 2 * row + 1; }
        __syncthreads();
    }
}
#else
__device__ __forceinline__ void phase_router(Frame& F, const Args& A, int l, int dummy = 0) {
    const float* mod = (const float*)(F.ws + WS_MOD);
    bf16* H = (bf16*)(F.ws + WS_H);
    LAS f32x4* rwl = (LAS f32x4*)F.lds;
    LAS int* lcnt = (LAS int*)(F.lds + L_CNT); LAS int* gbase = lcnt + 16; LAS int* tokinfo = (LAS int*)(F.lds + L_TOK);
    unsigned* gcnt = F.ctl + CW_CNT + (dummy ? 3 : l) * 16;
    int* rowidx = (int*)(F.ws + (dummy ? WS_OB : WS_ROWIDX)); float* aw = (float*)(F.ws + (dummy ? WS_OB + 4 * MiB : WS_AW));
    for (int q = F.tid; q < 8192; q += NWAVES * 64) { const int k = q >> 2, e4 = q & 3, ln = (k & 255) >> 2, j = k >> 8, i = k & 3;
        rwl[((j * 4 + i) * 4 + e4) * 64 + ln] = *(const f32x4*)(A.in[I_RW] + (size_t)k * 16 + e4 * 4); }
    float rb[16];
#pragma unroll
    for (int e = 0; e < 16; ++e) rb[e] = __uint_as_float(__builtin_amdgcn_readfirstlane(__float_as_uint(A.in[I_RB][e])));
    __syncthreads();
    for (int bi = F.vcu; bi < T / 128; bi += F.G) {
        { const int t0_ = F.wave * 64 + lane_id(); if (t0_ < 16) lcnt[t0_] = 0; }
        __syncthreads();
        const int row0 = bi * 128 + F.wave * 16, b = row0 >> 13;
        const rsrc_t rml = RSRC(mod + ((size_t)l * 4 + b) * 12288), rgn = RSRC(A.in[I_N2G] + l * DM), rx = RSRC(ROUTER_SRC), rh = RSRC(H);
#ifdef XRES_BF16
        const rsrc_t rxb = RSRC(F.ws + WS_XB);
#endif
        const int lo16 = F.lane * 16, lo8 = F.lane * 8;
        float cst[16];
        { f32x4 ca[4] = {};
#pragma unroll
          for (int j = 0; j < 8; ++j) { const f32x4 sh = bld4f(rml, lo16 + j * 1024, 3 * DM * 4);
#pragma unroll
            for (int i = 0; i < 4; ++i)
#pragma unroll
                for (int e4 = 0; e4 < 4; ++e4) ca[e4] += rwl[((j * 4 + i) * 4 + e4) * 64 + F.lane] * sh[i];
            asm volatile("" ::: "memory"); }
#pragma unroll
          for (int e = 0; e < 16; ++e) cst[e] = __uint_as_float(__builtin_amdgcn_readfirstlane(__float_as_uint(wave_sum(ca[e >> 2][e & 3])))); }
        f32x4 gsv[8];
#pragma unroll
        for (int j = 0; j < 8; ++j) gsv[j] = bld4f(rgn, lo16 + j * 1024, 0) * (bld4f(rml, lo16 + j * 1024, 4 * DM * 4) + 1.0f);
#pragma unroll 1
        for (int rp = 0; rp < 8; ++rp) {
            float ss[2] = {0.f, 0.f}; f32x4 acc[2][4] = {};
            const int so0 = (row0 + rp * 2) * (DM * 4);
#ifdef XRES_BF16
            v2u xraw[2][8];
#pragma unroll
            for (int q = 0; q < 2; ++q)
#pragma unroll
                for (int j = 0; j < 8; ++j) xraw[q][j] = bld2u(rxb, lo8 + j * 512, (row0 + rp * 2 + q) * (DM * 2));
#define XV(q, j) ((f32x4){bf_lo(xraw[q][j].x), bf_hi(xraw[q][j].x), bf_lo(xraw[q][j].y), bf_hi(xraw[q][j].y)})
#else
            f32x4 xv[2][8];
#pragma unroll
            for (int q = 0; q < 2; ++q)
#pragma unroll
                for (int j = 0; j < 8; ++j) xv[q][j] = bld4f(rx, lo16 + j * 1024, so0 + q * (DM * 4));
#define XV(q, j) xv[q][j]
#endif
#pragma unroll
            for (int j = 0; j < 8; ++j) {
                f32x4 a[2];
#pragma unroll
                for (int q = 0; q < 2; ++q) { const f32x4 x = XV(q, j); ss[q] += (x.x * x.x + x.y * x.y) + (x.z * x.z + x.w * x.w); a[q] = x * gsv[j]; }
#pragma unroll
                for (int i = 0; i < 4; ++i) {
#pragma unroll
                    for (int e4 = 0; e4 < 4; ++e4) { const f32x4 w = rwl[((j * 4 + i) * 4 + e4) * 64 + F.lane]; acc[0][e4] += w * a[0][i]; acc[1][e4] += w * a[1][i]; }
                    asm volatile("" : "+v"(acc[0][0]), "+v"(acc[0][1]), "+v"(acc[0][2]), "+v"(acc[0][3]), "+v"(acc[1][0]), "+v"(acc[1][1]), "+v"(acc[1][2]), "+v"(acc[1][3]) :: "memory"); } }
            float rstd[2];
#pragma unroll
            for (int q = 0; q < 2; ++q) rstd[q] = __builtin_amdgcn_rsqf(wave_sum(ss[q]) * (1.f / DM) + EPS);
            asm volatile("" ::: "memory");
            f32x4 shv[8];
#pragma unroll
            for (int j = 0; j < 8; ++j) shv[j] = bld4f(rml, lo16 + j * 1024, 3 * DM * 4);
#pragma unroll
            for (int j = 0; j < 8; ++j) {
#pragma unroll
                for (int q = 0; q < 2; ++q) { const f32x4 o = XV(q, j) * rstd[q] * gsv[j] + shv[j]; __builtin_amdgcn_raw_buffer_store_b32(pk4_fp8(o.x, o.y, o.z, o.w), rh, F.lane * 4 + j * 256, (row0 + rp * 2 + q) * DM, 0); } }
#undef XV
#pragma unroll
            for (int q = 0; q < 2; ++q) {
                float sc[16], bs[16];
#pragma unroll
                for (int e = 0; e < 16; ++e) { const float lg = wave_sum(acc[q][e >> 2][e & 3]) * rstd[q] + cst[e]; sc[e] = 1.0f / (1.0f + __expf(-lg)); bs[e] = sc[e] + rb[e]; }
                float gs4[4];
#pragma unroll
                for (int g = 0; g < 4; ++g) { const float a = bs[4 * g], b2 = bs[4 * g + 1], c = bs[4 * g + 2], d = bs[4 * g + 3];
                    const float h1 = fmaxf(a, b2), l1 = fminf(a, b2), h2 = fmaxf(c, d), l2 = fminf(c, d);
                    gs4[g] = fmaxf(h1, h2) + fmaxf(fminf(h1, h2), fmaxf(l1, l2)); }
                int gsel = 0; float gbest = gs4[0];
#pragma unroll
                for (int g = 1; g < 4; ++g) if (gs4[g] > gbest) { gbest = gs4[g]; gsel = g; }
                float bv[4], sv[4];
#pragma unroll
                for (int i = 0; i < 4; ++i) { bv[i] = gsel == 0 ? bs[i] : gsel == 1 ? bs[4 + i] : gsel == 2 ? bs[8 + i] : bs[12 + i]; sv[i] = gsel == 0 ? sc[i] : gsel == 1 ? sc[4 + i] : gsel == 2 ? sc[8 + i] : sc[12 + i]; }
                int i1 = 0; float b1 = bv[0], s1 = sv[0];
#pragma unroll
                for (int i = 1; i < 4; ++i) if (bv[i] > b1) { b1 = bv[i]; s1 = sv[i]; i1 = i; }
                int i2 = -1; float b2v = -__builtin_inff(), s2 = 0.f;
#pragma unroll
                for (int i = 0; i < 4; ++i) if (i != i1 && bv[i] > b2v) { b2v = bv[i]; s2 = sv[i]; i2 = i; }
                const float inv = 1.0f / (s1 + s2);
                if (F.lane == 0) {
                    const int r = F.wave * 16 + rp * 2 + q, e0 = gsel * 4 + i1, e1 = gsel * 4 + i2;
                    tokinfo[r * 4 + 0] = e0; tokinfo[r * 4 + 2] = e1;
                    const int row = row0 + rp * 2 + q; *(f32x2*)(aw + (size_t)row * 2) = (f32x2){s1 * inv, s2 * inv};
                }
            }
        }
        __syncthreads();
        const int tb_ = F.wave * 64 + lane_id();
        if (tb_ < 16) {
            int c = 0;
            for (int r = 0; r < 128; ++r) { if (tokinfo[r * 4 + 0] == tb_) tokinfo[r * 4 + 1] = c++; if (tokinfo[r * 4 + 2] == tb_) tokinfo[r * 4 + 3] = c++; }
            gbase[tb_] = (int)__hip_atomic_fetch_add(gcnt + tb_, (unsigned)c, __ATOMIC_RELAXED, __HIP_MEMORY_SCOPE_AGENT); }
        __syncthreads();
        if (tb_ < 128) { const int e0 = tokinfo[tb_ * 4], p0 = tokinfo[tb_ * 4 + 1], e1 = tokinfo[tb_ * 4 + 2], p1 = tokinfo[tb_ * 4 + 3]; const int row = bi * 128 + tb_;
            rowidx[(size_t)e0 * 32768 + gbase[e0] + p0] = 2 * row; rowidx[(size_t)e1 * 32768 + gbase[e1] + p1] = 2 * row + 1; }
        __syncthreads();
    }
}
#endif
__device__ __forceinline__ int moe_setup(Frame& F, int l) {
    LAS int* ts = (LAS int*)(F.lds + L_TS);
    if (F.tid == 0) { int s = 0; for (int e = 0; e < 16; ++e) { ts[e] = s; s += ((int)__hip_atomic_load(F.ctl + CW_CNT + l * 16 + e, __ATOMIC_RELAXED, __HIP_MEMORY_SCOPE_AGENT) + 255) >> 8; } ts[16] = s; }
    __syncthreads();
    return __builtin_amdgcn_readfirstlane(ts[16]);
}

__device__ __forceinline__ att::Blk mla_blk(int bh, int qb) {
    const int b = bh >> 3, h = bh & 7; att::Blk k;
    k.qo = (unsigned)(WS_QA + ((size_t)b * SEQ * 1536 + h * 192) * 2); k.ko = (unsigned)(WS_KF + ((size_t)b * SEQ * 1536 + h * 192) * 2);
    k.vo = (unsigned)(WS_VB + ((size_t)b * SEQ * 1024 + h * 128) * 2); k.oo = (unsigned)(WS_OA + ((size_t)b * SEQ * 1024 + h * 128) * 2); k.lo = 0;
    k.P0 = qb * 256; k.rate = 1; k.beta = 0.f;
    return k;
}
__device__ __forceinline__ att::Blk dil_blk(int bh, int br, int blk) {
    const int b = bh >> 3, h = bh & 7, rate = br == 0 ? 1 : br == 1 ? 4 : 16, nqb = 32 / rate, cls = blk / nqb, qb = blk % nqb; att::Blk k;
    const size_t tok0 = (size_t)b * SEQ + cls;
    const unsigned p = (unsigned)(WS_PROJ + (tok0 * PROJ_LD + h * 128) * 2);
    k.qo = p + C_QB * 2; k.ko = p + C_KB * 2; k.vo = p + C_VB * 2;
    k.oo = (unsigned)(WS_OB + (((size_t)br * T + tok0) * 1024 + h * 128) * 2);
    k.lo = (unsigned)(WS_LSE + (((size_t)br * T + tok0) * 8 + h) * 4);
    k.P0 = qb * 256; k.rate = rate;
    const float slope = __builtin_amdgcn_exp2f(-(float)(h + 1));
    k.beta = slope * (float)rate * 11.313708498984761f;
    return k;
}
__device__ __forceinline__ void mla_decode(int id, int& bh, int& qb0, int& qb1) {
    const int v = id & 255, i = id >> 8, x = v >> 5, c = v & 31, j = i * 32 + c; bh = 4 * x + (j >> 4); const int s = j & 15; qb0 = s; qb1 = 31 - s;
}
__device__ __forceinline__ void dil_decode(int id, int& bh, int& br, int& blk) {
    const int v = id & 255, i = id >> 8, x = v >> 5, c = v & 31, j = i * 32 + c; bh = 4 * x + j / 96; const int r = j % 96; br = r >> 5; blk = r & 31;
}
#ifndef ATT_DIL_NS
#define ATT_DIL_NS 4
#endif
#ifndef ATT_SKEW_SEL
#define ATT_SKEW_SEL 0
#endif
#if ATT_SKEW_SEL == 0
#define ATT_SKEW_PICK(w) ((w) < 4)
#elif ATT_SKEW_SEL == 1
#define ATT_SKEW_PICK(w) (((w) & 1) == 0)
#elif ATT_SKEW_SEL == 2
#define ATT_SKEW_PICK(w) true
#else
#define ATT_SKEW_PICK(w) false
#endif
#ifdef ATT_DMA
#define ATT_SEAM(d) att::SeamD<d>
#define ATT_DMA_ON ATT_DMA
#else
#define ATT_SEAM(d) att::Seam<d>
#define ATT_DMA_ON 0
#endif
#if ATT_DMA_ON == 2
template <int ORD>
__device__ __forceinline__ void mla_stream2(Frame& F, char* lds) {
    constexpr int NIT = 512;
    int id = F.vcu;
    if (id < NIT) {
        att::SeamD<192> S; int bh, q0, q1; mla_decode(id, bh, q0, q1); int pass = 0;
        att::Blk cur = mla_blk(bh, q0);
        att::att_prime_dma2<192, false>(cur, (const char*)F.ws, lds, S, F.tid);
        for (;;) {
            const bool more_pass = pass == 0, more_item = id + F.G < NIT, last = !more_pass && !more_item;
            att::Blk nxt = cur; int idn = id, passn = pass + 1;
            if (more_pass) nxt = mla_blk(bh, q1);
            else if (more_item) { idn = id + F.G; passn = 0; mla_decode(idn, bh, q0, q1); nxt = mla_blk(bh, q0); }
            att::att_block_dma2<192, false, false, ORD>(cur, nxt, (const char*)F.ws, lds, S, F.tid);
            if (last) break;
            cur = nxt; id = idn; pass = passn;
        }
    }
}
template <int ORD>
__device__ __forceinline__ void dil_stream2(Frame& F, char* lds) {
    constexpr int NIT = 3072;
    int id = F.vcu;
    if (id < NIT) {
        att::SeamD<128> S; int bh, br, blk; dil_decode(id, bh, br, blk);
        att::Blk cur = dil_blk(bh, br, blk);
        att::att_prime_dma2<128, true>(cur, (const char*)F.ws, lds, S, F.tid);
        for (;;) {
            const bool last = id + F.G >= NIT;
            att::Blk nxt = cur;
            if (!last) { dil_decode(id + F.G, bh, br, blk); nxt = dil_blk(bh, br, blk); }
            att::att_block_dma2<128, true, true, ORD>(cur, nxt, (const char*)F.ws, lds, S, F.tid);
            if (last) break;
            cur = nxt; id += F.G;
        }
    }
}
#endif
template <int PV>
__device__ __forceinline__ void dil_stream_reg(Frame& F, char* lds, int rep_, const Args& A, int l, int cvj0) {
        constexpr int NIT = 3072;
        int id = F.vcu;
        if (id < NIT) {
#if ATT_DMA_ON == 1
            att::SeamD<128> S;
#else
            att::Seam<128> S;
#endif
            S.cv_j = cvj0;
            int bh, br, blk; dil_decode(id, bh, br, blk);
            att::Blk cur = dil_blk(bh, br, blk);
#if defined(ATT_CONV) && ATT_CONV == 2
            const size_t eo_ = (size_t)l * NEXP * DM * DEXP;
            const att::ConvCtx X = {A.in[I_EG] + eo_, A.in[I_EU] + eo_, A.in[I_ED] + eo_, F.ws + WS_W13, F.ws + WS_W2, F.vcu * 8 + __builtin_amdgcn_readfirstlane(F.tid >> 6)};
#endif
#if ATT_DMA_ON == 1
            att::att_prime_dma<128, true, ATT_DIL_NS>(cur, (const char*)F.ws, lds, S, F.tid);
#else
            att::att_prime<128, true, PV>(cur, (const char*)F.ws, lds, S, F.tid);
#endif
            for (;;) {
                const bool last = id + F.G >= NIT;
                att::Blk nxt = cur;
                if (!last) { dil_decode(id + F.G, bh, br, blk); nxt = dil_blk(bh, br, blk); }
#if ATT_DMA_ON == 1
                att::att_block_dma<128, true, true, ATT_DIL_NS>(cur, nxt, (const char*)F.ws, lds, lds + RING_BYTES + 512, S, F.tid);
#else
#if defined(ATT_CONV) && ATT_CONV == 2
                att::att_block<128, true, true, PV, 2>(cur, nxt, (const char*)F.ws, lds, S, F.tid, &X);
#else
                att::att_block<128, true, true, PV>(cur, nxt, (const char*)F.ws, lds, S, F.tid);
#endif
#endif
                if (last) break;
                cur = nxt; id += F.G;
            }
#if defined(ATT_CONV) && ATT_CONV == 2
            { const int ln_ = lane_id(); char* scr_ = lds + att::CONV_SCR_DIL + __builtin_amdgcn_readfirstlane(F.tid >> 6) * 4352;
              if (S.cv_pend) { asm volatile("s_waitcnt vmcnt(0)" ::: "memory"); att::conv_put_full(X, S.cv_j, S.cvf, scr_, ln_); ++S.cv_j; if (S.cv_pend > 1) { att::conv_put_full(X, S.cv_j, S.cvf + 16, scr_, ln_); ++S.cv_j; } S.cv_pend = 0; }
              int jj_ = S.cv_j;
#pragma unroll 1
              while (jj_ < att::CONV_NJ) { float cb_[4][16];
#pragma unroll
                  for (int u = 0; u < 4; ++u) if (jj_ + u < att::CONV_NJ) att::conv_load_full(X, jj_ + u, cb_[u], ln_);
                  asm volatile("s_waitcnt vmcnt(0)" ::: "memory");
#pragma unroll
                  for (int u = 0; u < 4; ++u) if (jj_ + u < att::CONV_NJ) att::conv_put_full(X, jj_ + u, cb_[u], scr_, ln_);
                  jj_ += 4; }
              S.cv_j = att::CONV_NJ; }
#endif
#if defined(ATT_DEFER) && ATT_DMA_ON != 1
            if (S.p_on) { const int ln_ = F.tid & 63; const char* stg_ = lds + att::DEFER_STG + __builtin_amdgcn_readfirstlane(F.tid >> 6) * 8192;
#pragma unroll
                for (int p = 0; p < 8; ++p) att::flush_piece(stg_, p, (const char*)F.ws + S.p_oo, S.p_rb, S.p_so0, ln_); }
#endif
        }
}
static_assert(WS_ROPE == att::ROPE_OFF, "rope table offset");
#ifdef ATT_QROPE
#define ATT_ROPE_FLAG true
#else
#define ATT_ROPE_FLAG false
#endif
__device__ __forceinline__ void phase_attention(Frame& F, char* lds, const Args& A, int l) {
#ifdef ATT_PRIO
    if (__builtin_amdgcn_readfirstlane(F.tid >> 6) >= 4) __builtin_amdgcn_s_setprio(1);
#endif
#ifndef ATT_MLA_SKCONV
#define ATT_MLA_SKCONV 0
#endif
    int cvj_ = 0;
#ifndef NO_MLA
#ifndef PROBE_REP_MLA
#define PROBE_REP_MLA 1
#endif
    for (int rep_ = 0; rep_ < PROBE_REP_MLA; ++rep_) {
        if (rep_) __syncthreads();
#if ATT_DMA_ON == 2
        { const int wsel_ = __builtin_amdgcn_readfirstlane(F.tid >> 6);
          if (ATT_SKEW_PICK(wsel_)) mla_stream2<0>(F, lds); else mla_stream2<1>(F, lds); }
#else
        constexpr int NIT = 512;
        int id = F.vcu;
        if (id < NIT) {
            ATT_SEAM(192) S; int bh, q0, q1; mla_decode(id, bh, q0, q1); int pass = 0;
            att::Blk cur = mla_blk(bh, q0);
#if defined(ATT_CONV) && (ATT_CONV == 1 || defined(ATT_MLA_SK))
            const size_t eo_ = (size_t)l * NEXP * DM * DEXP;
            const att::ConvCtx X = {A.in[I_EG] + eo_, A.in[I_EU] + eo_, A.in[I_ED] + eo_, F.ws + WS_W13, F.ws + WS_W2, F.vcu * 8 + __builtin_amdgcn_readfirstlane(F.tid >> 6)};
#endif
#if ATT_DMA_ON
            att::att_prime_dma<192, false, 3>(cur, (const char*)F.ws, lds, S, F.tid);
#else
#ifdef ATT_QROPE
            att::att_prime<192, false, 0, true>(cur, (const char*)F.ws, lds, S, F.tid);
#else
            att::att_prime<192, false>(cur, (const char*)F.ws, lds, S, F.tid);
#endif
#endif
            for (;;) {
                const bool more_pass = pass == 0, more_item = id + F.G < NIT, last = !more_pass && !more_item;
                att::Blk nxt = cur; int idn = id, passn = pass + 1;
                if (more_pass) nxt = mla_blk(bh, q1);
                else if (more_item) { idn = id + F.G; passn = 0; mla_decode(idn, bh, q0, q1); nxt = mla_blk(bh, q0); }
#if ATT_DMA_ON
                att::att_block_dma<192, false, false, 3>(cur, nxt, (const char*)F.ws, lds, lds + 3 * att::SHM_V + 3 * att::Cfg<192>::SHM_K, S, F.tid);
#else
#if defined(ATT_CONV) && ATT_CONV == 1
                att::att_block<192, false, false, 0, 1, ATT_ROPE_FLAG>(cur, nxt, (const char*)F.ws, lds, S, F.tid, &X);
#elif defined(ATT_MLA_SK)
                att::att_block<192, false, true, 0, ATT_MLA_SKCONV, ATT_ROPE_FLAG>(cur, nxt, (const char*)F.ws, lds, S, F.tid, &X);
#elif defined(ATT_QROPE)
                att::att_block<192, false, false, 0, 0, true>(cur, nxt, (const char*)F.ws, lds, S, F.tid);
#else
                att::att_block<192, false, false>(cur, nxt, (const char*)F.ws, lds, S, F.tid);
#endif
#endif
                if (last) break;
                cur = nxt; id = idn; pass = passn;
            }
#ifdef ATT_MLA_SK
            { const int ln_ = lane_id(); char* scr_ = lds + att::CONV_SCR + __builtin_amdgcn_readfirstlane(F.tid >> 6) * 4352;
              if (S.cv_pend) { asm volatile("s_waitcnt vmcnt(0)" ::: "memory"); att::conv_put_full(X, S.cv_j, S.cvf, scr_, ln_); ++S.cv_j; if (S.cv_pend > 1) { att::conv_put_full(X, S.cv_j, S.cvf + 16, scr_, ln_); ++S.cv_j; } S.cv_pend = 0; }
              cvj_ = S.cv_j; }
#endif
#if defined(ATT_CONV) && ATT_CONV == 1
            { const int ln_ = lane_id(); char* scr_ = lds + att::CONV_SCR + __builtin_amdgcn_readfirstlane(F.tid >> 6) * 4352;
              while (S.cv_j < att::CONV_NJ) { att::conv_load(X, S.cv_j, S.cv_q, S.cv, ln_); asm volatile("s_waitcnt vmcnt(0)" ::: "memory");
                  att::conv_put(X, S.cv_j, S.cv_q, S.cv, scr_, ln_); if (++S.cv_q == 4) { S.cv_q = 0; ++S.cv_j; } S.cl_j = S.cv_j; S.cl_q = S.cv_q; } }
#endif
        }
#endif
    }
#endif
#ifndef NO_DIL
#ifndef PROBE_REP_DIL
#define PROBE_REP_DIL 1
#endif
#ifndef PROBE_DIL_VAR
#define PROBE_DIL_VAR 0
#endif
#if ATT_DMA_ON == 2 && !defined(ATT_DIL_DMA2)
    asm volatile("s_waitcnt vmcnt(0)" ::: "memory"); __syncthreads();
#endif
    for (int rep_ = 0; rep_ < PROBE_REP_DIL; ++rep_) {
        if (rep_) __syncthreads();
#if ATT_DMA_ON == 2 && defined(ATT_DIL_DMA2)
        { const int wsel_ = __builtin_amdgcn_readfirstlane(F.tid >> 6);
          if (ATT_SKEW_PICK(wsel_)) dil_stream2<0>(F, lds); else dil_stream2<1>(F, lds); }
#else
        if (rep_ + 1 < PROBE_REP_DIL) dil_stream_reg<PROBE_DIL_VAR>(F, lds, rep_, A, l, cvj_); else dil_stream_reg<0>(F, lds, rep_, A, l, cvj_);
#endif
    }
#endif
#ifdef ATT_PRIO
    __builtin_amdgcn_s_setprio(0);
#endif
}
#ifndef MK_PER_PHASE
#define MK_PER_PHASE 0
#endif
constexpr int NPH = 2 + 11 * DEPTH;
__global__ void __launch_bounds__(NWAVES * 64, 2) mk_fwd(Args args) {
    extern __shared__ __attribute__((aligned(16))) unsigned char lds[];
    Frame F;
    F.lds = (LAS unsigned char*)lds; F.ldsg = lds;
    F.wave = __builtin_amdgcn_readfirstlane((int)threadIdx.x >> 6); F.lane = lane_id(); F.tid = F.wave * 64 + F.lane;
    F.G = gridDim.x; { const int bx = blockIdx.x; F.vcu = (F.G % 8 == 0) ? (bx % 8) * (F.G / 8) + bx / 8 : bx; }
    F.ws = args.ws; F.ctl = (unsigned*)(args.ws + WS_CTL);
    for (int u = F.tid; u < (LDS_BYTES - RING_BYTES) / 4; u += NWAVES * 64) ((LAS unsigned*)(F.lds + RING_BYTES))[u] = 0u;
    __syncthreads();
    volatile LAS unsigned* MISC = (volatile LAS unsigned*)(F.lds + L_MISC);
    XcdBarrier bar; bar.bar = F.ctl + CW_BAR; bar.x = 0; bar.st = nullptr;
    if (!MK_PER_PHASE) bar = xcd_barrier_post(F.ctl + CW_BAR, MISC + 8, F.tid);
    const int lo = args.ph_lo, hi = args.ph_hi;
#ifndef PROBE_GRID1_PHASE
#define PROBE_GRID1_PHASE (-1)
#endif
#define PROBE_GRID1(p) ((p) == PROBE_GRID1_PHASE)
#ifndef PROBE_MODE
#define PROBE_MODE 1
#endif
#ifndef PROBE_REP_MASK
#define PROBE_REP_MASK 0
#endif
#define NREP(j) ((((PROBE_REP_MASK) >> (j)) & 1) ? 2 : 1)
#ifndef PROBE_XIN
#define PROBE_XIN 0
#endif
#ifndef PH_MASK
#define PH_MASK 0x1FFF
#endif
#define IN(k) (lo <= (k) && (k) < hi)
#define MSK(j) (((PH_MASK) >> (j)) & 1)
#define FRESH(Fp) Frame Fp = F; { int l_ = lane_id(); int z_ = 0; asm volatile("" : "+v"(l_), "+s"(z_)); Fp.lane = l_; Fp.wave = F.wave + z_; Fp.tid = Fp.wave * 64 + l_; Fp.vcu = F.vcu + z_; Fp.ws = F.ws + z_; Fp.ctl = (unsigned*)(Fp.ws + WS_CTL); }
#define SEAM(k) do { if (IN(k) && IN((k) + 1)) xcd_barrier(bar, F.wave * 64 + lane_id()); } while (0)

    if (MSK(11) && IN(0)) { FRESH(P); phase_prologue(P, args);
#ifdef PROBE_REPEAT_PROLOGUE
        __syncthreads(); phase_prologue(P, args);
#endif
    }
    SEAM(0);
    for (int l = 0; l < DEPTH; ++l) {
        const int pb = 1 + 11 * l;
        const float* mod = (const float*)(F.ws + WS_MOD);
        if (MSK(0) && IN(pb + 0)) { for (int rep_ = 0; rep_ < (l == 0 ? NREP(0) : 1); ++rep_) { if (rep_) __syncthreads(); FRESH(P); phase_norm1(P, args, l); } }
        SEAM(pb + 0);
        if (MSK(1) && IN(pb + 1)) { for (int rep_ = 0; rep_ < NREP(1); ++rep_) { if (rep_) __syncthreads(); FRESH(P);
            pg8::Gemm g{(const bf16*)(P.ws + WS_H), (const bf16*)(P.ws + WS_WIN) + (size_t)l * 4096 * DM, DM * 2};
            pg8::StaticOrder S; S.init(T, PROJ_LD, P.G, (int)blockIdx.x);
            pg8::EpiPlain E{(bf16*)(P.ws + WS_PROJ), PROJ_LD};
            pg8::gemm_phase<pg8::EpiPlain, pg8::StaticOrder, pg8::ALinear>(P.lds, g, S, pg8::ALinear{}, E, P.tid);
        } }
        SEAM(pb + 1);
#ifdef PROBE_EXTRA_BARRIERS
        if (IN(pb + 2)) for (int xb_ = 0; xb_ < PROBE_EXTRA_BARRIERS; ++xb_) xcd_barrier(bar, F.wave * 64 + lane_id());
#endif
        if (MSK(2) && IN(pb + 2)) { for (int rep_ = 0; rep_ < NREP(2); ++rep_) { if (rep_) __syncthreads(); FRESH(P); phase_mla_prep(P, args); } }
        SEAM(pb + 2);
        if (MSK(3) && IN(pb + 3)) { for (int rep_ = 0; rep_ < NREP(3); ++rep_) { if (rep_) __syncthreads(); FRESH(P);
#ifdef PROBE_SWAP_UP
            { pg8::Gemm g{(const bf16*)(P.ws + WS_PROJ) + C_CKV, (const bf16*)(P.ws + WS_WUKV) + (size_t)l * 2048 * 256, 256 * 2};
              pg8::StaticOrder S; S.init(T, 2048, P.G, (int)blockIdx.x);
              pg8::EpiKVup E{(bf16*)(P.ws + WS_KF), (bf16*)(P.ws + WS_VB), (const float*)(P.ws + WS_RSTDKV)};
              pg8::gemm_phase<pg8::EpiKVup, pg8::StaticOrder, pg8::APitch>(P.lds, g, S, pg8::APitch{PROJ_LD * 2}, E, P.tid); }
            { pg8::Gemm g{(const bf16*)(P.ws + WS_PROJ) + C_CQ, (const bf16*)(P.ws + WS_WUQ) + (size_t)l * 1536 * 512, 512 * 2};
              pg8::StaticOrder S; S.init(T, 1536, P.G, (int)blockIdx.x);
              pg8::EpiQup E{(bf16*)(P.ws + WS_QA), (const float*)(P.ws + WS_RSTDQ)};
#ifdef PROBE_QUP_PLAIN
              { pg8::EpiPlain E2{(bf16*)(P.ws + WS_QA), 1536}; pg8::gemm_phase<pg8::EpiPlain, pg8::StaticOrder, pg8::APitch>(P.lds, g, S, pg8::APitch{PROJ_LD * 2}, E2, P.tid); }
#else
              pg8::gemm_phase<pg8::EpiQup, pg8::StaticOrder, pg8::APitch>(P.lds, g, S, pg8::APitch{PROJ_LD * 2}, E, P.tid);
#endif
            }
#else
            { pg8::Gemm g{(const bf16*)(P.ws + WS_PROJ) + C_CQ, (const bf16*)(P.ws + WS_WUQ) + (size_t)l * 1536 * 512, 512 * 2};
              pg8::StaticOrder S; S.init(T, 1536, P.G, (int)blockIdx.x);
              pg8::EpiQup E{(bf16*)(P.ws + WS_QA), (const float*)(P.ws + WS_RSTDQ)};
#ifdef PROBE_QUP_PLAIN
              { pg8::EpiPlain E2{(bf16*)(P.ws + WS_QA), 1536}; pg8::gemm_phase<pg8::EpiPlain, pg8::StaticOrder, pg8::APitch>(P.lds, g, S, pg8::APitch{PROJ_LD * 2}, E2, P.tid); }
#else
              pg8::gemm_phase<pg8::EpiQup, pg8::StaticOrder, pg8::APitch>(P.lds, g, S, pg8::APitch{PROJ_LD * 2}, E, P.tid);
#endif
            }
            { pg8::Gemm g{(const bf16*)(P.ws + WS_PROJ) + C_CKV, (const bf16*)(P.ws + WS_WUKV) + (size_t)l * 2048 * 256, 256 * 2};
              pg8::StaticOrder S; S.init(T, 2048, P.G, (int)blockIdx.x);
              pg8::EpiKVup E{(bf16*)(P.ws + WS_KF), (bf16*)(P.ws + WS_VB), (const float*)(P.ws + WS_RSTDKV)};
              pg8::gemm_phase<pg8::EpiKVup, pg8::StaticOrder, pg8::APitch>(P.lds, g, S, pg8::APitch{PROJ_LD * 2}, E, P.tid); }
#endif
        } }
        SEAM(pb + 3);
#ifndef ATT_QROPE
        if (MSK(4) && IN(pb + 4)) { FRESH(P); phase_q_rope(P, args); }
        SEAM(pb + 4);
#endif
        if (MSK(5) && IN(pb + 5)) { FRESH(P); phase_attention(P, (char*)lds, args, l);
#ifdef PROBE_REPEAT_ATT
            __syncthreads(); phase_attention(P, (char*)lds, args, l);
#endif
        }
        SEAM(pb + 5);
        if (MSK(6) && IN(pb + 6)) { for (int rep_ = 0; rep_ < NREP(6); ++rep_) { if (rep_) __syncthreads(); FRESH(P); phase_out_norm(P, args, l); } }
        SEAM(pb + 6);
        if (MSK(7) && IN(pb + 7)) { FRESH(P);
#ifdef G3_FP8
            pg8::Gemm g{P.ws + WS_H, P.ws + WS_WOUT + (size_t)l * DM * DM, DM};
            pg8::StaticOrder S; S.init(T, DM, P.G, (int)blockIdx.x);
#ifdef XRES_BF16
            pg8::EpiResidB E{l == 0 ? (const void*)args.in[I_X] : (const void*)(P.ws + WS_XB), (bf16*)(P.ws + WS_XB), mod + (size_t)l * 4 * 12288 + 2 * DM, 12288, 1.0f / 256.0f, l == 0 ? 1 : 0};
            pg8::gemm_phase<pg8::EpiResidB, pg8::StaticOrder, pg8::ALinear, true>(P.lds, g, S, pg8::ALinear{}, E, P.tid);
#else
            pg8::EpiResid E{l == 0 ? args.in[I_X] : args.out, args.out, mod + (size_t)l * 4 * 12288 + 2 * DM, DM, 12288, 1.0f / 256.0f};
            pg8::gemm_phase<pg8::EpiResid, pg8::StaticOrder, pg8::ALinear, true>(P.lds, g, S, pg8::ALinear{}, E, P.tid);
#endif
#elif defined(XRES_BF16)
            pg8::Gemm g{(const bf16*)(P.ws + WS_H), (const bf16*)(P.ws + WS_WOUT) + (size_t)l * DM * DM, DM * 2};
            pg8::StaticOrder S; S.init(T, DM, P.G, (int)blockIdx.x);
            pg8::EpiResidB E{l == 0 ? (const void*)args.in[I_X] : (const void*)(P.ws + WS_XB), (bf16*)(P.ws + WS_XB), mod + (size_t)l * 4 * 12288 + 2 * DM, 12288, 1.0f, l == 0 ? 1 : 0};
            pg8::gemm_phase<pg8::EpiResidB, pg8::StaticOrder, pg8::ALinear>(P.lds, g, S, pg8::ALinear{}, E, P.tid);
#else
            pg8::Gemm g{(const bf16*)(P.ws + WS_H), (const bf16*)(P.ws + WS_WOUT) + (size_t)l * DM * DM, DM * 2};
            pg8::StaticOrder S; S.init(T, DM, P.G, (int)blockIdx.x);
            pg8::EpiResid E{l == 0 ? args.in[I_X] : args.out, args.out, mod + (size_t)l * 4 * 12288 + 2 * DM, DM, 12288, 1.0f};
            pg8::gemm_phase<pg8::EpiResid, pg8::StaticOrder, pg8::ALinear>(P.lds, g, S, pg8::ALinear{}, E, P.tid);
#endif
        }
        SEAM(pb + 7);
        if (MSK(8) && IN(pb + 8)) { FRESH(P); phase_router(P, args, l);
#ifdef PROBE_REPEAT_ROUTER
            __syncthreads(); phase_router(P, args, l, 1);
#endif
        }
        SEAM(pb + 8);
        if (MSK(9) && IN(pb + 9)) { for (int rep_ = 0; rep_ < NREP(9); ++rep_) { if (rep_) __syncthreads(); FRESH(P);
            const int NT = moe_setup(P, l);
            pg8::MoeOrder S{NT, 8, P.G, (int)blockIdx.x, (const LAS int*)(P.lds + L_TS)};
            LAS unsigned* atab = (LAS unsigned*)(P.lds + L_ATAB); const int* rowidx = (const int*)(P.ws + WS_ROWIDX);
#pragma unroll 1
            for (int slot = 0; slot < MAXU; ++slot) { pg8::Unit u; if (!S.next(slot, u)) break;
                if (P.tid < 256) { const int lr = u.lt * 256 + P.tid; const int ce = (int)P.ctl[CW_CNT + l * 16 + u.e];
                    int tok = lr < ce ? (rowidx[(size_t)u.e * 32768 + lr] >> 1) : 0;
#ifdef PROBE_LINEAR_ATAB
                    tok = (int)(((unsigned)(u.pm * 256 + P.tid) * 2654435761u) >> 17) & 32767;
#endif
 atab[slot * 256 + P.tid] = (unsigned)tok * (unsigned)DM; } }
            __syncthreads();
            pg8::Gemm g{P.ws + WS_H, P.ws + WS_W13, DM};
            pg8::EpiSwiglu E{P.ws + WS_HMID, DEXP};
            pg8::gemm_phase<pg8::EpiSwiglu, pg8::MoeOrder, pg8::ATable, true>(P.lds, g, S, pg8::ATable{atab}, E, P.tid);
        } }
        SEAM(pb + 9);
        if (MSK(10) && IN(pb + 10)) { for (int rep_ = 0; rep_ < NREP(10); ++rep_) { if (rep_) __syncthreads(); FRESH(P);
            const int NT = moe_setup(P, l);
            pg8::MoeOrder S{NT, 8, P.G, (int)blockIdx.x, (const LAS int*)(P.lds + L_TS)};
            pg8::Gemm g{P.ws + WS_HMID, P.ws + WS_W2, DEXP};
            pg8::EpiMoeDown E{(bf16*)(P.ws + WS_Y), (const int*)(P.ws + WS_ROWIDX), (const float*)(P.ws + WS_AW), P.ctl + CW_CNT + l * 16};
            pg8::gemm_phase<pg8::EpiMoeDown, pg8::MoeOrder, pg8::ALinear, true>(P.lds, g, S, pg8::ALinear{}, E, P.tid);
        } }
        SEAM(pb + 10);
    }
    #ifdef PROBE_DUMP_OFF
    if (MSK(12) && IN(NPH - 1)) { FRESH(P); phase_dump(P, args, (size_t)(PROBE_DUMP_OFF), PROBE_DUMP_PITCH); }
#else
    if (MSK(12) && IN(NPH - 1)) { FRESH(P); phase_final(P, args, args.li != 0 ? (PROBE_XIN ? 2 : PROBE_MODE) : 0);
#ifdef PROBE_EXACT
        { const int gw = P.vcu * NWAVES + P.wave, NGW = P.G * NWAVES; __syncthreads();
          for (int ch = gw; ch < T / 16; ch += NGW) for (int rr = 0; rr < 16; ++rr) for (int j = 0; j < 8; ++j) { float* p = args.out + (size_t)(ch * 16 + rr) * DM + 4 * P.lane + 256 * j; asm volatile("s_waitcnt vmcnt(0)" ::: "memory");
              const v4u ub = *(const v4u*)p; *(f32x4*)p = (f32x4){(float)(ub.x & 0xFFFu), (float)(ub.y & 0xFFFu), (float)(ub.z & 0xFFFu), (float)(ub.w & 0xFFFu)}; } }
#endif
    }
#endif
#undef IN
#undef SEAM
}

extern "C" void kernel_launch(void* const* d_in, const int* in_sizes, int n_in, void* d_out, int out_size, void* d_ws, size_t ws_size, hipStream_t stream) {
    static int grid = 0;
    if (grid == 0) {
        if (n_in != 20 || in_sizes[0] != T * DM || out_size != T * DM || ws_size < WS_END) {
            fprintf(stderr, "kernel_launch: unexpected problem (n_in %d, in0 %d, out %d, ws %zu < %zu)\n", n_in, n_in > 0 ? in_sizes[0] : -1, out_size, ws_size, (size_t)WS_END); grid = -1; return; }
        int dev = 0, cus = 0;
        if (hipGetDevice(&dev) != hipSuccess || hipDeviceGetAttribute(&cus, hipDeviceAttributeMultiprocessorCount, dev) != hipSuccess) { grid = -1; return; }
        if (hipFuncSetAttribute((const void*)mk_fwd, hipFuncAttributeMaxDynamicSharedMemorySize, LDS_BYTES) != hipSuccess) { fprintf(stderr, "kernel_launch: hipFuncSetAttribute failed\n"); grid = -1; return; }
        int per_cu = 0;
        if (hipOccupancyMaxActiveBlocksPerMultiprocessor(&per_cu, (const void*)mk_fwd, NWAVES * 64, LDS_BYTES) != hipSuccess || per_cu < 1) fprintf(stderr, "kernel_launch: occupancy query says %d blocks per CU\n", per_cu);
        (void)hipGetLastError();
        grid = cus;
        if (grid != 256) fprintf(stderr, "kernel_launch: %d CUs (built for 256)\n", grid);
    }
    if (grid < 0) return;
    if (hipMemsetAsync((char*)d_ws + WS_CTL, 0, CTL_ZERO_BYTES, stream) != hipSuccess) return;
    Args a; memset(&a, 0, sizeof(a));
    for (int i = 0; i < 20; ++i) a.in[i] = (const float*)d_in[i];
    a.out = (float*)d_out; a.ws = (unsigned char*)d_ws;
    for (int i = 0; i < 32; ++i) a.invf[i] = (float)pow(10000.0, -(double)i / 32.0);
#if MK_PER_PHASE
#ifndef PROBE_LAST
#define PROBE_LAST (NPH - 2)
#endif
    for (int p = 0; p < NPH; ++p) { if (p > PROBE_LAST && p != NPH - 1) continue;
#ifdef PROBE_ONLY_MASK
        if (p != NPH - 1 && !((PROBE_ONLY_MASK >> p) & 1)) continue;
#endif
 a.ph_lo = p; a.ph_hi = p + 1; a.li = (PROBE_LAST != NPH - 2) ? 1 : 0; hipLaunchKernelGGL(mk_fwd, dim3(PROBE_GRID1(p) ? 1 : grid), dim3(NWAVES * 64), LDS_BYTES, stream, a); }
#else
    a.ph_lo = 0; a.ph_hi = NPH; a.li = 0;
    hipLaunchKernelGGL(mk_fwd, dim3(grid), dim3(NWAVES * 64), LDS_BYTES, stream, a);
#endif
    const hipError_t le = hipPeekAtLastError();
    if (le != hipSuccess) fprintf(stderr, "kernel_launch: launch failed: %s\n", hipGetErrorName(le));
}
```

```cpp
#define MK_PER_PHASE 0
#define XRES_BF16 1
#define G3_FP8 1
#define ATT_QROPE 1
#define ST16_IMM 1
#define ROUTER_MFMA 1
#define ATT_CONV 2
#define ATT_SLOAD_RECOMP 1
#define ATT_RAWBAR 1
#define ATT_MLA_SK 1
#define THIN_MLP 1
#define CONV_LAST_STEP 1
#define THIN_RO 4
#define RPA 4
#define ADA_FAST 1
#define Y_FP8 1
#include <hip/hip_runtime.h>
#include <cstdio>
#include <cstdint>
#include <cstring>
#include <cmath>
namespace pg8 {
#define PG8_LAS __attribute__((address_space(3)))
typedef unsigned short bf16_t;
typedef short bf16x8 __attribute__((ext_vector_type(8)));
typedef float f32x4 __attribute__((ext_vector_type(4)));
typedef float f32x2 __attribute__((ext_vector_type(2)));
typedef unsigned u32x4 __attribute__((ext_vector_type(4)));
typedef int v4i_t __attribute__((ext_vector_type(4)));
typedef int v8i_t __attribute__((ext_vector_type(8)));
constexpr int BM = 256, BK = 64, HALF = 128, HTB = HALF * BK * 2  , STAGE_BYTES = 8 * HTB, NXCD = 8, WGM = 8;

__host__ __device__ __forceinline__ int lds_byte(int r, int c) { const int st = (r >> 4) * 2 + (c >> 5), rr = r & 15, cc = c & 31, ob = rr * 64 + cc * 2; return st * 1024 + (ob ^ (((ob >> 9) & 1) << 5)); }
__host__ __device__ __forceinline__ void stage_rc(int b, int& R, int& C) { const int st = b / 1024, sb = b % 1024, swz = sb ^ (((sb >> 9) & 1) << 5); R = (st >> 1) * 16 + swz / 64; C = (st & 1) * 32 + (swz % 64) / 2; }
__host__ __device__ __forceinline__ int perm32(int rho) { const int n = rho >> 4, i = rho & 15; return 8 * (i >> 2) + 4 * n + (i & 3); }

struct Unit { int pm, pn, pb, e, lt; };
struct Gemm { const void* A; const void* Bt; int Kb; };

__device__ __forceinline__ bool order_tile(int i, int G, int c, int nM, int nN, int& pm, int& pn) {
    const int nwg = nM * nN; const long L = (long)i * G + c; if (L >= nwg) return false;
    int wgid = (int)L; { const int q = nwg / NXCD, r = nwg % NXCD, xcd = wgid % NXCD, off = wgid / NXCD; wgid = (xcd < r ? xcd * (q + 1) : r * (q + 1) + (xcd - r) * q) + off; }
    const int nig = WGM * nN, gid = wgid / nig, fm = gid * WGM, gsz = (nM - fm) < WGM ? (nM - fm) : WGM;
    pm = fm + ((wgid % nig) % gsz); pn = (wgid % nig) / gsz; return true;
}
struct StaticOrder {
    int nM, nN, G, c;
    __device__ __forceinline__ void init(int M, int N, int G_, int c_) { nM = M / BM; nN = N / BM; G = G_; c = c_; }
    __device__ __forceinline__ bool next(int i, Unit& u) const { int pm, pn; if (!order_tile(i, G, c, nM, nN, pm, pn)) return false; u.pm = pm; u.pn = pn; u.pb = pn; u.e = 0; u.lt = 0; return true; }
};
struct MoeOrder {
    int nM, nN, G, c; const PG8_LAS int* ts;
    __device__ __forceinline__ bool next(int i, Unit& u) const {
        int pm, pn; if (i >= 10 || !order_tile(i, G, c, nM, nN, pm, pn)) return false;
        int e = 0;
#pragma unroll
        for (int j = 1; j < 16; ++j) e += (__builtin_amdgcn_readfirstlane(ts[j]) <= pm) ? 1 : 0;
        e = __builtin_amdgcn_readfirstlane(e); u.pm = pm; u.pn = pn; u.e = e; u.lt = pm - __builtin_amdgcn_readfirstlane(ts[e]); u.pb = e * nN + pn; return true;
    }
};
struct ALinear { __device__ __forceinline__ unsigned off(const Unit& u, int slot, int r, int Kb) const { return (unsigned)(u.pm * BM + r) * (unsigned)Kb; } };
struct APitch  { unsigned pitchB; __device__ __forceinline__ unsigned off(const Unit& u, int slot, int r, int K) const { return (unsigned)(u.pm * BM + r) * pitchB; } };
struct ATable  { const PG8_LAS unsigned* tab; __device__ __forceinline__ unsigned off(const Unit& u, int slot, int r, int K) const { return tab[slot * BM + r]; } };

typedef __bf16 bf16x2_t __attribute__((ext_vector_type(2)));
__device__ __forceinline__ unsigned cvt_pk_bf16(float lo, float hi) { const f32x2 v = {lo, hi}; return __builtin_bit_cast(unsigned, __builtin_convertvector(v, bf16x2_t)); }

typedef f32x4 Acc[2][2][4][2];

typedef __amdgpu_buffer_rsrc_t rsrc_t;
#define PG8_RSRC(p) __builtin_amdgcn_make_buffer_rsrc((void*)(p), 0, 0x7fffffff, 0x00020000)
#ifdef ST16_IMM
__device__ __forceinline__ void st16(rsrc_t r, int vo, int so, u32x4 v) { __builtin_amdgcn_raw_buffer_store_b128(v, r, vo + so, 0, 0); }
#else
__device__ __forceinline__ void st16(rsrc_t r, int vo, int so, u32x4 v) { __builtin_amdgcn_raw_buffer_store_b128(v, r, vo, so, 0); }
#endif
__device__ __forceinline__ f32x4 ld16f(rsrc_t r, int vo, int so) { return __builtin_bit_cast(f32x4, __builtin_amdgcn_raw_buffer_load_b128(r, vo, so, 0)); }
__device__ __forceinline__ float ld4f(rsrc_t r, int vo, int so) { return __uint_as_float(__builtin_amdgcn_raw_buffer_load_b32(r, vo, so, 0)); }
__device__ __forceinline__ u32x4 pack8(const f32x4 v0, const f32x4 v1) { u32x4 w; w.x = cvt_pk_bf16(v0[0], v0[1]); w.y = cvt_pk_bf16(v0[2], v0[3]); w.z = cvt_pk_bf16(v1[0], v1[1]); w.w = cvt_pk_bf16(v1[2], v1[3]); return w; }
struct EpiPlain {
    static constexpr bool PERM = true;
    bf16_t* O; int ldc;
    __device__ __forceinline__ void operator()(const Acc& acc, const Unit& u, int wr, int wc, int fr, int fq) const {
        const rsrc_t ro = PG8_RSRC(O); const int vo = (fr * ldc + wc * 32 + 8 * fq) * 2;
#pragma unroll
        for (int ai = 0; ai < 2; ++ai)
#pragma unroll
            for (int m = 0; m < 4; ++m) { const int so = ((u.pm * BM + wr * 64 + ai * HALF + m * 16) * ldc + u.pn * BM) * 2;
#pragma unroll
                for (int bj = 0; bj < 2; ++bj) st16(ro, vo, so + bj * HALF * 2, pack8(acc[ai][bj][m][0], acc[ai][bj][m][1])); }
    }
};
struct EpiQup {
    static constexpr bool PERM = true;
    bf16_t* O; const float* rstd;
    __device__ __forceinline__ void operator()(const Acc& acc, const Unit& u, int wr, int wc, int fr, int fq) const {
        const rsrc_t ro = PG8_RSRC(O), rr = PG8_RSRC(rstd);
        const int vo = (fr * 1536 + wc * 32 + 8 * fq) * 2;
        float rs[2][4];
#pragma unroll
        for (int ai = 0; ai < 2; ++ai)
#pragma unroll
            for (int m = 0; m < 4; ++m) rs[ai][m] = ld4f(rr, fr * 4, (u.pm * BM + wr * 64 + ai * HALF + m * 16) * 4);
#pragma unroll
        for (int ai = 0; ai < 2; ++ai)
#pragma unroll
            for (int m = 0; m < 4; ++m) { const int rowu = u.pm * BM + wr * 64 + ai * HALF + m * 16; const float r1 = rs[ai][m];
                const int so = (rowu * 1536 + u.pn * BM) * 2;
                st16(ro, vo, so, pack8(acc[ai][0][m][0] * r1, acc[ai][0][m][1] * r1));
                st16(ro, vo, so + HALF * 2, pack8(acc[ai][1][m][0] * r1, acc[ai][1][m][1] * r1)); }
    }
};
struct EpiKVup {
    static constexpr bool PERM = true;
    bf16_t* KF; bf16_t* VB; const float* rstd;
    __device__ __forceinline__ void operator()(const Acc& acc, const Unit& u, int wr, int wc, int fr, int fq) const {
        const rsrc_t rk = PG8_RSRC(KF), rv = PG8_RSRC(VB), rr = PG8_RSRC(rstd);
        const int c0 = wc * 32 + 8 * fq, vok = (fr * 1536 + c0) * 2, vov = (fr * 1024 + c0) * 2;
        float rs[2][4];
#pragma unroll
        for (int ai = 0; ai < 2; ++ai)
#pragma unroll
            for (int m = 0; m < 4; ++m) rs[ai][m] = ld4f(rr, fr * 4, (u.pm * BM + wr * 64 + ai * HALF + m * 16) * 4);
#pragma unroll
        for (int ai = 0; ai < 2; ++ai)
#pragma unroll
            for (int m = 0; m < 4; ++m) { const int rowu = u.pm * BM + wr * 64 + ai * HALF + m * 16; const float r1 = rs[ai][m];
                st16(rk, vok, (rowu * 1536 + u.pn * 192) * 2, pack8(acc[ai][0][m][0] * r1, acc[ai][0][m][1] * r1));
                st16(rv, vov, (rowu * 1024 + u.pn * 128) * 2, pack8(acc[ai][1][m][0] * r1, acc[ai][1][m][1] * r1)); }
    }
};
struct EpiResid {
    static constexpr bool PERM = false;
    const float* base; float* out; const float* gate; int ldc; int gld; float ascale;
    __device__ __forceinline__ void operator()(const Acc& acc, const Unit& u, int wr, int wc, int fr, int fq) const {
        const rsrc_t rb = PG8_RSRC(base), ro = PG8_RSRC(out), rg = PG8_RSRC(gate);
        const int cl = (wc * 32 + 4 * fq) * 4, vo = fr * ldc * 4 + cl;
        f32x4 gv[2][2];
#pragma unroll
        for (int bj = 0; bj < 2; ++bj)
#pragma unroll
            for (int n = 0; n < 2; ++n) gv[bj][n] = ld16f(rg, cl, (((u.pm * BM) >> 13) * gld + u.pn * BM + bj * HALF + n * 16) * 4) * ascale;
#pragma unroll
        for (int ai = 0; ai < 2; ++ai) {
            f32x4 bs[4][2][2];
#pragma unroll
            for (int m = 0; m < 4; ++m) { const int so = ((u.pm * BM + ai * HALF + wr * 64 + m * 16) * ldc + u.pn * BM) * 4;
#pragma unroll
                for (int bj = 0; bj < 2; ++bj)
#pragma unroll
                    for (int n = 0; n < 2; ++n) bs[m][bj][n] = ld16f(rb, vo, so + (bj * HALF + n * 16) * 4); }
#pragma unroll
            for (int m = 0; m < 4; ++m) { const int so = ((u.pm * BM + ai * HALF + wr * 64 + m * 16) * ldc + u.pn * BM) * 4;
#pragma unroll
                for (int bj = 0; bj < 2; ++bj)
#pragma unroll
                    for (int n = 0; n < 2; ++n) st16(ro, vo, so + (bj * HALF + n * 16) * 4, __builtin_bit_cast(u32x4, bs[m][bj][n] + gv[bj][n] * acc[ai][bj][m][n])); }
            asm volatile("s_waitcnt vmcnt(0)" ::: "memory");
        }
    }
};
struct EpiResidB {
    static constexpr bool PERM = true;
    const void* base; bf16_t* out; const float* gate; int gld; float ascale; int BASE_F32;
    __device__ __forceinline__ void operator()(const Acc& acc, const Unit& u, int wr, int wc, int fr, int fq) const {
        const rsrc_t rb = PG8_RSRC(base), ro = PG8_RSRC(out), rg = PG8_RSRC(gate);
        const int c0 = wc * 32 + 8 * fq;
        f32x4 gv[2][2];
#pragma unroll
        for (int bj = 0; bj < 2; ++bj)
#pragma unroll
            for (int n = 0; n < 2; ++n) gv[bj][n] = ld16f(rg, (c0 + 4 * n) * 4, (((u.pm * BM) >> 13) * gld + u.pn * BM + bj * HALF) * 4) * ascale;
#pragma unroll
        for (int ai = 0; ai < 2; ++ai) {
            f32x4 bs[4][2][2];
#pragma unroll
            for (int m = 0; m < 4; ++m) { const int rowu = u.pm * BM + ai * HALF + wr * 64 + m * 16;
#pragma unroll
                for (int bj = 0; bj < 2; ++bj) {
                    if (BASE_F32) { const int so = (rowu * 2048 + u.pn * BM + bj * HALF) * 4, vo = (fr * 2048 + c0) * 4;
                        bs[m][bj][0] = ld16f(rb, vo, so); bs[m][bj][1] = ld16f(rb, vo + 16, so); }
                    else { const int so = (rowu * 2048 + u.pn * BM + bj * HALF) * 2, vo = (fr * 2048 + c0) * 2;
                        const u32x4 w = __builtin_bit_cast(u32x4, __builtin_amdgcn_raw_buffer_load_b128(rb, vo, so, 0));
                        bs[m][bj][0] = (f32x4){__uint_as_float(w.x << 16), __uint_as_float(w.x & 0xffff0000u), __uint_as_float(w.y << 16), __uint_as_float(w.y & 0xffff0000u)};
                        bs[m][bj][1] = (f32x4){__uint_as_float(w.z << 16), __uint_as_float(w.z & 0xffff0000u), __uint_as_float(w.w << 16), __uint_as_float(w.w & 0xffff0000u)}; } } }
#pragma unroll
            for (int m = 0; m < 4; ++m) { const int rowu = u.pm * BM + ai * HALF + wr * 64 + m * 16;
#pragma unroll
                for (int bj = 0; bj < 2; ++bj) st16(ro, (fr * 2048 + c0) * 2, (rowu * 2048 + u.pn * BM + bj * HALF) * 2,
                                                    pack8(bs[m][bj][0] + gv[bj][0] * acc[ai][bj][m][0], bs[m][bj][1] + gv[bj][1] * acc[ai][bj][m][1])); }
            asm volatile("s_waitcnt vmcnt(0)" ::: "memory");
        }
    }
};
struct EpiSwiglu {
    static constexpr bool PERM = true;
    unsigned char* O; int ldc;
    __device__ __forceinline__ void operator()(const Acc& acc, const Unit& u, int wr, int wc, int fr, int fq) const {
        const rsrc_t ro = PG8_RSRC(O); const int vo = fr * ldc + wc * 32 + 8 * fq;
#pragma unroll
        for (int ai = 0; ai < 2; ++ai)
#pragma unroll
            for (int m = 0; m < 4; ++m) { const int so = (u.pm * BM + wr * 64 + ai * HALF + m * 16) * ldc + u.pn * HALF; float r[8];
#pragma unroll
                for (int n = 0; n < 2; ++n)
#pragma unroll
                    for (int k = 0; k < 4; ++k) { const float g = acc[ai][0][m][n][k] * (1.0f / 256.0f), up = acc[ai][1][m][n][k] * (1.0f / 256.0f);
                        r[n * 4 + k] = g * __builtin_amdgcn_rcpf(1.0f + __builtin_amdgcn_exp2f(-1.4426950408889634f * g)) * up; }
                int w0 = 0, w1 = 0;
                w0 = __builtin_amdgcn_cvt_pk_fp8_f32(r[0], r[1], w0, false); w0 = __builtin_amdgcn_cvt_pk_fp8_f32(r[2], r[3], w0, true);
                w1 = __builtin_amdgcn_cvt_pk_fp8_f32(r[4], r[5], w1, false); w1 = __builtin_amdgcn_cvt_pk_fp8_f32(r[6], r[7], w1, true);
                typedef unsigned u32x2_t __attribute__((ext_vector_type(2)));
                __builtin_amdgcn_raw_buffer_store_b64((u32x2_t){(unsigned)w0, (unsigned)w1}, ro, vo, so, 0); }
    }
};
struct EpiMoeDown {
    static constexpr bool PERM = true;
    bf16_t* Y; const int* rowidx; const float* aw; const unsigned* cnt;
    __device__ __forceinline__ void operator()(const Acc& acc, const Unit& u, int wr, int wc, int fr, int fq) const {
        const rsrc_t ry = PG8_RSRC(Y), ri = PG8_RSRC(rowidx), ra = PG8_RSRC(aw);
        const int nvalid = (int)cnt[u.e] - u.lt * BM; const int cb = (u.pn * BM + wc * 32 + 8 * fq) * 2;
        int idx[2][4]; float w8[2][4];
#pragma unroll
        for (int ai = 0; ai < 2; ++ai)
#pragma unroll
            for (int m = 0; m < 4; ++m) { const int ru = ai * HALF + wr * 64 + m * 16; idx[ai][m] = -1; w8[ai][m] = 0.f;
                if (ru + fr < nvalid) { idx[ai][m] = (int)__builtin_amdgcn_raw_buffer_load_b32(ri, fr * 4, (u.e * 32768 + u.lt * BM + ru) * 4, 0); w8[ai][m] = ld4f(ra, idx[ai][m] * 4, 0); } }
#pragma unroll
        for (int ai = 0; ai < 2; ++ai)
#pragma unroll
            for (int m = 0; m < 4; ++m) if (idx[ai][m] >= 0) { const int vo = idx[ai][m] * 4096 + cb; const float w1 = w8[ai][m] * (1.0f / 256.0f);
#pragma unroll
#ifdef Y_FP8
                for (int bj = 0; bj < 2; ++bj) { const f32x4 a0 = acc[ai][bj][m][0] * (w1 * 16.0f), a1 = acc[ai][bj][m][1] * (w1 * 16.0f);
                    int w0 = 0, w1i = 0; w0 = __builtin_amdgcn_cvt_pk_fp8_f32(a0[0], a0[1], w0, false); w0 = __builtin_amdgcn_cvt_pk_fp8_f32(a0[2], a0[3], w0, true);
                    w1i = __builtin_amdgcn_cvt_pk_fp8_f32(a1[0], a1[1], w1i, false); w1i = __builtin_amdgcn_cvt_pk_fp8_f32(a1[2], a1[3], w1i, true);
                    typedef unsigned u32x2y_t __attribute__((ext_vector_type(2)));
                    __builtin_amdgcn_raw_buffer_store_b64((u32x2y_t){(unsigned)w0, (unsigned)w1i}, ry, idx[ai][m] * 2048 + (cb >> 1), bj * HALF, 0); } }
#else
                for (int bj = 0; bj < 2; ++bj) st16(ry, vo, bj * HALF * 2, pack8(acc[ai][bj][m][0] * w1, acc[ai][bj][m][1] * w1)); }
#endif
    }
};

template <class Epi, class Sched, class AOff, bool FP8 = false>
__device__ __forceinline__ void gemm_phase(PG8_LAS unsigned char* lds, const Gemm g, const Sched& S, const AOff& AO, const Epi& E, int tid_in) {
    int tid = tid_in; asm volatile("" : "+v"(tid));
    const int wid = __builtin_amdgcn_readfirstlane(tid >> 6), lane = tid & 63, wr = wid >> 2, wc = wid & 3, fr = lane & 15, fq = lane >> 4;
    int K = g.Kb; asm volatile("" : "+s"(K));
    const int nt = K / (BK * 2);
    int Ra[2], Ca[2]; unsigned voffB[2];
#pragma unroll
    for (int i = 0; i < 2; ++i) { int R, C; stage_rc(tid * 16 + i * 8192, R, C); const int Rb = Epi::PERM ? ((R & ~31) + perm32(R & 31)) : R;
        Ra[i] = R; Ca[i] = C * 2; voffB[i] = (unsigned)(Rb * K + C * 2); }
    const size_t kstep = (size_t)(BK * 2);
    const size_t hstep = (size_t)HALF * K;
    const size_t tstep = 2 * hstep;
    const unsigned ldsw = (unsigned)wid * 1024u;
    const unsigned lds0 = (unsigned)(uintptr_t)lds;
    const int aoff = lds_byte(wr * 64 + fr, fq * 8), boff = lds_byte(wc * 32 + fr, fq * 8);
#define PG8_SA(b, h) (((b) * 2 + (h)) * HTB)
#define PG8_SB(b, h) ((4 + (b) * 2 + (h)) * HTB)
#define PG8_STAGE(bufoff, gbase, voff) do { _Pragma("unroll") for (int _i = 0; _i < 2; ++_i) { unsigned keep_; \
        asm volatile("s_mov_b32 %0, m0\n\ts_mov_b32 m0, %2\n\ts_nop 0\n\tglobal_load_lds_dwordx4 %1, %3\n\ts_mov_b32 m0, %0" : "=&s"(keep_) \
            : "v"((voff)[_i]), "s"((unsigned)__builtin_amdgcn_readfirstlane((int)(lds0 + (bufoff) + ldsw + _i * 8192))), "s"((const void*)(gbase)) : "memory"); } } while (0)
#define PG8_LD8(addr) __builtin_shufflevector(*(const PG8_LAS v4i_t*)(addr), *(const PG8_LAS v4i_t*)((addr) + 1024), 0, 1, 2, 3, 4, 5, 6, 7)
#define PG8_LDA(dst, b, h) do { _Pragma("unroll") for (int m = 0; m < 4; ++m) dst[m] = PG8_LD8(lds + PG8_SA(b, h) + aoff + m * 2048); } while (0)
#define PG8_LDB(dst, b, h) do { _Pragma("unroll") for (int n = 0; n < 2; ++n) dst[n] = PG8_LD8(lds + PG8_SB(b, h) + boff + n * 2048); } while (0)
#define PG8_HALF(x, k) __builtin_bit_cast(bf16x8, __builtin_shufflevector(x, x, 4 * (k), 4 * (k) + 1, 4 * (k) + 2, 4 * (k) + 3))
#define PG8_MMA(ai, bj, At, Bt) do { __builtin_amdgcn_s_setprio(1); _Pragma("unroll") for (int m = 0; m < 4; ++m) _Pragma("unroll") for (int n = 0; n < 2; ++n) { \
        if constexpr (FP8) asm volatile("v_mfma_scale_f32_16x16x128_f8f6f4 %0, %1, %2, %0, %3, %3 op_sel_hi:[0,0,0]" : "+v"(acc[ai][bj][m][n]) : "v"(Bt[n]), "v"(At[m]), "v"(sc1_));   \
        else { acc[ai][bj][m][n] = __builtin_amdgcn_mfma_f32_16x16x32_bf16(PG8_HALF(Bt[n], 0), PG8_HALF(At[m], 0), acc[ai][bj][m][n], 0, 0, 0); \
               acc[ai][bj][m][n] = __builtin_amdgcn_mfma_f32_16x16x32_bf16(PG8_HALF(Bt[n], 1), PG8_HALF(At[m], 1), acc[ai][bj][m][n], 0, 0, 0); } } \
        __builtin_amdgcn_s_setprio(0); } while (0)
#define PG8_WAIT_V(n) asm volatile("s_waitcnt vmcnt(" #n ")" ::: "memory")
#define PG8_WAIT_L(n) asm volatile("s_waitcnt lgkmcnt(" #n ")" ::: "memory")
#define PG8_BAR __builtin_amdgcn_s_barrier()
#define PG8_SCHED __builtin_amdgcn_sched_barrier(0)
#define PG8_AOFF(dst, u, slot) do { _Pragma("unroll") for (int _h = 0; _h < 2; ++_h) _Pragma("unroll") for (int _i = 0; _i < 2; ++_i) dst[_h][_i] = AO.off(u, slot, _h * HALF + Ra[_i], K) + (unsigned)Ca[_i]; } while (0)
    Unit cur, nxt; int ui = 0;
    if (!S.next(0, cur)) return;
    Acc acc;
#pragma unroll
    for (int a = 0; a < 2; ++a)
#pragma unroll
        for (int b = 0; b < 2; ++b)
#pragma unroll
            for (int m = 0; m < 4; ++m)
#pragma unroll
                for (int n = 0; n < 2; ++n) acc[a][b][m][n] = (f32x4){0.f, 0.f, 0.f, 0.f};
    v8i_t At[4], B0[2], B1[2];
    int sc1_ = 0x7F7F7F7F; asm volatile("" : "+v"(sc1_));
    unsigned aoC[2][2];
    PG8_AOFF(aoC, cur, 0);
    const char* gA = (const char*)g.A; const char* gB = (const char*)g.Bt;
    asm volatile("" : "+s"(gA), "+s"(gB));
    const char* cB = gB + (size_t)cur.pb * tstep;
    PG8_STAGE(PG8_SB(0, 0), cB, voffB); PG8_STAGE(PG8_SB(0, 1), cB + hstep, voffB); PG8_STAGE(PG8_SA(0, 0), gA, aoC[0]); PG8_STAGE(PG8_SA(0, 1), gA, aoC[1]);
    if (wr == 1) PG8_BAR;
    PG8_WAIT_V(2); PG8_BAR;
    PG8_STAGE(PG8_SB(1, 0), cB + kstep, voffB); PG8_STAGE(PG8_SA(1, 0), gA + kstep, aoC[0]); PG8_STAGE(PG8_SB(1, 1), cB + hstep + kstep, voffB);
    PG8_WAIT_V(6); PG8_BAR;
    for (;;) {
        const bool has_next = S.next(ui + 1, nxt);
        const char* nB = has_next ? gB + (size_t)nxt.pb * tstep : cB;
        for (int t = 0; t < nt; t += 2) {
            const bool last = (t == nt - 2);
            const char* a1 = gA + (size_t)(t + 1) * kstep;
            const char* a2 = last ? gA : gA + (size_t)(t + 2) * kstep; const char* b2 = last ? nB : cB + (size_t)(t + 2) * kstep;
            const char* a3 = a2 + kstep; const char* b3 = b2 + kstep;
            unsigned ao2[2][2];
            if (last && has_next) { PG8_AOFF(ao2, nxt, ui + 1); }
            else {
#pragma unroll
                for (int _h = 0; _h < 2; ++_h)
#pragma unroll
                    for (int _i = 0; _i < 2; ++_i) ao2[_h][_i] = aoC[_h][_i]; }
            PG8_LDB(B0, 0, 0); PG8_LDB(B1, 0, 1); PG8_SCHED; PG8_LDA(At, 0, 0); PG8_STAGE(PG8_SA(1, 1), a1, aoC[1]);
            PG8_WAIT_V(8); PG8_WAIT_L(0); PG8_BAR; PG8_MMA(0, 0, At, B0); PG8_MMA(0, 1, At, B1); PG8_BAR; PG8_SCHED;
            PG8_LDA(At, 0, 1); PG8_STAGE(PG8_SB(0, 0), b2, voffB); PG8_STAGE(PG8_SB(0, 1), b2 + hstep, voffB); PG8_STAGE(PG8_SA(0, 0), a2, ao2[0]);
            PG8_WAIT_V(8); PG8_WAIT_L(0); PG8_BAR; PG8_MMA(1, 0, At, B0); PG8_MMA(1, 1, At, B1); PG8_BAR; PG8_SCHED;
            PG8_LDB(B0, 1, 0); PG8_LDB(B1, 1, 1); PG8_SCHED; PG8_LDA(At, 1, 0); PG8_STAGE(PG8_SA(0, 1), a2, ao2[1]);
            PG8_WAIT_V(8); PG8_WAIT_L(0); PG8_BAR; PG8_MMA(0, 0, At, B0); PG8_MMA(0, 1, At, B1); PG8_BAR; PG8_SCHED;
            PG8_LDA(At, 1, 1); PG8_STAGE(PG8_SB(1, 0), b3, voffB); PG8_STAGE(PG8_SB(1, 1), b3 + hstep, voffB); PG8_STAGE(PG8_SA(1, 0), a3, ao2[0]);
            PG8_WAIT_V(8); PG8_WAIT_L(0); PG8_BAR; PG8_MMA(1, 0, At, B0); PG8_MMA(1, 1, At, B1); PG8_BAR; PG8_SCHED;
        }
        if (wr == 0) PG8_BAR;
        E(acc, cur, wr, wc, fr, fq);
        if (!has_next) break;
#pragma unroll
        for (int a = 0; a < 2; ++a)
#pragma unroll
            for (int b = 0; b < 2; ++b)
#pragma unroll
                for (int m = 0; m < 4; ++m)
#pragma unroll
                    for (int n = 0; n < 2; ++n) acc[a][b][m][n] = (f32x4){0.f, 0.f, 0.f, 0.f};
        cur = nxt; cB = nB; ++ui;
        PG8_AOFF(aoC, cur, ui);
        if (wr == 1) PG8_BAR;
    }
    PG8_WAIT_V(0);
    PG8_BAR;
#undef PG8_SA
#undef PG8_SB
#undef PG8_STAGE
#undef PG8_LDA
#undef PG8_LDB
#undef PG8_MMA
#undef PG8_LD8
#undef PG8_HALF
#undef PG8_WAIT_V
#undef PG8_WAIT_L
#undef PG8_BAR
#undef PG8_SCHED
#undef PG8_AOFF
}
}
namespace att {
typedef unsigned short bf16;
typedef short bf16x8 __attribute__((ext_vector_type(8)));
typedef short s16x4 __attribute__((ext_vector_type(4)));
typedef float f32x16 __attribute__((ext_vector_type(16)));
typedef float f32x4 __attribute__((ext_vector_type(4)));
typedef unsigned u32x4 __attribute__((ext_vector_type(4)));
constexpr int NW = 8, QBLK = 32, KVBLK = 64, QB = NW * QBLK, DV = 128;
constexpr float THR = 8.f;
constexpr int SHM_V = KVBLK * DV * 2;
template <int DQK> struct Cfg { static constexpr int NKC = DQK / 8, KCH = NKC / 8, KPITCH = DQK * 2, SHM_K = KVBLK * KPITCH, NQF = DQK / 16, LDS_BYTES = 2 * SHM_V + 2 * SHM_K + NW * 64 * 4; };
#define SBAR() __builtin_amdgcn_sched_barrier(0)
__device__ __forceinline__ int v_st(int k, int c) { const int kk = (k & ~0xC) | ((k & 4) << 1) | ((k & 8) >> 1); return ((kk >> 3) * 4 + (c >> 5)) * 512 + ((kk & 7) * 32 + (c & 31)) * 2; }
__device__ __forceinline__ int v_rd_base(int lane) { return ((lane & 3) << 3) | (((lane >> 2) & 3) << 6) | (((lane >> 4) & 1) << 5) | (((lane >> 5) & 1) << 8); }
constexpr int v_rd_off(int d0, int ks, int half) { return d0 * 512 + ks * 4096 + half * 2048; }
__device__ __forceinline__ int crow(int r, int hi) { return (r & 3) + 8 * (r >> 2) + 4 * hi; }
__device__ __forceinline__ unsigned cvtpk(float lo, float hi) { return pg8::cvt_pk_bf16(lo, hi); }
__device__ __forceinline__ bf16x8 load8(const bf16* p) { return *reinterpret_cast<const bf16x8*>(p); }
__device__ __forceinline__ void mask_tile(f32x16& p0, f32x16& p1, int dq, unsigned W) {
    const float NEG = -__builtin_inff();
#pragma unroll
    for (int r = 0; r < 16; ++r) { const int c = (r & 3) + 8 * (r >> 2);
        if ((unsigned)(dq - c) >= W) p0[r] = NEG;
        if ((unsigned)(dq - c - 32) >= W) p1[r] = NEG; }
}
__device__ __forceinline__ void partialSM(f32x16& p0, f32x16& p1, float& m_reg, float& mn, float& alpha, float scale) {
    float pmax = p0[0];
#pragma unroll
    for (int r = 1; r < 16; ++r) pmax = fmaxf(pmax, p0[r]);
#pragma unroll
    for (int r = 0; r < 16; ++r) pmax = fmaxf(pmax, p1[r]);
    { auto rr = __builtin_amdgcn_permlane32_swap(__float_as_uint(pmax), __float_as_uint(pmax), false, false);
      pmax = fmaxf(__uint_as_float(rr[0]), __uint_as_float(rr[1])); }
    const float C2 = 1.4426950408889634f * scale;
    if (__builtin_expect(__all((pmax - m_reg) * scale <= THR), 1)) { mn = m_reg; alpha = 1.f; }
    else { mn = fmaxf(m_reg, pmax); alpha = __builtin_amdgcn_exp2f((m_reg - mn) * C2); m_reg = mn; }
    const float mnL = -mn * C2;
#pragma unroll
    for (int r = 0; r < 16; ++r) p0[r] = fmaf(p0[r], C2, mnL);
#pragma unroll
    for (int r = 0; r < 16; ++r) p1[r] = fmaf(p1[r], C2, mnL);
#pragma unroll
    for (int r = 0; r < 16; ++r) p0[r] = __builtin_amdgcn_exp2f(p0[r]);
}
__device__ __forceinline__ void finishSM(f32x16& p0, f32x16& p1, float alpha, float& l_reg, bf16x8& pa0, bf16x8& pa1, bf16x8& pa2, bf16x8& pa3) {
#pragma unroll
    for (int r = 0; r < 16; ++r) p1[r] = __builtin_amdgcn_exp2f(p1[r]);
    float ps = 0;
#pragma unroll
    for (int r = 0; r < 16; ++r) ps += p0[r];
#pragma unroll
    for (int r = 0; r < 16; ++r) ps += p1[r];
    { auto rr = __builtin_amdgcn_permlane32_swap(__float_as_uint(ps), __float_as_uint(ps), false, false);
      ps = __uint_as_float(rr[0]) + __uint_as_float(rr[1]); }
    l_reg = l_reg * alpha + ps;
#define PK4(P, B_, OUT) do { unsigned a0 = cvtpk(P[B_+0], P[B_+1]), a1 = cvtpk(P[B_+2], P[B_+3]);                          \
        unsigned b0 = cvtpk(P[B_+4], P[B_+5]), b1 = cvtpk(P[B_+6], P[B_+7]);                                             \
        auto r0 = __builtin_amdgcn_permlane32_swap(a0, b0, false, false); auto r1 = __builtin_amdgcn_permlane32_swap(a1, b1, false, false); \
        u32x4 w = {r0[0], r1[0], r0[1], r1[1]}; OUT = *reinterpret_cast<bf16x8*>(&w); } while (0)
    PK4(p0, 0, pa0); PK4(p0, 8, pa1); PK4(p1, 0, pa2); PK4(p1, 8, pa3);
#undef PK4
}
template <int KB, bool SK, int DQK, bool DIL>
__device__ __forceinline__ void qkt(f32x16& p0, f32x16& p1, const char* K_lds, int r32, int hi, const bf16x8* qr, bool act, float beta, int dq) {
    typedef Cfg<DQK> C;
    if (SK && !act) { const float NEG = -__builtin_inff();
#pragma unroll
        for (int r = 0; r < 16; ++r) { p0[r] = NEG; p1[r] = NEG; } return; }
    if constexpr (DIL) { const float b0 = -beta * (float)dq;
#pragma unroll
        for (int r = 0; r < 16; ++r) { const int c = (r & 3) + 8 * (r >> 2); p0[r] = fmaf(beta, (float)c, b0); p1[r] = fmaf(beta, (float)(c + 32), b0); } }
    else { p0 = f32x16{}; p1 = f32x16{}; }
    const char* kb[4];
#pragma unroll
    for (int dd = 0; dd < 4; ++dd) { const int colB = (dd * 16 + hi * 8) * 2; kb[dd] = K_lds + KB * C::SHM_K + r32 * C::KPITCH + (colB ^ ((r32 & 7) << 4)); }
#pragma unroll
    for (int d0 = 0; d0 < C::NQF; ++d0) { const char* a = kb[d0 & 3] + (d0 >> 2) * 128;
        bf16x8 b0 = *reinterpret_cast<const bf16x8*>(a);
        bf16x8 b1 = *reinterpret_cast<const bf16x8*>(a + 32 * C::KPITCH);
        p0 = __builtin_amdgcn_mfma_f32_32x32x16_bf16(b0, qr[d0], p0, 0, 0, 0);
        p1 = __builtin_amdgcn_mfma_f32_32x32x16_bf16(b1, qr[d0], p1, 0, 0, 0);
#ifndef ATT_NO_QKT_SBAR
        if ((d0 & 3) == 3) SBAR();
#endif
    }
}
#ifdef ATT_PV_PIPE
template <int VB, bool SK>
__device__ __forceinline__ void pv_tile(f32x16* o, int vb0, bf16x8 pa0, bf16x8 pa1, bf16x8 pa2, bf16x8 pa3, bool act) {
    if (SK && !act) return;
#define TRRD(dst, off) asm volatile("ds_read_b64_tr_b16 %0, %1 offset:%2" : "=&v"(dst) : "v"(vb0), "i"(off) : "memory")
#define PV_RD(S_, d0) do { constexpr int b_ = VB * SHM_V + v_rd_off(d0, 0, 0); \
        TRRD(S_##l0, b_); TRRD(S_##h0, b_ + 2048); TRRD(S_##l1, b_ + 4096); TRRD(S_##h1, b_ + 6144); TRRD(S_##l2, b_ + 8192); TRRD(S_##h2, b_ + 10240); TRRD(S_##l3, b_ + 12288); TRRD(S_##h3, b_ + 14336); } while (0)
#define PV_MM(S_, d0) do { \
        o[d0] = __builtin_amdgcn_mfma_f32_32x32x16_bf16(pa0, (bf16x8){S_##l0[0], S_##l0[1], S_##l0[2], S_##l0[3], S_##h0[0], S_##h0[1], S_##h0[2], S_##h0[3]}, o[d0], 0, 0, 0);   \
        o[d0] = __builtin_amdgcn_mfma_f32_32x32x16_bf16(pa1, (bf16x8){S_##l1[0], S_##l1[1], S_##l1[2], S_##l1[3], S_##h1[0], S_##h1[1], S_##h1[2], S_##h1[3]}, o[d0], 0, 0, 0);   \
        o[d0] = __builtin_amdgcn_mfma_f32_32x32x16_bf16(pa2, (bf16x8){S_##l2[0], S_##l2[1], S_##l2[2], S_##l2[3], S_##h2[0], S_##h2[1], S_##h2[2], S_##h2[3]}, o[d0], 0, 0, 0);   \
        o[d0] = __builtin_amdgcn_mfma_f32_32x32x16_bf16(pa3, (bf16x8){S_##l3[0], S_##l3[1], S_##l3[2], S_##l3[3], S_##h3[0], S_##h3[1], S_##h3[2], S_##h3[3]}, o[d0], 0, 0, 0); } while (0)
#define PV_W8() do { asm volatile("s_waitcnt lgkmcnt(8)" ::: "memory"); SBAR(); } while (0)
#define PV_W0() do { asm volatile("s_waitcnt lgkmcnt(0)" ::: "memory"); SBAR(); } while (0)
    s16x4 al0, al1, al2, al3, ah0, ah1, ah2, ah3, bl0, bl1, bl2, bl3, bh0, bh1, bh2, bh3;
    PV_RD(a, 0); PV_RD(b, 1); PV_W8(); PV_MM(a, 0); SBAR();
    PV_RD(a, 2); PV_W8(); PV_MM(b, 1); SBAR();
    PV_RD(b, 3); PV_W8(); PV_MM(a, 2); SBAR();
    PV_W0(); PV_MM(b, 3);
#undef PV_RD
#undef PV_MM
#undef PV_W8
#undef PV_W0
#undef TRRD
}
#else
template <int VB, bool SK>
__device__ __forceinline__ void pv_tile(f32x16* o, int vb0, bf16x8 pa0, bf16x8 pa1, bf16x8 pa2, bf16x8 pa3, bool act) {
    if (SK && !act) return;
#define TRRD(dst, off) asm volatile("ds_read_b64_tr_b16 %0, %1 offset:%2" : "=&v"(dst) : "v"(vb0), "i"(off) : "memory")
#define PV_D0(d0) do { s16x4 l0, l1, l2, l3, h0, h1, h2, h3; constexpr int b_ = VB * SHM_V + v_rd_off(d0, 0, 0); \
        TRRD(l0, b_); TRRD(h0, b_ + 2048); TRRD(l1, b_ + 4096); TRRD(h1, b_ + 6144); TRRD(l2, b_ + 8192); TRRD(h2, b_ + 10240); TRRD(l3, b_ + 12288); TRRD(h3, b_ + 14336); \
        asm volatile("s_waitcnt lgkmcnt(0)" ::: "memory"); SBAR();   \
        o[d0] = __builtin_amdgcn_mfma_f32_32x32x16_bf16(pa0, (bf16x8){l0[0], l0[1], l0[2], l0[3], h0[0], h0[1], h0[2], h0[3]}, o[d0], 0, 0, 0);   \
        o[d0] = __builtin_amdgcn_mfma_f32_32x32x16_bf16(pa1, (bf16x8){l1[0], l1[1], l1[2], l1[3], h1[0], h1[1], h1[2], h1[3]}, o[d0], 0, 0, 0);   \
        o[d0] = __builtin_amdgcn_mfma_f32_32x32x16_bf16(pa2, (bf16x8){l2[0], l2[1], l2[2], l2[3], h2[0], h2[1], h2[2], h2[3]}, o[d0], 0, 0, 0);   \
        o[d0] = __builtin_amdgcn_mfma_f32_32x32x16_bf16(pa3, (bf16x8){l3[0], l3[1], l3[2], l3[3], h3[0], h3[1], h3[2], h3[3]}, o[d0], 0, 0, 0); } while (0)
    PV_D0(0); PV_D0(1); PV_D0(2); PV_D0(3);
#undef PV_D0
#undef TRRD
}
#endif

struct Blk { unsigned qo, ko, vo, oo, lo; int P0, rate; float beta; };
constexpr int PVAR = 0;
#define QS_(B) (DIL ? ((PVAR & 4) ? 128 : (B).rate * 4096) : 1536)
#define KS_(B) (DIL ? ((PVAR & 2) ? 128 : (B).rate * 4096) : 1536)
#define VS_(B) (DIL ? ((PVAR & 2) ? 128 : (B).rate * 4096) : 1024)
#define OS_(B) (DIL ? (B).rate * 1024 : 1024)
#define LS_(B) ((B).rate * 8)
#define SKV_(B) (DIL ? 8192 / (B).rate : 8192)
#define W_(B) (DIL ? 129 : (1 << 30))
#define SCALE_ (DIL ? 0.08838834764831845f : 0.07216878364870322f)
template <int DQK> struct Seam { bf16x8 qr[Cfg<DQK>::NQF]; bf16x8 st_v0, st_v1; bf16x8 st_k[Cfg<DQK>::KCH]; unsigned p_oo = 0; int p_rb = 0, p_so0 = 0, p_on = 0; float cv[4], cw[4]; int cv_j = 0, cv_q = 0, cl_j = 0, cl_q = 0; f32x4 rt[8]; float cvf[32]; int cv_pend = 0; };
__device__ __forceinline__ int swa_jlo(int P0, int W) { const int lowk = P0 - W + 1; return lowk > 0 ? lowk / KVBLK : 0; }

#define VMW() asm volatile("s_waitcnt vmcnt(0)" ::: "memory")
#ifdef ATT_RAWBAR
#define A_STEPBAR() do { asm volatile("s_waitcnt lgkmcnt(0)" ::: "memory"); __builtin_amdgcn_s_barrier(); asm volatile("" ::: "memory"); } while (0)
#else
#define A_STEPBAR() __syncthreads()
#endif
#define VMWN(n) asm volatile("s_waitcnt vmcnt(%0)" :: "i"(n) : "memory")
#define A_RSRC(p) __builtin_amdgcn_make_buffer_rsrc((void*)(p), 0, 0x7fffffff, 0x00020000)
#define A_BLD(rs, vo, so) __builtin_bit_cast(bf16x8, __builtin_amdgcn_raw_buffer_load_b128((rs), (int)(vo), (int)(so), 0))
#ifdef ATT_SLOAD_RECOMP
#define A_SLOAD(B_, k0) do { const __amdgpu_buffer_rsrc_t rv_ = A_RSRC(wsb + (B_).vo), rk_ = A_RSRC(wsb + (B_).ko); const int sov_ = (k0) * VS_(B_) * 2, sok_ = (k0) * KS_(B_) * 2; \
        int t_ = tid; asm volatile("" : "+v"(t_)); const int sr_ = t_ >> 4, sc_ = (t_ & 15) * 8; \
        S.st_v0 = A_BLD(rv_, (sr_ * VS_(B_) + sc_) * 2, sov_); S.st_v1 = A_BLD(rv_, ((32 + sr_) * VS_(B_) + sc_) * 2, sov_); \
        _Pragma("unroll") for (int j_ = 0; j_ < C::KCH; ++j_) { const int q_ = t_ + 512 * j_; S.st_k[j_] = A_BLD(rk_, ((q_ / C::NKC) * KS_(B_) + (q_ % C::NKC) * 8) * 2, sok_); } } while (0)
#else
#define A_SLOAD(B_, k0) do { const __amdgpu_buffer_rsrc_t rv_ = A_RSRC(wsb + (B_).vo), rk_ = A_RSRC(wsb + (B_).ko); const int sov_ = (k0) * VS_(B_) * 2, sok_ = (k0) * KS_(B_) * 2; \
        S.st_v0 = A_BLD(rv_, (sr * VS_(B_) + sc) * 2, sov_); S.st_v1 = A_BLD(rv_, ((32 + sr) * VS_(B_) + sc) * 2, sov_); \
        _Pragma("unroll") for (int j_ = 0; j_ < C::KCH; ++j_) S.st_k[j_] = A_BLD(rk_, (krow[j_] * KS_(B_) + kcol[j_]) * 2, sok_); } while (0)
#endif
#define A_QLOAD(B_) do { const __amdgpu_buffer_rsrc_t rq_ = A_RSRC(wsb + (B_).qo); const int soq_ = ((B_).P0 + wid * QBLK) * QS_(B_) * 2; const int qo_ = r32 * QS_(B_) * 2 + hi * 16; \
        _Pragma("unroll") for (int d0 = 0; d0 < C::NQF; ++d0) S.qr[d0] = A_BLD(rq_, qo_ + d0 * 32, soq_); } while (0)
#define A_SWRITE_K(bf) do { _Pragma("unroll") for (int j_ = 0; j_ < C::KCH; ++j_) *(bf16x8*)(K_lds + (bf) * C::SHM_K + kws[j_]) = S.st_k[j_]; } while (0)
#define A_SWRITE_V(bf) do { *(bf16x8*)(V_lds + (bf) * SHM_V + vst0) = S.st_v0; *(bf16x8*)(V_lds + (bf) * SHM_V + vst1) = S.st_v1; } while (0)
#define A_STAGE_IDX() const int sr = tid >> 4, sc = (tid & 15) * 8; int krow[C::KCH], kcol[C::KCH], kws[C::KCH]; \
        _Pragma("unroll") for (int j_ = 0; j_ < C::KCH; ++j_) { const int q_ = tid + 512 * j_; krow[j_] = q_ / C::NKC; kcol[j_] = (q_ % C::NKC) * 8; kws[j_] = krow[j_] * C::KPITCH + ((kcol[j_] * 2) ^ ((krow[j_] & 7) << 4)); }

__device__ __forceinline__ void store_o_staged(const f32x16* o, const float* rli, char* stg, __amdgpu_buffer_rsrc_t ro_, int rowbytes, int so0_, int lane) {
    const int r32 = lane & 31, hi = lane >> 5, odd = lane & 1, g = odd | (hi << 1);
    char* wb = stg + (odd + 4 * hi) * 256 + (r32 >> 1) * 4;
    char* wa[4];
#pragma unroll
    for (int d0 = 0; d0 < 4; ++d0) wa[d0] = wb + ((d0 ^ g) << 6);
    const int lr = lane >> 4, ch = lane & 15, sp = ch >> 2, gl = lr & 1;
    const char* rb_e = stg + lr * 256 + ((sp ^ gl) << 6) + (lane & 3) * 16;
    const char* rb_o = stg + lr * 256 + ((sp ^ (gl | 2)) << 6) + (lane & 3) * 16;
    const int voff = lr * rowbytes + ch * 16;
#pragma unroll
    for (int h = 0; h < 2; ++h) {
#pragma unroll
        for (int rp = 0; rp < 4; ++rp) { const int r = 8 * h + 2 * rp, Rl = (r & 3) + 8 * ((r >> 2) & 1);
#pragma unroll
            for (int d0 = 0; d0 < 4; ++d0) { const float v0 = o[d0][r] * rli[r], v1 = o[d0][r + 1] * rli[r + 1];
                const float send = odd ? v0 : v1;
                const float recv = __int_as_float(__builtin_amdgcn_update_dpp(0, __float_as_int(send), 0xB1, 0xF, 0xF, true));
                *reinterpret_cast<unsigned*>(wa[d0] + Rl * 256) = cvtpk(odd ? recv : v0, odd ? v1 : recv); } }
        u32x4 d_[4];
#pragma unroll
        for (int i = 0; i < 4; ++i) d_[i] = *reinterpret_cast<const u32x4*>(((i & 1) ? rb_o : rb_e) + i * 1024);
#pragma unroll
        for (int i = 0; i < 4; ++i) __builtin_amdgcn_raw_buffer_store_b128(d_[i], ro_, voff + so0_ + (16 * h + 4 * i) * rowbytes, 0, 0);
    }
}
constexpr int DEFER_STG = 65536, DEFER_WS = 131072 + 512;
__device__ __forceinline__ void stage_write(const f32x16* o, const float* rli, char* stg, int lane) {
    const int r32 = lane & 31, hi = lane >> 5, odd = lane & 1, g = odd | (hi << 1);
    char* wb = stg + (odd + 4 * hi) * 256 + (r32 >> 1) * 4;
    char* wa[4];
#pragma unroll
    for (int d0 = 0; d0 < 4; ++d0) wa[d0] = wb + ((d0 ^ g) << 6);
#pragma unroll
    for (int h = 0; h < 2; ++h)
#pragma unroll
        for (int rp = 0; rp < 4; ++rp) { const int r = 8 * h + 2 * rp, Rl = (r & 3) + 8 * ((r >> 2) & 1);
#pragma unroll
            for (int d0 = 0; d0 < 4; ++d0) { const float v0 = o[d0][r] * rli[r], v1 = o[d0][r + 1] * rli[r + 1];
                const float send = odd ? v0 : v1;
                const float recv = __int_as_float(__builtin_amdgcn_update_dpp(0, __float_as_int(send), 0xB1, 0xF, 0xF, true));
                *reinterpret_cast<unsigned*>(wa[d0] + h * 4096 + Rl * 256) = cvtpk(odd ? recv : v0, odd ? v1 : recv); } }
}
__device__ __forceinline__ void flush_piece(const char* stg, int p, const char* obase, int rowbytes, int so0, int lane) {
    const int lr = lane >> 4, ch = lane & 15, sp = ch >> 2, g = (lr & 1) | ((p & 1) << 1);
    const u32x4 d = *reinterpret_cast<const u32x4*>(stg + p * 1024 + lr * 256 + ((sp ^ g) << 6) + (lane & 3) * 16);
    __builtin_amdgcn_raw_buffer_store_b128(d, A_RSRC(obase), lr * rowbytes + ch * 16 + so0 + 4 * p * rowbytes, 0, 0);
}
struct ConvCtx { const float* eg; const float* eu; const float* ed; unsigned char* w13; unsigned char* w2; int gw; };
constexpr int CONV_SCR = 86016, CONV_NJ = 48;
#ifndef CONV_AUX
#define CONV_AUX 2
#endif
struct ConvItem { const float* src; unsigned char* dst; int ldw, kd; };
__device__ __forceinline__ ConvItem conv_decode(const ConvCtx& X, int j) {
    const int q = X.gw + 2048 * j, e = q / 6144, r = q - e * 6144, m = r >> 11, r2 = r & 2047;
    ConvItem I;
    if (m < 2) { const int kb = r2 >> 6, nb = r2 & 63, n0 = nb * 16; I.ldw = 1024; I.kd = 2048;
        I.src = (m == 0 ? X.eg : X.eu) + (size_t)e * (2048 * 1024) + (size_t)kb * (64 * 1024) + n0;
        I.dst = X.w13 + (size_t)e * (2048 * 2048) + (size_t)((n0 >> 7) * 256 + (m == 1 ? 128 : 0) + (n0 & 127)) * 2048 + kb * 64; }
    else { const int kb = r2 >> 7, nb = r2 & 127; I.ldw = 2048; I.kd = 1024;
        I.src = X.ed + (size_t)e * (1024 * 2048) + (size_t)kb * (64 * 2048) + nb * 16;
        I.dst = X.w2 + (size_t)e * (2048 * 1024) + (size_t)(nb * 16) * 1024 + kb * 64; }
    return I;
}
__device__ __forceinline__ void conv_load(const ConvCtx& X, int j, int qd, float* cv, int lane) {
    const ConvItem I = conv_decode(X, j); const __amdgpu_buffer_rsrc_t rs = A_RSRC(I.src);
#pragma unroll
    for (int i = 0; i < 4; ++i) { const int k = 4 * (4 * qd + i) + (lane >> 4);
        cv[i] = __uint_as_float(__builtin_amdgcn_raw_buffer_load_b32(rs, (k * I.ldw + (lane & 15)) * 4, 0, CONV_AUX)); }
}
__device__ __forceinline__ void conv_put(const ConvCtx& X, int j, int qd, const float* cv, char* scr, int lane, bool finish_only = false) {
    float* s = reinterpret_cast<float*>(scr);
    if (!finish_only) {
#pragma unroll
    for (int i = 0; i < 4; ++i) { const int k = 4 * (4 * qd + i) + (lane >> 4); s[k * 17 + (lane & 15)] = cv[i] * 256.0f; } }
    if (qd == 3) {
        const ConvItem I = conv_decode(X, j); const int n = lane & 15, kq = lane >> 4; const float* c = s + (16 * kq) * 17 + n;
        u32x4 w;
        { int w0 = 0, w1 = 0, w2 = 0, w3 = 0;
          w0 = __builtin_amdgcn_cvt_pk_fp8_f32(c[0 * 17], c[1 * 17], w0, false); w0 = __builtin_amdgcn_cvt_pk_fp8_f32(c[2 * 17], c[3 * 17], w0, true);
          w1 = __builtin_amdgcn_cvt_pk_fp8_f32(c[4 * 17], c[5 * 17], w1, false); w1 = __builtin_amdgcn_cvt_pk_fp8_f32(c[6 * 17], c[7 * 17], w1, true);
          w2 = __builtin_amdgcn_cvt_pk_fp8_f32(c[8 * 17], c[9 * 17], w2, false); w2 = __builtin_amdgcn_cvt_pk_fp8_f32(c[10 * 17], c[11 * 17], w2, true);
          w3 = __builtin_amdgcn_cvt_pk_fp8_f32(c[12 * 17], c[13 * 17], w3, false); w3 = __builtin_amdgcn_cvt_pk_fp8_f32(c[14 * 17], c[15 * 17], w3, true);
          w = (u32x4){(unsigned)w0, (unsigned)w1, (unsigned)w2, (unsigned)w3}; }
        __builtin_amdgcn_raw_buffer_store_b128(w, A_RSRC(I.dst), n * I.kd + 16 * kq, 0, CONV_AUX);
    }
}
constexpr unsigned ROPE_OFF = 2u << 20;
#define A_RTLOAD(B_) do { const __amdgpu_buffer_rsrc_t rr_ = A_RSRC(wsb + ROPE_OFF); const int vo_ = ((B_).P0 + wid * QBLK + r32) * 256 + hi * 32; \
        _Pragma("unroll") for (int d_ = 0; d_ < 4; ++d_) { S.rt[2 * d_] = __builtin_bit_cast(f32x4, __builtin_amdgcn_raw_buffer_load_b128(rr_, vo_ + d_ * 64, 0, 0)); \
                                                            S.rt[2 * d_ + 1] = __builtin_bit_cast(f32x4, __builtin_amdgcn_raw_buffer_load_b128(rr_, vo_ + d_ * 64 + 16, 0, 0)); } } while (0)
__device__ __forceinline__ unsigned rope_pair(unsigned w, float c, float s) { const float x1 = __uint_as_float(w << 16), x2 = __uint_as_float(w & 0xffff0000u); return cvtpk(x1 * c - x2 * s, x2 * c + x1 * s); }
#define A_ROTATE() do { _Pragma("unroll") for (int d_ = 0; d_ < 4; ++d_) { u32x4 w_ = __builtin_bit_cast(u32x4, S.qr[8 + d_]); const f32x4 c01_ = S.rt[2 * d_], c23_ = S.rt[2 * d_ + 1]; \
        w_.x = rope_pair(w_.x, c01_[0], c01_[1]); w_.y = rope_pair(w_.y, c01_[2], c01_[3]); w_.z = rope_pair(w_.z, c23_[0], c23_[1]); w_.w = rope_pair(w_.w, c23_[2], c23_[3]); \
        S.qr[8 + d_] = __builtin_bit_cast(bf16x8, w_); } } while (0)
constexpr int CONV_SCR_DIL = 67584;
#ifndef CONV_PER_IDLE
#define CONV_PER_IDLE 1
#endif
#ifndef CONV_LAST_STEP
#define CONV_LAST_STEP 0
#endif
__device__ __forceinline__ void conv_load_full(const ConvCtx& X, int j, float* cv, int lane) {
    const ConvItem I = conv_decode(X, j); const __amdgpu_buffer_rsrc_t rs = A_RSRC(I.src);
#pragma unroll
    for (int i = 0; i < 16; ++i) { const int k = 4 * i + (lane >> 4); cv[i] = __uint_as_float(__builtin_amdgcn_raw_buffer_load_b32(rs, (k * I.ldw + (lane & 15)) * 4, 0, CONV_AUX)); }
}
__device__ __forceinline__ void conv_put_full(const ConvCtx& X, int j, const float* cv, char* scr, int lane) {
    float* s = reinterpret_cast<float*>(scr);
#pragma unroll
    for (int i = 0; i < 16; ++i) { const int k = 4 * i + (lane >> 4); s[k * 17 + (lane & 15)] = cv[i] * 256.0f; }
    float dummy_[4] = {0.f, 0.f, 0.f, 0.f};
    conv_put(X, j, 3, dummy_, scr, lane, true);
}
template <int DQK, bool DIL, int PVAR = 0, bool ROPE = false>
__device__ __forceinline__ void att_prime(const Blk& cur, const char* wsb, char* lds, Seam<DQK>& S, int tid_in) {
    typedef Cfg<DQK> C;
    int tid = tid_in; asm volatile("" : "+v"(tid));
    const int wid = __builtin_amdgcn_readfirstlane(tid >> 6), lane = tid & 63, r32 = lane & 31, hi = lane >> 5;
    A_STAGE_IDX(); char* K_lds = lds + 2 * SHM_V;
    const int kb0 = swa_jlo(cur.P0, W_(cur)) * KVBLK;
    A_QLOAD(cur);
    if constexpr (ROPE) A_RTLOAD(cur);
    A_SLOAD(cur, kb0); VMW(); A_SWRITE_K(0);
    __syncthreads();
}
template <int DQK, bool DIL, bool SK, int PVAR = 0, int CONV = 0, bool ROPE = false>
__device__ __forceinline__ void att_block(const Blk& cur, const Blk& nxt, const char* wsb, char* lds, Seam<DQK>& S, int tid_in, const ConvCtx* X = nullptr) {
    typedef Cfg<DQK> C;
    int tid = tid_in; asm volatile("" : "+v"(tid));
    const int wid = __builtin_amdgcn_readfirstlane(tid >> 6), lane = tid & 63, r32 = lane & 31, hi = lane >> 5;
    const int W = W_(cur); const float scale = SCALE_, beta = cur.beta;
    int j_lo = swa_jlo(cur.P0, W);
    int j_hi = (cur.P0 + QB - 1) / KVBLK + 1; if (j_hi > SKV_(cur) / KVBLK) j_hi = SKV_(cur) / KVBLK;
    if (PVAR & 8) j_lo = j_hi - 2;
    const int NT = j_hi - j_lo;
    const int kbn = swa_jlo(nxt.P0, W_(nxt)) * KVBLK;
    const int qlo = cur.P0 + wid * QBLK, qm = qlo + r32 - 4 * hi;
    char* V_lds = lds; char* K_lds = lds + 2 * SHM_V;
#ifdef ATT_DEFER
    constexpr bool DEFER = DIL;
#else
    constexpr bool DEFER = false;
#endif
    float* ws = (float*)(lds + (DEFER ? DEFER_WS : 2 * SHM_V + 2 * C::SHM_K)) + wid * 64; float* li_l = ws, * al_l = ws + 32;
    char* stg = lds + DEFER_STG + wid * 8192;
    float m_reg = -1e30f, l_reg = 0; f32x16 o[4] = {};
    A_STAGE_IDX();
    const int vst0 = v_st(sr, sc), vst1 = v_st(32 + sr, sc);
    const int vb0 = (int)(uintptr_t)V_lds + v_rd_base(lane);
#define RESC(a) do { if (__any((a) < 1.f)) { if (hi == 0) al_l[r32] = (a); asm volatile("s_waitcnt lgkmcnt(0)" ::: "memory");              \
                     _Pragma("unroll") for (int d_ = 0; d_ < 4; ++d_) _Pragma("unroll") for (int r = 0; r < 16; ++r) o[d_][r] *= al_l[crow(r, hi)]; } } while (0)
#define KBASE(t) ((j_lo + (t)) * KVBLK)
#define ACT(t) (KBASE(t) <= qlo + QBLK - 1 && KBASE(t) + KVBLK - 1 >= qlo - W + 1)
#define MASKT(P0_, P1_, t) do { const int kb_ = KBASE(t); if ((!SK || ACT(t)) && (kb_ + KVBLK - 1 > qlo || kb_ <= qlo + QBLK - 1 - W)) mask_tile(P0_, P1_, qm - kb_, (unsigned)W); } while (0)
    A_SWRITE_V(0);
    __syncthreads();
    if constexpr (ROPE) { VMW(); A_ROTATE(); }
#define STEP(t, BUF) do { const bool more_ = (t) + 1 < NT;                                                                        \
        if (more_) { A_SLOAD(cur, KBASE((t) + 1)); } else { A_SLOAD(nxt, kbn); }                                                   \
        const bool cpend_ = CONV == 1 && (S.cv_j != S.cl_j || S.cv_q != S.cl_q); const bool cld_ = CONV == 1 && more_ && S.cl_j < CONV_NJ;        \
        const bool act_ = !SK || ACT(t); const bool cidle_ = CONV == 2 && (more_ || CONV_LAST_STEP) && !act_ && (S.cv_j < CONV_NJ);                                \
        bool cnew_ = false;                                                                                                    \
        if (cidle_) { if (S.cv_pend) { VMWN(C::KCH + 2);        \
                          conv_put_full(*X, S.cv_j, S.cvf, lds + (DIL ? CONV_SCR_DIL : CONV_SCR) + wid * 4352, lane); ++S.cv_j;                 \
                          if (S.cv_pend > 1) { conv_put_full(*X, S.cv_j, S.cvf + 16, lds + (DIL ? CONV_SCR_DIL : CONV_SCR) + wid * 4352, lane); ++S.cv_j; } S.cv_pend = 0; } \
                      if (S.cv_j < CONV_NJ) { conv_load_full(*X, S.cv_j, S.cvf, lane); S.cv_pend = 1; cnew_ = true;                                \
                          if (CONV_PER_IDLE > 1 && S.cv_j + 1 < CONV_NJ) { conv_load_full(*X, S.cv_j + 1, S.cvf + 16, lane); S.cv_pend = 2; } } }        \
        if (cld_) { conv_load(*X, S.cl_j, S.cl_q, BUF ? S.cw : S.cv, lane); if (++S.cl_q == 4) { S.cl_q = 0; ++S.cl_j; } }               \
        if (DEFER && S.p_on && (t) < 4) { flush_piece(stg, 2 * (t), wsb + S.p_oo, S.p_rb, S.p_so0, lane); flush_piece(stg, 2 * (t) + 1, wsb + S.p_oo, S.p_rb, S.p_so0, lane); } \
        SBAR();                                                                                                                 \
        if (act_) { f32x16 p0, p1; float mn_, al_; bf16x8 pa0, pa1, pa2, pa3;      \
            qkt<BUF, false, DQK, DIL>(p0, p1, K_lds, r32, hi, S.qr, true, beta, qm - KBASE(t)); SBAR();                              \
            MASKT(p0, p1, t); partialSM(p0, p1, m_reg, mn_, al_, scale); finishSM(p0, p1, al_, l_reg, pa0, pa1, pa2, pa3); RESC(al_); SBAR(); \
            pv_tile<BUF, false>(o, vb0, pa0, pa1, pa2, pa3, true); }                                                             \
        if (!more_) { SBAR(); A_QLOAD(nxt); SBAR(); }                                 \
        if (more_) { if (cnew_) { if (S.cv_pend > 1) VMWN(32); else VMWN(16); } else if (cld_) VMWN(4); else VMW();            \
            A_SWRITE_V(1 - BUF); A_SWRITE_K(1 - BUF);                                                                              \
            if (cpend_) { conv_put(*X, S.cv_j, S.cv_q, BUF ? S.cv : S.cw, lds + CONV_SCR + wid * 4352, lane); if (++S.cv_q == 4) { S.cv_q = 0; ++S.cv_j; } } \
        }                                                                                                                       \
        A_STEPBAR(); } while (0)
    int t = 0;
    for (; t + 1 < NT; t += 2) { STEP(t, 0); STEP(t + 1, 1); }
    if (t < NT) { STEP(t, 0); }
    VMWN(C::NQF); A_SWRITE_K(0); SBAR();
    if (CONV == 1 && (S.cv_j != S.cl_j || S.cv_q != S.cl_q)) { conv_put(*X, S.cv_j, S.cv_q, S.cv, lds + CONV_SCR + wid * 4352, lane); if (++S.cv_q == 4) { S.cv_q = 0; ++S.cv_j; } }
    if (hi == 0) li_l[r32] = l_reg; asm volatile("s_waitcnt lgkmcnt(0)" ::: "memory");
    if constexpr (DIL) { if (hi == 0) __builtin_amdgcn_raw_buffer_store_b32(__float_as_uint(m_reg * scale + __logf(l_reg)), A_RSRC(wsb + cur.lo), r32 * LS_(cur) * 4, (cur.P0 + wid * QBLK) * LS_(cur) * 4, 0); }
    float rli[16];
#pragma unroll
    for (int r = 0; r < 16; ++r) rli[r] = __builtin_amdgcn_rcpf(li_l[crow(r, hi)]);
    if constexpr (DEFER) { stage_write(o, rli, stg, lane); S.p_oo = cur.oo; S.p_rb = OS_(cur) * 2; S.p_so0 = (cur.P0 + wid * QBLK) * OS_(cur) * 2; S.p_on = 1; }
    else {
#ifdef ATT_T21
    store_o_staged(o, rli, wid < 4 ? lds + SHM_V + wid * 4096 : lds + 2 * SHM_V + C::SHM_K + (wid - 4) * 4096, A_RSRC(wsb + cur.oo), OS_(cur) * 2, (cur.P0 + wid * QBLK) * OS_(cur) * 2, lane);
#else
    const int os_ = (PVAR & 1) ? 0 : OS_(cur);
    const __amdgpu_buffer_rsrc_t ro_ = A_RSRC(wsb + cur.oo); const int oo_ = (4 * hi * os_ + r32) * 2, so0_ = (cur.P0 + wid * QBLK) * os_ * 2;
#pragma unroll
    for (int r = 0; r < 16; ++r) { const int sor_ = so0_ + ((r & 3) + 8 * (r >> 2)) * os_ * 2;
#pragma unroll
        for (int d0 = 0; d0 < 4; ++d0) { const float v = o[d0][r] * rli[r];
            const float vn = __int_as_float(__builtin_amdgcn_update_dpp(0, __float_as_int(v), 0xB1, 0xF, 0xF, true));
            if ((r32 & 1) == 0) __builtin_amdgcn_raw_buffer_store_b32(cvtpk(v, vn), ro_, oo_ + d0 * 64, sor_, 0); } }
#endif
    }
    if constexpr (ROPE) A_RTLOAD(nxt);
#undef RESC
#undef KBASE
#undef ACT
#undef MASKT
#undef STEP
}

template <int DQK> struct SeamD { bf16x8 qr[Cfg<DQK>::NQF]; };
#define A_GLDS(voff, sbase, ldsdst) do { unsigned keep_; asm volatile("s_mov_b32 %0, m0\n\ts_mov_b32 m0, %2\n\ts_nop 0\n\tglobal_load_lds_dwordx4 %1, %3\n\ts_mov_b32 m0, %0" \
        : "=&s"(keep_) : "v"(voff), "s"((unsigned)__builtin_amdgcn_readfirstlane((int)(ldsdst))), "s"((const void*)(sbase)) : "memory"); } while (0)
#define A_DMA_IDX() int krow_[C::KCH], kcb_[C::KCH], vrow_[2], vcb_[2]; \
        _Pragma("unroll") for (int j_ = 0; j_ < C::KCH; ++j_) { const int p_ = (j_ * 8 + wid) * 1024 + lane * 16, row_ = p_ / C::KPITCH, pc_ = (p_ % C::KPITCH) / 16, lc_ = (pc_ & ~7) | ((pc_ & 7) ^ (row_ & 7)); \
            krow_[j_] = row_; kcb_[j_] = lc_ * 16; } \
        _Pragma("unroll") for (int j_ = 0; j_ < 2; ++j_) { const int p_ = (j_ * 8 + wid) * 1024 + lane * 16, s_ = p_ / 512, w_ = p_ % 512, kk_ = (s_ >> 2) * 8 + (w_ >> 6), col_ = (s_ & 3) * 32 + ((w_ & 63) >> 1); \
            vrow_[j_] = (kk_ & ~0xC) | ((kk_ & 4) << 1) | ((kk_ & 8) >> 1); vcb_[j_] = col_ * 2; }
#define A_DMA(B_, k0, sl_) do { const char* kb_ = wsb + (B_).ko + (size_t)(k0) * (size_t)(KS_(B_) * 2); const char* vb_ = wsb + (B_).vo + (size_t)(k0) * (size_t)(VS_(B_) * 2); \
        _Pragma("unroll") for (int j_ = 0; j_ < C::KCH; ++j_) A_GLDS((unsigned)(krow_[j_] * KS_(B_) * 2 + kcb_[j_]), kb_, lds0 + NS * SHM_V + (sl_) * C::SHM_K + (j_ * 8 + wid) * 1024); \
        _Pragma("unroll") for (int j_ = 0; j_ < 2; ++j_) A_GLDS((unsigned)(vrow_[j_] * VS_(B_) * 2 + vcb_[j_]), vb_, lds0 + (sl_) * SHM_V + (j_ * 8 + wid) * 1024); } while (0)
template <int DQK, bool DIL, int NS>
__device__ __forceinline__ void att_prime_dma(const Blk& cur, const char* wsb, char* lds, SeamD<DQK>& S, int tid_in) {
    typedef Cfg<DQK> C;
    int tid = tid_in; asm volatile("" : "+v"(tid));
    const int wid = __builtin_amdgcn_readfirstlane(tid >> 6), lane = tid & 63, r32 = lane & 31, hi = lane >> 5;
    const unsigned lds0 = (unsigned)(uintptr_t)lds;
    A_DMA_IDX();
    const int kb0 = swa_jlo(cur.P0, W_(cur)) * KVBLK;
    A_QLOAD(cur);
#pragma unroll
    for (int i_ = 0; i_ < NS - 1; ++i_) A_DMA(cur, kb0 + i_ * KVBLK, i_);
}
template <int DQK, bool DIL, bool SK, int NS>
__device__ __forceinline__ void att_block_dma(const Blk& cur, const Blk& nxt, const char* wsb, char* lds, char* wsl, SeamD<DQK>& S, int tid_in) {
    typedef Cfg<DQK> C;
    int tid = tid_in; asm volatile("" : "+v"(tid));
    const int wid = __builtin_amdgcn_readfirstlane(tid >> 6), lane = tid & 63, r32 = lane & 31, hi = lane >> 5;
    const int W = W_(cur); const float scale = SCALE_, beta = cur.beta;
    const int j_lo = swa_jlo(cur.P0, W);
    int j_hi = (cur.P0 + QB - 1) / KVBLK + 1; if (j_hi > SKV_(cur) / KVBLK) j_hi = SKV_(cur) / KVBLK;
    const int NT = j_hi - j_lo;
    const int kbn = swa_jlo(nxt.P0, W_(nxt)) * KVBLK;
    const int qlo = cur.P0 + wid * QBLK, qm = qlo + r32 - 4 * hi;
    const unsigned lds0 = (unsigned)(uintptr_t)lds;
    const char* K_lds = lds + NS * SHM_V;
    float* ws = (float*)wsl + wid * 64; float* li_l = ws, * al_l = ws + 32;
    float m_reg = -1e30f, l_reg = 0; f32x16 o[4] = {};
    A_DMA_IDX();
    const int vb0 = (int)lds0 + v_rd_base(lane);
    constexpr int NDMA = C::KCH + 2;
#define RESC(a) do { if (__any((a) < 1.f)) { if (hi == 0) al_l[r32] = (a); asm volatile("s_waitcnt lgkmcnt(0)" ::: "memory");              \
                     _Pragma("unroll") for (int d_ = 0; d_ < 4; ++d_) _Pragma("unroll") for (int r = 0; r < 16; ++r) o[d_][r] *= al_l[crow(r, hi)]; } } while (0)
#define KBASE(t) ((j_lo + (t)) * KVBLK)
#define ACT(t) (KBASE(t) <= qlo + QBLK - 1 && KBASE(t) + KVBLK - 1 >= qlo - W + 1)
#define MASKT(P0_, P1_, t) do { const int kb_ = KBASE(t); if ((!SK || ACT(t)) && (kb_ + KVBLK - 1 > qlo || kb_ <= qlo + QBLK - 1 - W)) mask_tile(P0_, P1_, qm - kb_, (unsigned)W); } while (0)
    VMW();
#pragma unroll
    for (int d0 = 0; d0 < C::NQF; ++d0) asm volatile("" : "+v"(S.qr[d0]));
    asm volatile("s_waitcnt lgkmcnt(0)" ::: "memory"); __builtin_amdgcn_s_barrier(); asm volatile("" ::: "memory");
    int sl = 0, sl2 = NS - 1;
#pragma unroll 1
    for (int t = 0; t < NT; ++t) {
        const bool pre = t + NS - 1 < NT;
        if (pre) A_DMA(cur, KBASE(t + NS - 1), sl2);
        SBAR(); f32x16 p0, p1; float mn_, al_; bf16x8 pa0, pa1, pa2, pa3;
        qkt<0, SK, DQK, DIL>(p0, p1, K_lds + sl * C::SHM_K, r32, hi, S.qr, ACT(t), beta, qm - KBASE(t)); SBAR();
        MASKT(p0, p1, t); partialSM(p0, p1, m_reg, mn_, al_, scale); finishSM(p0, p1, al_, l_reg, pa0, pa1, pa2, pa3); RESC(al_); SBAR();
        pv_tile<0, SK>(o, vb0 + sl * SHM_V, pa0, pa1, pa2, pa3, ACT(t));
        if (t + 1 < NT) { int infl = NT - 2 - t; if (infl > NS - 2) infl = NS - 2;
                          if (infl <= 0) VMW(); else if (infl == 1) VMWN(NDMA); else VMWN(2 * NDMA);
                          asm volatile("s_waitcnt lgkmcnt(0)" ::: "memory"); __builtin_amdgcn_s_barrier(); asm volatile("" ::: "memory"); }
        sl = sl == NS - 1 ? 0 : sl + 1; sl2 = sl2 == NS - 1 ? 0 : sl2 + 1;
    }
    asm volatile("s_waitcnt lgkmcnt(0)" ::: "memory"); __builtin_amdgcn_s_barrier(); asm volatile("" ::: "memory");
    A_QLOAD(nxt);
#pragma unroll
    for (int i_ = 0; i_ < NS - 1; ++i_) A_DMA(nxt, kbn + i_ * KVBLK, i_);
    if (hi == 0) li_l[r32] = l_reg; asm volatile("s_waitcnt lgkmcnt(0)" ::: "memory");
    if constexpr (DIL) { if (hi == 0) __builtin_amdgcn_raw_buffer_store_b32(__float_as_uint(m_reg * scale + __logf(l_reg)), A_RSRC(wsb + cur.lo), r32 * LS_(cur) * 4, (cur.P0 + wid * QBLK) * LS_(cur) * 4, 0); }
    float rli[16];
#pragma unroll
    for (int r = 0; r < 16; ++r) rli[r] = __builtin_amdgcn_rcpf(li_l[crow(r, hi)]);
    const __amdgpu_buffer_rsrc_t ro_ = A_RSRC(wsb + cur.oo); const int oo_ = (4 * hi * OS_(cur) + r32) * 2, so0_ = (cur.P0 + wid * QBLK) * OS_(cur) * 2;
#pragma unroll
    for (int r = 0; r < 16; ++r) { const int sor_ = so0_ + ((r & 3) + 8 * (r >> 2)) * OS_(cur) * 2;
#pragma unroll
        for (int d0 = 0; d0 < 4; ++d0) { const float v = o[d0][r] * rli[r];
            const float vn = __int_as_float(__builtin_amdgcn_update_dpp(0, __float_as_int(v), 0xB1, 0xF, 0xF, true));
            if ((r32 & 1) == 0) __builtin_amdgcn_raw_buffer_store_b32(cvtpk(v, vn), ro_, oo_ + d0 * 64, sor_, 0); } }
#undef RESC
#undef KBASE
#undef ACT
#undef MASKT
}

template <bool SK, int DQK, bool DIL>
__device__ __forceinline__ void qkt_fin(f32x16& p0, f32x16& p1, const char* K_lds, int r32, int hi, const bf16x8* qr, bool act, float beta, int dq,
                                        f32x16& y0, f32x16& y1, float alpha, float& l_reg, bf16x8& pa0, bf16x8& pa1, bf16x8& pa2, bf16x8& pa3) {
    typedef Cfg<DQK> C;
    const bool run = !(SK && !act);
    if (!run) { const float NEG = -__builtin_inff();
#pragma unroll
        for (int r = 0; r < 16; ++r) { p0[r] = NEG; p1[r] = NEG; } }
    else if constexpr (DIL) { const float b0 = -beta * (float)dq;
#pragma unroll
        for (int r = 0; r < 16; ++r) { const int c = (r & 3) + 8 * (r >> 2); p0[r] = fmaf(beta, (float)c, b0); p1[r] = fmaf(beta, (float)(c + 32), b0); } }
    else { p0 = f32x16{}; p1 = f32x16{}; }
    const char* kb[4];
#pragma unroll
    for (int dd = 0; dd < 4; ++dd) { const int colB = (dd * 16 + hi * 8) * 2; kb[dd] = K_lds + r32 * C::KPITCH + (colB ^ ((r32 & 7) << 4)); }
#define QK_CHUNK(c_) do { if (run) { _Pragma("unroll") for (int d0 = 4 * (c_); d0 < 4 * (c_) + 4 && d0 < C::NQF; ++d0) { const char* a = kb[d0 & 3] + (d0 >> 2) * 128; \
            bf16x8 b0 = *reinterpret_cast<const bf16x8*>(a); bf16x8 b1 = *reinterpret_cast<const bf16x8*>(a + 32 * C::KPITCH);                                  \
            p0 = __builtin_amdgcn_mfma_f32_32x32x16_bf16(b0, qr[d0], p0, 0, 0, 0); p1 = __builtin_amdgcn_mfma_f32_32x32x16_bf16(b1, qr[d0], p1, 0, 0, 0); } } } while (0)
#define PK4(P, B_, OUT) do { unsigned a0 = cvtpk(P[B_+0], P[B_+1]), a1 = cvtpk(P[B_+2], P[B_+3]);                          \
        unsigned b0 = cvtpk(P[B_+4], P[B_+5]), b1 = cvtpk(P[B_+6], P[B_+7]);                                             \
        auto r0 = __builtin_amdgcn_permlane32_swap(a0, b0, false, false); auto r1 = __builtin_amdgcn_permlane32_swap(a1, b1, false, false); \
        u32x4 w = {r0[0], r1[0], r0[1], r1[1]}; OUT = *reinterpret_cast<bf16x8*>(&w); } while (0)
    QK_CHUNK(0);
#pragma unroll
    for (int r = 0; r < 16; ++r) y1[r] = __builtin_amdgcn_exp2f(y1[r]);
    float ps = 0;
#pragma unroll
    for (int r = 0; r < 16; ++r) ps += y0[r];
#pragma unroll
    for (int r = 0; r < 16; ++r) ps += y1[r];
    SBAR();
    QK_CHUNK(1);
    { auto rr = __builtin_amdgcn_permlane32_swap(__float_as_uint(ps), __float_as_uint(ps), false, false);
      ps = __uint_as_float(rr[0]) + __uint_as_float(rr[1]); }
    l_reg = l_reg * alpha + ps;
    PK4(y0, 0, pa0); PK4(y0, 8, pa1);
    if constexpr (C::NQF > 8) { SBAR(); QK_CHUNK(2); }
    PK4(y1, 0, pa2); PK4(y1, 8, pa3);
#undef PK4
#undef QK_CHUNK
}
#ifndef ATT_SKEW_SEL
#define ATT_SKEW_SEL 0
#endif
#if ATT_SKEW_SEL == 0
#define ATT_SKEW_A (wid < 4)
#elif ATT_SKEW_SEL == 1
#define ATT_SKEW_A ((wid & 1) == 0)
#elif ATT_SKEW_SEL == 2
#define ATT_SKEW_A true
#else
#define ATT_SKEW_A false
#endif
#define A_DMA_K(B_, k0, sl_) do { const char* kb_ = wsb + (B_).ko + (size_t)(k0) * (size_t)(KS_(B_) * 2); int ln_ = lane; asm volatile("" : "+v"(ln_)); \
        _Pragma("unroll") for (int j_ = 0; j_ < C::KCH; ++j_) { const int p_ = (j_ * 8 + wid) * 1024 + ln_ * 16, row_ = p_ / C::KPITCH, pc_ = (p_ % C::KPITCH) / 16, lc_ = (pc_ & ~7) | ((pc_ & 7) ^ (row_ & 7)); \
            A_GLDS((unsigned)(row_ * KS_(B_) * 2 + lc_ * 16), kb_, lds0 + 3 * SHM_V + (sl_) * C::SHM_K + (j_ * 8 + wid) * 1024); } } while (0)
#define A_DMA_V(B_, k0, sl_) do { const char* vb_ = wsb + (B_).vo + (size_t)(k0) * (size_t)(VS_(B_) * 2); int ln_ = lane; asm volatile("" : "+v"(ln_)); \
        _Pragma("unroll") for (int j_ = 0; j_ < 2; ++j_) { const int p_ = (j_ * 8 + wid) * 1024 + ln_ * 16, s_ = p_ / 512, w_ = p_ % 512, kk_ = (s_ >> 2) * 8 + (w_ >> 6), col_ = (s_ & 3) * 32 + ((w_ & 63) >> 1); \
            const int vr_ = (kk_ & ~0xC) | ((kk_ & 4) << 1) | ((kk_ & 8) >> 1); \
            A_GLDS((unsigned)(vr_ * VS_(B_) * 2 + col_ * 2), vb_, lds0 + (sl_) * SHM_V + (j_ * 8 + wid) * 1024); } } while (0)
#define A_RAWBAR() do { asm volatile("s_waitcnt lgkmcnt(0)" ::: "memory"); __builtin_amdgcn_s_barrier(); asm volatile("" ::: "memory"); } while (0)
template <int DQK, bool DIL>
__device__ __forceinline__ void att_prime_dma2(const Blk& cur, const char* wsb, char* lds, SeamD<DQK>& S, int tid_in) {
    typedef Cfg<DQK> C; constexpr int NS = 3;
    int tid = tid_in; asm volatile("" : "+v"(tid));
    const int wid = __builtin_amdgcn_readfirstlane(tid >> 6), lane = tid & 63, r32 = lane & 31, hi = lane >> 5;
    const unsigned lds0 = (unsigned)(uintptr_t)lds;
    const int kb0 = swa_jlo(cur.P0, W_(cur)) * KVBLK;
    A_QLOAD(cur);
    A_DMA_K(cur, kb0, 0); A_DMA_V(cur, kb0, 0); A_DMA_K(cur, kb0 + KVBLK, 1);
}
template <int DQK, bool DIL, bool SK, int ORD>
__device__ __forceinline__ void att_block_dma2(const Blk& cur, const Blk& nxt, const char* wsb, char* lds, SeamD<DQK>& S, int tid_in) {
    typedef Cfg<DQK> C; constexpr int NS = 3;
    int tid = tid_in; asm volatile("" : "+v"(tid));
    const int wid = __builtin_amdgcn_readfirstlane(tid >> 6), lane = tid & 63, r32 = lane & 31, hi = lane >> 5;
    const int W = W_(cur); const float scale = SCALE_, beta = cur.beta;
    const int j_lo = swa_jlo(cur.P0, W);
    int j_hi = (cur.P0 + QB - 1) / KVBLK + 1; if (j_hi > SKV_(cur) / KVBLK) j_hi = SKV_(cur) / KVBLK;
    const int NT = j_hi - j_lo;
    const int kbn = swa_jlo(nxt.P0, W_(nxt)) * KVBLK;
    const int qlo = cur.P0 + wid * QBLK, qm = qlo + r32 - 4 * hi;
    const unsigned lds0 = (unsigned)(uintptr_t)lds;
    const char* K_lds = lds + 3 * SHM_V;
    float* ws = (float*)(lds + 3 * SHM_V + 3 * C::SHM_K) + wid * 64; float* li_l = ws, * al_l = ws + 32;
    float m_reg = -1e30f, l_reg = 0; f32x16 o[4] = {};
    const int vb0 = (int)lds0 + v_rd_base(lane);
#define RESC(a) do { if (__any((a) < 1.f)) { if (hi == 0) al_l[r32] = (a); asm volatile("s_waitcnt lgkmcnt(0)" ::: "memory");              \
                     _Pragma("unroll") for (int d_ = 0; d_ < 4; ++d_) _Pragma("unroll") for (int r = 0; r < 16; ++r) o[d_][r] *= al_l[crow(r, hi)]; } } while (0)
#define KBASE(t) ((j_lo + (t)) * KVBLK)
#define ACT(t) (KBASE(t) <= qlo + QBLK - 1 && KBASE(t) + KVBLK - 1 >= qlo - W + 1)
#define MASKT(P0_, P1_, t) do { const int kb_ = KBASE(t); if ((!SK || ACT(t)) && (kb_ + KVBLK - 1 > qlo || kb_ <= qlo + QBLK - 1 - W)) mask_tile(P0_, P1_, qm - kb_, (unsigned)W); } while (0)
#define ISSUE(t, n_) do { n_ = 0; if ((t) + 2 < NT) { int slotk_ = sl + 2; if (slotk_ >= 3) slotk_ -= 3; A_DMA_K(cur, KBASE((t) + 2), slotk_); n_ += C::KCH; } \
                          if ((t) + 1 < NT) { int slotv_ = sl + 1; if (slotv_ >= 3) slotv_ -= 3; A_DMA_V(cur, KBASE((t) + 1), slotv_); n_ += 2; } } while (0)
#define CLOSE(n_) do { if ((n_) == C::KCH + 2) VMWN(C::KCH + 2); else if ((n_) == 2) VMWN(2); else VMW(); A_RAWBAR(); } while (0)
    VMW();
#pragma unroll
    for (int d0 = 0; d0 < C::NQF; ++d0) asm volatile("" : "+v"(S.qr[d0]));
    A_RAWBAR();
    int sl = 0, slp = 2, nis;
    f32x16 pA0, pA1, pB0, pB1; float mnA, mnB, alA, alB; bf16x8 pa0, pa1, pa2, pa3;
    ISSUE(0, nis); SBAR();
    qkt<0, SK, DQK, DIL>(pA0, pA1, K_lds + sl * C::SHM_K, r32, hi, S.qr, ACT(0), beta, qm - KBASE(0)); SBAR();
    MASKT(pA0, pA1, 0); partialSM(pA0, pA1, m_reg, mnA, alA, scale);
    CLOSE(nis); slp = sl; sl = sl == 2 ? 0 : sl + 1;
#define STEPP(PX0, PX1, mnX, alX, PY0, PY1, alY, t) do { ISSUE(t, nis); SBAR();                                               \
        if constexpr (ORD == 0) {                                                                                               \
            qkt<0, SK, DQK, DIL>(PX0, PX1, K_lds + sl * C::SHM_K, r32, hi, S.qr, ACT(t), beta, qm - KBASE(t)); SBAR();           \
            finishSM(PY0, PY1, alY, l_reg, pa0, pa1, pa2, pa3); SBAR();                                                         \
            pv_tile<0, SK>(o, vb0 + slp * SHM_V, pa0, pa1, pa2, pa3, ACT((t) - 1)); SBAR();                                     \
        } else {                                                                                                                \
            finishSM(PY0, PY1, alY, l_reg, pa0, pa1, pa2, pa3); SBAR();                                                         \
            pv_tile<0, SK>(o, vb0 + slp * SHM_V, pa0, pa1, pa2, pa3, ACT((t) - 1)); SBAR();                                     \
            qkt<0, SK, DQK, DIL>(PX0, PX1, K_lds + sl * C::SHM_K, r32, hi, S.qr, ACT(t), beta, qm - KBASE(t)); SBAR();           \
        }                                                                                                                       \
        MASKT(PX0, PX1, (t)); partialSM(PX0, PX1, m_reg, mnX, alX, scale);                                                     \
        RESC(alX); CLOSE(nis); slp = sl; sl = sl == 2 ? 0 : sl + 1; } while (0)
    int t = 1;
#pragma unroll 1
    for (; t + 2 < NT; t += 2) {
        STEPP(pB0, pB1, mnB, alB, pA0, pA1, alA, t);
        STEPP(pA0, pA1, mnA, alA, pB0, pB1, alB, t + 1);
    }
    STEPP(pB0, pB1, mnB, alB, pA0, pA1, alA, t);
    finishSM(pB0, pB1, alB, l_reg, pa0, pa1, pa2, pa3); SBAR();
    pv_tile<0, SK>(o, vb0 + slp * SHM_V, pa0, pa1, pa2, pa3, ACT(NT - 1));
    A_RAWBAR();
    A_QLOAD(nxt);
    A_DMA_K(nxt, kbn, 0); A_DMA_V(nxt, kbn, 0); A_DMA_K(nxt, kbn + KVBLK, 1);
    if (hi == 0) li_l[r32] = l_reg; asm volatile("s_waitcnt lgkmcnt(0)" ::: "memory");
    if constexpr (DIL) { if (hi == 0) __builtin_amdgcn_raw_buffer_store_b32(__float_as_uint(m_reg * scale + __logf(l_reg)), A_RSRC(wsb + cur.lo), r32 * LS_(cur) * 4, (cur.P0 + wid * QBLK) * LS_(cur) * 4, 0); }
    float rli[16];
#pragma unroll
    for (int r = 0; r < 16; ++r) rli[r] = __builtin_amdgcn_rcpf(li_l[crow(r, hi)]);
    const __amdgpu_buffer_rsrc_t ro_ = A_RSRC(wsb + cur.oo); const int oo_ = (4 * hi * OS_(cur) + r32) * 2, so0_ = (cur.P0 + wid * QBLK) * OS_(cur) * 2;
#pragma unroll
    for (int r = 0; r < 16; ++r) { const int sor_ = so0_ + ((r & 3) + 8 * (r >> 2)) * OS_(cur) * 2;
#pragma unroll
        for (int d0 = 0; d0 < 4; ++d0) { const float v = o[d0][r] * rli[r];
            const float vn = __int_as_float(__builtin_amdgcn_update_dpp(0, __float_as_int(v), 0xB1, 0xF, 0xF, true));
            if ((r32 & 1) == 0) __builtin_amdgcn_raw_buffer_store_b32(cvtpk(v, vn), ro_, oo_ + d0 * 64, sor_, 0); } }
#undef RESC
#undef KBASE
#undef ACT
#undef MASKT
#undef ISSUE
#undef CLOSE
#undef STEPP
}
#undef A_DMA_K
#undef A_DMA_V
#undef A_RAWBAR
#undef A_GLDS
#undef A_DMA_IDX
#undef A_DMA
#undef VMW
#undef VMWN
#undef A_SLOAD
#undef A_RSRC
#undef A_BLD
#undef A_QLOAD
#undef A_SWRITE_K
#undef A_SWRITE_V
#undef A_STAGE_IDX
#undef SBAR
#undef QS_
#undef KS_
#undef VS_
#undef OS_
#undef LS_
#undef SKV_
#undef W_
#undef SCALE_
}
constexpr int NWAVES = 8;
constexpr int T = 32768, DM = 2048, SEQ = 8192, NB = 4, DEPTH = 2;
constexpr int IN_COLS = 3904, PROJ_LD = 4096, NEXP = 16, DEXP = 1024;
constexpr int C_QB = 0, C_KB = 1024, C_VB = 2048, C_CQ = 3072, C_CKV = 3584, C_KR = 3840;
constexpr float EPS = 1e-6f;
constexpr size_t MiB = 1u << 20;
constexpr size_t WS_CTL = 0, CTL_ZERO_BYTES = 1 * MiB;
constexpr size_t WS_MOD = 1 * MiB;
constexpr size_t WS_ROPE = 2 * MiB;
constexpr size_t WS_RSTDQ = 4 * MiB, WS_RSTDKV = 4 * MiB + 256 * 1024, WS_AW = 4 * MiB + 512 * 1024;
constexpr size_t WS_ROWIDX = 5 * MiB;
constexpr size_t WS_LSE = 8 * MiB;
constexpr size_t WS_WIN = 16 * MiB;
constexpr size_t WS_WUQ = 48 * MiB;
constexpr size_t WS_WUKV = 51 * MiB;
constexpr size_t WS_WOUT = 53 * MiB;
constexpr size_t WS_W13 = 72 * MiB;
constexpr size_t WS_W2 = 200 * MiB;
constexpr size_t WS_H = 264 * MiB;
constexpr size_t WS_PROJ = 392 * MiB;
constexpr size_t WS_QA = 648 * MiB;
constexpr size_t WS_KF = 744 * MiB;
constexpr size_t WS_VB = 840 * MiB;
constexpr size_t WS_OA = 904 * MiB;
constexpr size_t WS_OB = 968 * MiB;
constexpr size_t WS_XB = 1160 * MiB;
constexpr size_t WS_END = 1288 * MiB;
constexpr size_t WS_HMID = WS_PROJ;
constexpr size_t WS_Y = WS_QA;
constexpr int CW_TMO = 0;
constexpr int CW_CNT = 64;
constexpr int CW_BAR = 4096;
constexpr int RING_BYTES = 131072;
constexpr int L_MISC = RING_BYTES, L_TS = RING_BYTES + 256, L_CNT = RING_BYTES + 384, L_TOK = RING_BYTES + 512, L_ATAB = RING_BYTES + 2560;
constexpr int MAXU = 10;
constexpr int LDS_BYTES = 147456;
static_assert(L_ATAB + MAXU * 1024 <= LDS_BYTES, "LDS map");

#define GAS __attribute__((address_space(1)))
#define LAS __attribute__((address_space(3)))
typedef unsigned short bf16;
typedef unsigned v4u __attribute__((ext_vector_type(4)));
typedef unsigned v2u __attribute__((ext_vector_type(2)));
typedef float f32x4 __attribute__((ext_vector_type(4)));
typedef float f32x2 __attribute__((ext_vector_type(2)));
#define LDS_WAIT() asm volatile("s_waitcnt lgkmcnt(0)" ::: "memory")
#define VM_WAIT() asm volatile("s_waitcnt vmcnt(0)" ::: "memory")
__device__ __forceinline__ unsigned pk2(float lo, float hi) { return pg8::cvt_pk_bf16(lo, hi); }
__device__ __forceinline__ float bf_lo(unsigned w) { return __uint_as_float(w << 16); }
__device__ __forceinline__ float bf_hi(unsigned w) { return __uint_as_float(w & 0xffff0000u); }


typedef __amdgpu_buffer_rsrc_t rsrc_t;
#define RSRC(p) __builtin_amdgcn_make_buffer_rsrc((void*)(p), 0, 0x7fffffff, 0x00020000)
__device__ __forceinline__ f32x4 bld4f(rsrc_t r, int vo, int so) { return __builtin_bit_cast(f32x4, __builtin_amdgcn_raw_buffer_load_b128(r, vo, so, 0)); }
__device__ __forceinline__ v4u bld4u(rsrc_t r, int vo, int so) { return __builtin_bit_cast(v4u, __builtin_amdgcn_raw_buffer_load_b128(r, vo, so, 0)); }
__device__ __forceinline__ v2u bld2u(rsrc_t r, int vo, int so) { return __builtin_bit_cast(v2u, __builtin_amdgcn_raw_buffer_load_b64(r, vo, so, 0)); }
__device__ __forceinline__ void bst2u(rsrc_t r, int vo, int so, v2u v) { __builtin_amdgcn_raw_buffer_store_b64(v, r, vo, so, 0); }
__device__ __forceinline__ void bst4u(rsrc_t r, int vo, int so, v4u v) { __builtin_amdgcn_raw_buffer_store_b128(v, r, vo, so, 0); }
__device__ __forceinline__ void bst4f(rsrc_t r, int vo, int so, f32x4 v) { __builtin_amdgcn_raw_buffer_store_b128(__builtin_bit_cast(v4u, v), r, vo, so, 0); }

#define XB_TMO      128
#define XB_XCNT(j)  (256  + 64 * (j))
#define XB_XSUB(j)  (1280 + 64 * (j))
#define XB_XGEN(j)  (2304 + 64 * (j))
#define XB_TOP      3328
#define XB_TOPGEN   3392
#define XCD_BAR_WORDS 3456
#define XB_SPIN_CAP (1u << 18)
__device__ __forceinline__ unsigned xb_ld(unsigned* p)              { return __hip_atomic_load(p, __ATOMIC_RELAXED, __HIP_MEMORY_SCOPE_AGENT); }
__device__ __forceinline__ unsigned xb_add(unsigned* p, unsigned v) { return __hip_atomic_fetch_add(p, v, __ATOMIC_RELAXED, __HIP_MEMORY_SCOPE_AGENT); }
__device__ __forceinline__ unsigned xb_xcc_id() { return (unsigned)__builtin_amdgcn_s_getreg((3 << 11) | 20) & 0xFu; }
#define XB_SPIN(cond, bar) do { unsigned _sp = 0; while (cond) { __builtin_amdgcn_s_sleep(1); \
    if ((++_sp & 255u) == 0u) { if (xb_ld(&(bar)[XB_TMO])) break; if (_sp > XB_SPIN_CAP) { atomicAdd(&(bar)[XB_TMO], 1u); break; } } } } while (0)
struct XcdBarrier { unsigned* bar; unsigned x; volatile LAS unsigned* st; };
__device__ __forceinline__ XcdBarrier xcd_barrier_post(unsigned* bar, volatile LAS unsigned* st, int tid) {
    XcdBarrier b; b.bar = bar; b.x = xb_xcc_id(); b.st = st;
    if (tid == 0) (void)xb_add(&bar[XB_XCNT(b.x)], 1u);
    return b;
}
__device__ __forceinline__ void xcd_barrier_complete(unsigned* bar, unsigned x, unsigned& nloc, unsigned& nx) {
    const unsigned G = gridDim.x * gridDim.y * gridDim.z;
    unsigned sum, cnt, mine, sp = 0u;
    for (;;) {
        sum = 0u; cnt = 0u; mine = 0u;
#pragma unroll
        for (unsigned j = 0; j < 16; ++j) { const unsigned c = xb_ld(&bar[XB_XCNT(j)]); sum += c; cnt += (c > 0u) ? 1u : 0u; mine = (j == x) ? c : mine; }
        if (sum == G) break;
        __builtin_amdgcn_s_sleep(1);
        if ((++sp & 255u) == 0u) { if (xb_ld(&bar[XB_TMO])) break; if (sp > XB_SPIN_CAP) { atomicAdd(&bar[XB_TMO], 1u); break; } }
    }
    nloc = mine > 0u ? mine : 1u; nx = cnt > 0u ? cnt : 1u;
}
__device__ __forceinline__ void xcd_barrier(const XcdBarrier& b, int tid) {
    asm volatile("s_waitcnt vmcnt(0)" ::: "memory");
    __syncthreads();
    if (tid == 0) {
        unsigned* bar = b.bar; asm volatile("" : "+s"(bar));
        __builtin_amdgcn_s_waitcnt(0);
        unsigned nloc = b.st[0], nx = b.st[1];
        if (nloc == 0u) { xcd_barrier_complete(bar, b.x, nloc, nx); b.st[0] = nloc; b.st[1] = nx; }
        const unsigned old = xb_add(&bar[XB_XSUB(b.x)], 1u);
        const unsigned gen = old / nloc;
        if (old + 1u == (gen + 1u) * nloc) {
            __builtin_amdgcn_fence(__ATOMIC_RELEASE, "agent");
            asm volatile("s_waitcnt vmcnt(0)" ::: "memory");
            const unsigned og = xb_add(&bar[XB_TOP], 1u);
            const unsigned tg = og / nx;
            if (og + 1u == (tg + 1u) * nx) xb_add(&bar[XB_TOPGEN], 1u);
            else XB_SPIN(xb_ld(&bar[XB_TOPGEN]) == tg, bar);
            __builtin_amdgcn_fence(__ATOMIC_ACQUIRE, "agent");
            xb_add(&bar[XB_XGEN(b.x)], 1u);
            asm volatile("s_waitcnt vmcnt(0)" ::: "memory");
        } else {
            XB_SPIN(xb_ld(&bar[XB_XGEN(b.x)]) == gen, bar);
            __builtin_amdgcn_fence(__ATOMIC_ACQUIRE, "agent");
            asm volatile("s_waitcnt vmcnt(0)" ::: "memory");
        }
    }
    __syncthreads();
}

struct Args {
    const float* in[20]; float* out; unsigned char* ws;
    float invf[32];
    int ph_lo, ph_hi, li, pad;
};
enum { I_X = 0, I_C, I_ADAW, I_ADAB, I_N1G, I_N2G, I_WIN, I_QNG, I_KVNG, I_WUQ, I_WUKV, I_ONA, I_ONB, I_WOUT, I_RW, I_RB, I_EG, I_EU, I_ED, I_FG };

struct Frame {
    LAS unsigned char* lds; unsigned char* ldsg;
    unsigned* ctl; unsigned char* ws;
    int tid, lane, wave, vcu, G;
};
__device__ __forceinline__ int lane_id() { int l; asm volatile("v_mbcnt_lo_u32_b32 %0, -1, 0\n\tv_mbcnt_hi_u32_b32 %0, -1, %0" : "=v"(l)); return l; }
#define DPP_ADD(v, ctrl) v += __int_as_float(__builtin_amdgcn_update_dpp(0, __float_as_int(v), ctrl, 0xF, 0xF, true))
__device__ __forceinline__ float wave_sum(float v) {
    DPP_ADD(v, 0xB1); DPP_ADD(v, 0x4E); DPP_ADD(v, 0x141); DPP_ADD(v, 0x140);
    v += __int_as_float(__builtin_amdgcn_ds_swizzle(__float_as_int(v), 0x401F));
    auto rr = __builtin_amdgcn_permlane32_swap(__float_as_uint(v), __float_as_uint(v), false, false);
    return __uint_as_float(rr[0]) + __uint_as_float(rr[1]);
}
__device__ __forceinline__ int il64(int j) { return j < 32 ? 2 * j : 2 * (j - 32) + 1; }
template <int MODE> __device__ __forceinline__ int dest_row(int n) {
    if constexpr (MODE == 0) return n;
    else if constexpr (MODE == 1) {
        if (n < 512) return C_CQ + n; if (n < 768) return C_CKV + (n - 512); if (n < 832) return C_KR + il64(n - 768);
        if (n < 1856) return C_QB + (n - 832); if (n < 2880) return C_KB + (n - 1856); return C_VB + (n - 2880); }
    else if constexpr (MODE == 2) { const int h = n / 192, j = n % 192; return j < 128 ? n : h * 192 + 128 + il64(j - 128); }
    else if constexpr (MODE == 3) return (n >> 7) * 256 + (n & 127);
    else return (n >> 7) * 256 + 128 + (n & 127);
}
template <int MODE>
__device__ __forceinline__ void transpose_item(const float* W, int ldw, int K, int N, bf16* WT, const float* kscale, LAS float* scr, int item, int lane) {
    const int nblk = N / 32, kb = item / nblk, nb = item % nblk, k0 = 64 * kb, n0 = 32 * nb;
    float tv[32];
#pragma unroll
    for (int i = 0; i < 32; ++i) { const int kk = 2 * i + (lane >> 5); tv[i] = W[(size_t)(k0 + kk) * ldw + n0 + (lane & 31)]; }
#pragma unroll
    for (int i = 0; i < 32; ++i) { const int kk = 2 * i + (lane >> 5); float v = tv[i]; if (kscale) v *= kscale[k0 + kk]; scr[kk * 33 + (lane & 31)] = v; }
    LDS_WAIT(); asm volatile("" ::: "memory");
    const int c = lane & 7;
#pragma unroll
    for (int j = 0; j < 4; ++j) { const int n = (lane >> 3) + 8 * j; const LAS float* s = scr + (8 * c) * 33 + n;
        v4u o; o.x = pk2(s[0 * 33], s[1 * 33]); o.y = pk2(s[2 * 33], s[3 * 33]); o.z = pk2(s[4 * 33], s[5 * 33]); o.w = pk2(s[6 * 33], s[7 * 33]);
        *(v4u*)(WT + (size_t)dest_row<MODE>(n0 + n) * K + k0 + 8 * c) = o; }
    LDS_WAIT(); asm volatile("s_waitcnt vmcnt(0)" ::: "memory");
}

__device__ __forceinline__ unsigned pk4_fp8(float a, float b, float c, float d) { int w = 0; w = __builtin_amdgcn_cvt_pk_fp8_f32(a, b, w, false); w = __builtin_amdgcn_cvt_pk_fp8_f32(c, d, w, true); return (unsigned)w; }
template <int MODE>
__device__ __forceinline__ void transpose_item8(const float* W, int ldw, int K, int N, unsigned char* WT, LAS float* scr, int item, int lane) {
    const int nblk = N / 32, kb = item / nblk, nb = item % nblk, k0 = 64 * kb, n0 = 32 * nb;
    float tv[32];
#pragma unroll
    for (int i = 0; i < 32; ++i) { const int kk = 2 * i + (lane >> 5); tv[i] = W[(size_t)(k0 + kk) * ldw + n0 + (lane & 31)]; }
#pragma unroll
    for (int i = 0; i < 32; ++i) { const int kk = 2 * i + (lane >> 5); scr[kk * 33 + (lane & 31)] = tv[i] * 256.0f; }
    LDS_WAIT(); asm volatile("" ::: "memory");
    const int c = lane & 7;
#pragma unroll
    for (int j = 0; j < 4; ++j) { const int n = (lane >> 3) + 8 * j; const LAS float* s = scr + (8 * c) * 33 + n;
        v2u o; o.x = pk4_fp8(s[0 * 33], s[1 * 33], s[2 * 33], s[3 * 33]); o.y = pk4_fp8(s[4 * 33], s[5 * 33], s[6 * 33], s[7 * 33]);
        *(v2u*)(WT + (size_t)dest_row<MODE>(n0 + n) * K + k0 + 8 * c) = o; }
    LDS_WAIT(); asm volatile("s_waitcnt vmcnt(0)" ::: "memory");
}

__device__ __forceinline__ void phase_prologue(Frame& F, const Args& A) {
#ifdef ADA_FAST
    {
        const float* cc = A.in[I_C]; float* mod = (float*)(F.ws + WS_MOD);
        LAS float* red = (LAS float*)F.lds;
        LAS float* scl = (LAS float*)(F.lds + 32768);
        for (int q = F.tid; q < 4 * DM; q += NWAVES * 64) { const int b = q >> 11, k = q & (DM - 1); const float cv = cc[b * DM + k]; scl[k * 4 + b] = cv / (1.0f + __expf(-cv)); }
        __syncthreads();
        for (int id = F.vcu; id < 2 * 128; id += F.G) {
            const int l = id >> 7, ch = id & 127, cg = F.tid & 31, kg = F.tid >> 5, col = ch * 96 + cg * 4;
            const float* w = A.in[I_ADAW] + (size_t)l * DM * 12288 + col;
            f32x4 acc[4] = {};
            if (cg < 24) {
#pragma unroll 1
                for (int k0 = 0; k0 < 128; k0 += 16) { f32x4 wv[16];
#pragma unroll
                    for (int u = 0; u < 16; ++u) wv[u] = *(const f32x4*)(w + (size_t)(kg * 128 + k0 + u) * 12288);
#pragma unroll
                    for (int u = 0; u < 16; ++u) { const f32x4 ca = *(LAS f32x4*)(scl + (kg * 128 + k0 + u) * 4);
#pragma unroll
                        for (int b = 0; b < 4; ++b) acc[b] += wv[u] * ca[b]; } } }
#pragma unroll
            for (int b = 0; b < 4; ++b) *(LAS f32x4*)(red + ((kg * 32 + cg) * 16 + b * 4)) = acc[b];
            __syncthreads();
            if (F.tid < 128 && (F.tid & 31) < 24) { const int cg2 = F.tid & 31, b = F.tid >> 5; f32x4 s = {0.f, 0.f, 0.f, 0.f};
#pragma unroll
                for (int g = 0; g < 16; ++g) s += *(LAS f32x4*)(red + ((g * 32 + cg2) * 16 + b * 4));
                const int c2 = ch * 96 + cg2 * 4; const f32x4 bv = *(const f32x4*)(A.in[I_ADAB] + (size_t)l * 12288 + c2);
                *(f32x4*)(mod + ((size_t)l * 4 + b) * 12288 + c2) = s + bv; }
            asm volatile("s_waitcnt vmcnt(0)" ::: "memory");
            __syncthreads();
        }
    }
#else
    {
        const float* cc = A.in[I_C]; float* mod = (float*)(F.ws + WS_MOD);
        LAS float* red = (LAS float*)F.lds;
        for (int id = F.vcu; id < 2 * 96; id += F.G) {
            const int l = id / 96, ch = id % 96, cg = F.tid & 31, kg = F.tid >> 5, col = ch * 128 + cg * 4;
            const float* w = A.in[I_ADAW] + (size_t)l * DM * 12288 + col;
            f32x4 acc[4] = {};
#pragma unroll 4
            for (int kk = 0; kk < 128; ++kk) { const int k = kg * 128 + kk; const f32x4 wv = *(const f32x4*)(w + (size_t)k * 12288);
#pragma unroll
                for (int b = 0; b < 4; ++b) { const float cv = cc[b * DM + k]; const float ca = cv / (1.0f + __expf(-cv)); acc[b] += wv * ca; } }
#pragma unroll
            for (int b = 0; b < 4; ++b) *(LAS f32x4*)(red + ((kg * 32 + cg) * 16 + b * 4)) = acc[b];
            __syncthreads();
            if (F.tid < 128) { const int cg2 = F.tid & 31, b = F.tid >> 5; f32x4 s = {0.f, 0.f, 0.f, 0.f};
#pragma unroll
                for (int g = 0; g < 16; ++g) s += *(LAS f32x4*)(red + ((g * 32 + cg2) * 16 + b * 4));
                const int c2 = ch * 128 + cg2 * 4; const f32x4 bv = *(const f32x4*)(A.in[I_ADAB] + (size_t)l * 12288 + c2);
                *(f32x4*)(mod + ((size_t)l * 4 + b) * 12288 + c2) = s + bv; }
            asm volatile("s_waitcnt vmcnt(0)" ::: "memory");
            __syncthreads();
        }
    }
#endif
    {
        LAS float* scr = (LAS float*)(F.lds + F.wave * 16384);
        const int gw = F.vcu * NWAVES + F.wave, NGW = F.G * NWAVES;
        constexpr int I_IN = (DM / 64) * (IN_COLS / 32), I_UQ = (512 / 64) * (1536 / 32), I_UKV = (256 / 64) * (2048 / 32), I_OUT = (DM / 64) * (DM / 32), I_L = I_IN + I_UQ + I_UKV + I_OUT;
        for (int it = gw; it < 2 * I_L; it += NGW) {
            const int l = it / I_L; int r = it % I_L;
            if (r < I_IN) { transpose_item<1>(A.in[I_WIN] + (size_t)l * DM * IN_COLS, IN_COLS, DM, IN_COLS, (bf16*)(F.ws + WS_WIN) + (size_t)l * 4096 * DM, nullptr, scr, r, F.lane); continue; } r -= I_IN;
            if (r < I_UQ) { transpose_item<2>(A.in[I_WUQ] + (size_t)l * 512 * 1536, 1536, 512, 1536, (bf16*)(F.ws + WS_WUQ) + (size_t)l * 1536 * 512, A.in[I_QNG] + l * 512, scr, r, F.lane); continue; } r -= I_UQ;
            if (r < I_UKV) { transpose_item<0>(A.in[I_WUKV] + (size_t)l * 256 * 2048, 2048, 256, 2048, (bf16*)(F.ws + WS_WUKV) + (size_t)l * 2048 * 256, A.in[I_KVNG] + l * 256, scr, r, F.lane); continue; } r -= I_UKV;
#ifdef G3_FP8
            transpose_item8<0>(A.in[I_WOUT] + (size_t)l * DM * DM, DM, DM, DM, F.ws + WS_WOUT + (size_t)l * DM * DM, scr, r, F.lane);
#else
            transpose_item<0>(A.in[I_WOUT] + (size_t)l * DM * DM, DM, DM, DM, (bf16*)(F.ws + WS_WOUT) + (size_t)l * DM * DM, nullptr, scr, r, F.lane);
#endif
        }
    }
    {
        const int gt = F.vcu * (NWAVES * 64) + F.tid, NGT = F.G * NWAVES * 64;
        float* rope = (float*)(F.ws + WS_ROPE);
        for (int e = gt; e < SEQ * 32; e += NGT) { const int pos = e >> 5, i = e & 31;
            const float ang = (float)pos * A.invf[i];
            const double rev = (double)ang * 0.15915494309189535; const float fr = (float)(rev - __builtin_floor(rev));
            *(f32x2*)(rope + (size_t)e * 2) = (f32x2){__builtin_amdgcn_cosf(fr), __builtin_amdgcn_sinf(fr)}; }
        for (int e = gt; e < 2 * 192 * (DM / 8); e += NGT) { const int l = e / (192 * (DM / 8)), r = e % (192 * (DM / 8));
            *(v4u*)((bf16*)(F.ws + WS_WIN) + ((size_t)l * 4096 + IN_COLS) * DM + (size_t)r * 8) = (v4u){0u, 0u, 0u, 0u}; }
    }
}

#ifdef Y_FP8
typedef unsigned YRAW;
#define YLD(Yp, r, c) (*(const unsigned*)((const unsigned char*)(Yp) + (size_t)(r) * DM + (c)))
__device__ __forceinline__ f32x4 ysum8(unsigned a, unsigned b) {
    const f32x2 a0 = __builtin_amdgcn_cvt_pk_f32_fp8((int)a, false), a1 = __builtin_amdgcn_cvt_pk_f32_fp8((int)a, true), b0 = __builtin_amdgcn_cvt_pk_f32_fp8((int)b, false), b1 = __builtin_amdgcn_cvt_pk_f32_fp8((int)b, true);
    return (f32x4){a0[0] + b0[0], a0[1] + b0[1], a1[0] + b1[0], a1[1] + b1[1]} * (1.0f / 16.0f); }
#define YSUM(a, b) ysum8(a, b)
#else
typedef v2u YRAW;
#define YLD(Yp, r, c) (*(const v2u*)((Yp) + (size_t)(r) * DM + (c)))
#define YSUM(y0, y1) ((f32x4){bf_lo((y0).x) + bf_lo((y1).x), bf_hi((y0).x) + bf_hi((y1).x), bf_lo((y0).y) + bf_lo((y1).y), bf_hi((y0).y) + bf_hi((y1).y)})
#endif
__device__ __forceinline__ void phase_norm1(Frame& F, const Args& A, int l) {
    const int gw = F.vcu * NWAVES + F.wave, NGW = F.G * NWAVES;
    const float* mod = (const float*)(F.ws + WS_MOD);
    bf16* H = (bf16*)(F.ws + WS_H); const bf16* Y = (const bf16*)(F.ws + WS_Y);
#ifdef THIN_MLP
    for (int ch = gw; ch < T / 16; ch += NGW) {
        const int row0 = ch * 16, b = row0 >> 13;
        const float* ml = mod + ((size_t)l * 4 + b) * 12288;
        if (l == 0) {
#pragma unroll 1
            for (int rr = 0; rr < 16; rr += 4) {
                f32x4 v[4][8];
#pragma unroll
                for (int q = 0; q < 4; ++q)
#pragma unroll
                    for (int j = 0; j < 8; ++j) v[q][j] = *(const f32x4*)(A.in[I_X] + (size_t)(row0 + rr + q) * DM + 4 * F.lane + 256 * j);
                float rstd[4];
#pragma unroll
                for (int q = 0; q < 4; ++q) { float s = 0.f;
#pragma unroll
                    for (int j = 0; j < 8; ++j) s += (v[q][j].x * v[q][j].x + v[q][j].y * v[q][j].y) + (v[q][j].z * v[q][j].z + v[q][j].w * v[q][j].w);
                    rstd[q] = __builtin_amdgcn_rsqf(wave_sum(s) * (1.f / DM) + EPS); }
#pragma unroll
                for (int j = 0; j < 8; ++j) { const int c = 4 * F.lane + 256 * j;
                    const f32x4 gsc = *(const f32x4*)(A.in[I_N1G] + l * DM + c) * (*(const f32x4*)(ml + 1 * DM + c) + 1.0f), sh = *(const f32x4*)(ml + 0 * DM + c);
#pragma unroll
                    for (int q = 0; q < 4; ++q) { const f32x4 o = v[q][j] * rstd[q] * gsc + sh;
                        *(v2u*)(H + (size_t)(row0 + rr + q) * DM + c) = (v2u){pk2(o.x, o.y), pk2(o.z, o.w)}; } }
            }
            continue;
        }
#pragma unroll 1
        for (int rr = 0; rr < 16; rr += 2) {
            f32x4 v[2][8];
            if (l == 0) {
#pragma unroll
                for (int q = 0; q < 2; ++q)
#pragma unroll
                    for (int j = 0; j < 8; ++j) v[q][j] = *(const f32x4*)(A.in[I_X] + (size_t)(row0 + rr + q) * DM + 4 * F.lane + 256 * j);
            } else {
                bf16* XB = (bf16*)(F.ws + WS_XB);
                v2u xw[2][8]; YRAW ya[2][8], yb[2][8]; f32x4 g2p[8];
#pragma unroll
                for (int q = 0; q < 2; ++q)
#pragma unroll
                    for (int j = 0; j < 8; ++j) { const int c = 4 * F.lane + 256 * j; const int row = row0 + rr + q;
                        xw[q][j] = *(const v2u*)(XB + (size_t)row * DM + c); ya[q][j] = YLD(Y, 2 * row, c); yb[q][j] = YLD(Y, 2 * row + 1, c); }
#pragma unroll
                for (int j = 0; j < 8; ++j) g2p[j] = *(const f32x4*)(mod + ((size_t)(l - 1) * 4 + b) * 12288 + 5 * DM + 4 * F.lane + 256 * j);
#pragma unroll
                for (int q = 0; q < 2; ++q)
#pragma unroll
                    for (int j = 0; j < 8; ++j) { const int c = 4 * F.lane + 256 * j; const int row = row0 + rr + q;
                        const f32x4 xr = {bf_lo(xw[q][j].x), bf_hi(xw[q][j].x), bf_lo(xw[q][j].y), bf_hi(xw[q][j].y)};
                        const f32x4 ys = YSUM(ya[q][j], yb[q][j]);
                        const f32x4 t = xr + g2p[j] * ys;
                        const v2u ow = {pk2(t.x, t.y), pk2(t.z, t.w)}; *(v2u*)(XB + (size_t)row * DM + c) = ow;
                        v[q][j] = (f32x4){bf_lo(ow.x), bf_hi(ow.x), bf_lo(ow.y), bf_hi(ow.y)}; }
            }
            float rstd[2];
#pragma unroll
            for (int q = 0; q < 2; ++q) { float s = 0.f;
#pragma unroll
                for (int j = 0; j < 8; ++j) s += (v[q][j].x * v[q][j].x + v[q][j].y * v[q][j].y) + (v[q][j].z * v[q][j].z + v[q][j].w * v[q][j].w);
                rstd[q] = __builtin_amdgcn_rsqf(wave_sum(s) * (1.f / DM) + EPS); }
#pragma unroll
            for (int j = 0; j < 8; ++j) { const int c = 4 * F.lane + 256 * j;
                const f32x4 gsc = *(const f32x4*)(A.in[I_N1G] + l * DM + c) * (*(const f32x4*)(ml + 1 * DM + c) + 1.0f), sh = *(const f32x4*)(ml + 0 * DM + c);
#pragma unroll
                for (int q = 0; q < 2; ++q) { const f32x4 o = v[q][j] * rstd[q] * gsc + sh;
                    *(v2u*)(H + (size_t)(row0 + rr + q) * DM + c) = (v2u){pk2(o.x, o.y), pk2(o.z, o.w)}; } }
        }
    }
#else
    for (int ch = gw; ch < T / 16; ch += NGW) {
        const int row0 = ch * 16, b = row0 >> 13;
        const float* ml = mod + ((size_t)l * 4 + b) * 12288;
        f32x4 gsc[8], sh[8], g2p[8];
#pragma unroll
        for (int j = 0; j < 8; ++j) { const int c = 4 * F.lane + 256 * j; const f32x4 g = *(const f32x4*)(A.in[I_N1G] + l * DM + c), sc = *(const f32x4*)(ml + 1 * DM + c);
            gsc[j] = g * (sc + 1.0f); sh[j] = *(const f32x4*)(ml + 0 * DM + c);
            if (l > 0) g2p[j] = *(const f32x4*)(mod + ((size_t)(l - 1) * 4 + b) * 12288 + 5 * DM + c); }
#pragma unroll 1
        for (int rr = 0; rr < 16; ++rr) {
            const int row = row0 + rr; f32x4 v[8]; float s = 0.f;
            if (l == 0) {
#pragma unroll
                for (int j = 0; j < 8; ++j) v[j] = *(const f32x4*)(A.in[I_X] + (size_t)row * DM + 4 * F.lane + 256 * j);
            } else {
#pragma unroll
                for (int j = 0; j < 8; ++j) { const int c = 4 * F.lane + 256 * j;
#ifdef XRES_BF16
                    bf16* XB = (bf16*)(F.ws + WS_XB); const v2u xw = *(const v2u*)(XB + (size_t)row * DM + c); const f32x4 xr = {bf_lo(xw.x), bf_hi(xw.x), bf_lo(xw.y), bf_hi(xw.y)};
#else
                    const f32x4 xr = *(const f32x4*)(A.out + (size_t)row * DM + c);
#endif
                    const v2u y0 = *(const v2u*)(Y + (size_t)(2 * row) * DM + c), y1 = *(const v2u*)(Y + (size_t)(2 * row + 1) * DM + c);
                    const f32x4 ys = {bf_lo(y0.x) + bf_lo(y1.x), bf_hi(y0.x) + bf_hi(y1.x), bf_lo(y0.y) + bf_lo(y1.y), bf_hi(y0.y) + bf_hi(y1.y)};
                    v[j] = xr + g2p[j] * ys;
#ifdef XRES_BF16
                    { const v2u ow = {pk2(v[j].x, v[j].y), pk2(v[j].z, v[j].w)}; *(v2u*)(XB + (size_t)row * DM + c) = ow;
                      v[j] = (f32x4){bf_lo(ow.x), bf_hi(ow.x), bf_lo(ow.y), bf_hi(ow.y)}; }
#else
                    *(f32x4*)(A.out + (size_t)row * DM + c) = v[j];
#endif
                }
            }
#pragma unroll
            for (int j = 0; j < 8; ++j) s += (v[j].x * v[j].x + v[j].y * v[j].y) + (v[j].z * v[j].z + v[j].w * v[j].w);
            const float rstd = __builtin_amdgcn_rsqf(wave_sum(s) * (1.f / DM) + EPS);
#pragma unroll
            for (int j = 0; j < 8; ++j) { const f32x4 o = v[j] * rstd * gsc[j] + sh[j];
                *(v2u*)(H + (size_t)row * DM + 4 * F.lane + 256 * j) = (v2u){pk2(o.x, o.y), pk2(o.z, o.w)}; }
        }
    }
#endif
#ifndef ATT_CONV
    {
        LAS float* scr = (LAS float*)(F.lds + F.wave * 16384);
        constexpr int I_G = (DM / 64) * (DEXP / 32), I_D = (DEXP / 64) * (DM / 32), I_E = 2 * I_G + I_D;
        for (int it = gw; it < NEXP * I_E; it += NGW) {
            const int e = it / I_E; int r = it % I_E; const size_t eo = ((size_t)l * NEXP + e) * DM * DEXP;
            if (r < I_G) { transpose_item8<3>(A.in[I_EG] + eo, DEXP, DM, DEXP, F.ws + WS_W13 + (size_t)e * 2048 * DM, scr, r, F.lane); continue; } r -= I_G;
            if (r < I_G) { transpose_item8<4>(A.in[I_EU] + eo, DEXP, DM, DEXP, F.ws + WS_W13 + (size_t)e * 2048 * DM, scr, r, F.lane); continue; } r -= I_G;
            transpose_item8<0>(A.in[I_ED] + eo, DM, DEXP, DM, F.ws + WS_W2 + (size_t)e * DM * DEXP, scr, r, F.lane);
        }
    }
#endif
}
__device__ __forceinline__ void phase_final(Frame& F, const Args& A, int probe) {
    const int gw = F.vcu * NWAVES + F.wave, NGW = F.G * NWAVES;
    const float* mod = (const float*)(F.ws + WS_MOD); const bf16* Y = (const bf16*)(F.ws + WS_Y);
    for (int ch = gw; ch < T / 16; ch += NGW) {
        const int row0 = ch * 16, b = row0 >> 13;
#if defined(THIN_MLP) && defined(XRES_BF16)
#pragma unroll 1
        for (int rr = 0; rr < 16; rr += 2) {
            v2u xw[2][8]; YRAW ya[2][8], yb[2][8]; f32x4 g2p[8]; f32x4 v[2][8];
#pragma unroll
            for (int q = 0; q < 2; ++q)
#pragma unroll
                for (int j = 0; j < 8; ++j) { const int c = 4 * F.lane + 256 * j; const int row = row0 + rr + q;
                    xw[q][j] = *(const v2u*)((const bf16*)(F.ws + WS_XB) + (size_t)row * DM + c); ya[q][j] = YLD(Y, 2 * row, c); yb[q][j] = YLD(Y, 2 * row + 1, c); }
#pragma unroll
            for (int j = 0; j < 8; ++j) g2p[j] = *(const f32x4*)(mod + ((size_t)(probe == 3 ? 0 : DEPTH - 1) * 4 + b) * 12288 + 5 * DM + 4 * F.lane + 256 * j);
            float rstd[2];
#pragma unroll
            for (int q = 0; q < 2; ++q) { float s = 0.f;
#pragma unroll
                for (int j = 0; j < 8; ++j) { const f32x4 xr = {bf_lo(xw[q][j].x), bf_hi(xw[q][j].x), bf_lo(xw[q][j].y), bf_hi(xw[q][j].y)};
                    const f32x4 ys = YSUM(ya[q][j], yb[q][j]);
                    v[q][j] = (probe == 1 || probe == 2) ? xr : xr + g2p[j] * ys; }
#pragma unroll
                for (int j = 0; j < 8; ++j) s += (v[q][j].x * v[q][j].x + v[q][j].y * v[q][j].y) + (v[q][j].z * v[q][j].z + v[q][j].w * v[q][j].w);
                rstd[q] = __builtin_amdgcn_rsqf(wave_sum(s) * (1.f / DM) + EPS); }
#pragma unroll
            for (int j = 0; j < 8; ++j) { const int c = 4 * F.lane + 256 * j; const f32x4 fg = *(const f32x4*)(A.in[I_FG] + c);
#pragma unroll
                for (int q = 0; q < 2; ++q) *(f32x4*)(A.out + (size_t)(row0 + rr + q) * DM + c) = v[q][j] * rstd[q] * fg; }
        }
#else
        f32x4 fg[8], g2p[8];
#pragma unroll
        for (int j = 0; j < 8; ++j) { const int c = 4 * F.lane + 256 * j; fg[j] = *(const f32x4*)(A.in[I_FG] + c); g2p[j] = *(const f32x4*)(mod + ((size_t)(probe == 3 ? 0 : DEPTH - 1) * 4 + b) * 12288 + 5 * DM + c); }
#pragma unroll 1
        for (int rr = 0; rr < 16; ++rr) {
            const int row = row0 + rr; f32x4 v[8]; float s = 0.f;
#pragma unroll
            for (int j = 0; j < 8; ++j) { const int c = 4 * F.lane + 256 * j;
#ifdef XRES_BF16
                const v2u xw = *(const v2u*)((const bf16*)(F.ws + WS_XB) + (size_t)row * DM + c); const f32x4 xr = {bf_lo(xw.x), bf_hi(xw.x), bf_lo(xw.y), bf_hi(xw.y)};
#else
                const f32x4 xr = *(const f32x4*)((probe == 2 ? A.in[I_X] : A.out) + (size_t)row * DM + c);
#endif
                const v2u y0 = *(const v2u*)(Y + (size_t)(2 * row) * DM + c), y1 = *(const v2u*)(Y + (size_t)(2 * row + 1) * DM + c);
                const f32x4 ys = {bf_lo(y0.x) + bf_lo(y1.x), bf_hi(y0.x) + bf_hi(y1.x), bf_lo(y0.y) + bf_lo(y1.y), bf_hi(y0.y) + bf_hi(y1.y)};
                v[j] = (probe == 1 || probe == 2) ? xr : xr + g2p[j] * ys; }
#pragma unroll
            for (int j = 0; j < 8; ++j) s += (v[j].x * v[j].x + v[j].y * v[j].y) + (v[j].z * v[j].z + v[j].w * v[j].w);
            const float rstd = __builtin_amdgcn_rsqf(wave_sum(s) * (1.f / DM) + EPS);
#pragma unroll
            for (int j = 0; j < 8; ++j) *(f32x4*)(A.out + (size_t)row * DM + 4 * F.lane + 256 * j) = v[j] * rstd * fg[j];
        }
#endif
    }
}
#ifndef PROBE_DUMP_SCALE
#define PROBE_DUMP_SCALE 1.0f
#endif
#ifndef PROBE_DUMP_W
#define PROBE_DUMP_W 2048
#endif
__device__ __forceinline__ void phase_dump(Frame& F, const Args& A, size_t off, int pitch) {
    const int gw = F.vcu * NWAVES + F.wave, NGW = F.G * NWAVES;
    for (int row = gw; row < T; row += NGW) { const bf16* src = (const bf16*)(F.ws + off) + (size_t)row * pitch;
#ifdef PROBE_DUMP_F32
        for (int j = 0; j < 8; ++j) { const int c = 4 * F.lane + 256 * j; const float* sf = (const float*)(F.ws + off) + (size_t)row * pitch + c;
#ifdef PROBE_DUMP_SRC_OUT
            sf = A.out + (size_t)row * DM + c;
#endif
            f32x4 o = {0.f, 0.f, 0.f, 0.f}; if (c < PROBE_DUMP_W) o = *(const f32x4*)sf * PROBE_DUMP_SCALE;
#ifdef PROBE_DUMP_LOWBITS
            { const v4u ub = __builtin_bit_cast(v4u, o); o = (f32x4){(float)(ub.x & 0xFFFu), (float)(ub.y & 0xFFFu), (float)(ub.z & 0xFFFu), (float)(ub.w & 0xFFFu)}; }
#endif
            *(f32x4*)(A.out + (size_t)row * DM + c) = o; }
        continue;
#endif
        for (int j = 0; j < 8; ++j) { const int c = 4 * F.lane + 256 * j; const v2u w = *(const v2u*)(src + c);
#ifdef PROBE_DUMP_LOWBITS
            *(f32x4*)(A.out + (size_t)row * DM + c) = c < PROBE_DUMP_W ? (f32x4){(float)(w.x & 0x7Fu), (float)((w.x >> 16) & 0x7Fu), (float)(w.y & 0x7Fu), (float)((w.y >> 16) & 0x7Fu)} : (f32x4){0.f, 0.f, 0.f, 0.f}; } }
#else
            *(f32x4*)(A.out + (size_t)row * DM + c) = c < PROBE_DUMP_W ? (f32x4){bf_lo(w.x), bf_hi(w.x), bf_lo(w.y), bf_hi(w.y)} : (f32x4){0.f, 0.f, 0.f, 0.f}; } }
#endif
}
__device__ __forceinline__ void phase_mla_prep(Frame& F, const Args& A) {
    const int gw = F.vcu * NWAVES + F.wave, NGW = F.G * NWAVES;
    const bf16* P = (const bf16*)(F.ws + WS_PROJ); bf16* KF = (bf16*)(F.ws + WS_KF);
    float* rq = (float*)(F.ws + WS_RSTDQ); float* rkv = (float*)(F.ws + WS_RSTDKV); const float* rope = (const float*)(F.ws + WS_ROPE);
    for (int ch = gw; ch < T / 16; ch += NGW) {
#pragma unroll 1
        for (int r4 = 0; r4 < 16; r4 += 4) {
            v4u q[4]; v2u kv[4]; unsigned kr[4]; f32x2 cs[4];
#pragma unroll
            for (int u = 0; u < 4; ++u) { const int row = ch * 16 + r4 + u; const bf16* pr = P + (size_t)row * PROJ_LD;
                q[u] = *(const v4u*)(pr + C_CQ + 8 * F.lane); kv[u] = *(const v2u*)(pr + C_CKV + 4 * F.lane);
                kr[u] = *(const unsigned*)(pr + C_KR + 2 * (F.lane & 31)); cs[u] = *(const f32x2*)(rope + ((size_t)(row & (SEQ - 1)) * 32 + (F.lane & 31)) * 2); }
#pragma unroll
            for (int u = 0; u < 4; ++u) { const int row = ch * 16 + r4 + u;
                float sq = 0.f, skv = 0.f;
#pragma unroll
                for (int i = 0; i < 4; ++i) { const float a = bf_lo(q[u][i]), b2 = bf_hi(q[u][i]); sq += a * a + b2 * b2; }
#pragma unroll
                for (int i = 0; i < 2; ++i) { const float a = bf_lo(kv[u][i]), b2 = bf_hi(kv[u][i]); skv += a * a + b2 * b2; }
                sq = wave_sum(sq); skv = wave_sum(skv);
                if (F.lane == 0) { rq[row] = __builtin_amdgcn_rsqf(sq * (1.f / 512.f) + EPS); rkv[row] = __builtin_amdgcn_rsqf(skv * (1.f / 256.f) + EPS); }
                if (F.lane < 32) { const float x1 = bf_lo(kr[u]), x2 = bf_hi(kr[u]);
                    const unsigned o = pk2(x1 * cs[u].x - x2 * cs[u].y, x2 * cs[u].x + x1 * cs[u].y);
#pragma unroll
                    for (int h = 0; h < 8; ++h) *(unsigned*)(KF + (size_t)row * 1536 + h * 192 + 128 + 2 * F.lane) = o; } }
        }
    }
}
__device__ __forceinline__ void phase_q_rope(Frame& F, const Args& A) {
    const int gw = F.vcu * NWAVES + F.wave, NGW = F.G * NWAVES;
    bf16* QA = (bf16*)(F.ws + WS_QA); const float* rope = (const float*)(F.ws + WS_ROPE);
    for (int ch = gw; ch < T / 16; ch += NGW) {
#pragma unroll 1
        for (int r4 = 0; r4 < 16; r4 += 4) {
            v4u w[4]; f32x4 c01[4], c23[4];
#pragma unroll
            for (int u = 0; u < 4; ++u) { const int row = ch * 16 + r4 + u;
                w[u] = *(const v4u*)(QA + (size_t)row * 1536 + (F.lane >> 3) * 192 + 128 + (F.lane & 7) * 8);
                const f32x4* cs = (const f32x4*)(rope + ((size_t)(row & (SEQ - 1)) * 32 + (F.lane & 7) * 4) * 2); c01[u] = cs[0]; c23[u] = cs[1]; }
#pragma unroll
            for (int u = 0; u < 4; ++u) { const int row = ch * 16 + r4 + u; v4u o;
                { const float x1 = bf_lo(w[u].x), x2 = bf_hi(w[u].x); o.x = pk2(x1 * c01[u][0] - x2 * c01[u][1], x2 * c01[u][0] + x1 * c01[u][1]); }
                { const float x1 = bf_lo(w[u].y), x2 = bf_hi(w[u].y); o.y = pk2(x1 * c01[u][2] - x2 * c01[u][3], x2 * c01[u][2] + x1 * c01[u][3]); }
                { const float x1 = bf_lo(w[u].z), x2 = bf_hi(w[u].z); o.z = pk2(x1 * c23[u][0] - x2 * c23[u][1], x2 * c23[u][0] + x1 * c23[u][1]); }
                { const float x1 = bf_lo(w[u].w), x2 = bf_hi(w[u].w); o.w = pk2(x1 * c23[u][2] - x2 * c23[u][3], x2 * c23[u][2] + x1 * c23[u][3]); }
                *(v4u*)(QA + (size_t)row * 1536 + (F.lane >> 3) * 192 + 128 + (F.lane & 7) * 8) = o; }
        }
    }
}
#ifndef THIN_RO
#define THIN_RO 2
#endif
__device__ __forceinline__ void phase_out_norm(Frame& F, const Args& A, int l) {
    const int gw = F.vcu * NWAVES + F.wave, NGW = F.G * NWAVES;
    const bf16* OA = (const bf16*)(F.ws + WS_OA); const bf16* OB = (const bf16*)(F.ws + WS_OB); const float* LSE = (const float*)(F.ws + WS_LSE); bf16* Yn = (bf16*)(F.ws + WS_H);
    for (int ch = gw; ch < T / 16; ch += NGW) {
        float ga[2][8], gb[2][8];
#pragma unroll
        for (int hf = 0; hf < 2; ++hf)
#pragma unroll
            for (int i = 0; i < 8; ++i) { ga[hf][i] = A.in[I_ONA][l * 1024 + hf * 512 + 8 * F.lane + i]; gb[hf][i] = A.in[I_ONB][l * 1024 + hf * 512 + 8 * F.lane + i]; }
#ifdef THIN_MLP
#pragma unroll 1
        for (int rr = 0; rr < 16; rr += THIN_RO) {
            v4u ra_[THIN_RO][2], ro_[THIN_RO][2][3]; float ls_[THIN_RO][2][3];
#pragma unroll
            for (int q = 0; q < THIN_RO; ++q)
#pragma unroll
                for (int hf = 0; hf < 2; ++hf) { const int row = ch * 16 + rr + q, c = hf * 512 + 8 * F.lane, hd = c >> 7;
                    ra_[q][hf] = *(const v4u*)(OA + (size_t)row * 1024 + c);
#pragma unroll
                    for (int n = 0; n < 3; ++n) { ro_[q][hf][n] = *(const v4u*)(OB + ((size_t)n * T + row) * 1024 + c); ls_[q][hf][n] = LSE[((size_t)n * T + row) * 8 + hd]; } }
#pragma unroll
            for (int q = 0; q < THIN_RO; ++q) {
                const int row = ch * 16 + rr + q;
                float va[2][8], vb[2][8]; float sa = 0.f, sb = 0.f;
#pragma unroll
                for (int hf = 0; hf < 2; ++hf) {
                    const v4u a = ra_[q][hf];
#pragma unroll
                    for (int i = 0; i < 4; ++i) { va[hf][2 * i] = bf_lo(a[i]); va[hf][2 * i + 1] = bf_hi(a[i]); }
                    const float l0 = ls_[q][hf][0], l1 = ls_[q][hf][1], l2 = ls_[q][hf][2];
                    const float mx = fmaxf(l0, fmaxf(l1, l2)); const float e0 = __expf(l0 - mx), e1 = __expf(l1 - mx), e2 = __expf(l2 - mx); const float inv = 1.0f / (e0 + e1 + e2);
                    const float al[3] = {e0 * inv, e1 * inv, e2 * inv};
#pragma unroll
                    for (int i = 0; i < 8; ++i) vb[hf][i] = 0.f;
#pragma unroll
                    for (int n = 0; n < 3; ++n) { const v4u o = ro_[q][hf][n];
#pragma unroll
                        for (int i = 0; i < 4; ++i) { vb[hf][2 * i] += al[n] * bf_lo(o[i]); vb[hf][2 * i + 1] += al[n] * bf_hi(o[i]); } }
#pragma unroll
                    for (int i = 0; i < 8; ++i) { sa += va[hf][i] * va[hf][i]; sb += vb[hf][i] * vb[hf][i]; }
                }
                const float ra = __builtin_amdgcn_rsqf(wave_sum(sa) * (1.f / 1024.f) + EPS), rb = __builtin_amdgcn_rsqf(wave_sum(sb) * (1.f / 1024.f) + EPS);
#pragma unroll
                for (int hf = 0; hf < 2; ++hf) { const int c = hf * 512 + 8 * F.lane;
#ifdef G3_FP8
                    { unsigned char* Y8 = (unsigned char*)Yn; float ya[8], yb[8];
#pragma unroll
                      for (int i = 0; i < 8; ++i) { ya[i] = va[hf][i] * ra * ga[hf][i]; yb[i] = vb[hf][i] * rb * gb[hf][i]; }
                      *(v2u*)(Y8 + (size_t)row * DM + c) = (v2u){pk4_fp8(ya[0], ya[1], ya[2], ya[3]), pk4_fp8(ya[4], ya[5], ya[6], ya[7])};
                      *(v2u*)(Y8 + (size_t)row * DM + 1024 + c) = (v2u){pk4_fp8(yb[0], yb[1], yb[2], yb[3]), pk4_fp8(yb[4], yb[5], yb[6], yb[7])}; }
#else
                    { v4u wa, wb;
#pragma unroll
                      for (int i = 0; i < 4; ++i) { wa[i] = pk2(va[hf][2 * i] * ra * ga[hf][2 * i], va[hf][2 * i + 1] * ra * ga[hf][2 * i + 1]); wb[i] = pk2(vb[hf][2 * i] * rb * gb[hf][2 * i], vb[hf][2 * i + 1] * rb * gb[hf][2 * i + 1]); }
                      *(v4u*)(Yn + (size_t)row * DM + c) = wa; *(v4u*)(Yn + (size_t)row * DM + 1024 + c) = wb; }
#endif
                }
            }
        }
#else
#pragma unroll 1
        for (int rr = 0; rr < 16; ++rr) {
            const int row = ch * 16 + rr;
            float va[2][8], vb[2][8]; float sa = 0.f, sb = 0.f;
#pragma unroll
            for (int hf = 0; hf < 2; ++hf) {
                const int c = hf * 512 + 8 * F.lane, hd = c >> 7;
                const v4u a = *(const v4u*)(OA + (size_t)row * 1024 + c);
#pragma unroll
                for (int i = 0; i < 4; ++i) { va[hf][2 * i] = bf_lo(a[i]); va[hf][2 * i + 1] = bf_hi(a[i]); }
                const float l0 = LSE[((size_t)0 * T + row) * 8 + hd], l1 = LSE[((size_t)1 * T + row) * 8 + hd], l2 = LSE[((size_t)2 * T + row) * 8 + hd];
                const float mx = fmaxf(l0, fmaxf(l1, l2)); const float e0 = __expf(l0 - mx), e1 = __expf(l1 - mx), e2 = __expf(l2 - mx); const float inv = 1.0f / (e0 + e1 + e2);
                const float al[3] = {e0 * inv, e1 * inv, e2 * inv};
#pragma unroll
                for (int i = 0; i < 8; ++i) vb[hf][i] = 0.f;
#pragma unroll
                for (int n = 0; n < 3; ++n) { const v4u o = *(const v4u*)(OB + ((size_t)n * T + row) * 1024 + c);
#pragma unroll
                    for (int i = 0; i < 4; ++i) { vb[hf][2 * i] += al[n] * bf_lo(o[i]); vb[hf][2 * i + 1] += al[n] * bf_hi(o[i]); } }
#pragma unroll
                for (int i = 0; i < 8; ++i) { sa += va[hf][i] * va[hf][i]; sb += vb[hf][i] * vb[hf][i]; }
            }
            const float ra = __builtin_amdgcn_rsqf(wave_sum(sa) * (1.f / 1024.f) + EPS), rb = __builtin_amdgcn_rsqf(wave_sum(sb) * (1.f / 1024.f) + EPS);
#pragma unroll
            for (int hf = 0; hf < 2; ++hf) { const int c = hf * 512 + 8 * F.lane; v4u wa, wb;
#pragma unroll
                for (int i = 0; i < 4; ++i) { wa[i] = pk2(va[hf][2 * i] * ra * ga[hf][2 * i], va[hf][2 * i + 1] * ra * ga[hf][2 * i + 1]); wb[i] = pk2(vb[hf][2 * i] * rb * gb[hf][2 * i], vb[hf][2 * i + 1] * rb * gb[hf][2 * i + 1]); }
#ifdef G3_FP8
                { unsigned char* Y8 = (unsigned char*)Yn; float ya[8], yb[8];
#pragma unroll
                  for (int i = 0; i < 8; ++i) { ya[i] = va[hf][i] * ra * ga[hf][i]; yb[i] = vb[hf][i] * rb * gb[hf][i]; }
                  *(v2u*)(Y8 + (size_t)row * DM + c) = (v2u){pk4_fp8(ya[0], ya[1], ya[2], ya[3]), pk4_fp8(ya[4], ya[5], ya[6], ya[7])};
                  *(v2u*)(Y8 + (size_t)row * DM + 1024 + c) = (v2u){pk4_fp8(yb[0], yb[1], yb[2], yb[3]), pk4_fp8(yb[4], yb[5], yb[6], yb[7])}; }
#else
                *(v4u*)(Yn + (size_t)row * DM + c) = wa; *(v4u*)(Yn + (size_t)row * DM + 1024 + c) = wb;
#endif
            }
        }
#endif
    }
}
#ifndef ROUTER_SRC
#define ROUTER_SRC A.out
#endif
#ifdef ROUTER_MFMA
typedef short r_bf16x8 __attribute__((ext_vector_type(8)));
#ifndef RPA
#define RPA 2
#endif
__device__ __forceinline__ void phase_router(Frame& F, const Args& A, int l, int dummy = 0) {
    const float* mod = (const float*)(F.ws + WS_MOD);
    bf16* H = (bf16*)(F.ws + WS_H);
    LAS int* lcnt = (LAS int*)(F.lds + L_CNT); LAS int* gbase = lcnt + 16; LAS int* tokinfo = (LAS int*)(F.lds + L_TOK);
    LAS float* lgs = (LAS float*)(F.lds + L_ATAB);
    LAS float* rsl = (LAS float*)(F.lds + L_ATAB + 8704);
    LAS float* wsm = (LAS float*)(F.lds + L_ATAB + 8704 + 512);
    LAS float* cstl = (LAS float*)(F.lds + L_ATAB + 8704 + 1024);
    unsigned* gcnt = F.ctl + CW_CNT + (dummy ? 3 : l) * 16;
    int* rowidx = (int*)(F.ws + (dummy ? WS_OB : WS_ROWIDX)); float* aw = (float*)(F.ws + (dummy ? WS_OB + 4 * MiB : WS_AW));
    float rb[16];
#pragma unroll
    for (int e = 0; e < 16; ++e) rb[e] = __uint_as_float(__builtin_amdgcn_readfirstlane(__float_as_uint(A.in[I_RB][e])));
    for (int bi = F.vcu; bi < T / 128; bi += F.G) {
        const int row0 = bi * 128 + F.wave * 16, b = row0 >> 13;
        const rsrc_t rml = RSRC(mod + ((size_t)l * 4 + b) * 12288), rgn = RSRC(A.in[I_N2G] + l * DM), rh = RSRC(H), rxb = RSRC(F.ws + WS_XB), rrw = RSRC(A.in[I_RW]);
        __syncthreads();
        { const int t0_ = F.wave * 64 + lane_id(); if (t0_ < 16) lcnt[t0_] = 0;
          const int e4 = t0_ & 3; f32x4 ca = {0.f, 0.f, 0.f, 0.f};
#pragma unroll 4
          for (int i = 0; i < 16; ++i) { const int k = (t0_ >> 2) + 128 * i;
              const f32x4 w4 = bld4f(rrw, (k * 16 + e4 * 4) * 4, 0);
              const float g = __uint_as_float(__builtin_amdgcn_raw_buffer_load_b32(rgn, k * 4, 0, 0)) * (__uint_as_float(__builtin_amdgcn_raw_buffer_load_b32(rml, k * 4, 4 * DM * 4, 0)) + 1.0f);
              const float sh = __uint_as_float(__builtin_amdgcn_raw_buffer_load_b32(rml, k * 4, 3 * DM * 4, 0));
              ca += w4 * sh;
              const int ob = (k >> 5) * 1024 + (((k >> 3) & 3) * 16 + e4 * 4) * 16 + (k & 7) * 2;
#pragma unroll
              for (int c = 0; c < 4; ++c) { const float wp = w4[c] * g; const unsigned hi = pk2(wp, 0.f) & 0xffffu; const float rem = wp - __uint_as_float(hi << 16);
                  *(LAS unsigned short*)(F.lds + ob + c * 16) = (unsigned short)hi; *(LAS unsigned short*)(F.lds + 65536 + ob + c * 16) = (unsigned short)(pk2(rem, 0.f) & 0xffffu); } }
          const int ln = t0_ & 63;
#pragma unroll
          for (int q = 0; q < 4; ++q)
#pragma unroll
              for (int c = 0; c < 4; ++c) { const float s = wave_sum((ln & 3) == q ? ca[c] : 0.f); if (ln == 0) wsm[F.wave * 16 + q * 4 + c] = s; }
        }
        __syncthreads();
        { const int t0_ = F.wave * 64 + lane_id(); if (t0_ < 16) { float s = 0.f;
#pragma unroll
              for (int w = 0; w < 8; ++w) s += wsm[w * 16 + t0_];
              cstl[t0_] = s; } }
        __syncthreads();
        const int lo16 = F.lane * 16, lo8 = F.lane * 8;
        f32x4 gsv[8];
#pragma unroll
        for (int j = 0; j < 8; ++j) gsv[j] = bld4f(rgn, lo16 + j * 1024, 0) * (bld4f(rml, lo16 + j * 1024, 4 * DM * 4) + 1.0f);
#pragma unroll 1
        for (int rp = 0; rp < 16 / RPA; ++rp) {
            float ss[RPA] = {};
            v2u xraw[RPA][8];
#pragma unroll
            for (int q = 0; q < RPA; ++q)
#pragma unroll
                for (int j = 0; j < 8; ++j) xraw[q][j] = bld2u(rxb, lo8 + j * 512, (row0 + rp * RPA + q) * (DM * 2));
#define XV(q, j) ((f32x4){bf_lo(xraw[q][j].x), bf_hi(xraw[q][j].x), bf_lo(xraw[q][j].y), bf_hi(xraw[q][j].y)})
            f32x4 shv[8];
#pragma unroll
            for (int j = 0; j < 8; ++j) shv[j] = bld4f(rml, lo16 + j * 1024, 3 * DM * 4);
#pragma unroll
            for (int j = 0; j < 8; ++j)
#pragma unroll
                for (int q = 0; q < RPA; ++q) { const f32x4 x = XV(q, j); ss[q] += (x.x * x.x + x.y * x.y) + (x.z * x.z + x.w * x.w); }
            float rstd[RPA];
#pragma unroll
            for (int q = 0; q < RPA; ++q) rstd[q] = __builtin_amdgcn_rsqf(wave_sum(ss[q]) * (1.f / DM) + EPS);
            if (F.lane == 0) {
#pragma unroll
                for (int q = 0; q < RPA; ++q) rsl[F.wave * 16 + rp * RPA + q] = rstd[q]; }
#pragma unroll
            for (int j = 0; j < 8; ++j) {
#pragma unroll
                for (int q = 0; q < RPA; ++q) { const f32x4 o = XV(q, j) * rstd[q] * gsv[j] + shv[j]; __builtin_amdgcn_raw_buffer_store_b32(pk4_fp8(o.x, o.y, o.z, o.w), rh, F.lane * 4 + j * 256, (row0 + rp * RPA + q) * DM, 0); } }
#undef XV
        }
        { const int ln = lane_id(), col = ln & 15, rq = ln >> 4;
          const int va = col * (DM * 2) + rq * 16, sa = row0 * (DM * 2);
          f32x4 acc = {0.f, 0.f, 0.f, 0.f};
          r_bf16x8 a0[8], a1[8];
#pragma unroll
          for (int i = 0; i < 8; ++i) a0[i] = __builtin_bit_cast(r_bf16x8, __builtin_amdgcn_raw_buffer_load_b128(rxb, va + i * 64, sa, 0));
#define RT_MM(AR, sb) do { _Pragma("unroll") for (int i = 0; i < 8; ++i) { const int st = (sb) * 8 + i; \
              const r_bf16x8 bh = *(const LAS r_bf16x8*)(F.lds + st * 1024 + ln * 16), bl = *(const LAS r_bf16x8*)(F.lds + 65536 + st * 1024 + ln * 16); \
              acc = __builtin_amdgcn_mfma_f32_16x16x32_bf16(AR[i], bh, acc, 0, 0, 0); acc = __builtin_amdgcn_mfma_f32_16x16x32_bf16(AR[i], bl, acc, 0, 0, 0); } } while (0)
#pragma unroll 1
          for (int sb = 0; sb < 8; sb += 2) {
#pragma unroll
              for (int i = 0; i < 8; ++i) a1[i] = __builtin_bit_cast(r_bf16x8, __builtin_amdgcn_raw_buffer_load_b128(rxb, va + ((sb + 1) * 8 + i) * 64, sa, 0));
              RT_MM(a0, sb);
              if (sb + 2 < 8) {
#pragma unroll
                  for (int i = 0; i < 8; ++i) a0[i] = __builtin_bit_cast(r_bf16x8, __builtin_amdgcn_raw_buffer_load_b128(rxb, va + ((sb + 2) * 8 + i) * 64, sa, 0)); }
              RT_MM(a1, sb + 1);
          }
#undef RT_MM
          LDS_WAIT();
          const float cs = cstl[col];
#pragma unroll
          for (int i = 0; i < 4; ++i) lgs[F.wave * 272 + (4 * rq + i) * 17 + col] = acc[i] * rsl[F.wave * 16 + 4 * rq + i] + cs;
          LDS_WAIT(); asm volatile("" ::: "memory");
          if (ln < 16) {
              float sc[16], bs[16];
#pragma unroll
              for (int e = 0; e < 16; ++e) { const float lg = lgs[F.wave * 272 + ln * 17 + e]; sc[e] = 1.0f / (1.0f + __expf(-lg)); bs[e] = sc[e] + rb[e]; }
              float gs4[4];
#pragma unroll
              for (int g = 0; g < 4; ++g) { const float a = bs[4 * g], b2 = bs[4 * g + 1], c = bs[4 * g + 2], d = bs[4 * g + 3];
                  const float h1 = fmaxf(a, b2), l1 = fminf(a, b2), h2 = fmaxf(c, d), l2 = fminf(c, d);
                  gs4[g] = fmaxf(h1, h2) + fmaxf(fminf(h1, h2), fmaxf(l1, l2)); }
              int gsel = 0; float gbest = gs4[0];
#pragma unroll
              for (int g = 1; g < 4; ++g) if (gs4[g] > gbest) { gbest = gs4[g]; gsel = g; }
              float bv[4], sv[4];
#pragma unroll
              for (int i = 0; i < 4; ++i) { bv[i] = gsel == 0 ? bs[i] : gsel == 1 ? bs[4 + i] : gsel == 2 ? bs[8 + i] : bs[12 + i]; sv[i] = gsel == 0 ? sc[i] : gsel == 1 ? sc[4 + i] : gsel == 2 ? sc[8 + i] : sc[12 + i]; }
              int i1 = 0; float b1 = bv[0], s1 = sv[0];
#pragma unroll
              for (int i = 1; i < 4; ++i) if (bv[i] > b1) { b1 = bv[i]; s1 = sv[i]; i1 = i; }
              int i2 = -1; float b2v = -__builtin_inff(), s2 = 0.f;
#pragma unroll
              for (int i = 0; i < 4; ++i) if (i != i1 && bv[i] > b2v) { b2v = bv[i]; s2 = sv[i]; i2 = i; }
              const float inv = 1.0f / (s1 + s2);
              const int r = F.wave * 16 + ln, e0 = gsel * 4 + i1, e1 = gsel * 4 + i2;
              tokinfo[r * 4 + 0] = e0; tokinfo[r * 4 + 2] = e1;
              const int row = row0 + ln; *(f32x2*)(aw + (size_t)row * 2) = (f32x2){s1 * inv, s2 * inv};
          }
        }
        __syncthreads();
        const int tb_ = F.wave * 64 + lane_id();
        {
            const int ln = tb_ & 63;
#pragma unroll
            for (int ee = 0; ee < 2; ++ee) { const int e = 2 * F.wave + ee; int base = 0;
#pragma unroll
                for (int hh = 0; hh < 2; ++hh) { const int r = hh * 64 + ln; const bool m0 = tokinfo[r * 4 + 0] == e, m1 = tokinfo[r * 4 + 2] == e;
                    const unsigned long long bal = __ballot(m0 || m1);
                    const int pos = base + __builtin_amdgcn_mbcnt_hi((unsigned)(bal >> 32), __builtin_amdgcn_mbcnt_lo((unsigned)bal, 0));
                    if (m0) tokinfo[r * 4 + 1] = pos; if (m1) tokinfo[r * 4 + 3] = pos;
                    base += __popcll(bal); }
                if (ln == 0) lcnt[e] = base; } }
        __syncthreads();
        if (tb_ < 16) gbase[tb_] = (int)__hip_atomic_fetch_add(gcnt + tb_, (unsigned)lcnt[tb_], __ATOMIC_RELAXED, __HIP_MEMORY_SCOPE_AGENT);
        __syncthreads();
        if (tb_ < 128) { const int e0 = tokinfo[tb_ * 4], p0 = tokinfo[tb_ * 4 + 1], e1 = tokinfo[tb_ * 4 + 2], p1 = tokinfo[tb_ * 4 + 3]; const int row = bi * 128 + tb_;
            rowidx[(size_t)e0 * 32768 + gbase[e0] + p0] = 2 * row; rowidx[(size_t)e1 * 32768 + gbase[e1] + p1] = 2 * row + 1; }
        __syncthreads();
    }
}
#else
__device__ __forceinline__ void phase_router(Frame& F, const Args& A, int l, int dummy = 0) {
    const float* mod = (const float*)(F.ws + WS_MOD);
    bf16* H = (bf16*)(F.ws + WS_H);
    LAS f32x4* rwl = (LAS f32x4*)F.lds;
    LAS int* lcnt = (LAS int*)(F.lds + L_CNT); LAS int* gbase = lcnt + 16; LAS int* tokinfo = (LAS int*)(F.lds + L_TOK);
    unsigned* gcnt = F.ctl + CW_CNT + (dummy ? 3 : l) * 16;
    int* rowidx = (int*)(F.ws + (dummy ? WS_OB : WS_ROWIDX)); float* aw = (float*)(F.ws + (dummy ? WS_OB + 4 * MiB : WS_AW));
    for (int q = F.tid; q < 8192; q += NWAVES * 64) { const int k = q >> 2, e4 = q & 3, ln = (k & 255) >> 2, j = k >> 8, i = k & 3;
        rwl[((j * 4 + i) * 4 + e4) * 64 + ln] = *(const f32x4*)(A.in[I_RW] + (size_t)k * 16 + e4 * 4); }
    float rb[16];
#pragma unroll
    for (int e = 0; e < 16; ++e) rb[e] = __uint_as_float(__builtin_amdgcn_readfirstlane(__float_as_uint(A.in[I_RB][e])));
    __syncthreads();
    for (int bi = F.vcu; bi < T / 128; bi += F.G) {
        { const int t0_ = F.wave * 64 + lane_id(); if (t0_ < 16) lcnt[t0_] = 0; }
        __syncthreads();
        const int row0 = bi * 128 + F.wave * 16, b = row0 >> 13;
        const rsrc_t rml = RSRC(mod + ((size_t)l * 4 + b) * 12288), rgn = RSRC(A.in[I_N2G] + l * DM), rx = RSRC(ROUTER_SRC), rh = RSRC(H);
#ifdef XRES_BF16
        const rsrc_t rxb = RSRC(F.ws + WS_XB);
#endif
        const int lo16 = F.lane * 16, lo8 = F.lane * 8;
        float cst[16];
        { f32x4 ca[4] = {};
#pragma unroll
          for (int j = 0; j < 8; ++j) { const f32x4 sh = bld4f(rml, lo16 + j * 1024, 3 * DM * 4);
#pragma unroll
            for (int i = 0; i < 4; ++i)
#pragma unroll
                for (int e4 = 0; e4 < 4; ++e4) ca[e4] += rwl[((j * 4 + i) * 4 + e4) * 64 + F.lane] * sh[i];
            asm volatile("" ::: "memory"); }
#pragma unroll
          for (int e = 0; e < 16; ++e) cst[e] = __uint_as_float(__builtin_amdgcn_readfirstlane(__float_as_uint(wave_sum(ca[e >> 2][e & 3])))); }
        f32x4 gsv[8];
#pragma unroll
        for (int j = 0; j < 8; ++j) gsv[j] = bld4f(rgn, lo16 + j * 1024, 0) * (bld4f(rml, lo16 + j * 1024, 4 * DM * 4) + 1.0f);
#pragma unroll 1
        for (int rp = 0; rp < 8; ++rp) {
            float ss[2] = {0.f, 0.f}; f32x4 acc[2][4] = {};
            const int so0 = (row0 + rp * 2) * (DM * 4);
#ifdef XRES_BF16
            v2u xraw[2][8];
#pragma unroll
            for (int q = 0; q < 2; ++q)
#pragma unroll
                for (int j = 0; j < 8; ++j) xraw[q][j] = bld2u(rxb, lo8 + j * 512, (row0 + rp * 2 + q) * (DM * 2));
#define XV(q, j) ((f32x4){bf_lo(xraw[q][j].x), bf_hi(xraw[q][j].x), bf_lo(xraw[q][j].y), bf_hi(xraw[q][j].y)})
#else
            f32x4 xv[2][8];
#pragma unroll
            for (int q = 0; q < 2; ++q)
#pragma unroll
                for (int j = 0; j < 8; ++j) xv[q][j] = bld4f(rx, lo16 + j * 1024, so0 + q * (DM * 4));
#define XV(q, j) xv[q][j]
#endif
#pragma unroll
            for (int j = 0; j < 8; ++j) {
                f32x4 a[2];
#pragma unroll
                for (int q = 0; q < 2; ++q) { const f32x4 x = XV(q, j); ss[q] += (x.x * x.x + x.y * x.y) + (x.z * x.z + x.w * x.w); a[q] = x * gsv[j]; }
#pragma unroll
                for (int i = 0; i < 4; ++i) {
#pragma unroll
                    for (int e4 = 0; e4 < 4; ++e4) { const f32x4 w = rwl[((j * 4 + i) * 4 + e4) * 64 + F.lane]; acc[0][e4] += w * a[0][i]; acc[1][e4] += w * a[1][i]; }
                    asm volatile("" : "+v"(acc[0][0]), "+v"(acc[0][1]), "+v"(acc[0][2]), "+v"(acc[0][3]), "+v"(acc[1][0]), "+v"(acc[1][1]), "+v"(acc[1][2]), "+v"(acc[1][3]) :: "memory"); } }
            float rstd[2];
#pragma unroll
            for (int q = 0; q < 2; ++q) rstd[q] = __builtin_amdgcn_rsqf(wave_sum(ss[q]) * (1.f / DM) + EPS);
            asm volatile("" ::: "memory");
            f32x4 shv[8];
#pragma unroll
            for (int j = 0; j < 8; ++j) shv[j] = bld4f(rml, lo16 + j * 1024, 3 * DM * 4);
#pragma unroll
            for (int j = 0; j < 8; ++j) {
#pragma unroll
                for (int q = 0; q < 2; ++q) { const f32x4 o = XV(q, j) * rstd[q] * gsv[j] + shv[j]; __builtin_amdgcn_raw_buffer_store_b32(pk4_fp8(o.x, o.y, o.z, o.w), rh, F.lane * 4 + j * 256, (row0 + rp * 2 + q) * DM, 0); } }
#undef XV
#pragma unroll
            for (int q = 0; q < 2; ++q) {
                float sc[16], bs[16];
#pragma unroll
                for (int e = 0; e < 16; ++e) { const float lg = wave_sum(acc[q][e >> 2][e & 3]) * rstd[q] + cst[e]; sc[e] = 1.0f / (1.0f + __expf(-lg)); bs[e] = sc[e] + rb[e]; }
                float gs4[4];
#pragma unroll
                for (int g = 0; g < 4; ++g) { const float a = bs[4 * g], b2 = bs[4 * g + 1], c = bs[4 * g + 2], d = bs[4 * g + 3];
                    const float h1 = fmaxf(a, b2), l1 = fminf(a, b2), h2 = fmaxf(c, d), l2 = fminf(c, d);
                    gs4[g] = fmaxf(h1, h2) + fmaxf(fminf(h1, h2), fmaxf(l1, l2)); }
                int gsel = 0; float gbest = gs4[0];
#pragma unroll
                for (int g = 1; g < 4; ++g) if (gs4[g] > gbest) { gbest = gs4[g]; gsel = g; }
                float bv[4], sv[4];
#pragma unroll
                for (int i = 0; i < 4; ++i) { bv[i] = gsel == 0 ? bs[i] : gsel == 1 ? bs[4 + i] : gsel == 2 ? bs[8 + i] : bs[12 + i]; sv[i] = gsel == 0 ? sc[i] : gsel == 1 ? sc[4 + i] : gsel == 2 ? sc[8 + i] : sc[12 + i]; }
                int i1 = 0; float b1 = bv[0], s1 = sv[0];
#pragma unroll
                for (int i = 1; i < 4; ++i) if (bv[i] > b1) { b1 = bv[i]; s1 = sv[i]; i1 = i; }
                int i2 = -1; float b2v = -__builtin_inff(), s2 = 0.f;
#pragma unroll
                for (int i = 0; i < 4; ++i) if (i != i1 && bv[i] > b2v) { b2v = bv[i]; s2 = sv[i]; i2 = i; }
                const float inv = 1.0f / (s1 + s2);
                if (F.lane == 0) {
                    const int r = F.wave * 16 + rp * 2 + q, e0 = gsel * 4 + i1, e1 = gsel * 4 + i2;
                    tokinfo[r * 4 + 0] = e0; tokinfo[r * 4 + 2] = e1;
                    const int row = row0 + rp * 2 + q; *(f32x2*)(aw + (size_t)row * 2) = (f32x2){s1 * inv, s2 * inv};
                }
            }
        }
        __syncthreads();
        const int tb_ = F.wave * 64 + lane_id();
        if (tb_ < 16) {
            int c = 0;
            for (int r = 0; r < 128; ++r) { if (tokinfo[r * 4 + 0] == tb_) tokinfo[r * 4 + 1] = c++; if (tokinfo[r * 4 + 2] == tb_) tokinfo[r * 4 + 3] = c++; }
            gbase[tb_] = (int)__hip_atomic_fetch_add(gcnt + tb_, (unsigned)c, __ATOMIC_RELAXED, __HIP_MEMORY_SCOPE_AGENT); }
        __syncthreads();
        if (tb_ < 128) { const int e0 = tokinfo[tb_ * 4], p0 = tokinfo[tb_ * 4 + 1], e1 = tokinfo[tb_ * 4 + 2], p1 = tokinfo[tb_ * 4 + 3]; const int row = bi * 128 + tb_;
            rowidx[(size_t)e0 * 32768 + gbase[e0] + p0] = 2 * row; rowidx[(size_t)e1 * 32768 + gbase[e1] + p1] = 2 * row + 1; }
        __syncthreads();
    }
}
#endif
__device__ __forceinline__ int moe_setup(Frame& F, int l) {
    LAS int* ts = (LAS int*)(F.lds + L_TS);
    if (F.tid == 0) { int s = 0; for (int e = 0; e < 16; ++e) { ts[e] = s; s += ((int)__hip_atomic_load(F.ctl + CW_CNT + l * 16 + e, __ATOMIC_RELAXED, __HIP_MEMORY_SCOPE_AGENT) + 255) >> 8; } ts[16] = s; }
    __syncthreads();
    return __builtin_amdgcn_readfirstlane(ts[16]);
}

__device__ __forceinline__ att::Blk mla_blk(int bh, int qb) {
    const int b = bh >> 3, h = bh & 7; att::Blk k;
    k.qo = (unsigned)(WS_QA + ((size_t)b * SEQ * 1536 + h * 192) * 2); k.ko = (unsigned)(WS_KF + ((size_t)b * SEQ * 1536 + h * 192) * 2);
    k.vo = (unsigned)(WS_VB + ((size_t)b * SEQ * 1024 + h * 128) * 2); k.oo = (unsigned)(WS_OA + ((size_t)b * SEQ * 1024 + h * 128) * 2); k.lo = 0;
    k.P0 = qb * 256; k.rate = 1; k.beta = 0.f;
    return k;
}
__device__ __forceinline__ att::Blk dil_blk(int bh, int br, int blk) {
    const int b = bh >> 3, h = bh & 7, rate = br == 0 ? 1 : br == 1 ? 4 : 16, nqb = 32 / rate, cls = blk / nqb, qb = blk % nqb; att::Blk k;
    const size_t tok0 = (size_t)b * SEQ + cls;
    const unsigned p = (unsigned)(WS_PROJ + (tok0 * PROJ_LD + h * 128) * 2);
    k.qo = p + C_QB * 2; k.ko = p + C_KB * 2; k.vo = p + C_VB * 2;
    k.oo = (unsigned)(WS_OB + (((size_t)br * T + tok0) * 1024 + h * 128) * 2);
    k.lo = (unsigned)(WS_LSE + (((size_t)br * T + tok0) * 8 + h) * 4);
    k.P0 = qb * 256; k.rate = rate;
    const float slope = __builtin_amdgcn_exp2f(-(float)(h + 1));
    k.beta = slope * (float)rate * 11.313708498984761f;
    return k;
}
__device__ __forceinline__ void mla_decode(int id, int& bh, int& qb0, int& qb1) {
    const int v = id & 255, i = id >> 8, x = v >> 5, c = v & 31, j = i * 32 + c; bh = 4 * x + (j >> 4); const int s = j & 15; qb0 = s; qb1 = 31 - s;
}
__device__ __forceinline__ void dil_decode(int id, int& bh, int& br, int& blk) {
    const int v = id & 255, i = id >> 8, x = v >> 5, c = v & 31, j = i * 32 + c; bh = 4 * x + j / 96; const int r = j % 96; br = r >> 5; blk = r & 31;
}
#ifndef ATT_DIL_NS
#define ATT_DIL_NS 4
#endif
#ifndef ATT_SKEW_SEL
#define ATT_SKEW_SEL 0
#endif
#if ATT_SKEW_SEL == 0
#define ATT_SKEW_PICK(w) ((w) < 4)
#elif ATT_SKEW_SEL == 1
#define ATT_SKEW_PICK(w) (((w) & 1) == 0)
#elif ATT_SKEW_SEL == 2
#define ATT_SKEW_PICK(w) true
#else
#define ATT_SKEW_PICK(w) false
#endif
#ifdef ATT_DMA
#define ATT_SEAM(d) att::SeamD<d>
#define ATT_DMA_ON ATT_DMA
#else
#define ATT_SEAM(d) att::Seam<d>
#define ATT_DMA_ON 0
#endif
#if ATT_DMA_ON == 2
template <int ORD>
__device__ __forceinline__ void mla_stream2(Frame& F, char* lds) {
    constexpr int NIT = 512;
    int id = F.vcu;
    if (id < NIT) {
        att::SeamD<192> S; int bh, q0, q1; mla_decode(id, bh, q0, q1); int pass = 0;
        att::Blk cur = mla_blk(bh, q0);
        att::att_prime_dma2<192, false>(cur, (const char*)F.ws, lds, S, F.tid);
        for (;;) {
            const bool more_pass = pass == 0, more_item = id + F.G < NIT, last = !more_pass && !more_item;
            att::Blk nxt = cur; int idn = id, passn = pass + 1;
            if (more_pass) nxt = mla_blk(bh, q1);
            else if (more_item) { idn = id + F.G; passn = 0; mla_decode(idn, bh, q0, q1); nxt = mla_blk(bh, q0); }
            att::att_block_dma2<192, false, false, ORD>(cur, nxt, (const char*)F.ws, lds, S, F.tid);
            if (last) break;
            cur = nxt; id = idn; pass = passn;
        }
    }
}
template <int ORD>
__device__ __forceinline__ void dil_stream2(Frame& F, char* lds) {
    constexpr int NIT = 3072;
    int id = F.vcu;
    if (id < NIT) {
        att::SeamD<128> S; int bh, br, blk; dil_decode(id, bh, br, blk);
        att::Blk cur = dil_blk(bh, br, blk);
        att::att_prime_dma2<128, true>(cur, (const char*)F.ws, lds, S, F.tid);
        for (;;) {
            const bool last = id + F.G >= NIT;
            att::Blk nxt = cur;
            if (!last) { dil_decode(id + F.G, bh, br, blk); nxt = dil_blk(bh, br, blk); }
            att::att_block_dma2<128, true, true, ORD>(cur, nxt, (const char*)F.ws, lds, S, F.tid);
            if (last) break;
            cur = nxt; id += F.G;
        }
    }
}
#endif
template <int PV>
__device__ __forceinline__ void dil_stream_reg(Frame& F, char* lds, int rep_, const Args& A, int l, int cvj0) {
        constexpr int NIT = 3072;
        int id = F.vcu;
        if (id < NIT) {
#if ATT_DMA_ON == 1
            att::SeamD<128> S;
#else
            att::Seam<128> S;
#endif
            S.cv_j = cvj0;
            int bh, br, blk; dil_decode(id, bh, br, blk);
            att::Blk cur = dil_blk(bh, br, blk);
#if defined(ATT_CONV) && ATT_CONV == 2
            const size_t eo_ = (size_t)l * NEXP * DM * DEXP;
            const att::ConvCtx X = {A.in[I_EG] + eo_, A.in[I_EU] + eo_, A.in[I_ED] + eo_, F.ws + WS_W13, F.ws + WS_W2, F.vcu * 8 + __builtin_amdgcn_readfirstlane(F.tid >> 6)};
#endif
#if ATT_DMA_ON == 1
            att::att_prime_dma<128, true, ATT_DIL_NS>(cur, (const char*)F.ws, lds, S, F.tid);
#else
            att::att_prime<128, true, PV>(cur, (const char*)F.ws, lds, S, F.tid);
#endif
            for (;;) {
                const bool last = id + F.G >= NIT;
                att::Blk nxt = cur;
                if (!last) { dil_decode(id + F.G, bh, br, blk); nxt = dil_blk(bh, br, blk); }
#if ATT_DMA_ON == 1
                att::att_block_dma<128, true, true, ATT_DIL_NS>(cur, nxt, (const char*)F.ws, lds, lds + RING_BYTES + 512, S, F.tid);
#else
#if defined(ATT_CONV) && ATT_CONV == 2
                att::att_block<128, true, true, PV, 2>(cur, nxt, (const char*)F.ws, lds, S, F.tid, &X);
#else
                att::att_block<128, true, true, PV>(cur, nxt, (const char*)F.ws, lds, S, F.tid);
#endif
#endif
                if (last) break;
                cur = nxt; id += F.G;
            }
#if defined(ATT_CONV) && ATT_CONV == 2
            { const int ln_ = lane_id(); char* scr_ = lds + att::CONV_SCR_DIL + __builtin_amdgcn_readfirstlane(F.tid >> 6) * 4352;
              if (S.cv_pend) { asm volatile("s_waitcnt vmcnt(0)" ::: "memory"); att::conv_put_full(X, S.cv_j, S.cvf, scr_, ln_); ++S.cv_j; if (S.cv_pend > 1) { att::conv_put_full(X, S.cv_j, S.cvf + 16, scr_, ln_); ++S.cv_j; } S.cv_pend = 0; }
              int jj_ = S.cv_j;
#pragma unroll 1
              while (jj_ < att::CONV_NJ) { float cb_[4][16];
#pragma unroll
                  for (int u = 0; u < 4; ++u) if (jj_ + u < att::CONV_NJ) att::conv_load_full(X, jj_ + u, cb_[u], ln_);
                  asm volatile("s_waitcnt vmcnt(0)" ::: "memory");
#pragma unroll
                  for (int u = 0; u < 4; ++u) if (jj_ + u < att::CONV_NJ) att::conv_put_full(X, jj_ + u, cb_[u], scr_, ln_);
                  jj_ += 4; }
              S.cv_j = att::CONV_NJ; }
#endif
#if defined(ATT_DEFER) && ATT_DMA_ON != 1
            if (S.p_on) { const int ln_ = F.tid & 63; const char* stg_ = lds + att::DEFER_STG + __builtin_amdgcn_readfirstlane(F.tid >> 6) * 8192;
#pragma unroll
                for (int p = 0; p < 8; ++p) att::flush_piece(stg_, p, (const char*)F.ws + S.p_oo, S.p_rb, S.p_so0, ln_); }
#endif
        }
}
static_assert(WS_ROPE == att::ROPE_OFF, "rope table offset");
#ifdef ATT_QROPE
#define ATT_ROPE_FLAG true
#else
#define ATT_ROPE_FLAG false
#endif
__device__ __forceinline__ void phase_attention(Frame& F, char* lds, const Args& A, int l) {
#ifdef ATT_PRIO
    if (__builtin_amdgcn_readfirstlane(F.tid >> 6) >= 4) __builtin_amdgcn_s_setprio(1);
#endif
#ifndef ATT_MLA_SKCONV
#define ATT_MLA_SKCONV 0
#endif
    int cvj_ = 0;
#ifndef NO_MLA
#ifndef PROBE_REP_MLA
#define PROBE_REP_MLA 1
#endif
    for (int rep_ = 0; rep_ < PROBE_REP_MLA; ++rep_) {
        if (rep_) __syncthreads();
#if ATT_DMA_ON == 2
        { const int wsel_ = __builtin_amdgcn_readfirstlane(F.tid >> 6);
          if (ATT_SKEW_PICK(wsel_)) mla_stream2<0>(F, lds); else mla_stream2<1>(F, lds); }
#else
        constexpr int NIT = 512;
        int id = F.vcu;
        if (id < NIT) {
            ATT_SEAM(192) S; int bh, q0, q1; mla_decode(id, bh, q0, q1); int pass = 0;
            att::Blk cur = mla_blk(bh, q0);
#if defined(ATT_CONV) && (ATT_CONV == 1 || defined(ATT_MLA_SK))
            const size_t eo_ = (size_t)l * NEXP * DM * DEXP;
            const att::ConvCtx X = {A.in[I_EG] + eo_, A.in[I_EU] + eo_, A.in[I_ED] + eo_, F.ws + WS_W13, F.ws + WS_W2, F.vcu * 8 + __builtin_amdgcn_readfirstlane(F.tid >> 6)};
#endif
#if ATT_DMA_ON
            att::att_prime_dma<192, false, 3>(cur, (const char*)F.ws, lds, S, F.tid);
#else
#ifdef ATT_QROPE
            att::att_prime<192, false, 0, true>(cur, (const char*)F.ws, lds, S, F.tid);
#else
            att::att_prime<192, false>(cur, (const char*)F.ws, lds, S, F.tid);
#endif
#endif
            for (;;) {
                const bool more_pass = pass == 0, more_item = id + F.G < NIT, last = !more_pass && !more_item;
                att::Blk nxt = cur; int idn = id, passn = pass + 1;
                if (more_pass) nxt = mla_blk(bh, q1);
                else if (more_item) { idn = id + F.G; passn = 0; mla_decode(idn, bh, q0, q1); nxt = mla_blk(bh, q0); }
#if ATT_DMA_ON
                att::att_block_dma<192, false, false, 3>(cur, nxt, (const char*)F.ws, lds, lds + 3 * att::SHM_V + 3 * att::Cfg<192>::SHM_K, S, F.tid);
#else
#if defined(ATT_CONV) && ATT_CONV == 1
                att::att_block<192, false, false, 0, 1, ATT_ROPE_FLAG>(cur, nxt, (const char*)F.ws, lds, S, F.tid, &X);
#elif defined(ATT_MLA_SK)
                att::att_block<192, false, true, 0, ATT_MLA_SKCONV, ATT_ROPE_FLAG>(cur, nxt, (const char*)F.ws, lds, S, F.tid, &X);
#elif defined(ATT_QROPE)
                att::att_block<192, false, false, 0, 0, true>(cur, nxt, (const char*)F.ws, lds, S, F.tid);
#else
                att::att_block<192, false, false>(cur, nxt, (const char*)F.ws, lds, S, F.tid);
#endif
#endif
                if (last) break;
                cur = nxt; id = idn; pass = passn;
            }
#ifdef ATT_MLA_SK
            { const int ln_ = lane_id(); char* scr_ = lds + att::CONV_SCR + __builtin_amdgcn_readfirstlane(F.tid >> 6) * 4352;
              if (S.cv_pend) { asm volatile("s_waitcnt vmcnt(0)" ::: "memory"); att::conv_put_full(X, S.cv_j, S.cvf, scr_, ln_); ++S.cv_j; if (S.cv_pend > 1) { att::conv_put_full(X, S.cv_j, S.cvf + 16, scr_, ln_); ++S.cv_j; } S.cv_pend = 0; }
              cvj_ = S.cv_j; }
#endif
#if defined(ATT_CONV) && ATT_CONV == 1
            { const int ln_ = lane_id(); char* scr_ = lds + att::CONV_SCR + __builtin_amdgcn_readfirstlane(F.tid >> 6) * 4352;
              while (S.cv_j < att::CONV_NJ) { att::conv_load(X, S.cv_j, S.cv_q, S.cv, ln_); asm volatile("s_waitcnt vmcnt(0)" ::: "memory");
                  att::conv_put(X, S.cv_j, S.cv_q, S.cv, scr_, ln_); if (++S.cv_q == 4) { S.cv_q = 0; ++S.cv_j; } S.cl_j = S.cv_j; S.cl_q = S.cv_q; } }
#endif
        }
#endif
    }
#endif
#ifndef NO_DIL
#ifndef PROBE_REP_DIL
#define PROBE_REP_DIL 1
#endif
#ifndef PROBE_DIL_VAR
#define PROBE_DIL_VAR 0
#endif
#if ATT_DMA_ON == 2 && !defined(ATT_DIL_DMA2)
    asm volatile("s_waitcnt vmcnt(0)" ::: "memory"); __syncthreads();
#endif
    for (int rep_ = 0; rep_ < PROBE_REP_DIL; ++rep_) {
        if (rep_) __syncthreads();
#if ATT_DMA_ON == 2 && defined(ATT_DIL_DMA2)
        { const int wsel_ = __builtin_amdgcn_readfirstlane(F.tid >> 6);
          if (ATT_SKEW_PICK(wsel_)) dil_stream2<0>(F, lds); else dil_stream2<1>(F, lds); }
#else
        if (rep_ + 1 < PROBE_REP_DIL) dil_stream_reg<PROBE_DIL_VAR>(F, lds, rep_, A, l, cvj_); else dil_stream_reg<0>(F, lds, rep_, A, l, cvj_);
#endif
    }
#endif
#ifdef ATT_PRIO
    __builtin_amdgcn_s_setprio(0);
#endif
}
#ifndef MK_PER_PHASE
#define MK_PER_PHASE 0
#endif
constexpr int NPH = 2 + 11 * DEPTH;
__global__ void __launch_bounds__(NWAVES * 64, 2) mk_fwd(Args args) {
    extern __shared__ __attribute__((aligned(16))) unsigned char lds[];
    Frame F;
    F.lds = (LAS unsigned char*)lds; F.ldsg = lds;
    F.wave = __builtin_amdgcn_readfirstlane((int)threadIdx.x >> 6); F.lane = lane_id(); F.tid = F.wave * 64 + F.lane;
    F.G = gridDim.x; { const int bx = blockIdx.x; F.vcu = (F.G % 8 == 0) ? (bx % 8) * (F.G / 8) + bx / 8 : bx; }
    F.ws = args.ws; F.ctl = (unsigned*)(args.ws + WS_CTL);
    for (int u = F.tid; u < (LDS_BYTES - RING_BYTES) / 4; u += NWAVES * 64) ((LAS unsigned*)(F.lds + RING_BYTES))[u] = 0u;
    __syncthreads();
    volatile LAS unsigned* MISC = (volatile LAS unsigned*)(F.lds + L_MISC);
    XcdBarrier bar; bar.bar = F.ctl + CW_BAR; bar.x = 0; bar.st = nullptr;
    if (!MK_PER_PHASE) bar = xcd_barrier_post(F.ctl + CW_BAR, MISC + 8, F.tid);
    const int lo = args.ph_lo, hi = args.ph_hi;
#ifndef PROBE_GRID1_PHASE
#define PROBE_GRID1_PHASE (-1)
#endif
#define PROBE_GRID1(p) ((p) == PROBE_GRID1_PHASE)
#ifndef PROBE_MODE
#define PROBE_MODE 1
#endif
#ifndef PROBE_REP_MASK
#define PROBE_REP_MASK 0
#endif
#define NREP(j) ((((PROBE_REP_MASK) >> (j)) & 1) ? 2 : 1)
#ifndef PROBE_XIN
#define PROBE_XIN 0
#endif
#ifndef PH_MASK
#define PH_MASK 0x1FFF
#endif
#define IN(k) (lo <= (k) && (k) < hi)
#define MSK(j) (((PH_MASK) >> (j)) & 1)
#define FRESH(Fp) Frame Fp = F; { int l_ = lane_id(); int z_ = 0; asm volatile("" : "+v"(l_), "+s"(z_)); Fp.lane = l_; Fp.wave = F.wave + z_; Fp.tid = Fp.wave * 64 + l_; Fp.vcu = F.vcu + z_; Fp.ws = F.ws + z_; Fp.ctl = (unsigned*)(Fp.ws + WS_CTL); }
#define SEAM(k) do { if (IN(k) && IN((k) + 1)) xcd_barrier(bar, F.wave * 64 + lane_id()); } while (0)

    if (MSK(11) && IN(0)) { FRESH(P); phase_prologue(P, args);
#ifdef PROBE_REPEAT_PROLOGUE
        __syncthreads(); phase_prologue(P, args);
#endif
    }
    SEAM(0);
    for (int l = 0; l < DEPTH; ++l) {
        const int pb = 1 + 11 * l;
        const float* mod = (const float*)(F.ws + WS_MOD);
        if (MSK(0) && IN(pb + 0)) { for (int rep_ = 0; rep_ < (l == 0 ? NREP(0) : 1); ++rep_) { if (rep_) __syncthreads(); FRESH(P); phase_norm1(P, args, l); } }
        SEAM(pb + 0);
        if (MSK(1) && IN(pb + 1)) { for (int rep_ = 0; rep_ < NREP(1); ++rep_) { if (rep_) __syncthreads(); FRESH(P);
            pg8::Gemm g{(const bf16*)(P.ws + WS_H), (const bf16*)(P.ws + WS_WIN) + (size_t)l * 4096 * DM, DM * 2};
            pg8::StaticOrder S; S.init(T, PROJ_LD, P.G, (int)blockIdx.x);
            pg8::EpiPlain E{(bf16*)(P.ws + WS_PROJ), PROJ_LD};
            pg8::gemm_phase<pg8::EpiPlain, pg8::StaticOrder, pg8::ALinear>(P.lds, g, S, pg8::ALinear{}, E, P.tid);
        } }
        SEAM(pb + 1);
#ifdef PROBE_EXTRA_BARRIERS
        if (IN(pb + 2)) for (int xb_ = 0; xb_ < PROBE_EXTRA_BARRIERS; ++xb_) xcd_barrier(bar, F.wave * 64 + lane_id());
#endif
        if (MSK(2) && IN(pb + 2)) { for (int rep_ = 0; rep_ < NREP(2); ++rep_) { if (rep_) __syncthreads(); FRESH(P); phase_mla_prep(P, args); } }
        SEAM(pb + 2);
        if (MSK(3) && IN(pb + 3)) { for (int rep_ = 0; rep_ < NREP(3); ++rep_) { if (rep_) __syncthreads(); FRESH(P);
#ifdef PROBE_SWAP_UP
            { pg8::Gemm g{(const bf16*)(P.ws + WS_PROJ) + C_CKV, (const bf16*)(P.ws + WS_WUKV) + (size_t)l * 2048 * 256, 256 * 2};
              pg8::StaticOrder S; S.init(T, 2048, P.G, (int)blockIdx.x);
              pg8::EpiKVup E{(bf16*)(P.ws + WS_KF), (bf16*)(P.ws + WS_VB), (const float*)(P.ws + WS_RSTDKV)};
              pg8::gemm_phase<pg8::EpiKVup, pg8::StaticOrder, pg8::APitch>(P.lds, g, S, pg8::APitch{PROJ_LD * 2}, E, P.tid); }
            { pg8::Gemm g{(const bf16*)(P.ws + WS_PROJ) + C_CQ, (const bf16*)(P.ws + WS_WUQ) + (size_t)l * 1536 * 512, 512 * 2};
              pg8::StaticOrder S; S.init(T, 1536, P.G, (int)blockIdx.x);
              pg8::EpiQup E{(bf16*)(P.ws + WS_QA), (const float*)(P.ws + WS_RSTDQ)};
#ifdef PROBE_QUP_PLAIN
              { pg8::EpiPlain E2{(bf16*)(P.ws + WS_QA), 1536}; pg8::gemm_phase<pg8::EpiPlain, pg8::StaticOrder, pg8::APitch>(P.lds, g, S, pg8::APitch{PROJ_LD * 2}, E2, P.tid); }
#else
              pg8::gemm_phase<pg8::EpiQup, pg8::StaticOrder, pg8::APitch>(P.lds, g, S, pg8::APitch{PROJ_LD * 2}, E, P.tid);
#endif
            }
#else
            { pg8::Gemm g{(const bf16*)(P.ws + WS_PROJ) + C_CQ, (const bf16*)(P.ws + WS_WUQ) + (size_t)l * 1536 * 512, 512 * 2};
              pg8::StaticOrder S; S.init(T, 1536, P.G, (int)blockIdx.x);
              pg8::EpiQup E{(bf16*)(P.ws + WS_QA), (const float*)(P.ws + WS_RSTDQ)};
#ifdef PROBE_QUP_PLAIN
              { pg8::EpiPlain E2{(bf16*)(P.ws + WS_QA), 1536}; pg8::gemm_phase<pg8::EpiPlain, pg8::StaticOrder, pg8::APitch>(P.lds, g, S, pg8::APitch{PROJ_LD * 2}, E2, P.tid); }
#else
              pg8::gemm_phase<pg8::EpiQup, pg8::StaticOrder, pg8::APitch>(P.lds, g, S, pg8::APitch{PROJ_LD * 2}, E, P.tid);
#endif
            }
            { pg8::Gemm g{(const bf16*)(P.ws + WS_PROJ) + C_CKV, (const bf16*)(P.ws + WS_WUKV) + (size_t)l * 2048 * 256, 256 * 2};
              pg8::StaticOrder S; S.init(T, 2048, P.G, (int)blockIdx.x);
              pg8::EpiKVup E{(bf16*)(P.ws + WS_KF), (bf16*)(P.ws + WS_VB), (const float*)(P.ws + WS_RSTDKV)};
              pg8::gemm_phase<pg8::EpiKVup, pg8::StaticOrder, pg8::APitch>(P.lds, g, S, pg8::APitch{PROJ_LD * 2}, E, P.tid); }
#endif
        } }
        SEAM(pb + 3);
#ifndef ATT_QROPE
        if (MSK(4) && IN(pb + 4)) { FRESH(P); phase_q_rope(P, args); }
        SEAM(pb + 4);
#endif
        if (MSK(5) && IN(pb + 5)) { FRESH(P); phase_attention(P, (char*)lds, args, l);
#ifdef PROBE_REPEAT_ATT
            __syncthreads(); phase_attention(P, (char*)lds, args, l);
#endif
        }
        SEAM(pb + 5);
        if (MSK(6) && IN(pb + 6)) { for (int rep_ = 0; rep_ < NREP(6); ++rep_) { if (rep_) __syncthreads(); FRESH(P); phase_out_norm(P, args, l); } }
        SEAM(pb + 6);
        if (MSK(7) && IN(pb + 7)) { FRESH(P);
#ifdef G3_FP8
            pg8::Gemm g{P.ws + WS_H, P.ws + WS_WOUT + (size_t)l * DM * DM, DM};
            pg8::StaticOrder S; S.init(T, DM, P.G, (int)blockIdx.x);
#ifdef XRES_BF16
            pg8::EpiResidB E{l == 0 ? (const void*)args.in[I_X] : (const void*)(P.ws + WS_XB), (bf16*)(P.ws + WS_XB), mod + (size_t)l * 4 * 12288 + 2 * DM, 12288, 1.0f / 256.0f, l == 0 ? 1 : 0};
            pg8::gemm_phase<pg8::EpiResidB, pg8::StaticOrder, pg8::ALinear, true>(P.lds, g, S, pg8::ALinear{}, E, P.tid);
#else
            pg8::EpiResid E{l == 0 ? args.in[I_X] : args.out, args.out, mod + (size_t)l * 4 * 12288 + 2 * DM, DM, 12288, 1.0f / 256.0f};
            pg8::gemm_phase<pg8::EpiResid, pg8::StaticOrder, pg8::ALinear, true>(P.lds, g, S, pg8::ALinear{}, E, P.tid);
#endif
#elif defined(XRES_BF16)
            pg8::Gemm g{(const bf16*)(P.ws + WS_H), (const bf16*)(P.ws + WS_WOUT) + (size_t)l * DM * DM, DM * 2};
            pg8::StaticOrder S; S.init(T, DM, P.G, (int)blockIdx.x);
            pg8::EpiResidB E{l == 0 ? (const void*)args.in[I_X] : (const void*)(P.ws + WS_XB), (bf16*)(P.ws + WS_XB), mod + (size_t)l * 4 * 12288 + 2 * DM, 12288, 1.0f, l == 0 ? 1 : 0};
            pg8::gemm_phase<pg8::EpiResidB, pg8::StaticOrder, pg8::ALinear>(P.lds, g, S, pg8::ALinear{}, E, P.tid);
#else
            pg8::Gemm g{(const bf16*)(P.ws + WS_H), (const bf16*)(P.ws + WS_WOUT) + (size_t)l * DM * DM, DM * 2};
            pg8::StaticOrder S; S.init(T, DM, P.G, (int)blockIdx.x);
            pg8::EpiResid E{l == 0 ? args.in[I_X] : args.out, args.out, mod + (size_t)l * 4 * 12288 + 2 * DM, DM, 12288, 1.0f};
            pg8::gemm_phase<pg8::EpiResid, pg8::StaticOrder, pg8::ALinear>(P.lds, g, S, pg8::ALinear{}, E, P.tid);
#endif
        }
        SEAM(pb + 7);
        if (MSK(8) && IN(pb + 8)) { FRESH(P); phase_router(P, args, l);
#ifdef PROBE_REPEAT_ROUTER
            __syncthreads(); phase_router(P, args, l, 1);
#endif
        }
        SEAM(pb + 8);
        if (MSK(9) && IN(pb + 9)) { for (int rep_ = 0; rep_ < NREP(9); ++rep_) { if (rep_) __syncthreads(); FRESH(P);
            const int NT = moe_setup(P, l);
            pg8::MoeOrder S{NT, 8, P.G, (int)blockIdx.x, (const LAS int*)(P.lds + L_TS)};
            LAS unsigned* atab = (LAS unsigned*)(P.lds + L_ATAB); const int* rowidx = (const int*)(P.ws + WS_ROWIDX);
#pragma unroll 1
            for (int slot = 0; slot < MAXU; ++slot) { pg8::Unit u; if (!S.next(slot, u)) break;
                if (P.tid < 256) { const int lr = u.lt * 256 + P.tid; const int ce = (int)P.ctl[CW_CNT + l * 16 + u.e];
                    int tok = lr < ce ? (rowidx[(size_t)u.e * 32768 + lr] >> 1) : 0;
#ifdef PROBE_LINEAR_ATAB
                    tok = (int)(((unsigned)(u.pm * 256 + P.tid) * 2654435761u) >> 17) & 32767;
#endif
 atab[slot * 256 + P.tid] = (unsigned)tok * (unsigned)DM; } }
            __syncthreads();
            pg8::Gemm g{P.ws + WS_H, P.ws + WS_W13, DM};
            pg8::EpiSwiglu E{P.ws + WS_HMID, DEXP};
            pg8::gemm_phase<pg8::EpiSwiglu, pg8::MoeOrder, pg8::ATable, true>(P.lds, g, S, pg8::ATable{atab}, E, P.tid);
        } }
        SEAM(pb + 9);
        if (MSK(10) && IN(pb + 10)) { for (int rep_ = 0; rep_ < NREP(10); ++rep_) { if (rep_) __syncthreads(); FRESH(P);
            const int NT = moe_setup(P, l);
            pg8::MoeOrder S{NT, 8, P.G, (int)blockIdx.x, (const LAS int*)(P.lds + L_TS)};
            pg8::Gemm g{P.ws + WS_HMID, P.ws + WS_W2, DEXP};
            pg8::EpiMoeDown E{(bf16*)(P.ws + WS_Y), (const int*)(P.ws + WS_ROWIDX), (const float*)(P.ws + WS_AW), P.ctl + CW_CNT + l * 16};
            pg8::gemm_phase<pg8::EpiMoeDown, pg8::MoeOrder, pg8::ALinear, true>(P.lds, g, S, pg8::ALinear{}, E, P.tid);
        } }
        SEAM(pb + 10);
    }
    #ifdef PROBE_DUMP_OFF
    if (MSK(12) && IN(NPH - 1)) { FRESH(P); phase_dump(P, args, (size_t)(PROBE_DUMP_OFF), PROBE_DUMP_PITCH); }
#else
    if (MSK(12) && IN(NPH - 1)) { FRESH(P); phase_final(P, args, args.li != 0 ? (PROBE_XIN ? 2 : PROBE_MODE) : 0);
#ifdef PROBE_EXACT
        { const int gw = P.vcu * NWAVES + P.wave, NGW = P.G * NWAVES; __syncthreads();
          for (int ch = gw; ch < T / 16; ch += NGW) for (int rr = 0; rr < 16; ++rr) for (int j = 0; j < 8; ++j) { float* p = args.out + (size_t)(ch * 16 + rr) * DM + 4 * P.lane + 256 * j; asm volatile("s_waitcnt vmcnt(0)" ::: "memory");
              const v4u ub = *(const v4u*)p; *(f32x4*)p = (f32x4){(float)(ub.x & 0xFFFu), (float)(ub.y & 0xFFFu), (float)(ub.z & 0xFFFu), (float)(ub.w & 0xFFFu)}; } }
#endif
    }
#endif
#undef IN
#undef SEAM
}

extern "C" void kernel_launch(void* const* d_in, const int* in_sizes, int n_in, void* d_out, int out_size, void* d_ws, size_t ws_size, hipStream_t stream) {
    static int grid = 0;
    if (grid == 0) {
        if (n_in != 20 || in_sizes[0] != T * DM || out_size != T * DM || ws_size < WS_END) {
            fprintf(stderr, "kernel_launch: unexpected problem (n_in %d, in0 %d, out %d, ws %zu < %zu)\n", n_in, n_in > 0 ? in_sizes[0] : -1, out_size, ws_size, (size_t)WS_END); grid = -1; return; }
        int dev = 0, cus = 0;
        if (hipGetDevice(&dev) != hipSuccess || hipDeviceGetAttribute(&cus, hipDeviceAttributeMultiprocessorCount, dev) != hipSuccess) { grid = -1; return; }
        if (hipFuncSetAttribute((const void*)mk_fwd, hipFuncAttributeMaxDynamicSharedMemorySize, LDS_BYTES) != hipSuccess) { fprintf(stderr, "kernel_launch: hipFuncSetAttribute failed\n"); grid = -1; return; }
        int per_cu = 0;
        if (hipOccupancyMaxActiveBlocksPerMultiprocessor(&per_cu, (const void*)mk_fwd, NWAVES * 64, LDS_BYTES) != hipSuccess || per_cu < 1) fprintf(stderr, "kernel_launch: occupancy query says %d blocks per CU\n", per_cu);
        (void)hipGetLastError();
        grid = cus;
        if (grid != 256) fprintf(stderr, "kernel_launch: %d CUs (built for 256)\n", grid);
    }
    if (grid < 0) return;
    if (hipMemsetAsync((char*)d_ws + WS_CTL, 0, CTL_ZERO_BYTES, stream) != hipSuccess) return;
    Args a; memset(&a, 0, sizeof(a));
    for (int i = 0; i < 20; ++i) a.in[i] = (const float*)d_in[i];
    a.out = (float*)d_out; a.ws = (unsigned char*)d_ws;
    for (int i = 0; i < 32; ++i) a.invf[i] = (float)pow(10000.0, -(double)i / 32.0);
#if MK_PER_PHASE
#ifndef PROBE_LAST
#define PROBE_LAST (NPH - 2)
#endif
    for (int p = 0; p < NPH; ++p) { if (p > PROBE_LAST && p != NPH - 1) continue;
#ifdef PROBE_ONLY_MASK
        if (p != NPH - 1 && !((PROBE_ONLY_MASK >> p) & 1)) continue;
#endif
 a.ph_lo = p; a.ph_hi = p + 1; a.li = (PROBE_LAST != NPH - 2) ? 1 : 0; hipLaunchKernelGGL(mk_fwd, dim3(PROBE_GRID1(p) ? 1 : grid), dim3(NWAVES * 64), LDS_BYTES, stream, a); }
#else
    a.ph_lo = 0; a.ph_hi = NPH; a.li = 0;
    hipLaunchKernelGGL(mk_fwd, dim3(grid), dim3(NWAVES * 64), LDS_BYTES, stream, a);
#endif
    const hipError_t le = hipPeekAtLastError();
    if (le != hipSuccess) fprintf(stderr, "kernel_launch: launch failed: %s\n", hipGetErrorName(le));
}
```
